# Optimizing an MI355X kernel written in HIP

```python
import math
import jax, jax.numpy as jnp
from jax import lax
import numpy as np

D_MODEL = 1024
BATCH = 4
SEQ = 4096
DEPTH = 2

GRID_W = 64
CTX_LEN = 256
RMS_EPS = 1e-6

SSD_HEAD_DIM = 64
SSD_WIDTH = D_MODEL
SSD_HEADS = SSD_WIDTH // SSD_HEAD_DIM
SSD_GROUPS = 2
SSD_STATE = 128
SSD_CONV = 3
SSD_CHUNK = 128
SSD_XBC = SSD_WIDTH + 2 * SSD_GROUPS * SSD_STATE

POOL_WINDOWS = (2, 4, 8, 16)
POOL_WIDTH = D_MODEL // 2
POOL_GROUP_DIM = POOL_WIDTH // len(POOL_WINDOWS)

NA_HEAD_DIM = 64
NA_WIDTH = D_MODEL // 2
NA_HEADS = NA_WIDTH // NA_HEAD_DIM
NA_KH = 8
NA_KW = 16

MIX_WIDTH = SSD_WIDTH + POOL_WIDTH + NA_WIDTH
IN_WIDTH = SSD_WIDTH + SSD_XBC + 2 * SSD_HEADS + POOL_WIDTH + 3 * NA_WIDTH

PEER_HEADS = 8
PEER_NKEYS = 128
PEER_EXPERTS = PEER_NKEYS * PEER_NKEYS
PEER_QDIM = 256
PEER_TOPK = 16
PEER_BLOCK = 128

kernel_name = 'hybrid_ssd_pool_natten_peer_dit'


def rmsnorm(x, g):
    x32 = x.astype(jnp.float32)
    ms = jnp.mean(x32 * x32, axis=-1, keepdims=True)
    return (x32 * lax.rsqrt(ms + RMS_EPS)).astype(x.dtype) * g


def project(h, shift, scale, g, w_in):
    u = rmsnorm(h, g) * (1 + scale) + shift
    p = u @ w_in
    sizes = (SSD_WIDTH, SSD_XBC, 2 * SSD_HEADS, POOL_WIDTH, NA_WIDTH, NA_WIDTH, NA_WIDTH)
    points = [int(v) for v in np.cumsum(sizes)[:-1]]
    return jnp.split(p, points, axis=-1)


def to_heads(t):
    return t.reshape(t.shape[:-1] + (NA_HEADS, NA_HEAD_DIM))


def dwconv(x, w, b):
    k, ch = w.shape
    y = lax.conv_general_dilated(x, w[:, None, :].astype(x.dtype), window_strides=(1,),
                                 padding=[(k // 2, k // 2)], dimension_numbers=('NWC', 'WIO', 'NWC'),
                                 feature_group_count=ch)
    return y + b


def segsum(a):
    t = a.shape[-1]
    cs = jnp.cumsum(a, axis=-1)
    diff = cs[..., :, None] - cs[..., None, :]
    mask = jnp.tril(jnp.ones((t, t), dtype=bool))
    return jnp.where(mask, diff, -jnp.inf)


def ssd_chunked(x, dt, a_head, bm, cm, init, with_y):
    b, l, h, p = x.shape
    n = bm.shape[-1]
    nc = l // SSD_CHUNK
    xd = (x * dt[..., None]).reshape(b, nc, SSD_CHUNK, h, p)
    a = jnp.moveaxis((dt * a_head).reshape(b, nc, SSD_CHUNK, h), -1, 1)
    bc = bm.reshape(b, nc, SSD_CHUNK, h, n)
    a_cs = jnp.cumsum(a, axis=-1)
    decay_to_end = jnp.exp(a_cs[..., -1:] - a_cs)
    chunk_states = jnp.einsum('bclhn,bhcl,bclhp->bchpn', bc, decay_to_end, xd)
    states = jnp.concatenate([init[:, None], chunk_states], axis=1)
    chunk_decay = jnp.exp(segsum(jnp.pad(a_cs[..., -1], ((0, 0), (0, 0), (1, 0)))))
    states = jnp.einsum('bhzc,bchpn->bzhpn', chunk_decay, states)
    final = states[:, -1]
    if not with_y:
        return None, final
    cc = cm.reshape(b, nc, SSD_CHUNK, h, n)
    lmat = jnp.exp(segsum(a))
    cb = jnp.einsum('bclhn,bcshn->bhcls', cc, bc)
    y_diag = jnp.einsum('bhcls,bcshp->bclhp', cb * lmat, xd)
    in_decay = jnp.exp(a_cs).transpose(0, 2, 3, 1)[..., None]
    y_off = jnp.einsum('bclhn,bchpn->bclhp', cc, states[:, :-1]) * in_decay
    return (y_diag + y_off).reshape(b, l, h, p), final


def ssd_mixer(z, xbc_raw, dt_raw, conv_w, conv_b, a_log, dt_bias, d_skip, norm_g, init_f, init_b, with_y):
    xbc = jax.nn.silu(dwconv(xbc_raw, conv_w, conv_b))
    b, l, _ = xbc.shape
    gs = SSD_GROUPS * SSD_STATE
    xs = xbc[..., :SSD_WIDTH].reshape(b, l, SSD_HEADS, SSD_HEAD_DIM).astype(jnp.float32)
    hpg = SSD_HEADS // SSD_GROUPS
    bm = jnp.repeat(xbc[..., SSD_WIDTH:SSD_WIDTH + gs].reshape(b, l, SSD_GROUPS, SSD_STATE), hpg, axis=2).astype(jnp.float32)
    cm = jnp.repeat(xbc[..., SSD_WIDTH + gs:].reshape(b, l, SSD_GROUPS, SSD_STATE), hpg, axis=2).astype(jnp.float32)
    dt = jax.nn.softplus(dt_raw.astype(jnp.float32).reshape(b, l, 2, SSD_HEADS) + dt_bias.astype(jnp.float32))
    a_head = -jnp.exp(a_log.astype(jnp.float32))
    if init_f is None:
        init_f = jnp.zeros((b, SSD_HEADS, SSD_HEAD_DIM, SSD_STATE), jnp.float32)
        init_b = init_f
    flip = lambda t: jnp.flip(t, axis=1)
    y_f, s_f = ssd_chunked(xs, dt[:, :, 0], a_head[0], bm, cm, init_f, with_y)
    y_b, s_b = ssd_chunked(flip(xs), flip(dt[:, :, 1]), a_head[1], flip(bm), flip(cm), init_b, with_y)
    if not with_y:
        return None, s_f, s_b
    y = y_f + flip(y_b) + d_skip.astype(jnp.float32)[:, None] * xs
    y = y.reshape(b, l, SSD_WIDTH) * jax.nn.silu(z.astype(jnp.float32))
    return rmsnorm(y, norm_g).astype(z.dtype), s_f, s_b


def pool_mixer(u, w_pool, scale):
    b, l, _ = u.shape
    t = jnp.arange(l)
    cs = jnp.pad(jnp.cumsum(u.astype(jnp.float32), axis=1), ((0, 0), (1, 0), (0, 0)))
    outs = []
    for gi, w in enumerate(POOL_WINDOWS):
        sl = slice(gi * POOL_GROUP_DIM, (gi + 1) * POOL_GROUP_DIM)
        lo = jnp.clip(t - w // 2, 0, l - 1)
        hi = jnp.clip(t + w - w // 2 - 1, 0, l - 1)
        seg = cs[..., sl]
        cnt = (hi - lo + 1).astype(jnp.float32)[:, None]
        mean = (jnp.take(seg, hi + 1, axis=1) - jnp.take(seg, lo, axis=1)) / cnt
        outs.append(mean - u[..., sl].astype(jnp.float32))
    pooled = jnp.stack(outs, axis=2)
    y = jnp.einsum('blgi,gio->blgo', pooled, w_pool).reshape(b, l, POOL_WIDTH)
    return (y * scale).astype(u.dtype)


def context_attention(q, k, v):
    b, l, h, d = q.shape
    s = jnp.einsum('bqhd,bkhd->bhqk', q * (d ** -0.5), k).astype(jnp.float32)
    p = jax.nn.softmax(s, axis=-1).astype(v.dtype)
    return jnp.einsum('bhqk,bkhd->bqhd', p, v).reshape(b, l, h * d)


def neighbourhood_attention(q, k, v, k_ctx, v_ctx, rpb):
    b, s, h, d = q.shape
    rows = s // GRID_W
    kh = min(NA_KH, rows)
    qg = (q * (d ** -0.5)).reshape(b, rows, GRID_W, h, d)
    kg = k.reshape(b, rows, GRID_W, h, d)
    vg = v.reshape(b, rows, GRID_W, h, d)
    row_start = jnp.clip(jnp.arange(rows) - kh // 2, 0, rows - kh)
    col = jnp.arange(GRID_W)
    col_start = jnp.clip(col - NA_KW // 2, 0, GRID_W - NA_KW)
    in_window = (col[None, :] >= col_start[:, None]) & (col[None, :] < col_start[:, None] + NA_KW)
    dc = jnp.clip(col[None, :] - col[:, None], -(NA_KW - 1), NA_KW - 1) + NA_KW - 1
    col_bias = jnp.where(in_window[None, None], rpb[:, :, dc].astype(jnp.float32), -jnp.inf)

    def row_block(args):
        q_row, r0, r = args
        k_blk = lax.dynamic_slice_in_dim(kg, r0, kh, axis=1)
        v_blk = lax.dynamic_slice_in_dim(vg, r0, kh, axis=1)
        dr = r0 + jnp.arange(kh) - r + NA_KH - 1
        bias = jnp.take(col_bias, dr, axis=1).transpose(0, 2, 1, 3)
        s_loc = jnp.einsum('bqhd,bkwhd->bhqkw', q_row, k_blk).astype(jnp.float32) + bias[None]
        s_ctx = jnp.einsum('bqhd,bchd->bhqc', q_row, k_ctx).astype(jnp.float32)
        s_all = jnp.concatenate([s_loc.reshape(b, h, GRID_W, kh * GRID_W), s_ctx], axis=-1)
        p = jax.nn.softmax(s_all, axis=-1).astype(v.dtype)
        p_loc = p[..., :kh * GRID_W].reshape(b, h, GRID_W, kh, GRID_W)
        return (jnp.einsum('bhqkw,bkwhd->bqhd', p_loc, v_blk)
                + jnp.einsum('bhqc,bchd->bqhd', p[..., kh * GRID_W:], v_ctx))

    out = lax.map(row_block, (jnp.moveaxis(qg, 1, 0), row_start, jnp.arange(rows)))
    return jnp.moveaxis(out, 0, 1).reshape(b, s, h * d)


def peer_ffn(u, w_q, sub_keys, u_tab, v_tab):
    b, l, dm = u.shape
    t = u.reshape(b * l, dm)
    n_tok = b * l
    q = (t @ w_q).reshape(n_tok, PEER_HEADS, 2, PEER_QDIM // 2)
    s = jnp.einsum('thid,hikd->thik', q, sub_keys).astype(jnp.float32)
    v1, i1 = lax.top_k(s[:, :, 0], PEER_TOPK)
    v2, i2 = lax.top_k(s[:, :, 1], PEER_TOPK)
    cand = (v1[..., :, None] + v2[..., None, :]).reshape(n_tok, PEER_HEADS, PEER_TOPK * PEER_TOPK)
    cand_idx = (i1[..., :, None] * PEER_NKEYS + i2[..., None, :]).reshape(n_tok, PEER_HEADS, PEER_TOPK * PEER_TOPK)
    top_s, pos = lax.top_k(cand, PEER_TOPK)
    idx = jnp.take_along_axis(cand_idx, pos, axis=-1).reshape(n_tok, PEER_HEADS * PEER_TOPK)
    g = jax.nn.softmax(top_s, axis=-1).astype(u.dtype).reshape(n_tok, PEER_HEADS * PEER_TOPK)
    nb = n_tok // PEER_BLOCK

    def block(args):
        xb, ib, gb = args
        act = jax.nn.gelu(jnp.einsum('tkd,td->tk', jnp.take(u_tab, ib, axis=0), xb), approximate=False)
        return jnp.einsum('tk,tkd->td', gb * act, jnp.take(v_tab, ib, axis=0))

    out = lax.map(block, (t.reshape(nb, PEER_BLOCK, dm), idx.reshape(nb, PEER_BLOCK, -1), g.reshape(nb, PEER_BLOCK, -1)))
    return out.reshape(b, l, dm)


def setup_inputs(seed: int = 0) -> dict:
    key = jax.random.key(seed)
    ks = jax.random.split(key, 24)
    L, D = DEPTH, D_MODEL
    nrm = lambda k, shape, s: jax.random.normal(k, shape, jnp.float32) * s
    dt0 = jnp.exp(jax.random.uniform(ks[9], (L, 2, SSD_HEADS), jnp.float32, math.log(1e-3), math.log(1e-1)))
    dt_bias = dt0 + jnp.log(-jnp.expm1(-dt0))
    return {
        'x': nrm(ks[0], (BATCH, SEQ, D), 1.0),
        'c': nrm(ks[1], (BATCH, D), 1.0),
        'ctx': nrm(ks[2], (BATCH, CTX_LEN, D), 1.0),
        'c_ctx': nrm(ks[3], (D,), 0.5),
        'ada_w': nrm(ks[4], (L, D, 6 * D), 0.5 * D ** -0.5),
        'ada_b': nrm(ks[5], (L, 6 * D), 0.01),
        'norm1_g': 1.0 + nrm(ks[6], (L, D), 0.01),
        'w_in': nrm(ks[7], (L, D, IN_WIDTH), D ** -0.5),
        'conv_w': nrm(ks[8], (L, SSD_CONV, SSD_XBC), SSD_CONV ** -0.5),
        'conv_b': nrm(ks[10], (L, SSD_XBC), 0.01),
        'a_log': jnp.log(jax.random.uniform(ks[11], (L, 2, SSD_HEADS), jnp.float32, 1.0, 16.0)),
        'dt_bias': dt_bias,
        'd_skip': 1.0 + nrm(ks[12], (L, SSD_HEADS), 0.1),
        'ssd_norm_g': 1.0 + nrm(ks[13], (L, SSD_WIDTH), 0.01),
        'pool_w': nrm(ks[14], (L, len(POOL_WINDOWS), POOL_GROUP_DIM, POOL_GROUP_DIM), POOL_GROUP_DIM ** -0.5),
        'pool_scale': 1.0 + nrm(ks[15], (L, POOL_WIDTH), 0.1),
        'na_rpb': nrm(ks[16], (L, NA_HEADS, 2 * NA_KH - 1, 2 * NA_KW - 1), 0.02),
        'w_out': nrm(ks[17], (L, MIX_WIDTH, D), MIX_WIDTH ** -0.5),
        'norm2_g': 1.0 + nrm(ks[18], (L, D), 0.01),
        'peer_wq': nrm(ks[19], (L, D, PEER_HEADS * PEER_QDIM), D ** -0.5),
        'peer_keys': nrm(ks[20], (L, PEER_HEADS, 2, PEER_NKEYS, PEER_QDIM // 2), (PEER_QDIM // 2) ** -0.5),
        'peer_u': nrm(ks[21], (L, PEER_EXPERTS, D), D ** -0.5),
        'peer_v': nrm(ks[22], (L, PEER_EXPERTS, D), PEER_TOPK ** -0.5),
        'final_g': 1.0 + nrm(ks[23], (D,), 0.01),
    }


def reference(x, c, ctx, c_ctx, ada_w, ada_b, norm1_g, w_in, conv_w, conv_b, a_log, dt_bias, d_skip,
              ssd_norm_g, pool_w, pool_scale, na_rpb, w_out, norm2_g, peer_wq, peer_keys, peer_u, peer_v, final_g):
    h, hc = x, ctx
    for i in range(DEPTH):
        need_ctx_out = i < DEPTH - 1
        mod = jax.nn.silu(c) @ ada_w[i] + ada_b[i]
        sh1, sc1, g1, sh2, sc2, g2 = jnp.split(mod[:, None, :], 6, axis=-1)
        mod_c = jax.nn.silu(c_ctx) @ ada_w[i] + ada_b[i]
        csh1, csc1, cg1, csh2, csc2, cg2 = jnp.split(mod_c, 6, axis=-1)
        ssd_args = (conv_w[i], conv_b[i], a_log[i], dt_bias[i], d_skip[i], ssd_norm_g[i])

        zc, xbcc, dtc, poolc, qc, kc, vc = project(hc, csh1, csc1, norm1_g[i], w_in[i])
        kc, vc = to_heads(kc), to_heads(vc)
        ssd_c, st_f, st_b = ssd_mixer(zc, xbcc, dtc, *ssd_args, None, None, need_ctx_out)
        if need_ctx_out:
            mix_c = jnp.concatenate([ssd_c, pool_mixer(poolc, pool_w[i], pool_scale[i]),
                                     context_attention(to_heads(qc), kc, vc)], axis=-1) @ w_out[i]
            hc = hc + cg1 * mix_c
            uc = rmsnorm(hc, norm2_g[i]) * (1 + csc2) + csh2
            hc = hc + cg2 * peer_ffn(uc, peer_wq[i], peer_keys[i], peer_u[i], peer_v[i])

        z, xbc, dtr, pl, q, k, v = project(h, sh1, sc1, norm1_g[i], w_in[i])
        ssd_l, _, _ = ssd_mixer(z, xbc, dtr, *ssd_args, st_f, st_b, True)
        na = neighbourhood_attention(to_heads(q), to_heads(k), to_heads(v), kc, vc, na_rpb[i])
        mix = jnp.concatenate([ssd_l, pool_mixer(pl, pool_w[i], pool_scale[i]), na], axis=-1) @ w_out[i]
        h = h + g1 * mix
        u = rmsnorm(h, norm2_g[i]) * (1 + sc2) + sh2
        h = h + g2 * peer_ffn(u, peer_wq[i], peer_keys[i], peer_u[i], peer_v[i])
    return rmsnorm(h, final_g)
```

```cpp
#include <hip/hip_runtime.h>
#include <hip/hip_bf16.h>
#include <stdint.h>
#include <stdio.h>

typedef unsigned short bf16_t;
typedef __attribute__((ext_vector_type(8))) short bf16x8;
typedef __attribute__((ext_vector_type(4))) float f32x4;

#define NTHR 256
constexpr int DM = 1024;
constexpr int SEQ = 4096;
constexpr int NLAT = 16384;
constexpr int NCTXR = 1024;
constexpr int NTOK = 17408;
constexpr int INW = 4640;
constexpr int INW_PAD = 4736;
constexpr int OFF_Z = 0, OFF_XBC = 1024, OFF_DT = 2560, OFF_POOL = 2592, OFF_Q = 3104, OFF_K = 3616, OFF_V = 4128;
constexpr int NCHUNK = 136;
constexpr int MODW = 6144;

struct Params {
  const float *x, *c, *ctx, *c_ctx, *ada_w, *ada_b, *norm1_g, *w_in, *conv_w, *conv_b, *a_log, *dt_bias, *d_skip,
      *ssd_norm_g, *pool_w, *pool_scale, *na_rpb, *w_out, *norm2_g, *peer_wq, *peer_keys, *peer_u, *peer_v, *final_g;
  float* out;
  float* mod;
  float* h;
  bf16_t* u;
  bf16_t* p;
  float* dtraw;
  float* dtv;
  float* csv;
  bf16_t* xbc;
  bf16_t* states;
  bf16_t* concat;
  bf16_t* q;
  int* sel_idx;
  float* sel_g;
  bf16_t* w_inT;
  bf16_t* w_outT;
  bf16_t* w_qT;
};

__device__ __forceinline__ float bf2f(bf16_t v) { return __uint_as_float(((uint32_t)v) << 16); }
__device__ __forceinline__ bf16_t f2bf(float f) {
  uint32_t u = __float_as_uint(f);
  u += 0x7fffu + ((u >> 16) & 1u);
  return (bf16_t)(u >> 16);
}
__device__ __forceinline__ float wave_sum(float v) {
#pragma unroll
  for (int o = 32; o > 0; o >>= 1) v += __shfl_xor(v, o, 64);
  return v;
}
__device__ __forceinline__ float wave_max(float v) {
#pragma unroll
  for (int o = 32; o > 0; o >>= 1) v = fmaxf(v, __shfl_xor(v, o, 64));
  return v;
}
__device__ __forceinline__ float silu_f(float v) { return v / (1.f + expf(-v)); }
__device__ __forceinline__ float softplus_f(float v) { return fmaxf(v, 0.f) + log1pf(expf(-fabsf(v))); }
__device__ __forceinline__ float gelu_f(float v) { return 0.5f * v * (1.f + erff(v * 0.70710678118654752f)); }

__device__ __forceinline__ const float* hrow(const float* hl, const float* hc, int row) {
  return row < NLAT ? hl + (size_t)row * DM : hc + (size_t)(row - NLAT) * DM;
}
__device__ __forceinline__ int modrow(int row) { return row < NLAT ? (row >> 12) : 4; }

__device__ void ph_transpose(const float* __restrict__ src, bf16_t* __restrict__ dst, int K, int N, int Npad,
                             float* tile, int bid, int nb) {
  const int tk = K / 32, tn = Npad / 32;
  const int tx = threadIdx.x & 31, ty = threadIdx.x >> 5;
  for (int t = bid; t < tk * tn; t += nb) {
    const int kt = t / tn, nt = t % tn;
    __syncthreads();
    for (int i = ty; i < 32; i += 8) {
      const int k = kt * 32 + i, n = nt * 32 + tx;
      tile[i * 33 + tx] = (n < N) ? src[(size_t)k * N + n] : 0.f;
    }
    __syncthreads();
    for (int i = ty; i < 32; i += 8) {
      const int n = nt * 32 + i, k = kt * 32 + tx;
      dst[(size_t)n * K + k] = f2bf(tile[tx * 33 + i]);
    }
  }
}

__device__ void ph_mod(const Params& P, float* sm, int bid, int nb) {
  const int tid = threadIdx.x;
  float* sv = sm;
  float* red = sm + 5 * 1024;
  for (int i = tid; i < 5 * 1024; i += NTHR) {
    const float v = (i < 4096) ? P.c[i] : P.c_ctx[i - 4096];
    sv[i] = silu_f(v);
  }
  __syncthreads();
  const int col = tid & 31, kg = tid >> 5;
  for (int it = bid; it < 384; it += nb) {
    const int layer = it / 192, cb = it % 192;
    const float* W = P.ada_w + (size_t)layer * 1024 * MODW + cb * 32 + col;
    float a0 = 0, a1 = 0, a2 = 0, a3 = 0, a4 = 0;
    for (int k = kg * 128; k < kg * 128 + 128; ++k) {
      const float w = W[(size_t)k * MODW];
      a0 += sv[k] * w; a1 += sv[1024 + k] * w; a2 += sv[2048 + k] * w; a3 += sv[3072 + k] * w; a4 += sv[4096 + k] * w;
    }
    float* r = red + (kg * 32 + col) * 5;
    r[0] = a0; r[1] = a1; r[2] = a2; r[3] = a3; r[4] = a4;
    __syncthreads();
    if (tid < 160) {
      const int rr = tid >> 5, cc = tid & 31;
      float s = 0;
      for (int g = 0; g < 8; ++g) s += red[(g * 32 + cc) * 5 + rr];
      P.mod[(size_t)(layer * 5 + rr) * MODW + cb * 32 + cc] = s + P.ada_b[layer * MODW + cb * 32 + cc];
    }
    __syncthreads();
  }
}

__device__ void ph_norm(const float* hl, const float* hc, const float* __restrict__ g, const float* __restrict__ modl,
                        int shift_off, int scale_off, int nrows, bf16_t* __restrict__ dst, int bid, int nb) {
  const int wave = threadIdx.x >> 6, lane = threadIdx.x & 63;
  for (int row = bid * 4 + wave; row < nrows; row += nb * 4) {
    const float* src = hrow(hl, hc, row);
    const float* mr = modl + (size_t)modrow(row) * MODW;
    float4 v[4];
    float ss = 0.f;
#pragma unroll
    for (int i = 0; i < 4; ++i) {
      v[i] = ((const float4*)src)[i * 64 + lane];
      ss += v[i].x * v[i].x + v[i].y * v[i].y + v[i].z * v[i].z + v[i].w * v[i].w;
    }
    ss = wave_sum(ss);
    const float rstd = rsqrtf(ss * (1.f / 1024.f) + 1e-6f);
#pragma unroll
    for (int i = 0; i < 4; ++i) {
      const int idx = i * 256 + lane * 4;
      const float4 gg = *(const float4*)(g + idx);
      const float4 sc = *(const float4*)(mr + scale_off + idx);
      const float4 sh = *(const float4*)(mr + shift_off + idx);
      const float o0 = v[i].x * rstd * gg.x * (1.f + sc.x) + sh.x;
      const float o1 = v[i].y * rstd * gg.y * (1.f + sc.y) + sh.y;
      const float o2 = v[i].z * rstd * gg.z * (1.f + sc.z) + sh.z;
      const float o3 = v[i].w * rstd * gg.w * (1.f + sc.w) + sh.w;
      uint2 pk;
      pk.x = (uint32_t)f2bf(o0) | ((uint32_t)f2bf(o1) << 16);
      pk.y = (uint32_t)f2bf(o2) | ((uint32_t)f2bf(o3) << 16);
      *(uint2*)(dst + (size_t)row * DM + idx) = pk;
    }
  }
}

enum { EPI_INPROJ = 0, EPI_OUTPROJ = 1, EPI_Q = 2 };

template <int EPI>
__device__ void ph_gemm(const Params& P, int layer, const bf16_t* __restrict__ A, const bf16_t* __restrict__ Bt, int M,
                        int Npad, int K, const float* hl, const float* hc, char* smem, int bid, int nb) {
  bf16_t* sA = (bf16_t*)smem;
  bf16_t* sB = sA + 128 * 72;
  const int tid = threadIdx.x, lane = tid & 63, wave = tid >> 6;
  const int wr = wave >> 1, wc = wave & 1;
  const int tiles_m = M / 128, tiles_n = Npad / 128;
  const int l15 = lane & 15, l4 = lane >> 4;
  for (int tile = bid; tile < tiles_m * tiles_n; tile += nb) {
    const int tn = tile / tiles_m, tm = tile % tiles_m;
    f32x4 acc[4][4];
#pragma unroll
    for (int i = 0; i < 4; ++i)
#pragma unroll
      for (int j = 0; j < 4; ++j) acc[i][j] = (f32x4){0.f, 0.f, 0.f, 0.f};
    for (int k0 = 0; k0 < K; k0 += 64) {
      __syncthreads();
#pragma unroll
      for (int i = 0; i < 4; ++i) {
        const int idx = i * 256 + tid;
        const int r = idx >> 3, sg = idx & 7;
        const uint4 va = *(const uint4*)(A + (size_t)(tm * 128 + r) * K + k0 + sg * 8);
        *(uint4*)(sA + r * 72 + sg * 8) = va;
        const uint4 vb = *(const uint4*)(Bt + (size_t)(tn * 128 + r) * K + k0 + sg * 8);
        *(uint4*)(sB + r * 72 + sg * 8) = vb;
      }
      __syncthreads();
#pragma unroll
      for (int kk = 0; kk < 2; ++kk) {
        bf16x8 af[4], bfr[4];
#pragma unroll
        for (int i = 0; i < 4; ++i) af[i] = *(const bf16x8*)(sA + (wr * 64 + i * 16 + l15) * 72 + kk * 32 + l4 * 8);
#pragma unroll
        for (int j = 0; j < 4; ++j) bfr[j] = *(const bf16x8*)(sB + (wc * 64 + j * 16 + l15) * 72 + kk * 32 + l4 * 8);
#pragma unroll
        for (int i = 0; i < 4; ++i)
#pragma unroll
          for (int j = 0; j < 4; ++j) acc[i][j] = __builtin_amdgcn_mfma_f32_16x16x32_bf16(af[i], bfr[j], acc[i][j], 0, 0, 0);
      }
    }
#pragma unroll
    for (int i = 0; i < 4; ++i)
#pragma unroll
      for (int j = 0; j < 4; ++j)
#pragma unroll
        for (int e = 0; e < 4; ++e) {
          const int row = tm * 128 + wr * 64 + i * 16 + l4 * 4 + e;
          const int col = tn * 128 + wc * 64 + j * 16 + l15;
          const float v = acc[i][j][e];
          if (EPI == EPI_INPROJ) {
            if (col < INW) P.p[(size_t)row * INW + col] = f2bf(v);
            if (col >= OFF_DT && col < OFF_DT + 32) P.dtraw[(size_t)row * 32 + col - OFF_DT] = v;
          } else if (EPI == EPI_OUTPROJ) {
            const float* src = hrow(hl, hc, row);
            const float gate = P.mod[(size_t)(layer * 5 + modrow(row)) * MODW + 2048 + col];
            P.h[(size_t)row * DM + col] = src[col] + gate * v;
          } else {
            P.q[(size_t)row * 2048 + col] = f2bf(v);
          }
        }
  }
}

__device__ void ph_conv(const Params& P, int layer, int bid, int nb) {
  const float* cw = P.conv_w + (size_t)layer * 3 * 1536;
  const float* cb = P.conv_b + (size_t)layer * 1536;
  const int total = NTOK * 192;
  for (int it = bid * NTHR + threadIdx.x; it < total; it += nb * NTHR) {
    const int row = it / 192, c8 = (it % 192) * 8;
    int l, L;
    if (row < NLAT) { l = row & 4095; L = 4096; } else { l = (row - NLAT) & 255; L = 256; }
    const bf16_t* pc = P.p + (size_t)row * INW + OFF_XBC + c8;
    uint4 cur = *(const uint4*)pc;
    uint4 prv = make_uint4(0, 0, 0, 0), nxt = make_uint4(0, 0, 0, 0);
    if (l > 0) prv = *(const uint4*)(pc - INW);
    if (l < L - 1) nxt = *(const uint4*)(pc + INW);
    const bf16_t* c_ = (const bf16_t*)&cur;
    const bf16_t* p_ = (const bf16_t*)&prv;
    const bf16_t* n_ = (const bf16_t*)&nxt;
    uint4 o;
    bf16_t* o_ = (bf16_t*)&o;
#pragma unroll
    for (int e = 0; e < 8; ++e) {
      const int c = c8 + e;
      const float v = cb[c] + cw[c] * bf2f(p_[e]) + cw[1536 + c] * bf2f(c_[e]) + cw[3072 + c] * bf2f(n_[e]);
      o_[e] = f2bf(silu_f(v));
    }
    *(uint4*)(P.xbc + (size_t)row * 1536 + c8) = o;
  }
}

__device__ void ph_ssdprep(const Params& P, int layer, int bid, int nb) {
  for (int it = bid * NTHR + threadIdx.x; it < NCHUNK * 32; it += nb * NTHR) {
    const int gc = it >> 5, dh = it & 31;
    const float bias = P.dt_bias[layer * 32 + dh];
    const float ah = -expf(P.a_log[layer * 32 + dh]);
    float cs = 0.f;
    for (int j = 0; j < 128; ++j) {
      const size_t o = (size_t)(gc * 128 + j) * 32 + dh;
      const float dt = softplus_f(P.dtraw[o] + bias);
      cs += dt * ah;
      P.dtv[o] = dt;
      P.csv[o] = cs;
    }
  }
}

__device__ void ph_states(const Params& P, char* smem, int bid, int nb) {
  float* wx = (float*)smem;
  bf16_t* Bm = (bf16_t*)(smem + 128 * 64 * 4);
  const int tid = threadIdx.x;
  const int n = tid & 127, pg = tid >> 7;
  for (int it = bid; it < NCHUNK * 32; it += nb) {
    const int gc = it >> 5, dh = it & 31, dir = dh >> 4, head = dh & 15, g = head >> 3;
    const int row0 = gc * 128;
    __syncthreads();
    const float at = P.csv[(size_t)(row0 + 127) * 32 + dh];
    for (int i = tid; i < 128 * 64; i += NTHR) {
      const int j = i >> 6, pp = i & 63, row = row0 + j;
      const float cs = P.csv[(size_t)row * 32 + dh], dt = P.dtv[(size_t)row * 32 + dh];
      float w;
      if (dir == 0) w = expf(at - cs);
      else w = expf(j > 0 ? P.csv[(size_t)(row - 1) * 32 + dh] : 0.f);
      wx[i] = bf2f(P.xbc[(size_t)row * 1536 + head * 64 + pp]) * dt * w;
    }
    for (int i = tid; i < 128 * 128; i += NTHR) {
      const int j = i >> 7, nn = i & 127;
      Bm[i] = P.xbc[(size_t)(row0 + j) * 1536 + 1024 + g * 128 + nn];
    }
    __syncthreads();
    float acc[32];
#pragma unroll
    for (int i = 0; i < 32; ++i) acc[i] = 0.f;
    for (int j = 0; j < 128; ++j) {
      const float b = bf2f(Bm[j * 128 + n]);
#pragma unroll
      for (int i = 0; i < 32; ++i) acc[i] += wx[j * 64 + pg * 32 + i] * b;
    }
    bf16_t* dst = P.states + (size_t)it * 8192;
#pragma unroll
    for (int i = 0; i < 32; ++i) dst[(pg * 32 + i) * 128 + n] = f2bf(acc[i]);
  }
}

__device__ void ph_scan(const Params& P, int bid, int nb) {
  const int total = 4 * 32 * 8192;
  for (int it = bid * NTHR + threadIdx.x; it < total; it += nb * NTHR) {
    const int e = it & 8191, dh = (it >> 13) & 31, b = it >> 18, dir = dh >> 4;
    float S = 0.f;
    for (int s = 0; s < 34; ++s) {
      int gc;
      if (dir == 0) gc = (s < 2) ? (128 + 2 * b + s) : (32 * b + (s - 2));
      else gc = (s < 2) ? (128 + 2 * b + 1 - s) : (32 * b + 31 - (s - 2));
      bf16_t* ptr = P.states + (size_t)(gc * 32 + dh) * 8192 + e;
      const float cstate = bf2f(*ptr);
      *ptr = f2bf(S);
      const float at = P.csv[(size_t)(gc * 128 + 127) * 32 + dh];
      S = expf(at) * S + cstate;
    }
  }
}

__device__ void ph_ssdy(const Params& P, int layer, int nchunks, char* smem, int bid, int nb) {
  bf16_t* Cm = (bf16_t*)smem;
  bf16_t* Gm = Cm + 128 * 130;
  char* R = (char*)(Gm + 128 * 130);
  bf16_t* Bm = (bf16_t*)R;
  float* xd = (float*)R;
  bf16_t* Sm = (bf16_t*)(R + 128 * 130 * 2);
  float* csl = (float*)(Sm + 64 * 130);
  float* exl = csl + 128;
  const int tid = threadIdx.x;
  for (int it = bid; it < nchunks * 16; it += nb) {
    const int gc = it >> 4, head = it & 15, g = head >> 3;
    const int row0 = gc * 128;
    __syncthreads();
    for (int i = tid; i < 128 * 128; i += NTHR) {
      const int j = i >> 7, nn = i & 127;
      const bf16_t* xr = P.xbc + (size_t)(row0 + j) * 1536 + 1024 + g * 128 + nn;
      Bm[j * 130 + nn] = xr[0];
      Cm[j * 130 + nn] = xr[256];
    }
    __syncthreads();
    {
      const int s = tid & 127, jh = tid >> 7;
      for (int jb = 0; jb < 2; ++jb) {
        float acc[32];
#pragma unroll
        for (int i = 0; i < 32; ++i) acc[i] = 0.f;
        for (int nn = 0; nn < 128; ++nn) {
          const float b = bf2f(Bm[s * 130 + nn]);
#pragma unroll
          for (int i = 0; i < 32; ++i) acc[i] += bf2f(Cm[(jh * 64 + jb * 32 + i) * 130 + nn]) * b;
        }
#pragma unroll
        for (int i = 0; i < 32; ++i) Gm[(jh * 64 + jb * 32 + i) * 130 + s] = f2bf(acc[i]);
      }
    }
    const int pp = tid & 63, jg = tid >> 6;
    float yacc[32];
#pragma unroll
    for (int i = 0; i < 32; ++i) yacc[i] = 0.f;
    for (int dir = 0; dir < 2; ++dir) {
      const int dh = dir * 16 + head;
      __syncthreads();
      for (int i = tid; i < 128 * 64; i += NTHR) {
        const int j = i >> 6, p2 = i & 63, row = row0 + j;
        xd[i] = bf2f(P.xbc[(size_t)row * 1536 + head * 64 + p2]) * P.dtv[(size_t)row * 32 + dh];
      }
      const bf16_t* st = P.states + (size_t)(gc * 32 + dh) * 8192;
      for (int i = tid; i < 64 * 128; i += NTHR) Sm[(i >> 7) * 130 + (i & 127)] = st[i];
      if (tid < 128) {
        const float cs = P.csv[(size_t)(row0 + tid) * 32 + dh];
        csl[tid] = cs;
        exl[tid] = tid > 0 ? P.csv[(size_t)(row0 + tid - 1) * 32 + dh] : 0.f;
      }
      __syncthreads();
      const float atot = csl[127];
      for (int s = 0; s < 128; ++s) {
        const float xv = xd[s * 64 + pp];
        const float cs_s = csl[s], ex_s = exl[s];
#pragma unroll
        for (int i = 0; i < 32; ++i) {
          const int j = jg * 32 + i;
          if (dir == 0) {
            if (s <= j) yacc[i] += bf2f(Gm[j * 130 + s]) * expf(csl[j] - cs_s) * xv;
          } else {
            if (s >= j) yacc[i] += bf2f(Gm[j * 130 + s]) * expf(ex_s - exl[j]) * xv;
          }
        }
      }
      float offacc[32];
#pragma unroll
      for (int i = 0; i < 32; ++i) offacc[i] = 0.f;
      for (int nn = 0; nn < 128; ++nn) {
        const float sv = bf2f(Sm[pp * 130 + nn]);
#pragma unroll
        for (int i = 0; i < 32; ++i) offacc[i] += bf2f(Cm[(jg * 32 + i) * 130 + nn]) * sv;
      }
#pragma unroll
      for (int i = 0; i < 32; ++i) {
        const int j = jg * 32 + i;
        const float sc = dir == 0 ? expf(csl[j]) : expf(atot - exl[j]);
        yacc[i] += offacc[i] * sc;
      }
    }
    const float dsk = P.d_skip[layer * 16 + head];
#pragma unroll
    for (int i = 0; i < 32; ++i) {
      const int row = row0 + jg * 32 + i;
      const float xs = bf2f(P.xbc[(size_t)row * 1536 + head * 64 + pp]);
      const float z = bf2f(P.p[(size_t)row * INW + OFF_Z + head * 64 + pp]);
      const float y = (yacc[i] + dsk * xs) * silu_f(z);
      P.concat[(size_t)row * 2048 + head * 64 + pp] = f2bf(y);
    }
  }
}

__device__ void ph_ssdnorm(const Params& P, int layer, int nrows, int bid, int nb) {
  const int wave = threadIdx.x >> 6, lane = threadIdx.x & 63;
  const float* g = P.ssd_norm_g + layer * 1024;
  for (int row = bid * 4 + wave; row < nrows; row += nb * 4) {
    bf16_t* src = P.concat + (size_t)row * 2048;
    float v[16];
    float ss = 0.f;
#pragma unroll
    for (int i = 0; i < 4; ++i) {
      const uint2 pk = *(const uint2*)(src + i * 256 + lane * 4);
      v[i * 4 + 0] = bf2f((bf16_t)(pk.x & 0xffff)); v[i * 4 + 1] = bf2f((bf16_t)(pk.x >> 16));
      v[i * 4 + 2] = bf2f((bf16_t)(pk.y & 0xffff)); v[i * 4 + 3] = bf2f((bf16_t)(pk.y >> 16));
    }
#pragma unroll
    for (int i = 0; i < 16; ++i) ss += v[i] * v[i];
    ss = wave_sum(ss);
    const float rstd = rsqrtf(ss * (1.f / 1024.f) + 1e-6f);
#pragma unroll
    for (int i = 0; i < 4; ++i) {
      const int idx = i * 256 + lane * 4;
      uint2 pk;
      pk.x = (uint32_t)f2bf(v[i * 4 + 0] * rstd * g[idx + 0]) | ((uint32_t)f2bf(v[i * 4 + 1] * rstd * g[idx + 1]) << 16);
      pk.y = (uint32_t)f2bf(v[i * 4 + 2] * rstd * g[idx + 2]) | ((uint32_t)f2bf(v[i * 4 + 3] * rstd * g[idx + 3]) << 16);
      *(uint2*)(src + idx) = pk;
    }
  }
}

__device__ void ph_pool(const Params& P, int layer, int nrows, char* smem, int bid, int nb) {
  float* pooled = (float*)smem;
  const int tid = threadIdx.x;
  const int ntile = nrows / 32;
  for (int it = bid; it < ntile * 4; it += nb) {
    const int tt = it >> 2, gi = it & 3;
    const int w = 2 << gi;
    const int row0 = tt * 32;
    __syncthreads();
    for (int i = tid; i < 32 * 128; i += NTHR) {
      const int t = i >> 7, ch = i & 127, row = row0 + t;
      int l, L, base;
      if (row < NLAT) { l = row & 4095; L = 4096; base = row - l; } else { l = (row - NLAT) & 255; L = 256; base = row - l; }
      int lo = l - w / 2; lo = lo < 0 ? 0 : lo;
      int hi = l + w - w / 2 - 1; hi = hi > L - 1 ? L - 1 : hi;
      float s = 0.f;
      for (int r = lo; r <= hi; ++r) s += bf2f(P.p[(size_t)(base + r) * INW + OFF_POOL + gi * 128 + ch]);
      pooled[i] = s / (float)(hi - lo + 1) - bf2f(P.p[(size_t)row * INW + OFF_POOL + gi * 128 + ch]);
    }
    __syncthreads();
    const int o = tid & 127, tg = tid >> 7;
    const float* W = P.pool_w + ((size_t)(layer * 4 + gi) * 128) * 128 + o;
    float acc[16];
#pragma unroll
    for (int i = 0; i < 16; ++i) acc[i] = 0.f;
    for (int k = 0; k < 128; ++k) {
      const float wv = W[(size_t)k * 128];
#pragma unroll
      for (int i = 0; i < 16; ++i) acc[i] += pooled[(tg * 16 + i) * 128 + k] * wv;
    }
    const float sc = P.pool_scale[layer * 512 + gi * 128 + o];
#pragma unroll
    for (int i = 0; i < 16; ++i)
      P.concat[(size_t)(row0 + tg * 16 + i) * 2048 + 1024 + gi * 128 + o] = f2bf(acc[i] * sc);
  }
}

__device__ void ph_na(const Params& P, int layer, int nrows, char* smem, int bid, int nb) {
  const int wave = threadIdx.x >> 6, lane = threadIdx.x & 63;
  float* qs = (float*)smem + wave * 448;
  float* ps = qs + 64;
  const float* rpb = P.na_rpb + (size_t)layer * 8 * 15 * 31;
  for (int it = bid * 4 + wave; it < nrows * 8; it += nb * 4) {
    const int row = it >> 3, hd = it & 7;
    const bool lat = row < NLAT;
    int b, r = 0, cq = 0, r0 = 0, c0 = 0;
    if (lat) {
      b = row >> 12; const int l = row & 4095; r = l >> 6; cq = l & 63;
      r0 = r - 4; r0 = r0 < 0 ? 0 : (r0 > 56 ? 56 : r0);
      c0 = cq - 8; c0 = c0 < 0 ? 0 : (c0 > 48 ? 48 : c0);
    } else {
      b = (row - NLAT) >> 8;
    }
    qs[lane] = bf2f(P.p[(size_t)row * INW + OFF_Q + hd * 64 + lane]) * 0.125f;
    __builtin_amdgcn_wave_barrier();
    const int nkeys = lat ? 384 : 256;
    float sc[6];
    float mx = -3.0e38f;
#pragma unroll
    for (int t = 0; t < 6; ++t) {
      const int n = t * 64 + lane;
      float s = -3.0e38f;
      if (n < nkeys) {
        int krow; float bias = 0.f;
        if (lat && n < 128) {
          const int kr = n >> 4, kc = n & 15;
          const int rk = r0 + kr, ck = c0 + kc;
          krow = b * 4096 + rk * 64 + ck;
          bias = rpb[(hd * 15 + (rk - r + 7)) * 31 + (ck - cq + 15)];
        } else {
          krow = NLAT + b * 256 + (lat ? n - 128 : n);
        }
        const bf16_t* kp = P.p + (size_t)krow * INW + OFF_K + hd * 64;
        float d = 0.f;
#pragma unroll
        for (int v8 = 0; v8 < 8; ++v8) {
          const uint4 kk = *(const uint4*)(kp + v8 * 8);
          const bf16_t* ke = (const bf16_t*)&kk;
#pragma unroll
          for (int e = 0; e < 8; ++e) d += qs[v8 * 8 + e] * bf2f(ke[e]);
        }
        s = d + bias;
      }
      sc[t] = s;
      mx = fmaxf(mx, s);
    }
    mx = wave_max(mx);
    float sum = 0.f;
#pragma unroll
    for (int t = 0; t < 6; ++t) {
      const int n = t * 64 + lane;
      const float e = (n < nkeys) ? expf(sc[t] - mx) : 0.f;
      sum += e;
      ps[n] = e;
    }
    sum = wave_sum(sum);
    __builtin_amdgcn_wave_barrier();
    float acc = 0.f;
    for (int n = 0; n < nkeys; ++n) {
      int krow;
      if (lat && n < 128) krow = b * 4096 + (r0 + (n >> 4)) * 64 + c0 + (n & 15);
      else krow = NLAT + b * 256 + (lat ? n - 128 : n);
      acc += ps[n] * bf2f(P.p[(size_t)krow * INW + OFF_V + hd * 64 + lane]);
    }
    P.concat[(size_t)row * 2048 + 1536 + hd * 64 + lane] = f2bf(acc / sum);
    __builtin_amdgcn_wave_barrier();
  }
}

__device__ void ph_peer_topk(const Params& P, int layer, int nrows, char* smem, int bid, int nb) {
  bf16_t* Ks = (bf16_t*)smem;
  float* qt = (float*)(smem + 33280);
  float* sc = qt + 32 * 256;
  float* tv = sc + 64 * 129;
  int* ti = (int*)(tv + 64 * 16);
  const int tid = threadIdx.x;
  const int ntile = nrows / 32;
  for (int it = bid; it < ntile * 8; it += nb) {
    const int hd = it % 8, tt = it / 8;
    const int row0 = tt * 32;
    __syncthreads();
    for (int i = tid; i < 32 * 256; i += NTHR) {
      const int t = i >> 8, d = i & 255;
      qt[i] = bf2f(P.q[(size_t)(row0 + t) * 2048 + hd * 256 + d]);
    }
    for (int half = 0; half < 2; ++half) {
      __syncthreads();
      const float* kk = P.peer_keys + ((size_t)((layer * 8 + hd) * 2 + half) * 128) * 128;
      for (int i = tid; i < 128 * 128; i += NTHR) Ks[(i >> 7) * 130 + (i & 127)] = f2bf(kk[i]);
      __syncthreads();
      const int k = tid & 127, tg = tid >> 7;
      float acc[16];
#pragma unroll
      for (int i = 0; i < 16; ++i) acc[i] = 0.f;
      for (int d = 0; d < 128; ++d) {
        const float kv = bf2f(Ks[k * 130 + d]);
#pragma unroll
        for (int i = 0; i < 16; ++i) acc[i] += qt[(tg * 16 + i) * 256 + half * 128 + d] * kv;
      }
#pragma unroll
      for (int i = 0; i < 16; ++i) sc[((tg * 16 + i) * 2 + half) * 129 + k] = acc[i];
    }
    __syncthreads();
    if (tid < 64) {
      float* s = sc + tid * 129;
      for (int r = 0; r < 16; ++r) {
        float best = -3.0e38f; int bi = 0;
        for (int k = 0; k < 128; ++k) { const float v = s[k]; if (v > best) { best = v; bi = k; } }
        tv[tid * 16 + r] = best; ti[tid * 16 + r] = bi;
        s[bi] = -3.0e38f;
      }
    }
    __syncthreads();
    float* cand = qt;
    for (int i = tid; i < 32 * 256; i += NTHR) {
      const int t = i >> 8, a = (i >> 4) & 15, b2 = i & 15;
      cand[i] = tv[(t * 2 + 0) * 16 + a] + tv[(t * 2 + 1) * 16 + b2];
    }
    __syncthreads();
    if (tid < 32) {
      float* cd = cand + tid * 256;
      float ts[16];
      const int row = row0 + tid;
      float mx = 0.f;
#pragma unroll
      for (int r = 0; r < 16; ++r) {
        float best = -3.0e38f; int bi = 0;
        for (int k = 0; k < 256; ++k) { const float v = cd[k]; if (v > best) { best = v; bi = k; } }
        cd[bi] = -3.0e38f;
        ts[r] = best;
        if (r == 0) mx = best;
        const int e = ti[(tid * 2 + 0) * 16 + (bi >> 4)] * 128 + ti[(tid * 2 + 1) * 16 + (bi & 15)];
        P.sel_idx[(size_t)row * 128 + hd * 16 + r] = e;
      }
      float sum = 0.f;
#pragma unroll
      for (int r = 0; r < 16; ++r) { ts[r] = expf(ts[r] - mx); sum += ts[r]; }
      const float inv = 1.f / sum;
#pragma unroll
      for (int r = 0; r < 16; ++r) P.sel_g[(size_t)row * 128 + hd * 16 + r] = ts[r] * inv;
    }
  }
}

__device__ void ph_peer_gather(const Params& P, int layer, int nrows, int bid, int nb) {
  const int wave = threadIdx.x >> 6, lane = threadIdx.x & 63;
  const float* UT = P.peer_u + (size_t)layer * 16384 * 1024;
  const float* VT = P.peer_v + (size_t)layer * 16384 * 1024;
  for (int row = bid * 4 + wave; row < nrows; row += nb * 4) {
    float xv[16], o[16];
#pragma unroll
    for (int i = 0; i < 4; ++i) {
      const uint2 pk = *(const uint2*)(P.u + (size_t)row * DM + i * 256 + lane * 4);
      xv[i * 4 + 0] = bf2f((bf16_t)(pk.x & 0xffff)); xv[i * 4 + 1] = bf2f((bf16_t)(pk.x >> 16));
      xv[i * 4 + 2] = bf2f((bf16_t)(pk.y & 0xffff)); xv[i * 4 + 3] = bf2f((bf16_t)(pk.y >> 16));
    }
#pragma unroll
    for (int i = 0; i < 16; ++i) o[i] = 0.f;
    for (int k = 0; k < 128; ++k) {
      const int e = P.sel_idx[(size_t)row * 128 + k];
      const float gk = P.sel_g[(size_t)row * 128 + k];
      const float4* ur = (const float4*)(UT + (size_t)e * 1024);
      float d = 0.f;
#pragma unroll
      for (int i = 0; i < 4; ++i) {
        const float4 uu = ur[i * 64 + lane];
        d += uu.x * xv[i * 4 + 0] + uu.y * xv[i * 4 + 1] + uu.z * xv[i * 4 + 2] + uu.w * xv[i * 4 + 3];
      }
      d = wave_sum(d);
      const float a = gelu_f(d) * gk;
      const float4* vr = (const float4*)(VT + (size_t)e * 1024);
#pragma unroll
      for (int i = 0; i < 4; ++i) {
        const float4 vv = vr[i * 64 + lane];
        o[i * 4 + 0] += a * vv.x; o[i * 4 + 1] += a * vv.y; o[i * 4 + 2] += a * vv.z; o[i * 4 + 3] += a * vv.w;
      }
    }
    const float* gate = P.mod + (size_t)(layer * 5 + modrow(row)) * MODW + 5120;
    float* hr = P.h + (size_t)row * DM;
#pragma unroll
    for (int i = 0; i < 4; ++i) {
      const int idx = i * 256 + lane * 4;
      float4 hv = *(float4*)(hr + idx);
      const float4 gg = *(const float4*)(gate + idx);
      hv.x += gg.x * o[i * 4 + 0]; hv.y += gg.y * o[i * 4 + 1]; hv.z += gg.z * o[i * 4 + 2]; hv.w += gg.w * o[i * 4 + 3];
      *(float4*)(hr + idx) = hv;
    }
  }
}

__device__ void ph_final(const Params& P, int bid, int nb) {
  const int wave = threadIdx.x >> 6, lane = threadIdx.x & 63;
  for (int row = bid * 4 + wave; row < NLAT; row += nb * 4) {
    const float* src = P.h + (size_t)row * DM;
    float4 v[4];
    float ss = 0.f;
#pragma unroll
    for (int i = 0; i < 4; ++i) {
      v[i] = ((const float4*)src)[i * 64 + lane];
      ss += v[i].x * v[i].x + v[i].y * v[i].y + v[i].z * v[i].z + v[i].w * v[i].w;
    }
    ss = wave_sum(ss);
    const float rstd = rsqrtf(ss * (1.f / 1024.f) + 1e-6f);
#pragma unroll
    for (int i = 0; i < 4; ++i) {
      const int idx = i * 256 + lane * 4;
      const float4 gg = *(const float4*)(P.final_g + idx);
      float4 o;
      o.x = v[i].x * rstd * gg.x; o.y = v[i].y * rstd * gg.y; o.z = v[i].z * rstd * gg.z; o.w = v[i].w * rstd * gg.w;
      *(float4*)(P.out + (size_t)row * DM + idx) = o;
    }
  }
}

enum {
  PH_PREP = 0, PH_NORM1, PH_INPROJ, PH_CONV, PH_SSDPREP, PH_STATES, PH_SCAN, PH_SSDY, PH_SSDNORM, PH_POOL, PH_NA,
  PH_OUTPROJ, PH_NORM2, PH_QGEMM, PH_TOPK, PH_GATHER, PH_FINAL
};

#define SMEM_BYTES 117760

__device__ void run_phase(const Params& P, int ph, int layer, char* smem, int bid, int nb) {
  const float* hl = layer == 0 ? P.x : P.h;
  const float* hc = layer == 0 ? P.ctx : P.h + (size_t)NLAT * DM;
  const int nrows = layer == 0 ? NTOK : NLAT;
  switch (ph) {
    case PH_PREP:
      ph_mod(P, (float*)smem, bid, nb);
      for (int l = 0; l < 2; ++l) {
        ph_transpose(P.w_in + (size_t)l * 1024 * INW, P.w_inT + (size_t)l * INW_PAD * 1024, 1024, INW, INW_PAD, (float*)smem, bid, nb);
        ph_transpose(P.w_out + (size_t)l * 2048 * 1024, P.w_outT + (size_t)l * 1024 * 2048, 2048, 1024, 1024, (float*)smem, bid, nb);
        ph_transpose(P.peer_wq + (size_t)l * 1024 * 2048, P.w_qT + (size_t)l * 2048 * 1024, 1024, 2048, 2048, (float*)smem, bid, nb);
      }
      break;
    case PH_NORM1:
      ph_norm(hl, hc, P.norm1_g + layer * 1024, P.mod + (size_t)layer * 5 * MODW, 0, 1024, NTOK, P.u, bid, nb);
      break;
    case PH_INPROJ:
      ph_gemm<EPI_INPROJ>(P, layer, P.u, P.w_inT + (size_t)layer * INW_PAD * 1024, NTOK, INW_PAD, 1024, hl, hc, smem, bid, nb);
      break;
    case PH_CONV: ph_conv(P, layer, bid, nb); break;
    case PH_SSDPREP: ph_ssdprep(P, layer, bid, nb); break;
    case PH_STATES: ph_states(P, smem, bid, nb); break;
    case PH_SCAN: ph_scan(P, bid, nb); break;
    case PH_SSDY: ph_ssdy(P, layer, nrows / 128, smem, bid, nb); break;
    case PH_SSDNORM: ph_ssdnorm(P, layer, nrows, bid, nb); break;
    case PH_POOL: ph_pool(P, layer, nrows, smem, bid, nb); break;
    case PH_NA: ph_na(P, layer, nrows, smem, bid, nb); break;
    case PH_OUTPROJ:
      ph_gemm<EPI_OUTPROJ>(P, layer, P.concat, P.w_outT + (size_t)layer * 1024 * 2048, nrows, 1024, 2048, hl, hc, smem, bid, nb);
      break;
    case PH_NORM2:
      ph_norm(P.h, P.h + (size_t)NLAT * DM, P.norm2_g + layer * 1024, P.mod + (size_t)layer * 5 * MODW, 3072, 4096, nrows, P.u, bid, nb);
      break;
    case PH_QGEMM:
      ph_gemm<EPI_Q>(P, layer, P.u, P.w_qT + (size_t)layer * 2048 * 1024, nrows, 2048, 1024, hl, hc, smem, bid, nb);
      break;
    case PH_TOPK: ph_peer_topk(P, layer, nrows, smem, bid, nb); break;
    case PH_GATHER: ph_peer_gather(P, layer, nrows, bid, nb); break;
    case PH_FINAL: ph_final(P, bid, nb); break;
  }
}

__global__ void __launch_bounds__(NTHR) k_phase(Params P, int ph, int layer) {
  __shared__ __attribute__((aligned(16))) char smem[SMEM_BYTES];
  run_phase(P, ph, layer, smem, blockIdx.x, gridDim.x);
}

extern "C" void kernel_launch(void* const* d_in, const int* in_sizes, int n_in, void* d_out, int out_size, void* d_ws,
                              size_t ws_size, hipStream_t stream) {
  Params P{};
  const float* const* in = (const float* const*)d_in;
  P.x = in[0]; P.c = in[1]; P.ctx = in[2]; P.c_ctx = in[3]; P.ada_w = in[4]; P.ada_b = in[5]; P.norm1_g = in[6];
  P.w_in = in[7]; P.conv_w = in[8]; P.conv_b = in[9]; P.a_log = in[10]; P.dt_bias = in[11]; P.d_skip = in[12];
  P.ssd_norm_g = in[13]; P.pool_w = in[14]; P.pool_scale = in[15]; P.na_rpb = in[16]; P.w_out = in[17];
  P.norm2_g = in[18]; P.peer_wq = in[19]; P.peer_keys = in[20]; P.peer_u = in[21]; P.peer_v = in[22]; P.final_g = in[23];
  P.out = (float*)d_out;
  char* w = (char*)d_ws;
  size_t off = 0;
  auto take = [&](size_t bytes) { char* r = w + off; off += (bytes + 255) & ~(size_t)255; return r; };
  P.mod = (float*)take((size_t)2 * 5 * MODW * 4);
  P.h = (float*)take((size_t)NTOK * DM * 4);
  P.p = (bf16_t*)take((size_t)NTOK * INW * 2);
  P.q = P.p;
  P.dtraw = (float*)take((size_t)NTOK * 32 * 4);
  P.dtv = (float*)take((size_t)NTOK * 32 * 4);
  P.csv = (float*)take((size_t)NTOK * 32 * 4);
  P.xbc = (bf16_t*)take((size_t)NTOK * 1536 * 2);
  P.states = (bf16_t*)take((size_t)NCHUNK * 32 * 8192 * 2);
  P.concat = (bf16_t*)take((size_t)NTOK * 2048 * 2);
  P.u = P.concat;
  P.sel_idx = (int*)take((size_t)NTOK * 128 * 4);
  P.sel_g = (float*)take((size_t)NTOK * 128 * 4);
  P.w_inT = (bf16_t*)take((size_t)2 * INW_PAD * 1024 * 2);
  P.w_outT = (bf16_t*)take((size_t)2 * 1024 * 2048 * 2);
  P.w_qT = (bf16_t*)take((size_t)2 * 2048 * 1024 * 2);
  if (off > ws_size) { fprintf(stderr, "workspace too small: need %zu have %zu\n", off, ws_size); return; }

  const int G = 1024;
  auto L = [&](int ph, int layer) { hipLaunchKernelGGL(k_phase, dim3(G), dim3(NTHR), 0, stream, P, ph, layer); };
  L(PH_PREP, 0);
  for (int layer = 0; layer < 2; ++layer) {
    L(PH_NORM1, layer); L(PH_INPROJ, layer); L(PH_CONV, layer); L(PH_SSDPREP, layer); L(PH_STATES, layer);
    L(PH_SCAN, layer); L(PH_SSDY, layer); L(PH_SSDNORM, layer); L(PH_POOL, layer); L(PH_NA, layer);
    L(PH_OUTPROJ, layer); L(PH_NORM2, layer); L(PH_QGEMM, layer); L(PH_TOPK, layer); L(PH_GATHER, layer);
  }
  L(PH_FINAL, 0);
}
```

```cpp
#include <hip/hip_runtime.h>
#include <hip/hip_bf16.h>
#include <hip/hip_cooperative_groups.h>
#include <stdint.h>
#include <stdio.h>

typedef unsigned short bf16_t;
typedef __attribute__((ext_vector_type(8))) short bf16x8;
typedef __attribute__((ext_vector_type(4))) float f32x4;

#define NTHR 256
constexpr int DM = 1024;
constexpr int SEQ = 4096;
constexpr int NLAT = 16384;
constexpr int NCTXR = 1024;
constexpr int NTOK = 17408;
constexpr int INW = 4640;
constexpr int INW_PAD = 4736;
constexpr int OFF_Z = 0, OFF_XBC = 1024, OFF_DT = 2560, OFF_POOL = 2592, OFF_Q = 3104, OFF_K = 3616, OFF_V = 4128;
constexpr int NCHUNK = 136;
constexpr int MODW = 6144;

struct Params {
  const float *x, *c, *ctx, *c_ctx, *ada_w, *ada_b, *norm1_g, *w_in, *conv_w, *conv_b, *a_log, *dt_bias, *d_skip,
      *ssd_norm_g, *pool_w, *pool_scale, *na_rpb, *w_out, *norm2_g, *peer_wq, *peer_keys, *peer_u, *peer_v, *final_g;
  float* out;
  float* mod;
  float* h;
  bf16_t* u;
  bf16_t* p;
  float* dtraw;
  float* dtv;
  float* csv;
  bf16_t* xbc;
  bf16_t* states;
  bf16_t* concat;
  bf16_t* q;
  int* sel_idx;
  float* sel_g;
  bf16_t* w_inT;
  bf16_t* w_outT;
  bf16_t* w_qT;
};

__device__ __forceinline__ int otid() { int t = threadIdx.x; asm volatile("" : "+v"(t)); return t; }
__device__ __forceinline__ float bf2f(bf16_t v) { return __uint_as_float(((uint32_t)v) << 16); }
__device__ __forceinline__ bf16_t f2bf(float f) {
  uint32_t u = __float_as_uint(f);
  u += 0x7fffu + ((u >> 16) & 1u);
  return (bf16_t)(u >> 16);
}
__device__ __forceinline__ float wave_sum(float v) {
#pragma unroll
  for (int o = 32; o > 0; o >>= 1) v += __shfl_xor(v, o, 64);
  return v;
}
__device__ __forceinline__ float wave_max(float v) {
#pragma unroll
  for (int o = 32; o > 0; o >>= 1) v = fmaxf(v, __shfl_xor(v, o, 64));
  return v;
}
__device__ __forceinline__ float silu_f(float v) { return v / (1.f + expf(-v)); }
__device__ __forceinline__ float softplus_f(float v) { return fmaxf(v, 0.f) + log1pf(expf(-fabsf(v))); }
__device__ __forceinline__ float gelu_f(float v) { return 0.5f * v * (1.f + erff(v * 0.70710678118654752f)); }

__device__ __forceinline__ const float* hrow(const float* hl, const float* hc, int row) {
  return row < NLAT ? hl + (size_t)row * DM : hc + (size_t)(row - NLAT) * DM;
}
__device__ __forceinline__ int modrow(int row) { return row < NLAT ? (row >> 12) : 4; }

__device__ void ph_transpose(const float* __restrict__ src, bf16_t* __restrict__ dst, int K, int N, int Npad,
                             float* tile, int bid, int nb) {
  const int tk = K / 32, tn = Npad / 32;
  const int tx = otid() & 31, ty = otid() >> 5;
  for (int t = bid; t < tk * tn; t += nb) {
    const int kt = t / tn, nt = t % tn;
    __syncthreads();
    for (int i = ty; i < 32; i += 8) {
      const int k = kt * 32 + i, n = nt * 32 + tx;
      tile[i * 33 + tx] = (n < N) ? src[(size_t)k * N + n] : 0.f;
    }
    __syncthreads();
    for (int i = ty; i < 32; i += 8) {
      const int n = nt * 32 + i, k = kt * 32 + tx;
      dst[(size_t)n * K + k] = f2bf(tile[tx * 33 + i]);
    }
  }
}

__device__ void ph_mod(const Params& P, float* sm, int bid, int nb) {
  const int tid = otid();
  float* sv = sm;
  float* red = sm + 5 * 1024;
  for (int i = tid; i < 5 * 1024; i += NTHR) {
    const float v = (i < 4096) ? P.c[i] : P.c_ctx[i - 4096];
    sv[i] = silu_f(v);
  }
  __syncthreads();
  const int col = tid & 31, kg = tid >> 5;
  for (int it = bid; it < 384; it += nb) {
    const int layer = it / 192, cb = it % 192;
    const float* W = P.ada_w + (size_t)layer * 1024 * MODW + cb * 32 + col;
    float a0 = 0, a1 = 0, a2 = 0, a3 = 0, a4 = 0;
    for (int k = kg * 128; k < kg * 128 + 128; ++k) {
      const float w = W[(size_t)k * MODW];
      a0 += sv[k] * w; a1 += sv[1024 + k] * w; a2 += sv[2048 + k] * w; a3 += sv[3072 + k] * w; a4 += sv[4096 + k] * w;
    }
    float* r = red + (kg * 32 + col) * 5;
    r[0] = a0; r[1] = a1; r[2] = a2; r[3] = a3; r[4] = a4;
    __syncthreads();
    if (tid < 160) {
      const int rr = tid >> 5, cc = tid & 31;
      float s = 0;
      for (int g = 0; g < 8; ++g) s += red[(g * 32 + cc) * 5 + rr];
      P.mod[(size_t)(layer * 5 + rr) * MODW + cb * 32 + cc] = s + P.ada_b[layer * MODW + cb * 32 + cc];
    }
    __syncthreads();
  }
}

__device__ void ph_norm(const float* hl, const float* hc, const float* __restrict__ g, const float* __restrict__ modl,
                        int shift_off, int scale_off, int nrows, bf16_t* __restrict__ dst, int bid, int nb) {
  const int wave = otid() >> 6, lane = otid() & 63;
  for (int row = bid * 4 + wave; row < nrows; row += nb * 4) {
    const float* src = hrow(hl, hc, row);
    const float* mr = modl + (size_t)modrow(row) * MODW;
    float4 v[4];
    float ss = 0.f;
#pragma unroll
    for (int i = 0; i < 4; ++i) {
      v[i] = ((const float4*)src)[i * 64 + lane];
      ss += v[i].x * v[i].x + v[i].y * v[i].y + v[i].z * v[i].z + v[i].w * v[i].w;
    }
    ss = wave_sum(ss);
    const float rstd = rsqrtf(ss * (1.f / 1024.f) + 1e-6f);
#pragma unroll
    for (int i = 0; i < 4; ++i) {
      const int idx = i * 256 + lane * 4;
      const float4 gg = *(const float4*)(g + idx);
      const float4 sc = *(const float4*)(mr + scale_off + idx);
      const float4 sh = *(const float4*)(mr + shift_off + idx);
      const float o0 = v[i].x * rstd * gg.x * (1.f + sc.x) + sh.x;
      const float o1 = v[i].y * rstd * gg.y * (1.f + sc.y) + sh.y;
      const float o2 = v[i].z * rstd * gg.z * (1.f + sc.z) + sh.z;
      const float o3 = v[i].w * rstd * gg.w * (1.f + sc.w) + sh.w;
      uint2 pk;
      pk.x = (uint32_t)f2bf(o0) | ((uint32_t)f2bf(o1) << 16);
      pk.y = (uint32_t)f2bf(o2) | ((uint32_t)f2bf(o3) << 16);
      *(uint2*)(dst + (size_t)row * DM + idx) = pk;
    }
  }
}

enum { EPI_INPROJ = 0, EPI_OUTPROJ = 1, EPI_Q = 2 };

template <int EPI>
__device__ void ph_gemm(const Params& P, int layer, const bf16_t* __restrict__ A, const bf16_t* __restrict__ Bt, int M,
                        int Npad, int K, const float* hl, const float* hc, char* smem, int bid, int nb) {
  bf16_t* sA = (bf16_t*)smem;
  bf16_t* sB = sA + 128 * 72;
  const int tid = otid(), lane = tid & 63, wave = tid >> 6;
  const int wr = wave >> 1, wc = wave & 1;
  const int tiles_m = M / 128, tiles_n = Npad / 128;
  const int l15 = lane & 15, l4 = lane >> 4;
  for (int tile = bid; tile < tiles_m * tiles_n; tile += nb) {
    const int tn = tile / tiles_m, tm = tile % tiles_m;
    f32x4 acc[4][4];
#pragma unroll
    for (int i = 0; i < 4; ++i)
#pragma unroll
      for (int j = 0; j < 4; ++j) acc[i][j] = (f32x4){0.f, 0.f, 0.f, 0.f};
    for (int k0 = 0; k0 < K; k0 += 64) {
      __syncthreads();
#pragma unroll
      for (int i = 0; i < 4; ++i) {
        const int idx = i * 256 + tid;
        const int r = idx >> 3, sg = idx & 7;
        const uint4 va = *(const uint4*)(A + (size_t)(tm * 128 + r) * K + k0 + sg * 8);
        *(uint4*)(sA + r * 72 + sg * 8) = va;
        const uint4 vb = *(const uint4*)(Bt + (size_t)(tn * 128 + r) * K + k0 + sg * 8);
        *(uint4*)(sB + r * 72 + sg * 8) = vb;
      }
      __syncthreads();
#pragma unroll
      for (int kk = 0; kk < 2; ++kk) {
        bf16x8 af[4], bfr[4];
#pragma unroll
        for (int i = 0; i < 4; ++i) af[i] = *(const bf16x8*)(sA + (wr * 64 + i * 16 + l15) * 72 + kk * 32 + l4 * 8);
#pragma unroll
        for (int j = 0; j < 4; ++j) bfr[j] = *(const bf16x8*)(sB + (wc * 64 + j * 16 + l15) * 72 + kk * 32 + l4 * 8);
#pragma unroll
        for (int i = 0; i < 4; ++i)
#pragma unroll
          for (int j = 0; j < 4; ++j) acc[i][j] = __builtin_amdgcn_mfma_f32_16x16x32_bf16(af[i], bfr[j], acc[i][j], 0, 0, 0);
      }
    }
#pragma unroll
    for (int i = 0; i < 4; ++i)
#pragma unroll
      for (int j = 0; j < 4; ++j)
#pragma unroll
        for (int e = 0; e < 4; ++e) {
          const int row = tm * 128 + wr * 64 + i * 16 + l4 * 4 + e;
          const int col = tn * 128 + wc * 64 + j * 16 + l15;
          const float v = acc[i][j][e];
          if (EPI == EPI_INPROJ) {
            if (col < INW) P.p[(size_t)row * INW + col] = f2bf(v);
            if (col >= OFF_DT && col < OFF_DT + 32) P.dtraw[(size_t)row * 32 + col - OFF_DT] = v;
          } else if (EPI == EPI_OUTPROJ) {
            const float* src = hrow(hl, hc, row);
            const float gate = P.mod[(size_t)(layer * 5 + modrow(row)) * MODW + 2048 + col];
            P.h[(size_t)row * DM + col] = src[col] + gate * v;
          } else {
            P.q[(size_t)row * 2048 + col] = f2bf(v);
          }
        }
  }
}

__device__ void ph_conv(const Params& P, int layer, int bid, int nb) {
  const float* cw = P.conv_w + (size_t)layer * 3 * 1536;
  const float* cb = P.conv_b + (size_t)layer * 1536;
  const int total = NTOK * 192;
  for (int it = bid * NTHR + otid(); it < total; it += nb * NTHR) {
    const int row = it / 192, c8 = (it % 192) * 8;
    int l, L;
    if (row < NLAT) { l = row & 4095; L = 4096; } else { l = (row - NLAT) & 255; L = 256; }
    const bf16_t* pc = P.p + (size_t)row * INW + OFF_XBC + c8;
    uint4 cur = *(const uint4*)pc;
    uint4 prv = make_uint4(0, 0, 0, 0), nxt = make_uint4(0, 0, 0, 0);
    if (l > 0) prv = *(const uint4*)(pc - INW);
    if (l < L - 1) nxt = *(const uint4*)(pc + INW);
    const bf16_t* c_ = (const bf16_t*)&cur;
    const bf16_t* p_ = (const bf16_t*)&prv;
    const bf16_t* n_ = (const bf16_t*)&nxt;
    uint4 o;
    bf16_t* o_ = (bf16_t*)&o;
#pragma unroll
    for (int e = 0; e < 8; ++e) {
      const int c = c8 + e;
      const float v = cb[c] + cw[c] * bf2f(p_[e]) + cw[1536 + c] * bf2f(c_[e]) + cw[3072 + c] * bf2f(n_[e]);
      o_[e] = f2bf(silu_f(v));
    }
    *(uint4*)(P.xbc + (size_t)row * 1536 + c8) = o;
  }
}

__device__ void ph_ssdprep(const Params& P, int layer, int bid, int nb) {
  for (int it = bid * NTHR + otid(); it < NCHUNK * 32; it += nb * NTHR) {
    const int gc = it >> 5, dh = it & 31;
    const float bias = P.dt_bias[layer * 32 + dh];
    const float ah = -expf(P.a_log[layer * 32 + dh]);
    float cs = 0.f;
    for (int j = 0; j < 128; ++j) {
      const size_t o = (size_t)(gc * 128 + j) * 32 + dh;
      const float dt = softplus_f(P.dtraw[o] + bias);
      cs += dt * ah;
      P.dtv[o] = dt;
      P.csv[o] = cs;
    }
  }
}

__device__ void ph_states(const Params& P, char* smem, int bid, int nb) {
  float* wx = (float*)smem;
  bf16_t* Bm = (bf16_t*)(smem + 128 * 64 * 4);
  const int tid = otid();
  const int n = tid & 127, pg = tid >> 7;
  for (int it = bid; it < NCHUNK * 32; it += nb) {
    const int gc = it >> 5, dh = it & 31, dir = dh >> 4, head = dh & 15, g = head >> 3;
    const int row0 = gc * 128;
    __syncthreads();
    const float at = P.csv[(size_t)(row0 + 127) * 32 + dh];
    for (int i = tid; i < 128 * 64; i += NTHR) {
      const int j = i >> 6, pp = i & 63, row = row0 + j;
      const float cs = P.csv[(size_t)row * 32 + dh], dt = P.dtv[(size_t)row * 32 + dh];
      float w;
      if (dir == 0) w = expf(at - cs);
      else w = expf(j > 0 ? P.csv[(size_t)(row - 1) * 32 + dh] : 0.f);
      wx[i] = bf2f(P.xbc[(size_t)row * 1536 + head * 64 + pp]) * dt * w;
    }
    for (int i = tid; i < 128 * 128; i += NTHR) {
      const int j = i >> 7, nn = i & 127;
      Bm[i] = P.xbc[(size_t)(row0 + j) * 1536 + 1024 + g * 128 + nn];
    }
    __syncthreads();
    float acc[32];
#pragma unroll
    for (int i = 0; i < 32; ++i) acc[i] = 0.f;
    for (int j = 0; j < 128; ++j) {
      const float b = bf2f(Bm[j * 128 + n]);
#pragma unroll
      for (int i = 0; i < 32; ++i) acc[i] += wx[j * 64 + pg * 32 + i] * b;
    }
    bf16_t* dst = P.states + (size_t)it * 8192;
#pragma unroll
    for (int i = 0; i < 32; ++i) dst[(pg * 32 + i) * 128 + n] = f2bf(acc[i]);
  }
}

__device__ void ph_scan(const Params& P, int bid, int nb) {
  const int total = 4 * 32 * 8192;
  for (int it = bid * NTHR + otid(); it < total; it += nb * NTHR) {
    const int e = it & 8191, dh = (it >> 13) & 31, b = it >> 18, dir = dh >> 4;
    float S = 0.f;
    for (int s = 0; s < 34; ++s) {
      int gc;
      if (dir == 0) gc = (s < 2) ? (128 + 2 * b + s) : (32 * b + (s - 2));
      else gc = (s < 2) ? (128 + 2 * b + 1 - s) : (32 * b + 31 - (s - 2));
      bf16_t* ptr = P.states + (size_t)(gc * 32 + dh) * 8192 + e;
      const float cstate = bf2f(*ptr);
      *ptr = f2bf(S);
      const float at = P.csv[(size_t)(gc * 128 + 127) * 32 + dh];
      S = expf(at) * S + cstate;
    }
  }
}

__device__ void ph_ssdy(const Params& P, int layer, int nchunks, char* smem, int bid, int nb) {
  bf16_t* Cm = (bf16_t*)smem;
  bf16_t* Gm = Cm + 128 * 130;
  char* R = (char*)(Gm + 128 * 130);
  bf16_t* Bm = (bf16_t*)R;
  float* xd = (float*)R;
  bf16_t* Sm = (bf16_t*)(R + 128 * 130 * 2);
  float* csl = (float*)(Sm + 64 * 130);
  float* exl = csl + 128;
  const int tid = otid();
  for (int it = bid; it < nchunks * 16; it += nb) {
    const int gc = it >> 4, head = it & 15, g = head >> 3;
    const int row0 = gc * 128;
    __syncthreads();
    for (int i = tid; i < 128 * 128; i += NTHR) {
      const int j = i >> 7, nn = i & 127;
      const bf16_t* xr = P.xbc + (size_t)(row0 + j) * 1536 + 1024 + g * 128 + nn;
      Bm[j * 130 + nn] = xr[0];
      Cm[j * 130 + nn] = xr[256];
    }
    __syncthreads();
    {
      const int s = tid & 127, jh = tid >> 7;
      for (int jb = 0; jb < 2; ++jb) {
        float acc[32];
#pragma unroll
        for (int i = 0; i < 32; ++i) acc[i] = 0.f;
        for (int nn = 0; nn < 128; ++nn) {
          const float b = bf2f(Bm[s * 130 + nn]);
#pragma unroll
          for (int i = 0; i < 32; ++i) acc[i] += bf2f(Cm[(jh * 64 + jb * 32 + i) * 130 + nn]) * b;
        }
#pragma unroll
        for (int i = 0; i < 32; ++i) Gm[(jh * 64 + jb * 32 + i) * 130 + s] = f2bf(acc[i]);
      }
    }
    const int pp = tid & 63, jg = tid >> 6;
    float yacc[32];
#pragma unroll
    for (int i = 0; i < 32; ++i) yacc[i] = 0.f;
    for (int dir = 0; dir < 2; ++dir) {
      const int dh = dir * 16 + head;
      __syncthreads();
      for (int i = tid; i < 128 * 64; i += NTHR) {
        const int j = i >> 6, p2 = i & 63, row = row0 + j;
        xd[i] = bf2f(P.xbc[(size_t)row * 1536 + head * 64 + p2]) * P.dtv[(size_t)row * 32 + dh];
      }
      const bf16_t* st = P.states + (size_t)(gc * 32 + dh) * 8192;
      for (int i = tid; i < 64 * 128; i += NTHR) Sm[(i >> 7) * 130 + (i & 127)] = st[i];
      if (tid < 128) {
        const float cs = P.csv[(size_t)(row0 + tid) * 32 + dh];
        csl[tid] = cs;
        exl[tid] = tid > 0 ? P.csv[(size_t)(row0 + tid - 1) * 32 + dh] : 0.f;
      }
      __syncthreads();
      const float atot = csl[127];
      for (int s = 0; s < 128; ++s) {
        const float xv = xd[s * 64 + pp];
        const float cs_s = csl[s], ex_s = exl[s];
#pragma unroll
        for (int i = 0; i < 32; ++i) {
          const int j = jg * 32 + i;
          if (dir == 0) {
            if (s <= j) yacc[i] += bf2f(Gm[j * 130 + s]) * expf(csl[j] - cs_s) * xv;
          } else {
            if (s >= j) yacc[i] += bf2f(Gm[j * 130 + s]) * expf(ex_s - exl[j]) * xv;
          }
        }
      }
      float offacc[32];
#pragma unroll
      for (int i = 0; i < 32; ++i) offacc[i] = 0.f;
      for (int nn = 0; nn < 128; ++nn) {
        const float sv = bf2f(Sm[pp * 130 + nn]);
#pragma unroll
        for (int i = 0; i < 32; ++i) offacc[i] += bf2f(Cm[(jg * 32 + i) * 130 + nn]) * sv;
      }
#pragma unroll
      for (int i = 0; i < 32; ++i) {
        const int j = jg * 32 + i;
        const float sc = dir == 0 ? expf(csl[j]) : expf(atot - exl[j]);
        yacc[i] += offacc[i] * sc;
      }
    }
    const float dsk = P.d_skip[layer * 16 + head];
#pragma unroll
    for (int i = 0; i < 32; ++i) {
      const int row = row0 + jg * 32 + i;
      const float xs = bf2f(P.xbc[(size_t)row * 1536 + head * 64 + pp]);
      const float z = bf2f(P.p[(size_t)row * INW + OFF_Z + head * 64 + pp]);
      const float y = (yacc[i] + dsk * xs) * silu_f(z);
      P.concat[(size_t)row * 2048 + head * 64 + pp] = f2bf(y);
    }
  }
}

__device__ void ph_ssdnorm(const Params& P, int layer, int nrows, int bid, int nb) {
  const int wave = otid() >> 6, lane = otid() & 63;
  const float* g = P.ssd_norm_g + layer * 1024;
  for (int row = bid * 4 + wave; row < nrows; row += nb * 4) {
    bf16_t* src = P.concat + (size_t)row * 2048;
    float v[16];
    float ss = 0.f;
#pragma unroll
    for (int i = 0; i < 4; ++i) {
      const uint2 pk = *(const uint2*)(src + i * 256 + lane * 4);
      v[i * 4 + 0] = bf2f((bf16_t)(pk.x & 0xffff)); v[i * 4 + 1] = bf2f((bf16_t)(pk.x >> 16));
      v[i * 4 + 2] = bf2f((bf16_t)(pk.y & 0xffff)); v[i * 4 + 3] = bf2f((bf16_t)(pk.y >> 16));
    }
#pragma unroll
    for (int i = 0; i < 16; ++i) ss += v[i] * v[i];
    ss = wave_sum(ss);
    const float rstd = rsqrtf(ss * (1.f / 1024.f) + 1e-6f);
#pragma unroll
    for (int i = 0; i < 4; ++i) {
      const int idx = i * 256 + lane * 4;
      uint2 pk;
      pk.x = (uint32_t)f2bf(v[i * 4 + 0] * rstd * g[idx + 0]) | ((uint32_t)f2bf(v[i * 4 + 1] * rstd * g[idx + 1]) << 16);
      pk.y = (uint32_t)f2bf(v[i * 4 + 2] * rstd * g[idx + 2]) | ((uint32_t)f2bf(v[i * 4 + 3] * rstd * g[idx + 3]) << 16);
      *(uint2*)(src + idx) = pk;
    }
  }
}

__device__ void ph_pool(const Params& P, int layer, int nrows, char* smem, int bid, int nb) {
  float* pooled = (float*)smem;
  const int tid = otid();
  const int ntile = nrows / 32;
  for (int it = bid; it < ntile * 4; it += nb) {
    const int tt = it >> 2, gi = it & 3;
    const int w = 2 << gi;
    const int row0 = tt * 32;
    __syncthreads();
    for (int i = tid; i < 32 * 128; i += NTHR) {
      const int t = i >> 7, ch = i & 127, row = row0 + t;
      int l, L, base;
      if (row < NLAT) { l = row & 4095; L = 4096; base = row - l; } else { l = (row - NLAT) & 255; L = 256; base = row - l; }
      int lo = l - w / 2; lo = lo < 0 ? 0 : lo;
      int hi = l + w - w / 2 - 1; hi = hi > L - 1 ? L - 1 : hi;
      float s = 0.f;
      for (int r = lo; r <= hi; ++r) s += bf2f(P.p[(size_t)(base + r) * INW + OFF_POOL + gi * 128 + ch]);
      pooled[i] = s / (float)(hi - lo + 1) - bf2f(P.p[(size_t)row * INW + OFF_POOL + gi * 128 + ch]);
    }
    __syncthreads();
    const int o = tid & 127, tg = tid >> 7;
    const float* W = P.pool_w + ((size_t)(layer * 4 + gi) * 128) * 128 + o;
    float acc[16];
#pragma unroll
    for (int i = 0; i < 16; ++i) acc[i] = 0.f;
    for (int k = 0; k < 128; ++k) {
      const float wv = W[(size_t)k * 128];
#pragma unroll
      for (int i = 0; i < 16; ++i) acc[i] += pooled[(tg * 16 + i) * 128 + k] * wv;
    }
    const float sc = P.pool_scale[layer * 512 + gi * 128 + o];
#pragma unroll
    for (int i = 0; i < 16; ++i)
      P.concat[(size_t)(row0 + tg * 16 + i) * 2048 + 1024 + gi * 128 + o] = f2bf(acc[i] * sc);
  }
}

__device__ void ph_na(const Params& P, int layer, int nrows, char* smem, int bid, int nb) {
  const int wave = otid() >> 6, lane = otid() & 63;
  float* qs = (float*)smem + wave * 448;
  float* ps = qs + 64;
  const float* rpb = P.na_rpb + (size_t)layer * 8 * 15 * 31;
  for (int it = bid * 4 + wave; it < nrows * 8; it += nb * 4) {
    const int row = it >> 3, hd = it & 7;
    const bool lat = row < NLAT;
    int b, r = 0, cq = 0, r0 = 0, c0 = 0;
    if (lat) {
      b = row >> 12; const int l = row & 4095; r = l >> 6; cq = l & 63;
      r0 = r - 4; r0 = r0 < 0 ? 0 : (r0 > 56 ? 56 : r0);
      c0 = cq - 8; c0 = c0 < 0 ? 0 : (c0 > 48 ? 48 : c0);
    } else {
      b = (row - NLAT) >> 8;
    }
    qs[lane] = bf2f(P.p[(size_t)row * INW + OFF_Q + hd * 64 + lane]) * 0.125f;
    __builtin_amdgcn_wave_barrier();
    const int nkeys = lat ? 384 : 256;
    float sc[6];
    float mx = -3.0e38f;
#pragma unroll
    for (int t = 0; t < 6; ++t) {
      const int n = t * 64 + lane;
      float s = -3.0e38f;
      if (n < nkeys) {
        int krow; float bias = 0.f;
        if (lat && n < 128) {
          const int kr = n >> 4, kc = n & 15;
          const int rk = r0 + kr, ck = c0 + kc;
          krow = b * 4096 + rk * 64 + ck;
          bias = rpb[(hd * 15 + (rk - r + 7)) * 31 + (ck - cq + 15)];
        } else {
          krow = NLAT + b * 256 + (lat ? n - 128 : n);
        }
        const bf16_t* kp = P.p + (size_t)krow * INW + OFF_K + hd * 64;
        float d = 0.f;
#pragma unroll
        for (int v8 = 0; v8 < 8; ++v8) {
          const uint4 kk = *(const uint4*)(kp + v8 * 8);
          const bf16_t* ke = (const bf16_t*)&kk;
#pragma unroll
          for (int e = 0; e < 8; ++e) d += qs[v8 * 8 + e] * bf2f(ke[e]);
        }
        s = d + bias;
      }
      sc[t] = s;
      mx = fmaxf(mx, s);
    }
    mx = wave_max(mx);
    float sum = 0.f;
#pragma unroll
    for (int t = 0; t < 6; ++t) {
      const int n = t * 64 + lane;
      const float e = (n < nkeys) ? expf(sc[t] - mx) : 0.f;
      sum += e;
      ps[n] = e;
    }
    sum = wave_sum(sum);
    __builtin_amdgcn_wave_barrier();
    float acc = 0.f;
    for (int n = 0; n < nkeys; ++n) {
      int krow;
      if (lat && n < 128) krow = b * 4096 + (r0 + (n >> 4)) * 64 + c0 + (n & 15);
      else krow = NLAT + b * 256 + (lat ? n - 128 : n);
      acc += ps[n] * bf2f(P.p[(size_t)krow * INW + OFF_V + hd * 64 + lane]);
    }
    P.concat[(size_t)row * 2048 + 1536 + hd * 64 + lane] = f2bf(acc / sum);
    __builtin_amdgcn_wave_barrier();
  }
}

__device__ void ph_peer_topk(const Params& P, int layer, int nrows, char* smem, int bid, int nb) {
  bf16_t* Ks = (bf16_t*)smem;
  float* qt = (float*)(smem + 33280);
  float* sc = qt + 32 * 256;
  float* tv = sc + 64 * 129;
  int* ti = (int*)(tv + 64 * 16);
  const int tid = otid();
  const int ntile = nrows / 32;
  for (int it = bid; it < ntile * 8; it += nb) {
    const int hd = it % 8, tt = it / 8;
    const int row0 = tt * 32;
    __syncthreads();
    for (int i = tid; i < 32 * 256; i += NTHR) {
      const int t = i >> 8, d = i & 255;
      qt[i] = bf2f(P.q[(size_t)(row0 + t) * 2048 + hd * 256 + d]);
    }
    for (int half = 0; half < 2; ++half) {
      __syncthreads();
      const float* kk = P.peer_keys + ((size_t)((layer * 8 + hd) * 2 + half) * 128) * 128;
      for (int i = tid; i < 128 * 128; i += NTHR) Ks[(i >> 7) * 130 + (i & 127)] = f2bf(kk[i]);
      __syncthreads();
      const int k = tid & 127, tg = tid >> 7;
      float acc[16];
#pragma unroll
      for (int i = 0; i < 16; ++i) acc[i] = 0.f;
      for (int d = 0; d < 128; ++d) {
        const float kv = bf2f(Ks[k * 130 + d]);
#pragma unroll
        for (int i = 0; i < 16; ++i) acc[i] += qt[(tg * 16 + i) * 256 + half * 128 + d] * kv;
      }
#pragma unroll
      for (int i = 0; i < 16; ++i) sc[((tg * 16 + i) * 2 + half) * 129 + k] = acc[i];
    }
    __syncthreads();
    if (tid < 64) {
      float* s = sc + tid * 129;
      for (int r = 0; r < 16; ++r) {
        float best = -3.0e38f; int bi = 0;
        for (int k = 0; k < 128; ++k) { const float v = s[k]; if (v > best) { best = v; bi = k; } }
        tv[tid * 16 + r] = best; ti[tid * 16 + r] = bi;
        s[bi] = -3.0e38f;
      }
    }
    __syncthreads();
    float* cand = qt;
    for (int i = tid; i < 32 * 256; i += NTHR) {
      const int t = i >> 8, a = (i >> 4) & 15, b2 = i & 15;
      cand[i] = tv[(t * 2 + 0) * 16 + a] + tv[(t * 2 + 1) * 16 + b2];
    }
    __syncthreads();
    if (tid < 32) {
      float* cd = cand + tid * 256;
      float ts[16];
      const int row = row0 + tid;
      float mx = 0.f;
#pragma unroll
      for (int r = 0; r < 16; ++r) {
        float best = -3.0e38f; int bi = 0;
        for (int k = 0; k < 256; ++k) { const float v = cd[k]; if (v > best) { best = v; bi = k; } }
        cd[bi] = -3.0e38f;
        ts[r] = best;
        if (r == 0) mx = best;
        const int e = ti[(tid * 2 + 0) * 16 + (bi >> 4)] * 128 + ti[(tid * 2 + 1) * 16 + (bi & 15)];
        P.sel_idx[(size_t)row * 128 + hd * 16 + r] = e;
      }
      float sum = 0.f;
#pragma unroll
      for (int r = 0; r < 16; ++r) { ts[r] = expf(ts[r] - mx); sum += ts[r]; }
      const float inv = 1.f / sum;
#pragma unroll
      for (int r = 0; r < 16; ++r) P.sel_g[(size_t)row * 128 + hd * 16 + r] = ts[r] * inv;
    }
  }
}

__device__ void ph_peer_gather(const Params& P, int layer, int nrows, int bid, int nb) {
  const int wave = otid() >> 6, lane = otid() & 63;
  const float* UT = P.peer_u + (size_t)layer * 16384 * 1024;
  const float* VT = P.peer_v + (size_t)layer * 16384 * 1024;
  for (int row = bid * 4 + wave; row < nrows; row += nb * 4) {
    float xv[16], o[16];
#pragma unroll
    for (int i = 0; i < 4; ++i) {
      const uint2 pk = *(const uint2*)(P.u + (size_t)row * DM + i * 256 + lane * 4);
      xv[i * 4 + 0] = bf2f((bf16_t)(pk.x & 0xffff)); xv[i * 4 + 1] = bf2f((bf16_t)(pk.x >> 16));
      xv[i * 4 + 2] = bf2f((bf16_t)(pk.y & 0xffff)); xv[i * 4 + 3] = bf2f((bf16_t)(pk.y >> 16));
    }
#pragma unroll
    for (int i = 0; i < 16; ++i) o[i] = 0.f;
    for (int k = 0; k < 128; ++k) {
      const int e = P.sel_idx[(size_t)row * 128 + k];
      const float gk = P.sel_g[(size_t)row * 128 + k];
      const float4* ur = (const float4*)(UT + (size_t)e * 1024);
      float d = 0.f;
#pragma unroll
      for (int i = 0; i < 4; ++i) {
        const float4 uu = ur[i * 64 + lane];
        d += uu.x * xv[i * 4 + 0] + uu.y * xv[i * 4 + 1] + uu.z * xv[i * 4 + 2] + uu.w * xv[i * 4 + 3];
      }
      d = wave_sum(d);
      const float a = gelu_f(d) * gk;
      const float4* vr = (const float4*)(VT + (size_t)e * 1024);
#pragma unroll
      for (int i = 0; i < 4; ++i) {
        const float4 vv = vr[i * 64 + lane];
        o[i * 4 + 0] += a * vv.x; o[i * 4 + 1] += a * vv.y; o[i * 4 + 2] += a * vv.z; o[i * 4 + 3] += a * vv.w;
      }
    }
    const float* gate = P.mod + (size_t)(layer * 5 + modrow(row)) * MODW + 5120;
    float* hr = P.h + (size_t)row * DM;
#pragma unroll
    for (int i = 0; i < 4; ++i) {
      const int idx = i * 256 + lane * 4;
      float4 hv = *(float4*)(hr + idx);
      const float4 gg = *(const float4*)(gate + idx);
      hv.x += gg.x * o[i * 4 + 0]; hv.y += gg.y * o[i * 4 + 1]; hv.z += gg.z * o[i * 4 + 2]; hv.w += gg.w * o[i * 4 + 3];
      *(float4*)(hr + idx) = hv;
    }
  }
}

__device__ void ph_final(const Params& P, int bid, int nb) {
  const int wave = otid() >> 6, lane = otid() & 63;
  for (int row = bid * 4 + wave; row < NLAT; row += nb * 4) {
    const float* src = P.h + (size_t)row * DM;
    float4 v[4];
    float ss = 0.f;
#pragma unroll
    for (int i = 0; i < 4; ++i) {
      v[i] = ((const float4*)src)[i * 64 + lane];
      ss += v[i].x * v[i].x + v[i].y * v[i].y + v[i].z * v[i].z + v[i].w * v[i].w;
    }
    ss = wave_sum(ss);
    const float rstd = rsqrtf(ss * (1.f / 1024.f) + 1e-6f);
#pragma unroll
    for (int i = 0; i < 4; ++i) {
      const int idx = i * 256 + lane * 4;
      const float4 gg = *(const float4*)(P.final_g + idx);
      float4 o;
      o.x = v[i].x * rstd * gg.x; o.y = v[i].y * rstd * gg.y; o.z = v[i].z * rstd * gg.z; o.w = v[i].w * rstd * gg.w;
      *(float4*)(P.out + (size_t)row * DM + idx) = o;
    }
  }
}

enum {
  PH_PREP = 0, PH_NORM1, PH_INPROJ, PH_CONV, PH_SSDPREP, PH_STATES, PH_SCAN, PH_SSDY, PH_SSDNORM, PH_POOL, PH_NA,
  PH_OUTPROJ, PH_NORM2, PH_QGEMM, PH_TOPK, PH_GATHER, PH_FINAL
};

#define SMEM_BYTES 117760

__device__ __forceinline__ void run_phase(const Params& P, int ph, int layer, char* smem, int bid, int nb) {
  const float* hl = layer == 0 ? P.x : P.h;
  const float* hc = layer == 0 ? P.ctx : P.h + (size_t)NLAT * DM;
  const int nrows = layer == 0 ? NTOK : NLAT;
  switch (ph) {
    case PH_PREP:
      ph_mod(P, (float*)smem, bid, nb);
      for (int l = 0; l < 2; ++l) {
        ph_transpose(P.w_in + (size_t)l * 1024 * INW, P.w_inT + (size_t)l * INW_PAD * 1024, 1024, INW, INW_PAD, (float*)smem, bid, nb);
        ph_transpose(P.w_out + (size_t)l * 2048 * 1024, P.w_outT + (size_t)l * 1024 * 2048, 2048, 1024, 1024, (float*)smem, bid, nb);
        ph_transpose(P.peer_wq + (size_t)l * 1024 * 2048, P.w_qT + (size_t)l * 2048 * 1024, 1024, 2048, 2048, (float*)smem, bid, nb);
      }
      break;
    case PH_NORM1:
      ph_norm(hl, hc, P.norm1_g + layer * 1024, P.mod + (size_t)layer * 5 * MODW, 0, 1024, NTOK, P.u, bid, nb);
      break;
    case PH_INPROJ:
      ph_gemm<EPI_INPROJ>(P, layer, P.u, P.w_inT + (size_t)layer * INW_PAD * 1024, NTOK, INW_PAD, 1024, hl, hc, smem, bid, nb);
      break;
    case PH_CONV: ph_conv(P, layer, bid, nb); break;
    case PH_SSDPREP: ph_ssdprep(P, layer, bid, nb); break;
    case PH_STATES: ph_states(P, smem, bid, nb); break;
    case PH_SCAN: ph_scan(P, bid, nb); break;
    case PH_SSDY: ph_ssdy(P, layer, nrows / 128, smem, bid, nb); break;
    case PH_SSDNORM: ph_ssdnorm(P, layer, nrows, bid, nb); break;
    case PH_POOL: ph_pool(P, layer, nrows, smem, bid, nb); break;
    case PH_NA: ph_na(P, layer, nrows, smem, bid, nb); break;
    case PH_OUTPROJ:
      ph_gemm<EPI_OUTPROJ>(P, layer, P.concat, P.w_outT + (size_t)layer * 1024 * 2048, nrows, 1024, 2048, hl, hc, smem, bid, nb);
      break;
    case PH_NORM2:
      ph_norm(P.h, P.h + (size_t)NLAT * DM, P.norm2_g + layer * 1024, P.mod + (size_t)layer * 5 * MODW, 3072, 4096, nrows, P.u, bid, nb);
      break;
    case PH_QGEMM:
      ph_gemm<EPI_Q>(P, layer, P.u, P.w_qT + (size_t)layer * 2048 * 1024, nrows, 2048, 1024, hl, hc, smem, bid, nb);
      break;
    case PH_TOPK: ph_peer_topk(P, layer, nrows, smem, bid, nb); break;
    case PH_GATHER: ph_peer_gather(P, layer, nrows, bid, nb); break;
    case PH_FINAL: ph_final(P, bid, nb); break;
  }
}

namespace cg = cooperative_groups;
__global__ void __launch_bounds__(NTHR) k_mega(Params P) {
  __shared__ __attribute__((aligned(16))) char smem[SMEM_BYTES];
  cg::grid_group grid = cg::this_grid();
  const int bid = blockIdx.x, nb = gridDim.x;
  run_phase(P, PH_PREP, 0, smem, bid, nb);
  grid.sync();
#pragma unroll 1
  for (int layer = 0; layer < 2; ++layer) {
    run_phase(P, PH_NORM1, layer, smem, bid, nb); grid.sync();
    run_phase(P, PH_INPROJ, layer, smem, bid, nb); grid.sync();
    run_phase(P, PH_CONV, layer, smem, bid, nb); grid.sync();
    run_phase(P, PH_SSDPREP, layer, smem, bid, nb); grid.sync();
    run_phase(P, PH_STATES, layer, smem, bid, nb); grid.sync();
    run_phase(P, PH_SCAN, layer, smem, bid, nb); grid.sync();
    run_phase(P, PH_SSDY, layer, smem, bid, nb); grid.sync();
    run_phase(P, PH_SSDNORM, layer, smem, bid, nb); grid.sync();
    run_phase(P, PH_POOL, layer, smem, bid, nb); grid.sync();
    run_phase(P, PH_NA, layer, smem, bid, nb); grid.sync();
    run_phase(P, PH_OUTPROJ, layer, smem, bid, nb); grid.sync();
    run_phase(P, PH_NORM2, layer, smem, bid, nb); grid.sync();
    run_phase(P, PH_QGEMM, layer, smem, bid, nb); grid.sync();
    run_phase(P, PH_TOPK, layer, smem, bid, nb); grid.sync();
    run_phase(P, PH_GATHER, layer, smem, bid, nb); grid.sync();
  }
  run_phase(P, PH_FINAL, 0, smem, bid, nb);
}

extern "C" void kernel_launch(void* const* d_in, const int* in_sizes, int n_in, void* d_out, int out_size, void* d_ws,
                              size_t ws_size, hipStream_t stream) {
  Params P{};
  const float* const* in = (const float* const*)d_in;
  P.x = in[0]; P.c = in[1]; P.ctx = in[2]; P.c_ctx = in[3]; P.ada_w = in[4]; P.ada_b = in[5]; P.norm1_g = in[6];
  P.w_in = in[7]; P.conv_w = in[8]; P.conv_b = in[9]; P.a_log = in[10]; P.dt_bias = in[11]; P.d_skip = in[12];
  P.ssd_norm_g = in[13]; P.pool_w = in[14]; P.pool_scale = in[15]; P.na_rpb = in[16]; P.w_out = in[17];
  P.norm2_g = in[18]; P.peer_wq = in[19]; P.peer_keys = in[20]; P.peer_u = in[21]; P.peer_v = in[22]; P.final_g = in[23];
  P.out = (float*)d_out;
  char* w = (char*)d_ws;
  size_t off = 0;
  auto take = [&](size_t bytes) { char* r = w + off; off += (bytes + 255) & ~(size_t)255; return r; };
  P.mod = (float*)take((size_t)2 * 5 * MODW * 4);
  P.h = (float*)take((size_t)NTOK * DM * 4);
  P.p = (bf16_t*)take((size_t)NTOK * INW * 2);
  P.q = P.p;
  P.dtraw = (float*)take((size_t)NTOK * 32 * 4);
  P.dtv = (float*)take((size_t)NTOK * 32 * 4);
  P.csv = (float*)take((size_t)NTOK * 32 * 4);
  P.xbc = (bf16_t*)take((size_t)NTOK * 1536 * 2);
  P.states = (bf16_t*)take((size_t)NCHUNK * 32 * 8192 * 2);
  P.concat = (bf16_t*)take((size_t)NTOK * 2048 * 2);
  P.u = P.concat;
  P.sel_idx = (int*)take((size_t)NTOK * 128 * 4);
  P.sel_g = (float*)take((size_t)NTOK * 128 * 4);
  P.w_inT = (bf16_t*)take((size_t)2 * INW_PAD * 1024 * 2);
  P.w_outT = (bf16_t*)take((size_t)2 * 1024 * 2048 * 2);
  P.w_qT = (bf16_t*)take((size_t)2 * 2048 * 1024 * 2);
  if (off > ws_size) { fprintf(stderr, "workspace too small: need %zu have %zu\n", off, ws_size); return; }

  static int grid_blocks = 0;
  if (!grid_blocks) {
    int dev = 0, cus = 0, per_cu = 0;
    hipGetDevice(&dev);
    hipDeviceGetAttribute(&cus, hipDeviceAttributeMultiprocessorCount, dev);
    hipOccupancyMaxActiveBlocksPerMultiprocessor(&per_cu, k_mega, NTHR, 0);
    if (per_cu > 4) per_cu = 4;
    grid_blocks = cus * per_cu;
  }
  void* args[] = {&P};
  hipError_t e = hipLaunchCooperativeKernel((void*)k_mega, dim3(grid_blocks), dim3(NTHR), args, 0, stream);
  if (e != hipSuccess) fprintf(stderr, "cooperative launch failed: %s (grid %d)\n", hipGetErrorString(e), grid_blocks);
}
```

```cpp
#include <hip/hip_runtime.h>
#include <hip/hip_bf16.h>
#include <hip/hip_cooperative_groups.h>
#include <stdint.h>
#include <stdio.h>

typedef unsigned short bf16_t;
typedef __attribute__((ext_vector_type(8))) short bf16x8;
typedef __attribute__((ext_vector_type(4))) float f32x4;

#define NTHR 512
#define NWAVE 8
constexpr int DM = 1024;
constexpr int SEQ = 4096;
constexpr int NLAT = 16384;
constexpr int NCTXR = 1024;
constexpr int NTOK = 17408;
constexpr int INW = 4640;
constexpr int PW = 4608;
constexpr int OFF_Z = 0, OFF_XBC = 1024, OFF_POOL = 2560, OFF_Q = 3072, OFF_K = 3584, OFF_V = 4096;
constexpr int NCHUNK = 136;
constexpr int MODW = 6144;

constexpr size_t al256(size_t x) { return (x + 255) & ~(size_t)255; }
constexpr size_t WS_MOD = 0;
constexpr size_t WS_H = WS_MOD + al256((size_t)2 * 5 * MODW * 4);
constexpr size_t WS_P = WS_H + al256((size_t)NTOK * DM * 4);
constexpr size_t WS_TABU = WS_P + (size_t)80 * 1024 * 1024;
constexpr size_t WS_TABV = WS_TABU + (size_t)16384 * 1024 * 2;
constexpr size_t WS_DTRAW = WS_P + al256((size_t)NTOK * PW * 2);
constexpr size_t WS_DTV = WS_DTRAW + al256((size_t)NTOK * 32 * 4);
constexpr size_t WS_CSV = WS_DTV + al256((size_t)NTOK * 32 * 4);
constexpr size_t WS_XBC = WS_CSV + al256((size_t)NTOK * 32 * 4);
constexpr size_t WS_VTL = WS_XBC + al256((size_t)NTOK * 512 * 2);
constexpr size_t WS_VTC = WS_VTL + al256((size_t)4 * 8 * 64 * 4096 * 2);
constexpr size_t WS_KEYSB = WS_VTC + al256((size_t)4 * 8 * 64 * 256 * 2);
constexpr size_t WS_STATES = WS_XBC + al256((size_t)NTOK * 1536 * 2);
static_assert(WS_KEYSB + (size_t)2 * 8 * 2 * 128 * 128 * 2 <= WS_STATES, "must fit in the old xbc region");
constexpr size_t WS_CONCAT = WS_STATES + al256((size_t)NCHUNK * 32 * 8192 * 2);
constexpr size_t WS_SELIDX = WS_CONCAT + al256((size_t)NTOK * 2048 * 2);
constexpr size_t WS_SELG = WS_SELIDX + al256((size_t)NTOK * 128 * 4);
constexpr size_t WS_WINT = WS_SELG + al256((size_t)NTOK * 128 * 4);
constexpr size_t WS_WDTT = WS_WINT + al256((size_t)2 * PW * 1024 * 2);
constexpr size_t WS_WOUTT = WS_WDTT + al256((size_t)2 * 128 * 1024 * 2);
constexpr size_t WS_WQT = WS_WOUTT + al256((size_t)2 * 1024 * 2048 * 2);
constexpr size_t WS_TOTAL = WS_WQT + al256((size_t)2 * 2048 * 1024 * 2);
static_assert(WS_TABV + (size_t)16384 * 1024 * 2 <= WS_DTRAW, "tables must fit in the tail of p");
static_assert((size_t)NTOK * 2048 * 2 <= (size_t)80 * 1024 * 1024, "q must fit below the tables");

struct Params {
  const float *x, *c, *ctx, *c_ctx, *ada_w, *ada_b, *norm1_g, *w_in, *conv_w, *conv_b, *a_log, *dt_bias, *d_skip,
      *ssd_norm_g, *pool_w, *pool_scale, *na_rpb, *w_out, *norm2_g, *peer_wq, *peer_keys, *peer_u, *peer_v, *final_g;
  float* out;
  char* ws;
  __device__ __forceinline__ float* mod() const { return (float*)(ws + WS_MOD); }
  __device__ __forceinline__ float* h() const { return (float*)(ws + WS_H); }
  __device__ __forceinline__ bf16_t* u() const { return (bf16_t*)(ws + WS_CONCAT); }
  __device__ __forceinline__ bf16_t* p() const { return (bf16_t*)(ws + WS_P); }
  __device__ __forceinline__ float* dtraw() const { return (float*)(ws + WS_DTRAW); }
  __device__ __forceinline__ float* dtv() const { return (float*)(ws + WS_DTV); }
  __device__ __forceinline__ float* csv() const { return (float*)(ws + WS_CSV); }
  __device__ __forceinline__ bf16_t* xbc() const { return (bf16_t*)(ws + WS_XBC); }
  __device__ __forceinline__ bf16_t* states() const { return (bf16_t*)(ws + WS_STATES); }
  __device__ __forceinline__ bf16_t* concat() const { return (bf16_t*)(ws + WS_CONCAT); }
  __device__ __forceinline__ bf16_t* q() const { return (bf16_t*)(ws + WS_P); }
  __device__ __forceinline__ int* sel_idx() const { return (int*)(ws + WS_SELIDX); }
  __device__ __forceinline__ float* sel_g() const { return (float*)(ws + WS_SELG); }
  __device__ __forceinline__ bf16_t* w_inT() const { return (bf16_t*)(ws + WS_WINT); }
  __device__ __forceinline__ bf16_t* w_dtT() const { return (bf16_t*)(ws + WS_WDTT); }
  __device__ __forceinline__ bf16_t* w_outT() const { return (bf16_t*)(ws + WS_WOUTT); }
  __device__ __forceinline__ bf16_t* w_qT() const { return (bf16_t*)(ws + WS_WQT); }
  __device__ __forceinline__ bf16_t* vtl() const { return (bf16_t*)(ws + WS_VTL); }
  __device__ __forceinline__ bf16_t* vtc() const { return (bf16_t*)(ws + WS_VTC); }
  __device__ __forceinline__ bf16_t* keysb() const { return (bf16_t*)(ws + WS_KEYSB); }
  __device__ __forceinline__ bf16_t* tabU() const { return (bf16_t*)(ws + WS_TABU); }
  __device__ __forceinline__ bf16_t* tabV() const { return (bf16_t*)(ws + WS_TABV); }
};

__device__ __forceinline__ int otid(int wv) {
  int l;
  asm volatile("v_mbcnt_lo_u32_b32 %0, -1, 0\n\tv_mbcnt_hi_u32_b32 %0, -1, %0" : "=v"(l));
  return (wv << 6) | l;
}
__device__ __forceinline__ float bf2f(bf16_t v) { return __uint_as_float(((uint32_t)v) << 16); }
__device__ __forceinline__ bf16_t f2bf(float f) {
  uint32_t u = __float_as_uint(f);
  u += 0x7fffu + ((u >> 16) & 1u);
  return (bf16_t)(u >> 16);
}
#define DPP_F(v, ctrl) __int_as_float(__builtin_amdgcn_update_dpp(0, __float_as_int(v), (ctrl), 0xf, 0xf, true))
__device__ __forceinline__ float wave_sum(float v) {
  v += DPP_F(v, 0xB1);
  v += DPP_F(v, 0x4E);
  v += DPP_F(v, 0x141);
  v += DPP_F(v, 0x140);
  const int iv = __float_as_int(v);
  return __int_as_float(__builtin_amdgcn_readlane(iv, 0)) + __int_as_float(__builtin_amdgcn_readlane(iv, 16)) +
         __int_as_float(__builtin_amdgcn_readlane(iv, 32)) + __int_as_float(__builtin_amdgcn_readlane(iv, 48));
}
__device__ __forceinline__ float wave_max(float v) {
  v = fmaxf(v, DPP_F(v, 0xB1));
  v = fmaxf(v, DPP_F(v, 0x4E));
  v = fmaxf(v, DPP_F(v, 0x141));
  v = fmaxf(v, DPP_F(v, 0x140));
  const int iv = __float_as_int(v);
  return fmaxf(fmaxf(__int_as_float(__builtin_amdgcn_readlane(iv, 0)), __int_as_float(__builtin_amdgcn_readlane(iv, 16))),
               fmaxf(__int_as_float(__builtin_amdgcn_readlane(iv, 32)), __int_as_float(__builtin_amdgcn_readlane(iv, 48))));
}
__device__ __forceinline__ float silu_f(float v) { return v / (1.f + expf(-v)); }
__device__ __forceinline__ float softplus_f(float v) { return fmaxf(v, 0.f) + log1pf(expf(-fabsf(v))); }
__device__ __forceinline__ float gelu_f(float v) { return 0.5f * v * (1.f + erff(v * 0.70710678118654752f)); }

__device__ __forceinline__ void unpack8(const uint4 v, float* f) {
  f[0] = __uint_as_float(v.x << 16); f[1] = __uint_as_float(v.x & 0xffff0000u);
  f[2] = __uint_as_float(v.y << 16); f[3] = __uint_as_float(v.y & 0xffff0000u);
  f[4] = __uint_as_float(v.z << 16); f[5] = __uint_as_float(v.z & 0xffff0000u);
  f[6] = __uint_as_float(v.w << 16); f[7] = __uint_as_float(v.w & 0xffff0000u);
}
__device__ __forceinline__ uint32_t pack2(float a, float b) { return (uint32_t)f2bf(a) | ((uint32_t)f2bf(b) << 16); }
typedef short s16x4 __attribute__((ext_vector_type(4)));
typedef __attribute__((address_space(3))) s16x4 lds_s16x4;
__device__ __forceinline__ bf16x8 tr_read2(const char* a0, const char* a1) {
  const s16x4 a = __builtin_amdgcn_ds_read_tr16_b64_v4i16((lds_s16x4*)a0);
  const s16x4 b = __builtin_amdgcn_ds_read_tr16_b64_v4i16((lds_s16x4*)a1);
  return (bf16x8){a[0], a[1], a[2], a[3], b[0], b[1], b[2], b[3]};
}

__device__ __forceinline__ const float* hrow(const float* hl, const float* hc, int row) {
  return row < NLAT ? hl + (size_t)row * DM : hc + (size_t)(row - NLAT) * DM;
}
__device__ __forceinline__ int modrow(int row) { return row < NLAT ? (row >> 12) : 4; }

namespace pg8 {
#define PG8_LAS __attribute__((address_space(3)))
typedef unsigned short bf16_t;
typedef short bf16x8 __attribute__((ext_vector_type(8)));
typedef float f32x4 __attribute__((ext_vector_type(4)));
typedef unsigned u32x4 __attribute__((ext_vector_type(4)));
constexpr int BM = 256, BK = 64, HALF = 128, HTB = HALF * BK * 2  , STAGE_BYTES = 8 * HTB, NXCD = 8, WGM = 8;

__host__ __device__ __forceinline__ int lds_byte(int r, int c) { const int st = (r >> 4) * 2 + (c >> 5), rr = r & 15, cc = c & 31, ob = rr * 64 + cc * 2; return st * 1024 + (ob ^ (((ob >> 9) & 1) << 5)); }
__host__ __device__ __forceinline__ void stage_rc(int b, int& R, int& C) { const int st = b / 1024, sb = b % 1024, swz = sb ^ (((sb >> 9) & 1) << 5); R = (st >> 1) * 16 + swz / 64; C = (st & 1) * 32 + (swz % 64) / 2; }
__host__ __device__ __forceinline__ int perm32(int rho) { const int n = rho >> 4, i = rho & 15; return 8 * (i >> 2) + 4 * n + (i & 3); }

struct Unit { int pm, pn; };
struct Gemm { const bf16_t* A; const bf16_t* Bt; int M, N, K; };

struct StaticOrder {
    int nM, nN, nwg, G, c;
    __host__ __device__ void init(int M, int N, int G_, int c_) { nM = M / BM; nN = N / BM; nwg = nM * nN; G = G_; c = c_; }
    __host__ __device__ bool next(int i, Unit& u) const {
        const long L = (long)i * G + c; if (L >= nwg) return false;
        int wgid = (int)L; { const int q = nwg / NXCD, r = nwg % NXCD, xcd = wgid % NXCD, off = wgid / NXCD; wgid = (xcd < r ? xcd * (q + 1) : r * (q + 1) + (xcd - r) * q) + off; }
        const int nig = WGM * nN, gid = wgid / nig, fm = gid * WGM, gsz = (nM - fm) < WGM ? (nM - fm) : WGM;
        u.pm = fm + ((wgid % nig) % gsz); u.pn = (wgid % nig) / gsz; return true;
    }
    __device__ __forceinline__ void a_ready(const Unit&) const {}
    __device__ __forceinline__ void done(const Unit&) const {}
};

__device__ __forceinline__ unsigned cvt_pk_bf16(float lo, float hi) { unsigned r; asm volatile("v_cvt_pk_bf16_f32 %0, %1, %2" : "=v"(r) : "v"(lo), "v"(hi)); return r; }
typedef float f32x2 __attribute__((ext_vector_type(2)));
__device__ __forceinline__ f32x2 gelu_pk(f32x2 v) { return v; }
template <int ACT  > struct EpiBf16 {
    static constexpr bool PERM = true, AFTER_DRAIN = false;
    bf16_t* O; int ldc; const float* bias; int split_cols; size_t split_stride;
    __device__ __forceinline__ void operator()(const f32x4 (&acc)[2][2][4][2], const Unit& u, int wr, int wc, int fr, int fq) const {
        const int row0 = u.pm * BM + wr * 64 + fr; int colt = u.pn * BM; bf16_t* base = O;
        if (split_cols) { const int t = colt / split_cols; base += (size_t)t * split_stride; colt -= t * split_cols; }
        const int col0 = colt + wc * 32 + 8 * fq, bcol0 = u.pn * BM + wc * 32 + 8 * fq;
        f32x4 bv[2][2];
#pragma unroll
        for (int bj = 0; bj < 2; ++bj)
#pragma unroll
            for (int n = 0; n < 2; ++n) bv[bj][n] = bias ? *(const f32x4*)(bias + bcol0 + bj * HALF + 4 * n) : (f32x4){0.f, 0.f, 0.f, 0.f};
#pragma unroll
        for (int ai = 0; ai < 2; ++ai)
#pragma unroll
            for (int m = 0; m < 4; ++m) { bf16_t* rowp = base + (size_t)(row0 + ai * HALF + m * 16) * ldc + col0;
#pragma unroll
                for (int bj = 0; bj < 2; ++bj) { f32x4 v0 = acc[ai][bj][m][0] + bv[bj][0], v1 = acc[ai][bj][m][1] + bv[bj][1];
                    if (ACT == 1) { f32x2 a = gelu_pk((f32x2){v0[0], v0[1]}), b = gelu_pk((f32x2){v0[2], v0[3]}), c = gelu_pk((f32x2){v1[0], v1[1]}), d = gelu_pk((f32x2){v1[2], v1[3]});
                        v0 = (f32x4){a.x, a.y, b.x, b.y}; v1 = (f32x4){c.x, c.y, d.x, d.y}; }
                    if (ACT == 2) {
#pragma unroll
                        for (int j = 0; j < 4; ++j) { v0[j] = 0.5f * v0[j] * (1.0f + erff(v0[j] * 0.70710678f)); v1[j] = 0.5f * v1[j] * (1.0f + erff(v1[j] * 0.70710678f)); } }
                    u32x4 w; w.x = cvt_pk_bf16(v0[0], v0[1]); w.y = cvt_pk_bf16(v0[2], v0[3]); w.z = cvt_pk_bf16(v1[0], v1[1]); w.w = cvt_pk_bf16(v1[2], v1[3]);
                    *(u32x4*)(rowp + bj * HALF) = w; } }
    }
};

template <class Epi, class Sched, bool STAMP = false>
__device__ __forceinline__ void gemm_phase(int wv, PG8_LAS unsigned char* lds, const Gemm g, const Sched& S, const Epi& E, unsigned long long* stamps) {
    const int tid = otid(wv), wid = __builtin_amdgcn_readfirstlane(tid >> 6), lane = tid & 63, wr = wid >> 2, wc = wid & 3, fr = lane & 15, fq = lane >> 4;
    const int K = g.K, nt = K / BK;
    int ts_lo = 0, ts_hi = 0, nts = 0; const unsigned long long rt_entry = STAMP ? (unsigned long long)wall_clock64() : 0ull;
#define PG8_STAMP() do { if (STAMP && wid == 0 && nts < 64) { const unsigned long long _c = (unsigned long long)clock64(); \
        ts_lo = (lane == nts) ? (int)(unsigned)_c : ts_lo; ts_hi = (lane == nts) ? (int)(unsigned)(_c >> 32) : ts_hi; ++nts; } } while (0)
    PG8_STAMP();
    unsigned voffA[2], voffB[2];
#pragma unroll
    for (int i = 0; i < 2; ++i) { int R, C; stage_rc(tid * 16 + i * 8192, R, C); const int Rb = Epi::PERM ? ((R & ~31) + perm32(R & 31)) : R;
        voffA[i] = (unsigned)(R * K + C) * 2u; voffB[i] = (unsigned)(Rb * K + C) * 2u; }
    const size_t kstep = (size_t)(BK * 2);
    const size_t hstep = (size_t)HALF * K * 2;
    const size_t tstep = 2 * hstep;
    const unsigned ldsw = (unsigned)wid * 1024u;
    const int aoff = lds_byte(wr * 64 + fr, fq * 8), boff = lds_byte(wc * 32 + fr, fq * 8);
#define PG8_SA(b, h) (((b) * 2 + (h)) * HTB)
#define PG8_SB(b, h) ((4 + (b) * 2 + (h)) * HTB)
#define PG8_STAGE(bufoff, gbase, voff) do { _Pragma("unroll") for (int _i = 0; _i < 2; ++_i) \
        __builtin_amdgcn_global_load_lds((const unsigned*)((const char*)(gbase) + (voff)[_i]), (PG8_LAS unsigned*)(lds + (bufoff) + ldsw + _i * 8192), 16, 0, 0); } while (0)
#define PG8_LDA(dst, b, h) do { _Pragma("unroll") for (int m = 0; m < 4; ++m) _Pragma("unroll") for (int k = 0; k < 2; ++k) dst[m][k] = *(const PG8_LAS bf16x8*)(lds + PG8_SA(b, h) + aoff + m * 2048 + k * 1024); } while (0)
#define PG8_LDB(dst, b, h) do { _Pragma("unroll") for (int n = 0; n < 2; ++n) _Pragma("unroll") for (int k = 0; k < 2; ++k) dst[n][k] = *(const PG8_LAS bf16x8*)(lds + PG8_SB(b, h) + boff + n * 2048 + k * 1024); } while (0)
#define PG8_MMA(ai, bj, At, Bt) do { __builtin_amdgcn_s_setprio(1); _Pragma("unroll") for (int m = 0; m < 4; ++m) _Pragma("unroll") for (int n = 0; n < 2; ++n) _Pragma("unroll") for (int k = 0; k < 2; ++k) \
        acc[ai][bj][m][n] = __builtin_amdgcn_mfma_f32_16x16x32_bf16(Bt[n][k], At[m][k], acc[ai][bj][m][n], 0, 0, 0); __builtin_amdgcn_s_setprio(0); } while (0)
#define PG8_WAIT_V(n) asm volatile("s_waitcnt vmcnt(" #n ")" ::: "memory")
#define PG8_WAIT_L(n) asm volatile("s_waitcnt lgkmcnt(" #n ")" ::: "memory")
#define PG8_BAR __builtin_amdgcn_s_barrier()
#define PG8_SCHED __builtin_amdgcn_sched_barrier(0)
    Unit cur, nxt; int ui = 0;
    if (!S.next(0, cur)) return;
    f32x4 acc[2][2][4][2];
#pragma unroll
    for (int a = 0; a < 2; ++a)
#pragma unroll
        for (int b = 0; b < 2; ++b)
#pragma unroll
            for (int m = 0; m < 4; ++m)
#pragma unroll
                for (int n = 0; n < 2; ++n) acc[a][b][m][n] = (f32x4){0.f, 0.f, 0.f, 0.f};
    bf16x8 At[4][2], B0[2][2], B1[2][2];
    const char* cA = (const char*)g.A + (size_t)cur.pm * tstep; const char* cB = (const char*)g.Bt + (size_t)cur.pn * tstep;
    S.a_ready(cur);
    PG8_STAGE(PG8_SB(0, 0), cB, voffB); PG8_STAGE(PG8_SA(0, 0), cA, voffA); PG8_STAGE(PG8_SB(0, 1), cB + hstep, voffB); PG8_STAGE(PG8_SA(0, 1), cA + hstep, voffA);
    if (wr == 1) PG8_BAR;
    PG8_WAIT_V(4); PG8_BAR;
    PG8_STAGE(PG8_SB(1, 0), cB + kstep, voffB); PG8_STAGE(PG8_SA(1, 0), cA + kstep, voffA); PG8_STAGE(PG8_SB(1, 1), cB + hstep + kstep, voffB);
    PG8_WAIT_V(6); PG8_BAR;
    PG8_STAMP();
    for (;;) {
        const bool has_next = S.next(ui + 1, nxt);
        const char* nA = has_next ? (const char*)g.A + (size_t)nxt.pm * tstep : cA; const char* nB = has_next ? (const char*)g.Bt + (size_t)nxt.pn * tstep : cB;
        for (int t = 0; t < nt; t += 2) {
            const bool last = (t == nt - 2);
            const char* a1 = cA + (size_t)(t + 1) * kstep;
            const char* a2 = last ? nA : cA + (size_t)(t + 2) * kstep; const char* b2 = last ? nB : cB + (size_t)(t + 2) * kstep;
            const char* a3 = a2 + kstep; const char* b3 = b2 + kstep;
            if (last && has_next) S.a_ready(nxt);
            PG8_LDB(B0, 0, 0); PG8_SCHED; PG8_LDA(At, 0, 0); PG8_STAGE(PG8_SA(1, 1), a1 + hstep, voffA);
            PG8_WAIT_L(8); PG8_BAR; PG8_WAIT_L(0); PG8_MMA(0, 0, At, B0); PG8_BAR; PG8_SCHED;
            PG8_LDB(B1, 0, 1); PG8_STAGE(PG8_SB(0, 0), b2, voffB);
            PG8_BAR; PG8_WAIT_L(0); PG8_MMA(0, 1, At, B1); PG8_BAR;
            PG8_LDA(At, 0, 1); PG8_STAGE(PG8_SA(0, 0), a2, voffA);
            PG8_BAR; PG8_WAIT_L(0); PG8_MMA(1, 0, At, B0); PG8_BAR; PG8_SCHED;
            PG8_STAGE(PG8_SB(0, 1), b2 + hstep, voffB);
            PG8_WAIT_V(6); PG8_BAR; PG8_MMA(1, 1, At, B1); PG8_BAR;
            PG8_LDB(B0, 1, 0); PG8_SCHED; PG8_LDA(At, 1, 0); PG8_STAGE(PG8_SA(0, 1), a2 + hstep, voffA);
            PG8_WAIT_L(8); PG8_BAR; PG8_WAIT_L(0); PG8_MMA(0, 0, At, B0); PG8_BAR; PG8_SCHED;
            PG8_LDB(B1, 1, 1); PG8_STAGE(PG8_SB(1, 0), b3, voffB);
            PG8_BAR; PG8_WAIT_L(0); PG8_MMA(0, 1, At, B1); PG8_BAR;
            PG8_LDA(At, 1, 1); PG8_STAGE(PG8_SA(1, 0), a3, voffA);
            PG8_BAR; PG8_WAIT_L(0); PG8_MMA(1, 0, At, B0); PG8_BAR; PG8_SCHED;
            PG8_STAGE(PG8_SB(1, 1), b3 + hstep, voffB);
            PG8_WAIT_V(6); PG8_BAR; PG8_MMA(1, 1, At, B1); PG8_BAR;
        }
        PG8_STAMP();
        if constexpr (!Epi::AFTER_DRAIN) { E(acc, cur, wr, wc, fr, fq); S.done(cur); }
        PG8_STAMP();
        if (!has_next) break;
#pragma unroll
        for (int a = 0; a < 2; ++a)
#pragma unroll
            for (int b = 0; b < 2; ++b)
#pragma unroll
                for (int m = 0; m < 4; ++m)
#pragma unroll
                    for (int n = 0; n < 2; ++n) acc[a][b][m][n] = (f32x4){0.f, 0.f, 0.f, 0.f};
        cur = nxt; cA = nA; cB = nB; ++ui;
    }
    PG8_WAIT_V(0);
    if (wr == 0) PG8_BAR;
    PG8_BAR;
    if constexpr (Epi::AFTER_DRAIN) { E.fused(acc, cur, wr, wc, fr, fq, lds, wid, lane); S.done(cur); }
    PG8_STAMP();
    if (STAMP && wid == 0) { stamps[lane] = lane < nts ? (((unsigned long long)(unsigned)ts_hi << 32) | (unsigned)ts_lo) : 0ull;
        if (lane == 62) stamps[62] = rt_entry; if (lane == 63) stamps[63] = (unsigned long long)wall_clock64(); }
#undef PG8_STAMP
#undef PG8_SA
#undef PG8_SB
#undef PG8_STAGE
#undef PG8_LDA
#undef PG8_LDB
#undef PG8_MMA
#undef PG8_WAIT_V
#undef PG8_WAIT_L
#undef PG8_BAR
#undef PG8_SCHED
}
}

__device__ void ph_transpose(int wv, const float* __restrict__ src, bf16_t* __restrict__ dst, int K, int N, int Npad,
                             int col0, int skip_from, int skip, int nvalid, float* tile, int bid, int nb) {
  const int tk = K / 32, tn = Npad / 32;
  const int t5 = otid(wv) & 255;
  const int tx = t5 & 31, ty = t5 >> 5;
  for (int t = bid; t < tk * tn; t += nb) {
    const int kt = t / tn, nt = t % tn;
    __syncthreads();
    for (int i = ty; i < 32; i += 8) {
      const int k = kt * 32 + i, n = nt * 32 + tx;
      const int cc = col0 + n + (n >= skip_from ? skip : 0);
      tile[i * 33 + tx] = (n < nvalid) ? src[(size_t)k * N + cc] : 0.f;
    }
    __syncthreads();
    for (int i = ty; i < 32; i += 8) {
      const int n = nt * 32 + i, k = kt * 32 + tx;
      dst[(size_t)n * K + k] = f2bf(tile[tx * 33 + i]);
    }
  }
}

__device__ void ph_mod(int wv, const Params& P, float* sm, int bid, int nb) {
  const int tid = otid(wv) & 255;
  float* sv = sm;
  float* red = sm + 5 * 1024;
  for (int i = tid; i < 5 * 1024; i += 256) {
    const float v = (i < 4096) ? P.c[i] : P.c_ctx[i - 4096];
    sv[i] = silu_f(v);
  }
  __syncthreads();
  const int col = tid & 31, kg = tid >> 5;
  for (int it = bid; it < 384; it += nb) {
    const int layer = it / 192, cb = it % 192;
    const float* W = P.ada_w + (size_t)layer * 1024 * MODW + cb * 32 + col;
    float a0 = 0, a1 = 0, a2 = 0, a3 = 0, a4 = 0;
    for (int k = kg * 128; k < kg * 128 + 128; ++k) {
      const float w = W[(size_t)k * MODW];
      a0 += sv[k] * w; a1 += sv[1024 + k] * w; a2 += sv[2048 + k] * w; a3 += sv[3072 + k] * w; a4 += sv[4096 + k] * w;
    }
    float* r = red + (kg * 32 + col) * 5;
    r[0] = a0; r[1] = a1; r[2] = a2; r[3] = a3; r[4] = a4;
    __syncthreads();
    if (tid < 160) {
      const int rr = tid >> 5, cc = tid & 31;
      float s = 0;
      for (int g = 0; g < 8; ++g) s += red[(g * 32 + cc) * 5 + rr];
      P.mod()[(size_t)(layer * 5 + rr) * MODW + cb * 32 + cc] = s + P.ada_b[layer * MODW + cb * 32 + cc];
    }
    __syncthreads();
  }
}

__device__ void ph_norm(int wv, const float* hl, const float* hc, const float* __restrict__ g, const float* __restrict__ modl,
                        int shift_off, int scale_off, int nrows, bf16_t* __restrict__ dst, int bid, int nb) {
  const int wave = otid(wv) >> 6, lane = otid(wv) & 63;
  for (int row = bid * NWAVE + wave; row < nrows; row += nb * NWAVE) {
    const float* src = hrow(hl, hc, row);
    const float* mr = modl + (size_t)modrow(row) * MODW;
    float4 v[4];
    float ss = 0.f;
#pragma unroll
    for (int i = 0; i < 4; ++i) {
      v[i] = ((const float4*)src)[i * 64 + lane];
      ss += v[i].x * v[i].x + v[i].y * v[i].y + v[i].z * v[i].z + v[i].w * v[i].w;
    }
    ss = wave_sum(ss);
    const float rstd = rsqrtf(ss * (1.f / 1024.f) + 1e-6f);
#pragma unroll
    for (int i = 0; i < 4; ++i) {
      const int idx = i * 256 + lane * 4;
      const float4 gg = *(const float4*)(g + idx);
      const float4 sc = *(const float4*)(mr + scale_off + idx);
      const float4 sh = *(const float4*)(mr + shift_off + idx);
      const float o0 = v[i].x * rstd * gg.x * (1.f + sc.x) + sh.x;
      const float o1 = v[i].y * rstd * gg.y * (1.f + sc.y) + sh.y;
      const float o2 = v[i].z * rstd * gg.z * (1.f + sc.z) + sh.z;
      const float o3 = v[i].w * rstd * gg.w * (1.f + sc.w) + sh.w;
      uint2 pk;
      pk.x = (uint32_t)f2bf(o0) | ((uint32_t)f2bf(o1) << 16);
      pk.y = (uint32_t)f2bf(o2) | ((uint32_t)f2bf(o3) << 16);
      *(uint2*)(dst + (size_t)row * DM + idx) = pk;
    }
  }
}

enum { EPI_INPROJ = 0, EPI_OUTPROJ = 1, EPI_Q = 2 };

template <int EPI>
__device__ void ph_gemm(int wv, const Params& P, int layer, const bf16_t* __restrict__ A, const bf16_t* __restrict__ Bt, int M,
                        int Npad, int K, const float* hl, const float* hc, char* smem, int bid, int nb) {
  bf16_t* sA = (bf16_t*)smem;
  bf16_t* sB = sA + 128 * 72;
  const int tid = otid(wv) & 255, lane = tid & 63, wave = tid >> 6;
  const int wr = wave >> 1, wc = wave & 1;
  const int tiles_m = M / 128, tiles_n = Npad / 128;
  const int l15 = lane & 15, l4 = lane >> 4;
  for (int tile = bid; tile < tiles_m * tiles_n; tile += nb) {
    const int tn = tile / tiles_m, tm = tile % tiles_m;
    f32x4 acc[4][4];
#pragma unroll
    for (int i = 0; i < 4; ++i)
#pragma unroll
      for (int j = 0; j < 4; ++j) acc[i][j] = (f32x4){0.f, 0.f, 0.f, 0.f};
    for (int k0 = 0; k0 < K; k0 += 64) {
      __syncthreads();
#pragma unroll
      for (int i = 0; i < 4; ++i) {
        const int idx = i * 256 + tid;
        const int r = idx >> 3, sg = idx & 7;
        const uint4 va = *(const uint4*)(A + (size_t)(tm * 128 + r) * K + k0 + sg * 8);
        *(uint4*)(sA + r * 72 + sg * 8) = va;
        const uint4 vb = *(const uint4*)(Bt + (size_t)(tn * 128 + r) * K + k0 + sg * 8);
        *(uint4*)(sB + r * 72 + sg * 8) = vb;
      }
      __syncthreads();
#pragma unroll
      for (int kk = 0; kk < 2; ++kk) {
        bf16x8 af[4], bfr[4];
#pragma unroll
        for (int i = 0; i < 4; ++i) af[i] = *(const bf16x8*)(sA + (wr * 64 + i * 16 + l15) * 72 + kk * 32 + l4 * 8);
#pragma unroll
        for (int j = 0; j < 4; ++j) bfr[j] = *(const bf16x8*)(sB + (wc * 64 + j * 16 + l15) * 72 + kk * 32 + l4 * 8);
#pragma unroll
        for (int i = 0; i < 4; ++i)
#pragma unroll
          for (int j = 0; j < 4; ++j) acc[i][j] = __builtin_amdgcn_mfma_f32_16x16x32_bf16(af[i], bfr[j], acc[i][j], 0, 0, 0);
      }
    }
#pragma unroll
    for (int i = 0; i < 4; ++i)
#pragma unroll
      for (int j = 0; j < 4; ++j)
#pragma unroll
        for (int e = 0; e < 4; ++e) {
          const int row = tm * 128 + wr * 64 + i * 16 + l4 * 4 + e;
          const int col = tn * 128 + wc * 64 + j * 16 + l15;
          const float v = acc[i][j][e];
          if (EPI == EPI_INPROJ) {
            if (col < 32) P.dtraw()[(size_t)row * 32 + col] = v;
          } else if (EPI == EPI_OUTPROJ) {
            const float* src = hrow(hl, hc, row);
            const float gate = P.mod()[(size_t)(layer * 5 + modrow(row)) * MODW + 2048 + col];
            P.h()[(size_t)row * DM + col] = src[col] + gate * v;
          } else {
            P.q()[(size_t)row * 2048 + col] = f2bf(v);
          }
        }
  }
}

__device__ void ph_conv(int wv, const Params& P, int layer, int bid, int nb) {
  const float* cw = P.conv_w + (size_t)layer * 3 * 1536;
  const float* cb = P.conv_b + (size_t)layer * 1536;
  const int total = NTOK * 64;
  for (int it = bid * NTHR + otid(wv); it < total; it += nb * NTHR) {
    const int row = it >> 6, c8 = 1024 + (it & 63) * 8;
    int l, L;
    if (row < NLAT) { l = row & 4095; L = 4096; } else { l = (row - NLAT) & 255; L = 256; }
    const bf16_t* pc = P.p() + (size_t)row * PW + OFF_XBC + c8;
    uint4 cur = *(const uint4*)pc;
    uint4 prv = make_uint4(0, 0, 0, 0), nxt = make_uint4(0, 0, 0, 0);
    if (l > 0) prv = *(const uint4*)(pc - PW);
    if (l < L - 1) nxt = *(const uint4*)(pc + PW);
    const bf16_t* c_ = (const bf16_t*)&cur;
    const bf16_t* p_ = (const bf16_t*)&prv;
    const bf16_t* n_ = (const bf16_t*)&nxt;
    uint4 o;
    bf16_t* o_ = (bf16_t*)&o;
#pragma unroll
    for (int e = 0; e < 8; ++e) {
      const int c = c8 + e;
      const float v = cb[c] + cw[c] * bf2f(p_[e]) + cw[1536 + c] * bf2f(c_[e]) + cw[3072 + c] * bf2f(n_[e]);
      o_[e] = f2bf(silu_f(v));
    }
    *(uint4*)(P.xbc() + (size_t)row * 512 + c8 - 1024) = o;
  }
}

__device__ void ph_ssdprep(int wv, const Params& P, int layer, int bid, int nb) {
  for (int it = bid * NTHR + otid(wv); it < NCHUNK * 32; it += nb * NTHR) {
    const int gc = it >> 5, dh = it & 31;
    const float bias = P.dt_bias[layer * 32 + dh];
    const float ah = -expf(P.a_log[layer * 32 + dh]);
    float cs = 0.f;
    for (int j = 0; j < 128; ++j) {
      const size_t o = (size_t)(gc * 128 + j) * 32 + dh;
      const float dt = softplus_f(P.dtraw()[o] + bias);
      cs += dt * ah;
      P.dtv()[o] = dt;
      P.csv()[o] = cs;
    }
  }
}

__device__ void ph_states(int wv, const Params& P, char* smem, int bid, int nb) {
  float* wx = (float*)smem;
  bf16_t* Bm = (bf16_t*)(smem + 128 * 64 * 4);
  const int tid = otid(wv);
  const int n = tid & 127, pg = (tid >> 7) & 1;
  for (int it = bid; it < NCHUNK * 32; it += nb) {
    const int gc = it >> 5, dh = it & 31, dir = dh >> 4, head = dh & 15, g = head >> 3;
    const int row0 = gc * 128;
    __syncthreads();
    const float at = P.csv()[(size_t)(row0 + 127) * 32 + dh];
    for (int i = tid; i < 128 * 64; i += NTHR) {
      const int j = i >> 6, pp = i & 63, row = row0 + j;
      const float cs = P.csv()[(size_t)row * 32 + dh], dt = P.dtv()[(size_t)row * 32 + dh];
      float w;
      if (dir == 0) w = expf(at - cs);
      else w = expf(j > 0 ? P.csv()[(size_t)(row - 1) * 32 + dh] : 0.f);
      wx[i] = bf2f(P.xbc()[(size_t)row * 1536 + head * 64 + pp]) * dt * w;
    }
    for (int i = tid; i < 128 * 128; i += NTHR) {
      const int j = i >> 7, nn = i & 127;
      Bm[i] = P.xbc()[(size_t)(row0 + j) * 1536 + 1024 + g * 128 + nn];
    }
    __syncthreads();
    float acc[32];
#pragma unroll
    for (int i = 0; i < 32; ++i) acc[i] = 0.f;
    for (int j = 0; j < 128; ++j) {
      const float b = bf2f(Bm[j * 128 + n]);
#pragma unroll
      for (int i = 0; i < 32; ++i) acc[i] += wx[j * 64 + pg * 32 + i] * b;
    }
    bf16_t* dst = P.states() + (size_t)it * 8192;
#pragma unroll
    for (int i = 0; i < 32; ++i) dst[(pg * 32 + i) * 128 + n] = f2bf(acc[i]);
  }
}

__device__ void ph_scan(int wv, const Params& P, int bid, int nb) {
  const int total = 4 * 32 * 8192;
  for (int it = bid * NTHR + otid(wv); it < total; it += nb * NTHR) {
    const int e = it & 8191, dh = (it >> 13) & 31, b = it >> 18, dir = dh >> 4;
    float S = 0.f;
    for (int s = 0; s < 34; ++s) {
      int gc;
      if (dir == 0) gc = (s < 2) ? (128 + 2 * b + s) : (32 * b + (s - 2));
      else gc = (s < 2) ? (128 + 2 * b + 1 - s) : (32 * b + 31 - (s - 2));
      bf16_t* ptr = P.states() + (size_t)(gc * 32 + dh) * 8192 + e;
      const float cstate = bf2f(*ptr);
      *ptr = f2bf(S);
      const float at = P.csv()[(size_t)(gc * 128 + 127) * 32 + dh];
      S = expf(at) * S + cstate;
    }
  }
}

__device__ void ph_ssdy(int wv, const Params& P, int layer, int nchunks, char* smem, int bid, int nb) {
  bf16_t* Cm = (bf16_t*)smem;
  bf16_t* Gm = Cm + 128 * 130;
  char* R = (char*)(Gm + 128 * 130);
  bf16_t* Bm = (bf16_t*)R;
  float* xd = (float*)R;
  bf16_t* Sm = (bf16_t*)(R + 128 * 130 * 2);
  float* csl = (float*)(Sm + 64 * 130);
  float* exl = csl + 128;
  const int tid = otid(wv);
  for (int it = bid; it < nchunks * 16; it += nb) {
    const int gc = it >> 4, head = it & 15, g = head >> 3;
    const int row0 = gc * 128;
    __syncthreads();
    for (int i = tid; i < 128 * 128; i += NTHR) {
      const int j = i >> 7, nn = i & 127;
      const bf16_t* xr = P.xbc() + (size_t)(row0 + j) * 1536 + 1024 + g * 128 + nn;
      Bm[j * 130 + nn] = xr[0];
      Cm[j * 130 + nn] = xr[256];
    }
    __syncthreads();
    {
      const int s = tid & 127, jh = (tid >> 7) & 1;
      for (int jb = 0; jb < 2; ++jb) {
        float acc[32];
#pragma unroll
        for (int i = 0; i < 32; ++i) acc[i] = 0.f;
        for (int nn = 0; nn < 128; ++nn) {
          const float b = bf2f(Bm[s * 130 + nn]);
#pragma unroll
          for (int i = 0; i < 32; ++i) acc[i] += bf2f(Cm[(jh * 64 + jb * 32 + i) * 130 + nn]) * b;
        }
#pragma unroll
        for (int i = 0; i < 32; ++i) Gm[(jh * 64 + jb * 32 + i) * 130 + s] = f2bf(acc[i]);
      }
    }
    const int pp = tid & 63, jg0 = (tid >> 6) & 3;
#pragma unroll 1
    for (int jpass = 0; jpass < 2; ++jpass) {
    const int jg = jg0 * 2 + jpass;
    float yacc[16];
#pragma unroll
    for (int i = 0; i < 16; ++i) yacc[i] = 0.f;
#pragma unroll 1
    for (int dir = 0; dir < 2; ++dir) {
      const int dh = dir * 16 + head;
      __syncthreads();
      for (int i = tid; i < 128 * 64; i += NTHR) {
        const int j = i >> 6, p2 = i & 63, row = row0 + j;
        xd[i] = bf2f(P.xbc()[(size_t)row * 1536 + head * 64 + p2]) * P.dtv()[(size_t)row * 32 + dh];
      }
      const bf16_t* st = P.states() + (size_t)(gc * 32 + dh) * 8192;
      for (int i = tid; i < 64 * 128; i += NTHR) Sm[(i >> 7) * 130 + (i & 127)] = st[i];
      if (tid < 128) {
        const float cs = P.csv()[(size_t)(row0 + tid) * 32 + dh];
        csl[tid] = cs;
        exl[tid] = tid > 0 ? P.csv()[(size_t)(row0 + tid - 1) * 32 + dh] : 0.f;
      }
      __syncthreads();
      const float atot = csl[127];
      for (int s = 0; s < 128; ++s) {
        const float xv = xd[s * 64 + pp];
        const float cs_s = csl[s], ex_s = exl[s];
#pragma unroll
        for (int i = 0; i < 16; ++i) {
          const int j = jg * 16 + i;
          if (dir == 0) {
            if (s <= j) yacc[i] += bf2f(Gm[j * 130 + s]) * expf(csl[j] - cs_s) * xv;
          } else {
            if (s >= j) yacc[i] += bf2f(Gm[j * 130 + s]) * expf(ex_s - exl[j]) * xv;
          }
        }
      }
      float offacc[16];
#pragma unroll
      for (int i = 0; i < 16; ++i) offacc[i] = 0.f;
      for (int nn = 0; nn < 128; ++nn) {
        const float sv = bf2f(Sm[pp * 130 + nn]);
#pragma unroll
        for (int i = 0; i < 16; ++i) offacc[i] += bf2f(Cm[(jg * 16 + i) * 130 + nn]) * sv;
      }
#pragma unroll
      for (int i = 0; i < 16; ++i) {
        const int j = jg * 16 + i;
        const float sc = dir == 0 ? expf(csl[j]) : expf(atot - exl[j]);
        yacc[i] += offacc[i] * sc;
      }
    }
    const float dsk = P.d_skip[layer * 16 + head];
#pragma unroll
    for (int i = 0; i < 16; ++i) {
      const int row = row0 + jg * 16 + i;
      const float xs = bf2f(P.xbc()[(size_t)row * 1536 + head * 64 + pp]);
      const float z = bf2f(P.p()[(size_t)row * PW + OFF_Z + head * 64 + pp]);
      const float y = (yacc[i] + dsk * xs) * silu_f(z);
      P.concat()[(size_t)row * 2048 + head * 64 + pp] = f2bf(y);
    }
    }
  }
}


__device__ __forceinline__ void conv_x8(const Params& P, int layer, int row, int ch0, float* out) {
  int l, L;
  if (row < NLAT) { l = row & 4095; L = 4096; } else { l = (row - NLAT) & 255; L = 256; }
  const bf16_t* pc = P.p() + (size_t)row * PW + OFF_XBC + ch0;
  const uint4 cur = *(const uint4*)pc;
  uint4 prv = make_uint4(0, 0, 0, 0), nxt = make_uint4(0, 0, 0, 0);
  if (l > 0) prv = *(const uint4*)(pc - PW);
  if (l < L - 1) nxt = *(const uint4*)(pc + PW);
  float fp[8], fc[8], fn[8];
  unpack8(prv, fp); unpack8(cur, fc); unpack8(nxt, fn);
  const float* cw = P.conv_w + (size_t)layer * 3 * 1536 + ch0;
  const float* cb = P.conv_b + (size_t)layer * 1536 + ch0;
#pragma unroll
  for (int e = 0; e < 8; ++e) out[e] = silu_f(cb[e] + cw[e] * fp[e] + cw[1536 + e] * fc[e] + cw[3072 + e] * fn[e]);
}

constexpr int XS = 72;
constexpr int BS = 136;

__device__ void ph_states_mfma(int wv, const Params& P, int layer, char* smem, int bid, int nb) {
  char* XW = smem;
  char* Bm = smem + 2 * 128 * XS * 2;
  const int tid = otid(wv), lane = tid & 63, li = lane & 15, g = lane >> 4;
  const int dir = wv >> 2, pb = wv & 3;
  for (int it = bid; it < NCHUNK * 16; it += nb) {
    const int gc = it >> 4, head = it & 15, grp = head >> 3;
    const int row0 = gc * 128;
    __syncthreads();
#pragma unroll
    for (int i = 0; i < 2; ++i) {
      const int idx = tid + i * 512, j = idx >> 3, seg = idx & 7, row = row0 + j;
      float xv[8];
      conv_x8(P, layer, row, head * 64 + seg * 8, xv);
      const float* cs = P.csv() + (size_t)row * 32;
      const float* dt = P.dtv() + (size_t)row * 32;
      const float at_f = P.csv()[(size_t)(row0 + 127) * 32 + head];
      const float wf = expf(at_f - cs[head]) * dt[head];
      const float wb = expf(j > 0 ? cs[16 + head - 32] : 0.f) * dt[16 + head];
      uint4 of, ob;
      of.x = pack2(xv[0] * wf, xv[1] * wf); of.y = pack2(xv[2] * wf, xv[3] * wf); of.z = pack2(xv[4] * wf, xv[5] * wf); of.w = pack2(xv[6] * wf, xv[7] * wf);
      ob.x = pack2(xv[0] * wb, xv[1] * wb); ob.y = pack2(xv[2] * wb, xv[3] * wb); ob.z = pack2(xv[4] * wb, xv[5] * wb); ob.w = pack2(xv[6] * wb, xv[7] * wb);
      *(uint4*)(XW + (j * XS + seg * 8) * 2) = of;
      *(uint4*)(XW + ((128 + j) * XS + seg * 8) * 2) = ob;
    }
#pragma unroll
    for (int i = 0; i < 4; ++i) {
      const int idx = tid + i * 512, j = idx >> 4, seg = idx & 15;
      *(uint4*)(Bm + (j * BS + seg * 8) * 2) = *(const uint4*)(P.xbc() + (size_t)(row0 + j) * 512 + grp * 128 + seg * 8);
    }
    __syncthreads();
    f32x4 acc[8];
#pragma unroll
    for (int n = 0; n < 8; ++n) acc[n] = (f32x4){0.f, 0.f, 0.f, 0.f};
    const char* xbase = XW + ((dir * 128 + (li >> 2)) * XS + pb * 16 + 4 * (li & 3)) * 2;
    const char* bbase = Bm + ((li >> 2) * BS + 4 * (li & 3)) * 2;
#pragma unroll
    for (int t = 0; t < 4; ++t) {
      const int R = 32 * t + 8 * g;
      const bf16x8 bfrag = tr_read2(xbase + R * XS * 2, xbase + (R + 4) * XS * 2);
#pragma unroll
      for (int n = 0; n < 8; ++n) {
        const bf16x8 afrag = tr_read2(bbase + (R * BS + n * 16) * 2, bbase + ((R + 4) * BS + n * 16) * 2);
        acc[n] = __builtin_amdgcn_mfma_f32_16x16x32_bf16(afrag, bfrag, acc[n], 0, 0, 0);
      }
    }
    bf16_t* dst = P.states() + (size_t)(gc * 32 + dir * 16 + head) * 8192 + (pb * 16 + li) * 128;
#pragma unroll
    for (int n = 0; n < 8; ++n) {
      uint2 o;
      o.x = pack2(acc[n][0], acc[n][1]); o.y = pack2(acc[n][2], acc[n][3]);
      *(uint2*)(dst + n * 16 + 4 * g) = o;
    }
  }
}

__device__ void ph_ssdy_mfma(int wv, const Params& P, int layer, int nchunks, char* smem, int bid, int nb) {
  char* Bm = smem;
  char* Cm = Bm + 128 * BS * 2;
  char* X0 = Cm + 128 * BS * 2;
  char* XD = X0 + 128 * XS * 2;
  float* csf = (float*)(XD + 2 * 128 * XS * 2);
  float* exb = csf + 128;
  const int tid = otid(wv), lane = tid & 63, li = lane & 15, g = lane >> 4;
  for (int it = bid; it < nchunks * 16; it += nb) {
    const int gc = it >> 4, head = it & 15, grp = head >> 3;
    const int row0 = gc * 128;
    __syncthreads();
#pragma unroll
    for (int i = 0; i < 2; ++i) {
      const int idx = tid + i * 512, j = idx >> 3, seg = idx & 7, row = row0 + j;
      float xv[8];
      conv_x8(P, layer, row, head * 64 + seg * 8, xv);
      const float df = P.dtv()[(size_t)row * 32 + head], db = P.dtv()[(size_t)row * 32 + 16 + head];
      uint4 o0, of, ob;
      o0.x = pack2(xv[0], xv[1]); o0.y = pack2(xv[2], xv[3]); o0.z = pack2(xv[4], xv[5]); o0.w = pack2(xv[6], xv[7]);
      of.x = pack2(xv[0] * df, xv[1] * df); of.y = pack2(xv[2] * df, xv[3] * df); of.z = pack2(xv[4] * df, xv[5] * df); of.w = pack2(xv[6] * df, xv[7] * df);
      ob.x = pack2(xv[0] * db, xv[1] * db); ob.y = pack2(xv[2] * db, xv[3] * db); ob.z = pack2(xv[4] * db, xv[5] * db); ob.w = pack2(xv[6] * db, xv[7] * db);
      *(uint4*)(X0 + (j * XS + seg * 8) * 2) = o0;
      *(uint4*)(XD + (j * XS + seg * 8) * 2) = of;
      *(uint4*)(XD + ((128 + j) * XS + seg * 8) * 2) = ob;
    }
#pragma unroll
    for (int i = 0; i < 4; ++i) {
      const int idx = tid + i * 512, j = idx >> 4, seg = idx & 15;
      const bf16_t* s = P.xbc() + (size_t)(row0 + j) * 512 + grp * 128 + seg * 8;
      *(uint4*)(Bm + (j * BS + seg * 8) * 2) = *(const uint4*)s;
      *(uint4*)(Cm + (j * BS + seg * 8) * 2) = *(const uint4*)(s + 256);
    }
    if (tid < 128) {
      csf[tid] = P.csv()[(size_t)(row0 + tid) * 32 + head];
      exb[tid] = tid > 0 ? P.csv()[(size_t)(row0 + tid - 1) * 32 + 16 + head] : 0.f;
    }
    __syncthreads();
    const float atb = P.csv()[(size_t)(row0 + 127) * 32 + 16 + head];
    f32x4 accG[8];
#pragma unroll
    for (int sb = 0; sb < 8; ++sb) accG[sb] = (f32x4){0.f, 0.f, 0.f, 0.f};
#pragma unroll
    for (int t = 0; t < 4; ++t) {
      const bf16x8 cfrag = *(const bf16x8*)(Cm + ((16 * wv + li) * BS + 32 * t + 8 * g) * 2);
#pragma unroll
      for (int sb = 0; sb < 8; ++sb) {
        const bf16x8 bfr = *(const bf16x8*)(Bm + ((16 * sb + li) * BS + 32 * t + 8 * g) * 2);
        accG[sb] = __builtin_amdgcn_mfma_f32_16x16x32_bf16(bfr, cfrag, accG[sb], 0, 0, 0);
      }
    }
    f32x4 accY[4];
#pragma unroll
    for (int pb = 0; pb < 4; ++pb) accY[pb] = (f32x4){0.f, 0.f, 0.f, 0.f};
    const int jl = 16 * wv + li;
    const float csf_j = csf[jl], exb_j = exb[jl];
#pragma unroll
    for (int dir = 0; dir < 2; ++dir) {
      f32x4 accO[4];
#pragma unroll
      for (int pb = 0; pb < 4; ++pb) accO[pb] = (f32x4){0.f, 0.f, 0.f, 0.f};
      const bf16_t* st = P.states() + (size_t)(gc * 32 + dir * 16 + head) * 8192;
#pragma unroll
      for (int t = 0; t < 4; ++t) {
        const bf16x8 cfrag = *(const bf16x8*)(Cm + ((16 * wv + li) * BS + 32 * t + 8 * g) * 2);
#pragma unroll
        for (int pb = 0; pb < 4; ++pb) {
          const bf16x8 sfr = *(const bf16x8*)(st + (16 * pb + li) * 128 + 32 * t + 8 * g);
          accO[pb] = __builtin_amdgcn_mfma_f32_16x16x32_bf16(cfrag, sfr, accO[pb], 0, 0, 0);
        }
      }
#pragma unroll
      for (int e = 0; e < 4; ++e) {
        const int j = 16 * wv + 4 * g + e;
        const float sc = dir == 0 ? expf(csf[j]) : expf(atb - exb[j]);
#pragma unroll
        for (int pb = 0; pb < 4; ++pb) accY[pb][e] += accO[pb][e] * sc;
      }
#pragma unroll
      for (int t = 0; t < 4; ++t) {
        const bool skip = dir == 0 ? (32 * t > 16 * wv + 15) : (32 * t + 31 < 16 * wv);
        if (skip) continue;
        bf16x8 afrag;
#pragma unroll
        for (int hh = 0; hh < 2; ++hh) {
          const int s0 = 32 * t + 16 * hh + 4 * g;
          const f32x4 gv = accG[2 * t + hh];
          const f32x4 cv = dir == 0 ? *(const f32x4*)(csf + s0) : *(const f32x4*)(exb + s0);
#pragma unroll
          for (int e = 0; e < 4; ++e) {
            const int s = s0 + e;
            float m;
            if (dir == 0) m = (s <= jl) ? gv[e] * expf(csf_j - cv[e]) : 0.f;
            else m = (s >= jl) ? gv[e] * expf(cv[e] - exb_j) : 0.f;
            afrag[hh * 4 + e] = (short)f2bf(m);
          }
        }
        const char* xb = XD + ((dir * 128 + 32 * t + 4 * g + (li >> 2)) * XS + 4 * (li & 3)) * 2;
#pragma unroll
        for (int pb = 0; pb < 4; ++pb) {
          const bf16x8 bfr = tr_read2(xb + pb * 32, xb + 16 * XS * 2 + pb * 32);
          accY[pb] = __builtin_amdgcn_mfma_f32_16x16x32_bf16(afrag, bfr, accY[pb], 0, 0, 0);
        }
      }
    }
    const float dsk = P.d_skip[layer * 16 + head];
#pragma unroll
    for (int e = 0; e < 4; ++e) {
      const int j = 16 * wv + 4 * g + e, row = row0 + j;
#pragma unroll
      for (int pb = 0; pb < 4; ++pb) {
        const int pp = 16 * pb + li;
        const float xs = bf2f(*(const bf16_t*)(X0 + (j * XS + pp) * 2));
        const float z = bf2f(P.p()[(size_t)row * PW + OFF_Z + head * 64 + pp]);
        P.concat()[(size_t)row * 2048 + head * 64 + pp] = f2bf((accY[pb][e] + dsk * xs) * silu_f(z));
      }
    }
  }
}

__device__ void ph_ssdnorm(int wv, const Params& P, int layer, int nrows, int bid, int nb) {
  const int wave = otid(wv) >> 6, lane = otid(wv) & 63;
  const float* g = P.ssd_norm_g + layer * 1024;
  for (int row = bid * NWAVE + wave; row < nrows; row += nb * NWAVE) {
    bf16_t* src = P.concat() + (size_t)row * 2048;
    float v[16];
    float ss = 0.f;
#pragma unroll
    for (int i = 0; i < 4; ++i) {
      const uint2 pk = *(const uint2*)(src + i * 256 + lane * 4);
      v[i * 4 + 0] = bf2f((bf16_t)(pk.x & 0xffff)); v[i * 4 + 1] = bf2f((bf16_t)(pk.x >> 16));
      v[i * 4 + 2] = bf2f((bf16_t)(pk.y & 0xffff)); v[i * 4 + 3] = bf2f((bf16_t)(pk.y >> 16));
    }
#pragma unroll
    for (int i = 0; i < 16; ++i) ss += v[i] * v[i];
    ss = wave_sum(ss);
    const float rstd = rsqrtf(ss * (1.f / 1024.f) + 1e-6f);
#pragma unroll
    for (int i = 0; i < 4; ++i) {
      const int idx = i * 256 + lane * 4;
      uint2 pk;
      pk.x = (uint32_t)f2bf(v[i * 4 + 0] * rstd * g[idx + 0]) | ((uint32_t)f2bf(v[i * 4 + 1] * rstd * g[idx + 1]) << 16);
      pk.y = (uint32_t)f2bf(v[i * 4 + 2] * rstd * g[idx + 2]) | ((uint32_t)f2bf(v[i * 4 + 3] * rstd * g[idx + 3]) << 16);
      *(uint2*)(src + idx) = pk;
    }
  }
}

__device__ void ph_pool(int wv, const Params& P, int layer, int nrows, char* smem, int bid, int nb) {
  float* pooled = (float*)smem;
  const int tid = otid(wv);
  const int ntile = nrows / 32;
  for (int it = bid; it < ntile * 4; it += nb) {
    const int tt = it >> 2, gi = it & 3;
    const int w = 2 << gi;
    const int row0 = tt * 32;
    __syncthreads();
    for (int i = tid; i < 32 * 128; i += NTHR) {
      const int t = i >> 7, ch = i & 127, row = row0 + t;
      int l, L, base;
      if (row < NLAT) { l = row & 4095; L = 4096; base = row - l; } else { l = (row - NLAT) & 255; L = 256; base = row - l; }
      int lo = l - w / 2; lo = lo < 0 ? 0 : lo;
      int hi = l + w - w / 2 - 1; hi = hi > L - 1 ? L - 1 : hi;
      float s = 0.f;
      for (int r = lo; r <= hi; ++r) s += bf2f(P.p()[(size_t)(base + r) * PW + OFF_POOL + gi * 128 + ch]);
      pooled[i] = s / (float)(hi - lo + 1) - bf2f(P.p()[(size_t)row * PW + OFF_POOL + gi * 128 + ch]);
    }
    __syncthreads();
    const int o = tid & 127, tg = (tid >> 7) & 1;
    const float* W = P.pool_w + ((size_t)(layer * 4 + gi) * 128) * 128 + o;
    float acc[16];
#pragma unroll
    for (int i = 0; i < 16; ++i) acc[i] = 0.f;
    for (int k = 0; k < 128; ++k) {
      const float wv = W[(size_t)k * 128];
#pragma unroll
      for (int i = 0; i < 16; ++i) acc[i] += pooled[(tg * 16 + i) * 128 + k] * wv;
    }
    const float sc = P.pool_scale[layer * 512 + gi * 128 + o];
#pragma unroll
    for (int i = 0; i < 16; ++i)
      P.concat()[(size_t)(row0 + tg * 16 + i) * 2048 + 1024 + gi * 128 + o] = f2bf(acc[i] * sc);
  }
}

__device__ void ph_na(int wv, const Params& P, int layer, int nrows, char* smem, int bid, int nb) {
  const int wave = otid(wv) >> 6, lane = otid(wv) & 63;
  float* qs = (float*)smem + wave * 448;
  float* ps = qs + 64;
  const float* rpb = P.na_rpb + (size_t)layer * 8 * 15 * 31;
  for (int it = bid * NWAVE + wave; it < nrows * 8; it += nb * NWAVE) {
    const int row = it >> 3, hd = it & 7;
    const bool lat = row < NLAT;
    int b, r = 0, cq = 0, r0 = 0, c0 = 0;
    if (lat) {
      b = row >> 12; const int l = row & 4095; r = l >> 6; cq = l & 63;
      r0 = r - 4; r0 = r0 < 0 ? 0 : (r0 > 56 ? 56 : r0);
      c0 = cq - 8; c0 = c0 < 0 ? 0 : (c0 > 48 ? 48 : c0);
    } else {
      b = (row - NLAT) >> 8;
    }
    qs[lane] = bf2f(P.p()[(size_t)row * PW + OFF_Q + hd * 64 + lane]) * 0.125f;
    __builtin_amdgcn_wave_barrier();
    const int nkeys = lat ? 384 : 256;
    float mx = -3.0e38f;
#pragma unroll 1
    for (int t = 0; t < 6; ++t) {
      const int n = t * 64 + lane;
      float s = -3.0e38f;
      if (n < nkeys) {
        int krow; float bias = 0.f;
        if (lat && n < 128) {
          const int kr = n >> 4, kc = n & 15;
          const int rk = r0 + kr, ck = c0 + kc;
          krow = b * 4096 + rk * 64 + ck;
          bias = rpb[(hd * 15 + (rk - r + 7)) * 31 + (ck - cq + 15)];
        } else {
          krow = NLAT + b * 256 + (lat ? n - 128 : n);
        }
        const bf16_t* kp = P.p() + (size_t)krow * PW + OFF_K + hd * 64;
        float d = 0.f;
#pragma unroll
        for (int v8 = 0; v8 < 8; ++v8) {
          const uint4 kk = *(const uint4*)(kp + v8 * 8);
          const bf16_t* ke = (const bf16_t*)&kk;
#pragma unroll
          for (int e = 0; e < 8; ++e) d += qs[v8 * 8 + e] * bf2f(ke[e]);
        }
        s = d + bias;
      }
      ps[t * 64 + lane] = s;
      mx = fmaxf(mx, s);
    }
    mx = wave_max(mx);
    float sum = 0.f;
#pragma unroll 1
    for (int t = 0; t < 6; ++t) {
      const int n = t * 64 + lane;
      const float e = (n < nkeys) ? expf(ps[n] - mx) : 0.f;
      sum += e;
      ps[n] = e;
    }
    sum = wave_sum(sum);
    __builtin_amdgcn_wave_barrier();
    float acc = 0.f;
    for (int n = 0; n < nkeys; ++n) {
      int krow;
      if (lat && n < 128) krow = b * 4096 + (r0 + (n >> 4)) * 64 + c0 + (n & 15);
      else krow = NLAT + b * 256 + (lat ? n - 128 : n);
      acc += ps[n] * bf2f(P.p()[(size_t)krow * PW + OFF_V + hd * 64 + lane]);
    }
    P.concat()[(size_t)row * 2048 + 1536 + hd * 64 + lane] = f2bf(acc / sum);
    __builtin_amdgcn_wave_barrier();
  }
}


__device__ void ph_vtranspose(int wv, const Params& P, char* smem, int bid, int nb) {
  const int lane = otid(wv) & 63;
  bf16_t* tile = (bf16_t*)smem + wv * 64 * 72;
  for (int it = bid * NWAVE + wv; it < 272 * 8; it += nb * NWAVE) {
    const int hd = it & 7, tt = it >> 3, row0 = tt * 64;
    const bf16_t* src = P.p() + (size_t)(row0 + lane) * PW + OFF_V + hd * 64;
#pragma unroll
    for (int i = 0; i < 8; ++i) *(uint4*)(tile + lane * 72 + i * 8) = *(const uint4*)(src + i * 8);
    __builtin_amdgcn_wave_barrier();
    bf16_t* dst;
    if (row0 < NLAT) dst = P.vtl() + ((size_t)((row0 >> 12) * 8 + hd) * 64 + lane) * 4096 + (row0 & 4095);
    else dst = P.vtc() + ((size_t)(((row0 - NLAT) >> 8) * 8 + hd) * 64 + lane) * 256 + ((row0 - NLAT) & 255);
#pragma unroll
    for (int i = 0; i < 8; ++i) {
      uint32_t w[4];
#pragma unroll
      for (int k = 0; k < 4; ++k)
        w[k] = (uint32_t)tile[(i * 8 + 2 * k) * 72 + lane] | ((uint32_t)tile[(i * 8 + 2 * k + 1) * 72 + lane] << 16);
      *(uint4*)(dst + i * 8) = make_uint4(w[0], w[1], w[2], w[3]);
    }
    __builtin_amdgcn_wave_barrier();
  }
}

__device__ __forceinline__ float grp_max(float v) {
  auto a = __builtin_amdgcn_permlane16_swap(__float_as_uint(v), __float_as_uint(v), false, false);
  v = fmaxf(__uint_as_float(a[0]), __uint_as_float(a[1]));
  auto b = __builtin_amdgcn_permlane32_swap(__float_as_uint(v), __float_as_uint(v), false, false);
  return fmaxf(__uint_as_float(b[0]), __uint_as_float(b[1]));
}
__device__ __forceinline__ float grp_sum(float v) {
  auto a = __builtin_amdgcn_permlane16_swap(__float_as_uint(v), __float_as_uint(v), false, false);
  v = __uint_as_float(a[0]) + __uint_as_float(a[1]);
  auto b = __builtin_amdgcn_permlane32_swap(__float_as_uint(v), __float_as_uint(v), false, false);
  return __uint_as_float(b[0]) + __uint_as_float(b[1]);
}

__device__ void ph_na_mfma(int wv, const Params& P, int layer, int nrows, int bid, int nb) {
  const int lane = otid(wv) & 63, li = lane & 15, g = lane >> 4;
  const float* rpb = P.na_rpb + (size_t)layer * 8 * 15 * 31;
  const int n_lat = 4 * 64 * 8 * 4;
  const int n_items = n_lat + (nrows > NLAT ? 4 * 16 * 8 : 0);
  for (int it = bid * NWAVE + wv; it < n_items; it += nb * NWAVE) {
    const bool lat = it < n_lat;
    int b, hd, qrow0, r = 0, cq0 = 0, r0 = 0, cs = 0;
    if (lat) {
      const int qt = it & 3; hd = (it >> 2) & 7; r = (it >> 5) & 63; b = it >> 11;
      cq0 = qt * 16; qrow0 = b * 4096 + r * 64 + cq0;
      r0 = r - 4; r0 = r0 < 0 ? 0 : (r0 > 56 ? 56 : r0);
      int clo = cq0 - 8; clo = clo < 0 ? 0 : (clo > 48 ? 48 : clo);
      cs = clo < 32 ? clo : 32;
    } else {
      const int t = it - n_lat; hd = t & 7; const int qt = (t >> 3) & 15; b = t >> 7;
      qrow0 = NLAT + b * 256 + qt * 16;
    }
    const bf16_t* qp = P.p() + (size_t)(qrow0 + li) * PW + OFF_Q + hd * 64 + 8 * g;
    const bf16x8 qf0 = *(const bf16x8*)qp, qf1 = *(const bf16x8*)(qp + 32);
    f32x4 accS[16], accC[16];
#pragma unroll
    for (int kt = 0; kt < 16; ++kt) {
      const int krow = b * 4096 + (r0 + (kt >> 1)) * 64 + cs + 16 * (kt & 1) + li;
      const bf16_t* kp = P.p() + (size_t)krow * PW + OFF_K + hd * 64 + 8 * g;
      const bf16x8 a0 = *(const bf16x8*)kp, a1 = *(const bf16x8*)(kp + 32);
      f32x4 z = (f32x4){0.f, 0.f, 0.f, 0.f};
      z = __builtin_amdgcn_mfma_f32_16x16x32_bf16(a0, qf0, z, 0, 0, 0);
      accS[kt] = __builtin_amdgcn_mfma_f32_16x16x32_bf16(a1, qf1, z, 0, 0, 0);
    }
#pragma unroll
    for (int ct = 0; ct < 16; ++ct) {
      const int krow = NLAT + b * 256 + 16 * ct + li;
      const bf16_t* kp = P.p() + (size_t)krow * PW + OFF_K + hd * 64 + 8 * g;
      const bf16x8 a0 = *(const bf16x8*)kp, a1 = *(const bf16x8*)(kp + 32);
      f32x4 z = (f32x4){0.f, 0.f, 0.f, 0.f};
      z = __builtin_amdgcn_mfma_f32_16x16x32_bf16(a0, qf0, z, 0, 0, 0);
      accC[ct] = __builtin_amdgcn_mfma_f32_16x16x32_bf16(a1, qf1, z, 0, 0, 0);
    }
    const int cq = cq0 + li;
    int c0q = cq - 8; c0q = c0q < 0 ? 0 : (c0q > 48 ? 48 : c0q);
    float mx = -3.0e38f;
#pragma unroll
    for (int kt = 0; kt < 16; ++kt) {
      const int rk = r0 + (kt >> 1);
#pragma unroll
      for (int e = 0; e < 4; ++e) {
        const int ck = cs + 16 * (kt & 1) + 4 * g + e;
        const bool ok = lat && ck >= c0q && ck < c0q + 16;
        float s = -3.0e38f;
        if (ok) s = accS[kt][e] * 0.125f + rpb[(hd * 15 + (rk - r + 7)) * 31 + (ck - cq + 15)];
        accS[kt][e] = s;
        mx = fmaxf(mx, s);
      }
    }
#pragma unroll
    for (int ct = 0; ct < 16; ++ct)
#pragma unroll
      for (int e = 0; e < 4; ++e) { const float s = accC[ct][e] * 0.125f; accC[ct][e] = s; mx = fmaxf(mx, s); }
    mx = grp_max(mx);
    float sum = 0.f;
#pragma unroll
    for (int kt = 0; kt < 16; ++kt)
#pragma unroll
      for (int e = 0; e < 4; ++e) { const float p = __expf(accS[kt][e] - mx); accS[kt][e] = p; sum += p; }
#pragma unroll
    for (int ct = 0; ct < 16; ++ct)
#pragma unroll
      for (int e = 0; e < 4; ++e) { const float p = __expf(accC[ct][e] - mx); accC[ct][e] = p; sum += p; }
    sum = grp_sum(sum);
    const float inv = 1.f / sum;
    f32x4 accO[4];
#pragma unroll
    for (int db = 0; db < 4; ++db) accO[db] = (f32x4){0.f, 0.f, 0.f, 0.f};
    const bf16_t* vl = P.vtl() + ((size_t)(b * 8 + hd) * 64 + li) * 4096;
    const bf16_t* vc = P.vtc() + ((size_t)(b * 8 + hd) * 64 + li) * 256;
#pragma unroll
    for (int kr = 0; kr < 8; ++kr) {
      bf16x8 af;
#pragma unroll
      for (int e = 0; e < 4; ++e) { af[e] = (short)f2bf(accS[2 * kr][e] * inv); af[4 + e] = (short)f2bf(accS[2 * kr + 1][e] * inv); }
      const int tok = (r0 + kr) * 64 + cs + 4 * g;
#pragma unroll
      for (int db = 0; db < 4; ++db) {
        const bf16_t* vp = vl + (size_t)db * 16 * 4096 + tok;
        const s16x4 lo = *(const s16x4*)vp, hi = *(const s16x4*)(vp + 16);
        const bf16x8 bfr = (bf16x8){lo[0], lo[1], lo[2], lo[3], hi[0], hi[1], hi[2], hi[3]};
        accO[db] = __builtin_amdgcn_mfma_f32_16x16x32_bf16(af, bfr, accO[db], 0, 0, 0);
      }
    }
#pragma unroll
    for (int t = 0; t < 8; ++t) {
      bf16x8 af;
#pragma unroll
      for (int e = 0; e < 4; ++e) { af[e] = (short)f2bf(accC[2 * t][e] * inv); af[4 + e] = (short)f2bf(accC[2 * t + 1][e] * inv); }
      const int tok = 32 * t + 4 * g;
#pragma unroll
      for (int db = 0; db < 4; ++db) {
        const bf16_t* vp = vc + (size_t)db * 16 * 256 + tok;
        const s16x4 lo = *(const s16x4*)vp, hi = *(const s16x4*)(vp + 16);
        const bf16x8 bfr = (bf16x8){lo[0], lo[1], lo[2], lo[3], hi[0], hi[1], hi[2], hi[3]};
        accO[db] = __builtin_amdgcn_mfma_f32_16x16x32_bf16(af, bfr, accO[db], 0, 0, 0);
      }
    }
#pragma unroll
    for (int db = 0; db < 4; ++db)
#pragma unroll
      for (int e = 0; e < 4; ++e)
        P.concat()[(size_t)(qrow0 + 4 * g + e) * 2048 + 1536 + hd * 64 + 16 * db + li] = f2bf(accO[db][e]);
  }
}

__device__ void ph_peer_topk(int wv, const Params& P, int layer, int nrows, char* smem, int bid, int nb) {
  bf16_t* Ks = (bf16_t*)smem;
  float* qt = (float*)(smem + 33280);
  float* sc = qt + 32 * 256;
  float* tv = sc + 64 * 129;
  int* ti = (int*)(tv + 64 * 16);
  const int tid = otid(wv);
  const int ntile = nrows / 32;
  for (int it = bid; it < ntile * 8; it += nb) {
    const int hd = it % 8, tt = it / 8;
    const int row0 = tt * 32;
    __syncthreads();
    for (int i = tid; i < 32 * 256; i += NTHR) {
      const int t = i >> 8, d = i & 255;
      qt[i] = bf2f(P.q()[(size_t)(row0 + t) * 2048 + hd * 256 + d]);
    }
    for (int half = 0; half < 2; ++half) {
      __syncthreads();
      const float* kk = P.peer_keys + ((size_t)((layer * 8 + hd) * 2 + half) * 128) * 128;
      for (int i = tid; i < 128 * 128; i += NTHR) Ks[(i >> 7) * 130 + (i & 127)] = f2bf(kk[i]);
      __syncthreads();
      const int k = tid & 127, tg = (tid >> 7) & 1;
      float acc[16];
#pragma unroll
      for (int i = 0; i < 16; ++i) acc[i] = 0.f;
      for (int d = 0; d < 128; ++d) {
        const float kv = bf2f(Ks[k * 130 + d]);
#pragma unroll
        for (int i = 0; i < 16; ++i) acc[i] += qt[(tg * 16 + i) * 256 + half * 128 + d] * kv;
      }
#pragma unroll
      for (int i = 0; i < 16; ++i) sc[((tg * 16 + i) * 2 + half) * 129 + k] = acc[i];
    }
    __syncthreads();
    if (tid < 64) {
      float* s = sc + tid * 129;
      for (int r = 0; r < 16; ++r) {
        float best = -3.0e38f; int bi = 0;
        for (int k = 0; k < 128; ++k) { const float v = s[k]; if (v > best) { best = v; bi = k; } }
        tv[tid * 16 + r] = best; ti[tid * 16 + r] = bi;
        s[bi] = -3.0e38f;
      }
    }
    __syncthreads();
    float* cand = qt;
    for (int i = tid; i < 32 * 256; i += NTHR) {
      const int t = i >> 8, a = (i >> 4) & 15, b2 = i & 15;
      cand[i] = tv[(t * 2 + 0) * 16 + a] + tv[(t * 2 + 1) * 16 + b2];
    }
    __syncthreads();
    if (tid < 32) {
      float* cd = cand + tid * 256;
      float ts[16];
      const int row = row0 + tid;
      float mx = 0.f;
#pragma unroll
      for (int r = 0; r < 16; ++r) {
        float best = -3.0e38f; int bi = 0;
        for (int k = 0; k < 256; ++k) { const float v = cd[k]; if (v > best) { best = v; bi = k; } }
        cd[bi] = -3.0e38f;
        ts[r] = best;
        if (r == 0) mx = best;
        const int e = ti[(tid * 2 + 0) * 16 + (bi >> 4)] * 128 + ti[(tid * 2 + 1) * 16 + (bi & 15)];
        P.sel_idx()[(size_t)row * 128 + hd * 16 + r] = e;
      }
      float sum = 0.f;
#pragma unroll
      for (int r = 0; r < 16; ++r) { ts[r] = expf(ts[r] - mx); sum += ts[r]; }
      const float inv = 1.f / sum;
#pragma unroll
      for (int r = 0; r < 16; ++r) P.sel_g()[(size_t)row * 128 + hd * 16 + r] = ts[r] * inv;
    }
  }
}


__device__ __forceinline__ uint32_t mono_u(float f) { const uint32_t u = __float_as_uint(f); return u ^ ((uint32_t)((int)u >> 31) | 0x80000000u); }
__device__ __forceinline__ float unmono_f(uint32_t m) { return __uint_as_float((m & 0x80000000u) ? (m ^ 0x80000000u) : ~m); }
__device__ __forceinline__ uint32_t grp_max_u(uint32_t v) {
  auto a = __builtin_amdgcn_permlane16_swap(v, v, false, false);
  v = a[0] > a[1] ? a[0] : a[1];
  auto b = __builtin_amdgcn_permlane32_swap(v, v, false, false);
  return b[0] > b[1] ? b[0] : b[1];
}
__device__ void ph_peer_topk_mfma(int wv, const Params& P, int layer, int nrows, char* smem, int bid, int nb) {
  const int tid = otid(wv), lane = tid & 63, li = lane & 15, g = lane >> 4;
  unsigned char* ctab = (unsigned char*)smem;
  float* vals = (float*)(smem + 256) + wv * 512;
  int* idxs = (int*)(smem + 256 + 8 * 2048) + wv * 512;
  __syncthreads();
  if (tid < 64) ctab[tid] = 0xFF;
  __syncthreads();
  if (tid == 0) {
    int n = 0;
    for (int a = 0; a < 16; ++a)
      for (int b = 0; b < 16; ++b)
        if ((a + 1) * (b + 1) <= 16) { ctab[(n & 3) * 16 + (n >> 2)] = (unsigned char)(a * 16 + b); ++n; }
  }
  __syncthreads();
  const int ntile = nrows / 16;
  for (int it = bid * NWAVE + wv; it < ntile * 8; it += nb * NWAVE) {
    const int hd = it & 7, row0 = (it >> 3) * 16;
    const bf16_t* qp = P.q() + (size_t)(row0 + li) * 2048 + hd * 256 + 8 * g;
    uint32_t win[2][16];
#pragma unroll
    for (int half = 0; half < 2; ++half) {
      bf16x8 qf[4];
#pragma unroll
      for (int t = 0; t < 4; ++t) qf[t] = *(const bf16x8*)(qp + half * 128 + 32 * t);
      const bf16_t* kb = P.keysb() + ((size_t)((layer * 8 + hd) * 2 + half) * 128 + li) * 128 + 8 * g;
      uint32_t pk[32];
#pragma unroll
      for (int kt = 0; kt < 8; ++kt) {
        f32x4 acc = (f32x4){0.f, 0.f, 0.f, 0.f};
#pragma unroll
        for (int t = 0; t < 4; ++t) {
          const bf16x8 a = *(const bf16x8*)(kb + (size_t)kt * 16 * 128 + 32 * t);
          acc = __builtin_amdgcn_mfma_f32_16x16x32_bf16(a, qf[t], acc, 0, 0, 0);
        }
#pragma unroll
        for (int e = 0; e < 4; ++e) pk[kt * 4 + e] = (mono_u(acc[e]) & ~127u) | (uint32_t)(16 * kt + 4 * g + e);
      }
#pragma unroll
      for (int r = 0; r < 16; ++r) {
        uint32_t m = pk[0];
#pragma unroll
        for (int i = 1; i < 32; ++i) m = pk[i] > m ? pk[i] : m;
        m = grp_max_u(m);
        win[half][r] = m;
#pragma unroll
        for (int i = 0; i < 32; ++i) pk[i] = (pk[i] == m) ? 0u : pk[i];
      }
    }
    if (g == 0) {
#pragma unroll
      for (int half = 0; half < 2; ++half)
#pragma unroll
        for (int r = 0; r < 16; ++r) {
          vals[li * 32 + half * 16 + r] = unmono_f(win[half][r] & ~127u);
          idxs[li * 32 + half * 16 + r] = (int)(win[half][r] & 127u);
        }
    }
    __builtin_amdgcn_wave_barrier();
    uint32_t cp[16];
#pragma unroll
    for (int s = 0; s < 16; ++s) {
      const uint32_t ab = ctab[g * 16 + s];
      uint32_t v = 0u;
      if (ab != 0xFFu) v = (mono_u(vals[li * 32 + (ab >> 4)] + vals[li * 32 + 16 + (ab & 15u)]) & ~255u) | ab;
      cp[s] = v;
    }
    uint32_t cw[16];
#pragma unroll
    for (int r = 0; r < 16; ++r) {
      uint32_t m = cp[0];
#pragma unroll
      for (int i = 1; i < 16; ++i) m = cp[i] > m ? cp[i] : m;
      m = grp_max_u(m);
      cw[r] = m;
#pragma unroll
      for (int i = 0; i < 16; ++i) cp[i] = (cp[i] == m) ? 0u : cp[i];
    }
    const float mx = unmono_f(cw[0] & ~255u);
    float ex[16];
    float sum = 0.f;
#pragma unroll
    for (int r = 0; r < 16; ++r) { ex[r] = __expf(unmono_f(cw[r] & ~255u) - mx); sum += ex[r]; }
    const float inv = 1.f / sum;
    const size_t ob = (size_t)(row0 + li) * 128 + hd * 16;
#pragma unroll
    for (int r = 0; r < 16; ++r) {
      if ((r >> 2) == g) {
        const uint32_t ab = cw[r] & 255u;
        P.sel_idx()[ob + r] = idxs[li * 32 + (ab >> 4)] * 128 + idxs[li * 32 + 16 + (ab & 15u)];
        P.sel_g()[ob + r] = ex[r] * inv;
      }
    }
    __builtin_amdgcn_wave_barrier();
  }
}

__device__ void ph_peer_gather(int wv, const Params& P, int layer, int nrows, int bid, int nb) {
  const int wave = otid(wv) >> 6, lane = otid(wv) & 63;
  for (int row = bid * NWAVE + wave; row < nrows; row += nb * NWAVE) {
    float xv[16], o[16];
    unpack8(*(const uint4*)(P.u() + (size_t)row * DM + lane * 8), xv);
    unpack8(*(const uint4*)(P.u() + (size_t)row * DM + 512 + lane * 8), xv + 8);
    int idx[2]; float act[2];
    idx[0] = P.sel_idx()[(size_t)row * 128 + lane]; idx[1] = P.sel_idx()[(size_t)row * 128 + 64 + lane];
#pragma unroll
    for (int hb = 0; hb < 2; ++hb) {
      float dk = 0.f;
#pragma unroll 4
      for (int k = 0; k < 64; ++k) {
        const int e = __builtin_amdgcn_readlane(idx[hb], k);
        const bf16_t* ur = P.tabU() + (size_t)e * 1024 + lane * 8;
        float f[16];
        unpack8(*(const uint4*)ur, f);
        unpack8(*(const uint4*)(ur + 512), f + 8);
        float d = 0.f;
#pragma unroll
        for (int i = 0; i < 16; ++i) d += f[i] * xv[i];
        d = wave_sum(d);
        dk = (lane == k) ? d : dk;
      }
      act[hb] = gelu_f(dk) * P.sel_g()[(size_t)row * 128 + hb * 64 + lane];
    }
#pragma unroll
    for (int i = 0; i < 16; ++i) o[i] = 0.f;
#pragma unroll
    for (int hb = 0; hb < 2; ++hb) {
#pragma unroll 4
      for (int k = 0; k < 64; ++k) {
        const int e = __builtin_amdgcn_readlane(idx[hb], k);
        const float a = __int_as_float(__builtin_amdgcn_readlane(__float_as_int(act[hb]), k));
        const bf16_t* vr = P.tabV() + (size_t)e * 1024 + lane * 8;
        float f[16];
        unpack8(*(const uint4*)vr, f);
        unpack8(*(const uint4*)(vr + 512), f + 8);
#pragma unroll
        for (int i = 0; i < 16; ++i) o[i] += a * f[i];
      }
    }
    const float* gate = P.mod() + (size_t)(layer * 5 + modrow(row)) * MODW + 5120;
    float* hr = P.h() + (size_t)row * DM;
#pragma unroll
    for (int j = 0; j < 2; ++j)
#pragma unroll
      for (int q = 0; q < 2; ++q) {
        const int idx0 = j * 512 + lane * 8 + q * 4;
        float4 hv = *(float4*)(hr + idx0);
        const float4 gg = *(const float4*)(gate + idx0);
        hv.x += gg.x * o[j * 8 + q * 4 + 0]; hv.y += gg.y * o[j * 8 + q * 4 + 1];
        hv.z += gg.z * o[j * 8 + q * 4 + 2]; hv.w += gg.w * o[j * 8 + q * 4 + 3];
        *(float4*)(hr + idx0) = hv;
      }
  }
}

__device__ void ph_final(int wv, const Params& P, int bid, int nb) {
  const int wave = otid(wv) >> 6, lane = otid(wv) & 63;
  for (int row = bid * NWAVE + wave; row < NLAT; row += nb * NWAVE) {
    const float* src = P.h() + (size_t)row * DM;
    float4 v[4];
    float ss = 0.f;
#pragma unroll
    for (int i = 0; i < 4; ++i) {
      v[i] = ((const float4*)src)[i * 64 + lane];
      ss += v[i].x * v[i].x + v[i].y * v[i].y + v[i].z * v[i].z + v[i].w * v[i].w;
    }
    ss = wave_sum(ss);
    const float rstd = rsqrtf(ss * (1.f / 1024.f) + 1e-6f);
#pragma unroll
    for (int i = 0; i < 4; ++i) {
      const int idx = i * 256 + lane * 4;
      const float4 gg = *(const float4*)(P.final_g + idx);
      float4 o;
      o.x = v[i].x * rstd * gg.x; o.y = v[i].y * rstd * gg.y; o.z = v[i].z * rstd * gg.z; o.w = v[i].w * rstd * gg.w;
      *(float4*)(P.out + (size_t)row * DM + idx) = o;
    }
  }
}


struct EpiOutproj {
  static constexpr bool PERM = false, AFTER_DRAIN = false;
  float* H; const float* hl; const float* hc; const float* modl;
  __device__ __forceinline__ void operator()(const pg8::f32x4 (&acc)[2][2][4][2], const pg8::Unit& u, int wr, int wc, int fr, int fq) const {
    const int row0 = u.pm * 256 + wr * 64 + fr, col0 = u.pn * 256 + wc * 32 + 4 * fq;
#pragma unroll
    for (int ai = 0; ai < 2; ++ai)
#pragma unroll
      for (int m = 0; m < 4; ++m) {
        const int row = row0 + ai * 128 + m * 16;
        const float* src = hrow(hl, hc, row) + col0;
        const float* gate = modl + (size_t)modrow(row) * MODW + 2048 + col0;
        float* dst = H + (size_t)row * DM + col0;
#pragma unroll
        for (int bj = 0; bj < 2; ++bj)
#pragma unroll
          for (int n = 0; n < 2; ++n) {
            const pg8::f32x4 s = *(const pg8::f32x4*)(src + bj * 128 + n * 16);
            const pg8::f32x4 g = *(const pg8::f32x4*)(gate + bj * 128 + n * 16);
            *(pg8::f32x4*)(dst + bj * 128 + n * 16) = s + g * acc[ai][bj][m][n];
          }
      }
  }
};

__device__ void ph_convert_tables(int wv, const Params& P, int layer, int bid, int nb) {
  const size_t n8 = (size_t)16384 * 1024 / 8;
  for (int t = 0; t < 2; ++t) {
    const float* src = (t == 0 ? P.peer_u : P.peer_v) + (size_t)layer * 16384 * 1024;
    bf16_t* dst = t == 0 ? P.tabU() : P.tabV();
    for (size_t i = (size_t)bid * NTHR + otid(wv); i < n8; i += (size_t)nb * NTHR) {
      const float4 a = ((const float4*)src)[i * 2], b = ((const float4*)src)[i * 2 + 1];
      uint4 o;
      o.x = (uint32_t)f2bf(a.x) | ((uint32_t)f2bf(a.y) << 16); o.y = (uint32_t)f2bf(a.z) | ((uint32_t)f2bf(a.w) << 16);
      o.z = (uint32_t)f2bf(b.x) | ((uint32_t)f2bf(b.y) << 16); o.w = (uint32_t)f2bf(b.z) | ((uint32_t)f2bf(b.w) << 16);
      ((uint4*)dst)[i] = o;
    }
  }
}

enum {
  PH_PREP = 0, PH_NORM1, PH_INPROJ, PH_CONV, PH_SSDPREP, PH_STATES, PH_SCAN, PH_SSDY, PH_SSDNORM, PH_POOL, PH_NA,
  PH_OUTPROJ, PH_NORM2, PH_QGEMM, PH_TOPK, PH_GATHER, PH_FINAL
};

#define SMEM_BYTES 131072

__device__ __forceinline__ void run_phase(int wv, const Params& P, int ph, int layer, char* smem, int bid, int nb) {
  const float* hl = layer == 0 ? P.x : P.h();
  const float* hc = layer == 0 ? P.ctx : P.h() + (size_t)NLAT * DM;
  const int nrows = layer == 0 ? NTOK : NLAT;
  switch (ph) {
    case PH_PREP:
      for (int i = bid * NTHR + otid(wv); i < 2 * 8 * 2 * 128 * 128; i += nb * NTHR) P.keysb()[i] = f2bf(P.peer_keys[i]);
      ph_mod(wv, P, (float*)smem, bid, nb);
      for (int l = 0; l < 2; ++l) {
        ph_transpose(wv, P.w_in + (size_t)l * 1024 * INW, P.w_inT() + (size_t)l * PW * 1024, 1024, INW, PW, 0, 2560, 32, PW, (float*)smem, bid, nb);
        ph_transpose(wv, P.w_in + (size_t)l * 1024 * INW, P.w_dtT() + (size_t)l * 128 * 1024, 1024, INW, 128, 2560, 1 << 30, 0, 32, (float*)smem, bid, nb);
        ph_transpose(wv, P.w_out + (size_t)l * 2048 * 1024, P.w_outT() + (size_t)l * 1024 * 2048, 2048, 1024, 1024, 0, 1 << 30, 0, 1024, (float*)smem, bid, nb);
        ph_transpose(wv, P.peer_wq + (size_t)l * 1024 * 2048, P.w_qT() + (size_t)l * 2048 * 1024, 1024, 2048, 2048, 0, 1 << 30, 0, 2048, (float*)smem, bid, nb);
      }
      break;
    case PH_NORM1:
      ph_norm(wv, hl, hc, P.norm1_g + layer * 1024, P.mod() + (size_t)layer * 5 * MODW, 0, 1024, NTOK, P.u(), bid, nb);
      break;
    case PH_INPROJ:
    {
      pg8::Gemm g{P.u(), P.w_inT() + (size_t)layer * PW * 1024, NTOK, PW, 1024};
      pg8::StaticOrder S; S.init(g.M, g.N, nb, bid);
      pg8::EpiBf16<0> E{P.p(), PW, nullptr, 0, 0};
      pg8::gemm_phase<pg8::EpiBf16<0>, pg8::StaticOrder, false>(wv, (PG8_LAS unsigned char*)smem, g, S, E, nullptr);
      ph_gemm<EPI_INPROJ>(wv, P, layer, P.u(), P.w_dtT() + (size_t)layer * 128 * 1024, NTOK, 128, 1024, hl, hc, smem, bid, nb);
      break;
    }
    case PH_CONV: ph_conv(wv, P, layer, bid, nb); ph_vtranspose(wv, P, smem, bid, nb); break;
    case PH_SSDPREP: ph_ssdprep(wv, P, layer, bid, nb); break;
    case PH_STATES: ph_states_mfma(wv, P, layer, smem, bid, nb); break;
    case PH_SCAN: ph_scan(wv, P, bid, nb); break;
    case PH_SSDY: ph_ssdy_mfma(wv, P, layer, nrows / 128, smem, bid, nb); break;
    case PH_SSDNORM: ph_ssdnorm(wv, P, layer, nrows, bid, nb); break;
    case PH_POOL: ph_pool(wv, P, layer, nrows, smem, bid, nb); break;
    case PH_NA: ph_na_mfma(wv, P, layer, nrows, bid, nb); break;
    case PH_OUTPROJ:
    {
      pg8::Gemm g{P.concat(), P.w_outT() + (size_t)layer * 1024 * 2048, nrows, 1024, 2048};
      pg8::StaticOrder S; S.init(g.M, g.N, nb, bid);
      EpiOutproj E{P.h(), hl, hc, P.mod() + (size_t)layer * 5 * MODW};
      pg8::gemm_phase<EpiOutproj, pg8::StaticOrder, false>(wv, (PG8_LAS unsigned char*)smem, g, S, E, nullptr);
      break;
    }
    case PH_NORM2:
      ph_norm(wv, P.h(), P.h() + (size_t)NLAT * DM, P.norm2_g + layer * 1024, P.mod() + (size_t)layer * 5 * MODW, 3072, 4096, nrows, P.u(), bid, nb);
      break;
    case PH_QGEMM:
    {
      pg8::Gemm g{P.u(), P.w_qT() + (size_t)layer * 2048 * 1024, nrows, 2048, 1024};
      pg8::StaticOrder S; S.init(g.M, g.N, nb, bid);
      pg8::EpiBf16<0> E{P.q(), 2048, nullptr, 0, 0};
      pg8::gemm_phase<pg8::EpiBf16<0>, pg8::StaticOrder, false>(wv, (PG8_LAS unsigned char*)smem, g, S, E, nullptr);
      ph_convert_tables(wv, P, layer, bid, nb);
      break;
    }
    case PH_TOPK: ph_peer_topk_mfma(wv, P, layer, nrows, smem, bid, nb); break;
    case PH_GATHER: ph_peer_gather(wv, P, layer, nrows, bid, nb); break;
    case PH_FINAL: ph_final(wv, P, bid, nb); break;
  }
}

namespace cg = cooperative_groups;
typedef const __attribute__((address_space(4))) Params* kparams_t;
__device__ __forceinline__ const Params& kp_fresh() {
  kparams_t kp = (kparams_t)__builtin_amdgcn_kernarg_segment_ptr();
  asm volatile("" : "+s"(kp));
  return *(const Params*)kp;
}
__global__ void __launch_bounds__(NTHR) k_mega(Params P_unused) {
  __shared__ __attribute__((aligned(16))) char smem[SMEM_BYTES];
  cg::grid_group grid = cg::this_grid();
  const int bid = blockIdx.x, nb = gridDim.x;
  const int wv = __builtin_amdgcn_readfirstlane(threadIdx.x >> 6);
  run_phase(wv, kp_fresh(), PH_PREP, 0, smem, bid, nb);
  grid.sync();
#pragma unroll 1
  for (int layer = 0; layer < 2; ++layer) {
    run_phase(wv, kp_fresh(), PH_NORM1, layer, smem, bid, nb); grid.sync();
    run_phase(wv, kp_fresh(), PH_INPROJ, layer, smem, bid, nb); grid.sync();
    run_phase(wv, kp_fresh(), PH_CONV, layer, smem, bid, nb); grid.sync();
    run_phase(wv, kp_fresh(), PH_SSDPREP, layer, smem, bid, nb); grid.sync();
    run_phase(wv, kp_fresh(), PH_STATES, layer, smem, bid, nb); grid.sync();
    run_phase(wv, kp_fresh(), PH_SCAN, layer, smem, bid, nb); grid.sync();
    run_phase(wv, kp_fresh(), PH_SSDY, layer, smem, bid, nb); grid.sync();
    run_phase(wv, kp_fresh(), PH_SSDNORM, layer, smem, bid, nb); grid.sync();
    run_phase(wv, kp_fresh(), PH_POOL, layer, smem, bid, nb); grid.sync();
    run_phase(wv, kp_fresh(), PH_NA, layer, smem, bid, nb); grid.sync();
    run_phase(wv, kp_fresh(), PH_OUTPROJ, layer, smem, bid, nb); grid.sync();
    run_phase(wv, kp_fresh(), PH_NORM2, layer, smem, bid, nb); grid.sync();
    run_phase(wv, kp_fresh(), PH_QGEMM, layer, smem, bid, nb); grid.sync();
    run_phase(wv, kp_fresh(), PH_TOPK, layer, smem, bid, nb); grid.sync();
    run_phase(wv, kp_fresh(), PH_GATHER, layer, smem, bid, nb); grid.sync();
  }
  run_phase(wv, kp_fresh(), PH_FINAL, 0, smem, bid, nb);
}

extern "C" void kernel_launch(void* const* d_in, const int* in_sizes, int n_in, void* d_out, int out_size, void* d_ws,
                              size_t ws_size, hipStream_t stream) {
  Params P{};
  const float* const* in = (const float* const*)d_in;
  P.x = in[0]; P.c = in[1]; P.ctx = in[2]; P.c_ctx = in[3]; P.ada_w = in[4]; P.ada_b = in[5]; P.norm1_g = in[6];
  P.w_in = in[7]; P.conv_w = in[8]; P.conv_b = in[9]; P.a_log = in[10]; P.dt_bias = in[11]; P.d_skip = in[12];
  P.ssd_norm_g = in[13]; P.pool_w = in[14]; P.pool_scale = in[15]; P.na_rpb = in[16]; P.w_out = in[17];
  P.norm2_g = in[18]; P.peer_wq = in[19]; P.peer_keys = in[20]; P.peer_u = in[21]; P.peer_v = in[22]; P.final_g = in[23];
  P.out = (float*)d_out;
  P.ws = (char*)d_ws;
  if (WS_TOTAL > ws_size) { fprintf(stderr, "workspace too small: need %zu have %zu\n", (size_t)WS_TOTAL, ws_size); return; }

  static int grid_blocks = 0;
  if (!grid_blocks) {
    int dev = 0, cus = 0, per_cu = 0;
    hipGetDevice(&dev);
    hipDeviceGetAttribute(&cus, hipDeviceAttributeMultiprocessorCount, dev);
    hipOccupancyMaxActiveBlocksPerMultiprocessor(&per_cu, k_mega, NTHR, 0);
    if (per_cu > 4) per_cu = 4;
    grid_blocks = cus * per_cu;
  }
  void* args[] = {&P};
  hipError_t e = hipLaunchCooperativeKernel((void*)k_mega, dim3(grid_blocks), dim3(NTHR), args, 0, stream);
  if (e != hipSuccess) fprintf(stderr, "cooperative launch failed: %s (grid %d)\n", hipGetErrorString(e), grid_blocks);
}
```

```cpp
#include <hip/hip_runtime.h>
#include <hip/hip_bf16.h>
#include <hip/hip_cooperative_groups.h>
#include <stdint.h>
#include <stdio.h>

typedef unsigned short bf16_t;
typedef __attribute__((ext_vector_type(8))) short bf16x8;
typedef __attribute__((ext_vector_type(4))) float f32x4;

#define NTHR 512
#define NWAVE 8
constexpr int DM = 1024;
constexpr int SEQ = 4096;
constexpr int NLAT = 16384;
constexpr int NCTXR = 1024;
constexpr int NTOK = 17408;
constexpr int INW = 4640;
constexpr int PW = 4608;
constexpr int OFF_Z = 0, OFF_XBC = 1024, OFF_POOL = 2560, OFF_Q = 3072, OFF_K = 3584, OFF_V = 4096;
constexpr int NCHUNK = 136;
constexpr int MODW = 6144;

constexpr size_t al256(size_t x) { return (x + 255) & ~(size_t)255; }
constexpr size_t WS_MOD = 0;
constexpr size_t WS_H = WS_MOD + al256((size_t)2 * 5 * MODW * 4);
constexpr size_t WS_P = WS_H + al256((size_t)NTOK * DM * 4);
constexpr size_t WS_TABU = WS_P + (size_t)80 * 1024 * 1024;
constexpr size_t WS_TABV = WS_TABU + (size_t)16384 * 1024 * 2;
constexpr size_t WS_DTRAW = WS_P + al256((size_t)NTOK * PW * 2);
constexpr size_t WS_DTV = WS_DTRAW + al256((size_t)NTOK * 32 * 4);
constexpr size_t WS_CSV = WS_DTV + al256((size_t)NTOK * 32 * 4);
constexpr size_t WS_XBC = WS_CSV + al256((size_t)NTOK * 32 * 4);
constexpr size_t WS_VTL = WS_XBC + al256((size_t)NTOK * 512 * 2);
constexpr size_t WS_VTC = WS_VTL + al256((size_t)4 * 8 * 64 * 4096 * 2);
constexpr size_t WS_KEYSB = WS_VTC + al256((size_t)4 * 8 * 64 * 256 * 2);
constexpr size_t WS_STATES = WS_XBC + al256((size_t)NTOK * 1536 * 2);
static_assert(WS_KEYSB + (size_t)2 * 8 * 2 * 128 * 128 * 2 <= WS_STATES, "must fit in the old xbc region");
constexpr size_t WS_CONCAT = WS_STATES + al256((size_t)NCHUNK * 32 * 8192 * 2);
constexpr size_t WS_SELIDX = WS_CONCAT + al256((size_t)NTOK * 2048 * 2);
constexpr size_t WS_SELG = WS_SELIDX + al256((size_t)NTOK * 128 * 4);
constexpr size_t WS_WINT = WS_SELG + al256((size_t)NTOK * 128 * 4);
constexpr size_t WS_WDTT = WS_WINT + al256((size_t)2 * PW * 1024 * 2);
constexpr size_t WS_WOUTT = WS_WDTT + al256((size_t)2 * 128 * 1024 * 2);
constexpr size_t WS_WQT = WS_WOUTT + al256((size_t)2 * 1024 * 2048 * 2);
constexpr size_t WS_BAR = WS_WQT + al256((size_t)2 * 2048 * 1024 * 2);
constexpr size_t WS_TOTAL = WS_BAR + al256((size_t)4096 * 4);
static_assert(WS_TABV + (size_t)16384 * 1024 * 2 <= WS_DTRAW, "tables must fit in the tail of p");
static_assert((size_t)NTOK * 2048 * 2 <= (size_t)80 * 1024 * 1024, "q must fit below the tables");

struct Params {
  const float *x, *c, *ctx, *c_ctx, *ada_w, *ada_b, *norm1_g, *w_in, *conv_w, *conv_b, *a_log, *dt_bias, *d_skip,
      *ssd_norm_g, *pool_w, *pool_scale, *na_rpb, *w_out, *norm2_g, *peer_wq, *peer_keys, *peer_u, *peer_v, *final_g;
  float* out;
  char* ws;
  __device__ __forceinline__ float* mod() const { return (float*)(ws + WS_MOD); }
  __device__ __forceinline__ float* h() const { return (float*)(ws + WS_H); }
  __device__ __forceinline__ bf16_t* u() const { return (bf16_t*)(ws + WS_CONCAT); }
  __device__ __forceinline__ bf16_t* p() const { return (bf16_t*)(ws + WS_P); }
  __device__ __forceinline__ float* dtraw() const { return (float*)(ws + WS_DTRAW); }
  __device__ __forceinline__ float* dtv() const { return (float*)(ws + WS_DTV); }
  __device__ __forceinline__ float* csv() const { return (float*)(ws + WS_CSV); }
  __device__ __forceinline__ bf16_t* xbc() const { return (bf16_t*)(ws + WS_XBC); }
  __device__ __forceinline__ bf16_t* states() const { return (bf16_t*)(ws + WS_STATES); }
  __device__ __forceinline__ bf16_t* concat() const { return (bf16_t*)(ws + WS_CONCAT); }
  __device__ __forceinline__ bf16_t* q() const { return (bf16_t*)(ws + WS_P); }
  __device__ __forceinline__ int* sel_idx() const { return (int*)(ws + WS_SELIDX); }
  __device__ __forceinline__ float* sel_g() const { return (float*)(ws + WS_SELG); }
  __device__ __forceinline__ bf16_t* w_inT() const { return (bf16_t*)(ws + WS_WINT); }
  __device__ __forceinline__ bf16_t* w_dtT() const { return (bf16_t*)(ws + WS_WDTT); }
  __device__ __forceinline__ bf16_t* w_outT() const { return (bf16_t*)(ws + WS_WOUTT); }
  __device__ __forceinline__ bf16_t* w_qT() const { return (bf16_t*)(ws + WS_WQT); }
  __device__ __forceinline__ bf16_t* vtl() const { return (bf16_t*)(ws + WS_VTL); }
  __device__ __forceinline__ bf16_t* vtc() const { return (bf16_t*)(ws + WS_VTC); }
  __device__ __forceinline__ bf16_t* keysb() const { return (bf16_t*)(ws + WS_KEYSB); }
  __device__ __forceinline__ bf16_t* tabU() const { return (bf16_t*)(ws + WS_TABU); }
  __device__ __forceinline__ bf16_t* tabV() const { return (bf16_t*)(ws + WS_TABV); }
};

__device__ __forceinline__ int otid(int wv) {
  int l;
  asm volatile("v_mbcnt_lo_u32_b32 %0, -1, 0\n\tv_mbcnt_hi_u32_b32 %0, -1, %0" : "=v"(l));
  return (wv << 6) | l;
}
__device__ __forceinline__ float bf2f(bf16_t v) { return __uint_as_float(((uint32_t)v) << 16); }
__device__ __forceinline__ bf16_t f2bf(float f) {
  uint32_t u = __float_as_uint(f);
  u += 0x7fffu + ((u >> 16) & 1u);
  return (bf16_t)(u >> 16);
}
#define DPP_F(v, ctrl) __int_as_float(__builtin_amdgcn_update_dpp(0, __float_as_int(v), (ctrl), 0xf, 0xf, true))
__device__ __forceinline__ float wave_sum(float v) {
  v += DPP_F(v, 0xB1);
  v += DPP_F(v, 0x4E);
  v += DPP_F(v, 0x141);
  v += DPP_F(v, 0x140);
  const int iv = __float_as_int(v);
  return __int_as_float(__builtin_amdgcn_readlane(iv, 0)) + __int_as_float(__builtin_amdgcn_readlane(iv, 16)) +
         __int_as_float(__builtin_amdgcn_readlane(iv, 32)) + __int_as_float(__builtin_amdgcn_readlane(iv, 48));
}
__device__ __forceinline__ float wave_max(float v) {
  v = fmaxf(v, DPP_F(v, 0xB1));
  v = fmaxf(v, DPP_F(v, 0x4E));
  v = fmaxf(v, DPP_F(v, 0x141));
  v = fmaxf(v, DPP_F(v, 0x140));
  const int iv = __float_as_int(v);
  return fmaxf(fmaxf(__int_as_float(__builtin_amdgcn_readlane(iv, 0)), __int_as_float(__builtin_amdgcn_readlane(iv, 16))),
               fmaxf(__int_as_float(__builtin_amdgcn_readlane(iv, 32)), __int_as_float(__builtin_amdgcn_readlane(iv, 48))));
}
__device__ __forceinline__ float silu_f(float v) { return v / (1.f + expf(-v)); }
__device__ __forceinline__ float softplus_f(float v) { return fmaxf(v, 0.f) + log1pf(expf(-fabsf(v))); }
__device__ __forceinline__ float gelu_f(float v) { return 0.5f * v * (1.f + erff(v * 0.70710678118654752f)); }

__device__ __forceinline__ void unpack8(const uint4 v, float* f) {
  f[0] = __uint_as_float(v.x << 16); f[1] = __uint_as_float(v.x & 0xffff0000u);
  f[2] = __uint_as_float(v.y << 16); f[3] = __uint_as_float(v.y & 0xffff0000u);
  f[4] = __uint_as_float(v.z << 16); f[5] = __uint_as_float(v.z & 0xffff0000u);
  f[6] = __uint_as_float(v.w << 16); f[7] = __uint_as_float(v.w & 0xffff0000u);
}
__device__ __forceinline__ uint32_t pack2(float a, float b) { return (uint32_t)f2bf(a) | ((uint32_t)f2bf(b) << 16); }
typedef short s16x4 __attribute__((ext_vector_type(4)));
typedef __attribute__((address_space(3))) s16x4 lds_s16x4;
__device__ __forceinline__ bf16x8 tr_read2(const char* a0, const char* a1) {
  const s16x4 a = __builtin_amdgcn_ds_read_tr16_b64_v4i16((lds_s16x4*)a0);
  const s16x4 b = __builtin_amdgcn_ds_read_tr16_b64_v4i16((lds_s16x4*)a1);
  return (bf16x8){a[0], a[1], a[2], a[3], b[0], b[1], b[2], b[3]};
}

__device__ __forceinline__ const float* hrow(const float* hl, const float* hc, int row) {
  return row < NLAT ? hl + (size_t)row * DM : hc + (size_t)(row - NLAT) * DM;
}
__device__ __forceinline__ int modrow(int row) { return row < NLAT ? (row >> 12) : 4; }

namespace pg8 {
#define PG8_LAS __attribute__((address_space(3)))
typedef unsigned short bf16_t;
typedef short bf16x8 __attribute__((ext_vector_type(8)));
typedef float f32x4 __attribute__((ext_vector_type(4)));
typedef unsigned u32x4 __attribute__((ext_vector_type(4)));
constexpr int BM = 256, BK = 64, HALF = 128, HTB = HALF * BK * 2  , STAGE_BYTES = 8 * HTB, NXCD = 8, WGM = 8;

__host__ __device__ __forceinline__ int lds_byte(int r, int c) { const int st = (r >> 4) * 2 + (c >> 5), rr = r & 15, cc = c & 31, ob = rr * 64 + cc * 2; return st * 1024 + (ob ^ (((ob >> 9) & 1) << 5)); }
__host__ __device__ __forceinline__ void stage_rc(int b, int& R, int& C) { const int st = b / 1024, sb = b % 1024, swz = sb ^ (((sb >> 9) & 1) << 5); R = (st >> 1) * 16 + swz / 64; C = (st & 1) * 32 + (swz % 64) / 2; }
__host__ __device__ __forceinline__ int perm32(int rho) { const int n = rho >> 4, i = rho & 15; return 8 * (i >> 2) + 4 * n + (i & 3); }

struct Unit { int pm, pn; };
struct Gemm { const bf16_t* A; const bf16_t* Bt; int M, N, K; };

struct StaticOrder {
    int nM, nN, nwg, G, c;
    __host__ __device__ void init(int M, int N, int G_, int c_) { nM = M / BM; nN = N / BM; nwg = nM * nN; G = G_; c = c_; }
    __host__ __device__ bool next(int i, Unit& u) const {
        const long L = (long)i * G + c; if (L >= nwg) return false;
        int wgid = (int)L; { const int q = nwg / NXCD, r = nwg % NXCD, xcd = wgid % NXCD, off = wgid / NXCD; wgid = (xcd < r ? xcd * (q + 1) : r * (q + 1) + (xcd - r) * q) + off; }
        const int nig = WGM * nN, gid = wgid / nig, fm = gid * WGM, gsz = (nM - fm) < WGM ? (nM - fm) : WGM;
        u.pm = fm + ((wgid % nig) % gsz); u.pn = (wgid % nig) / gsz; return true;
    }
    __device__ __forceinline__ void a_ready(const Unit&) const {}
    __device__ __forceinline__ void done(const Unit&) const {}
};

__device__ __forceinline__ unsigned cvt_pk_bf16(float lo, float hi) { unsigned r; asm volatile("v_cvt_pk_bf16_f32 %0, %1, %2" : "=v"(r) : "v"(lo), "v"(hi)); return r; }
typedef float f32x2 __attribute__((ext_vector_type(2)));
__device__ __forceinline__ f32x2 gelu_pk(f32x2 v) { return v; }
template <int ACT  > struct EpiBf16 {
    static constexpr bool PERM = true, AFTER_DRAIN = false;
    bf16_t* O; int ldc; const float* bias; int split_cols; size_t split_stride;
    __device__ __forceinline__ void operator()(const f32x4 (&acc)[2][2][4][2], const Unit& u, int wr, int wc, int fr, int fq) const {
        const int row0 = u.pm * BM + wr * 64 + fr; int colt = u.pn * BM; bf16_t* base = O;
        if (split_cols) { const int t = colt / split_cols; base += (size_t)t * split_stride; colt -= t * split_cols; }
        const int col0 = colt + wc * 32 + 8 * fq, bcol0 = u.pn * BM + wc * 32 + 8 * fq;
        f32x4 bv[2][2];
#pragma unroll
        for (int bj = 0; bj < 2; ++bj)
#pragma unroll
            for (int n = 0; n < 2; ++n) bv[bj][n] = bias ? *(const f32x4*)(bias + bcol0 + bj * HALF + 4 * n) : (f32x4){0.f, 0.f, 0.f, 0.f};
#pragma unroll
        for (int ai = 0; ai < 2; ++ai)
#pragma unroll
            for (int m = 0; m < 4; ++m) { bf16_t* rowp = base + (size_t)(row0 + ai * HALF + m * 16) * ldc + col0;
#pragma unroll
                for (int bj = 0; bj < 2; ++bj) { f32x4 v0 = acc[ai][bj][m][0] + bv[bj][0], v1 = acc[ai][bj][m][1] + bv[bj][1];
                    if (ACT == 1) { f32x2 a = gelu_pk((f32x2){v0[0], v0[1]}), b = gelu_pk((f32x2){v0[2], v0[3]}), c = gelu_pk((f32x2){v1[0], v1[1]}), d = gelu_pk((f32x2){v1[2], v1[3]});
                        v0 = (f32x4){a.x, a.y, b.x, b.y}; v1 = (f32x4){c.x, c.y, d.x, d.y}; }
                    if (ACT == 2) {
#pragma unroll
                        for (int j = 0; j < 4; ++j) { v0[j] = 0.5f * v0[j] * (1.0f + erff(v0[j] * 0.70710678f)); v1[j] = 0.5f * v1[j] * (1.0f + erff(v1[j] * 0.70710678f)); } }
                    u32x4 w; w.x = cvt_pk_bf16(v0[0], v0[1]); w.y = cvt_pk_bf16(v0[2], v0[3]); w.z = cvt_pk_bf16(v1[0], v1[1]); w.w = cvt_pk_bf16(v1[2], v1[3]);
                    *(u32x4*)(rowp + bj * HALF) = w; } }
    }
};

template <class Epi, class Sched, bool STAMP = false>
__device__ __forceinline__ void gemm_phase(int wv, PG8_LAS unsigned char* lds, const Gemm g, const Sched& S, const Epi& E, unsigned long long* stamps) {
    const int tid = otid(wv), wid = __builtin_amdgcn_readfirstlane(tid >> 6), lane = tid & 63, wr = wid >> 2, wc = wid & 3, fr = lane & 15, fq = lane >> 4;
    const int K = g.K, nt = K / BK;
    int ts_lo = 0, ts_hi = 0, nts = 0; const unsigned long long rt_entry = STAMP ? (unsigned long long)wall_clock64() : 0ull;
#define PG8_STAMP() do { if (STAMP && wid == 0 && nts < 64) { const unsigned long long _c = (unsigned long long)clock64(); \
        ts_lo = (lane == nts) ? (int)(unsigned)_c : ts_lo; ts_hi = (lane == nts) ? (int)(unsigned)(_c >> 32) : ts_hi; ++nts; } } while (0)
    PG8_STAMP();
    unsigned voffA[2], voffB[2];
#pragma unroll
    for (int i = 0; i < 2; ++i) { int R, C; stage_rc(tid * 16 + i * 8192, R, C); const int Rb = Epi::PERM ? ((R & ~31) + perm32(R & 31)) : R;
        voffA[i] = (unsigned)(R * K + C) * 2u; voffB[i] = (unsigned)(Rb * K + C) * 2u; }
    const size_t kstep = (size_t)(BK * 2);
    const size_t hstep = (size_t)HALF * K * 2;
    const size_t tstep = 2 * hstep;
    const unsigned ldsw = (unsigned)wid * 1024u;
    const int aoff = lds_byte(wr * 64 + fr, fq * 8), boff = lds_byte(wc * 32 + fr, fq * 8);
#define PG8_SA(b, h) (((b) * 2 + (h)) * HTB)
#define PG8_SB(b, h) ((4 + (b) * 2 + (h)) * HTB)
#define PG8_STAGE(bufoff, gbase, voff) do { _Pragma("unroll") for (int _i = 0; _i < 2; ++_i) \
        __builtin_amdgcn_global_load_lds((const unsigned*)((const char*)(gbase) + (voff)[_i]), (PG8_LAS unsigned*)(lds + (bufoff) + ldsw + _i * 8192), 16, 0, 0); } while (0)
#define PG8_LDA(dst, b, h) do { _Pragma("unroll") for (int m = 0; m < 4; ++m) _Pragma("unroll") for (int k = 0; k < 2; ++k) dst[m][k] = *(const PG8_LAS bf16x8*)(lds + PG8_SA(b, h) + aoff + m * 2048 + k * 1024); } while (0)
#define PG8_LDB(dst, b, h) do { _Pragma("unroll") for (int n = 0; n < 2; ++n) _Pragma("unroll") for (int k = 0; k < 2; ++k) dst[n][k] = *(const PG8_LAS bf16x8*)(lds + PG8_SB(b, h) + boff + n * 2048 + k * 1024); } while (0)
#define PG8_MMA(ai, bj, At, Bt) do { __builtin_amdgcn_s_setprio(1); _Pragma("unroll") for (int m = 0; m < 4; ++m) _Pragma("unroll") for (int n = 0; n < 2; ++n) _Pragma("unroll") for (int k = 0; k < 2; ++k) \
        acc[ai][bj][m][n] = __builtin_amdgcn_mfma_f32_16x16x32_bf16(Bt[n][k], At[m][k], acc[ai][bj][m][n], 0, 0, 0); __builtin_amdgcn_s_setprio(0); } while (0)
#define PG8_WAIT_V(n) asm volatile("s_waitcnt vmcnt(" #n ")" ::: "memory")
#define PG8_WAIT_L(n) asm volatile("s_waitcnt lgkmcnt(" #n ")" ::: "memory")
#define PG8_BAR __builtin_amdgcn_s_barrier()
#define PG8_SCHED __builtin_amdgcn_sched_barrier(0)
    Unit cur, nxt; int ui = 0;
    if (!S.next(0, cur)) return;
    f32x4 acc[2][2][4][2];
#pragma unroll
    for (int a = 0; a < 2; ++a)
#pragma unroll
        for (int b = 0; b < 2; ++b)
#pragma unroll
            for (int m = 0; m < 4; ++m)
#pragma unroll
                for (int n = 0; n < 2; ++n) acc[a][b][m][n] = (f32x4){0.f, 0.f, 0.f, 0.f};
    bf16x8 At[4][2], B0[2][2], B1[2][2];
    const char* cA = (const char*)g.A + (size_t)cur.pm * tstep; const char* cB = (const char*)g.Bt + (size_t)cur.pn * tstep;
    S.a_ready(cur);
    PG8_STAGE(PG8_SB(0, 0), cB, voffB); PG8_STAGE(PG8_SA(0, 0), cA, voffA); PG8_STAGE(PG8_SB(0, 1), cB + hstep, voffB); PG8_STAGE(PG8_SA(0, 1), cA + hstep, voffA);
    if (wr == 1) PG8_BAR;
    PG8_WAIT_V(4); PG8_BAR;
    PG8_STAGE(PG8_SB(1, 0), cB + kstep, voffB); PG8_STAGE(PG8_SA(1, 0), cA + kstep, voffA); PG8_STAGE(PG8_SB(1, 1), cB + hstep + kstep, voffB);
    PG8_WAIT_V(6); PG8_BAR;
    PG8_STAMP();
    for (;;) {
        const bool has_next = S.next(ui + 1, nxt);
        const char* nA = has_next ? (const char*)g.A + (size_t)nxt.pm * tstep : cA; const char* nB = has_next ? (const char*)g.Bt + (size_t)nxt.pn * tstep : cB;
        for (int t = 0; t < nt; t += 2) {
            const bool last = (t == nt - 2);
            const char* a1 = cA + (size_t)(t + 1) * kstep;
            const char* a2 = last ? nA : cA + (size_t)(t + 2) * kstep; const char* b2 = last ? nB : cB + (size_t)(t + 2) * kstep;
            const char* a3 = a2 + kstep; const char* b3 = b2 + kstep;
            if (last && has_next) S.a_ready(nxt);
            PG8_LDB(B0, 0, 0); PG8_SCHED; PG8_LDA(At, 0, 0); PG8_STAGE(PG8_SA(1, 1), a1 + hstep, voffA);
            PG8_WAIT_L(8); PG8_BAR; PG8_WAIT_L(0); PG8_MMA(0, 0, At, B0); PG8_BAR; PG8_SCHED;
            PG8_LDB(B1, 0, 1); PG8_STAGE(PG8_SB(0, 0), b2, voffB);
            PG8_BAR; PG8_WAIT_L(0); PG8_MMA(0, 1, At, B1); PG8_BAR;
            PG8_LDA(At, 0, 1); PG8_STAGE(PG8_SA(0, 0), a2, voffA);
            PG8_BAR; PG8_WAIT_L(0); PG8_MMA(1, 0, At, B0); PG8_BAR; PG8_SCHED;
            PG8_STAGE(PG8_SB(0, 1), b2 + hstep, voffB);
            PG8_WAIT_V(6); PG8_BAR; PG8_MMA(1, 1, At, B1); PG8_BAR;
            PG8_LDB(B0, 1, 0); PG8_SCHED; PG8_LDA(At, 1, 0); PG8_STAGE(PG8_SA(0, 1), a2 + hstep, voffA);
            PG8_WAIT_L(8); PG8_BAR; PG8_WAIT_L(0); PG8_MMA(0, 0, At, B0); PG8_BAR; PG8_SCHED;
            PG8_LDB(B1, 1, 1); PG8_STAGE(PG8_SB(1, 0), b3, voffB);
            PG8_BAR; PG8_WAIT_L(0); PG8_MMA(0, 1, At, B1); PG8_BAR;
            PG8_LDA(At, 1, 1); PG8_STAGE(PG8_SA(1, 0), a3, voffA);
            PG8_BAR; PG8_WAIT_L(0); PG8_MMA(1, 0, At, B0); PG8_BAR; PG8_SCHED;
            PG8_STAGE(PG8_SB(1, 1), b3 + hstep, voffB);
            PG8_WAIT_V(6); PG8_BAR; PG8_MMA(1, 1, At, B1); PG8_BAR;
        }
        PG8_STAMP();
        if constexpr (!Epi::AFTER_DRAIN) { E(acc, cur, wr, wc, fr, fq); S.done(cur); }
        PG8_STAMP();
        if (!has_next) break;
#pragma unroll
        for (int a = 0; a < 2; ++a)
#pragma unroll
            for (int b = 0; b < 2; ++b)
#pragma unroll
                for (int m = 0; m < 4; ++m)
#pragma unroll
                    for (int n = 0; n < 2; ++n) acc[a][b][m][n] = (f32x4){0.f, 0.f, 0.f, 0.f};
        cur = nxt; cA = nA; cB = nB; ++ui;
    }
    PG8_WAIT_V(0);
    if (wr == 0) PG8_BAR;
    PG8_BAR;
    if constexpr (Epi::AFTER_DRAIN) { E.fused(acc, cur, wr, wc, fr, fq, lds, wid, lane); S.done(cur); }
    PG8_STAMP();
    if (STAMP && wid == 0) { stamps[lane] = lane < nts ? (((unsigned long long)(unsigned)ts_hi << 32) | (unsigned)ts_lo) : 0ull;
        if (lane == 62) stamps[62] = rt_entry; if (lane == 63) stamps[63] = (unsigned long long)wall_clock64(); }
#undef PG8_STAMP
#undef PG8_SA
#undef PG8_SB
#undef PG8_STAGE
#undef PG8_LDA
#undef PG8_LDB
#undef PG8_MMA
#undef PG8_WAIT_V
#undef PG8_WAIT_L
#undef PG8_BAR
#undef PG8_SCHED
}
}

#define XB_TMO      128
#define XB_XCNT(j)  (256  + 64 * (j))
#define XB_XSUB(j)  (1280 + 64 * (j))
#define XB_XGEN(j)  (2304 + 64 * (j))
#define XB_TOP      3328
#define XB_TOPGEN   3392
#define XCD_BAR_WORDS 3456
#define XB_SPIN_CAP (1u << 27)
#define LAS __attribute__((address_space(3)))

__device__ __forceinline__ unsigned xb_ld(unsigned* p)              { return __hip_atomic_load(p, __ATOMIC_RELAXED, __HIP_MEMORY_SCOPE_AGENT); }
__device__ __forceinline__ unsigned xb_add(unsigned* p, unsigned v) { return __hip_atomic_fetch_add(p, v, __ATOMIC_RELAXED, __HIP_MEMORY_SCOPE_AGENT); }
__device__ __forceinline__ unsigned xb_xcc_id() { return (unsigned)__builtin_amdgcn_s_getreg((3 << 11) | 20) & 0xFu; }
#define XB_SPIN(cond, bar) do { unsigned _sp = 0; while (cond) { __builtin_amdgcn_s_sleep(1); \
    if ((++_sp & 255u) == 0u) { if (xb_ld(&(bar)[XB_TMO])) break; if (_sp > XB_SPIN_CAP) { atomicAdd(&(bar)[XB_TMO], 1u); break; } } } } while (0)

struct XcdBarrier {
    unsigned* bar; unsigned x;
    volatile LAS unsigned* st;
};

__device__ __forceinline__ XcdBarrier xcd_barrier_post(unsigned* bar, volatile LAS unsigned* st, bool xb_t0) {
    XcdBarrier b; b.bar = bar; b.x = xb_xcc_id(); b.st = st;
    if (xb_t0) (void)xb_add(&bar[XB_XCNT(b.x)], 1u);
    return b;
}
__device__ __forceinline__ void xcd_barrier_complete(unsigned* bar, unsigned x, unsigned& nloc, unsigned& nx) {
    const unsigned G = gridDim.x * gridDim.y * gridDim.z;
    unsigned sum, cnt, mine, sp = 0u;
    for (;;) {
        sum = 0u; cnt = 0u; mine = 0u;
#pragma unroll
        for (unsigned j = 0; j < 16; ++j) { const unsigned c = xb_ld(&bar[XB_XCNT(j)]); sum += c; cnt += (c > 0u) ? 1u : 0u; mine = (j == x) ? c : mine; }
        if (sum == G) break;
        __builtin_amdgcn_s_sleep(1);
        if ((++sp & 255u) == 0u) { if (xb_ld(&bar[XB_TMO])) break; if (sp > XB_SPIN_CAP) { atomicAdd(&bar[XB_TMO], 1u); break; } }
    }
    nloc = mine > 0u ? mine : 1u; nx = cnt > 0u ? cnt : 1u;
}

__device__ __forceinline__ void xcd_barrier(const XcdBarrier& b, bool xb_t0) {
    asm volatile("s_waitcnt vmcnt(0)" ::: "memory");
    __syncthreads();
    if (xb_t0) {
        unsigned* bar = b.bar;
        __builtin_amdgcn_s_waitcnt(0);
        unsigned nloc = b.st[0], nx = b.st[1];
        if (nloc == 0u) { xcd_barrier_complete(bar, b.x, nloc, nx); b.st[0] = nloc; b.st[1] = nx; }
        const unsigned old = xb_add(&bar[XB_XSUB(b.x)], 1u);
        const unsigned gen = old / nloc;
        if (old + 1u == (gen + 1u) * nloc) {
            __builtin_amdgcn_fence(__ATOMIC_RELEASE, "agent");
            asm volatile("s_waitcnt vmcnt(0)" ::: "memory");
            const unsigned og = xb_add(&bar[XB_TOP], 1u);
            const unsigned tg = og / nx;
            if (og + 1u == (tg + 1u) * nx) xb_add(&bar[XB_TOPGEN], 1u);
            else XB_SPIN(xb_ld(&bar[XB_TOPGEN]) == tg, bar);
            __builtin_amdgcn_fence(__ATOMIC_ACQUIRE, "agent");
            xb_add(&bar[XB_XGEN(b.x)], 1u);
            asm volatile("s_waitcnt vmcnt(0)" ::: "memory");
        } else {
            XB_SPIN(xb_ld(&bar[XB_XGEN(b.x)]) == gen, bar);
            __builtin_amdgcn_fence(__ATOMIC_ACQUIRE, "agent");
            asm volatile("s_waitcnt vmcnt(0)" ::: "memory");
        }
    }
    __syncthreads();
}


__device__ void ph_transpose(int wv, const float* __restrict__ src, bf16_t* __restrict__ dst, int K, int N, int Npad,
                             int col0, int skip_from, int skip, int nvalid, float* tile, int bid, int nb) {
  const int tk = K / 32, tn = Npad / 32;
  const int t5 = otid(wv) & 255;
  const int tx = t5 & 31, ty = t5 >> 5;
  for (int t = bid; t < tk * tn; t += nb) {
    const int kt = t / tn, nt = t % tn;
    __syncthreads();
    for (int i = ty; i < 32; i += 8) {
      const int k = kt * 32 + i, n = nt * 32 + tx;
      const int cc = col0 + n + (n >= skip_from ? skip : 0);
      tile[i * 33 + tx] = (n < nvalid) ? src[(size_t)k * N + cc] : 0.f;
    }
    __syncthreads();
    for (int i = ty; i < 32; i += 8) {
      const int n = nt * 32 + i, k = kt * 32 + tx;
      dst[(size_t)n * K + k] = f2bf(tile[tx * 33 + i]);
    }
  }
}

__device__ void ph_mod(int wv, const Params& P, float* sm, int bid, int nb) {
  const int tid = otid(wv) & 255;
  float* sv = sm;
  float* red = sm + 5 * 1024;
  for (int i = tid; i < 5 * 1024; i += 256) {
    const float v = (i < 4096) ? P.c[i] : P.c_ctx[i - 4096];
    sv[i] = silu_f(v);
  }
  __syncthreads();
  const int col = tid & 31, kg = tid >> 5;
  for (int it = bid; it < 384; it += nb) {
    const int layer = it / 192, cb = it % 192;
    const float* W = P.ada_w + (size_t)layer * 1024 * MODW + cb * 32 + col;
    float a0 = 0, a1 = 0, a2 = 0, a3 = 0, a4 = 0;
    for (int k = kg * 128; k < kg * 128 + 128; ++k) {
      const float w = W[(size_t)k * MODW];
      a0 += sv[k] * w; a1 += sv[1024 + k] * w; a2 += sv[2048 + k] * w; a3 += sv[3072 + k] * w; a4 += sv[4096 + k] * w;
    }
    float* r = red + (kg * 32 + col) * 5;
    r[0] = a0; r[1] = a1; r[2] = a2; r[3] = a3; r[4] = a4;
    __syncthreads();
    if (tid < 160) {
      const int rr = tid >> 5, cc = tid & 31;
      float s = 0;
      for (int g = 0; g < 8; ++g) s += red[(g * 32 + cc) * 5 + rr];
      P.mod()[(size_t)(layer * 5 + rr) * MODW + cb * 32 + cc] = s + P.ada_b[layer * MODW + cb * 32 + cc];
    }
    __syncthreads();
  }
}

__device__ void ph_norm(int wv, const float* hl, const float* hc, const float* __restrict__ g, const float* __restrict__ modl,
                        int shift_off, int scale_off, int nrows, bf16_t* __restrict__ dst, int bid, int nb) {
  const int wave = otid(wv) >> 6, lane = otid(wv) & 63;
  for (int row = bid * NWAVE + wave; row < nrows; row += nb * NWAVE) {
    const float* src = hrow(hl, hc, row);
    const float* mr = modl + (size_t)modrow(row) * MODW;
    float4 v[4];
    float ss = 0.f;
#pragma unroll
    for (int i = 0; i < 4; ++i) {
      v[i] = ((const float4*)src)[i * 64 + lane];
      ss += v[i].x * v[i].x + v[i].y * v[i].y + v[i].z * v[i].z + v[i].w * v[i].w;
    }
    ss = wave_sum(ss);
    const float rstd = rsqrtf(ss * (1.f / 1024.f) + 1e-6f);
#pragma unroll
    for (int i = 0; i < 4; ++i) {
      const int idx = i * 256 + lane * 4;
      const float4 gg = *(const float4*)(g + idx);
      const float4 sc = *(const float4*)(mr + scale_off + idx);
      const float4 sh = *(const float4*)(mr + shift_off + idx);
      const float o0 = v[i].x * rstd * gg.x * (1.f + sc.x) + sh.x;
      const float o1 = v[i].y * rstd * gg.y * (1.f + sc.y) + sh.y;
      const float o2 = v[i].z * rstd * gg.z * (1.f + sc.z) + sh.z;
      const float o3 = v[i].w * rstd * gg.w * (1.f + sc.w) + sh.w;
      uint2 pk;
      pk.x = (uint32_t)f2bf(o0) | ((uint32_t)f2bf(o1) << 16);
      pk.y = (uint32_t)f2bf(o2) | ((uint32_t)f2bf(o3) << 16);
      *(uint2*)(dst + (size_t)row * DM + idx) = pk;
    }
  }
}

enum { EPI_INPROJ = 0, EPI_OUTPROJ = 1, EPI_Q = 2 };

template <int EPI>
__device__ void ph_gemm(int wv, const Params& P, int layer, const bf16_t* __restrict__ A, const bf16_t* __restrict__ Bt, int M,
                        int Npad, int K, const float* hl, const float* hc, char* smem, int bid, int nb) {
  bf16_t* sA = (bf16_t*)smem;
  bf16_t* sB = sA + 128 * 72;
  const int tid = otid(wv) & 255, lane = tid & 63, wave = tid >> 6;
  const int wr = wave >> 1, wc = wave & 1;
  const int tiles_m = M / 128, tiles_n = Npad / 128;
  const int l15 = lane & 15, l4 = lane >> 4;
  for (int tile = bid; tile < tiles_m * tiles_n; tile += nb) {
    const int tn = tile / tiles_m, tm = tile % tiles_m;
    f32x4 acc[4][4];
#pragma unroll
    for (int i = 0; i < 4; ++i)
#pragma unroll
      for (int j = 0; j < 4; ++j) acc[i][j] = (f32x4){0.f, 0.f, 0.f, 0.f};
    for (int k0 = 0; k0 < K; k0 += 64) {
      __syncthreads();
#pragma unroll
      for (int i = 0; i < 4; ++i) {
        const int idx = i * 256 + tid;
        const int r = idx >> 3, sg = idx & 7;
        const uint4 va = *(const uint4*)(A + (size_t)(tm * 128 + r) * K + k0 + sg * 8);
        *(uint4*)(sA + r * 72 + sg * 8) = va;
        const uint4 vb = *(const uint4*)(Bt + (size_t)(tn * 128 + r) * K + k0 + sg * 8);
        *(uint4*)(sB + r * 72 + sg * 8) = vb;
      }
      __syncthreads();
#pragma unroll
      for (int kk = 0; kk < 2; ++kk) {
        bf16x8 af[4], bfr[4];
#pragma unroll
        for (int i = 0; i < 4; ++i) af[i] = *(const bf16x8*)(sA + (wr * 64 + i * 16 + l15) * 72 + kk * 32 + l4 * 8);
#pragma unroll
        for (int j = 0; j < 4; ++j) bfr[j] = *(const bf16x8*)(sB + (wc * 64 + j * 16 + l15) * 72 + kk * 32 + l4 * 8);
#pragma unroll
        for (int i = 0; i < 4; ++i)
#pragma unroll
          for (int j = 0; j < 4; ++j) acc[i][j] = __builtin_amdgcn_mfma_f32_16x16x32_bf16(af[i], bfr[j], acc[i][j], 0, 0, 0);
      }
    }
#pragma unroll
    for (int i = 0; i < 4; ++i)
#pragma unroll
      for (int j = 0; j < 4; ++j)
#pragma unroll
        for (int e = 0; e < 4; ++e) {
          const int row = tm * 128 + wr * 64 + i * 16 + l4 * 4 + e;
          const int col = tn * 128 + wc * 64 + j * 16 + l15;
          const float v = acc[i][j][e];
          if (EPI == EPI_INPROJ) {
            if (col < 32) P.dtraw()[(size_t)row * 32 + col] = v;
          } else if (EPI == EPI_OUTPROJ) {
            const float* src = hrow(hl, hc, row);
            const float gate = P.mod()[(size_t)(layer * 5 + modrow(row)) * MODW + 2048 + col];
            P.h()[(size_t)row * DM + col] = src[col] + gate * v;
          } else {
            P.q()[(size_t)row * 2048 + col] = f2bf(v);
          }
        }
  }
}

__device__ void ph_conv(int wv, const Params& P, int layer, int bid, int nb) {
  const float* cw = P.conv_w + (size_t)layer * 3 * 1536;
  const float* cb = P.conv_b + (size_t)layer * 1536;
  const int total = NTOK * 64;
  for (int it = bid * NTHR + otid(wv); it < total; it += nb * NTHR) {
    const int row = it >> 6, c8 = 1024 + (it & 63) * 8;
    int l, L;
    if (row < NLAT) { l = row & 4095; L = 4096; } else { l = (row - NLAT) & 255; L = 256; }
    const bf16_t* pc = P.p() + (size_t)row * PW + OFF_XBC + c8;
    uint4 cur = *(const uint4*)pc;
    uint4 prv = make_uint4(0, 0, 0, 0), nxt = make_uint4(0, 0, 0, 0);
    if (l > 0) prv = *(const uint4*)(pc - PW);
    if (l < L - 1) nxt = *(const uint4*)(pc + PW);
    const bf16_t* c_ = (const bf16_t*)&cur;
    const bf16_t* p_ = (const bf16_t*)&prv;
    const bf16_t* n_ = (const bf16_t*)&nxt;
    uint4 o;
    bf16_t* o_ = (bf16_t*)&o;
#pragma unroll
    for (int e = 0; e < 8; ++e) {
      const int c = c8 + e;
      const float v = cb[c] + cw[c] * bf2f(p_[e]) + cw[1536 + c] * bf2f(c_[e]) + cw[3072 + c] * bf2f(n_[e]);
      o_[e] = f2bf(silu_f(v));
    }
    *(uint4*)(P.xbc() + (size_t)row * 512 + c8 - 1024) = o;
  }
}

__device__ void ph_ssdprep(int wv, const Params& P, int layer, int bid, int nb) {
  for (int it = bid * NTHR + otid(wv); it < NCHUNK * 32; it += nb * NTHR) {
    const int gc = it >> 5, dh = it & 31;
    const float bias = P.dt_bias[layer * 32 + dh];
    const float ah = -expf(P.a_log[layer * 32 + dh]);
    float cs = 0.f;
    for (int j = 0; j < 128; ++j) {
      const size_t o = (size_t)(gc * 128 + j) * 32 + dh;
      const float dt = softplus_f(P.dtraw()[o] + bias);
      cs += dt * ah;
      P.dtv()[o] = dt;
      P.csv()[o] = cs;
    }
  }
}

__device__ void ph_states(int wv, const Params& P, char* smem, int bid, int nb) {
  float* wx = (float*)smem;
  bf16_t* Bm = (bf16_t*)(smem + 128 * 64 * 4);
  const int tid = otid(wv);
  const int n = tid & 127, pg = (tid >> 7) & 1;
  for (int it = bid; it < NCHUNK * 32; it += nb) {
    const int gc = it >> 5, dh = it & 31, dir = dh >> 4, head = dh & 15, g = head >> 3;
    const int row0 = gc * 128;
    __syncthreads();
    const float at = P.csv()[(size_t)(row0 + 127) * 32 + dh];
    for (int i = tid; i < 128 * 64; i += NTHR) {
      const int j = i >> 6, pp = i & 63, row = row0 + j;
      const float cs = P.csv()[(size_t)row * 32 + dh], dt = P.dtv()[(size_t)row * 32 + dh];
      float w;
      if (dir == 0) w = expf(at - cs);
      else w = expf(j > 0 ? P.csv()[(size_t)(row - 1) * 32 + dh] : 0.f);
      wx[i] = bf2f(P.xbc()[(size_t)row * 1536 + head * 64 + pp]) * dt * w;
    }
    for (int i = tid; i < 128 * 128; i += NTHR) {
      const int j = i >> 7, nn = i & 127;
      Bm[i] = P.xbc()[(size_t)(row0 + j) * 1536 + 1024 + g * 128 + nn];
    }
    __syncthreads();
    float acc[32];
#pragma unroll
    for (int i = 0; i < 32; ++i) acc[i] = 0.f;
    for (int j = 0; j < 128; ++j) {
      const float b = bf2f(Bm[j * 128 + n]);
#pragma unroll
      for (int i = 0; i < 32; ++i) acc[i] += wx[j * 64 + pg * 32 + i] * b;
    }
    bf16_t* dst = P.states() + (size_t)it * 8192;
#pragma unroll
    for (int i = 0; i < 32; ++i) dst[(pg * 32 + i) * 128 + n] = f2bf(acc[i]);
  }
}

__device__ void ph_scan(int wv, const Params& P, int bid, int nb) {
  const int total = 4 * 32 * 8192;
  for (int it = bid * NTHR + otid(wv); it < total; it += nb * NTHR) {
    const int e = it & 8191, dh = (it >> 13) & 31, b = it >> 18, dir = dh >> 4;
    float S = 0.f;
    for (int s = 0; s < 34; ++s) {
      int gc;
      if (dir == 0) gc = (s < 2) ? (128 + 2 * b + s) : (32 * b + (s - 2));
      else gc = (s < 2) ? (128 + 2 * b + 1 - s) : (32 * b + 31 - (s - 2));
      bf16_t* ptr = P.states() + (size_t)(gc * 32 + dh) * 8192 + e;
      const float cstate = bf2f(*ptr);
      *ptr = f2bf(S);
      const float at = P.csv()[(size_t)(gc * 128 + 127) * 32 + dh];
      S = expf(at) * S + cstate;
    }
  }
}

__device__ void ph_ssdy(int wv, const Params& P, int layer, int nchunks, char* smem, int bid, int nb) {
  bf16_t* Cm = (bf16_t*)smem;
  bf16_t* Gm = Cm + 128 * 130;
  char* R = (char*)(Gm + 128 * 130);
  bf16_t* Bm = (bf16_t*)R;
  float* xd = (float*)R;
  bf16_t* Sm = (bf16_t*)(R + 128 * 130 * 2);
  float* csl = (float*)(Sm + 64 * 130);
  float* exl = csl + 128;
  const int tid = otid(wv);
  for (int it = bid; it < nchunks * 16; it += nb) {
    const int gc = it >> 4, head = it & 15, g = head >> 3;
    const int row0 = gc * 128;
    __syncthreads();
    for (int i = tid; i < 128 * 128; i += NTHR) {
      const int j = i >> 7, nn = i & 127;
      const bf16_t* xr = P.xbc() + (size_t)(row0 + j) * 1536 + 1024 + g * 128 + nn;
      Bm[j * 130 + nn] = xr[0];
      Cm[j * 130 + nn] = xr[256];
    }
    __syncthreads();
    {
      const int s = tid & 127, jh = (tid >> 7) & 1;
      for (int jb = 0; jb < 2; ++jb) {
        float acc[32];
#pragma unroll
        for (int i = 0; i < 32; ++i) acc[i] = 0.f;
        for (int nn = 0; nn < 128; ++nn) {
          const float b = bf2f(Bm[s * 130 + nn]);
#pragma unroll
          for (int i = 0; i < 32; ++i) acc[i] += bf2f(Cm[(jh * 64 + jb * 32 + i) * 130 + nn]) * b;
        }
#pragma unroll
        for (int i = 0; i < 32; ++i) Gm[(jh * 64 + jb * 32 + i) * 130 + s] = f2bf(acc[i]);
      }
    }
    const int pp = tid & 63, jg0 = (tid >> 6) & 3;
#pragma unroll 1
    for (int jpass = 0; jpass < 2; ++jpass) {
    const int jg = jg0 * 2 + jpass;
    float yacc[16];
#pragma unroll
    for (int i = 0; i < 16; ++i) yacc[i] = 0.f;
#pragma unroll 1
    for (int dir = 0; dir < 2; ++dir) {
      const int dh = dir * 16 + head;
      __syncthreads();
      for (int i = tid; i < 128 * 64; i += NTHR) {
        const int j = i >> 6, p2 = i & 63, row = row0 + j;
        xd[i] = bf2f(P.xbc()[(size_t)row * 1536 + head * 64 + p2]) * P.dtv()[(size_t)row * 32 + dh];
      }
      const bf16_t* st = P.states() + (size_t)(gc * 32 + dh) * 8192;
      for (int i = tid; i < 64 * 128; i += NTHR) Sm[(i >> 7) * 130 + (i & 127)] = st[i];
      if (tid < 128) {
        const float cs = P.csv()[(size_t)(row0 + tid) * 32 + dh];
        csl[tid] = cs;
        exl[tid] = tid > 0 ? P.csv()[(size_t)(row0 + tid - 1) * 32 + dh] : 0.f;
      }
      __syncthreads();
      const float atot = csl[127];
      for (int s = 0; s < 128; ++s) {
        const float xv = xd[s * 64 + pp];
        const float cs_s = csl[s], ex_s = exl[s];
#pragma unroll
        for (int i = 0; i < 16; ++i) {
          const int j = jg * 16 + i;
          if (dir == 0) {
            if (s <= j) yacc[i] += bf2f(Gm[j * 130 + s]) * expf(csl[j] - cs_s) * xv;
          } else {
            if (s >= j) yacc[i] += bf2f(Gm[j * 130 + s]) * expf(ex_s - exl[j]) * xv;
          }
        }
      }
      float offacc[16];
#pragma unroll
      for (int i = 0; i < 16; ++i) offacc[i] = 0.f;
      for (int nn = 0; nn < 128; ++nn) {
        const float sv = bf2f(Sm[pp * 130 + nn]);
#pragma unroll
        for (int i = 0; i < 16; ++i) offacc[i] += bf2f(Cm[(jg * 16 + i) * 130 + nn]) * sv;
      }
#pragma unroll
      for (int i = 0; i < 16; ++i) {
        const int j = jg * 16 + i;
        const float sc = dir == 0 ? expf(csl[j]) : expf(atot - exl[j]);
        yacc[i] += offacc[i] * sc;
      }
    }
    const float dsk = P.d_skip[layer * 16 + head];
#pragma unroll
    for (int i = 0; i < 16; ++i) {
      const int row = row0 + jg * 16 + i;
      const float xs = bf2f(P.xbc()[(size_t)row * 1536 + head * 64 + pp]);
      const float z = bf2f(P.p()[(size_t)row * PW + OFF_Z + head * 64 + pp]);
      const float y = (yacc[i] + dsk * xs) * silu_f(z);
      P.concat()[(size_t)row * 2048 + head * 64 + pp] = f2bf(y);
    }
    }
  }
}


__device__ __forceinline__ void conv_x8(const Params& P, int layer, int row, int ch0, float* out) {
  int l, L;
  if (row < NLAT) { l = row & 4095; L = 4096; } else { l = (row - NLAT) & 255; L = 256; }
  const bf16_t* pc = P.p() + (size_t)row * PW + OFF_XBC + ch0;
  const uint4 cur = *(const uint4*)pc;
  uint4 prv = make_uint4(0, 0, 0, 0), nxt = make_uint4(0, 0, 0, 0);
  if (l > 0) prv = *(const uint4*)(pc - PW);
  if (l < L - 1) nxt = *(const uint4*)(pc + PW);
  float fp[8], fc[8], fn[8];
  unpack8(prv, fp); unpack8(cur, fc); unpack8(nxt, fn);
  const float* cw = P.conv_w + (size_t)layer * 3 * 1536 + ch0;
  const float* cb = P.conv_b + (size_t)layer * 1536 + ch0;
#pragma unroll
  for (int e = 0; e < 8; ++e) out[e] = silu_f(cb[e] + cw[e] * fp[e] + cw[1536 + e] * fc[e] + cw[3072 + e] * fn[e]);
}

constexpr int XS = 72;
constexpr int BS = 136;

__device__ void ph_states_mfma(int wv, const Params& P, int layer, char* smem, int bid, int nb) {
  char* XW = smem;
  char* Bm = smem + 2 * 128 * XS * 2;
  const int tid = otid(wv), lane = tid & 63, li = lane & 15, g = lane >> 4;
  const int dir = wv >> 2, pb = wv & 3;
  for (int it = bid; it < NCHUNK * 16; it += nb) {
    const int gc = it >> 4, head = it & 15, grp = head >> 3;
    const int row0 = gc * 128;
    __syncthreads();
#pragma unroll
    for (int i = 0; i < 2; ++i) {
      const int idx = tid + i * 512, j = idx >> 3, seg = idx & 7, row = row0 + j;
      float xv[8];
      conv_x8(P, layer, row, head * 64 + seg * 8, xv);
      const float* cs = P.csv() + (size_t)row * 32;
      const float* dt = P.dtv() + (size_t)row * 32;
      const float at_f = P.csv()[(size_t)(row0 + 127) * 32 + head];
      const float wf = expf(at_f - cs[head]) * dt[head];
      const float wb = expf(j > 0 ? cs[16 + head - 32] : 0.f) * dt[16 + head];
      uint4 of, ob;
      of.x = pack2(xv[0] * wf, xv[1] * wf); of.y = pack2(xv[2] * wf, xv[3] * wf); of.z = pack2(xv[4] * wf, xv[5] * wf); of.w = pack2(xv[6] * wf, xv[7] * wf);
      ob.x = pack2(xv[0] * wb, xv[1] * wb); ob.y = pack2(xv[2] * wb, xv[3] * wb); ob.z = pack2(xv[4] * wb, xv[5] * wb); ob.w = pack2(xv[6] * wb, xv[7] * wb);
      *(uint4*)(XW + (j * XS + seg * 8) * 2) = of;
      *(uint4*)(XW + ((128 + j) * XS + seg * 8) * 2) = ob;
    }
#pragma unroll
    for (int i = 0; i < 4; ++i) {
      const int idx = tid + i * 512, j = idx >> 4, seg = idx & 15;
      *(uint4*)(Bm + (j * BS + seg * 8) * 2) = *(const uint4*)(P.xbc() + (size_t)(row0 + j) * 512 + grp * 128 + seg * 8);
    }
    __syncthreads();
    f32x4 acc[8];
#pragma unroll
    for (int n = 0; n < 8; ++n) acc[n] = (f32x4){0.f, 0.f, 0.f, 0.f};
    const char* xbase = XW + ((dir * 128 + (li >> 2)) * XS + pb * 16 + 4 * (li & 3)) * 2;
    const char* bbase = Bm + ((li >> 2) * BS + 4 * (li & 3)) * 2;
#pragma unroll
    for (int t = 0; t < 4; ++t) {
      const int R = 32 * t + 8 * g;
      const bf16x8 bfrag = tr_read2(xbase + R * XS * 2, xbase + (R + 4) * XS * 2);
#pragma unroll
      for (int n = 0; n < 8; ++n) {
        const bf16x8 afrag = tr_read2(bbase + (R * BS + n * 16) * 2, bbase + ((R + 4) * BS + n * 16) * 2);
        acc[n] = __builtin_amdgcn_mfma_f32_16x16x32_bf16(afrag, bfrag, acc[n], 0, 0, 0);
      }
    }
    bf16_t* dst = P.states() + (size_t)(gc * 32 + dir * 16 + head) * 8192 + (pb * 16 + li) * 128;
#pragma unroll
    for (int n = 0; n < 8; ++n) {
      uint2 o;
      o.x = pack2(acc[n][0], acc[n][1]); o.y = pack2(acc[n][2], acc[n][3]);
      *(uint2*)(dst + n * 16 + 4 * g) = o;
    }
  }
}

__device__ void ph_ssdy_mfma(int wv, const Params& P, int layer, int nchunks, char* smem, int bid, int nb) {
  char* Bm = smem;
  char* Cm = Bm + 128 * BS * 2;
  char* X0 = Cm + 128 * BS * 2;
  char* XD = X0 + 128 * XS * 2;
  float* csf = (float*)(XD + 2 * 128 * XS * 2);
  float* exb = csf + 128;
  const int tid = otid(wv), lane = tid & 63, li = lane & 15, g = lane >> 4;
  for (int it = bid; it < nchunks * 16; it += nb) {
    const int gc = it >> 4, head = it & 15, grp = head >> 3;
    const int row0 = gc * 128;
    __syncthreads();
#pragma unroll
    for (int i = 0; i < 2; ++i) {
      const int idx = tid + i * 512, j = idx >> 3, seg = idx & 7, row = row0 + j;
      float xv[8];
      conv_x8(P, layer, row, head * 64 + seg * 8, xv);
      const float df = P.dtv()[(size_t)row * 32 + head], db = P.dtv()[(size_t)row * 32 + 16 + head];
      uint4 o0, of, ob;
      o0.x = pack2(xv[0], xv[1]); o0.y = pack2(xv[2], xv[3]); o0.z = pack2(xv[4], xv[5]); o0.w = pack2(xv[6], xv[7]);
      of.x = pack2(xv[0] * df, xv[1] * df); of.y = pack2(xv[2] * df, xv[3] * df); of.z = pack2(xv[4] * df, xv[5] * df); of.w = pack2(xv[6] * df, xv[7] * df);
      ob.x = pack2(xv[0] * db, xv[1] * db); ob.y = pack2(xv[2] * db, xv[3] * db); ob.z = pack2(xv[4] * db, xv[5] * db); ob.w = pack2(xv[6] * db, xv[7] * db);
      *(uint4*)(X0 + (j * XS + seg * 8) * 2) = o0;
      *(uint4*)(XD + (j * XS + seg * 8) * 2) = of;
      *(uint4*)(XD + ((128 + j) * XS + seg * 8) * 2) = ob;
    }
#pragma unroll
    for (int i = 0; i < 4; ++i) {
      const int idx = tid + i * 512, j = idx >> 4, seg = idx & 15;
      const bf16_t* s = P.xbc() + (size_t)(row0 + j) * 512 + grp * 128 + seg * 8;
      *(uint4*)(Bm + (j * BS + seg * 8) * 2) = *(const uint4*)s;
      *(uint4*)(Cm + (j * BS + seg * 8) * 2) = *(const uint4*)(s + 256);
    }
    if (tid < 128) {
      csf[tid] = P.csv()[(size_t)(row0 + tid) * 32 + head];
      exb[tid] = tid > 0 ? P.csv()[(size_t)(row0 + tid - 1) * 32 + 16 + head] : 0.f;
    }
    __syncthreads();
    const float atb = P.csv()[(size_t)(row0 + 127) * 32 + 16 + head];
    f32x4 accG[8];
#pragma unroll
    for (int sb = 0; sb < 8; ++sb) accG[sb] = (f32x4){0.f, 0.f, 0.f, 0.f};
#pragma unroll
    for (int t = 0; t < 4; ++t) {
      const bf16x8 cfrag = *(const bf16x8*)(Cm + ((16 * wv + li) * BS + 32 * t + 8 * g) * 2);
#pragma unroll
      for (int sb = 0; sb < 8; ++sb) {
        const bf16x8 bfr = *(const bf16x8*)(Bm + ((16 * sb + li) * BS + 32 * t + 8 * g) * 2);
        accG[sb] = __builtin_amdgcn_mfma_f32_16x16x32_bf16(bfr, cfrag, accG[sb], 0, 0, 0);
      }
    }
    f32x4 accY[4];
#pragma unroll
    for (int pb = 0; pb < 4; ++pb) accY[pb] = (f32x4){0.f, 0.f, 0.f, 0.f};
    const int jl = 16 * wv + li;
    const float csf_j = csf[jl], exb_j = exb[jl];
#pragma unroll
    for (int dir = 0; dir < 2; ++dir) {
      f32x4 accO[4];
#pragma unroll
      for (int pb = 0; pb < 4; ++pb) accO[pb] = (f32x4){0.f, 0.f, 0.f, 0.f};
      const bf16_t* st = P.states() + (size_t)(gc * 32 + dir * 16 + head) * 8192;
#pragma unroll
      for (int t = 0; t < 4; ++t) {
        const bf16x8 cfrag = *(const bf16x8*)(Cm + ((16 * wv + li) * BS + 32 * t + 8 * g) * 2);
#pragma unroll
        for (int pb = 0; pb < 4; ++pb) {
          const bf16x8 sfr = *(const bf16x8*)(st + (16 * pb + li) * 128 + 32 * t + 8 * g);
          accO[pb] = __builtin_amdgcn_mfma_f32_16x16x32_bf16(cfrag, sfr, accO[pb], 0, 0, 0);
        }
      }
#pragma unroll
      for (int e = 0; e < 4; ++e) {
        const int j = 16 * wv + 4 * g + e;
        const float sc = dir == 0 ? expf(csf[j]) : expf(atb - exb[j]);
#pragma unroll
        for (int pb = 0; pb < 4; ++pb) accY[pb][e] += accO[pb][e] * sc;
      }
#pragma unroll
      for (int t = 0; t < 4; ++t) {
        const bool skip = dir == 0 ? (32 * t > 16 * wv + 15) : (32 * t + 31 < 16 * wv);
        if (skip) continue;
        bf16x8 afrag;
#pragma unroll
        for (int hh = 0; hh < 2; ++hh) {
          const int s0 = 32 * t + 16 * hh + 4 * g;
          const f32x4 gv = accG[2 * t + hh];
          const f32x4 cv = dir == 0 ? *(const f32x4*)(csf + s0) : *(const f32x4*)(exb + s0);
#pragma unroll
          for (int e = 0; e < 4; ++e) {
            const int s = s0 + e;
            float m;
            if (dir == 0) m = (s <= jl) ? gv[e] * expf(csf_j - cv[e]) : 0.f;
            else m = (s >= jl) ? gv[e] * expf(cv[e] - exb_j) : 0.f;
            afrag[hh * 4 + e] = (short)f2bf(m);
          }
        }
        const char* xb = XD + ((dir * 128 + 32 * t + 4 * g + (li >> 2)) * XS + 4 * (li & 3)) * 2;
#pragma unroll
        for (int pb = 0; pb < 4; ++pb) {
          const bf16x8 bfr = tr_read2(xb + pb * 32, xb + 16 * XS * 2 + pb * 32);
          accY[pb] = __builtin_amdgcn_mfma_f32_16x16x32_bf16(afrag, bfr, accY[pb], 0, 0, 0);
        }
      }
    }
    const float dsk = P.d_skip[layer * 16 + head];
#pragma unroll
    for (int e = 0; e < 4; ++e) {
      const int j = 16 * wv + 4 * g + e, row = row0 + j;
#pragma unroll
      for (int pb = 0; pb < 4; ++pb) {
        const int pp = 16 * pb + li;
        const float xs = bf2f(*(const bf16_t*)(X0 + (j * XS + pp) * 2));
        const float z = bf2f(P.p()[(size_t)row * PW + OFF_Z + head * 64 + pp]);
        P.concat()[(size_t)row * 2048 + head * 64 + pp] = f2bf((accY[pb][e] + dsk * xs) * silu_f(z));
      }
    }
  }
}

__device__ void ph_ssdnorm(int wv, const Params& P, int layer, int nrows, int bid, int nb) {
  const int wave = otid(wv) >> 6, lane = otid(wv) & 63;
  const float* g = P.ssd_norm_g + layer * 1024;
  for (int row = bid * NWAVE + wave; row < nrows; row += nb * NWAVE) {
    bf16_t* src = P.concat() + (size_t)row * 2048;
    float v[16];
    float ss = 0.f;
#pragma unroll
    for (int i = 0; i < 4; ++i) {
      const uint2 pk = *(const uint2*)(src + i * 256 + lane * 4);
      v[i * 4 + 0] = bf2f((bf16_t)(pk.x & 0xffff)); v[i * 4 + 1] = bf2f((bf16_t)(pk.x >> 16));
      v[i * 4 + 2] = bf2f((bf16_t)(pk.y & 0xffff)); v[i * 4 + 3] = bf2f((bf16_t)(pk.y >> 16));
    }
#pragma unroll
    for (int i = 0; i < 16; ++i) ss += v[i] * v[i];
    ss = wave_sum(ss);
    const float rstd = rsqrtf(ss * (1.f / 1024.f) + 1e-6f);
#pragma unroll
    for (int i = 0; i < 4; ++i) {
      const int idx = i * 256 + lane * 4;
      uint2 pk;
      pk.x = (uint32_t)f2bf(v[i * 4 + 0] * rstd * g[idx + 0]) | ((uint32_t)f2bf(v[i * 4 + 1] * rstd * g[idx + 1]) << 16);
      pk.y = (uint32_t)f2bf(v[i * 4 + 2] * rstd * g[idx + 2]) | ((uint32_t)f2bf(v[i * 4 + 3] * rstd * g[idx + 3]) << 16);
      *(uint2*)(src + idx) = pk;
    }
  }
}

__device__ void ph_pool(int wv, const Params& P, int layer, int nrows, char* smem, int bid, int nb) {
  float* pooled = (float*)smem;
  const int tid = otid(wv);
  const int ntile = nrows / 32;
  for (int it = bid; it < ntile * 4; it += nb) {
    const int tt = it >> 2, gi = it & 3;
    const int w = 2 << gi;
    const int row0 = tt * 32;
    __syncthreads();
    for (int i = tid; i < 32 * 128; i += NTHR) {
      const int t = i >> 7, ch = i & 127, row = row0 + t;
      int l, L, base;
      if (row < NLAT) { l = row & 4095; L = 4096; base = row - l; } else { l = (row - NLAT) & 255; L = 256; base = row - l; }
      int lo = l - w / 2; lo = lo < 0 ? 0 : lo;
      int hi = l + w - w / 2 - 1; hi = hi > L - 1 ? L - 1 : hi;
      float s = 0.f;
      for (int r = lo; r <= hi; ++r) s += bf2f(P.p()[(size_t)(base + r) * PW + OFF_POOL + gi * 128 + ch]);
      pooled[i] = s / (float)(hi - lo + 1) - bf2f(P.p()[(size_t)row * PW + OFF_POOL + gi * 128 + ch]);
    }
    __syncthreads();
    const int o = tid & 127, tg = (tid >> 7) & 1;
    const float* W = P.pool_w + ((size_t)(layer * 4 + gi) * 128) * 128 + o;
    float acc[16];
#pragma unroll
    for (int i = 0; i < 16; ++i) acc[i] = 0.f;
    for (int k = 0; k < 128; ++k) {
      const float wv = W[(size_t)k * 128];
#pragma unroll
      for (int i = 0; i < 16; ++i) acc[i] += pooled[(tg * 16 + i) * 128 + k] * wv;
    }
    const float sc = P.pool_scale[layer * 512 + gi * 128 + o];
#pragma unroll
    for (int i = 0; i < 16; ++i)
      P.concat()[(size_t)(row0 + tg * 16 + i) * 2048 + 1024 + gi * 128 + o] = f2bf(acc[i] * sc);
  }
}

__device__ void ph_na(int wv, const Params& P, int layer, int nrows, char* smem, int bid, int nb) {
  const int wave = otid(wv) >> 6, lane = otid(wv) & 63;
  float* qs = (float*)smem + wave * 448;
  float* ps = qs + 64;
  const float* rpb = P.na_rpb + (size_t)layer * 8 * 15 * 31;
  for (int it = bid * NWAVE + wave; it < nrows * 8; it += nb * NWAVE) {
    const int row = it >> 3, hd = it & 7;
    const bool lat = row < NLAT;
    int b, r = 0, cq = 0, r0 = 0, c0 = 0;
    if (lat) {
      b = row >> 12; const int l = row & 4095; r = l >> 6; cq = l & 63;
      r0 = r - 4; r0 = r0 < 0 ? 0 : (r0 > 56 ? 56 : r0);
      c0 = cq - 8; c0 = c0 < 0 ? 0 : (c0 > 48 ? 48 : c0);
    } else {
      b = (row - NLAT) >> 8;
    }
    qs[lane] = bf2f(P.p()[(size_t)row * PW + OFF_Q + hd * 64 + lane]) * 0.125f;
    __builtin_amdgcn_wave_barrier();
    const int nkeys = lat ? 384 : 256;
    float mx = -3.0e38f;
#pragma unroll 1
    for (int t = 0; t < 6; ++t) {
      const int n = t * 64 + lane;
      float s = -3.0e38f;
      if (n < nkeys) {
        int krow; float bias = 0.f;
        if (lat && n < 128) {
          const int kr = n >> 4, kc = n & 15;
          const int rk = r0 + kr, ck = c0 + kc;
          krow = b * 4096 + rk * 64 + ck;
          bias = rpb[(hd * 15 + (rk - r + 7)) * 31 + (ck - cq + 15)];
        } else {
          krow = NLAT + b * 256 + (lat ? n - 128 : n);
        }
        const bf16_t* kp = P.p() + (size_t)krow * PW + OFF_K + hd * 64;
        float d = 0.f;
#pragma unroll
        for (int v8 = 0; v8 < 8; ++v8) {
          const uint4 kk = *(const uint4*)(kp + v8 * 8);
          const bf16_t* ke = (const bf16_t*)&kk;
#pragma unroll
          for (int e = 0; e < 8; ++e) d += qs[v8 * 8 + e] * bf2f(ke[e]);
        }
        s = d + bias;
      }
      ps[t * 64 + lane] = s;
      mx = fmaxf(mx, s);
    }
    mx = wave_max(mx);
    float sum = 0.f;
#pragma unroll 1
    for (int t = 0; t < 6; ++t) {
      const int n = t * 64 + lane;
      const float e = (n < nkeys) ? expf(ps[n] - mx) : 0.f;
      sum += e;
      ps[n] = e;
    }
    sum = wave_sum(sum);
    __builtin_amdgcn_wave_barrier();
    float acc = 0.f;
    for (int n = 0; n < nkeys; ++n) {
      int krow;
      if (lat && n < 128) krow = b * 4096 + (r0 + (n >> 4)) * 64 + c0 + (n & 15);
      else krow = NLAT + b * 256 + (lat ? n - 128 : n);
      acc += ps[n] * bf2f(P.p()[(size_t)krow * PW + OFF_V + hd * 64 + lane]);
    }
    P.concat()[(size_t)row * 2048 + 1536 + hd * 64 + lane] = f2bf(acc / sum);
    __builtin_amdgcn_wave_barrier();
  }
}


__device__ void ph_vtranspose(int wv, const Params& P, char* smem, int bid, int nb) {
  const int lane = otid(wv) & 63;
  bf16_t* tile = (bf16_t*)smem + wv * 64 * 72;
  for (int it = bid * NWAVE + wv; it < 272 * 8; it += nb * NWAVE) {
    const int hd = it & 7, tt = it >> 3, row0 = tt * 64;
    const bf16_t* src = P.p() + (size_t)(row0 + lane) * PW + OFF_V + hd * 64;
#pragma unroll
    for (int i = 0; i < 8; ++i) *(uint4*)(tile + lane * 72 + i * 8) = *(const uint4*)(src + i * 8);
    __builtin_amdgcn_wave_barrier();
    bf16_t* dst;
    if (row0 < NLAT) dst = P.vtl() + ((size_t)((row0 >> 12) * 8 + hd) * 64 + lane) * 4096 + (row0 & 4095);
    else dst = P.vtc() + ((size_t)(((row0 - NLAT) >> 8) * 8 + hd) * 64 + lane) * 256 + ((row0 - NLAT) & 255);
#pragma unroll
    for (int i = 0; i < 8; ++i) {
      uint32_t w[4];
#pragma unroll
      for (int k = 0; k < 4; ++k)
        w[k] = (uint32_t)tile[(i * 8 + 2 * k) * 72 + lane] | ((uint32_t)tile[(i * 8 + 2 * k + 1) * 72 + lane] << 16);
      *(uint4*)(dst + i * 8) = make_uint4(w[0], w[1], w[2], w[3]);
    }
    __builtin_amdgcn_wave_barrier();
  }
}

__device__ __forceinline__ float grp_max(float v) {
  auto a = __builtin_amdgcn_permlane16_swap(__float_as_uint(v), __float_as_uint(v), false, false);
  v = fmaxf(__uint_as_float(a[0]), __uint_as_float(a[1]));
  auto b = __builtin_amdgcn_permlane32_swap(__float_as_uint(v), __float_as_uint(v), false, false);
  return fmaxf(__uint_as_float(b[0]), __uint_as_float(b[1]));
}
__device__ __forceinline__ float grp_sum(float v) {
  auto a = __builtin_amdgcn_permlane16_swap(__float_as_uint(v), __float_as_uint(v), false, false);
  v = __uint_as_float(a[0]) + __uint_as_float(a[1]);
  auto b = __builtin_amdgcn_permlane32_swap(__float_as_uint(v), __float_as_uint(v), false, false);
  return __uint_as_float(b[0]) + __uint_as_float(b[1]);
}

__device__ void ph_na_mfma(int wv, const Params& P, int layer, int nrows, int bid, int nb) {
  const int lane = otid(wv) & 63, li = lane & 15, g = lane >> 4;
  const float* rpb = P.na_rpb + (size_t)layer * 8 * 15 * 31;
  const int n_lat = 4 * 64 * 8 * 4;
  const int n_items = n_lat + (nrows > NLAT ? 4 * 16 * 8 : 0);
  for (int it = bid * NWAVE + wv; it < n_items; it += nb * NWAVE) {
    const bool lat = it < n_lat;
    int b, hd, qrow0, r = 0, cq0 = 0, r0 = 0, cs = 0;
    if (lat) {
      const int qt = it & 3; hd = (it >> 2) & 7; r = (it >> 5) & 63; b = it >> 11;
      cq0 = qt * 16; qrow0 = b * 4096 + r * 64 + cq0;
      r0 = r - 4; r0 = r0 < 0 ? 0 : (r0 > 56 ? 56 : r0);
      int clo = cq0 - 8; clo = clo < 0 ? 0 : (clo > 48 ? 48 : clo);
      cs = clo < 32 ? clo : 32;
    } else {
      const int t = it - n_lat; hd = t & 7; const int qt = (t >> 3) & 15; b = t >> 7;
      qrow0 = NLAT + b * 256 + qt * 16;
    }
    const bf16_t* qp = P.p() + (size_t)(qrow0 + li) * PW + OFF_Q + hd * 64 + 8 * g;
    const bf16x8 qf0 = *(const bf16x8*)qp, qf1 = *(const bf16x8*)(qp + 32);
    f32x4 accS[16], accC[16];
#pragma unroll
    for (int kt = 0; kt < 16; ++kt) {
      const int krow = b * 4096 + (r0 + (kt >> 1)) * 64 + cs + 16 * (kt & 1) + li;
      const bf16_t* kp = P.p() + (size_t)krow * PW + OFF_K + hd * 64 + 8 * g;
      const bf16x8 a0 = *(const bf16x8*)kp, a1 = *(const bf16x8*)(kp + 32);
      f32x4 z = (f32x4){0.f, 0.f, 0.f, 0.f};
      z = __builtin_amdgcn_mfma_f32_16x16x32_bf16(a0, qf0, z, 0, 0, 0);
      accS[kt] = __builtin_amdgcn_mfma_f32_16x16x32_bf16(a1, qf1, z, 0, 0, 0);
    }
#pragma unroll
    for (int ct = 0; ct < 16; ++ct) {
      const int krow = NLAT + b * 256 + 16 * ct + li;
      const bf16_t* kp = P.p() + (size_t)krow * PW + OFF_K + hd * 64 + 8 * g;
      const bf16x8 a0 = *(const bf16x8*)kp, a1 = *(const bf16x8*)(kp + 32);
      f32x4 z = (f32x4){0.f, 0.f, 0.f, 0.f};
      z = __builtin_amdgcn_mfma_f32_16x16x32_bf16(a0, qf0, z, 0, 0, 0);
      accC[ct] = __builtin_amdgcn_mfma_f32_16x16x32_bf16(a1, qf1, z, 0, 0, 0);
    }
    const int cq = cq0 + li;
    int c0q = cq - 8; c0q = c0q < 0 ? 0 : (c0q > 48 ? 48 : c0q);
    float mx = -3.0e38f;
#pragma unroll
    for (int kt = 0; kt < 16; ++kt) {
      const int rk = r0 + (kt >> 1);
#pragma unroll
      for (int e = 0; e < 4; ++e) {
        const int ck = cs + 16 * (kt & 1) + 4 * g + e;
        const bool ok = lat && ck >= c0q && ck < c0q + 16;
        float s = -3.0e38f;
        if (ok) s = accS[kt][e] * 0.125f + rpb[(hd * 15 + (rk - r + 7)) * 31 + (ck - cq + 15)];
        accS[kt][e] = s;
        mx = fmaxf(mx, s);
      }
    }
#pragma unroll
    for (int ct = 0; ct < 16; ++ct)
#pragma unroll
      for (int e = 0; e < 4; ++e) { const float s = accC[ct][e] * 0.125f; accC[ct][e] = s; mx = fmaxf(mx, s); }
    mx = grp_max(mx);
    float sum = 0.f;
#pragma unroll
    for (int kt = 0; kt < 16; ++kt)
#pragma unroll
      for (int e = 0; e < 4; ++e) { const float p = __expf(accS[kt][e] - mx); accS[kt][e] = p; sum += p; }
#pragma unroll
    for (int ct = 0; ct < 16; ++ct)
#pragma unroll
      for (int e = 0; e < 4; ++e) { const float p = __expf(accC[ct][e] - mx); accC[ct][e] = p; sum += p; }
    sum = grp_sum(sum);
    const float inv = 1.f / sum;
    f32x4 accO[4];
#pragma unroll
    for (int db = 0; db < 4; ++db) accO[db] = (f32x4){0.f, 0.f, 0.f, 0.f};
    const bf16_t* vl = P.vtl() + ((size_t)(b * 8 + hd) * 64 + li) * 4096;
    const bf16_t* vc = P.vtc() + ((size_t)(b * 8 + hd) * 64 + li) * 256;
#pragma unroll
    for (int kr = 0; kr < 8; ++kr) {
      bf16x8 af;
#pragma unroll
      for (int e = 0; e < 4; ++e) { af[e] = (short)f2bf(accS[2 * kr][e] * inv); af[4 + e] = (short)f2bf(accS[2 * kr + 1][e] * inv); }
      const int tok = (r0 + kr) * 64 + cs + 4 * g;
#pragma unroll
      for (int db = 0; db < 4; ++db) {
        const bf16_t* vp = vl + (size_t)db * 16 * 4096 + tok;
        const s16x4 lo = *(const s16x4*)vp, hi = *(const s16x4*)(vp + 16);
        const bf16x8 bfr = (bf16x8){lo[0], lo[1], lo[2], lo[3], hi[0], hi[1], hi[2], hi[3]};
        accO[db] = __builtin_amdgcn_mfma_f32_16x16x32_bf16(af, bfr, accO[db], 0, 0, 0);
      }
    }
#pragma unroll
    for (int t = 0; t < 8; ++t) {
      bf16x8 af;
#pragma unroll
      for (int e = 0; e < 4; ++e) { af[e] = (short)f2bf(accC[2 * t][e] * inv); af[4 + e] = (short)f2bf(accC[2 * t + 1][e] * inv); }
      const int tok = 32 * t + 4 * g;
#pragma unroll
      for (int db = 0; db < 4; ++db) {
        const bf16_t* vp = vc + (size_t)db * 16 * 256 + tok;
        const s16x4 lo = *(const s16x4*)vp, hi = *(const s16x4*)(vp + 16);
        const bf16x8 bfr = (bf16x8){lo[0], lo[1], lo[2], lo[3], hi[0], hi[1], hi[2], hi[3]};
        accO[db] = __builtin_amdgcn_mfma_f32_16x16x32_bf16(af, bfr, accO[db], 0, 0, 0);
      }
    }
#pragma unroll
    for (int db = 0; db < 4; ++db)
#pragma unroll
      for (int e = 0; e < 4; ++e)
        P.concat()[(size_t)(qrow0 + 4 * g + e) * 2048 + 1536 + hd * 64 + 16 * db + li] = f2bf(accO[db][e]);
  }
}

__device__ void ph_peer_topk(int wv, const Params& P, int layer, int nrows, char* smem, int bid, int nb) {
  bf16_t* Ks = (bf16_t*)smem;
  float* qt = (float*)(smem + 33280);
  float* sc = qt + 32 * 256;
  float* tv = sc + 64 * 129;
  int* ti = (int*)(tv + 64 * 16);
  const int tid = otid(wv);
  const int ntile = nrows / 32;
  for (int it = bid; it < ntile * 8; it += nb) {
    const int hd = it % 8, tt = it / 8;
    const int row0 = tt * 32;
    __syncthreads();
    for (int i = tid; i < 32 * 256; i += NTHR) {
      const int t = i >> 8, d = i & 255;
      qt[i] = bf2f(P.q()[(size_t)(row0 + t) * 2048 + hd * 256 + d]);
    }
    for (int half = 0; half < 2; ++half) {
      __syncthreads();
      const float* kk = P.peer_keys + ((size_t)((layer * 8 + hd) * 2 + half) * 128) * 128;
      for (int i = tid; i < 128 * 128; i += NTHR) Ks[(i >> 7) * 130 + (i & 127)] = f2bf(kk[i]);
      __syncthreads();
      const int k = tid & 127, tg = (tid >> 7) & 1;
      float acc[16];
#pragma unroll
      for (int i = 0; i < 16; ++i) acc[i] = 0.f;
      for (int d = 0; d < 128; ++d) {
        const float kv = bf2f(Ks[k * 130 + d]);
#pragma unroll
        for (int i = 0; i < 16; ++i) acc[i] += qt[(tg * 16 + i) * 256 + half * 128 + d] * kv;
      }
#pragma unroll
      for (int i = 0; i < 16; ++i) sc[((tg * 16 + i) * 2 + half) * 129 + k] = acc[i];
    }
    __syncthreads();
    if (tid < 64) {
      float* s = sc + tid * 129;
      for (int r = 0; r < 16; ++r) {
        float best = -3.0e38f; int bi = 0;
        for (int k = 0; k < 128; ++k) { const float v = s[k]; if (v > best) { best = v; bi = k; } }
        tv[tid * 16 + r] = best; ti[tid * 16 + r] = bi;
        s[bi] = -3.0e38f;
      }
    }
    __syncthreads();
    float* cand = qt;
    for (int i = tid; i < 32 * 256; i += NTHR) {
      const int t = i >> 8, a = (i >> 4) & 15, b2 = i & 15;
      cand[i] = tv[(t * 2 + 0) * 16 + a] + tv[(t * 2 + 1) * 16 + b2];
    }
    __syncthreads();
    if (tid < 32) {
      float* cd = cand + tid * 256;
      float ts[16];
      const int row = row0 + tid;
      float mx = 0.f;
#pragma unroll
      for (int r = 0; r < 16; ++r) {
        float best = -3.0e38f; int bi = 0;
        for (int k = 0; k < 256; ++k) { const float v = cd[k]; if (v > best) { best = v; bi = k; } }
        cd[bi] = -3.0e38f;
        ts[r] = best;
        if (r == 0) mx = best;
        const int e = ti[(tid * 2 + 0) * 16 + (bi >> 4)] * 128 + ti[(tid * 2 + 1) * 16 + (bi & 15)];
        P.sel_idx()[(size_t)row * 128 + hd * 16 + r] = e;
      }
      float sum = 0.f;
#pragma unroll
      for (int r = 0; r < 16; ++r) { ts[r] = expf(ts[r] - mx); sum += ts[r]; }
      const float inv = 1.f / sum;
#pragma unroll
      for (int r = 0; r < 16; ++r) P.sel_g()[(size_t)row * 128 + hd * 16 + r] = ts[r] * inv;
    }
  }
}


__device__ __forceinline__ uint32_t mono_u(float f) { const uint32_t u = __float_as_uint(f); return u ^ ((uint32_t)((int)u >> 31) | 0x80000000u); }
__device__ __forceinline__ float unmono_f(uint32_t m) { return __uint_as_float((m & 0x80000000u) ? (m ^ 0x80000000u) : ~m); }
__device__ __forceinline__ uint32_t grp_max_u(uint32_t v) {
  auto a = __builtin_amdgcn_permlane16_swap(v, v, false, false);
  v = a[0] > a[1] ? a[0] : a[1];
  auto b = __builtin_amdgcn_permlane32_swap(v, v, false, false);
  return b[0] > b[1] ? b[0] : b[1];
}
__device__ void ph_peer_topk_mfma(int wv, const Params& P, int layer, int nrows, char* smem, int bid, int nb) {
  const int tid = otid(wv), lane = tid & 63, li = lane & 15, g = lane >> 4;
  unsigned char* ctab = (unsigned char*)smem;
  float* vals = (float*)(smem + 256) + wv * 512;
  int* idxs = (int*)(smem + 256 + 8 * 2048) + wv * 512;
  __syncthreads();
  if (tid < 64) ctab[tid] = 0xFF;
  __syncthreads();
  if (tid == 0) {
    int n = 0, one = 1;
    asm volatile("" : "+s"(one));
#pragma unroll 1
    for (int a = 0; a < 16; ++a)
#pragma unroll 1
      for (int b = 0; b < 16; ++b)
        if ((a + one) * (b + 1) <= 16) { ctab[(n & 3) * 16 + (n >> 2)] = (unsigned char)(a * 16 + b); ++n; }
  }
  __syncthreads();
  const int ntile = nrows / 16;
  for (int it = bid * NWAVE + wv; it < ntile * 8; it += nb * NWAVE) {
    const int hd = it & 7, row0 = (it >> 3) * 16;
    const bf16_t* qp = P.q() + (size_t)(row0 + li) * 2048 + hd * 256 + 8 * g;
    uint32_t win[2][16];
#pragma unroll
    for (int half = 0; half < 2; ++half) {
      bf16x8 qf[4];
#pragma unroll
      for (int t = 0; t < 4; ++t) qf[t] = *(const bf16x8*)(qp + half * 128 + 32 * t);
      const bf16_t* kb = P.keysb() + ((size_t)((layer * 8 + hd) * 2 + half) * 128 + li) * 128 + 8 * g;
      uint32_t pk[32];
#pragma unroll
      for (int kt = 0; kt < 8; ++kt) {
        f32x4 acc = (f32x4){0.f, 0.f, 0.f, 0.f};
#pragma unroll
        for (int t = 0; t < 4; ++t) {
          const bf16x8 a = *(const bf16x8*)(kb + (size_t)kt * 16 * 128 + 32 * t);
          acc = __builtin_amdgcn_mfma_f32_16x16x32_bf16(a, qf[t], acc, 0, 0, 0);
        }
#pragma unroll
        for (int e = 0; e < 4; ++e) pk[kt * 4 + e] = (mono_u(acc[e]) & ~127u) | (uint32_t)(16 * kt + 4 * g + e);
      }
#pragma unroll
      for (int r = 0; r < 16; ++r) {
        uint32_t m = pk[0];
#pragma unroll
        for (int i = 1; i < 32; ++i) m = pk[i] > m ? pk[i] : m;
        m = grp_max_u(m);
        win[half][r] = m;
#pragma unroll
        for (int i = 0; i < 32; ++i) pk[i] = (pk[i] == m) ? 0u : pk[i];
      }
    }
    if (g == 0) {
#pragma unroll
      for (int half = 0; half < 2; ++half)
#pragma unroll
        for (int r = 0; r < 16; ++r) {
          vals[li * 32 + half * 16 + r] = unmono_f(win[half][r] & ~127u);
          idxs[li * 32 + half * 16 + r] = (int)(win[half][r] & 127u);
        }
    }
    __builtin_amdgcn_wave_barrier();
    uint32_t cp[16];
#pragma unroll
    for (int s = 0; s < 16; ++s) {
      const uint32_t ab = ctab[g * 16 + s];
      uint32_t v = 0u;
      if (ab != 0xFFu) v = (mono_u(vals[li * 32 + (ab >> 4)] + vals[li * 32 + 16 + (ab & 15u)]) & ~255u) | ab;
      cp[s] = v;
    }
    uint32_t cw[16];
#pragma unroll
    for (int r = 0; r < 16; ++r) {
      uint32_t m = cp[0];
#pragma unroll
      for (int i = 1; i < 16; ++i) m = cp[i] > m ? cp[i] : m;
      m = grp_max_u(m);
      cw[r] = m;
#pragma unroll
      for (int i = 0; i < 16; ++i) cp[i] = (cp[i] == m) ? 0u : cp[i];
    }
    const float mx = unmono_f(cw[0] & ~255u);
    float ex[16];
    float sum = 0.f;
#pragma unroll
    for (int r = 0; r < 16; ++r) { ex[r] = __expf(unmono_f(cw[r] & ~255u) - mx); sum += ex[r]; }
    const float inv = 1.f / sum;
    const size_t ob = (size_t)(row0 + li) * 128 + hd * 16;
#pragma unroll
    for (int r = 0; r < 16; ++r) {
      if ((r >> 2) == g) {
        const uint32_t ab = cw[r] & 255u;
        P.sel_idx()[ob + r] = idxs[li * 32 + (ab >> 4)] * 128 + idxs[li * 32 + 16 + (ab & 15u)];
        P.sel_g()[ob + r] = ex[r] * inv;
      }
    }
    __builtin_amdgcn_wave_barrier();
  }
}

__device__ void ph_peer_gather(int wv, const Params& P, int layer, int nrows, int bid, int nb) {
  const int wave = otid(wv) >> 6, lane = otid(wv) & 63;
  for (int row = bid * NWAVE + wave; row < nrows; row += nb * NWAVE) {
    float xv[16], o[16];
    unpack8(*(const uint4*)(P.u() + (size_t)row * DM + lane * 8), xv);
    unpack8(*(const uint4*)(P.u() + (size_t)row * DM + 512 + lane * 8), xv + 8);
    int idx[2]; float act[2];
    idx[0] = P.sel_idx()[(size_t)row * 128 + lane]; idx[1] = P.sel_idx()[(size_t)row * 128 + 64 + lane];
#pragma unroll
    for (int hb = 0; hb < 2; ++hb) {
      float dk = 0.f;
#pragma unroll 4
      for (int k = 0; k < 64; ++k) {
        const int e = __builtin_amdgcn_readlane(idx[hb], k);
        const bf16_t* ur = P.tabU() + (size_t)e * 1024 + lane * 8;
        float f[16];
        unpack8(*(const uint4*)ur, f);
        unpack8(*(const uint4*)(ur + 512), f + 8);
        float d = 0.f;
#pragma unroll
        for (int i = 0; i < 16; ++i) d += f[i] * xv[i];
        d = wave_sum(d);
        dk = (lane == k) ? d : dk;
      }
      act[hb] = gelu_f(dk) * P.sel_g()[(size_t)row * 128 + hb * 64 + lane];
    }
#pragma unroll
    for (int i = 0; i < 16; ++i) o[i] = 0.f;
#pragma unroll
    for (int hb = 0; hb < 2; ++hb) {
#pragma unroll 4
      for (int k = 0; k < 64; ++k) {
        const int e = __builtin_amdgcn_readlane(idx[hb], k);
        const float a = __int_as_float(__builtin_amdgcn_readlane(__float_as_int(act[hb]), k));
        const bf16_t* vr = P.tabV() + (size_t)e * 1024 + lane * 8;
        float f[16];
        unpack8(*(const uint4*)vr, f);
        unpack8(*(const uint4*)(vr + 512), f + 8);
#pragma unroll
        for (int i = 0; i < 16; ++i) o[i] += a * f[i];
      }
    }
    const float* gate = P.mod() + (size_t)(layer * 5 + modrow(row)) * MODW + 5120;
    float* hr = P.h() + (size_t)row * DM;
    float hn[16];
    float ss = 0.f;
#pragma unroll
    for (int j = 0; j < 2; ++j)
#pragma unroll
      for (int q = 0; q < 2; ++q) {
        const int idx0 = j * 512 + lane * 8 + q * 4;
        float4 hv = *(float4*)(hr + idx0);
        const float4 gg = *(const float4*)(gate + idx0);
        hv.x += gg.x * o[j * 8 + q * 4 + 0]; hv.y += gg.y * o[j * 8 + q * 4 + 1];
        hv.z += gg.z * o[j * 8 + q * 4 + 2]; hv.w += gg.w * o[j * 8 + q * 4 + 3];
        if (layer == 0) *(float4*)(hr + idx0) = hv;
        hn[j * 8 + q * 4 + 0] = hv.x; hn[j * 8 + q * 4 + 1] = hv.y; hn[j * 8 + q * 4 + 2] = hv.z; hn[j * 8 + q * 4 + 3] = hv.w;
        ss += hv.x * hv.x + hv.y * hv.y + hv.z * hv.z + hv.w * hv.w;
      }
    ss = wave_sum(ss);
    const float rstd = rsqrtf(ss * (1.f / 1024.f) + 1e-6f);
    if (layer == 0) {
      const float* g1 = P.norm1_g + 1024;
      const float* mr = P.mod() + (size_t)(5 + modrow(row)) * MODW;
#pragma unroll
      for (int j = 0; j < 2; ++j) {
        const int idx0 = j * 512 + lane * 8;
        float ov[8];
#pragma unroll
        for (int e = 0; e < 8; ++e) ov[e] = hn[j * 8 + e] * rstd * g1[idx0 + e] * (1.f + mr[1024 + idx0 + e]) + mr[idx0 + e];
        *(uint4*)(P.u() + (size_t)row * DM + idx0) = make_uint4(pack2(ov[0], ov[1]), pack2(ov[2], ov[3]), pack2(ov[4], ov[5]), pack2(ov[6], ov[7]));
      }
    } else {
#pragma unroll
      for (int j = 0; j < 2; ++j)
#pragma unroll
        for (int q = 0; q < 2; ++q) {
          const int idx0 = j * 512 + lane * 8 + q * 4;
          const float4 gg = *(const float4*)(P.final_g + idx0);
          float4 ov;
          ov.x = hn[j * 8 + q * 4 + 0] * rstd * gg.x; ov.y = hn[j * 8 + q * 4 + 1] * rstd * gg.y;
          ov.z = hn[j * 8 + q * 4 + 2] * rstd * gg.z; ov.w = hn[j * 8 + q * 4 + 3] * rstd * gg.w;
          *(float4*)(P.out + (size_t)row * DM + idx0) = ov;
        }
    }
  }
}

__device__ void ph_final(int wv, const Params& P, int bid, int nb) {
  const int wave = otid(wv) >> 6, lane = otid(wv) & 63;
  for (int row = bid * NWAVE + wave; row < NLAT; row += nb * NWAVE) {
    const float* src = P.h() + (size_t)row * DM;
    float4 v[4];
    float ss = 0.f;
#pragma unroll
    for (int i = 0; i < 4; ++i) {
      v[i] = ((const float4*)src)[i * 64 + lane];
      ss += v[i].x * v[i].x + v[i].y * v[i].y + v[i].z * v[i].z + v[i].w * v[i].w;
    }
    ss = wave_sum(ss);
    const float rstd = rsqrtf(ss * (1.f / 1024.f) + 1e-6f);
#pragma unroll
    for (int i = 0; i < 4; ++i) {
      const int idx = i * 256 + lane * 4;
      const float4 gg = *(const float4*)(P.final_g + idx);
      float4 o;
      o.x = v[i].x * rstd * gg.x; o.y = v[i].y * rstd * gg.y; o.z = v[i].z * rstd * gg.z; o.w = v[i].w * rstd * gg.w;
      *(float4*)(P.out + (size_t)row * DM + idx) = o;
    }
  }
}


struct EpiOutproj {
  static constexpr bool PERM = false, AFTER_DRAIN = false;
  float* H; const float* hl; const float* hc; const float* modl;
  __device__ __forceinline__ void operator()(const pg8::f32x4 (&acc)[2][2][4][2], const pg8::Unit& u, int wr, int wc, int fr, int fq) const {
    const int row0 = u.pm * 256 + wr * 64 + fr, col0 = u.pn * 256 + wc * 32 + 4 * fq;
#pragma unroll
    for (int ai = 0; ai < 2; ++ai)
#pragma unroll
      for (int m = 0; m < 4; ++m) {
        const int row = row0 + ai * 128 + m * 16;
        const float* src = hrow(hl, hc, row) + col0;
        const float* gate = modl + (size_t)modrow(row) * MODW + 2048 + col0;
        float* dst = H + (size_t)row * DM + col0;
#pragma unroll
        for (int bj = 0; bj < 2; ++bj)
#pragma unroll
          for (int n = 0; n < 2; ++n) {
            const pg8::f32x4 s = *(const pg8::f32x4*)(src + bj * 128 + n * 16);
            const pg8::f32x4 g = *(const pg8::f32x4*)(gate + bj * 128 + n * 16);
            *(pg8::f32x4*)(dst + bj * 128 + n * 16) = s + g * acc[ai][bj][m][n];
          }
      }
  }
};

__device__ void ph_convert_tables(int wv, const Params& P, int layer, int bid, int nb) {
  const size_t n8 = (size_t)16384 * 1024 / 8;
  for (int t = 0; t < 2; ++t) {
    const float* src = (t == 0 ? P.peer_u : P.peer_v) + (size_t)layer * 16384 * 1024;
    bf16_t* dst = t == 0 ? P.tabU() : P.tabV();
    for (size_t i = (size_t)bid * NTHR + otid(wv); i < n8; i += (size_t)nb * NTHR) {
      const float4 a = ((const float4*)src)[i * 2], b = ((const float4*)src)[i * 2 + 1];
      uint4 o;
      o.x = (uint32_t)f2bf(a.x) | ((uint32_t)f2bf(a.y) << 16); o.y = (uint32_t)f2bf(a.z) | ((uint32_t)f2bf(a.w) << 16);
      o.z = (uint32_t)f2bf(b.x) | ((uint32_t)f2bf(b.y) << 16); o.w = (uint32_t)f2bf(b.z) | ((uint32_t)f2bf(b.w) << 16);
      ((uint4*)dst)[i] = o;
    }
  }
}

enum {
  PH_PREP = 0, PH_NORM1, PH_INPROJ, PH_CONV, PH_SSDPREP, PH_STATES, PH_SCAN, PH_SSDY, PH_SSDNORM, PH_POOL, PH_NA,
  PH_OUTPROJ, PH_NORM2, PH_QGEMM, PH_TOPK, PH_GATHER, PH_FINAL
};

#define SMEM_BYTES 131072

__device__ __forceinline__ void run_phase(int wv, const Params& P, int ph, int layer, char* smem, int bid, int nb) {
  const float* hl = layer == 0 ? P.x : P.h();
  const float* hc = layer == 0 ? P.ctx : P.h() + (size_t)NLAT * DM;
  const int nrows = layer == 0 ? NTOK : NLAT;
  switch (ph) {
    case PH_PREP:
      for (int i = bid * NTHR + otid(wv); i < 2 * 8 * 2 * 128 * 128; i += nb * NTHR) P.keysb()[i] = f2bf(P.peer_keys[i]);
      ph_mod(wv, P, (float*)smem, bid, nb);
      for (int l = 0; l < 2; ++l) {
        ph_transpose(wv, P.w_in + (size_t)l * 1024 * INW, P.w_inT() + (size_t)l * PW * 1024, 1024, INW, PW, 0, 2560, 32, PW, (float*)smem, bid, nb);
        ph_transpose(wv, P.w_in + (size_t)l * 1024 * INW, P.w_dtT() + (size_t)l * 128 * 1024, 1024, INW, 128, 2560, 1 << 30, 0, 32, (float*)smem, bid, nb);
        ph_transpose(wv, P.w_out + (size_t)l * 2048 * 1024, P.w_outT() + (size_t)l * 1024 * 2048, 2048, 1024, 1024, 0, 1 << 30, 0, 1024, (float*)smem, bid, nb);
        ph_transpose(wv, P.peer_wq + (size_t)l * 1024 * 2048, P.w_qT() + (size_t)l * 2048 * 1024, 1024, 2048, 2048, 0, 1 << 30, 0, 2048, (float*)smem, bid, nb);
      }
      break;
    case PH_NORM1:
      ph_norm(wv, hl, hc, P.norm1_g + layer * 1024, P.mod() + (size_t)layer * 5 * MODW, 0, 1024, NTOK, P.u(), bid, nb);
      break;
    case PH_INPROJ:
    {
      pg8::Gemm g{P.u(), P.w_inT() + (size_t)layer * PW * 1024, NTOK, PW, 1024};
      pg8::StaticOrder S; S.init(g.M, g.N, nb, bid);
      pg8::EpiBf16<0> E{P.p(), PW, nullptr, 0, 0};
      pg8::gemm_phase<pg8::EpiBf16<0>, pg8::StaticOrder, false>(wv, (PG8_LAS unsigned char*)smem, g, S, E, nullptr);
      ph_gemm<EPI_INPROJ>(wv, P, layer, P.u(), P.w_dtT() + (size_t)layer * 128 * 1024, NTOK, 128, 1024, hl, hc, smem, bid, nb);
      break;
    }
    case PH_CONV: ph_conv(wv, P, layer, bid, nb); ph_vtranspose(wv, P, smem, bid, nb); break;
    case PH_SSDPREP: ph_ssdprep(wv, P, layer, bid, nb); break;
    case PH_STATES: ph_states_mfma(wv, P, layer, smem, bid, nb); break;
    case PH_SCAN: ph_scan(wv, P, bid, nb); break;
    case PH_SSDY: ph_ssdy_mfma(wv, P, layer, nrows / 128, smem, bid, nb); break;
    case PH_SSDNORM: ph_ssdnorm(wv, P, layer, nrows, bid, nb); break;
    case PH_POOL: ph_pool(wv, P, layer, nrows, smem, bid, nb); break;
    case PH_NA: ph_na_mfma(wv, P, layer, nrows, bid, nb); break;
    case PH_OUTPROJ:
    {
      pg8::Gemm g{P.concat(), P.w_outT() + (size_t)layer * 1024 * 2048, nrows, 1024, 2048};
      pg8::StaticOrder S; S.init(g.M, g.N, nb, bid);
      EpiOutproj E{P.h(), hl, hc, P.mod() + (size_t)layer * 5 * MODW};
      pg8::gemm_phase<EpiOutproj, pg8::StaticOrder, false>(wv, (PG8_LAS unsigned char*)smem, g, S, E, nullptr);
      break;
    }
    case PH_NORM2:
      ph_norm(wv, P.h(), P.h() + (size_t)NLAT * DM, P.norm2_g + layer * 1024, P.mod() + (size_t)layer * 5 * MODW, 3072, 4096, nrows, P.u(), bid, nb);
      break;
    case PH_QGEMM:
    {
      pg8::Gemm g{P.u(), P.w_qT() + (size_t)layer * 2048 * 1024, nrows, 2048, 1024};
      pg8::StaticOrder S; S.init(g.M, g.N, nb, bid);
      pg8::EpiBf16<0> E{P.q(), 2048, nullptr, 0, 0};
      pg8::gemm_phase<pg8::EpiBf16<0>, pg8::StaticOrder, false>(wv, (PG8_LAS unsigned char*)smem, g, S, E, nullptr);
      ph_convert_tables(wv, P, layer, bid, nb);
      break;
    }
    case PH_TOPK: ph_peer_topk_mfma(wv, P, layer, nrows, smem, bid, nb); break;
    case PH_GATHER: ph_peer_gather(wv, P, layer, nrows, bid, nb); break;
    case PH_FINAL: ph_final(wv, P, bid, nb); break;
  }
}

namespace cg = cooperative_groups;
typedef const __attribute__((address_space(4))) Params* kparams_t;
__device__ __forceinline__ const Params& kp_fresh() {
  kparams_t kp = (kparams_t)__builtin_amdgcn_kernarg_segment_ptr();
  asm volatile("" : "+s"(kp));
  return *(const Params*)kp;
}
__global__ void __launch_bounds__(NTHR) k_mega(Params P_unused) {
  __shared__ __attribute__((aligned(16))) char smem[SMEM_BYTES + 16];
  cg::grid_group grid = cg::this_grid();
  const int bid = blockIdx.x, nb = gridDim.x;
  const int wv = __builtin_amdgcn_readfirstlane(threadIdx.x >> 6);
  if (threadIdx.x == 0) *(uint4*)(smem + SMEM_BYTES) = make_uint4(0u, 0u, 0u, 0u);
  __syncthreads();
  (void)xcd_barrier_post((unsigned*)(kp_fresh().ws + WS_BAR), (volatile LAS unsigned*)(smem + SMEM_BYTES), threadIdx.x == 0);
#define GSYNC() do { XcdBarrier xb_; xb_.bar = (unsigned*)(kp_fresh().ws + WS_BAR); xb_.x = xb_xcc_id(); \
    xb_.st = (volatile LAS unsigned*)(smem + SMEM_BYTES); xcd_barrier(xb_, otid(wv) == 0); } while (0)
  run_phase(wv, kp_fresh(), PH_PREP, 0, smem, bid, nb);
  grid.sync();
  run_phase(wv, kp_fresh(), PH_NORM1, 0, smem, bid, nb); GSYNC();
#pragma unroll 1
  for (int layer = 0; layer < 2; ++layer) {
    run_phase(wv, kp_fresh(), PH_INPROJ, layer, smem, bid, nb); GSYNC();
    run_phase(wv, kp_fresh(), PH_CONV, layer, smem, bid, nb);
    run_phase(wv, kp_fresh(), PH_SSDPREP, layer, smem, bid, nb); GSYNC();
    run_phase(wv, kp_fresh(), PH_STATES, layer, smem, bid, nb);
    run_phase(wv, kp_fresh(), PH_POOL, layer, smem, bid, nb);
    run_phase(wv, kp_fresh(), PH_NA, layer, smem, bid, nb); GSYNC();
    run_phase(wv, kp_fresh(), PH_SCAN, layer, smem, bid, nb); GSYNC();
    run_phase(wv, kp_fresh(), PH_SSDY, layer, smem, bid, nb); GSYNC();
    run_phase(wv, kp_fresh(), PH_SSDNORM, layer, smem, bid, nb); GSYNC();
    run_phase(wv, kp_fresh(), PH_OUTPROJ, layer, smem, bid, nb); GSYNC();
    run_phase(wv, kp_fresh(), PH_NORM2, layer, smem, bid, nb); GSYNC();
    run_phase(wv, kp_fresh(), PH_QGEMM, layer, smem, bid, nb); GSYNC();
    run_phase(wv, kp_fresh(), PH_TOPK, layer, smem, bid, nb); GSYNC();
    run_phase(wv, kp_fresh(), PH_GATHER, layer, smem, bid, nb);
    if (layer == 0) GSYNC();
  }
}

extern "C" void kernel_launch(void* const* d_in, const int* in_sizes, int n_in, void* d_out, int out_size, void* d_ws,
                              size_t ws_size, hipStream_t stream) {
  Params P{};
  const float* const* in = (const float* const*)d_in;
  P.x = in[0]; P.c = in[1]; P.ctx = in[2]; P.c_ctx = in[3]; P.ada_w = in[4]; P.ada_b = in[5]; P.norm1_g = in[6];
  P.w_in = in[7]; P.conv_w = in[8]; P.conv_b = in[9]; P.a_log = in[10]; P.dt_bias = in[11]; P.d_skip = in[12];
  P.ssd_norm_g = in[13]; P.pool_w = in[14]; P.pool_scale = in[15]; P.na_rpb = in[16]; P.w_out = in[17];
  P.norm2_g = in[18]; P.peer_wq = in[19]; P.peer_keys = in[20]; P.peer_u = in[21]; P.peer_v = in[22]; P.final_g = in[23];
  P.out = (float*)d_out;
  P.ws = (char*)d_ws;
  if (WS_TOTAL > ws_size) { fprintf(stderr, "workspace too small: need %zu have %zu\n", (size_t)WS_TOTAL, ws_size); return; }

  static int grid_blocks = 0;
  if (!grid_blocks) {
    int dev = 0, cus = 0, per_cu = 0;
    hipGetDevice(&dev);
    hipDeviceGetAttribute(&cus, hipDeviceAttributeMultiprocessorCount, dev);
    hipOccupancyMaxActiveBlocksPerMultiprocessor(&per_cu, k_mega, NTHR, 0);
    if (per_cu > 4) per_cu = 4;
    grid_blocks = cus * per_cu;
  }
  hipMemsetAsync((char*)d_ws + WS_BAR, 0, 4096 * 4, stream);
  void* args[] = {&P};
  hipError_t e = hipLaunchCooperativeKernel((void*)k_mega, dim3(grid_blocks), dim3(NTHR), args, 0, stream);
  if (e != hipSuccess) fprintf(stderr, "cooperative launch failed: %s (grid %d)\n", hipGetErrorString(e), grid_blocks);
}
```

```cpp
#include <hip/hip_runtime.h>
#include <hip/hip_bf16.h>
#include <hip/hip_cooperative_groups.h>
#include <stdint.h>
#include <stdio.h>

typedef unsigned short bf16_t;
typedef __attribute__((ext_vector_type(8))) short bf16x8;
typedef __attribute__((ext_vector_type(4))) float f32x4;

#define NTHR 512
#define NWAVE 8
constexpr int DM = 1024;
constexpr int SEQ = 4096;
constexpr int NLAT = 16384;
constexpr int NCTXR = 1024;
constexpr int NTOK = 17408;
constexpr int INW = 4640;
constexpr int PW = 4608;
constexpr int OFF_Z = 0, OFF_XBC = 1024, OFF_POOL = 2560, OFF_Q = 3072, OFF_K = 3584, OFF_V = 4096;
constexpr int NCHUNK = 136;
constexpr int MODW = 6144;

constexpr size_t al256(size_t x) { return (x + 255) & ~(size_t)255; }
constexpr size_t WS_MOD = 0;
constexpr size_t WS_H = WS_MOD + al256((size_t)2 * 5 * MODW * 4);
constexpr size_t WS_P = WS_H + al256((size_t)NTOK * DM * 4);
constexpr size_t WS_TABU = WS_P + (size_t)80 * 1024 * 1024;
constexpr size_t WS_TABV = WS_TABU + (size_t)16384 * 1024;
constexpr size_t WS_INVU = WS_TABV + (size_t)16384 * 1024;
constexpr size_t WS_INVV = WS_INVU + (size_t)16384 * 4;
constexpr size_t WS_DTRAW = WS_P + al256((size_t)NTOK * PW * 2);
constexpr size_t WS_DTV = WS_DTRAW + al256((size_t)NTOK * 32 * 4);
constexpr size_t WS_CSV = WS_DTV + al256((size_t)NTOK * 32 * 4);
constexpr size_t WS_XBC = WS_CSV + al256((size_t)NTOK * 32 * 4);
constexpr size_t WS_VTL = WS_XBC + al256((size_t)NTOK * 512 * 2);
constexpr size_t WS_VTC = WS_VTL + al256((size_t)4 * 8 * 64 * 4096 * 2);
constexpr size_t WS_KEYSB = WS_VTC + al256((size_t)4 * 8 * 64 * 256 * 2);
constexpr size_t WS_POOLWT = WS_KEYSB + al256((size_t)2 * 8 * 2 * 128 * 128 * 2);
constexpr size_t WS_STATES = WS_XBC + al256((size_t)NTOK * 1536 * 2);
static_assert(WS_POOLWT + (size_t)2 * 4 * 128 * 128 * 2 <= WS_STATES, "must fit in the old xbc region");
constexpr size_t WS_CONCAT = WS_STATES + al256((size_t)NCHUNK * 32 * 8192 * 2);
constexpr size_t WS_SELIDX = WS_CONCAT + al256((size_t)NTOK * 2048 * 2);
constexpr size_t WS_SELG = WS_SELIDX + al256((size_t)NTOK * 128 * 4);
constexpr size_t WS_WINT = WS_SELG + al256((size_t)NTOK * 128 * 4);
constexpr size_t WS_WDTT = WS_WINT + al256((size_t)2 * PW * 1024 * 2);
constexpr size_t WS_WOUTT = WS_WDTT + al256((size_t)2 * 128 * 1024 * 2);
constexpr size_t WS_WQT = WS_WOUTT + al256((size_t)2 * 1024 * 2048 * 2);
constexpr size_t WS_BAR = WS_WQT + al256((size_t)2 * 2048 * 1024 * 2);
constexpr size_t WS_TOTAL = WS_BAR + al256((size_t)4096 * 4);
static_assert(WS_INVV + (size_t)16384 * 4 <= WS_DTRAW, "tables must fit in the tail of p");
static_assert((size_t)NTOK * 2048 * 2 <= (size_t)80 * 1024 * 1024, "q must fit below the tables");

struct Params {
  const float *x, *c, *ctx, *c_ctx, *ada_w, *ada_b, *norm1_g, *w_in, *conv_w, *conv_b, *a_log, *dt_bias, *d_skip,
      *ssd_norm_g, *pool_w, *pool_scale, *na_rpb, *w_out, *norm2_g, *peer_wq, *peer_keys, *peer_u, *peer_v, *final_g;
  float* out;
  char* ws;
  __device__ __forceinline__ float* mod() const { return (float*)(ws + WS_MOD); }
  __device__ __forceinline__ float* h() const { return (float*)(ws + WS_H); }
  __device__ __forceinline__ bf16_t* u() const { return (bf16_t*)(ws + WS_CONCAT); }
  __device__ __forceinline__ bf16_t* p() const { return (bf16_t*)(ws + WS_P); }
  __device__ __forceinline__ float* dtraw() const { return (float*)(ws + WS_DTRAW); }
  __device__ __forceinline__ float* dtv() const { return (float*)(ws + WS_DTV); }
  __device__ __forceinline__ float* csv() const { return (float*)(ws + WS_CSV); }
  __device__ __forceinline__ bf16_t* xbc() const { return (bf16_t*)(ws + WS_XBC); }
  __device__ __forceinline__ bf16_t* states() const { return (bf16_t*)(ws + WS_STATES); }
  __device__ __forceinline__ bf16_t* concat() const { return (bf16_t*)(ws + WS_CONCAT); }
  __device__ __forceinline__ bf16_t* q() const { return (bf16_t*)(ws + WS_P); }
  __device__ __forceinline__ int* sel_idx() const { return (int*)(ws + WS_SELIDX); }
  __device__ __forceinline__ float* sel_g() const { return (float*)(ws + WS_SELG); }
  __device__ __forceinline__ bf16_t* w_inT() const { return (bf16_t*)(ws + WS_WINT); }
  __device__ __forceinline__ bf16_t* w_dtT() const { return (bf16_t*)(ws + WS_WDTT); }
  __device__ __forceinline__ bf16_t* w_outT() const { return (bf16_t*)(ws + WS_WOUTT); }
  __device__ __forceinline__ bf16_t* w_qT() const { return (bf16_t*)(ws + WS_WQT); }
  __device__ __forceinline__ bf16_t* vtl() const { return (bf16_t*)(ws + WS_VTL); }
  __device__ __forceinline__ bf16_t* vtc() const { return (bf16_t*)(ws + WS_VTC); }
  __device__ __forceinline__ bf16_t* poolwT() const { return (bf16_t*)(ws + WS_POOLWT); }
  __device__ __forceinline__ bf16_t* keysb() const { return (bf16_t*)(ws + WS_KEYSB); }
  __device__ __forceinline__ unsigned char* tabU() const { return (unsigned char*)(ws + WS_TABU); }
  __device__ __forceinline__ unsigned char* tabV() const { return (unsigned char*)(ws + WS_TABV); }
  __device__ __forceinline__ float* invU() const { return (float*)(ws + WS_INVU); }
  __device__ __forceinline__ float* invV() const { return (float*)(ws + WS_INVV); }
};

__device__ __forceinline__ int otid(int wv) {
  int l;
  asm volatile("v_mbcnt_lo_u32_b32 %0, -1, 0\n\tv_mbcnt_hi_u32_b32 %0, -1, %0" : "=v"(l));
  return (wv << 6) | l;
}
__device__ __forceinline__ float bf2f(bf16_t v) { return __uint_as_float(((uint32_t)v) << 16); }
__device__ __forceinline__ bf16_t f2bf(float f) {
  uint32_t u = __float_as_uint(f);
  u += 0x7fffu + ((u >> 16) & 1u);
  return (bf16_t)(u >> 16);
}
#define DPP_F(v, ctrl) __int_as_float(__builtin_amdgcn_update_dpp(0, __float_as_int(v), (ctrl), 0xf, 0xf, true))
__device__ __forceinline__ float wave_sum(float v) {
  v += DPP_F(v, 0xB1);
  v += DPP_F(v, 0x4E);
  v += DPP_F(v, 0x141);
  v += DPP_F(v, 0x140);
  const int iv = __float_as_int(v);
  return __int_as_float(__builtin_amdgcn_readlane(iv, 0)) + __int_as_float(__builtin_amdgcn_readlane(iv, 16)) +
         __int_as_float(__builtin_amdgcn_readlane(iv, 32)) + __int_as_float(__builtin_amdgcn_readlane(iv, 48));
}
__device__ __forceinline__ float wave_max(float v) {
  v = fmaxf(v, DPP_F(v, 0xB1));
  v = fmaxf(v, DPP_F(v, 0x4E));
  v = fmaxf(v, DPP_F(v, 0x141));
  v = fmaxf(v, DPP_F(v, 0x140));
  const int iv = __float_as_int(v);
  return fmaxf(fmaxf(__int_as_float(__builtin_amdgcn_readlane(iv, 0)), __int_as_float(__builtin_amdgcn_readlane(iv, 16))),
               fmaxf(__int_as_float(__builtin_amdgcn_readlane(iv, 32)), __int_as_float(__builtin_amdgcn_readlane(iv, 48))));
}
__device__ __forceinline__ float silu_f(float v) { return v / (1.f + expf(-v)); }
__device__ __forceinline__ float softplus_f(float v) { return fmaxf(v, 0.f) + log1pf(expf(-fabsf(v))); }
__device__ __forceinline__ float gelu_f(float v) { return 0.5f * v * (1.f + erff(v * 0.70710678118654752f)); }

__device__ __forceinline__ void unpack8(const uint4 v, float* f) {
  f[0] = __uint_as_float(v.x << 16); f[1] = __uint_as_float(v.x & 0xffff0000u);
  f[2] = __uint_as_float(v.y << 16); f[3] = __uint_as_float(v.y & 0xffff0000u);
  f[4] = __uint_as_float(v.z << 16); f[5] = __uint_as_float(v.z & 0xffff0000u);
  f[6] = __uint_as_float(v.w << 16); f[7] = __uint_as_float(v.w & 0xffff0000u);
}
__device__ __forceinline__ uint32_t pack2(float a, float b) { return (uint32_t)f2bf(a) | ((uint32_t)f2bf(b) << 16); }
typedef float f32x2_t __attribute__((ext_vector_type(2)));
typedef short s16x4 __attribute__((ext_vector_type(4)));
typedef __attribute__((address_space(3))) s16x4 lds_s16x4;
__device__ __forceinline__ bf16x8 tr_read2(const char* a0, const char* a1) {
  const s16x4 a = __builtin_amdgcn_ds_read_tr16_b64_v4i16((lds_s16x4*)a0);
  const s16x4 b = __builtin_amdgcn_ds_read_tr16_b64_v4i16((lds_s16x4*)a1);
  return (bf16x8){a[0], a[1], a[2], a[3], b[0], b[1], b[2], b[3]};
}

__device__ __forceinline__ const float* hrow(const float* hl, const float* hc, int row) {
  return row < NLAT ? hl + (size_t)row * DM : hc + (size_t)(row - NLAT) * DM;
}
__device__ __forceinline__ int modrow(int row) { return row < NLAT ? (row >> 12) : 4; }

namespace pg8 {
#define PG8_LAS __attribute__((address_space(3)))
typedef unsigned short bf16_t;
typedef short bf16x8 __attribute__((ext_vector_type(8)));
typedef float f32x4 __attribute__((ext_vector_type(4)));
typedef unsigned u32x4 __attribute__((ext_vector_type(4)));
constexpr int BM = 256, BK = 64, HALF = 128, HTB = HALF * BK * 2  , STAGE_BYTES = 8 * HTB, NXCD = 8, WGM = 8;

__host__ __device__ __forceinline__ int lds_byte(int r, int c) { const int st = (r >> 4) * 2 + (c >> 5), rr = r & 15, cc = c & 31, ob = rr * 64 + cc * 2; return st * 1024 + (ob ^ (((ob >> 9) & 1) << 5)); }
__host__ __device__ __forceinline__ void stage_rc(int b, int& R, int& C) { const int st = b / 1024, sb = b % 1024, swz = sb ^ (((sb >> 9) & 1) << 5); R = (st >> 1) * 16 + swz / 64; C = (st & 1) * 32 + (swz % 64) / 2; }
__host__ __device__ __forceinline__ int perm32(int rho) { const int n = rho >> 4, i = rho & 15; return 8 * (i >> 2) + 4 * n + (i & 3); }

struct Unit { int pm, pn; };
struct Gemm { const bf16_t* A; const bf16_t* Bt; int M, N, K; };

struct StaticOrder {
    int nM, nN, nwg, G, c;
    __host__ __device__ void init(int M, int N, int G_, int c_) { nM = M / BM; nN = N / BM; nwg = nM * nN; G = G_; c = c_; }
    __host__ __device__ bool next(int i, Unit& u) const {
        const long L = (long)i * G + c; if (L >= nwg) return false;
        int wgid = (int)L; { const int q = nwg / NXCD, r = nwg % NXCD, xcd = wgid % NXCD, off = wgid / NXCD; wgid = (xcd < r ? xcd * (q + 1) : r * (q + 1) + (xcd - r) * q) + off; }
        const int nig = WGM * nN, gid = wgid / nig, fm = gid * WGM, gsz = (nM - fm) < WGM ? (nM - fm) : WGM;
        u.pm = fm + ((wgid % nig) % gsz); u.pn = (wgid % nig) / gsz; return true;
    }
    __device__ __forceinline__ void a_ready(const Unit&) const {}
    __device__ __forceinline__ void done(const Unit&) const {}
};

__device__ __forceinline__ unsigned cvt_pk_bf16(float lo, float hi) { unsigned r; asm volatile("v_cvt_pk_bf16_f32 %0, %1, %2" : "=v"(r) : "v"(lo), "v"(hi)); return r; }
typedef float f32x2 __attribute__((ext_vector_type(2)));
__device__ __forceinline__ f32x2 gelu_pk(f32x2 v) { return v; }
template <int ACT  > struct EpiBf16 {
    static constexpr bool PERM = true, AFTER_DRAIN = false;
    bf16_t* O; int ldc; const float* bias; int split_cols; size_t split_stride;
    __device__ __forceinline__ void operator()(const f32x4 (&acc)[2][2][4][2], const Unit& u, int wr, int wc, int fr, int fq) const {
        const int row0 = u.pm * BM + wr * 64 + fr; int colt = u.pn * BM; bf16_t* base = O;
        if (split_cols) { const int t = colt / split_cols; base += (size_t)t * split_stride; colt -= t * split_cols; }
        const int col0 = colt + wc * 32 + 8 * fq, bcol0 = u.pn * BM + wc * 32 + 8 * fq;
        f32x4 bv[2][2];
#pragma unroll
        for (int bj = 0; bj < 2; ++bj)
#pragma unroll
            for (int n = 0; n < 2; ++n) bv[bj][n] = bias ? *(const f32x4*)(bias + bcol0 + bj * HALF + 4 * n) : (f32x4){0.f, 0.f, 0.f, 0.f};
#pragma unroll
        for (int ai = 0; ai < 2; ++ai)
#pragma unroll
            for (int m = 0; m < 4; ++m) { bf16_t* rowp = base + (size_t)(row0 + ai * HALF + m * 16) * ldc + col0;
#pragma unroll
                for (int bj = 0; bj < 2; ++bj) { f32x4 v0 = acc[ai][bj][m][0] + bv[bj][0], v1 = acc[ai][bj][m][1] + bv[bj][1];
                    if (ACT == 1) { f32x2 a = gelu_pk((f32x2){v0[0], v0[1]}), b = gelu_pk((f32x2){v0[2], v0[3]}), c = gelu_pk((f32x2){v1[0], v1[1]}), d = gelu_pk((f32x2){v1[2], v1[3]});
                        v0 = (f32x4){a.x, a.y, b.x, b.y}; v1 = (f32x4){c.x, c.y, d.x, d.y}; }
                    if (ACT == 2) {
#pragma unroll
                        for (int j = 0; j < 4; ++j) { v0[j] = 0.5f * v0[j] * (1.0f + erff(v0[j] * 0.70710678f)); v1[j] = 0.5f * v1[j] * (1.0f + erff(v1[j] * 0.70710678f)); } }
                    u32x4 w; w.x = cvt_pk_bf16(v0[0], v0[1]); w.y = cvt_pk_bf16(v0[2], v0[3]); w.z = cvt_pk_bf16(v1[0], v1[1]); w.w = cvt_pk_bf16(v1[2], v1[3]);
                    *(u32x4*)(rowp + bj * HALF) = w; } }
    }
};

template <class Epi, class Sched, bool STAMP = false>
__device__ __forceinline__ void gemm_phase(int wv, PG8_LAS unsigned char* lds, const Gemm g, const Sched& S, const Epi& E, unsigned long long* stamps) {
    const int tid = otid(wv), wid = __builtin_amdgcn_readfirstlane(tid >> 6), lane = tid & 63, wr = wid >> 2, wc = wid & 3, fr = lane & 15, fq = lane >> 4;
    const int K = g.K, nt = K / BK;
    int ts_lo = 0, ts_hi = 0, nts = 0; const unsigned long long rt_entry = STAMP ? (unsigned long long)wall_clock64() : 0ull;
#define PG8_STAMP() do { if (STAMP && wid == 0 && nts < 64) { const unsigned long long _c = (unsigned long long)clock64(); \
        ts_lo = (lane == nts) ? (int)(unsigned)_c : ts_lo; ts_hi = (lane == nts) ? (int)(unsigned)(_c >> 32) : ts_hi; ++nts; } } while (0)
    PG8_STAMP();
    unsigned voffA[2], voffB[2];
#pragma unroll
    for (int i = 0; i < 2; ++i) { int R, C; stage_rc(tid * 16 + i * 8192, R, C); const int Rb = Epi::PERM ? ((R & ~31) + perm32(R & 31)) : R;
        voffA[i] = (unsigned)(R * K + C) * 2u; voffB[i] = (unsigned)(Rb * K + C) * 2u; }
    const size_t kstep = (size_t)(BK * 2);
    const size_t hstep = (size_t)HALF * K * 2;
    const size_t tstep = 2 * hstep;
    const unsigned ldsw = (unsigned)wid * 1024u;
    const int aoff = lds_byte(wr * 64 + fr, fq * 8), boff = lds_byte(wc * 32 + fr, fq * 8);
#define PG8_SA(b, h) (((b) * 2 + (h)) * HTB)
#define PG8_SB(b, h) ((4 + (b) * 2 + (h)) * HTB)
#define PG8_STAGE(bufoff, gbase, voff) do { _Pragma("unroll") for (int _i = 0; _i < 2; ++_i) \
        __builtin_amdgcn_global_load_lds((const unsigned*)((const char*)(gbase) + (voff)[_i]), (PG8_LAS unsigned*)(lds + (bufoff) + ldsw + _i * 8192), 16, 0, 0); } while (0)
#define PG8_LDA(dst, b, h) do { _Pragma("unroll") for (int m = 0; m < 4; ++m) _Pragma("unroll") for (int k = 0; k < 2; ++k) dst[m][k] = *(const PG8_LAS bf16x8*)(lds + PG8_SA(b, h) + aoff + m * 2048 + k * 1024); } while (0)
#define PG8_LDB(dst, b, h) do { _Pragma("unroll") for (int n = 0; n < 2; ++n) _Pragma("unroll") for (int k = 0; k < 2; ++k) dst[n][k] = *(const PG8_LAS bf16x8*)(lds + PG8_SB(b, h) + boff + n * 2048 + k * 1024); } while (0)
#define PG8_MMA(ai, bj, At, Bt) do { __builtin_amdgcn_s_setprio(1); _Pragma("unroll") for (int m = 0; m < 4; ++m) _Pragma("unroll") for (int n = 0; n < 2; ++n) _Pragma("unroll") for (int k = 0; k < 2; ++k) \
        acc[ai][bj][m][n] = __builtin_amdgcn_mfma_f32_16x16x32_bf16(Bt[n][k], At[m][k], acc[ai][bj][m][n], 0, 0, 0); __builtin_amdgcn_s_setprio(0); } while (0)
#define PG8_WAIT_V(n) asm volatile("s_waitcnt vmcnt(" #n ")" ::: "memory")
#define PG8_WAIT_L(n) asm volatile("s_waitcnt lgkmcnt(" #n ")" ::: "memory")
#define PG8_BAR __builtin_amdgcn_s_barrier()
#define PG8_SCHED __builtin_amdgcn_sched_barrier(0)
    Unit cur, nxt; int ui = 0;
    if (!S.next(0, cur)) return;
    f32x4 acc[2][2][4][2];
#pragma unroll
    for (int a = 0; a < 2; ++a)
#pragma unroll
        for (int b = 0; b < 2; ++b)
#pragma unroll
            for (int m = 0; m < 4; ++m)
#pragma unroll
                for (int n = 0; n < 2; ++n) acc[a][b][m][n] = (f32x4){0.f, 0.f, 0.f, 0.f};
    bf16x8 At[4][2], B0[2][2], B1[2][2];
    const char* cA = (const char*)g.A + (size_t)cur.pm * tstep; const char* cB = (const char*)g.Bt + (size_t)cur.pn * tstep;
    S.a_ready(cur);
    PG8_STAGE(PG8_SB(0, 0), cB, voffB); PG8_STAGE(PG8_SA(0, 0), cA, voffA); PG8_STAGE(PG8_SB(0, 1), cB + hstep, voffB); PG8_STAGE(PG8_SA(0, 1), cA + hstep, voffA);
    if (wr == 1) PG8_BAR;
    PG8_WAIT_V(4); PG8_BAR;
    PG8_STAGE(PG8_SB(1, 0), cB + kstep, voffB); PG8_STAGE(PG8_SA(1, 0), cA + kstep, voffA); PG8_STAGE(PG8_SB(1, 1), cB + hstep + kstep, voffB);
    PG8_WAIT_V(6); PG8_BAR;
    PG8_STAMP();
    for (;;) {
        const bool has_next = S.next(ui + 1, nxt);
        const char* nA = has_next ? (const char*)g.A + (size_t)nxt.pm * tstep : cA; const char* nB = has_next ? (const char*)g.Bt + (size_t)nxt.pn * tstep : cB;
        for (int t = 0; t < nt; t += 2) {
            const bool last = (t == nt - 2);
            const char* a1 = cA + (size_t)(t + 1) * kstep;
            const char* a2 = last ? nA : cA + (size_t)(t + 2) * kstep; const char* b2 = last ? nB : cB + (size_t)(t + 2) * kstep;
            const char* a3 = a2 + kstep; const char* b3 = b2 + kstep;
            if (last && has_next) S.a_ready(nxt);
            PG8_LDB(B0, 0, 0); PG8_SCHED; PG8_LDA(At, 0, 0); PG8_STAGE(PG8_SA(1, 1), a1 + hstep, voffA);
            PG8_WAIT_L(8); PG8_BAR; PG8_WAIT_L(0); PG8_MMA(0, 0, At, B0); PG8_BAR; PG8_SCHED;
            PG8_LDB(B1, 0, 1); PG8_STAGE(PG8_SB(0, 0), b2, voffB);
            PG8_BAR; PG8_WAIT_L(0); PG8_MMA(0, 1, At, B1); PG8_BAR;
            PG8_LDA(At, 0, 1); PG8_STAGE(PG8_SA(0, 0), a2, voffA);
            PG8_BAR; PG8_WAIT_L(0); PG8_MMA(1, 0, At, B0); PG8_BAR; PG8_SCHED;
            PG8_STAGE(PG8_SB(0, 1), b2 + hstep, voffB);
            PG8_WAIT_V(6); PG8_BAR; PG8_MMA(1, 1, At, B1); PG8_BAR;
            PG8_LDB(B0, 1, 0); PG8_SCHED; PG8_LDA(At, 1, 0); PG8_STAGE(PG8_SA(0, 1), a2 + hstep, voffA);
            PG8_WAIT_L(8); PG8_BAR; PG8_WAIT_L(0); PG8_MMA(0, 0, At, B0); PG8_BAR; PG8_SCHED;
            PG8_LDB(B1, 1, 1); PG8_STAGE(PG8_SB(1, 0), b3, voffB);
            PG8_BAR; PG8_WAIT_L(0); PG8_MMA(0, 1, At, B1); PG8_BAR;
            PG8_LDA(At, 1, 1); PG8_STAGE(PG8_SA(1, 0), a3, voffA);
            PG8_BAR; PG8_WAIT_L(0); PG8_MMA(1, 0, At, B0); PG8_BAR; PG8_SCHED;
            PG8_STAGE(PG8_SB(1, 1), b3 + hstep, voffB);
            PG8_WAIT_V(6); PG8_BAR; PG8_MMA(1, 1, At, B1); PG8_BAR;
        }
        PG8_STAMP();
        if constexpr (!Epi::AFTER_DRAIN) { E(acc, cur, wr, wc, fr, fq); S.done(cur); }
        PG8_STAMP();
        if (!has_next) break;
#pragma unroll
        for (int a = 0; a < 2; ++a)
#pragma unroll
            for (int b = 0; b < 2; ++b)
#pragma unroll
                for (int m = 0; m < 4; ++m)
#pragma unroll
                    for (int n = 0; n < 2; ++n) acc[a][b][m][n] = (f32x4){0.f, 0.f, 0.f, 0.f};
        cur = nxt; cA = nA; cB = nB; ++ui;
    }
    PG8_WAIT_V(0);
    if (wr == 0) PG8_BAR;
    PG8_BAR;
    if constexpr (Epi::AFTER_DRAIN) { E.fused(acc, cur, wr, wc, fr, fq, lds, wid, lane); S.done(cur); }
    PG8_STAMP();
    if (STAMP && wid == 0) { stamps[lane] = lane < nts ? (((unsigned long long)(unsigned)ts_hi << 32) | (unsigned)ts_lo) : 0ull;
        if (lane == 62) stamps[62] = rt_entry; if (lane == 63) stamps[63] = (unsigned long long)wall_clock64(); }
#undef PG8_STAMP
#undef PG8_SA
#undef PG8_SB
#undef PG8_STAGE
#undef PG8_LDA
#undef PG8_LDB
#undef PG8_MMA
#undef PG8_WAIT_V
#undef PG8_WAIT_L
#undef PG8_BAR
#undef PG8_SCHED
}
}

#define XB_TMO      128
#define XB_XCNT(j)  (256  + 64 * (j))
#define XB_XSUB(j)  (1280 + 64 * (j))
#define XB_XGEN(j)  (2304 + 64 * (j))
#define XB_TOP      3328
#define XB_TOPGEN   3392
#define XCD_BAR_WORDS 3456
#define XB_SPIN_CAP (1u << 27)
#define LAS __attribute__((address_space(3)))

__device__ __forceinline__ unsigned xb_ld(unsigned* p)              { return __hip_atomic_load(p, __ATOMIC_RELAXED, __HIP_MEMORY_SCOPE_AGENT); }
__device__ __forceinline__ unsigned xb_add(unsigned* p, unsigned v) { return __hip_atomic_fetch_add(p, v, __ATOMIC_RELAXED, __HIP_MEMORY_SCOPE_AGENT); }
__device__ __forceinline__ unsigned xb_xcc_id() { return (unsigned)__builtin_amdgcn_s_getreg((3 << 11) | 20) & 0xFu; }
#define XB_SPIN(cond, bar) do { unsigned _sp = 0; while (cond) { __builtin_amdgcn_s_sleep(1); \
    if ((++_sp & 255u) == 0u) { if (xb_ld(&(bar)[XB_TMO])) break; if (_sp > XB_SPIN_CAP) { atomicAdd(&(bar)[XB_TMO], 1u); break; } } } } while (0)

struct XcdBarrier {
    unsigned* bar; unsigned x;
    volatile LAS unsigned* st;
};

__device__ __forceinline__ XcdBarrier xcd_barrier_post(unsigned* bar, volatile LAS unsigned* st, bool xb_t0) {
    XcdBarrier b; b.bar = bar; b.x = xb_xcc_id(); b.st = st;
    if (xb_t0) (void)xb_add(&bar[XB_XCNT(b.x)], 1u);
    return b;
}
__device__ __forceinline__ void xcd_barrier_complete(unsigned* bar, unsigned x, unsigned& nloc, unsigned& nx) {
    const unsigned G = gridDim.x * gridDim.y * gridDim.z;
    unsigned sum, cnt, mine, sp = 0u;
    for (;;) {
        sum = 0u; cnt = 0u; mine = 0u;
#pragma unroll
        for (unsigned j = 0; j < 16; ++j) { const unsigned c = xb_ld(&bar[XB_XCNT(j)]); sum += c; cnt += (c > 0u) ? 1u : 0u; mine = (j == x) ? c : mine; }
        if (sum == G) break;
        __builtin_amdgcn_s_sleep(1);
        if ((++sp & 255u) == 0u) { if (xb_ld(&bar[XB_TMO])) break; if (sp > XB_SPIN_CAP) { atomicAdd(&bar[XB_TMO], 1u); break; } }
    }
    nloc = mine > 0u ? mine : 1u; nx = cnt > 0u ? cnt : 1u;
}

__device__ __forceinline__ void xcd_barrier(const XcdBarrier& b, bool xb_t0) {
    asm volatile("s_waitcnt vmcnt(0)" ::: "memory");
    __syncthreads();
    if (xb_t0) {
        unsigned* bar = b.bar;
        __builtin_amdgcn_s_waitcnt(0);
        unsigned nloc = b.st[0], nx = b.st[1];
        if (nloc == 0u) { xcd_barrier_complete(bar, b.x, nloc, nx); b.st[0] = nloc; b.st[1] = nx; }
        const unsigned old = xb_add(&bar[XB_XSUB(b.x)], 1u);
        const unsigned gen = old / nloc;
        if (old + 1u == (gen + 1u) * nloc) {
            __builtin_amdgcn_fence(__ATOMIC_RELEASE, "agent");
            asm volatile("s_waitcnt vmcnt(0)" ::: "memory");
            const unsigned og = xb_add(&bar[XB_TOP], 1u);
            const unsigned tg = og / nx;
            if (og + 1u == (tg + 1u) * nx) xb_add(&bar[XB_TOPGEN], 1u);
            else XB_SPIN(xb_ld(&bar[XB_TOPGEN]) == tg, bar);
            __builtin_amdgcn_fence(__ATOMIC_ACQUIRE, "agent");
            xb_add(&bar[XB_XGEN(b.x)], 1u);
            asm volatile("s_waitcnt vmcnt(0)" ::: "memory");
        } else {
            XB_SPIN(xb_ld(&bar[XB_XGEN(b.x)]) == gen, bar);
            __builtin_amdgcn_fence(__ATOMIC_ACQUIRE, "agent");
            asm volatile("s_waitcnt vmcnt(0)" ::: "memory");
        }
    }
    __syncthreads();
}


__device__ void ph_transpose(int wv, const float* __restrict__ src, bf16_t* __restrict__ dst, int K, int N, int Npad,
                             int col0, int skip_from, int skip, int nvalid, float* tile, int bid, int nb) {
  const int tk = K / 32, tn = Npad / 32;
  const int t5 = otid(wv) & 255;
  const int tx = t5 & 31, ty = t5 >> 5;
  for (int t = bid; t < tk * tn; t += nb) {
    const int kt = t / tn, nt = t % tn;
    __syncthreads();
    for (int i = ty; i < 32; i += 8) {
      const int k = kt * 32 + i, n = nt * 32 + tx;
      const int cc = col0 + n + (n >= skip_from ? skip : 0);
      tile[i * 33 + tx] = (n < nvalid) ? src[(size_t)k * N + cc] : 0.f;
    }
    __syncthreads();
    for (int i = ty; i < 32; i += 8) {
      const int n = nt * 32 + i, k = kt * 32 + tx;
      dst[(size_t)n * K + k] = f2bf(tile[tx * 33 + i]);
    }
  }
}

__device__ void ph_mod(int wv, const Params& P, float* sm, int bid, int nb) {
  const int tid = otid(wv) & 255;
  float* sv = sm;
  float* red = sm + 5 * 1024;
  for (int i = tid; i < 5 * 1024; i += 256) {
    const float v = (i < 4096) ? P.c[i] : P.c_ctx[i - 4096];
    sv[i] = silu_f(v);
  }
  __syncthreads();
  const int col = tid & 31, kg = tid >> 5;
  for (int it = bid; it < 384; it += nb) {
    const int layer = it / 192, cb = it % 192;
    const float* W = P.ada_w + (size_t)layer * 1024 * MODW + cb * 32 + col;
    float a0 = 0, a1 = 0, a2 = 0, a3 = 0, a4 = 0;
    for (int k = kg * 128; k < kg * 128 + 128; ++k) {
      const float w = W[(size_t)k * MODW];
      a0 += sv[k] * w; a1 += sv[1024 + k] * w; a2 += sv[2048 + k] * w; a3 += sv[3072 + k] * w; a4 += sv[4096 + k] * w;
    }
    float* r = red + (kg * 32 + col) * 5;
    r[0] = a0; r[1] = a1; r[2] = a2; r[3] = a3; r[4] = a4;
    __syncthreads();
    if (tid < 160) {
      const int rr = tid >> 5, cc = tid & 31;
      float s = 0;
      for (int g = 0; g < 8; ++g) s += red[(g * 32 + cc) * 5 + rr];
      P.mod()[(size_t)(layer * 5 + rr) * MODW + cb * 32 + cc] = s + P.ada_b[layer * MODW + cb * 32 + cc];
    }
    __syncthreads();
  }
}

__device__ void ph_norm(int wv, const float* hl, const float* hc, const float* __restrict__ g, const float* __restrict__ modl,
                        int shift_off, int scale_off, int nrows, bf16_t* __restrict__ dst, int bid, int nb) {
  const int wave = otid(wv) >> 6, lane = otid(wv) & 63;
  for (int row = bid * NWAVE + wave; row < nrows; row += nb * NWAVE) {
    const float* src = hrow(hl, hc, row);
    const float* mr = modl + (size_t)modrow(row) * MODW;
    float4 v[4];
    float ss = 0.f;
#pragma unroll
    for (int i = 0; i < 4; ++i) {
      v[i] = ((const float4*)src)[i * 64 + lane];
      ss += v[i].x * v[i].x + v[i].y * v[i].y + v[i].z * v[i].z + v[i].w * v[i].w;
    }
    ss = wave_sum(ss);
    const float rstd = rsqrtf(ss * (1.f / 1024.f) + 1e-6f);
#pragma unroll
    for (int i = 0; i < 4; ++i) {
      const int idx = i * 256 + lane * 4;
      const float4 gg = *(const float4*)(g + idx);
      const float4 sc = *(const float4*)(mr + scale_off + idx);
      const float4 sh = *(const float4*)(mr + shift_off + idx);
      const float o0 = v[i].x * rstd * gg.x * (1.f + sc.x) + sh.x;
      const float o1 = v[i].y * rstd * gg.y * (1.f + sc.y) + sh.y;
      const float o2 = v[i].z * rstd * gg.z * (1.f + sc.z) + sh.z;
      const float o3 = v[i].w * rstd * gg.w * (1.f + sc.w) + sh.w;
      uint2 pk;
      pk.x = (uint32_t)f2bf(o0) | ((uint32_t)f2bf(o1) << 16);
      pk.y = (uint32_t)f2bf(o2) | ((uint32_t)f2bf(o3) << 16);
      *(uint2*)(dst + (size_t)row * DM + idx) = pk;
    }
  }
}

enum { EPI_INPROJ = 0, EPI_OUTPROJ = 1, EPI_Q = 2 };

template <int EPI>
__device__ void ph_gemm(int wv, const Params& P, int layer, const bf16_t* __restrict__ A, const bf16_t* __restrict__ Bt, int M,
                        int Npad, int K, const float* hl, const float* hc, char* smem, int bid, int nb) {
  bf16_t* sA = (bf16_t*)smem;
  bf16_t* sB = sA + 128 * 72;
  const int tid = otid(wv) & 255, lane = tid & 63, wave = tid >> 6;
  const int wr = wave >> 1, wc = wave & 1;
  const int tiles_m = M / 128, tiles_n = Npad / 128;
  const int l15 = lane & 15, l4 = lane >> 4;
  for (int tile = bid; tile < tiles_m * tiles_n; tile += nb) {
    const int tn = tile / tiles_m, tm = tile % tiles_m;
    f32x4 acc[4][4];
#pragma unroll
    for (int i = 0; i < 4; ++i)
#pragma unroll
      for (int j = 0; j < 4; ++j) acc[i][j] = (f32x4){0.f, 0.f, 0.f, 0.f};
    for (int k0 = 0; k0 < K; k0 += 64) {
      __syncthreads();
#pragma unroll
      for (int i = 0; i < 4; ++i) {
        const int idx = i * 256 + tid;
        const int r = idx >> 3, sg = idx & 7;
        const uint4 va = *(const uint4*)(A + (size_t)(tm * 128 + r) * K + k0 + sg * 8);
        *(uint4*)(sA + r * 72 + sg * 8) = va;
        const uint4 vb = *(const uint4*)(Bt + (size_t)(tn * 128 + r) * K + k0 + sg * 8);
        *(uint4*)(sB + r * 72 + sg * 8) = vb;
      }
      __syncthreads();
#pragma unroll
      for (int kk = 0; kk < 2; ++kk) {
        bf16x8 af[4], bfr[4];
#pragma unroll
        for (int i = 0; i < 4; ++i) af[i] = *(const bf16x8*)(sA + (wr * 64 + i * 16 + l15) * 72 + kk * 32 + l4 * 8);
#pragma unroll
        for (int j = 0; j < 4; ++j) bfr[j] = *(const bf16x8*)(sB + (wc * 64 + j * 16 + l15) * 72 + kk * 32 + l4 * 8);
#pragma unroll
        for (int i = 0; i < 4; ++i)
#pragma unroll
          for (int j = 0; j < 4; ++j) acc[i][j] = __builtin_amdgcn_mfma_f32_16x16x32_bf16(af[i], bfr[j], acc[i][j], 0, 0, 0);
      }
    }
#pragma unroll
    for (int i = 0; i < 4; ++i)
#pragma unroll
      for (int j = 0; j < 4; ++j)
#pragma unroll
        for (int e = 0; e < 4; ++e) {
          const int row = tm * 128 + wr * 64 + i * 16 + l4 * 4 + e;
          const int col = tn * 128 + wc * 64 + j * 16 + l15;
          const float v = acc[i][j][e];
          if (EPI == EPI_INPROJ) {
            if (col < 32) P.dtraw()[(size_t)row * 32 + col] = v;
          } else if (EPI == EPI_OUTPROJ) {
            const float* src = hrow(hl, hc, row);
            const float gate = P.mod()[(size_t)(layer * 5 + modrow(row)) * MODW + 2048 + col];
            P.h()[(size_t)row * DM + col] = src[col] + gate * v;
          } else {
            P.q()[(size_t)row * 2048 + col] = f2bf(v);
          }
        }
  }
}

__device__ void ph_conv(int wv, const Params& P, int layer, int bid, int nb) {
  const float* cw = P.conv_w + (size_t)layer * 3 * 1536;
  const float* cb = P.conv_b + (size_t)layer * 1536;
  const int total = NTOK * 64;
  for (int it = bid * NTHR + otid(wv); it < total; it += nb * NTHR) {
    const int row = it >> 6, c8 = 1024 + (it & 63) * 8;
    int l, L;
    if (row < NLAT) { l = row & 4095; L = 4096; } else { l = (row - NLAT) & 255; L = 256; }
    const bf16_t* pc = P.p() + (size_t)row * PW + OFF_XBC + c8;
    uint4 cur = *(const uint4*)pc;
    uint4 prv = make_uint4(0, 0, 0, 0), nxt = make_uint4(0, 0, 0, 0);
    if (l > 0) prv = *(const uint4*)(pc - PW);
    if (l < L - 1) nxt = *(const uint4*)(pc + PW);
    const bf16_t* c_ = (const bf16_t*)&cur;
    const bf16_t* p_ = (const bf16_t*)&prv;
    const bf16_t* n_ = (const bf16_t*)&nxt;
    uint4 o;
    bf16_t* o_ = (bf16_t*)&o;
#pragma unroll
    for (int e = 0; e < 8; ++e) {
      const int c = c8 + e;
      const float v = cb[c] + cw[c] * bf2f(p_[e]) + cw[1536 + c] * bf2f(c_[e]) + cw[3072 + c] * bf2f(n_[e]);
      o_[e] = f2bf(silu_f(v));
    }
    *(uint4*)(P.xbc() + (size_t)row * 512 + c8 - 1024) = o;
  }
}

__device__ void ph_ssdprep(int wv, const Params& P, int layer, char* smem, int bid, int nb) {
  const int tid = otid(wv), dh = tid & 31, seg = tid >> 5;
  float* segtot = (float*)smem;
  const float bias = P.dt_bias[layer * 32 + dh];
  const float ah = -expf(P.a_log[layer * 32 + dh]);
  for (int gc = bid; gc < NCHUNK; gc += nb) {
    const size_t base = (size_t)(gc * 128 + seg * 8) * 32 + dh;
    float r[8], c[8];
#pragma unroll
    for (int j = 0; j < 8; ++j) r[j] = P.dtraw()[base + (size_t)j * 32];
    float cs = 0.f;
#pragma unroll
    for (int j = 0; j < 8; ++j) { r[j] = softplus_f(r[j] + bias); cs += r[j] * ah; c[j] = cs; }
    __syncthreads();
    segtot[seg * 32 + dh] = cs;
    __syncthreads();
    float off = 0.f;
    for (int s = 0; s < seg; ++s) off += segtot[s * 32 + dh];
#pragma unroll
    for (int j = 0; j < 8; ++j) { P.dtv()[base + (size_t)j * 32] = r[j]; P.csv()[base + (size_t)j * 32] = off + c[j]; }
  }
}

__device__ void ph_states(int wv, const Params& P, char* smem, int bid, int nb) {
  float* wx = (float*)smem;
  bf16_t* Bm = (bf16_t*)(smem + 128 * 64 * 4);
  const int tid = otid(wv);
  const int n = tid & 127, pg = (tid >> 7) & 1;
  for (int it = bid; it < NCHUNK * 32; it += nb) {
    const int gc = it >> 5, dh = it & 31, dir = dh >> 4, head = dh & 15, g = head >> 3;
    const int row0 = gc * 128;
    __syncthreads();
    const float at = P.csv()[(size_t)(row0 + 127) * 32 + dh];
    for (int i = tid; i < 128 * 64; i += NTHR) {
      const int j = i >> 6, pp = i & 63, row = row0 + j;
      const float cs = P.csv()[(size_t)row * 32 + dh], dt = P.dtv()[(size_t)row * 32 + dh];
      float w;
      if (dir == 0) w = expf(at - cs);
      else w = expf(j > 0 ? P.csv()[(size_t)(row - 1) * 32 + dh] : 0.f);
      wx[i] = bf2f(P.xbc()[(size_t)row * 1536 + head * 64 + pp]) * dt * w;
    }
    for (int i = tid; i < 128 * 128; i += NTHR) {
      const int j = i >> 7, nn = i & 127;
      Bm[i] = P.xbc()[(size_t)(row0 + j) * 1536 + 1024 + g * 128 + nn];
    }
    __syncthreads();
    float acc[32];
#pragma unroll
    for (int i = 0; i < 32; ++i) acc[i] = 0.f;
    for (int j = 0; j < 128; ++j) {
      const float b = bf2f(Bm[j * 128 + n]);
#pragma unroll
      for (int i = 0; i < 32; ++i) acc[i] += wx[j * 64 + pg * 32 + i] * b;
    }
    bf16_t* dst = P.states() + (size_t)it * 8192;
#pragma unroll
    for (int i = 0; i < 32; ++i) dst[(pg * 32 + i) * 128 + n] = f2bf(acc[i]);
  }
}

__device__ void ph_scan(int wv, const Params& P, int bid, int nb) {
  const int total = 4 * 32 * 8192;
  for (int it = bid * NTHR + otid(wv); it < total; it += nb * NTHR) {
    const int e = it & 8191, dh = (it >> 13) & 31, b = it >> 18, dir = dh >> 4;
    float S = 0.f;
    for (int s = 0; s < 34; ++s) {
      int gc;
      if (dir == 0) gc = (s < 2) ? (128 + 2 * b + s) : (32 * b + (s - 2));
      else gc = (s < 2) ? (128 + 2 * b + 1 - s) : (32 * b + 31 - (s - 2));
      bf16_t* ptr = P.states() + (size_t)(gc * 32 + dh) * 8192 + e;
      const float cstate = bf2f(*ptr);
      *ptr = f2bf(S);
      const float at = P.csv()[(size_t)(gc * 128 + 127) * 32 + dh];
      S = expf(at) * S + cstate;
    }
  }
}

__device__ void ph_ssdy(int wv, const Params& P, int layer, int nchunks, char* smem, int bid, int nb) {
  bf16_t* Cm = (bf16_t*)smem;
  bf16_t* Gm = Cm + 128 * 130;
  char* R = (char*)(Gm + 128 * 130);
  bf16_t* Bm = (bf16_t*)R;
  float* xd = (float*)R;
  bf16_t* Sm = (bf16_t*)(R + 128 * 130 * 2);
  float* csl = (float*)(Sm + 64 * 130);
  float* exl = csl + 128;
  const int tid = otid(wv);
  for (int it = bid; it < nchunks * 16; it += nb) {
    const int gc = it >> 4, head = it & 15, g = head >> 3;
    const int row0 = gc * 128;
    __syncthreads();
    for (int i = tid; i < 128 * 128; i += NTHR) {
      const int j = i >> 7, nn = i & 127;
      const bf16_t* xr = P.xbc() + (size_t)(row0 + j) * 1536 + 1024 + g * 128 + nn;
      Bm[j * 130 + nn] = xr[0];
      Cm[j * 130 + nn] = xr[256];
    }
    __syncthreads();
    {
      const int s = tid & 127, jh = (tid >> 7) & 1;
      for (int jb = 0; jb < 2; ++jb) {
        float acc[32];
#pragma unroll
        for (int i = 0; i < 32; ++i) acc[i] = 0.f;
        for (int nn = 0; nn < 128; ++nn) {
          const float b = bf2f(Bm[s * 130 + nn]);
#pragma unroll
          for (int i = 0; i < 32; ++i) acc[i] += bf2f(Cm[(jh * 64 + jb * 32 + i) * 130 + nn]) * b;
        }
#pragma unroll
        for (int i = 0; i < 32; ++i) Gm[(jh * 64 + jb * 32 + i) * 130 + s] = f2bf(acc[i]);
      }
    }
    const int pp = tid & 63, jg0 = (tid >> 6) & 3;
#pragma unroll 1
    for (int jpass = 0; jpass < 2; ++jpass) {
    const int jg = jg0 * 2 + jpass;
    float yacc[16];
#pragma unroll
    for (int i = 0; i < 16; ++i) yacc[i] = 0.f;
#pragma unroll 1
    for (int dir = 0; dir < 2; ++dir) {
      const int dh = dir * 16 + head;
      __syncthreads();
      for (int i = tid; i < 128 * 64; i += NTHR) {
        const int j = i >> 6, p2 = i & 63, row = row0 + j;
        xd[i] = bf2f(P.xbc()[(size_t)row * 1536 + head * 64 + p2]) * P.dtv()[(size_t)row * 32 + dh];
      }
      const bf16_t* st = P.states() + (size_t)(gc * 32 + dh) * 8192;
      for (int i = tid; i < 64 * 128; i += NTHR) Sm[(i >> 7) * 130 + (i & 127)] = st[i];
      if (tid < 128) {
        const float cs = P.csv()[(size_t)(row0 + tid) * 32 + dh];
        csl[tid] = cs;
        exl[tid] = tid > 0 ? P.csv()[(size_t)(row0 + tid - 1) * 32 + dh] : 0.f;
      }
      __syncthreads();
      const float atot = csl[127];
      for (int s = 0; s < 128; ++s) {
        const float xv = xd[s * 64 + pp];
        const float cs_s = csl[s], ex_s = exl[s];
#pragma unroll
        for (int i = 0; i < 16; ++i) {
          const int j = jg * 16 + i;
          if (dir == 0) {
            if (s <= j) yacc[i] += bf2f(Gm[j * 130 + s]) * expf(csl[j] - cs_s) * xv;
          } else {
            if (s >= j) yacc[i] += bf2f(Gm[j * 130 + s]) * expf(ex_s - exl[j]) * xv;
          }
        }
      }
      float offacc[16];
#pragma unroll
      for (int i = 0; i < 16; ++i) offacc[i] = 0.f;
      for (int nn = 0; nn < 128; ++nn) {
        const float sv = bf2f(Sm[pp * 130 + nn]);
#pragma unroll
        for (int i = 0; i < 16; ++i) offacc[i] += bf2f(Cm[(jg * 16 + i) * 130 + nn]) * sv;
      }
#pragma unroll
      for (int i = 0; i < 16; ++i) {
        const int j = jg * 16 + i;
        const float sc = dir == 0 ? expf(csl[j]) : expf(atot - exl[j]);
        yacc[i] += offacc[i] * sc;
      }
    }
    const float dsk = P.d_skip[layer * 16 + head];
#pragma unroll
    for (int i = 0; i < 16; ++i) {
      const int row = row0 + jg * 16 + i;
      const float xs = bf2f(P.xbc()[(size_t)row * 1536 + head * 64 + pp]);
      const float z = bf2f(P.p()[(size_t)row * PW + OFF_Z + head * 64 + pp]);
      const float y = (yacc[i] + dsk * xs) * silu_f(z);
      P.concat()[(size_t)row * 2048 + head * 64 + pp] = f2bf(y);
    }
    }
  }
}


__device__ __forceinline__ void conv_x8(const Params& P, int layer, int row, int ch0, float* out) {
  int l, L;
  if (row < NLAT) { l = row & 4095; L = 4096; } else { l = (row - NLAT) & 255; L = 256; }
  const bf16_t* pc = P.p() + (size_t)row * PW + OFF_XBC + ch0;
  const uint4 cur = *(const uint4*)pc;
  uint4 prv = make_uint4(0, 0, 0, 0), nxt = make_uint4(0, 0, 0, 0);
  if (l > 0) prv = *(const uint4*)(pc - PW);
  if (l < L - 1) nxt = *(const uint4*)(pc + PW);
  float fp[8], fc[8], fn[8];
  unpack8(prv, fp); unpack8(cur, fc); unpack8(nxt, fn);
  const float* cw = P.conv_w + (size_t)layer * 3 * 1536 + ch0;
  const float* cb = P.conv_b + (size_t)layer * 1536 + ch0;
#pragma unroll
  for (int e = 0; e < 8; ++e) out[e] = silu_f(cb[e] + cw[e] * fp[e] + cw[1536 + e] * fc[e] + cw[3072 + e] * fn[e]);
}

constexpr int XS = 72;
constexpr int BS = 136;

__device__ void ph_states_mfma(int wv, const Params& P, int layer, char* smem, int bid, int nb) {
  char* XW = smem;
  char* Bm = smem + 2 * 128 * XS * 2;
  const int tid = otid(wv), lane = tid & 63, li = lane & 15, g = lane >> 4;
  const int dir = wv >> 2, pb = wv & 3;
  for (int it = bid; it < NCHUNK * 16; it += nb) {
    const int gc = it >> 4, head = it & 15, grp = head >> 3;
    const int row0 = gc * 128;
    __syncthreads();
#pragma unroll
    for (int i = 0; i < 2; ++i) {
      const int idx = tid + i * 512, j = idx >> 3, seg = idx & 7, row = row0 + j;
      float xv[8];
      conv_x8(P, layer, row, head * 64 + seg * 8, xv);
      const float* cs = P.csv() + (size_t)row * 32;
      const float* dt = P.dtv() + (size_t)row * 32;
      const float at_f = P.csv()[(size_t)(row0 + 127) * 32 + head];
      const float wf = expf(at_f - cs[head]) * dt[head];
      const float wb = expf(j > 0 ? cs[16 + head - 32] : 0.f) * dt[16 + head];
      uint4 of, ob;
      of.x = pack2(xv[0] * wf, xv[1] * wf); of.y = pack2(xv[2] * wf, xv[3] * wf); of.z = pack2(xv[4] * wf, xv[5] * wf); of.w = pack2(xv[6] * wf, xv[7] * wf);
      ob.x = pack2(xv[0] * wb, xv[1] * wb); ob.y = pack2(xv[2] * wb, xv[3] * wb); ob.z = pack2(xv[4] * wb, xv[5] * wb); ob.w = pack2(xv[6] * wb, xv[7] * wb);
      *(uint4*)(XW + (j * XS + seg * 8) * 2) = of;
      *(uint4*)(XW + ((128 + j) * XS + seg * 8) * 2) = ob;
    }
#pragma unroll
    for (int i = 0; i < 4; ++i) {
      const int idx = tid + i * 512, j = idx >> 4, seg = idx & 15;
      *(uint4*)(Bm + (j * BS + seg * 8) * 2) = *(const uint4*)(P.xbc() + (size_t)(row0 + j) * 512 + grp * 128 + seg * 8);
    }
    __syncthreads();
    f32x4 acc[8];
#pragma unroll
    for (int n = 0; n < 8; ++n) acc[n] = (f32x4){0.f, 0.f, 0.f, 0.f};
    const char* xbase = XW + ((dir * 128 + (li >> 2)) * XS + pb * 16 + 4 * (li & 3)) * 2;
    const char* bbase = Bm + ((li >> 2) * BS + 4 * (li & 3)) * 2;
#pragma unroll
    for (int t = 0; t < 4; ++t) {
      const int R = 32 * t + 8 * g;
      const bf16x8 bfrag = tr_read2(xbase + R * XS * 2, xbase + (R + 4) * XS * 2);
#pragma unroll
      for (int n = 0; n < 8; ++n) {
        const bf16x8 afrag = tr_read2(bbase + (R * BS + n * 16) * 2, bbase + ((R + 4) * BS + n * 16) * 2);
        acc[n] = __builtin_amdgcn_mfma_f32_16x16x32_bf16(afrag, bfrag, acc[n], 0, 0, 0);
      }
    }
    bf16_t* dst = P.states() + (size_t)(gc * 32 + dir * 16 + head) * 8192 + (pb * 16 + li) * 128;
#pragma unroll
    for (int n = 0; n < 8; ++n) {
      uint2 o;
      o.x = pack2(acc[n][0], acc[n][1]); o.y = pack2(acc[n][2], acc[n][3]);
      *(uint2*)(dst + n * 16 + 4 * g) = o;
    }
  }
}

__device__ void ph_ssdy_mfma(int wv, const Params& P, int layer, int nchunks, char* smem, int bid, int nb) {
  char* Bm = smem;
  char* Cm = Bm + 128 * BS * 2;
  char* X0 = Cm + 128 * BS * 2;
  char* XD = X0 + 128 * XS * 2;
  float* csf = (float*)(XD + 2 * 128 * XS * 2);
  float* exb = csf + 128;
  const int tid = otid(wv), lane = tid & 63, li = lane & 15, g = lane >> 4;
  for (int it = bid; it < nchunks * 16; it += nb) {
    const int gc = it >> 4, head = it & 15, grp = head >> 3;
    const int row0 = gc * 128;
    __syncthreads();
#pragma unroll
    for (int i = 0; i < 2; ++i) {
      const int idx = tid + i * 512, j = idx >> 3, seg = idx & 7, row = row0 + j;
      float xv[8];
      conv_x8(P, layer, row, head * 64 + seg * 8, xv);
      const float df = P.dtv()[(size_t)row * 32 + head], db = P.dtv()[(size_t)row * 32 + 16 + head];
      uint4 o0, of, ob;
      o0.x = pack2(xv[0], xv[1]); o0.y = pack2(xv[2], xv[3]); o0.z = pack2(xv[4], xv[5]); o0.w = pack2(xv[6], xv[7]);
      of.x = pack2(xv[0] * df, xv[1] * df); of.y = pack2(xv[2] * df, xv[3] * df); of.z = pack2(xv[4] * df, xv[5] * df); of.w = pack2(xv[6] * df, xv[7] * df);
      ob.x = pack2(xv[0] * db, xv[1] * db); ob.y = pack2(xv[2] * db, xv[3] * db); ob.z = pack2(xv[4] * db, xv[5] * db); ob.w = pack2(xv[6] * db, xv[7] * db);
      *(uint4*)(X0 + (j * XS + seg * 8) * 2) = o0;
      *(uint4*)(XD + (j * XS + seg * 8) * 2) = of;
      *(uint4*)(XD + ((128 + j) * XS + seg * 8) * 2) = ob;
    }
#pragma unroll
    for (int i = 0; i < 4; ++i) {
      const int idx = tid + i * 512, j = idx >> 4, seg = idx & 15;
      const bf16_t* s = P.xbc() + (size_t)(row0 + j) * 512 + grp * 128 + seg * 8;
      *(uint4*)(Bm + (j * BS + seg * 8) * 2) = *(const uint4*)s;
      *(uint4*)(Cm + (j * BS + seg * 8) * 2) = *(const uint4*)(s + 256);
    }
    if (tid < 128) {
      csf[tid] = P.csv()[(size_t)(row0 + tid) * 32 + head];
      exb[tid] = tid > 0 ? P.csv()[(size_t)(row0 + tid - 1) * 32 + 16 + head] : 0.f;
    }
    __syncthreads();
    const float atb = P.csv()[(size_t)(row0 + 127) * 32 + 16 + head];
    f32x4 accG[8];
#pragma unroll
    for (int sb = 0; sb < 8; ++sb) accG[sb] = (f32x4){0.f, 0.f, 0.f, 0.f};
#pragma unroll
    for (int t = 0; t < 4; ++t) {
      const bf16x8 cfrag = *(const bf16x8*)(Cm + ((16 * wv + li) * BS + 32 * t + 8 * g) * 2);
#pragma unroll
      for (int sb = 0; sb < 8; ++sb) {
        const bf16x8 bfr = *(const bf16x8*)(Bm + ((16 * sb + li) * BS + 32 * t + 8 * g) * 2);
        accG[sb] = __builtin_amdgcn_mfma_f32_16x16x32_bf16(bfr, cfrag, accG[sb], 0, 0, 0);
      }
    }
    f32x4 accY[4];
#pragma unroll
    for (int pb = 0; pb < 4; ++pb) accY[pb] = (f32x4){0.f, 0.f, 0.f, 0.f};
    const int jl = 16 * wv + li;
    const float csf_j = csf[jl], exb_j = exb[jl];
#pragma unroll
    for (int dir = 0; dir < 2; ++dir) {
      f32x4 accO[4];
#pragma unroll
      for (int pb = 0; pb < 4; ++pb) accO[pb] = (f32x4){0.f, 0.f, 0.f, 0.f};
      const bf16_t* st = P.states() + (size_t)(gc * 32 + dir * 16 + head) * 8192;
#pragma unroll
      for (int t = 0; t < 4; ++t) {
        const bf16x8 cfrag = *(const bf16x8*)(Cm + ((16 * wv + li) * BS + 32 * t + 8 * g) * 2);
#pragma unroll
        for (int pb = 0; pb < 4; ++pb) {
          const bf16x8 sfr = *(const bf16x8*)(st + (16 * pb + li) * 128 + 32 * t + 8 * g);
          accO[pb] = __builtin_amdgcn_mfma_f32_16x16x32_bf16(cfrag, sfr, accO[pb], 0, 0, 0);
        }
      }
#pragma unroll
      for (int e = 0; e < 4; ++e) {
        const int j = 16 * wv + 4 * g + e;
        const float sc = dir == 0 ? expf(csf[j]) : expf(atb - exb[j]);
#pragma unroll
        for (int pb = 0; pb < 4; ++pb) accY[pb][e] += accO[pb][e] * sc;
      }
#pragma unroll
      for (int t = 0; t < 4; ++t) {
        const bool skip = dir == 0 ? (32 * t > 16 * wv + 15) : (32 * t + 31 < 16 * wv);
        if (skip) continue;
        bf16x8 afrag;
#pragma unroll
        for (int hh = 0; hh < 2; ++hh) {
          const int s0 = 32 * t + 16 * hh + 4 * g;
          const f32x4 gv = accG[2 * t + hh];
          const f32x4 cv = dir == 0 ? *(const f32x4*)(csf + s0) : *(const f32x4*)(exb + s0);
#pragma unroll
          for (int e = 0; e < 4; ++e) {
            const int s = s0 + e;
            float m;
            if (dir == 0) m = (s <= jl) ? gv[e] * expf(csf_j - cv[e]) : 0.f;
            else m = (s >= jl) ? gv[e] * expf(cv[e] - exb_j) : 0.f;
            afrag[hh * 4 + e] = (short)f2bf(m);
          }
        }
        const char* xb = XD + ((dir * 128 + 32 * t + 4 * g + (li >> 2)) * XS + 4 * (li & 3)) * 2;
#pragma unroll
        for (int pb = 0; pb < 4; ++pb) {
          const bf16x8 bfr = tr_read2(xb + pb * 32, xb + 16 * XS * 2 + pb * 32);
          accY[pb] = __builtin_amdgcn_mfma_f32_16x16x32_bf16(afrag, bfr, accY[pb], 0, 0, 0);
        }
      }
    }
    const float dsk = P.d_skip[layer * 16 + head];
#pragma unroll
    for (int e = 0; e < 4; ++e) {
      const int j = 16 * wv + 4 * g + e, row = row0 + j;
#pragma unroll
      for (int pb = 0; pb < 4; ++pb) {
        const int pp = 16 * pb + li;
        const float xs = bf2f(*(const bf16_t*)(X0 + (j * XS + pp) * 2));
        const float z = bf2f(P.p()[(size_t)row * PW + OFF_Z + head * 64 + pp]);
        P.concat()[(size_t)row * 2048 + head * 64 + pp] = f2bf((accY[pb][e] + dsk * xs) * silu_f(z));
      }
    }
  }
}

__device__ void ph_ssdnorm(int wv, const Params& P, int layer, int nrows, int bid, int nb) {
  const int wave = otid(wv) >> 6, lane = otid(wv) & 63;
  const float* g = P.ssd_norm_g + layer * 1024;
  for (int row = bid * NWAVE + wave; row < nrows; row += nb * NWAVE) {
    bf16_t* src = P.concat() + (size_t)row * 2048;
    float v[16];
    float ss = 0.f;
#pragma unroll
    for (int i = 0; i < 4; ++i) {
      const uint2 pk = *(const uint2*)(src + i * 256 + lane * 4);
      v[i * 4 + 0] = bf2f((bf16_t)(pk.x & 0xffff)); v[i * 4 + 1] = bf2f((bf16_t)(pk.x >> 16));
      v[i * 4 + 2] = bf2f((bf16_t)(pk.y & 0xffff)); v[i * 4 + 3] = bf2f((bf16_t)(pk.y >> 16));
    }
#pragma unroll
    for (int i = 0; i < 16; ++i) ss += v[i] * v[i];
    ss = wave_sum(ss);
    const float rstd = rsqrtf(ss * (1.f / 1024.f) + 1e-6f);
#pragma unroll
    for (int i = 0; i < 4; ++i) {
      const int idx = i * 256 + lane * 4;
      uint2 pk;
      pk.x = (uint32_t)f2bf(v[i * 4 + 0] * rstd * g[idx + 0]) | ((uint32_t)f2bf(v[i * 4 + 1] * rstd * g[idx + 1]) << 16);
      pk.y = (uint32_t)f2bf(v[i * 4 + 2] * rstd * g[idx + 2]) | ((uint32_t)f2bf(v[i * 4 + 3] * rstd * g[idx + 3]) << 16);
      *(uint2*)(src + idx) = pk;
    }
  }
}

__device__ void ph_pool(int wv, const Params& P, int layer, int nrows, char* smem, int bid, int nb) {
  float* pooled = (float*)smem;
  const int tid = otid(wv);
  const int ntile = nrows / 32;
  for (int it = bid; it < ntile * 4; it += nb) {
    const int tt = it >> 2, gi = it & 3;
    const int w = 2 << gi;
    const int row0 = tt * 32;
    __syncthreads();
    for (int i = tid; i < 32 * 128; i += NTHR) {
      const int t = i >> 7, ch = i & 127, row = row0 + t;
      int l, L, base;
      if (row < NLAT) { l = row & 4095; L = 4096; base = row - l; } else { l = (row - NLAT) & 255; L = 256; base = row - l; }
      int lo = l - w / 2; lo = lo < 0 ? 0 : lo;
      int hi = l + w - w / 2 - 1; hi = hi > L - 1 ? L - 1 : hi;
      float s = 0.f;
      for (int r = lo; r <= hi; ++r) s += bf2f(P.p()[(size_t)(base + r) * PW + OFF_POOL + gi * 128 + ch]);
      pooled[i] = s / (float)(hi - lo + 1) - bf2f(P.p()[(size_t)row * PW + OFF_POOL + gi * 128 + ch]);
    }
    __syncthreads();
    const int o = tid & 127, tg = (tid >> 7) & 1;
    const float* W = P.pool_w + ((size_t)(layer * 4 + gi) * 128) * 128 + o;
    float acc[16];
#pragma unroll
    for (int i = 0; i < 16; ++i) acc[i] = 0.f;
    for (int k = 0; k < 128; ++k) {
      const float wv = W[(size_t)k * 128];
#pragma unroll
      for (int i = 0; i < 16; ++i) acc[i] += pooled[(tg * 16 + i) * 128 + k] * wv;
    }
    const float sc = P.pool_scale[layer * 512 + gi * 128 + o];
#pragma unroll
    for (int i = 0; i < 16; ++i)
      P.concat()[(size_t)(row0 + tg * 16 + i) * 2048 + 1024 + gi * 128 + o] = f2bf(acc[i] * sc);
  }
}

__device__ void ph_na(int wv, const Params& P, int layer, int nrows, char* smem, int bid, int nb) {
  const int wave = otid(wv) >> 6, lane = otid(wv) & 63;
  float* qs = (float*)smem + wave * 448;
  float* ps = qs + 64;
  const float* rpb = P.na_rpb + (size_t)layer * 8 * 15 * 31;
  for (int it = bid * NWAVE + wave; it < nrows * 8; it += nb * NWAVE) {
    const int row = it >> 3, hd = it & 7;
    const bool lat = row < NLAT;
    int b, r = 0, cq = 0, r0 = 0, c0 = 0;
    if (lat) {
      b = row >> 12; const int l = row & 4095; r = l >> 6; cq = l & 63;
      r0 = r - 4; r0 = r0 < 0 ? 0 : (r0 > 56 ? 56 : r0);
      c0 = cq - 8; c0 = c0 < 0 ? 0 : (c0 > 48 ? 48 : c0);
    } else {
      b = (row - NLAT) >> 8;
    }
    qs[lane] = bf2f(P.p()[(size_t)row * PW + OFF_Q + hd * 64 + lane]) * 0.125f;
    __builtin_amdgcn_wave_barrier();
    const int nkeys = lat ? 384 : 256;
    float mx = -3.0e38f;
#pragma unroll 1
    for (int t = 0; t < 6; ++t) {
      const int n = t * 64 + lane;
      float s = -3.0e38f;
      if (n < nkeys) {
        int krow; float bias = 0.f;
        if (lat && n < 128) {
          const int kr = n >> 4, kc = n & 15;
          const int rk = r0 + kr, ck = c0 + kc;
          krow = b * 4096 + rk * 64 + ck;
          bias = rpb[(hd * 15 + (rk - r + 7)) * 31 + (ck - cq + 15)];
        } else {
          krow = NLAT + b * 256 + (lat ? n - 128 : n);
        }
        const bf16_t* kp = P.p() + (size_t)krow * PW + OFF_K + hd * 64;
        float d = 0.f;
#pragma unroll
        for (int v8 = 0; v8 < 8; ++v8) {
          const uint4 kk = *(const uint4*)(kp + v8 * 8);
          const bf16_t* ke = (const bf16_t*)&kk;
#pragma unroll
          for (int e = 0; e < 8; ++e) d += qs[v8 * 8 + e] * bf2f(ke[e]);
        }
        s = d + bias;
      }
      ps[t * 64 + lane] = s;
      mx = fmaxf(mx, s);
    }
    mx = wave_max(mx);
    float sum = 0.f;
#pragma unroll 1
    for (int t = 0; t < 6; ++t) {
      const int n = t * 64 + lane;
      const float e = (n < nkeys) ? expf(ps[n] - mx) : 0.f;
      sum += e;
      ps[n] = e;
    }
    sum = wave_sum(sum);
    __builtin_amdgcn_wave_barrier();
    float acc = 0.f;
    for (int n = 0; n < nkeys; ++n) {
      int krow;
      if (lat && n < 128) krow = b * 4096 + (r0 + (n >> 4)) * 64 + c0 + (n & 15);
      else krow = NLAT + b * 256 + (lat ? n - 128 : n);
      acc += ps[n] * bf2f(P.p()[(size_t)krow * PW + OFF_V + hd * 64 + lane]);
    }
    P.concat()[(size_t)row * 2048 + 1536 + hd * 64 + lane] = f2bf(acc / sum);
    __builtin_amdgcn_wave_barrier();
  }
}


__device__ void ph_pool_mfma(int wv, const Params& P, int layer, int nrows, int bid, int nb) {
  const int lane = otid(wv) & 63, li = lane & 15, g = lane >> 4;
  const int nitems = (nrows / 16) * 4;
  for (int it = bid * NWAVE + wv; it < nitems; it += nb * NWAVE) {
    const int gi = it & 3, row0 = (it >> 2) * 16, w = 2 << gi;
    const int row = row0 + li;
    int l, L;
    if (row < NLAT) { l = row & 4095; L = 4096; } else { l = (row - NLAT) & 255; L = 256; }
    int lo = l - w / 2; lo = lo < 0 ? 0 : lo;
    int hi = l + w - w / 2 - 1; hi = hi > L - 1 ? L - 1 : hi;
    const float rc = 1.f / (float)(hi - lo + 1);
    const bf16_t* pc = P.p() + (size_t)row * PW + OFF_POOL + gi * 128 + 8 * g;
    bf16x8 af[4];
#pragma unroll
    for (int t = 0; t < 4; ++t) {
      float s[8], own[8];
#pragma unroll
      for (int e = 0; e < 8; ++e) s[e] = 0.f;
      for (int o = 0; o < w; ++o) {
        const int rr = l - w / 2 + o;
        if (rr >= 0 && rr < L) {
          float f[8];
          unpack8(*(const uint4*)(pc + (ptrdiff_t)(rr - l) * PW + 32 * t), f);
#pragma unroll
          for (int e = 0; e < 8; ++e) s[e] += f[e];
        }
      }
      unpack8(*(const uint4*)(pc + 32 * t), own);
#pragma unroll
      for (int e = 0; e < 8; ++e) af[t][e] = (short)f2bf(s[e] * rc - own[e]);
    }
    const bf16_t* wt = P.poolwT() + ((size_t)(layer * 4 + gi) * 128 + li) * 128 + 8 * g;
    const float* sc = P.pool_scale + layer * 512 + gi * 128;
#pragma unroll
    for (int nt = 0; nt < 8; ++nt) {
      f32x4 acc = (f32x4){0.f, 0.f, 0.f, 0.f};
#pragma unroll
      for (int t = 0; t < 4; ++t) {
        const bf16x8 bfr = *(const bf16x8*)(wt + (size_t)nt * 16 * 128 + 32 * t);
        acc = __builtin_amdgcn_mfma_f32_16x16x32_bf16(af[t], bfr, acc, 0, 0, 0);
      }
      const float scv = sc[nt * 16 + li];
#pragma unroll
      for (int e = 0; e < 4; ++e)
        P.concat()[(size_t)(row0 + 4 * g + e) * 2048 + 1024 + gi * 128 + nt * 16 + li] = f2bf(acc[e] * scv);
    }
  }
}

__device__ void ph_vtranspose(int wv, const Params& P, char* smem, int bid, int nb) {
  const int lane = otid(wv) & 63;
  bf16_t* tile = (bf16_t*)smem + wv * 64 * 72;
  for (int it = bid * NWAVE + wv; it < 272 * 8; it += nb * NWAVE) {
    const int hd = it & 7, tt = it >> 3, row0 = tt * 64;
    const bf16_t* src = P.p() + (size_t)(row0 + lane) * PW + OFF_V + hd * 64;
#pragma unroll
    for (int i = 0; i < 8; ++i) *(uint4*)(tile + lane * 72 + i * 8) = *(const uint4*)(src + i * 8);
    __builtin_amdgcn_wave_barrier();
    bf16_t* dst;
    if (row0 < NLAT) dst = P.vtl() + ((size_t)((row0 >> 12) * 8 + hd) * 64 + lane) * 4096 + (row0 & 4095);
    else dst = P.vtc() + ((size_t)(((row0 - NLAT) >> 8) * 8 + hd) * 64 + lane) * 256 + ((row0 - NLAT) & 255);
#pragma unroll
    for (int i = 0; i < 8; ++i) {
      uint32_t w[4];
#pragma unroll
      for (int k = 0; k < 4; ++k)
        w[k] = (uint32_t)tile[(i * 8 + 2 * k) * 72 + lane] | ((uint32_t)tile[(i * 8 + 2 * k + 1) * 72 + lane] << 16);
      *(uint4*)(dst + i * 8) = make_uint4(w[0], w[1], w[2], w[3]);
    }
    __builtin_amdgcn_wave_barrier();
  }
}

__device__ __forceinline__ float grp_max(float v) {
  auto a = __builtin_amdgcn_permlane16_swap(__float_as_uint(v), __float_as_uint(v), false, false);
  v = fmaxf(__uint_as_float(a[0]), __uint_as_float(a[1]));
  auto b = __builtin_amdgcn_permlane32_swap(__float_as_uint(v), __float_as_uint(v), false, false);
  return fmaxf(__uint_as_float(b[0]), __uint_as_float(b[1]));
}
__device__ __forceinline__ float grp_sum(float v) {
  auto a = __builtin_amdgcn_permlane16_swap(__float_as_uint(v), __float_as_uint(v), false, false);
  v = __uint_as_float(a[0]) + __uint_as_float(a[1]);
  auto b = __builtin_amdgcn_permlane32_swap(__float_as_uint(v), __float_as_uint(v), false, false);
  return __uint_as_float(b[0]) + __uint_as_float(b[1]);
}

__device__ void ph_na_mfma(int wv, const Params& P, int layer, int nrows, int bid, int nb) {
  const int lane = otid(wv) & 63, li = lane & 15, g = lane >> 4;
  const float* rpb = P.na_rpb + (size_t)layer * 8 * 15 * 31;
  const int n_lat = 4 * 64 * 8 * 4;
  const int n_items = n_lat + (nrows > NLAT ? 4 * 16 * 8 : 0);
  for (int it = bid * NWAVE + wv; it < n_items; it += nb * NWAVE) {
    const bool lat = it < n_lat;
    int b, hd, qrow0, r = 0, cq0 = 0, r0 = 0, cs = 0;
    if (lat) {
      const int qt = it & 3; hd = (it >> 2) & 7; r = (it >> 5) & 63; b = it >> 11;
      cq0 = qt * 16; qrow0 = b * 4096 + r * 64 + cq0;
      r0 = r - 4; r0 = r0 < 0 ? 0 : (r0 > 56 ? 56 : r0);
      int clo = cq0 - 8; clo = clo < 0 ? 0 : (clo > 48 ? 48 : clo);
      cs = clo < 32 ? clo : 32;
    } else {
      const int t = it - n_lat; hd = t & 7; const int qt = (t >> 3) & 15; b = t >> 7;
      qrow0 = NLAT + b * 256 + qt * 16;
    }
    const bf16_t* qp = P.p() + (size_t)(qrow0 + li) * PW + OFF_Q + hd * 64 + 8 * g;
    const bf16x8 qf0 = *(const bf16x8*)qp, qf1 = *(const bf16x8*)(qp + 32);
    f32x4 accS[16], accC[16];
#pragma unroll
    for (int kt = 0; kt < 16; ++kt) {
      const int krow = b * 4096 + (r0 + (kt >> 1)) * 64 + cs + 16 * (kt & 1) + li;
      const bf16_t* kp = P.p() + (size_t)krow * PW + OFF_K + hd * 64 + 8 * g;
      const bf16x8 a0 = *(const bf16x8*)kp, a1 = *(const bf16x8*)(kp + 32);
      f32x4 z = (f32x4){0.f, 0.f, 0.f, 0.f};
      z = __builtin_amdgcn_mfma_f32_16x16x32_bf16(a0, qf0, z, 0, 0, 0);
      accS[kt] = __builtin_amdgcn_mfma_f32_16x16x32_bf16(a1, qf1, z, 0, 0, 0);
    }
#pragma unroll
    for (int ct = 0; ct < 16; ++ct) {
      const int krow = NLAT + b * 256 + 16 * ct + li;
      const bf16_t* kp = P.p() + (size_t)krow * PW + OFF_K + hd * 64 + 8 * g;
      const bf16x8 a0 = *(const bf16x8*)kp, a1 = *(const bf16x8*)(kp + 32);
      f32x4 z = (f32x4){0.f, 0.f, 0.f, 0.f};
      z = __builtin_amdgcn_mfma_f32_16x16x32_bf16(a0, qf0, z, 0, 0, 0);
      accC[ct] = __builtin_amdgcn_mfma_f32_16x16x32_bf16(a1, qf1, z, 0, 0, 0);
    }
    const int cq = cq0 + li;
    int c0q = cq - 8; c0q = c0q < 0 ? 0 : (c0q > 48 ? 48 : c0q);
    float mx = -3.0e38f;
#pragma unroll
    for (int kt = 0; kt < 16; ++kt) {
      const int rk = r0 + (kt >> 1);
#pragma unroll
      for (int e = 0; e < 4; ++e) {
        const int ck = cs + 16 * (kt & 1) + 4 * g + e;
        const bool ok = lat && ck >= c0q && ck < c0q + 16;
        float s = -3.0e38f;
        if (ok) s = accS[kt][e] * 0.125f + rpb[(hd * 15 + (rk - r + 7)) * 31 + (ck - cq + 15)];
        accS[kt][e] = s;
        mx = fmaxf(mx, s);
      }
    }
#pragma unroll
    for (int ct = 0; ct < 16; ++ct)
#pragma unroll
      for (int e = 0; e < 4; ++e) { const float s = accC[ct][e] * 0.125f; accC[ct][e] = s; mx = fmaxf(mx, s); }
    mx = grp_max(mx);
    float sum = 0.f;
#pragma unroll
    for (int kt = 0; kt < 16; ++kt)
#pragma unroll
      for (int e = 0; e < 4; ++e) { const float p = __expf(accS[kt][e] - mx); accS[kt][e] = p; sum += p; }
#pragma unroll
    for (int ct = 0; ct < 16; ++ct)
#pragma unroll
      for (int e = 0; e < 4; ++e) { const float p = __expf(accC[ct][e] - mx); accC[ct][e] = p; sum += p; }
    sum = grp_sum(sum);
    const float inv = 1.f / sum;
    f32x4 accO[4];
#pragma unroll
    for (int db = 0; db < 4; ++db) accO[db] = (f32x4){0.f, 0.f, 0.f, 0.f};
    const bf16_t* vl = P.vtl() + ((size_t)(b * 8 + hd) * 64 + li) * 4096;
    const bf16_t* vc = P.vtc() + ((size_t)(b * 8 + hd) * 64 + li) * 256;
#pragma unroll
    for (int kr = 0; kr < 8; ++kr) {
      bf16x8 af;
#pragma unroll
      for (int e = 0; e < 4; ++e) { af[e] = (short)f2bf(accS[2 * kr][e] * inv); af[4 + e] = (short)f2bf(accS[2 * kr + 1][e] * inv); }
      const int tok = (r0 + kr) * 64 + cs + 4 * g;
#pragma unroll
      for (int db = 0; db < 4; ++db) {
        const bf16_t* vp = vl + (size_t)db * 16 * 4096 + tok;
        const s16x4 lo = *(const s16x4*)vp, hi = *(const s16x4*)(vp + 16);
        const bf16x8 bfr = (bf16x8){lo[0], lo[1], lo[2], lo[3], hi[0], hi[1], hi[2], hi[3]};
        accO[db] = __builtin_amdgcn_mfma_f32_16x16x32_bf16(af, bfr, accO[db], 0, 0, 0);
      }
    }
#pragma unroll
    for (int t = 0; t < 8; ++t) {
      bf16x8 af;
#pragma unroll
      for (int e = 0; e < 4; ++e) { af[e] = (short)f2bf(accC[2 * t][e] * inv); af[4 + e] = (short)f2bf(accC[2 * t + 1][e] * inv); }
      const int tok = 32 * t + 4 * g;
#pragma unroll
      for (int db = 0; db < 4; ++db) {
        const bf16_t* vp = vc + (size_t)db * 16 * 256 + tok;
        const s16x4 lo = *(const s16x4*)vp, hi = *(const s16x4*)(vp + 16);
        const bf16x8 bfr = (bf16x8){lo[0], lo[1], lo[2], lo[3], hi[0], hi[1], hi[2], hi[3]};
        accO[db] = __builtin_amdgcn_mfma_f32_16x16x32_bf16(af, bfr, accO[db], 0, 0, 0);
      }
    }
#pragma unroll
    for (int db = 0; db < 4; ++db)
#pragma unroll
      for (int e = 0; e < 4; ++e)
        P.concat()[(size_t)(qrow0 + 4 * g + e) * 2048 + 1536 + hd * 64 + 16 * db + li] = f2bf(accO[db][e]);
  }
}

__device__ void ph_peer_topk(int wv, const Params& P, int layer, int nrows, char* smem, int bid, int nb) {
  bf16_t* Ks = (bf16_t*)smem;
  float* qt = (float*)(smem + 33280);
  float* sc = qt + 32 * 256;
  float* tv = sc + 64 * 129;
  int* ti = (int*)(tv + 64 * 16);
  const int tid = otid(wv);
  const int ntile = nrows / 32;
  for (int it = bid; it < ntile * 8; it += nb) {
    const int hd = it % 8, tt = it / 8;
    const int row0 = tt * 32;
    __syncthreads();
    for (int i = tid; i < 32 * 256; i += NTHR) {
      const int t = i >> 8, d = i & 255;
      qt[i] = bf2f(P.q()[(size_t)(row0 + t) * 2048 + hd * 256 + d]);
    }
    for (int half = 0; half < 2; ++half) {
      __syncthreads();
      const float* kk = P.peer_keys + ((size_t)((layer * 8 + hd) * 2 + half) * 128) * 128;
      for (int i = tid; i < 128 * 128; i += NTHR) Ks[(i >> 7) * 130 + (i & 127)] = f2bf(kk[i]);
      __syncthreads();
      const int k = tid & 127, tg = (tid >> 7) & 1;
      float acc[16];
#pragma unroll
      for (int i = 0; i < 16; ++i) acc[i] = 0.f;
      for (int d = 0; d < 128; ++d) {
        const float kv = bf2f(Ks[k * 130 + d]);
#pragma unroll
        for (int i = 0; i < 16; ++i) acc[i] += qt[(tg * 16 + i) * 256 + half * 128 + d] * kv;
      }
#pragma unroll
      for (int i = 0; i < 16; ++i) sc[((tg * 16 + i) * 2 + half) * 129 + k] = acc[i];
    }
    __syncthreads();
    if (tid < 64) {
      float* s = sc + tid * 129;
      for (int r = 0; r < 16; ++r) {
        float best = -3.0e38f; int bi = 0;
        for (int k = 0; k < 128; ++k) { const float v = s[k]; if (v > best) { best = v; bi = k; } }
        tv[tid * 16 + r] = best; ti[tid * 16 + r] = bi;
        s[bi] = -3.0e38f;
      }
    }
    __syncthreads();
    float* cand = qt;
    for (int i = tid; i < 32 * 256; i += NTHR) {
      const int t = i >> 8, a = (i >> 4) & 15, b2 = i & 15;
      cand[i] = tv[(t * 2 + 0) * 16 + a] + tv[(t * 2 + 1) * 16 + b2];
    }
    __syncthreads();
    if (tid < 32) {
      float* cd = cand + tid * 256;
      float ts[16];
      const int row = row0 + tid;
      float mx = 0.f;
#pragma unroll
      for (int r = 0; r < 16; ++r) {
        float best = -3.0e38f; int bi = 0;
        for (int k = 0; k < 256; ++k) { const float v = cd[k]; if (v > best) { best = v; bi = k; } }
        cd[bi] = -3.0e38f;
        ts[r] = best;
        if (r == 0) mx = best;
        const int e = ti[(tid * 2 + 0) * 16 + (bi >> 4)] * 128 + ti[(tid * 2 + 1) * 16 + (bi & 15)];
        P.sel_idx()[(size_t)row * 128 + hd * 16 + r] = e;
      }
      float sum = 0.f;
#pragma unroll
      for (int r = 0; r < 16; ++r) { ts[r] = expf(ts[r] - mx); sum += ts[r]; }
      const float inv = 1.f / sum;
#pragma unroll
      for (int r = 0; r < 16; ++r) P.sel_g()[(size_t)row * 128 + hd * 16 + r] = ts[r] * inv;
    }
  }
}


__device__ __forceinline__ uint32_t mono_u(float f) { const uint32_t u = __float_as_uint(f); return u ^ ((uint32_t)((int)u >> 31) | 0x80000000u); }
__device__ __forceinline__ float unmono_f(uint32_t m) { return __uint_as_float((m & 0x80000000u) ? (m ^ 0x80000000u) : ~m); }
__device__ __forceinline__ uint32_t grp_max_u(uint32_t v) {
  auto a = __builtin_amdgcn_permlane16_swap(v, v, false, false);
  v = a[0] > a[1] ? a[0] : a[1];
  auto b = __builtin_amdgcn_permlane32_swap(v, v, false, false);
  return b[0] > b[1] ? b[0] : b[1];
}

template <int N>
__device__ __forceinline__ void bitonic_sort_desc(uint32_t (&a)[N], int base = 0) { (void)base;
#pragma unroll
  for (int k = 2; k <= N; k <<= 1)
#pragma unroll
    for (int j = k >> 1; j > 0; j >>= 1)
#pragma unroll
      for (int i = 0; i < N; ++i) {
        const int l = i ^ j;
        if (l > i) {
          const bool desc = (i & k) == 0;
          const uint32_t hi = a[i] > a[l] ? a[i] : a[l], lo = a[i] > a[l] ? a[l] : a[i];
          a[i] = desc ? hi : lo; a[l] = desc ? lo : hi;
        }
      }
}
template <int N>
__device__ __forceinline__ void bitonic_merge_desc(uint32_t (&a)[N]) {
#pragma unroll
  for (int j = N >> 1; j > 0; j >>= 1)
#pragma unroll
    for (int i = 0; i < N; ++i) {
      const int l = i ^ j;
      if (l > i) {
        const uint32_t hi = a[i] > a[l] ? a[i] : a[l], lo = a[i] > a[l] ? a[l] : a[i];
        a[i] = hi; a[l] = lo;
      }
    }
}
__device__ __forceinline__ void merge4_top16(uint32_t (&a)[16]) {
  uint32_t e[16], o[16];
#pragma unroll
  for (int i = 0; i < 16; ++i) { auto r = __builtin_amdgcn_permlane16_swap(a[i], a[i], false, false); e[i] = r[0]; o[i] = r[1]; }
#pragma unroll
  for (int i = 0; i < 16; ++i) a[i] = e[i] > o[15 - i] ? e[i] : o[15 - i];
  bitonic_merge_desc<16>(a);
#pragma unroll
  for (int i = 0; i < 16; ++i) { auto r = __builtin_amdgcn_permlane32_swap(a[i], a[i], false, false); e[i] = r[0]; o[i] = r[1]; }
#pragma unroll
  for (int i = 0; i < 16; ++i) a[i] = e[i] > o[15 - i] ? e[i] : o[15 - i];
  bitonic_merge_desc<16>(a);
}
__device__ void ph_peer_topk_mfma(int wv, const Params& P, int layer, int nrows, char* smem, int bid, int nb) {
  const int tid = otid(wv), lane = tid & 63, li = lane & 15, g = lane >> 4;
  unsigned char* ctab = (unsigned char*)smem;
  float* vals = (float*)(smem + 256) + wv * 512;
  int* idxs = (int*)(smem + 256 + 8 * 2048) + wv * 512;
  __syncthreads();
  if (tid < 64) ctab[tid] = 0xFF;
  __syncthreads();
  if (tid == 0) {
    int n = 0, one = 1;
    asm volatile("" : "+s"(one));
#pragma unroll 1
    for (int a = 0; a < 16; ++a)
#pragma unroll 1
      for (int b = 0; b < 16; ++b)
        if ((a + one) * (b + 1) <= 16) { ctab[(n & 3) * 16 + (n >> 2)] = (unsigned char)(a * 16 + b); ++n; }
  }
  const int hd = bid & 7, tg = bid >> 3, ngroups = nb >> 3;
  char* ksm = smem + 33280;
  {
    const bf16_t* ksrc = P.keysb() + (size_t)(layer * 8 + hd) * 2 * 128 * 128;
#pragma unroll
    for (int i = 0; i < 8; ++i) {
      const int idx = tid + i * 512, r = idx >> 4, sg = idx & 15;
      *(uint4*)(ksm + (r * 136 + sg * 8) * 2) = *(const uint4*)(ksrc + (size_t)r * 128 + sg * 8);
    }
  }
  __syncthreads();
  const int ntile = nrows / 16;
  for (int tile = tg + ngroups * wv; tile < ntile && tg < ngroups; tile += ngroups * NWAVE) {
    const int row0 = tile * 16;
    const bf16_t* qp = P.q() + (size_t)(row0 + li) * 2048 + hd * 256 + 8 * g;
    uint32_t win[2][16];
#pragma unroll
    for (int half = 0; half < 2; ++half) {
      bf16x8 qf[4];
#pragma unroll
      for (int t = 0; t < 4; ++t) qf[t] = *(const bf16x8*)(qp + half * 128 + 32 * t);
      const char* kb = ksm + ((half * 128 + li) * 136 + 8 * g) * 2;
      uint32_t pk[32];
#pragma unroll
      for (int kt = 0; kt < 8; ++kt) {
        f32x4 acc = (f32x4){0.f, 0.f, 0.f, 0.f};
#pragma unroll
        for (int t = 0; t < 4; ++t) {
          const bf16x8 a = *(const bf16x8*)(kb + (kt * 16 * 136 + 32 * t) * 2);
          acc = __builtin_amdgcn_mfma_f32_16x16x32_bf16(a, qf[t], acc, 0, 0, 0);
        }
#pragma unroll
        for (int e = 0; e < 4; ++e) pk[kt * 4 + e] = (mono_u(acc[e]) & ~127u) | (uint32_t)(16 * kt + 4 * g + e);
      }
      {
        uint32_t lo16[16], hi16[16];
#pragma unroll
        for (int i = 0; i < 16; ++i) { lo16[i] = pk[i]; hi16[i] = pk[16 + i]; }
        bitonic_sort_desc<16>(lo16);
        bitonic_sort_desc<16>(hi16);
#pragma unroll
        for (int i = 0; i < 16; ++i) lo16[i] = lo16[i] > hi16[15 - i] ? lo16[i] : hi16[15 - i];
        bitonic_merge_desc<16>(lo16);
        merge4_top16(lo16);
#pragma unroll
        for (int r = 0; r < 16; ++r) win[half][r] = lo16[r];
      }
    }
    if (g == 0) {
#pragma unroll
      for (int half = 0; half < 2; ++half)
#pragma unroll
        for (int r = 0; r < 16; ++r) {
          vals[li * 32 + half * 16 + r] = unmono_f(win[half][r] & ~127u);
          idxs[li * 32 + half * 16 + r] = (int)(win[half][r] & 127u);
        }
    }
    __builtin_amdgcn_wave_barrier();
    uint32_t cp[16];
#pragma unroll
    for (int s = 0; s < 16; ++s) {
      const uint32_t ab = ctab[g * 16 + s];
      uint32_t v = 0u;
      if (ab != 0xFFu) v = (mono_u(vals[li * 32 + (ab >> 4)] + vals[li * 32 + 16 + (ab & 15u)]) & ~255u) | ab;
      cp[s] = v;
    }
    bitonic_sort_desc<16>(cp);
    merge4_top16(cp);
    uint32_t cw[16];
#pragma unroll
    for (int r = 0; r < 16; ++r) cw[r] = cp[r];
    const float mx = unmono_f(cw[0] & ~255u);
    float ex[16];
    float sum = 0.f;
#pragma unroll
    for (int r = 0; r < 16; ++r) { ex[r] = __expf(unmono_f(cw[r] & ~255u) - mx); sum += ex[r]; }
    const float inv = 1.f / sum;
    const size_t ob = (size_t)(row0 + li) * 128 + hd * 16;
#pragma unroll
    for (int r = 0; r < 16; ++r) {
      if ((r >> 2) == g) {
        const uint32_t ab = cw[r] & 255u;
        P.sel_idx()[ob + r] = idxs[li * 32 + (ab >> 4)] * 128 + idxs[li * 32 + 16 + (ab & 15u)];
        P.sel_g()[ob + r] = ex[r] * inv;
      }
    }
    __builtin_amdgcn_wave_barrier();
  }
}

__device__ __forceinline__ void cvt16(const uint4 v, float* f) {
  const f32x2_t a0 = __builtin_amdgcn_cvt_pk_f32_fp8((int)v.x, false), a1 = __builtin_amdgcn_cvt_pk_f32_fp8((int)v.x, true);
  const f32x2_t b0 = __builtin_amdgcn_cvt_pk_f32_fp8((int)v.y, false), b1 = __builtin_amdgcn_cvt_pk_f32_fp8((int)v.y, true);
  const f32x2_t c0 = __builtin_amdgcn_cvt_pk_f32_fp8((int)v.z, false), c1 = __builtin_amdgcn_cvt_pk_f32_fp8((int)v.z, true);
  const f32x2_t d0 = __builtin_amdgcn_cvt_pk_f32_fp8((int)v.w, false), d1 = __builtin_amdgcn_cvt_pk_f32_fp8((int)v.w, true);
  f[0] = a0.x; f[1] = a0.y; f[2] = a1.x; f[3] = a1.y; f[4] = b0.x; f[5] = b0.y; f[6] = b1.x; f[7] = b1.y;
  f[8] = c0.x; f[9] = c0.y; f[10] = c1.x; f[11] = c1.y; f[12] = d0.x; f[13] = d0.y; f[14] = d1.x; f[15] = d1.y;
}
__device__ __forceinline__ float swap32_add(float a, float b) {
  auto r = __builtin_amdgcn_permlane32_swap(__float_as_uint(a), __float_as_uint(b), false, false);
  return __uint_as_float(r[0]) + __uint_as_float(r[1]);
}
__device__ __forceinline__ float swap16_add(float a, float b) {
  auto r = __builtin_amdgcn_permlane16_swap(__float_as_uint(a), __float_as_uint(b), false, false);
  return __uint_as_float(r[0]) + __uint_as_float(r[1]);
}
__device__ void ph_peer_gather(int wv, const Params& P, int layer, int nrows, int bid, int nb) {
  const int lane = otid(wv) & 63;
  const unsigned char* TU = P.tabU() + lane * 16;
  const unsigned char* TV = P.tabV() + lane * 16;
  for (int row = bid * NWAVE + wv; row < nrows; row += nb * NWAVE) {
    float xv[16], o[16];
    unpack8(*(const uint4*)(P.u() + (size_t)row * DM + lane * 16), xv);
    unpack8(*(const uint4*)(P.u() + (size_t)row * DM + lane * 16 + 8), xv + 8);
    const int idx0 = P.sel_idx()[(size_t)row * 128 + lane], idx1 = P.sel_idx()[(size_t)row * 128 + 64 + lane];
    const float gt0 = P.sel_g()[(size_t)row * 128 + lane] * P.invV()[idx0], gt1 = P.sel_g()[(size_t)row * 128 + 64 + lane] * P.invV()[idx1];
    const float iu0 = P.invU()[idx0], iu1 = P.invU()[idx1];
    float d0 = 0.f, d1 = 0.f;
    uint4 bufA[8], bufB[8];
#define PG_LOAD(buf, T, kk) do { _Pragma("unroll") for (int j = 0; j < 8; ++j) { \
      const int k_ = (kk) + j; const int e_ = __builtin_amdgcn_readlane(k_ < 64 ? idx0 : idx1, k_ & 63); \
      buf[j] = *(const uint4*)(T + (size_t)e_ * 1024); } } while (0)
#define PG_DOT(buf, kk) do { float pv[8]; _Pragma("unroll") for (int j = 0; j < 8; ++j) { float f[16]; cvt16(buf[j], f); float s_ = 0.f; \
      _Pragma("unroll") for (int i = 0; i < 16; ++i) s_ += f[i] * xv[i]; pv[j] = s_; } \
      const float w0 = swap32_add(pv[0], pv[4]), w1 = swap32_add(pv[1], pv[5]), w2 = swap32_add(pv[2], pv[6]), w3 = swap32_add(pv[3], pv[7]); \
      const float z0 = swap16_add(w0, w2), z1 = swap16_add(w1, w3); \
      const bool hi8 = (lane & 8) != 0; \
      float y = (hi8 ? z1 : z0) + DPP_F(hi8 ? z0 : z1, 0x128); \
      y += DPP_F(y, 0xB1); y += DPP_F(y, 0x4E); y += DPP_F(y, 0x141); \
      const float t_ = __int_as_float(__builtin_amdgcn_ds_bpermute((lane & 7) * 32, __float_as_int(y))); \
      const int m_ = ((kk) >> 3) & 7; \
      if ((kk) < 64) d0 = ((lane >> 3) == m_) ? t_ : d0; else d1 = ((lane >> 3) == m_) ? t_ : d1; } while (0)
    PG_LOAD(bufA, TU, 0);
#pragma unroll 1
    for (int kk = 0; kk < 128; kk += 16) {
      PG_LOAD(bufB, TU, kk + 8);
      PG_DOT(bufA, kk);
      if (kk + 16 < 128) PG_LOAD(bufA, TU, kk + 16); else PG_LOAD(bufA, TV, 0);
      PG_DOT(bufB, kk + 8);
    }
    const float act0 = gelu_f(d0 * iu0) * gt0, act1 = gelu_f(d1 * iu1) * gt1;
#pragma unroll
    for (int i = 0; i < 16; ++i) o[i] = 0.f;
#define PG_ACC(buf, kk) do { _Pragma("unroll") for (int j = 0; j < 8; ++j) { const int k_ = (kk) + j; \
      const float a_ = __int_as_float(__builtin_amdgcn_readlane(__float_as_int(k_ < 64 ? act0 : act1), k_ & 63)); \
      float f[16]; cvt16(buf[j], f); _Pragma("unroll") for (int i = 0; i < 16; ++i) o[i] += a_ * f[i]; } } while (0)
#pragma unroll 1
    for (int kk = 0; kk < 128; kk += 16) {
      PG_LOAD(bufB, TV, kk + 8);
      PG_ACC(bufA, kk);
      if (kk + 16 < 128) PG_LOAD(bufA, TV, kk + 16);
      PG_ACC(bufB, kk + 8);
    }
#undef PG_LOAD
#undef PG_DOT
#undef PG_ACC
    const float* gate = P.mod() + (size_t)(layer * 5 + modrow(row)) * MODW + 5120;
    float* hr = P.h() + (size_t)row * DM;
    float hn[16];
    float ss = 0.f;
#pragma unroll
    for (int j = 0; j < 2; ++j)
#pragma unroll
      for (int q = 0; q < 2; ++q) {
        const int idx0 = lane * 16 + j * 8 + q * 4;
        float4 hv = *(float4*)(hr + idx0);
        const float4 gg = *(const float4*)(gate + idx0);
        hv.x += gg.x * o[j * 8 + q * 4 + 0]; hv.y += gg.y * o[j * 8 + q * 4 + 1];
        hv.z += gg.z * o[j * 8 + q * 4 + 2]; hv.w += gg.w * o[j * 8 + q * 4 + 3];
        if (layer == 0) *(float4*)(hr + idx0) = hv;
        hn[j * 8 + q * 4 + 0] = hv.x; hn[j * 8 + q * 4 + 1] = hv.y; hn[j * 8 + q * 4 + 2] = hv.z; hn[j * 8 + q * 4 + 3] = hv.w;
        ss += hv.x * hv.x + hv.y * hv.y + hv.z * hv.z + hv.w * hv.w;
      }
    ss = wave_sum(ss);
    const float rstd = rsqrtf(ss * (1.f / 1024.f) + 1e-6f);
    if (layer == 0) {
      const float* g1 = P.norm1_g + 1024;
      const float* mr = P.mod() + (size_t)(5 + modrow(row)) * MODW;
#pragma unroll
      for (int j = 0; j < 2; ++j) {
        const int idx0 = lane * 16 + j * 8;
        float ov[8];
#pragma unroll
        for (int e = 0; e < 8; ++e) ov[e] = hn[j * 8 + e] * rstd * g1[idx0 + e] * (1.f + mr[1024 + idx0 + e]) + mr[idx0 + e];
        *(uint4*)(P.u() + (size_t)row * DM + idx0) = make_uint4(pack2(ov[0], ov[1]), pack2(ov[2], ov[3]), pack2(ov[4], ov[5]), pack2(ov[6], ov[7]));
      }
    } else {
#pragma unroll
      for (int j = 0; j < 2; ++j)
#pragma unroll
        for (int q = 0; q < 2; ++q) {
          const int idx0 = lane * 16 + j * 8 + q * 4;
          const float4 gg = *(const float4*)(P.final_g + idx0);
          float4 ov;
          ov.x = hn[j * 8 + q * 4 + 0] * rstd * gg.x; ov.y = hn[j * 8 + q * 4 + 1] * rstd * gg.y;
          ov.z = hn[j * 8 + q * 4 + 2] * rstd * gg.z; ov.w = hn[j * 8 + q * 4 + 3] * rstd * gg.w;
          *(float4*)(P.out + (size_t)row * DM + idx0) = ov;
        }
    }
  }
}

__device__ void ph_final(int wv, const Params& P, int bid, int nb) {
  const int wave = otid(wv) >> 6, lane = otid(wv) & 63;
  for (int row = bid * NWAVE + wave; row < NLAT; row += nb * NWAVE) {
    const float* src = P.h() + (size_t)row * DM;
    float4 v[4];
    float ss = 0.f;
#pragma unroll
    for (int i = 0; i < 4; ++i) {
      v[i] = ((const float4*)src)[i * 64 + lane];
      ss += v[i].x * v[i].x + v[i].y * v[i].y + v[i].z * v[i].z + v[i].w * v[i].w;
    }
    ss = wave_sum(ss);
    const float rstd = rsqrtf(ss * (1.f / 1024.f) + 1e-6f);
#pragma unroll
    for (int i = 0; i < 4; ++i) {
      const int idx = i * 256 + lane * 4;
      const float4 gg = *(const float4*)(P.final_g + idx);
      float4 o;
      o.x = v[i].x * rstd * gg.x; o.y = v[i].y * rstd * gg.y; o.z = v[i].z * rstd * gg.z; o.w = v[i].w * rstd * gg.w;
      *(float4*)(P.out + (size_t)row * DM + idx) = o;
    }
  }
}


struct EpiOutproj {
  static constexpr bool PERM = false, AFTER_DRAIN = false;
  float* H; const float* hl; const float* hc; const float* modl;
  __device__ __forceinline__ void operator()(const pg8::f32x4 (&acc)[2][2][4][2], const pg8::Unit& u, int wr, int wc, int fr, int fq) const {
    const int row0 = u.pm * 256 + wr * 64 + fr, col0 = u.pn * 256 + wc * 32 + 4 * fq;
#pragma unroll
    for (int ai = 0; ai < 2; ++ai)
#pragma unroll
      for (int m = 0; m < 4; ++m) {
        const int row = row0 + ai * 128 + m * 16;
        const float* src = hrow(hl, hc, row) + col0;
        const float* gate = modl + (size_t)modrow(row) * MODW + 2048 + col0;
        float* dst = H + (size_t)row * DM + col0;
#pragma unroll
        for (int bj = 0; bj < 2; ++bj)
#pragma unroll
          for (int n = 0; n < 2; ++n) {
            const pg8::f32x4 s = *(const pg8::f32x4*)(src + bj * 128 + n * 16);
            const pg8::f32x4 g = *(const pg8::f32x4*)(gate + bj * 128 + n * 16);
            *(pg8::f32x4*)(dst + bj * 128 + n * 16) = s + g * acc[ai][bj][m][n];
          }
      }
  }
};

__device__ void ph_convert_tables(int wv, const Params& P, int layer, int bid, int nb) {
  const int lane = otid(wv) & 63;
  for (int it = bid * NWAVE + wv; it < 2 * 16384; it += nb * NWAVE) {
    const int t = it >> 14, e = it & 16383;
    const float* src = (t == 0 ? P.peer_u : P.peer_v) + ((size_t)layer * 16384 + e) * 1024 + lane * 16;
    float4 v[4];
    float m = 0.f;
#pragma unroll
    for (int i = 0; i < 4; ++i) {
      v[i] = ((const float4*)src)[i];
      m = fmaxf(m, fmaxf(fmaxf(fabsf(v[i].x), fabsf(v[i].y)), fmaxf(fabsf(v[i].z), fabsf(v[i].w))));
    }
    m = wave_max(m);
    int E = (int)((__float_as_uint(m) >> 23) & 0xffu);
    E = E < 8 ? 8 : E;
    const float sc = __uint_as_float((uint32_t)(261 - E) << 23);
    const float inv = __uint_as_float((uint32_t)(E - 7) << 23);
    uint4 o;
    uint32_t* op = (uint32_t*)&o;
#pragma unroll
    for (int i = 0; i < 4; ++i) {
      int p = __builtin_amdgcn_cvt_pk_fp8_f32(v[i].x * sc, v[i].y * sc, 0, false);
      p = __builtin_amdgcn_cvt_pk_fp8_f32(v[i].z * sc, v[i].w * sc, p, true);
      op[i] = (uint32_t)p;
    }
    *(uint4*)((t == 0 ? P.tabU() : P.tabV()) + (size_t)e * 1024 + lane * 16) = o;
    if (lane == 0) (t == 0 ? P.invU() : P.invV())[e] = inv;
  }
}

enum {
  PH_PREP = 0, PH_NORM1, PH_INPROJ, PH_CONV, PH_SSDPREP, PH_STATES, PH_SCAN, PH_SSDY, PH_SSDNORM, PH_POOL, PH_NA,
  PH_OUTPROJ, PH_NORM2, PH_QGEMM, PH_TOPK, PH_GATHER, PH_FINAL
};

#define SMEM_BYTES 131072

__device__ __forceinline__ void run_phase(int wv, const Params& P, int ph, int layer, char* smem, int bid, int nb) {
  const float* hl = layer == 0 ? P.x : P.h();
  const float* hc = layer == 0 ? P.ctx : P.h() + (size_t)NLAT * DM;
  const int nrows = layer == 0 ? NTOK : NLAT;
  switch (ph) {
    case PH_PREP:
      for (int i = bid * NTHR + otid(wv); i < 2 * 8 * 2 * 128 * 128; i += nb * NTHR) P.keysb()[i] = f2bf(P.peer_keys[i]);
      for (int i = bid * NTHR + otid(wv); i < 2 * 4 * 128 * 128; i += nb * NTHR) {
        const int k = i & 127, n = (i >> 7) & 127, lg = i >> 14;
        P.poolwT()[i] = f2bf(P.pool_w[((size_t)lg * 128 + k) * 128 + n]);
      }
      ph_mod(wv, P, (float*)smem, bid, nb);
      for (int l = 0; l < 2; ++l) {
        ph_transpose(wv, P.w_in + (size_t)l * 1024 * INW, P.w_inT() + (size_t)l * PW * 1024, 1024, INW, PW, 0, 2560, 32, PW, (float*)smem, bid, nb);
        ph_transpose(wv, P.w_in + (size_t)l * 1024 * INW, P.w_dtT() + (size_t)l * 128 * 1024, 1024, INW, 128, 2560, 1 << 30, 0, 32, (float*)smem, bid, nb);
        ph_transpose(wv, P.w_out + (size_t)l * 2048 * 1024, P.w_outT() + (size_t)l * 1024 * 2048, 2048, 1024, 1024, 0, 1 << 30, 0, 1024, (float*)smem, bid, nb);
        ph_transpose(wv, P.peer_wq + (size_t)l * 1024 * 2048, P.w_qT() + (size_t)l * 2048 * 1024, 1024, 2048, 2048, 0, 1 << 30, 0, 2048, (float*)smem, bid, nb);
      }
      break;
    case PH_NORM1:
      ph_norm(wv, hl, hc, P.norm1_g + layer * 1024, P.mod() + (size_t)layer * 5 * MODW, 0, 1024, NTOK, P.u(), bid, nb);
      break;
    case PH_INPROJ:
    {
      pg8::Gemm g{P.u(), P.w_inT() + (size_t)layer * PW * 1024, NTOK, PW, 1024};
      pg8::StaticOrder S; S.init(g.M, g.N, nb, bid);
      pg8::EpiBf16<0> E{P.p(), PW, nullptr, 0, 0};
      pg8::gemm_phase<pg8::EpiBf16<0>, pg8::StaticOrder, false>(wv, (PG8_LAS unsigned char*)smem, g, S, E, nullptr);
      ph_gemm<EPI_INPROJ>(wv, P, layer, P.u(), P.w_dtT() + (size_t)layer * 128 * 1024, NTOK, 128, 1024, hl, hc, smem, bid, nb);
      break;
    }
    case PH_CONV: ph_conv(wv, P, layer, bid, nb); ph_vtranspose(wv, P, smem, bid, nb); break;
    case PH_SSDPREP: ph_ssdprep(wv, P, layer, smem, bid, nb); break;
    case PH_STATES: ph_states_mfma(wv, P, layer, smem, bid, nb); break;
    case PH_SCAN: ph_scan(wv, P, bid, nb); break;
    case PH_SSDY: ph_ssdy_mfma(wv, P, layer, nrows / 128, smem, bid, nb); break;
    case PH_SSDNORM: ph_ssdnorm(wv, P, layer, nrows, bid, nb); break;
    case PH_POOL: ph_pool_mfma(wv, P, layer, nrows, bid, nb); break;
    case PH_NA: ph_na_mfma(wv, P, layer, nrows, bid, nb); break;
    case PH_OUTPROJ:
    {
      pg8::Gemm g{P.concat(), P.w_outT() + (size_t)layer * 1024 * 2048, nrows, 1024, 2048};
      pg8::StaticOrder S; S.init(g.M, g.N, nb, bid);
      EpiOutproj E{P.h(), hl, hc, P.mod() + (size_t)layer * 5 * MODW};
      pg8::gemm_phase<EpiOutproj, pg8::StaticOrder, false>(wv, (PG8_LAS unsigned char*)smem, g, S, E, nullptr);
      break;
    }
    case PH_NORM2:
      ph_norm(wv, P.h(), P.h() + (size_t)NLAT * DM, P.norm2_g + layer * 1024, P.mod() + (size_t)layer * 5 * MODW, 3072, 4096, nrows, P.u(), bid, nb);
      break;
    case PH_QGEMM:
    {
      pg8::Gemm g{P.u(), P.w_qT() + (size_t)layer * 2048 * 1024, nrows, 2048, 1024};
      pg8::StaticOrder S; S.init(g.M, g.N, nb, bid);
      pg8::EpiBf16<0> E{P.q(), 2048, nullptr, 0, 0};
      pg8::gemm_phase<pg8::EpiBf16<0>, pg8::StaticOrder, false>(wv, (PG8_LAS unsigned char*)smem, g, S, E, nullptr);
      ph_convert_tables(wv, P, layer, bid, nb);
      break;
    }
    case PH_TOPK: ph_peer_topk_mfma(wv, P, layer, nrows, smem, bid, nb); break;
    case PH_GATHER: ph_peer_gather(wv, P, layer, nrows, bid, nb); break;
    case PH_FINAL: ph_final(wv, P, bid, nb); break;
  }
}

namespace cg = cooperative_groups;
typedef const __attribute__((address_space(4))) Params* kparams_t;
__device__ __forceinline__ const Params& kp_fresh() {
  kparams_t kp = (kparams_t)__builtin_amdgcn_kernarg_segment_ptr();
  asm volatile("" : "+s"(kp));
  return *(const Params*)kp;
}
__global__ void __launch_bounds__(NTHR) k_mega(Params P_unused) {
  __shared__ __attribute__((aligned(16))) char smem[SMEM_BYTES + 16];
  cg::grid_group grid = cg::this_grid();
  const int bid = blockIdx.x, nb = gridDim.x;
  const int wv = __builtin_amdgcn_readfirstlane(threadIdx.x >> 6);
  if (threadIdx.x == 0) *(uint4*)(smem + SMEM_BYTES) = make_uint4(0u, 0u, 0u, 0u);
  __syncthreads();
  (void)xcd_barrier_post((unsigned*)(kp_fresh().ws + WS_BAR), (volatile LAS unsigned*)(smem + SMEM_BYTES), threadIdx.x == 0);
#define GSYNC() do { XcdBarrier xb_; xb_.bar = (unsigned*)(kp_fresh().ws + WS_BAR); xb_.x = xb_xcc_id(); \
    xb_.st = (volatile LAS unsigned*)(smem + SMEM_BYTES); xcd_barrier(xb_, otid(wv) == 0); } while (0)
  run_phase(wv, kp_fresh(), PH_PREP, 0, smem, bid, nb);
  grid.sync();
  run_phase(wv, kp_fresh(), PH_NORM1, 0, smem, bid, nb); GSYNC();
#pragma unroll 1
  for (int layer = 0; layer < 2; ++layer) {
    run_phase(wv, kp_fresh(), PH_INPROJ, layer, smem, bid, nb); GSYNC();
    run_phase(wv, kp_fresh(), PH_CONV, layer, smem, bid, nb);
    run_phase(wv, kp_fresh(), PH_SSDPREP, layer, smem, bid, nb); GSYNC();
    run_phase(wv, kp_fresh(), PH_CONV, layer, smem, bid, nb);
    run_phase(wv, kp_fresh(), PH_SSDPREP, layer, smem, bid, nb); GSYNC();
    run_phase(wv, kp_fresh(), PH_STATES, layer, smem, bid, nb);
    run_phase(wv, kp_fresh(), PH_POOL, layer, smem, bid, nb);
    run_phase(wv, kp_fresh(), PH_NA, layer, smem, bid, nb); GSYNC();
    run_phase(wv, kp_fresh(), PH_SCAN, layer, smem, bid, nb); GSYNC();
    run_phase(wv, kp_fresh(), PH_SSDY, layer, smem, bid, nb); GSYNC();
    run_phase(wv, kp_fresh(), PH_SSDNORM, layer, smem, bid, nb); GSYNC();
    run_phase(wv, kp_fresh(), PH_OUTPROJ, layer, smem, bid, nb); GSYNC();
    run_phase(wv, kp_fresh(), PH_NORM2, layer, smem, bid, nb); GSYNC();
    run_phase(wv, kp_fresh(), PH_QGEMM, layer, smem, bid, nb); GSYNC();
    run_phase(wv, kp_fresh(), PH_TOPK, layer, smem, bid, nb); GSYNC();
    run_phase(wv, kp_fresh(), PH_GATHER, layer, smem, bid, nb);
    if (layer == 0) GSYNC();
  }
}

extern "C" void kernel_launch(void* const* d_in, const int* in_sizes, int n_in, void* d_out, int out_size, void* d_ws,
                              size_t ws_size, hipStream_t stream) {
  Params P{};
  const float* const* in = (const float* const*)d_in;
  P.x = in[0]; P.c = in[1]; P.ctx = in[2]; P.c_ctx = in[3]; P.ada_w = in[4]; P.ada_b = in[5]; P.norm1_g = in[6];
  P.w_in = in[7]; P.conv_w = in[8]; P.conv_b = in[9]; P.a_log = in[10]; P.dt_bias = in[11]; P.d_skip = in[12];
  P.ssd_norm_g = in[13]; P.pool_w = in[14]; P.pool_scale = in[15]; P.na_rpb = in[16]; P.w_out = in[17];
  P.norm2_g = in[18]; P.peer_wq = in[19]; P.peer_keys = in[20]; P.peer_u = in[21]; P.peer_v = in[22]; P.final_g = in[23];
  P.out = (float*)d_out;
  P.ws = (char*)d_ws;
  if (WS_TOTAL > ws_size) { fprintf(stderr, "workspace too small: need %zu have %zu\n", (size_t)WS_TOTAL, ws_size); return; }

  static int grid_blocks = 0;
  if (!grid_blocks) {
    int dev = 0, cus = 0, per_cu = 0;
    hipGetDevice(&dev);
    hipDeviceGetAttribute(&cus, hipDeviceAttributeMultiprocessorCount, dev);
    hipOccupancyMaxActiveBlocksPerMultiprocessor(&per_cu, k_mega, NTHR, 0);
    if (per_cu > 4) per_cu = 4;
    grid_blocks = cus * per_cu;
  }
  hipMemsetAsync((char*)d_ws + WS_BAR, 0, 4096 * 4, stream);
  void* args[] = {&P};
  hipError_t e = hipLaunchCooperativeKernel((void*)k_mega, dim3(grid_blocks), dim3(NTHR), args, 0, stream);
  if (e != hipSuccess) fprintf(stderr, "cooperative launch failed: %s (grid %d)\n", hipGetErrorString(e), grid_blocks);
}
```

```cpp
#include <hip/hip_runtime.h>
#include <hip/hip_bf16.h>
#include <hip/hip_cooperative_groups.h>
#include <stdint.h>
#include <stdio.h>

typedef unsigned short bf16_t;
typedef __attribute__((ext_vector_type(8))) short bf16x8;
typedef __attribute__((ext_vector_type(4))) float f32x4;

#define NTHR 512
#define NWAVE 8
constexpr int DM = 1024;
constexpr int SEQ = 4096;
constexpr int NLAT = 16384;
constexpr int NCTXR = 1024;
constexpr int NTOK = 17408;
constexpr int INW = 4640;
constexpr int PW = 4608;
constexpr int OFF_Z = 0, OFF_XBC = 1024, OFF_POOL = 2560, OFF_Q = 3072, OFF_K = 3584, OFF_V = 4096;
constexpr int NCHUNK = 136;
constexpr int MODW = 6144;

constexpr size_t al256(size_t x) { return (x + 255) & ~(size_t)255; }
constexpr size_t WS_MOD = 0;
constexpr size_t WS_H = WS_MOD + al256((size_t)2 * 5 * MODW * 4);
constexpr size_t WS_P = WS_H + al256((size_t)NTOK * DM * 4);
constexpr size_t WS_TABU = WS_P + (size_t)80 * 1024 * 1024;
constexpr size_t WS_TABV = WS_TABU + (size_t)16384 * 512;
constexpr size_t WS_INVU = WS_TABV + (size_t)16384 * 512;
constexpr size_t WS_INVV = WS_INVU + (size_t)16384 * 4;
constexpr size_t WS_DTRAW = WS_P + al256((size_t)NTOK * PW * 2);
constexpr size_t WS_DTV = WS_DTRAW + al256((size_t)NTOK * 32 * 4);
constexpr size_t WS_CSV = WS_DTV + al256((size_t)NTOK * 32 * 4);
constexpr size_t WS_XBC = WS_CSV + al256((size_t)NTOK * 32 * 4);
constexpr size_t WS_VTL = WS_XBC + al256((size_t)NTOK * 512 * 2);
constexpr size_t WS_VTC = WS_VTL + al256((size_t)4 * 8 * 64 * 4096 * 2);
constexpr size_t WS_KEYSB = WS_VTC + al256((size_t)4 * 8 * 64 * 256 * 2);
constexpr size_t WS_POOLWT = WS_KEYSB + al256((size_t)2 * 8 * 2 * 128 * 128 * 2);
constexpr size_t WS_STATES = WS_XBC + al256((size_t)NTOK * 1536 * 2);
static_assert(WS_POOLWT + (size_t)2 * 4 * 128 * 128 * 2 <= WS_STATES, "must fit in the old xbc region");
constexpr size_t WS_CONCAT = WS_STATES + al256((size_t)NCHUNK * 32 * 8192 * 2);
constexpr size_t WS_SELIDX = WS_CONCAT + al256((size_t)NTOK * 2048 * 2);
constexpr size_t WS_SELG = WS_SELIDX + al256((size_t)NTOK * 128 * 4);
constexpr size_t WS_WINT = WS_SELG + al256((size_t)NTOK * 128 * 4);
constexpr size_t WS_WDTT = WS_WINT + al256((size_t)2 * PW * 1024 * 2);
constexpr size_t WS_WOUTT = WS_WDTT + al256((size_t)2 * 128 * 1024 * 2);
constexpr size_t WS_WQT = WS_WOUTT + al256((size_t)2 * 1024 * 2048 * 2);
constexpr size_t WS_BAR = WS_WQT + al256((size_t)2 * 2048 * 1024 * 2);
constexpr size_t WS_TOTAL = WS_BAR + al256((size_t)4096 * 4);
static_assert(WS_INVV + (size_t)16384 * 4 <= WS_DTRAW, "tables must fit in the tail of p");
static_assert((size_t)NTOK * 2048 * 2 <= (size_t)80 * 1024 * 1024, "q must fit below the tables");

struct Params {
  const float *x, *c, *ctx, *c_ctx, *ada_w, *ada_b, *norm1_g, *w_in, *conv_w, *conv_b, *a_log, *dt_bias, *d_skip,
      *ssd_norm_g, *pool_w, *pool_scale, *na_rpb, *w_out, *norm2_g, *peer_wq, *peer_keys, *peer_u, *peer_v, *final_g;
  float* out;
  char* ws;
  __device__ __forceinline__ float* mod() const { return (float*)(ws + WS_MOD); }
  __device__ __forceinline__ float* h() const { return (float*)(ws + WS_H); }
  __device__ __forceinline__ bf16_t* u() const { return (bf16_t*)(ws + WS_CONCAT); }
  __device__ __forceinline__ bf16_t* p() const { return (bf16_t*)(ws + WS_P); }
  __device__ __forceinline__ float* dtraw() const { return (float*)(ws + WS_DTRAW); }
  __device__ __forceinline__ float* dtv() const { return (float*)(ws + WS_DTV); }
  __device__ __forceinline__ float* csv() const { return (float*)(ws + WS_CSV); }
  __device__ __forceinline__ bf16_t* xbc() const { return (bf16_t*)(ws + WS_XBC); }
  __device__ __forceinline__ bf16_t* states() const { return (bf16_t*)(ws + WS_STATES); }
  __device__ __forceinline__ bf16_t* concat() const { return (bf16_t*)(ws + WS_CONCAT); }
  __device__ __forceinline__ bf16_t* q() const { return (bf16_t*)(ws + WS_P); }
  __device__ __forceinline__ int* sel_idx() const { return (int*)(ws + WS_SELIDX); }
  __device__ __forceinline__ float* sel_g() const { return (float*)(ws + WS_SELG); }
  __device__ __forceinline__ bf16_t* w_inT() const { return (bf16_t*)(ws + WS_WINT); }
  __device__ __forceinline__ bf16_t* w_dtT() const { return (bf16_t*)(ws + WS_WDTT); }
  __device__ __forceinline__ bf16_t* w_outT() const { return (bf16_t*)(ws + WS_WOUTT); }
  __device__ __forceinline__ bf16_t* w_qT() const { return (bf16_t*)(ws + WS_WQT); }
  __device__ __forceinline__ bf16_t* vtl() const { return (bf16_t*)(ws + WS_VTL); }
  __device__ __forceinline__ bf16_t* vtc() const { return (bf16_t*)(ws + WS_VTC); }
  __device__ __forceinline__ bf16_t* poolwT() const { return (bf16_t*)(ws + WS_POOLWT); }
  __device__ __forceinline__ bf16_t* keysb() const { return (bf16_t*)(ws + WS_KEYSB); }
  __device__ __forceinline__ unsigned char* tabU() const { return (unsigned char*)(ws + WS_TABU); }
  __device__ __forceinline__ unsigned char* tabV() const { return (unsigned char*)(ws + WS_TABV); }
  __device__ __forceinline__ float* invU() const { return (float*)(ws + WS_INVU); }
  __device__ __forceinline__ float* invV() const { return (float*)(ws + WS_INVV); }
};

__device__ __forceinline__ int otid(int wv) {
  int l;
  asm volatile("v_mbcnt_lo_u32_b32 %0, -1, 0\n\tv_mbcnt_hi_u32_b32 %0, -1, %0" : "=v"(l));
  return (wv << 6) | l;
}
__device__ __forceinline__ float bf2f(bf16_t v) { return __uint_as_float(((uint32_t)v) << 16); }
__device__ __forceinline__ bf16_t f2bf(float f) {
  uint32_t u = __float_as_uint(f);
  u += 0x7fffu + ((u >> 16) & 1u);
  return (bf16_t)(u >> 16);
}
#define DPP_F(v, ctrl) __int_as_float(__builtin_amdgcn_update_dpp(0, __float_as_int(v), (ctrl), 0xf, 0xf, true))
__device__ __forceinline__ float wave_sum(float v) {
  v += DPP_F(v, 0xB1);
  v += DPP_F(v, 0x4E);
  v += DPP_F(v, 0x141);
  v += DPP_F(v, 0x140);
  const int iv = __float_as_int(v);
  return __int_as_float(__builtin_amdgcn_readlane(iv, 0)) + __int_as_float(__builtin_amdgcn_readlane(iv, 16)) +
         __int_as_float(__builtin_amdgcn_readlane(iv, 32)) + __int_as_float(__builtin_amdgcn_readlane(iv, 48));
}
__device__ __forceinline__ float wave_max(float v) {
  v = fmaxf(v, DPP_F(v, 0xB1));
  v = fmaxf(v, DPP_F(v, 0x4E));
  v = fmaxf(v, DPP_F(v, 0x141));
  v = fmaxf(v, DPP_F(v, 0x140));
  const int iv = __float_as_int(v);
  return fmaxf(fmaxf(__int_as_float(__builtin_amdgcn_readlane(iv, 0)), __int_as_float(__builtin_amdgcn_readlane(iv, 16))),
               fmaxf(__int_as_float(__builtin_amdgcn_readlane(iv, 32)), __int_as_float(__builtin_amdgcn_readlane(iv, 48))));
}
__device__ __forceinline__ float silu_f(float v) { return v / (1.f + expf(-v)); }
__device__ __forceinline__ float softplus_f(float v) { return fmaxf(v, 0.f) + log1pf(expf(-fabsf(v))); }
__device__ __forceinline__ float gelu_f(float v) { return 0.5f * v * (1.f + erff(v * 0.70710678118654752f)); }

__device__ __forceinline__ void unpack8(const uint4 v, float* f) {
  f[0] = __uint_as_float(v.x << 16); f[1] = __uint_as_float(v.x & 0xffff0000u);
  f[2] = __uint_as_float(v.y << 16); f[3] = __uint_as_float(v.y & 0xffff0000u);
  f[4] = __uint_as_float(v.z << 16); f[5] = __uint_as_float(v.z & 0xffff0000u);
  f[6] = __uint_as_float(v.w << 16); f[7] = __uint_as_float(v.w & 0xffff0000u);
}
__device__ __forceinline__ uint32_t pack2(float a, float b) { return (uint32_t)f2bf(a) | ((uint32_t)f2bf(b) << 16); }
typedef float f32x2_t __attribute__((ext_vector_type(2)));
typedef short s16x4 __attribute__((ext_vector_type(4)));
typedef __attribute__((address_space(3))) s16x4 lds_s16x4;
__device__ __forceinline__ bf16x8 tr_read2(const char* a0, const char* a1) {
  const s16x4 a = __builtin_amdgcn_ds_read_tr16_b64_v4i16((lds_s16x4*)a0);
  const s16x4 b = __builtin_amdgcn_ds_read_tr16_b64_v4i16((lds_s16x4*)a1);
  return (bf16x8){a[0], a[1], a[2], a[3], b[0], b[1], b[2], b[3]};
}

__device__ __forceinline__ const float* hrow(const float* hl, const float* hc, int row) {
  return row < NLAT ? hl + (size_t)row * DM : hc + (size_t)(row - NLAT) * DM;
}
__device__ __forceinline__ int modrow(int row) { return row < NLAT ? (row >> 12) : 4; }

namespace pg8 {
#define PG8_LAS __attribute__((address_space(3)))
typedef unsigned short bf16_t;
typedef short bf16x8 __attribute__((ext_vector_type(8)));
typedef float f32x4 __attribute__((ext_vector_type(4)));
typedef unsigned u32x4 __attribute__((ext_vector_type(4)));
constexpr int BM = 256, BK = 64, HALF = 128, HTB = HALF * BK * 2  , STAGE_BYTES = 8 * HTB, NXCD = 8, WGM = 8;

__host__ __device__ __forceinline__ int lds_byte(int r, int c) { const int st = (r >> 4) * 2 + (c >> 5), rr = r & 15, cc = c & 31, ob = rr * 64 + cc * 2; return st * 1024 + (ob ^ (((ob >> 9) & 1) << 5)); }
__host__ __device__ __forceinline__ void stage_rc(int b, int& R, int& C) { const int st = b / 1024, sb = b % 1024, swz = sb ^ (((sb >> 9) & 1) << 5); R = (st >> 1) * 16 + swz / 64; C = (st & 1) * 32 + (swz % 64) / 2; }
__host__ __device__ __forceinline__ int perm32(int rho) { const int n = rho >> 4, i = rho & 15; return 8 * (i >> 2) + 4 * n + (i & 3); }

struct Unit { int pm, pn; };
struct Gemm { const bf16_t* A; const bf16_t* Bt; int M, N, K; };

struct StaticOrder {
    int nM, nN, nwg, G, c;
    __host__ __device__ void init(int M, int N, int G_, int c_) { nM = M / BM; nN = N / BM; nwg = nM * nN; G = G_; c = c_; }
    __host__ __device__ bool next(int i, Unit& u) const {
        const long L = (long)i * G + c; if (L >= nwg) return false;
        int wgid = (int)L; { const int q = nwg / NXCD, r = nwg % NXCD, xcd = wgid % NXCD, off = wgid / NXCD; wgid = (xcd < r ? xcd * (q + 1) : r * (q + 1) + (xcd - r) * q) + off; }
        const int nig = WGM * nN, gid = wgid / nig, fm = gid * WGM, gsz = (nM - fm) < WGM ? (nM - fm) : WGM;
        u.pm = fm + ((wgid % nig) % gsz); u.pn = (wgid % nig) / gsz; return true;
    }
    __device__ __forceinline__ void a_ready(const Unit&) const {}
    __device__ __forceinline__ void done(const Unit&) const {}
};

__device__ __forceinline__ unsigned cvt_pk_bf16(float lo, float hi) { unsigned r; asm volatile("v_cvt_pk_bf16_f32 %0, %1, %2" : "=v"(r) : "v"(lo), "v"(hi)); return r; }
typedef float f32x2 __attribute__((ext_vector_type(2)));
__device__ __forceinline__ f32x2 gelu_pk(f32x2 v) { return v; }
template <int ACT  > struct EpiBf16 {
    static constexpr bool PERM = true, AFTER_DRAIN = false;
    bf16_t* O; int ldc; const float* bias; int split_cols; size_t split_stride;
    __device__ __forceinline__ void operator()(const f32x4 (&acc)[2][2][4][2], const Unit& u, int wr, int wc, int fr, int fq) const {
        const int row0 = u.pm * BM + wr * 64 + fr; int colt = u.pn * BM; bf16_t* base = O;
        if (split_cols) { const int t = colt / split_cols; base += (size_t)t * split_stride; colt -= t * split_cols; }
        const int col0 = colt + wc * 32 + 8 * fq, bcol0 = u.pn * BM + wc * 32 + 8 * fq;
        f32x4 bv[2][2];
#pragma unroll
        for (int bj = 0; bj < 2; ++bj)
#pragma unroll
            for (int n = 0; n < 2; ++n) bv[bj][n] = bias ? *(const f32x4*)(bias + bcol0 + bj * HALF + 4 * n) : (f32x4){0.f, 0.f, 0.f, 0.f};
#pragma unroll
        for (int ai = 0; ai < 2; ++ai)
#pragma unroll
            for (int m = 0; m < 4; ++m) { bf16_t* rowp = base + (size_t)(row0 + ai * HALF + m * 16) * ldc + col0;
#pragma unroll
                for (int bj = 0; bj < 2; ++bj) { f32x4 v0 = acc[ai][bj][m][0] + bv[bj][0], v1 = acc[ai][bj][m][1] + bv[bj][1];
                    if (ACT == 1) { f32x2 a = gelu_pk((f32x2){v0[0], v0[1]}), b = gelu_pk((f32x2){v0[2], v0[3]}), c = gelu_pk((f32x2){v1[0], v1[1]}), d = gelu_pk((f32x2){v1[2], v1[3]});
                        v0 = (f32x4){a.x, a.y, b.x, b.y}; v1 = (f32x4){c.x, c.y, d.x, d.y}; }
                    if (ACT == 2) {
#pragma unroll
                        for (int j = 0; j < 4; ++j) { v0[j] = 0.5f * v0[j] * (1.0f + erff(v0[j] * 0.70710678f)); v1[j] = 0.5f * v1[j] * (1.0f + erff(v1[j] * 0.70710678f)); } }
                    u32x4 w; w.x = cvt_pk_bf16(v0[0], v0[1]); w.y = cvt_pk_bf16(v0[2], v0[3]); w.z = cvt_pk_bf16(v1[0], v1[1]); w.w = cvt_pk_bf16(v1[2], v1[3]);
                    *(u32x4*)(rowp + bj * HALF) = w; } }
    }
};

template <class Epi, class Sched, bool STAMP = false>
__device__ __forceinline__ void gemm_phase(int wv, PG8_LAS unsigned char* lds, const Gemm g, const Sched& S, const Epi& E, unsigned long long* stamps) {
    const int tid = otid(wv), wid = __builtin_amdgcn_readfirstlane(tid >> 6), lane = tid & 63, wr = wid >> 2, wc = wid & 3, fr = lane & 15, fq = lane >> 4;
    const int K = g.K, nt = K / BK;
    int ts_lo = 0, ts_hi = 0, nts = 0; const unsigned long long rt_entry = STAMP ? (unsigned long long)wall_clock64() : 0ull;
#define PG8_STAMP() do { if (STAMP && wid == 0 && nts < 64) { const unsigned long long _c = (unsigned long long)clock64(); \
        ts_lo = (lane == nts) ? (int)(unsigned)_c : ts_lo; ts_hi = (lane == nts) ? (int)(unsigned)(_c >> 32) : ts_hi; ++nts; } } while (0)
    PG8_STAMP();
    unsigned voffA[2], voffB[2];
#pragma unroll
    for (int i = 0; i < 2; ++i) { int R, C; stage_rc(tid * 16 + i * 8192, R, C); const int Rb = Epi::PERM ? ((R & ~31) + perm32(R & 31)) : R;
        voffA[i] = (unsigned)(R * K + C) * 2u; voffB[i] = (unsigned)(Rb * K + C) * 2u; }
    const size_t kstep = (size_t)(BK * 2);
    const size_t hstep = (size_t)HALF * K * 2;
    const size_t tstep = 2 * hstep;
    const unsigned ldsw = (unsigned)wid * 1024u;
    const int aoff = lds_byte(wr * 64 + fr, fq * 8), boff = lds_byte(wc * 32 + fr, fq * 8);
#define PG8_SA(b, h) (((b) * 2 + (h)) * HTB)
#define PG8_SB(b, h) ((4 + (b) * 2 + (h)) * HTB)
#define PG8_STAGE(bufoff, gbase, voff) do { _Pragma("unroll") for (int _i = 0; _i < 2; ++_i) \
        __builtin_amdgcn_global_load_lds((const unsigned*)((const char*)(gbase) + (voff)[_i]), (PG8_LAS unsigned*)(lds + (bufoff) + ldsw + _i * 8192), 16, 0, 0); } while (0)
#define PG8_LDA(dst, b, h) do { _Pragma("unroll") for (int m = 0; m < 4; ++m) _Pragma("unroll") for (int k = 0; k < 2; ++k) dst[m][k] = *(const PG8_LAS bf16x8*)(lds + PG8_SA(b, h) + aoff + m * 2048 + k * 1024); } while (0)
#define PG8_LDB(dst, b, h) do { _Pragma("unroll") for (int n = 0; n < 2; ++n) _Pragma("unroll") for (int k = 0; k < 2; ++k) dst[n][k] = *(const PG8_LAS bf16x8*)(lds + PG8_SB(b, h) + boff + n * 2048 + k * 1024); } while (0)
#define PG8_MMA(ai, bj, At, Bt) do { __builtin_amdgcn_s_setprio(1); _Pragma("unroll") for (int m = 0; m < 4; ++m) _Pragma("unroll") for (int n = 0; n < 2; ++n) _Pragma("unroll") for (int k = 0; k < 2; ++k) \
        acc[ai][bj][m][n] = __builtin_amdgcn_mfma_f32_16x16x32_bf16(Bt[n][k], At[m][k], acc[ai][bj][m][n], 0, 0, 0); __builtin_amdgcn_s_setprio(0); } while (0)
#define PG8_WAIT_V(n) asm volatile("s_waitcnt vmcnt(" #n ")" ::: "memory")
#define PG8_WAIT_L(n) asm volatile("s_waitcnt lgkmcnt(" #n ")" ::: "memory")
#define PG8_BAR __builtin_amdgcn_s_barrier()
#define PG8_SCHED __builtin_amdgcn_sched_barrier(0)
    Unit cur, nxt; int ui = 0;
    if (!S.next(0, cur)) return;
    f32x4 acc[2][2][4][2];
#pragma unroll
    for (int a = 0; a < 2; ++a)
#pragma unroll
        for (int b = 0; b < 2; ++b)
#pragma unroll
            for (int m = 0; m < 4; ++m)
#pragma unroll
                for (int n = 0; n < 2; ++n) acc[a][b][m][n] = (f32x4){0.f, 0.f, 0.f, 0.f};
    bf16x8 At[4][2], B0[2][2], B1[2][2];
    const char* cA = (const char*)g.A + (size_t)cur.pm * tstep; const char* cB = (const char*)g.Bt + (size_t)cur.pn * tstep;
    S.a_ready(cur);
    PG8_STAGE(PG8_SB(0, 0), cB, voffB); PG8_STAGE(PG8_SA(0, 0), cA, voffA); PG8_STAGE(PG8_SB(0, 1), cB + hstep, voffB); PG8_STAGE(PG8_SA(0, 1), cA + hstep, voffA);
    if (wr == 1) PG8_BAR;
    PG8_WAIT_V(4); PG8_BAR;
    PG8_STAGE(PG8_SB(1, 0), cB + kstep, voffB); PG8_STAGE(PG8_SA(1, 0), cA + kstep, voffA); PG8_STAGE(PG8_SB(1, 1), cB + hstep + kstep, voffB);
    PG8_WAIT_V(6); PG8_BAR;
    PG8_STAMP();
    for (;;) {
        const bool has_next = S.next(ui + 1, nxt);
        const char* nA = has_next ? (const char*)g.A + (size_t)nxt.pm * tstep : cA; const char* nB = has_next ? (const char*)g.Bt + (size_t)nxt.pn * tstep : cB;
        for (int t = 0; t < nt; t += 2) {
            const bool last = (t == nt - 2);
            const char* a1 = cA + (size_t)(t + 1) * kstep;
            const char* a2 = last ? nA : cA + (size_t)(t + 2) * kstep; const char* b2 = last ? nB : cB + (size_t)(t + 2) * kstep;
            const char* a3 = a2 + kstep; const char* b3 = b2 + kstep;
            if (last && has_next) S.a_ready(nxt);
            PG8_LDB(B0, 0, 0); PG8_SCHED; PG8_LDA(At, 0, 0); PG8_STAGE(PG8_SA(1, 1), a1 + hstep, voffA);
            PG8_WAIT_L(8); PG8_BAR; PG8_WAIT_L(0); PG8_MMA(0, 0, At, B0); PG8_BAR; PG8_SCHED;
            PG8_LDB(B1, 0, 1); PG8_STAGE(PG8_SB(0, 0), b2, voffB);
            PG8_BAR; PG8_WAIT_L(0); PG8_MMA(0, 1, At, B1); PG8_BAR;
            PG8_LDA(At, 0, 1); PG8_STAGE(PG8_SA(0, 0), a2, voffA);
            PG8_BAR; PG8_WAIT_L(0); PG8_MMA(1, 0, At, B0); PG8_BAR; PG8_SCHED;
            PG8_STAGE(PG8_SB(0, 1), b2 + hstep, voffB);
            PG8_WAIT_V(6); PG8_BAR; PG8_MMA(1, 1, At, B1); PG8_BAR;
            PG8_LDB(B0, 1, 0); PG8_SCHED; PG8_LDA(At, 1, 0); PG8_STAGE(PG8_SA(0, 1), a2 + hstep, voffA);
            PG8_WAIT_L(8); PG8_BAR; PG8_WAIT_L(0); PG8_MMA(0, 0, At, B0); PG8_BAR; PG8_SCHED;
            PG8_LDB(B1, 1, 1); PG8_STAGE(PG8_SB(1, 0), b3, voffB);
            PG8_BAR; PG8_WAIT_L(0); PG8_MMA(0, 1, At, B1); PG8_BAR;
            PG8_LDA(At, 1, 1); PG8_STAGE(PG8_SA(1, 0), a3, voffA);
            PG8_BAR; PG8_WAIT_L(0); PG8_MMA(1, 0, At, B0); PG8_BAR; PG8_SCHED;
            PG8_STAGE(PG8_SB(1, 1), b3 + hstep, voffB);
            PG8_WAIT_V(6); PG8_BAR; PG8_MMA(1, 1, At, B1); PG8_BAR;
        }
        PG8_STAMP();
        if constexpr (!Epi::AFTER_DRAIN) { E(acc, cur, wr, wc, fr, fq); S.done(cur); }
        PG8_STAMP();
        if (!has_next) break;
#pragma unroll
        for (int a = 0; a < 2; ++a)
#pragma unroll
            for (int b = 0; b < 2; ++b)
#pragma unroll
                for (int m = 0; m < 4; ++m)
#pragma unroll
                    for (int n = 0; n < 2; ++n) acc[a][b][m][n] = (f32x4){0.f, 0.f, 0.f, 0.f};
        cur = nxt; cA = nA; cB = nB; ++ui;
    }
    PG8_WAIT_V(0);
    if (wr == 0) PG8_BAR;
    PG8_BAR;
    if constexpr (Epi::AFTER_DRAIN) { E.fused(acc, cur, wr, wc, fr, fq, lds, wid, lane); S.done(cur); }
    PG8_STAMP();
    if (STAMP && wid == 0) { stamps[lane] = lane < nts ? (((unsigned long long)(unsigned)ts_hi << 32) | (unsigned)ts_lo) : 0ull;
        if (lane == 62) stamps[62] = rt_entry; if (lane == 63) stamps[63] = (unsigned long long)wall_clock64(); }
#undef PG8_STAMP
#undef PG8_SA
#undef PG8_SB
#undef PG8_STAGE
#undef PG8_LDA
#undef PG8_LDB
#undef PG8_MMA
#undef PG8_WAIT_V
#undef PG8_WAIT_L
#undef PG8_BAR
#undef PG8_SCHED
}
}

#define XB_TMO      128
#define XB_XCNT(j)  (256  + 64 * (j))
#define XB_XSUB(j)  (1280 + 64 * (j))
#define XB_XGEN(j)  (2304 + 64 * (j))
#define XB_TOP      3328
#define XB_TOPGEN   3392
#define XCD_BAR_WORDS 3456
#define XB_SPIN_CAP (1u << 27)
#define LAS __attribute__((address_space(3)))

__device__ __forceinline__ unsigned xb_ld(unsigned* p)              { return __hip_atomic_load(p, __ATOMIC_RELAXED, __HIP_MEMORY_SCOPE_AGENT); }
__device__ __forceinline__ unsigned xb_add(unsigned* p, unsigned v) { return __hip_atomic_fetch_add(p, v, __ATOMIC_RELAXED, __HIP_MEMORY_SCOPE_AGENT); }
__device__ __forceinline__ unsigned xb_xcc_id() { return (unsigned)__builtin_amdgcn_s_getreg((3 << 11) | 20) & 0xFu; }
#define XB_SPIN(cond, bar) do { unsigned _sp = 0; while (cond) { __builtin_amdgcn_s_sleep(1); \
    if ((++_sp & 255u) == 0u) { if (xb_ld(&(bar)[XB_TMO])) break; if (_sp > XB_SPIN_CAP) { atomicAdd(&(bar)[XB_TMO], 1u); break; } } } } while (0)

struct XcdBarrier {
    unsigned* bar; unsigned x;
    volatile LAS unsigned* st;
};

__device__ __forceinline__ XcdBarrier xcd_barrier_post(unsigned* bar, volatile LAS unsigned* st, bool xb_t0) {
    XcdBarrier b; b.bar = bar; b.x = xb_xcc_id(); b.st = st;
    if (xb_t0) (void)xb_add(&bar[XB_XCNT(b.x)], 1u);
    return b;
}
__device__ __forceinline__ void xcd_barrier_complete(unsigned* bar, unsigned x, unsigned& nloc, unsigned& nx) {
    const unsigned G = gridDim.x * gridDim.y * gridDim.z;
    unsigned sum, cnt, mine, sp = 0u;
    for (;;) {
        sum = 0u; cnt = 0u; mine = 0u;
#pragma unroll
        for (unsigned j = 0; j < 16; ++j) { const unsigned c = xb_ld(&bar[XB_XCNT(j)]); sum += c; cnt += (c > 0u) ? 1u : 0u; mine = (j == x) ? c : mine; }
        if (sum == G) break;
        __builtin_amdgcn_s_sleep(1);
        if ((++sp & 255u) == 0u) { if (xb_ld(&bar[XB_TMO])) break; if (sp > XB_SPIN_CAP) { atomicAdd(&bar[XB_TMO], 1u); break; } }
    }
    nloc = mine > 0u ? mine : 1u; nx = cnt > 0u ? cnt : 1u;
}

__device__ __forceinline__ void xcd_barrier(const XcdBarrier& b, bool xb_t0) {
    asm volatile("s_waitcnt vmcnt(0)" ::: "memory");
    __syncthreads();
    if (xb_t0) {
        unsigned* bar = b.bar;
        __builtin_amdgcn_s_waitcnt(0);
        unsigned nloc = b.st[0], nx = b.st[1];
        if (nloc == 0u) { xcd_barrier_complete(bar, b.x, nloc, nx); b.st[0] = nloc; b.st[1] = nx; }
        const unsigned old = xb_add(&bar[XB_XSUB(b.x)], 1u);
        const unsigned gen = old / nloc;
        if (old + 1u == (gen + 1u) * nloc) {
            __builtin_amdgcn_fence(__ATOMIC_RELEASE, "agent");
            asm volatile("s_waitcnt vmcnt(0)" ::: "memory");
            const unsigned og = xb_add(&bar[XB_TOP], 1u);
            const unsigned tg = og / nx;
            if (og + 1u == (tg + 1u) * nx) xb_add(&bar[XB_TOPGEN], 1u);
            else XB_SPIN(xb_ld(&bar[XB_TOPGEN]) == tg, bar);
            __builtin_amdgcn_fence(__ATOMIC_ACQUIRE, "agent");
            xb_add(&bar[XB_XGEN(b.x)], 1u);
            asm volatile("s_waitcnt vmcnt(0)" ::: "memory");
        } else {
            XB_SPIN(xb_ld(&bar[XB_XGEN(b.x)]) == gen, bar);
            __builtin_amdgcn_fence(__ATOMIC_ACQUIRE, "agent");
            asm volatile("s_waitcnt vmcnt(0)" ::: "memory");
        }
    }
    __syncthreads();
}


__device__ void ph_transpose(int wv, const float* __restrict__ src, bf16_t* __restrict__ dst, int K, int N, int Npad,
                             int col0, int skip_from, int skip, int nvalid, float* tile, int bid, int nb) {
  const int tk = K / 32, tn = Npad / 32;
  const int t5 = otid(wv) & 255;
  const int tx = t5 & 31, ty = t5 >> 5;
  for (int t = bid; t < tk * tn; t += nb) {
    const int kt = t / tn, nt = t % tn;
    __syncthreads();
    for (int i = ty; i < 32; i += 8) {
      const int k = kt * 32 + i, n = nt * 32 + tx;
      const int cc = col0 + n + (n >= skip_from ? skip : 0);
      tile[i * 33 + tx] = (n < nvalid) ? src[(size_t)k * N + cc] : 0.f;
    }
    __syncthreads();
    for (int i = ty; i < 32; i += 8) {
      const int n = nt * 32 + i, k = kt * 32 + tx;
      dst[(size_t)n * K + k] = f2bf(tile[tx * 33 + i]);
    }
  }
}

__device__ void ph_mod(int wv, const Params& P, float* sm, int bid, int nb) {
  const int tid = otid(wv) & 255;
  float* sv = sm;
  float* red = sm + 5 * 1024;
  for (int i = tid; i < 5 * 1024; i += 256) {
    const float v = (i < 4096) ? P.c[i] : P.c_ctx[i - 4096];
    sv[i] = silu_f(v);
  }
  __syncthreads();
  const int col = tid & 31, kg = tid >> 5;
  for (int it = bid; it < 384; it += nb) {
    const int layer = it / 192, cb = it % 192;
    const float* W = P.ada_w + (size_t)layer * 1024 * MODW + cb * 32 + col;
    float a0 = 0, a1 = 0, a2 = 0, a3 = 0, a4 = 0;
    for (int k = kg * 128; k < kg * 128 + 128; ++k) {
      const float w = W[(size_t)k * MODW];
      a0 += sv[k] * w; a1 += sv[1024 + k] * w; a2 += sv[2048 + k] * w; a3 += sv[3072 + k] * w; a4 += sv[4096 + k] * w;
    }
    float* r = red + (kg * 32 + col) * 5;
    r[0] = a0; r[1] = a1; r[2] = a2; r[3] = a3; r[4] = a4;
    __syncthreads();
    if (tid < 160) {
      const int rr = tid >> 5, cc = tid & 31;
      float s = 0;
      for (int g = 0; g < 8; ++g) s += red[(g * 32 + cc) * 5 + rr];
      P.mod()[(size_t)(layer * 5 + rr) * MODW + cb * 32 + cc] = s + P.ada_b[layer * MODW + cb * 32 + cc];
    }
    __syncthreads();
  }
}

__device__ void ph_norm(int wv, const float* hl, const float* hc, const float* __restrict__ g, const float* __restrict__ modl,
                        int shift_off, int scale_off, int nrows, bf16_t* __restrict__ dst, int bid, int nb) {
  const int wave = otid(wv) >> 6, lane = otid(wv) & 63;
  for (int row = bid * NWAVE + wave; row < nrows; row += nb * NWAVE) {
    const float* src = hrow(hl, hc, row);
    const float* mr = modl + (size_t)modrow(row) * MODW;
    float4 v[4];
    float ss = 0.f;
#pragma unroll
    for (int i = 0; i < 4; ++i) {
      v[i] = ((const float4*)src)[i * 64 + lane];
      ss += v[i].x * v[i].x + v[i].y * v[i].y + v[i].z * v[i].z + v[i].w * v[i].w;
    }
    ss = wave_sum(ss);
    const float rstd = rsqrtf(ss * (1.f / 1024.f) + 1e-6f);
#pragma unroll
    for (int i = 0; i < 4; ++i) {
      const int idx = i * 256 + lane * 4;
      const float4 gg = *(const float4*)(g + idx);
      const float4 sc = *(const float4*)(mr + scale_off + idx);
      const float4 sh = *(const float4*)(mr + shift_off + idx);
      const float o0 = v[i].x * rstd * gg.x * (1.f + sc.x) + sh.x;
      const float o1 = v[i].y * rstd * gg.y * (1.f + sc.y) + sh.y;
      const float o2 = v[i].z * rstd * gg.z * (1.f + sc.z) + sh.z;
      const float o3 = v[i].w * rstd * gg.w * (1.f + sc.w) + sh.w;
      uint2 pk;
      pk.x = (uint32_t)f2bf(o0) | ((uint32_t)f2bf(o1) << 16);
      pk.y = (uint32_t)f2bf(o2) | ((uint32_t)f2bf(o3) << 16);
      *(uint2*)(dst + (size_t)row * DM + idx) = pk;
    }
  }
}

enum { EPI_INPROJ = 0, EPI_OUTPROJ = 1, EPI_Q = 2 };

template <int EPI>
__device__ void ph_gemm(int wv, const Params& P, int layer, const bf16_t* __restrict__ A, const bf16_t* __restrict__ Bt, int M,
                        int Npad, int K, const float* hl, const float* hc, char* smem, int bid, int nb) {
  bf16_t* sA = (bf16_t*)smem;
  bf16_t* sB = sA + 128 * 72;
  const int tid = otid(wv) & 255, lane = tid & 63, wave = tid >> 6;
  const int wr = wave >> 1, wc = wave & 1;
  const int tiles_m = M / 128, tiles_n = Npad / 128;
  const int l15 = lane & 15, l4 = lane >> 4;
  for (int tile = bid; tile < tiles_m * tiles_n; tile += nb) {
    const int tn = tile / tiles_m, tm = tile % tiles_m;
    f32x4 acc[4][4];
#pragma unroll
    for (int i = 0; i < 4; ++i)
#pragma unroll
      for (int j = 0; j < 4; ++j) acc[i][j] = (f32x4){0.f, 0.f, 0.f, 0.f};
    for (int k0 = 0; k0 < K; k0 += 64) {
      __syncthreads();
#pragma unroll
      for (int i = 0; i < 4; ++i) {
        const int idx = i * 256 + tid;
        const int r = idx >> 3, sg = idx & 7;
        const uint4 va = *(const uint4*)(A + (size_t)(tm * 128 + r) * K + k0 + sg * 8);
        *(uint4*)(sA + r * 72 + sg * 8) = va;
        const uint4 vb = *(const uint4*)(Bt + (size_t)(tn * 128 + r) * K + k0 + sg * 8);
        *(uint4*)(sB + r * 72 + sg * 8) = vb;
      }
      __syncthreads();
#pragma unroll
      for (int kk = 0; kk < 2; ++kk) {
        bf16x8 af[4], bfr[4];
#pragma unroll
        for (int i = 0; i < 4; ++i) af[i] = *(const bf16x8*)(sA + (wr * 64 + i * 16 + l15) * 72 + kk * 32 + l4 * 8);
#pragma unroll
        for (int j = 0; j < 4; ++j) bfr[j] = *(const bf16x8*)(sB + (wc * 64 + j * 16 + l15) * 72 + kk * 32 + l4 * 8);
#pragma unroll
        for (int i = 0; i < 4; ++i)
#pragma unroll
          for (int j = 0; j < 4; ++j) acc[i][j] = __builtin_amdgcn_mfma_f32_16x16x32_bf16(af[i], bfr[j], acc[i][j], 0, 0, 0);
      }
    }
#pragma unroll
    for (int i = 0; i < 4; ++i)
#pragma unroll
      for (int j = 0; j < 4; ++j)
#pragma unroll
        for (int e = 0; e < 4; ++e) {
          const int row = tm * 128 + wr * 64 + i * 16 + l4 * 4 + e;
          const int col = tn * 128 + wc * 64 + j * 16 + l15;
          const float v = acc[i][j][e];
          if (EPI == EPI_INPROJ) {
            if (col < 32) P.dtraw()[(size_t)row * 32 + col] = v;
          } else if (EPI == EPI_OUTPROJ) {
            const float* src = hrow(hl, hc, row);
            const float gate = P.mod()[(size_t)(layer * 5 + modrow(row)) * MODW + 2048 + col];
            P.h()[(size_t)row * DM + col] = src[col] + gate * v;
          } else {
            P.q()[(size_t)row * 2048 + col] = f2bf(v);
          }
        }
  }
}

__device__ void ph_conv(int wv, const Params& P, int layer, int bid, int nb) {
  const float* cw = P.conv_w + (size_t)layer * 3 * 1536;
  const float* cb = P.conv_b + (size_t)layer * 1536;
  const int total = NTOK * 64;
  for (int it = bid * NTHR + otid(wv); it < total; it += nb * NTHR) {
    const int row = it >> 6, c8 = 1024 + (it & 63) * 8;
    int l, L;
    if (row < NLAT) { l = row & 4095; L = 4096; } else { l = (row - NLAT) & 255; L = 256; }
    const bf16_t* pc = P.p() + (size_t)row * PW + OFF_XBC + c8;
    uint4 cur = *(const uint4*)pc;
    uint4 prv = make_uint4(0, 0, 0, 0), nxt = make_uint4(0, 0, 0, 0);
    if (l > 0) prv = *(const uint4*)(pc - PW);
    if (l < L - 1) nxt = *(const uint4*)(pc + PW);
    const bf16_t* c_ = (const bf16_t*)&cur;
    const bf16_t* p_ = (const bf16_t*)&prv;
    const bf16_t* n_ = (const bf16_t*)&nxt;
    uint4 o;
    bf16_t* o_ = (bf16_t*)&o;
#pragma unroll
    for (int e = 0; e < 8; ++e) {
      const int c = c8 + e;
      const float v = cb[c] + cw[c] * bf2f(p_[e]) + cw[1536 + c] * bf2f(c_[e]) + cw[3072 + c] * bf2f(n_[e]);
      o_[e] = f2bf(silu_f(v));
    }
    *(uint4*)(P.xbc() + (size_t)row * 512 + c8 - 1024) = o;
  }
}

__device__ void ph_ssdprep(int wv, const Params& P, int layer, char* smem, int bid, int nb) {
  const int tid = otid(wv), dh = tid & 31, seg = tid >> 5;
  float* segtot = (float*)smem;
  const float bias = P.dt_bias[layer * 32 + dh];
  const float ah = -expf(P.a_log[layer * 32 + dh]);
  for (int gc = bid; gc < NCHUNK; gc += nb) {
    const size_t base = (size_t)(gc * 128 + seg * 8) * 32 + dh;
    float r[8], c[8];
#pragma unroll
    for (int j = 0; j < 8; ++j) r[j] = P.dtraw()[base + (size_t)j * 32];
    float cs = 0.f;
#pragma unroll
    for (int j = 0; j < 8; ++j) { r[j] = softplus_f(r[j] + bias); cs += r[j] * ah; c[j] = cs; }
    __syncthreads();
    segtot[seg * 32 + dh] = cs;
    __syncthreads();
    float off = 0.f;
    for (int s = 0; s < seg; ++s) off += segtot[s * 32 + dh];
#pragma unroll
    for (int j = 0; j < 8; ++j) { P.dtv()[base + (size_t)j * 32] = r[j]; P.csv()[base + (size_t)j * 32] = off + c[j]; }
  }
}

__device__ void ph_states(int wv, const Params& P, char* smem, int bid, int nb) {
  float* wx = (float*)smem;
  bf16_t* Bm = (bf16_t*)(smem + 128 * 64 * 4);
  const int tid = otid(wv);
  const int n = tid & 127, pg = (tid >> 7) & 1;
  for (int it = bid; it < NCHUNK * 32; it += nb) {
    const int gc = it >> 5, dh = it & 31, dir = dh >> 4, head = dh & 15, g = head >> 3;
    const int row0 = gc * 128;
    __syncthreads();
    const float at = P.csv()[(size_t)(row0 + 127) * 32 + dh];
    for (int i = tid; i < 128 * 64; i += NTHR) {
      const int j = i >> 6, pp = i & 63, row = row0 + j;
      const float cs = P.csv()[(size_t)row * 32 + dh], dt = P.dtv()[(size_t)row * 32 + dh];
      float w;
      if (dir == 0) w = expf(at - cs);
      else w = expf(j > 0 ? P.csv()[(size_t)(row - 1) * 32 + dh] : 0.f);
      wx[i] = bf2f(P.xbc()[(size_t)row * 1536 + head * 64 + pp]) * dt * w;
    }
    for (int i = tid; i < 128 * 128; i += NTHR) {
      const int j = i >> 7, nn = i & 127;
      Bm[i] = P.xbc()[(size_t)(row0 + j) * 1536 + 1024 + g * 128 + nn];
    }
    __syncthreads();
    float acc[32];
#pragma unroll
    for (int i = 0; i < 32; ++i) acc[i] = 0.f;
    for (int j = 0; j < 128; ++j) {
      const float b = bf2f(Bm[j * 128 + n]);
#pragma unroll
      for (int i = 0; i < 32; ++i) acc[i] += wx[j * 64 + pg * 32 + i] * b;
    }
    bf16_t* dst = P.states() + (size_t)it * 8192;
#pragma unroll
    for (int i = 0; i < 32; ++i) dst[(pg * 32 + i) * 128 + n] = f2bf(acc[i]);
  }
}

__device__ void ph_scan(int wv, const Params& P, int bid, int nb) {
  const int total = 4 * 32 * 8192;
  for (int it = bid * NTHR + otid(wv); it < total; it += nb * NTHR) {
    const int e = it & 8191, dh = (it >> 13) & 31, b = it >> 18, dir = dh >> 4;
    float S = 0.f;
    for (int s = 0; s < 34; ++s) {
      int gc;
      if (dir == 0) gc = (s < 2) ? (128 + 2 * b + s) : (32 * b + (s - 2));
      else gc = (s < 2) ? (128 + 2 * b + 1 - s) : (32 * b + 31 - (s - 2));
      bf16_t* ptr = P.states() + (size_t)(gc * 32 + dh) * 8192 + e;
      const float cstate = bf2f(*ptr);
      *ptr = f2bf(S);
      const float at = P.csv()[(size_t)(gc * 128 + 127) * 32 + dh];
      S = expf(at) * S + cstate;
    }
  }
}

__device__ void ph_ssdy(int wv, const Params& P, int layer, int nchunks, char* smem, int bid, int nb) {
  bf16_t* Cm = (bf16_t*)smem;
  bf16_t* Gm = Cm + 128 * 130;
  char* R = (char*)(Gm + 128 * 130);
  bf16_t* Bm = (bf16_t*)R;
  float* xd = (float*)R;
  bf16_t* Sm = (bf16_t*)(R + 128 * 130 * 2);
  float* csl = (float*)(Sm + 64 * 130);
  float* exl = csl + 128;
  const int tid = otid(wv);
  for (int it = bid; it < nchunks * 16; it += nb) {
    const int gc = it >> 4, head = it & 15, g = head >> 3;
    const int row0 = gc * 128;
    __syncthreads();
    for (int i = tid; i < 128 * 128; i += NTHR) {
      const int j = i >> 7, nn = i & 127;
      const bf16_t* xr = P.xbc() + (size_t)(row0 + j) * 1536 + 1024 + g * 128 + nn;
      Bm[j * 130 + nn] = xr[0];
      Cm[j * 130 + nn] = xr[256];
    }
    __syncthreads();
    {
      const int s = tid & 127, jh = (tid >> 7) & 1;
      for (int jb = 0; jb < 2; ++jb) {
        float acc[32];
#pragma unroll
        for (int i = 0; i < 32; ++i) acc[i] = 0.f;
        for (int nn = 0; nn < 128; ++nn) {
          const float b = bf2f(Bm[s * 130 + nn]);
#pragma unroll
          for (int i = 0; i < 32; ++i) acc[i] += bf2f(Cm[(jh * 64 + jb * 32 + i) * 130 + nn]) * b;
        }
#pragma unroll
        for (int i = 0; i < 32; ++i) Gm[(jh * 64 + jb * 32 + i) * 130 + s] = f2bf(acc[i]);
      }
    }
    const int pp = tid & 63, jg0 = (tid >> 6) & 3;
#pragma unroll 1
    for (int jpass = 0; jpass < 2; ++jpass) {
    const int jg = jg0 * 2 + jpass;
    float yacc[16];
#pragma unroll
    for (int i = 0; i < 16; ++i) yacc[i] = 0.f;
#pragma unroll 1
    for (int dir = 0; dir < 2; ++dir) {
      const int dh = dir * 16 + head;
      __syncthreads();
      for (int i = tid; i < 128 * 64; i += NTHR) {
        const int j = i >> 6, p2 = i & 63, row = row0 + j;
        xd[i] = bf2f(P.xbc()[(size_t)row * 1536 + head * 64 + p2]) * P.dtv()[(size_t)row * 32 + dh];
      }
      const bf16_t* st = P.states() + (size_t)(gc * 32 + dh) * 8192;
      for (int i = tid; i < 64 * 128; i += NTHR) Sm[(i >> 7) * 130 + (i & 127)] = st[i];
      if (tid < 128) {
        const float cs = P.csv()[(size_t)(row0 + tid) * 32 + dh];
        csl[tid] = cs;
        exl[tid] = tid > 0 ? P.csv()[(size_t)(row0 + tid - 1) * 32 + dh] : 0.f;
      }
      __syncthreads();
      const float atot = csl[127];
      for (int s = 0; s < 128; ++s) {
        const float xv = xd[s * 64 + pp];
        const float cs_s = csl[s], ex_s = exl[s];
#pragma unroll
        for (int i = 0; i < 16; ++i) {
          const int j = jg * 16 + i;
          if (dir == 0) {
            if (s <= j) yacc[i] += bf2f(Gm[j * 130 + s]) * expf(csl[j] - cs_s) * xv;
          } else {
            if (s >= j) yacc[i] += bf2f(Gm[j * 130 + s]) * expf(ex_s - exl[j]) * xv;
          }
        }
      }
      float offacc[16];
#pragma unroll
      for (int i = 0; i < 16; ++i) offacc[i] = 0.f;
      for (int nn = 0; nn < 128; ++nn) {
        const float sv = bf2f(Sm[pp * 130 + nn]);
#pragma unroll
        for (int i = 0; i < 16; ++i) offacc[i] += bf2f(Cm[(jg * 16 + i) * 130 + nn]) * sv;
      }
#pragma unroll
      for (int i = 0; i < 16; ++i) {
        const int j = jg * 16 + i;
        const float sc = dir == 0 ? expf(csl[j]) : expf(atot - exl[j]);
        yacc[i] += offacc[i] * sc;
      }
    }
    const float dsk = P.d_skip[layer * 16 + head];
#pragma unroll
    for (int i = 0; i < 16; ++i) {
      const int row = row0 + jg * 16 + i;
      const float xs = bf2f(P.xbc()[(size_t)row * 1536 + head * 64 + pp]);
      const float z = bf2f(P.p()[(size_t)row * PW + OFF_Z + head * 64 + pp]);
      const float y = (yacc[i] + dsk * xs) * silu_f(z);
      P.concat()[(size_t)row * 2048 + head * 64 + pp] = f2bf(y);
    }
    }
  }
}


__device__ __forceinline__ void conv_x8(const Params& P, int layer, int row, int ch0, float* out) {
  int l, L;
  if (row < NLAT) { l = row & 4095; L = 4096; } else { l = (row - NLAT) & 255; L = 256; }
  const bf16_t* pc = P.p() + (size_t)row * PW + OFF_XBC + ch0;
  const uint4 cur = *(const uint4*)pc;
  uint4 prv = make_uint4(0, 0, 0, 0), nxt = make_uint4(0, 0, 0, 0);
  if (l > 0) prv = *(const uint4*)(pc - PW);
  if (l < L - 1) nxt = *(const uint4*)(pc + PW);
  float fp[8], fc[8], fn[8];
  unpack8(prv, fp); unpack8(cur, fc); unpack8(nxt, fn);
  const float* cw = P.conv_w + (size_t)layer * 3 * 1536 + ch0;
  const float* cb = P.conv_b + (size_t)layer * 1536 + ch0;
#pragma unroll
  for (int e = 0; e < 8; ++e) out[e] = silu_f(cb[e] + cw[e] * fp[e] + cw[1536 + e] * fc[e] + cw[3072 + e] * fn[e]);
}

constexpr int XS = 72;
constexpr int BS = 136;

__device__ void ph_states_mfma(int wv, const Params& P, int layer, char* smem, int bid, int nb) {
  char* XW = smem;
  char* Bm = smem + 2 * 128 * XS * 2;
  const int tid = otid(wv), lane = tid & 63, li = lane & 15, g = lane >> 4;
  const int dir = wv >> 2, pb = wv & 3;
  for (int it = bid; it < NCHUNK * 16; it += nb) {
    const int gc = it >> 4, head = it & 15, grp = head >> 3;
    const int row0 = gc * 128;
    __syncthreads();
#pragma unroll
    for (int i = 0; i < 2; ++i) {
      const int idx = tid + i * 512, j = idx >> 3, seg = idx & 7, row = row0 + j;
      float xv[8];
      conv_x8(P, layer, row, head * 64 + seg * 8, xv);
      const float* cs = P.csv() + (size_t)row * 32;
      const float* dt = P.dtv() + (size_t)row * 32;
      const float at_f = P.csv()[(size_t)(row0 + 127) * 32 + head];
      const float wf = expf(at_f - cs[head]) * dt[head];
      const float wb = expf(j > 0 ? cs[16 + head - 32] : 0.f) * dt[16 + head];
      uint4 of, ob;
      of.x = pack2(xv[0] * wf, xv[1] * wf); of.y = pack2(xv[2] * wf, xv[3] * wf); of.z = pack2(xv[4] * wf, xv[5] * wf); of.w = pack2(xv[6] * wf, xv[7] * wf);
      ob.x = pack2(xv[0] * wb, xv[1] * wb); ob.y = pack2(xv[2] * wb, xv[3] * wb); ob.z = pack2(xv[4] * wb, xv[5] * wb); ob.w = pack2(xv[6] * wb, xv[7] * wb);
      *(uint4*)(XW + (j * XS + seg * 8) * 2) = of;
      *(uint4*)(XW + ((128 + j) * XS + seg * 8) * 2) = ob;
    }
#pragma unroll
    for (int i = 0; i < 4; ++i) {
      const int idx = tid + i * 512, j = idx >> 4, seg = idx & 15;
      *(uint4*)(Bm + (j * BS + seg * 8) * 2) = *(const uint4*)(P.xbc() + (size_t)(row0 + j) * 512 + grp * 128 + seg * 8);
    }
    __syncthreads();
    f32x4 acc[8];
#pragma unroll
    for (int n = 0; n < 8; ++n) acc[n] = (f32x4){0.f, 0.f, 0.f, 0.f};
    const char* xbase = XW + ((dir * 128 + (li >> 2)) * XS + pb * 16 + 4 * (li & 3)) * 2;
    const char* bbase = Bm + ((li >> 2) * BS + 4 * (li & 3)) * 2;
#pragma unroll
    for (int t = 0; t < 4; ++t) {
      const int R = 32 * t + 8 * g;
      const bf16x8 bfrag = tr_read2(xbase + R * XS * 2, xbase + (R + 4) * XS * 2);
#pragma unroll
      for (int n = 0; n < 8; ++n) {
        const bf16x8 afrag = tr_read2(bbase + (R * BS + n * 16) * 2, bbase + ((R + 4) * BS + n * 16) * 2);
        acc[n] = __builtin_amdgcn_mfma_f32_16x16x32_bf16(afrag, bfrag, acc[n], 0, 0, 0);
      }
    }
    bf16_t* dst = P.states() + (size_t)(gc * 32 + dir * 16 + head) * 8192 + (pb * 16 + li) * 128;
#pragma unroll
    for (int n = 0; n < 8; ++n) {
      uint2 o;
      o.x = pack2(acc[n][0], acc[n][1]); o.y = pack2(acc[n][2], acc[n][3]);
      *(uint2*)(dst + n * 16 + 4 * g) = o;
    }
  }
}

__device__ void ph_ssdy_mfma(int wv, const Params& P, int layer, int nchunks, char* smem, int bid, int nb) {
  char* Bm = smem;
  char* Cm = Bm + 128 * BS * 2;
  char* X0 = Cm + 128 * BS * 2;
  char* XD = X0 + 128 * XS * 2;
  float* csf = (float*)(XD + 2 * 128 * XS * 2);
  float* exb = csf + 128;
  const int tid = otid(wv), lane = tid & 63, li = lane & 15, g = lane >> 4;
  for (int it = bid; it < nchunks * 16; it += nb) {
    const int gc = it >> 4, head = it & 15, grp = head >> 3;
    const int row0 = gc * 128;
    __syncthreads();
#pragma unroll
    for (int i = 0; i < 2; ++i) {
      const int idx = tid + i * 512, j = idx >> 3, seg = idx & 7, row = row0 + j;
      float xv[8];
      conv_x8(P, layer, row, head * 64 + seg * 8, xv);
      const float df = P.dtv()[(size_t)row * 32 + head], db = P.dtv()[(size_t)row * 32 + 16 + head];
      uint4 o0, of, ob;
      o0.x = pack2(xv[0], xv[1]); o0.y = pack2(xv[2], xv[3]); o0.z = pack2(xv[4], xv[5]); o0.w = pack2(xv[6], xv[7]);
      of.x = pack2(xv[0] * df, xv[1] * df); of.y = pack2(xv[2] * df, xv[3] * df); of.z = pack2(xv[4] * df, xv[5] * df); of.w = pack2(xv[6] * df, xv[7] * df);
      ob.x = pack2(xv[0] * db, xv[1] * db); ob.y = pack2(xv[2] * db, xv[3] * db); ob.z = pack2(xv[4] * db, xv[5] * db); ob.w = pack2(xv[6] * db, xv[7] * db);
      *(uint4*)(X0 + (j * XS + seg * 8) * 2) = o0;
      *(uint4*)(XD + (j * XS + seg * 8) * 2) = of;
      *(uint4*)(XD + ((128 + j) * XS + seg * 8) * 2) = ob;
    }
#pragma unroll
    for (int i = 0; i < 4; ++i) {
      const int idx = tid + i * 512, j = idx >> 4, seg = idx & 15;
      const bf16_t* s = P.xbc() + (size_t)(row0 + j) * 512 + grp * 128 + seg * 8;
      *(uint4*)(Bm + (j * BS + seg * 8) * 2) = *(const uint4*)s;
      *(uint4*)(Cm + (j * BS + seg * 8) * 2) = *(const uint4*)(s + 256);
    }
    if (tid < 128) {
      csf[tid] = P.csv()[(size_t)(row0 + tid) * 32 + head];
      exb[tid] = tid > 0 ? P.csv()[(size_t)(row0 + tid - 1) * 32 + 16 + head] : 0.f;
    }
    __syncthreads();
    const float atb = P.csv()[(size_t)(row0 + 127) * 32 + 16 + head];
    f32x4 accG[8];
#pragma unroll
    for (int sb = 0; sb < 8; ++sb) accG[sb] = (f32x4){0.f, 0.f, 0.f, 0.f};
#pragma unroll
    for (int t = 0; t < 4; ++t) {
      const bf16x8 cfrag = *(const bf16x8*)(Cm + ((16 * wv + li) * BS + 32 * t + 8 * g) * 2);
#pragma unroll
      for (int sb = 0; sb < 8; ++sb) {
        const bf16x8 bfr = *(const bf16x8*)(Bm + ((16 * sb + li) * BS + 32 * t + 8 * g) * 2);
        accG[sb] = __builtin_amdgcn_mfma_f32_16x16x32_bf16(bfr, cfrag, accG[sb], 0, 0, 0);
      }
    }
    f32x4 accY[4];
#pragma unroll
    for (int pb = 0; pb < 4; ++pb) accY[pb] = (f32x4){0.f, 0.f, 0.f, 0.f};
    const int jl = 16 * wv + li;
    const float csf_j = csf[jl], exb_j = exb[jl];
#pragma unroll
    for (int dir = 0; dir < 2; ++dir) {
      f32x4 accO[4];
#pragma unroll
      for (int pb = 0; pb < 4; ++pb) accO[pb] = (f32x4){0.f, 0.f, 0.f, 0.f};
      const bf16_t* st = P.states() + (size_t)(gc * 32 + dir * 16 + head) * 8192;
#pragma unroll
      for (int t = 0; t < 4; ++t) {
        const bf16x8 cfrag = *(const bf16x8*)(Cm + ((16 * wv + li) * BS + 32 * t + 8 * g) * 2);
#pragma unroll
        for (int pb = 0; pb < 4; ++pb) {
          const bf16x8 sfr = *(const bf16x8*)(st + (16 * pb + li) * 128 + 32 * t + 8 * g);
          accO[pb] = __builtin_amdgcn_mfma_f32_16x16x32_bf16(cfrag, sfr, accO[pb], 0, 0, 0);
        }
      }
#pragma unroll
      for (int e = 0; e < 4; ++e) {
        const int j = 16 * wv + 4 * g + e;
        const float sc = dir == 0 ? expf(csf[j]) : expf(atb - exb[j]);
#pragma unroll
        for (int pb = 0; pb < 4; ++pb) accY[pb][e] += accO[pb][e] * sc;
      }
#pragma unroll
      for (int t = 0; t < 4; ++t) {
        const bool skip = dir == 0 ? (32 * t > 16 * wv + 15) : (32 * t + 31 < 16 * wv);
        if (skip) continue;
        bf16x8 afrag;
#pragma unroll
        for (int hh = 0; hh < 2; ++hh) {
          const int s0 = 32 * t + 16 * hh + 4 * g;
          const f32x4 gv = accG[2 * t + hh];
          const f32x4 cv = dir == 0 ? *(const f32x4*)(csf + s0) : *(const f32x4*)(exb + s0);
#pragma unroll
          for (int e = 0; e < 4; ++e) {
            const int s = s0 + e;
            float m;
            if (dir == 0) m = (s <= jl) ? gv[e] * expf(csf_j - cv[e]) : 0.f;
            else m = (s >= jl) ? gv[e] * expf(cv[e] - exb_j) : 0.f;
            afrag[hh * 4 + e] = (short)f2bf(m);
          }
        }
        const char* xb = XD + ((dir * 128 + 32 * t + 4 * g + (li >> 2)) * XS + 4 * (li & 3)) * 2;
#pragma unroll
        for (int pb = 0; pb < 4; ++pb) {
          const bf16x8 bfr = tr_read2(xb + pb * 32, xb + 16 * XS * 2 + pb * 32);
          accY[pb] = __builtin_amdgcn_mfma_f32_16x16x32_bf16(afrag, bfr, accY[pb], 0, 0, 0);
        }
      }
    }
    const float dsk = P.d_skip[layer * 16 + head];
#pragma unroll
    for (int e = 0; e < 4; ++e) {
      const int j = 16 * wv + 4 * g + e, row = row0 + j;
#pragma unroll
      for (int pb = 0; pb < 4; ++pb) {
        const int pp = 16 * pb + li;
        const float xs = bf2f(*(const bf16_t*)(X0 + (j * XS + pp) * 2));
        const float z = bf2f(P.p()[(size_t)row * PW + OFF_Z + head * 64 + pp]);
        P.concat()[(size_t)row * 2048 + head * 64 + pp] = f2bf((accY[pb][e] + dsk * xs) * silu_f(z));
      }
    }
  }
}

__device__ void ph_ssdnorm(int wv, const Params& P, int layer, int nrows, int bid, int nb) {
  const int wave = otid(wv) >> 6, lane = otid(wv) & 63;
  const float* g = P.ssd_norm_g + layer * 1024;
  for (int row = bid * NWAVE + wave; row < nrows; row += nb * NWAVE) {
    bf16_t* src = P.concat() + (size_t)row * 2048;
    float v[16];
    float ss = 0.f;
#pragma unroll
    for (int i = 0; i < 4; ++i) {
      const uint2 pk = *(const uint2*)(src + i * 256 + lane * 4);
      v[i * 4 + 0] = bf2f((bf16_t)(pk.x & 0xffff)); v[i * 4 + 1] = bf2f((bf16_t)(pk.x >> 16));
      v[i * 4 + 2] = bf2f((bf16_t)(pk.y & 0xffff)); v[i * 4 + 3] = bf2f((bf16_t)(pk.y >> 16));
    }
#pragma unroll
    for (int i = 0; i < 16; ++i) ss += v[i] * v[i];
    ss = wave_sum(ss);
    const float rstd = rsqrtf(ss * (1.f / 1024.f) + 1e-6f);
#pragma unroll
    for (int i = 0; i < 4; ++i) {
      const int idx = i * 256 + lane * 4;
      uint2 pk;
      pk.x = (uint32_t)f2bf(v[i * 4 + 0] * rstd * g[idx + 0]) | ((uint32_t)f2bf(v[i * 4 + 1] * rstd * g[idx + 1]) << 16);
      pk.y = (uint32_t)f2bf(v[i * 4 + 2] * rstd * g[idx + 2]) | ((uint32_t)f2bf(v[i * 4 + 3] * rstd * g[idx + 3]) << 16);
      *(uint2*)(src + idx) = pk;
    }
  }
}

__device__ void ph_pool(int wv, const Params& P, int layer, int nrows, char* smem, int bid, int nb) {
  float* pooled = (float*)smem;
  const int tid = otid(wv);
  const int ntile = nrows / 32;
  for (int it = bid; it < ntile * 4; it += nb) {
    const int tt = it >> 2, gi = it & 3;
    const int w = 2 << gi;
    const int row0 = tt * 32;
    __syncthreads();
    for (int i = tid; i < 32 * 128; i += NTHR) {
      const int t = i >> 7, ch = i & 127, row = row0 + t;
      int l, L, base;
      if (row < NLAT) { l = row & 4095; L = 4096; base = row - l; } else { l = (row - NLAT) & 255; L = 256; base = row - l; }
      int lo = l - w / 2; lo = lo < 0 ? 0 : lo;
      int hi = l + w - w / 2 - 1; hi = hi > L - 1 ? L - 1 : hi;
      float s = 0.f;
      for (int r = lo; r <= hi; ++r) s += bf2f(P.p()[(size_t)(base + r) * PW + OFF_POOL + gi * 128 + ch]);
      pooled[i] = s / (float)(hi - lo + 1) - bf2f(P.p()[(size_t)row * PW + OFF_POOL + gi * 128 + ch]);
    }
    __syncthreads();
    const int o = tid & 127, tg = (tid >> 7) & 1;
    const float* W = P.pool_w + ((size_t)(layer * 4 + gi) * 128) * 128 + o;
    float acc[16];
#pragma unroll
    for (int i = 0; i < 16; ++i) acc[i] = 0.f;
    for (int k = 0; k < 128; ++k) {
      const float wv = W[(size_t)k * 128];
#pragma unroll
      for (int i = 0; i < 16; ++i) acc[i] += pooled[(tg * 16 + i) * 128 + k] * wv;
    }
    const float sc = P.pool_scale[layer * 512 + gi * 128 + o];
#pragma unroll
    for (int i = 0; i < 16; ++i)
      P.concat()[(size_t)(row0 + tg * 16 + i) * 2048 + 1024 + gi * 128 + o] = f2bf(acc[i] * sc);
  }
}

__device__ void ph_na(int wv, const Params& P, int layer, int nrows, char* smem, int bid, int nb) {
  const int wave = otid(wv) >> 6, lane = otid(wv) & 63;
  float* qs = (float*)smem + wave * 448;
  float* ps = qs + 64;
  const float* rpb = P.na_rpb + (size_t)layer * 8 * 15 * 31;
  for (int it = bid * NWAVE + wave; it < nrows * 8; it += nb * NWAVE) {
    const int row = it >> 3, hd = it & 7;
    const bool lat = row < NLAT;
    int b, r = 0, cq = 0, r0 = 0, c0 = 0;
    if (lat) {
      b = row >> 12; const int l = row & 4095; r = l >> 6; cq = l & 63;
      r0 = r - 4; r0 = r0 < 0 ? 0 : (r0 > 56 ? 56 : r0);
      c0 = cq - 8; c0 = c0 < 0 ? 0 : (c0 > 48 ? 48 : c0);
    } else {
      b = (row - NLAT) >> 8;
    }
    qs[lane] = bf2f(P.p()[(size_t)row * PW + OFF_Q + hd * 64 + lane]) * 0.125f;
    __builtin_amdgcn_wave_barrier();
    const int nkeys = lat ? 384 : 256;
    float mx = -3.0e38f;
#pragma unroll 1
    for (int t = 0; t < 6; ++t) {
      const int n = t * 64 + lane;
      float s = -3.0e38f;
      if (n < nkeys) {
        int krow; float bias = 0.f;
        if (lat && n < 128) {
          const int kr = n >> 4, kc = n & 15;
          const int rk = r0 + kr, ck = c0 + kc;
          krow = b * 4096 + rk * 64 + ck;
          bias = rpb[(hd * 15 + (rk - r + 7)) * 31 + (ck - cq + 15)];
        } else {
          krow = NLAT + b * 256 + (lat ? n - 128 : n);
        }
        const bf16_t* kp = P.p() + (size_t)krow * PW + OFF_K + hd * 64;
        float d = 0.f;
#pragma unroll
        for (int v8 = 0; v8 < 8; ++v8) {
          const uint4 kk = *(const uint4*)(kp + v8 * 8);
          const bf16_t* ke = (const bf16_t*)&kk;
#pragma unroll
          for (int e = 0; e < 8; ++e) d += qs[v8 * 8 + e] * bf2f(ke[e]);
        }
        s = d + bias;
      }
      ps[t * 64 + lane] = s;
      mx = fmaxf(mx, s);
    }
    mx = wave_max(mx);
    float sum = 0.f;
#pragma unroll 1
    for (int t = 0; t < 6; ++t) {
      const int n = t * 64 + lane;
      const float e = (n < nkeys) ? expf(ps[n] - mx) : 0.f;
      sum += e;
      ps[n] = e;
    }
    sum = wave_sum(sum);
    __builtin_amdgcn_wave_barrier();
    float acc = 0.f;
    for (int n = 0; n < nkeys; ++n) {
      int krow;
      if (lat && n < 128) krow = b * 4096 + (r0 + (n >> 4)) * 64 + c0 + (n & 15);
      else krow = NLAT + b * 256 + (lat ? n - 128 : n);
      acc += ps[n] * bf2f(P.p()[(size_t)krow * PW + OFF_V + hd * 64 + lane]);
    }
    P.concat()[(size_t)row * 2048 + 1536 + hd * 64 + lane] = f2bf(acc / sum);
    __builtin_amdgcn_wave_barrier();
  }
}


__device__ void ph_pool_mfma(int wv, const Params& P, int layer, int nrows, int bid, int nb) {
  const int lane = otid(wv) & 63, li = lane & 15, g = lane >> 4;
  const int nitems = (nrows / 16) * 4;
  for (int it = bid * NWAVE + wv; it < nitems; it += nb * NWAVE) {
    const int gi = it & 3, row0 = (it >> 2) * 16, w = 2 << gi;
    const int row = row0 + li;
    int l, L;
    if (row < NLAT) { l = row & 4095; L = 4096; } else { l = (row - NLAT) & 255; L = 256; }
    int lo = l - w / 2; lo = lo < 0 ? 0 : lo;
    int hi = l + w - w / 2 - 1; hi = hi > L - 1 ? L - 1 : hi;
    const float rc = 1.f / (float)(hi - lo + 1);
    const bf16_t* pc = P.p() + (size_t)row * PW + OFF_POOL + gi * 128 + 8 * g;
    bf16x8 af[4];
#pragma unroll
    for (int t = 0; t < 4; ++t) {
      float s[8], own[8];
#pragma unroll
      for (int e = 0; e < 8; ++e) s[e] = 0.f;
      for (int o = 0; o < w; ++o) {
        const int rr = l - w / 2 + o;
        if (rr >= 0 && rr < L) {
          float f[8];
          unpack8(*(const uint4*)(pc + (ptrdiff_t)(rr - l) * PW + 32 * t), f);
#pragma unroll
          for (int e = 0; e < 8; ++e) s[e] += f[e];
        }
      }
      unpack8(*(const uint4*)(pc + 32 * t), own);
#pragma unroll
      for (int e = 0; e < 8; ++e) af[t][e] = (short)f2bf(s[e] * rc - own[e]);
    }
    const bf16_t* wt = P.poolwT() + ((size_t)(layer * 4 + gi) * 128 + li) * 128 + 8 * g;
    const float* sc = P.pool_scale + layer * 512 + gi * 128;
#pragma unroll
    for (int nt = 0; nt < 8; ++nt) {
      f32x4 acc = (f32x4){0.f, 0.f, 0.f, 0.f};
#pragma unroll
      for (int t = 0; t < 4; ++t) {
        const bf16x8 bfr = *(const bf16x8*)(wt + (size_t)nt * 16 * 128 + 32 * t);
        acc = __builtin_amdgcn_mfma_f32_16x16x32_bf16(af[t], bfr, acc, 0, 0, 0);
      }
      const float scv = sc[nt * 16 + li];
#pragma unroll
      for (int e = 0; e < 4; ++e)
        P.concat()[(size_t)(row0 + 4 * g + e) * 2048 + 1024 + gi * 128 + nt * 16 + li] = f2bf(acc[e] * scv);
    }
  }
}

__device__ void ph_vtranspose(int wv, const Params& P, char* smem, int bid, int nb) {
  const int lane = otid(wv) & 63;
  bf16_t* tile = (bf16_t*)smem + wv * 64 * 72;
  for (int it = bid * NWAVE + wv; it < 272 * 8; it += nb * NWAVE) {
    const int hd = it & 7, tt = it >> 3, row0 = tt * 64;
    const bf16_t* src = P.p() + (size_t)(row0 + lane) * PW + OFF_V + hd * 64;
#pragma unroll
    for (int i = 0; i < 8; ++i) *(uint4*)(tile + lane * 72 + i * 8) = *(const uint4*)(src + i * 8);
    __builtin_amdgcn_wave_barrier();
    bf16_t* dst;
    if (row0 < NLAT) dst = P.vtl() + ((size_t)((row0 >> 12) * 8 + hd) * 64 + lane) * 4096 + (row0 & 4095);
    else dst = P.vtc() + ((size_t)(((row0 - NLAT) >> 8) * 8 + hd) * 64 + lane) * 256 + ((row0 - NLAT) & 255);
#pragma unroll
    for (int i = 0; i < 8; ++i) {
      uint32_t w[4];
#pragma unroll
      for (int k = 0; k < 4; ++k)
        w[k] = (uint32_t)tile[(i * 8 + 2 * k) * 72 + lane] | ((uint32_t)tile[(i * 8 + 2 * k + 1) * 72 + lane] << 16);
      *(uint4*)(dst + i * 8) = make_uint4(w[0], w[1], w[2], w[3]);
    }
    __builtin_amdgcn_wave_barrier();
  }
}

__device__ __forceinline__ float grp_max(float v) {
  auto a = __builtin_amdgcn_permlane16_swap(__float_as_uint(v), __float_as_uint(v), false, false);
  v = fmaxf(__uint_as_float(a[0]), __uint_as_float(a[1]));
  auto b = __builtin_amdgcn_permlane32_swap(__float_as_uint(v), __float_as_uint(v), false, false);
  return fmaxf(__uint_as_float(b[0]), __uint_as_float(b[1]));
}
__device__ __forceinline__ float grp_sum(float v) {
  auto a = __builtin_amdgcn_permlane16_swap(__float_as_uint(v), __float_as_uint(v), false, false);
  v = __uint_as_float(a[0]) + __uint_as_float(a[1]);
  auto b = __builtin_amdgcn_permlane32_swap(__float_as_uint(v), __float_as_uint(v), false, false);
  return __uint_as_float(b[0]) + __uint_as_float(b[1]);
}

__device__ void ph_na_mfma(int wv, const Params& P, int layer, int nrows, int bid, int nb) {
  const int lane = otid(wv) & 63, li = lane & 15, g = lane >> 4;
  const float* rpb = P.na_rpb + (size_t)layer * 8 * 15 * 31;
  const int n_lat = 4 * 64 * 8 * 4;
  const int n_items = n_lat + (nrows > NLAT ? 4 * 16 * 8 : 0);
  for (int it = bid * NWAVE + wv; it < n_items; it += nb * NWAVE) {
    const bool lat = it < n_lat;
    int b, hd, qrow0, r = 0, cq0 = 0, r0 = 0, cs = 0;
    if (lat) {
      const int qt = it & 3; hd = (it >> 2) & 7; r = (it >> 5) & 63; b = it >> 11;
      cq0 = qt * 16; qrow0 = b * 4096 + r * 64 + cq0;
      r0 = r - 4; r0 = r0 < 0 ? 0 : (r0 > 56 ? 56 : r0);
      int clo = cq0 - 8; clo = clo < 0 ? 0 : (clo > 48 ? 48 : clo);
      cs = clo < 32 ? clo : 32;
    } else {
      const int t = it - n_lat; hd = t & 7; const int qt = (t >> 3) & 15; b = t >> 7;
      qrow0 = NLAT + b * 256 + qt * 16;
    }
    const bf16_t* qp = P.p() + (size_t)(qrow0 + li) * PW + OFF_Q + hd * 64 + 8 * g;
    const bf16x8 qf0 = *(const bf16x8*)qp, qf1 = *(const bf16x8*)(qp + 32);
    f32x4 accS[16], accC[16];
#pragma unroll
    for (int kt = 0; kt < 16; ++kt) {
      const int krow = b * 4096 + (r0 + (kt >> 1)) * 64 + cs + 16 * (kt & 1) + li;
      const bf16_t* kp = P.p() + (size_t)krow * PW + OFF_K + hd * 64 + 8 * g;
      const bf16x8 a0 = *(const bf16x8*)kp, a1 = *(const bf16x8*)(kp + 32);
      f32x4 z = (f32x4){0.f, 0.f, 0.f, 0.f};
      z = __builtin_amdgcn_mfma_f32_16x16x32_bf16(a0, qf0, z, 0, 0, 0);
      accS[kt] = __builtin_amdgcn_mfma_f32_16x16x32_bf16(a1, qf1, z, 0, 0, 0);
    }
#pragma unroll
    for (int ct = 0; ct < 16; ++ct) {
      const int krow = NLAT + b * 256 + 16 * ct + li;
      const bf16_t* kp = P.p() + (size_t)krow * PW + OFF_K + hd * 64 + 8 * g;
      const bf16x8 a0 = *(const bf16x8*)kp, a1 = *(const bf16x8*)(kp + 32);
      f32x4 z = (f32x4){0.f, 0.f, 0.f, 0.f};
      z = __builtin_amdgcn_mfma_f32_16x16x32_bf16(a0, qf0, z, 0, 0, 0);
      accC[ct] = __builtin_amdgcn_mfma_f32_16x16x32_bf16(a1, qf1, z, 0, 0, 0);
    }
    const int cq = cq0 + li;
    int c0q = cq - 8; c0q = c0q < 0 ? 0 : (c0q > 48 ? 48 : c0q);
    float mx = -3.0e38f;
#pragma unroll
    for (int kt = 0; kt < 16; ++kt) {
      const int rk = r0 + (kt >> 1);
#pragma unroll
      for (int e = 0; e < 4; ++e) {
        const int ck = cs + 16 * (kt & 1) + 4 * g + e;
        const bool ok = lat && ck >= c0q && ck < c0q + 16;
        float s = -3.0e38f;
        if (ok) s = accS[kt][e] * 0.125f + rpb[(hd * 15 + (rk - r + 7)) * 31 + (ck - cq + 15)];
        accS[kt][e] = s;
        mx = fmaxf(mx, s);
      }
    }
#pragma unroll
    for (int ct = 0; ct < 16; ++ct)
#pragma unroll
      for (int e = 0; e < 4; ++e) { const float s = accC[ct][e] * 0.125f; accC[ct][e] = s; mx = fmaxf(mx, s); }
    mx = grp_max(mx);
    float sum = 0.f;
#pragma unroll
    for (int kt = 0; kt < 16; ++kt)
#pragma unroll
      for (int e = 0; e < 4; ++e) { const float p = __expf(accS[kt][e] - mx); accS[kt][e] = p; sum += p; }
#pragma unroll
    for (int ct = 0; ct < 16; ++ct)
#pragma unroll
      for (int e = 0; e < 4; ++e) { const float p = __expf(accC[ct][e] - mx); accC[ct][e] = p; sum += p; }
    sum = grp_sum(sum);
    const float inv = 1.f / sum;
    f32x4 accO[4];
#pragma unroll
    for (int db = 0; db < 4; ++db) accO[db] = (f32x4){0.f, 0.f, 0.f, 0.f};
    const bf16_t* vl = P.vtl() + ((size_t)(b * 8 + hd) * 64 + li) * 4096;
    const bf16_t* vc = P.vtc() + ((size_t)(b * 8 + hd) * 64 + li) * 256;
#pragma unroll
    for (int kr = 0; kr < 8; ++kr) {
      bf16x8 af;
#pragma unroll
      for (int e = 0; e < 4; ++e) { af[e] = (short)f2bf(accS[2 * kr][e] * inv); af[4 + e] = (short)f2bf(accS[2 * kr + 1][e] * inv); }
      const int tok = (r0 + kr) * 64 + cs + 4 * g;
#pragma unroll
      for (int db = 0; db < 4; ++db) {
        const bf16_t* vp = vl + (size_t)db * 16 * 4096 + tok;
        const s16x4 lo = *(const s16x4*)vp, hi = *(const s16x4*)(vp + 16);
        const bf16x8 bfr = (bf16x8){lo[0], lo[1], lo[2], lo[3], hi[0], hi[1], hi[2], hi[3]};
        accO[db] = __builtin_amdgcn_mfma_f32_16x16x32_bf16(af, bfr, accO[db], 0, 0, 0);
      }
    }
#pragma unroll
    for (int t = 0; t < 8; ++t) {
      bf16x8 af;
#pragma unroll
      for (int e = 0; e < 4; ++e) { af[e] = (short)f2bf(accC[2 * t][e] * inv); af[4 + e] = (short)f2bf(accC[2 * t + 1][e] * inv); }
      const int tok = 32 * t + 4 * g;
#pragma unroll
      for (int db = 0; db < 4; ++db) {
        const bf16_t* vp = vc + (size_t)db * 16 * 256 + tok;
        const s16x4 lo = *(const s16x4*)vp, hi = *(const s16x4*)(vp + 16);
        const bf16x8 bfr = (bf16x8){lo[0], lo[1], lo[2], lo[3], hi[0], hi[1], hi[2], hi[3]};
        accO[db] = __builtin_amdgcn_mfma_f32_16x16x32_bf16(af, bfr, accO[db], 0, 0, 0);
      }
    }
#pragma unroll
    for (int db = 0; db < 4; ++db)
#pragma unroll
      for (int e = 0; e < 4; ++e)
        P.concat()[(size_t)(qrow0 + 4 * g + e) * 2048 + 1536 + hd * 64 + 16 * db + li] = f2bf(accO[db][e]);
  }
}

__device__ void ph_peer_topk(int wv, const Params& P, int layer, int nrows, char* smem, int bid, int nb) {
  bf16_t* Ks = (bf16_t*)smem;
  float* qt = (float*)(smem + 33280);
  float* sc = qt + 32 * 256;
  float* tv = sc + 64 * 129;
  int* ti = (int*)(tv + 64 * 16);
  const int tid = otid(wv);
  const int ntile = nrows / 32;
  for (int it = bid; it < ntile * 8; it += nb) {
    const int hd = it % 8, tt = it / 8;
    const int row0 = tt * 32;
    __syncthreads();
    for (int i = tid; i < 32 * 256; i += NTHR) {
      const int t = i >> 8, d = i & 255;
      qt[i] = bf2f(P.q()[(size_t)(row0 + t) * 2048 + hd * 256 + d]);
    }
    for (int half = 0; half < 2; ++half) {
      __syncthreads();
      const float* kk = P.peer_keys + ((size_t)((layer * 8 + hd) * 2 + half) * 128) * 128;
      for (int i = tid; i < 128 * 128; i += NTHR) Ks[(i >> 7) * 130 + (i & 127)] = f2bf(kk[i]);
      __syncthreads();
      const int k = tid & 127, tg = (tid >> 7) & 1;
      float acc[16];
#pragma unroll
      for (int i = 0; i < 16; ++i) acc[i] = 0.f;
      for (int d = 0; d < 128; ++d) {
        const float kv = bf2f(Ks[k * 130 + d]);
#pragma unroll
        for (int i = 0; i < 16; ++i) acc[i] += qt[(tg * 16 + i) * 256 + half * 128 + d] * kv;
      }
#pragma unroll
      for (int i = 0; i < 16; ++i) sc[((tg * 16 + i) * 2 + half) * 129 + k] = acc[i];
    }
    __syncthreads();
    if (tid < 64) {
      float* s = sc + tid * 129;
      for (int r = 0; r < 16; ++r) {
        float best = -3.0e38f; int bi = 0;
        for (int k = 0; k < 128; ++k) { const float v = s[k]; if (v > best) { best = v; bi = k; } }
        tv[tid * 16 + r] = best; ti[tid * 16 + r] = bi;
        s[bi] = -3.0e38f;
      }
    }
    __syncthreads();
    float* cand = qt;
    for (int i = tid; i < 32 * 256; i += NTHR) {
      const int t = i >> 8, a = (i >> 4) & 15, b2 = i & 15;
      cand[i] = tv[(t * 2 + 0) * 16 + a] + tv[(t * 2 + 1) * 16 + b2];
    }
    __syncthreads();
    if (tid < 32) {
      float* cd = cand + tid * 256;
      float ts[16];
      const int row = row0 + tid;
      float mx = 0.f;
#pragma unroll
      for (int r = 0; r < 16; ++r) {
        float best = -3.0e38f; int bi = 0;
        for (int k = 0; k < 256; ++k) { const float v = cd[k]; if (v > best) { best = v; bi = k; } }
        cd[bi] = -3.0e38f;
        ts[r] = best;
        if (r == 0) mx = best;
        const int e = ti[(tid * 2 + 0) * 16 + (bi >> 4)] * 128 + ti[(tid * 2 + 1) * 16 + (bi & 15)];
        P.sel_idx()[(size_t)row * 128 + hd * 16 + r] = e;
      }
      float sum = 0.f;
#pragma unroll
      for (int r = 0; r < 16; ++r) { ts[r] = expf(ts[r] - mx); sum += ts[r]; }
      const float inv = 1.f / sum;
#pragma unroll
      for (int r = 0; r < 16; ++r) P.sel_g()[(size_t)row * 128 + hd * 16 + r] = ts[r] * inv;
    }
  }
}


__device__ __forceinline__ uint32_t mono_u(float f) { const uint32_t u = __float_as_uint(f); return u ^ ((uint32_t)((int)u >> 31) | 0x80000000u); }
__device__ __forceinline__ float unmono_f(uint32_t m) { return __uint_as_float((m & 0x80000000u) ? (m ^ 0x80000000u) : ~m); }
__device__ __forceinline__ uint32_t grp_max_u(uint32_t v) {
  auto a = __builtin_amdgcn_permlane16_swap(v, v, false, false);
  v = a[0] > a[1] ? a[0] : a[1];
  auto b = __builtin_amdgcn_permlane32_swap(v, v, false, false);
  return b[0] > b[1] ? b[0] : b[1];
}

template <int N>
__device__ __forceinline__ void bitonic_sort_desc(uint32_t (&a)[N], int base = 0) { (void)base;
#pragma unroll
  for (int k = 2; k <= N; k <<= 1)
#pragma unroll
    for (int j = k >> 1; j > 0; j >>= 1)
#pragma unroll
      for (int i = 0; i < N; ++i) {
        const int l = i ^ j;
        if (l > i) {
          const bool desc = (i & k) == 0;
          const uint32_t hi = a[i] > a[l] ? a[i] : a[l], lo = a[i] > a[l] ? a[l] : a[i];
          a[i] = desc ? hi : lo; a[l] = desc ? lo : hi;
        }
      }
}
template <int N>
__device__ __forceinline__ void bitonic_merge_desc(uint32_t (&a)[N]) {
#pragma unroll
  for (int j = N >> 1; j > 0; j >>= 1)
#pragma unroll
    for (int i = 0; i < N; ++i) {
      const int l = i ^ j;
      if (l > i) {
        const uint32_t hi = a[i] > a[l] ? a[i] : a[l], lo = a[i] > a[l] ? a[l] : a[i];
        a[i] = hi; a[l] = lo;
      }
    }
}
__device__ __forceinline__ void merge4_top16(uint32_t (&a)[16]) {
  uint32_t e[16], o[16];
#pragma unroll
  for (int i = 0; i < 16; ++i) { auto r = __builtin_amdgcn_permlane16_swap(a[i], a[i], false, false); e[i] = r[0]; o[i] = r[1]; }
#pragma unroll
  for (int i = 0; i < 16; ++i) a[i] = e[i] > o[15 - i] ? e[i] : o[15 - i];
  bitonic_merge_desc<16>(a);
#pragma unroll
  for (int i = 0; i < 16; ++i) { auto r = __builtin_amdgcn_permlane32_swap(a[i], a[i], false, false); e[i] = r[0]; o[i] = r[1]; }
#pragma unroll
  for (int i = 0; i < 16; ++i) a[i] = e[i] > o[15 - i] ? e[i] : o[15 - i];
  bitonic_merge_desc<16>(a);
}
__device__ void ph_peer_topk_mfma(int wv, const Params& P, int layer, int nrows, char* smem, int bid, int nb) {
  const int tid = otid(wv), lane = tid & 63, li = lane & 15, g = lane >> 4;
  unsigned char* ctab = (unsigned char*)smem;
  float* vals = (float*)(smem + 256) + wv * 512;
  int* idxs = (int*)(smem + 256 + 8 * 2048) + wv * 512;
  __syncthreads();
  if (tid < 64) ctab[tid] = 0xFF;
  __syncthreads();
  if (tid == 0) {
    int n = 0, one = 1;
    asm volatile("" : "+s"(one));
#pragma unroll 1
    for (int a = 0; a < 16; ++a)
#pragma unroll 1
      for (int b = 0; b < 16; ++b)
        if ((a + one) * (b + 1) <= 16) { ctab[(n & 3) * 16 + (n >> 2)] = (unsigned char)(a * 16 + b); ++n; }
  }
  const int hd = bid & 7, tg = bid >> 3, ngroups = nb >> 3;
  char* ksm = smem + 33280;
  {
    const bf16_t* ksrc = P.keysb() + (size_t)(layer * 8 + hd) * 2 * 128 * 128;
#pragma unroll
    for (int i = 0; i < 8; ++i) {
      const int idx = tid + i * 512, r = idx >> 4, sg = idx & 15;
      *(uint4*)(ksm + (r * 136 + sg * 8) * 2) = *(const uint4*)(ksrc + (size_t)r * 128 + sg * 8);
    }
  }
  __syncthreads();
  const int ntile = nrows / 16;
  for (int tile = tg + ngroups * wv; tile < ntile && tg < ngroups; tile += ngroups * NWAVE) {
    const int row0 = tile * 16;
    const bf16_t* qp = P.q() + (size_t)(row0 + li) * 2048 + hd * 256 + 8 * g;
    uint32_t win[2][16];
#pragma unroll
    for (int half = 0; half < 2; ++half) {
      bf16x8 qf[4];
#pragma unroll
      for (int t = 0; t < 4; ++t) qf[t] = *(const bf16x8*)(qp + half * 128 + 32 * t);
      const char* kb = ksm + ((half * 128 + li) * 136 + 8 * g) * 2;
      uint32_t pk[32];
#pragma unroll
      for (int kt = 0; kt < 8; ++kt) {
        f32x4 acc = (f32x4){0.f, 0.f, 0.f, 0.f};
#pragma unroll
        for (int t = 0; t < 4; ++t) {
          const bf16x8 a = *(const bf16x8*)(kb + (kt * 16 * 136 + 32 * t) * 2);
          acc = __builtin_amdgcn_mfma_f32_16x16x32_bf16(a, qf[t], acc, 0, 0, 0);
        }
#pragma unroll
        for (int e = 0; e < 4; ++e) pk[kt * 4 + e] = (mono_u(acc[e]) & ~127u) | (uint32_t)(16 * kt + 4 * g + e);
      }
      {
        uint32_t lo16[16], hi16[16];
#pragma unroll
        for (int i = 0; i < 16; ++i) { lo16[i] = pk[i]; hi16[i] = pk[16 + i]; }
        bitonic_sort_desc<16>(lo16);
        bitonic_sort_desc<16>(hi16);
#pragma unroll
        for (int i = 0; i < 16; ++i) lo16[i] = lo16[i] > hi16[15 - i] ? lo16[i] : hi16[15 - i];
        bitonic_merge_desc<16>(lo16);
        merge4_top16(lo16);
#pragma unroll
        for (int r = 0; r < 16; ++r) win[half][r] = lo16[r];
      }
    }
    if (g == 0) {
#pragma unroll
      for (int half = 0; half < 2; ++half)
#pragma unroll
        for (int r = 0; r < 16; ++r) {
          vals[li * 32 + half * 16 + r] = unmono_f(win[half][r] & ~127u);
          idxs[li * 32 + half * 16 + r] = (int)(win[half][r] & 127u);
        }
    }
    __builtin_amdgcn_wave_barrier();
    uint32_t cp[16];
#pragma unroll
    for (int s = 0; s < 16; ++s) {
      const uint32_t ab = ctab[g * 16 + s];
      uint32_t v = 0u;
      if (ab != 0xFFu) v = (mono_u(vals[li * 32 + (ab >> 4)] + vals[li * 32 + 16 + (ab & 15u)]) & ~255u) | ab;
      cp[s] = v;
    }
    bitonic_sort_desc<16>(cp);
    merge4_top16(cp);
    uint32_t cw[16];
#pragma unroll
    for (int r = 0; r < 16; ++r) cw[r] = cp[r];
    const float mx = unmono_f(cw[0] & ~255u);
    float ex[16];
    float sum = 0.f;
#pragma unroll
    for (int r = 0; r < 16; ++r) { ex[r] = __expf(unmono_f(cw[r] & ~255u) - mx); sum += ex[r]; }
    const float inv = 1.f / sum;
    const size_t ob = (size_t)(row0 + li) * 128 + hd * 16;
#pragma unroll
    for (int r = 0; r < 16; ++r) {
      if ((r >> 2) == g) {
        const uint32_t ab = cw[r] & 255u;
        P.sel_idx()[ob + r] = idxs[li * 32 + (ab >> 4)] * 128 + idxs[li * 32 + 16 + (ab & 15u)];
        P.sel_g()[ob + r] = ex[r] * inv;
      }
    }
    __builtin_amdgcn_wave_barrier();
  }
}

__device__ __forceinline__ void cvt8(const uint32_t w, float* f) {
  const f32x2_t a = __builtin_amdgcn_cvt_scalef32_pk_f32_fp4(w, 1.0f, 0), b = __builtin_amdgcn_cvt_scalef32_pk_f32_fp4(w, 1.0f, 1);
  const f32x2_t c = __builtin_amdgcn_cvt_scalef32_pk_f32_fp4(w, 1.0f, 2), e = __builtin_amdgcn_cvt_scalef32_pk_f32_fp4(w, 1.0f, 3);
  f[0] = a.x; f[1] = a.y; f[2] = b.x; f[3] = b.y; f[4] = c.x; f[5] = c.y; f[6] = e.x; f[7] = e.y;
}
__device__ __forceinline__ float swap16_add(float a, float b) {
  auto r = __builtin_amdgcn_permlane16_swap(__float_as_uint(a), __float_as_uint(b), false, false);
  return __uint_as_float(r[0]) + __uint_as_float(r[1]);
}
__device__ void ph_peer_gather(int wv, const Params& P, int layer, int nrows, int bid, int nb) {
  for (int row = bid * NWAVE + wv; row < nrows; row += nb * NWAVE) {
    const int lane = otid(wv) & 63, l5 = lane & 31;
    const bool up = lane >= 32;
    const unsigned char* TU = P.tabU() + l5 * 16;
    const unsigned char* TV = P.tabV() + l5 * 16;
    const int j15 = lane & 15;
    const int rr = ((j15 >> 3) & 1) | ((j15 & 1) << 1), zi = (j15 >> 1) & 3;
    const int srcl = (rr * 4 + (zi & 1) * 2 + (zi >> 1)) * 4;
    float xv[32], o[32];
    {
      const bf16_t* xp = P.u() + (size_t)row * DM + l5 * 32;
      unpack8(*(const uint4*)xp, xv); unpack8(*(const uint4*)(xp + 8), xv + 8);
      unpack8(*(const uint4*)(xp + 16), xv + 16); unpack8(*(const uint4*)(xp + 24), xv + 24);
    }
    const int idx0 = P.sel_idx()[(size_t)row * 128 + lane], idx1 = P.sel_idx()[(size_t)row * 128 + 64 + lane];
    const float gt0 = P.sel_g()[(size_t)row * 128 + lane] * P.invV()[idx0], gt1 = P.sel_g()[(size_t)row * 128 + 64 + lane] * P.invV()[idx1];
    const float iu0 = P.invU()[idx0], iu1 = P.invU()[idx1];
    float d0 = 0.f, d1 = 0.f;
    uint4 bufA[8], bufB[8];
#define PG_LOAD(buf, T, kk) do { _Pragma("unroll") for (int j = 0; j < 8; ++j) { \
      const int k_ = (kk) + 2 * j; const int src_ = k_ < 64 ? idx0 : idx1; \
      const int elo_ = __builtin_amdgcn_readlane(src_, k_ & 63), ehi_ = __builtin_amdgcn_readlane(src_, (k_ & 63) + 1); \
      buf[j] = *(const uint4*)(T + (size_t)(up ? ehi_ : elo_) * 512); } } while (0)
#define PG_DOT(buf, kk) do { float pv[8]; _Pragma("unroll") for (int j = 0; j < 8; ++j) { float s_ = 0.f; const uint32_t w_[4] = {buf[j].x, buf[j].y, buf[j].z, buf[j].w}; \
      _Pragma("unroll") for (int d = 0; d < 4; ++d) { float f[8]; uint32_t wd_ = w_[d]; asm volatile("" : "+v"(wd_) : "v"(s_)); cvt8(wd_, f); \
        _Pragma("unroll") for (int i = 0; i < 8; ++i) s_ += f[i] * xv[d * 8 + i]; } pv[j] = s_; } \
      const float z0 = swap16_add(pv[0], pv[4]), z1 = swap16_add(pv[1], pv[5]), z2 = swap16_add(pv[2], pv[6]), z3 = swap16_add(pv[3], pv[7]); \
      const bool hi8 = (lane & 8) != 0, hi4 = (lane & 4) != 0; \
      const float y0 = (hi8 ? z1 : z0) + DPP_F(hi8 ? z0 : z1, 0x128); \
      const float y1 = (hi8 ? z3 : z2) + DPP_F(hi8 ? z2 : z3, 0x128); \
      float q_ = (hi4 ? y1 : y0) + DPP_F(hi4 ? y0 : y1, 0x141); \
      q_ += DPP_F(q_, 0xB1); q_ += DPP_F(q_, 0x4E); \
      const float t_ = __int_as_float(__builtin_amdgcn_ds_bpermute(srcl * 4, __float_as_int(q_))); \
      const int m_ = ((kk) >> 4) & 3; \
      if ((kk) < 64) d0 = ((lane >> 4) == m_) ? t_ : d0; else d1 = ((lane >> 4) == m_) ? t_ : d1; } while (0)
    PG_LOAD(bufA, TU, 0);
#pragma unroll 1
    for (int kk = 0; kk < 128; kk += 32) {
      PG_LOAD(bufB, TU, kk + 16);
      PG_DOT(bufA, kk);
      if (kk + 32 < 128) PG_LOAD(bufA, TU, kk + 32); else PG_LOAD(bufA, TV, 0);
      PG_DOT(bufB, kk + 16);
    }
    const float act0 = gelu_f(d0 * iu0) * gt0, act1 = gelu_f(d1 * iu1) * gt1;
#pragma unroll
    for (int i = 0; i < 32; ++i) o[i] = 0.f;
#define PG_ACC(buf, kk) do { _Pragma("unroll") for (int j = 0; j < 8; ++j) { const int k_ = (kk) + 2 * j; \
      const int asrc_ = __float_as_int(k_ < 64 ? act0 : act1); \
      const float alo_ = __int_as_float(__builtin_amdgcn_readlane(asrc_, k_ & 63)), ahi_ = __int_as_float(__builtin_amdgcn_readlane(asrc_, (k_ & 63) + 1)); \
      const float a_ = up ? ahi_ : alo_; \
      const uint32_t w_[4] = {buf[j].x, buf[j].y, buf[j].z, buf[j].w}; \
      _Pragma("unroll") for (int d = 0; d < 4; ++d) { float f[8]; uint32_t wd_ = w_[d]; asm volatile("" : "+v"(wd_) : "v"(o[(d * 8 + 31) & 31])); cvt8(wd_, f); \
        _Pragma("unroll") for (int i = 0; i < 8; ++i) o[d * 8 + i] += a_ * f[i]; } } } while (0)
#pragma unroll 1
    for (int kk = 0; kk < 128; kk += 32) {
      PG_LOAD(bufB, TV, kk + 16);
      PG_ACC(bufA, kk);
      if (kk + 32 < 128) PG_LOAD(bufA, TV, kk + 32);
      PG_ACC(bufB, kk + 16);
    }
#undef PG_LOAD
#undef PG_DOT
#undef PG_ACC
#pragma unroll
    for (int i = 0; i < 32; ++i) {
      auto r = __builtin_amdgcn_permlane32_swap(__float_as_uint(o[i]), __float_as_uint(o[i]), false, false);
      o[i] = __uint_as_float(r[0]) + __uint_as_float(r[1]);
    }
    const int lane_e = otid(wv) & 63, l5e = lane_e & 31;
    const bool upe = lane_e >= 32;
    const float* gate = P.mod() + (size_t)(layer * 5 + modrow(row)) * MODW + 5120 + l5e * 32;
    float* hr = P.h() + (size_t)row * DM + l5e * 32;
    float ss = 0.f;
#pragma unroll
    for (int q = 0; q < 8; ++q) {
      float4 hv = *(float4*)(hr + q * 4);
      const float4 gg = *(const float4*)(gate + q * 4);
      hv.x += gg.x * o[q * 4 + 0]; hv.y += gg.y * o[q * 4 + 1]; hv.z += gg.z * o[q * 4 + 2]; hv.w += gg.w * o[q * 4 + 3];
      if (layer == 0 && !upe) *(float4*)(hr + q * 4) = hv;
      o[q * 4 + 0] = hv.x; o[q * 4 + 1] = hv.y; o[q * 4 + 2] = hv.z; o[q * 4 + 3] = hv.w;
      if (!upe) ss += hv.x * hv.x + hv.y * hv.y + hv.z * hv.z + hv.w * hv.w;
    }
    ss = wave_sum(ss);
    const float rstd = rsqrtf(ss * (1.f / 1024.f) + 1e-6f);
    if (layer == 0) {
      const float* g1 = P.norm1_g + 1024 + l5e * 32;
      const float* mr = P.mod() + (size_t)(5 + modrow(row)) * MODW + l5e * 32;
      if (!upe) {
#pragma unroll
        for (int q = 0; q < 4; ++q) {
          float ov[8];
#pragma unroll
          for (int e = 0; e < 8; ++e) ov[e] = o[q * 8 + e] * rstd * g1[q * 8 + e] * (1.f + mr[1024 + q * 8 + e]) + mr[q * 8 + e];
          *(uint4*)(P.u() + (size_t)row * DM + l5e * 32 + q * 8) = make_uint4(pack2(ov[0], ov[1]), pack2(ov[2], ov[3]), pack2(ov[4], ov[5]), pack2(ov[6], ov[7]));
        }
      }
    } else {
      const float* gf = P.final_g + l5e * 32;
      if (!upe) {
#pragma unroll
        for (int q = 0; q < 8; ++q) {
          const float4 gg = *(const float4*)(gf + q * 4);
          *(float4*)(P.out + (size_t)row * DM + l5e * 32 + q * 4) =
              make_float4(o[q * 4] * rstd * gg.x, o[q * 4 + 1] * rstd * gg.y, o[q * 4 + 2] * rstd * gg.z, o[q * 4 + 3] * rstd * gg.w);
        }
      }
    }
  }
}

__device__ void ph_final(int wv, const Params& P, int bid, int nb) {
  const int wave = otid(wv) >> 6, lane = otid(wv) & 63;
  for (int row = bid * NWAVE + wave; row < NLAT; row += nb * NWAVE) {
    const float* src = P.h() + (size_t)row * DM;
    float4 v[4];
    float ss = 0.f;
#pragma unroll
    for (int i = 0; i < 4; ++i) {
      v[i] = ((const float4*)src)[i * 64 + lane];
      ss += v[i].x * v[i].x + v[i].y * v[i].y + v[i].z * v[i].z + v[i].w * v[i].w;
    }
    ss = wave_sum(ss);
    const float rstd = rsqrtf(ss * (1.f / 1024.f) + 1e-6f);
#pragma unroll
    for (int i = 0; i < 4; ++i) {
      const int idx = i * 256 + lane * 4;
      const float4 gg = *(const float4*)(P.final_g + idx);
      float4 o;
      o.x = v[i].x * rstd * gg.x; o.y = v[i].y * rstd * gg.y; o.z = v[i].z * rstd * gg.z; o.w = v[i].w * rstd * gg.w;
      *(float4*)(P.out + (size_t)row * DM + idx) = o;
    }
  }
}


struct EpiOutproj {
  static constexpr bool PERM = false, AFTER_DRAIN = false;
  float* H; const float* hl; const float* hc; const float* modl;
  __device__ __forceinline__ void operator()(const pg8::f32x4 (&acc)[2][2][4][2], const pg8::Unit& u, int wr, int wc, int fr, int fq) const {
    const int row0 = u.pm * 256 + wr * 64 + fr, col0 = u.pn * 256 + wc * 32 + 4 * fq;
#pragma unroll
    for (int ai = 0; ai < 2; ++ai)
#pragma unroll
      for (int m = 0; m < 4; ++m) {
        const int row = row0 + ai * 128 + m * 16;
        const float* src = hrow(hl, hc, row) + col0;
        const float* gate = modl + (size_t)modrow(row) * MODW + 2048 + col0;
        float* dst = H + (size_t)row * DM + col0;
#pragma unroll
        for (int bj = 0; bj < 2; ++bj)
#pragma unroll
          for (int n = 0; n < 2; ++n) {
            const pg8::f32x4 s = *(const pg8::f32x4*)(src + bj * 128 + n * 16);
            const pg8::f32x4 g = *(const pg8::f32x4*)(gate + bj * 128 + n * 16);
            *(pg8::f32x4*)(dst + bj * 128 + n * 16) = s + g * acc[ai][bj][m][n];
          }
      }
  }
};

__device__ __forceinline__ uint32_t fp4_code(float x, float sc) {
  const float a = fabsf(x) * sc;
  const uint32_t c = (uint32_t)(a > 0.25f) + (uint32_t)(a > 0.75f) + (uint32_t)(a > 1.25f) + (uint32_t)(a > 1.75f) +
                     (uint32_t)(a > 2.5f) + (uint32_t)(a > 3.5f) + (uint32_t)(a > 5.0f);
  return c | (x < 0.f ? 8u : 0u);
}
__device__ void ph_convert_tables(int wv, const Params& P, int layer, int bid, int nb) {
  const int lane = otid(wv) & 63;
  for (int it = bid * NWAVE + wv; it < 2 * 16384; it += nb * NWAVE) {
    const int t = it >> 14, e = it & 16383;
    const float* src = (t == 0 ? P.peer_u : P.peer_v) + ((size_t)layer * 16384 + e) * 1024 + lane * 16;
    float4 v[4];
    float m = 0.f;
#pragma unroll
    for (int i = 0; i < 4; ++i) {
      v[i] = ((const float4*)src)[i];
      m = fmaxf(m, fmaxf(fmaxf(fabsf(v[i].x), fabsf(v[i].y)), fmaxf(fabsf(v[i].z), fabsf(v[i].w))));
    }
    m = wave_max(m);
    m = fmaxf(m, 1e-30f);
    const float sc = 6.0f / m, inv = m * (1.0f / 6.0f);
    uint2 o;
    o.x = fp4_code(v[0].x, sc) | (fp4_code(v[0].y, sc) << 4) | (fp4_code(v[0].z, sc) << 8) | (fp4_code(v[0].w, sc) << 12) |
          (fp4_code(v[1].x, sc) << 16) | (fp4_code(v[1].y, sc) << 20) | (fp4_code(v[1].z, sc) << 24) | (fp4_code(v[1].w, sc) << 28);
    o.y = fp4_code(v[2].x, sc) | (fp4_code(v[2].y, sc) << 4) | (fp4_code(v[2].z, sc) << 8) | (fp4_code(v[2].w, sc) << 12) |
          (fp4_code(v[3].x, sc) << 16) | (fp4_code(v[3].y, sc) << 20) | (fp4_code(v[3].z, sc) << 24) | (fp4_code(v[3].w, sc) << 28);
    *(uint2*)((t == 0 ? P.tabU() : P.tabV()) + (size_t)e * 512 + lane * 8) = o;
    if (lane == 0) (t == 0 ? P.invU() : P.invV())[e] = inv;
  }
}

enum {
  PH_PREP = 0, PH_NORM1, PH_INPROJ, PH_CONV, PH_SSDPREP, PH_STATES, PH_SCAN, PH_SSDY, PH_SSDNORM, PH_POOL, PH_NA,
  PH_OUTPROJ, PH_NORM2, PH_QGEMM, PH_TOPK, PH_GATHER, PH_FINAL
};

#define SMEM_BYTES 131072

__device__ __forceinline__ void run_phase(int wv, const Params& P, int ph, int layer, char* smem, int bid, int nb) {
  const float* hl = layer == 0 ? P.x : P.h();
  const float* hc = layer == 0 ? P.ctx : P.h() + (size_t)NLAT * DM;
  const int nrows = layer == 0 ? NTOK : NLAT;
  switch (ph) {
    case PH_PREP:
      for (int i = bid * NTHR + otid(wv); i < 2 * 8 * 2 * 128 * 128; i += nb * NTHR) P.keysb()[i] = f2bf(P.peer_keys[i]);
      for (int i = bid * NTHR + otid(wv); i < 2 * 4 * 128 * 128; i += nb * NTHR) {
        const int k = i & 127, n = (i >> 7) & 127, lg = i >> 14;
        P.poolwT()[i] = f2bf(P.pool_w[((size_t)lg * 128 + k) * 128 + n]);
      }
      ph_mod(wv, P, (float*)smem, bid, nb);
      for (int l = 0; l < 2; ++l) {
        ph_transpose(wv, P.w_in + (size_t)l * 1024 * INW, P.w_inT() + (size_t)l * PW * 1024, 1024, INW, PW, 0, 2560, 32, PW, (float*)smem, bid, nb);
        ph_transpose(wv, P.w_in + (size_t)l * 1024 * INW, P.w_dtT() + (size_t)l * 128 * 1024, 1024, INW, 128, 2560, 1 << 30, 0, 32, (float*)smem, bid, nb);
        ph_transpose(wv, P.w_out + (size_t)l * 2048 * 1024, P.w_outT() + (size_t)l * 1024 * 2048, 2048, 1024, 1024, 0, 1 << 30, 0, 1024, (float*)smem, bid, nb);
        ph_transpose(wv, P.peer_wq + (size_t)l * 1024 * 2048, P.w_qT() + (size_t)l * 2048 * 1024, 1024, 2048, 2048, 0, 1 << 30, 0, 2048, (float*)smem, bid, nb);
      }
      break;
    case PH_NORM1:
      ph_norm(wv, hl, hc, P.norm1_g + layer * 1024, P.mod() + (size_t)layer * 5 * MODW, 0, 1024, NTOK, P.u(), bid, nb);
      break;
    case PH_INPROJ:
    {
      pg8::Gemm g{P.u(), P.w_inT() + (size_t)layer * PW * 1024, NTOK, PW, 1024};
      pg8::StaticOrder S; S.init(g.M, g.N, nb, bid);
      pg8::EpiBf16<0> E{P.p(), PW, nullptr, 0, 0};
      pg8::gemm_phase<pg8::EpiBf16<0>, pg8::StaticOrder, false>(wv, (PG8_LAS unsigned char*)smem, g, S, E, nullptr);
      ph_gemm<EPI_INPROJ>(wv, P, layer, P.u(), P.w_dtT() + (size_t)layer * 128 * 1024, NTOK, 128, 1024, hl, hc, smem, bid, nb);
      break;
    }
    case PH_CONV: ph_conv(wv, P, layer, bid, nb); ph_vtranspose(wv, P, smem, bid, nb); break;
    case PH_SSDPREP: ph_ssdprep(wv, P, layer, smem, bid, nb); break;
    case PH_STATES: ph_states_mfma(wv, P, layer, smem, bid, nb); break;
    case PH_SCAN: ph_scan(wv, P, bid, nb); break;
    case PH_SSDY: ph_ssdy_mfma(wv, P, layer, nrows / 128, smem, bid, nb); break;
    case PH_SSDNORM: ph_ssdnorm(wv, P, layer, nrows, bid, nb); break;
    case PH_POOL: ph_pool_mfma(wv, P, layer, nrows, bid, nb); break;
    case PH_NA: ph_na_mfma(wv, P, layer, nrows, bid, nb); break;
    case PH_OUTPROJ:
    {
      pg8::Gemm g{P.concat(), P.w_outT() + (size_t)layer * 1024 * 2048, nrows, 1024, 2048};
      pg8::StaticOrder S; S.init(g.M, g.N, nb, bid);
      EpiOutproj E{P.h(), hl, hc, P.mod() + (size_t)layer * 5 * MODW};
      pg8::gemm_phase<EpiOutproj, pg8::StaticOrder, false>(wv, (PG8_LAS unsigned char*)smem, g, S, E, nullptr);
      break;
    }
    case PH_NORM2:
      ph_norm(wv, P.h(), P.h() + (size_t)NLAT * DM, P.norm2_g + layer * 1024, P.mod() + (size_t)layer * 5 * MODW, 3072, 4096, nrows, P.u(), bid, nb);
      break;
    case PH_QGEMM:
    {
      pg8::Gemm g{P.u(), P.w_qT() + (size_t)layer * 2048 * 1024, nrows, 2048, 1024};
      pg8::StaticOrder S; S.init(g.M, g.N, nb, bid);
      pg8::EpiBf16<0> E{P.q(), 2048, nullptr, 0, 0};
      pg8::gemm_phase<pg8::EpiBf16<0>, pg8::StaticOrder, false>(wv, (PG8_LAS unsigned char*)smem, g, S, E, nullptr);
      ph_convert_tables(wv, P, layer, bid, nb);
      break;
    }
    case PH_TOPK: ph_peer_topk_mfma(wv, P, layer, nrows, smem, bid, nb); break;
    case PH_GATHER: ph_peer_gather(wv, P, layer, nrows, bid, nb); break;
    case PH_FINAL: ph_final(wv, P, bid, nb); break;
  }
}

namespace cg = cooperative_groups;
typedef const __attribute__((address_space(4))) Params* kparams_t;
__device__ __forceinline__ const Params& kp_fresh() {
  kparams_t kp = (kparams_t)__builtin_amdgcn_kernarg_segment_ptr();
  asm volatile("" : "+s"(kp));
  return *(const Params*)kp;
}
__global__ void __launch_bounds__(NTHR) k_mega(Params P_unused) {
  __shared__ __attribute__((aligned(16))) char smem[SMEM_BYTES + 16];
  cg::grid_group grid = cg::this_grid();
  const int bid = blockIdx.x, nb = gridDim.x;
  const int wv = __builtin_amdgcn_readfirstlane(threadIdx.x >> 6);
  if (threadIdx.x == 0) *(uint4*)(smem + SMEM_BYTES) = make_uint4(0u, 0u, 0u, 0u);
  __syncthreads();
  (void)xcd_barrier_post((unsigned*)(kp_fresh().ws + WS_BAR), (volatile LAS unsigned*)(smem + SMEM_BYTES), threadIdx.x == 0);
#define GSYNC() do { XcdBarrier xb_; xb_.bar = (unsigned*)(kp_fresh().ws + WS_BAR); xb_.x = xb_xcc_id(); \
    xb_.st = (volatile LAS unsigned*)(smem + SMEM_BYTES); xcd_barrier(xb_, otid(wv) == 0); } while (0)
  run_phase(wv, kp_fresh(), PH_PREP, 0, smem, bid, nb);
  grid.sync();
  run_phase(wv, kp_fresh(), PH_NORM1, 0, smem, bid, nb); GSYNC();
#pragma unroll 1
  for (int layer = 0; layer < 2; ++layer) {
    run_phase(wv, kp_fresh(), PH_INPROJ, layer, smem, bid, nb); GSYNC();
    run_phase(wv, kp_fresh(), PH_CONV, layer, smem, bid, nb);
    run_phase(wv, kp_fresh(), PH_SSDPREP, layer, smem, bid, nb); GSYNC();
    run_phase(wv, kp_fresh(), PH_CONV, layer, smem, bid, nb);
    run_phase(wv, kp_fresh(), PH_SSDPREP, layer, smem, bid, nb); GSYNC();
    run_phase(wv, kp_fresh(), PH_STATES, layer, smem, bid, nb);
    run_phase(wv, kp_fresh(), PH_POOL, layer, smem, bid, nb);
    run_phase(wv, kp_fresh(), PH_NA, layer, smem, bid, nb); GSYNC();
    run_phase(wv, kp_fresh(), PH_SCAN, layer, smem, bid, nb); GSYNC();
    run_phase(wv, kp_fresh(), PH_SSDY, layer, smem, bid, nb); GSYNC();
    run_phase(wv, kp_fresh(), PH_SSDNORM, layer, smem, bid, nb); GSYNC();
    run_phase(wv, kp_fresh(), PH_OUTPROJ, layer, smem, bid, nb); GSYNC();
    run_phase(wv, kp_fresh(), PH_NORM2, layer, smem, bid, nb); GSYNC();
    run_phase(wv, kp_fresh(), PH_QGEMM, layer, smem, bid, nb); GSYNC();
    run_phase(wv, kp_fresh(), PH_TOPK, layer, smem, bid, nb); GSYNC();
    run_phase(wv, kp_fresh(), PH_GATHER, layer, smem, bid, nb);
    if (layer == 0) GSYNC();
  }
}

extern "C" void kernel_launch(void* const* d_in, const int* in_sizes, int n_in, void* d_out, int out_size, void* d_ws,
                              size_t ws_size, hipStream_t stream) {
  Params P{};
  const float* const* in = (const float* const*)d_in;
  P.x = in[0]; P.c = in[1]; P.ctx = in[2]; P.c_ctx = in[3]; P.ada_w = in[4]; P.ada_b = in[5]; P.norm1_g = in[6];
  P.w_in = in[7]; P.conv_w = in[8]; P.conv_b = in[9]; P.a_log = in[10]; P.dt_bias = in[11]; P.d_skip = in[12];
  P.ssd_norm_g = in[13]; P.pool_w = in[14]; P.pool_scale = in[15]; P.na_rpb = in[16]; P.w_out = in[17];
  P.norm2_g = in[18]; P.peer_wq = in[19]; P.peer_keys = in[20]; P.peer_u = in[21]; P.peer_v = in[22]; P.final_g = in[23];
  P.out = (float*)d_out;
  P.ws = (char*)d_ws;
  if (WS_TOTAL > ws_size) { fprintf(stderr, "workspace too small: need %zu have %zu\n", (size_t)WS_TOTAL, ws_size); return; }

  static int grid_blocks = 0;
  if (!grid_blocks) {
    int dev = 0, cus = 0, per_cu = 0;
    hipGetDevice(&dev);
    hipDeviceGetAttribute(&cus, hipDeviceAttributeMultiprocessorCount, dev);
    hipOccupancyMaxActiveBlocksPerMultiprocessor(&per_cu, k_mega, NTHR, 0);
    if (per_cu > 4) per_cu = 4;
    grid_blocks = cus * per_cu;
  }
  hipMemsetAsync((char*)d_ws + WS_BAR, 0, 4096 * 4, stream);
  void* args[] = {&P};
  hipError_t e = hipLaunchCooperativeKernel((void*)k_mega, dim3(grid_blocks), dim3(NTHR), args, 0, stream);
  if (e != hipSuccess) fprintf(stderr, "cooperative launch failed: %s (grid %d)\n", hipGetErrorString(e), grid_blocks);
}
```

```cpp
#include <hip/hip_runtime.h>
#include <hip/hip_bf16.h>
#include <hip/hip_cooperative_groups.h>
#include <stdint.h>
#include <stdio.h>

typedef unsigned short bf16_t;
typedef __attribute__((ext_vector_type(8))) short bf16x8;
typedef __attribute__((ext_vector_type(4))) float f32x4;

#define NTHR 512
#define NWAVE 8
constexpr int DM = 1024;
constexpr int SEQ = 4096;
constexpr int NLAT = 16384;
constexpr int NCTXR = 1024;
constexpr int NTOK = 17408;
constexpr int INW = 4640;
constexpr int PW = 4608;
constexpr int OFF_Z = 0, OFF_XBC = 1024, OFF_POOL = 2560, OFF_Q = 3072, OFF_K = 3584, OFF_V = 4096;
constexpr int NCHUNK = 136;
constexpr int MODW = 6144;

constexpr size_t al256(size_t x) { return (x + 255) & ~(size_t)255; }
constexpr size_t WS_MOD = 0;
constexpr size_t WS_H = WS_MOD + al256((size_t)2 * 5 * MODW * 4);
constexpr size_t WS_P = WS_H + al256((size_t)NTOK * DM * 4);
constexpr size_t WS_TABU = WS_P + (size_t)80 * 1024 * 1024;
constexpr size_t WS_TABV = WS_TABU + (size_t)16384 * 512;
constexpr size_t WS_INVU = WS_TABV + (size_t)16384 * 512;
constexpr size_t WS_INVV = WS_INVU + (size_t)16384 * 4;
constexpr size_t WS_DTRAW = WS_P + al256((size_t)NTOK * PW * 2);
constexpr size_t WS_DTV = WS_DTRAW + al256((size_t)NTOK * 32 * 4);
constexpr size_t WS_CSV = WS_DTV + al256((size_t)NTOK * 32 * 4);
constexpr size_t WS_XBC = WS_CSV + al256((size_t)NTOK * 32 * 4);
constexpr size_t WS_VTL = WS_XBC + al256((size_t)NTOK * 512 * 2);
constexpr size_t WS_VTC = WS_VTL + al256((size_t)4 * 8 * 64 * 4096 * 2);
constexpr size_t WS_KEYSB = WS_VTC + al256((size_t)4 * 8 * 64 * 256 * 2);
constexpr size_t WS_POOLWT = WS_KEYSB + al256((size_t)2 * 8 * 2 * 128 * 128 * 2);
constexpr size_t WS_STATES = WS_XBC + al256((size_t)NTOK * 1536 * 2);
static_assert(WS_POOLWT + (size_t)2 * 4 * 128 * 128 * 2 <= WS_STATES, "must fit in the old xbc region");
constexpr size_t WS_CONCAT = WS_STATES + al256((size_t)NCHUNK * 32 * 8192 * 2);
constexpr size_t WS_SELIDX = WS_CONCAT + al256((size_t)NTOK * 2048 * 2);
constexpr size_t WS_SELG = WS_SELIDX + al256((size_t)NTOK * 128 * 4);
constexpr size_t WS_WINT = WS_SELG + al256((size_t)NTOK * 128 * 4);
constexpr size_t WS_WDTT = WS_WINT + al256((size_t)2 * PW * 1024 * 2);
constexpr size_t WS_WOUTT = WS_WDTT + al256((size_t)2 * 128 * 1024 * 2);
constexpr size_t WS_WQT = WS_WOUTT + al256((size_t)2 * 1024 * 2048 * 2);
constexpr size_t WS_BAR = WS_WQT + al256((size_t)2 * 2048 * 1024 * 2);
constexpr size_t WS_TOTAL = WS_BAR + al256((size_t)4096 * 4);
static_assert(WS_INVV + (size_t)16384 * 4 <= WS_DTRAW, "tables must fit in the tail of p");
static_assert((size_t)NTOK * 2048 * 2 <= (size_t)80 * 1024 * 1024, "q must fit below the tables");

struct Params {
  const float *x, *c, *ctx, *c_ctx, *ada_w, *ada_b, *norm1_g, *w_in, *conv_w, *conv_b, *a_log, *dt_bias, *d_skip,
      *ssd_norm_g, *pool_w, *pool_scale, *na_rpb, *w_out, *norm2_g, *peer_wq, *peer_keys, *peer_u, *peer_v, *final_g;
  float* out;
  char* ws;
  __device__ __forceinline__ float* mod() const { return (float*)(ws + WS_MOD); }
  __device__ __forceinline__ float* h() const { return (float*)(ws + WS_H); }
  __device__ __forceinline__ bf16_t* u() const { return (bf16_t*)(ws + WS_CONCAT); }
  __device__ __forceinline__ bf16_t* p() const { return (bf16_t*)(ws + WS_P); }
  __device__ __forceinline__ float* dtraw() const { return (float*)(ws + WS_DTRAW); }
  __device__ __forceinline__ float* dtv() const { return (float*)(ws + WS_DTV); }
  __device__ __forceinline__ float* csv() const { return (float*)(ws + WS_CSV); }
  __device__ __forceinline__ bf16_t* xbc() const { return (bf16_t*)(ws + WS_XBC); }
  __device__ __forceinline__ bf16_t* states() const { return (bf16_t*)(ws + WS_STATES); }
  __device__ __forceinline__ bf16_t* concat() const { return (bf16_t*)(ws + WS_CONCAT); }
  __device__ __forceinline__ bf16_t* q() const { return (bf16_t*)(ws + WS_P); }
  __device__ __forceinline__ int* sel_idx() const { return (int*)(ws + WS_SELIDX); }
  __device__ __forceinline__ float* sel_g() const { return (float*)(ws + WS_SELG); }
  __device__ __forceinline__ bf16_t* w_inT() const { return (bf16_t*)(ws + WS_WINT); }
  __device__ __forceinline__ bf16_t* w_dtT() const { return (bf16_t*)(ws + WS_WDTT); }
  __device__ __forceinline__ bf16_t* w_outT() const { return (bf16_t*)(ws + WS_WOUTT); }
  __device__ __forceinline__ bf16_t* w_qT() const { return (bf16_t*)(ws + WS_WQT); }
  __device__ __forceinline__ bf16_t* vtl() const { return (bf16_t*)(ws + WS_VTL); }
  __device__ __forceinline__ bf16_t* vtc() const { return (bf16_t*)(ws + WS_VTC); }
  __device__ __forceinline__ bf16_t* poolwT() const { return (bf16_t*)(ws + WS_POOLWT); }
  __device__ __forceinline__ bf16_t* keysb() const { return (bf16_t*)(ws + WS_KEYSB); }
  __device__ __forceinline__ unsigned char* tabU() const { return (unsigned char*)(ws + WS_TABU); }
  __device__ __forceinline__ unsigned char* tabV() const { return (unsigned char*)(ws + WS_TABV); }
  __device__ __forceinline__ float* invU() const { return (float*)(ws + WS_INVU); }
  __device__ __forceinline__ float* invV() const { return (float*)(ws + WS_INVV); }
};

__device__ __forceinline__ int otid(int wv) {
  int l;
  asm volatile("v_mbcnt_lo_u32_b32 %0, -1, 0\n\tv_mbcnt_hi_u32_b32 %0, -1, %0" : "=v"(l));
  return (wv << 6) | l;
}
__device__ __forceinline__ float bf2f(bf16_t v) { return __uint_as_float(((uint32_t)v) << 16); }
__device__ __forceinline__ bf16_t f2bf(float f) {
  uint32_t u = __float_as_uint(f);
  u += 0x7fffu + ((u >> 16) & 1u);
  return (bf16_t)(u >> 16);
}
#define DPP_F(v, ctrl) __int_as_float(__builtin_amdgcn_update_dpp(0, __float_as_int(v), (ctrl), 0xf, 0xf, true))
__device__ __forceinline__ float wave_sum(float v) {
  v += DPP_F(v, 0xB1);
  v += DPP_F(v, 0x4E);
  v += DPP_F(v, 0x141);
  v += DPP_F(v, 0x140);
  const int iv = __float_as_int(v);
  return __int_as_float(__builtin_amdgcn_readlane(iv, 0)) + __int_as_float(__builtin_amdgcn_readlane(iv, 16)) +
         __int_as_float(__builtin_amdgcn_readlane(iv, 32)) + __int_as_float(__builtin_amdgcn_readlane(iv, 48));
}
__device__ __forceinline__ float wave_max(float v) {
  v = fmaxf(v, DPP_F(v, 0xB1));
  v = fmaxf(v, DPP_F(v, 0x4E));
  v = fmaxf(v, DPP_F(v, 0x141));
  v = fmaxf(v, DPP_F(v, 0x140));
  const int iv = __float_as_int(v);
  return fmaxf(fmaxf(__int_as_float(__builtin_amdgcn_readlane(iv, 0)), __int_as_float(__builtin_amdgcn_readlane(iv, 16))),
               fmaxf(__int_as_float(__builtin_amdgcn_readlane(iv, 32)), __int_as_float(__builtin_amdgcn_readlane(iv, 48))));
}
__device__ __forceinline__ float silu_f(float v) { return v / (1.f + expf(-v)); }
__device__ __forceinline__ float softplus_f(float v) { return fmaxf(v, 0.f) + log1pf(expf(-fabsf(v))); }
__device__ __forceinline__ float gelu_f(float v) { return 0.5f * v * (1.f + erff(v * 0.70710678118654752f)); }

__device__ __forceinline__ void unpack8(const uint4 v, float* f) {
  f[0] = __uint_as_float(v.x << 16); f[1] = __uint_as_float(v.x & 0xffff0000u);
  f[2] = __uint_as_float(v.y << 16); f[3] = __uint_as_float(v.y & 0xffff0000u);
  f[4] = __uint_as_float(v.z << 16); f[5] = __uint_as_float(v.z & 0xffff0000u);
  f[6] = __uint_as_float(v.w << 16); f[7] = __uint_as_float(v.w & 0xffff0000u);
}
__device__ __forceinline__ uint32_t pack2(float a, float b) { return (uint32_t)f2bf(a) | ((uint32_t)f2bf(b) << 16); }
typedef float f32x2_t __attribute__((ext_vector_type(2)));
typedef unsigned u32x4_t __attribute__((ext_vector_type(4)));
typedef short s16x4 __attribute__((ext_vector_type(4)));
typedef __attribute__((address_space(3))) s16x4 lds_s16x4;
__device__ __forceinline__ bf16x8 tr_read2(const char* a0, const char* a1) {
  const s16x4 a = __builtin_amdgcn_ds_read_tr16_b64_v4i16((lds_s16x4*)a0);
  const s16x4 b = __builtin_amdgcn_ds_read_tr16_b64_v4i16((lds_s16x4*)a1);
  return (bf16x8){a[0], a[1], a[2], a[3], b[0], b[1], b[2], b[3]};
}

__device__ __forceinline__ const float* hrow(const float* hl, const float* hc, int row) {
  return row < NLAT ? hl + (size_t)row * DM : hc + (size_t)(row - NLAT) * DM;
}
__device__ __forceinline__ int modrow(int row) { return row < NLAT ? (row >> 12) : 4; }

namespace pg8 {
#define PG8_LAS __attribute__((address_space(3)))
typedef unsigned short bf16_t;
typedef short bf16x8 __attribute__((ext_vector_type(8)));
typedef float f32x4 __attribute__((ext_vector_type(4)));
typedef unsigned u32x4 __attribute__((ext_vector_type(4)));
constexpr int BM = 256, BK = 64, HALF = 128, HTB = HALF * BK * 2  , STAGE_BYTES = 8 * HTB, NXCD = 8, WGM = 8;

__host__ __device__ __forceinline__ int lds_byte(int r, int c) { const int st = (r >> 4) * 2 + (c >> 5), rr = r & 15, cc = c & 31, ob = rr * 64 + cc * 2; return st * 1024 + (ob ^ (((ob >> 9) & 1) << 5)); }
__host__ __device__ __forceinline__ void stage_rc(int b, int& R, int& C) { const int st = b / 1024, sb = b % 1024, swz = sb ^ (((sb >> 9) & 1) << 5); R = (st >> 1) * 16 + swz / 64; C = (st & 1) * 32 + (swz % 64) / 2; }
__host__ __device__ __forceinline__ int perm32(int rho) { const int n = rho >> 4, i = rho & 15; return 8 * (i >> 2) + 4 * n + (i & 3); }

struct Unit { int pm, pn; };
struct Gemm { const bf16_t* A; const bf16_t* Bt; int M, N, K; };

struct StaticOrder {
    int nM, nN, nwg, G, c;
    __host__ __device__ void init(int M, int N, int G_, int c_) { nM = M / BM; nN = N / BM; nwg = nM * nN; G = G_; c = c_; }
    __host__ __device__ bool next(int i, Unit& u) const {
        const long L = (long)i * G + c; if (L >= nwg) return false;
        int wgid = (int)L; { const int q = nwg / NXCD, r = nwg % NXCD, xcd = wgid % NXCD, off = wgid / NXCD; wgid = (xcd < r ? xcd * (q + 1) : r * (q + 1) + (xcd - r) * q) + off; }
        const int nig = WGM * nN, gid = wgid / nig, fm = gid * WGM, gsz = (nM - fm) < WGM ? (nM - fm) : WGM;
        u.pm = fm + ((wgid % nig) % gsz); u.pn = (wgid % nig) / gsz; return true;
    }
    __device__ __forceinline__ void a_ready(const Unit&) const {}
    __device__ __forceinline__ void done(const Unit&) const {}
};

__device__ __forceinline__ unsigned cvt_pk_bf16(float lo, float hi) { unsigned r; asm volatile("v_cvt_pk_bf16_f32 %0, %1, %2" : "=v"(r) : "v"(lo), "v"(hi)); return r; }
typedef float f32x2 __attribute__((ext_vector_type(2)));
__device__ __forceinline__ f32x2 gelu_pk(f32x2 v) { return v; }
template <int ACT  > struct EpiBf16 {
    static constexpr bool PERM = true, AFTER_DRAIN = false;
    bf16_t* O; int ldc; const float* bias; int split_cols; size_t split_stride;
    __device__ __forceinline__ void operator()(const f32x4 (&acc)[2][2][4][2], const Unit& u, int wr, int wc, int fr, int fq) const {
        const int row0 = u.pm * BM + wr * 64 + fr; int colt = u.pn * BM; bf16_t* base = O;
        if (split_cols) { const int t = colt / split_cols; base += (size_t)t * split_stride; colt -= t * split_cols; }
        const int col0 = colt + wc * 32 + 8 * fq, bcol0 = u.pn * BM + wc * 32 + 8 * fq;
        f32x4 bv[2][2];
#pragma unroll
        for (int bj = 0; bj < 2; ++bj)
#pragma unroll
            for (int n = 0; n < 2; ++n) bv[bj][n] = bias ? *(const f32x4*)(bias + bcol0 + bj * HALF + 4 * n) : (f32x4){0.f, 0.f, 0.f, 0.f};
#pragma unroll
        for (int ai = 0; ai < 2; ++ai)
#pragma unroll
            for (int m = 0; m < 4; ++m) { bf16_t* rowp = base + (size_t)(row0 + ai * HALF + m * 16) * ldc + col0;
#pragma unroll
                for (int bj = 0; bj < 2; ++bj) { f32x4 v0 = acc[ai][bj][m][0] + bv[bj][0], v1 = acc[ai][bj][m][1] + bv[bj][1];
                    if (ACT == 1) { f32x2 a = gelu_pk((f32x2){v0[0], v0[1]}), b = gelu_pk((f32x2){v0[2], v0[3]}), c = gelu_pk((f32x2){v1[0], v1[1]}), d = gelu_pk((f32x2){v1[2], v1[3]});
                        v0 = (f32x4){a.x, a.y, b.x, b.y}; v1 = (f32x4){c.x, c.y, d.x, d.y}; }
                    if (ACT == 2) {
#pragma unroll
                        for (int j = 0; j < 4; ++j) { v0[j] = 0.5f * v0[j] * (1.0f + erff(v0[j] * 0.70710678f)); v1[j] = 0.5f * v1[j] * (1.0f + erff(v1[j] * 0.70710678f)); } }
                    u32x4 w; w.x = cvt_pk_bf16(v0[0], v0[1]); w.y = cvt_pk_bf16(v0[2], v0[3]); w.z = cvt_pk_bf16(v1[0], v1[1]); w.w = cvt_pk_bf16(v1[2], v1[3]);
                    *(u32x4*)(rowp + bj * HALF) = w; } }
    }
};

template <class Epi, class Sched, bool STAMP = false>
__device__ __forceinline__ void gemm_phase(int wv, PG8_LAS unsigned char* lds, const Gemm g, const Sched& S, const Epi& E, unsigned long long* stamps) {
    const int tid = otid(wv), wid = __builtin_amdgcn_readfirstlane(tid >> 6), lane = tid & 63, wr = wid >> 2, wc = wid & 3, fr = lane & 15, fq = lane >> 4;
    const int K = g.K, nt = K / BK;
    int ts_lo = 0, ts_hi = 0, nts = 0; const unsigned long long rt_entry = STAMP ? (unsigned long long)wall_clock64() : 0ull;
#define PG8_STAMP() do { if (STAMP && wid == 0 && nts < 64) { const unsigned long long _c = (unsigned long long)clock64(); \
        ts_lo = (lane == nts) ? (int)(unsigned)_c : ts_lo; ts_hi = (lane == nts) ? (int)(unsigned)(_c >> 32) : ts_hi; ++nts; } } while (0)
    PG8_STAMP();
    unsigned voffA[2], voffB[2];
#pragma unroll
    for (int i = 0; i < 2; ++i) { int R, C; stage_rc(tid * 16 + i * 8192, R, C); const int Rb = Epi::PERM ? ((R & ~31) + perm32(R & 31)) : R;
        voffA[i] = (unsigned)(R * K + C) * 2u; voffB[i] = (unsigned)(Rb * K + C) * 2u; }
    const size_t kstep = (size_t)(BK * 2);
    const size_t hstep = (size_t)HALF * K * 2;
    const size_t tstep = 2 * hstep;
    const unsigned ldsw = (unsigned)wid * 1024u;
    const int aoff = lds_byte(wr * 64 + fr, fq * 8), boff = lds_byte(wc * 32 + fr, fq * 8);
#define PG8_SA(b, h) (((b) * 2 + (h)) * HTB)
#define PG8_SB(b, h) ((4 + (b) * 2 + (h)) * HTB)
#define PG8_STAGE(bufoff, gbase, voff) do { _Pragma("unroll") for (int _i = 0; _i < 2; ++_i) \
        __builtin_amdgcn_global_load_lds((const unsigned*)((const char*)(gbase) + (voff)[_i]), (PG8_LAS unsigned*)(lds + (bufoff) + ldsw + _i * 8192), 16, 0, 0); } while (0)
#define PG8_LDA(dst, b, h) do { _Pragma("unroll") for (int m = 0; m < 4; ++m) _Pragma("unroll") for (int k = 0; k < 2; ++k) dst[m][k] = *(const PG8_LAS bf16x8*)(lds + PG8_SA(b, h) + aoff + m * 2048 + k * 1024); } while (0)
#define PG8_LDB(dst, b, h) do { _Pragma("unroll") for (int n = 0; n < 2; ++n) _Pragma("unroll") for (int k = 0; k < 2; ++k) dst[n][k] = *(const PG8_LAS bf16x8*)(lds + PG8_SB(b, h) + boff + n * 2048 + k * 1024); } while (0)
#define PG8_MMA(ai, bj, At, Bt) do { __builtin_amdgcn_s_setprio(1); _Pragma("unroll") for (int m = 0; m < 4; ++m) _Pragma("unroll") for (int n = 0; n < 2; ++n) _Pragma("unroll") for (int k = 0; k < 2; ++k) \
        acc[ai][bj][m][n] = __builtin_amdgcn_mfma_f32_16x16x32_bf16(Bt[n][k], At[m][k], acc[ai][bj][m][n], 0, 0, 0); __builtin_amdgcn_s_setprio(0); } while (0)
#define PG8_WAIT_V(n) asm volatile("s_waitcnt vmcnt(" #n ")" ::: "memory")
#define PG8_WAIT_L(n) asm volatile("s_waitcnt lgkmcnt(" #n ")" ::: "memory")
#define PG8_BAR __builtin_amdgcn_s_barrier()
#define PG8_SCHED __builtin_amdgcn_sched_barrier(0)
    Unit cur, nxt; int ui = 0;
    if (!S.next(0, cur)) return;
    f32x4 acc[2][2][4][2];
#pragma unroll
    for (int a = 0; a < 2; ++a)
#pragma unroll
        for (int b = 0; b < 2; ++b)
#pragma unroll
            for (int m = 0; m < 4; ++m)
#pragma unroll
                for (int n = 0; n < 2; ++n) acc[a][b][m][n] = (f32x4){0.f, 0.f, 0.f, 0.f};
    bf16x8 At[4][2], B0[2][2], B1[2][2];
    const char* cA = (const char*)g.A + (size_t)cur.pm * tstep; const char* cB = (const char*)g.Bt + (size_t)cur.pn * tstep;
    S.a_ready(cur);
    PG8_STAGE(PG8_SB(0, 0), cB, voffB); PG8_STAGE(PG8_SA(0, 0), cA, voffA); PG8_STAGE(PG8_SB(0, 1), cB + hstep, voffB); PG8_STAGE(PG8_SA(0, 1), cA + hstep, voffA);
    if (wr == 1) PG8_BAR;
    PG8_WAIT_V(4); PG8_BAR;
    PG8_STAGE(PG8_SB(1, 0), cB + kstep, voffB); PG8_STAGE(PG8_SA(1, 0), cA + kstep, voffA); PG8_STAGE(PG8_SB(1, 1), cB + hstep + kstep, voffB);
    PG8_WAIT_V(6); PG8_BAR;
    PG8_STAMP();
    for (;;) {
        const bool has_next = S.next(ui + 1, nxt);
        const char* nA = has_next ? (const char*)g.A + (size_t)nxt.pm * tstep : cA; const char* nB = has_next ? (const char*)g.Bt + (size_t)nxt.pn * tstep : cB;
        for (int t = 0; t < nt; t += 2) {
            const bool last = (t == nt - 2);
            const char* a1 = cA + (size_t)(t + 1) * kstep;
            const char* a2 = last ? nA : cA + (size_t)(t + 2) * kstep; const char* b2 = last ? nB : cB + (size_t)(t + 2) * kstep;
            const char* a3 = a2 + kstep; const char* b3 = b2 + kstep;
            if (last && has_next) S.a_ready(nxt);
            PG8_LDB(B0, 0, 0); PG8_SCHED; PG8_LDA(At, 0, 0); PG8_STAGE(PG8_SA(1, 1), a1 + hstep, voffA);
            PG8_WAIT_L(8); PG8_BAR; PG8_WAIT_L(0); PG8_MMA(0, 0, At, B0); PG8_BAR; PG8_SCHED;
            PG8_LDB(B1, 0, 1); PG8_STAGE(PG8_SB(0, 0), b2, voffB);
            PG8_BAR; PG8_WAIT_L(0); PG8_MMA(0, 1, At, B1); PG8_BAR;
            PG8_LDA(At, 0, 1); PG8_STAGE(PG8_SA(0, 0), a2, voffA);
            PG8_BAR; PG8_WAIT_L(0); PG8_MMA(1, 0, At, B0); PG8_BAR; PG8_SCHED;
            PG8_STAGE(PG8_SB(0, 1), b2 + hstep, voffB);
            PG8_WAIT_V(6); PG8_BAR; PG8_MMA(1, 1, At, B1); PG8_BAR;
            PG8_LDB(B0, 1, 0); PG8_SCHED; PG8_LDA(At, 1, 0); PG8_STAGE(PG8_SA(0, 1), a2 + hstep, voffA);
            PG8_WAIT_L(8); PG8_BAR; PG8_WAIT_L(0); PG8_MMA(0, 0, At, B0); PG8_BAR; PG8_SCHED;
            PG8_LDB(B1, 1, 1); PG8_STAGE(PG8_SB(1, 0), b3, voffB);
            PG8_BAR; PG8_WAIT_L(0); PG8_MMA(0, 1, At, B1); PG8_BAR;
            PG8_LDA(At, 1, 1); PG8_STAGE(PG8_SA(1, 0), a3, voffA);
            PG8_BAR; PG8_WAIT_L(0); PG8_MMA(1, 0, At, B0); PG8_BAR; PG8_SCHED;
            PG8_STAGE(PG8_SB(1, 1), b3 + hstep, voffB);
            PG8_WAIT_V(6); PG8_BAR; PG8_MMA(1, 1, At, B1); PG8_BAR;
        }
        PG8_STAMP();
        if constexpr (!Epi::AFTER_DRAIN) { E(acc, cur, wr, wc, fr, fq); S.done(cur); }
        PG8_STAMP();
        if (!has_next) break;
#pragma unroll
        for (int a = 0; a < 2; ++a)
#pragma unroll
            for (int b = 0; b < 2; ++b)
#pragma unroll
                for (int m = 0; m < 4; ++m)
#pragma unroll
                    for (int n = 0; n < 2; ++n) acc[a][b][m][n] = (f32x4){0.f, 0.f, 0.f, 0.f};
        cur = nxt; cA = nA; cB = nB; ++ui;
    }
    PG8_WAIT_V(0);
    if (wr == 0) PG8_BAR;
    PG8_BAR;
    if constexpr (Epi::AFTER_DRAIN) { E.fused(acc, cur, wr, wc, fr, fq, lds, wid, lane); S.done(cur); }
    PG8_STAMP();
    if (STAMP && wid == 0) { stamps[lane] = lane < nts ? (((unsigned long long)(unsigned)ts_hi << 32) | (unsigned)ts_lo) : 0ull;
        if (lane == 62) stamps[62] = rt_entry; if (lane == 63) stamps[63] = (unsigned long long)wall_clock64(); }
#undef PG8_STAMP
#undef PG8_SA
#undef PG8_SB
#undef PG8_STAGE
#undef PG8_LDA
#undef PG8_LDB
#undef PG8_MMA
#undef PG8_WAIT_V
#undef PG8_WAIT_L
#undef PG8_BAR
#undef PG8_SCHED
}
}

#define XB_TMO      128
#define XB_XCNT(j)  (256  + 64 * (j))
#define XB_XSUB(j)  (1280 + 64 * (j))
#define XB_XGEN(j)  (2304 + 64 * (j))
#define XB_TOP      3328
#define XB_TOPGEN   3392
#define XCD_BAR_WORDS 3456
#define XB_SPIN_CAP (1u << 27)
#define LAS __attribute__((address_space(3)))

__device__ __forceinline__ unsigned xb_ld(unsigned* p)              { return __hip_atomic_load(p, __ATOMIC_RELAXED, __HIP_MEMORY_SCOPE_AGENT); }
__device__ __forceinline__ unsigned xb_add(unsigned* p, unsigned v) { return __hip_atomic_fetch_add(p, v, __ATOMIC_RELAXED, __HIP_MEMORY_SCOPE_AGENT); }
__device__ __forceinline__ unsigned xb_xcc_id() { return (unsigned)__builtin_amdgcn_s_getreg((3 << 11) | 20) & 0xFu; }
#define XB_SPIN(cond, bar) do { unsigned _sp = 0; while (cond) { __builtin_amdgcn_s_sleep(1); \
    if ((++_sp & 255u) == 0u) { if (xb_ld(&(bar)[XB_TMO])) break; if (_sp > XB_SPIN_CAP) { atomicAdd(&(bar)[XB_TMO], 1u); break; } } } } while (0)

struct XcdBarrier {
    unsigned* bar; unsigned x;
    volatile LAS unsigned* st;
};

__device__ __forceinline__ XcdBarrier xcd_barrier_post(unsigned* bar, volatile LAS unsigned* st, bool xb_t0) {
    XcdBarrier b; b.bar = bar; b.x = xb_xcc_id(); b.st = st;
    if (xb_t0) (void)xb_add(&bar[XB_XCNT(b.x)], 1u);
    return b;
}
__device__ __forceinline__ void xcd_barrier_complete(unsigned* bar, unsigned x, unsigned& nloc, unsigned& nx) {
    const unsigned G = gridDim.x * gridDim.y * gridDim.z;
    unsigned sum, cnt, mine, sp = 0u;
    for (;;) {
        sum = 0u; cnt = 0u; mine = 0u;
#pragma unroll
        for (unsigned j = 0; j < 16; ++j) { const unsigned c = xb_ld(&bar[XB_XCNT(j)]); sum += c; cnt += (c > 0u) ? 1u : 0u; mine = (j == x) ? c : mine; }
        if (sum == G) break;
        __builtin_amdgcn_s_sleep(1);
        if ((++sp & 255u) == 0u) { if (xb_ld(&bar[XB_TMO])) break; if (sp > XB_SPIN_CAP) { atomicAdd(&bar[XB_TMO], 1u); break; } }
    }
    nloc = mine > 0u ? mine : 1u; nx = cnt > 0u ? cnt : 1u;
}

__device__ __forceinline__ void xcd_barrier(const XcdBarrier& b, bool xb_t0) {
    asm volatile("s_waitcnt vmcnt(0)" ::: "memory");
    __syncthreads();
    if (xb_t0) {
        unsigned* bar = b.bar;
        __builtin_amdgcn_s_waitcnt(0);
        unsigned nloc = b.st[0], nx = b.st[1];
        if (nloc == 0u) { xcd_barrier_complete(bar, b.x, nloc, nx); b.st[0] = nloc; b.st[1] = nx; }
        const unsigned old = xb_add(&bar[XB_XSUB(b.x)], 1u);
        const unsigned gen = old / nloc;
        if (old + 1u == (gen + 1u) * nloc) {
            __builtin_amdgcn_fence(__ATOMIC_RELEASE, "agent");
            asm volatile("s_waitcnt vmcnt(0)" ::: "memory");
            const unsigned og = xb_add(&bar[XB_TOP], 1u);
            const unsigned tg = og / nx;
            if (og + 1u == (tg + 1u) * nx) xb_add(&bar[XB_TOPGEN], 1u);
            else XB_SPIN(xb_ld(&bar[XB_TOPGEN]) == tg, bar);
            __builtin_amdgcn_fence(__ATOMIC_ACQUIRE, "agent");
            xb_add(&bar[XB_XGEN(b.x)], 1u);
            asm volatile("s_waitcnt vmcnt(0)" ::: "memory");
        } else {
            XB_SPIN(xb_ld(&bar[XB_XGEN(b.x)]) == gen, bar);
            __builtin_amdgcn_fence(__ATOMIC_ACQUIRE, "agent");
            asm volatile("s_waitcnt vmcnt(0)" ::: "memory");
        }
    }
    __syncthreads();
}


__device__ void ph_transpose(int wv, const float* __restrict__ src, bf16_t* __restrict__ dst, int K, int N, int Npad,
                             int col0, int skip_from, int skip, int nvalid, float* tile0, int bid, int nb) {
  const int tk = K / 32, tn = Npad / 32;
  const int tid = otid(wv), half = tid >> 8, t5 = tid & 255;
  const int tx = t5 & 31, ty = t5 >> 5;
  float* tile = tile0 + half * (32 * 33);
  for (int tb = bid * 2; tb < tk * tn; tb += nb * 2) {
    const int t = tb + half;
    const bool act = t < tk * tn;
    const int kt = t / tn, nt = t % tn;
    __syncthreads();
    if (act)
      for (int i = ty; i < 32; i += 8) {
        const int k = kt * 32 + i, n = nt * 32 + tx;
        const int cc = col0 + n + (n >= skip_from ? skip : 0);
        tile[i * 33 + tx] = (n < nvalid) ? src[(size_t)k * N + cc] : 0.f;
      }
    __syncthreads();
    if (act)
      for (int i = ty; i < 32; i += 8) {
        const int n = nt * 32 + i, k = kt * 32 + tx;
        dst[(size_t)n * K + k] = f2bf(tile[tx * 33 + i]);
      }
  }
}

__device__ void ph_mod(int wv, const Params& P, float* sm, int bid, int nb) {
  const int tid = otid(wv);
  float* sv = sm;
  float* red = sm + 5 * 1024;
  for (int i = tid; i < 5 * 1024; i += NTHR) {
    const float v = (i < 4096) ? P.c[i] : P.c_ctx[i - 4096];
    sv[i] = silu_f(v);
  }
  __syncthreads();
  const int c4 = tid & 15, kg = tid >> 4;
  for (int it = bid; it < 192; it += nb) {
    const int layer = it / 96, cb = it % 96;
    const float4* W = (const float4*)(P.ada_w + (size_t)layer * 1024 * MODW + cb * 64) + c4;
    float4 a[5];
#pragma unroll
    for (int r = 0; r < 5; ++r) a[r] = make_float4(0.f, 0.f, 0.f, 0.f);
#pragma unroll 8
    for (int kk = 0; kk < 32; ++kk) {
      const int k = kg * 32 + kk;
      const float4 w = W[(size_t)k * (MODW / 4)];
#pragma unroll
      for (int r = 0; r < 5; ++r) {
        const float s = sv[r * 1024 + k];
        a[r].x += s * w.x; a[r].y += s * w.y; a[r].z += s * w.z; a[r].w += s * w.w;
      }
    }
#pragma unroll
    for (int r = 0; r < 5; ++r) *(float4*)(red + ((kg * 16 + c4) * 5 + r) * 4) = a[r];
    __syncthreads();
    if (tid < 320) {
      const int r = tid >> 6, c = tid & 63;
      float s = 0.f;
      for (int g = 0; g < 32; ++g) s += red[((g * 16 + (c >> 2)) * 5 + r) * 4 + (c & 3)];
      P.mod()[(size_t)(layer * 5 + r) * MODW + cb * 64 + c] = s + P.ada_b[layer * MODW + cb * 64 + c];
    }
    __syncthreads();
  }
}

__device__ void ph_norm(int wv, const float* hl, const float* hc, const float* __restrict__ g, const float* __restrict__ modl,
                        int shift_off, int scale_off, int nrows, bf16_t* __restrict__ dst, int bid, int nb) {
  const int wave = otid(wv) >> 6, lane = otid(wv) & 63;
  for (int row = bid * NWAVE + wave; row < nrows; row += nb * NWAVE) {
    const float* src = hrow(hl, hc, row);
    const float* mr = modl + (size_t)modrow(row) * MODW;
    float4 v[4];
    float ss = 0.f;
#pragma unroll
    for (int i = 0; i < 4; ++i) {
      v[i] = ((const float4*)src)[i * 64 + lane];
      ss += v[i].x * v[i].x + v[i].y * v[i].y + v[i].z * v[i].z + v[i].w * v[i].w;
    }
    ss = wave_sum(ss);
    const float rstd = rsqrtf(ss * (1.f / 1024.f) + 1e-6f);
    f32x4 ggv[4], scv[4], shv[4];
#pragma unroll
    for (int i = 0; i < 4; ++i) {
      const int idx = i * 256 + lane * 4;
      ggv[i] = *(const f32x4*)(g + idx); scv[i] = *(const f32x4*)(mr + scale_off + idx); shv[i] = *(const f32x4*)(mr + shift_off + idx);
    }
#pragma unroll
    for (int i = 0; i < 4; ++i) asm volatile("" : "+v"(ggv[i]), "+v"(scv[i]), "+v"(shv[i]));
#pragma unroll
    for (int i = 0; i < 4; ++i) {
      const int idx = i * 256 + lane * 4;
      const float4 gg = make_float4(ggv[i][0], ggv[i][1], ggv[i][2], ggv[i][3]);
      const float4 sc = make_float4(scv[i][0], scv[i][1], scv[i][2], scv[i][3]);
      const float4 sh = make_float4(shv[i][0], shv[i][1], shv[i][2], shv[i][3]);
      const float o0 = v[i].x * rstd * gg.x * (1.f + sc.x) + sh.x;
      const float o1 = v[i].y * rstd * gg.y * (1.f + sc.y) + sh.y;
      const float o2 = v[i].z * rstd * gg.z * (1.f + sc.z) + sh.z;
      const float o3 = v[i].w * rstd * gg.w * (1.f + sc.w) + sh.w;
      uint2 pk;
      pk.x = (uint32_t)f2bf(o0) | ((uint32_t)f2bf(o1) << 16);
      pk.y = (uint32_t)f2bf(o2) | ((uint32_t)f2bf(o3) << 16);
      *(uint2*)(dst + (size_t)row * DM + idx) = pk;
    }
  }
}

enum { EPI_INPROJ = 0, EPI_OUTPROJ = 1, EPI_Q = 2 };

template <int EPI>
__device__ void ph_gemm(int wv, const Params& P, int layer, const bf16_t* __restrict__ A, const bf16_t* __restrict__ Bt, int M,
                        int Npad, int K, const float* hl, const float* hc, char* smem, int bid, int nb) {
  bf16_t* sA = (bf16_t*)smem;
  bf16_t* sB = sA + 128 * 72;
  const int tid = otid(wv) & 255, lane = tid & 63, wave = tid >> 6;
  const int wr = wave >> 1, wc = wave & 1;
  const int tiles_m = M / 128, tiles_n = Npad / 128;
  const int l15 = lane & 15, l4 = lane >> 4;
  for (int tile = bid; tile < tiles_m * tiles_n; tile += nb) {
    const int tn = tile / tiles_m, tm = tile % tiles_m;
    f32x4 acc[4][4];
#pragma unroll
    for (int i = 0; i < 4; ++i)
#pragma unroll
      for (int j = 0; j < 4; ++j) acc[i][j] = (f32x4){0.f, 0.f, 0.f, 0.f};
    for (int k0 = 0; k0 < K; k0 += 64) {
      __syncthreads();
#pragma unroll
      for (int i = 0; i < 4; ++i) {
        const int idx = i * 256 + tid;
        const int r = idx >> 3, sg = idx & 7;
        const uint4 va = *(const uint4*)(A + (size_t)(tm * 128 + r) * K + k0 + sg * 8);
        *(uint4*)(sA + r * 72 + sg * 8) = va;
        const uint4 vb = *(const uint4*)(Bt + (size_t)(tn * 128 + r) * K + k0 + sg * 8);
        *(uint4*)(sB + r * 72 + sg * 8) = vb;
      }
      __syncthreads();
#pragma unroll
      for (int kk = 0; kk < 2; ++kk) {
        bf16x8 af[4], bfr[4];
#pragma unroll
        for (int i = 0; i < 4; ++i) af[i] = *(const bf16x8*)(sA + (wr * 64 + i * 16 + l15) * 72 + kk * 32 + l4 * 8);
#pragma unroll
        for (int j = 0; j < 4; ++j) bfr[j] = *(const bf16x8*)(sB + (wc * 64 + j * 16 + l15) * 72 + kk * 32 + l4 * 8);
#pragma unroll
        for (int i = 0; i < 4; ++i)
#pragma unroll
          for (int j = 0; j < 4; ++j) acc[i][j] = __builtin_amdgcn_mfma_f32_16x16x32_bf16(af[i], bfr[j], acc[i][j], 0, 0, 0);
      }
    }
#pragma unroll
    for (int i = 0; i < 4; ++i)
#pragma unroll
      for (int j = 0; j < 4; ++j)
#pragma unroll
        for (int e = 0; e < 4; ++e) {
          const int row = tm * 128 + wr * 64 + i * 16 + l4 * 4 + e;
          const int col = tn * 128 + wc * 64 + j * 16 + l15;
          const float v = acc[i][j][e];
          if (EPI == EPI_INPROJ) {
            if (col < 32) P.dtraw()[(size_t)row * 32 + col] = v;
          } else if (EPI == EPI_OUTPROJ) {
            const float* src = hrow(hl, hc, row);
            const float gate = P.mod()[(size_t)(layer * 5 + modrow(row)) * MODW + 2048 + col];
            P.h()[(size_t)row * DM + col] = src[col] + gate * v;
          } else {
            P.q()[(size_t)row * 2048 + col] = f2bf(v);
          }
        }
  }
}

__device__ void ph_conv(int wv, const Params& P, int layer, int bid, int nb) {
  const float* cw = P.conv_w + (size_t)layer * 3 * 1536;
  const float* cb = P.conv_b + (size_t)layer * 1536;
  const int total = NTOK * 64;
  for (int it = bid * NTHR + otid(wv); it < total; it += nb * NTHR) {
    const int row = it >> 6, c8 = 1024 + (it & 63) * 8;
    int l, L;
    if (row < NLAT) { l = row & 4095; L = 4096; } else { l = (row - NLAT) & 255; L = 256; }
    const bf16_t* pc = P.p() + (size_t)row * PW + OFF_XBC + c8;
    const uint4 cur = *(const uint4*)pc;
    uint4 prv = *(const uint4*)(pc - (l > 0 ? PW : 0));
    uint4 nxt = *(const uint4*)(pc + (l < L - 1 ? PW : 0));
    if (l == 0) prv = make_uint4(0, 0, 0, 0);
    if (l == L - 1) nxt = make_uint4(0, 0, 0, 0);
    const bf16_t* c_ = (const bf16_t*)&cur;
    const bf16_t* p_ = (const bf16_t*)&prv;
    const bf16_t* n_ = (const bf16_t*)&nxt;
    uint4 o;
    bf16_t* o_ = (bf16_t*)&o;
#pragma unroll
    for (int e = 0; e < 8; ++e) {
      const int c = c8 + e;
      const float v = cb[c] + cw[c] * bf2f(p_[e]) + cw[1536 + c] * bf2f(c_[e]) + cw[3072 + c] * bf2f(n_[e]);
      o_[e] = f2bf(silu_f(v));
    }
    *(uint4*)(P.xbc() + (size_t)row * 512 + c8 - 1024) = o;
  }
}

__device__ void ph_ssdprep(int wv, const Params& P, int layer, char* smem, int bid, int nb) {
  const int tid = otid(wv), dh = tid & 31, seg = tid >> 5;
  float* segtot = (float*)smem;
  const float bias = P.dt_bias[layer * 32 + dh];
  const float ah = -expf(P.a_log[layer * 32 + dh]);
  for (int gc = bid; gc < NCHUNK; gc += nb) {
    const size_t base = (size_t)(gc * 128 + seg * 8) * 32 + dh;
    float r[8], c[8];
#pragma unroll
    for (int j = 0; j < 8; ++j) r[j] = P.dtraw()[base + (size_t)j * 32];
    float cs = 0.f;
#pragma unroll
    for (int j = 0; j < 8; ++j) { r[j] = softplus_f(r[j] + bias); cs += r[j] * ah; c[j] = cs; }
    __syncthreads();
    segtot[seg * 32 + dh] = cs;
    __syncthreads();
    float off = 0.f;
    for (int s = 0; s < seg; ++s) off += segtot[s * 32 + dh];
#pragma unroll
    for (int j = 0; j < 8; ++j) { P.dtv()[base + (size_t)j * 32] = r[j]; P.csv()[base + (size_t)j * 32] = off + c[j]; }
  }
}

__device__ void ph_states(int wv, const Params& P, char* smem, int bid, int nb) {
  float* wx = (float*)smem;
  bf16_t* Bm = (bf16_t*)(smem + 128 * 64 * 4);
  const int tid = otid(wv);
  const int n = tid & 127, pg = (tid >> 7) & 1;
  for (int it = bid; it < NCHUNK * 32; it += nb) {
    const int gc = it >> 5, dh = it & 31, dir = dh >> 4, head = dh & 15, g = head >> 3;
    const int row0 = gc * 128;
    __syncthreads();
    const float at = P.csv()[(size_t)(row0 + 127) * 32 + dh];
    for (int i = tid; i < 128 * 64; i += NTHR) {
      const int j = i >> 6, pp = i & 63, row = row0 + j;
      const float cs = P.csv()[(size_t)row * 32 + dh], dt = P.dtv()[(size_t)row * 32 + dh];
      float w;
      if (dir == 0) w = expf(at - cs);
      else w = expf(j > 0 ? P.csv()[(size_t)(row - 1) * 32 + dh] : 0.f);
      wx[i] = bf2f(P.xbc()[(size_t)row * 1536 + head * 64 + pp]) * dt * w;
    }
    for (int i = tid; i < 128 * 128; i += NTHR) {
      const int j = i >> 7, nn = i & 127;
      Bm[i] = P.xbc()[(size_t)(row0 + j) * 1536 + 1024 + g * 128 + nn];
    }
    __syncthreads();
    float acc[32];
#pragma unroll
    for (int i = 0; i < 32; ++i) acc[i] = 0.f;
    for (int j = 0; j < 128; ++j) {
      const float b = bf2f(Bm[j * 128 + n]);
#pragma unroll
      for (int i = 0; i < 32; ++i) acc[i] += wx[j * 64 + pg * 32 + i] * b;
    }
    bf16_t* dst = P.states() + (size_t)it * 8192;
#pragma unroll
    for (int i = 0; i < 32; ++i) dst[(pg * 32 + i) * 128 + n] = f2bf(acc[i]);
  }
}

__device__ __forceinline__ int scan_chunk(int b, int dir, int s) {
  if (dir == 0) return (s < 2) ? (128 + 2 * b + s) : (32 * b + (s - 2));
  return (s < 2) ? (128 + 2 * b + 1 - s) : (32 * b + 31 - (s - 2));
}
__device__ void ph_scan(int wv, const Params& P, int bid, int nb) {
  const int total = 4 * 32 * 1024;
  for (int it = bid * NTHR + otid(wv); it < total; it += nb * NTHR) {
    const int e8 = it & 1023, dh = (it >> 10) & 31, b = it >> 15, dir = dh >> 4;
    float S[8];
#pragma unroll
    for (int i = 0; i < 8; ++i) S[i] = 0.f;
#pragma unroll
    for (int hb = 0; hb < 2; ++hb) {
      u32x4_t v[17];
      float at[17];
#pragma unroll
      for (int s = 0; s < 17; ++s) {
        const int gc = scan_chunk(b, dir, hb * 17 + s);
        v[s] = *(const u32x4_t*)(P.states() + (size_t)(gc * 32 + dh) * 8192 + e8 * 8);
        at[s] = P.csv()[(size_t)(gc * 128 + 127) * 32 + dh];
      }
#pragma unroll
      for (int s = 0; s < 17; ++s) asm volatile("" : "+v"(v[s]));
#pragma unroll
      for (int s = 0; s < 17; ++s) {
        const int gc = scan_chunk(b, dir, hb * 17 + s);
        const float dec = expf(at[s]);
        float cst[8];
        unpack8(make_uint4(v[s].x, v[s].y, v[s].z, v[s].w), cst);
        *(uint4*)(P.states() + (size_t)(gc * 32 + dh) * 8192 + e8 * 8) =
            make_uint4(pack2(S[0], S[1]), pack2(S[2], S[3]), pack2(S[4], S[5]), pack2(S[6], S[7]));
#pragma unroll
        for (int i = 0; i < 8; ++i) S[i] = dec * S[i] + cst[i];
      }
    }
  }
}

__device__ void ph_ssdy(int wv, const Params& P, int layer, int nchunks, char* smem, int bid, int nb) {
  bf16_t* Cm = (bf16_t*)smem;
  bf16_t* Gm = Cm + 128 * 130;
  char* R = (char*)(Gm + 128 * 130);
  bf16_t* Bm = (bf16_t*)R;
  float* xd = (float*)R;
  bf16_t* Sm = (bf16_t*)(R + 128 * 130 * 2);
  float* csl = (float*)(Sm + 64 * 130);
  float* exl = csl + 128;
  const int tid = otid(wv);
  for (int it = bid; it < nchunks * 16; it += nb) {
    const int gc = it >> 4, head = it & 15, g = head >> 3;
    const int row0 = gc * 128;
    __syncthreads();
    for (int i = tid; i < 128 * 128; i += NTHR) {
      const int j = i >> 7, nn = i & 127;
      const bf16_t* xr = P.xbc() + (size_t)(row0 + j) * 1536 + 1024 + g * 128 + nn;
      Bm[j * 130 + nn] = xr[0];
      Cm[j * 130 + nn] = xr[256];
    }
    __syncthreads();
    {
      const int s = tid & 127, jh = (tid >> 7) & 1;
      for (int jb = 0; jb < 2; ++jb) {
        float acc[32];
#pragma unroll
        for (int i = 0; i < 32; ++i) acc[i] = 0.f;
        for (int nn = 0; nn < 128; ++nn) {
          const float b = bf2f(Bm[s * 130 + nn]);
#pragma unroll
          for (int i = 0; i < 32; ++i) acc[i] += bf2f(Cm[(jh * 64 + jb * 32 + i) * 130 + nn]) * b;
        }
#pragma unroll
        for (int i = 0; i < 32; ++i) Gm[(jh * 64 + jb * 32 + i) * 130 + s] = f2bf(acc[i]);
      }
    }
    const int pp = tid & 63, jg0 = (tid >> 6) & 3;
#pragma unroll 1
    for (int jpass = 0; jpass < 2; ++jpass) {
    const int jg = jg0 * 2 + jpass;
    float yacc[16];
#pragma unroll
    for (int i = 0; i < 16; ++i) yacc[i] = 0.f;
#pragma unroll 1
    for (int dir = 0; dir < 2; ++dir) {
      const int dh = dir * 16 + head;
      __syncthreads();
      for (int i = tid; i < 128 * 64; i += NTHR) {
        const int j = i >> 6, p2 = i & 63, row = row0 + j;
        xd[i] = bf2f(P.xbc()[(size_t)row * 1536 + head * 64 + p2]) * P.dtv()[(size_t)row * 32 + dh];
      }
      const bf16_t* st = P.states() + (size_t)(gc * 32 + dh) * 8192;
      for (int i = tid; i < 64 * 128; i += NTHR) Sm[(i >> 7) * 130 + (i & 127)] = st[i];
      if (tid < 128) {
        const float cs = P.csv()[(size_t)(row0 + tid) * 32 + dh];
        csl[tid] = cs;
        exl[tid] = tid > 0 ? P.csv()[(size_t)(row0 + tid - 1) * 32 + dh] : 0.f;
      }
      __syncthreads();
      const float atot = csl[127];
      for (int s = 0; s < 128; ++s) {
        const float xv = xd[s * 64 + pp];
        const float cs_s = csl[s], ex_s = exl[s];
#pragma unroll
        for (int i = 0; i < 16; ++i) {
          const int j = jg * 16 + i;
          if (dir == 0) {
            if (s <= j) yacc[i] += bf2f(Gm[j * 130 + s]) * expf(csl[j] - cs_s) * xv;
          } else {
            if (s >= j) yacc[i] += bf2f(Gm[j * 130 + s]) * expf(ex_s - exl[j]) * xv;
          }
        }
      }
      float offacc[16];
#pragma unroll
      for (int i = 0; i < 16; ++i) offacc[i] = 0.f;
      for (int nn = 0; nn < 128; ++nn) {
        const float sv = bf2f(Sm[pp * 130 + nn]);
#pragma unroll
        for (int i = 0; i < 16; ++i) offacc[i] += bf2f(Cm[(jg * 16 + i) * 130 + nn]) * sv;
      }
#pragma unroll
      for (int i = 0; i < 16; ++i) {
        const int j = jg * 16 + i;
        const float sc = dir == 0 ? expf(csl[j]) : expf(atot - exl[j]);
        yacc[i] += offacc[i] * sc;
      }
    }
    const float dsk = P.d_skip[layer * 16 + head];
#pragma unroll
    for (int i = 0; i < 16; ++i) {
      const int row = row0 + jg * 16 + i;
      const float xs = bf2f(P.xbc()[(size_t)row * 1536 + head * 64 + pp]);
      const float z = bf2f(P.p()[(size_t)row * PW + OFF_Z + head * 64 + pp]);
      const float y = (yacc[i] + dsk * xs) * silu_f(z);
      P.concat()[(size_t)row * 2048 + head * 64 + pp] = f2bf(y);
    }
    }
  }
}


__device__ __forceinline__ void conv_x8(const Params& P, int layer, int row, int ch0, float* out) {
  int l, L;
  if (row < NLAT) { l = row & 4095; L = 4096; } else { l = (row - NLAT) & 255; L = 256; }
  const bf16_t* pc = P.p() + (size_t)row * PW + OFF_XBC + ch0;
  const uint4 cur = *(const uint4*)pc;
  const uint4 prv = *(const uint4*)(pc - (l > 0 ? PW : 0));
  const uint4 nxt = *(const uint4*)(pc + (l < L - 1 ? PW : 0));
  const float mp = l > 0 ? 1.f : 0.f, mn = l < L - 1 ? 1.f : 0.f;
  float fp[8], fc[8], fn[8];
  unpack8(prv, fp); unpack8(cur, fc); unpack8(nxt, fn);
  const float* cw = P.conv_w + (size_t)layer * 3 * 1536 + ch0;
  const float* cb = P.conv_b + (size_t)layer * 1536 + ch0;
#pragma unroll
  for (int e = 0; e < 8; ++e) out[e] = silu_f(cb[e] + cw[e] * (mp * fp[e]) + cw[1536 + e] * fc[e] + cw[3072 + e] * (mn * fn[e]));
}

constexpr int XS = 72;
constexpr int BS = 136;

__device__ void ph_states_mfma(int wv, const Params& P, int layer, char* smem, int bid, int nb) {
  char* XW = smem;
  char* Bm = smem + 2 * 128 * XS * 2;
  const int tid = otid(wv), lane = tid & 63, li = lane & 15, g = lane >> 4;
  const int dir = wv >> 2, pb = wv & 3;
  for (int it = bid; it < NCHUNK * 16; it += nb) {
    const int gc = it >> 4, head = it & 15, grp = head >> 3;
    const int row0 = gc * 128;
    __syncthreads();
#pragma unroll
    for (int i = 0; i < 2; ++i) {
      const int idx = tid + i * 512, j = idx >> 3, seg = idx & 7, row = row0 + j;
      float xv[8];
      conv_x8(P, layer, row, head * 64 + seg * 8, xv);
      const float* cs = P.csv() + (size_t)row * 32;
      const float* dt = P.dtv() + (size_t)row * 32;
      const float at_f = P.csv()[(size_t)(row0 + 127) * 32 + head];
      const float wf = expf(at_f - cs[head]) * dt[head];
      const float wb = expf(j > 0 ? cs[16 + head - 32] : 0.f) * dt[16 + head];
      uint4 of, ob;
      of.x = pack2(xv[0] * wf, xv[1] * wf); of.y = pack2(xv[2] * wf, xv[3] * wf); of.z = pack2(xv[4] * wf, xv[5] * wf); of.w = pack2(xv[6] * wf, xv[7] * wf);
      ob.x = pack2(xv[0] * wb, xv[1] * wb); ob.y = pack2(xv[2] * wb, xv[3] * wb); ob.z = pack2(xv[4] * wb, xv[5] * wb); ob.w = pack2(xv[6] * wb, xv[7] * wb);
      *(uint4*)(XW + (j * XS + seg * 8) * 2) = of;
      *(uint4*)(XW + ((128 + j) * XS + seg * 8) * 2) = ob;
    }
    {
      u32x4_t tb[4];
#pragma unroll
      for (int i = 0; i < 4; ++i) {
        const int idx = tid + i * 512, j = idx >> 4, seg = idx & 15;
        tb[i] = *(const u32x4_t*)(P.xbc() + (size_t)(row0 + j) * 512 + grp * 128 + seg * 8);
      }
#pragma unroll
      for (int i = 0; i < 4; ++i) asm volatile("" : "+v"(tb[i]));
#pragma unroll
      for (int i = 0; i < 4; ++i) {
        const int idx = tid + i * 512, j = idx >> 4, seg = idx & 15;
        *(u32x4_t*)(Bm + (j * BS + seg * 8) * 2) = tb[i];
      }
    }
    __syncthreads();
    f32x4 acc[8];
#pragma unroll
    for (int n = 0; n < 8; ++n) acc[n] = (f32x4){0.f, 0.f, 0.f, 0.f};
    const char* xbase = XW + ((dir * 128 + (li >> 2)) * XS + pb * 16 + 4 * (li & 3)) * 2;
    const char* bbase = Bm + ((li >> 2) * BS + 4 * (li & 3)) * 2;
#pragma unroll
    for (int t = 0; t < 4; ++t) {
      const int R = 32 * t + 8 * g;
      const bf16x8 bfrag = tr_read2(xbase + R * XS * 2, xbase + (R + 4) * XS * 2);
#pragma unroll
      for (int n = 0; n < 8; ++n) {
        const bf16x8 afrag = tr_read2(bbase + (R * BS + n * 16) * 2, bbase + ((R + 4) * BS + n * 16) * 2);
        acc[n] = __builtin_amdgcn_mfma_f32_16x16x32_bf16(afrag, bfrag, acc[n], 0, 0, 0);
      }
    }
    bf16_t* dst = P.states() + (size_t)(gc * 32 + dir * 16 + head) * 8192 + (pb * 16 + li) * 128;
#pragma unroll
    for (int n = 0; n < 8; ++n) {
      uint2 o;
      o.x = pack2(acc[n][0], acc[n][1]); o.y = pack2(acc[n][2], acc[n][3]);
      *(uint2*)(dst + n * 16 + 4 * g) = o;
    }
  }
}

__device__ void ph_ssdy_mfma(int wv, const Params& P, int layer, int nchunks, char* smem, int bid, int nb) {
  char* Bm = smem;
  char* Cm = Bm + 128 * BS * 2;
  char* X0 = Cm + 128 * BS * 2;
  char* XD = X0 + 128 * XS * 2;
  float* csf = (float*)(XD + 2 * 128 * XS * 2);
  float* exb = csf + 128;
  const int tid = otid(wv), lane = tid & 63, li = lane & 15, g = lane >> 4;
  for (int it = bid; it < nchunks * 16; it += nb) {
    const int gc = it >> 4, head = it & 15, grp = head >> 3;
    const int row0 = gc * 128;
    __syncthreads();
#pragma unroll
    for (int i = 0; i < 2; ++i) {
      const int idx = tid + i * 512, j = idx >> 3, seg = idx & 7, row = row0 + j;
      float xv[8];
      conv_x8(P, layer, row, head * 64 + seg * 8, xv);
      const float df = P.dtv()[(size_t)row * 32 + head], db = P.dtv()[(size_t)row * 32 + 16 + head];
      uint4 o0, of, ob;
      o0.x = pack2(xv[0], xv[1]); o0.y = pack2(xv[2], xv[3]); o0.z = pack2(xv[4], xv[5]); o0.w = pack2(xv[6], xv[7]);
      of.x = pack2(xv[0] * df, xv[1] * df); of.y = pack2(xv[2] * df, xv[3] * df); of.z = pack2(xv[4] * df, xv[5] * df); of.w = pack2(xv[6] * df, xv[7] * df);
      ob.x = pack2(xv[0] * db, xv[1] * db); ob.y = pack2(xv[2] * db, xv[3] * db); ob.z = pack2(xv[4] * db, xv[5] * db); ob.w = pack2(xv[6] * db, xv[7] * db);
      *(uint4*)(X0 + (j * XS + seg * 8) * 2) = o0;
      *(uint4*)(XD + (j * XS + seg * 8) * 2) = of;
      *(uint4*)(XD + ((128 + j) * XS + seg * 8) * 2) = ob;
    }
    {
      u32x4_t tb[4], tc[4];
#pragma unroll
      for (int i = 0; i < 4; ++i) {
        const int idx = tid + i * 512, j = idx >> 4, seg = idx & 15;
        const bf16_t* s = P.xbc() + (size_t)(row0 + j) * 512 + grp * 128 + seg * 8;
        tb[i] = *(const u32x4_t*)s; tc[i] = *(const u32x4_t*)(s + 256);
      }
#pragma unroll
      for (int i = 0; i < 4; ++i) asm volatile("" : "+v"(tb[i]), "+v"(tc[i]));
#pragma unroll
      for (int i = 0; i < 4; ++i) {
        const int idx = tid + i * 512, j = idx >> 4, seg = idx & 15;
        *(u32x4_t*)(Bm + (j * BS + seg * 8) * 2) = tb[i];
        *(u32x4_t*)(Cm + (j * BS + seg * 8) * 2) = tc[i];
      }
    }
    if (tid < 128) {
      csf[tid] = P.csv()[(size_t)(row0 + tid) * 32 + head];
      exb[tid] = tid > 0 ? P.csv()[(size_t)(row0 + tid - 1) * 32 + 16 + head] : 0.f;
    }
    __syncthreads();
    const float atb = P.csv()[(size_t)(row0 + 127) * 32 + 16 + head];
    f32x4 accG[8];
#pragma unroll
    for (int sb = 0; sb < 8; ++sb) accG[sb] = (f32x4){0.f, 0.f, 0.f, 0.f};
#pragma unroll
    for (int t = 0; t < 4; ++t) {
      const bf16x8 cfrag = *(const bf16x8*)(Cm + ((16 * wv + li) * BS + 32 * t + 8 * g) * 2);
#pragma unroll
      for (int sb = 0; sb < 8; ++sb) {
        const bf16x8 bfr = *(const bf16x8*)(Bm + ((16 * sb + li) * BS + 32 * t + 8 * g) * 2);
        accG[sb] = __builtin_amdgcn_mfma_f32_16x16x32_bf16(bfr, cfrag, accG[sb], 0, 0, 0);
      }
    }
    f32x4 accY[4];
#pragma unroll
    for (int pb = 0; pb < 4; ++pb) accY[pb] = (f32x4){0.f, 0.f, 0.f, 0.f};
    const int jl = 16 * wv + li;
    const float csf_j = csf[jl], exb_j = exb[jl];
#pragma unroll
    for (int dir = 0; dir < 2; ++dir) {
      f32x4 accO[4];
#pragma unroll
      for (int pb = 0; pb < 4; ++pb) accO[pb] = (f32x4){0.f, 0.f, 0.f, 0.f};
      const bf16_t* st = P.states() + (size_t)(gc * 32 + dir * 16 + head) * 8192;
#pragma unroll
      for (int th = 0; th < 2; ++th) {
        bf16x8 sfr[8];
#pragma unroll
        for (int i = 0; i < 8; ++i) sfr[i] = *(const bf16x8*)(st + (16 * (i & 3) + li) * 128 + 32 * (th * 2 + (i >> 2)) + 8 * g);
#pragma unroll
        for (int i = 0; i < 8; ++i) asm volatile("" : "+v"(sfr[i]));
#pragma unroll
        for (int tt = 0; tt < 2; ++tt) {
          const int t = th * 2 + tt;
          const bf16x8 cfrag = *(const bf16x8*)(Cm + ((16 * wv + li) * BS + 32 * t + 8 * g) * 2);
#pragma unroll
          for (int pb = 0; pb < 4; ++pb) accO[pb] = __builtin_amdgcn_mfma_f32_16x16x32_bf16(cfrag, sfr[tt * 4 + pb], accO[pb], 0, 0, 0);
        }
      }
#pragma unroll
      for (int e = 0; e < 4; ++e) {
        const int j = 16 * wv + 4 * g + e;
        const float sc = dir == 0 ? expf(csf[j]) : expf(atb - exb[j]);
#pragma unroll
        for (int pb = 0; pb < 4; ++pb) accY[pb][e] += accO[pb][e] * sc;
      }
#pragma unroll
      for (int t = 0; t < 4; ++t) {
        const bool skip = dir == 0 ? (32 * t > 16 * wv + 15) : (32 * t + 31 < 16 * wv);
        if (skip) continue;
        bf16x8 afrag;
#pragma unroll
        for (int hh = 0; hh < 2; ++hh) {
          const int s0 = 32 * t + 16 * hh + 4 * g;
          const f32x4 gv = accG[2 * t + hh];
          const f32x4 cv = dir == 0 ? *(const f32x4*)(csf + s0) : *(const f32x4*)(exb + s0);
#pragma unroll
          for (int e = 0; e < 4; ++e) {
            const int s = s0 + e;
            float m;
            if (dir == 0) m = (s <= jl) ? gv[e] * expf(csf_j - cv[e]) : 0.f;
            else m = (s >= jl) ? gv[e] * expf(cv[e] - exb_j) : 0.f;
            afrag[hh * 4 + e] = (short)f2bf(m);
          }
        }
        const char* xb = XD + ((dir * 128 + 32 * t + 4 * g + (li >> 2)) * XS + 4 * (li & 3)) * 2;
#pragma unroll
        for (int pb = 0; pb < 4; ++pb) {
          const bf16x8 bfr = tr_read2(xb + pb * 32, xb + 16 * XS * 2 + pb * 32);
          accY[pb] = __builtin_amdgcn_mfma_f32_16x16x32_bf16(afrag, bfr, accY[pb], 0, 0, 0);
        }
      }
    }
    const float dsk = P.d_skip[layer * 16 + head];
    unsigned zv[16];
#pragma unroll
    for (int e = 0; e < 4; ++e)
#pragma unroll
      for (int pb = 0; pb < 4; ++pb)
        zv[e * 4 + pb] = P.p()[(size_t)(row0 + 16 * wv + 4 * g + e) * PW + OFF_Z + head * 64 + 16 * pb + li];
#pragma unroll
    for (int i = 0; i < 16; ++i) asm volatile("" : "+v"(zv[i]));
#pragma unroll
    for (int e = 0; e < 4; ++e) {
      const int j = 16 * wv + 4 * g + e, row = row0 + j;
#pragma unroll
      for (int pb = 0; pb < 4; ++pb) {
        const int pp = 16 * pb + li;
        const float xs = bf2f(*(const bf16_t*)(X0 + (j * XS + pp) * 2));
        const float z = bf2f((bf16_t)zv[e * 4 + pb]);
        P.concat()[(size_t)row * 2048 + head * 64 + pp] = f2bf((accY[pb][e] + dsk * xs) * silu_f(z));
      }
    }
  }
}

__device__ void ph_ssdnorm(int wv, const Params& P, int layer, int nrows, int bid, int nb) {
  const int wave = otid(wv) >> 6, lane = otid(wv) & 63;
  const float* g = P.ssd_norm_g + layer * 1024;
  for (int row = bid * NWAVE + wave; row < nrows; row += nb * NWAVE) {
    bf16_t* src = P.concat() + (size_t)row * 2048;
    float v[16];
    float ss = 0.f;
#pragma unroll
    for (int i = 0; i < 4; ++i) {
      const uint2 pk = *(const uint2*)(src + i * 256 + lane * 4);
      v[i * 4 + 0] = bf2f((bf16_t)(pk.x & 0xffff)); v[i * 4 + 1] = bf2f((bf16_t)(pk.x >> 16));
      v[i * 4 + 2] = bf2f((bf16_t)(pk.y & 0xffff)); v[i * 4 + 3] = bf2f((bf16_t)(pk.y >> 16));
    }
#pragma unroll
    for (int i = 0; i < 16; ++i) ss += v[i] * v[i];
    ss = wave_sum(ss);
    const float rstd = rsqrtf(ss * (1.f / 1024.f) + 1e-6f);
    f32x4 gv[4];
#pragma unroll
    for (int i = 0; i < 4; ++i) gv[i] = *(const f32x4*)(g + i * 256 + lane * 4);
#pragma unroll
    for (int i = 0; i < 4; ++i) asm volatile("" : "+v"(gv[i]));
#pragma unroll
    for (int i = 0; i < 4; ++i) {
      const int idx = i * 256 + lane * 4;
      uint2 pk;
      pk.x = (uint32_t)f2bf(v[i * 4 + 0] * rstd * gv[i][0]) | ((uint32_t)f2bf(v[i * 4 + 1] * rstd * gv[i][1]) << 16);
      pk.y = (uint32_t)f2bf(v[i * 4 + 2] * rstd * gv[i][2]) | ((uint32_t)f2bf(v[i * 4 + 3] * rstd * gv[i][3]) << 16);
      *(uint2*)(src + idx) = pk;
    }
  }
}

__device__ void ph_pool(int wv, const Params& P, int layer, int nrows, char* smem, int bid, int nb) {
  float* pooled = (float*)smem;
  const int tid = otid(wv);
  const int ntile = nrows / 32;
  for (int it = bid; it < ntile * 4; it += nb) {
    const int tt = it >> 2, gi = it & 3;
    const int w = 2 << gi;
    const int row0 = tt * 32;
    __syncthreads();
    for (int i = tid; i < 32 * 128; i += NTHR) {
      const int t = i >> 7, ch = i & 127, row = row0 + t;
      int l, L, base;
      if (row < NLAT) { l = row & 4095; L = 4096; base = row - l; } else { l = (row - NLAT) & 255; L = 256; base = row - l; }
      int lo = l - w / 2; lo = lo < 0 ? 0 : lo;
      int hi = l + w - w / 2 - 1; hi = hi > L - 1 ? L - 1 : hi;
      float s = 0.f;
      for (int r = lo; r <= hi; ++r) s += bf2f(P.p()[(size_t)(base + r) * PW + OFF_POOL + gi * 128 + ch]);
      pooled[i] = s / (float)(hi - lo + 1) - bf2f(P.p()[(size_t)row * PW + OFF_POOL + gi * 128 + ch]);
    }
    __syncthreads();
    const int o = tid & 127, tg = (tid >> 7) & 1;
    const float* W = P.pool_w + ((size_t)(layer * 4 + gi) * 128) * 128 + o;
    float acc[16];
#pragma unroll
    for (int i = 0; i < 16; ++i) acc[i] = 0.f;
    for (int k = 0; k < 128; ++k) {
      const float wv = W[(size_t)k * 128];
#pragma unroll
      for (int i = 0; i < 16; ++i) acc[i] += pooled[(tg * 16 + i) * 128 + k] * wv;
    }
    const float sc = P.pool_scale[layer * 512 + gi * 128 + o];
#pragma unroll
    for (int i = 0; i < 16; ++i)
      P.concat()[(size_t)(row0 + tg * 16 + i) * 2048 + 1024 + gi * 128 + o] = f2bf(acc[i] * sc);
  }
}

__device__ void ph_na(int wv, const Params& P, int layer, int nrows, char* smem, int bid, int nb) {
  const int wave = otid(wv) >> 6, lane = otid(wv) & 63;
  float* qs = (float*)smem + wave * 448;
  float* ps = qs + 64;
  const float* rpb = P.na_rpb + (size_t)layer * 8 * 15 * 31;
  for (int it = bid * NWAVE + wave; it < nrows * 8; it += nb * NWAVE) {
    const int row = it >> 3, hd = it & 7;
    const bool lat = row < NLAT;
    int b, r = 0, cq = 0, r0 = 0, c0 = 0;
    if (lat) {
      b = row >> 12; const int l = row & 4095; r = l >> 6; cq = l & 63;
      r0 = r - 4; r0 = r0 < 0 ? 0 : (r0 > 56 ? 56 : r0);
      c0 = cq - 8; c0 = c0 < 0 ? 0 : (c0 > 48 ? 48 : c0);
    } else {
      b = (row - NLAT) >> 8;
    }
    qs[lane] = bf2f(P.p()[(size_t)row * PW + OFF_Q + hd * 64 + lane]) * 0.125f;
    __builtin_amdgcn_wave_barrier();
    const int nkeys = lat ? 384 : 256;
    float mx = -3.0e38f;
#pragma unroll 1
    for (int t = 0; t < 6; ++t) {
      const int n = t * 64 + lane;
      float s = -3.0e38f;
      if (n < nkeys) {
        int krow; float bias = 0.f;
        if (lat && n < 128) {
          const int kr = n >> 4, kc = n & 15;
          const int rk = r0 + kr, ck = c0 + kc;
          krow = b * 4096 + rk * 64 + ck;
          bias = rpb[(hd * 15 + (rk - r + 7)) * 31 + (ck - cq + 15)];
        } else {
          krow = NLAT + b * 256 + (lat ? n - 128 : n);
        }
        const bf16_t* kp = P.p() + (size_t)krow * PW + OFF_K + hd * 64;
        float d = 0.f;
#pragma unroll
        for (int v8 = 0; v8 < 8; ++v8) {
          const uint4 kk = *(const uint4*)(kp + v8 * 8);
          const bf16_t* ke = (const bf16_t*)&kk;
#pragma unroll
          for (int e = 0; e < 8; ++e) d += qs[v8 * 8 + e] * bf2f(ke[e]);
        }
        s = d + bias;
      }
      ps[t * 64 + lane] = s;
      mx = fmaxf(mx, s);
    }
    mx = wave_max(mx);
    float sum = 0.f;
#pragma unroll 1
    for (int t = 0; t < 6; ++t) {
      const int n = t * 64 + lane;
      const float e = (n < nkeys) ? expf(ps[n] - mx) : 0.f;
      sum += e;
      ps[n] = e;
    }
    sum = wave_sum(sum);
    __builtin_amdgcn_wave_barrier();
    float acc = 0.f;
    for (int n = 0; n < nkeys; ++n) {
      int krow;
      if (lat && n < 128) krow = b * 4096 + (r0 + (n >> 4)) * 64 + c0 + (n & 15);
      else krow = NLAT + b * 256 + (lat ? n - 128 : n);
      acc += ps[n] * bf2f(P.p()[(size_t)krow * PW + OFF_V + hd * 64 + lane]);
    }
    P.concat()[(size_t)row * 2048 + 1536 + hd * 64 + lane] = f2bf(acc / sum);
    __builtin_amdgcn_wave_barrier();
  }
}


template <int W>
__device__ __forceinline__ void pool_frags(const bf16_t* pc, int l, int L, float rc, bf16x8 (&af)[4]) {
#pragma unroll
  for (int t = 0; t < 4; ++t) {
    constexpr int WB = W < 8 ? W : 8;
    float s[8], f[8];
#pragma unroll
    for (int e = 0; e < 8; ++e) s[e] = 0.f;
    const u32x4_t own = *(const u32x4_t*)(pc + 32 * t);
#pragma unroll
    for (int ob = 0; ob < W; ob += WB) {
      u32x4_t rows[WB];
#pragma unroll
      for (int o = 0; o < WB; ++o) {
        const int rr = l - W / 2 + ob + o;
        const int rcl = (rr >= 0 && rr < L) ? rr : l;
        rows[o] = *(const u32x4_t*)(pc + (ptrdiff_t)(rcl - l) * PW + 32 * t);
      }
#pragma unroll
      for (int o = 0; o < WB; ++o) asm volatile("" : "+v"(rows[o]));
#pragma unroll
      for (int o = 0; o < WB; ++o) {
        const int rr = l - W / 2 + ob + o;
        const float mk = (rr >= 0 && rr < L) ? 1.f : 0.f;
        unpack8(make_uint4(rows[o].x, rows[o].y, rows[o].z, rows[o].w), f);
#pragma unroll
        for (int e = 0; e < 8; ++e) s[e] += mk * f[e];
      }
    }
    unpack8(make_uint4(own.x, own.y, own.z, own.w), f);
#pragma unroll
    for (int e = 0; e < 8; ++e) af[t][e] = (short)f2bf(s[e] * rc - f[e]);
  }
}
__device__ void ph_pool_mfma(int wv, const Params& P, int layer, int nrows, int bid, int nb) {
  const int lane = otid(wv) & 63, li = lane & 15, g = lane >> 4;
  const int nitems = (nrows / 16) * 4;
  for (int it = bid * NWAVE + wv; it < nitems; it += nb * NWAVE) {
    const int gi = it & 3, row0 = (it >> 2) * 16, w = 2 << gi;
    const int row = row0 + li;
    int l, L;
    if (row < NLAT) { l = row & 4095; L = 4096; } else { l = (row - NLAT) & 255; L = 256; }
    int lo = l - w / 2; lo = lo < 0 ? 0 : lo;
    int hi = l + w - w / 2 - 1; hi = hi > L - 1 ? L - 1 : hi;
    const float rc = 1.f / (float)(hi - lo + 1);
    const bf16_t* pc = P.p() + (size_t)row * PW + OFF_POOL + gi * 128 + 8 * g;
    bf16x8 af[4];
    if (gi == 0) pool_frags<2>(pc, l, L, rc, af);
    else if (gi == 1) pool_frags<4>(pc, l, L, rc, af);
    else if (gi == 2) pool_frags<8>(pc, l, L, rc, af);
    else pool_frags<16>(pc, l, L, rc, af);
    const bf16_t* wt = P.poolwT() + ((size_t)(layer * 4 + gi) * 128 + li) * 128 + 8 * g;
    const float* sc = P.pool_scale + layer * 512 + gi * 128;
#pragma unroll
    for (int nh = 0; nh < 4; ++nh) {
      bf16x8 wf[2][4];
#pragma unroll
      for (int n = 0; n < 2; ++n)
#pragma unroll
        for (int t = 0; t < 4; ++t) wf[n][t] = *(const bf16x8*)(wt + (size_t)(nh * 2 + n) * 16 * 128 + 32 * t);
#pragma unroll
      for (int n = 0; n < 2; ++n)
#pragma unroll
        for (int t = 0; t < 4; ++t) asm volatile("" : "+v"(wf[n][t]));
#pragma unroll
      for (int n = 0; n < 2; ++n) {
        const int nt = nh * 2 + n;
        f32x4 acc = (f32x4){0.f, 0.f, 0.f, 0.f};
#pragma unroll
        for (int t = 0; t < 4; ++t) acc = __builtin_amdgcn_mfma_f32_16x16x32_bf16(af[t], wf[n][t], acc, 0, 0, 0);
        const float scv = sc[nt * 16 + li];
#pragma unroll
        for (int e = 0; e < 4; ++e)
          P.concat()[(size_t)(row0 + 4 * g + e) * 2048 + 1024 + gi * 128 + nt * 16 + li] = f2bf(acc[e] * scv);
      }
    }
  }
}

__device__ void ph_vtranspose(int wv, const Params& P, char* smem, int bid, int nb) {
  const int lane = otid(wv) & 63;
  bf16_t* tile = (bf16_t*)smem + wv * 64 * 72;
  for (int it = bid * NWAVE + wv; it < 272 * 8; it += nb * NWAVE) {
    const int hd = it & 7, tt = it >> 3, row0 = tt * 64;
    const bf16_t* src = P.p() + (size_t)(row0 + lane) * PW + OFF_V + hd * 64;
#pragma unroll
    for (int i = 0; i < 8; ++i) *(uint4*)(tile + lane * 72 + i * 8) = *(const uint4*)(src + i * 8);
    __builtin_amdgcn_wave_barrier();
    bf16_t* dst;
    if (row0 < NLAT) dst = P.vtl() + ((size_t)((row0 >> 12) * 8 + hd) * 64 + lane) * 4096 + (row0 & 4095);
    else dst = P.vtc() + ((size_t)(((row0 - NLAT) >> 8) * 8 + hd) * 64 + lane) * 256 + ((row0 - NLAT) & 255);
#pragma unroll
    for (int i = 0; i < 8; ++i) {
      uint32_t w[4];
#pragma unroll
      for (int k = 0; k < 4; ++k)
        w[k] = (uint32_t)tile[(i * 8 + 2 * k) * 72 + lane] | ((uint32_t)tile[(i * 8 + 2 * k + 1) * 72 + lane] << 16);
      *(uint4*)(dst + i * 8) = make_uint4(w[0], w[1], w[2], w[3]);
    }
    __builtin_amdgcn_wave_barrier();
  }
}

__device__ __forceinline__ float grp_max(float v) {
  auto a = __builtin_amdgcn_permlane16_swap(__float_as_uint(v), __float_as_uint(v), false, false);
  v = fmaxf(__uint_as_float(a[0]), __uint_as_float(a[1]));
  auto b = __builtin_amdgcn_permlane32_swap(__float_as_uint(v), __float_as_uint(v), false, false);
  return fmaxf(__uint_as_float(b[0]), __uint_as_float(b[1]));
}
__device__ __forceinline__ float grp_sum(float v) {
  auto a = __builtin_amdgcn_permlane16_swap(__float_as_uint(v), __float_as_uint(v), false, false);
  v = __uint_as_float(a[0]) + __uint_as_float(a[1]);
  auto b = __builtin_amdgcn_permlane32_swap(__float_as_uint(v), __float_as_uint(v), false, false);
  return __uint_as_float(b[0]) + __uint_as_float(b[1]);
}

__device__ void ph_na_mfma(int wv, const Params& P, int layer, int nrows, char* smem, int bid, int nb) {
  const int lane = otid(wv) & 63, li = lane & 15, g = lane >> 4;
  float* btab = (float*)smem + wv * 256;
  const float* rpb = P.na_rpb + (size_t)layer * 8 * 15 * 31;
  const int n_lat = 4 * 64 * 8 * 4;
  const int n_items = n_lat + (nrows > NLAT ? 4 * 16 * 8 : 0);
  const int nrank = nb >> 3;
  const bool xmap = ((nb & 7) == 0) && nrank > 0 && (1024 % nrank) == 0 && (64 % nrank) == 0;
  const int per_lat = xmap ? 1024 / nrank : 0, per_ctx = (xmap && nrows > NLAT) ? 64 / nrank : 0;
  const int q_begin = xmap ? wv : bid * NWAVE + wv, q_end = xmap ? per_lat + per_ctx : n_items, q_step = xmap ? NWAVE : nb * NWAVE;
  for (int q = q_begin; q < q_end; q += q_step) {
    bool lat;
    int b, hd, qrow0, r = 0, cq0 = 0, r0 = 0, cs = 0, qt;
    if (xmap) {
      hd = bid & 7;
      const int rank = bid >> 3;
      lat = q < per_lat;
      if (lat) { const int i = rank * per_lat + q; qt = i & 3; r = (i >> 2) & 63; b = i >> 8; }
      else { const int c = rank * per_ctx + (q - per_lat); qt = c & 15; b = c >> 4; }
    } else {
      lat = q < n_lat;
      if (lat) { qt = q & 3; hd = (q >> 2) & 7; r = (q >> 5) & 63; b = q >> 11; }
      else { const int t = q - n_lat; hd = t & 7; qt = (t >> 3) & 15; b = t >> 7; }
    }
    if (lat) {
      cq0 = qt * 16; qrow0 = b * 4096 + r * 64 + cq0;
      r0 = r - 4; r0 = r0 < 0 ? 0 : (r0 > 56 ? 56 : r0);
      int clo = cq0 - 8; clo = clo < 0 ? 0 : (clo > 48 ? 48 : clo);
      cs = clo < 32 ? clo : 32;
    } else {
      qrow0 = NLAT + b * 256 + qt * 16;
    }
    const bf16_t* qp = P.p() + (size_t)(qrow0 + li) * PW + OFF_Q + hd * 64 + 8 * g;
    const bf16x8 qf0 = *(const bf16x8*)qp, qf1 = *(const bf16x8*)(qp + 32);
    __builtin_amdgcn_wave_barrier();
#pragma unroll
    for (int i = 0; i < 4; ++i) {
      const int e_ = i * 64 + lane, kr_ = e_ >> 5, dc_ = e_ & 31;
      int dr_ = r0 + kr_ - r + 7; dr_ = dr_ < 0 ? 0 : (dr_ > 14 ? 14 : dr_);
      btab[e_] = rpb[(hd * 15 + dr_) * 31 + (dc_ < 31 ? dc_ : 30)];
    }
    __builtin_amdgcn_wave_barrier();
    f32x4 accS[16], accC[16];
#define NA_KPTR(tile) ((tile) < 16 ? P.p() + (size_t)(b * 4096 + (r0 + ((tile) >> 1)) * 64 + cs + 16 * ((tile) & 1) + li) * PW + OFF_K + hd * 64 + 8 * g \
                                   : P.p() + (size_t)(NLAT + b * 256 + 16 * ((tile) - 16) + li) * PW + OFF_K + hd * 64 + 8 * g)
    bf16x8 kA[2][2], kB[2][2];
#pragma unroll
    for (int i = 0; i < 2; ++i) { const bf16_t* kp = NA_KPTR(i); kA[i][0] = *(const bf16x8*)kp; kA[i][1] = *(const bf16x8*)(kp + 32); }
#pragma unroll
    for (int tb = 0; tb < 32; tb += 4) {
#pragma unroll
      for (int i = 0; i < 2; ++i) { const bf16_t* kp = NA_KPTR(tb + 2 + i); kB[i][0] = *(const bf16x8*)kp; kB[i][1] = *(const bf16x8*)(kp + 32); }
#pragma unroll
      for (int i = 0; i < 2; ++i) { asm volatile("" : "+v"(kA[i][0]), "+v"(kA[i][1])); }
#pragma unroll
      for (int i = 0; i < 2; ++i) {
        f32x4 z = (f32x4){0.f, 0.f, 0.f, 0.f};
        z = __builtin_amdgcn_mfma_f32_16x16x32_bf16(kA[i][0], qf0, z, 0, 0, 0);
        z = __builtin_amdgcn_mfma_f32_16x16x32_bf16(kA[i][1], qf1, z, 0, 0, 0);
        if (tb + i < 16) accS[(tb + i) & 15] = z; else accC[(tb + i) & 15] = z;
      }
      if (tb + 4 < 32) {
#pragma unroll
        for (int i = 0; i < 2; ++i) { const bf16_t* kp = NA_KPTR(tb + 4 + i); kA[i][0] = *(const bf16x8*)kp; kA[i][1] = *(const bf16x8*)(kp + 32); }
      }
#pragma unroll
      for (int i = 0; i < 2; ++i) { asm volatile("" : "+v"(kB[i][0]), "+v"(kB[i][1])); }
#pragma unroll
      for (int i = 0; i < 2; ++i) {
        f32x4 z = (f32x4){0.f, 0.f, 0.f, 0.f};
        z = __builtin_amdgcn_mfma_f32_16x16x32_bf16(kB[i][0], qf0, z, 0, 0, 0);
        z = __builtin_amdgcn_mfma_f32_16x16x32_bf16(kB[i][1], qf1, z, 0, 0, 0);
        if (tb + 2 + i < 16) accS[(tb + 2 + i) & 15] = z; else accC[(tb + 2 + i) & 15] = z;
      }
    }
#undef NA_KPTR
    const int cq = cq0 + li;
    int c0q = cq - 8; c0q = c0q < 0 ? 0 : (c0q > 48 ? 48 : c0q);
    float mx = -3.0e38f;
#pragma unroll
    for (int kt = 0; kt < 16; ++kt) {
      const int rk = r0 + (kt >> 1);
#pragma unroll
      for (int e = 0; e < 4; ++e) {
        const int ck = cs + 16 * (kt & 1) + 4 * g + e;
        const bool ok = lat && ck >= c0q && ck < c0q + 16;
        int bi = (kt >> 1) * 32 + (ck - cq + 15);
        bi = ok ? bi : 0;
        const float bv = btab[bi];
        const float s = ok ? accS[kt][e] * 0.125f + bv : -3.0e38f;
        accS[kt][e] = s;
        mx = fmaxf(mx, s);
      }
    }
#pragma unroll
    for (int ct = 0; ct < 16; ++ct)
#pragma unroll
      for (int e = 0; e < 4; ++e) { const float s = accC[ct][e] * 0.125f; accC[ct][e] = s; mx = fmaxf(mx, s); }
    mx = grp_max(mx);
    float sum = 0.f;
#pragma unroll
    for (int kt = 0; kt < 16; ++kt)
#pragma unroll
      for (int e = 0; e < 4; ++e) { const float p = __expf(accS[kt][e] - mx); accS[kt][e] = p; sum += p; }
#pragma unroll
    for (int ct = 0; ct < 16; ++ct)
#pragma unroll
      for (int e = 0; e < 4; ++e) { const float p = __expf(accC[ct][e] - mx); accC[ct][e] = p; sum += p; }
    sum = grp_sum(sum);
    const float inv = 1.f / sum;
    bf16x8 afL[8], afC[8];
#pragma unroll
    for (int kr = 0; kr < 8; ++kr) {
#pragma unroll
      for (int e = 0; e < 4; ++e) {
        afL[kr][e] = (short)f2bf(accS[2 * kr][e] * inv); afL[kr][4 + e] = (short)f2bf(accS[2 * kr + 1][e] * inv);
        afC[kr][e] = (short)f2bf(accC[2 * kr][e] * inv); afC[kr][4 + e] = (short)f2bf(accC[2 * kr + 1][e] * inv);
      }
    }
    f32x4 accO[4];
#pragma unroll
    for (int db = 0; db < 4; ++db) accO[db] = (f32x4){0.f, 0.f, 0.f, 0.f};
    const bf16_t* vl = P.vtl() + ((size_t)(b * 8 + hd) * 64 + li) * 4096;
    const bf16_t* vc = P.vtc() + ((size_t)(b * 8 + hd) * 64 + li) * 256;
#pragma unroll
    for (int kr = 0; kr < 8; ++kr) {
      const int tok = (r0 + kr) * 64 + cs + 4 * g;
      s16x4 lo[4], hi[4];
#pragma unroll
      for (int db = 0; db < 4; ++db) {
        const bf16_t* vp = vl + (size_t)db * 16 * 4096 + tok;
        lo[db] = *(const s16x4*)vp; hi[db] = *(const s16x4*)(vp + 16);
      }
#pragma unroll
      for (int db = 0; db < 4; ++db) {
        const bf16x8 bfr = (bf16x8){lo[db][0], lo[db][1], lo[db][2], lo[db][3], hi[db][0], hi[db][1], hi[db][2], hi[db][3]};
        accO[db] = __builtin_amdgcn_mfma_f32_16x16x32_bf16(afL[kr], bfr, accO[db], 0, 0, 0);
      }
    }
#pragma unroll
    for (int t = 0; t < 8; ++t) {
      const int tok = 32 * t + 4 * g;
      s16x4 lo[4], hi[4];
#pragma unroll
      for (int db = 0; db < 4; ++db) {
        const bf16_t* vp = vc + (size_t)db * 16 * 256 + tok;
        lo[db] = *(const s16x4*)vp; hi[db] = *(const s16x4*)(vp + 16);
      }
#pragma unroll
      for (int db = 0; db < 4; ++db) {
        const bf16x8 bfr = (bf16x8){lo[db][0], lo[db][1], lo[db][2], lo[db][3], hi[db][0], hi[db][1], hi[db][2], hi[db][3]};
        accO[db] = __builtin_amdgcn_mfma_f32_16x16x32_bf16(afC[t], bfr, accO[db], 0, 0, 0);
      }
    }
#pragma unroll
    for (int db = 0; db < 4; ++db)
#pragma unroll
      for (int e = 0; e < 4; ++e)
        P.concat()[(size_t)(qrow0 + 4 * g + e) * 2048 + 1536 + hd * 64 + 16 * db + li] = f2bf(accO[db][e]);
  }
}

__device__ void ph_peer_topk(int wv, const Params& P, int layer, int nrows, char* smem, int bid, int nb) {
  bf16_t* Ks = (bf16_t*)smem;
  float* qt = (float*)(smem + 33280);
  float* sc = qt + 32 * 256;
  float* tv = sc + 64 * 129;
  int* ti = (int*)(tv + 64 * 16);
  const int tid = otid(wv);
  const int ntile = nrows / 32;
  for (int it = bid; it < ntile * 8; it += nb) {
    const int hd = it % 8, tt = it / 8;
    const int row0 = tt * 32;
    __syncthreads();
    for (int i = tid; i < 32 * 256; i += NTHR) {
      const int t = i >> 8, d = i & 255;
      qt[i] = bf2f(P.q()[(size_t)(row0 + t) * 2048 + hd * 256 + d]);
    }
    for (int half = 0; half < 2; ++half) {
      __syncthreads();
      const float* kk = P.peer_keys + ((size_t)((layer * 8 + hd) * 2 + half) * 128) * 128;
      for (int i = tid; i < 128 * 128; i += NTHR) Ks[(i >> 7) * 130 + (i & 127)] = f2bf(kk[i]);
      __syncthreads();
      const int k = tid & 127, tg = (tid >> 7) & 1;
      float acc[16];
#pragma unroll
      for (int i = 0; i < 16; ++i) acc[i] = 0.f;
      for (int d = 0; d < 128; ++d) {
        const float kv = bf2f(Ks[k * 130 + d]);
#pragma unroll
        for (int i = 0; i < 16; ++i) acc[i] += qt[(tg * 16 + i) * 256 + half * 128 + d] * kv;
      }
#pragma unroll
      for (int i = 0; i < 16; ++i) sc[((tg * 16 + i) * 2 + half) * 129 + k] = acc[i];
    }
    __syncthreads();
    if (tid < 64) {
      float* s = sc + tid * 129;
      for (int r = 0; r < 16; ++r) {
        float best = -3.0e38f; int bi = 0;
        for (int k = 0; k < 128; ++k) { const float v = s[k]; if (v > best) { best = v; bi = k; } }
        tv[tid * 16 + r] = best; ti[tid * 16 + r] = bi;
        s[bi] = -3.0e38f;
      }
    }
    __syncthreads();
    float* cand = qt;
    for (int i = tid; i < 32 * 256; i += NTHR) {
      const int t = i >> 8, a = (i >> 4) & 15, b2 = i & 15;
      cand[i] = tv[(t * 2 + 0) * 16 + a] + tv[(t * 2 + 1) * 16 + b2];
    }
    __syncthreads();
    if (tid < 32) {
      float* cd = cand + tid * 256;
      float ts[16];
      const int row = row0 + tid;
      float mx = 0.f;
#pragma unroll
      for (int r = 0; r < 16; ++r) {
        float best = -3.0e38f; int bi = 0;
        for (int k = 0; k < 256; ++k) { const float v = cd[k]; if (v > best) { best = v; bi = k; } }
        cd[bi] = -3.0e38f;
        ts[r] = best;
        if (r == 0) mx = best;
        const int e = ti[(tid * 2 + 0) * 16 + (bi >> 4)] * 128 + ti[(tid * 2 + 1) * 16 + (bi & 15)];
        P.sel_idx()[(size_t)row * 128 + hd * 16 + r] = e;
      }
      float sum = 0.f;
#pragma unroll
      for (int r = 0; r < 16; ++r) { ts[r] = expf(ts[r] - mx); sum += ts[r]; }
      const float inv = 1.f / sum;
#pragma unroll
      for (int r = 0; r < 16; ++r) P.sel_g()[(size_t)row * 128 + hd * 16 + r] = ts[r] * inv;
    }
  }
}


__device__ __forceinline__ uint32_t mono_u(float f) { const uint32_t u = __float_as_uint(f); return u ^ ((uint32_t)((int)u >> 31) | 0x80000000u); }
__device__ __forceinline__ float unmono_f(uint32_t m) { return __uint_as_float((m & 0x80000000u) ? (m ^ 0x80000000u) : ~m); }
__device__ __forceinline__ uint32_t grp_max_u(uint32_t v) {
  auto a = __builtin_amdgcn_permlane16_swap(v, v, false, false);
  v = a[0] > a[1] ? a[0] : a[1];
  auto b = __builtin_amdgcn_permlane32_swap(v, v, false, false);
  return b[0] > b[1] ? b[0] : b[1];
}

template <int N>
__device__ __forceinline__ void bitonic_sort_desc(uint32_t (&a)[N], int base = 0) { (void)base;
#pragma unroll
  for (int k = 2; k <= N; k <<= 1)
#pragma unroll
    for (int j = k >> 1; j > 0; j >>= 1)
#pragma unroll
      for (int i = 0; i < N; ++i) {
        const int l = i ^ j;
        if (l > i) {
          const bool desc = (i & k) == 0;
          const uint32_t hi = a[i] > a[l] ? a[i] : a[l], lo = a[i] > a[l] ? a[l] : a[i];
          a[i] = desc ? hi : lo; a[l] = desc ? lo : hi;
        }
      }
}
template <int N>
__device__ __forceinline__ void bitonic_merge_desc(uint32_t (&a)[N]) {
#pragma unroll
  for (int j = N >> 1; j > 0; j >>= 1)
#pragma unroll
    for (int i = 0; i < N; ++i) {
      const int l = i ^ j;
      if (l > i) {
        const uint32_t hi = a[i] > a[l] ? a[i] : a[l], lo = a[i] > a[l] ? a[l] : a[i];
        a[i] = hi; a[l] = lo;
      }
    }
}
__device__ __forceinline__ void merge4_top16(uint32_t (&a)[16]) {
  uint32_t e[16], o[16];
#pragma unroll
  for (int i = 0; i < 16; ++i) { auto r = __builtin_amdgcn_permlane16_swap(a[i], a[i], false, false); e[i] = r[0]; o[i] = r[1]; }
#pragma unroll
  for (int i = 0; i < 16; ++i) a[i] = e[i] > o[15 - i] ? e[i] : o[15 - i];
  bitonic_merge_desc<16>(a);
#pragma unroll
  for (int i = 0; i < 16; ++i) { auto r = __builtin_amdgcn_permlane32_swap(a[i], a[i], false, false); e[i] = r[0]; o[i] = r[1]; }
#pragma unroll
  for (int i = 0; i < 16; ++i) a[i] = e[i] > o[15 - i] ? e[i] : o[15 - i];
  bitonic_merge_desc<16>(a);
}
__device__ void ph_peer_topk_mfma(int wv, const Params& P, int layer, int nrows, char* smem, int bid, int nb) {
  const int tid = otid(wv), lane = tid & 63, li = lane & 15, g = lane >> 4;
  unsigned char* ctab = (unsigned char*)smem;
  float* vals = (float*)(smem + 256) + wv * 512;
  int* idxs = (int*)(smem + 256 + 8 * 2048) + wv * 512;
  __syncthreads();
  if (tid < 64) ctab[tid] = 0xFF;
  __syncthreads();
  if (tid == 0) {
    int n = 0, one = 1;
    asm volatile("" : "+s"(one));
#pragma unroll 1
    for (int a = 0; a < 16; ++a)
#pragma unroll 1
      for (int b = 0; b < 16; ++b)
        if ((a + one) * (b + 1) <= 16) { ctab[(n & 3) * 16 + (n >> 2)] = (unsigned char)(a * 16 + b); ++n; }
  }
  const int hd = bid & 7, tg = bid >> 3, ngroups = nb >> 3;
  char* ksm = smem + 33280;
  {
    const bf16_t* ksrc = P.keysb() + (size_t)(layer * 8 + hd) * 2 * 128 * 128;
#pragma unroll
    for (int i = 0; i < 8; ++i) {
      const int idx = tid + i * 512, r = idx >> 4, sg = idx & 15;
      *(uint4*)(ksm + (r * 136 + sg * 8) * 2) = *(const uint4*)(ksrc + (size_t)r * 128 + sg * 8);
    }
  }
  __syncthreads();
  const int ntile = nrows / 16;
  for (int tile = tg + ngroups * wv; tile < ntile && tg < ngroups; tile += ngroups * NWAVE) {
    const int row0 = tile * 16;
    const bf16_t* qp = P.q() + (size_t)(row0 + li) * 2048 + hd * 256 + 8 * g;
    uint32_t win[2][16];
#pragma unroll
    for (int half = 0; half < 2; ++half) {
      bf16x8 qf[4];
#pragma unroll
      for (int t = 0; t < 4; ++t) qf[t] = *(const bf16x8*)(qp + half * 128 + 32 * t);
      const char* kb = ksm + ((half * 128 + li) * 136 + 8 * g) * 2;
      uint32_t pk[32];
#pragma unroll
      for (int kt = 0; kt < 8; ++kt) {
        f32x4 acc = (f32x4){0.f, 0.f, 0.f, 0.f};
#pragma unroll
        for (int t = 0; t < 4; ++t) {
          const bf16x8 a = *(const bf16x8*)(kb + (kt * 16 * 136 + 32 * t) * 2);
          acc = __builtin_amdgcn_mfma_f32_16x16x32_bf16(a, qf[t], acc, 0, 0, 0);
        }
#pragma unroll
        for (int e = 0; e < 4; ++e) pk[kt * 4 + e] = (mono_u(acc[e]) & ~127u) | (uint32_t)(16 * kt + 4 * g + e);
      }
      {
        uint32_t lo16[16], hi16[16];
#pragma unroll
        for (int i = 0; i < 16; ++i) { lo16[i] = pk[i]; hi16[i] = pk[16 + i]; }
        bitonic_sort_desc<16>(lo16);
        bitonic_sort_desc<16>(hi16);
#pragma unroll
        for (int i = 0; i < 16; ++i) lo16[i] = lo16[i] > hi16[15 - i] ? lo16[i] : hi16[15 - i];
        bitonic_merge_desc<16>(lo16);
        merge4_top16(lo16);
#pragma unroll
        for (int r = 0; r < 16; ++r) win[half][r] = lo16[r];
      }
    }
    if (g == 0) {
#pragma unroll
      for (int half = 0; half < 2; ++half)
#pragma unroll
        for (int r = 0; r < 16; ++r) {
          vals[li * 32 + half * 16 + r] = unmono_f(win[half][r] & ~127u);
          idxs[li * 32 + half * 16 + r] = (int)(win[half][r] & 127u);
        }
    }
    __builtin_amdgcn_wave_barrier();
    uint32_t cp[16];
#pragma unroll
    for (int s = 0; s < 16; ++s) {
      const uint32_t ab = ctab[g * 16 + s];
      uint32_t v = 0u;
      if (ab != 0xFFu) v = (mono_u(vals[li * 32 + (ab >> 4)] + vals[li * 32 + 16 + (ab & 15u)]) & ~255u) | ab;
      cp[s] = v;
    }
    bitonic_sort_desc<16>(cp);
    merge4_top16(cp);
    uint32_t cw[16];
#pragma unroll
    for (int r = 0; r < 16; ++r) cw[r] = cp[r];
    const float mx = unmono_f(cw[0] & ~255u);
    float ex[16];
    float sum = 0.f;
#pragma unroll
    for (int r = 0; r < 16; ++r) { ex[r] = __expf(unmono_f(cw[r] & ~255u) - mx); sum += ex[r]; }
    const float inv = 1.f / sum;
    const size_t ob = (size_t)(row0 + li) * 128 + hd * 16;
#pragma unroll
    for (int r = 0; r < 16; ++r) {
      if ((r >> 2) == g) {
        const uint32_t ab = cw[r] & 255u;
        P.sel_idx()[ob + r] = idxs[li * 32 + (ab >> 4)] * 128 + idxs[li * 32 + 16 + (ab & 15u)];
        P.sel_g()[ob + r] = ex[r] * inv;
      }
    }
    __builtin_amdgcn_wave_barrier();
  }
}

__device__ __forceinline__ void cvt8(const uint32_t w, float* f) {
  const f32x2_t a = __builtin_amdgcn_cvt_scalef32_pk_f32_fp4(w, 1.0f, 0), b = __builtin_amdgcn_cvt_scalef32_pk_f32_fp4(w, 1.0f, 1);
  const f32x2_t c = __builtin_amdgcn_cvt_scalef32_pk_f32_fp4(w, 1.0f, 2), e = __builtin_amdgcn_cvt_scalef32_pk_f32_fp4(w, 1.0f, 3);
  f[0] = a.x; f[1] = a.y; f[2] = b.x; f[3] = b.y; f[4] = c.x; f[5] = c.y; f[6] = e.x; f[7] = e.y;
}
__device__ __forceinline__ float swap16_add(float a, float b) {
  auto r = __builtin_amdgcn_permlane16_swap(__float_as_uint(a), __float_as_uint(b), false, false);
  return __uint_as_float(r[0]) + __uint_as_float(r[1]);
}
__device__ void ph_peer_gather(int wv, const Params& P, int layer, int nrows, int bid, int nb) {
  for (int row = bid * NWAVE + wv; row < nrows; row += nb * NWAVE) {
    const int lane = otid(wv) & 63, l5 = lane & 31;
    const bool up = lane >= 32;
    const unsigned char* TU = P.tabU() + l5 * 16;
    const unsigned char* TV = P.tabV() + l5 * 16;
    const int j15 = lane & 15;
    const int rr = ((j15 >> 3) & 1) | ((j15 & 1) << 1), zi = (j15 >> 1) & 3;
    const int srcl = (rr * 4 + (zi & 1) * 2 + (zi >> 1)) * 4;
    float xv[32], o[32];
    {
      const bf16_t* xp = P.u() + (size_t)row * DM + l5 * 32;
      unpack8(*(const uint4*)xp, xv); unpack8(*(const uint4*)(xp + 8), xv + 8);
      unpack8(*(const uint4*)(xp + 16), xv + 16); unpack8(*(const uint4*)(xp + 24), xv + 24);
    }
    const int idx0 = P.sel_idx()[(size_t)row * 128 + lane], idx1 = P.sel_idx()[(size_t)row * 128 + 64 + lane];
    const float gt0 = P.sel_g()[(size_t)row * 128 + lane] * P.invV()[idx0], gt1 = P.sel_g()[(size_t)row * 128 + 64 + lane] * P.invV()[idx1];
    const float iu0 = P.invU()[idx0], iu1 = P.invU()[idx1];
    float d0 = 0.f, d1 = 0.f;
    uint4 bufA[8], bufB[8];
#define PG_LOAD(buf, T, kk) do { _Pragma("unroll") for (int j = 0; j < 8; ++j) { \
      const int k_ = (kk) + 2 * j; const int src_ = k_ < 64 ? idx0 : idx1; \
      const int elo_ = __builtin_amdgcn_readlane(src_, k_ & 63), ehi_ = __builtin_amdgcn_readlane(src_, (k_ & 63) + 1); \
      buf[j] = *(const uint4*)(T + (size_t)(up ? ehi_ : elo_) * 512); } } while (0)
#define PG_DOT(buf, kk) do { float pv[8]; _Pragma("unroll") for (int j = 0; j < 8; ++j) { float s_ = 0.f; const uint32_t w_[4] = {buf[j].x, buf[j].y, buf[j].z, buf[j].w}; \
      _Pragma("unroll") for (int d = 0; d < 4; ++d) { float f[8]; uint32_t wd_ = w_[d]; asm volatile("" : "+v"(wd_) : "v"(s_)); cvt8(wd_, f); \
        _Pragma("unroll") for (int i = 0; i < 8; ++i) s_ += f[i] * xv[d * 8 + i]; } pv[j] = s_; } \
      const float z0 = swap16_add(pv[0], pv[4]), z1 = swap16_add(pv[1], pv[5]), z2 = swap16_add(pv[2], pv[6]), z3 = swap16_add(pv[3], pv[7]); \
      const bool hi8 = (lane & 8) != 0, hi4 = (lane & 4) != 0; \
      const float y0 = (hi8 ? z1 : z0) + DPP_F(hi8 ? z0 : z1, 0x128); \
      const float y1 = (hi8 ? z3 : z2) + DPP_F(hi8 ? z2 : z3, 0x128); \
      float q_ = (hi4 ? y1 : y0) + DPP_F(hi4 ? y0 : y1, 0x141); \
      q_ += DPP_F(q_, 0xB1); q_ += DPP_F(q_, 0x4E); \
      const float t_ = __int_as_float(__builtin_amdgcn_ds_bpermute(srcl * 4, __float_as_int(q_))); \
      const int m_ = ((kk) >> 4) & 3; \
      if ((kk) < 64) d0 = ((lane >> 4) == m_) ? t_ : d0; else d1 = ((lane >> 4) == m_) ? t_ : d1; } while (0)
    PG_LOAD(bufA, TU, 0);
#pragma unroll 1
    for (int kk = 0; kk < 128; kk += 32) {
      PG_LOAD(bufB, TU, kk + 16);
      PG_DOT(bufA, kk);
      if (kk + 32 < 128) PG_LOAD(bufA, TU, kk + 32); else PG_LOAD(bufA, TV, 0);
      PG_DOT(bufB, kk + 16);
    }
    const float act0 = gelu_f(d0 * iu0) * gt0, act1 = gelu_f(d1 * iu1) * gt1;
#pragma unroll
    for (int i = 0; i < 32; ++i) o[i] = 0.f;
#define PG_ACC(buf, kk) do { _Pragma("unroll") for (int j = 0; j < 8; ++j) { const int k_ = (kk) + 2 * j; \
      const int asrc_ = __float_as_int(k_ < 64 ? act0 : act1); \
      const float alo_ = __int_as_float(__builtin_amdgcn_readlane(asrc_, k_ & 63)), ahi_ = __int_as_float(__builtin_amdgcn_readlane(asrc_, (k_ & 63) + 1)); \
      const float a_ = up ? ahi_ : alo_; \
      const uint32_t w_[4] = {buf[j].x, buf[j].y, buf[j].z, buf[j].w}; \
      _Pragma("unroll") for (int d = 0; d < 4; ++d) { float f[8]; uint32_t wd_ = w_[d]; asm volatile("" : "+v"(wd_) : "v"(o[(d * 8 + 31) & 31])); cvt8(wd_, f); \
        _Pragma("unroll") for (int i = 0; i < 8; ++i) o[d * 8 + i] += a_ * f[i]; } } } while (0)
#pragma unroll 1
    for (int kk = 0; kk < 128; kk += 32) {
      PG_LOAD(bufB, TV, kk + 16);
      PG_ACC(bufA, kk);
      if (kk + 32 < 128) PG_LOAD(bufA, TV, kk + 32);
      PG_ACC(bufB, kk + 16);
    }
#undef PG_LOAD
#undef PG_DOT
#undef PG_ACC
#pragma unroll
    for (int i = 0; i < 32; ++i) {
      auto r = __builtin_amdgcn_permlane32_swap(__float_as_uint(o[i]), __float_as_uint(o[i]), false, false);
      o[i] = __uint_as_float(r[0]) + __uint_as_float(r[1]);
    }
    const int lane_e = otid(wv) & 63, l5e = lane_e & 31;
    const bool upe = lane_e >= 32;
    const float* gate = P.mod() + (size_t)(layer * 5 + modrow(row)) * MODW + 5120 + l5e * 32;
    float* hr = P.h() + (size_t)row * DM + l5e * 32;
    float ss = 0.f;
    f32x4 hvv[8], ggv[8];
#pragma unroll
    for (int q = 0; q < 8; ++q) { hvv[q] = *(const f32x4*)(hr + q * 4); ggv[q] = *(const f32x4*)(gate + q * 4); }
#pragma unroll
    for (int q = 0; q < 8; ++q) asm volatile("" : "+v"(hvv[q]), "+v"(ggv[q]));
#pragma unroll
    for (int q = 0; q < 8; ++q) {
      float4 hv = make_float4(hvv[q][0], hvv[q][1], hvv[q][2], hvv[q][3]);
      const float4 gg = make_float4(ggv[q][0], ggv[q][1], ggv[q][2], ggv[q][3]);
      hv.x += gg.x * o[q * 4 + 0]; hv.y += gg.y * o[q * 4 + 1]; hv.z += gg.z * o[q * 4 + 2]; hv.w += gg.w * o[q * 4 + 3];
      if (layer == 0 && !upe) *(float4*)(hr + q * 4) = hv;
      o[q * 4 + 0] = hv.x; o[q * 4 + 1] = hv.y; o[q * 4 + 2] = hv.z; o[q * 4 + 3] = hv.w;
      if (!upe) ss += hv.x * hv.x + hv.y * hv.y + hv.z * hv.z + hv.w * hv.w;
    }
    ss = wave_sum(ss);
    const float rstd = rsqrtf(ss * (1.f / 1024.f) + 1e-6f);
    if (layer == 0) {
      const float* g1 = P.norm1_g + 1024 + l5e * 32;
      const float* mr = P.mod() + (size_t)(5 + modrow(row)) * MODW + l5e * 32;
      if (!upe) {
#pragma unroll
        for (int q = 0; q < 4; ++q) {
          float ov[8];
#pragma unroll
          for (int e = 0; e < 8; ++e) ov[e] = o[q * 8 + e] * rstd * g1[q * 8 + e] * (1.f + mr[1024 + q * 8 + e]) + mr[q * 8 + e];
          *(uint4*)(P.u() + (size_t)row * DM + l5e * 32 + q * 8) = make_uint4(pack2(ov[0], ov[1]), pack2(ov[2], ov[3]), pack2(ov[4], ov[5]), pack2(ov[6], ov[7]));
        }
      }
    } else {
      const float* gf = P.final_g + l5e * 32;
      if (!upe) {
#pragma unroll
        for (int q = 0; q < 8; ++q) {
          const float4 gg = *(const float4*)(gf + q * 4);
          *(float4*)(P.out + (size_t)row * DM + l5e * 32 + q * 4) =
              make_float4(o[q * 4] * rstd * gg.x, o[q * 4 + 1] * rstd * gg.y, o[q * 4 + 2] * rstd * gg.z, o[q * 4 + 3] * rstd * gg.w);
        }
      }
    }
  }
}

__device__ void ph_final(int wv, const Params& P, int bid, int nb) {
  const int wave = otid(wv) >> 6, lane = otid(wv) & 63;
  for (int row = bid * NWAVE + wave; row < NLAT; row += nb * NWAVE) {
    const float* src = P.h() + (size_t)row * DM;
    float4 v[4];
    float ss = 0.f;
#pragma unroll
    for (int i = 0; i < 4; ++i) {
      v[i] = ((const float4*)src)[i * 64 + lane];
      ss += v[i].x * v[i].x + v[i].y * v[i].y + v[i].z * v[i].z + v[i].w * v[i].w;
    }
    ss = wave_sum(ss);
    const float rstd = rsqrtf(ss * (1.f / 1024.f) + 1e-6f);
#pragma unroll
    for (int i = 0; i < 4; ++i) {
      const int idx = i * 256 + lane * 4;
      const float4 gg = *(const float4*)(P.final_g + idx);
      float4 o;
      o.x = v[i].x * rstd * gg.x; o.y = v[i].y * rstd * gg.y; o.z = v[i].z * rstd * gg.z; o.w = v[i].w * rstd * gg.w;
      *(float4*)(P.out + (size_t)row * DM + idx) = o;
    }
  }
}


struct EpiOutproj {
  static constexpr bool PERM = false, AFTER_DRAIN = false;
  float* H; const float* hl; const float* hc; const float* modl;
  __device__ __forceinline__ void operator()(const pg8::f32x4 (&acc)[2][2][4][2], const pg8::Unit& u, int wr, int wc, int fr, int fq) const {
    const int row0 = u.pm * 256 + wr * 64 + fr, col0 = u.pn * 256 + wc * 32 + 4 * fq;
#pragma unroll
    for (int ai = 0; ai < 2; ++ai)
#pragma unroll
      for (int m = 0; m < 4; ++m) {
        const int row = row0 + ai * 128 + m * 16;
        const float* src = hrow(hl, hc, row) + col0;
        const float* gate = modl + (size_t)modrow(row) * MODW + 2048 + col0;
        float* dst = H + (size_t)row * DM + col0;
#pragma unroll
        for (int bj = 0; bj < 2; ++bj)
#pragma unroll
          for (int n = 0; n < 2; ++n) {
            const pg8::f32x4 s = *(const pg8::f32x4*)(src + bj * 128 + n * 16);
            const pg8::f32x4 g = *(const pg8::f32x4*)(gate + bj * 128 + n * 16);
            *(pg8::f32x4*)(dst + bj * 128 + n * 16) = s + g * acc[ai][bj][m][n];
          }
      }
  }
};

__device__ __forceinline__ uint32_t fp4_code(float x, float sc) {
  const float a = fabsf(x) * sc;
  const uint32_t c = (uint32_t)(a > 0.25f) + (uint32_t)(a > 0.75f) + (uint32_t)(a > 1.25f) + (uint32_t)(a > 1.75f) +
                     (uint32_t)(a > 2.5f) + (uint32_t)(a > 3.5f) + (uint32_t)(a > 5.0f);
  return c | (x < 0.f ? 8u : 0u);
}
__device__ void ph_convert_tables(int wv, const Params& P, int layer, int bid, int nb) {
  const int lane = otid(wv) & 63;
  for (int it = bid * NWAVE + wv; it < 2 * 16384; it += nb * NWAVE) {
    const int t = it >> 14, e = it & 16383;
    const float* src = (t == 0 ? P.peer_u : P.peer_v) + ((size_t)layer * 16384 + e) * 1024 + lane * 16;
    float4 v[4];
    float m = 0.f;
#pragma unroll
    for (int i = 0; i < 4; ++i) {
      v[i] = ((const float4*)src)[i];
      m = fmaxf(m, fmaxf(fmaxf(fabsf(v[i].x), fabsf(v[i].y)), fmaxf(fabsf(v[i].z), fabsf(v[i].w))));
    }
    m = wave_max(m);
    m = fmaxf(m, 1e-30f);
    const float sc = 6.0f / m, inv = m * (1.0f / 6.0f);
    uint2 o;
    o.x = fp4_code(v[0].x, sc) | (fp4_code(v[0].y, sc) << 4) | (fp4_code(v[0].z, sc) << 8) | (fp4_code(v[0].w, sc) << 12) |
          (fp4_code(v[1].x, sc) << 16) | (fp4_code(v[1].y, sc) << 20) | (fp4_code(v[1].z, sc) << 24) | (fp4_code(v[1].w, sc) << 28);
    o.y = fp4_code(v[2].x, sc) | (fp4_code(v[2].y, sc) << 4) | (fp4_code(v[2].z, sc) << 8) | (fp4_code(v[2].w, sc) << 12) |
          (fp4_code(v[3].x, sc) << 16) | (fp4_code(v[3].y, sc) << 20) | (fp4_code(v[3].z, sc) << 24) | (fp4_code(v[3].w, sc) << 28);
    *(uint2*)((t == 0 ? P.tabU() : P.tabV()) + (size_t)e * 512 + lane * 8) = o;
    if (lane == 0) (t == 0 ? P.invU() : P.invV())[e] = inv;
  }
}

enum {
  PH_PREP = 0, PH_NORM1, PH_INPROJ, PH_CONV, PH_SSDPREP, PH_STATES, PH_SCAN, PH_SSDY, PH_SSDNORM, PH_POOL, PH_NA,
  PH_OUTPROJ, PH_NORM2, PH_QGEMM, PH_TOPK, PH_GATHER, PH_FINAL
};

#define SMEM_BYTES 131072

__device__ __forceinline__ void run_phase(int wv, const Params& P, int ph, int layer, char* smem, int bid, int nb) {
  const float* hl = layer == 0 ? P.x : P.h();
  const float* hc = layer == 0 ? P.ctx : P.h() + (size_t)NLAT * DM;
  const int nrows = layer == 0 ? NTOK : NLAT;
  switch (ph) {
    case PH_PREP:
      for (int i = bid * NTHR + otid(wv); i < 2 * 8 * 2 * 128 * 128; i += nb * NTHR) P.keysb()[i] = f2bf(P.peer_keys[i]);
      for (int i = bid * NTHR + otid(wv); i < 2 * 4 * 128 * 128; i += nb * NTHR) {
        const int k = i & 127, n = (i >> 7) & 127, lg = i >> 14;
        P.poolwT()[i] = f2bf(P.pool_w[((size_t)lg * 128 + k) * 128 + n]);
      }
      ph_mod(wv, P, (float*)smem, bid, nb);
      for (int l = 0; l < 2; ++l) {
        ph_transpose(wv, P.w_in + (size_t)l * 1024 * INW, P.w_inT() + (size_t)l * PW * 1024, 1024, INW, PW, 0, 2560, 32, PW, (float*)smem, bid, nb);
        ph_transpose(wv, P.w_in + (size_t)l * 1024 * INW, P.w_dtT() + (size_t)l * 128 * 1024, 1024, INW, 128, 2560, 1 << 30, 0, 32, (float*)smem, bid, nb);
        ph_transpose(wv, P.w_out + (size_t)l * 2048 * 1024, P.w_outT() + (size_t)l * 1024 * 2048, 2048, 1024, 1024, 0, 1 << 30, 0, 1024, (float*)smem, bid, nb);
        ph_transpose(wv, P.peer_wq + (size_t)l * 1024 * 2048, P.w_qT() + (size_t)l * 2048 * 1024, 1024, 2048, 2048, 0, 1 << 30, 0, 2048, (float*)smem, bid, nb);
      }
      break;
    case PH_NORM1:
      ph_norm(wv, hl, hc, P.norm1_g + layer * 1024, P.mod() + (size_t)layer * 5 * MODW, 0, 1024, NTOK, P.u(), bid, nb);
      break;
    case PH_INPROJ:
    {
      pg8::Gemm g{P.u(), P.w_inT() + (size_t)layer * PW * 1024, NTOK, PW, 1024};
      pg8::StaticOrder S; S.init(g.M, g.N, nb, bid);
      pg8::EpiBf16<0> E{P.p(), PW, nullptr, 0, 0};
      pg8::gemm_phase<pg8::EpiBf16<0>, pg8::StaticOrder, false>(wv, (PG8_LAS unsigned char*)smem, g, S, E, nullptr);
      ph_gemm<EPI_INPROJ>(wv, P, layer, P.u(), P.w_dtT() + (size_t)layer * 128 * 1024, NTOK, 128, 1024, hl, hc, smem, bid, nb);
      break;
    }
    case PH_CONV: ph_conv(wv, P, layer, bid, nb); ph_vtranspose(wv, P, smem, bid, nb); break;
    case PH_SSDPREP: ph_ssdprep(wv, P, layer, smem, bid, nb); break;
    case PH_STATES: ph_states_mfma(wv, P, layer, smem, bid, nb); break;
    case PH_SCAN: ph_scan(wv, P, bid, nb); break;
    case PH_SSDY: ph_ssdy_mfma(wv, P, layer, nrows / 128, smem, bid, nb); break;
    case PH_SSDNORM: ph_ssdnorm(wv, P, layer, nrows, bid, nb); break;
    case PH_POOL: ph_pool_mfma(wv, P, layer, nrows, bid, nb); break;
    case PH_NA: ph_na_mfma(wv, P, layer, nrows, smem, bid, nb); break;
    case PH_OUTPROJ:
    {
      pg8::Gemm g{P.concat(), P.w_outT() + (size_t)layer * 1024 * 2048, nrows, 1024, 2048};
      pg8::StaticOrder S; S.init(g.M, g.N, nb, bid);
      EpiOutproj E{P.h(), hl, hc, P.mod() + (size_t)layer * 5 * MODW};
      pg8::gemm_phase<EpiOutproj, pg8::StaticOrder, false>(wv, (PG8_LAS unsigned char*)smem, g, S, E, nullptr);
      break;
    }
    case PH_NORM2:
      ph_norm(wv, P.h(), P.h() + (size_t)NLAT * DM, P.norm2_g + layer * 1024, P.mod() + (size_t)layer * 5 * MODW, 3072, 4096, nrows, P.u(), bid, nb);
      break;
    case PH_QGEMM:
    {
      pg8::Gemm g{P.u(), P.w_qT() + (size_t)layer * 2048 * 1024, nrows, 2048, 1024};
      pg8::StaticOrder S; S.init(g.M, g.N, nb, bid);
      pg8::EpiBf16<0> E{P.q(), 2048, nullptr, 0, 0};
      pg8::gemm_phase<pg8::EpiBf16<0>, pg8::StaticOrder, false>(wv, (PG8_LAS unsigned char*)smem, g, S, E, nullptr);
      ph_convert_tables(wv, P, layer, bid, nb);
      break;
    }
    case PH_TOPK: ph_peer_topk_mfma(wv, P, layer, nrows, smem, bid, nb); break;
    case PH_GATHER: ph_peer_gather(wv, P, layer, nrows, bid, nb); break;
    case PH_FINAL: ph_final(wv, P, bid, nb); break;
  }
}

namespace cg = cooperative_groups;
typedef const __attribute__((address_space(4))) Params* kparams_t;
__device__ __forceinline__ const Params& kp_fresh() {
  kparams_t kp = (kparams_t)__builtin_amdgcn_kernarg_segment_ptr();
  asm volatile("" : "+s"(kp));
  return *(const Params*)kp;
}
__global__ void __launch_bounds__(NTHR) k_mega(Params P_unused) {
  __shared__ __attribute__((aligned(16))) char smem[SMEM_BYTES + 16];
  cg::grid_group grid = cg::this_grid();
  const int bid = blockIdx.x, nb = gridDim.x;
  const int wv = __builtin_amdgcn_readfirstlane(threadIdx.x >> 6);
  if (threadIdx.x == 0) *(uint4*)(smem + SMEM_BYTES) = make_uint4(0u, 0u, 0u, 0u);
  __syncthreads();
  (void)xcd_barrier_post((unsigned*)(kp_fresh().ws + WS_BAR), (volatile LAS unsigned*)(smem + SMEM_BYTES), threadIdx.x == 0);
#define GSYNC() do { XcdBarrier xb_; xb_.bar = (unsigned*)(kp_fresh().ws + WS_BAR); xb_.x = xb_xcc_id(); \
    xb_.st = (volatile LAS unsigned*)(smem + SMEM_BYTES); xcd_barrier(xb_, otid(wv) == 0); } while (0)
  run_phase(wv, kp_fresh(), PH_PREP, 0, smem, bid, nb);
  grid.sync();
  run_phase(wv, kp_fresh(), PH_NORM1, 0, smem, bid, nb); GSYNC();
#pragma unroll 1
  for (int layer = 0; layer < 2; ++layer) {
    run_phase(wv, kp_fresh(), PH_INPROJ, layer, smem, bid, nb); GSYNC();
    run_phase(wv, kp_fresh(), PH_CONV, layer, smem, bid, nb);
    run_phase(wv, kp_fresh(), PH_SSDPREP, layer, smem, bid, nb); GSYNC();
    run_phase(wv, kp_fresh(), PH_CONV, layer, smem, bid, nb);
    run_phase(wv, kp_fresh(), PH_SSDPREP, layer, smem, bid, nb); GSYNC();
    run_phase(wv, kp_fresh(), PH_STATES, layer, smem, bid, nb);
    run_phase(wv, kp_fresh(), PH_POOL, layer, smem, bid, nb);
    run_phase(wv, kp_fresh(), PH_NA, layer, smem, bid, nb); GSYNC();
    run_phase(wv, kp_fresh(), PH_SCAN, layer, smem, bid, nb); GSYNC();
    run_phase(wv, kp_fresh(), PH_SSDY, layer, smem, bid, nb); GSYNC();
    run_phase(wv, kp_fresh(), PH_SSDNORM, layer, smem, bid, nb); GSYNC();
    run_phase(wv, kp_fresh(), PH_OUTPROJ, layer, smem, bid, nb); GSYNC();
    run_phase(wv, kp_fresh(), PH_NORM2, layer, smem, bid, nb); GSYNC();
    run_phase(wv, kp_fresh(), PH_QGEMM, layer, smem, bid, nb); GSYNC();
    run_phase(wv, kp_fresh(), PH_TOPK, layer, smem, bid, nb); GSYNC();
    run_phase(wv, kp_fresh(), PH_GATHER, layer, smem, bid, nb);
    if (layer == 0) GSYNC();
  }
}

extern "C" void kernel_launch(void* const* d_in, const int* in_sizes, int n_in, void* d_out, int out_size, void* d_ws,
                              size_t ws_size, hipStream_t stream) {
  Params P{};
  const float* const* in = (const float* const*)d_in;
  P.x = in[0]; P.c = in[1]; P.ctx = in[2]; P.c_ctx = in[3]; P.ada_w = in[4]; P.ada_b = in[5]; P.norm1_g = in[6];
  P.w_in = in[7]; P.conv_w = in[8]; P.conv_b = in[9]; P.a_log = in[10]; P.dt_bias = in[11]; P.d_skip = in[12];
  P.ssd_norm_g = in[13]; P.pool_w = in[14]; P.pool_scale = in[15]; P.na_rpb = in[16]; P.w_out = in[17];
  P.norm2_g = in[18]; P.peer_wq = in[19]; P.peer_keys = in[20]; P.peer_u = in[21]; P.peer_v = in[22]; P.final_g = in[23];
  P.out = (float*)d_out;
  P.ws = (char*)d_ws;
  if (WS_TOTAL > ws_size) { fprintf(stderr, "workspace too small: need %zu have %zu\n", (size_t)WS_TOTAL, ws_size); return; }

  static int grid_blocks = 0;
  if (!grid_blocks) {
    int dev = 0, cus = 0, per_cu = 0;
    hipGetDevice(&dev);
    hipDeviceGetAttribute(&cus, hipDeviceAttributeMultiprocessorCount, dev);
    hipOccupancyMaxActiveBlocksPerMultiprocessor(&per_cu, k_mega, NTHR, 0);
    if (per_cu > 4) per_cu = 4;
    grid_blocks = cus * per_cu;
  }
  hipMemsetAsync((char*)d_ws + WS_BAR, 0, 4096 * 4, stream);
  void* args[] = {&P};
  hipError_t e = hipLaunchCooperativeKernel((void*)k_mega, dim3(grid_blocks), dim3(NTHR), args, 0, stream);
  if (e != hipSuccess) fprintf(stderr, "cooperative launch failed: %s (grid %d)\n", hipGetErrorString(e), grid_blocks);
}
```

```cpp
#include <hip/hip_runtime.h>
#include <hip/hip_bf16.h>
#include <hip/hip_cooperative_groups.h>
#include <stdint.h>
#include <stdio.h>

typedef unsigned short bf16_t;
typedef __attribute__((ext_vector_type(8))) short bf16x8;
typedef __attribute__((ext_vector_type(4))) float f32x4;

#define NTHR 512
#define NWAVE 8
constexpr int DM = 1024;
constexpr int SEQ = 4096;
constexpr int NLAT = 16384;
constexpr int NCTXR = 1024;
constexpr int NTOK = 17408;
constexpr int INW = 4640;
constexpr int PW = 4608;
constexpr int OFF_Z = 0, OFF_XBC = 1024, OFF_POOL = 2560, OFF_Q = 3072, OFF_K = 3584, OFF_V = 4096;
constexpr int NCHUNK = 136;
constexpr int MODW = 6144;

constexpr size_t al256(size_t x) { return (x + 255) & ~(size_t)255; }
constexpr size_t WS_MOD = 0;
constexpr size_t WS_H = WS_MOD + al256((size_t)2 * 5 * MODW * 4);
constexpr size_t WS_P = WS_H + al256((size_t)NTOK * DM * 4);
constexpr size_t WS_TABU = WS_P + (size_t)80 * 1024 * 1024;
constexpr size_t WS_TABV = WS_TABU + (size_t)16384 * 512;
constexpr size_t WS_INVU = WS_TABV + (size_t)16384 * 512;
constexpr size_t WS_INVV = WS_INVU + (size_t)16384 * 4;
constexpr size_t WS_DTRAW = WS_P + al256((size_t)NTOK * PW * 2);
constexpr size_t WS_DTV = WS_DTRAW + al256((size_t)NTOK * 32 * 4);
constexpr size_t WS_CSV = WS_DTV + al256((size_t)NTOK * 32 * 4);
constexpr size_t WS_XBC = WS_CSV + al256((size_t)NTOK * 32 * 4);
constexpr size_t WS_VTL = WS_XBC + al256((size_t)NTOK * 512 * 2);
constexpr size_t WS_VTC = WS_VTL + al256((size_t)4 * 8 * 64 * 4096 * 2);
constexpr size_t WS_KEYSB = WS_VTC + al256((size_t)4 * 8 * 64 * 256 * 2);
constexpr size_t WS_POOLWT = WS_KEYSB + al256((size_t)2 * 8 * 2 * 128 * 128 * 2);
constexpr size_t WS_STATES = WS_XBC + al256((size_t)NTOK * 1536 * 2);
static_assert(WS_POOLWT + (size_t)2 * 4 * 128 * 128 * 2 <= WS_STATES, "must fit in the old xbc region");
constexpr size_t WS_CONCAT = WS_STATES + al256((size_t)NCHUNK * 32 * 8192 * 2);
constexpr size_t WS_SELIDX = WS_CONCAT + al256((size_t)NTOK * 2048 * 2);
constexpr size_t WS_SELG = WS_SELIDX + al256((size_t)NTOK * 128 * 4);
constexpr size_t WS_WINT = WS_SELG + al256((size_t)NTOK * 128 * 4);
constexpr size_t WS_WDTT = WS_WINT + al256((size_t)2 * PW * 1024 * 2);
constexpr size_t WS_WOUTT = WS_WDTT + al256((size_t)2 * 128 * 1024 * 2);
constexpr size_t WS_WQT = WS_WOUTT + al256((size_t)2 * 1024 * 2048 * 2);
constexpr size_t WS_BAR = WS_WQT + al256((size_t)2 * 2048 * 1024 * 2);
constexpr size_t WS_TOTAL = WS_BAR + al256((size_t)4096 * 4);
static_assert(WS_INVV + (size_t)16384 * 4 <= WS_DTRAW, "tables must fit in the tail of p");
static_assert((size_t)NTOK * 2048 * 2 <= (size_t)80 * 1024 * 1024, "q must fit below the tables");

struct Params {
  const float *x, *c, *ctx, *c_ctx, *ada_w, *ada_b, *norm1_g, *w_in, *conv_w, *conv_b, *a_log, *dt_bias, *d_skip,
      *ssd_norm_g, *pool_w, *pool_scale, *na_rpb, *w_out, *norm2_g, *peer_wq, *peer_keys, *peer_u, *peer_v, *final_g;
  float* out;
  char* ws;
  __device__ __forceinline__ float* mod() const { return (float*)(ws + WS_MOD); }
  __device__ __forceinline__ float* h() const { return (float*)(ws + WS_H); }
  __device__ __forceinline__ bf16_t* u() const { return (bf16_t*)(ws + WS_CONCAT); }
  __device__ __forceinline__ bf16_t* p() const { return (bf16_t*)(ws + WS_P); }
  __device__ __forceinline__ float* dtraw() const { return (float*)(ws + WS_DTRAW); }
  __device__ __forceinline__ float* dtv() const { return (float*)(ws + WS_DTV); }
  __device__ __forceinline__ float* csv() const { return (float*)(ws + WS_CSV); }
  __device__ __forceinline__ bf16_t* xbc() const { return (bf16_t*)(ws + WS_XBC); }
  __device__ __forceinline__ bf16_t* states() const { return (bf16_t*)(ws + WS_STATES); }
  __device__ __forceinline__ bf16_t* concat() const { return (bf16_t*)(ws + WS_CONCAT); }
  __device__ __forceinline__ bf16_t* q() const { return (bf16_t*)(ws + WS_P); }
  __device__ __forceinline__ int* sel_idx() const { return (int*)(ws + WS_SELIDX); }
  __device__ __forceinline__ float* sel_g() const { return (float*)(ws + WS_SELG); }
  __device__ __forceinline__ bf16_t* w_inT() const { return (bf16_t*)(ws + WS_WINT); }
  __device__ __forceinline__ bf16_t* w_dtT() const { return (bf16_t*)(ws + WS_WDTT); }
  __device__ __forceinline__ bf16_t* w_outT() const { return (bf16_t*)(ws + WS_WOUTT); }
  __device__ __forceinline__ bf16_t* w_qT() const { return (bf16_t*)(ws + WS_WQT); }
  __device__ __forceinline__ bf16_t* vtl() const { return (bf16_t*)(ws + WS_VTL); }
  __device__ __forceinline__ bf16_t* vtc() const { return (bf16_t*)(ws + WS_VTC); }
  __device__ __forceinline__ bf16_t* poolwT() const { return (bf16_t*)(ws + WS_POOLWT); }
  __device__ __forceinline__ bf16_t* keysb() const { return (bf16_t*)(ws + WS_KEYSB); }
  __device__ __forceinline__ unsigned char* tabU() const { return (unsigned char*)(ws + WS_TABU); }
  __device__ __forceinline__ unsigned char* tabV() const { return (unsigned char*)(ws + WS_TABV); }
  __device__ __forceinline__ float* invU() const { return (float*)(ws + WS_INVU); }
  __device__ __forceinline__ float* invV() const { return (float*)(ws + WS_INVV); }
};

__device__ __forceinline__ int otid(int wv) {
  int l;
  asm volatile("v_mbcnt_lo_u32_b32 %0, -1, 0\n\tv_mbcnt_hi_u32_b32 %0, -1, %0" : "=v"(l));
  return (wv << 6) | l;
}
__device__ __forceinline__ float bf2f(bf16_t v) { return __uint_as_float(((uint32_t)v) << 16); }
__device__ __forceinline__ bf16_t f2bf(float f) {
  uint32_t u = __float_as_uint(f);
  u += 0x7fffu + ((u >> 16) & 1u);
  return (bf16_t)(u >> 16);
}
#define DPP_F(v, ctrl) __int_as_float(__builtin_amdgcn_update_dpp(0, __float_as_int(v), (ctrl), 0xf, 0xf, true))
__device__ __forceinline__ float wave_sum(float v) {
  v += DPP_F(v, 0xB1);
  v += DPP_F(v, 0x4E);
  v += DPP_F(v, 0x141);
  v += DPP_F(v, 0x140);
  const int iv = __float_as_int(v);
  return __int_as_float(__builtin_amdgcn_readlane(iv, 0)) + __int_as_float(__builtin_amdgcn_readlane(iv, 16)) +
         __int_as_float(__builtin_amdgcn_readlane(iv, 32)) + __int_as_float(__builtin_amdgcn_readlane(iv, 48));
}
__device__ __forceinline__ float wave_max(float v) {
  v = fmaxf(v, DPP_F(v, 0xB1));
  v = fmaxf(v, DPP_F(v, 0x4E));
  v = fmaxf(v, DPP_F(v, 0x141));
  v = fmaxf(v, DPP_F(v, 0x140));
  const int iv = __float_as_int(v);
  return fmaxf(fmaxf(__int_as_float(__builtin_amdgcn_readlane(iv, 0)), __int_as_float(__builtin_amdgcn_readlane(iv, 16))),
               fmaxf(__int_as_float(__builtin_amdgcn_readlane(iv, 32)), __int_as_float(__builtin_amdgcn_readlane(iv, 48))));
}
__device__ __forceinline__ float silu_f(float v) { return v / (1.f + expf(-v)); }
__device__ __forceinline__ float softplus_f(float v) { return fmaxf(v, 0.f) + log1pf(expf(-fabsf(v))); }
__device__ __forceinline__ float gelu_f(float v) { return 0.5f * v * (1.f + erff(v * 0.70710678118654752f)); }

__device__ __forceinline__ void unpack8(const uint4 v, float* f) {
  f[0] = __uint_as_float(v.x << 16); f[1] = __uint_as_float(v.x & 0xffff0000u);
  f[2] = __uint_as_float(v.y << 16); f[3] = __uint_as_float(v.y & 0xffff0000u);
  f[4] = __uint_as_float(v.z << 16); f[5] = __uint_as_float(v.z & 0xffff0000u);
  f[6] = __uint_as_float(v.w << 16); f[7] = __uint_as_float(v.w & 0xffff0000u);
}
__device__ __forceinline__ uint32_t pack2(float a, float b) { return (uint32_t)f2bf(a) | ((uint32_t)f2bf(b) << 16); }
typedef float f32x2_t __attribute__((ext_vector_type(2)));
typedef unsigned u32x4_t __attribute__((ext_vector_type(4)));
typedef short s16x4 __attribute__((ext_vector_type(4)));
typedef __attribute__((address_space(3))) s16x4 lds_s16x4;
__device__ __forceinline__ bf16x8 tr_read2(const char* a0, const char* a1) {
  const s16x4 a = __builtin_amdgcn_ds_read_tr16_b64_v4i16((lds_s16x4*)a0);
  const s16x4 b = __builtin_amdgcn_ds_read_tr16_b64_v4i16((lds_s16x4*)a1);
  return (bf16x8){a[0], a[1], a[2], a[3], b[0], b[1], b[2], b[3]};
}

__device__ __forceinline__ const float* hrow(const float* hl, const float* hc, int row) {
  return row < NLAT ? hl + (size_t)row * DM : hc + (size_t)(row - NLAT) * DM;
}
__device__ __forceinline__ int modrow(int row) { return row < NLAT ? (row >> 12) : 4; }

namespace pg8 {
#define PG8_LAS __attribute__((address_space(3)))
typedef unsigned short bf16_t;
typedef short bf16x8 __attribute__((ext_vector_type(8)));
typedef float f32x4 __attribute__((ext_vector_type(4)));
typedef unsigned u32x4 __attribute__((ext_vector_type(4)));
constexpr int BM = 256, BK = 64, HALF = 128, HTB = HALF * BK * 2  , STAGE_BYTES = 8 * HTB, NXCD = 8, WGM = 8;

__host__ __device__ __forceinline__ int lds_byte(int r, int c) { const int st = (r >> 4) * 2 + (c >> 5), rr = r & 15, cc = c & 31, ob = rr * 64 + cc * 2; return st * 1024 + (ob ^ (((ob >> 9) & 1) << 5)); }
__host__ __device__ __forceinline__ void stage_rc(int b, int& R, int& C) { const int st = b / 1024, sb = b % 1024, swz = sb ^ (((sb >> 9) & 1) << 5); R = (st >> 1) * 16 + swz / 64; C = (st & 1) * 32 + (swz % 64) / 2; }
__host__ __device__ __forceinline__ int perm32(int rho) { const int n = rho >> 4, i = rho & 15; return 8 * (i >> 2) + 4 * n + (i & 3); }

struct Unit { int pm, pn; };
struct Gemm { const bf16_t* A; const bf16_t* Bt; int M, N, K; };

struct StaticOrder {
    int nM, nN, nwg, G, c;
    __host__ __device__ void init(int M, int N, int G_, int c_) { nM = M / BM; nN = N / BM; nwg = nM * nN; G = G_; c = c_; }
    __host__ __device__ bool next(int i, Unit& u) const {
        const long L = (long)i * G + c; if (L >= nwg) return false;
        int wgid = (int)L; { const int q = nwg / NXCD, r = nwg % NXCD, xcd = wgid % NXCD, off = wgid / NXCD; wgid = (xcd < r ? xcd * (q + 1) : r * (q + 1) + (xcd - r) * q) + off; }
        const int nig = WGM * nN, gid = wgid / nig, fm = gid * WGM, gsz = (nM - fm) < WGM ? (nM - fm) : WGM;
        u.pm = fm + ((wgid % nig) % gsz); u.pn = (wgid % nig) / gsz; return true;
    }
    __device__ __forceinline__ void a_ready(const Unit&) const {}
    __device__ __forceinline__ void done(const Unit&) const {}
};

__device__ __forceinline__ unsigned cvt_pk_bf16(float lo, float hi) { unsigned r; asm volatile("v_cvt_pk_bf16_f32 %0, %1, %2" : "=v"(r) : "v"(lo), "v"(hi)); return r; }
typedef float f32x2 __attribute__((ext_vector_type(2)));
__device__ __forceinline__ f32x2 gelu_pk(f32x2 v) { return v; }
template <int ACT  > struct EpiBf16 {
    static constexpr bool PERM = true, AFTER_DRAIN = false;
    bf16_t* O; int ldc; const float* bias; int split_cols; size_t split_stride;
    __device__ __forceinline__ void operator()(const f32x4 (&acc)[2][2][4][2], const Unit& u, int wr, int wc, int fr, int fq) const {
        const int row0 = u.pm * BM + wr * 64 + fr; int colt = u.pn * BM; bf16_t* base = O;
        if (split_cols) { const int t = colt / split_cols; base += (size_t)t * split_stride; colt -= t * split_cols; }
        const int col0 = colt + wc * 32 + 8 * fq, bcol0 = u.pn * BM + wc * 32 + 8 * fq;
        f32x4 bv[2][2];
#pragma unroll
        for (int bj = 0; bj < 2; ++bj)
#pragma unroll
            for (int n = 0; n < 2; ++n) bv[bj][n] = bias ? *(const f32x4*)(bias + bcol0 + bj * HALF + 4 * n) : (f32x4){0.f, 0.f, 0.f, 0.f};
#pragma unroll
        for (int ai = 0; ai < 2; ++ai)
#pragma unroll
            for (int m = 0; m < 4; ++m) { bf16_t* rowp = base + (size_t)(row0 + ai * HALF + m * 16) * ldc + col0;
#pragma unroll
                for (int bj = 0; bj < 2; ++bj) { f32x4 v0 = acc[ai][bj][m][0] + bv[bj][0], v1 = acc[ai][bj][m][1] + bv[bj][1];
                    if (ACT == 1) { f32x2 a = gelu_pk((f32x2){v0[0], v0[1]}), b = gelu_pk((f32x2){v0[2], v0[3]}), c = gelu_pk((f32x2){v1[0], v1[1]}), d = gelu_pk((f32x2){v1[2], v1[3]});
                        v0 = (f32x4){a.x, a.y, b.x, b.y}; v1 = (f32x4){c.x, c.y, d.x, d.y}; }
                    if (ACT == 2) {
#pragma unroll
                        for (int j = 0; j < 4; ++j) { v0[j] = 0.5f * v0[j] * (1.0f + erff(v0[j] * 0.70710678f)); v1[j] = 0.5f * v1[j] * (1.0f + erff(v1[j] * 0.70710678f)); } }
                    u32x4 w; w.x = cvt_pk_bf16(v0[0], v0[1]); w.y = cvt_pk_bf16(v0[2], v0[3]); w.z = cvt_pk_bf16(v1[0], v1[1]); w.w = cvt_pk_bf16(v1[2], v1[3]);
                    *(u32x4*)(rowp + bj * HALF) = w; } }
    }
};

template <class Epi, class Sched, bool STAMP = false>
__device__ __forceinline__ void gemm_phase(int wv, PG8_LAS unsigned char* lds, const Gemm g, const Sched& S, const Epi& E, unsigned long long* stamps) {
    const int tid = otid(wv), wid = __builtin_amdgcn_readfirstlane(tid >> 6), lane = tid & 63, wr = wid >> 2, wc = wid & 3, fr = lane & 15, fq = lane >> 4;
    const int K = g.K, nt = K / BK;
    int ts_lo = 0, ts_hi = 0, nts = 0; const unsigned long long rt_entry = STAMP ? (unsigned long long)wall_clock64() : 0ull;
#define PG8_STAMP() do { if (STAMP && wid == 0 && nts < 64) { const unsigned long long _c = (unsigned long long)clock64(); \
        ts_lo = (lane == nts) ? (int)(unsigned)_c : ts_lo; ts_hi = (lane == nts) ? (int)(unsigned)(_c >> 32) : ts_hi; ++nts; } } while (0)
    PG8_STAMP();
    unsigned voffA[2], voffB[2];
#pragma unroll
    for (int i = 0; i < 2; ++i) { int R, C; stage_rc(tid * 16 + i * 8192, R, C); const int Rb = Epi::PERM ? ((R & ~31) + perm32(R & 31)) : R;
        voffA[i] = (unsigned)(R * K + C) * 2u; voffB[i] = (unsigned)(Rb * K + C) * 2u; }
    const size_t kstep = (size_t)(BK * 2);
    const size_t hstep = (size_t)HALF * K * 2;
    const size_t tstep = 2 * hstep;
    const unsigned ldsw = (unsigned)wid * 1024u;
    const int aoff = lds_byte(wr * 64 + fr, fq * 8), boff = lds_byte(wc * 32 + fr, fq * 8);
#define PG8_SA(b, h) (((b) * 2 + (h)) * HTB)
#define PG8_SB(b, h) ((4 + (b) * 2 + (h)) * HTB)
#define PG8_STAGE(bufoff, gbase, voff) do { _Pragma("unroll") for (int _i = 0; _i < 2; ++_i) \
        __builtin_amdgcn_global_load_lds((const unsigned*)((const char*)(gbase) + (voff)[_i]), (PG8_LAS unsigned*)(lds + (bufoff) + ldsw + _i * 8192), 16, 0, 0); } while (0)
#define PG8_LDA(dst, b, h) do { _Pragma("unroll") for (int m = 0; m < 4; ++m) _Pragma("unroll") for (int k = 0; k < 2; ++k) dst[m][k] = *(const PG8_LAS bf16x8*)(lds + PG8_SA(b, h) + aoff + m * 2048 + k * 1024); } while (0)
#define PG8_LDB(dst, b, h) do { _Pragma("unroll") for (int n = 0; n < 2; ++n) _Pragma("unroll") for (int k = 0; k < 2; ++k) dst[n][k] = *(const PG8_LAS bf16x8*)(lds + PG8_SB(b, h) + boff + n * 2048 + k * 1024); } while (0)
#define PG8_MMA(ai, bj, At, Bt) do { __builtin_amdgcn_s_setprio(1); _Pragma("unroll") for (int m = 0; m < 4; ++m) _Pragma("unroll") for (int n = 0; n < 2; ++n) _Pragma("unroll") for (int k = 0; k < 2; ++k) \
        acc[ai][bj][m][n] = __builtin_amdgcn_mfma_f32_16x16x32_bf16(Bt[n][k], At[m][k], acc[ai][bj][m][n], 0, 0, 0); __builtin_amdgcn_s_setprio(0); } while (0)
#define PG8_WAIT_V(n) asm volatile("s_waitcnt vmcnt(" #n ")" ::: "memory")
#define PG8_WAIT_L(n) asm volatile("s_waitcnt lgkmcnt(" #n ")" ::: "memory")
#define PG8_BAR __builtin_amdgcn_s_barrier()
#define PG8_SCHED __builtin_amdgcn_sched_barrier(0)
    Unit cur, nxt; int ui = 0;
    if (!S.next(0, cur)) return;
    f32x4 acc[2][2][4][2];
#pragma unroll
    for (int a = 0; a < 2; ++a)
#pragma unroll
        for (int b = 0; b < 2; ++b)
#pragma unroll
            for (int m = 0; m < 4; ++m)
#pragma unroll
                for (int n = 0; n < 2; ++n) acc[a][b][m][n] = (f32x4){0.f, 0.f, 0.f, 0.f};
    bf16x8 At[4][2], B0[2][2], B1[2][2];
    const char* cA = (const char*)g.A + (size_t)cur.pm * tstep; const char* cB = (const char*)g.Bt + (size_t)cur.pn * tstep;
    S.a_ready(cur);
    PG8_STAGE(PG8_SB(0, 0), cB, voffB); PG8_STAGE(PG8_SA(0, 0), cA, voffA); PG8_STAGE(PG8_SB(0, 1), cB + hstep, voffB); PG8_STAGE(PG8_SA(0, 1), cA + hstep, voffA);
    if (wr == 1) PG8_BAR;
    PG8_WAIT_V(4); PG8_BAR;
    PG8_STAGE(PG8_SB(1, 0), cB + kstep, voffB); PG8_STAGE(PG8_SA(1, 0), cA + kstep, voffA); PG8_STAGE(PG8_SB(1, 1), cB + hstep + kstep, voffB);
    PG8_WAIT_V(6); PG8_BAR;
    PG8_STAMP();
    for (;;) {
        const bool has_next = S.next(ui + 1, nxt);
        const char* nA = has_next ? (const char*)g.A + (size_t)nxt.pm * tstep : cA; const char* nB = has_next ? (const char*)g.Bt + (size_t)nxt.pn * tstep : cB;
        for (int t = 0; t < nt; t += 2) {
            const bool last = (t == nt - 2);
            const char* a1 = cA + (size_t)(t + 1) * kstep;
            const char* a2 = last ? nA : cA + (size_t)(t + 2) * kstep; const char* b2 = last ? nB : cB + (size_t)(t + 2) * kstep;
            const char* a3 = a2 + kstep; const char* b3 = b2 + kstep;
            if (last && has_next) S.a_ready(nxt);
            PG8_LDB(B0, 0, 0); PG8_SCHED; PG8_LDA(At, 0, 0); PG8_STAGE(PG8_SA(1, 1), a1 + hstep, voffA);
            PG8_WAIT_L(8); PG8_BAR; PG8_WAIT_L(0); PG8_MMA(0, 0, At, B0); PG8_BAR; PG8_SCHED;
            PG8_LDB(B1, 0, 1); PG8_STAGE(PG8_SB(0, 0), b2, voffB);
            PG8_BAR; PG8_WAIT_L(0); PG8_MMA(0, 1, At, B1); PG8_BAR;
            PG8_LDA(At, 0, 1); PG8_STAGE(PG8_SA(0, 0), a2, voffA);
            PG8_BAR; PG8_WAIT_L(0); PG8_MMA(1, 0, At, B0); PG8_BAR; PG8_SCHED;
            PG8_STAGE(PG8_SB(0, 1), b2 + hstep, voffB);
            PG8_WAIT_V(6); PG8_BAR; PG8_MMA(1, 1, At, B1); PG8_BAR;
            PG8_LDB(B0, 1, 0); PG8_SCHED; PG8_LDA(At, 1, 0); PG8_STAGE(PG8_SA(0, 1), a2 + hstep, voffA);
            PG8_WAIT_L(8); PG8_BAR; PG8_WAIT_L(0); PG8_MMA(0, 0, At, B0); PG8_BAR; PG8_SCHED;
            PG8_LDB(B1, 1, 1); PG8_STAGE(PG8_SB(1, 0), b3, voffB);
            PG8_BAR; PG8_WAIT_L(0); PG8_MMA(0, 1, At, B1); PG8_BAR;
            PG8_LDA(At, 1, 1); PG8_STAGE(PG8_SA(1, 0), a3, voffA);
            PG8_BAR; PG8_WAIT_L(0); PG8_MMA(1, 0, At, B0); PG8_BAR; PG8_SCHED;
            PG8_STAGE(PG8_SB(1, 1), b3 + hstep, voffB);
            PG8_WAIT_V(6); PG8_BAR; PG8_MMA(1, 1, At, B1); PG8_BAR;
        }
        PG8_STAMP();
        if constexpr (!Epi::AFTER_DRAIN) { E(acc, cur, wr, wc, fr, fq); S.done(cur); }
        PG8_STAMP();
        if (!has_next) break;
#pragma unroll
        for (int a = 0; a < 2; ++a)
#pragma unroll
            for (int b = 0; b < 2; ++b)
#pragma unroll
                for (int m = 0; m < 4; ++m)
#pragma unroll
                    for (int n = 0; n < 2; ++n) acc[a][b][m][n] = (f32x4){0.f, 0.f, 0.f, 0.f};
        cur = nxt; cA = nA; cB = nB; ++ui;
    }
    PG8_WAIT_V(0);
    if (wr == 0) PG8_BAR;
    PG8_BAR;
    if constexpr (Epi::AFTER_DRAIN) { E.fused(acc, cur, wr, wc, fr, fq, lds, wid, lane); S.done(cur); }
    PG8_STAMP();
    if (STAMP && wid == 0) { stamps[lane] = lane < nts ? (((unsigned long long)(unsigned)ts_hi << 32) | (unsigned)ts_lo) : 0ull;
        if (lane == 62) stamps[62] = rt_entry; if (lane == 63) stamps[63] = (unsigned long long)wall_clock64(); }
#undef PG8_STAMP
#undef PG8_SA
#undef PG8_SB
#undef PG8_STAGE
#undef PG8_LDA
#undef PG8_LDB
#undef PG8_MMA
#undef PG8_WAIT_V
#undef PG8_WAIT_L
#undef PG8_BAR
#undef PG8_SCHED
}
}

#define XB_TMO      128
#define XB_XCNT(j)  (256  + 64 * (j))
#define XB_XSUB(j)  (1280 + 64 * (j))
#define XB_XGEN(j)  (2304 + 64 * (j))
#define XB_TOP      3328
#define XB_TOPGEN   3392
#define XCD_BAR_WORDS 3456
#define XB_SPIN_CAP (1u << 27)
#define LAS __attribute__((address_space(3)))

__device__ __forceinline__ unsigned xb_ld(unsigned* p)              { return __hip_atomic_load(p, __ATOMIC_RELAXED, __HIP_MEMORY_SCOPE_AGENT); }
__device__ __forceinline__ unsigned xb_add(unsigned* p, unsigned v) { return __hip_atomic_fetch_add(p, v, __ATOMIC_RELAXED, __HIP_MEMORY_SCOPE_AGENT); }
__device__ __forceinline__ unsigned xb_xcc_id() { return (unsigned)__builtin_amdgcn_s_getreg((3 << 11) | 20) & 0xFu; }
#define XB_SPIN(cond, bar) do { unsigned _sp = 0; while (cond) { __builtin_amdgcn_s_sleep(1); \
    if ((++_sp & 255u) == 0u) { if (xb_ld(&(bar)[XB_TMO])) break; if (_sp > XB_SPIN_CAP) { atomicAdd(&(bar)[XB_TMO], 1u); break; } } } } while (0)

struct XcdBarrier {
    unsigned* bar; unsigned x;
    volatile LAS unsigned* st;
};

__device__ __forceinline__ XcdBarrier xcd_barrier_post(unsigned* bar, volatile LAS unsigned* st, bool xb_t0) {
    XcdBarrier b; b.bar = bar; b.x = xb_xcc_id(); b.st = st;
    if (xb_t0) (void)xb_add(&bar[XB_XCNT(b.x)], 1u);
    return b;
}
__device__ __forceinline__ void xcd_barrier_complete(unsigned* bar, unsigned x, unsigned& nloc, unsigned& nx) {
    const unsigned G = gridDim.x * gridDim.y * gridDim.z;
    unsigned sum, cnt, mine, sp = 0u;
    for (;;) {
        sum = 0u; cnt = 0u; mine = 0u;
#pragma unroll
        for (unsigned j = 0; j < 16; ++j) { const unsigned c = xb_ld(&bar[XB_XCNT(j)]); sum += c; cnt += (c > 0u) ? 1u : 0u; mine = (j == x) ? c : mine; }
        if (sum == G) break;
        __builtin_amdgcn_s_sleep(1);
        if ((++sp & 255u) == 0u) { if (xb_ld(&bar[XB_TMO])) break; if (sp > XB_SPIN_CAP) { atomicAdd(&bar[XB_TMO], 1u); break; } }
    }
    nloc = mine > 0u ? mine : 1u; nx = cnt > 0u ? cnt : 1u;
}

__device__ __forceinline__ void xcd_barrier(const XcdBarrier& b, bool xb_t0) {
    asm volatile("s_waitcnt vmcnt(0)" ::: "memory");
    __syncthreads();
    if (xb_t0) {
        unsigned* bar = b.bar;
        __builtin_amdgcn_s_waitcnt(0);
        unsigned nloc = b.st[0], nx = b.st[1];
        if (nloc == 0u) { xcd_barrier_complete(bar, b.x, nloc, nx); b.st[0] = nloc; b.st[1] = nx; }
        const unsigned old = xb_add(&bar[XB_XSUB(b.x)], 1u);
        const unsigned gen = old / nloc;
        if (old + 1u == (gen + 1u) * nloc) {
            __builtin_amdgcn_fence(__ATOMIC_RELEASE, "agent");
            asm volatile("s_waitcnt vmcnt(0)" ::: "memory");
            const unsigned og = xb_add(&bar[XB_TOP], 1u);
            const unsigned tg = og / nx;
            if (og + 1u == (tg + 1u) * nx) xb_add(&bar[XB_TOPGEN], 1u);
            else XB_SPIN(xb_ld(&bar[XB_TOPGEN]) == tg, bar);
            __builtin_amdgcn_fence(__ATOMIC_ACQUIRE, "agent");
            xb_add(&bar[XB_XGEN(b.x)], 1u);
            asm volatile("s_waitcnt vmcnt(0)" ::: "memory");
        } else {
            XB_SPIN(xb_ld(&bar[XB_XGEN(b.x)]) == gen, bar);
            __builtin_amdgcn_fence(__ATOMIC_ACQUIRE, "agent");
            asm volatile("s_waitcnt vmcnt(0)" ::: "memory");
        }
    }
    __syncthreads();
}


__device__ void ph_transpose(int wv, const float* __restrict__ src, bf16_t* __restrict__ dst, int K, int N, int Npad,
                             int col0, int skip_from, int skip, int nvalid, float* tile0, int bid, int nb) {
  const int tk = K / 32, tn = Npad / 32;
  const int tid = otid(wv), half = tid >> 8, t5 = tid & 255;
  const int tx = t5 & 31, ty = t5 >> 5;
  float* tile = tile0 + half * (32 * 33);
  for (int tb = bid * 2; tb < tk * tn; tb += nb * 2) {
    const int t = tb + half;
    const bool act = t < tk * tn;
    const int kt = t / tn, nt = t % tn;
    __syncthreads();
    if (act)
      for (int i = ty; i < 32; i += 8) {
        const int k = kt * 32 + i, n = nt * 32 + tx;
        const int cc = col0 + n + (n >= skip_from ? skip : 0);
        tile[i * 33 + tx] = (n < nvalid) ? src[(size_t)k * N + cc] : 0.f;
      }
    __syncthreads();
    if (act)
      for (int i = ty; i < 32; i += 8) {
        const int n = nt * 32 + i, k = kt * 32 + tx;
        dst[(size_t)n * K + k] = f2bf(tile[tx * 33 + i]);
      }
  }
}

__device__ void ph_mod(int wv, const Params& P, float* sm, int bid, int nb) {
  const int tid = otid(wv);
  float* sv = sm;
  float* red = sm + 5 * 1024;
  for (int i = tid; i < 5 * 1024; i += NTHR) {
    const float v = (i < 4096) ? P.c[i] : P.c_ctx[i - 4096];
    sv[i] = silu_f(v);
  }
  __syncthreads();
  const int c4 = tid & 15, kg = tid >> 4;
  for (int it = bid; it < 192; it += nb) {
    const int layer = it / 96, cb = it % 96;
    const float4* W = (const float4*)(P.ada_w + (size_t)layer * 1024 * MODW + cb * 64) + c4;
    float4 a[5];
#pragma unroll
    for (int r = 0; r < 5; ++r) a[r] = make_float4(0.f, 0.f, 0.f, 0.f);
#pragma unroll 8
    for (int kk = 0; kk < 32; ++kk) {
      const int k = kg * 32 + kk;
      const float4 w = W[(size_t)k * (MODW / 4)];
#pragma unroll
      for (int r = 0; r < 5; ++r) {
        const float s = sv[r * 1024 + k];
        a[r].x += s * w.x; a[r].y += s * w.y; a[r].z += s * w.z; a[r].w += s * w.w;
      }
    }
#pragma unroll
    for (int r = 0; r < 5; ++r) *(float4*)(red + ((kg * 16 + c4) * 5 + r) * 4) = a[r];
    __syncthreads();
    if (tid < 320) {
      const int r = tid >> 6, c = tid & 63;
      float s = 0.f;
      for (int g = 0; g < 32; ++g) s += red[((g * 16 + (c >> 2)) * 5 + r) * 4 + (c & 3)];
      P.mod()[(size_t)(layer * 5 + r) * MODW + cb * 64 + c] = s + P.ada_b[layer * MODW + cb * 64 + c];
    }
    __syncthreads();
  }
}

__device__ void ph_norm(int wv, const float* hl, const float* hc, const float* __restrict__ g, const float* __restrict__ modl,
                        int shift_off, int scale_off, int nrows, bf16_t* __restrict__ dst, int bid, int nb) {
  const int wave = otid(wv) >> 6, lane = otid(wv) & 63;
  for (int row = bid * NWAVE + wave; row < nrows; row += nb * NWAVE) {
    const float* src = hrow(hl, hc, row);
    const float* mr = modl + (size_t)modrow(row) * MODW;
    float4 v[4];
    float ss = 0.f;
#pragma unroll
    for (int i = 0; i < 4; ++i) {
      v[i] = ((const float4*)src)[i * 64 + lane];
      ss += v[i].x * v[i].x + v[i].y * v[i].y + v[i].z * v[i].z + v[i].w * v[i].w;
    }
    ss = wave_sum(ss);
    const float rstd = rsqrtf(ss * (1.f / 1024.f) + 1e-6f);
    f32x4 ggv[4], scv[4], shv[4];
#pragma unroll
    for (int i = 0; i < 4; ++i) {
      const int idx = i * 256 + lane * 4;
      ggv[i] = *(const f32x4*)(g + idx); scv[i] = *(const f32x4*)(mr + scale_off + idx); shv[i] = *(const f32x4*)(mr + shift_off + idx);
    }
#pragma unroll
    for (int i = 0; i < 4; ++i) asm volatile("" : "+v"(ggv[i]), "+v"(scv[i]), "+v"(shv[i]));
#pragma unroll
    for (int i = 0; i < 4; ++i) {
      const int idx = i * 256 + lane * 4;
      const float4 gg = make_float4(ggv[i][0], ggv[i][1], ggv[i][2], ggv[i][3]);
      const float4 sc = make_float4(scv[i][0], scv[i][1], scv[i][2], scv[i][3]);
      const float4 sh = make_float4(shv[i][0], shv[i][1], shv[i][2], shv[i][3]);
      const float o0 = v[i].x * rstd * gg.x * (1.f + sc.x) + sh.x;
      const float o1 = v[i].y * rstd * gg.y * (1.f + sc.y) + sh.y;
      const float o2 = v[i].z * rstd * gg.z * (1.f + sc.z) + sh.z;
      const float o3 = v[i].w * rstd * gg.w * (1.f + sc.w) + sh.w;
      uint2 pk;
      pk.x = (uint32_t)f2bf(o0) | ((uint32_t)f2bf(o1) << 16);
      pk.y = (uint32_t)f2bf(o2) | ((uint32_t)f2bf(o3) << 16);
      *(uint2*)(dst + (size_t)row * DM + idx) = pk;
    }
  }
}

enum { EPI_INPROJ = 0, EPI_OUTPROJ = 1, EPI_Q = 2 };

template <int EPI>
__device__ void ph_gemm(int wv, const Params& P, int layer, const bf16_t* __restrict__ A, const bf16_t* __restrict__ Bt, int M,
                        int Npad, int K, const float* hl, const float* hc, char* smem, int bid, int nb) {
  bf16_t* sA = (bf16_t*)smem;
  bf16_t* sB = sA + 128 * 72;
  const int tid = otid(wv) & 255, lane = tid & 63, wave = tid >> 6;
  const int wr = wave >> 1, wc = wave & 1;
  const int tiles_m = M / 128, tiles_n = Npad / 128;
  const int l15 = lane & 15, l4 = lane >> 4;
  for (int tile = bid; tile < tiles_m * tiles_n; tile += nb) {
    const int tn = tile / tiles_m, tm = tile % tiles_m;
    f32x4 acc[4][4];
#pragma unroll
    for (int i = 0; i < 4; ++i)
#pragma unroll
      for (int j = 0; j < 4; ++j) acc[i][j] = (f32x4){0.f, 0.f, 0.f, 0.f};
    for (int k0 = 0; k0 < K; k0 += 64) {
      __syncthreads();
#pragma unroll
      for (int i = 0; i < 4; ++i) {
        const int idx = i * 256 + tid;
        const int r = idx >> 3, sg = idx & 7;
        const uint4 va = *(const uint4*)(A + (size_t)(tm * 128 + r) * K + k0 + sg * 8);
        *(uint4*)(sA + r * 72 + sg * 8) = va;
        const uint4 vb = *(const uint4*)(Bt + (size_t)(tn * 128 + r) * K + k0 + sg * 8);
        *(uint4*)(sB + r * 72 + sg * 8) = vb;
      }
      __syncthreads();
#pragma unroll
      for (int kk = 0; kk < 2; ++kk) {
        bf16x8 af[4], bfr[4];
#pragma unroll
        for (int i = 0; i < 4; ++i) af[i] = *(const bf16x8*)(sA + (wr * 64 + i * 16 + l15) * 72 + kk * 32 + l4 * 8);
#pragma unroll
        for (int j = 0; j < 4; ++j) bfr[j] = *(const bf16x8*)(sB + (wc * 64 + j * 16 + l15) * 72 + kk * 32 + l4 * 8);
#pragma unroll
        for (int i = 0; i < 4; ++i)
#pragma unroll
          for (int j = 0; j < 4; ++j) acc[i][j] = __builtin_amdgcn_mfma_f32_16x16x32_bf16(af[i], bfr[j], acc[i][j], 0, 0, 0);
      }
    }
#pragma unroll
    for (int i = 0; i < 4; ++i)
#pragma unroll
      for (int j = 0; j < 4; ++j)
#pragma unroll
        for (int e = 0; e < 4; ++e) {
          const int row = tm * 128 + wr * 64 + i * 16 + l4 * 4 + e;
          const int col = tn * 128 + wc * 64 + j * 16 + l15;
          const float v = acc[i][j][e];
          if (EPI == EPI_INPROJ) {
            if (col < 32) P.dtraw()[(size_t)row * 32 + col] = v;
          } else if (EPI == EPI_OUTPROJ) {
            const float* src = hrow(hl, hc, row);
            const float gate = P.mod()[(size_t)(layer * 5 + modrow(row)) * MODW + 2048 + col];
            P.h()[(size_t)row * DM + col] = src[col] + gate * v;
          } else {
            P.q()[(size_t)row * 2048 + col] = f2bf(v);
          }
        }
  }
}

__device__ void ph_conv(int wv, const Params& P, int layer, int bid, int nb) {
  const float* cw = P.conv_w + (size_t)layer * 3 * 1536;
  const float* cb = P.conv_b + (size_t)layer * 1536;
  const int total = NTOK * 64;
  for (int it = bid * NTHR + otid(wv); it < total; it += nb * NTHR) {
    const int row = it >> 6, c8 = 1024 + (it & 63) * 8;
    int l, L;
    if (row < NLAT) { l = row & 4095; L = 4096; } else { l = (row - NLAT) & 255; L = 256; }
    const bf16_t* pc = P.p() + (size_t)row * PW + OFF_XBC + c8;
    const uint4 cur = *(const uint4*)pc;
    uint4 prv = *(const uint4*)(pc - (l > 0 ? PW : 0));
    uint4 nxt = *(const uint4*)(pc + (l < L - 1 ? PW : 0));
    if (l == 0) prv = make_uint4(0, 0, 0, 0);
    if (l == L - 1) nxt = make_uint4(0, 0, 0, 0);
    const bf16_t* c_ = (const bf16_t*)&cur;
    const bf16_t* p_ = (const bf16_t*)&prv;
    const bf16_t* n_ = (const bf16_t*)&nxt;
    uint4 o;
    bf16_t* o_ = (bf16_t*)&o;
#pragma unroll
    for (int e = 0; e < 8; ++e) {
      const int c = c8 + e;
      const float v = cb[c] + cw[c] * bf2f(p_[e]) + cw[1536 + c] * bf2f(c_[e]) + cw[3072 + c] * bf2f(n_[e]);
      o_[e] = f2bf(silu_f(v));
    }
    *(uint4*)(P.xbc() + (size_t)row * 512 + c8 - 1024) = o;
  }
}

__device__ void ph_ssdprep(int wv, const Params& P, int layer, char* smem, int bid, int nb) {
  const int tid = otid(wv), dh = tid & 31, seg = tid >> 5;
  float* segtot = (float*)smem;
  const float bias = P.dt_bias[layer * 32 + dh];
  const float ah = -expf(P.a_log[layer * 32 + dh]);
  for (int gc = bid; gc < NCHUNK; gc += nb) {
    const size_t base = (size_t)(gc * 128 + seg * 8) * 32 + dh;
    float r[8], c[8];
#pragma unroll
    for (int j = 0; j < 8; ++j) r[j] = P.dtraw()[base + (size_t)j * 32];
    float cs = 0.f;
#pragma unroll
    for (int j = 0; j < 8; ++j) { r[j] = softplus_f(r[j] + bias); cs += r[j] * ah; c[j] = cs; }
    __syncthreads();
    segtot[seg * 32 + dh] = cs;
    __syncthreads();
    float off = 0.f;
    for (int s = 0; s < seg; ++s) off += segtot[s * 32 + dh];
#pragma unroll
    for (int j = 0; j < 8; ++j) { P.dtv()[base + (size_t)j * 32] = r[j]; P.csv()[base + (size_t)j * 32] = off + c[j]; }
  }
}


__device__ void ph_dtprep(int wv, const Params& P, int layer, char* smem, int first, int step) {
  const int tid = otid(wv), lane = tid & 63, li = lane & 15, g = lane >> 4;
  float* tile = (float*)smem;
  float* segtot = tile + 128 * 33;
  const int dh = tid & 31, seg = tid >> 5;
  const float bias = P.dt_bias[layer * 32 + dh];
  const float ah = -expf(P.a_log[layer * 32 + dh]);
  const bf16_t* wb = P.w_dtT() + (size_t)layer * 128 * 1024 + (size_t)li * 1024 + 8 * g;
  for (int gc = first; gc < NCHUNK; gc += step) {
    const bf16_t* ua = P.u() + (size_t)(gc * 128 + wv * 16 + li) * DM + 8 * g;
    f32x4 acc0 = (f32x4){0.f, 0.f, 0.f, 0.f}, acc1 = acc0;
#pragma unroll 1
    for (int t0 = 0; t0 < 32; t0 += 8) {
      bf16x8 a[8], b0[8], b1[8];
#pragma unroll
      for (int t = 0; t < 8; ++t) {
        a[t] = *(const bf16x8*)(ua + 32 * (t0 + t));
        b0[t] = *(const bf16x8*)(wb + 32 * (t0 + t));
        b1[t] = *(const bf16x8*)(wb + 16 * 1024 + 32 * (t0 + t));
      }
#pragma unroll
      for (int t = 0; t < 8; ++t) asm volatile("" : "+v"(a[t]), "+v"(b0[t]), "+v"(b1[t]));
#pragma unroll
      for (int t = 0; t < 8; ++t) {
        acc0 = __builtin_amdgcn_mfma_f32_16x16x32_bf16(a[t], b0[t], acc0, 0, 0, 0);
        acc1 = __builtin_amdgcn_mfma_f32_16x16x32_bf16(a[t], b1[t], acc1, 0, 0, 0);
      }
    }
    __syncthreads();
#pragma unroll
    for (int e = 0; e < 4; ++e) {
      tile[(wv * 16 + 4 * g + e) * 33 + li] = acc0[e];
      tile[(wv * 16 + 4 * g + e) * 33 + 16 + li] = acc1[e];
    }
    __syncthreads();
    float r[8], c[8];
    float cs = 0.f;
#pragma unroll
    for (int j = 0; j < 8; ++j) { r[j] = softplus_f(tile[(seg * 8 + j) * 33 + dh] + bias); cs += r[j] * ah; c[j] = cs; }
    segtot[seg * 32 + dh] = cs;
    __syncthreads();
    float off = 0.f;
    for (int s = 0; s < seg; ++s) off += segtot[s * 32 + dh];
    const size_t base = (size_t)(gc * 128 + seg * 8) * 32 + dh;
#pragma unroll
    for (int j = 0; j < 8; ++j) { P.dtv()[base + (size_t)j * 32] = r[j]; P.csv()[base + (size_t)j * 32] = off + c[j]; }
  }
}

__device__ void ph_states(int wv, const Params& P, char* smem, int bid, int nb) {
  float* wx = (float*)smem;
  bf16_t* Bm = (bf16_t*)(smem + 128 * 64 * 4);
  const int tid = otid(wv);
  const int n = tid & 127, pg = (tid >> 7) & 1;
  for (int it = bid; it < NCHUNK * 32; it += nb) {
    const int gc = it >> 5, dh = it & 31, dir = dh >> 4, head = dh & 15, g = head >> 3;
    const int row0 = gc * 128;
    __syncthreads();
    const float at = P.csv()[(size_t)(row0 + 127) * 32 + dh];
    for (int i = tid; i < 128 * 64; i += NTHR) {
      const int j = i >> 6, pp = i & 63, row = row0 + j;
      const float cs = P.csv()[(size_t)row * 32 + dh], dt = P.dtv()[(size_t)row * 32 + dh];
      float w;
      if (dir == 0) w = expf(at - cs);
      else w = expf(j > 0 ? P.csv()[(size_t)(row - 1) * 32 + dh] : 0.f);
      wx[i] = bf2f(P.xbc()[(size_t)row * 1536 + head * 64 + pp]) * dt * w;
    }
    for (int i = tid; i < 128 * 128; i += NTHR) {
      const int j = i >> 7, nn = i & 127;
      Bm[i] = P.xbc()[(size_t)(row0 + j) * 1536 + 1024 + g * 128 + nn];
    }
    __syncthreads();
    float acc[32];
#pragma unroll
    for (int i = 0; i < 32; ++i) acc[i] = 0.f;
    for (int j = 0; j < 128; ++j) {
      const float b = bf2f(Bm[j * 128 + n]);
#pragma unroll
      for (int i = 0; i < 32; ++i) acc[i] += wx[j * 64 + pg * 32 + i] * b;
    }
    bf16_t* dst = P.states() + (size_t)it * 8192;
#pragma unroll
    for (int i = 0; i < 32; ++i) dst[(pg * 32 + i) * 128 + n] = f2bf(acc[i]);
  }
}

__device__ __forceinline__ int scan_chunk(int b, int dir, int s) {
  if (dir == 0) return (s < 2) ? (128 + 2 * b + s) : (32 * b + (s - 2));
  return (s < 2) ? (128 + 2 * b + 1 - s) : (32 * b + 31 - (s - 2));
}
__device__ void ph_scan(int wv, const Params& P, int bid, int nb) {
  const int total = 4 * 32 * 1024;
  for (int it = bid * NTHR + otid(wv); it < total; it += nb * NTHR) {
    const int e8 = it & 1023, dh = (it >> 10) & 31, b = it >> 15, dir = dh >> 4;
    float S[8];
#pragma unroll
    for (int i = 0; i < 8; ++i) S[i] = 0.f;
#pragma unroll
    for (int hb = 0; hb < 2; ++hb) {
      u32x4_t v[17];
      float at[17];
#pragma unroll
      for (int s = 0; s < 17; ++s) {
        const int gc = scan_chunk(b, dir, hb * 17 + s);
        v[s] = *(const u32x4_t*)(P.states() + (size_t)(gc * 32 + dh) * 8192 + e8 * 8);
        at[s] = P.csv()[(size_t)(gc * 128 + 127) * 32 + dh];
      }
#pragma unroll
      for (int s = 0; s < 17; ++s) asm volatile("" : "+v"(v[s]));
#pragma unroll
      for (int s = 0; s < 17; ++s) {
        const int gc = scan_chunk(b, dir, hb * 17 + s);
        const float dec = expf(at[s]);
        float cst[8];
        unpack8(make_uint4(v[s].x, v[s].y, v[s].z, v[s].w), cst);
        *(uint4*)(P.states() + (size_t)(gc * 32 + dh) * 8192 + e8 * 8) =
            make_uint4(pack2(S[0], S[1]), pack2(S[2], S[3]), pack2(S[4], S[5]), pack2(S[6], S[7]));
#pragma unroll
        for (int i = 0; i < 8; ++i) S[i] = dec * S[i] + cst[i];
      }
    }
  }
}

__device__ void ph_ssdy(int wv, const Params& P, int layer, int nchunks, char* smem, int bid, int nb) {
  bf16_t* Cm = (bf16_t*)smem;
  bf16_t* Gm = Cm + 128 * 130;
  char* R = (char*)(Gm + 128 * 130);
  bf16_t* Bm = (bf16_t*)R;
  float* xd = (float*)R;
  bf16_t* Sm = (bf16_t*)(R + 128 * 130 * 2);
  float* csl = (float*)(Sm + 64 * 130);
  float* exl = csl + 128;
  const int tid = otid(wv);
  for (int it = bid; it < nchunks * 16; it += nb) {
    const int gc = it >> 4, head = it & 15, g = head >> 3;
    const int row0 = gc * 128;
    __syncthreads();
    for (int i = tid; i < 128 * 128; i += NTHR) {
      const int j = i >> 7, nn = i & 127;
      const bf16_t* xr = P.xbc() + (size_t)(row0 + j) * 1536 + 1024 + g * 128 + nn;
      Bm[j * 130 + nn] = xr[0];
      Cm[j * 130 + nn] = xr[256];
    }
    __syncthreads();
    {
      const int s = tid & 127, jh = (tid >> 7) & 1;
      for (int jb = 0; jb < 2; ++jb) {
        float acc[32];
#pragma unroll
        for (int i = 0; i < 32; ++i) acc[i] = 0.f;
        for (int nn = 0; nn < 128; ++nn) {
          const float b = bf2f(Bm[s * 130 + nn]);
#pragma unroll
          for (int i = 0; i < 32; ++i) acc[i] += bf2f(Cm[(jh * 64 + jb * 32 + i) * 130 + nn]) * b;
        }
#pragma unroll
        for (int i = 0; i < 32; ++i) Gm[(jh * 64 + jb * 32 + i) * 130 + s] = f2bf(acc[i]);
      }
    }
    const int pp = tid & 63, jg0 = (tid >> 6) & 3;
#pragma unroll 1
    for (int jpass = 0; jpass < 2; ++jpass) {
    const int jg = jg0 * 2 + jpass;
    float yacc[16];
#pragma unroll
    for (int i = 0; i < 16; ++i) yacc[i] = 0.f;
#pragma unroll 1
    for (int dir = 0; dir < 2; ++dir) {
      const int dh = dir * 16 + head;
      __syncthreads();
      for (int i = tid; i < 128 * 64; i += NTHR) {
        const int j = i >> 6, p2 = i & 63, row = row0 + j;
        xd[i] = bf2f(P.xbc()[(size_t)row * 1536 + head * 64 + p2]) * P.dtv()[(size_t)row * 32 + dh];
      }
      const bf16_t* st = P.states() + (size_t)(gc * 32 + dh) * 8192;
      for (int i = tid; i < 64 * 128; i += NTHR) Sm[(i >> 7) * 130 + (i & 127)] = st[i];
      if (tid < 128) {
        const float cs = P.csv()[(size_t)(row0 + tid) * 32 + dh];
        csl[tid] = cs;
        exl[tid] = tid > 0 ? P.csv()[(size_t)(row0 + tid - 1) * 32 + dh] : 0.f;
      }
      __syncthreads();
      const float atot = csl[127];
      for (int s = 0; s < 128; ++s) {
        const float xv = xd[s * 64 + pp];
        const float cs_s = csl[s], ex_s = exl[s];
#pragma unroll
        for (int i = 0; i < 16; ++i) {
          const int j = jg * 16 + i;
          if (dir == 0) {
            if (s <= j) yacc[i] += bf2f(Gm[j * 130 + s]) * expf(csl[j] - cs_s) * xv;
          } else {
            if (s >= j) yacc[i] += bf2f(Gm[j * 130 + s]) * expf(ex_s - exl[j]) * xv;
          }
        }
      }
      float offacc[16];
#pragma unroll
      for (int i = 0; i < 16; ++i) offacc[i] = 0.f;
      for (int nn = 0; nn < 128; ++nn) {
        const float sv = bf2f(Sm[pp * 130 + nn]);
#pragma unroll
        for (int i = 0; i < 16; ++i) offacc[i] += bf2f(Cm[(jg * 16 + i) * 130 + nn]) * sv;
      }
#pragma unroll
      for (int i = 0; i < 16; ++i) {
        const int j = jg * 16 + i;
        const float sc = dir == 0 ? expf(csl[j]) : expf(atot - exl[j]);
        yacc[i] += offacc[i] * sc;
      }
    }
    const float dsk = P.d_skip[layer * 16 + head];
#pragma unroll
    for (int i = 0; i < 16; ++i) {
      const int row = row0 + jg * 16 + i;
      const float xs = bf2f(P.xbc()[(size_t)row * 1536 + head * 64 + pp]);
      const float z = bf2f(P.p()[(size_t)row * PW + OFF_Z + head * 64 + pp]);
      const float y = (yacc[i] + dsk * xs) * silu_f(z);
      P.concat()[(size_t)row * 2048 + head * 64 + pp] = f2bf(y);
    }
    }
  }
}


__device__ __forceinline__ void conv_x8(const Params& P, int layer, int row, int ch0, float* out) {
  int l, L;
  if (row < NLAT) { l = row & 4095; L = 4096; } else { l = (row - NLAT) & 255; L = 256; }
  const bf16_t* pc = P.p() + (size_t)row * PW + OFF_XBC + ch0;
  const uint4 cur = *(const uint4*)pc;
  const uint4 prv = *(const uint4*)(pc - (l > 0 ? PW : 0));
  const uint4 nxt = *(const uint4*)(pc + (l < L - 1 ? PW : 0));
  const float mp = l > 0 ? 1.f : 0.f, mn = l < L - 1 ? 1.f : 0.f;
  float fp[8], fc[8], fn[8];
  unpack8(prv, fp); unpack8(cur, fc); unpack8(nxt, fn);
  const float* cw = P.conv_w + (size_t)layer * 3 * 1536 + ch0;
  const float* cb = P.conv_b + (size_t)layer * 1536 + ch0;
#pragma unroll
  for (int e = 0; e < 8; ++e) out[e] = silu_f(cb[e] + cw[e] * (mp * fp[e]) + cw[1536 + e] * fc[e] + cw[3072 + e] * (mn * fn[e]));
}

constexpr int XS = 72;
constexpr int BS = 136;

__device__ void ph_states_mfma(int wv, const Params& P, int layer, char* smem, int bid, int nb) {
  char* XW = smem;
  char* Bm = smem + 2 * 128 * XS * 2;
  const int tid = otid(wv), lane = tid & 63, li = lane & 15, g = lane >> 4;
  const int dir = wv >> 2, pb = wv & 3;
  for (int it = bid; it < NCHUNK * 16; it += nb) {
    const int gc = it >> 4, head = it & 15, grp = head >> 3;
    const int row0 = gc * 128;
    __syncthreads();
#pragma unroll
    for (int i = 0; i < 2; ++i) {
      const int idx = tid + i * 512, j = idx >> 3, seg = idx & 7, row = row0 + j;
      float xv[8];
      conv_x8(P, layer, row, head * 64 + seg * 8, xv);
      const float* cs = P.csv() + (size_t)row * 32;
      const float* dt = P.dtv() + (size_t)row * 32;
      const float at_f = P.csv()[(size_t)(row0 + 127) * 32 + head];
      const float wf = expf(at_f - cs[head]) * dt[head];
      const float wb = expf(j > 0 ? cs[16 + head - 32] : 0.f) * dt[16 + head];
      uint4 of, ob;
      of.x = pack2(xv[0] * wf, xv[1] * wf); of.y = pack2(xv[2] * wf, xv[3] * wf); of.z = pack2(xv[4] * wf, xv[5] * wf); of.w = pack2(xv[6] * wf, xv[7] * wf);
      ob.x = pack2(xv[0] * wb, xv[1] * wb); ob.y = pack2(xv[2] * wb, xv[3] * wb); ob.z = pack2(xv[4] * wb, xv[5] * wb); ob.w = pack2(xv[6] * wb, xv[7] * wb);
      *(uint4*)(XW + (j * XS + seg * 8) * 2) = of;
      *(uint4*)(XW + ((128 + j) * XS + seg * 8) * 2) = ob;
    }
    {
      u32x4_t tb[4];
#pragma unroll
      for (int i = 0; i < 4; ++i) {
        const int idx = tid + i * 512, j = idx >> 4, seg = idx & 15;
        tb[i] = *(const u32x4_t*)(P.xbc() + (size_t)(row0 + j) * 512 + grp * 128 + seg * 8);
      }
#pragma unroll
      for (int i = 0; i < 4; ++i) asm volatile("" : "+v"(tb[i]));
#pragma unroll
      for (int i = 0; i < 4; ++i) {
        const int idx = tid + i * 512, j = idx >> 4, seg = idx & 15;
        *(u32x4_t*)(Bm + (j * BS + seg * 8) * 2) = tb[i];
      }
    }
    __syncthreads();
    f32x4 acc[8];
#pragma unroll
    for (int n = 0; n < 8; ++n) acc[n] = (f32x4){0.f, 0.f, 0.f, 0.f};
    const char* xbase = XW + ((dir * 128 + (li >> 2)) * XS + pb * 16 + 4 * (li & 3)) * 2;
    const char* bbase = Bm + ((li >> 2) * BS + 4 * (li & 3)) * 2;
#pragma unroll
    for (int t = 0; t < 4; ++t) {
      const int R = 32 * t + 8 * g;
      const bf16x8 bfrag = tr_read2(xbase + R * XS * 2, xbase + (R + 4) * XS * 2);
#pragma unroll
      for (int n = 0; n < 8; ++n) {
        const bf16x8 afrag = tr_read2(bbase + (R * BS + n * 16) * 2, bbase + ((R + 4) * BS + n * 16) * 2);
        acc[n] = __builtin_amdgcn_mfma_f32_16x16x32_bf16(afrag, bfrag, acc[n], 0, 0, 0);
      }
    }
    bf16_t* dst = P.states() + (size_t)(gc * 32 + dir * 16 + head) * 8192 + (pb * 16 + li) * 128;
#pragma unroll
    for (int n = 0; n < 8; ++n) {
      uint2 o;
      o.x = pack2(acc[n][0], acc[n][1]); o.y = pack2(acc[n][2], acc[n][3]);
      *(uint2*)(dst + n * 16 + 4 * g) = o;
    }
  }
}

__device__ void ph_ssdy_mfma(int wv, const Params& P, int layer, int nchunks, char* smem, int bid, int nb) {
  char* Bm = smem;
  char* Cm = Bm + 128 * BS * 2;
  char* X0 = Cm + 128 * BS * 2;
  char* XD = X0 + 128 * XS * 2;
  float* csf = (float*)(XD + 2 * 128 * XS * 2);
  float* exb = csf + 128;
  const int tid = otid(wv), lane = tid & 63, li = lane & 15, g = lane >> 4;
  for (int it = bid; it < nchunks * 16; it += nb) {
    const int gc = it >> 4, head = it & 15, grp = head >> 3;
    const int row0 = gc * 128;
    __syncthreads();
#pragma unroll
    for (int i = 0; i < 2; ++i) {
      const int idx = tid + i * 512, j = idx >> 3, seg = idx & 7, row = row0 + j;
      float xv[8];
      conv_x8(P, layer, row, head * 64 + seg * 8, xv);
      const float df = P.dtv()[(size_t)row * 32 + head], db = P.dtv()[(size_t)row * 32 + 16 + head];
      uint4 o0, of, ob;
      o0.x = pack2(xv[0], xv[1]); o0.y = pack2(xv[2], xv[3]); o0.z = pack2(xv[4], xv[5]); o0.w = pack2(xv[6], xv[7]);
      of.x = pack2(xv[0] * df, xv[1] * df); of.y = pack2(xv[2] * df, xv[3] * df); of.z = pack2(xv[4] * df, xv[5] * df); of.w = pack2(xv[6] * df, xv[7] * df);
      ob.x = pack2(xv[0] * db, xv[1] * db); ob.y = pack2(xv[2] * db, xv[3] * db); ob.z = pack2(xv[4] * db, xv[5] * db); ob.w = pack2(xv[6] * db, xv[7] * db);
      *(uint4*)(X0 + (j * XS + seg * 8) * 2) = o0;
      *(uint4*)(XD + (j * XS + seg * 8) * 2) = of;
      *(uint4*)(XD + ((128 + j) * XS + seg * 8) * 2) = ob;
    }
    {
      u32x4_t tb[4], tc[4];
#pragma unroll
      for (int i = 0; i < 4; ++i) {
        const int idx = tid + i * 512, j = idx >> 4, seg = idx & 15;
        const bf16_t* s = P.xbc() + (size_t)(row0 + j) * 512 + grp * 128 + seg * 8;
        tb[i] = *(const u32x4_t*)s; tc[i] = *(const u32x4_t*)(s + 256);
      }
#pragma unroll
      for (int i = 0; i < 4; ++i) asm volatile("" : "+v"(tb[i]), "+v"(tc[i]));
#pragma unroll
      for (int i = 0; i < 4; ++i) {
        const int idx = tid + i * 512, j = idx >> 4, seg = idx & 15;
        *(u32x4_t*)(Bm + (j * BS + seg * 8) * 2) = tb[i];
        *(u32x4_t*)(Cm + (j * BS + seg * 8) * 2) = tc[i];
      }
    }
    if (tid < 128) {
      csf[tid] = P.csv()[(size_t)(row0 + tid) * 32 + head];
      exb[tid] = tid > 0 ? P.csv()[(size_t)(row0 + tid - 1) * 32 + 16 + head] : 0.f;
    }
    __syncthreads();
    const float atb = P.csv()[(size_t)(row0 + 127) * 32 + 16 + head];
    f32x4 accG[8];
#pragma unroll
    for (int sb = 0; sb < 8; ++sb) accG[sb] = (f32x4){0.f, 0.f, 0.f, 0.f};
#pragma unroll
    for (int t = 0; t < 4; ++t) {
      const bf16x8 cfrag = *(const bf16x8*)(Cm + ((16 * wv + li) * BS + 32 * t + 8 * g) * 2);
#pragma unroll
      for (int sb = 0; sb < 8; ++sb) {
        const bf16x8 bfr = *(const bf16x8*)(Bm + ((16 * sb + li) * BS + 32 * t + 8 * g) * 2);
        accG[sb] = __builtin_amdgcn_mfma_f32_16x16x32_bf16(bfr, cfrag, accG[sb], 0, 0, 0);
      }
    }
    f32x4 accY[4];
#pragma unroll
    for (int pb = 0; pb < 4; ++pb) accY[pb] = (f32x4){0.f, 0.f, 0.f, 0.f};
    const int jl = 16 * wv + li;
    const float csf_j = csf[jl], exb_j = exb[jl];
#pragma unroll
    for (int dir = 0; dir < 2; ++dir) {
      f32x4 accO[4];
#pragma unroll
      for (int pb = 0; pb < 4; ++pb) accO[pb] = (f32x4){0.f, 0.f, 0.f, 0.f};
      const bf16_t* st = P.states() + (size_t)(gc * 32 + dir * 16 + head) * 8192;
#pragma unroll
      for (int th = 0; th < 2; ++th) {
        bf16x8 sfr[8];
#pragma unroll
        for (int i = 0; i < 8; ++i) sfr[i] = *(const bf16x8*)(st + (16 * (i & 3) + li) * 128 + 32 * (th * 2 + (i >> 2)) + 8 * g);
#pragma unroll
        for (int i = 0; i < 8; ++i) asm volatile("" : "+v"(sfr[i]));
#pragma unroll
        for (int tt = 0; tt < 2; ++tt) {
          const int t = th * 2 + tt;
          const bf16x8 cfrag = *(const bf16x8*)(Cm + ((16 * wv + li) * BS + 32 * t + 8 * g) * 2);
#pragma unroll
          for (int pb = 0; pb < 4; ++pb) accO[pb] = __builtin_amdgcn_mfma_f32_16x16x32_bf16(cfrag, sfr[tt * 4 + pb], accO[pb], 0, 0, 0);
        }
      }
#pragma unroll
      for (int e = 0; e < 4; ++e) {
        const int j = 16 * wv + 4 * g + e;
        const float sc = dir == 0 ? expf(csf[j]) : expf(atb - exb[j]);
#pragma unroll
        for (int pb = 0; pb < 4; ++pb) accY[pb][e] += accO[pb][e] * sc;
      }
#pragma unroll
      for (int t = 0; t < 4; ++t) {
        const bool skip = dir == 0 ? (32 * t > 16 * wv + 15) : (32 * t + 31 < 16 * wv);
        if (skip) continue;
        bf16x8 afrag;
#pragma unroll
        for (int hh = 0; hh < 2; ++hh) {
          const int s0 = 32 * t + 16 * hh + 4 * g;
          const f32x4 gv = accG[2 * t + hh];
          const f32x4 cv = dir == 0 ? *(const f32x4*)(csf + s0) : *(const f32x4*)(exb + s0);
#pragma unroll
          for (int e = 0; e < 4; ++e) {
            const int s = s0 + e;
            float m;
            if (dir == 0) m = (s <= jl) ? gv[e] * expf(csf_j - cv[e]) : 0.f;
            else m = (s >= jl) ? gv[e] * expf(cv[e] - exb_j) : 0.f;
            afrag[hh * 4 + e] = (short)f2bf(m);
          }
        }
        const char* xb = XD + ((dir * 128 + 32 * t + 4 * g + (li >> 2)) * XS + 4 * (li & 3)) * 2;
#pragma unroll
        for (int pb = 0; pb < 4; ++pb) {
          const bf16x8 bfr = tr_read2(xb + pb * 32, xb + 16 * XS * 2 + pb * 32);
          accY[pb] = __builtin_amdgcn_mfma_f32_16x16x32_bf16(afrag, bfr, accY[pb], 0, 0, 0);
        }
      }
    }
    const float dsk = P.d_skip[layer * 16 + head];
    unsigned zv[16];
#pragma unroll
    for (int e = 0; e < 4; ++e)
#pragma unroll
      for (int pb = 0; pb < 4; ++pb)
        zv[e * 4 + pb] = P.p()[(size_t)(row0 + 16 * wv + 4 * g + e) * PW + OFF_Z + head * 64 + 16 * pb + li];
#pragma unroll
    for (int i = 0; i < 16; ++i) asm volatile("" : "+v"(zv[i]));
#pragma unroll
    for (int e = 0; e < 4; ++e) {
      const int j = 16 * wv + 4 * g + e, row = row0 + j;
#pragma unroll
      for (int pb = 0; pb < 4; ++pb) {
        const int pp = 16 * pb + li;
        const float xs = bf2f(*(const bf16_t*)(X0 + (j * XS + pp) * 2));
        const float z = bf2f((bf16_t)zv[e * 4 + pb]);
        P.concat()[(size_t)row * 2048 + head * 64 + pp] = f2bf((accY[pb][e] + dsk * xs) * silu_f(z));
      }
    }
  }
}

__device__ void ph_ssdnorm(int wv, const Params& P, int layer, int nrows, int bid, int nb) {
  const int wave = otid(wv) >> 6, lane = otid(wv) & 63;
  const float* g = P.ssd_norm_g + layer * 1024;
  for (int row = bid * NWAVE + wave; row < nrows; row += nb * NWAVE) {
    bf16_t* src = P.concat() + (size_t)row * 2048;
    float v[16];
    float ss = 0.f;
#pragma unroll
    for (int i = 0; i < 4; ++i) {
      const uint2 pk = *(const uint2*)(src + i * 256 + lane * 4);
      v[i * 4 + 0] = bf2f((bf16_t)(pk.x & 0xffff)); v[i * 4 + 1] = bf2f((bf16_t)(pk.x >> 16));
      v[i * 4 + 2] = bf2f((bf16_t)(pk.y & 0xffff)); v[i * 4 + 3] = bf2f((bf16_t)(pk.y >> 16));
    }
#pragma unroll
    for (int i = 0; i < 16; ++i) ss += v[i] * v[i];
    ss = wave_sum(ss);
    const float rstd = rsqrtf(ss * (1.f / 1024.f) + 1e-6f);
    f32x4 gv[4];
#pragma unroll
    for (int i = 0; i < 4; ++i) gv[i] = *(const f32x4*)(g + i * 256 + lane * 4);
#pragma unroll
    for (int i = 0; i < 4; ++i) asm volatile("" : "+v"(gv[i]));
#pragma unroll
    for (int i = 0; i < 4; ++i) {
      const int idx = i * 256 + lane * 4;
      uint2 pk;
      pk.x = (uint32_t)f2bf(v[i * 4 + 0] * rstd * gv[i][0]) | ((uint32_t)f2bf(v[i * 4 + 1] * rstd * gv[i][1]) << 16);
      pk.y = (uint32_t)f2bf(v[i * 4 + 2] * rstd * gv[i][2]) | ((uint32_t)f2bf(v[i * 4 + 3] * rstd * gv[i][3]) << 16);
      *(uint2*)(src + idx) = pk;
    }
  }
}

__device__ void ph_pool(int wv, const Params& P, int layer, int nrows, char* smem, int bid, int nb) {
  float* pooled = (float*)smem;
  const int tid = otid(wv);
  const int ntile = nrows / 32;
  for (int it = bid; it < ntile * 4; it += nb) {
    const int tt = it >> 2, gi = it & 3;
    const int w = 2 << gi;
    const int row0 = tt * 32;
    __syncthreads();
    for (int i = tid; i < 32 * 128; i += NTHR) {
      const int t = i >> 7, ch = i & 127, row = row0 + t;
      int l, L, base;
      if (row < NLAT) { l = row & 4095; L = 4096; base = row - l; } else { l = (row - NLAT) & 255; L = 256; base = row - l; }
      int lo = l - w / 2; lo = lo < 0 ? 0 : lo;
      int hi = l + w - w / 2 - 1; hi = hi > L - 1 ? L - 1 : hi;
      float s = 0.f;
      for (int r = lo; r <= hi; ++r) s += bf2f(P.p()[(size_t)(base + r) * PW + OFF_POOL + gi * 128 + ch]);
      pooled[i] = s / (float)(hi - lo + 1) - bf2f(P.p()[(size_t)row * PW + OFF_POOL + gi * 128 + ch]);
    }
    __syncthreads();
    const int o = tid & 127, tg = (tid >> 7) & 1;
    const float* W = P.pool_w + ((size_t)(layer * 4 + gi) * 128) * 128 + o;
    float acc[16];
#pragma unroll
    for (int i = 0; i < 16; ++i) acc[i] = 0.f;
    for (int k = 0; k < 128; ++k) {
      const float wv = W[(size_t)k * 128];
#pragma unroll
      for (int i = 0; i < 16; ++i) acc[i] += pooled[(tg * 16 + i) * 128 + k] * wv;
    }
    const float sc = P.pool_scale[layer * 512 + gi * 128 + o];
#pragma unroll
    for (int i = 0; i < 16; ++i)
      P.concat()[(size_t)(row0 + tg * 16 + i) * 2048 + 1024 + gi * 128 + o] = f2bf(acc[i] * sc);
  }
}

__device__ void ph_na(int wv, const Params& P, int layer, int nrows, char* smem, int bid, int nb) {
  const int wave = otid(wv) >> 6, lane = otid(wv) & 63;
  float* qs = (float*)smem + wave * 448;
  float* ps = qs + 64;
  const float* rpb = P.na_rpb + (size_t)layer * 8 * 15 * 31;
  for (int it = bid * NWAVE + wave; it < nrows * 8; it += nb * NWAVE) {
    const int row = it >> 3, hd = it & 7;
    const bool lat = row < NLAT;
    int b, r = 0, cq = 0, r0 = 0, c0 = 0;
    if (lat) {
      b = row >> 12; const int l = row & 4095; r = l >> 6; cq = l & 63;
      r0 = r - 4; r0 = r0 < 0 ? 0 : (r0 > 56 ? 56 : r0);
      c0 = cq - 8; c0 = c0 < 0 ? 0 : (c0 > 48 ? 48 : c0);
    } else {
      b = (row - NLAT) >> 8;
    }
    qs[lane] = bf2f(P.p()[(size_t)row * PW + OFF_Q + hd * 64 + lane]) * 0.125f;
    __builtin_amdgcn_wave_barrier();
    const int nkeys = lat ? 384 : 256;
    float mx = -3.0e38f;
#pragma unroll 1
    for (int t = 0; t < 6; ++t) {
      const int n = t * 64 + lane;
      float s = -3.0e38f;
      if (n < nkeys) {
        int krow; float bias = 0.f;
        if (lat && n < 128) {
          const int kr = n >> 4, kc = n & 15;
          const int rk = r0 + kr, ck = c0 + kc;
          krow = b * 4096 + rk * 64 + ck;
          bias = rpb[(hd * 15 + (rk - r + 7)) * 31 + (ck - cq + 15)];
        } else {
          krow = NLAT + b * 256 + (lat ? n - 128 : n);
        }
        const bf16_t* kp = P.p() + (size_t)krow * PW + OFF_K + hd * 64;
        float d = 0.f;
#pragma unroll
        for (int v8 = 0; v8 < 8; ++v8) {
          const uint4 kk = *(const uint4*)(kp + v8 * 8);
          const bf16_t* ke = (const bf16_t*)&kk;
#pragma unroll
          for (int e = 0; e < 8; ++e) d += qs[v8 * 8 + e] * bf2f(ke[e]);
        }
        s = d + bias;
      }
      ps[t * 64 + lane] = s;
      mx = fmaxf(mx, s);
    }
    mx = wave_max(mx);
    float sum = 0.f;
#pragma unroll 1
    for (int t = 0; t < 6; ++t) {
      const int n = t * 64 + lane;
      const float e = (n < nkeys) ? expf(ps[n] - mx) : 0.f;
      sum += e;
      ps[n] = e;
    }
    sum = wave_sum(sum);
    __builtin_amdgcn_wave_barrier();
    float acc = 0.f;
    for (int n = 0; n < nkeys; ++n) {
      int krow;
      if (lat && n < 128) krow = b * 4096 + (r0 + (n >> 4)) * 64 + c0 + (n & 15);
      else krow = NLAT + b * 256 + (lat ? n - 128 : n);
      acc += ps[n] * bf2f(P.p()[(size_t)krow * PW + OFF_V + hd * 64 + lane]);
    }
    P.concat()[(size_t)row * 2048 + 1536 + hd * 64 + lane] = f2bf(acc / sum);
    __builtin_amdgcn_wave_barrier();
  }
}


template <int W>
__device__ __forceinline__ void pool_frags(const bf16_t* pc, int l, int L, float rc, bf16x8 (&af)[4]) {
#pragma unroll
  for (int t = 0; t < 4; ++t) {
    constexpr int WB = W < 8 ? W : 8;
    float s[8], f[8];
#pragma unroll
    for (int e = 0; e < 8; ++e) s[e] = 0.f;
    const u32x4_t own = *(const u32x4_t*)(pc + 32 * t);
#pragma unroll
    for (int ob = 0; ob < W; ob += WB) {
      u32x4_t rows[WB];
#pragma unroll
      for (int o = 0; o < WB; ++o) {
        const int rr = l - W / 2 + ob + o;
        const int rcl = (rr >= 0 && rr < L) ? rr : l;
        rows[o] = *(const u32x4_t*)(pc + (ptrdiff_t)(rcl - l) * PW + 32 * t);
      }
#pragma unroll
      for (int o = 0; o < WB; ++o) asm volatile("" : "+v"(rows[o]));
#pragma unroll
      for (int o = 0; o < WB; ++o) {
        const int rr = l - W / 2 + ob + o;
        const float mk = (rr >= 0 && rr < L) ? 1.f : 0.f;
        unpack8(make_uint4(rows[o].x, rows[o].y, rows[o].z, rows[o].w), f);
#pragma unroll
        for (int e = 0; e < 8; ++e) s[e] += mk * f[e];
      }
    }
    unpack8(make_uint4(own.x, own.y, own.z, own.w), f);
#pragma unroll
    for (int e = 0; e < 8; ++e) af[t][e] = (short)f2bf(s[e] * rc - f[e]);
  }
}
__device__ void ph_pool_mfma(int wv, const Params& P, int layer, int nrows, int bid, int nb) {
  const int lane = otid(wv) & 63, li = lane & 15, g = lane >> 4;
  const int nitems = (nrows / 16) * 4;
  for (int it = bid * NWAVE + wv; it < nitems; it += nb * NWAVE) {
    const int gi = it & 3, row0 = (it >> 2) * 16, w = 2 << gi;
    const int row = row0 + li;
    int l, L;
    if (row < NLAT) { l = row & 4095; L = 4096; } else { l = (row - NLAT) & 255; L = 256; }
    int lo = l - w / 2; lo = lo < 0 ? 0 : lo;
    int hi = l + w - w / 2 - 1; hi = hi > L - 1 ? L - 1 : hi;
    const float rc = 1.f / (float)(hi - lo + 1);
    const bf16_t* pc = P.p() + (size_t)row * PW + OFF_POOL + gi * 128 + 8 * g;
    bf16x8 af[4];
    if (gi == 0) pool_frags<2>(pc, l, L, rc, af);
    else if (gi == 1) pool_frags<4>(pc, l, L, rc, af);
    else if (gi == 2) pool_frags<8>(pc, l, L, rc, af);
    else pool_frags<16>(pc, l, L, rc, af);
    const bf16_t* wt = P.poolwT() + ((size_t)(layer * 4 + gi) * 128 + li) * 128 + 8 * g;
    const float* sc = P.pool_scale + layer * 512 + gi * 128;
#pragma unroll
    for (int nh = 0; nh < 4; ++nh) {
      bf16x8 wf[2][4];
#pragma unroll
      for (int n = 0; n < 2; ++n)
#pragma unroll
        for (int t = 0; t < 4; ++t) wf[n][t] = *(const bf16x8*)(wt + (size_t)(nh * 2 + n) * 16 * 128 + 32 * t);
#pragma unroll
      for (int n = 0; n < 2; ++n)
#pragma unroll
        for (int t = 0; t < 4; ++t) asm volatile("" : "+v"(wf[n][t]));
#pragma unroll
      for (int n = 0; n < 2; ++n) {
        const int nt = nh * 2 + n;
        f32x4 acc = (f32x4){0.f, 0.f, 0.f, 0.f};
#pragma unroll
        for (int t = 0; t < 4; ++t) acc = __builtin_amdgcn_mfma_f32_16x16x32_bf16(af[t], wf[n][t], acc, 0, 0, 0);
        const float scv = sc[nt * 16 + li];
#pragma unroll
        for (int e = 0; e < 4; ++e)
          P.concat()[(size_t)(row0 + 4 * g + e) * 2048 + 1024 + gi * 128 + nt * 16 + li] = f2bf(acc[e] * scv);
      }
    }
  }
}

__device__ void ph_vtranspose(int wv, const Params& P, char* smem, int bid, int nb) {
  const int lane = otid(wv) & 63;
  bf16_t* tile = (bf16_t*)smem + wv * 64 * 72;
  for (int it = bid * NWAVE + wv; it < 272 * 8; it += nb * NWAVE) {
    const int hd = it & 7, tt = it >> 3, row0 = tt * 64;
    const bf16_t* src = P.p() + (size_t)(row0 + lane) * PW + OFF_V + hd * 64;
#pragma unroll
    for (int i = 0; i < 8; ++i) *(uint4*)(tile + lane * 72 + i * 8) = *(const uint4*)(src + i * 8);
    __builtin_amdgcn_wave_barrier();
    bf16_t* dst;
    if (row0 < NLAT) dst = P.vtl() + ((size_t)((row0 >> 12) * 8 + hd) * 64 + lane) * 4096 + (row0 & 4095);
    else dst = P.vtc() + ((size_t)(((row0 - NLAT) >> 8) * 8 + hd) * 64 + lane) * 256 + ((row0 - NLAT) & 255);
#pragma unroll
    for (int i = 0; i < 8; ++i) {
      uint32_t w[4];
#pragma unroll
      for (int k = 0; k < 4; ++k)
        w[k] = (uint32_t)tile[(i * 8 + 2 * k) * 72 + lane] | ((uint32_t)tile[(i * 8 + 2 * k + 1) * 72 + lane] << 16);
      *(uint4*)(dst + i * 8) = make_uint4(w[0], w[1], w[2], w[3]);
    }
    __builtin_amdgcn_wave_barrier();
  }
}

__device__ __forceinline__ float grp_max(float v) {
  auto a = __builtin_amdgcn_permlane16_swap(__float_as_uint(v), __float_as_uint(v), false, false);
  v = fmaxf(__uint_as_float(a[0]), __uint_as_float(a[1]));
  auto b = __builtin_amdgcn_permlane32_swap(__float_as_uint(v), __float_as_uint(v), false, false);
  return fmaxf(__uint_as_float(b[0]), __uint_as_float(b[1]));
}
__device__ __forceinline__ float grp_sum(float v) {
  auto a = __builtin_amdgcn_permlane16_swap(__float_as_uint(v), __float_as_uint(v), false, false);
  v = __uint_as_float(a[0]) + __uint_as_float(a[1]);
  auto b = __builtin_amdgcn_permlane32_swap(__float_as_uint(v), __float_as_uint(v), false, false);
  return __uint_as_float(b[0]) + __uint_as_float(b[1]);
}

__device__ void ph_na_mfma(int wv, const Params& P, int layer, int nrows, char* smem, int bid, int nb) {
  const int lane = otid(wv) & 63, li = lane & 15, g = lane >> 4;
  float* btab = (float*)smem + wv * 256;
  const float* rpb = P.na_rpb + (size_t)layer * 8 * 15 * 31;
  const int n_lat = 4 * 64 * 8 * 4;
  const int n_items = n_lat + (nrows > NLAT ? 4 * 16 * 8 : 0);
  const int nrank = nb >> 3;
  const bool xmap = ((nb & 7) == 0) && nrank > 0 && (1024 % nrank) == 0 && (64 % nrank) == 0;
  const int per_lat = xmap ? 1024 / nrank : 0, per_ctx = (xmap && nrows > NLAT) ? 64 / nrank : 0;
  const int q_begin = xmap ? wv : bid * NWAVE + wv, q_end = xmap ? per_lat + per_ctx : n_items, q_step = xmap ? NWAVE : nb * NWAVE;
  for (int q = q_begin; q < q_end; q += q_step) {
    bool lat;
    int b, hd, qrow0, r = 0, cq0 = 0, r0 = 0, cs = 0, qt;
    if (xmap) {
      hd = bid & 7;
      const int rank = bid >> 3;
      lat = q < per_lat;
      if (lat) { const int i = rank * per_lat + q; qt = i & 3; r = (i >> 2) & 63; b = i >> 8; }
      else { const int c = rank * per_ctx + (q - per_lat); qt = c & 15; b = c >> 4; }
    } else {
      lat = q < n_lat;
      if (lat) { qt = q & 3; hd = (q >> 2) & 7; r = (q >> 5) & 63; b = q >> 11; }
      else { const int t = q - n_lat; hd = t & 7; qt = (t >> 3) & 15; b = t >> 7; }
    }
    if (lat) {
      cq0 = qt * 16; qrow0 = b * 4096 + r * 64 + cq0;
      r0 = r - 4; r0 = r0 < 0 ? 0 : (r0 > 56 ? 56 : r0);
      int clo = cq0 - 8; clo = clo < 0 ? 0 : (clo > 48 ? 48 : clo);
      cs = clo < 32 ? clo : 32;
    } else {
      qrow0 = NLAT + b * 256 + qt * 16;
    }
    const bf16_t* qp = P.p() + (size_t)(qrow0 + li) * PW + OFF_Q + hd * 64 + 8 * g;
    const bf16x8 qf0 = *(const bf16x8*)qp, qf1 = *(const bf16x8*)(qp + 32);
    __builtin_amdgcn_wave_barrier();
#pragma unroll
    for (int i = 0; i < 4; ++i) {
      const int e_ = i * 64 + lane, kr_ = e_ >> 5, dc_ = e_ & 31;
      int dr_ = r0 + kr_ - r + 7; dr_ = dr_ < 0 ? 0 : (dr_ > 14 ? 14 : dr_);
      btab[e_] = rpb[(hd * 15 + dr_) * 31 + (dc_ < 31 ? dc_ : 30)];
    }
    __builtin_amdgcn_wave_barrier();
    f32x4 accS[16], accC[16];
#define NA_KPTR(tile) ((tile) < 16 ? P.p() + (size_t)(b * 4096 + (r0 + ((tile) >> 1)) * 64 + cs + 16 * ((tile) & 1) + li) * PW + OFF_K + hd * 64 + 8 * g \
                                   : P.p() + (size_t)(NLAT + b * 256 + 16 * ((tile) - 16) + li) * PW + OFF_K + hd * 64 + 8 * g)
    bf16x8 kA[2][2], kB[2][2];
#pragma unroll
    for (int i = 0; i < 2; ++i) { const bf16_t* kp = NA_KPTR(i); kA[i][0] = *(const bf16x8*)kp; kA[i][1] = *(const bf16x8*)(kp + 32); }
#pragma unroll
    for (int tb = 0; tb < 32; tb += 4) {
#pragma unroll
      for (int i = 0; i < 2; ++i) { const bf16_t* kp = NA_KPTR(tb + 2 + i); kB[i][0] = *(const bf16x8*)kp; kB[i][1] = *(const bf16x8*)(kp + 32); }
#pragma unroll
      for (int i = 0; i < 2; ++i) { asm volatile("" : "+v"(kA[i][0]), "+v"(kA[i][1])); }
#pragma unroll
      for (int i = 0; i < 2; ++i) {
        f32x4 z = (f32x4){0.f, 0.f, 0.f, 0.f};
        z = __builtin_amdgcn_mfma_f32_16x16x32_bf16(kA[i][0], qf0, z, 0, 0, 0);
        z = __builtin_amdgcn_mfma_f32_16x16x32_bf16(kA[i][1], qf1, z, 0, 0, 0);
        if (tb + i < 16) accS[(tb + i) & 15] = z; else accC[(tb + i) & 15] = z;
      }
      if (tb + 4 < 32) {
#pragma unroll
        for (int i = 0; i < 2; ++i) { const bf16_t* kp = NA_KPTR(tb + 4 + i); kA[i][0] = *(const bf16x8*)kp; kA[i][1] = *(const bf16x8*)(kp + 32); }
      }
#pragma unroll
      for (int i = 0; i < 2; ++i) { asm volatile("" : "+v"(kB[i][0]), "+v"(kB[i][1])); }
#pragma unroll
      for (int i = 0; i < 2; ++i) {
        f32x4 z = (f32x4){0.f, 0.f, 0.f, 0.f};
        z = __builtin_amdgcn_mfma_f32_16x16x32_bf16(kB[i][0], qf0, z, 0, 0, 0);
        z = __builtin_amdgcn_mfma_f32_16x16x32_bf16(kB[i][1], qf1, z, 0, 0, 0);
        if (tb + 2 + i < 16) accS[(tb + 2 + i) & 15] = z; else accC[(tb + 2 + i) & 15] = z;
      }
    }
#undef NA_KPTR
    const int cq = cq0 + li;
    int c0q = cq - 8; c0q = c0q < 0 ? 0 : (c0q > 48 ? 48 : c0q);
    float mx = -3.0e38f;
#pragma unroll
    for (int kt = 0; kt < 16; ++kt) {
      int bi[4]; bool okv[4]; float bv[4];
#pragma unroll
      for (int e = 0; e < 4; ++e) {
        const int ck = cs + 16 * (kt & 1) + 4 * g + e;
        okv[e] = lat && ck >= c0q && ck < c0q + 16;
        bi[e] = okv[e] ? (kt >> 1) * 32 + (ck - cq + 15) : 0;
      }
      asm volatile("" : "+v"(bi[0]), "+v"(bi[1]), "+v"(bi[2]), "+v"(bi[3]));
#pragma unroll
      for (int e = 0; e < 4; ++e) bv[e] = btab[bi[e]];
#pragma unroll
      for (int e = 0; e < 4; ++e) {
        const float s = okv[e] ? accS[kt][e] * 0.125f + bv[e] : -3.0e38f;
        accS[kt][e] = s;
        mx = fmaxf(mx, s);
      }
    }
#pragma unroll
    for (int ct = 0; ct < 16; ++ct)
#pragma unroll
      for (int e = 0; e < 4; ++e) { const float s = accC[ct][e] * 0.125f; accC[ct][e] = s; mx = fmaxf(mx, s); }
    mx = grp_max(mx);
    float sum = 0.f;
#pragma unroll
    for (int kt = 0; kt < 16; ++kt)
#pragma unroll
      for (int e = 0; e < 4; ++e) { const float p = __expf(accS[kt][e] - mx); accS[kt][e] = p; sum += p; }
#pragma unroll
    for (int ct = 0; ct < 16; ++ct)
#pragma unroll
      for (int e = 0; e < 4; ++e) { const float p = __expf(accC[ct][e] - mx); accC[ct][e] = p; sum += p; }
    sum = grp_sum(sum);
    const float inv = 1.f / sum;
    bf16x8 afL[8], afC[8];
#pragma unroll
    for (int kr = 0; kr < 8; ++kr) {
#pragma unroll
      for (int e = 0; e < 4; ++e) {
        afL[kr][e] = (short)f2bf(accS[2 * kr][e] * inv); afL[kr][4 + e] = (short)f2bf(accS[2 * kr + 1][e] * inv);
        afC[kr][e] = (short)f2bf(accC[2 * kr][e] * inv); afC[kr][4 + e] = (short)f2bf(accC[2 * kr + 1][e] * inv);
      }
    }
    f32x4 accO[4];
#pragma unroll
    for (int db = 0; db < 4; ++db) accO[db] = (f32x4){0.f, 0.f, 0.f, 0.f};
    const bf16_t* vl = P.vtl() + ((size_t)(b * 8 + hd) * 64 + li) * 4096;
    const bf16_t* vc = P.vtc() + ((size_t)(b * 8 + hd) * 64 + li) * 256;
#pragma unroll
    for (int kr = 0; kr < 8; ++kr) {
      const int tok = (r0 + kr) * 64 + cs + 4 * g;
      s16x4 lo[4], hi[4];
#pragma unroll
      for (int db = 0; db < 4; ++db) {
        const bf16_t* vp = vl + (size_t)db * 16 * 4096 + tok;
        lo[db] = *(const s16x4*)vp; hi[db] = *(const s16x4*)(vp + 16);
      }
#pragma unroll
      for (int db = 0; db < 4; ++db) {
        const bf16x8 bfr = (bf16x8){lo[db][0], lo[db][1], lo[db][2], lo[db][3], hi[db][0], hi[db][1], hi[db][2], hi[db][3]};
        accO[db] = __builtin_amdgcn_mfma_f32_16x16x32_bf16(afL[kr], bfr, accO[db], 0, 0, 0);
      }
    }
#pragma unroll
    for (int t = 0; t < 8; ++t) {
      const int tok = 32 * t + 4 * g;
      s16x4 lo[4], hi[4];
#pragma unroll
      for (int db = 0; db < 4; ++db) {
        const bf16_t* vp = vc + (size_t)db * 16 * 256 + tok;
        lo[db] = *(const s16x4*)vp; hi[db] = *(const s16x4*)(vp + 16);
      }
#pragma unroll
      for (int db = 0; db < 4; ++db) {
        const bf16x8 bfr = (bf16x8){lo[db][0], lo[db][1], lo[db][2], lo[db][3], hi[db][0], hi[db][1], hi[db][2], hi[db][3]};
        accO[db] = __builtin_amdgcn_mfma_f32_16x16x32_bf16(afC[t], bfr, accO[db], 0, 0, 0);
      }
    }
#pragma unroll
    for (int db = 0; db < 4; ++db)
#pragma unroll
      for (int e = 0; e < 4; ++e)
        P.concat()[(size_t)(qrow0 + 4 * g + e) * 2048 + 1536 + hd * 64 + 16 * db + li] = f2bf(accO[db][e]);
  }
}

__device__ void ph_peer_topk(int wv, const Params& P, int layer, int nrows, char* smem, int bid, int nb) {
  bf16_t* Ks = (bf16_t*)smem;
  float* qt = (float*)(smem + 33280);
  float* sc = qt + 32 * 256;
  float* tv = sc + 64 * 129;
  int* ti = (int*)(tv + 64 * 16);
  const int tid = otid(wv);
  const int ntile = nrows / 32;
  for (int it = bid; it < ntile * 8; it += nb) {
    const int hd = it % 8, tt = it / 8;
    const int row0 = tt * 32;
    __syncthreads();
    for (int i = tid; i < 32 * 256; i += NTHR) {
      const int t = i >> 8, d = i & 255;
      qt[i] = bf2f(P.q()[(size_t)(row0 + t) * 2048 + hd * 256 + d]);
    }
    for (int half = 0; half < 2; ++half) {
      __syncthreads();
      const float* kk = P.peer_keys + ((size_t)((layer * 8 + hd) * 2 + half) * 128) * 128;
      for (int i = tid; i < 128 * 128; i += NTHR) Ks[(i >> 7) * 130 + (i & 127)] = f2bf(kk[i]);
      __syncthreads();
      const int k = tid & 127, tg = (tid >> 7) & 1;
      float acc[16];
#pragma unroll
      for (int i = 0; i < 16; ++i) acc[i] = 0.f;
      for (int d = 0; d < 128; ++d) {
        const float kv = bf2f(Ks[k * 130 + d]);
#pragma unroll
        for (int i = 0; i < 16; ++i) acc[i] += qt[(tg * 16 + i) * 256 + half * 128 + d] * kv;
      }
#pragma unroll
      for (int i = 0; i < 16; ++i) sc[((tg * 16 + i) * 2 + half) * 129 + k] = acc[i];
    }
    __syncthreads();
    if (tid < 64) {
      float* s = sc + tid * 129;
      for (int r = 0; r < 16; ++r) {
        float best = -3.0e38f; int bi = 0;
        for (int k = 0; k < 128; ++k) { const float v = s[k]; if (v > best) { best = v; bi = k; } }
        tv[tid * 16 + r] = best; ti[tid * 16 + r] = bi;
        s[bi] = -3.0e38f;
      }
    }
    __syncthreads();
    float* cand = qt;
    for (int i = tid; i < 32 * 256; i += NTHR) {
      const int t = i >> 8, a = (i >> 4) & 15, b2 = i & 15;
      cand[i] = tv[(t * 2 + 0) * 16 + a] + tv[(t * 2 + 1) * 16 + b2];
    }
    __syncthreads();
    if (tid < 32) {
      float* cd = cand + tid * 256;
      float ts[16];
      const int row = row0 + tid;
      float mx = 0.f;
#pragma unroll
      for (int r = 0; r < 16; ++r) {
        float best = -3.0e38f; int bi = 0;
        for (int k = 0; k < 256; ++k) { const float v = cd[k]; if (v > best) { best = v; bi = k; } }
        cd[bi] = -3.0e38f;
        ts[r] = best;
        if (r == 0) mx = best;
        const int e = ti[(tid * 2 + 0) * 16 + (bi >> 4)] * 128 + ti[(tid * 2 + 1) * 16 + (bi & 15)];
        P.sel_idx()[(size_t)row * 128 + hd * 16 + r] = e;
      }
      float sum = 0.f;
#pragma unroll
      for (int r = 0; r < 16; ++r) { ts[r] = expf(ts[r] - mx); sum += ts[r]; }
      const float inv = 1.f / sum;
#pragma unroll
      for (int r = 0; r < 16; ++r) P.sel_g()[(size_t)row * 128 + hd * 16 + r] = ts[r] * inv;
    }
  }
}


__device__ __forceinline__ uint32_t mono_u(float f) { const uint32_t u = __float_as_uint(f); return u ^ ((uint32_t)((int)u >> 31) | 0x80000000u); }
__device__ __forceinline__ float unmono_f(uint32_t m) { return __uint_as_float((m & 0x80000000u) ? (m ^ 0x80000000u) : ~m); }
__device__ __forceinline__ uint32_t grp_max_u(uint32_t v) {
  auto a = __builtin_amdgcn_permlane16_swap(v, v, false, false);
  v = a[0] > a[1] ? a[0] : a[1];
  auto b = __builtin_amdgcn_permlane32_swap(v, v, false, false);
  return b[0] > b[1] ? b[0] : b[1];
}

template <int N>
__device__ __forceinline__ void bitonic_sort_desc(uint32_t (&a)[N], int base = 0) { (void)base;
#pragma unroll
  for (int k = 2; k <= N; k <<= 1)
#pragma unroll
    for (int j = k >> 1; j > 0; j >>= 1)
#pragma unroll
      for (int i = 0; i < N; ++i) {
        const int l = i ^ j;
        if (l > i) {
          const bool desc = (i & k) == 0;
          const uint32_t hi = a[i] > a[l] ? a[i] : a[l], lo = a[i] > a[l] ? a[l] : a[i];
          a[i] = desc ? hi : lo; a[l] = desc ? lo : hi;
        }
      }
}
template <int N>
__device__ __forceinline__ void bitonic_merge_desc(uint32_t (&a)[N]) {
#pragma unroll
  for (int j = N >> 1; j > 0; j >>= 1)
#pragma unroll
    for (int i = 0; i < N; ++i) {
      const int l = i ^ j;
      if (l > i) {
        const uint32_t hi = a[i] > a[l] ? a[i] : a[l], lo = a[i] > a[l] ? a[l] : a[i];
        a[i] = hi; a[l] = lo;
      }
    }
}
__device__ __forceinline__ void merge4_top16(uint32_t (&a)[16]) {
  uint32_t e[16], o[16];
#pragma unroll
  for (int i = 0; i < 16; ++i) { auto r = __builtin_amdgcn_permlane16_swap(a[i], a[i], false, false); e[i] = r[0]; o[i] = r[1]; }
#pragma unroll
  for (int i = 0; i < 16; ++i) a[i] = e[i] > o[15 - i] ? e[i] : o[15 - i];
  bitonic_merge_desc<16>(a);
#pragma unroll
  for (int i = 0; i < 16; ++i) { auto r = __builtin_amdgcn_permlane32_swap(a[i], a[i], false, false); e[i] = r[0]; o[i] = r[1]; }
#pragma unroll
  for (int i = 0; i < 16; ++i) a[i] = e[i] > o[15 - i] ? e[i] : o[15 - i];
  bitonic_merge_desc<16>(a);
}
__device__ void ph_peer_topk_mfma(int wv, const Params& P, int layer, int nrows, char* smem, int bid, int nb) {
  const int tid = otid(wv), lane = tid & 63, li = lane & 15, g = lane >> 4;
  unsigned char* ctab = (unsigned char*)smem;
  float* vals = (float*)(smem + 256) + wv * 512;
  int* idxs = (int*)(smem + 256 + 8 * 2048) + wv * 512;
  __syncthreads();
  if (tid < 64) ctab[tid] = 0xFF;
  __syncthreads();
  if (tid == 0) {
    int n = 0, one = 1;
    asm volatile("" : "+s"(one));
#pragma unroll 1
    for (int a = 0; a < 16; ++a)
#pragma unroll 1
      for (int b = 0; b < 16; ++b)
        if ((a + one) * (b + 1) <= 16) { ctab[(n & 3) * 16 + (n >> 2)] = (unsigned char)(a * 16 + b); ++n; }
  }
  const int hd = bid & 7, tg = bid >> 3, ngroups = nb >> 3;
  char* ksm = smem + 33280;
  {
    const bf16_t* ksrc = P.keysb() + (size_t)(layer * 8 + hd) * 2 * 128 * 128;
#pragma unroll
    for (int i = 0; i < 8; ++i) {
      const int idx = tid + i * 512, r = idx >> 4, sg = idx & 15;
      *(uint4*)(ksm + (r * 136 + sg * 8) * 2) = *(const uint4*)(ksrc + (size_t)r * 128 + sg * 8);
    }
  }
  __syncthreads();
  const int ntile = nrows / 16;
  for (int tile = tg + ngroups * wv; tile < ntile && tg < ngroups; tile += ngroups * NWAVE) {
    const int row0 = tile * 16;
    const bf16_t* qp = P.q() + (size_t)(row0 + li) * 2048 + hd * 256 + 8 * g;
    uint32_t win[2][16];
#pragma unroll
    for (int half = 0; half < 2; ++half) {
      bf16x8 qf[4];
#pragma unroll
      for (int t = 0; t < 4; ++t) qf[t] = *(const bf16x8*)(qp + half * 128 + 32 * t);
      const char* kb = ksm + ((half * 128 + li) * 136 + 8 * g) * 2;
      uint32_t pk[32];
#pragma unroll
      for (int kt = 0; kt < 8; ++kt) {
        f32x4 acc = (f32x4){0.f, 0.f, 0.f, 0.f};
#pragma unroll
        for (int t = 0; t < 4; ++t) {
          const bf16x8 a = *(const bf16x8*)(kb + (kt * 16 * 136 + 32 * t) * 2);
          acc = __builtin_amdgcn_mfma_f32_16x16x32_bf16(a, qf[t], acc, 0, 0, 0);
        }
#pragma unroll
        for (int e = 0; e < 4; ++e) pk[kt * 4 + e] = (mono_u(acc[e]) & ~127u) | (uint32_t)(16 * kt + 4 * g + e);
      }
      {
        uint32_t lo16[16], hi16[16];
#pragma unroll
        for (int i = 0; i < 16; ++i) { lo16[i] = pk[i]; hi16[i] = pk[16 + i]; }
        bitonic_sort_desc<16>(lo16);
        bitonic_sort_desc<16>(hi16);
#pragma unroll
        for (int i = 0; i < 16; ++i) lo16[i] = lo16[i] > hi16[15 - i] ? lo16[i] : hi16[15 - i];
        bitonic_merge_desc<16>(lo16);
        merge4_top16(lo16);
#pragma unroll
        for (int r = 0; r < 16; ++r) win[half][r] = lo16[r];
      }
    }
    if (g == 0) {
#pragma unroll
      for (int half = 0; half < 2; ++half)
#pragma unroll
        for (int r = 0; r < 16; ++r) {
          vals[li * 32 + half * 16 + r] = unmono_f(win[half][r] & ~127u);
          idxs[li * 32 + half * 16 + r] = (int)(win[half][r] & 127u);
        }
    }
    __builtin_amdgcn_wave_barrier();
    uint32_t cp[16];
#pragma unroll
    for (int s = 0; s < 16; ++s) {
      const uint32_t ab = ctab[g * 16 + s];
      uint32_t v = 0u;
      if (ab != 0xFFu) v = (mono_u(vals[li * 32 + (ab >> 4)] + vals[li * 32 + 16 + (ab & 15u)]) & ~255u) | ab;
      cp[s] = v;
    }
    bitonic_sort_desc<16>(cp);
    merge4_top16(cp);
    uint32_t cw[16];
#pragma unroll
    for (int r = 0; r < 16; ++r) cw[r] = cp[r];
    const float mx = unmono_f(cw[0] & ~255u);
    float ex[16];
    float sum = 0.f;
#pragma unroll
    for (int r = 0; r < 16; ++r) { ex[r] = __expf(unmono_f(cw[r] & ~255u) - mx); sum += ex[r]; }
    const float inv = 1.f / sum;
    const size_t ob = (size_t)(row0 + li) * 128 + hd * 16;
#pragma unroll
    for (int r = 0; r < 16; ++r) {
      if ((r >> 2) == g) {
        const uint32_t ab = cw[r] & 255u;
        P.sel_idx()[ob + r] = idxs[li * 32 + (ab >> 4)] * 128 + idxs[li * 32 + 16 + (ab & 15u)];
        P.sel_g()[ob + r] = ex[r] * inv;
      }
    }
    __builtin_amdgcn_wave_barrier();
  }
}

__device__ __forceinline__ void cvt8(const uint32_t w, float* f) {
  const f32x2_t a = __builtin_amdgcn_cvt_scalef32_pk_f32_fp4(w, 1.0f, 0), b = __builtin_amdgcn_cvt_scalef32_pk_f32_fp4(w, 1.0f, 1);
  const f32x2_t c = __builtin_amdgcn_cvt_scalef32_pk_f32_fp4(w, 1.0f, 2), e = __builtin_amdgcn_cvt_scalef32_pk_f32_fp4(w, 1.0f, 3);
  f[0] = a.x; f[1] = a.y; f[2] = b.x; f[3] = b.y; f[4] = c.x; f[5] = c.y; f[6] = e.x; f[7] = e.y;
}
__device__ __forceinline__ float swap16_add(float a, float b) {
  auto r = __builtin_amdgcn_permlane16_swap(__float_as_uint(a), __float_as_uint(b), false, false);
  return __uint_as_float(r[0]) + __uint_as_float(r[1]);
}
__device__ void ph_peer_gather(int wv, const Params& P, int layer, int nrows, int bid, int nb) {
  for (int row = bid * NWAVE + wv; row < nrows; row += nb * NWAVE) {
    const int lane = otid(wv) & 63, l5 = lane & 31;
    const bool up = lane >= 32;
    const unsigned char* TU = P.tabU() + l5 * 16;
    const unsigned char* TV = P.tabV() + l5 * 16;
    const int j15 = lane & 15;
    const int rr = ((j15 >> 3) & 1) | ((j15 & 1) << 1), zi = (j15 >> 1) & 3;
    const int srcl = (rr * 4 + (zi & 1) * 2 + (zi >> 1)) * 4;
    float xv[32], o[32];
    {
      const bf16_t* xp = P.u() + (size_t)row * DM + l5 * 32;
      unpack8(*(const uint4*)xp, xv); unpack8(*(const uint4*)(xp + 8), xv + 8);
      unpack8(*(const uint4*)(xp + 16), xv + 16); unpack8(*(const uint4*)(xp + 24), xv + 24);
    }
    const int idx0 = P.sel_idx()[(size_t)row * 128 + lane], idx1 = P.sel_idx()[(size_t)row * 128 + 64 + lane];
    const float gt0 = P.sel_g()[(size_t)row * 128 + lane] * P.invV()[idx0], gt1 = P.sel_g()[(size_t)row * 128 + 64 + lane] * P.invV()[idx1];
    const float iu0 = P.invU()[idx0], iu1 = P.invU()[idx1];
    float d0 = 0.f, d1 = 0.f;
    uint4 bufA[8], bufB[8];
#define PG_LOAD(buf, T, kk) do { _Pragma("unroll") for (int j = 0; j < 8; ++j) { \
      const int k_ = (kk) + 2 * j; const int src_ = k_ < 64 ? idx0 : idx1; \
      const int elo_ = __builtin_amdgcn_readlane(src_, k_ & 63), ehi_ = __builtin_amdgcn_readlane(src_, (k_ & 63) + 1); \
      buf[j] = *(const uint4*)(T + (size_t)(up ? ehi_ : elo_) * 512); } } while (0)
#define PG_DOT(buf, kk) do { float pv[8]; _Pragma("unroll") for (int j = 0; j < 8; ++j) { float s_ = 0.f; const uint32_t w_[4] = {buf[j].x, buf[j].y, buf[j].z, buf[j].w}; \
      _Pragma("unroll") for (int d = 0; d < 4; ++d) { float f[8]; uint32_t wd_ = w_[d]; asm volatile("" : "+v"(wd_) : "v"(s_)); cvt8(wd_, f); \
        _Pragma("unroll") for (int i = 0; i < 8; ++i) s_ += f[i] * xv[d * 8 + i]; } pv[j] = s_; } \
      const float z0 = swap16_add(pv[0], pv[4]), z1 = swap16_add(pv[1], pv[5]), z2 = swap16_add(pv[2], pv[6]), z3 = swap16_add(pv[3], pv[7]); \
      const bool hi8 = (lane & 8) != 0, hi4 = (lane & 4) != 0; \
      const float y0 = (hi8 ? z1 : z0) + DPP_F(hi8 ? z0 : z1, 0x128); \
      const float y1 = (hi8 ? z3 : z2) + DPP_F(hi8 ? z2 : z3, 0x128); \
      float q_ = (hi4 ? y1 : y0) + DPP_F(hi4 ? y0 : y1, 0x141); \
      q_ += DPP_F(q_, 0xB1); q_ += DPP_F(q_, 0x4E); \
      const float t_ = __int_as_float(__builtin_amdgcn_ds_bpermute(srcl * 4, __float_as_int(q_))); \
      const int m_ = ((kk) >> 4) & 3; \
      if ((kk) < 64) d0 = ((lane >> 4) == m_) ? t_ : d0; else d1 = ((lane >> 4) == m_) ? t_ : d1; } while (0)
    PG_LOAD(bufA, TU, 0);
#pragma unroll 1
    for (int kk = 0; kk < 128; kk += 32) {
      PG_LOAD(bufB, TU, kk + 16);
      PG_DOT(bufA, kk);
      if (kk + 32 < 128) PG_LOAD(bufA, TU, kk + 32); else PG_LOAD(bufA, TV, 0);
      PG_DOT(bufB, kk + 16);
    }
    const float act0 = gelu_f(d0 * iu0) * gt0, act1 = gelu_f(d1 * iu1) * gt1;
#pragma unroll
    for (int i = 0; i < 32; ++i) o[i] = 0.f;
#define PG_ACC(buf, kk) do { _Pragma("unroll") for (int j = 0; j < 8; ++j) { const int k_ = (kk) + 2 * j; \
      const int asrc_ = __float_as_int(k_ < 64 ? act0 : act1); \
      const float alo_ = __int_as_float(__builtin_amdgcn_readlane(asrc_, k_ & 63)), ahi_ = __int_as_float(__builtin_amdgcn_readlane(asrc_, (k_ & 63) + 1)); \
      const float a_ = up ? ahi_ : alo_; \
      const uint32_t w_[4] = {buf[j].x, buf[j].y, buf[j].z, buf[j].w}; \
      _Pragma("unroll") for (int d = 0; d < 4; ++d) { float f[8]; uint32_t wd_ = w_[d]; asm volatile("" : "+v"(wd_) : "v"(o[(d * 8 + 31) & 31])); cvt8(wd_, f); \
        _Pragma("unroll") for (int i = 0; i < 8; ++i) o[d * 8 + i] += a_ * f[i]; } } } while (0)
#pragma unroll 1
    for (int kk = 0; kk < 128; kk += 32) {
      PG_LOAD(bufB, TV, kk + 16);
      PG_ACC(bufA, kk);
      if (kk + 32 < 128) PG_LOAD(bufA, TV, kk + 32);
      PG_ACC(bufB, kk + 16);
    }
#undef PG_LOAD
#undef PG_DOT
#undef PG_ACC
#pragma unroll
    for (int i = 0; i < 32; ++i) {
      auto r = __builtin_amdgcn_permlane32_swap(__float_as_uint(o[i]), __float_as_uint(o[i]), false, false);
      o[i] = __uint_as_float(r[0]) + __uint_as_float(r[1]);
    }
    const int lane_e = otid(wv) & 63, l5e = lane_e & 31;
    const bool upe = lane_e >= 32;
    const float* gate = P.mod() + (size_t)(layer * 5 + modrow(row)) * MODW + 5120 + l5e * 32;
    float* hr = P.h() + (size_t)row * DM + l5e * 32;
    float ss = 0.f;
    f32x4 hvv[8], ggv[8];
#pragma unroll
    for (int q = 0; q < 8; ++q) { hvv[q] = *(const f32x4*)(hr + q * 4); ggv[q] = *(const f32x4*)(gate + q * 4); }
#pragma unroll
    for (int q = 0; q < 8; ++q) asm volatile("" : "+v"(hvv[q]), "+v"(ggv[q]));
#pragma unroll
    for (int q = 0; q < 8; ++q) {
      float4 hv = make_float4(hvv[q][0], hvv[q][1], hvv[q][2], hvv[q][3]);
      const float4 gg = make_float4(ggv[q][0], ggv[q][1], ggv[q][2], ggv[q][3]);
      hv.x += gg.x * o[q * 4 + 0]; hv.y += gg.y * o[q * 4 + 1]; hv.z += gg.z * o[q * 4 + 2]; hv.w += gg.w * o[q * 4 + 3];
      if (layer == 0 && !upe) *(float4*)(hr + q * 4) = hv;
      o[q * 4 + 0] = hv.x; o[q * 4 + 1] = hv.y; o[q * 4 + 2] = hv.z; o[q * 4 + 3] = hv.w;
      if (!upe) ss += hv.x * hv.x + hv.y * hv.y + hv.z * hv.z + hv.w * hv.w;
    }
    ss = wave_sum(ss);
    const float rstd = rsqrtf(ss * (1.f / 1024.f) + 1e-6f);
    if (layer == 0) {
      const float* g1 = P.norm1_g + 1024 + l5e * 32;
      const float* mr = P.mod() + (size_t)(5 + modrow(row)) * MODW + l5e * 32;
      if (!upe) {
#pragma unroll
        for (int q = 0; q < 4; ++q) {
          float ov[8];
#pragma unroll
          for (int e = 0; e < 8; ++e) ov[e] = o[q * 8 + e] * rstd * g1[q * 8 + e] * (1.f + mr[1024 + q * 8 + e]) + mr[q * 8 + e];
          *(uint4*)(P.u() + (size_t)row * DM + l5e * 32 + q * 8) = make_uint4(pack2(ov[0], ov[1]), pack2(ov[2], ov[3]), pack2(ov[4], ov[5]), pack2(ov[6], ov[7]));
        }
      }
    } else {
      const float* gf = P.final_g + l5e * 32;
      if (!upe) {
#pragma unroll
        for (int q = 0; q < 8; ++q) {
          const float4 gg = *(const float4*)(gf + q * 4);
          *(float4*)(P.out + (size_t)row * DM + l5e * 32 + q * 4) =
              make_float4(o[q * 4] * rstd * gg.x, o[q * 4 + 1] * rstd * gg.y, o[q * 4 + 2] * rstd * gg.z, o[q * 4 + 3] * rstd * gg.w);
        }
      }
    }
  }
}

__device__ void ph_final(int wv, const Params& P, int bid, int nb) {
  const int wave = otid(wv) >> 6, lane = otid(wv) & 63;
  for (int row = bid * NWAVE + wave; row < NLAT; row += nb * NWAVE) {
    const float* src = P.h() + (size_t)row * DM;
    float4 v[4];
    float ss = 0.f;
#pragma unroll
    for (int i = 0; i < 4; ++i) {
      v[i] = ((const float4*)src)[i * 64 + lane];
      ss += v[i].x * v[i].x + v[i].y * v[i].y + v[i].z * v[i].z + v[i].w * v[i].w;
    }
    ss = wave_sum(ss);
    const float rstd = rsqrtf(ss * (1.f / 1024.f) + 1e-6f);
#pragma unroll
    for (int i = 0; i < 4; ++i) {
      const int idx = i * 256 + lane * 4;
      const float4 gg = *(const float4*)(P.final_g + idx);
      float4 o;
      o.x = v[i].x * rstd * gg.x; o.y = v[i].y * rstd * gg.y; o.z = v[i].z * rstd * gg.z; o.w = v[i].w * rstd * gg.w;
      *(float4*)(P.out + (size_t)row * DM + idx) = o;
    }
  }
}


struct EpiOutproj {
  static constexpr bool PERM = false, AFTER_DRAIN = false;
  float* H; const float* hl; const float* hc; const float* modl;
  __device__ __forceinline__ void operator()(const pg8::f32x4 (&acc)[2][2][4][2], const pg8::Unit& u, int wr, int wc, int fr, int fq) const {
    const int row0 = u.pm * 256 + wr * 64 + fr, col0 = u.pn * 256 + wc * 32 + 4 * fq;
    const float* gate = modl + (size_t)modrow(row0) * MODW + 2048 + col0;
    pg8::f32x4 gv[2][2];
#pragma unroll
    for (int bj = 0; bj < 2; ++bj)
#pragma unroll
      for (int n = 0; n < 2; ++n) gv[bj][n] = *(const pg8::f32x4*)(gate + bj * 128 + n * 16);
    pg8::f32x4 sA[4], sB[4];
#define EO_LOAD(dstv, ai_, m_) do { const float* s_ = hrow(hl, hc, row0 + (ai_) * 128 + (m_) * 16) + col0; \
      dstv[0] = *(const pg8::f32x4*)(s_); dstv[1] = *(const pg8::f32x4*)(s_ + 16); dstv[2] = *(const pg8::f32x4*)(s_ + 128); dstv[3] = *(const pg8::f32x4*)(s_ + 144); } while (0)
#define EO_STORE(srcv, ai_, m_) do { asm volatile("" : "+v"(srcv[0]), "+v"(srcv[1]), "+v"(srcv[2]), "+v"(srcv[3])); \
      float* d_ = H + (size_t)(row0 + (ai_) * 128 + (m_) * 16) * DM + col0; \
      *(pg8::f32x4*)(d_) = srcv[0] + gv[0][0] * acc[ai_][0][m_][0]; *(pg8::f32x4*)(d_ + 16) = srcv[1] + gv[0][1] * acc[ai_][0][m_][1]; \
      *(pg8::f32x4*)(d_ + 128) = srcv[2] + gv[1][0] * acc[ai_][1][m_][0]; *(pg8::f32x4*)(d_ + 144) = srcv[3] + gv[1][1] * acc[ai_][1][m_][1]; } while (0)
    EO_LOAD(sA, 0, 0);
#pragma unroll
    for (int i = 0; i < 8; i += 2) {
      EO_LOAD(sB, (i + 1) >> 2, (i + 1) & 3);
      EO_STORE(sA, i >> 2, i & 3);
      if (i + 2 < 8) EO_LOAD(sA, (i + 2) >> 2, (i + 2) & 3);
      EO_STORE(sB, (i + 1) >> 2, (i + 1) & 3);
    }
#undef EO_LOAD
#undef EO_STORE
  }
};

__device__ __forceinline__ uint32_t fp4_code(float x, float sc) {
  const float a = fabsf(x) * sc;
  const uint32_t c = (uint32_t)(a > 0.25f) + (uint32_t)(a > 0.75f) + (uint32_t)(a > 1.25f) + (uint32_t)(a > 1.75f) +
                     (uint32_t)(a > 2.5f) + (uint32_t)(a > 3.5f) + (uint32_t)(a > 5.0f);
  return c | (x < 0.f ? 8u : 0u);
}
__device__ void ph_convert_tables(int wv, const Params& P, int layer, int bid, int nb) {
  const int lane = otid(wv) & 63;
  for (int it0 = (bid * NWAVE + wv) * 2; it0 < 2 * 16384; it0 += nb * NWAVE * 2) {
    f32x4 v[2][4];
#pragma unroll
    for (int rr = 0; rr < 2; ++rr) {
      const int it = it0 + rr, t = it >> 14, e = it & 16383;
      const float* src = (t == 0 ? P.peer_u : P.peer_v) + ((size_t)layer * 16384 + e) * 1024 + lane * 16;
#pragma unroll
      for (int i = 0; i < 4; ++i) v[rr][i] = ((const f32x4*)src)[i];
    }
#pragma unroll
    for (int rr = 0; rr < 2; ++rr)
#pragma unroll
      for (int i = 0; i < 4; ++i) asm volatile("" : "+v"(v[rr][i]));
#pragma unroll
    for (int rr = 0; rr < 2; ++rr) {
      const int it = it0 + rr, t = it >> 14, e = it & 16383;
      float m = 0.f;
#pragma unroll
      for (int i = 0; i < 4; ++i)
        m = fmaxf(m, fmaxf(fmaxf(fabsf(v[rr][i][0]), fabsf(v[rr][i][1])), fmaxf(fabsf(v[rr][i][2]), fabsf(v[rr][i][3]))));
      m = wave_max(m);
      m = fmaxf(m, 1e-30f);
      const float sc = 6.0f / m, inv = m * (1.0f / 6.0f);
      uint2 o;
      o.x = fp4_code(v[rr][0][0], sc) | (fp4_code(v[rr][0][1], sc) << 4) | (fp4_code(v[rr][0][2], sc) << 8) | (fp4_code(v[rr][0][3], sc) << 12) |
            (fp4_code(v[rr][1][0], sc) << 16) | (fp4_code(v[rr][1][1], sc) << 20) | (fp4_code(v[rr][1][2], sc) << 24) | (fp4_code(v[rr][1][3], sc) << 28);
      o.y = fp4_code(v[rr][2][0], sc) | (fp4_code(v[rr][2][1], sc) << 4) | (fp4_code(v[rr][2][2], sc) << 8) | (fp4_code(v[rr][2][3], sc) << 12) |
            (fp4_code(v[rr][3][0], sc) << 16) | (fp4_code(v[rr][3][1], sc) << 20) | (fp4_code(v[rr][3][2], sc) << 24) | (fp4_code(v[rr][3][3], sc) << 28);
      *(uint2*)((t == 0 ? P.tabU() : P.tabV()) + (size_t)e * 512 + lane * 8) = o;
      if (lane == 0) (t == 0 ? P.invU() : P.invV())[e] = inv;
    }
  }
}

enum {
  PH_PREP = 0, PH_NORM1, PH_INPROJ, PH_CONV, PH_SSDPREP, PH_STATES, PH_SCAN, PH_SSDY, PH_SSDNORM, PH_POOL, PH_NA,
  PH_OUTPROJ, PH_NORM2, PH_QGEMM, PH_TOPK, PH_GATHER, PH_FINAL
};

#define SMEM_BYTES 131072

__device__ __forceinline__ void run_phase(int wv, const Params& P, int ph, int layer, char* smem, int bid, int nb) {
  const float* hl = layer == 0 ? P.x : P.h();
  const float* hc = layer == 0 ? P.ctx : P.h() + (size_t)NLAT * DM;
  const int nrows = layer == 0 ? NTOK : NLAT;
  switch (ph) {
    case PH_PREP:
      for (int i = bid * NTHR + otid(wv); i < 2 * 8 * 2 * 128 * 128; i += nb * NTHR) P.keysb()[i] = f2bf(P.peer_keys[i]);
      for (int i = bid * NTHR + otid(wv); i < 2 * 4 * 128 * 128; i += nb * NTHR) {
        const int k = i & 127, n = (i >> 7) & 127, lg = i >> 14;
        P.poolwT()[i] = f2bf(P.pool_w[((size_t)lg * 128 + k) * 128 + n]);
      }
      ph_mod(wv, P, (float*)smem, bid, nb);
      for (int l = 0; l < 2; ++l) {
        ph_transpose(wv, P.w_in + (size_t)l * 1024 * INW, P.w_inT() + (size_t)l * PW * 1024, 1024, INW, PW, 0, 2560, 32, PW, (float*)smem, bid, nb);
        ph_transpose(wv, P.w_in + (size_t)l * 1024 * INW, P.w_dtT() + (size_t)l * 128 * 1024, 1024, INW, 128, 2560, 1 << 30, 0, 32, (float*)smem, bid, nb);
        ph_transpose(wv, P.w_out + (size_t)l * 2048 * 1024, P.w_outT() + (size_t)l * 1024 * 2048, 2048, 1024, 1024, 0, 1 << 30, 0, 1024, (float*)smem, bid, nb);
        ph_transpose(wv, P.peer_wq + (size_t)l * 1024 * 2048, P.w_qT() + (size_t)l * 2048 * 1024, 1024, 2048, 2048, 0, 1 << 30, 0, 2048, (float*)smem, bid, nb);
      }
      break;
    case PH_NORM1:
      ph_norm(wv, hl, hc, P.norm1_g + layer * 1024, P.mod() + (size_t)layer * 5 * MODW, 0, 1024, NTOK, P.u(), bid, nb);
      break;
    case PH_INPROJ:
    {
      pg8::Gemm g{P.u(), P.w_inT() + (size_t)layer * PW * 1024, NTOK, PW, 1024};
      pg8::StaticOrder S; S.init(g.M, g.N, nb, bid);
      pg8::EpiBf16<0> E{P.p(), PW, nullptr, 0, 0};
      pg8::gemm_phase<pg8::EpiBf16<0>, pg8::StaticOrder, false>(wv, (PG8_LAS unsigned char*)smem, g, S, E, nullptr);
      {
        const int units = (NTOK / 256) * (PW / 256), rem = units % nb;
        const int nidle = rem == 0 ? nb : nb - rem, first_idle = rem == 0 ? 0 : rem;
        if (bid >= first_idle) ph_dtprep(wv, P, layer, smem, bid - first_idle, nidle);
      }
      break;
    }
    case PH_CONV: ph_conv(wv, P, layer, bid, nb); ph_vtranspose(wv, P, smem, bid, nb); break;
    case PH_SSDPREP: ph_ssdprep(wv, P, layer, smem, bid, nb); break;
    case PH_STATES: ph_states_mfma(wv, P, layer, smem, bid, nb); break;
    case PH_SCAN: ph_scan(wv, P, bid, nb); break;
    case PH_SSDY: ph_ssdy_mfma(wv, P, layer, nrows / 128, smem, bid, nb); break;
    case PH_SSDNORM: ph_ssdnorm(wv, P, layer, nrows, bid, nb); break;
    case PH_POOL: ph_pool_mfma(wv, P, layer, nrows, bid, nb); break;
    case PH_NA: ph_na_mfma(wv, P, layer, nrows, smem, bid, nb); break;
    case PH_OUTPROJ:
    {
      pg8::Gemm g{P.concat(), P.w_outT() + (size_t)layer * 1024 * 2048, nrows, 1024, 2048};
      pg8::StaticOrder S; S.init(g.M, g.N, nb, bid);
      EpiOutproj E{P.h(), hl, hc, P.mod() + (size_t)layer * 5 * MODW};
      pg8::gemm_phase<EpiOutproj, pg8::StaticOrder, false>(wv, (PG8_LAS unsigned char*)smem, g, S, E, nullptr);
      break;
    }
    case PH_NORM2:
      ph_norm(wv, P.h(), P.h() + (size_t)NLAT * DM, P.norm2_g + layer * 1024, P.mod() + (size_t)layer * 5 * MODW, 3072, 4096, nrows, P.u(), bid, nb);
      break;
    case PH_QGEMM:
    {
      pg8::Gemm g{P.u(), P.w_qT() + (size_t)layer * 2048 * 1024, nrows, 2048, 1024};
      pg8::StaticOrder S; S.init(g.M, g.N, nb, bid);
      pg8::EpiBf16<0> E{P.q(), 2048, nullptr, 0, 0};
      pg8::gemm_phase<pg8::EpiBf16<0>, pg8::StaticOrder, false>(wv, (PG8_LAS unsigned char*)smem, g, S, E, nullptr);
      ph_convert_tables(wv, P, layer, bid, nb);
      break;
    }
    case PH_TOPK: ph_peer_topk_mfma(wv, P, layer, nrows, smem, bid, nb); break;
    case PH_GATHER: ph_peer_gather(wv, P, layer, nrows, bid, nb); break;
    case PH_FINAL: ph_final(wv, P, bid, nb); break;
  }
}

namespace cg = cooperative_groups;
typedef const __attribute__((address_space(4))) Params* kparams_t;
__device__ __forceinline__ const Params& kp_fresh() {
  kparams_t kp = (kparams_t)__builtin_amdgcn_kernarg_segment_ptr();
  asm volatile("" : "+s"(kp));
  return *(const Params*)kp;
}
__global__ void __launch_bounds__(NTHR) k_mega(Params P_unused) {
  __shared__ __attribute__((aligned(16))) char smem[SMEM_BYTES + 16];
  cg::grid_group grid = cg::this_grid();
  const int bid = blockIdx.x, nb = gridDim.x;
  const int wv = __builtin_amdgcn_readfirstlane(threadIdx.x >> 6);
  if (threadIdx.x == 0) *(uint4*)(smem + SMEM_BYTES) = make_uint4(0u, 0u, 0u, 0u);
  __syncthreads();
  (void)xcd_barrier_post((unsigned*)(kp_fresh().ws + WS_BAR), (volatile LAS unsigned*)(smem + SMEM_BYTES), threadIdx.x == 0);
#define GSYNC() do { XcdBarrier xb_; xb_.bar = (unsigned*)(kp_fresh().ws + WS_BAR); xb_.x = xb_xcc_id(); \
    xb_.st = (volatile LAS unsigned*)(smem + SMEM_BYTES); xcd_barrier(xb_, otid(wv) == 0); } while (0)
  run_phase(wv, kp_fresh(), PH_PREP, 0, smem, bid, nb);
  grid.sync();
  run_phase(wv, kp_fresh(), PH_NORM1, 0, smem, bid, nb); GSYNC();
#pragma unroll 1
  for (int layer = 0; layer < 2; ++layer) {
    run_phase(wv, kp_fresh(), PH_INPROJ, layer, smem, bid, nb); GSYNC();
    run_phase(wv, kp_fresh(), PH_CONV, layer, smem, bid, nb);
    GSYNC();
    run_phase(wv, kp_fresh(), PH_STATES, layer, smem, bid, nb);
    run_phase(wv, kp_fresh(), PH_POOL, layer, smem, bid, nb);
    run_phase(wv, kp_fresh(), PH_NA, layer, smem, bid, nb); GSYNC();
    run_phase(wv, kp_fresh(), PH_SCAN, layer, smem, bid, nb); GSYNC();
    run_phase(wv, kp_fresh(), PH_SSDY, layer, smem, bid, nb); GSYNC();
    run_phase(wv, kp_fresh(), PH_SSDNORM, layer, smem, bid, nb); GSYNC();
    run_phase(wv, kp_fresh(), PH_OUTPROJ, layer, smem, bid, nb); GSYNC();
    run_phase(wv, kp_fresh(), PH_NORM2, layer, smem, bid, nb); GSYNC();
    run_phase(wv, kp_fresh(), PH_QGEMM, layer, smem, bid, nb); GSYNC();
    run_phase(wv, kp_fresh(), PH_TOPK, layer, smem, bid, nb); GSYNC();
    run_phase(wv, kp_fresh(), PH_GATHER, layer, smem, bid, nb);
    if (layer == 0) GSYNC();
  }
}

extern "C" void kernel_launch(void* const* d_in, const int* in_sizes, int n_in, void* d_out, int out_size, void* d_ws,
                              size_t ws_size, hipStream_t stream) {
  Params P{};
  const float* const* in = (const float* const*)d_in;
  P.x = in[0]; P.c = in[1]; P.ctx = in[2]; P.c_ctx = in[3]; P.ada_w = in[4]; P.ada_b = in[5]; P.norm1_g = in[6];
  P.w_in = in[7]; P.conv_w = in[8]; P.conv_b = in[9]; P.a_log = in[10]; P.dt_bias = in[11]; P.d_skip = in[12];
  P.ssd_norm_g = in[13]; P.pool_w = in[14]; P.pool_scale = in[15]; P.na_rpb = in[16]; P.w_out = in[17];
  P.norm2_g = in[18]; P.peer_wq = in[19]; P.peer_keys = in[20]; P.peer_u = in[21]; P.peer_v = in[22]; P.final_g = in[23];
  P.out = (float*)d_out;
  P.ws = (char*)d_ws;
  if (WS_TOTAL > ws_size) { fprintf(stderr, "workspace too small: need %zu have %zu\n", (size_t)WS_TOTAL, ws_size); return; }

  static int grid_blocks = 0;
  if (!grid_blocks) {
    int dev = 0, cus = 0, per_cu = 0;
    hipGetDevice(&dev);
    hipDeviceGetAttribute(&cus, hipDeviceAttributeMultiprocessorCount, dev);
    hipOccupancyMaxActiveBlocksPerMultiprocessor(&per_cu, k_mega, NTHR, 0);
    if (per_cu > 4) per_cu = 4;
    grid_blocks = cus * per_cu;
  }
  hipMemsetAsync((char*)d_ws + WS_BAR, 0, 4096 * 4, stream);
  void* args[] = {&P};
  hipError_t e = hipLaunchCooperativeKernel((void*)k_mega, dim3(grid_blocks), dim3(NTHR), args, 0, stream);
  if (e != hipSuccess) fprintf(stderr, "cooperative launch failed: %s (grid %d)\n", hipGetErrorString(e), grid_blocks);
}
```

```cpp
#include <hip/hip_runtime.h>
#include <hip/hip_bf16.h>
#include <hip/hip_cooperative_groups.h>
#include <stdint.h>
#include <stdio.h>

typedef unsigned short bf16_t;
typedef __attribute__((ext_vector_type(8))) short bf16x8;
typedef __attribute__((ext_vector_type(4))) float f32x4;

#define NTHR 512
#define NWAVE 8
constexpr int DM = 1024;
constexpr int SEQ = 4096;
constexpr int NLAT = 16384;
constexpr int NCTXR = 1024;
constexpr int NTOK = 17408;
constexpr int INW = 4640;
constexpr int PW = 4608;
constexpr int OFF_Z = 0, OFF_XBC = 1024, OFF_POOL = 2560, OFF_Q = 3072, OFF_K = 3584, OFF_V = 4096;
constexpr int NCHUNK = 136;
constexpr int MODW = 6144;

constexpr size_t al256(size_t x) { return (x + 255) & ~(size_t)255; }
constexpr size_t WS_MOD = 0;
constexpr size_t WS_H = WS_MOD + al256((size_t)2 * 5 * MODW * 4);
constexpr size_t WS_P = WS_H + al256((size_t)NTOK * DM * 4);
constexpr size_t WS_TABU = WS_P + (size_t)80 * 1024 * 1024;
constexpr size_t WS_TABV = WS_TABU + (size_t)16384 * 512;
constexpr size_t WS_INVU = WS_TABV + (size_t)16384 * 512;
constexpr size_t WS_INVV = WS_INVU + (size_t)16384 * 4;
constexpr size_t WS_DTRAW = WS_P + al256((size_t)NTOK * PW * 2);
constexpr size_t WS_DTV = WS_DTRAW + al256((size_t)NTOK * 32 * 4);
constexpr size_t WS_CSV = WS_DTV + al256((size_t)NTOK * 32 * 4);
constexpr size_t WS_XBC = WS_CSV + al256((size_t)NTOK * 32 * 4);
constexpr size_t WS_VTL = WS_XBC + al256((size_t)NTOK * 512 * 2);
constexpr size_t WS_VTC = WS_VTL + al256((size_t)4 * 8 * 64 * 4096 * 2);
constexpr size_t WS_KEYSB = WS_VTC + al256((size_t)4 * 8 * 64 * 256 * 2);
constexpr size_t WS_POOLWT = WS_KEYSB + al256((size_t)2 * 8 * 2 * 128 * 128 * 2);
constexpr size_t WS_BT4 = WS_POOLWT + al256((size_t)2 * 4 * 128 * 128 * 2);
constexpr size_t WS_ATOT = WS_BT4 + al256((size_t)NTOK * 256 * 2);
constexpr size_t WS_STATES = WS_XBC + al256((size_t)NTOK * 1536 * 2);
constexpr size_t WS_YSS = WS_ATOT + al256((size_t)NCHUNK * 32 * 4);
static_assert(WS_YSS + (size_t)NTOK * 4 <= WS_STATES, "must fit in the old xbc region");
constexpr size_t WS_CONCAT = WS_STATES + al256((size_t)NCHUNK * 32 * 8192 * 2);
constexpr size_t WS_SELIDX = WS_CONCAT + al256((size_t)NTOK * 2048 * 2);
constexpr size_t WS_SELG = WS_SELIDX + al256((size_t)NTOK * 128 * 4);
constexpr size_t WS_WINT = WS_SELG + al256((size_t)NTOK * 128 * 4);
constexpr size_t WS_WDTT = WS_WINT + al256((size_t)2 * PW * 1024 * 2);
constexpr size_t WS_WOUTT = WS_WDTT + al256((size_t)2 * 128 * 1024 * 2);
constexpr size_t WS_WQT = WS_WOUTT + al256((size_t)2 * 1024 * 2048 * 2);
constexpr size_t WS_BAR = WS_WQT + al256((size_t)2 * 2048 * 1024 * 2);
constexpr size_t WS_XT4 = WS_BAR + al256((size_t)4096 * 4);
constexpr size_t WS_TOTAL = WS_XT4 + al256((size_t)NTOK * 1024 * 2);
static_assert((size_t)4 * 8 * (4096 + 256) * 64 * 2 <= WS_WINT - WS_SELIDX, "K relayout must fit in the sel_idx/sel_g region");
static_assert(WS_INVV + (size_t)16384 * 4 <= WS_DTRAW, "tables must fit in the tail of p");
static_assert((size_t)NTOK * 2048 * 2 <= (size_t)80 * 1024 * 1024, "q must fit below the tables");

struct Params {
  const float *x, *c, *ctx, *c_ctx, *ada_w, *ada_b, *norm1_g, *w_in, *conv_w, *conv_b, *a_log, *dt_bias, *d_skip,
      *ssd_norm_g, *pool_w, *pool_scale, *na_rpb, *w_out, *norm2_g, *peer_wq, *peer_keys, *peer_u, *peer_v, *final_g;
  float* out;
  char* ws;
  __device__ __forceinline__ float* mod() const { return (float*)(ws + WS_MOD); }
  __device__ __forceinline__ float* h() const { return (float*)(ws + WS_H); }
  __device__ __forceinline__ bf16_t* u() const { return (bf16_t*)(ws + WS_CONCAT); }
  __device__ __forceinline__ bf16_t* p() const { return (bf16_t*)(ws + WS_P); }
  __device__ __forceinline__ float* dtraw() const { return (float*)(ws + WS_DTRAW); }
  __device__ __forceinline__ float* dtv() const { return (float*)(ws + WS_DTV); }
  __device__ __forceinline__ float* csv() const { return (float*)(ws + WS_CSV); }
  __device__ __forceinline__ bf16_t* xbc() const { return (bf16_t*)(ws + WS_XBC); }
  __device__ __forceinline__ bf16_t* states() const { return (bf16_t*)(ws + WS_STATES); }
  __device__ __forceinline__ bf16_t* concat() const { return (bf16_t*)(ws + WS_CONCAT); }
  __device__ __forceinline__ bf16_t* q() const { return (bf16_t*)(ws + WS_P); }
  __device__ __forceinline__ int* sel_idx() const { return (int*)(ws + WS_SELIDX); }
  __device__ __forceinline__ float* sel_g() const { return (float*)(ws + WS_SELG); }
  __device__ __forceinline__ bf16_t* w_inT() const { return (bf16_t*)(ws + WS_WINT); }
  __device__ __forceinline__ bf16_t* w_dtT() const { return (bf16_t*)(ws + WS_WDTT); }
  __device__ __forceinline__ bf16_t* w_outT() const { return (bf16_t*)(ws + WS_WOUTT); }
  __device__ __forceinline__ bf16_t* w_qT() const { return (bf16_t*)(ws + WS_WQT); }
  __device__ __forceinline__ bf16_t* vtl() const { return (bf16_t*)(ws + WS_VTL); }
  __device__ __forceinline__ bf16_t* vtc() const { return (bf16_t*)(ws + WS_VTC); }
  __device__ __forceinline__ bf16_t* poolwT() const { return (bf16_t*)(ws + WS_POOLWT); }
  __device__ __forceinline__ bf16_t* keysb() const { return (bf16_t*)(ws + WS_KEYSB); }
  __device__ __forceinline__ bf16_t* xt4() const { return (bf16_t*)(ws + WS_XT4); }
  __device__ __forceinline__ bf16_t* bt4() const { return (bf16_t*)(ws + WS_BT4); }
  __device__ __forceinline__ float* wst() const { return (float*)(ws + WS_DTRAW); }
  __device__ __forceinline__ float* cst() const { return (float*)(ws + WS_CSV); }
  __device__ __forceinline__ float* dtt() const { return (float*)(ws + WS_DTV); }
  __device__ __forceinline__ float* yss() const { return (float*)(ws + WS_YSS); }
  __device__ __forceinline__ float* atot() const { return (float*)(ws + WS_ATOT); }
  __device__ __forceinline__ bf16_t* bfr() const { return (bf16_t*)(ws + WS_XBC); }
  __device__ __forceinline__ bf16_t* cfr() const { return (bf16_t*)(ws + WS_XBC + (size_t)NTOK * 256 * 2); }
  __device__ __forceinline__ bf16_t* ktl() const { return (bf16_t*)(ws + WS_SELIDX); }
  __device__ __forceinline__ bf16_t* ktc() const { return (bf16_t*)(ws + WS_SELIDX + (size_t)4 * 8 * 4096 * 64 * 2); }
  __device__ __forceinline__ unsigned char* tabU() const { return (unsigned char*)(ws + WS_TABU); }
  __device__ __forceinline__ unsigned char* tabV() const { return (unsigned char*)(ws + WS_TABV); }
  __device__ __forceinline__ float* invU() const { return (float*)(ws + WS_INVU); }
  __device__ __forceinline__ float* invV() const { return (float*)(ws + WS_INVV); }
};

__device__ __forceinline__ int otid(int wv) {
  int l;
  asm volatile("v_mbcnt_lo_u32_b32 %0, -1, 0\n\tv_mbcnt_hi_u32_b32 %0, -1, %0" : "=v"(l));
  return (wv << 6) | l;
}
__device__ __forceinline__ float bf2f(bf16_t v) { return __uint_as_float(((uint32_t)v) << 16); }
__device__ __forceinline__ bf16_t f2bf(float f) {
  uint32_t u = __float_as_uint(f);
  u += 0x7fffu + ((u >> 16) & 1u);
  return (bf16_t)(u >> 16);
}
#define DPP_F(v, ctrl) __int_as_float(__builtin_amdgcn_update_dpp(0, __float_as_int(v), (ctrl), 0xf, 0xf, true))
__device__ __forceinline__ float wave_sum(float v) {
  v += DPP_F(v, 0xB1);
  v += DPP_F(v, 0x4E);
  v += DPP_F(v, 0x141);
  v += DPP_F(v, 0x140);
  const int iv = __float_as_int(v);
  return __int_as_float(__builtin_amdgcn_readlane(iv, 0)) + __int_as_float(__builtin_amdgcn_readlane(iv, 16)) +
         __int_as_float(__builtin_amdgcn_readlane(iv, 32)) + __int_as_float(__builtin_amdgcn_readlane(iv, 48));
}
__device__ __forceinline__ float wave_max(float v) {
  v = fmaxf(v, DPP_F(v, 0xB1));
  v = fmaxf(v, DPP_F(v, 0x4E));
  v = fmaxf(v, DPP_F(v, 0x141));
  v = fmaxf(v, DPP_F(v, 0x140));
  const int iv = __float_as_int(v);
  return fmaxf(fmaxf(__int_as_float(__builtin_amdgcn_readlane(iv, 0)), __int_as_float(__builtin_amdgcn_readlane(iv, 16))),
               fmaxf(__int_as_float(__builtin_amdgcn_readlane(iv, 32)), __int_as_float(__builtin_amdgcn_readlane(iv, 48))));
}
__device__ __forceinline__ float silu_f(float v) { return v / (1.f + expf(-v)); }
__device__ __forceinline__ float softplus_f(float v) { return fmaxf(v, 0.f) + log1pf(expf(-fabsf(v))); }
__device__ __forceinline__ float gelu_f(float v) { return 0.5f * v * (1.f + erff(v * 0.70710678118654752f)); }

__device__ __forceinline__ void unpack8(const uint4 v, float* f) {
  f[0] = __uint_as_float(v.x << 16); f[1] = __uint_as_float(v.x & 0xffff0000u);
  f[2] = __uint_as_float(v.y << 16); f[3] = __uint_as_float(v.y & 0xffff0000u);
  f[4] = __uint_as_float(v.z << 16); f[5] = __uint_as_float(v.z & 0xffff0000u);
  f[6] = __uint_as_float(v.w << 16); f[7] = __uint_as_float(v.w & 0xffff0000u);
}
__device__ __forceinline__ uint32_t pack2(float a, float b) { return (uint32_t)f2bf(a) | ((uint32_t)f2bf(b) << 16); }
typedef float f32x2_t __attribute__((ext_vector_type(2)));
typedef unsigned u32x4_t __attribute__((ext_vector_type(4)));
typedef short s16x4 __attribute__((ext_vector_type(4)));
typedef __attribute__((address_space(3))) s16x4 lds_s16x4;
__device__ __forceinline__ bf16x8 tr_read2(const char* a0, const char* a1) {
  const s16x4 a = __builtin_amdgcn_ds_read_tr16_b64_v4i16((lds_s16x4*)a0);
  const s16x4 b = __builtin_amdgcn_ds_read_tr16_b64_v4i16((lds_s16x4*)a1);
  return (bf16x8){a[0], a[1], a[2], a[3], b[0], b[1], b[2], b[3]};
}

__device__ __forceinline__ const float* hrow(const float* hl, const float* hc, int row) {
  return row < NLAT ? hl + (size_t)row * DM : hc + (size_t)(row - NLAT) * DM;
}
__device__ __forceinline__ int modrow(int row) { return row < NLAT ? (row >> 12) : 4; }

namespace pg8 {
#define PG8_LAS __attribute__((address_space(3)))
typedef unsigned short bf16_t;
typedef short bf16x8 __attribute__((ext_vector_type(8)));
typedef float f32x4 __attribute__((ext_vector_type(4)));
typedef unsigned u32x4 __attribute__((ext_vector_type(4)));
constexpr int BM = 256, BK = 64, HALF = 128, HTB = HALF * BK * 2  , STAGE_BYTES = 8 * HTB, NXCD = 8, WGM = 8;

__host__ __device__ __forceinline__ int lds_byte(int r, int c) { const int st = (r >> 4) * 2 + (c >> 5), rr = r & 15, cc = c & 31, ob = rr * 64 + cc * 2; return st * 1024 + (ob ^ (((ob >> 9) & 1) << 5)); }
__host__ __device__ __forceinline__ void stage_rc(int b, int& R, int& C) { const int st = b / 1024, sb = b % 1024, swz = sb ^ (((sb >> 9) & 1) << 5); R = (st >> 1) * 16 + swz / 64; C = (st & 1) * 32 + (swz % 64) / 2; }
__host__ __device__ __forceinline__ int perm32(int rho) { const int n = rho >> 4, i = rho & 15; return 8 * (i >> 2) + 4 * n + (i & 3); }

struct Unit { int pm, pn; };
struct Gemm { const bf16_t* A; const bf16_t* Bt; int M, N, K; };

struct StaticOrder {
    int nM, nN, nwg, G, c;
    __host__ __device__ void init(int M, int N, int G_, int c_) { nM = M / BM; nN = N / BM; nwg = nM * nN; G = G_; c = c_; }
    __host__ __device__ bool next(int i, Unit& u) const {
        const long L = (long)i * G + c; if (L >= nwg) return false;
        int wgid = (int)L; { const int q = nwg / NXCD, r = nwg % NXCD, xcd = wgid % NXCD, off = wgid / NXCD; wgid = (xcd < r ? xcd * (q + 1) : r * (q + 1) + (xcd - r) * q) + off; }
        const int nig = WGM * nN, gid = wgid / nig, fm = gid * WGM, gsz = (nM - fm) < WGM ? (nM - fm) : WGM;
        u.pm = fm + ((wgid % nig) % gsz); u.pn = (wgid % nig) / gsz; return true;
    }
    __device__ __forceinline__ void a_ready(const Unit&) const {}
    __device__ __forceinline__ void done(const Unit&) const {}
};

__device__ __forceinline__ unsigned cvt_pk_bf16(float lo, float hi) { unsigned r; asm volatile("v_cvt_pk_bf16_f32 %0, %1, %2" : "=v"(r) : "v"(lo), "v"(hi)); return r; }
typedef float f32x2 __attribute__((ext_vector_type(2)));
__device__ __forceinline__ f32x2 gelu_pk(f32x2 v) { return v; }
template <int ACT  > struct EpiBf16 {
    static constexpr bool PERM = true, AFTER_DRAIN = false; static constexpr int MIDK_T = 0;
    bf16_t* O; int ldc; const float* bias; int split_cols; size_t split_stride;
    __device__ __forceinline__ void operator()(const f32x4 (&acc)[2][2][4][2], const Unit& u, int wr, int wc, int fr, int fq) const {
        const int row0 = u.pm * BM + wr * 64 + fr; int colt = u.pn * BM; bf16_t* base = O;
        if (split_cols) { const int t = colt / split_cols; base += (size_t)t * split_stride; colt -= t * split_cols; }
        const int col0 = colt + wc * 32 + 8 * fq, bcol0 = u.pn * BM + wc * 32 + 8 * fq;
        f32x4 bv[2][2];
#pragma unroll
        for (int bj = 0; bj < 2; ++bj)
#pragma unroll
            for (int n = 0; n < 2; ++n) bv[bj][n] = bias ? *(const f32x4*)(bias + bcol0 + bj * HALF + 4 * n) : (f32x4){0.f, 0.f, 0.f, 0.f};
#pragma unroll
        for (int ai = 0; ai < 2; ++ai)
#pragma unroll
            for (int m = 0; m < 4; ++m) { bf16_t* rowp = base + (size_t)(row0 + ai * HALF + m * 16) * ldc + col0;
#pragma unroll
                for (int bj = 0; bj < 2; ++bj) { f32x4 v0 = acc[ai][bj][m][0] + bv[bj][0], v1 = acc[ai][bj][m][1] + bv[bj][1];
                    if (ACT == 1) { f32x2 a = gelu_pk((f32x2){v0[0], v0[1]}), b = gelu_pk((f32x2){v0[2], v0[3]}), c = gelu_pk((f32x2){v1[0], v1[1]}), d = gelu_pk((f32x2){v1[2], v1[3]});
                        v0 = (f32x4){a.x, a.y, b.x, b.y}; v1 = (f32x4){c.x, c.y, d.x, d.y}; }
                    if (ACT == 2) {
#pragma unroll
                        for (int j = 0; j < 4; ++j) { v0[j] = 0.5f * v0[j] * (1.0f + erff(v0[j] * 0.70710678f)); v1[j] = 0.5f * v1[j] * (1.0f + erff(v1[j] * 0.70710678f)); } }
                    u32x4 w; w.x = cvt_pk_bf16(v0[0], v0[1]); w.y = cvt_pk_bf16(v0[2], v0[3]); w.z = cvt_pk_bf16(v1[0], v1[1]); w.w = cvt_pk_bf16(v1[2], v1[3]);
                    *(u32x4*)(rowp + bj * HALF) = w; } }
    }
};

template <class Epi, class Sched, bool STAMP = false>
__device__ __forceinline__ void gemm_phase(int wv, PG8_LAS unsigned char* lds, const Gemm g, const Sched& S, const Epi& E, unsigned long long* stamps) {
    const int tid = otid(wv), wid = __builtin_amdgcn_readfirstlane(tid >> 6), lane = tid & 63, wr = wid >> 2, wc = wid & 3, fr = lane & 15, fq = lane >> 4;
    const int K = g.K, nt = K / BK;
    int ts_lo = 0, ts_hi = 0, nts = 0; const unsigned long long rt_entry = STAMP ? (unsigned long long)wall_clock64() : 0ull;
#define PG8_STAMP() do { if (STAMP && wid == 0 && nts < 64) { const unsigned long long _c = (unsigned long long)clock64(); \
        ts_lo = (lane == nts) ? (int)(unsigned)_c : ts_lo; ts_hi = (lane == nts) ? (int)(unsigned)(_c >> 32) : ts_hi; ++nts; } } while (0)
    PG8_STAMP();
    unsigned voffA[2], voffB[2];
#pragma unroll
    for (int i = 0; i < 2; ++i) { int R, C; stage_rc(tid * 16 + i * 8192, R, C); const int Rb = Epi::PERM ? ((R & ~31) + perm32(R & 31)) : R;
        voffA[i] = (unsigned)(R * K + C) * 2u; voffB[i] = (unsigned)(Rb * K + C) * 2u; }
    const size_t kstep = (size_t)(BK * 2);
    const size_t hstep = (size_t)HALF * K * 2;
    const size_t tstep = 2 * hstep;
    const unsigned ldsw = (unsigned)wid * 1024u;
    const int aoff = lds_byte(wr * 64 + fr, fq * 8), boff = lds_byte(wc * 32 + fr, fq * 8);
#define PG8_SA(b, h) (((b) * 2 + (h)) * HTB)
#define PG8_SB(b, h) ((4 + (b) * 2 + (h)) * HTB)
#define PG8_STAGE(bufoff, gbase, voff) do { _Pragma("unroll") for (int _i = 0; _i < 2; ++_i) \
        __builtin_amdgcn_global_load_lds((const unsigned*)((const char*)(gbase) + (voff)[_i]), (PG8_LAS unsigned*)(lds + (bufoff) + ldsw + _i * 8192), 16, 0, 0); } while (0)
#define PG8_LDA(dst, b, h) do { _Pragma("unroll") for (int m = 0; m < 4; ++m) _Pragma("unroll") for (int k = 0; k < 2; ++k) dst[m][k] = *(const PG8_LAS bf16x8*)(lds + PG8_SA(b, h) + aoff + m * 2048 + k * 1024); } while (0)
#define PG8_LDB(dst, b, h) do { _Pragma("unroll") for (int n = 0; n < 2; ++n) _Pragma("unroll") for (int k = 0; k < 2; ++k) dst[n][k] = *(const PG8_LAS bf16x8*)(lds + PG8_SB(b, h) + boff + n * 2048 + k * 1024); } while (0)
#define PG8_MMA(ai, bj, At, Bt) do { __builtin_amdgcn_s_setprio(1); _Pragma("unroll") for (int m = 0; m < 4; ++m) _Pragma("unroll") for (int n = 0; n < 2; ++n) _Pragma("unroll") for (int k = 0; k < 2; ++k) \
        acc[ai][bj][m][n] = __builtin_amdgcn_mfma_f32_16x16x32_bf16(Bt[n][k], At[m][k], acc[ai][bj][m][n], 0, 0, 0); __builtin_amdgcn_s_setprio(0); } while (0)
#define PG8_WAIT_V(n) asm volatile("s_waitcnt vmcnt(" #n ")" ::: "memory")
#define PG8_WAIT_L(n) asm volatile("s_waitcnt lgkmcnt(" #n ")" ::: "memory")
#define PG8_BAR __builtin_amdgcn_s_barrier()
#define PG8_SCHED __builtin_amdgcn_sched_barrier(0)
    Unit cur, nxt; int ui = 0;
    if (!S.next(0, cur)) return;
    f32x4 acc[2][2][4][2];
#pragma unroll
    for (int a = 0; a < 2; ++a)
#pragma unroll
        for (int b = 0; b < 2; ++b)
#pragma unroll
            for (int m = 0; m < 4; ++m)
#pragma unroll
                for (int n = 0; n < 2; ++n) acc[a][b][m][n] = (f32x4){0.f, 0.f, 0.f, 0.f};
    bf16x8 At[4][2], B0[2][2], B1[2][2];
    const char* cA = (const char*)g.A + (size_t)cur.pm * tstep; const char* cB = (const char*)g.Bt + (size_t)cur.pn * tstep;
    S.a_ready(cur);
    PG8_STAGE(PG8_SB(0, 0), cB, voffB); PG8_STAGE(PG8_SA(0, 0), cA, voffA); PG8_STAGE(PG8_SB(0, 1), cB + hstep, voffB); PG8_STAGE(PG8_SA(0, 1), cA + hstep, voffA);
    if (wr == 1) PG8_BAR;
    PG8_WAIT_V(4); PG8_BAR;
    PG8_STAGE(PG8_SB(1, 0), cB + kstep, voffB); PG8_STAGE(PG8_SA(1, 0), cA + kstep, voffA); PG8_STAGE(PG8_SB(1, 1), cB + hstep + kstep, voffB);
    PG8_WAIT_V(6); PG8_BAR;
    PG8_STAMP();
    for (;;) {
        const bool has_next = S.next(ui + 1, nxt);
        const char* nA = has_next ? (const char*)g.A + (size_t)nxt.pm * tstep : cA; const char* nB = has_next ? (const char*)g.Bt + (size_t)nxt.pn * tstep : cB;
        for (int t = 0; t < nt; t += 2) {
            if constexpr (Epi::MIDK_T > 0) { if (t == Epi::MIDK_T) E.midk(acc, cur, wr, wc, fr, fq); }
            const bool last = (t == nt - 2);
            const char* a1 = cA + (size_t)(t + 1) * kstep;
            const char* a2 = last ? nA : cA + (size_t)(t + 2) * kstep; const char* b2 = last ? nB : cB + (size_t)(t + 2) * kstep;
            const char* a3 = a2 + kstep; const char* b3 = b2 + kstep;
            if (last && has_next) S.a_ready(nxt);
            PG8_LDB(B0, 0, 0); PG8_SCHED; PG8_LDA(At, 0, 0); PG8_STAGE(PG8_SA(1, 1), a1 + hstep, voffA);
            PG8_WAIT_L(8); PG8_BAR; PG8_WAIT_L(0); PG8_MMA(0, 0, At, B0); PG8_BAR; PG8_SCHED;
            PG8_LDB(B1, 0, 1); PG8_STAGE(PG8_SB(0, 0), b2, voffB);
            PG8_BAR; PG8_WAIT_L(0); PG8_MMA(0, 1, At, B1); PG8_BAR;
            PG8_LDA(At, 0, 1); PG8_STAGE(PG8_SA(0, 0), a2, voffA);
            PG8_BAR; PG8_WAIT_L(0); PG8_MMA(1, 0, At, B0); PG8_BAR; PG8_SCHED;
            PG8_STAGE(PG8_SB(0, 1), b2 + hstep, voffB);
            PG8_WAIT_V(6); PG8_BAR; PG8_MMA(1, 1, At, B1); PG8_BAR;
            PG8_LDB(B0, 1, 0); PG8_SCHED; PG8_LDA(At, 1, 0); PG8_STAGE(PG8_SA(0, 1), a2 + hstep, voffA);
            PG8_WAIT_L(8); PG8_BAR; PG8_WAIT_L(0); PG8_MMA(0, 0, At, B0); PG8_BAR; PG8_SCHED;
            PG8_LDB(B1, 1, 1); PG8_STAGE(PG8_SB(1, 0), b3, voffB);
            PG8_BAR; PG8_WAIT_L(0); PG8_MMA(0, 1, At, B1); PG8_BAR;
            PG8_LDA(At, 1, 1); PG8_STAGE(PG8_SA(1, 0), a3, voffA);
            PG8_BAR; PG8_WAIT_L(0); PG8_MMA(1, 0, At, B0); PG8_BAR; PG8_SCHED;
            PG8_STAGE(PG8_SB(1, 1), b3 + hstep, voffB);
            PG8_WAIT_V(6); PG8_BAR; PG8_MMA(1, 1, At, B1); PG8_BAR;
        }
        PG8_STAMP();
        if constexpr (!Epi::AFTER_DRAIN) { E(acc, cur, wr, wc, fr, fq); S.done(cur); }
        PG8_STAMP();
        if (!has_next) break;
#pragma unroll
        for (int a = 0; a < 2; ++a)
#pragma unroll
            for (int b = 0; b < 2; ++b)
#pragma unroll
                for (int m = 0; m < 4; ++m)
#pragma unroll
                    for (int n = 0; n < 2; ++n) acc[a][b][m][n] = (f32x4){0.f, 0.f, 0.f, 0.f};
        cur = nxt; cA = nA; cB = nB; ++ui;
    }
    PG8_WAIT_V(0);
    if (wr == 0) PG8_BAR;
    PG8_BAR;
    if constexpr (Epi::AFTER_DRAIN) { E.fused(acc, cur, wr, wc, fr, fq, lds, wid, lane); S.done(cur); }
    PG8_STAMP();
    if (STAMP && wid == 0) { stamps[lane] = lane < nts ? (((unsigned long long)(unsigned)ts_hi << 32) | (unsigned)ts_lo) : 0ull;
        if (lane == 62) stamps[62] = rt_entry; if (lane == 63) stamps[63] = (unsigned long long)wall_clock64(); }
#undef PG8_STAMP
#undef PG8_SA
#undef PG8_SB
#undef PG8_STAGE
#undef PG8_LDA
#undef PG8_LDB
#undef PG8_MMA
#undef PG8_WAIT_V
#undef PG8_WAIT_L
#undef PG8_BAR
#undef PG8_SCHED
}
}

#define XB_TMO      128
#define XB_XCNT(j)  (256  + 64 * (j))
#define XB_XSUB(j)  (1280 + 64 * (j))
#define XB_XGEN(j)  (2304 + 64 * (j))
#define XB_TOP      3328
#define XB_TOPGEN   3392
#define XCD_BAR_WORDS 3456
#define XB_SPIN_CAP (1u << 27)
#define LAS __attribute__((address_space(3)))

__device__ __forceinline__ unsigned xb_ld(unsigned* p)              { return __hip_atomic_load(p, __ATOMIC_RELAXED, __HIP_MEMORY_SCOPE_AGENT); }
__device__ __forceinline__ unsigned xb_add(unsigned* p, unsigned v) { return __hip_atomic_fetch_add(p, v, __ATOMIC_RELAXED, __HIP_MEMORY_SCOPE_AGENT); }
__device__ __forceinline__ unsigned xb_xcc_id() { return (unsigned)__builtin_amdgcn_s_getreg((3 << 11) | 20) & 0xFu; }
#define XB_SPIN(cond, bar) do { unsigned _sp = 0; while (cond) { __builtin_amdgcn_s_sleep(1); \
    if ((++_sp & 255u) == 0u) { if (xb_ld(&(bar)[XB_TMO])) break; if (_sp > XB_SPIN_CAP) { atomicAdd(&(bar)[XB_TMO], 1u); break; } } } } while (0)

struct XcdBarrier {
    unsigned* bar; unsigned x;
    volatile LAS unsigned* st;
};

__device__ __forceinline__ XcdBarrier xcd_barrier_post(unsigned* bar, volatile LAS unsigned* st, bool xb_t0) {
    XcdBarrier b; b.bar = bar; b.x = xb_xcc_id(); b.st = st;
    if (xb_t0) (void)xb_add(&bar[XB_XCNT(b.x)], 1u);
    return b;
}
__device__ __forceinline__ void xcd_barrier_complete(unsigned* bar, unsigned x, unsigned& nloc, unsigned& nx) {
    const unsigned G = gridDim.x * gridDim.y * gridDim.z;
    unsigned sum, cnt, mine, sp = 0u;
    for (;;) {
        sum = 0u; cnt = 0u; mine = 0u;
#pragma unroll
        for (unsigned j = 0; j < 16; ++j) { const unsigned c = xb_ld(&bar[XB_XCNT(j)]); sum += c; cnt += (c > 0u) ? 1u : 0u; mine = (j == x) ? c : mine; }
        if (sum == G) break;
        __builtin_amdgcn_s_sleep(1);
        if ((++sp & 255u) == 0u) { if (xb_ld(&bar[XB_TMO])) break; if (sp > XB_SPIN_CAP) { atomicAdd(&bar[XB_TMO], 1u); break; } }
    }
    nloc = mine > 0u ? mine : 1u; nx = cnt > 0u ? cnt : 1u;
}

__device__ __forceinline__ void xcd_barrier(const XcdBarrier& b, bool xb_t0) {
    asm volatile("s_waitcnt vmcnt(0)" ::: "memory");
    __syncthreads();
    if (xb_t0) {
        unsigned* bar = b.bar;
        __builtin_amdgcn_s_waitcnt(0);
        unsigned nloc = b.st[0], nx = b.st[1];
        if (nloc == 0u) { xcd_barrier_complete(bar, b.x, nloc, nx); b.st[0] = nloc; b.st[1] = nx; }
        const unsigned old = xb_add(&bar[XB_XSUB(b.x)], 1u);
        const unsigned gen = old / nloc;
        if (old + 1u == (gen + 1u) * nloc) {
            __builtin_amdgcn_fence(__ATOMIC_RELEASE, "agent");
            asm volatile("s_waitcnt vmcnt(0)" ::: "memory");
            const unsigned og = xb_add(&bar[XB_TOP], 1u);
            const unsigned tg = og / nx;
            if (og + 1u == (tg + 1u) * nx) xb_add(&bar[XB_TOPGEN], 1u);
            else XB_SPIN(xb_ld(&bar[XB_TOPGEN]) == tg, bar);
            __builtin_amdgcn_fence(__ATOMIC_ACQUIRE, "agent");
            xb_add(&bar[XB_XGEN(b.x)], 1u);
            asm volatile("s_waitcnt vmcnt(0)" ::: "memory");
        } else {
            XB_SPIN(xb_ld(&bar[XB_XGEN(b.x)]) == gen, bar);
            __builtin_amdgcn_fence(__ATOMIC_ACQUIRE, "agent");
            asm volatile("s_waitcnt vmcnt(0)" ::: "memory");
        }
    }
    __syncthreads();
}


__device__ void ph_transpose(int wv, const float* __restrict__ src, bf16_t* __restrict__ dst, int K, int N, int Npad,
                             int col0, int skip_from, int skip, int nvalid, float* tile0, int bid, int nb,
                             const float* kscale = nullptr, int kscale_n = 0) {
  const int tk = K / 32, tn = Npad / 32;
  const int tid = otid(wv), half = tid >> 8, t5 = tid & 255;
  const int tx = t5 & 31, ty = t5 >> 5;
  float* tile = tile0 + half * (32 * 33);
  for (int tb = bid * 2; tb < tk * tn; tb += nb * 2) {
    const int t = tb + half;
    const bool act = t < tk * tn;
    const int kt = t / tn, nt = t % tn;
    __syncthreads();
    if (act)
      for (int i = ty; i < 32; i += 8) {
        const int k = kt * 32 + i, n = nt * 32 + tx;
        const int cc = col0 + n + (n >= skip_from ? skip : 0);
        const float ks = (kscale != nullptr && k < kscale_n) ? kscale[k] : 1.f;
        tile[i * 33 + tx] = (n < nvalid) ? src[(size_t)k * N + cc] * ks : 0.f;
      }
    __syncthreads();
    if (act)
      for (int i = ty; i < 32; i += 8) {
        const int n = nt * 32 + i, k = kt * 32 + tx;
        dst[(size_t)n * K + k] = f2bf(tile[tx * 33 + i]);
      }
  }
}

__device__ void ph_mod(int wv, const Params& P, float* sm, int bid, int nb) {
  const int tid = otid(wv);
  float* sv = sm;
  float* red = sm + 5 * 1024;
  for (int i = tid; i < 5 * 1024; i += NTHR) {
    const float v = (i < 4096) ? P.c[i] : P.c_ctx[i - 4096];
    sv[i] = silu_f(v);
  }
  __syncthreads();
  const int c4 = tid & 15, kg = tid >> 4;
  for (int it = bid; it < 192; it += nb) {
    const int layer = it / 96, cb = it % 96;
    const float4* W = (const float4*)(P.ada_w + (size_t)layer * 1024 * MODW + cb * 64) + c4;
    float4 a[5];
#pragma unroll
    for (int r = 0; r < 5; ++r) a[r] = make_float4(0.f, 0.f, 0.f, 0.f);
#pragma unroll 8
    for (int kk = 0; kk < 32; ++kk) {
      const int k = kg * 32 + kk;
      const float4 w = W[(size_t)k * (MODW / 4)];
#pragma unroll
      for (int r = 0; r < 5; ++r) {
        const float s = sv[r * 1024 + k];
        a[r].x += s * w.x; a[r].y += s * w.y; a[r].z += s * w.z; a[r].w += s * w.w;
      }
    }
#pragma unroll
    for (int r = 0; r < 5; ++r) *(float4*)(red + ((kg * 16 + c4) * 5 + r) * 4) = a[r];
    __syncthreads();
    if (tid < 320) {
      const int r = tid >> 6, c = tid & 63;
      float s = 0.f;
      for (int g = 0; g < 32; ++g) s += red[((g * 16 + (c >> 2)) * 5 + r) * 4 + (c & 3)];
      P.mod()[(size_t)(layer * 5 + r) * MODW + cb * 64 + c] = s + P.ada_b[layer * MODW + cb * 64 + c];
    }
    __syncthreads();
  }
}

__device__ void ph_norm(int wv, const float* hl, const float* hc, const float* __restrict__ g, const float* __restrict__ modl,
                        int shift_off, int scale_off, int nrows, bf16_t* __restrict__ dst, int bid, int nb) {
  const int wave = otid(wv) >> 6, lane = otid(wv) & 63;
  for (int row = bid * NWAVE + wave; row < nrows; row += nb * NWAVE) {
    const float* src = hrow(hl, hc, row);
    const float* mr = modl + (size_t)modrow(row) * MODW;
    float4 v[4];
    float ss = 0.f;
#pragma unroll
    for (int i = 0; i < 4; ++i) {
      v[i] = ((const float4*)src)[i * 64 + lane];
      ss += v[i].x * v[i].x + v[i].y * v[i].y + v[i].z * v[i].z + v[i].w * v[i].w;
    }
    ss = wave_sum(ss);
    const float rstd = rsqrtf(ss * (1.f / 1024.f) + 1e-6f);
    f32x4 ggv[4], scv[4], shv[4];
#pragma unroll
    for (int i = 0; i < 4; ++i) {
      const int idx = i * 256 + lane * 4;
      ggv[i] = *(const f32x4*)(g + idx); scv[i] = *(const f32x4*)(mr + scale_off + idx); shv[i] = *(const f32x4*)(mr + shift_off + idx);
    }
#pragma unroll
    for (int i = 0; i < 4; ++i) asm volatile("" : "+v"(ggv[i]), "+v"(scv[i]), "+v"(shv[i]));
#pragma unroll
    for (int i = 0; i < 4; ++i) {
      const int idx = i * 256 + lane * 4;
      const float4 gg = make_float4(ggv[i][0], ggv[i][1], ggv[i][2], ggv[i][3]);
      const float4 sc = make_float4(scv[i][0], scv[i][1], scv[i][2], scv[i][3]);
      const float4 sh = make_float4(shv[i][0], shv[i][1], shv[i][2], shv[i][3]);
      const float o0 = v[i].x * rstd * gg.x * (1.f + sc.x) + sh.x;
      const float o1 = v[i].y * rstd * gg.y * (1.f + sc.y) + sh.y;
      const float o2 = v[i].z * rstd * gg.z * (1.f + sc.z) + sh.z;
      const float o3 = v[i].w * rstd * gg.w * (1.f + sc.w) + sh.w;
      uint2 pk;
      pk.x = (uint32_t)f2bf(o0) | ((uint32_t)f2bf(o1) << 16);
      pk.y = (uint32_t)f2bf(o2) | ((uint32_t)f2bf(o3) << 16);
      *(uint2*)(dst + (size_t)row * DM + idx) = pk;
    }
  }
}

__device__ void ph_conv(int wv, const Params& P, int layer, int bid, int nb) {
  const float* cw = P.conv_w + (size_t)layer * 3 * 1536;
  const float* cb = P.conv_b + (size_t)layer * 1536;
  {
    int zs_ = nb * NTHR;
    asm volatile("" : "+s"(zs_));
#pragma unroll 1
    for (int i = bid * NTHR + otid(wv); i < NTOK; i += zs_) P.yss()[i] = 0.f;
  }
  const int total = (NTOK / 4) * 192;
  for (int it = bid * NTHR + otid(wv); it < total; it += nb * NTHR) {
    const int rq = it / 192, c8 = (it % 192) * 8, row0 = rq * 4;
    int l, L;
    if (row0 < NLAT) { l = row0 & 4095; L = 4096; } else { l = (row0 - NLAT) & 255; L = 256; }
    const bf16_t* pc = P.p() + (size_t)row0 * PW + OFF_XBC + c8;
    u32x4_t rv[6];
    rv[0] = *(const u32x4_t*)(pc - (l > 0 ? PW : 0));
#pragma unroll
    for (int i = 0; i < 4; ++i) rv[1 + i] = *(const u32x4_t*)(pc + (size_t)i * PW);
    rv[5] = *(const u32x4_t*)(pc + (size_t)(l + 4 < L ? 4 : 3) * PW);
#pragma unroll
    for (int i = 0; i < 6; ++i) asm volatile("" : "+v"(rv[i]));
    float f[6][8];
#pragma unroll
    for (int i = 0; i < 6; ++i) unpack8(make_uint4(rv[i].x, rv[i].y, rv[i].z, rv[i].w), f[i]);
    const float mp = l > 0 ? 1.f : 0.f, mn = l + 4 < L ? 1.f : 0.f;
    float o[4][8];
#pragma unroll
    for (int e = 0; e < 8; ++e) {
      const int c = c8 + e;
      const float w0 = cw[c], w1 = cw[1536 + c], w2 = cw[3072 + c], bb = cb[c];
#pragma unroll
      for (int i = 0; i < 4; ++i) {
        const float pv = i == 0 ? mp * f[0][e] : f[i][e];
        const float nv = i == 3 ? mn * f[5][e] : f[i + 2][e];
        o[i][e] = silu_f(bb + w0 * pv + w1 * f[i + 1][e] + w2 * nv);
      }
    }
    if (c8 < 1024) {
      const int head = c8 >> 6, p0 = c8 & 63;
      bf16_t* dst = P.xt4() + (((size_t)head * (NTOK / 4) + rq) * 64 + p0) * 4;
#pragma unroll
      for (int e2 = 0; e2 < 4; ++e2)
        *(uint4*)(dst + e2 * 8) = make_uint4(pack2(o[0][2 * e2], o[1][2 * e2]), pack2(o[2][2 * e2], o[3][2 * e2]),
                                             pack2(o[0][2 * e2 + 1], o[1][2 * e2 + 1]), pack2(o[2][2 * e2 + 1], o[3][2 * e2 + 1]));
    } else {
      {
        const int cc = (c8 - 1024) & 255, grp_ = cc >> 7, n0_ = cc & 127;
        bf16_t* fb = (c8 < 1280 ? P.bfr() : P.cfr()) + ((((size_t)grp_ * (NTOK / 16) + (row0 >> 4)) * 4 + (n0_ >> 5)) * 16 + (row0 & 15)) * 32 + (n0_ & 31);
#pragma unroll
        for (int i = 0; i < 4; ++i)
          *(uint4*)(fb + i * 32) = make_uint4(pack2(o[i][0], o[i][1]), pack2(o[i][2], o[i][3]), pack2(o[i][4], o[i][5]), pack2(o[i][6], o[i][7]));
      }
      if (c8 < 1280) {
        const int grp = (c8 - 1024) >> 7, n0 = (c8 - 1024) & 127;
        bf16_t* dst = P.bt4() + (((size_t)grp * (NTOK / 4) + rq) * 128 + n0) * 4;
#pragma unroll
        for (int e2 = 0; e2 < 4; ++e2)
          *(uint4*)(dst + e2 * 8) = make_uint4(pack2(o[0][2 * e2], o[1][2 * e2]), pack2(o[2][2 * e2], o[3][2 * e2]),
                                               pack2(o[0][2 * e2 + 1], o[1][2 * e2 + 1]), pack2(o[2][2 * e2 + 1], o[3][2 * e2 + 1]));
      }
    }
  }
}

__device__ void ph_dtprep(int wv, const Params& P, int layer, char* smem, int first, int step) {
  const int tid = otid(wv), lane = tid & 63, li = lane & 15, g = lane >> 4;
  float* tile = (float*)smem;
  float* segtot = tile + 128 * 33;
  const int dh = tid & 31, seg = tid >> 5;
  const float bias = P.dt_bias[layer * 32 + dh];
  const float ah = -expf(P.a_log[layer * 32 + dh]);
  const bf16_t* wb = P.w_dtT() + (size_t)layer * 128 * 1024 + (size_t)li * 1024 + 8 * g;
  for (int gc = first; gc < NCHUNK; gc += step) {
    const bf16_t* ua = P.u() + (size_t)(gc * 128 + wv * 16 + li) * DM + 8 * g;
    f32x4 acc0 = (f32x4){0.f, 0.f, 0.f, 0.f}, acc1 = acc0;
#pragma unroll 1
    for (int t0 = 0; t0 < 32; t0 += 8) {
      bf16x8 a[8], b0[8], b1[8];
#pragma unroll
      for (int t = 0; t < 8; ++t) {
        a[t] = *(const bf16x8*)(ua + 32 * (t0 + t));
        b0[t] = *(const bf16x8*)(wb + 32 * (t0 + t));
        b1[t] = *(const bf16x8*)(wb + 16 * 1024 + 32 * (t0 + t));
      }
#pragma unroll
      for (int t = 0; t < 8; ++t) asm volatile("" : "+v"(a[t]), "+v"(b0[t]), "+v"(b1[t]));
#pragma unroll
      for (int t = 0; t < 8; ++t) {
        acc0 = __builtin_amdgcn_mfma_f32_16x16x32_bf16(a[t], b0[t], acc0, 0, 0, 0);
        acc1 = __builtin_amdgcn_mfma_f32_16x16x32_bf16(a[t], b1[t], acc1, 0, 0, 0);
      }
    }
    __syncthreads();
#pragma unroll
    for (int e = 0; e < 4; ++e) {
      tile[(wv * 16 + 4 * g + e) * 33 + li] = acc0[e];
      tile[(wv * 16 + 4 * g + e) * 33 + 16 + li] = acc1[e];
    }
    __syncthreads();
    float r[8], c[8];
    float cs = 0.f;
#pragma unroll
    for (int j = 0; j < 8; ++j) { r[j] = softplus_f(tile[(seg * 8 + j) * 33 + dh] + bias); cs += r[j] * ah; c[j] = cs; }
    segtot[seg * 32 + dh] = cs;
    __syncthreads();
    float off = 0.f, tot = 0.f;
    for (int s = 0; s < 16; ++s) { const float v = segtot[s * 32 + dh]; if (s < seg) off += v; tot += v; }
    const size_t base = ((size_t)(gc * 32 + dh) * 128 + seg * 8);
    float cso[8], wso[8];
#pragma unroll
    for (int j = 0; j < 8; ++j) {
      const float csj = off + c[j], csp = j == 0 ? off : off + c[j - 1];
      cso[j] = dh < 16 ? csj : csp;
      wso[j] = r[j] * (dh < 16 ? expf(tot - csj) : expf(csp));
    }
#pragma unroll
    for (int q = 0; q < 2; ++q) {
      *(float4*)(P.cst() + base + q * 4) = make_float4(cso[q * 4], cso[q * 4 + 1], cso[q * 4 + 2], cso[q * 4 + 3]);
      *(float4*)(P.dtt() + base + q * 4) = make_float4(r[q * 4], r[q * 4 + 1], r[q * 4 + 2], r[q * 4 + 3]);
      *(float4*)(P.wst() + base + q * 4) = make_float4(wso[q * 4], wso[q * 4 + 1], wso[q * 4 + 2], wso[q * 4 + 3]);
    }
    if (seg == 0) P.atot()[gc * 32 + dh] = tot;
  }
}

__device__ __forceinline__ int scan_chunk(int b, int dir, int s) {
  if (dir == 0) return (s < 2) ? (128 + 2 * b + s) : (32 * b + (s - 2));
  return (s < 2) ? (128 + 2 * b + 1 - s) : (32 * b + 31 - (s - 2));
}
__device__ void ph_scan(int wv, const Params& P, int bid, int nb) {
  const int total = 4 * 32 * 1024;
  for (int it = bid * NTHR + otid(wv); it < total; it += nb * NTHR) {
    const int e8 = it & 1023, dh = (it >> 10) & 31, b = it >> 15, dir = dh >> 4;
    float S[8];
    float zero_ = 0.f;
    asm volatile("" : "+v"(zero_));
#pragma unroll
    for (int i = 0; i < 8; ++i) S[i] = zero_;
#pragma unroll
    for (int hb = 0; hb < 2; ++hb) {
      u32x4_t v[17];
      float at[17];
#pragma unroll
      for (int s = 0; s < 17; ++s) {
        const int gc = scan_chunk(b, dir, hb * 17 + s);
        v[s] = *(const u32x4_t*)(P.states() + (size_t)(gc * 32 + dh) * 8192 + e8 * 8);
        at[s] = P.atot()[gc * 32 + dh];
      }
#pragma unroll
      for (int s = 0; s < 17; ++s) asm volatile("" : "+v"(v[s]));
#pragma unroll
      for (int s = 0; s < 17; ++s) {
        const int gc = scan_chunk(b, dir, hb * 17 + s);
        const float dec = expf(at[s]);
        float cst[8];
        unpack8(make_uint4(v[s].x, v[s].y, v[s].z, v[s].w), cst);
        *(uint4*)(P.states() + (size_t)(gc * 32 + dh) * 8192 + e8 * 8) =
            make_uint4(pack2(S[0], S[1]), pack2(S[2], S[3]), pack2(S[4], S[5]), pack2(S[6], S[7]));
#pragma unroll
        for (int i = 0; i < 8; ++i) S[i] = dec * S[i] + cst[i];
      }
    }
  }
}

__device__ __forceinline__ void conv_x8(const Params& P, int layer, int row, int ch0, float* out) {
  int l, L;
  if (row < NLAT) { l = row & 4095; L = 4096; } else { l = (row - NLAT) & 255; L = 256; }
  const bf16_t* pc = P.p() + (size_t)row * PW + OFF_XBC + ch0;
  const uint4 cur = *(const uint4*)pc;
  const uint4 prv = *(const uint4*)(pc - (l > 0 ? PW : 0));
  const uint4 nxt = *(const uint4*)(pc + (l < L - 1 ? PW : 0));
  const float mp = l > 0 ? 1.f : 0.f, mn = l < L - 1 ? 1.f : 0.f;
  float fp[8], fc[8], fn[8];
  unpack8(prv, fp); unpack8(cur, fc); unpack8(nxt, fn);
  const float* cw = P.conv_w + (size_t)layer * 3 * 1536 + ch0;
  const float* cb = P.conv_b + (size_t)layer * 1536 + ch0;
#pragma unroll
  for (int e = 0; e < 8; ++e) out[e] = silu_f(cb[e] + cw[e] * (mp * fp[e]) + cw[1536 + e] * fc[e] + cw[3072 + e] * (mn * fn[e]));
}

constexpr int XS = 72;
constexpr int BS = 136;


__device__ __forceinline__ bool ssd_item(int round, int bid, int nb, int nchunks, int& gc, int& head) {
  if ((nb & 63) == 0) {
    const int x = bid & 7, j = bid >> 3, per = nb >> 6;
    const int cg = (round * per + (j >> 3)) * 8 + x;
    if (cg >= nchunks * 2) return false;
    gc = cg >> 1; head = (cg & 1) * 8 + (j & 7);
    return true;
  }
  const int it = round * nb + bid;
  if (it >= nchunks * 16) return false;
  gc = it >> 4; head = it & 15;
  return true;
}

__device__ void ph_states_mfma(int wv, const Params& P, int layer, char* smem, int bid, int nb) {
  const int lane = otid(wv) & 63, li = lane & 15, g = lane >> 4;
  const int dir = wv >> 2, pb = wv & 3;
  for (int round = 0;; ++round) {
    int gc, head;
    if (!ssd_item(round, bid, nb, NCHUNK, gc, head)) break;
    const int grp = head >> 3, dh = dir * 16 + head, q0 = gc * 32;
    const bf16_t* xb = P.xt4() + (((size_t)head * (NTOK / 4) + q0 + g) * 64 + pb * 16 + li) * 4;
    const bf16_t* bb = P.bt4() + (((size_t)grp * (NTOK / 4) + q0 + g) * 128 + li) * 4;
    const float* wp = P.wst() + (size_t)(gc * 32 + dh) * 128 + 4 * g;
    f32x4 acc[8];
#pragma unroll
    for (int n = 0; n < 8; ++n) acc[n] = (f32x4){0.f, 0.f, 0.f, 0.f};
#pragma unroll
    for (int t = 0; t < 4; ++t) {
      s16x4 alo[8], ahi[8], xlo, xhi;
      float w[8];
#pragma unroll
      for (int n = 0; n < 8; ++n) {
        alo[n] = *(const s16x4*)(bb + ((size_t)(t * 8) * 128 + n * 16) * 4);
        ahi[n] = *(const s16x4*)(bb + ((size_t)(t * 8 + 4) * 128 + n * 16) * 4);
      }
      xlo = *(const s16x4*)(xb + (size_t)(t * 8) * 64 * 4);
      xhi = *(const s16x4*)(xb + (size_t)(t * 8 + 4) * 64 * 4);
#pragma unroll
      for (int i = 0; i < 4; ++i) { w[i] = wp[32 * t + i]; w[4 + i] = wp[32 * t + 16 + i]; }
#pragma unroll
      for (int n = 0; n < 8; ++n) asm volatile("" : "+v"(alo[n]), "+v"(ahi[n]));
      bf16x8 bfrag;
#pragma unroll
      for (int i = 0; i < 4; ++i) {
        bfrag[i] = (short)f2bf(bf2f((bf16_t)xlo[i]) * w[i]);
        bfrag[4 + i] = (short)f2bf(bf2f((bf16_t)xhi[i]) * w[4 + i]);
      }
#pragma unroll
      for (int n = 0; n < 8; ++n) {
        const bf16x8 afrag = (bf16x8){alo[n][0], alo[n][1], alo[n][2], alo[n][3], ahi[n][0], ahi[n][1], ahi[n][2], ahi[n][3]};
        acc[n] = __builtin_amdgcn_mfma_f32_16x16x32_bf16(afrag, bfrag, acc[n], 0, 0, 0);
      }
    }
    bf16_t* dst = P.states() + (size_t)(gc * 32 + dir * 16 + head) * 8192 + (pb * 16 + li) * 32;
#pragma unroll
    for (int n = 0; n < 8; ++n) {
      uint2 o;
      o.x = pack2(acc[n][0], acc[n][1]); o.y = pack2(acc[n][2], acc[n][3]);
      *(uint2*)(dst + (n >> 1) * 2048 + (n & 1) * 16 + 4 * g) = o;
    }
  }
}

__device__ void ph_ssdy_mfma(int wv, const Params& P, int layer, int nchunks, char* smem, int bid, int nb) {
  const int tid = otid(wv), lane = tid & 63, li = lane & 15, g = lane >> 4;
  char* sbuf = smem + 16384;
  float* csf = (float*)smem + wv * 512;
  float* dtf = csf + 128;
  float* exb = csf + 256;
  float* dtb = csf + 384;
  u32x4_t pf[6];
#pragma unroll
  for (int i = 0; i < 6; ++i) pf[i] = (u32x4_t){0u, 0u, 0u, 0u};
#define SSDY_FETCH(gc_, head_) do { const int grp_ = (head_) >> 3; \
      const char* bsrc_ = (const char*)(P.bfr() + ((size_t)grp_ * (NTOK / 16) + (gc_) * 8) * 4 * 16 * 32); \
      const char* xsrc_ = (const char*)(P.xt4() + ((size_t)(head_) * (NTOK / 4) + (gc_) * 32) * 64 * 4); \
      _Pragma("unroll") for (int i_ = 0; i_ < 4; ++i_) pf[i_] = *(const u32x4_t*)(bsrc_ + (size_t)(tid + i_ * 512) * 16); \
      _Pragma("unroll") for (int i_ = 0; i_ < 2; ++i_) pf[4 + i_] = *(const u32x4_t*)(xsrc_ + (size_t)(tid + i_ * 512) * 16); } while (0)
#define SSDY_PUT(buf_) do { char* d_ = sbuf + (buf_) * 49152; \
      _Pragma("unroll") for (int i_ = 0; i_ < 4; ++i_) *(u32x4_t*)(d_ + (size_t)(tid + i_ * 512) * 16) = pf[i_]; \
      _Pragma("unroll") for (int i_ = 0; i_ < 2; ++i_) *(u32x4_t*)(d_ + 32768 + (size_t)(tid + i_ * 512) * 16) = pf[4 + i_]; } while (0)
  {
    int gc0, head0;
    __syncthreads();
    if (ssd_item(0, bid, nb, nchunks, gc0, head0)) { SSDY_FETCH(gc0, head0); SSDY_PUT(0); }
    __syncthreads();
  }
  for (int round = 0;; ++round) {
    int gc, head;
    if (!ssd_item(round, bid, nb, nchunks, gc, head)) break;
    const int grp = head >> 3, q0 = gc * 32, row0 = gc * 128;
    const char* bs = sbuf + (round & 1) * 49152;
    const char* xs_l = bs + 32768;
    int gcn = 0, headn = 0;
    const bool has_next = ssd_item(round + 1, bid, nb, nchunks, gcn, headn);
    if (has_next) SSDY_FETCH(gcn, headn);
    __builtin_amdgcn_wave_barrier();
    {
      const float* c0 = P.cst() + (size_t)(gc * 32 + head) * 128;
      const float* d0 = P.dtt() + (size_t)(gc * 32 + head) * 128;
      const float v0 = c0[lane], v1 = c0[lane + 64], v2 = d0[lane], v3 = d0[lane + 64];
      const float v4 = c0[16 * 128 + lane], v5 = c0[16 * 128 + lane + 64], v6 = d0[16 * 128 + lane], v7 = d0[16 * 128 + lane + 64];
      csf[lane] = v0; csf[lane + 64] = v1; dtf[lane] = v2; dtf[lane + 64] = v3;
      exb[lane] = v4; exb[lane + 64] = v5; dtb[lane] = v6; dtb[lane + 64] = v7;
    }
    __builtin_amdgcn_wave_barrier();
    const float atb = P.atot()[gc * 32 + 16 + head];
    bf16x8 cfrag[4];
    {
      const bf16_t* cp = P.cfr() + ((((size_t)grp * (NTOK / 16) + gc * 8 + wv) * 4) * 16 + li) * 32 + 8 * g;
#pragma unroll
      for (int t = 0; t < 4; ++t) cfrag[t] = *(const bf16x8*)(cp + t * 512);
    }
    f32x4 accG[8];
#pragma unroll
    for (int sb = 0; sb < 8; ++sb) accG[sb] = (f32x4){0.f, 0.f, 0.f, 0.f};
#pragma unroll
    for (int sp = 0; sp < 4; ++sp) {
      bf16x8 bfv[8];
#pragma unroll
      for (int i = 0; i < 8; ++i) {
        const int sb = sp * 2 + (i >> 2), t = i & 3;
        bfv[i] = *(const bf16x8*)(bs + (((sb * 4 + t) * 16 + li) * 32 + 8 * g) * 2);
      }
#pragma unroll
      for (int i = 0; i < 8; ++i) {
        const int sb = sp * 2 + (i >> 2), t = i & 3;
        accG[sb] = __builtin_amdgcn_mfma_f32_16x16x32_bf16(bfv[i], cfrag[t], accG[sb], 0, 0, 0);
      }
    }
    f32x4 accY[4];
#pragma unroll
    for (int pb = 0; pb < 4; ++pb) accY[pb] = (f32x4){0.f, 0.f, 0.f, 0.f};
    const int jl = 16 * wv + li;
    const float csf_j = csf[jl], exb_j = exb[jl];
#pragma unroll
    for (int dir = 0; dir < 2; ++dir) {
      f32x4 accO[4];
#pragma unroll
      for (int pb = 0; pb < 4; ++pb) accO[pb] = (f32x4){0.f, 0.f, 0.f, 0.f};
      const bf16_t* st = P.states() + (size_t)(gc * 32 + dir * 16 + head) * 8192;
#pragma unroll
      for (int th = 0; th < 2; ++th) {
        bf16x8 sfr[8];
#pragma unroll
        for (int i = 0; i < 8; ++i) sfr[i] = *(const bf16x8*)(st + ((th * 2 + (i >> 2)) * 4 + (i & 3)) * 512 + li * 32 + 8 * g);
#pragma unroll
        for (int i = 0; i < 8; ++i) asm volatile("" : "+v"(sfr[i]));
#pragma unroll
        for (int tt = 0; tt < 2; ++tt)
#pragma unroll
          for (int pb = 0; pb < 4; ++pb) accO[pb] = __builtin_amdgcn_mfma_f32_16x16x32_bf16(cfrag[th * 2 + tt], sfr[tt * 4 + pb], accO[pb], 0, 0, 0);
      }
#pragma unroll
      for (int e = 0; e < 4; ++e) {
        const int j = 16 * wv + 4 * g + e;
        const float sc = dir == 0 ? expf(csf[j]) : expf(atb - exb[j]);
#pragma unroll
        for (int pb = 0; pb < 4; ++pb) accY[pb][e] += accO[pb][e] * sc;
      }
    }
    const char* xq = xs_l + ((g * 64 + li) * 4) * 2;
#pragma unroll
    for (int t = 0; t < 4; ++t) {
      const bool need_f = !(32 * t > 16 * wv + 15), need_b = !(32 * t + 31 < 16 * wv);
      if (!need_f && !need_b) continue;
      s16x4 xlo[4], xhi[4];
#pragma unroll
      for (int pb = 0; pb < 4; ++pb) {
        xlo[pb] = *(const s16x4*)(xq + (((8 * t) * 64 + 16 * pb) * 4) * 2);
        xhi[pb] = *(const s16x4*)(xq + (((8 * t + 4) * 64 + 16 * pb) * 4) * 2);
      }
#pragma unroll
      for (int dir = 0; dir < 2; ++dir) {
        if (dir == 0 ? !need_f : !need_b) continue;
        bf16x8 afrag;
#pragma unroll
        for (int hh = 0; hh < 2; ++hh) {
          const int s0 = 32 * t + 16 * hh + 4 * g;
          const f32x4 gv = accG[2 * t + hh];
          const f32x4 cv = dir == 0 ? *(const f32x4*)(csf + s0) : *(const f32x4*)(exb + s0);
          const f32x4 dv = dir == 0 ? *(const f32x4*)(dtf + s0) : *(const f32x4*)(dtb + s0);
#pragma unroll
          for (int e = 0; e < 4; ++e) {
            const int s = s0 + e;
            float m;
            if (dir == 0) m = (s <= jl) ? gv[e] * dv[e] * expf(csf_j - cv[e]) : 0.f;
            else m = (s >= jl) ? gv[e] * dv[e] * expf(cv[e] - exb_j) : 0.f;
            afrag[hh * 4 + e] = (short)f2bf(m);
          }
        }
#pragma unroll
        for (int pb = 0; pb < 4; ++pb) {
          const bf16x8 bfr2 = (bf16x8){xlo[pb][0], xlo[pb][1], xlo[pb][2], xlo[pb][3], xhi[pb][0], xhi[pb][1], xhi[pb][2], xhi[pb][3]};
          accY[pb] = __builtin_amdgcn_mfma_f32_16x16x32_bf16(afrag, bfr2, accY[pb], 0, 0, 0);
        }
      }
    }
    const float dsk = P.d_skip[layer * 16 + head];
    s16x4 xs[4];
#pragma unroll
    for (int pb = 0; pb < 4; ++pb) xs[pb] = *(const s16x4*)(xs_l + ((((4 * wv + g) * 64 + 16 * pb + li) * 4) * 2));
    unsigned zv[16];
#pragma unroll
    for (int e = 0; e < 4; ++e)
#pragma unroll
      for (int pb = 0; pb < 4; ++pb)
        zv[e * 4 + pb] = P.p()[(size_t)(row0 + 16 * wv + 4 * g + e) * PW + OFF_Z + head * 64 + 16 * pb + li];
#pragma unroll
    for (int i = 0; i < 16; ++i) asm volatile("" : "+v"(zv[i]));
#pragma unroll
    for (int e = 0; e < 4; ++e) {
      const int row = row0 + 16 * wv + 4 * g + e;
      float sq = 0.f;
#pragma unroll
      for (int pb = 0; pb < 4; ++pb) {
        const float xv = bf2f((bf16_t)xs[pb][e]);
        const float z = bf2f((bf16_t)zv[e * 4 + pb]);
        const bf16_t yb = f2bf((accY[pb][e] + dsk * xv) * silu_f(z));
        P.concat()[(size_t)row * 2048 + head * 64 + 16 * pb + li] = yb;
        const float yf = bf2f(yb);
        sq += yf * yf;
      }
      sq += DPP_F(sq, 0xB1); sq += DPP_F(sq, 0x4E); sq += DPP_F(sq, 0x141); sq += DPP_F(sq, 0x140);
      if (li == 0) atomicAdd(P.yss() + row, sq);
    }
    if (has_next) SSDY_PUT((round + 1) & 1);
    __syncthreads();
  }
#undef SSDY_FETCH
#undef SSDY_PUT
}

__device__ void ph_ssdnorm(int wv, const Params& P, int layer, int nrows, int bid, int nb) {
  const int wave = otid(wv) >> 6, lane = otid(wv) & 63;
  const float* g = P.ssd_norm_g + layer * 1024;
  for (int row = bid * NWAVE + wave; row < nrows; row += nb * NWAVE) {
    bf16_t* src = P.concat() + (size_t)row * 2048;
    float v[16];
    float ss = 0.f;
#pragma unroll
    for (int i = 0; i < 4; ++i) {
      const uint2 pk = *(const uint2*)(src + i * 256 + lane * 4);
      v[i * 4 + 0] = bf2f((bf16_t)(pk.x & 0xffff)); v[i * 4 + 1] = bf2f((bf16_t)(pk.x >> 16));
      v[i * 4 + 2] = bf2f((bf16_t)(pk.y & 0xffff)); v[i * 4 + 3] = bf2f((bf16_t)(pk.y >> 16));
    }
#pragma unroll
    for (int i = 0; i < 16; ++i) ss += v[i] * v[i];
    ss = wave_sum(ss);
    const float rstd = rsqrtf(ss * (1.f / 1024.f) + 1e-6f);
    f32x4 gv[4];
#pragma unroll
    for (int i = 0; i < 4; ++i) gv[i] = *(const f32x4*)(g + i * 256 + lane * 4);
#pragma unroll
    for (int i = 0; i < 4; ++i) asm volatile("" : "+v"(gv[i]));
#pragma unroll
    for (int i = 0; i < 4; ++i) {
      const int idx = i * 256 + lane * 4;
      uint2 pk;
      pk.x = (uint32_t)f2bf(v[i * 4 + 0] * rstd * gv[i][0]) | ((uint32_t)f2bf(v[i * 4 + 1] * rstd * gv[i][1]) << 16);
      pk.y = (uint32_t)f2bf(v[i * 4 + 2] * rstd * gv[i][2]) | ((uint32_t)f2bf(v[i * 4 + 3] * rstd * gv[i][3]) << 16);
      *(uint2*)(src + idx) = pk;
    }
  }
}

template <int W>
__device__ __forceinline__ void pool_frags(const bf16_t* pc, int l, int L, float rc, bf16x8 (&af)[4]) {
#pragma unroll
  for (int t = 0; t < 4; ++t) {
    constexpr int WB = W < 8 ? W : 8;
    float s[8], f[8];
#pragma unroll
    for (int e = 0; e < 8; ++e) s[e] = 0.f;
    const u32x4_t own = *(const u32x4_t*)(pc + 32 * t);
#pragma unroll
    for (int ob = 0; ob < W; ob += WB) {
      u32x4_t rows[WB];
#pragma unroll
      for (int o = 0; o < WB; ++o) {
        const int rr = l - W / 2 + ob + o;
        const int rcl = (rr >= 0 && rr < L) ? rr : l;
        rows[o] = *(const u32x4_t*)(pc + (ptrdiff_t)(rcl - l) * PW + 32 * t);
      }
#pragma unroll
      for (int o = 0; o < WB; ++o) asm volatile("" : "+v"(rows[o]));
#pragma unroll
      for (int o = 0; o < WB; ++o) {
        const int rr = l - W / 2 + ob + o;
        const float mk = (rr >= 0 && rr < L) ? 1.f : 0.f;
        unpack8(make_uint4(rows[o].x, rows[o].y, rows[o].z, rows[o].w), f);
#pragma unroll
        for (int e = 0; e < 8; ++e) s[e] += mk * f[e];
      }
    }
    unpack8(make_uint4(own.x, own.y, own.z, own.w), f);
#pragma unroll
    for (int e = 0; e < 8; ++e) af[t][e] = (short)f2bf(s[e] * rc - f[e]);
  }
}
__device__ void ph_pool_mfma(int wv, const Params& P, int layer, int nrows, int bid, int nb) {
  const int lane = otid(wv) & 63, li = lane & 15, g = lane >> 4;
  const int nitems = (nrows / 16) * 4;
  for (int it = bid * NWAVE + wv; it < nitems; it += nb * NWAVE) {
    const int gi = it & 3, row0 = (it >> 2) * 16, w = 2 << gi;
    const int row = row0 + li;
    int l, L;
    if (row < NLAT) { l = row & 4095; L = 4096; } else { l = (row - NLAT) & 255; L = 256; }
    int lo = l - w / 2; lo = lo < 0 ? 0 : lo;
    int hi = l + w - w / 2 - 1; hi = hi > L - 1 ? L - 1 : hi;
    const float rc = 1.f / (float)(hi - lo + 1);
    const bf16_t* pc = P.p() + (size_t)row * PW + OFF_POOL + gi * 128 + 8 * g;
    bf16x8 af[4];
    if (gi == 0) pool_frags<2>(pc, l, L, rc, af);
    else if (gi == 1) pool_frags<4>(pc, l, L, rc, af);
    else if (gi == 2) pool_frags<8>(pc, l, L, rc, af);
    else pool_frags<16>(pc, l, L, rc, af);
    const bf16_t* wt = P.poolwT() + ((size_t)(layer * 4 + gi) * 128 + li) * 128 + 8 * g;
    const float* sc = P.pool_scale + layer * 512 + gi * 128;
#pragma unroll
    for (int nh = 0; nh < 4; ++nh) {
      bf16x8 wf[2][4];
#pragma unroll
      for (int n = 0; n < 2; ++n)
#pragma unroll
        for (int t = 0; t < 4; ++t) wf[n][t] = *(const bf16x8*)(wt + (size_t)(nh * 2 + n) * 16 * 128 + 32 * t);
#pragma unroll
      for (int n = 0; n < 2; ++n)
#pragma unroll
        for (int t = 0; t < 4; ++t) asm volatile("" : "+v"(wf[n][t]));
#pragma unroll
      for (int n = 0; n < 2; ++n) {
        const int nt = nh * 2 + n;
        f32x4 acc = (f32x4){0.f, 0.f, 0.f, 0.f};
#pragma unroll
        for (int t = 0; t < 4; ++t) acc = __builtin_amdgcn_mfma_f32_16x16x32_bf16(af[t], wf[n][t], acc, 0, 0, 0);
        const float scv = sc[nt * 16 + li];
#pragma unroll
        for (int e = 0; e < 4; ++e)
          P.concat()[(size_t)(row0 + 4 * g + e) * 2048 + 1024 + gi * 128 + nt * 16 + li] = f2bf(acc[e] * scv);
      }
    }
  }
}

__device__ void ph_vtranspose(int wv, const Params& P, char* smem, int bid, int nb) {
  const int lane = otid(wv) & 63;
  bf16_t* tile = (bf16_t*)smem + wv * 64 * 72;
  for (int it = bid * NWAVE + wv; it < 272 * 8; it += nb * NWAVE) {
    const int hd = it & 7, tt = it >> 3, row0 = tt * 64;
    const bf16_t* src = P.p() + (size_t)(row0 + lane) * PW + OFF_V + hd * 64;
#pragma unroll
    for (int i = 0; i < 8; ++i) *(uint4*)(tile + lane * 72 + i * 8) = *(const uint4*)(src + i * 8);
    __builtin_amdgcn_wave_barrier();
    bf16_t* dst;
    if (row0 < NLAT) dst = P.vtl() + (size_t)((row0 >> 12) * 8 + hd) * 64 * 4096 + ((size_t)((row0 & 4095) >> 2) * 64 + lane) * 4;
    else dst = P.vtc() + (size_t)(((row0 - NLAT) >> 8) * 8 + hd) * 64 * 256 + ((size_t)(((row0 - NLAT) & 255) >> 2) * 64 + lane) * 4;
#pragma unroll
    for (int i = 0; i < 16; ++i) {
      uint2 w;
      w.x = (uint32_t)tile[(i * 4 + 0) * 72 + lane] | ((uint32_t)tile[(i * 4 + 1) * 72 + lane] << 16);
      w.y = (uint32_t)tile[(i * 4 + 2) * 72 + lane] | ((uint32_t)tile[(i * 4 + 3) * 72 + lane] << 16);
      *(uint2*)(dst + (size_t)i * 64 * 4) = w;
    }
    __builtin_amdgcn_wave_barrier();
    {
      const bf16_t* ksrc = P.p() + (size_t)(row0 + lane) * PW + OFF_K + hd * 64;
      u32x4_t kv[8];
#pragma unroll
      for (int i = 0; i < 8; ++i) kv[i] = *(const u32x4_t*)(ksrc + i * 8);
      bf16_t* kd;
      int tk;
      if (row0 < NLAT) { tk = (row0 & 4095) + lane; kd = P.ktl() + (size_t)((row0 >> 12) * 8 + hd) * 4096 * 64; }
      else { tk = ((row0 - NLAT) & 255) + lane; kd = P.ktc() + (size_t)(((row0 - NLAT) >> 8) * 8 + hd) * 256 * 64; }
#pragma unroll
      for (int i = 0; i < 8; ++i)
        *(u32x4_t*)(kd + ((size_t)((tk >> 3) * 2 + (i >> 2)) * 8 + (tk & 7)) * 32 + (i & 3) * 8) = kv[i];
    }
  }
}

__device__ __forceinline__ float grp_max(float v) {
  auto a = __builtin_amdgcn_permlane16_swap(__float_as_uint(v), __float_as_uint(v), false, false);
  v = fmaxf(__uint_as_float(a[0]), __uint_as_float(a[1]));
  auto b = __builtin_amdgcn_permlane32_swap(__float_as_uint(v), __float_as_uint(v), false, false);
  return fmaxf(__uint_as_float(b[0]), __uint_as_float(b[1]));
}
__device__ __forceinline__ float grp_sum(float v) {
  auto a = __builtin_amdgcn_permlane16_swap(__float_as_uint(v), __float_as_uint(v), false, false);
  v = __uint_as_float(a[0]) + __uint_as_float(a[1]);
  auto b = __builtin_amdgcn_permlane32_swap(__float_as_uint(v), __float_as_uint(v), false, false);
  return __uint_as_float(b[0]) + __uint_as_float(b[1]);
}

__device__ void ph_na_mfma(int wv, const Params& P, int layer, int nrows, char* smem, int bid, int nb) {
  const int lane = otid(wv) & 63, li = lane & 15, g = lane >> 4;
  float* btab = (float*)smem + wv * 256;
  const float* rpb = P.na_rpb + (size_t)layer * 8 * 15 * 31;
  const int n_lat = 4 * 64 * 8 * 4;
  const int n_items = n_lat + (nrows > NLAT ? 4 * 16 * 8 : 0);
  const int nrank = nb >> 3;
  const bool xmap = ((nb & 7) == 0) && nrank > 0 && (1024 % nrank) == 0 && (64 % nrank) == 0;
  const int per_lat = xmap ? 1024 / nrank : 0, per_ctx = (xmap && nrows > NLAT) ? 64 / nrank : 0;
  const int q_begin = xmap ? wv : bid * NWAVE + wv, q_end = xmap ? per_lat + per_ctx : n_items, q_step = xmap ? NWAVE : nb * NWAVE;
  for (int q = q_begin; q < q_end; q += q_step) {
    bool lat;
    int b, hd, qrow0, r = 0, cq0 = 0, r0 = 0, cs = 0, qt;
    if (xmap) {
      hd = bid & 7;
      const int rank = bid >> 3;
      lat = q < per_lat;
      if (lat) { const int i = rank * per_lat + q; qt = i & 3; r = (i >> 2) & 63; b = i >> 8; }
      else { const int c = rank * per_ctx + (q - per_lat); qt = c & 15; b = c >> 4; }
    } else {
      lat = q < n_lat;
      if (lat) { qt = q & 3; hd = (q >> 2) & 7; r = (q >> 5) & 63; b = q >> 11; }
      else { const int t = q - n_lat; hd = t & 7; qt = (t >> 3) & 15; b = t >> 7; }
    }
    if (lat) {
      cq0 = qt * 16; qrow0 = b * 4096 + r * 64 + cq0;
      r0 = r - 4; r0 = r0 < 0 ? 0 : (r0 > 56 ? 56 : r0);
      int clo = cq0 - 8; clo = clo < 0 ? 0 : (clo > 48 ? 48 : clo);
      cs = clo < 32 ? clo : 32;
    } else {
      qrow0 = NLAT + b * 256 + qt * 16;
    }
    const bf16_t* qp = P.p() + (size_t)(qrow0 + li) * PW + OFF_Q + hd * 64 + 8 * g;
    const bf16x8 qf0 = *(const bf16x8*)qp, qf1 = *(const bf16x8*)(qp + 32);
    __builtin_amdgcn_wave_barrier();
#pragma unroll
    for (int i = 0; i < 4; ++i) {
      const int e_ = i * 64 + lane, kr_ = e_ >> 5, dc_ = e_ & 31;
      int dr_ = r0 + kr_ - r + 7; dr_ = dr_ < 0 ? 0 : (dr_ > 14 ? 14 : dr_);
      btab[e_] = rpb[(hd * 15 + dr_) * 31 + (dc_ < 31 ? dc_ : 30)];
    }
    __builtin_amdgcn_wave_barrier();
    f32x4 accS[16], accC[16];
    const int k_lane = ((li >> 3) * 16 + (li & 7)) * 32 + 8 * g;
    const bf16_t* klb = P.ktl() + (size_t)(b * 8 + hd) * 4096 * 64 + k_lane;
    const bf16_t* kcb = P.ktc() + (size_t)(b * 8 + hd) * 256 * 64 + k_lane;
#define NA_KPTR(tile) ((tile) < 16 ? klb + ((r0 + ((tile) >> 1)) * 64 + cs + 16 * ((tile) & 1)) * 64 : kcb + (16 * ((tile) - 16)) * 64)
    bf16x8 kA[2][2], kB[2][2];
#pragma unroll
    for (int i = 0; i < 2; ++i) { const bf16_t* kp = NA_KPTR(i); kA[i][0] = *(const bf16x8*)kp; kA[i][1] = *(const bf16x8*)(kp + 256); }
#pragma unroll
    for (int tb = 0; tb < 32; tb += 4) {
#pragma unroll
      for (int i = 0; i < 2; ++i) { const bf16_t* kp = NA_KPTR(tb + 2 + i); kB[i][0] = *(const bf16x8*)kp; kB[i][1] = *(const bf16x8*)(kp + 256); }
#pragma unroll
      for (int i = 0; i < 2; ++i) { asm volatile("" : "+v"(kA[i][0]), "+v"(kA[i][1])); }
#pragma unroll
      for (int i = 0; i < 2; ++i) {
        f32x4 z = (f32x4){0.f, 0.f, 0.f, 0.f};
        z = __builtin_amdgcn_mfma_f32_16x16x32_bf16(kA[i][0], qf0, z, 0, 0, 0);
        z = __builtin_amdgcn_mfma_f32_16x16x32_bf16(kA[i][1], qf1, z, 0, 0, 0);
        if (tb + i < 16) accS[(tb + i) & 15] = z; else accC[(tb + i) & 15] = z;
      }
      if (tb + 4 < 32) {
#pragma unroll
        for (int i = 0; i < 2; ++i) { const bf16_t* kp = NA_KPTR(tb + 4 + i); kA[i][0] = *(const bf16x8*)kp; kA[i][1] = *(const bf16x8*)(kp + 256); }
      }
#pragma unroll
      for (int i = 0; i < 2; ++i) { asm volatile("" : "+v"(kB[i][0]), "+v"(kB[i][1])); }
#pragma unroll
      for (int i = 0; i < 2; ++i) {
        f32x4 z = (f32x4){0.f, 0.f, 0.f, 0.f};
        z = __builtin_amdgcn_mfma_f32_16x16x32_bf16(kB[i][0], qf0, z, 0, 0, 0);
        z = __builtin_amdgcn_mfma_f32_16x16x32_bf16(kB[i][1], qf1, z, 0, 0, 0);
        if (tb + 2 + i < 16) accS[(tb + 2 + i) & 15] = z; else accC[(tb + 2 + i) & 15] = z;
      }
    }
#undef NA_KPTR
    const int cq = cq0 + li;
    int c0q = cq - 8; c0q = c0q < 0 ? 0 : (c0q > 48 ? 48 : c0q);
    float mx = -3.0e38f;
#pragma unroll
    for (int kt = 0; kt < 16; ++kt) {
      int bi[4]; bool okv[4]; float bv[4];
#pragma unroll
      for (int e = 0; e < 4; ++e) {
        const int ck = cs + 16 * (kt & 1) + 4 * g + e;
        okv[e] = lat && ck >= c0q && ck < c0q + 16;
        bi[e] = okv[e] ? (kt >> 1) * 32 + (ck - cq + 15) : 0;
      }
      asm volatile("" : "+v"(bi[0]), "+v"(bi[1]), "+v"(bi[2]), "+v"(bi[3]));
#pragma unroll
      for (int e = 0; e < 4; ++e) bv[e] = btab[bi[e]];
#pragma unroll
      for (int e = 0; e < 4; ++e) {
        const float s = okv[e] ? accS[kt][e] * 0.125f + bv[e] : -3.0e38f;
        accS[kt][e] = s;
        mx = fmaxf(mx, s);
      }
    }
#pragma unroll
    for (int ct = 0; ct < 16; ++ct)
#pragma unroll
      for (int e = 0; e < 4; ++e) { const float s = accC[ct][e] * 0.125f; accC[ct][e] = s; mx = fmaxf(mx, s); }
    mx = grp_max(mx);
    float sum = 0.f;
#pragma unroll
    for (int kt = 0; kt < 16; ++kt)
#pragma unroll
      for (int e = 0; e < 4; ++e) { const float p = __expf(accS[kt][e] - mx); accS[kt][e] = p; sum += p; }
#pragma unroll
    for (int ct = 0; ct < 16; ++ct)
#pragma unroll
      for (int e = 0; e < 4; ++e) { const float p = __expf(accC[ct][e] - mx); accC[ct][e] = p; sum += p; }
    sum = grp_sum(sum);
    const float inv = 1.f / sum;
    bf16x8 afL[8], afC[8];
#pragma unroll
    for (int kr = 0; kr < 8; ++kr) {
#pragma unroll
      for (int e = 0; e < 4; ++e) {
        afL[kr][e] = (short)f2bf(accS[2 * kr][e] * inv); afL[kr][4 + e] = (short)f2bf(accS[2 * kr + 1][e] * inv);
        afC[kr][e] = (short)f2bf(accC[2 * kr][e] * inv); afC[kr][4 + e] = (short)f2bf(accC[2 * kr + 1][e] * inv);
      }
    }
    f32x4 accO[4];
#pragma unroll
    for (int db = 0; db < 4; ++db) accO[db] = (f32x4){0.f, 0.f, 0.f, 0.f};
    const bf16_t* vl = P.vtl() + (size_t)(b * 8 + hd) * 64 * 4096 + li * 4;
    const bf16_t* vc = P.vtc() + (size_t)(b * 8 + hd) * 64 * 256 + li * 4;
#pragma unroll
    for (int kr = 0; kr < 8; ++kr) {
      const int tok = (r0 + kr) * 64 + cs + 4 * g;
      s16x4 lo[4], hi[4];
#pragma unroll
      for (int db = 0; db < 4; ++db) {
        const bf16_t* vp = vl + ((size_t)(tok >> 2) * 64 + db * 16) * 4;
        lo[db] = *(const s16x4*)vp; hi[db] = *(const s16x4*)(vp + 4 * 64 * 4);
      }
#pragma unroll
      for (int db = 0; db < 4; ++db) {
        const bf16x8 bfr = (bf16x8){lo[db][0], lo[db][1], lo[db][2], lo[db][3], hi[db][0], hi[db][1], hi[db][2], hi[db][3]};
        accO[db] = __builtin_amdgcn_mfma_f32_16x16x32_bf16(afL[kr], bfr, accO[db], 0, 0, 0);
      }
    }
#pragma unroll
    for (int t = 0; t < 8; ++t) {
      const int tok = 32 * t + 4 * g;
      s16x4 lo[4], hi[4];
#pragma unroll
      for (int db = 0; db < 4; ++db) {
        const bf16_t* vp = vc + ((size_t)(tok >> 2) * 64 + db * 16) * 4;
        lo[db] = *(const s16x4*)vp; hi[db] = *(const s16x4*)(vp + 4 * 64 * 4);
      }
#pragma unroll
      for (int db = 0; db < 4; ++db) {
        const bf16x8 bfr = (bf16x8){lo[db][0], lo[db][1], lo[db][2], lo[db][3], hi[db][0], hi[db][1], hi[db][2], hi[db][3]};
        accO[db] = __builtin_amdgcn_mfma_f32_16x16x32_bf16(afC[t], bfr, accO[db], 0, 0, 0);
      }
    }
#pragma unroll
    for (int db = 0; db < 4; ++db)
#pragma unroll
      for (int e = 0; e < 4; ++e)
        P.concat()[(size_t)(qrow0 + 4 * g + e) * 2048 + 1536 + hd * 64 + 16 * db + li] = f2bf(accO[db][e]);
  }
}

__device__ __forceinline__ uint32_t mono_u(float f) { const uint32_t u = __float_as_uint(f); return u ^ ((uint32_t)((int)u >> 31) | 0x80000000u); }
__device__ __forceinline__ float unmono_f(uint32_t m) { return __uint_as_float((m & 0x80000000u) ? (m ^ 0x80000000u) : ~m); }
__device__ __forceinline__ uint32_t grp_max_u(uint32_t v) {
  auto a = __builtin_amdgcn_permlane16_swap(v, v, false, false);
  v = a[0] > a[1] ? a[0] : a[1];
  auto b = __builtin_amdgcn_permlane32_swap(v, v, false, false);
  return b[0] > b[1] ? b[0] : b[1];
}

template <int N>
__device__ __forceinline__ void bitonic_sort_desc(uint32_t (&a)[N], int base = 0) { (void)base;
#pragma unroll
  for (int k = 2; k <= N; k <<= 1)
#pragma unroll
    for (int j = k >> 1; j > 0; j >>= 1)
#pragma unroll
      for (int i = 0; i < N; ++i) {
        const int l = i ^ j;
        if (l > i) {
          const bool desc = (i & k) == 0;
          const uint32_t hi = a[i] > a[l] ? a[i] : a[l], lo = a[i] > a[l] ? a[l] : a[i];
          a[i] = desc ? hi : lo; a[l] = desc ? lo : hi;
        }
      }
}
template <int N>
__device__ __forceinline__ void bitonic_merge_desc(uint32_t (&a)[N]) {
#pragma unroll
  for (int j = N >> 1; j > 0; j >>= 1)
#pragma unroll
    for (int i = 0; i < N; ++i) {
      const int l = i ^ j;
      if (l > i) {
        const uint32_t hi = a[i] > a[l] ? a[i] : a[l], lo = a[i] > a[l] ? a[l] : a[i];
        a[i] = hi; a[l] = lo;
      }
    }
}
__device__ __forceinline__ void merge4_top16(uint32_t (&a)[16]) {
  uint32_t e[16], o[16];
#pragma unroll
  for (int i = 0; i < 16; ++i) { auto r = __builtin_amdgcn_permlane16_swap(a[i], a[i], false, false); e[i] = r[0]; o[i] = r[1]; }
#pragma unroll
  for (int i = 0; i < 16; ++i) a[i] = e[i] > o[15 - i] ? e[i] : o[15 - i];
  bitonic_merge_desc<16>(a);
#pragma unroll
  for (int i = 0; i < 16; ++i) { auto r = __builtin_amdgcn_permlane32_swap(a[i], a[i], false, false); e[i] = r[0]; o[i] = r[1]; }
#pragma unroll
  for (int i = 0; i < 16; ++i) a[i] = e[i] > o[15 - i] ? e[i] : o[15 - i];
  bitonic_merge_desc<16>(a);
}
__device__ void ph_peer_topk_mfma(int wv, const Params& P, int layer, int nrows, char* smem, int bid, int nb) {
  const int tid = otid(wv), lane = tid & 63, li = lane & 15, g = lane >> 4;
  unsigned char* ctab = (unsigned char*)smem;
  float* vals = (float*)(smem + 256) + wv * 512;
  int* idxs = (int*)(smem + 256 + 8 * 2048) + wv * 512;
  __syncthreads();
  if (tid < 64) ctab[tid] = 0xFF;
  __syncthreads();
  if (tid == 0) {
    int n = 0, one = 1;
    asm volatile("" : "+s"(one));
#pragma unroll 1
    for (int a = 0; a < 16; ++a)
#pragma unroll 1
      for (int b = 0; b < 16; ++b)
        if ((a + one) * (b + 1) <= 16) { ctab[(n & 3) * 16 + (n >> 2)] = (unsigned char)(a * 16 + b); ++n; }
  }
  const int hd = bid & 7, tg = bid >> 3, ngroups = nb >> 3;
  char* ksm = smem + 33280;
  {
    const bf16_t* ksrc = P.keysb() + (size_t)(layer * 8 + hd) * 2 * 128 * 128;
#pragma unroll
    for (int i = 0; i < 8; ++i) {
      const int idx = tid + i * 512, r = idx >> 4, sg = idx & 15;
      *(uint4*)(ksm + (r * 136 + sg * 8) * 2) = *(const uint4*)(ksrc + (size_t)r * 128 + sg * 8);
    }
  }
  __syncthreads();
  const int ntile = nrows / 16;
  for (int tile = tg + ngroups * wv; tile < ntile && tg < ngroups; tile += ngroups * NWAVE) {
    const int row0 = tile * 16;
    const bf16_t* qp = P.q() + (size_t)(row0 + li) * 2048 + hd * 256 + 8 * g;
    uint32_t win[2][16];
#pragma unroll
    for (int half = 0; half < 2; ++half) {
      bf16x8 qf[4];
#pragma unroll
      for (int t = 0; t < 4; ++t) qf[t] = *(const bf16x8*)(qp + half * 128 + 32 * t);
      const char* kb = ksm + ((half * 128 + li) * 136 + 8 * g) * 2;
      uint32_t pk[32];
#pragma unroll
      for (int kt = 0; kt < 8; ++kt) {
        f32x4 acc = (f32x4){0.f, 0.f, 0.f, 0.f};
#pragma unroll
        for (int t = 0; t < 4; ++t) {
          const bf16x8 a = *(const bf16x8*)(kb + (kt * 16 * 136 + 32 * t) * 2);
          acc = __builtin_amdgcn_mfma_f32_16x16x32_bf16(a, qf[t], acc, 0, 0, 0);
        }
#pragma unroll
        for (int e = 0; e < 4; ++e) pk[kt * 4 + e] = (mono_u(acc[e]) & ~127u) | (uint32_t)(16 * kt + 4 * g + e);
      }
      {
        uint32_t lo16[16], hi16[16];
#pragma unroll
        for (int i = 0; i < 16; ++i) { lo16[i] = pk[i]; hi16[i] = pk[16 + i]; }
        bitonic_sort_desc<16>(lo16);
        bitonic_sort_desc<16>(hi16);
#pragma unroll
        for (int i = 0; i < 16; ++i) lo16[i] = lo16[i] > hi16[15 - i] ? lo16[i] : hi16[15 - i];
        bitonic_merge_desc<16>(lo16);
        merge4_top16(lo16);
#pragma unroll
        for (int r = 0; r < 16; ++r) win[half][r] = lo16[r];
      }
    }
    if (g == 0) {
#pragma unroll
      for (int half = 0; half < 2; ++half)
#pragma unroll
        for (int r = 0; r < 16; ++r) {
          vals[li * 32 + half * 16 + r] = unmono_f(win[half][r] & ~127u);
          idxs[li * 32 + half * 16 + r] = (int)(win[half][r] & 127u);
        }
    }
    __builtin_amdgcn_wave_barrier();
    uint32_t cp[16];
#pragma unroll
    for (int s = 0; s < 16; ++s) {
      const uint32_t ab = ctab[g * 16 + s];
      uint32_t v = 0u;
      if (ab != 0xFFu) v = (mono_u(vals[li * 32 + (ab >> 4)] + vals[li * 32 + 16 + (ab & 15u)]) & ~255u) | ab;
      cp[s] = v;
    }
    bitonic_sort_desc<16>(cp);
    merge4_top16(cp);
    uint32_t cw[16];
#pragma unroll
    for (int r = 0; r < 16; ++r) cw[r] = cp[r];
    const float mx = unmono_f(cw[0] & ~255u);
    float ex[16];
    float sum = 0.f;
#pragma unroll
    for (int r = 0; r < 16; ++r) { ex[r] = __expf(unmono_f(cw[r] & ~255u) - mx); sum += ex[r]; }
    const float inv = 1.f / sum;
    const size_t ob = (size_t)(row0 + li) * 128 + hd * 16;
#pragma unroll
    for (int r = 0; r < 16; ++r) {
      if ((r >> 2) == g) {
        const uint32_t ab = cw[r] & 255u;
        P.sel_idx()[ob + r] = idxs[li * 32 + (ab >> 4)] * 128 + idxs[li * 32 + 16 + (ab & 15u)];
        P.sel_g()[ob + r] = ex[r] * inv;
      }
    }
    __builtin_amdgcn_wave_barrier();
  }
}

__device__ __forceinline__ void cvt8(const uint32_t w, float* f) {
  const f32x2_t a = __builtin_amdgcn_cvt_scalef32_pk_f32_fp4(w, 1.0f, 0), b = __builtin_amdgcn_cvt_scalef32_pk_f32_fp4(w, 1.0f, 1);
  const f32x2_t c = __builtin_amdgcn_cvt_scalef32_pk_f32_fp4(w, 1.0f, 2), e = __builtin_amdgcn_cvt_scalef32_pk_f32_fp4(w, 1.0f, 3);
  f[0] = a.x; f[1] = a.y; f[2] = b.x; f[3] = b.y; f[4] = c.x; f[5] = c.y; f[6] = e.x; f[7] = e.y;
}
__device__ __forceinline__ float swap16_add(float a, float b) {
  auto r = __builtin_amdgcn_permlane16_swap(__float_as_uint(a), __float_as_uint(b), false, false);
  return __uint_as_float(r[0]) + __uint_as_float(r[1]);
}
__device__ void ph_peer_gather(int wv, const Params& P, int layer, int nrows, int bid, int nb) {
  for (int row = bid * NWAVE + wv; row < nrows; row += nb * NWAVE) {
    const int lane = otid(wv) & 63, l5 = lane & 31;
    const bool up = lane >= 32;
    const unsigned char* TU = P.tabU() + l5 * 16;
    const unsigned char* TV = P.tabV() + l5 * 16;
    const int j15 = lane & 15;
    const int rr = ((j15 >> 3) & 1) | ((j15 & 1) << 1), zi = (j15 >> 1) & 3;
    const int srcl = (rr * 4 + (zi & 1) * 2 + (zi >> 1)) * 4;
    float xv[32], o[32];
    {
      const bf16_t* xp = P.u() + (size_t)row * DM + l5 * 32;
      unpack8(*(const uint4*)xp, xv); unpack8(*(const uint4*)(xp + 8), xv + 8);
      unpack8(*(const uint4*)(xp + 16), xv + 16); unpack8(*(const uint4*)(xp + 24), xv + 24);
    }
    const int idx0 = P.sel_idx()[(size_t)row * 128 + lane], idx1 = P.sel_idx()[(size_t)row * 128 + 64 + lane];
    const float gt0 = P.sel_g()[(size_t)row * 128 + lane] * P.invV()[idx0], gt1 = P.sel_g()[(size_t)row * 128 + 64 + lane] * P.invV()[idx1];
    const float iu0 = P.invU()[idx0], iu1 = P.invU()[idx1];
    float d0 = 0.f, d1 = 0.f;
    uint4 bufA[8], bufB[8];
#define PG_LOAD(buf, T, kk) do { _Pragma("unroll") for (int j = 0; j < 8; ++j) { \
      const int k_ = (kk) + 2 * j; const int src_ = k_ < 64 ? idx0 : idx1; \
      const int elo_ = __builtin_amdgcn_readlane(src_, k_ & 63), ehi_ = __builtin_amdgcn_readlane(src_, (k_ & 63) + 1); \
      buf[j] = *(const uint4*)(T + (size_t)(up ? ehi_ : elo_) * 512); } } while (0)
#define PG_DOT(buf, kk) do { float pv[8]; _Pragma("unroll") for (int j = 0; j < 8; ++j) { float s_ = 0.f; const uint32_t w_[4] = {buf[j].x, buf[j].y, buf[j].z, buf[j].w}; \
      _Pragma("unroll") for (int d = 0; d < 4; ++d) { float f[8]; uint32_t wd_ = w_[d]; asm volatile("" : "+v"(wd_) : "v"(s_)); cvt8(wd_, f); \
        _Pragma("unroll") for (int i = 0; i < 8; ++i) s_ += f[i] * xv[d * 8 + i]; } pv[j] = s_; } \
      const float z0 = swap16_add(pv[0], pv[4]), z1 = swap16_add(pv[1], pv[5]), z2 = swap16_add(pv[2], pv[6]), z3 = swap16_add(pv[3], pv[7]); \
      const bool hi8 = (lane & 8) != 0, hi4 = (lane & 4) != 0; \
      const float y0 = (hi8 ? z1 : z0) + DPP_F(hi8 ? z0 : z1, 0x128); \
      const float y1 = (hi8 ? z3 : z2) + DPP_F(hi8 ? z2 : z3, 0x128); \
      float q_ = (hi4 ? y1 : y0) + DPP_F(hi4 ? y0 : y1, 0x141); \
      q_ += DPP_F(q_, 0xB1); q_ += DPP_F(q_, 0x4E); \
      const float t_ = __int_as_float(__builtin_amdgcn_ds_bpermute(srcl * 4, __float_as_int(q_))); \
      const int m_ = ((kk) >> 4) & 3; \
      if ((kk) < 64) d0 = ((lane >> 4) == m_) ? t_ : d0; else d1 = ((lane >> 4) == m_) ? t_ : d1; } while (0)
    PG_LOAD(bufA, TU, 0);
#pragma unroll 1
    for (int kk = 0; kk < 128; kk += 32) {
      PG_LOAD(bufB, TU, kk + 16);
      PG_DOT(bufA, kk);
      if (kk + 32 < 128) PG_LOAD(bufA, TU, kk + 32); else PG_LOAD(bufA, TV, 0);
      PG_DOT(bufB, kk + 16);
    }
    const float act0 = gelu_f(d0 * iu0) * gt0, act1 = gelu_f(d1 * iu1) * gt1;
#pragma unroll
    for (int i = 0; i < 32; ++i) o[i] = 0.f;
#define PG_ACC(buf, kk) do { _Pragma("unroll") for (int j = 0; j < 8; ++j) { const int k_ = (kk) + 2 * j; \
      const int asrc_ = __float_as_int(k_ < 64 ? act0 : act1); \
      const float alo_ = __int_as_float(__builtin_amdgcn_readlane(asrc_, k_ & 63)), ahi_ = __int_as_float(__builtin_amdgcn_readlane(asrc_, (k_ & 63) + 1)); \
      const float a_ = up ? ahi_ : alo_; \
      const uint32_t w_[4] = {buf[j].x, buf[j].y, buf[j].z, buf[j].w}; \
      _Pragma("unroll") for (int d = 0; d < 4; ++d) { float f[8]; uint32_t wd_ = w_[d]; asm volatile("" : "+v"(wd_) : "v"(o[(d * 8 + 31) & 31])); cvt8(wd_, f); \
        _Pragma("unroll") for (int i = 0; i < 8; ++i) o[d * 8 + i] += a_ * f[i]; } } } while (0)
#pragma unroll 1
    for (int kk = 0; kk < 128; kk += 32) {
      PG_LOAD(bufB, TV, kk + 16);
      PG_ACC(bufA, kk);
      if (kk + 32 < 128) PG_LOAD(bufA, TV, kk + 32);
      PG_ACC(bufB, kk + 16);
    }
#undef PG_LOAD
#undef PG_DOT
#undef PG_ACC
#pragma unroll
    for (int i = 0; i < 32; ++i) {
      auto r = __builtin_amdgcn_permlane32_swap(__float_as_uint(o[i]), __float_as_uint(o[i]), false, false);
      o[i] = __uint_as_float(r[0]) + __uint_as_float(r[1]);
    }
    const int lane_e = otid(wv) & 63, l5e = lane_e & 31;
    const bool upe = lane_e >= 32;
    const float* gate = P.mod() + (size_t)(layer * 5 + modrow(row)) * MODW + 5120 + l5e * 32;
    float* hr = P.h() + (size_t)row * DM + l5e * 32;
    float ss = 0.f;
    f32x4 hvv[8], ggv[8];
#pragma unroll
    for (int q = 0; q < 8; ++q) { hvv[q] = *(const f32x4*)(hr + q * 4); ggv[q] = *(const f32x4*)(gate + q * 4); }
#pragma unroll
    for (int q = 0; q < 8; ++q) asm volatile("" : "+v"(hvv[q]), "+v"(ggv[q]));
#pragma unroll
    for (int q = 0; q < 8; ++q) {
      float4 hv = make_float4(hvv[q][0], hvv[q][1], hvv[q][2], hvv[q][3]);
      const float4 gg = make_float4(ggv[q][0], ggv[q][1], ggv[q][2], ggv[q][3]);
      hv.x += gg.x * o[q * 4 + 0]; hv.y += gg.y * o[q * 4 + 1]; hv.z += gg.z * o[q * 4 + 2]; hv.w += gg.w * o[q * 4 + 3];
      if (layer == 0 && !upe) *(float4*)(hr + q * 4) = hv;
      o[q * 4 + 0] = hv.x; o[q * 4 + 1] = hv.y; o[q * 4 + 2] = hv.z; o[q * 4 + 3] = hv.w;
      if (!upe) ss += hv.x * hv.x + hv.y * hv.y + hv.z * hv.z + hv.w * hv.w;
    }
    ss = wave_sum(ss);
    const float rstd = rsqrtf(ss * (1.f / 1024.f) + 1e-6f);
    if (layer == 0) {
      const float* g1 = P.norm1_g + 1024 + l5e * 32;
      const float* mr = P.mod() + (size_t)(5 + modrow(row)) * MODW + l5e * 32;
      if (!upe) {
#pragma unroll
        for (int q = 0; q < 4; ++q) {
          float ov[8];
#pragma unroll
          for (int e = 0; e < 8; ++e) ov[e] = o[q * 8 + e] * rstd * g1[q * 8 + e] * (1.f + mr[1024 + q * 8 + e]) + mr[q * 8 + e];
          *(uint4*)(P.u() + (size_t)row * DM + l5e * 32 + q * 8) = make_uint4(pack2(ov[0], ov[1]), pack2(ov[2], ov[3]), pack2(ov[4], ov[5]), pack2(ov[6], ov[7]));
        }
      }
    } else {
      const float* gf = P.final_g + l5e * 32;
      if (!upe) {
#pragma unroll
        for (int q = 0; q < 8; ++q) {
          const float4 gg = *(const float4*)(gf + q * 4);
          *(float4*)(P.out + (size_t)row * DM + l5e * 32 + q * 4) =
              make_float4(o[q * 4] * rstd * gg.x, o[q * 4 + 1] * rstd * gg.y, o[q * 4 + 2] * rstd * gg.z, o[q * 4 + 3] * rstd * gg.w);
        }
      }
    }
  }
}

struct EpiOutproj {
  static constexpr bool PERM = false, AFTER_DRAIN = false;
  static constexpr int MIDK_T = 16;
  float* H; const float* hl; const float* hc; const float* modl;
  const float* yss;
  __device__ __forceinline__ void midk(pg8::f32x4 (&acc)[2][2][4][2], const pg8::Unit& u, int wr, int wc, int fr, int fq) const {
    const int row0 = u.pm * 256 + wr * 64 + fr;
#pragma unroll
    for (int ai = 0; ai < 2; ++ai)
#pragma unroll
      for (int m = 0; m < 4; ++m) {
        const float rstd = rsqrtf(yss[row0 + ai * 128 + m * 16] * (1.f / 1024.f) + 1e-6f);
#pragma unroll
        for (int bj = 0; bj < 2; ++bj)
#pragma unroll
          for (int n = 0; n < 2; ++n) acc[ai][bj][m][n] *= rstd;
      }
  }
  __device__ __forceinline__ void operator()(const pg8::f32x4 (&acc)[2][2][4][2], const pg8::Unit& u, int wr, int wc, int fr, int fq) const {
    const int row0 = u.pm * 256 + wr * 64 + fr, col0 = u.pn * 256 + wc * 32 + 4 * fq;
    const float* gate = modl + (size_t)modrow(row0) * MODW + 2048 + col0;
    pg8::f32x4 gv[2][2];
#pragma unroll
    for (int bj = 0; bj < 2; ++bj)
#pragma unroll
      for (int n = 0; n < 2; ++n) gv[bj][n] = *(const pg8::f32x4*)(gate + bj * 128 + n * 16);
    pg8::f32x4 sA[4], sB[4];
#define EO_LOAD(dstv, ai_, m_) do { const float* s_ = hrow(hl, hc, row0 + (ai_) * 128 + (m_) * 16) + col0; \
      dstv[0] = *(const pg8::f32x4*)(s_); dstv[1] = *(const pg8::f32x4*)(s_ + 16); dstv[2] = *(const pg8::f32x4*)(s_ + 128); dstv[3] = *(const pg8::f32x4*)(s_ + 144); } while (0)
#define EO_STORE(srcv, ai_, m_) do { asm volatile("" : "+v"(srcv[0]), "+v"(srcv[1]), "+v"(srcv[2]), "+v"(srcv[3])); \
      float* d_ = H + (size_t)(row0 + (ai_) * 128 + (m_) * 16) * DM + col0; \
      *(pg8::f32x4*)(d_) = srcv[0] + gv[0][0] * acc[ai_][0][m_][0]; *(pg8::f32x4*)(d_ + 16) = srcv[1] + gv[0][1] * acc[ai_][0][m_][1]; \
      *(pg8::f32x4*)(d_ + 128) = srcv[2] + gv[1][0] * acc[ai_][1][m_][0]; *(pg8::f32x4*)(d_ + 144) = srcv[3] + gv[1][1] * acc[ai_][1][m_][1]; } while (0)
    EO_LOAD(sA, 0, 0);
#pragma unroll
    for (int i = 0; i < 8; i += 2) {
      EO_LOAD(sB, (i + 1) >> 2, (i + 1) & 3);
      EO_STORE(sA, i >> 2, i & 3);
      if (i + 2 < 8) EO_LOAD(sA, (i + 2) >> 2, (i + 2) & 3);
      EO_STORE(sB, (i + 1) >> 2, (i + 1) & 3);
    }
#undef EO_LOAD
#undef EO_STORE
  }
};

__device__ __forceinline__ uint32_t fp4_code(float x, float sc) {
  const float a = fabsf(x) * sc;
  const uint32_t c = (uint32_t)(a > 0.25f) + (uint32_t)(a > 0.75f) + (uint32_t)(a > 1.25f) + (uint32_t)(a > 1.75f) +
                     (uint32_t)(a > 2.5f) + (uint32_t)(a > 3.5f) + (uint32_t)(a > 5.0f);
  return c | (x < 0.f ? 8u : 0u);
}
__device__ void ph_convert_tables(int wv, const Params& P, int layer, int bid, int nb) {
  const int lane = otid(wv) & 63;
  for (int it0 = (bid * NWAVE + wv) * 2; it0 < 2 * 16384; it0 += nb * NWAVE * 2) {
    f32x4 v[2][4];
#pragma unroll
    for (int rr = 0; rr < 2; ++rr) {
      const int it = it0 + rr, t = it >> 14, e = it & 16383;
      const float* src = (t == 0 ? P.peer_u : P.peer_v) + ((size_t)layer * 16384 + e) * 1024 + lane * 16;
#pragma unroll
      for (int i = 0; i < 4; ++i) v[rr][i] = ((const f32x4*)src)[i];
    }
#pragma unroll
    for (int rr = 0; rr < 2; ++rr)
#pragma unroll
      for (int i = 0; i < 4; ++i) asm volatile("" : "+v"(v[rr][i]));
#pragma unroll
    for (int rr = 0; rr < 2; ++rr) {
      const int it = it0 + rr, t = it >> 14, e = it & 16383;
      float m = 0.f;
#pragma unroll
      for (int i = 0; i < 4; ++i)
        m = fmaxf(m, fmaxf(fmaxf(fabsf(v[rr][i][0]), fabsf(v[rr][i][1])), fmaxf(fabsf(v[rr][i][2]), fabsf(v[rr][i][3]))));
      m = wave_max(m);
      m = fmaxf(m, 1e-30f);
      const float sc = 6.0f / m, inv = m * (1.0f / 6.0f);
      uint2 o;
      o.x = fp4_code(v[rr][0][0], sc) | (fp4_code(v[rr][0][1], sc) << 4) | (fp4_code(v[rr][0][2], sc) << 8) | (fp4_code(v[rr][0][3], sc) << 12) |
            (fp4_code(v[rr][1][0], sc) << 16) | (fp4_code(v[rr][1][1], sc) << 20) | (fp4_code(v[rr][1][2], sc) << 24) | (fp4_code(v[rr][1][3], sc) << 28);
      o.y = fp4_code(v[rr][2][0], sc) | (fp4_code(v[rr][2][1], sc) << 4) | (fp4_code(v[rr][2][2], sc) << 8) | (fp4_code(v[rr][2][3], sc) << 12) |
            (fp4_code(v[rr][3][0], sc) << 16) | (fp4_code(v[rr][3][1], sc) << 20) | (fp4_code(v[rr][3][2], sc) << 24) | (fp4_code(v[rr][3][3], sc) << 28);
      *(uint2*)((t == 0 ? P.tabU() : P.tabV()) + (size_t)e * 512 + lane * 8) = o;
      if (lane == 0) (t == 0 ? P.invU() : P.invV())[e] = inv;
    }
  }
}

enum {
  PH_PREP = 0, PH_NORM1, PH_INPROJ, PH_CONV, PH_SSDPREP, PH_STATES, PH_SCAN, PH_SSDY, PH_SSDNORM, PH_POOL, PH_NA,
  PH_OUTPROJ, PH_NORM2, PH_QGEMM, PH_TOPK, PH_GATHER, PH_FINAL
};

#define SMEM_BYTES 131072

__device__ __forceinline__ void run_phase(int wv, const Params& P, int ph, int layer, char* smem, int bid, int nb) {
  const float* hl = layer == 0 ? P.x : P.h();
  const float* hc = layer == 0 ? P.ctx : P.h() + (size_t)NLAT * DM;
  const int nrows = layer == 0 ? NTOK : NLAT;
  switch (ph) {
    case PH_PREP:
      for (int i = bid * NTHR + otid(wv); i < 2 * 8 * 2 * 128 * 128; i += nb * NTHR) P.keysb()[i] = f2bf(P.peer_keys[i]);
      for (int i = bid * NTHR + otid(wv); i < 2 * 4 * 128 * 128; i += nb * NTHR) {
        const int k = i & 127, n = (i >> 7) & 127, lg = i >> 14;
        P.poolwT()[i] = f2bf(P.pool_w[((size_t)lg * 128 + k) * 128 + n]);
      }
      ph_mod(wv, P, (float*)smem, bid, nb);
      for (int l = 0; l < 2; ++l) {
        ph_transpose(wv, P.w_in + (size_t)l * 1024 * INW, P.w_inT() + (size_t)l * PW * 1024, 1024, INW, PW, 0, 2560, 32, PW, (float*)smem, bid, nb);
        ph_transpose(wv, P.w_in + (size_t)l * 1024 * INW, P.w_dtT() + (size_t)l * 128 * 1024, 1024, INW, 128, 2560, 1 << 30, 0, 32, (float*)smem, bid, nb);
        ph_transpose(wv, P.w_out + (size_t)l * 2048 * 1024, P.w_outT() + (size_t)l * 1024 * 2048, 2048, 1024, 1024, 0, 1 << 30, 0, 1024, (float*)smem, bid, nb,
                     P.ssd_norm_g + l * 1024, 1024);
        ph_transpose(wv, P.peer_wq + (size_t)l * 1024 * 2048, P.w_qT() + (size_t)l * 2048 * 1024, 1024, 2048, 2048, 0, 1 << 30, 0, 2048, (float*)smem, bid, nb);
      }
      break;
    case PH_NORM1:
      ph_norm(wv, hl, hc, P.norm1_g + layer * 1024, P.mod() + (size_t)layer * 5 * MODW, 0, 1024, NTOK, P.u(), bid, nb);
      break;
    case PH_INPROJ:
    {
      pg8::Gemm g{P.u(), P.w_inT() + (size_t)layer * PW * 1024, NTOK, PW, 1024};
      pg8::StaticOrder S; S.init(g.M, g.N, nb, bid);
      pg8::EpiBf16<0> E{P.p(), PW, nullptr, 0, 0};
      pg8::gemm_phase<pg8::EpiBf16<0>, pg8::StaticOrder, false>(wv, (PG8_LAS unsigned char*)smem, g, S, E, nullptr);
      {
        const int units = (NTOK / 256) * (PW / 256), rem = units % nb;
        const int nidle = rem == 0 ? nb : nb - rem, first_idle = rem == 0 ? 0 : rem;
        if (bid >= first_idle) ph_dtprep(wv, P, layer, smem, bid - first_idle, nidle);
      }
      break;
    }
    case PH_CONV: ph_conv(wv, P, layer, bid, nb); ph_vtranspose(wv, P, smem, bid, nb); break;
    case PH_STATES: ph_states_mfma(wv, P, layer, smem, bid, nb); break;
    case PH_SCAN: ph_scan(wv, P, bid, nb); break;
    case PH_SSDY: ph_ssdy_mfma(wv, P, layer, nrows / 128, smem, bid, nb); break;
    case PH_SSDNORM: ph_ssdnorm(wv, P, layer, nrows, bid, nb); break;
    case PH_POOL: ph_pool_mfma(wv, P, layer, nrows, bid, nb); break;
    case PH_NA: ph_na_mfma(wv, P, layer, nrows, smem, bid, nb); break;
    case PH_OUTPROJ:
    {
      pg8::Gemm g{P.concat(), P.w_outT() + (size_t)layer * 1024 * 2048, nrows, 1024, 2048};
      pg8::StaticOrder S; S.init(g.M, g.N, nb, bid);
      EpiOutproj E{P.h(), hl, hc, P.mod() + (size_t)layer * 5 * MODW, P.yss()};
      pg8::gemm_phase<EpiOutproj, pg8::StaticOrder, false>(wv, (PG8_LAS unsigned char*)smem, g, S, E, nullptr);
      break;
    }
    case PH_NORM2:
      ph_norm(wv, P.h(), P.h() + (size_t)NLAT * DM, P.norm2_g + layer * 1024, P.mod() + (size_t)layer * 5 * MODW, 3072, 4096, nrows, P.u(), bid, nb);
      break;
    case PH_QGEMM:
    {
      pg8::Gemm g{P.u(), P.w_qT() + (size_t)layer * 2048 * 1024, nrows, 2048, 1024};
      pg8::StaticOrder S; S.init(g.M, g.N, nb, bid);
      pg8::EpiBf16<0> E{P.q(), 2048, nullptr, 0, 0};
      pg8::gemm_phase<pg8::EpiBf16<0>, pg8::StaticOrder, false>(wv, (PG8_LAS unsigned char*)smem, g, S, E, nullptr);
      ph_convert_tables(wv, P, layer, bid, nb);
      break;
    }
    case PH_TOPK: ph_peer_topk_mfma(wv, P, layer, nrows, smem, bid, nb); break;
    case PH_GATHER: ph_peer_gather(wv, P, layer, nrows, bid, nb); break;
  }
}

namespace cg = cooperative_groups;
typedef const __attribute__((address_space(4))) Params* kparams_t;
__device__ __forceinline__ const Params& kp_fresh() {
  kparams_t kp = (kparams_t)__builtin_amdgcn_kernarg_segment_ptr();
  asm volatile("" : "+s"(kp));
  return *(const Params*)kp;
}
__global__ void __launch_bounds__(NTHR) k_mega(Params P_unused) {
  __shared__ __attribute__((aligned(16))) char smem[SMEM_BYTES + 16];
  cg::grid_group grid = cg::this_grid();
  const int bid = blockIdx.x, nb = gridDim.x;
  const int wv = __builtin_amdgcn_readfirstlane(threadIdx.x >> 6);
  if (threadIdx.x == 0) *(uint4*)(smem + SMEM_BYTES) = make_uint4(0u, 0u, 0u, 0u);
  __syncthreads();
  (void)xcd_barrier_post((unsigned*)(kp_fresh().ws + WS_BAR), (volatile LAS unsigned*)(smem + SMEM_BYTES), threadIdx.x == 0);
#define GSYNC() do { XcdBarrier xb_; xb_.bar = (unsigned*)(kp_fresh().ws + WS_BAR); xb_.x = xb_xcc_id(); \
    xb_.st = (volatile LAS unsigned*)(smem + SMEM_BYTES); xcd_barrier(xb_, otid(wv) == 0); } while (0)
  run_phase(wv, kp_fresh(), PH_PREP, 0, smem, bid, nb);
  grid.sync();
  run_phase(wv, kp_fresh(), PH_NORM1, 0, smem, bid, nb); GSYNC();
#pragma unroll 1
  for (int layer = 0; layer < 2; ++layer) {
    run_phase(wv, kp_fresh(), PH_INPROJ, layer, smem, bid, nb); GSYNC();
    run_phase(wv, kp_fresh(), PH_CONV, layer, smem, bid, nb);
    GSYNC();
    run_phase(wv, kp_fresh(), PH_STATES, layer, smem, bid, nb);
    run_phase(wv, kp_fresh(), PH_POOL, layer, smem, bid, nb);
    run_phase(wv, kp_fresh(), PH_NA, layer, smem, bid, nb); GSYNC();
    run_phase(wv, kp_fresh(), PH_SCAN, layer, smem, bid, nb); GSYNC();
    run_phase(wv, kp_fresh(), PH_SSDY, layer, smem, bid, nb); GSYNC();
    run_phase(wv, kp_fresh(), PH_OUTPROJ, layer, smem, bid, nb); GSYNC();
    run_phase(wv, kp_fresh(), PH_NORM2, layer, smem, bid, nb); GSYNC();
    run_phase(wv, kp_fresh(), PH_QGEMM, layer, smem, bid, nb); GSYNC();
    run_phase(wv, kp_fresh(), PH_TOPK, layer, smem, bid, nb); GSYNC();
    run_phase(wv, kp_fresh(), PH_GATHER, layer, smem, bid, nb);
    if (layer == 0) GSYNC();
  }
}

extern "C" void kernel_launch(void* const* d_in, const int* in_sizes, int n_in, void* d_out, int out_size, void* d_ws,
                              size_t ws_size, hipStream_t stream) {
  Params P{};
  const float* const* in = (const float* const*)d_in;
  P.x = in[0]; P.c = in[1]; P.ctx = in[2]; P.c_ctx = in[3]; P.ada_w = in[4]; P.ada_b = in[5]; P.norm1_g = in[6];
  P.w_in = in[7]; P.conv_w = in[8]; P.conv_b = in[9]; P.a_log = in[10]; P.dt_bias = in[11]; P.d_skip = in[12];
  P.ssd_norm_g = in[13]; P.pool_w = in[14]; P.pool_scale = in[15]; P.na_rpb = in[16]; P.w_out = in[17];
  P.norm2_g = in[18]; P.peer_wq = in[19]; P.peer_keys = in[20]; P.peer_u = in[21]; P.peer_v = in[22]; P.final_g = in[23];
  P.out = (float*)d_out;
  P.ws = (char*)d_ws;
  if (WS_TOTAL > ws_size) { fprintf(stderr, "workspace too small: need %zu have %zu\n", (size_t)WS_TOTAL, ws_size); return; }

  static int grid_blocks = 0;
  if (!grid_blocks) {
    int dev = 0, cus = 0, per_cu = 0;
    hipGetDevice(&dev);
    hipDeviceGetAttribute(&cus, hipDeviceAttributeMultiprocessorCount, dev);
    hipOccupancyMaxActiveBlocksPerMultiprocessor(&per_cu, k_mega, NTHR, 0);
    if (per_cu > 4) per_cu = 4;
    grid_blocks = cus * per_cu;
  }
  hipMemsetAsync((char*)d_ws + WS_BAR, 0, 4096 * 4, stream);
  void* args[] = {&P};
  hipError_t e = hipLaunchCooperativeKernel((void*)k_mega, dim3(grid_blocks), dim3(NTHR), args, 0, stream);
  if (e != hipSuccess) fprintf(stderr, "cooperative launch failed: %s (grid %d)\n", hipGetErrorString(e), grid_blocks);
}
```

```cpp
#include <hip/hip_runtime.h>
#include <hip/hip_bf16.h>
#include <hip/hip_cooperative_groups.h>
#include <stdint.h>
#include <stdio.h>

typedef unsigned short bf16_t;
typedef __attribute__((ext_vector_type(8))) short bf16x8;
typedef __attribute__((ext_vector_type(4))) float f32x4;

#define NTHR 512
#define NWAVE 8
constexpr int DM = 1024;
constexpr int SEQ = 4096;
constexpr int NLAT = 16384;
constexpr int NCTXR = 1024;
constexpr int NTOK = 17408;
constexpr int INW = 4640;
constexpr int PW = 4608;
constexpr int OFF_Z = 0, OFF_XBC = 1024, OFF_POOL = 2560, OFF_Q = 3072, OFF_K = 3584, OFF_V = 4096;
constexpr int NCHUNK = 136;
constexpr int MODW = 6144;

constexpr size_t al256(size_t x) { return (x + 255) & ~(size_t)255; }
constexpr size_t WS_MOD = 0;
constexpr size_t WS_H = WS_MOD + al256((size_t)2 * 5 * MODW * 4);
constexpr size_t WS_P = WS_H + al256((size_t)NTOK * DM * 4);
constexpr size_t WS_TABU = WS_P + (size_t)80 * 1024 * 1024;
constexpr size_t WS_TABV = WS_TABU + (size_t)16384 * 512;
constexpr size_t WS_INVU = WS_TABV + (size_t)16384 * 512;
constexpr size_t WS_INVV = WS_INVU + (size_t)16384 * 4;
constexpr size_t WS_DTRAW = WS_P + al256((size_t)NTOK * PW * 2);
constexpr size_t WS_DTV = WS_DTRAW + al256((size_t)NTOK * 32 * 4);
constexpr size_t WS_CSV = WS_DTV + al256((size_t)NTOK * 32 * 4);
constexpr size_t WS_XBC = WS_CSV + al256((size_t)NTOK * 32 * 4);
constexpr size_t WS_VTL = WS_XBC + al256((size_t)NTOK * 512 * 2);
constexpr size_t WS_VTC = WS_VTL + al256((size_t)4 * 8 * 64 * 4096 * 2);
constexpr size_t WS_KEYSB = WS_VTC + al256((size_t)4 * 8 * 64 * 256 * 2);
constexpr size_t WS_POOLWT = WS_KEYSB + al256((size_t)2 * 8 * 2 * 128 * 128 * 2);
constexpr size_t WS_BT4 = WS_POOLWT + al256((size_t)2 * 4 * 128 * 128 * 2);
constexpr size_t WS_ATOT = WS_BT4 + al256((size_t)NTOK * 256 * 2);
constexpr size_t WS_STATES = WS_XBC + al256((size_t)NTOK * 1536 * 2);
constexpr size_t WS_YSS = WS_ATOT + al256((size_t)NCHUNK * 32 * 4);
static_assert(WS_YSS + (size_t)NTOK * 16 * 4 <= WS_STATES, "must fit in the old xbc region");
constexpr size_t WS_CONCAT = WS_STATES + al256((size_t)NCHUNK * 32 * 8192 * 2);
constexpr size_t WS_SELIDX = WS_CONCAT + al256((size_t)NTOK * 2048 * 2);
constexpr size_t WS_SELG = WS_SELIDX + al256((size_t)NTOK * 128 * 4);
constexpr size_t WS_WINT = WS_SELG + al256((size_t)NTOK * 128 * 4);
constexpr size_t WS_WDTT = WS_WINT + al256((size_t)2 * PW * 1024 * 2);
constexpr size_t WS_WOUTT = WS_WDTT + al256((size_t)2 * 128 * 1024 * 2);
constexpr size_t WS_WQT = WS_WOUTT + al256((size_t)2 * 1024 * 2048 * 2);
constexpr size_t WS_BAR = WS_WQT + al256((size_t)2 * 2048 * 1024 * 2);
constexpr size_t WS_XT4 = WS_BAR + al256((size_t)4096 * 4);
constexpr size_t WS_TOTAL = WS_XT4 + al256((size_t)NTOK * 1024 * 2);
static_assert((size_t)4 * 8 * (4096 + 256) * 64 * 2 <= WS_WINT - WS_SELIDX, "K relayout must fit in the sel_idx/sel_g region");
static_assert(WS_INVV + (size_t)16384 * 4 <= WS_DTRAW, "tables must fit in the tail of p");
static_assert((size_t)NTOK * 2048 * 2 <= (size_t)80 * 1024 * 1024, "q must fit below the tables");

struct Params {
  const float *x, *c, *ctx, *c_ctx, *ada_w, *ada_b, *norm1_g, *w_in, *conv_w, *conv_b, *a_log, *dt_bias, *d_skip,
      *ssd_norm_g, *pool_w, *pool_scale, *na_rpb, *w_out, *norm2_g, *peer_wq, *peer_keys, *peer_u, *peer_v, *final_g;
  float* out;
  char* ws;
  __device__ __forceinline__ float* mod() const { return (float*)(ws + WS_MOD); }
  __device__ __forceinline__ float* h() const { return (float*)(ws + WS_H); }
  __device__ __forceinline__ bf16_t* u() const { return (bf16_t*)(ws + WS_CONCAT); }
  __device__ __forceinline__ bf16_t* p() const { return (bf16_t*)(ws + WS_P); }
  __device__ __forceinline__ float* dtraw() const { return (float*)(ws + WS_DTRAW); }
  __device__ __forceinline__ float* dtv() const { return (float*)(ws + WS_DTV); }
  __device__ __forceinline__ float* csv() const { return (float*)(ws + WS_CSV); }
  __device__ __forceinline__ bf16_t* xbc() const { return (bf16_t*)(ws + WS_XBC); }
  __device__ __forceinline__ bf16_t* states() const { return (bf16_t*)(ws + WS_STATES); }
  __device__ __forceinline__ bf16_t* concat() const { return (bf16_t*)(ws + WS_CONCAT); }
  __device__ __forceinline__ bf16_t* q() const { return (bf16_t*)(ws + WS_P); }
  __device__ __forceinline__ int* sel_idx() const { return (int*)(ws + WS_SELIDX); }
  __device__ __forceinline__ float* sel_g() const { return (float*)(ws + WS_SELG); }
  __device__ __forceinline__ bf16_t* w_inT() const { return (bf16_t*)(ws + WS_WINT); }
  __device__ __forceinline__ bf16_t* w_dtT() const { return (bf16_t*)(ws + WS_WDTT); }
  __device__ __forceinline__ bf16_t* w_outT() const { return (bf16_t*)(ws + WS_WOUTT); }
  __device__ __forceinline__ bf16_t* w_qT() const { return (bf16_t*)(ws + WS_WQT); }
  __device__ __forceinline__ bf16_t* vtl() const { return (bf16_t*)(ws + WS_VTL); }
  __device__ __forceinline__ bf16_t* vtc() const { return (bf16_t*)(ws + WS_VTC); }
  __device__ __forceinline__ bf16_t* poolwT() const { return (bf16_t*)(ws + WS_POOLWT); }
  __device__ __forceinline__ bf16_t* keysb() const { return (bf16_t*)(ws + WS_KEYSB); }
  __device__ __forceinline__ bf16_t* xt4() const { return (bf16_t*)(ws + WS_XT4); }
  __device__ __forceinline__ bf16_t* bt4() const { return (bf16_t*)(ws + WS_BT4); }
  __device__ __forceinline__ float* wst() const { return (float*)(ws + WS_DTRAW); }
  __device__ __forceinline__ float* cst() const { return (float*)(ws + WS_CSV); }
  __device__ __forceinline__ float* dtt() const { return (float*)(ws + WS_DTV); }
  __device__ __forceinline__ float* yss() const { return (float*)(ws + WS_YSS); }
  __device__ __forceinline__ float* atot() const { return (float*)(ws + WS_ATOT); }
  __device__ __forceinline__ bf16_t* bfr() const { return (bf16_t*)(ws + WS_XBC); }
  __device__ __forceinline__ bf16_t* cfr() const { return (bf16_t*)(ws + WS_XBC + (size_t)NTOK * 256 * 2); }
  __device__ __forceinline__ bf16_t* ktl() const { return (bf16_t*)(ws + WS_SELIDX); }
  __device__ __forceinline__ bf16_t* ktc() const { return (bf16_t*)(ws + WS_SELIDX + (size_t)4 * 8 * 4096 * 64 * 2); }
  __device__ __forceinline__ unsigned char* tabU() const { return (unsigned char*)(ws + WS_TABU); }
  __device__ __forceinline__ unsigned char* tabV() const { return (unsigned char*)(ws + WS_TABV); }
  __device__ __forceinline__ float* invU() const { return (float*)(ws + WS_INVU); }
  __device__ __forceinline__ float* invV() const { return (float*)(ws + WS_INVV); }
};

__device__ __forceinline__ int otid(int wv) {
  int l;
  asm volatile("v_mbcnt_lo_u32_b32 %0, -1, 0\n\tv_mbcnt_hi_u32_b32 %0, -1, %0" : "=v"(l));
  return (wv << 6) | l;
}
__device__ __forceinline__ float bf2f(bf16_t v) { return __uint_as_float(((uint32_t)v) << 16); }
typedef __bf16 bf16x2_hw __attribute__((ext_vector_type(2)));
__device__ __forceinline__ uint32_t pack2(float a, float b) {
  const float __attribute__((ext_vector_type(2))) v = {a, b};
  return __builtin_bit_cast(uint32_t, __builtin_convertvector(v, bf16x2_hw));
}
__device__ __forceinline__ bf16_t f2bf(float f) { return (bf16_t)(pack2(f, 0.f) & 0xffffu); }
#define DPP_F(v, ctrl) __int_as_float(__builtin_amdgcn_update_dpp(0, __float_as_int(v), (ctrl), 0xf, 0xf, true))
__device__ __forceinline__ float wave_sum(float v) {
  v += DPP_F(v, 0xB1);
  v += DPP_F(v, 0x4E);
  v += DPP_F(v, 0x141);
  v += DPP_F(v, 0x140);
  const int iv = __float_as_int(v);
  return __int_as_float(__builtin_amdgcn_readlane(iv, 0)) + __int_as_float(__builtin_amdgcn_readlane(iv, 16)) +
         __int_as_float(__builtin_amdgcn_readlane(iv, 32)) + __int_as_float(__builtin_amdgcn_readlane(iv, 48));
}
__device__ __forceinline__ float wave_max(float v) {
  v = fmaxf(v, DPP_F(v, 0xB1));
  v = fmaxf(v, DPP_F(v, 0x4E));
  v = fmaxf(v, DPP_F(v, 0x141));
  v = fmaxf(v, DPP_F(v, 0x140));
  const int iv = __float_as_int(v);
  return fmaxf(fmaxf(__int_as_float(__builtin_amdgcn_readlane(iv, 0)), __int_as_float(__builtin_amdgcn_readlane(iv, 16))),
               fmaxf(__int_as_float(__builtin_amdgcn_readlane(iv, 32)), __int_as_float(__builtin_amdgcn_readlane(iv, 48))));
}
__device__ __forceinline__ float fexp(float v) { return __builtin_amdgcn_exp2f(v * 1.44269504088896341f); }
__device__ __forceinline__ float silu_f(float v) { return v * __builtin_amdgcn_rcpf(1.f + fexp(-v)); }
__device__ __forceinline__ float softplus_f(float v) { return fmaxf(v, 0.f) + log1pf(expf(-fabsf(v))); }
__device__ __forceinline__ float gelu_f(float v) { return 0.5f * v * (1.f + erff(v * 0.70710678118654752f)); }

__device__ __forceinline__ void unpack8(const uint4 v, float* f) {
  f[0] = __uint_as_float(v.x << 16); f[1] = __uint_as_float(v.x & 0xffff0000u);
  f[2] = __uint_as_float(v.y << 16); f[3] = __uint_as_float(v.y & 0xffff0000u);
  f[4] = __uint_as_float(v.z << 16); f[5] = __uint_as_float(v.z & 0xffff0000u);
  f[6] = __uint_as_float(v.w << 16); f[7] = __uint_as_float(v.w & 0xffff0000u);
}
typedef float f32x2_t __attribute__((ext_vector_type(2)));
typedef unsigned u32x4_t __attribute__((ext_vector_type(4)));
typedef short s16x4 __attribute__((ext_vector_type(4)));
typedef __attribute__((address_space(3))) s16x4 lds_s16x4;
__device__ __forceinline__ bf16x8 tr_read2(const char* a0, const char* a1) {
  const s16x4 a = __builtin_amdgcn_ds_read_tr16_b64_v4i16((lds_s16x4*)a0);
  const s16x4 b = __builtin_amdgcn_ds_read_tr16_b64_v4i16((lds_s16x4*)a1);
  return (bf16x8){a[0], a[1], a[2], a[3], b[0], b[1], b[2], b[3]};
}

__device__ __forceinline__ const float* hrow(const float* hl, const float* hc, int row) {
  return row < NLAT ? hl + (size_t)row * DM : hc + (size_t)(row - NLAT) * DM;
}
__device__ __forceinline__ int modrow(int row) { return row < NLAT ? (row >> 12) : 4; }

namespace pg8 {
#define PG8_LAS __attribute__((address_space(3)))
typedef unsigned short bf16_t;
typedef short bf16x8 __attribute__((ext_vector_type(8)));
typedef float f32x4 __attribute__((ext_vector_type(4)));
typedef unsigned u32x4 __attribute__((ext_vector_type(4)));
constexpr int BM = 256, BK = 64, HALF = 128, HTB = HALF * BK * 2  , STAGE_BYTES = 8 * HTB, NXCD = 8, WGM = 8;

__host__ __device__ __forceinline__ int lds_byte(int r, int c) { const int st = (r >> 4) * 2 + (c >> 5), rr = r & 15, cc = c & 31, ob = rr * 64 + cc * 2; return st * 1024 + (ob ^ (((ob >> 9) & 1) << 5)); }
__host__ __device__ __forceinline__ void stage_rc(int b, int& R, int& C) { const int st = b / 1024, sb = b % 1024, swz = sb ^ (((sb >> 9) & 1) << 5); R = (st >> 1) * 16 + swz / 64; C = (st & 1) * 32 + (swz % 64) / 2; }
__host__ __device__ __forceinline__ int perm32(int rho) { const int n = rho >> 4, i = rho & 15; return 8 * (i >> 2) + 4 * n + (i & 3); }

struct Unit { int pm, pn; };
struct Gemm { const bf16_t* A; const bf16_t* Bt; int M, N, K; };

struct StaticOrder {
    int nM, nN, nwg, G, c;
    __host__ __device__ void init(int M, int N, int G_, int c_) { nM = M / BM; nN = N / BM; nwg = nM * nN; G = G_; c = c_; }
    __host__ __device__ bool next(int i, Unit& u) const {
        const long L = (long)i * G + c; if (L >= nwg) return false;
        int wgid = (int)L; { const int q = nwg / NXCD, r = nwg % NXCD, xcd = wgid % NXCD, off = wgid / NXCD; wgid = (xcd < r ? xcd * (q + 1) : r * (q + 1) + (xcd - r) * q) + off; }
        const int nig = WGM * nN, gid = wgid / nig, fm = gid * WGM, gsz = (nM - fm) < WGM ? (nM - fm) : WGM;
        u.pm = fm + ((wgid % nig) % gsz); u.pn = (wgid % nig) / gsz; return true;
    }
    __device__ __forceinline__ void a_ready(const Unit&) const {}
    __device__ __forceinline__ void done(const Unit&) const {}
};

__device__ __forceinline__ unsigned cvt_pk_bf16(float lo, float hi) { unsigned r; asm volatile("v_cvt_pk_bf16_f32 %0, %1, %2" : "=v"(r) : "v"(lo), "v"(hi)); return r; }
typedef float f32x2 __attribute__((ext_vector_type(2)));
__device__ __forceinline__ f32x2 gelu_pk(f32x2 v) { return v; }
template <int ACT  > struct EpiBf16 {
    static constexpr bool PERM = true, AFTER_DRAIN = false; static constexpr int MIDK_T = 0;
    bf16_t* O; int ldc; const float* bias; int split_cols; size_t split_stride;
    __device__ __forceinline__ void operator()(const f32x4 (&acc)[2][2][4][2], const Unit& u, int wr, int wc, int fr, int fq) const {
        const int row0 = u.pm * BM + wr * 64 + fr; int colt = u.pn * BM; bf16_t* base = O;
        if (split_cols) { const int t = colt / split_cols; base += (size_t)t * split_stride; colt -= t * split_cols; }
        const int col0 = colt + wc * 32 + 8 * fq, bcol0 = u.pn * BM + wc * 32 + 8 * fq;
        f32x4 bv[2][2];
#pragma unroll
        for (int bj = 0; bj < 2; ++bj)
#pragma unroll
            for (int n = 0; n < 2; ++n) bv[bj][n] = bias ? *(const f32x4*)(bias + bcol0 + bj * HALF + 4 * n) : (f32x4){0.f, 0.f, 0.f, 0.f};
#pragma unroll
        for (int ai = 0; ai < 2; ++ai)
#pragma unroll
            for (int m = 0; m < 4; ++m) { bf16_t* rowp = base + (size_t)(row0 + ai * HALF + m * 16) * ldc + col0;
#pragma unroll
                for (int bj = 0; bj < 2; ++bj) { f32x4 v0 = acc[ai][bj][m][0] + bv[bj][0], v1 = acc[ai][bj][m][1] + bv[bj][1];
                    if (ACT == 1) { f32x2 a = gelu_pk((f32x2){v0[0], v0[1]}), b = gelu_pk((f32x2){v0[2], v0[3]}), c = gelu_pk((f32x2){v1[0], v1[1]}), d = gelu_pk((f32x2){v1[2], v1[3]});
                        v0 = (f32x4){a.x, a.y, b.x, b.y}; v1 = (f32x4){c.x, c.y, d.x, d.y}; }
                    if (ACT == 2) {
#pragma unroll
                        for (int j = 0; j < 4; ++j) { v0[j] = 0.5f * v0[j] * (1.0f + erff(v0[j] * 0.70710678f)); v1[j] = 0.5f * v1[j] * (1.0f + erff(v1[j] * 0.70710678f)); } }
                    u32x4 w; w.x = cvt_pk_bf16(v0[0], v0[1]); w.y = cvt_pk_bf16(v0[2], v0[3]); w.z = cvt_pk_bf16(v1[0], v1[1]); w.w = cvt_pk_bf16(v1[2], v1[3]);
                    *(u32x4*)(rowp + bj * HALF) = w; } }
    }
};

template <class Epi, class Sched, bool STAMP = false>
__device__ __forceinline__ void gemm_phase(int wv, PG8_LAS unsigned char* lds, const Gemm g, const Sched& S, const Epi& E, unsigned long long* stamps) {
    const int tid = otid(wv), wid = __builtin_amdgcn_readfirstlane(tid >> 6), lane = tid & 63, wr = wid >> 2, wc = wid & 3, fr = lane & 15, fq = lane >> 4;
    const int K = g.K, nt = K / BK;
    int ts_lo = 0, ts_hi = 0, nts = 0; const unsigned long long rt_entry = STAMP ? (unsigned long long)wall_clock64() : 0ull;
#define PG8_STAMP() do { if (STAMP && wid == 0 && nts < 64) { const unsigned long long _c = (unsigned long long)clock64(); \
        ts_lo = (lane == nts) ? (int)(unsigned)_c : ts_lo; ts_hi = (lane == nts) ? (int)(unsigned)(_c >> 32) : ts_hi; ++nts; } } while (0)
    PG8_STAMP();
    unsigned voffA[2], voffB[2];
#pragma unroll
    for (int i = 0; i < 2; ++i) { int R, C; stage_rc(tid * 16 + i * 8192, R, C); const int Rb = Epi::PERM ? ((R & ~31) + perm32(R & 31)) : R;
        voffA[i] = (unsigned)(R * K + C) * 2u; voffB[i] = (unsigned)(Rb * K + C) * 2u; }
    const size_t kstep = (size_t)(BK * 2);
    const size_t hstep = (size_t)HALF * K * 2;
    const size_t tstep = 2 * hstep;
    const unsigned ldsw = (unsigned)wid * 1024u;
    const int aoff = lds_byte(wr * 64 + fr, fq * 8), boff = lds_byte(wc * 32 + fr, fq * 8);
#define PG8_SA(b, h) (((b) * 2 + (h)) * HTB)
#define PG8_SB(b, h) ((4 + (b) * 2 + (h)) * HTB)
#define PG8_STAGE(bufoff, gbase, voff) do { _Pragma("unroll") for (int _i = 0; _i < 2; ++_i) \
        __builtin_amdgcn_global_load_lds((const unsigned*)((const char*)(gbase) + (voff)[_i]), (PG8_LAS unsigned*)(lds + (bufoff) + ldsw + _i * 8192), 16, 0, 0); } while (0)
#define PG8_LDA(dst, b, h) do { _Pragma("unroll") for (int m = 0; m < 4; ++m) _Pragma("unroll") for (int k = 0; k < 2; ++k) dst[m][k] = *(const PG8_LAS bf16x8*)(lds + PG8_SA(b, h) + aoff + m * 2048 + k * 1024); } while (0)
#define PG8_LDB(dst, b, h) do { _Pragma("unroll") for (int n = 0; n < 2; ++n) _Pragma("unroll") for (int k = 0; k < 2; ++k) dst[n][k] = *(const PG8_LAS bf16x8*)(lds + PG8_SB(b, h) + boff + n * 2048 + k * 1024); } while (0)
#define PG8_MMA(ai, bj, At, Bt) do { __builtin_amdgcn_s_setprio(1); _Pragma("unroll") for (int m = 0; m < 4; ++m) _Pragma("unroll") for (int n = 0; n < 2; ++n) _Pragma("unroll") for (int k = 0; k < 2; ++k) \
        acc[ai][bj][m][n] = __builtin_amdgcn_mfma_f32_16x16x32_bf16(Bt[n][k], At[m][k], acc[ai][bj][m][n], 0, 0, 0); __builtin_amdgcn_s_setprio(0); } while (0)
#define PG8_WAIT_V(n) asm volatile("s_waitcnt vmcnt(" #n ")" ::: "memory")
#define PG8_WAIT_L(n) asm volatile("s_waitcnt lgkmcnt(" #n ")" ::: "memory")
#define PG8_BAR __builtin_amdgcn_s_barrier()
#define PG8_SCHED __builtin_amdgcn_sched_barrier(0)
    Unit cur, nxt; int ui = 0;
    if (!S.next(0, cur)) return;
    f32x4 acc[2][2][4][2];
#pragma unroll
    for (int a = 0; a < 2; ++a)
#pragma unroll
        for (int b = 0; b < 2; ++b)
#pragma unroll
            for (int m = 0; m < 4; ++m)
#pragma unroll
                for (int n = 0; n < 2; ++n) acc[a][b][m][n] = (f32x4){0.f, 0.f, 0.f, 0.f};
    bf16x8 At[4][2], B0[2][2], B1[2][2];
    const char* cA = (const char*)g.A + (size_t)cur.pm * tstep; const char* cB = (const char*)g.Bt + (size_t)cur.pn * tstep;
    S.a_ready(cur);
    PG8_STAGE(PG8_SB(0, 0), cB, voffB); PG8_STAGE(PG8_SA(0, 0), cA, voffA); PG8_STAGE(PG8_SB(0, 1), cB + hstep, voffB); PG8_STAGE(PG8_SA(0, 1), cA + hstep, voffA);
    if (wr == 1) PG8_BAR;
    PG8_WAIT_V(4); PG8_BAR;
    PG8_STAGE(PG8_SB(1, 0), cB + kstep, voffB); PG8_STAGE(PG8_SA(1, 0), cA + kstep, voffA); PG8_STAGE(PG8_SB(1, 1), cB + hstep + kstep, voffB);
    PG8_WAIT_V(6); PG8_BAR;
    PG8_STAMP();
    for (;;) {
        const bool has_next = S.next(ui + 1, nxt);
        const char* nA = has_next ? (const char*)g.A + (size_t)nxt.pm * tstep : cA; const char* nB = has_next ? (const char*)g.Bt + (size_t)nxt.pn * tstep : cB;
        for (int t = 0; t < nt; t += 2) {
            if constexpr (Epi::MIDK_T > 0) { if (t == Epi::MIDK_T) E.midk(acc, cur, wr, wc, fr, fq); }
            const bool last = (t == nt - 2);
            const char* a1 = cA + (size_t)(t + 1) * kstep;
            const char* a2 = last ? nA : cA + (size_t)(t + 2) * kstep; const char* b2 = last ? nB : cB + (size_t)(t + 2) * kstep;
            const char* a3 = a2 + kstep; const char* b3 = b2 + kstep;
            if (last && has_next) S.a_ready(nxt);
            PG8_LDB(B0, 0, 0); PG8_SCHED; PG8_LDA(At, 0, 0); PG8_STAGE(PG8_SA(1, 1), a1 + hstep, voffA);
            PG8_WAIT_L(8); PG8_BAR; PG8_WAIT_L(0); PG8_MMA(0, 0, At, B0); PG8_BAR; PG8_SCHED;
            PG8_LDB(B1, 0, 1); PG8_STAGE(PG8_SB(0, 0), b2, voffB);
            PG8_BAR; PG8_WAIT_L(0); PG8_MMA(0, 1, At, B1); PG8_BAR;
            PG8_LDA(At, 0, 1); PG8_STAGE(PG8_SA(0, 0), a2, voffA);
            PG8_BAR; PG8_WAIT_L(0); PG8_MMA(1, 0, At, B0); PG8_BAR; PG8_SCHED;
            PG8_STAGE(PG8_SB(0, 1), b2 + hstep, voffB);
            PG8_WAIT_V(6); PG8_BAR; PG8_MMA(1, 1, At, B1); PG8_BAR;
            PG8_LDB(B0, 1, 0); PG8_SCHED; PG8_LDA(At, 1, 0); PG8_STAGE(PG8_SA(0, 1), a2 + hstep, voffA);
            PG8_WAIT_L(8); PG8_BAR; PG8_WAIT_L(0); PG8_MMA(0, 0, At, B0); PG8_BAR; PG8_SCHED;
            PG8_LDB(B1, 1, 1); PG8_STAGE(PG8_SB(1, 0), b3, voffB);
            PG8_BAR; PG8_WAIT_L(0); PG8_MMA(0, 1, At, B1); PG8_BAR;
            PG8_LDA(At, 1, 1); PG8_STAGE(PG8_SA(1, 0), a3, voffA);
            PG8_BAR; PG8_WAIT_L(0); PG8_MMA(1, 0, At, B0); PG8_BAR; PG8_SCHED;
            PG8_STAGE(PG8_SB(1, 1), b3 + hstep, voffB);
            PG8_WAIT_V(6); PG8_BAR; PG8_MMA(1, 1, At, B1); PG8_BAR;
        }
        PG8_STAMP();
        if constexpr (!Epi::AFTER_DRAIN) { E(acc, cur, wr, wc, fr, fq); S.done(cur); }
        PG8_STAMP();
        if (!has_next) break;
#pragma unroll
        for (int a = 0; a < 2; ++a)
#pragma unroll
            for (int b = 0; b < 2; ++b)
#pragma unroll
                for (int m = 0; m < 4; ++m)
#pragma unroll
                    for (int n = 0; n < 2; ++n) acc[a][b][m][n] = (f32x4){0.f, 0.f, 0.f, 0.f};
        cur = nxt; cA = nA; cB = nB; ++ui;
    }
    PG8_WAIT_V(0);
    if (wr == 0) PG8_BAR;
    PG8_BAR;
    if constexpr (Epi::AFTER_DRAIN) { E.fused(acc, cur, wr, wc, fr, fq, lds, wid, lane); S.done(cur); }
    PG8_STAMP();
    if (STAMP && wid == 0) { stamps[lane] = lane < nts ? (((unsigned long long)(unsigned)ts_hi << 32) | (unsigned)ts_lo) : 0ull;
        if (lane == 62) stamps[62] = rt_entry; if (lane == 63) stamps[63] = (unsigned long long)wall_clock64(); }
#undef PG8_STAMP
#undef PG8_SA
#undef PG8_SB
#undef PG8_STAGE
#undef PG8_LDA
#undef PG8_LDB
#undef PG8_MMA
#undef PG8_WAIT_V
#undef PG8_WAIT_L
#undef PG8_BAR
#undef PG8_SCHED
}
}

#define XB_TMO      128
#define XB_XCNT(j)  (256  + 64 * (j))
#define XB_XSUB(j)  (1280 + 64 * (j))
#define XB_XGEN(j)  (2304 + 64 * (j))
#define XB_TOP      3328
#define XB_TOPGEN   3392
#define XCD_BAR_WORDS 3456
#define XB_SPIN_CAP (1u << 27)
#define LAS __attribute__((address_space(3)))

__device__ __forceinline__ unsigned xb_ld(unsigned* p)              { return __hip_atomic_load(p, __ATOMIC_RELAXED, __HIP_MEMORY_SCOPE_AGENT); }
__device__ __forceinline__ unsigned xb_add(unsigned* p, unsigned v) { return __hip_atomic_fetch_add(p, v, __ATOMIC_RELAXED, __HIP_MEMORY_SCOPE_AGENT); }
__device__ __forceinline__ unsigned xb_xcc_id() { return (unsigned)__builtin_amdgcn_s_getreg((3 << 11) | 20) & 0xFu; }
#define XB_SPIN(cond, bar) do { unsigned _sp = 0; while (cond) { __builtin_amdgcn_s_sleep(1); \
    if ((++_sp & 255u) == 0u) { if (xb_ld(&(bar)[XB_TMO])) break; if (_sp > XB_SPIN_CAP) { atomicAdd(&(bar)[XB_TMO], 1u); break; } } } } while (0)

struct XcdBarrier {
    unsigned* bar; unsigned x;
    volatile LAS unsigned* st;
};

__device__ __forceinline__ XcdBarrier xcd_barrier_post(unsigned* bar, volatile LAS unsigned* st, bool xb_t0) {
    XcdBarrier b; b.bar = bar; b.x = xb_xcc_id(); b.st = st;
    if (xb_t0) (void)xb_add(&bar[XB_XCNT(b.x)], 1u);
    return b;
}
__device__ __forceinline__ void xcd_barrier_complete(unsigned* bar, unsigned x, unsigned& nloc, unsigned& nx) {
    const unsigned G = gridDim.x * gridDim.y * gridDim.z;
    unsigned sum, cnt, mine, sp = 0u;
    for (;;) {
        sum = 0u; cnt = 0u; mine = 0u;
#pragma unroll
        for (unsigned j = 0; j < 16; ++j) { const unsigned c = xb_ld(&bar[XB_XCNT(j)]); sum += c; cnt += (c > 0u) ? 1u : 0u; mine = (j == x) ? c : mine; }
        if (sum == G) break;
        __builtin_amdgcn_s_sleep(1);
        if ((++sp & 255u) == 0u) { if (xb_ld(&bar[XB_TMO])) break; if (sp > XB_SPIN_CAP) { atomicAdd(&bar[XB_TMO], 1u); break; } }
    }
    nloc = mine > 0u ? mine : 1u; nx = cnt > 0u ? cnt : 1u;
}

__device__ __forceinline__ void xcd_barrier(const XcdBarrier& b, bool xb_t0) {
    asm volatile("s_waitcnt vmcnt(0)" ::: "memory");
    __syncthreads();
    if (xb_t0) {
        unsigned* bar = b.bar;
        __builtin_amdgcn_s_waitcnt(0);
        unsigned nloc = b.st[0], nx = b.st[1];
        if (nloc == 0u) { xcd_barrier_complete(bar, b.x, nloc, nx); b.st[0] = nloc; b.st[1] = nx; }
        const unsigned old = xb_add(&bar[XB_XSUB(b.x)], 1u);
        const unsigned gen = old / nloc;
        if (old + 1u == (gen + 1u) * nloc) {
            __builtin_amdgcn_fence(__ATOMIC_RELEASE, "agent");
            asm volatile("s_waitcnt vmcnt(0)" ::: "memory");
            const unsigned og = xb_add(&bar[XB_TOP], 1u);
            const unsigned tg = og / nx;
            if (og + 1u == (tg + 1u) * nx) xb_add(&bar[XB_TOPGEN], 1u);
            else XB_SPIN(xb_ld(&bar[XB_TOPGEN]) == tg, bar);
            __builtin_amdgcn_fence(__ATOMIC_ACQUIRE, "agent");
            xb_add(&bar[XB_XGEN(b.x)], 1u);
            asm volatile("s_waitcnt vmcnt(0)" ::: "memory");
        } else {
            XB_SPIN(xb_ld(&bar[XB_XGEN(b.x)]) == gen, bar);
            __builtin_amdgcn_fence(__ATOMIC_ACQUIRE, "agent");
            asm volatile("s_waitcnt vmcnt(0)" ::: "memory");
        }
    }
    __syncthreads();
}


__device__ void ph_transpose(int wv, const float* __restrict__ src, bf16_t* __restrict__ dst, int K, int N, int Npad,
                             int col0, int skip_from, int skip, int nvalid, float* tile0, int bid, int nb,
                             const float* kscale = nullptr, int kscale_n = 0) {
  const int tk = K / 32, tn = Npad / 32;
  const int tid = otid(wv), half = tid >> 8, t5 = tid & 255;
  const int tx = t5 & 31, ty = t5 >> 5;
  float* tile = tile0 + half * (32 * 33);
  for (int tb = bid * 2; tb < tk * tn; tb += nb * 2) {
    const int t = tb + half;
    const bool act = t < tk * tn;
    const int kt = t / tn, nt = t % tn;
    __syncthreads();
    if (act)
      for (int i = ty; i < 32; i += 8) {
        const int k = kt * 32 + i, n = nt * 32 + tx;
        const int cc = col0 + n + (n >= skip_from ? skip : 0);
        const float ks = (kscale != nullptr && k < kscale_n) ? kscale[k] : 1.f;
        tile[i * 33 + tx] = (n < nvalid) ? src[(size_t)k * N + cc] * ks : 0.f;
      }
    __syncthreads();
    if (act)
      for (int i = ty; i < 32; i += 8) {
        const int n = nt * 32 + i, k = kt * 32 + tx;
        dst[(size_t)n * K + k] = f2bf(tile[tx * 33 + i]);
      }
  }
}

__device__ void ph_mod(int wv, const Params& P, float* sm, int bid, int nb) {
  const int tid = otid(wv);
  float* sv = sm;
  float* red = sm + 5 * 1024;
  for (int i = tid; i < 5 * 1024; i += NTHR) {
    const float v = (i < 4096) ? P.c[i] : P.c_ctx[i - 4096];
    sv[i] = silu_f(v);
  }
  __syncthreads();
  const int c4 = tid & 15, kg = tid >> 4;
  for (int it = bid; it < 192; it += nb) {
    const int layer = it / 96, cb = it % 96;
    const float4* W = (const float4*)(P.ada_w + (size_t)layer * 1024 * MODW + cb * 64) + c4;
    float4 a[5];
#pragma unroll
    for (int r = 0; r < 5; ++r) a[r] = make_float4(0.f, 0.f, 0.f, 0.f);
#pragma unroll 8
    for (int kk = 0; kk < 32; ++kk) {
      const int k = kg * 32 + kk;
      const float4 w = W[(size_t)k * (MODW / 4)];
#pragma unroll
      for (int r = 0; r < 5; ++r) {
        const float s = sv[r * 1024 + k];
        a[r].x += s * w.x; a[r].y += s * w.y; a[r].z += s * w.z; a[r].w += s * w.w;
      }
    }
#pragma unroll
    for (int r = 0; r < 5; ++r) *(float4*)(red + ((kg * 16 + c4) * 5 + r) * 4) = a[r];
    __syncthreads();
    if (tid < 320) {
      const int r = tid >> 6, c = tid & 63;
      float s = 0.f;
      for (int g = 0; g < 32; ++g) s += red[((g * 16 + (c >> 2)) * 5 + r) * 4 + (c & 3)];
      P.mod()[(size_t)(layer * 5 + r) * MODW + cb * 64 + c] = s + P.ada_b[layer * MODW + cb * 64 + c];
    }
    __syncthreads();
  }
}

__device__ void ph_norm(int wv, const float* hl, const float* hc, const float* __restrict__ g, const float* __restrict__ modl,
                        int shift_off, int scale_off, int nrows, bf16_t* __restrict__ dst, int bid, int nb) {
  const int wave = otid(wv) >> 6, lane = otid(wv) & 63;
  for (int row = bid * NWAVE + wave; row < nrows; row += nb * NWAVE) {
    const float* src = hrow(hl, hc, row);
    const float* mr = modl + (size_t)modrow(row) * MODW;
    float4 v[4];
    float ss = 0.f;
#pragma unroll
    for (int i = 0; i < 4; ++i) {
      v[i] = ((const float4*)src)[i * 64 + lane];
      ss += v[i].x * v[i].x + v[i].y * v[i].y + v[i].z * v[i].z + v[i].w * v[i].w;
    }
    ss = wave_sum(ss);
    const float rstd = rsqrtf(ss * (1.f / 1024.f) + 1e-6f);
    f32x4 ggv[4], scv[4], shv[4];
#pragma unroll
    for (int i = 0; i < 4; ++i) {
      const int idx = i * 256 + lane * 4;
      ggv[i] = *(const f32x4*)(g + idx); scv[i] = *(const f32x4*)(mr + scale_off + idx); shv[i] = *(const f32x4*)(mr + shift_off + idx);
    }
#pragma unroll
    for (int i = 0; i < 4; ++i) asm volatile("" : "+v"(ggv[i]), "+v"(scv[i]), "+v"(shv[i]));
#pragma unroll
    for (int i = 0; i < 4; ++i) {
      const int idx = i * 256 + lane * 4;
      const float4 gg = make_float4(ggv[i][0], ggv[i][1], ggv[i][2], ggv[i][3]);
      const float4 sc = make_float4(scv[i][0], scv[i][1], scv[i][2], scv[i][3]);
      const float4 sh = make_float4(shv[i][0], shv[i][1], shv[i][2], shv[i][3]);
      const float o0 = v[i].x * rstd * gg.x * (1.f + sc.x) + sh.x;
      const float o1 = v[i].y * rstd * gg.y * (1.f + sc.y) + sh.y;
      const float o2 = v[i].z * rstd * gg.z * (1.f + sc.z) + sh.z;
      const float o3 = v[i].w * rstd * gg.w * (1.f + sc.w) + sh.w;
      uint2 pk;
      pk.x = (uint32_t)f2bf(o0) | ((uint32_t)f2bf(o1) << 16);
      pk.y = (uint32_t)f2bf(o2) | ((uint32_t)f2bf(o3) << 16);
      *(uint2*)(dst + (size_t)row * DM + idx) = pk;
    }
  }
}

__device__ void ph_conv(int wv, const Params& P, int layer, int bid, int nb) {
  const float* cw = P.conv_w + (size_t)layer * 3 * 1536;
  const float* cb = P.conv_b + (size_t)layer * 1536;
  const int total = (NTOK / 4) * 192;
  for (int it = bid * NTHR + otid(wv); it < total; it += nb * NTHR) {
    const int rq = it / 192, c8 = (it % 192) * 8, row0 = rq * 4;
    int l, L;
    if (row0 < NLAT) { l = row0 & 4095; L = 4096; } else { l = (row0 - NLAT) & 255; L = 256; }
    const bf16_t* pc = P.p() + (size_t)row0 * PW + OFF_XBC + c8;
    u32x4_t rv[6];
    rv[0] = *(const u32x4_t*)(pc - (l > 0 ? PW : 0));
#pragma unroll
    for (int i = 0; i < 4; ++i) rv[1 + i] = *(const u32x4_t*)(pc + (size_t)i * PW);
    rv[5] = *(const u32x4_t*)(pc + (size_t)(l + 4 < L ? 4 : 3) * PW);
#pragma unroll
    for (int i = 0; i < 6; ++i) asm volatile("" : "+v"(rv[i]));
    float f[6][8];
#pragma unroll
    for (int i = 0; i < 6; ++i) unpack8(make_uint4(rv[i].x, rv[i].y, rv[i].z, rv[i].w), f[i]);
    const float mp = l > 0 ? 1.f : 0.f, mn = l + 4 < L ? 1.f : 0.f;
    float o[4][8];
#pragma unroll
    for (int e = 0; e < 8; ++e) {
      const int c = c8 + e;
      const float w0 = cw[c], w1 = cw[1536 + c], w2 = cw[3072 + c], bb = cb[c];
#pragma unroll
      for (int i = 0; i < 4; ++i) {
        const float pv = i == 0 ? mp * f[0][e] : f[i][e];
        const float nv = i == 3 ? mn * f[5][e] : f[i + 2][e];
        o[i][e] = silu_f(bb + w0 * pv + w1 * f[i + 1][e] + w2 * nv);
      }
    }
    if (c8 < 1024) {
      const int head = c8 >> 6, p0 = c8 & 63;
      bf16_t* dst = P.xt4() + (((size_t)head * (NTOK / 4) + rq) * 64 + p0) * 4;
#pragma unroll
      for (int e2 = 0; e2 < 4; ++e2)
        *(uint4*)(dst + e2 * 8) = make_uint4(pack2(o[0][2 * e2], o[1][2 * e2]), pack2(o[2][2 * e2], o[3][2 * e2]),
                                             pack2(o[0][2 * e2 + 1], o[1][2 * e2 + 1]), pack2(o[2][2 * e2 + 1], o[3][2 * e2 + 1]));
    } else {
      {
        const int cc = (c8 - 1024) & 255, grp_ = cc >> 7, n0_ = cc & 127;
        bf16_t* fb = (c8 < 1280 ? P.bfr() : P.cfr()) + ((((size_t)grp_ * (NTOK / 16) + (row0 >> 4)) * 4 + (n0_ >> 5)) * 16 + (row0 & 15)) * 32 + (n0_ & 31);
#pragma unroll
        for (int i = 0; i < 4; ++i)
          *(uint4*)(fb + i * 32) = make_uint4(pack2(o[i][0], o[i][1]), pack2(o[i][2], o[i][3]), pack2(o[i][4], o[i][5]), pack2(o[i][6], o[i][7]));
      }
      if (c8 < 1280) {
        const int grp = (c8 - 1024) >> 7, n0 = (c8 - 1024) & 127;
        bf16_t* dst = P.bt4() + (((size_t)grp * (NTOK / 4) + rq) * 128 + n0) * 4;
#pragma unroll
        for (int e2 = 0; e2 < 4; ++e2)
          *(uint4*)(dst + e2 * 8) = make_uint4(pack2(o[0][2 * e2], o[1][2 * e2]), pack2(o[2][2 * e2], o[3][2 * e2]),
                                               pack2(o[0][2 * e2 + 1], o[1][2 * e2 + 1]), pack2(o[2][2 * e2 + 1], o[3][2 * e2 + 1]));
      }
    }
  }
}

__device__ void ph_dtprep(int wv, const Params& P, int layer, char* smem, int first, int step) {
  const int tid = otid(wv), lane = tid & 63, li = lane & 15, g = lane >> 4;
  float* tile = (float*)smem;
  float* segtot = tile + 128 * 33;
  const int dh = tid & 31, seg = tid >> 5;
  const float bias = P.dt_bias[layer * 32 + dh];
  const float ah = -expf(P.a_log[layer * 32 + dh]);
  const bf16_t* wb = P.w_dtT() + (size_t)layer * 128 * 1024 + (size_t)li * 1024 + 8 * g;
  for (int gc = first; gc < NCHUNK; gc += step) {
    const bf16_t* ua = P.u() + (size_t)(gc * 128 + wv * 16 + li) * DM + 8 * g;
    f32x4 acc0 = (f32x4){0.f, 0.f, 0.f, 0.f}, acc1 = acc0;
#pragma unroll 1
    for (int t0 = 0; t0 < 32; t0 += 8) {
      bf16x8 a[8], b0[8], b1[8];
#pragma unroll
      for (int t = 0; t < 8; ++t) {
        a[t] = *(const bf16x8*)(ua + 32 * (t0 + t));
        b0[t] = *(const bf16x8*)(wb + 32 * (t0 + t));
        b1[t] = *(const bf16x8*)(wb + 16 * 1024 + 32 * (t0 + t));
      }
#pragma unroll
      for (int t = 0; t < 8; ++t) asm volatile("" : "+v"(a[t]), "+v"(b0[t]), "+v"(b1[t]));
#pragma unroll
      for (int t = 0; t < 8; ++t) {
        acc0 = __builtin_amdgcn_mfma_f32_16x16x32_bf16(a[t], b0[t], acc0, 0, 0, 0);
        acc1 = __builtin_amdgcn_mfma_f32_16x16x32_bf16(a[t], b1[t], acc1, 0, 0, 0);
      }
    }
    __syncthreads();
#pragma unroll
    for (int e = 0; e < 4; ++e) {
      tile[(wv * 16 + 4 * g + e) * 33 + li] = acc0[e];
      tile[(wv * 16 + 4 * g + e) * 33 + 16 + li] = acc1[e];
    }
    __syncthreads();
    float r[8], c[8];
    float cs = 0.f;
#pragma unroll
    for (int j = 0; j < 8; ++j) { r[j] = softplus_f(tile[(seg * 8 + j) * 33 + dh] + bias); cs += r[j] * ah; c[j] = cs; }
    segtot[seg * 32 + dh] = cs;
    __syncthreads();
    float off = 0.f, tot = 0.f;
    for (int s = 0; s < 16; ++s) { const float v = segtot[s * 32 + dh]; if (s < seg) off += v; tot += v; }
    const size_t base = ((size_t)(gc * 32 + dh) * 128 + seg * 8);
    float cso[8], wso[8];
#pragma unroll
    for (int j = 0; j < 8; ++j) {
      const float csj = off + c[j], csp = j == 0 ? off : off + c[j - 1];
      cso[j] = dh < 16 ? csj : csp;
      wso[j] = r[j] * (dh < 16 ? fexp(tot - csj) : fexp(csp));
    }
#pragma unroll
    for (int q = 0; q < 2; ++q) {
      *(float4*)(P.cst() + base + q * 4) = make_float4(cso[q * 4], cso[q * 4 + 1], cso[q * 4 + 2], cso[q * 4 + 3]);
      *(float4*)(P.dtt() + base + q * 4) = make_float4(r[q * 4], r[q * 4 + 1], r[q * 4 + 2], r[q * 4 + 3]);
      *(float4*)(P.wst() + base + q * 4) = make_float4(wso[q * 4], wso[q * 4 + 1], wso[q * 4 + 2], wso[q * 4 + 3]);
    }
    if (seg == 0) P.atot()[gc * 32 + dh] = tot;
  }
}

__device__ __forceinline__ int scan_chunk(int b, int dir, int s) {
  if (dir == 0) return (s < 2) ? (128 + 2 * b + s) : (32 * b + (s - 2));
  return (s < 2) ? (128 + 2 * b + 1 - s) : (32 * b + 31 - (s - 2));
}
__device__ void ph_scan(int wv, const Params& P, int bid, int nb) {
  const int total = 4 * 32 * 1024;
  for (int it = bid * NTHR + otid(wv); it < total; it += nb * NTHR) {
    const int e8 = it & 1023, dh = (it >> 10) & 31, b = it >> 15, dir = dh >> 4;
    float S[8];
    float zero_ = 0.f;
    asm volatile("" : "+v"(zero_));
#pragma unroll
    for (int i = 0; i < 8; ++i) S[i] = zero_;
#pragma unroll
    for (int hb = 0; hb < 2; ++hb) {
      u32x4_t v[17];
      float at[17];
#pragma unroll
      for (int s = 0; s < 17; ++s) {
        const int gc = scan_chunk(b, dir, hb * 17 + s);
        v[s] = *(const u32x4_t*)(P.states() + (size_t)(gc * 32 + dh) * 8192 + e8 * 8);
        at[s] = P.atot()[gc * 32 + dh];
      }
#pragma unroll
      for (int s = 0; s < 17; ++s) asm volatile("" : "+v"(v[s]));
#pragma unroll
      for (int s = 0; s < 17; ++s) {
        const int gc = scan_chunk(b, dir, hb * 17 + s);
        const float dec = fexp(at[s]);
        float cst[8];
        unpack8(make_uint4(v[s].x, v[s].y, v[s].z, v[s].w), cst);
        *(uint4*)(P.states() + (size_t)(gc * 32 + dh) * 8192 + e8 * 8) =
            make_uint4(pack2(S[0], S[1]), pack2(S[2], S[3]), pack2(S[4], S[5]), pack2(S[6], S[7]));
#pragma unroll
        for (int i = 0; i < 8; ++i) S[i] = dec * S[i] + cst[i];
      }
    }
  }
}

__device__ __forceinline__ void conv_x8(const Params& P, int layer, int row, int ch0, float* out) {
  int l, L;
  if (row < NLAT) { l = row & 4095; L = 4096; } else { l = (row - NLAT) & 255; L = 256; }
  const bf16_t* pc = P.p() + (size_t)row * PW + OFF_XBC + ch0;
  const uint4 cur = *(const uint4*)pc;
  const uint4 prv = *(const uint4*)(pc - (l > 0 ? PW : 0));
  const uint4 nxt = *(const uint4*)(pc + (l < L - 1 ? PW : 0));
  const float mp = l > 0 ? 1.f : 0.f, mn = l < L - 1 ? 1.f : 0.f;
  float fp[8], fc[8], fn[8];
  unpack8(prv, fp); unpack8(cur, fc); unpack8(nxt, fn);
  const float* cw = P.conv_w + (size_t)layer * 3 * 1536 + ch0;
  const float* cb = P.conv_b + (size_t)layer * 1536 + ch0;
#pragma unroll
  for (int e = 0; e < 8; ++e) out[e] = silu_f(cb[e] + cw[e] * (mp * fp[e]) + cw[1536 + e] * fc[e] + cw[3072 + e] * (mn * fn[e]));
}

constexpr int XS = 72;
constexpr int BS = 136;


__device__ __forceinline__ bool ssd_item(int round, int bid, int nb, int nchunks, int& gc, int& head) {
  if ((nb & 63) == 0) {
    const int x = bid & 7, j = bid >> 3, per = nb >> 6;
    const int cg = (round * per + (j >> 3)) * 8 + x;
    if (cg >= nchunks * 2) return false;
    gc = cg >> 1; head = (cg & 1) * 8 + (j & 7);
    return true;
  }
  const int it = round * nb + bid;
  if (it >= nchunks * 16) return false;
  gc = it >> 4; head = it & 15;
  return true;
}

__device__ void ph_states_mfma(int wv, const Params& P, int layer, char* smem, int bid, int nb) {
  const int lane = otid(wv) & 63, li = lane & 15, g = lane >> 4;
  const int nq = wv >> 1, ph = wv & 1;
  for (int round = 0;; ++round) {
    int gc, head;
    if (!ssd_item(round, bid, nb, NCHUNK, gc, head)) break;
    const int grp = head >> 3, q0 = gc * 32;
    const bf16_t* xb = P.xt4() + (((size_t)head * (NTOK / 4) + q0 + g) * 64 + ph * 32 + li) * 4;
    const bf16_t* bb = P.bt4() + (((size_t)grp * (NTOK / 4) + q0 + g) * 128 + nq * 32 + li) * 4;
    const float* wpf = P.wst() + (size_t)(gc * 32 + head) * 128 + 4 * g;
    const float* wpb = wpf + 16 * 128;
    f32x4 acc[2][2][2];
#pragma unroll
    for (int d = 0; d < 2; ++d)
#pragma unroll
      for (int a = 0; a < 2; ++a)
#pragma unroll
        for (int b = 0; b < 2; ++b) acc[d][a][b] = (f32x4){0.f, 0.f, 0.f, 0.f};
#pragma unroll
    for (int t = 0; t < 4; ++t) {
      s16x4 alo[2], ahi[2], xlo[2], xhi[2];
      f32x4 wfl, wfh, wbl, wbh;
#pragma unroll
      for (int i = 0; i < 2; ++i) {
        alo[i] = *(const s16x4*)(bb + ((size_t)(t * 8) * 128 + i * 16) * 4);
        ahi[i] = *(const s16x4*)(bb + ((size_t)(t * 8 + 4) * 128 + i * 16) * 4);
        xlo[i] = *(const s16x4*)(xb + ((size_t)(t * 8) * 64 + i * 16) * 4);
        xhi[i] = *(const s16x4*)(xb + ((size_t)(t * 8 + 4) * 64 + i * 16) * 4);
      }
      wfl = *(const f32x4*)(wpf + 32 * t); wfh = *(const f32x4*)(wpf + 32 * t + 16);
      wbl = *(const f32x4*)(wpb + 32 * t); wbh = *(const f32x4*)(wpb + 32 * t + 16);
      asm volatile("" : "+v"(alo[0]), "+v"(alo[1]), "+v"(ahi[0]), "+v"(ahi[1]));
      bf16x8 af[2];
#pragma unroll
      for (int i = 0; i < 2; ++i) af[i] = (bf16x8){alo[i][0], alo[i][1], alo[i][2], alo[i][3], ahi[i][0], ahi[i][1], ahi[i][2], ahi[i][3]};
#pragma unroll
      for (int d = 0; d < 2; ++d) {
        const f32x4 wl = d == 0 ? wfl : wbl, wh = d == 0 ? wfh : wbh;
#pragma unroll
        for (int b = 0; b < 2; ++b) {
          bf16x8 bfrag;
#pragma unroll
          for (int i = 0; i < 4; ++i) {
            bfrag[i] = (short)f2bf(bf2f((bf16_t)xlo[b][i]) * wl[i]);
            bfrag[4 + i] = (short)f2bf(bf2f((bf16_t)xhi[b][i]) * wh[i]);
          }
#pragma unroll
          for (int a = 0; a < 2; ++a) acc[d][a][b] = __builtin_amdgcn_mfma_f32_16x16x32_bf16(af[a], bfrag, acc[d][a][b], 0, 0, 0);
        }
      }
    }
#pragma unroll
    for (int d = 0; d < 2; ++d) {
      bf16_t* dst = P.states() + (size_t)(gc * 32 + d * 16 + head) * 8192;
#pragma unroll
      for (int a = 0; a < 2; ++a)
#pragma unroll
        for (int b = 0; b < 2; ++b) {
          uint2 o;
          o.x = pack2(acc[d][a][b][0], acc[d][a][b][1]); o.y = pack2(acc[d][a][b][2], acc[d][a][b][3]);
          *(uint2*)(dst + ((nq * 4 + 2 * ph + b) * 16 + li) * 32 + 16 * a + 4 * g) = o;
        }
    }
  }
}

__device__ void ph_ssdy_mfma(int wv, const Params& P, int layer, int nchunks, char* smem, int bid, int nb) {
  const int tid = otid(wv), lane = tid & 63, li = lane & 15, g = lane >> 4;
  float* tabs = (float*)smem;
  char* bbuf = smem + 4096;
  char* xbuf = bbuf + 65536;
  char* sbufS = xbuf + 32768;
  u32x4_t pf[10];
  float pft = 0.f;
#pragma unroll
  for (int i = 0; i < 10; ++i) pf[i] = (u32x4_t){0u, 0u, 0u, 0u};
#define SSDY_FETCH(gc_, head_) do { const int grp_ = (head_) >> 3; \
      const char* bsrc_ = (const char*)(P.bfr() + ((size_t)grp_ * (NTOK / 16) + (gc_) * 8) * 4 * 16 * 32); \
      const char* xsrc_ = (const char*)(P.xt4() + ((size_t)(head_) * (NTOK / 4) + (gc_) * 32) * 64 * 4); \
      _Pragma("unroll") for (int i_ = 0; i_ < 4; ++i_) pf[i_] = *(const u32x4_t*)(bsrc_ + (size_t)(tid + i_ * 512) * 16); \
      _Pragma("unroll") for (int i_ = 0; i_ < 2; ++i_) pf[4 + i_] = *(const u32x4_t*)(xsrc_ + (size_t)(tid + i_ * 512) * 16); \
      _Pragma("unroll") for (int i_ = 0; i_ < 4; ++i_) { const int c_ = tid + i_ * 512; \
        pf[6 + i_] = *(const u32x4_t*)((const char*)(P.states() + (size_t)((gc_) * 32 + (c_ >> 10) * 16 + (head_)) * 8192) + (size_t)(c_ & 1023) * 16); } \
      { const int arr_ = tid >> 7, j_ = tid & 127; \
        pft = ((arr_ & 1) ? P.dtt() : P.cst())[(size_t)((gc_) * 32 + (arr_ >> 1) * 16 + (head_)) * 128 + j_]; } } while (0)
#define SSDY_PUT_S() do { _Pragma("unroll") for (int i_ = 0; i_ < 4; ++i_) *(u32x4_t*)(sbufS + (size_t)(tid + i_ * 512) * 16) = pf[6 + i_]; } while (0)
#define SSDY_PUT_BX(buf_) do { \
      _Pragma("unroll") for (int i_ = 0; i_ < 4; ++i_) *(u32x4_t*)(bbuf + (buf_) * 32768 + (size_t)(tid + i_ * 512) * 16) = pf[i_]; \
      _Pragma("unroll") for (int i_ = 0; i_ < 2; ++i_) *(u32x4_t*)(xbuf + (buf_) * 16384 + (size_t)(tid + i_ * 512) * 16) = pf[4 + i_]; \
      tabs[(buf_) * 512 + tid] = pft; } while (0)
  {
    int gc0 = 0, head0 = 0;
    __syncthreads();
    if (ssd_item(0, bid, nb, nchunks, gc0, head0)) { SSDY_FETCH(gc0, head0); SSDY_PUT_BX(0); SSDY_PUT_S(); }
    __syncthreads();
  }
  for (int round = 0;; ++round) {
    int gc, head;
    if (!ssd_item(round, bid, nb, nchunks, gc, head)) break;
    const int grp = head >> 3, row0 = gc * 128;
    const char* bs = bbuf + (round & 1) * 32768;
    const char* xs_l = xbuf + (round & 1) * 16384;
    const float* csf = tabs + (round & 1) * 512;
    const float* dtf = csf + 128;
    const float* exb = csf + 256;
    const float* dtb = csf + 384;
    int gcn = 0, headn = 0;
    const bool has_next = ssd_item(round + 1, bid, nb, nchunks, gcn, headn);
    if (has_next) SSDY_FETCH(gcn, headn);
    const float atb = P.atot()[gc * 32 + 16 + head];
    bf16x8 cfrag[4];
    {
      const bf16_t* cp = P.cfr() + ((((size_t)grp * (NTOK / 16) + gc * 8 + wv) * 4) * 16 + li) * 32 + 8 * g;
#pragma unroll
      for (int t = 0; t < 4; ++t) cfrag[t] = *(const bf16x8*)(cp + t * 512);
    }
    f32x4 accG[8];
#pragma unroll
    for (int sb = 0; sb < 8; ++sb) accG[sb] = (f32x4){0.f, 0.f, 0.f, 0.f};
#pragma unroll
    for (int sp = 0; sp < 4; ++sp) {
      bf16x8 bfv[8];
#pragma unroll
      for (int i = 0; i < 8; ++i) {
        const int sb = sp * 2 + (i >> 2), t = i & 3;
        bfv[i] = *(const bf16x8*)(bs + (((sb * 4 + t) * 16 + li) * 32 + 8 * g) * 2);
      }
#pragma unroll
      for (int i = 0; i < 8; ++i) {
        const int sb = sp * 2 + (i >> 2), t = i & 3;
        accG[sb] = __builtin_amdgcn_mfma_f32_16x16x32_bf16(bfv[i], cfrag[t], accG[sb], 0, 0, 0);
      }
    }
    f32x4 accY[4];
#pragma unroll
    for (int pb = 0; pb < 4; ++pb) accY[pb] = (f32x4){0.f, 0.f, 0.f, 0.f};
    const int jl = 16 * wv + li;
    const float csf_j = csf[jl], exb_j = exb[jl];
#pragma unroll
    for (int dir = 0; dir < 2; ++dir) {
      f32x4 accO[4];
#pragma unroll
      for (int pb = 0; pb < 4; ++pb) accO[pb] = (f32x4){0.f, 0.f, 0.f, 0.f};
      const char* st = sbufS + dir * 16384;
#pragma unroll
      for (int th = 0; th < 2; ++th) {
        bf16x8 sfr[8];
#pragma unroll
        for (int i = 0; i < 8; ++i) sfr[i] = *(const bf16x8*)(st + (((th * 2 + (i >> 2)) * 4 + (i & 3)) * 512 + li * 32 + 8 * g) * 2);
#pragma unroll
        for (int tt = 0; tt < 2; ++tt)
#pragma unroll
          for (int pb = 0; pb < 4; ++pb) accO[pb] = __builtin_amdgcn_mfma_f32_16x16x32_bf16(cfrag[th * 2 + tt], sfr[tt * 4 + pb], accO[pb], 0, 0, 0);
      }
#pragma unroll
      for (int e = 0; e < 4; ++e) {
        const int j = 16 * wv + 4 * g + e;
        const float sc = dir == 0 ? fexp(csf[j]) : fexp(atb - exb[j]);
#pragma unroll
        for (int pb = 0; pb < 4; ++pb) accY[pb][e] += accO[pb][e] * sc;
      }
    }
    __syncthreads();
    if (has_next) SSDY_PUT_S();
    const char* xq = xs_l + ((g * 64 + li) * 4) * 2;
#pragma unroll
    for (int t = 0; t < 4; ++t) {
      const bool need_f = !(32 * t > 16 * wv + 15), need_b = !(32 * t + 31 < 16 * wv);
      if (!need_f && !need_b) continue;
      s16x4 xlo[4], xhi[4];
#pragma unroll
      for (int pb = 0; pb < 4; ++pb) {
        xlo[pb] = *(const s16x4*)(xq + (((8 * t) * 64 + 16 * pb) * 4) * 2);
        xhi[pb] = *(const s16x4*)(xq + (((8 * t + 4) * 64 + 16 * pb) * 4) * 2);
      }
#pragma unroll
      for (int dir = 0; dir < 2; ++dir) {
        if (dir == 0 ? !need_f : !need_b) continue;
        bf16x8 afrag;
#pragma unroll
        for (int hh = 0; hh < 2; ++hh) {
          const int s0 = 32 * t + 16 * hh + 4 * g;
          const f32x4 gv = accG[2 * t + hh];
          const f32x4 cv = dir == 0 ? *(const f32x4*)(csf + s0) : *(const f32x4*)(exb + s0);
          const f32x4 dv = dir == 0 ? *(const f32x4*)(dtf + s0) : *(const f32x4*)(dtb + s0);
#pragma unroll
          for (int e = 0; e < 4; ++e) {
            const int s = s0 + e;
            float m;
            if (dir == 0) m = (s <= jl) ? gv[e] * dv[e] * fexp(csf_j - cv[e]) : 0.f;
            else m = (s >= jl) ? gv[e] * dv[e] * fexp(cv[e] - exb_j) : 0.f;
            afrag[hh * 4 + e] = (short)f2bf(m);
          }
        }
#pragma unroll
        for (int pb = 0; pb < 4; ++pb) {
          const bf16x8 bfr2 = (bf16x8){xlo[pb][0], xlo[pb][1], xlo[pb][2], xlo[pb][3], xhi[pb][0], xhi[pb][1], xhi[pb][2], xhi[pb][3]};
          accY[pb] = __builtin_amdgcn_mfma_f32_16x16x32_bf16(afrag, bfr2, accY[pb], 0, 0, 0);
        }
      }
    }
    const float dsk = P.d_skip[layer * 16 + head];
    s16x4 xs[4];
#pragma unroll
    for (int pb = 0; pb < 4; ++pb) xs[pb] = *(const s16x4*)(xs_l + ((((4 * wv + g) * 64 + 16 * pb + li) * 4) * 2));
    unsigned zv[16];
#pragma unroll
    for (int e = 0; e < 4; ++e)
#pragma unroll
      for (int pb = 0; pb < 4; ++pb)
        zv[e * 4 + pb] = P.p()[(size_t)(row0 + 16 * wv + 4 * g + e) * PW + OFF_Z + head * 64 + 16 * pb + li];
#pragma unroll
    for (int i = 0; i < 16; ++i) asm volatile("" : "+v"(zv[i]));
#pragma unroll
    for (int e = 0; e < 4; ++e) {
      const int row = row0 + 16 * wv + 4 * g + e;
      float sq = 0.f;
#pragma unroll
      for (int pb = 0; pb < 4; ++pb) {
        const float xv = bf2f((bf16_t)xs[pb][e]);
        const float z = bf2f((bf16_t)zv[e * 4 + pb]);
        const bf16_t yb = f2bf((accY[pb][e] + dsk * xv) * silu_f(z));
        P.concat()[(size_t)row * 2048 + head * 64 + 16 * pb + li] = yb;
        const float yf = bf2f(yb);
        sq += yf * yf;
      }
      sq += DPP_F(sq, 0xB1); sq += DPP_F(sq, 0x4E); sq += DPP_F(sq, 0x141); sq += DPP_F(sq, 0x140);
      if (li == 0) P.yss()[(size_t)row * 16 + head] = sq;
    }
    if (has_next) SSDY_PUT_BX((round + 1) & 1);
    __syncthreads();
  }
#undef SSDY_FETCH
#undef SSDY_PUT_S
#undef SSDY_PUT_BX
}

__device__ void ph_ssdnorm(int wv, const Params& P, int layer, int nrows, int bid, int nb) {
  const int wave = otid(wv) >> 6, lane = otid(wv) & 63;
  const float* g = P.ssd_norm_g + layer * 1024;
  for (int row = bid * NWAVE + wave; row < nrows; row += nb * NWAVE) {
    bf16_t* src = P.concat() + (size_t)row * 2048;
    float v[16];
    float ss = 0.f;
#pragma unroll
    for (int i = 0; i < 4; ++i) {
      const uint2 pk = *(const uint2*)(src + i * 256 + lane * 4);
      v[i * 4 + 0] = bf2f((bf16_t)(pk.x & 0xffff)); v[i * 4 + 1] = bf2f((bf16_t)(pk.x >> 16));
      v[i * 4 + 2] = bf2f((bf16_t)(pk.y & 0xffff)); v[i * 4 + 3] = bf2f((bf16_t)(pk.y >> 16));
    }
#pragma unroll
    for (int i = 0; i < 16; ++i) ss += v[i] * v[i];
    ss = wave_sum(ss);
    const float rstd = rsqrtf(ss * (1.f / 1024.f) + 1e-6f);
    f32x4 gv[4];
#pragma unroll
    for (int i = 0; i < 4; ++i) gv[i] = *(const f32x4*)(g + i * 256 + lane * 4);
#pragma unroll
    for (int i = 0; i < 4; ++i) asm volatile("" : "+v"(gv[i]));
#pragma unroll
    for (int i = 0; i < 4; ++i) {
      const int idx = i * 256 + lane * 4;
      uint2 pk;
      pk.x = (uint32_t)f2bf(v[i * 4 + 0] * rstd * gv[i][0]) | ((uint32_t)f2bf(v[i * 4 + 1] * rstd * gv[i][1]) << 16);
      pk.y = (uint32_t)f2bf(v[i * 4 + 2] * rstd * gv[i][2]) | ((uint32_t)f2bf(v[i * 4 + 3] * rstd * gv[i][3]) << 16);
      *(uint2*)(src + idx) = pk;
    }
  }
}

template <int W>
__device__ __forceinline__ void pool_frags(const bf16_t* pc, int l, int L, float rc, bf16x8 (&af)[4]) {
#pragma unroll
  for (int t = 0; t < 4; ++t) {
    constexpr int WB = W < 8 ? W : 8;
    float s[8], f[8];
#pragma unroll
    for (int e = 0; e < 8; ++e) s[e] = 0.f;
    const u32x4_t own = *(const u32x4_t*)(pc + 32 * t);
#pragma unroll
    for (int ob = 0; ob < W; ob += WB) {
      u32x4_t rows[WB];
#pragma unroll
      for (int o = 0; o < WB; ++o) {
        const int rr = l - W / 2 + ob + o;
        const int rcl = (rr >= 0 && rr < L) ? rr : l;
        rows[o] = *(const u32x4_t*)(pc + (ptrdiff_t)(rcl - l) * PW + 32 * t);
      }
#pragma unroll
      for (int o = 0; o < WB; ++o) asm volatile("" : "+v"(rows[o]));
#pragma unroll
      for (int o = 0; o < WB; ++o) {
        const int rr = l - W / 2 + ob + o;
        const float mk = (rr >= 0 && rr < L) ? 1.f : 0.f;
        unpack8(make_uint4(rows[o].x, rows[o].y, rows[o].z, rows[o].w), f);
#pragma unroll
        for (int e = 0; e < 8; ++e) s[e] += mk * f[e];
      }
    }
    unpack8(make_uint4(own.x, own.y, own.z, own.w), f);
#pragma unroll
    for (int e = 0; e < 8; ++e) af[t][e] = (short)f2bf(s[e] * rc - f[e]);
  }
}
__device__ void ph_pool_mfma(int wv, const Params& P, int layer, int nrows, int bid, int nb) {
  const int lane = otid(wv) & 63, li = lane & 15, g = lane >> 4;
  const int nitems = (nrows / 16) * 4;
  for (int it = bid * NWAVE + wv; it < nitems; it += nb * NWAVE) {
    const int gi = it & 3, row0 = (it >> 2) * 16, w = 2 << gi;
    const int row = row0 + li;
    int l, L;
    if (row < NLAT) { l = row & 4095; L = 4096; } else { l = (row - NLAT) & 255; L = 256; }
    int lo = l - w / 2; lo = lo < 0 ? 0 : lo;
    int hi = l + w - w / 2 - 1; hi = hi > L - 1 ? L - 1 : hi;
    const float rc = 1.f / (float)(hi - lo + 1);
    const bf16_t* pc = P.p() + (size_t)row * PW + OFF_POOL + gi * 128 + 8 * g;
    bf16x8 af[4];
    if (gi == 0) pool_frags<2>(pc, l, L, rc, af);
    else if (gi == 1) pool_frags<4>(pc, l, L, rc, af);
    else if (gi == 2) pool_frags<8>(pc, l, L, rc, af);
    else pool_frags<16>(pc, l, L, rc, af);
    const bf16_t* wt = P.poolwT() + ((size_t)(layer * 4 + gi) * 128 + li) * 128 + 8 * g;
    const float* sc = P.pool_scale + layer * 512 + gi * 128;
#pragma unroll
    for (int nh = 0; nh < 4; ++nh) {
      bf16x8 wf[2][4];
#pragma unroll
      for (int n = 0; n < 2; ++n)
#pragma unroll
        for (int t = 0; t < 4; ++t) wf[n][t] = *(const bf16x8*)(wt + (size_t)(nh * 2 + n) * 16 * 128 + 32 * t);
#pragma unroll
      for (int n = 0; n < 2; ++n)
#pragma unroll
        for (int t = 0; t < 4; ++t) asm volatile("" : "+v"(wf[n][t]));
#pragma unroll
      for (int n = 0; n < 2; ++n) {
        const int nt = nh * 2 + n;
        f32x4 acc = (f32x4){0.f, 0.f, 0.f, 0.f};
#pragma unroll
        for (int t = 0; t < 4; ++t) acc = __builtin_amdgcn_mfma_f32_16x16x32_bf16(af[t], wf[n][t], acc, 0, 0, 0);
        const float scv = sc[nt * 16 + li];
#pragma unroll
        for (int e = 0; e < 4; ++e)
          P.concat()[(size_t)(row0 + 4 * g + e) * 2048 + 1024 + gi * 128 + nt * 16 + li] = f2bf(acc[e] * scv);
      }
    }
  }
}

__device__ void ph_vtranspose(int wv, const Params& P, char* smem, int bid, int nb) {
  const int lane = otid(wv) & 63;
  bf16_t* tile = (bf16_t*)smem + wv * 64 * 72;
  for (int it = bid * NWAVE + wv; it < 272 * 8; it += nb * NWAVE) {
    const int hd = it & 7, tt = it >> 3, row0 = tt * 64;
    const bf16_t* src = P.p() + (size_t)(row0 + lane) * PW + OFF_V + hd * 64;
#pragma unroll
    for (int i = 0; i < 8; ++i) *(uint4*)(tile + lane * 72 + i * 8) = *(const uint4*)(src + i * 8);
    __builtin_amdgcn_wave_barrier();
    bf16_t* dst;
    if (row0 < NLAT) dst = P.vtl() + (size_t)((row0 >> 12) * 8 + hd) * 64 * 4096 + ((size_t)((row0 & 4095) >> 2) * 64 + lane) * 4;
    else dst = P.vtc() + (size_t)(((row0 - NLAT) >> 8) * 8 + hd) * 64 * 256 + ((size_t)(((row0 - NLAT) & 255) >> 2) * 64 + lane) * 4;
#pragma unroll
    for (int i = 0; i < 16; ++i) {
      uint2 w;
      w.x = (uint32_t)tile[(i * 4 + 0) * 72 + lane] | ((uint32_t)tile[(i * 4 + 1) * 72 + lane] << 16);
      w.y = (uint32_t)tile[(i * 4 + 2) * 72 + lane] | ((uint32_t)tile[(i * 4 + 3) * 72 + lane] << 16);
      *(uint2*)(dst + (size_t)i * 64 * 4) = w;
    }
    __builtin_amdgcn_wave_barrier();
    {
      const bf16_t* ksrc = P.p() + (size_t)(row0 + lane) * PW + OFF_K + hd * 64;
      u32x4_t kv[8];
#pragma unroll
      for (int i = 0; i < 8; ++i) kv[i] = *(const u32x4_t*)(ksrc + i * 8);
      bf16_t* kd;
      int tk;
      if (row0 < NLAT) { tk = (row0 & 4095) + lane; kd = P.ktl() + (size_t)((row0 >> 12) * 8 + hd) * 4096 * 64; }
      else { tk = ((row0 - NLAT) & 255) + lane; kd = P.ktc() + (size_t)(((row0 - NLAT) >> 8) * 8 + hd) * 256 * 64; }
#pragma unroll
      for (int i = 0; i < 8; ++i)
        *(u32x4_t*)(kd + ((size_t)((tk >> 3) * 2 + (i >> 2)) * 8 + (tk & 7)) * 32 + (i & 3) * 8) = kv[i];
    }
  }
}

__device__ __forceinline__ float grp_max(float v) {
  auto a = __builtin_amdgcn_permlane16_swap(__float_as_uint(v), __float_as_uint(v), false, false);
  v = fmaxf(__uint_as_float(a[0]), __uint_as_float(a[1]));
  auto b = __builtin_amdgcn_permlane32_swap(__float_as_uint(v), __float_as_uint(v), false, false);
  return fmaxf(__uint_as_float(b[0]), __uint_as_float(b[1]));
}
__device__ __forceinline__ float grp_sum(float v) {
  auto a = __builtin_amdgcn_permlane16_swap(__float_as_uint(v), __float_as_uint(v), false, false);
  v = __uint_as_float(a[0]) + __uint_as_float(a[1]);
  auto b = __builtin_amdgcn_permlane32_swap(__float_as_uint(v), __float_as_uint(v), false, false);
  return __uint_as_float(b[0]) + __uint_as_float(b[1]);
}

__device__ void ph_na_mfma(int wv, const Params& P, int layer, int nrows, char* smem, int bid, int nb) {
  const int lane = otid(wv) & 63, li = lane & 15, g = lane >> 4;
  float* btab = (float*)smem + wv * 256;
  const float* rpb = P.na_rpb + (size_t)layer * 8 * 15 * 31;
  const int n_lat = 4 * 64 * 8 * 4;
  const int n_items = n_lat + (nrows > NLAT ? 4 * 16 * 8 : 0);
  const int nrank = nb >> 3;
  const bool xmap = ((nb & 7) == 0) && nrank > 0 && (1024 % nrank) == 0 && (64 % nrank) == 0;
  const int per_lat = xmap ? 1024 / nrank : 0, per_ctx = (xmap && nrows > NLAT) ? 64 / nrank : 0;
  const int q_begin = xmap ? wv : bid * NWAVE + wv, q_end = xmap ? per_lat + per_ctx : n_items, q_step = xmap ? NWAVE : nb * NWAVE;
  for (int q = q_begin; q < q_end; q += q_step) {
    bool lat;
    int b, hd, qrow0, r = 0, cq0 = 0, r0 = 0, cs = 0, qt;
    if (xmap) {
      hd = bid & 7;
      const int rank = bid >> 3;
      lat = q < per_lat;
      if (lat) { const int i = rank * per_lat + q; qt = i & 3; r = (i >> 2) & 63; b = i >> 8; }
      else { const int c = rank * per_ctx + (q - per_lat); qt = c & 15; b = c >> 4; }
    } else {
      lat = q < n_lat;
      if (lat) { qt = q & 3; hd = (q >> 2) & 7; r = (q >> 5) & 63; b = q >> 11; }
      else { const int t = q - n_lat; hd = t & 7; qt = (t >> 3) & 15; b = t >> 7; }
    }
    if (lat) {
      cq0 = qt * 16; qrow0 = b * 4096 + r * 64 + cq0;
      r0 = r - 4; r0 = r0 < 0 ? 0 : (r0 > 56 ? 56 : r0);
      int clo = cq0 - 8; clo = clo < 0 ? 0 : (clo > 48 ? 48 : clo);
      cs = clo < 32 ? clo : 32;
    } else {
      qrow0 = NLAT + b * 256 + qt * 16;
    }
    const bf16_t* qp = P.p() + (size_t)(qrow0 + li) * PW + OFF_Q + hd * 64 + 8 * g;
    const bf16x8 qf0 = *(const bf16x8*)qp, qf1 = *(const bf16x8*)(qp + 32);
    __builtin_amdgcn_wave_barrier();
#pragma unroll
    for (int i = 0; i < 4; ++i) {
      const int e_ = i * 64 + lane, kr_ = e_ >> 5, dc_ = e_ & 31;
      int dr_ = r0 + kr_ - r + 7; dr_ = dr_ < 0 ? 0 : (dr_ > 14 ? 14 : dr_);
      btab[e_] = rpb[(hd * 15 + dr_) * 31 + (dc_ < 31 ? dc_ : 30)];
    }
    __builtin_amdgcn_wave_barrier();
    f32x4 accS[16], accC[16];
    const int k_lane = ((li >> 3) * 16 + (li & 7)) * 32 + 8 * g;
    const bf16_t* klb = P.ktl() + (size_t)(b * 8 + hd) * 4096 * 64 + k_lane;
    const bf16_t* kcb = P.ktc() + (size_t)(b * 8 + hd) * 256 * 64 + k_lane;
#define NA_KPTR(tile) ((tile) < 16 ? klb + ((r0 + ((tile) >> 1)) * 64 + cs + 16 * ((tile) & 1)) * 64 : kcb + (16 * ((tile) - 16)) * 64)
    bf16x8 kA[2][2], kB[2][2];
#pragma unroll
    for (int i = 0; i < 2; ++i) { const bf16_t* kp = NA_KPTR(i); kA[i][0] = *(const bf16x8*)kp; kA[i][1] = *(const bf16x8*)(kp + 256); }
#pragma unroll
    for (int tb = 0; tb < 32; tb += 4) {
#pragma unroll
      for (int i = 0; i < 2; ++i) { const bf16_t* kp = NA_KPTR(tb + 2 + i); kB[i][0] = *(const bf16x8*)kp; kB[i][1] = *(const bf16x8*)(kp + 256); }
#pragma unroll
      for (int i = 0; i < 2; ++i) { asm volatile("" : "+v"(kA[i][0]), "+v"(kA[i][1])); }
#pragma unroll
      for (int i = 0; i < 2; ++i) {
        f32x4 z = (f32x4){0.f, 0.f, 0.f, 0.f};
        z = __builtin_amdgcn_mfma_f32_16x16x32_bf16(kA[i][0], qf0, z, 0, 0, 0);
        z = __builtin_amdgcn_mfma_f32_16x16x32_bf16(kA[i][1], qf1, z, 0, 0, 0);
        if (tb + i < 16) accS[(tb + i) & 15] = z; else accC[(tb + i) & 15] = z;
      }
      if (tb + 4 < 32) {
#pragma unroll
        for (int i = 0; i < 2; ++i) { const bf16_t* kp = NA_KPTR(tb + 4 + i); kA[i][0] = *(const bf16x8*)kp; kA[i][1] = *(const bf16x8*)(kp + 256); }
      }
#pragma unroll
      for (int i = 0; i < 2; ++i) { asm volatile("" : "+v"(kB[i][0]), "+v"(kB[i][1])); }
#pragma unroll
      for (int i = 0; i < 2; ++i) {
        f32x4 z = (f32x4){0.f, 0.f, 0.f, 0.f};
        z = __builtin_amdgcn_mfma_f32_16x16x32_bf16(kB[i][0], qf0, z, 0, 0, 0);
        z = __builtin_amdgcn_mfma_f32_16x16x32_bf16(kB[i][1], qf1, z, 0, 0, 0);
        if (tb + 2 + i < 16) accS[(tb + 2 + i) & 15] = z; else accC[(tb + 2 + i) & 15] = z;
      }
    }
#undef NA_KPTR
    const int cq = cq0 + li;
    int c0q = cq - 8; c0q = c0q < 0 ? 0 : (c0q > 48 ? 48 : c0q);
    float mx = -3.0e38f;
#pragma unroll
    for (int kt = 0; kt < 16; ++kt) {
      int bi[4]; bool okv[4]; float bv[4];
#pragma unroll
      for (int e = 0; e < 4; ++e) {
        const int ck = cs + 16 * (kt & 1) + 4 * g + e;
        okv[e] = lat && ck >= c0q && ck < c0q + 16;
        bi[e] = okv[e] ? (kt >> 1) * 32 + (ck - cq + 15) : 0;
      }
      asm volatile("" : "+v"(bi[0]), "+v"(bi[1]), "+v"(bi[2]), "+v"(bi[3]));
#pragma unroll
      for (int e = 0; e < 4; ++e) bv[e] = btab[bi[e]];
#pragma unroll
      for (int e = 0; e < 4; ++e) {
        const float s = okv[e] ? accS[kt][e] * 0.125f + bv[e] : -3.0e38f;
        accS[kt][e] = s;
        mx = fmaxf(mx, s);
      }
    }
#pragma unroll
    for (int ct = 0; ct < 16; ++ct)
#pragma unroll
      for (int e = 0; e < 4; ++e) { const float s = accC[ct][e] * 0.125f; accC[ct][e] = s; mx = fmaxf(mx, s); }
    mx = grp_max(mx);
    float sum = 0.f;
#pragma unroll
    for (int kt = 0; kt < 16; ++kt)
#pragma unroll
      for (int e = 0; e < 4; ++e) { const float p = __expf(accS[kt][e] - mx); accS[kt][e] = p; sum += p; }
#pragma unroll
    for (int ct = 0; ct < 16; ++ct)
#pragma unroll
      for (int e = 0; e < 4; ++e) { const float p = __expf(accC[ct][e] - mx); accC[ct][e] = p; sum += p; }
    sum = grp_sum(sum);
    const float inv = 1.f / sum;
    bf16x8 afL[8], afC[8];
#pragma unroll
    for (int kr = 0; kr < 8; ++kr) {
#pragma unroll
      for (int e = 0; e < 4; ++e) {
        afL[kr][e] = (short)f2bf(accS[2 * kr][e] * inv); afL[kr][4 + e] = (short)f2bf(accS[2 * kr + 1][e] * inv);
        afC[kr][e] = (short)f2bf(accC[2 * kr][e] * inv); afC[kr][4 + e] = (short)f2bf(accC[2 * kr + 1][e] * inv);
      }
    }
    f32x4 accO[4];
#pragma unroll
    for (int db = 0; db < 4; ++db) accO[db] = (f32x4){0.f, 0.f, 0.f, 0.f};
    const bf16_t* vl = P.vtl() + (size_t)(b * 8 + hd) * 64 * 4096 + li * 4;
    const bf16_t* vc = P.vtc() + (size_t)(b * 8 + hd) * 64 * 256 + li * 4;
#pragma unroll
    for (int kr = 0; kr < 8; ++kr) {
      const int tok = (r0 + kr) * 64 + cs + 4 * g;
      s16x4 lo[4], hi[4];
#pragma unroll
      for (int db = 0; db < 4; ++db) {
        const bf16_t* vp = vl + ((size_t)(tok >> 2) * 64 + db * 16) * 4;
        lo[db] = *(const s16x4*)vp; hi[db] = *(const s16x4*)(vp + 4 * 64 * 4);
      }
#pragma unroll
      for (int db = 0; db < 4; ++db) {
        const bf16x8 bfr = (bf16x8){lo[db][0], lo[db][1], lo[db][2], lo[db][3], hi[db][0], hi[db][1], hi[db][2], hi[db][3]};
        accO[db] = __builtin_amdgcn_mfma_f32_16x16x32_bf16(afL[kr], bfr, accO[db], 0, 0, 0);
      }
    }
#pragma unroll
    for (int t = 0; t < 8; ++t) {
      const int tok = 32 * t + 4 * g;
      s16x4 lo[4], hi[4];
#pragma unroll
      for (int db = 0; db < 4; ++db) {
        const bf16_t* vp = vc + ((size_t)(tok >> 2) * 64 + db * 16) * 4;
        lo[db] = *(const s16x4*)vp; hi[db] = *(const s16x4*)(vp + 4 * 64 * 4);
      }
#pragma unroll
      for (int db = 0; db < 4; ++db) {
        const bf16x8 bfr = (bf16x8){lo[db][0], lo[db][1], lo[db][2], lo[db][3], hi[db][0], hi[db][1], hi[db][2], hi[db][3]};
        accO[db] = __builtin_amdgcn_mfma_f32_16x16x32_bf16(afC[t], bfr, accO[db], 0, 0, 0);
      }
    }
#pragma unroll
    for (int db = 0; db < 4; ++db)
#pragma unroll
      for (int e = 0; e < 4; ++e)
        P.concat()[(size_t)(qrow0 + 4 * g + e) * 2048 + 1536 + hd * 64 + 16 * db + li] = f2bf(accO[db][e]);
  }
}

__device__ __forceinline__ uint32_t mono_u(float f) { const uint32_t u = __float_as_uint(f); return u ^ ((uint32_t)((int)u >> 31) | 0x80000000u); }
__device__ __forceinline__ float unmono_f(uint32_t m) { return __uint_as_float((m & 0x80000000u) ? (m ^ 0x80000000u) : ~m); }
__device__ __forceinline__ uint32_t grp_max_u(uint32_t v) {
  auto a = __builtin_amdgcn_permlane16_swap(v, v, false, false);
  v = a[0] > a[1] ? a[0] : a[1];
  auto b = __builtin_amdgcn_permlane32_swap(v, v, false, false);
  return b[0] > b[1] ? b[0] : b[1];
}

template <int N>
__device__ __forceinline__ void bitonic_sort_desc(uint32_t (&a)[N], int base = 0) { (void)base;
#pragma unroll
  for (int k = 2; k <= N; k <<= 1)
#pragma unroll
    for (int j = k >> 1; j > 0; j >>= 1)
#pragma unroll
      for (int i = 0; i < N; ++i) {
        const int l = i ^ j;
        if (l > i) {
          const bool desc = (i & k) == 0;
          const uint32_t hi = a[i] > a[l] ? a[i] : a[l], lo = a[i] > a[l] ? a[l] : a[i];
          a[i] = desc ? hi : lo; a[l] = desc ? lo : hi;
        }
      }
}
template <int N>
__device__ __forceinline__ void bitonic_merge_desc(uint32_t (&a)[N]) {
#pragma unroll
  for (int j = N >> 1; j > 0; j >>= 1)
#pragma unroll
    for (int i = 0; i < N; ++i) {
      const int l = i ^ j;
      if (l > i) {
        const uint32_t hi = a[i] > a[l] ? a[i] : a[l], lo = a[i] > a[l] ? a[l] : a[i];
        a[i] = hi; a[l] = lo;
      }
    }
}
__device__ __forceinline__ void merge4_top16(uint32_t (&a)[16]) {
  uint32_t e[16], o[16];
#pragma unroll
  for (int i = 0; i < 16; ++i) { auto r = __builtin_amdgcn_permlane16_swap(a[i], a[i], false, false); e[i] = r[0]; o[i] = r[1]; }
#pragma unroll
  for (int i = 0; i < 16; ++i) a[i] = e[i] > o[15 - i] ? e[i] : o[15 - i];
  bitonic_merge_desc<16>(a);
#pragma unroll
  for (int i = 0; i < 16; ++i) { auto r = __builtin_amdgcn_permlane32_swap(a[i], a[i], false, false); e[i] = r[0]; o[i] = r[1]; }
#pragma unroll
  for (int i = 0; i < 16; ++i) a[i] = e[i] > o[15 - i] ? e[i] : o[15 - i];
  bitonic_merge_desc<16>(a);
}
__device__ void ph_peer_topk_mfma(int wv, const Params& P, int layer, int nrows, char* smem, int bid, int nb) {
  const int tid = otid(wv), lane = tid & 63, li = lane & 15, g = lane >> 4;
  unsigned char* ctab = (unsigned char*)smem;
  float* vals = (float*)(smem + 256) + wv * 512;
  int* idxs = (int*)(smem + 256 + 8 * 2048) + wv * 512;
  __syncthreads();
  if (tid < 64) ctab[tid] = 0xFF;
  __syncthreads();
  if (tid == 0) {
    int n = 0, one = 1;
    asm volatile("" : "+s"(one));
#pragma unroll 1
    for (int a = 0; a < 16; ++a)
#pragma unroll 1
      for (int b = 0; b < 16; ++b)
        if ((a + one) * (b + 1) <= 16) { ctab[(n & 3) * 16 + (n >> 2)] = (unsigned char)(a * 16 + b); ++n; }
  }
  const int hd = bid & 7, tg = bid >> 3, ngroups = nb >> 3;
  char* ksm = smem + 33280;
  {
    const bf16_t* ksrc = P.keysb() + (size_t)(layer * 8 + hd) * 2 * 128 * 128;
#pragma unroll
    for (int i = 0; i < 8; ++i) {
      const int idx = tid + i * 512, r = idx >> 4, sg = idx & 15;
      *(uint4*)(ksm + (r * 136 + sg * 8) * 2) = *(const uint4*)(ksrc + (size_t)r * 128 + sg * 8);
    }
  }
  __syncthreads();
  uint32_t cab[16];
#pragma unroll
  for (int s = 0; s < 16; ++s) cab[s] = ctab[g * 16 + s];
  const int ntile = nrows / 16;
  for (int tile = tg + ngroups * wv; tile < ntile && tg < ngroups; tile += ngroups * NWAVE) {
    const int row0 = tile * 16;
    const bf16_t* qp = P.q() + (size_t)(row0 + li) * 2048 + hd * 256 + 8 * g;
    uint32_t win[2][16];
#pragma unroll
    for (int half = 0; half < 2; ++half) {
      bf16x8 qf[4];
#pragma unroll
      for (int t = 0; t < 4; ++t) qf[t] = *(const bf16x8*)(qp + half * 128 + 32 * t);
      const char* kb = ksm + ((half * 128 + li) * 136 + 8 * g) * 2;
      uint32_t pk[32];
#pragma unroll
      for (int kt = 0; kt < 8; ++kt) {
        f32x4 acc = (f32x4){0.f, 0.f, 0.f, 0.f};
#pragma unroll
        for (int t = 0; t < 4; ++t) {
          const bf16x8 a = *(const bf16x8*)(kb + (kt * 16 * 136 + 32 * t) * 2);
          acc = __builtin_amdgcn_mfma_f32_16x16x32_bf16(a, qf[t], acc, 0, 0, 0);
        }
#pragma unroll
        for (int e = 0; e < 4; ++e) pk[kt * 4 + e] = (mono_u(acc[e]) & ~127u) | (uint32_t)(16 * kt + 4 * g + e);
      }
      {
        uint32_t lo16[16], hi16[16];
#pragma unroll
        for (int i = 0; i < 16; ++i) { lo16[i] = pk[i]; hi16[i] = pk[16 + i]; }
        bitonic_sort_desc<16>(lo16);
        bitonic_sort_desc<16>(hi16);
#pragma unroll
        for (int i = 0; i < 16; ++i) lo16[i] = lo16[i] > hi16[15 - i] ? lo16[i] : hi16[15 - i];
        bitonic_merge_desc<16>(lo16);
        merge4_top16(lo16);
#pragma unroll
        for (int r = 0; r < 16; ++r) win[half][r] = lo16[r];
      }
    }
    if (g == 0) {
#pragma unroll
      for (int half = 0; half < 2; ++half)
#pragma unroll
        for (int r = 0; r < 16; ++r) {
          vals[li * 32 + half * 16 + r] = unmono_f(win[half][r] & ~127u);
          idxs[li * 32 + half * 16 + r] = (int)(win[half][r] & 127u);
        }
    }
    __builtin_amdgcn_wave_barrier();
    uint32_t cp[16];
    {
      float va[16], vb[16];
#pragma unroll
      for (int s = 0; s < 16; ++s) {
        const uint32_t ab = cab[s] == 0xFFu ? 0u : cab[s];
        va[s] = vals[li * 32 + (ab >> 4)]; vb[s] = vals[li * 32 + 16 + (ab & 15u)];
      }
#pragma unroll
      for (int s = 0; s < 16; ++s) cp[s] = cab[s] == 0xFFu ? 0u : ((mono_u(va[s] + vb[s]) & ~255u) | cab[s]);
    }
    bitonic_sort_desc<16>(cp);
    merge4_top16(cp);
    uint32_t cw[16];
#pragma unroll
    for (int r = 0; r < 16; ++r) cw[r] = cp[r];
    const float mx = unmono_f(cw[0] & ~255u);
    float ex[16];
    float sum = 0.f;
#pragma unroll
    for (int r = 0; r < 16; ++r) { ex[r] = __expf(unmono_f(cw[r] & ~255u) - mx); sum += ex[r]; }
    const float inv = 1.f / sum;
    const size_t ob = (size_t)(row0 + li) * 128 + hd * 16;
#pragma unroll
    for (int r = 0; r < 16; ++r) {
      if ((r >> 2) == g) {
        const uint32_t ab = cw[r] & 255u;
        P.sel_idx()[ob + r] = idxs[li * 32 + (ab >> 4)] * 128 + idxs[li * 32 + 16 + (ab & 15u)];
        P.sel_g()[ob + r] = ex[r] * inv;
      }
    }
    __builtin_amdgcn_wave_barrier();
  }
}

__device__ __forceinline__ void cvt8(const uint32_t w, float* f) {
  const f32x2_t a = __builtin_amdgcn_cvt_scalef32_pk_f32_fp4(w, 1.0f, 0), b = __builtin_amdgcn_cvt_scalef32_pk_f32_fp4(w, 1.0f, 1);
  const f32x2_t c = __builtin_amdgcn_cvt_scalef32_pk_f32_fp4(w, 1.0f, 2), e = __builtin_amdgcn_cvt_scalef32_pk_f32_fp4(w, 1.0f, 3);
  f[0] = a.x; f[1] = a.y; f[2] = b.x; f[3] = b.y; f[4] = c.x; f[5] = c.y; f[6] = e.x; f[7] = e.y;
}
__device__ __forceinline__ float swap16_add(float a, float b) {
  auto r = __builtin_amdgcn_permlane16_swap(__float_as_uint(a), __float_as_uint(b), false, false);
  return __uint_as_float(r[0]) + __uint_as_float(r[1]);
}
__device__ void ph_peer_gather(int wv, const Params& P, int layer, int nrows, int bid, int nb) {
  for (int row = bid * NWAVE + wv; row < nrows; row += nb * NWAVE) {
    const int lane = otid(wv) & 63, l5 = lane & 31;
    const bool up = lane >= 32;
    const unsigned char* TU = P.tabU() + l5 * 16;
    const unsigned char* TV = P.tabV() + l5 * 16;
    const int j15 = lane & 15;
    const int rr = ((j15 >> 3) & 1) | ((j15 & 1) << 1), zi = (j15 >> 1) & 3;
    const int srcl = (rr * 4 + (zi & 1) * 2 + (zi >> 1)) * 4;
    float xv[32], o[32];
    {
      const bf16_t* xp = P.u() + (size_t)row * DM + l5 * 32;
      unpack8(*(const uint4*)xp, xv); unpack8(*(const uint4*)(xp + 8), xv + 8);
      unpack8(*(const uint4*)(xp + 16), xv + 16); unpack8(*(const uint4*)(xp + 24), xv + 24);
    }
    const int idx0 = P.sel_idx()[(size_t)row * 128 + lane], idx1 = P.sel_idx()[(size_t)row * 128 + 64 + lane];
    const float gt0 = P.sel_g()[(size_t)row * 128 + lane] * P.invV()[idx0], gt1 = P.sel_g()[(size_t)row * 128 + 64 + lane] * P.invV()[idx1];
    const float iu0 = P.invU()[idx0], iu1 = P.invU()[idx1];
    float d0 = 0.f, d1 = 0.f;
    uint4 bufA[8], bufB[8];
#define PG_LOAD(buf, T, kk) do { _Pragma("unroll") for (int j = 0; j < 8; ++j) { \
      const int k_ = (kk) + 2 * j; const int src_ = k_ < 64 ? idx0 : idx1; \
      const int elo_ = __builtin_amdgcn_readlane(src_, k_ & 63), ehi_ = __builtin_amdgcn_readlane(src_, (k_ & 63) + 1); \
      buf[j] = *(const uint4*)(T + (size_t)(up ? ehi_ : elo_) * 512); } } while (0)
#define PG_DOT(buf, kk) do { float pv[8]; _Pragma("unroll") for (int j = 0; j < 8; ++j) { float s_ = 0.f; const uint32_t w_[4] = {buf[j].x, buf[j].y, buf[j].z, buf[j].w}; \
      _Pragma("unroll") for (int d = 0; d < 4; ++d) { float f[8]; uint32_t wd_ = w_[d]; asm volatile("" : "+v"(wd_) : "v"(s_)); cvt8(wd_, f); \
        _Pragma("unroll") for (int i = 0; i < 8; ++i) s_ += f[i] * xv[d * 8 + i]; } pv[j] = s_; } \
      const float z0 = swap16_add(pv[0], pv[4]), z1 = swap16_add(pv[1], pv[5]), z2 = swap16_add(pv[2], pv[6]), z3 = swap16_add(pv[3], pv[7]); \
      const bool hi8 = (lane & 8) != 0, hi4 = (lane & 4) != 0; \
      const float y0 = (hi8 ? z1 : z0) + DPP_F(hi8 ? z0 : z1, 0x128); \
      const float y1 = (hi8 ? z3 : z2) + DPP_F(hi8 ? z2 : z3, 0x128); \
      float q_ = (hi4 ? y1 : y0) + DPP_F(hi4 ? y0 : y1, 0x141); \
      q_ += DPP_F(q_, 0xB1); q_ += DPP_F(q_, 0x4E); \
      const float t_ = __int_as_float(__builtin_amdgcn_ds_bpermute(srcl * 4, __float_as_int(q_))); \
      const int m_ = ((kk) >> 4) & 3; \
      if ((kk) < 64) d0 = ((lane >> 4) == m_) ? t_ : d0; else d1 = ((lane >> 4) == m_) ? t_ : d1; } while (0)
    PG_LOAD(bufA, TU, 0);
#pragma unroll 1
    for (int kk = 0; kk < 128; kk += 32) {
      PG_LOAD(bufB, TU, kk + 16);
      PG_DOT(bufA, kk);
      if (kk + 32 < 128) PG_LOAD(bufA, TU, kk + 32); else PG_LOAD(bufA, TV, 0);
      PG_DOT(bufB, kk + 16);
    }
    const float act0 = gelu_f(d0 * iu0) * gt0, act1 = gelu_f(d1 * iu1) * gt1;
#pragma unroll
    for (int i = 0; i < 32; ++i) o[i] = 0.f;
#define PG_ACC(buf, kk) do { _Pragma("unroll") for (int j = 0; j < 8; ++j) { const int k_ = (kk) + 2 * j; \
      const int asrc_ = __float_as_int(k_ < 64 ? act0 : act1); \
      const float alo_ = __int_as_float(__builtin_amdgcn_readlane(asrc_, k_ & 63)), ahi_ = __int_as_float(__builtin_amdgcn_readlane(asrc_, (k_ & 63) + 1)); \
      const float a_ = up ? ahi_ : alo_; \
      const uint32_t w_[4] = {buf[j].x, buf[j].y, buf[j].z, buf[j].w}; \
      _Pragma("unroll") for (int d = 0; d < 4; ++d) { float f[8]; uint32_t wd_ = w_[d]; asm volatile("" : "+v"(wd_) : "v"(o[(d * 8 + 31) & 31])); cvt8(wd_, f); \
        _Pragma("unroll") for (int i = 0; i < 8; ++i) o[d * 8 + i] += a_ * f[i]; } } } while (0)
#pragma unroll 1
    for (int kk = 0; kk < 128; kk += 32) {
      PG_LOAD(bufB, TV, kk + 16);
      PG_ACC(bufA, kk);
      if (kk + 32 < 128) PG_LOAD(bufA, TV, kk + 32);
      PG_ACC(bufB, kk + 16);
    }
#undef PG_LOAD
#undef PG_DOT
#undef PG_ACC
#pragma unroll
    for (int i = 0; i < 32; ++i) {
      auto r = __builtin_amdgcn_permlane32_swap(__float_as_uint(o[i]), __float_as_uint(o[i]), false, false);
      o[i] = __uint_as_float(r[0]) + __uint_as_float(r[1]);
    }
    const int lane_e = otid(wv) & 63, l5e = lane_e & 31;
    const bool upe = lane_e >= 32;
    const float* gate = P.mod() + (size_t)(layer * 5 + modrow(row)) * MODW + 5120 + l5e * 32;
    float* hr = P.h() + (size_t)row * DM + l5e * 32;
    float ss = 0.f;
    f32x4 hvv[8], ggv[8];
#pragma unroll
    for (int q = 0; q < 8; ++q) { hvv[q] = *(const f32x4*)(hr + q * 4); ggv[q] = *(const f32x4*)(gate + q * 4); }
#pragma unroll
    for (int q = 0; q < 8; ++q) asm volatile("" : "+v"(hvv[q]), "+v"(ggv[q]));
#pragma unroll
    for (int q = 0; q < 8; ++q) {
      float4 hv = make_float4(hvv[q][0], hvv[q][1], hvv[q][2], hvv[q][3]);
      const float4 gg = make_float4(ggv[q][0], ggv[q][1], ggv[q][2], ggv[q][3]);
      hv.x += gg.x * o[q * 4 + 0]; hv.y += gg.y * o[q * 4 + 1]; hv.z += gg.z * o[q * 4 + 2]; hv.w += gg.w * o[q * 4 + 3];
      if (layer == 0 && !upe) *(float4*)(hr + q * 4) = hv;
      o[q * 4 + 0] = hv.x; o[q * 4 + 1] = hv.y; o[q * 4 + 2] = hv.z; o[q * 4 + 3] = hv.w;
      if (!upe) ss += hv.x * hv.x + hv.y * hv.y + hv.z * hv.z + hv.w * hv.w;
    }
    ss = wave_sum(ss);
    const float rstd = rsqrtf(ss * (1.f / 1024.f) + 1e-6f);
    if (layer == 0) {
      const float* g1 = P.norm1_g + 1024 + l5e * 32;
      const float* mr = P.mod() + (size_t)(5 + modrow(row)) * MODW + l5e * 32;
      if (!upe) {
#pragma unroll
        for (int q = 0; q < 4; ++q) {
          float ov[8];
#pragma unroll
          for (int e = 0; e < 8; ++e) ov[e] = o[q * 8 + e] * rstd * g1[q * 8 + e] * (1.f + mr[1024 + q * 8 + e]) + mr[q * 8 + e];
          *(uint4*)(P.u() + (size_t)row * DM + l5e * 32 + q * 8) = make_uint4(pack2(ov[0], ov[1]), pack2(ov[2], ov[3]), pack2(ov[4], ov[5]), pack2(ov[6], ov[7]));
        }
      }
    } else {
      const float* gf = P.final_g + l5e * 32;
      if (!upe) {
#pragma unroll
        for (int q = 0; q < 8; ++q) {
          const float4 gg = *(const float4*)(gf + q * 4);
          *(float4*)(P.out + (size_t)row * DM + l5e * 32 + q * 4) =
              make_float4(o[q * 4] * rstd * gg.x, o[q * 4 + 1] * rstd * gg.y, o[q * 4 + 2] * rstd * gg.z, o[q * 4 + 3] * rstd * gg.w);
        }
      }
    }
  }
}

struct EpiOutproj {
  static constexpr bool PERM = false, AFTER_DRAIN = false;
  static constexpr int MIDK_T = 16;
  float* H; const float* hl; const float* hc; const float* modl;
  const float* yss;
  __device__ __forceinline__ void midk(pg8::f32x4 (&acc)[2][2][4][2], const pg8::Unit& u, int wr, int wc, int fr, int fq) const {
    const int row0 = u.pm * 256 + wr * 64 + fr;
#pragma unroll
    for (int ai = 0; ai < 2; ++ai)
#pragma unroll
      for (int m = 0; m < 4; ++m) {
        const pg8::f32x4* yp = (const pg8::f32x4*)(yss + (size_t)(row0 + ai * 128 + m * 16) * 16);
        const pg8::f32x4 y4 = (yp[0] + yp[1]) + (yp[2] + yp[3]);
        const float rstd = rsqrtf(((y4[0] + y4[1]) + (y4[2] + y4[3])) * (1.f / 1024.f) + 1e-6f);
#pragma unroll
        for (int bj = 0; bj < 2; ++bj)
#pragma unroll
          for (int n = 0; n < 2; ++n) acc[ai][bj][m][n] *= rstd;
      }
  }
  __device__ __forceinline__ void operator()(const pg8::f32x4 (&acc)[2][2][4][2], const pg8::Unit& u, int wr, int wc, int fr, int fq) const {
    const int row0 = u.pm * 256 + wr * 64 + fr, col0 = u.pn * 256 + wc * 32 + 4 * fq;
    const float* gate = modl + (size_t)modrow(row0) * MODW + 2048 + col0;
    pg8::f32x4 gv[2][2];
#pragma unroll
    for (int bj = 0; bj < 2; ++bj)
#pragma unroll
      for (int n = 0; n < 2; ++n) gv[bj][n] = *(const pg8::f32x4*)(gate + bj * 128 + n * 16);
    pg8::f32x4 sA[4], sB[4];
#define EO_LOAD(dstv, ai_, m_) do { const float* s_ = hrow(hl, hc, row0 + (ai_) * 128 + (m_) * 16) + col0; \
      dstv[0] = *(const pg8::f32x4*)(s_); dstv[1] = *(const pg8::f32x4*)(s_ + 16); dstv[2] = *(const pg8::f32x4*)(s_ + 128); dstv[3] = *(const pg8::f32x4*)(s_ + 144); } while (0)
#define EO_STORE(srcv, ai_, m_) do { asm volatile("" : "+v"(srcv[0]), "+v"(srcv[1]), "+v"(srcv[2]), "+v"(srcv[3])); \
      float* d_ = H + (size_t)(row0 + (ai_) * 128 + (m_) * 16) * DM + col0; \
      *(pg8::f32x4*)(d_) = srcv[0] + gv[0][0] * acc[ai_][0][m_][0]; *(pg8::f32x4*)(d_ + 16) = srcv[1] + gv[0][1] * acc[ai_][0][m_][1]; \
      *(pg8::f32x4*)(d_ + 128) = srcv[2] + gv[1][0] * acc[ai_][1][m_][0]; *(pg8::f32x4*)(d_ + 144) = srcv[3] + gv[1][1] * acc[ai_][1][m_][1]; } while (0)
    EO_LOAD(sA, 0, 0);
#pragma unroll
    for (int i = 0; i < 8; i += 2) {
      EO_LOAD(sB, (i + 1) >> 2, (i + 1) & 3);
      EO_STORE(sA, i >> 2, i & 3);
      if (i + 2 < 8) EO_LOAD(sA, (i + 2) >> 2, (i + 2) & 3);
      EO_STORE(sB, (i + 1) >> 2, (i + 1) & 3);
    }
#undef EO_LOAD
#undef EO_STORE
  }
};

__device__ __forceinline__ uint32_t fp4_code(float x, float sc) {
  const float a = fabsf(x) * sc;
  const uint32_t c = (uint32_t)(a > 0.25f) + (uint32_t)(a > 0.75f) + (uint32_t)(a > 1.25f) + (uint32_t)(a > 1.75f) +
                     (uint32_t)(a > 2.5f) + (uint32_t)(a > 3.5f) + (uint32_t)(a > 5.0f);
  return c | (x < 0.f ? 8u : 0u);
}
__device__ void ph_convert_tables(int wv, const Params& P, int layer, int bid, int nb) {
  const int lane = otid(wv) & 63;
  for (int it0 = (bid * NWAVE + wv) * 2; it0 < 2 * 16384; it0 += nb * NWAVE * 2) {
    f32x4 v[2][4];
#pragma unroll
    for (int rr = 0; rr < 2; ++rr) {
      const int it = it0 + rr, t = it >> 14, e = it & 16383;
      const float* src = (t == 0 ? P.peer_u : P.peer_v) + ((size_t)layer * 16384 + e) * 1024 + lane * 16;
#pragma unroll
      for (int i = 0; i < 4; ++i) v[rr][i] = ((const f32x4*)src)[i];
    }
#pragma unroll
    for (int rr = 0; rr < 2; ++rr)
#pragma unroll
      for (int i = 0; i < 4; ++i) asm volatile("" : "+v"(v[rr][i]));
#pragma unroll
    for (int rr = 0; rr < 2; ++rr) {
      const int it = it0 + rr, t = it >> 14, e = it & 16383;
      float m = 0.f;
#pragma unroll
      for (int i = 0; i < 4; ++i)
        m = fmaxf(m, fmaxf(fmaxf(fabsf(v[rr][i][0]), fabsf(v[rr][i][1])), fmaxf(fabsf(v[rr][i][2]), fabsf(v[rr][i][3]))));
      m = wave_max(m);
      m = fmaxf(m, 1e-30f);
      const float sc = 6.0f / m, inv = m * (1.0f / 6.0f);
      uint2 o;
      {
        uint32_t p0 = 0u, p1 = 0u;
        p0 = __builtin_amdgcn_cvt_scalef32_pk_fp4_f32(p0, v[rr][0][0] * sc, v[rr][0][1] * sc, 1.0f, 0);
        p0 = __builtin_amdgcn_cvt_scalef32_pk_fp4_f32(p0, v[rr][0][2] * sc, v[rr][0][3] * sc, 1.0f, 1);
        p0 = __builtin_amdgcn_cvt_scalef32_pk_fp4_f32(p0, v[rr][1][0] * sc, v[rr][1][1] * sc, 1.0f, 2);
        p0 = __builtin_amdgcn_cvt_scalef32_pk_fp4_f32(p0, v[rr][1][2] * sc, v[rr][1][3] * sc, 1.0f, 3);
        p1 = __builtin_amdgcn_cvt_scalef32_pk_fp4_f32(p1, v[rr][2][0] * sc, v[rr][2][1] * sc, 1.0f, 0);
        p1 = __builtin_amdgcn_cvt_scalef32_pk_fp4_f32(p1, v[rr][2][2] * sc, v[rr][2][3] * sc, 1.0f, 1);
        p1 = __builtin_amdgcn_cvt_scalef32_pk_fp4_f32(p1, v[rr][3][0] * sc, v[rr][3][1] * sc, 1.0f, 2);
        p1 = __builtin_amdgcn_cvt_scalef32_pk_fp4_f32(p1, v[rr][3][2] * sc, v[rr][3][3] * sc, 1.0f, 3);
        o.x = p0; o.y = p1;
      }
      *(uint2*)((t == 0 ? P.tabU() : P.tabV()) + (size_t)e * 512 + lane * 8) = o;
      if (lane == 0) (t == 0 ? P.invU() : P.invV())[e] = inv;
    }
  }
}

enum {
  PH_PREP = 0, PH_NORM1, PH_INPROJ, PH_CONV, PH_SSDPREP, PH_STATES, PH_SCAN, PH_SSDY, PH_SSDNORM, PH_POOL, PH_NA,
  PH_OUTPROJ, PH_NORM2, PH_QGEMM, PH_TOPK, PH_GATHER, PH_FINAL
};

#define SMEM_BYTES 135168

__device__ __forceinline__ void run_phase(int wv, const Params& P, int ph, int layer, char* smem, int bid, int nb) {
  const float* hl = layer == 0 ? P.x : P.h();
  const float* hc = layer == 0 ? P.ctx : P.h() + (size_t)NLAT * DM;
  const int nrows = layer == 0 ? NTOK : NLAT;
  switch (ph) {
    case PH_PREP:
      for (int i = bid * NTHR + otid(wv); i < 2 * 8 * 2 * 128 * 128; i += nb * NTHR) P.keysb()[i] = f2bf(P.peer_keys[i]);
      for (int i = bid * NTHR + otid(wv); i < 2 * 4 * 128 * 128; i += nb * NTHR) {
        const int k = i & 127, n = (i >> 7) & 127, lg = i >> 14;
        P.poolwT()[i] = f2bf(P.pool_w[((size_t)lg * 128 + k) * 128 + n]);
      }
      ph_mod(wv, P, (float*)smem, bid, nb);
      for (int l = 0; l < 2; ++l) {
        ph_transpose(wv, P.w_in + (size_t)l * 1024 * INW, P.w_inT() + (size_t)l * PW * 1024, 1024, INW, PW, 0, 2560, 32, PW, (float*)smem, bid, nb);
        ph_transpose(wv, P.w_in + (size_t)l * 1024 * INW, P.w_dtT() + (size_t)l * 128 * 1024, 1024, INW, 128, 2560, 1 << 30, 0, 32, (float*)smem, bid, nb);
        ph_transpose(wv, P.w_out + (size_t)l * 2048 * 1024, P.w_outT() + (size_t)l * 1024 * 2048, 2048, 1024, 1024, 0, 1 << 30, 0, 1024, (float*)smem, bid, nb,
                     P.ssd_norm_g + l * 1024, 1024);
        ph_transpose(wv, P.peer_wq + (size_t)l * 1024 * 2048, P.w_qT() + (size_t)l * 2048 * 1024, 1024, 2048, 2048, 0, 1 << 30, 0, 2048, (float*)smem, bid, nb);
      }
      break;
    case PH_NORM1:
      ph_norm(wv, hl, hc, P.norm1_g + layer * 1024, P.mod() + (size_t)layer * 5 * MODW, 0, 1024, NTOK, P.u(), bid, nb);
      break;
    case PH_INPROJ:
    {
      pg8::Gemm g{P.u(), P.w_inT() + (size_t)layer * PW * 1024, NTOK, PW, 1024};
      pg8::StaticOrder S; S.init(g.M, g.N, nb, bid);
      pg8::EpiBf16<0> E{P.p(), PW, nullptr, 0, 0};
      pg8::gemm_phase<pg8::EpiBf16<0>, pg8::StaticOrder, false>(wv, (PG8_LAS unsigned char*)smem, g, S, E, nullptr);
      {
        const int units = (NTOK / 256) * (PW / 256), rem = units % nb;
        const int nidle = rem == 0 ? nb : nb - rem, first_idle = rem == 0 ? 0 : rem;
        if (bid >= first_idle) ph_dtprep(wv, P, layer, smem, bid - first_idle, nidle);
      }
      break;
    }
    case PH_CONV: ph_conv(wv, P, layer, bid, nb); ph_vtranspose(wv, P, smem, bid, nb); break;
    case PH_STATES: ph_states_mfma(wv, P, layer, smem, bid, nb); break;
    case PH_SCAN: ph_scan(wv, P, bid, nb); break;
    case PH_SSDY: ph_ssdy_mfma(wv, P, layer, nrows / 128, smem, bid, nb); break;
    case PH_SSDNORM: ph_ssdnorm(wv, P, layer, nrows, bid, nb); break;
    case PH_POOL: ph_pool_mfma(wv, P, layer, nrows, bid, nb); break;
    case PH_NA: ph_na_mfma(wv, P, layer, nrows, smem, bid, nb); break;
    case PH_OUTPROJ:
    {
      pg8::Gemm g{P.concat(), P.w_outT() + (size_t)layer * 1024 * 2048, nrows, 1024, 2048};
      pg8::StaticOrder S; S.init(g.M, g.N, nb, bid);
      EpiOutproj E{P.h(), hl, hc, P.mod() + (size_t)layer * 5 * MODW, P.yss()};
      pg8::gemm_phase<EpiOutproj, pg8::StaticOrder, false>(wv, (PG8_LAS unsigned char*)smem, g, S, E, nullptr);
      break;
    }
    case PH_NORM2:
      ph_norm(wv, P.h(), P.h() + (size_t)NLAT * DM, P.norm2_g + layer * 1024, P.mod() + (size_t)layer * 5 * MODW, 3072, 4096, nrows, P.u(), bid, nb);
      break;
    case PH_QGEMM:
    {
      pg8::Gemm g{P.u(), P.w_qT() + (size_t)layer * 2048 * 1024, nrows, 2048, 1024};
      pg8::StaticOrder S; S.init(g.M, g.N, nb, bid);
      pg8::EpiBf16<0> E{P.q(), 2048, nullptr, 0, 0};
      pg8::gemm_phase<pg8::EpiBf16<0>, pg8::StaticOrder, false>(wv, (PG8_LAS unsigned char*)smem, g, S, E, nullptr);
      ph_convert_tables(wv, P, layer, bid, nb);
      break;
    }
    case PH_TOPK: ph_peer_topk_mfma(wv, P, layer, nrows, smem, bid, nb); break;
    case PH_GATHER: ph_peer_gather(wv, P, layer, nrows, bid, nb); break;
  }
}

namespace cg = cooperative_groups;
typedef const __attribute__((address_space(4))) Params* kparams_t;
__device__ __forceinline__ const Params& kp_fresh() {
  kparams_t kp = (kparams_t)__builtin_amdgcn_kernarg_segment_ptr();
  asm volatile("" : "+s"(kp));
  return *(const Params*)kp;
}
__global__ void __launch_bounds__(NTHR) k_mega(Params P_unused) {
  __shared__ __attribute__((aligned(16))) char smem[SMEM_BYTES + 16];
  cg::grid_group grid = cg::this_grid();
  const int bid = blockIdx.x, nb = gridDim.x;
  const int wv = __builtin_amdgcn_readfirstlane(threadIdx.x >> 6);
  if (threadIdx.x == 0) *(uint4*)(smem + SMEM_BYTES) = make_uint4(0u, 0u, 0u, 0u);
  __syncthreads();
  (void)xcd_barrier_post((unsigned*)(kp_fresh().ws + WS_BAR), (volatile LAS unsigned*)(smem + SMEM_BYTES), threadIdx.x == 0);
#define GSYNC() do { XcdBarrier xb_; xb_.bar = (unsigned*)(kp_fresh().ws + WS_BAR); xb_.x = xb_xcc_id(); \
    xb_.st = (volatile LAS unsigned*)(smem + SMEM_BYTES); xcd_barrier(xb_, otid(wv) == 0); } while (0)
  run_phase(wv, kp_fresh(), PH_PREP, 0, smem, bid, nb);
  if (nb == 0x7fffff00) grid.sync();
  GSYNC();
  run_phase(wv, kp_fresh(), PH_NORM1, 0, smem, bid, nb); GSYNC();
#pragma unroll 1
  for (int layer = 0; layer < 2; ++layer) {
    run_phase(wv, kp_fresh(), PH_INPROJ, layer, smem, bid, nb); GSYNC();
    run_phase(wv, kp_fresh(), PH_CONV, layer, smem, bid, nb);
    GSYNC();
    run_phase(wv, kp_fresh(), PH_STATES, layer, smem, bid, nb);
    run_phase(wv, kp_fresh(), PH_POOL, layer, smem, bid, nb);
    run_phase(wv, kp_fresh(), PH_NA, layer, smem, bid, nb); GSYNC();
    run_phase(wv, kp_fresh(), PH_SCAN, layer, smem, bid, nb); GSYNC();
    run_phase(wv, kp_fresh(), PH_SSDY, layer, smem, bid, nb); GSYNC();
    run_phase(wv, kp_fresh(), PH_OUTPROJ, layer, smem, bid, nb); GSYNC();
    run_phase(wv, kp_fresh(), PH_NORM2, layer, smem, bid, nb); GSYNC();
    run_phase(wv, kp_fresh(), PH_QGEMM, layer, smem, bid, nb); GSYNC();
    run_phase(wv, kp_fresh(), PH_TOPK, layer, smem, bid, nb); GSYNC();
    run_phase(wv, kp_fresh(), PH_GATHER, layer, smem, bid, nb);
    if (layer == 0) GSYNC();
  }
}

extern "C" void kernel_launch(void* const* d_in, const int* in_sizes, int n_in, void* d_out, int out_size, void* d_ws,
                              size_t ws_size, hipStream_t stream) {
  Params P{};
  const float* const* in = (const float* const*)d_in;
  P.x = in[0]; P.c = in[1]; P.ctx = in[2]; P.c_ctx = in[3]; P.ada_w = in[4]; P.ada_b = in[5]; P.norm1_g = in[6];
  P.w_in = in[7]; P.conv_w = in[8]; P.conv_b = in[9]; P.a_log = in[10]; P.dt_bias = in[11]; P.d_skip = in[12];
  P.ssd_norm_g = in[13]; P.pool_w = in[14]; P.pool_scale = in[15]; P.na_rpb = in[16]; P.w_out = in[17];
  P.norm2_g = in[18]; P.peer_wq = in[19]; P.peer_keys = in[20]; P.peer_u = in[21]; P.peer_v = in[22]; P.final_g = in[23];
  P.out = (float*)d_out;
  P.ws = (char*)d_ws;
  if (WS_TOTAL > ws_size) { fprintf(stderr, "workspace too small: need %zu have %zu\n", (size_t)WS_TOTAL, ws_size); return; }

  static int grid_blocks = 0;
  if (!grid_blocks) {
    int dev = 0, cus = 0, per_cu = 0;
    hipGetDevice(&dev);
    hipDeviceGetAttribute(&cus, hipDeviceAttributeMultiprocessorCount, dev);
    hipOccupancyMaxActiveBlocksPerMultiprocessor(&per_cu, k_mega, NTHR, 0);
    if (per_cu > 4) per_cu = 4;
    grid_blocks = cus * per_cu;
  }
  hipMemsetAsync((char*)d_ws + WS_BAR, 0, 4096 * 4, stream);
  void* args[] = {&P};
  hipError_t e = hipLaunchCooperativeKernel((void*)k_mega, dim3(grid_blocks), dim3(NTHR), args, 0, stream);
  if (e != hipSuccess) fprintf(stderr, "cooperative launch failed: %s (grid %d)\n", hipGetErrorString(e), grid_blocks);
}
```

```cpp
#include <hip/hip_runtime.h>
#include <hip/hip_bf16.h>
#include <hip/hip_cooperative_groups.h>
#include <stdint.h>
#include <stdio.h>

typedef unsigned short bf16_t;
typedef __attribute__((ext_vector_type(8))) short bf16x8;
typedef __attribute__((ext_vector_type(4))) float f32x4;

#define NTHR 512
#define NWAVE 8
constexpr int DM = 1024;
constexpr int SEQ = 4096;
constexpr int NLAT = 16384;
constexpr int NCTXR = 1024;
constexpr int NTOK = 17408;
constexpr int INW = 4640;
constexpr int PW = 4608;
constexpr int OFF_Z = 0, OFF_XBC = 1024, OFF_POOL = 2560, OFF_Q = 3072, OFF_K = 3584, OFF_V = 4096;
constexpr int NCHUNK = 136;
constexpr int MODW = 6144;

constexpr size_t al256(size_t x) { return (x + 255) & ~(size_t)255; }
constexpr size_t WS_MOD = 0;
constexpr size_t WS_H = WS_MOD + al256((size_t)2 * 5 * MODW * 4);
constexpr size_t WS_P = WS_H + al256((size_t)NTOK * DM * 4);
constexpr size_t WS_TABU = WS_P + (size_t)80 * 1024 * 1024;
constexpr size_t WS_TABV = WS_TABU + (size_t)16384 * 512;
constexpr size_t WS_INVU = WS_TABV + (size_t)16384 * 512;
constexpr size_t WS_INVV = WS_INVU + (size_t)16384 * 4;
constexpr size_t WS_DTRAW = WS_P + al256((size_t)NTOK * PW * 2);
constexpr size_t WS_DTV = WS_DTRAW + al256((size_t)NTOK * 32 * 4);
constexpr size_t WS_CSV = WS_DTV + al256((size_t)NTOK * 32 * 4);
constexpr size_t WS_XBC = WS_CSV + al256((size_t)NTOK * 32 * 4);
constexpr size_t WS_VTL = WS_XBC + al256((size_t)NTOK * 512 * 2);
constexpr size_t WS_VTC = WS_VTL + al256((size_t)4 * 8 * 64 * 4096 * 2);
constexpr size_t WS_KEYSB = WS_VTC + al256((size_t)4 * 8 * 64 * 256 * 2);
constexpr size_t WS_POOLWT = WS_KEYSB + al256((size_t)2 * 8 * 2 * 128 * 128 * 2);
constexpr size_t WS_BT4 = WS_POOLWT + al256((size_t)2 * 4 * 128 * 128 * 2);
constexpr size_t WS_ATOT = WS_BT4 + al256((size_t)NTOK * 256 * 2);
constexpr size_t WS_STATES = WS_XBC + al256((size_t)NTOK * 1536 * 2);
constexpr size_t WS_YSS = WS_ATOT + al256((size_t)NCHUNK * 32 * 4);
static_assert(WS_YSS + (size_t)NTOK * 16 * 4 <= WS_STATES, "must fit in the old xbc region");
constexpr size_t WS_CONCAT = WS_STATES + al256((size_t)NCHUNK * 32 * 8192 * 2);
constexpr size_t WS_SELIDX = WS_CONCAT + al256((size_t)NTOK * 2048 * 2);
constexpr size_t WS_SELG = WS_SELIDX + al256((size_t)NTOK * 128 * 4);
constexpr size_t WS_WINT = WS_SELG + al256((size_t)NTOK * 128 * 4);
constexpr size_t WS_WDTT = WS_WINT + al256((size_t)2 * PW * 1024 * 2);
constexpr size_t WS_WOUTT = WS_WDTT + al256((size_t)2 * 128 * 1024 * 2);
constexpr size_t WS_WQT = WS_WOUTT + al256((size_t)2 * 1024 * 2048 * 2);
constexpr size_t WS_BAR = WS_WQT + al256((size_t)2 * 2048 * 1024 * 2);
constexpr size_t WS_XT4 = WS_BAR + al256((size_t)4096 * 4);
constexpr size_t WS_TOTAL = WS_XT4 + al256((size_t)NTOK * 1024 * 2);
static_assert((size_t)4 * 8 * (4096 + 256) * 64 * 2 <= WS_WINT - WS_SELIDX, "K relayout must fit in the sel_idx/sel_g region");
static_assert(WS_INVV + (size_t)16384 * 4 <= WS_DTRAW, "tables must fit in the tail of p");
static_assert((size_t)NTOK * 2048 * 2 <= (size_t)80 * 1024 * 1024, "q must fit below the tables");

struct Params {
  const float *x, *c, *ctx, *c_ctx, *ada_w, *ada_b, *norm1_g, *w_in, *conv_w, *conv_b, *a_log, *dt_bias, *d_skip,
      *ssd_norm_g, *pool_w, *pool_scale, *na_rpb, *w_out, *norm2_g, *peer_wq, *peer_keys, *peer_u, *peer_v, *final_g;
  float* out;
  char* ws;
  __device__ __forceinline__ float* mod() const { return (float*)(ws + WS_MOD); }
  __device__ __forceinline__ float* h() const { return (float*)(ws + WS_H); }
  __device__ __forceinline__ bf16_t* u() const { return (bf16_t*)(ws + WS_CONCAT); }
  __device__ __forceinline__ bf16_t* p() const { return (bf16_t*)(ws + WS_P); }
  __device__ __forceinline__ float* dtraw() const { return (float*)(ws + WS_DTRAW); }
  __device__ __forceinline__ float* dtv() const { return (float*)(ws + WS_DTV); }
  __device__ __forceinline__ float* csv() const { return (float*)(ws + WS_CSV); }
  __device__ __forceinline__ bf16_t* xbc() const { return (bf16_t*)(ws + WS_XBC); }
  __device__ __forceinline__ bf16_t* states() const { return (bf16_t*)(ws + WS_STATES); }
  __device__ __forceinline__ bf16_t* concat() const { return (bf16_t*)(ws + WS_CONCAT); }
  __device__ __forceinline__ bf16_t* q() const { return (bf16_t*)(ws + WS_P); }
  __device__ __forceinline__ int* sel_idx() const { return (int*)(ws + WS_SELIDX); }
  __device__ __forceinline__ float* sel_g() const { return (float*)(ws + WS_SELG); }
  __device__ __forceinline__ bf16_t* w_inT() const { return (bf16_t*)(ws + WS_WINT); }
  __device__ __forceinline__ bf16_t* w_dtT() const { return (bf16_t*)(ws + WS_WDTT); }
  __device__ __forceinline__ bf16_t* w_outT() const { return (bf16_t*)(ws + WS_WOUTT); }
  __device__ __forceinline__ bf16_t* w_qT() const { return (bf16_t*)(ws + WS_WQT); }
  __device__ __forceinline__ bf16_t* vtl() const { return (bf16_t*)(ws + WS_VTL); }
  __device__ __forceinline__ bf16_t* vtc() const { return (bf16_t*)(ws + WS_VTC); }
  __device__ __forceinline__ bf16_t* poolwT() const { return (bf16_t*)(ws + WS_POOLWT); }
  __device__ __forceinline__ bf16_t* keysb() const { return (bf16_t*)(ws + WS_KEYSB); }
  __device__ __forceinline__ bf16_t* xt4() const { return (bf16_t*)(ws + WS_XT4); }
  __device__ __forceinline__ bf16_t* bt4() const { return (bf16_t*)(ws + WS_BT4); }
  __device__ __forceinline__ float* wst() const { return (float*)(ws + WS_DTRAW); }
  __device__ __forceinline__ float* cst() const { return (float*)(ws + WS_CSV); }
  __device__ __forceinline__ float* dtt() const { return (float*)(ws + WS_DTV); }
  __device__ __forceinline__ float* yss() const { return (float*)(ws + WS_YSS); }
  __device__ __forceinline__ float* atot() const { return (float*)(ws + WS_ATOT); }
  __device__ __forceinline__ bf16_t* bfr() const { return (bf16_t*)(ws + WS_XBC); }
  __device__ __forceinline__ bf16_t* cfr() const { return (bf16_t*)(ws + WS_XBC + (size_t)NTOK * 256 * 2); }
  __device__ __forceinline__ bf16_t* ktl() const { return (bf16_t*)(ws + WS_SELIDX); }
  __device__ __forceinline__ bf16_t* ktc() const { return (bf16_t*)(ws + WS_SELIDX + (size_t)4 * 8 * 4096 * 64 * 2); }
  __device__ __forceinline__ unsigned char* tabU() const { return (unsigned char*)(ws + WS_TABU); }
  __device__ __forceinline__ unsigned char* tabV() const { return (unsigned char*)(ws + WS_TABV); }
  __device__ __forceinline__ float* invU() const { return (float*)(ws + WS_INVU); }
  __device__ __forceinline__ float* invV() const { return (float*)(ws + WS_INVV); }
};

__device__ __forceinline__ int otid(int wv) {
  int l;
  asm volatile("v_mbcnt_lo_u32_b32 %0, -1, 0\n\tv_mbcnt_hi_u32_b32 %0, -1, %0" : "=v"(l));
  return (wv << 6) | l;
}
__device__ __forceinline__ float bf2f(bf16_t v) { return __uint_as_float(((uint32_t)v) << 16); }
typedef __bf16 bf16x2_hw __attribute__((ext_vector_type(2)));
__device__ __forceinline__ uint32_t pack2(float a, float b) {
  const float __attribute__((ext_vector_type(2))) v = {a, b};
  return __builtin_bit_cast(uint32_t, __builtin_convertvector(v, bf16x2_hw));
}
__device__ __forceinline__ bf16_t f2bf(float f) { return (bf16_t)(pack2(f, 0.f) & 0xffffu); }
#define DPP_F(v, ctrl) __int_as_float(__builtin_amdgcn_update_dpp(0, __float_as_int(v), (ctrl), 0xf, 0xf, true))
__device__ __forceinline__ float wave_sum(float v) {
  v += DPP_F(v, 0xB1);
  v += DPP_F(v, 0x4E);
  v += DPP_F(v, 0x141);
  v += DPP_F(v, 0x140);
  const int iv = __float_as_int(v);
  return __int_as_float(__builtin_amdgcn_readlane(iv, 0)) + __int_as_float(__builtin_amdgcn_readlane(iv, 16)) +
         __int_as_float(__builtin_amdgcn_readlane(iv, 32)) + __int_as_float(__builtin_amdgcn_readlane(iv, 48));
}
__device__ __forceinline__ float wave_max(float v) {
  v = fmaxf(v, DPP_F(v, 0xB1));
  v = fmaxf(v, DPP_F(v, 0x4E));
  v = fmaxf(v, DPP_F(v, 0x141));
  v = fmaxf(v, DPP_F(v, 0x140));
  const int iv = __float_as_int(v);
  return fmaxf(fmaxf(__int_as_float(__builtin_amdgcn_readlane(iv, 0)), __int_as_float(__builtin_amdgcn_readlane(iv, 16))),
               fmaxf(__int_as_float(__builtin_amdgcn_readlane(iv, 32)), __int_as_float(__builtin_amdgcn_readlane(iv, 48))));
}
__device__ __forceinline__ float fexp(float v) { return __builtin_amdgcn_exp2f(v * 1.44269504088896341f); }
__device__ __forceinline__ float silu_f(float v) { return v * __builtin_amdgcn_rcpf(1.f + fexp(-v)); }
__device__ __forceinline__ float softplus_f(float v) { return fmaxf(v, 0.f) + log1pf(expf(-fabsf(v))); }
__device__ __forceinline__ float gelu_f(float v) { return 0.5f * v * (1.f + erff(v * 0.70710678118654752f)); }

__device__ __forceinline__ void unpack8(const uint4 v, float* f) {
  f[0] = __uint_as_float(v.x << 16); f[1] = __uint_as_float(v.x & 0xffff0000u);
  f[2] = __uint_as_float(v.y << 16); f[3] = __uint_as_float(v.y & 0xffff0000u);
  f[4] = __uint_as_float(v.z << 16); f[5] = __uint_as_float(v.z & 0xffff0000u);
  f[6] = __uint_as_float(v.w << 16); f[7] = __uint_as_float(v.w & 0xffff0000u);
}
typedef float f32x2_t __attribute__((ext_vector_type(2)));
typedef unsigned u32x4_t __attribute__((ext_vector_type(4)));
typedef short s16x4 __attribute__((ext_vector_type(4)));
typedef __attribute__((address_space(3))) s16x4 lds_s16x4;
__device__ __forceinline__ bf16x8 tr_read2(const char* a0, const char* a1) {
  const s16x4 a = __builtin_amdgcn_ds_read_tr16_b64_v4i16((lds_s16x4*)a0);
  const s16x4 b = __builtin_amdgcn_ds_read_tr16_b64_v4i16((lds_s16x4*)a1);
  return (bf16x8){a[0], a[1], a[2], a[3], b[0], b[1], b[2], b[3]};
}

__device__ __forceinline__ const float* hrow(const float* hl, const float* hc, int row) {
  return row < NLAT ? hl + (size_t)row * DM : hc + (size_t)(row - NLAT) * DM;
}
__device__ __forceinline__ int modrow(int row) { return row < NLAT ? (row >> 12) : 4; }

namespace pg8 {
#define PG8_LAS __attribute__((address_space(3)))
typedef unsigned short bf16_t;
typedef short bf16x8 __attribute__((ext_vector_type(8)));
typedef float f32x4 __attribute__((ext_vector_type(4)));
typedef unsigned u32x4 __attribute__((ext_vector_type(4)));
constexpr int BM = 256, BK = 64, HALF = 128, HTB = HALF * BK * 2  , STAGE_BYTES = 8 * HTB, NXCD = 8, WGM = 8;

__host__ __device__ __forceinline__ int lds_byte(int r, int c) { const int st = (r >> 4) * 2 + (c >> 5), rr = r & 15, cc = c & 31, ob = rr * 64 + cc * 2; return st * 1024 + (ob ^ (((ob >> 9) & 1) << 5)); }
__host__ __device__ __forceinline__ void stage_rc(int b, int& R, int& C) { const int st = b / 1024, sb = b % 1024, swz = sb ^ (((sb >> 9) & 1) << 5); R = (st >> 1) * 16 + swz / 64; C = (st & 1) * 32 + (swz % 64) / 2; }
__host__ __device__ __forceinline__ int perm32(int rho) { const int n = rho >> 4, i = rho & 15; return 8 * (i >> 2) + 4 * n + (i & 3); }

struct Unit { int pm, pn; };
struct Gemm { const bf16_t* A; const bf16_t* Bt; int M, N, K; };

struct StaticOrder {
    int nM, nN, nwg, G, c;
    __host__ __device__ void init(int M, int N, int G_, int c_) { nM = M / BM; nN = N / BM; nwg = nM * nN; G = G_; c = c_; }
    __host__ __device__ bool next(int i, Unit& u) const {
        const long L = (long)i * G + c; if (L >= nwg) return false;
        int wgid = (int)L; { const int q = nwg / NXCD, r = nwg % NXCD, xcd = wgid % NXCD, off = wgid / NXCD; wgid = (xcd < r ? xcd * (q + 1) : r * (q + 1) + (xcd - r) * q) + off; }
        const int nig = WGM * nN, gid = wgid / nig, fm = gid * WGM, gsz = (nM - fm) < WGM ? (nM - fm) : WGM;
        u.pm = fm + ((wgid % nig) % gsz); u.pn = (wgid % nig) / gsz; return true;
    }
    __device__ __forceinline__ void a_ready(const Unit&) const {}
    __device__ __forceinline__ void done(const Unit&) const {}
};

__device__ __forceinline__ unsigned cvt_pk_bf16(float lo, float hi) { unsigned r; asm volatile("v_cvt_pk_bf16_f32 %0, %1, %2" : "=v"(r) : "v"(lo), "v"(hi)); return r; }
typedef float f32x2 __attribute__((ext_vector_type(2)));
__device__ __forceinline__ f32x2 gelu_pk(f32x2 v) { return v; }
template <int ACT  > struct EpiBf16 {
    static constexpr bool PERM = true, AFTER_DRAIN = false; static constexpr int MIDK_T = 0;
    bf16_t* O; int ldc; const float* bias; int split_cols; size_t split_stride;
    __device__ __forceinline__ void operator()(const f32x4 (&acc)[2][2][4][2], const Unit& u, int wr, int wc, int fr, int fq) const {
        const int row0 = u.pm * BM + wr * 64 + fr; int colt = u.pn * BM; bf16_t* base = O;
        if (split_cols) { const int t = colt / split_cols; base += (size_t)t * split_stride; colt -= t * split_cols; }
        const int col0 = colt + wc * 32 + 8 * fq, bcol0 = u.pn * BM + wc * 32 + 8 * fq;
        f32x4 bv[2][2];
#pragma unroll
        for (int bj = 0; bj < 2; ++bj)
#pragma unroll
            for (int n = 0; n < 2; ++n) bv[bj][n] = bias ? *(const f32x4*)(bias + bcol0 + bj * HALF + 4 * n) : (f32x4){0.f, 0.f, 0.f, 0.f};
#pragma unroll
        for (int ai = 0; ai < 2; ++ai)
#pragma unroll
            for (int m = 0; m < 4; ++m) { bf16_t* rowp = base + (size_t)(row0 + ai * HALF + m * 16) * ldc + col0;
#pragma unroll
                for (int bj = 0; bj < 2; ++bj) { f32x4 v0 = acc[ai][bj][m][0] + bv[bj][0], v1 = acc[ai][bj][m][1] + bv[bj][1];
                    if (ACT == 1) { f32x2 a = gelu_pk((f32x2){v0[0], v0[1]}), b = gelu_pk((f32x2){v0[2], v0[3]}), c = gelu_pk((f32x2){v1[0], v1[1]}), d = gelu_pk((f32x2){v1[2], v1[3]});
                        v0 = (f32x4){a.x, a.y, b.x, b.y}; v1 = (f32x4){c.x, c.y, d.x, d.y}; }
                    if (ACT == 2) {
#pragma unroll
                        for (int j = 0; j < 4; ++j) { v0[j] = 0.5f * v0[j] * (1.0f + erff(v0[j] * 0.70710678f)); v1[j] = 0.5f * v1[j] * (1.0f + erff(v1[j] * 0.70710678f)); } }
                    u32x4 w; w.x = cvt_pk_bf16(v0[0], v0[1]); w.y = cvt_pk_bf16(v0[2], v0[3]); w.z = cvt_pk_bf16(v1[0], v1[1]); w.w = cvt_pk_bf16(v1[2], v1[3]);
                    *(u32x4*)(rowp + bj * HALF) = w; } }
    }
};

template <class Epi, class Sched, bool STAMP = false>
__device__ __forceinline__ void gemm_phase(int wv, PG8_LAS unsigned char* lds, const Gemm g, const Sched& S, const Epi& E, unsigned long long* stamps) {
    const int tid = otid(wv), wid = __builtin_amdgcn_readfirstlane(tid >> 6), lane = tid & 63, wr = wid >> 2, wc = wid & 3, fr = lane & 15, fq = lane >> 4;
    const int K = g.K, nt = K / BK;
    int ts_lo = 0, ts_hi = 0, nts = 0; const unsigned long long rt_entry = STAMP ? (unsigned long long)wall_clock64() : 0ull;
#define PG8_STAMP() do { if (STAMP && wid == 0 && nts < 64) { const unsigned long long _c = (unsigned long long)clock64(); \
        ts_lo = (lane == nts) ? (int)(unsigned)_c : ts_lo; ts_hi = (lane == nts) ? (int)(unsigned)(_c >> 32) : ts_hi; ++nts; } } while (0)
    PG8_STAMP();
    unsigned voffA[2], voffB[2];
#pragma unroll
    for (int i = 0; i < 2; ++i) { int R, C; stage_rc(tid * 16 + i * 8192, R, C); const int Rb = Epi::PERM ? ((R & ~31) + perm32(R & 31)) : R;
        voffA[i] = (unsigned)(R * K + C) * 2u; voffB[i] = (unsigned)(Rb * K + C) * 2u; }
    const size_t kstep = (size_t)(BK * 2);
    const size_t hstep = (size_t)HALF * K * 2;
    const size_t tstep = 2 * hstep;
    const unsigned ldsw = (unsigned)wid * 1024u;
    const int aoff = lds_byte(wr * 64 + fr, fq * 8), boff = lds_byte(wc * 32 + fr, fq * 8);
#define PG8_SA(b, h) (((b) * 2 + (h)) * HTB)
#define PG8_SB(b, h) ((4 + (b) * 2 + (h)) * HTB)
#define PG8_STAGE(bufoff, gbase, voff) do { _Pragma("unroll") for (int _i = 0; _i < 2; ++_i) \
        __builtin_amdgcn_global_load_lds((const unsigned*)((const char*)(gbase) + (voff)[_i]), (PG8_LAS unsigned*)(lds + (bufoff) + ldsw + _i * 8192), 16, 0, 0); } while (0)
#define PG8_LDA(dst, b, h) do { _Pragma("unroll") for (int m = 0; m < 4; ++m) _Pragma("unroll") for (int k = 0; k < 2; ++k) dst[m][k] = *(const PG8_LAS bf16x8*)(lds + PG8_SA(b, h) + aoff + m * 2048 + k * 1024); } while (0)
#define PG8_LDB(dst, b, h) do { _Pragma("unroll") for (int n = 0; n < 2; ++n) _Pragma("unroll") for (int k = 0; k < 2; ++k) dst[n][k] = *(const PG8_LAS bf16x8*)(lds + PG8_SB(b, h) + boff + n * 2048 + k * 1024); } while (0)
#define PG8_MMA(ai, bj, At, Bt) do { __builtin_amdgcn_s_setprio(1); _Pragma("unroll") for (int m = 0; m < 4; ++m) _Pragma("unroll") for (int n = 0; n < 2; ++n) _Pragma("unroll") for (int k = 0; k < 2; ++k) \
        acc[ai][bj][m][n] = __builtin_amdgcn_mfma_f32_16x16x32_bf16(Bt[n][k], At[m][k], acc[ai][bj][m][n], 0, 0, 0); __builtin_amdgcn_s_setprio(0); } while (0)
#define PG8_WAIT_V(n) asm volatile("s_waitcnt vmcnt(" #n ")" ::: "memory")
#define PG8_WAIT_L(n) asm volatile("s_waitcnt lgkmcnt(" #n ")" ::: "memory")
#define PG8_BAR __builtin_amdgcn_s_barrier()
#define PG8_SCHED __builtin_amdgcn_sched_barrier(0)
    Unit cur, nxt; int ui = 0;
    if (!S.next(0, cur)) return;
    f32x4 acc[2][2][4][2];
#pragma unroll
    for (int a = 0; a < 2; ++a)
#pragma unroll
        for (int b = 0; b < 2; ++b)
#pragma unroll
            for (int m = 0; m < 4; ++m)
#pragma unroll
                for (int n = 0; n < 2; ++n) acc[a][b][m][n] = (f32x4){0.f, 0.f, 0.f, 0.f};
    bf16x8 At[4][2], B0[2][2], B1[2][2];
    const char* cA = (const char*)g.A + (size_t)cur.pm * tstep; const char* cB = (const char*)g.Bt + (size_t)cur.pn * tstep;
    S.a_ready(cur);
    PG8_STAGE(PG8_SB(0, 0), cB, voffB); PG8_STAGE(PG8_SA(0, 0), cA, voffA); PG8_STAGE(PG8_SB(0, 1), cB + hstep, voffB); PG8_STAGE(PG8_SA(0, 1), cA + hstep, voffA);
    if (wr == 1) PG8_BAR;
    PG8_WAIT_V(4); PG8_BAR;
    PG8_STAGE(PG8_SB(1, 0), cB + kstep, voffB); PG8_STAGE(PG8_SA(1, 0), cA + kstep, voffA); PG8_STAGE(PG8_SB(1, 1), cB + hstep + kstep, voffB);
    PG8_WAIT_V(6); PG8_BAR;
    PG8_STAMP();
    for (;;) {
        const bool has_next = S.next(ui + 1, nxt);
        const char* nA = has_next ? (const char*)g.A + (size_t)nxt.pm * tstep : cA; const char* nB = has_next ? (const char*)g.Bt + (size_t)nxt.pn * tstep : cB;
        for (int t = 0; t < nt; t += 2) {
            if constexpr (Epi::MIDK_T > 0) { if (t == Epi::MIDK_T) E.midk(acc, cur, wr, wc, fr, fq); }
            const bool last = (t == nt - 2);
            const char* a1 = cA + (size_t)(t + 1) * kstep;
            const char* a2 = last ? nA : cA + (size_t)(t + 2) * kstep; const char* b2 = last ? nB : cB + (size_t)(t + 2) * kstep;
            const char* a3 = a2 + kstep; const char* b3 = b2 + kstep;
            if (last && has_next) S.a_ready(nxt);
            PG8_LDB(B0, 0, 0); PG8_SCHED; PG8_LDA(At, 0, 0); PG8_STAGE(PG8_SA(1, 1), a1 + hstep, voffA);
            PG8_WAIT_L(8); PG8_BAR; PG8_WAIT_L(0); PG8_MMA(0, 0, At, B0); PG8_BAR; PG8_SCHED;
            PG8_LDB(B1, 0, 1); PG8_STAGE(PG8_SB(0, 0), b2, voffB);
            PG8_BAR; PG8_WAIT_L(0); PG8_MMA(0, 1, At, B1); PG8_BAR;
            PG8_LDA(At, 0, 1); PG8_STAGE(PG8_SA(0, 0), a2, voffA);
            PG8_BAR; PG8_WAIT_L(0); PG8_MMA(1, 0, At, B0); PG8_BAR; PG8_SCHED;
            PG8_STAGE(PG8_SB(0, 1), b2 + hstep, voffB);
            PG8_WAIT_V(6); PG8_BAR; PG8_MMA(1, 1, At, B1); PG8_BAR;
            PG8_LDB(B0, 1, 0); PG8_SCHED; PG8_LDA(At, 1, 0); PG8_STAGE(PG8_SA(0, 1), a2 + hstep, voffA);
            PG8_WAIT_L(8); PG8_BAR; PG8_WAIT_L(0); PG8_MMA(0, 0, At, B0); PG8_BAR; PG8_SCHED;
            PG8_LDB(B1, 1, 1); PG8_STAGE(PG8_SB(1, 0), b3, voffB);
            PG8_BAR; PG8_WAIT_L(0); PG8_MMA(0, 1, At, B1); PG8_BAR;
            PG8_LDA(At, 1, 1); PG8_STAGE(PG8_SA(1, 0), a3, voffA);
            PG8_BAR; PG8_WAIT_L(0); PG8_MMA(1, 0, At, B0); PG8_BAR; PG8_SCHED;
            PG8_STAGE(PG8_SB(1, 1), b3 + hstep, voffB);
            PG8_WAIT_V(6); PG8_BAR; PG8_MMA(1, 1, At, B1); PG8_BAR;
        }
        PG8_STAMP();
        if constexpr (!Epi::AFTER_DRAIN) { E(acc, cur, wr, wc, fr, fq); S.done(cur); }
        PG8_STAMP();
        if (!has_next) break;
#pragma unroll
        for (int a = 0; a < 2; ++a)
#pragma unroll
            for (int b = 0; b < 2; ++b)
#pragma unroll
                for (int m = 0; m < 4; ++m)
#pragma unroll
                    for (int n = 0; n < 2; ++n) acc[a][b][m][n] = (f32x4){0.f, 0.f, 0.f, 0.f};
        cur = nxt; cA = nA; cB = nB; ++ui;
    }
    PG8_WAIT_V(0);
    if (wr == 0) PG8_BAR;
    PG8_BAR;
    if constexpr (Epi::AFTER_DRAIN) { E.fused(acc, cur, wr, wc, fr, fq, lds, wid, lane); S.done(cur); }
    PG8_STAMP();
    if (STAMP && wid == 0) { stamps[lane] = lane < nts ? (((unsigned long long)(unsigned)ts_hi << 32) | (unsigned)ts_lo) : 0ull;
        if (lane == 62) stamps[62] = rt_entry; if (lane == 63) stamps[63] = (unsigned long long)wall_clock64(); }
#undef PG8_STAMP
#undef PG8_SA
#undef PG8_SB
#undef PG8_STAGE
#undef PG8_LDA
#undef PG8_LDB
#undef PG8_MMA
#undef PG8_WAIT_V
#undef PG8_WAIT_L
#undef PG8_BAR
#undef PG8_SCHED
}
}

#define XB_TMO      128
#define XB_XCNT(j)  (256  + 64 * (j))
#define XB_XSUB(j)  (1280 + 64 * (j))
#define XB_XGEN(j)  (2304 + 64 * (j))
#define XB_TOP      3328
#define XB_TOPGEN   3392
#define XCD_BAR_WORDS 3456
#define XB_SPIN_CAP (1u << 27)
#define LAS __attribute__((address_space(3)))

__device__ __forceinline__ unsigned xb_ld(unsigned* p)              { return __hip_atomic_load(p, __ATOMIC_RELAXED, __HIP_MEMORY_SCOPE_AGENT); }
__device__ __forceinline__ unsigned xb_add(unsigned* p, unsigned v) { return __hip_atomic_fetch_add(p, v, __ATOMIC_RELAXED, __HIP_MEMORY_SCOPE_AGENT); }
__device__ __forceinline__ unsigned xb_xcc_id() { return (unsigned)__builtin_amdgcn_s_getreg((3 << 11) | 20) & 0xFu; }
#define XB_SPIN(cond, bar) do { unsigned _sp = 0; while (cond) { __builtin_amdgcn_s_sleep(1); \
    if ((++_sp & 255u) == 0u) { if (xb_ld(&(bar)[XB_TMO])) break; if (_sp > XB_SPIN_CAP) { atomicAdd(&(bar)[XB_TMO], 1u); break; } } } } while (0)

struct XcdBarrier {
    unsigned* bar; unsigned x;
    volatile LAS unsigned* st;
};

__device__ __forceinline__ XcdBarrier xcd_barrier_post(unsigned* bar, volatile LAS unsigned* st, bool xb_t0) {
    XcdBarrier b; b.bar = bar; b.x = xb_xcc_id(); b.st = st;
    if (xb_t0) (void)xb_add(&bar[XB_XCNT(b.x)], 1u);
    return b;
}
__device__ __forceinline__ void xcd_barrier_complete(unsigned* bar, unsigned x, unsigned& nloc, unsigned& nx) {
    const unsigned G = gridDim.x * gridDim.y * gridDim.z;
    unsigned sum, cnt, mine, sp = 0u;
    for (;;) {
        sum = 0u; cnt = 0u; mine = 0u;
#pragma unroll
        for (unsigned j = 0; j < 16; ++j) { const unsigned c = xb_ld(&bar[XB_XCNT(j)]); sum += c; cnt += (c > 0u) ? 1u : 0u; mine = (j == x) ? c : mine; }
        if (sum == G) break;
        __builtin_amdgcn_s_sleep(1);
        if ((++sp & 255u) == 0u) { if (xb_ld(&bar[XB_TMO])) break; if (sp > XB_SPIN_CAP) { atomicAdd(&bar[XB_TMO], 1u); break; } }
    }
    nloc = mine > 0u ? mine : 1u; nx = cnt > 0u ? cnt : 1u;
}

__device__ __forceinline__ void xcd_barrier(const XcdBarrier& b, bool xb_t0) {
    asm volatile("s_waitcnt vmcnt(0)" ::: "memory");
    __syncthreads();
    if (xb_t0) {
        unsigned* bar = b.bar;
        __builtin_amdgcn_s_waitcnt(0);
        unsigned nloc = b.st[0], nx = b.st[1];
        if (nloc == 0u) { xcd_barrier_complete(bar, b.x, nloc, nx); b.st[0] = nloc; b.st[1] = nx; }
        const unsigned old = xb_add(&bar[XB_XSUB(b.x)], 1u);
        const unsigned gen = old / nloc;
        if (old + 1u == (gen + 1u) * nloc) {
            __builtin_amdgcn_fence(__ATOMIC_RELEASE, "agent");
            asm volatile("s_waitcnt vmcnt(0)" ::: "memory");
            const unsigned og = xb_add(&bar[XB_TOP], 1u);
            const unsigned tg = og / nx;
            if (og + 1u == (tg + 1u) * nx) xb_add(&bar[XB_TOPGEN], 1u);
            else XB_SPIN(xb_ld(&bar[XB_TOPGEN]) == tg, bar);
            __builtin_amdgcn_fence(__ATOMIC_ACQUIRE, "agent");
            xb_add(&bar[XB_XGEN(b.x)], 1u);
            asm volatile("s_waitcnt vmcnt(0)" ::: "memory");
        } else {
            XB_SPIN(xb_ld(&bar[XB_XGEN(b.x)]) == gen, bar);
            __builtin_amdgcn_fence(__ATOMIC_ACQUIRE, "agent");
            asm volatile("s_waitcnt vmcnt(0)" ::: "memory");
        }
    }
    __syncthreads();
}


__device__ void ph_transpose(int wv, const float* __restrict__ src, bf16_t* __restrict__ dst, int K, int N, int Npad,
                             int col0, int skip_from, int skip, int nvalid, float* tile, int bid, int nb,
                             const float* kscale = nullptr, int kscale_n = 0) {
  const int tk = K / 64, tn = Npad / 64;
  const int tid = otid(wv);
  for (int t = bid; t < tk * tn; t += nb) {
    const int kt = t / tn, nt = t % tn;
    __syncthreads();
#pragma unroll
    for (int i = 0; i < 2; ++i) {
      const int idx = tid + i * 512, kk = idx >> 4, n4 = (idx & 15) * 4;
      const int k = kt * 64 + kk, n = nt * 64 + n4;
      const int cc = col0 + n + (n >= skip_from ? skip : 0);
      const float ks = (kscale != nullptr && k < kscale_n) ? kscale[k] : 1.f;
      float4 v = make_float4(0.f, 0.f, 0.f, 0.f);
      if (n < nvalid) v = *(const float4*)(src + (size_t)k * N + cc);
      tile[kk * 65 + n4 + 0] = v.x * ks; tile[kk * 65 + n4 + 1] = v.y * ks; tile[kk * 65 + n4 + 2] = v.z * ks; tile[kk * 65 + n4 + 3] = v.w * ks;
    }
    __syncthreads();
    {
      const int nn = tid >> 3, k8 = (tid & 7) * 8;
      float f[8];
#pragma unroll
      for (int e = 0; e < 8; ++e) f[e] = tile[(k8 + e) * 65 + nn];
      *(uint4*)(dst + (size_t)(nt * 64 + nn) * K + kt * 64 + k8) = make_uint4(pack2(f[0], f[1]), pack2(f[2], f[3]), pack2(f[4], f[5]), pack2(f[6], f[7]));
    }
  }
}

__device__ void ph_mod(int wv, const Params& P, float* sm, int bid, int nb) {
  const int tid = otid(wv);
  float* sv = sm;
  float* red = sm + 5 * 1024;
  for (int i = tid; i < 5 * 1024; i += NTHR) {
    const float v = (i < 4096) ? P.c[i] : P.c_ctx[i - 4096];
    sv[i] = silu_f(v);
  }
  __syncthreads();
  const int c4 = tid & 15, kg = tid >> 4;
  for (int it = bid; it < 192; it += nb) {
    const int layer = it / 96, cb = it % 96;
    const float4* W = (const float4*)(P.ada_w + (size_t)layer * 1024 * MODW + cb * 64) + c4;
    float4 a[5];
#pragma unroll
    for (int r = 0; r < 5; ++r) a[r] = make_float4(0.f, 0.f, 0.f, 0.f);
#pragma unroll 8
    for (int kk = 0; kk < 32; ++kk) {
      const int k = kg * 32 + kk;
      const float4 w = W[(size_t)k * (MODW / 4)];
#pragma unroll
      for (int r = 0; r < 5; ++r) {
        const float s = sv[r * 1024 + k];
        a[r].x += s * w.x; a[r].y += s * w.y; a[r].z += s * w.z; a[r].w += s * w.w;
      }
    }
#pragma unroll
    for (int r = 0; r < 5; ++r) *(float4*)(red + ((kg * 16 + c4) * 5 + r) * 4) = a[r];
    __syncthreads();
    if (tid < 320) {
      const int r = tid >> 6, c = tid & 63;
      float s = 0.f;
      for (int g = 0; g < 32; ++g) s += red[((g * 16 + (c >> 2)) * 5 + r) * 4 + (c & 3)];
      P.mod()[(size_t)(layer * 5 + r) * MODW + cb * 64 + c] = s + P.ada_b[layer * MODW + cb * 64 + c];
    }
    __syncthreads();
  }
}

__device__ void ph_norm(int wv, const float* hl, const float* hc, const float* __restrict__ g, const float* __restrict__ modl,
                        int shift_off, int scale_off, int nrows, bf16_t* __restrict__ dst, int bid, int nb) {
  const int wave = otid(wv) >> 6, lane = otid(wv) & 63;
  const int stride = nb * NWAVE;
  for (int row0 = bid * NWAVE + wave; row0 < nrows; row0 += 2 * stride) {
    const int row1 = row0 + stride;
    const bool two = row1 < nrows;
    const int rows[2] = {row0, two ? row1 : row0};
    f32x4 v[2][4], ggv[4], scv[2][4], shv[2][4];
#pragma unroll
    for (int r = 0; r < 2; ++r) {
      const float* src = hrow(hl, hc, rows[r]);
      const float* mr = modl + (size_t)modrow(rows[r]) * MODW;
#pragma unroll
      for (int i = 0; i < 4; ++i) {
        const int idx = i * 256 + lane * 4;
        v[r][i] = *(const f32x4*)(src + idx);
        scv[r][i] = *(const f32x4*)(mr + scale_off + idx); shv[r][i] = *(const f32x4*)(mr + shift_off + idx);
      }
    }
#pragma unroll
    for (int i = 0; i < 4; ++i) ggv[i] = *(const f32x4*)(g + i * 256 + lane * 4);
#pragma unroll
    for (int r = 0; r < 2; ++r)
#pragma unroll
      for (int i = 0; i < 4; ++i) asm volatile("" : "+v"(v[r][i]), "+v"(scv[r][i]), "+v"(shv[r][i]));
#pragma unroll
    for (int r = 0; r < 2; ++r) {
      float ss = 0.f;
#pragma unroll
      for (int i = 0; i < 4; ++i) ss += v[r][i][0] * v[r][i][0] + v[r][i][1] * v[r][i][1] + v[r][i][2] * v[r][i][2] + v[r][i][3] * v[r][i][3];
      ss = wave_sum(ss);
      const float rstd = rsqrtf(ss * (1.f / 1024.f) + 1e-6f);
      if (r == 0 || two) {
#pragma unroll
        for (int i = 0; i < 4; ++i) {
          const int idx = i * 256 + lane * 4;
          const float o0 = v[r][i][0] * rstd * ggv[i][0] * (1.f + scv[r][i][0]) + shv[r][i][0];
          const float o1 = v[r][i][1] * rstd * ggv[i][1] * (1.f + scv[r][i][1]) + shv[r][i][1];
          const float o2 = v[r][i][2] * rstd * ggv[i][2] * (1.f + scv[r][i][2]) + shv[r][i][2];
          const float o3 = v[r][i][3] * rstd * ggv[i][3] * (1.f + scv[r][i][3]) + shv[r][i][3];
          *(uint2*)(dst + (size_t)rows[r] * DM + idx) = make_uint2(pack2(o0, o1), pack2(o2, o3));
        }
      }
    }
  }
}

__device__ void ph_conv(int wv, const Params& P, int layer, int bid, int nb) {
  const float* cw = P.conv_w + (size_t)layer * 3 * 1536;
  const float* cb = P.conv_b + (size_t)layer * 1536;
  const int total = (NTOK / 4) * 192;
  for (int it = bid * NTHR + otid(wv); it < total; it += nb * NTHR) {
    const int rq = it / 192, c8 = (it % 192) * 8, row0 = rq * 4;
    int l, L;
    if (row0 < NLAT) { l = row0 & 4095; L = 4096; } else { l = (row0 - NLAT) & 255; L = 256; }
    const bf16_t* pc = P.p() + (size_t)row0 * PW + OFF_XBC + c8;
    u32x4_t rv[6];
    rv[0] = *(const u32x4_t*)(pc - (l > 0 ? PW : 0));
#pragma unroll
    for (int i = 0; i < 4; ++i) rv[1 + i] = *(const u32x4_t*)(pc + (size_t)i * PW);
    rv[5] = *(const u32x4_t*)(pc + (size_t)(l + 4 < L ? 4 : 3) * PW);
#pragma unroll
    for (int i = 0; i < 6; ++i) asm volatile("" : "+v"(rv[i]));
    float f[6][8];
#pragma unroll
    for (int i = 0; i < 6; ++i) unpack8(make_uint4(rv[i].x, rv[i].y, rv[i].z, rv[i].w), f[i]);
    const float mp = l > 0 ? 1.f : 0.f, mn = l + 4 < L ? 1.f : 0.f;
    float o[4][8];
#pragma unroll
    for (int e = 0; e < 8; ++e) {
      const int c = c8 + e;
      const float w0 = cw[c], w1 = cw[1536 + c], w2 = cw[3072 + c], bb = cb[c];
#pragma unroll
      for (int i = 0; i < 4; ++i) {
        const float pv = i == 0 ? mp * f[0][e] : f[i][e];
        const float nv = i == 3 ? mn * f[5][e] : f[i + 2][e];
        o[i][e] = silu_f(bb + w0 * pv + w1 * f[i + 1][e] + w2 * nv);
      }
    }
    if (c8 < 1024) {
      const int head = c8 >> 6, p0 = c8 & 63;
      bf16_t* dst = P.xt4() + (((size_t)head * (NTOK / 4) + rq) * 64 + p0) * 4;
#pragma unroll
      for (int e2 = 0; e2 < 4; ++e2)
        *(uint4*)(dst + e2 * 8) = make_uint4(pack2(o[0][2 * e2], o[1][2 * e2]), pack2(o[2][2 * e2], o[3][2 * e2]),
                                             pack2(o[0][2 * e2 + 1], o[1][2 * e2 + 1]), pack2(o[2][2 * e2 + 1], o[3][2 * e2 + 1]));
    } else {
      {
        const int cc = (c8 - 1024) & 255, grp_ = cc >> 7, n0_ = cc & 127;
        bf16_t* fb = (c8 < 1280 ? P.bfr() : P.cfr()) + ((((size_t)grp_ * (NTOK / 16) + (row0 >> 4)) * 4 + (n0_ >> 5)) * 16 + (row0 & 15)) * 32 + (n0_ & 31);
#pragma unroll
        for (int i = 0; i < 4; ++i)
          *(uint4*)(fb + i * 32) = make_uint4(pack2(o[i][0], o[i][1]), pack2(o[i][2], o[i][3]), pack2(o[i][4], o[i][5]), pack2(o[i][6], o[i][7]));
      }
      if (c8 < 1280) {
        const int grp = (c8 - 1024) >> 7, n0 = (c8 - 1024) & 127;
        bf16_t* dst = P.bt4() + (((size_t)grp * (NTOK / 4) + rq) * 128 + n0) * 4;
#pragma unroll
        for (int e2 = 0; e2 < 4; ++e2)
          *(uint4*)(dst + e2 * 8) = make_uint4(pack2(o[0][2 * e2], o[1][2 * e2]), pack2(o[2][2 * e2], o[3][2 * e2]),
                                               pack2(o[0][2 * e2 + 1], o[1][2 * e2 + 1]), pack2(o[2][2 * e2 + 1], o[3][2 * e2 + 1]));
      }
    }
  }
}

__device__ void ph_dtprep(int wv, const Params& P, int layer, char* smem, int first, int step) {
  const int tid = otid(wv), lane = tid & 63, li = lane & 15, g = lane >> 4;
  float* tile = (float*)smem;
  float* segtot = tile + 128 * 33;
  const int dh = tid & 31, seg = tid >> 5;
  const float bias = P.dt_bias[layer * 32 + dh];
  const float ah = -expf(P.a_log[layer * 32 + dh]);
  const bf16_t* wb = P.w_dtT() + (size_t)layer * 128 * 1024 + (size_t)li * 1024 + 8 * g;
  for (int gc = first; gc < NCHUNK; gc += step) {
    const bf16_t* ua = P.u() + (size_t)(gc * 128 + wv * 16 + li) * DM + 8 * g;
    f32x4 acc0 = (f32x4){0.f, 0.f, 0.f, 0.f}, acc1 = acc0;
#pragma unroll 1
    for (int t0 = 0; t0 < 32; t0 += 8) {
      bf16x8 a[8], b0[8], b1[8];
#pragma unroll
      for (int t = 0; t < 8; ++t) {
        a[t] = *(const bf16x8*)(ua + 32 * (t0 + t));
        b0[t] = *(const bf16x8*)(wb + 32 * (t0 + t));
        b1[t] = *(const bf16x8*)(wb + 16 * 1024 + 32 * (t0 + t));
      }
#pragma unroll
      for (int t = 0; t < 8; ++t) asm volatile("" : "+v"(a[t]), "+v"(b0[t]), "+v"(b1[t]));
#pragma unroll
      for (int t = 0; t < 8; ++t) {
        acc0 = __builtin_amdgcn_mfma_f32_16x16x32_bf16(a[t], b0[t], acc0, 0, 0, 0);
        acc1 = __builtin_amdgcn_mfma_f32_16x16x32_bf16(a[t], b1[t], acc1, 0, 0, 0);
      }
    }
    __syncthreads();
#pragma unroll
    for (int e = 0; e < 4; ++e) {
      tile[(wv * 16 + 4 * g + e) * 33 + li] = acc0[e];
      tile[(wv * 16 + 4 * g + e) * 33 + 16 + li] = acc1[e];
    }
    __syncthreads();
    float r[8], c[8];
    float cs = 0.f;
#pragma unroll
    for (int j = 0; j < 8; ++j) { r[j] = softplus_f(tile[(seg * 8 + j) * 33 + dh] + bias); cs += r[j] * ah; c[j] = cs; }
    segtot[seg * 32 + dh] = cs;
    __syncthreads();
    float off = 0.f, tot = 0.f;
    for (int s = 0; s < 16; ++s) { const float v = segtot[s * 32 + dh]; if (s < seg) off += v; tot += v; }
    const size_t base = ((size_t)(gc * 32 + dh) * 128 + seg * 8);
    float cso[8], wso[8];
#pragma unroll
    for (int j = 0; j < 8; ++j) {
      const float csj = off + c[j], csp = j == 0 ? off : off + c[j - 1];
      cso[j] = dh < 16 ? csj : csp;
      wso[j] = r[j] * (dh < 16 ? fexp(tot - csj) : fexp(csp));
    }
#pragma unroll
    for (int q = 0; q < 2; ++q) {
      *(float4*)(P.cst() + base + q * 4) = make_float4(cso[q * 4], cso[q * 4 + 1], cso[q * 4 + 2], cso[q * 4 + 3]);
      *(float4*)(P.dtt() + base + q * 4) = make_float4(r[q * 4], r[q * 4 + 1], r[q * 4 + 2], r[q * 4 + 3]);
      *(float4*)(P.wst() + base + q * 4) = make_float4(wso[q * 4], wso[q * 4 + 1], wso[q * 4 + 2], wso[q * 4 + 3]);
    }
    if (seg == 0) P.atot()[gc * 32 + dh] = tot;
  }
}

__device__ __forceinline__ int scan_chunk(int b, int dir, int s) {
  if (dir == 0) return (s < 2) ? (128 + 2 * b + s) : (32 * b + (s - 2));
  return (s < 2) ? (128 + 2 * b + 1 - s) : (32 * b + 31 - (s - 2));
}
__device__ void ph_scan(int wv, const Params& P, int bid, int nb) {
  const int total = 4 * 32 * 1024;
  for (int it = bid * NTHR + otid(wv); it < total; it += nb * NTHR) {
    const int e8 = it & 1023, dh = (it >> 10) & 31, b = it >> 15, dir = dh >> 4;
    float S[8];
    float zero_ = 0.f;
    asm volatile("" : "+v"(zero_));
#pragma unroll
    for (int i = 0; i < 8; ++i) S[i] = zero_;
#pragma unroll
    for (int hb = 0; hb < 2; ++hb) {
      u32x4_t v[17];
      float at[17];
#pragma unroll
      for (int s = 0; s < 17; ++s) {
        const int gc = scan_chunk(b, dir, hb * 17 + s);
        v[s] = *(const u32x4_t*)(P.states() + (size_t)(gc * 32 + dh) * 8192 + e8 * 8);
        at[s] = P.atot()[gc * 32 + dh];
      }
#pragma unroll
      for (int s = 0; s < 17; ++s) asm volatile("" : "+v"(v[s]));
#pragma unroll
      for (int s = 0; s < 17; ++s) {
        const int gc = scan_chunk(b, dir, hb * 17 + s);
        const float dec = fexp(at[s]);
        float cst[8];
        unpack8(make_uint4(v[s].x, v[s].y, v[s].z, v[s].w), cst);
        *(uint4*)(P.states() + (size_t)(gc * 32 + dh) * 8192 + e8 * 8) =
            make_uint4(pack2(S[0], S[1]), pack2(S[2], S[3]), pack2(S[4], S[5]), pack2(S[6], S[7]));
#pragma unroll
        for (int i = 0; i < 8; ++i) S[i] = dec * S[i] + cst[i];
      }
    }
  }
}

__device__ __forceinline__ void conv_x8(const Params& P, int layer, int row, int ch0, float* out) {
  int l, L;
  if (row < NLAT) { l = row & 4095; L = 4096; } else { l = (row - NLAT) & 255; L = 256; }
  const bf16_t* pc = P.p() + (size_t)row * PW + OFF_XBC + ch0;
  const uint4 cur = *(const uint4*)pc;
  const uint4 prv = *(const uint4*)(pc - (l > 0 ? PW : 0));
  const uint4 nxt = *(const uint4*)(pc + (l < L - 1 ? PW : 0));
  const float mp = l > 0 ? 1.f : 0.f, mn = l < L - 1 ? 1.f : 0.f;
  float fp[8], fc[8], fn[8];
  unpack8(prv, fp); unpack8(cur, fc); unpack8(nxt, fn);
  const float* cw = P.conv_w + (size_t)layer * 3 * 1536 + ch0;
  const float* cb = P.conv_b + (size_t)layer * 1536 + ch0;
#pragma unroll
  for (int e = 0; e < 8; ++e) out[e] = silu_f(cb[e] + cw[e] * (mp * fp[e]) + cw[1536 + e] * fc[e] + cw[3072 + e] * (mn * fn[e]));
}

constexpr int XS = 72;
constexpr int BS = 136;


__device__ __forceinline__ bool ssd_item(int round, int bid, int nb, int nchunks, int& gc, int& head) {
  if ((nb & 63) == 0) {
    const int x = bid & 7, j = bid >> 3, per = nb >> 6;
    const int cg = (round * per + (j >> 3)) * 8 + x;
    if (cg >= nchunks * 2) return false;
    gc = cg >> 1; head = (cg & 1) * 8 + (j & 7);
    return true;
  }
  const int it = round * nb + bid;
  if (it >= nchunks * 16) return false;
  gc = it >> 4; head = it & 15;
  return true;
}

__device__ void ph_states_mfma(int wv, const Params& P, int layer, char* smem, int bid, int nb) {
  const int lane = otid(wv) & 63, li = lane & 15, g = lane >> 4;
  const int nq = wv >> 1, ph = wv & 1;
  for (int round = 0;; ++round) {
    int gc, head;
    if (!ssd_item(round, bid, nb, NCHUNK, gc, head)) break;
    const int grp = head >> 3, q0 = gc * 32;
    const bf16_t* xb = P.xt4() + (((size_t)head * (NTOK / 4) + q0 + g) * 64 + ph * 32 + li) * 4;
    const bf16_t* bb = P.bt4() + (((size_t)grp * (NTOK / 4) + q0 + g) * 128 + nq * 32 + li) * 4;
    const float* wpf = P.wst() + (size_t)(gc * 32 + head) * 128 + 4 * g;
    const float* wpb = wpf + 16 * 128;
    f32x4 acc[2][2][2];
#pragma unroll
    for (int d = 0; d < 2; ++d)
#pragma unroll
      for (int a = 0; a < 2; ++a)
#pragma unroll
        for (int b = 0; b < 2; ++b) acc[d][a][b] = (f32x4){0.f, 0.f, 0.f, 0.f};
#pragma unroll
    for (int t = 0; t < 4; ++t) {
      s16x4 alo[2], ahi[2], xlo[2], xhi[2];
      f32x4 wfl, wfh, wbl, wbh;
#pragma unroll
      for (int i = 0; i < 2; ++i) {
        alo[i] = *(const s16x4*)(bb + ((size_t)(t * 8) * 128 + i * 16) * 4);
        ahi[i] = *(const s16x4*)(bb + ((size_t)(t * 8 + 4) * 128 + i * 16) * 4);
        xlo[i] = *(const s16x4*)(xb + ((size_t)(t * 8) * 64 + i * 16) * 4);
        xhi[i] = *(const s16x4*)(xb + ((size_t)(t * 8 + 4) * 64 + i * 16) * 4);
      }
      wfl = *(const f32x4*)(wpf + 32 * t); wfh = *(const f32x4*)(wpf + 32 * t + 16);
      wbl = *(const f32x4*)(wpb + 32 * t); wbh = *(const f32x4*)(wpb + 32 * t + 16);
      asm volatile("" : "+v"(alo[0]), "+v"(alo[1]), "+v"(ahi[0]), "+v"(ahi[1]));
      bf16x8 af[2];
#pragma unroll
      for (int i = 0; i < 2; ++i) af[i] = (bf16x8){alo[i][0], alo[i][1], alo[i][2], alo[i][3], ahi[i][0], ahi[i][1], ahi[i][2], ahi[i][3]};
#pragma unroll
      for (int d = 0; d < 2; ++d) {
        const f32x4 wl = d == 0 ? wfl : wbl, wh = d == 0 ? wfh : wbh;
#pragma unroll
        for (int b = 0; b < 2; ++b) {
          bf16x8 bfrag;
#pragma unroll
          for (int i = 0; i < 4; ++i) {
            bfrag[i] = (short)f2bf(bf2f((bf16_t)xlo[b][i]) * wl[i]);
            bfrag[4 + i] = (short)f2bf(bf2f((bf16_t)xhi[b][i]) * wh[i]);
          }
#pragma unroll
          for (int a = 0; a < 2; ++a) acc[d][a][b] = __builtin_amdgcn_mfma_f32_16x16x32_bf16(af[a], bfrag, acc[d][a][b], 0, 0, 0);
        }
      }
    }
#pragma unroll
    for (int d = 0; d < 2; ++d) {
      bf16_t* dst = P.states() + (size_t)(gc * 32 + d * 16 + head) * 8192;
#pragma unroll
      for (int a = 0; a < 2; ++a)
#pragma unroll
        for (int b = 0; b < 2; ++b) {
          uint2 o;
          o.x = pack2(acc[d][a][b][0], acc[d][a][b][1]); o.y = pack2(acc[d][a][b][2], acc[d][a][b][3]);
          *(uint2*)(dst + ((nq * 4 + 2 * ph + b) * 16 + li) * 32 + 16 * a + 4 * g) = o;
        }
    }
  }
}

__device__ void ph_ssdy_mfma(int wv, const Params& P, int layer, int nchunks, char* smem, int bid, int nb) {
  const int tid = otid(wv), lane = tid & 63, li = lane & 15, g = lane >> 4;
  float* tabs = (float*)smem;
  char* bbuf = smem + 4096;
  char* xbuf = bbuf + 65536;
  char* sbufS = xbuf + 32768;
  u32x4_t pf[10];
  float pft = 0.f;
#pragma unroll
  for (int i = 0; i < 10; ++i) pf[i] = (u32x4_t){0u, 0u, 0u, 0u};
#define SSDY_FETCH(gc_, head_) do { const int grp_ = (head_) >> 3; \
      const char* bsrc_ = (const char*)(P.bfr() + ((size_t)grp_ * (NTOK / 16) + (gc_) * 8) * 4 * 16 * 32); \
      const char* xsrc_ = (const char*)(P.xt4() + ((size_t)(head_) * (NTOK / 4) + (gc_) * 32) * 64 * 4); \
      _Pragma("unroll") for (int i_ = 0; i_ < 4; ++i_) pf[i_] = *(const u32x4_t*)(bsrc_ + (size_t)(tid + i_ * 512) * 16); \
      _Pragma("unroll") for (int i_ = 0; i_ < 2; ++i_) pf[4 + i_] = *(const u32x4_t*)(xsrc_ + (size_t)(tid + i_ * 512) * 16); \
      _Pragma("unroll") for (int i_ = 0; i_ < 4; ++i_) { const int c_ = tid + i_ * 512; \
        pf[6 + i_] = *(const u32x4_t*)((const char*)(P.states() + (size_t)((gc_) * 32 + (c_ >> 10) * 16 + (head_)) * 8192) + (size_t)(c_ & 1023) * 16); } \
      { const int arr_ = tid >> 7, j_ = tid & 127; \
        pft = ((arr_ & 1) ? P.dtt() : P.cst())[(size_t)((gc_) * 32 + (arr_ >> 1) * 16 + (head_)) * 128 + j_]; } } while (0)
#define SSDY_PUT_S() do { _Pragma("unroll") for (int i_ = 0; i_ < 4; ++i_) *(u32x4_t*)(sbufS + (size_t)(tid + i_ * 512) * 16) = pf[6 + i_]; } while (0)
#define SSDY_PUT_BX(buf_) do { \
      _Pragma("unroll") for (int i_ = 0; i_ < 4; ++i_) *(u32x4_t*)(bbuf + (buf_) * 32768 + (size_t)(tid + i_ * 512) * 16) = pf[i_]; \
      _Pragma("unroll") for (int i_ = 0; i_ < 2; ++i_) *(u32x4_t*)(xbuf + (buf_) * 16384 + (size_t)(tid + i_ * 512) * 16) = pf[4 + i_]; \
      tabs[(buf_) * 512 + tid] = pft; } while (0)
  {
    int gc0 = 0, head0 = 0;
    __syncthreads();
    if (ssd_item(0, bid, nb, nchunks, gc0, head0)) { SSDY_FETCH(gc0, head0); SSDY_PUT_BX(0); SSDY_PUT_S(); }
    __syncthreads();
  }
  for (int round = 0;; ++round) {
    int gc, head;
    if (!ssd_item(round, bid, nb, nchunks, gc, head)) break;
    const int grp = head >> 3, row0 = gc * 128;
    const char* bs = bbuf + (round & 1) * 32768;
    const char* xs_l = xbuf + (round & 1) * 16384;
    const float* csf = tabs + (round & 1) * 512;
    const float* dtf = csf + 128;
    const float* exb = csf + 256;
    const float* dtb = csf + 384;
    int gcn = 0, headn = 0;
    const bool has_next = ssd_item(round + 1, bid, nb, nchunks, gcn, headn);
    if (has_next) SSDY_FETCH(gcn, headn);
    const float atb = P.atot()[gc * 32 + 16 + head];
    bf16x8 cfrag[4];
    {
      const bf16_t* cp = P.cfr() + ((((size_t)grp * (NTOK / 16) + gc * 8 + wv) * 4) * 16 + li) * 32 + 8 * g;
#pragma unroll
      for (int t = 0; t < 4; ++t) cfrag[t] = *(const bf16x8*)(cp + t * 512);
    }
    f32x4 accG[8];
#pragma unroll
    for (int sb = 0; sb < 8; ++sb) accG[sb] = (f32x4){0.f, 0.f, 0.f, 0.f};
#pragma unroll
    for (int sp = 0; sp < 4; ++sp) {
      bf16x8 bfv[8];
#pragma unroll
      for (int i = 0; i < 8; ++i) {
        const int sb = sp * 2 + (i >> 2), t = i & 3;
        bfv[i] = *(const bf16x8*)(bs + (((sb * 4 + t) * 16 + li) * 32 + 8 * g) * 2);
      }
#pragma unroll
      for (int i = 0; i < 8; ++i) {
        const int sb = sp * 2 + (i >> 2), t = i & 3;
        accG[sb] = __builtin_amdgcn_mfma_f32_16x16x32_bf16(bfv[i], cfrag[t], accG[sb], 0, 0, 0);
      }
    }
    f32x4 accY[4];
#pragma unroll
    for (int pb = 0; pb < 4; ++pb) accY[pb] = (f32x4){0.f, 0.f, 0.f, 0.f};
    const int jl = 16 * wv + li;
    const float csf_j = csf[jl], exb_j = exb[jl];
#pragma unroll
    for (int dir = 0; dir < 2; ++dir) {
      f32x4 accO[4];
#pragma unroll
      for (int pb = 0; pb < 4; ++pb) accO[pb] = (f32x4){0.f, 0.f, 0.f, 0.f};
      const char* st = sbufS + dir * 16384;
#pragma unroll
      for (int th = 0; th < 2; ++th) {
        bf16x8 sfr[8];
#pragma unroll
        for (int i = 0; i < 8; ++i) sfr[i] = *(const bf16x8*)(st + (((th * 2 + (i >> 2)) * 4 + (i & 3)) * 512 + li * 32 + 8 * g) * 2);
#pragma unroll
        for (int tt = 0; tt < 2; ++tt)
#pragma unroll
          for (int pb = 0; pb < 4; ++pb) accO[pb] = __builtin_amdgcn_mfma_f32_16x16x32_bf16(cfrag[th * 2 + tt], sfr[tt * 4 + pb], accO[pb], 0, 0, 0);
      }
#pragma unroll
      for (int e = 0; e < 4; ++e) {
        const int j = 16 * wv + 4 * g + e;
        const float sc = dir == 0 ? fexp(csf[j]) : fexp(atb - exb[j]);
#pragma unroll
        for (int pb = 0; pb < 4; ++pb) accY[pb][e] += accO[pb][e] * sc;
      }
    }
    __syncthreads();
    if (has_next) SSDY_PUT_S();
    const char* xq = xs_l + ((g * 64 + li) * 4) * 2;
#pragma unroll
    for (int t = 0; t < 4; ++t) {
      const bool need_f = !(32 * t > 16 * wv + 15), need_b = !(32 * t + 31 < 16 * wv);
      if (!need_f && !need_b) continue;
      s16x4 xlo[4], xhi[4];
#pragma unroll
      for (int pb = 0; pb < 4; ++pb) {
        xlo[pb] = *(const s16x4*)(xq + (((8 * t) * 64 + 16 * pb) * 4) * 2);
        xhi[pb] = *(const s16x4*)(xq + (((8 * t + 4) * 64 + 16 * pb) * 4) * 2);
      }
#pragma unroll
      for (int dir = 0; dir < 2; ++dir) {
        if (dir == 0 ? !need_f : !need_b) continue;
        bf16x8 afrag;
#pragma unroll
        for (int hh = 0; hh < 2; ++hh) {
          const int s0 = 32 * t + 16 * hh + 4 * g;
          const f32x4 gv = accG[2 * t + hh];
          const f32x4 cv = dir == 0 ? *(const f32x4*)(csf + s0) : *(const f32x4*)(exb + s0);
          const f32x4 dv = dir == 0 ? *(const f32x4*)(dtf + s0) : *(const f32x4*)(dtb + s0);
#pragma unroll
          for (int e = 0; e < 4; ++e) {
            const int s = s0 + e;
            float m;
            if (dir == 0) m = (s <= jl) ? gv[e] * dv[e] * fexp(csf_j - cv[e]) : 0.f;
            else m = (s >= jl) ? gv[e] * dv[e] * fexp(cv[e] - exb_j) : 0.f;
            afrag[hh * 4 + e] = (short)f2bf(m);
          }
        }
#pragma unroll
        for (int pb = 0; pb < 4; ++pb) {
          const bf16x8 bfr2 = (bf16x8){xlo[pb][0], xlo[pb][1], xlo[pb][2], xlo[pb][3], xhi[pb][0], xhi[pb][1], xhi[pb][2], xhi[pb][3]};
          accY[pb] = __builtin_amdgcn_mfma_f32_16x16x32_bf16(afrag, bfr2, accY[pb], 0, 0, 0);
        }
      }
    }
    const float dsk = P.d_skip[layer * 16 + head];
    s16x4 xs[4];
#pragma unroll
    for (int pb = 0; pb < 4; ++pb) xs[pb] = *(const s16x4*)(xs_l + ((((4 * wv + g) * 64 + 16 * pb + li) * 4) * 2));
    unsigned zv[16];
#pragma unroll
    for (int e = 0; e < 4; ++e)
#pragma unroll
      for (int pb = 0; pb < 4; ++pb)
        zv[e * 4 + pb] = P.p()[(size_t)(row0 + 16 * wv + 4 * g + e) * PW + OFF_Z + head * 64 + 16 * pb + li];
#pragma unroll
    for (int i = 0; i < 16; ++i) asm volatile("" : "+v"(zv[i]));
#pragma unroll
    for (int e = 0; e < 4; ++e) {
      const int row = row0 + 16 * wv + 4 * g + e;
      float sq = 0.f;
#pragma unroll
      for (int pb = 0; pb < 4; ++pb) {
        const float xv = bf2f((bf16_t)xs[pb][e]);
        const float z = bf2f((bf16_t)zv[e * 4 + pb]);
        const bf16_t yb = f2bf((accY[pb][e] + dsk * xv) * silu_f(z));
        P.concat()[(size_t)row * 2048 + head * 64 + 16 * pb + li] = yb;
        const float yf = bf2f(yb);
        sq += yf * yf;
      }
      sq += DPP_F(sq, 0xB1); sq += DPP_F(sq, 0x4E); sq += DPP_F(sq, 0x141); sq += DPP_F(sq, 0x140);
      if (li == 0) P.yss()[(size_t)row * 16 + head] = sq;
    }
    if (has_next) SSDY_PUT_BX((round + 1) & 1);
    __syncthreads();
  }
#undef SSDY_FETCH
#undef SSDY_PUT_S
#undef SSDY_PUT_BX
}

template <int W>
__device__ __forceinline__ void pool_frags(const bf16_t* pc, int l, int L, float rc, bf16x8 (&af)[4]) {
#pragma unroll
  for (int t = 0; t < 4; ++t) {
    constexpr int WB = W < 8 ? W : 8;
    float s[8], f[8];
#pragma unroll
    for (int e = 0; e < 8; ++e) s[e] = 0.f;
    const u32x4_t own = *(const u32x4_t*)(pc + 32 * t);
#pragma unroll
    for (int ob = 0; ob < W; ob += WB) {
      u32x4_t rows[WB];
#pragma unroll
      for (int o = 0; o < WB; ++o) {
        const int rr = l - W / 2 + ob + o;
        const int rcl = (rr >= 0 && rr < L) ? rr : l;
        rows[o] = *(const u32x4_t*)(pc + (ptrdiff_t)(rcl - l) * PW + 32 * t);
      }
#pragma unroll
      for (int o = 0; o < WB; ++o) asm volatile("" : "+v"(rows[o]));
#pragma unroll
      for (int o = 0; o < WB; ++o) {
        const int rr = l - W / 2 + ob + o;
        const float mk = (rr >= 0 && rr < L) ? 1.f : 0.f;
        unpack8(make_uint4(rows[o].x, rows[o].y, rows[o].z, rows[o].w), f);
#pragma unroll
        for (int e = 0; e < 8; ++e) s[e] += mk * f[e];
      }
    }
    unpack8(make_uint4(own.x, own.y, own.z, own.w), f);
#pragma unroll
    for (int e = 0; e < 8; ++e) af[t][e] = (short)f2bf(s[e] * rc - f[e]);
  }
}
__device__ void ph_pool_mfma(int wv, const Params& P, int layer, int nrows, char* smem, int bid, int nb) {
  const int lane = otid(wv) & 63, li = lane & 15, g = lane >> 4;
  bf16_t* stg = (bf16_t*)(smem + 65536) + wv * (16 * 136);
  const int nitems = (nrows / 16) * 4;
  for (int it = bid * NWAVE + wv; it < nitems; it += nb * NWAVE) {
    const int gi = it & 3, row0 = (it >> 2) * 16, w = 2 << gi;
    const int row = row0 + li;
    int l, L;
    if (row < NLAT) { l = row & 4095; L = 4096; } else { l = (row - NLAT) & 255; L = 256; }
    int lo = l - w / 2; lo = lo < 0 ? 0 : lo;
    int hi = l + w - w / 2 - 1; hi = hi > L - 1 ? L - 1 : hi;
    const float rc = 1.f / (float)(hi - lo + 1);
    const bf16_t* pc = P.p() + (size_t)row * PW + OFF_POOL + gi * 128 + 8 * g;
    bf16x8 af[4];
    if (gi == 0) pool_frags<2>(pc, l, L, rc, af);
    else if (gi == 1) pool_frags<4>(pc, l, L, rc, af);
    else if (gi == 2) pool_frags<8>(pc, l, L, rc, af);
    else pool_frags<16>(pc, l, L, rc, af);
    const bf16_t* wt = P.poolwT() + ((size_t)(layer * 4 + gi) * 128 + li) * 128 + 8 * g;
    const float* sc = P.pool_scale + layer * 512 + gi * 128;
#pragma unroll
    for (int nh = 0; nh < 4; ++nh) {
      bf16x8 wf[2][4];
#pragma unroll
      for (int n = 0; n < 2; ++n)
#pragma unroll
        for (int t = 0; t < 4; ++t) wf[n][t] = *(const bf16x8*)(wt + (size_t)(nh * 2 + n) * 16 * 128 + 32 * t);
#pragma unroll
      for (int n = 0; n < 2; ++n)
#pragma unroll
        for (int t = 0; t < 4; ++t) asm volatile("" : "+v"(wf[n][t]));
#pragma unroll
      for (int n = 0; n < 2; ++n) {
        const int nt = nh * 2 + n;
        f32x4 acc = (f32x4){0.f, 0.f, 0.f, 0.f};
#pragma unroll
        for (int t = 0; t < 4; ++t) acc = __builtin_amdgcn_mfma_f32_16x16x32_bf16(af[t], wf[n][t], acc, 0, 0, 0);
        const float scv = sc[nt * 16 + li];
#pragma unroll
        for (int e = 0; e < 4; ++e) stg[(4 * g + e) * 136 + nt * 16 + li] = f2bf(acc[e] * scv);
      }
    }
    __builtin_amdgcn_wave_barrier();
#pragma unroll
    for (int i = 0; i < 4; ++i) {
      const int c = i * 64 + lane, rr = c >> 4, c8 = (c & 15) * 8;
      *(uint4*)(P.concat() + (size_t)(row0 + rr) * 2048 + 1024 + gi * 128 + c8) = *(const uint4*)(stg + rr * 136 + c8);
    }
    __builtin_amdgcn_wave_barrier();
  }
}

__device__ void ph_vtranspose(int wv, const Params& P, char* smem, int bid, int nb) {
  const int lane = otid(wv) & 63;
  bf16_t* tile = (bf16_t*)smem + wv * 64 * 72;
  for (int it = bid * NWAVE + wv; it < 272 * 8; it += nb * NWAVE) {
    const int hd = it & 7, tt = it >> 3, row0 = tt * 64;
    const bf16_t* src = P.p() + (size_t)(row0 + lane) * PW + OFF_V + hd * 64;
#pragma unroll
    for (int i = 0; i < 8; ++i) *(uint4*)(tile + lane * 72 + i * 8) = *(const uint4*)(src + i * 8);
    __builtin_amdgcn_wave_barrier();
    bf16_t* dst;
    if (row0 < NLAT) dst = P.vtl() + (size_t)((row0 >> 12) * 8 + hd) * 64 * 4096 + ((size_t)((row0 & 4095) >> 2) * 64 + lane) * 4;
    else dst = P.vtc() + (size_t)(((row0 - NLAT) >> 8) * 8 + hd) * 64 * 256 + ((size_t)(((row0 - NLAT) & 255) >> 2) * 64 + lane) * 4;
#pragma unroll
    for (int i = 0; i < 16; ++i) {
      uint2 w;
      w.x = (uint32_t)tile[(i * 4 + 0) * 72 + lane] | ((uint32_t)tile[(i * 4 + 1) * 72 + lane] << 16);
      w.y = (uint32_t)tile[(i * 4 + 2) * 72 + lane] | ((uint32_t)tile[(i * 4 + 3) * 72 + lane] << 16);
      *(uint2*)(dst + (size_t)i * 64 * 4) = w;
    }
    __builtin_amdgcn_wave_barrier();
    {
      const bf16_t* ksrc = P.p() + (size_t)(row0 + lane) * PW + OFF_K + hd * 64;
      u32x4_t kv[8];
#pragma unroll
      for (int i = 0; i < 8; ++i) kv[i] = *(const u32x4_t*)(ksrc + i * 8);
      bf16_t* kd;
      int tk;
      if (row0 < NLAT) { tk = (row0 & 4095) + lane; kd = P.ktl() + (size_t)((row0 >> 12) * 8 + hd) * 4096 * 64; }
      else { tk = ((row0 - NLAT) & 255) + lane; kd = P.ktc() + (size_t)(((row0 - NLAT) >> 8) * 8 + hd) * 256 * 64; }
#pragma unroll
      for (int i = 0; i < 8; ++i)
        *(u32x4_t*)(kd + ((size_t)((tk >> 3) * 2 + (i >> 2)) * 8 + (tk & 7)) * 32 + (i & 3) * 8) = kv[i];
    }
  }
}

__device__ __forceinline__ float grp_max(float v) {
  auto a = __builtin_amdgcn_permlane16_swap(__float_as_uint(v), __float_as_uint(v), false, false);
  v = fmaxf(__uint_as_float(a[0]), __uint_as_float(a[1]));
  auto b = __builtin_amdgcn_permlane32_swap(__float_as_uint(v), __float_as_uint(v), false, false);
  return fmaxf(__uint_as_float(b[0]), __uint_as_float(b[1]));
}
__device__ __forceinline__ float grp_sum(float v) {
  auto a = __builtin_amdgcn_permlane16_swap(__float_as_uint(v), __float_as_uint(v), false, false);
  v = __uint_as_float(a[0]) + __uint_as_float(a[1]);
  auto b = __builtin_amdgcn_permlane32_swap(__float_as_uint(v), __float_as_uint(v), false, false);
  return __uint_as_float(b[0]) + __uint_as_float(b[1]);
}

__device__ void ph_na_mfma(int wv, const Params& P, int layer, int nrows, char* smem, int bid, int nb) {
  const int lane = otid(wv) & 63, li = lane & 15, g = lane >> 4;
  float* btab = (float*)smem + wv * 256;
  const float* rpb = P.na_rpb + (size_t)layer * 8 * 15 * 31;
  const int n_lat = 4 * 64 * 8 * 4;
  const int n_items = n_lat + (nrows > NLAT ? 4 * 16 * 8 : 0);
  const int nrank = nb >> 3;
  const bool xmap = ((nb & 7) == 0) && nrank > 0 && (1024 % nrank) == 0 && (64 % nrank) == 0;
  const int per_lat = xmap ? 1024 / nrank : 0, per_ctx = (xmap && nrows > NLAT) ? 64 / nrank : 0;
  const int q_begin = xmap ? wv : bid * NWAVE + wv, q_end = xmap ? per_lat + per_ctx : n_items, q_step = xmap ? NWAVE : nb * NWAVE;
  for (int q = q_begin; q < q_end; q += q_step) {
    bool lat;
    int b, hd, qrow0, r = 0, cq0 = 0, r0 = 0, cs = 0, qt;
    if (xmap) {
      hd = bid & 7;
      const int rank = bid >> 3;
      lat = q < per_lat;
      if (lat) { const int i = rank * per_lat + q; qt = i & 3; r = (i >> 2) & 63; b = i >> 8; }
      else { const int c = rank * per_ctx + (q - per_lat); qt = c & 15; b = c >> 4; }
    } else {
      lat = q < n_lat;
      if (lat) { qt = q & 3; hd = (q >> 2) & 7; r = (q >> 5) & 63; b = q >> 11; }
      else { const int t = q - n_lat; hd = t & 7; qt = (t >> 3) & 15; b = t >> 7; }
    }
    if (lat) {
      cq0 = qt * 16; qrow0 = b * 4096 + r * 64 + cq0;
      r0 = r - 4; r0 = r0 < 0 ? 0 : (r0 > 56 ? 56 : r0);
      int clo = cq0 - 8; clo = clo < 0 ? 0 : (clo > 48 ? 48 : clo);
      cs = clo < 32 ? clo : 32;
    } else {
      qrow0 = NLAT + b * 256 + qt * 16;
    }
    const bf16_t* qp = P.p() + (size_t)(qrow0 + li) * PW + OFF_Q + hd * 64 + 8 * g;
    const bf16x8 qf0 = *(const bf16x8*)qp, qf1 = *(const bf16x8*)(qp + 32);
    __builtin_amdgcn_wave_barrier();
#pragma unroll
    for (int i = 0; i < 4; ++i) {
      const int e_ = i * 64 + lane, kr_ = e_ >> 5, dc_ = e_ & 31;
      int dr_ = r0 + kr_ - r + 7; dr_ = dr_ < 0 ? 0 : (dr_ > 14 ? 14 : dr_);
      btab[e_] = rpb[(hd * 15 + dr_) * 31 + (dc_ < 31 ? dc_ : 30)];
    }
    __builtin_amdgcn_wave_barrier();
    f32x4 accS[16], accC[16];
    const int k_lane = ((li >> 3) * 16 + (li & 7)) * 32 + 8 * g;
    const bf16_t* klb = P.ktl() + (size_t)(b * 8 + hd) * 4096 * 64 + k_lane;
    const bf16_t* kcb = P.ktc() + (size_t)(b * 8 + hd) * 256 * 64 + k_lane;
#define NA_KPTR(tile) ((tile) < 16 ? klb + ((r0 + ((tile) >> 1)) * 64 + cs + 16 * ((tile) & 1)) * 64 : kcb + (16 * ((tile) - 16)) * 64)
    bf16x8 kA[2][2], kB[2][2];
#pragma unroll
    for (int i = 0; i < 2; ++i) { const bf16_t* kp = NA_KPTR(i); kA[i][0] = *(const bf16x8*)kp; kA[i][1] = *(const bf16x8*)(kp + 256); }
#pragma unroll
    for (int tb = 0; tb < 32; tb += 4) {
#pragma unroll
      for (int i = 0; i < 2; ++i) { const bf16_t* kp = NA_KPTR(tb + 2 + i); kB[i][0] = *(const bf16x8*)kp; kB[i][1] = *(const bf16x8*)(kp + 256); }
#pragma unroll
      for (int i = 0; i < 2; ++i) { asm volatile("" : "+v"(kA[i][0]), "+v"(kA[i][1])); }
#pragma unroll
      for (int i = 0; i < 2; ++i) {
        f32x4 z = (f32x4){0.f, 0.f, 0.f, 0.f};
        z = __builtin_amdgcn_mfma_f32_16x16x32_bf16(kA[i][0], qf0, z, 0, 0, 0);
        z = __builtin_amdgcn_mfma_f32_16x16x32_bf16(kA[i][1], qf1, z, 0, 0, 0);
        if (tb + i < 16) accS[(tb + i) & 15] = z; else accC[(tb + i) & 15] = z;
      }
      if (tb + 4 < 32) {
#pragma unroll
        for (int i = 0; i < 2; ++i) { const bf16_t* kp = NA_KPTR(tb + 4 + i); kA[i][0] = *(const bf16x8*)kp; kA[i][1] = *(const bf16x8*)(kp + 256); }
      }
#pragma unroll
      for (int i = 0; i < 2; ++i) { asm volatile("" : "+v"(kB[i][0]), "+v"(kB[i][1])); }
#pragma unroll
      for (int i = 0; i < 2; ++i) {
        f32x4 z = (f32x4){0.f, 0.f, 0.f, 0.f};
        z = __builtin_amdgcn_mfma_f32_16x16x32_bf16(kB[i][0], qf0, z, 0, 0, 0);
        z = __builtin_amdgcn_mfma_f32_16x16x32_bf16(kB[i][1], qf1, z, 0, 0, 0);
        if (tb + 2 + i < 16) accS[(tb + 2 + i) & 15] = z; else accC[(tb + 2 + i) & 15] = z;
      }
    }
#undef NA_KPTR
    const int cq = cq0 + li;
    int c0q = cq - 8; c0q = c0q < 0 ? 0 : (c0q > 48 ? 48 : c0q);
    float mx = -3.0e38f;
#pragma unroll
    for (int kt = 0; kt < 16; ++kt) {
      int bi[4]; bool okv[4]; float bv[4];
#pragma unroll
      for (int e = 0; e < 4; ++e) {
        const int ck = cs + 16 * (kt & 1) + 4 * g + e;
        okv[e] = lat && ck >= c0q && ck < c0q + 16;
        bi[e] = okv[e] ? (kt >> 1) * 32 + (ck - cq + 15) : 0;
      }
      asm volatile("" : "+v"(bi[0]), "+v"(bi[1]), "+v"(bi[2]), "+v"(bi[3]));
#pragma unroll
      for (int e = 0; e < 4; ++e) bv[e] = btab[bi[e]];
#pragma unroll
      for (int e = 0; e < 4; ++e) {
        const float s = okv[e] ? accS[kt][e] * 0.125f + bv[e] : -3.0e38f;
        accS[kt][e] = s;
        mx = fmaxf(mx, s);
      }
    }
#pragma unroll
    for (int ct = 0; ct < 16; ++ct)
#pragma unroll
      for (int e = 0; e < 4; ++e) { const float s = accC[ct][e] * 0.125f; accC[ct][e] = s; mx = fmaxf(mx, s); }
    mx = grp_max(mx);
    float sum = 0.f;
#pragma unroll
    for (int kt = 0; kt < 16; ++kt)
#pragma unroll
      for (int e = 0; e < 4; ++e) { const float p = __expf(accS[kt][e] - mx); accS[kt][e] = p; sum += p; }
#pragma unroll
    for (int ct = 0; ct < 16; ++ct)
#pragma unroll
      for (int e = 0; e < 4; ++e) { const float p = __expf(accC[ct][e] - mx); accC[ct][e] = p; sum += p; }
    sum = grp_sum(sum);
    const float inv = 1.f / sum;
    bf16x8 afL[8], afC[8];
#pragma unroll
    for (int kr = 0; kr < 8; ++kr) {
#pragma unroll
      for (int e = 0; e < 4; ++e) {
        afL[kr][e] = (short)f2bf(accS[2 * kr][e] * inv); afL[kr][4 + e] = (short)f2bf(accS[2 * kr + 1][e] * inv);
        afC[kr][e] = (short)f2bf(accC[2 * kr][e] * inv); afC[kr][4 + e] = (short)f2bf(accC[2 * kr + 1][e] * inv);
      }
    }
    f32x4 accO[4];
#pragma unroll
    for (int db = 0; db < 4; ++db) accO[db] = (f32x4){0.f, 0.f, 0.f, 0.f};
    const bf16_t* vl = P.vtl() + (size_t)(b * 8 + hd) * 64 * 4096 + li * 4;
    const bf16_t* vc = P.vtc() + (size_t)(b * 8 + hd) * 64 * 256 + li * 4;
#pragma unroll
    for (int kr = 0; kr < 8; ++kr) {
      const int tok = (r0 + kr) * 64 + cs + 4 * g;
      s16x4 lo[4], hi[4];
#pragma unroll
      for (int db = 0; db < 4; ++db) {
        const bf16_t* vp = vl + ((size_t)(tok >> 2) * 64 + db * 16) * 4;
        lo[db] = *(const s16x4*)vp; hi[db] = *(const s16x4*)(vp + 4 * 64 * 4);
      }
#pragma unroll
      for (int db = 0; db < 4; ++db) {
        const bf16x8 bfr = (bf16x8){lo[db][0], lo[db][1], lo[db][2], lo[db][3], hi[db][0], hi[db][1], hi[db][2], hi[db][3]};
        accO[db] = __builtin_amdgcn_mfma_f32_16x16x32_bf16(afL[kr], bfr, accO[db], 0, 0, 0);
      }
    }
#pragma unroll
    for (int t = 0; t < 8; ++t) {
      const int tok = 32 * t + 4 * g;
      s16x4 lo[4], hi[4];
#pragma unroll
      for (int db = 0; db < 4; ++db) {
        const bf16_t* vp = vc + ((size_t)(tok >> 2) * 64 + db * 16) * 4;
        lo[db] = *(const s16x4*)vp; hi[db] = *(const s16x4*)(vp + 4 * 64 * 4);
      }
#pragma unroll
      for (int db = 0; db < 4; ++db) {
        const bf16x8 bfr = (bf16x8){lo[db][0], lo[db][1], lo[db][2], lo[db][3], hi[db][0], hi[db][1], hi[db][2], hi[db][3]};
        accO[db] = __builtin_amdgcn_mfma_f32_16x16x32_bf16(afC[t], bfr, accO[db], 0, 0, 0);
      }
    }
    {
      bf16_t* stg = (bf16_t*)(smem + 32768) + wv * (16 * 72);
#pragma unroll
      for (int db = 0; db < 4; ++db)
#pragma unroll
        for (int e = 0; e < 4; ++e) stg[(4 * g + e) * 72 + 16 * db + li] = f2bf(accO[db][e]);
      __builtin_amdgcn_wave_barrier();
#pragma unroll
      for (int i = 0; i < 2; ++i) {
        const int c = i * 64 + lane, rr = c >> 3, c8 = (c & 7) * 8;
        *(uint4*)(P.concat() + (size_t)(qrow0 + rr) * 2048 + 1536 + hd * 64 + c8) = *(const uint4*)(stg + rr * 72 + c8);
      }
      __builtin_amdgcn_wave_barrier();
    }
  }
}

__device__ __forceinline__ uint32_t mono_u(float f) { const uint32_t u = __float_as_uint(f); return u ^ ((uint32_t)((int)u >> 31) | 0x80000000u); }
__device__ __forceinline__ float unmono_f(uint32_t m) { return __uint_as_float((m & 0x80000000u) ? (m ^ 0x80000000u) : ~m); }
__device__ __forceinline__ uint32_t grp_max_u(uint32_t v) {
  auto a = __builtin_amdgcn_permlane16_swap(v, v, false, false);
  v = a[0] > a[1] ? a[0] : a[1];
  auto b = __builtin_amdgcn_permlane32_swap(v, v, false, false);
  return b[0] > b[1] ? b[0] : b[1];
}

template <int N>
__device__ __forceinline__ void bitonic_sort_desc(uint32_t (&a)[N], int base = 0) { (void)base;
#pragma unroll
  for (int k = 2; k <= N; k <<= 1)
#pragma unroll
    for (int j = k >> 1; j > 0; j >>= 1)
#pragma unroll
      for (int i = 0; i < N; ++i) {
        const int l = i ^ j;
        if (l > i) {
          const bool desc = (i & k) == 0;
          const uint32_t hi = a[i] > a[l] ? a[i] : a[l], lo = a[i] > a[l] ? a[l] : a[i];
          a[i] = desc ? hi : lo; a[l] = desc ? lo : hi;
        }
      }
}
template <int N>
__device__ __forceinline__ void bitonic_merge_desc(uint32_t (&a)[N]) {
#pragma unroll
  for (int j = N >> 1; j > 0; j >>= 1)
#pragma unroll
    for (int i = 0; i < N; ++i) {
      const int l = i ^ j;
      if (l > i) {
        const uint32_t hi = a[i] > a[l] ? a[i] : a[l], lo = a[i] > a[l] ? a[l] : a[i];
        a[i] = hi; a[l] = lo;
      }
    }
}
__device__ __forceinline__ void merge4_top16(uint32_t (&a)[16]) {
  uint32_t e[16], o[16];
#pragma unroll
  for (int i = 0; i < 16; ++i) { auto r = __builtin_amdgcn_permlane16_swap(a[i], a[i], false, false); e[i] = r[0]; o[i] = r[1]; }
#pragma unroll
  for (int i = 0; i < 16; ++i) a[i] = e[i] > o[15 - i] ? e[i] : o[15 - i];
  bitonic_merge_desc<16>(a);
#pragma unroll
  for (int i = 0; i < 16; ++i) { auto r = __builtin_amdgcn_permlane32_swap(a[i], a[i], false, false); e[i] = r[0]; o[i] = r[1]; }
#pragma unroll
  for (int i = 0; i < 16; ++i) a[i] = e[i] > o[15 - i] ? e[i] : o[15 - i];
  bitonic_merge_desc<16>(a);
}
__device__ void ph_peer_topk_mfma(int wv, const Params& P, int layer, int nrows, char* smem, int bid, int nb) {
  const int tid = otid(wv), lane = tid & 63, li = lane & 15, g = lane >> 4;
  unsigned char* ctab = (unsigned char*)smem;
  float* vals = (float*)(smem + 256) + wv * 512;
  int* idxs = (int*)(smem + 256 + 8 * 2048) + wv * 512;
  __syncthreads();
  if (tid < 64) ctab[tid] = 0xFF;
  __syncthreads();
  if (tid == 0) {
    int n = 0, one = 1;
    asm volatile("" : "+s"(one));
#pragma unroll 1
    for (int a = 0; a < 16; ++a)
#pragma unroll 1
      for (int b = 0; b < 16; ++b)
        if ((a + one) * (b + 1) <= 16) { ctab[(n & 3) * 16 + (n >> 2)] = (unsigned char)(a * 16 + b); ++n; }
  }
  const int hd = bid & 7, tg = bid >> 3, ngroups = nb >> 3;
  char* ksm = smem + 33280;
  {
    const bf16_t* ksrc = P.keysb() + (size_t)(layer * 8 + hd) * 2 * 128 * 128;
#pragma unroll
    for (int i = 0; i < 8; ++i) {
      const int idx = tid + i * 512, r = idx >> 4, sg = idx & 15;
      *(uint4*)(ksm + (r * 136 + sg * 8) * 2) = *(const uint4*)(ksrc + (size_t)r * 128 + sg * 8);
    }
  }
  __syncthreads();
  uint32_t cab[16];
#pragma unroll
  for (int s = 0; s < 16; ++s) cab[s] = ctab[g * 16 + s];
  const int ntile = nrows / 16;
  for (int tile = tg + ngroups * wv; tile < ntile && tg < ngroups; tile += ngroups * NWAVE) {
    const int row0 = tile * 16;
    const bf16_t* qp = P.q() + (size_t)(row0 + li) * 2048 + hd * 256 + 8 * g;
    uint32_t win[2][16];
#pragma unroll
    for (int half = 0; half < 2; ++half) {
      bf16x8 qf[4];
#pragma unroll
      for (int t = 0; t < 4; ++t) qf[t] = *(const bf16x8*)(qp + half * 128 + 32 * t);
      const char* kb = ksm + ((half * 128 + li) * 136 + 8 * g) * 2;
      uint32_t pk[32];
#pragma unroll
      for (int kt = 0; kt < 8; ++kt) {
        f32x4 acc = (f32x4){0.f, 0.f, 0.f, 0.f};
#pragma unroll
        for (int t = 0; t < 4; ++t) {
          const bf16x8 a = *(const bf16x8*)(kb + (kt * 16 * 136 + 32 * t) * 2);
          acc = __builtin_amdgcn_mfma_f32_16x16x32_bf16(a, qf[t], acc, 0, 0, 0);
        }
#pragma unroll
        for (int e = 0; e < 4; ++e) pk[kt * 4 + e] = (mono_u(acc[e]) & ~127u) | (uint32_t)(16 * kt + 4 * g + e);
      }
      {
        uint32_t lo16[16], hi16[16];
#pragma unroll
        for (int i = 0; i < 16; ++i) { lo16[i] = pk[i]; hi16[i] = pk[16 + i]; }
        bitonic_sort_desc<16>(lo16);
        bitonic_sort_desc<16>(hi16);
#pragma unroll
        for (int i = 0; i < 16; ++i) lo16[i] = lo16[i] > hi16[15 - i] ? lo16[i] : hi16[15 - i];
        bitonic_merge_desc<16>(lo16);
        merge4_top16(lo16);
#pragma unroll
        for (int r = 0; r < 16; ++r) win[half][r] = lo16[r];
      }
    }
    if (g == 0) {
#pragma unroll
      for (int half = 0; half < 2; ++half)
#pragma unroll
        for (int r = 0; r < 16; ++r) {
          vals[li * 32 + half * 16 + r] = unmono_f(win[half][r] & ~127u);
          idxs[li * 32 + half * 16 + r] = (int)(win[half][r] & 127u);
        }
    }
    __builtin_amdgcn_wave_barrier();
    uint32_t cp[16];
    {
      float va[16], vb[16];
#pragma unroll
      for (int s = 0; s < 16; ++s) {
        const uint32_t ab = cab[s] == 0xFFu ? 0u : cab[s];
        va[s] = vals[li * 32 + (ab >> 4)]; vb[s] = vals[li * 32 + 16 + (ab & 15u)];
      }
#pragma unroll
      for (int s = 0; s < 16; ++s) cp[s] = cab[s] == 0xFFu ? 0u : ((mono_u(va[s] + vb[s]) & ~255u) | cab[s]);
    }
    bitonic_sort_desc<16>(cp);
    merge4_top16(cp);
    uint32_t cw[16];
#pragma unroll
    for (int r = 0; r < 16; ++r) cw[r] = cp[r];
    const float mx = unmono_f(cw[0] & ~255u);
    float ex[16];
    float sum = 0.f;
#pragma unroll
    for (int r = 0; r < 16; ++r) { ex[r] = __expf(unmono_f(cw[r] & ~255u) - mx); sum += ex[r]; }
    const float inv = 1.f / sum;
    const size_t ob = (size_t)(row0 + li) * 128 + hd * 16;
#pragma unroll
    for (int r = 0; r < 16; ++r) {
      if ((r >> 2) == g) {
        const uint32_t ab = cw[r] & 255u;
        P.sel_idx()[ob + r] = idxs[li * 32 + (ab >> 4)] * 128 + idxs[li * 32 + 16 + (ab & 15u)];
        P.sel_g()[ob + r] = ex[r] * inv;
      }
    }
    __builtin_amdgcn_wave_barrier();
  }
}

__device__ __forceinline__ void cvt8(const uint32_t w, float* f) {
  const f32x2_t a = __builtin_amdgcn_cvt_scalef32_pk_f32_fp4(w, 1.0f, 0), b = __builtin_amdgcn_cvt_scalef32_pk_f32_fp4(w, 1.0f, 1);
  const f32x2_t c = __builtin_amdgcn_cvt_scalef32_pk_f32_fp4(w, 1.0f, 2), e = __builtin_amdgcn_cvt_scalef32_pk_f32_fp4(w, 1.0f, 3);
  f[0] = a.x; f[1] = a.y; f[2] = b.x; f[3] = b.y; f[4] = c.x; f[5] = c.y; f[6] = e.x; f[7] = e.y;
}
__device__ __forceinline__ float swap16_add(float a, float b) {
  auto r = __builtin_amdgcn_permlane16_swap(__float_as_uint(a), __float_as_uint(b), false, false);
  return __uint_as_float(r[0]) + __uint_as_float(r[1]);
}
__device__ void ph_peer_gather(int wv, const Params& P, int layer, int nrows, int bid, int nb) {
  for (int row = bid * NWAVE + wv; row < nrows; row += nb * NWAVE) {
    const int lane = otid(wv) & 63, l5 = lane & 31;
    const bool up = lane >= 32;
    const unsigned char* TU = P.tabU() + l5 * 16;
    const unsigned char* TV = P.tabV() + l5 * 16;
    const int j15 = lane & 15;
    const int rr = ((j15 >> 3) & 1) | ((j15 & 1) << 1), zi = (j15 >> 1) & 3;
    const int srcl = (rr * 4 + (zi & 1) * 2 + (zi >> 1)) * 4;
    float xv[32], o[32];
    {
      const bf16_t* xp = P.u() + (size_t)row * DM + l5 * 32;
      unpack8(*(const uint4*)xp, xv); unpack8(*(const uint4*)(xp + 8), xv + 8);
      unpack8(*(const uint4*)(xp + 16), xv + 16); unpack8(*(const uint4*)(xp + 24), xv + 24);
    }
    const int idx0 = P.sel_idx()[(size_t)row * 128 + lane], idx1 = P.sel_idx()[(size_t)row * 128 + 64 + lane];
    const float gt0 = P.sel_g()[(size_t)row * 128 + lane] * P.invV()[idx0], gt1 = P.sel_g()[(size_t)row * 128 + 64 + lane] * P.invV()[idx1];
    const float iu0 = P.invU()[idx0], iu1 = P.invU()[idx1];
    float d0 = 0.f, d1 = 0.f;
    uint4 bufA[8], bufB[8];
#define PG_LOAD(buf, T, kk) do { _Pragma("unroll") for (int j = 0; j < 8; ++j) { \
      const int k_ = (kk) + 2 * j; const int src_ = k_ < 64 ? idx0 : idx1; \
      const int elo_ = __builtin_amdgcn_readlane(src_, k_ & 63), ehi_ = __builtin_amdgcn_readlane(src_, (k_ & 63) + 1); \
      buf[j] = *(const uint4*)(T + (size_t)(up ? ehi_ : elo_) * 512); } } while (0)
#define PG_DOT(buf, kk) do { float pv[8]; _Pragma("unroll") for (int j = 0; j < 8; ++j) { float s_ = 0.f; const uint32_t w_[4] = {buf[j].x, buf[j].y, buf[j].z, buf[j].w}; \
      _Pragma("unroll") for (int d = 0; d < 4; ++d) { float f[8]; uint32_t wd_ = w_[d]; asm volatile("" : "+v"(wd_) : "v"(s_)); cvt8(wd_, f); \
        _Pragma("unroll") for (int i = 0; i < 8; ++i) s_ += f[i] * xv[d * 8 + i]; } pv[j] = s_; } \
      const float z0 = swap16_add(pv[0], pv[4]), z1 = swap16_add(pv[1], pv[5]), z2 = swap16_add(pv[2], pv[6]), z3 = swap16_add(pv[3], pv[7]); \
      const bool hi8 = (lane & 8) != 0, hi4 = (lane & 4) != 0; \
      const float y0 = (hi8 ? z1 : z0) + DPP_F(hi8 ? z0 : z1, 0x128); \
      const float y1 = (hi8 ? z3 : z2) + DPP_F(hi8 ? z2 : z3, 0x128); \
      float q_ = (hi4 ? y1 : y0) + DPP_F(hi4 ? y0 : y1, 0x141); \
      q_ += DPP_F(q_, 0xB1); q_ += DPP_F(q_, 0x4E); \
      const float t_ = __int_as_float(__builtin_amdgcn_ds_bpermute(srcl * 4, __float_as_int(q_))); \
      const int m_ = ((kk) >> 4) & 3; \
      if ((kk) < 64) d0 = ((lane >> 4) == m_) ? t_ : d0; else d1 = ((lane >> 4) == m_) ? t_ : d1; } while (0)
    PG_LOAD(bufA, TU, 0);
#pragma unroll 1
    for (int kk = 0; kk < 128; kk += 32) {
      PG_LOAD(bufB, TU, kk + 16);
      PG_DOT(bufA, kk);
      if (kk + 32 < 128) PG_LOAD(bufA, TU, kk + 32); else PG_LOAD(bufA, TV, 0);
      PG_DOT(bufB, kk + 16);
    }
    const float act0 = gelu_f(d0 * iu0) * gt0, act1 = gelu_f(d1 * iu1) * gt1;
#pragma unroll
    for (int i = 0; i < 32; ++i) o[i] = 0.f;
#define PG_ACC(buf, kk) do { _Pragma("unroll") for (int j = 0; j < 8; ++j) { const int k_ = (kk) + 2 * j; \
      const int asrc_ = __float_as_int(k_ < 64 ? act0 : act1); \
      const float alo_ = __int_as_float(__builtin_amdgcn_readlane(asrc_, k_ & 63)), ahi_ = __int_as_float(__builtin_amdgcn_readlane(asrc_, (k_ & 63) + 1)); \
      const float a_ = up ? ahi_ : alo_; \
      const uint32_t w_[4] = {buf[j].x, buf[j].y, buf[j].z, buf[j].w}; \
      _Pragma("unroll") for (int d = 0; d < 4; ++d) { float f[8]; uint32_t wd_ = w_[d]; asm volatile("" : "+v"(wd_) : "v"(o[(d * 8 + 31) & 31])); cvt8(wd_, f); \
        _Pragma("unroll") for (int i = 0; i < 8; ++i) o[d * 8 + i] += a_ * f[i]; } } } while (0)
#pragma unroll 1
    for (int kk = 0; kk < 128; kk += 32) {
      PG_LOAD(bufB, TV, kk + 16);
      PG_ACC(bufA, kk);
      if (kk + 32 < 128) PG_LOAD(bufA, TV, kk + 32);
      PG_ACC(bufB, kk + 16);
    }
#undef PG_LOAD
#undef PG_DOT
#undef PG_ACC
#pragma unroll
    for (int i = 0; i < 32; ++i) {
      auto r = __builtin_amdgcn_permlane32_swap(__float_as_uint(o[i]), __float_as_uint(o[i]), false, false);
      o[i] = __uint_as_float(r[0]) + __uint_as_float(r[1]);
    }
    const int lane_e = otid(wv) & 63, l5e = lane_e & 31;
    const bool upe = lane_e >= 32;
    const float* gate = P.mod() + (size_t)(layer * 5 + modrow(row)) * MODW + 5120 + l5e * 32;
    float* hr = P.h() + (size_t)row * DM + l5e * 32;
    float ss = 0.f;
    f32x4 hvv[8], ggv[8];
#pragma unroll
    for (int q = 0; q < 8; ++q) { hvv[q] = *(const f32x4*)(hr + q * 4); ggv[q] = *(const f32x4*)(gate + q * 4); }
#pragma unroll
    for (int q = 0; q < 8; ++q) asm volatile("" : "+v"(hvv[q]), "+v"(ggv[q]));
#pragma unroll
    for (int q = 0; q < 8; ++q) {
      float4 hv = make_float4(hvv[q][0], hvv[q][1], hvv[q][2], hvv[q][3]);
      const float4 gg = make_float4(ggv[q][0], ggv[q][1], ggv[q][2], ggv[q][3]);
      hv.x += gg.x * o[q * 4 + 0]; hv.y += gg.y * o[q * 4 + 1]; hv.z += gg.z * o[q * 4 + 2]; hv.w += gg.w * o[q * 4 + 3];
      if (layer == 0 && !upe) *(float4*)(hr + q * 4) = hv;
      o[q * 4 + 0] = hv.x; o[q * 4 + 1] = hv.y; o[q * 4 + 2] = hv.z; o[q * 4 + 3] = hv.w;
      if (!upe) ss += hv.x * hv.x + hv.y * hv.y + hv.z * hv.z + hv.w * hv.w;
    }
    ss = wave_sum(ss);
    const float rstd = rsqrtf(ss * (1.f / 1024.f) + 1e-6f);
    if (layer == 0) {
      const float* g1 = P.norm1_g + 1024 + l5e * 32;
      const float* mr = P.mod() + (size_t)(5 + modrow(row)) * MODW + l5e * 32;
      if (!upe) {
#pragma unroll
        for (int q = 0; q < 4; ++q) {
          float ov[8];
#pragma unroll
          for (int e = 0; e < 8; ++e) ov[e] = o[q * 8 + e] * rstd * g1[q * 8 + e] * (1.f + mr[1024 + q * 8 + e]) + mr[q * 8 + e];
          *(uint4*)(P.u() + (size_t)row * DM + l5e * 32 + q * 8) = make_uint4(pack2(ov[0], ov[1]), pack2(ov[2], ov[3]), pack2(ov[4], ov[5]), pack2(ov[6], ov[7]));
        }
      }
    } else {
      const float* gf = P.final_g + l5e * 32;
      if (!upe) {
#pragma unroll
        for (int q = 0; q < 8; ++q) {
          const float4 gg = *(const float4*)(gf + q * 4);
          *(float4*)(P.out + (size_t)row * DM + l5e * 32 + q * 4) =
              make_float4(o[q * 4] * rstd * gg.x, o[q * 4 + 1] * rstd * gg.y, o[q * 4 + 2] * rstd * gg.z, o[q * 4 + 3] * rstd * gg.w);
        }
      }
    }
  }
}

struct EpiOutproj {
  static constexpr bool PERM = false, AFTER_DRAIN = false;
  static constexpr int MIDK_T = 16;
  float* H; const float* hl; const float* hc; const float* modl;
  const float* yss;
  __device__ __forceinline__ void midk(pg8::f32x4 (&acc)[2][2][4][2], const pg8::Unit& u, int wr, int wc, int fr, int fq) const {
    const int row0 = u.pm * 256 + wr * 64 + fr;
#pragma unroll
    for (int ai = 0; ai < 2; ++ai)
#pragma unroll
      for (int m = 0; m < 4; ++m) {
        const pg8::f32x4* yp = (const pg8::f32x4*)(yss + (size_t)(row0 + ai * 128 + m * 16) * 16);
        const pg8::f32x4 y4 = (yp[0] + yp[1]) + (yp[2] + yp[3]);
        const float rstd = rsqrtf(((y4[0] + y4[1]) + (y4[2] + y4[3])) * (1.f / 1024.f) + 1e-6f);
#pragma unroll
        for (int bj = 0; bj < 2; ++bj)
#pragma unroll
          for (int n = 0; n < 2; ++n) acc[ai][bj][m][n] *= rstd;
      }
  }
  __device__ __forceinline__ void operator()(const pg8::f32x4 (&acc)[2][2][4][2], const pg8::Unit& u, int wr, int wc, int fr, int fq) const {
    const int row0 = u.pm * 256 + wr * 64 + fr, col0 = u.pn * 256 + wc * 32 + 4 * fq;
    const float* gate = modl + (size_t)modrow(row0) * MODW + 2048 + col0;
    pg8::f32x4 gv[2][2];
#pragma unroll
    for (int bj = 0; bj < 2; ++bj)
#pragma unroll
      for (int n = 0; n < 2; ++n) gv[bj][n] = *(const pg8::f32x4*)(gate + bj * 128 + n * 16);
    pg8::f32x4 sA[4], sB[4];
#define EO_LOAD(dstv, ai_, m_) do { const float* s_ = hrow(hl, hc, row0 + (ai_) * 128 + (m_) * 16) + col0; \
      dstv[0] = *(const pg8::f32x4*)(s_); dstv[1] = *(const pg8::f32x4*)(s_ + 16); dstv[2] = *(const pg8::f32x4*)(s_ + 128); dstv[3] = *(const pg8::f32x4*)(s_ + 144); } while (0)
#define EO_STORE(srcv, ai_, m_) do { asm volatile("" : "+v"(srcv[0]), "+v"(srcv[1]), "+v"(srcv[2]), "+v"(srcv[3])); \
      float* d_ = H + (size_t)(row0 + (ai_) * 128 + (m_) * 16) * DM + col0; \
      *(pg8::f32x4*)(d_) = srcv[0] + gv[0][0] * acc[ai_][0][m_][0]; *(pg8::f32x4*)(d_ + 16) = srcv[1] + gv[0][1] * acc[ai_][0][m_][1]; \
      *(pg8::f32x4*)(d_ + 128) = srcv[2] + gv[1][0] * acc[ai_][1][m_][0]; *(pg8::f32x4*)(d_ + 144) = srcv[3] + gv[1][1] * acc[ai_][1][m_][1]; } while (0)
    EO_LOAD(sA, 0, 0);
#pragma unroll
    for (int i = 0; i < 8; i += 2) {
      EO_LOAD(sB, (i + 1) >> 2, (i + 1) & 3);
      EO_STORE(sA, i >> 2, i & 3);
      if (i + 2 < 8) EO_LOAD(sA, (i + 2) >> 2, (i + 2) & 3);
      EO_STORE(sB, (i + 1) >> 2, (i + 1) & 3);
    }
#undef EO_LOAD
#undef EO_STORE
  }
};

__device__ __forceinline__ uint32_t fp4_code(float x, float sc) {
  const float a = fabsf(x) * sc;
  const uint32_t c = (uint32_t)(a > 0.25f) + (uint32_t)(a > 0.75f) + (uint32_t)(a > 1.25f) + (uint32_t)(a > 1.75f) +
                     (uint32_t)(a > 2.5f) + (uint32_t)(a > 3.5f) + (uint32_t)(a > 5.0f);
  return c | (x < 0.f ? 8u : 0u);
}
__device__ void ph_convert_tables(int wv, const Params& P, int layer, int bid, int nb) {
  const int lane = otid(wv) & 63;
  for (int it0 = (bid * NWAVE + wv) * 2; it0 < 2 * 16384; it0 += nb * NWAVE * 2) {
    f32x4 v[2][4];
#pragma unroll
    for (int rr = 0; rr < 2; ++rr) {
      const int it = it0 + rr, t = it >> 14, e = it & 16383;
      const float* src = (t == 0 ? P.peer_u : P.peer_v) + ((size_t)layer * 16384 + e) * 1024 + lane * 16;
#pragma unroll
      for (int i = 0; i < 4; ++i) v[rr][i] = ((const f32x4*)src)[i];
    }
#pragma unroll
    for (int rr = 0; rr < 2; ++rr)
#pragma unroll
      for (int i = 0; i < 4; ++i) asm volatile("" : "+v"(v[rr][i]));
#pragma unroll
    for (int rr = 0; rr < 2; ++rr) {
      const int it = it0 + rr, t = it >> 14, e = it & 16383;
      float m = 0.f;
#pragma unroll
      for (int i = 0; i < 4; ++i)
        m = fmaxf(m, fmaxf(fmaxf(fabsf(v[rr][i][0]), fabsf(v[rr][i][1])), fmaxf(fabsf(v[rr][i][2]), fabsf(v[rr][i][3]))));
      m = wave_max(m);
      m = fmaxf(m, 1e-30f);
      const float sc = 6.0f / m, inv = m * (1.0f / 6.0f);
      uint2 o;
      {
        uint32_t p0 = 0u, p1 = 0u;
        p0 = __builtin_amdgcn_cvt_scalef32_pk_fp4_f32(p0, v[rr][0][0] * sc, v[rr][0][1] * sc, 1.0f, 0);
        p0 = __builtin_amdgcn_cvt_scalef32_pk_fp4_f32(p0, v[rr][0][2] * sc, v[rr][0][3] * sc, 1.0f, 1);
        p0 = __builtin_amdgcn_cvt_scalef32_pk_fp4_f32(p0, v[rr][1][0] * sc, v[rr][1][1] * sc, 1.0f, 2);
        p0 = __builtin_amdgcn_cvt_scalef32_pk_fp4_f32(p0, v[rr][1][2] * sc, v[rr][1][3] * sc, 1.0f, 3);
        p1 = __builtin_amdgcn_cvt_scalef32_pk_fp4_f32(p1, v[rr][2][0] * sc, v[rr][2][1] * sc, 1.0f, 0);
        p1 = __builtin_amdgcn_cvt_scalef32_pk_fp4_f32(p1, v[rr][2][2] * sc, v[rr][2][3] * sc, 1.0f, 1);
        p1 = __builtin_amdgcn_cvt_scalef32_pk_fp4_f32(p1, v[rr][3][0] * sc, v[rr][3][1] * sc, 1.0f, 2);
        p1 = __builtin_amdgcn_cvt_scalef32_pk_fp4_f32(p1, v[rr][3][2] * sc, v[rr][3][3] * sc, 1.0f, 3);
        o.x = p0; o.y = p1;
      }
      *(uint2*)((t == 0 ? P.tabU() : P.tabV()) + (size_t)e * 512 + lane * 8) = o;
      if (lane == 0) (t == 0 ? P.invU() : P.invV())[e] = inv;
    }
  }
}

enum {
  PH_PREP = 0, PH_NORM1, PH_INPROJ, PH_CONV, PH_SSDPREP, PH_STATES, PH_SCAN, PH_SSDY, PH_SSDNORM, PH_POOL, PH_NA,
  PH_OUTPROJ, PH_NORM2, PH_QGEMM, PH_TOPK, PH_GATHER, PH_FINAL
};

#define SMEM_BYTES 135168

__device__ __forceinline__ void run_phase(int wv, const Params& P, int ph, int layer, char* smem, int bid, int nb) {
  const float* hl = layer == 0 ? P.x : P.h();
  const float* hc = layer == 0 ? P.ctx : P.h() + (size_t)NLAT * DM;
  const int nrows = layer == 0 ? NTOK : NLAT;
  switch (ph) {
    case PH_PREP:
      for (int i = bid * NTHR + otid(wv); i < 2 * 8 * 2 * 128 * 128; i += nb * NTHR) P.keysb()[i] = f2bf(P.peer_keys[i]);
      for (int i = bid * NTHR + otid(wv); i < 2 * 4 * 128 * 128; i += nb * NTHR) {
        const int k = i & 127, n = (i >> 7) & 127, lg = i >> 14;
        P.poolwT()[i] = f2bf(P.pool_w[((size_t)lg * 128 + k) * 128 + n]);
      }
      ph_mod(wv, P, (float*)smem, bid, nb);
      for (int l = 0; l < 2; ++l) {
        ph_transpose(wv, P.w_in + (size_t)l * 1024 * INW, P.w_inT() + (size_t)l * PW * 1024, 1024, INW, PW, 0, 2560, 32, PW, (float*)smem, bid, nb);
        ph_transpose(wv, P.w_in + (size_t)l * 1024 * INW, P.w_dtT() + (size_t)l * 128 * 1024, 1024, INW, 128, 2560, 1 << 30, 0, 32, (float*)smem, bid, nb);
        ph_transpose(wv, P.w_out + (size_t)l * 2048 * 1024, P.w_outT() + (size_t)l * 1024 * 2048, 2048, 1024, 1024, 0, 1 << 30, 0, 1024, (float*)smem, bid, nb,
                     P.ssd_norm_g + l * 1024, 1024);
        ph_transpose(wv, P.peer_wq + (size_t)l * 1024 * 2048, P.w_qT() + (size_t)l * 2048 * 1024, 1024, 2048, 2048, 0, 1 << 30, 0, 2048, (float*)smem, bid, nb);
      }
      break;
    case PH_NORM1:
      ph_norm(wv, hl, hc, P.norm1_g + layer * 1024, P.mod() + (size_t)layer * 5 * MODW, 0, 1024, NTOK, P.u(), bid, nb);
      break;
    case PH_INPROJ:
    {
      pg8::Gemm g{P.u(), P.w_inT() + (size_t)layer * PW * 1024, NTOK, PW, 1024};
      pg8::StaticOrder S; S.init(g.M, g.N, nb, bid);
      pg8::EpiBf16<0> E{P.p(), PW, nullptr, 0, 0};
      pg8::gemm_phase<pg8::EpiBf16<0>, pg8::StaticOrder, false>(wv, (PG8_LAS unsigned char*)smem, g, S, E, nullptr);
      {
        const int units = (NTOK / 256) * (PW / 256), rem = units % nb;
        const int nidle = rem == 0 ? nb : nb - rem, first_idle = rem == 0 ? 0 : rem;
        if (bid >= first_idle) ph_dtprep(wv, P, layer, smem, bid - first_idle, nidle);
      }
      break;
    }
    case PH_CONV: ph_conv(wv, P, layer, bid, nb); ph_vtranspose(wv, P, smem, bid, nb); break;
    case PH_STATES: ph_states_mfma(wv, P, layer, smem, bid, nb); break;
    case PH_SCAN: ph_scan(wv, P, bid, nb); break;
    case PH_SSDY: ph_ssdy_mfma(wv, P, layer, nrows / 128, smem, bid, nb); break;
    case PH_POOL: ph_pool_mfma(wv, P, layer, nrows, smem, bid, nb); break;
    case PH_NA: ph_na_mfma(wv, P, layer, nrows, smem, bid, nb); break;
    case PH_OUTPROJ:
    {
      pg8::Gemm g{P.concat(), P.w_outT() + (size_t)layer * 1024 * 2048, nrows, 1024, 2048};
      pg8::StaticOrder S; S.init(g.M, g.N, nb, bid);
      EpiOutproj E{P.h(), hl, hc, P.mod() + (size_t)layer * 5 * MODW, P.yss()};
      pg8::gemm_phase<EpiOutproj, pg8::StaticOrder, false>(wv, (PG8_LAS unsigned char*)smem, g, S, E, nullptr);
      break;
    }
    case PH_NORM2:
      ph_norm(wv, P.h(), P.h() + (size_t)NLAT * DM, P.norm2_g + layer * 1024, P.mod() + (size_t)layer * 5 * MODW, 3072, 4096, nrows, P.u(), bid, nb);
      break;
    case PH_QGEMM:
    {
      pg8::Gemm g{P.u(), P.w_qT() + (size_t)layer * 2048 * 1024, nrows, 2048, 1024};
      pg8::StaticOrder S; S.init(g.M, g.N, nb, bid);
      pg8::EpiBf16<0> E{P.q(), 2048, nullptr, 0, 0};
      pg8::gemm_phase<pg8::EpiBf16<0>, pg8::StaticOrder, false>(wv, (PG8_LAS unsigned char*)smem, g, S, E, nullptr);
      ph_convert_tables(wv, P, layer, bid, nb);
      break;
    }
    case PH_TOPK: ph_peer_topk_mfma(wv, P, layer, nrows, smem, bid, nb); break;
    case PH_GATHER: ph_peer_gather(wv, P, layer, nrows, bid, nb); break;
  }
}

namespace cg = cooperative_groups;
typedef const __attribute__((address_space(4))) Params* kparams_t;
__device__ __forceinline__ const Params& kp_fresh() {
  kparams_t kp = (kparams_t)__builtin_amdgcn_kernarg_segment_ptr();
  asm volatile("" : "+s"(kp));
  return *(const Params*)kp;
}
__global__ void __launch_bounds__(NTHR) k_mega(Params P_unused) {
  __shared__ __attribute__((aligned(16))) char smem[SMEM_BYTES + 16];
  cg::grid_group grid = cg::this_grid();
  const int bid = blockIdx.x, nb = gridDim.x;
  const int wv = __builtin_amdgcn_readfirstlane(threadIdx.x >> 6);
  if (threadIdx.x == 0) *(uint4*)(smem + SMEM_BYTES) = make_uint4(0u, 0u, 0u, 0u);
  __syncthreads();
  (void)xcd_barrier_post((unsigned*)(kp_fresh().ws + WS_BAR), (volatile LAS unsigned*)(smem + SMEM_BYTES), threadIdx.x == 0);
#define GSYNC() do { XcdBarrier xb_; xb_.bar = (unsigned*)(kp_fresh().ws + WS_BAR); xb_.x = xb_xcc_id(); \
    xb_.st = (volatile LAS unsigned*)(smem + SMEM_BYTES); xcd_barrier(xb_, otid(wv) == 0); } while (0)
  run_phase(wv, kp_fresh(), PH_PREP, 0, smem, bid, nb);
  if (nb == 0x7fffff00) grid.sync();
  GSYNC();
  run_phase(wv, kp_fresh(), PH_NORM1, 0, smem, bid, nb); GSYNC();
#pragma unroll 1
  for (int layer = 0; layer < 2; ++layer) {
    run_phase(wv, kp_fresh(), PH_INPROJ, layer, smem, bid, nb); GSYNC();
    run_phase(wv, kp_fresh(), PH_CONV, layer, smem, bid, nb);
    GSYNC();
    run_phase(wv, kp_fresh(), PH_STATES, layer, smem, bid, nb);
    run_phase(wv, kp_fresh(), PH_POOL, layer, smem, bid, nb);
    run_phase(wv, kp_fresh(), PH_NA, layer, smem, bid, nb); GSYNC();
    run_phase(wv, kp_fresh(), PH_SCAN, layer, smem, bid, nb); GSYNC();
    run_phase(wv, kp_fresh(), PH_SSDY, layer, smem, bid, nb); GSYNC();
    run_phase(wv, kp_fresh(), PH_OUTPROJ, layer, smem, bid, nb); GSYNC();
    run_phase(wv, kp_fresh(), PH_NORM2, layer, smem, bid, nb); GSYNC();
    run_phase(wv, kp_fresh(), PH_QGEMM, layer, smem, bid, nb); GSYNC();
    run_phase(wv, kp_fresh(), PH_TOPK, layer, smem, bid, nb); GSYNC();
    run_phase(wv, kp_fresh(), PH_GATHER, layer, smem, bid, nb);
    if (layer == 0) GSYNC();
  }
}

extern "C" void kernel_launch(void* const* d_in, const int* in_sizes, int n_in, void* d_out, int out_size, void* d_ws,
                              size_t ws_size, hipStream_t stream) {
  Params P{};
  const float* const* in = (const float* const*)d_in;
  P.x = in[0]; P.c = in[1]; P.ctx = in[2]; P.c_ctx = in[3]; P.ada_w = in[4]; P.ada_b = in[5]; P.norm1_g = in[6];
  P.w_in = in[7]; P.conv_w = in[8]; P.conv_b = in[9]; P.a_log = in[10]; P.dt_bias = in[11]; P.d_skip = in[12];
  P.ssd_norm_g = in[13]; P.pool_w = in[14]; P.pool_scale = in[15]; P.na_rpb = in[16]; P.w_out = in[17];
  P.norm2_g = in[18]; P.peer_wq = in[19]; P.peer_keys = in[20]; P.peer_u = in[21]; P.peer_v = in[22]; P.final_g = in[23];
  P.out = (float*)d_out;
  P.ws = (char*)d_ws;
  if (WS_TOTAL > ws_size) { fprintf(stderr, "workspace too small: need %zu have %zu\n", (size_t)WS_TOTAL, ws_size); return; }

  static int grid_blocks = 0;
  if (!grid_blocks) {
    int dev = 0, cus = 0, per_cu = 0;
    hipGetDevice(&dev);
    hipDeviceGetAttribute(&cus, hipDeviceAttributeMultiprocessorCount, dev);
    hipOccupancyMaxActiveBlocksPerMultiprocessor(&per_cu, k_mega, NTHR, 0);
    if (per_cu > 4) per_cu = 4;
    grid_blocks = cus * per_cu;
  }
  hipMemsetAsync((char*)d_ws + WS_BAR, 0, 4096 * 4, stream);
  void* args[] = {&P};
  hipError_t e = hipLaunchCooperativeKernel((void*)k_mega, dim3(grid_blocks), dim3(NTHR), args, 0, stream);
  if (e != hipSuccess) fprintf(stderr, "cooperative launch failed: %s (grid %d)\n", hipGetErrorString(e), grid_blocks);
}
```

```cpp
#include <hip/hip_runtime.h>
#include <hip/hip_bf16.h>
#include <hip/hip_cooperative_groups.h>
#include <stdint.h>
#include <stdio.h>

typedef unsigned short bf16_t;
typedef __attribute__((ext_vector_type(8))) short bf16x8;
typedef __attribute__((ext_vector_type(4))) float f32x4;

#define NTHR 512
#define NWAVE 8
constexpr int DM = 1024;
constexpr int SEQ = 4096;
constexpr int NLAT = 16384;
constexpr int NCTXR = 1024;
constexpr int NTOK = 17408;
constexpr int INW = 4640;
constexpr int PW = 4608;
constexpr int OFF_Z = 0, OFF_XBC = 1024, OFF_POOL = 2560, OFF_Q = 3072, OFF_K = 3584, OFF_V = 4096;
constexpr int NCHUNK = 136;
constexpr int MODW = 6144;

constexpr size_t al256(size_t x) { return (x + 255) & ~(size_t)255; }
constexpr size_t WS_MOD = 0;
constexpr size_t WS_H = WS_MOD + al256((size_t)2 * 5 * MODW * 4);
constexpr size_t WS_P = WS_H + al256((size_t)NTOK * DM * 4);
constexpr size_t WS_TABU = WS_P + (size_t)80 * 1024 * 1024;
constexpr size_t WS_TABV = WS_TABU + (size_t)16384 * 512;
constexpr size_t WS_INVU = WS_TABV + (size_t)16384 * 512;
constexpr size_t WS_INVV = WS_INVU + (size_t)16384 * 4;
constexpr size_t WS_DTRAW = WS_P + al256((size_t)NTOK * PW * 2);
constexpr size_t WS_DTV = WS_DTRAW + al256((size_t)NTOK * 32 * 4);
constexpr size_t WS_CSV = WS_DTV + al256((size_t)NTOK * 32 * 4);
constexpr size_t WS_XBC = WS_CSV + al256((size_t)NTOK * 32 * 4);
constexpr size_t WS_VTL = WS_XBC + al256((size_t)NTOK * 512 * 2);
constexpr size_t WS_VTC = WS_VTL + al256((size_t)4 * 8 * 64 * 4096 * 2);
constexpr size_t WS_KEYSB = WS_VTC + al256((size_t)4 * 8 * 64 * 256 * 2);
constexpr size_t WS_POOLWT = WS_KEYSB + al256((size_t)2 * 8 * 2 * 128 * 128 * 2);
constexpr size_t WS_BT4 = WS_POOLWT + al256((size_t)2 * 4 * 128 * 128 * 2);
constexpr size_t WS_ATOT = WS_BT4 + al256((size_t)NTOK * 256 * 2);
constexpr size_t WS_STATES = WS_XBC + al256((size_t)NTOK * 1536 * 2);
constexpr size_t WS_YSS = WS_ATOT + al256((size_t)NCHUNK * 32 * 4);
static_assert(WS_YSS + (size_t)NTOK * 16 * 4 <= WS_STATES, "must fit in the old xbc region");
constexpr size_t WS_CONCAT = WS_STATES + al256((size_t)NCHUNK * 32 * 8192 * 2);
constexpr size_t WS_SELIDX = WS_CONCAT + al256((size_t)NTOK * 2048 * 2);
constexpr size_t WS_SELG = WS_SELIDX + al256((size_t)NTOK * 128 * 4);
constexpr size_t WS_WINT = WS_SELG + al256((size_t)NTOK * 128 * 4);
constexpr size_t WS_WDTT = WS_WINT + al256((size_t)2 * PW * 1024 * 2);
constexpr size_t WS_WOUTT = WS_WDTT + al256((size_t)2 * 128 * 1024 * 2);
constexpr size_t WS_WQT = WS_WOUTT + al256((size_t)2 * 1024 * 2048 * 2);
constexpr size_t WS_BAR = WS_WQT + al256((size_t)2 * 2048 * 1024 * 2);
constexpr size_t WS_XT4 = WS_BAR + al256((size_t)4096 * 4);
constexpr size_t WS_TOTAL = WS_XT4 + al256((size_t)NTOK * 1024 * 2);
static_assert((size_t)4 * 8 * (4096 + 256) * 64 * 2 <= WS_WINT - WS_SELIDX, "K relayout must fit in the sel_idx/sel_g region");
static_assert(WS_INVV + (size_t)16384 * 4 <= WS_DTRAW, "tables must fit in the tail of p");
static_assert((size_t)NTOK * 2048 * 2 <= (size_t)80 * 1024 * 1024, "q must fit below the tables");

struct Params {
  const float *x, *c, *ctx, *c_ctx, *ada_w, *ada_b, *norm1_g, *w_in, *conv_w, *conv_b, *a_log, *dt_bias, *d_skip,
      *ssd_norm_g, *pool_w, *pool_scale, *na_rpb, *w_out, *norm2_g, *peer_wq, *peer_keys, *peer_u, *peer_v, *final_g;
  float* out;
  char* ws;
  __device__ __forceinline__ float* mod() const { return (float*)(ws + WS_MOD); }
  __device__ __forceinline__ float* h() const { return (float*)(ws + WS_H); }
  __device__ __forceinline__ bf16_t* u() const { return (bf16_t*)(ws + WS_CONCAT); }
  __device__ __forceinline__ bf16_t* p() const { return (bf16_t*)(ws + WS_P); }
  __device__ __forceinline__ float* dtraw() const { return (float*)(ws + WS_DTRAW); }
  __device__ __forceinline__ float* dtv() const { return (float*)(ws + WS_DTV); }
  __device__ __forceinline__ float* csv() const { return (float*)(ws + WS_CSV); }
  __device__ __forceinline__ bf16_t* xbc() const { return (bf16_t*)(ws + WS_XBC); }
  __device__ __forceinline__ bf16_t* states() const { return (bf16_t*)(ws + WS_STATES); }
  __device__ __forceinline__ bf16_t* concat() const { return (bf16_t*)(ws + WS_CONCAT); }
  __device__ __forceinline__ bf16_t* q() const { return (bf16_t*)(ws + WS_P); }
  __device__ __forceinline__ int* sel_idx() const { return (int*)(ws + WS_SELIDX); }
  __device__ __forceinline__ float* sel_g() const { return (float*)(ws + WS_SELG); }
  __device__ __forceinline__ bf16_t* w_inT() const { return (bf16_t*)(ws + WS_WINT); }
  __device__ __forceinline__ bf16_t* w_dtT() const { return (bf16_t*)(ws + WS_WDTT); }
  __device__ __forceinline__ bf16_t* w_outT() const { return (bf16_t*)(ws + WS_WOUTT); }
  __device__ __forceinline__ bf16_t* w_qT() const { return (bf16_t*)(ws + WS_WQT); }
  __device__ __forceinline__ bf16_t* vtl() const { return (bf16_t*)(ws + WS_VTL); }
  __device__ __forceinline__ bf16_t* vtc() const { return (bf16_t*)(ws + WS_VTC); }
  __device__ __forceinline__ bf16_t* poolwT() const { return (bf16_t*)(ws + WS_POOLWT); }
  __device__ __forceinline__ bf16_t* keysb() const { return (bf16_t*)(ws + WS_KEYSB); }
  __device__ __forceinline__ bf16_t* xt4() const { return (bf16_t*)(ws + WS_XT4); }
  __device__ __forceinline__ bf16_t* bt4() const { return (bf16_t*)(ws + WS_BT4); }
  __device__ __forceinline__ float* wst() const { return (float*)(ws + WS_DTRAW); }
  __device__ __forceinline__ float* cst() const { return (float*)(ws + WS_CSV); }
  __device__ __forceinline__ float* dtt() const { return (float*)(ws + WS_DTV); }
  __device__ __forceinline__ float* yss() const { return (float*)(ws + WS_YSS); }
  __device__ __forceinline__ float* atot() const { return (float*)(ws + WS_ATOT); }
  __device__ __forceinline__ bf16_t* bfr() const { return (bf16_t*)(ws + WS_XBC); }
  __device__ __forceinline__ bf16_t* cfr() const { return (bf16_t*)(ws + WS_XBC + (size_t)NTOK * 256 * 2); }
  __device__ __forceinline__ bf16_t* ktl() const { return (bf16_t*)(ws + WS_SELIDX); }
  __device__ __forceinline__ bf16_t* ktc() const { return (bf16_t*)(ws + WS_SELIDX + (size_t)4 * 8 * 4096 * 64 * 2); }
  __device__ __forceinline__ unsigned char* tabU() const { return (unsigned char*)(ws + WS_TABU); }
  __device__ __forceinline__ unsigned char* tabV() const { return (unsigned char*)(ws + WS_TABV); }
  __device__ __forceinline__ float* invU() const { return (float*)(ws + WS_INVU); }
  __device__ __forceinline__ float* invV() const { return (float*)(ws + WS_INVV); }
};

__device__ __forceinline__ int otid(int wv) {
  int l;
  asm volatile("v_mbcnt_lo_u32_b32 %0, -1, 0\n\tv_mbcnt_hi_u32_b32 %0, -1, %0" : "=v"(l));
  return (wv << 6) | l;
}
__device__ __forceinline__ float bf2f(bf16_t v) { return __uint_as_float(((uint32_t)v) << 16); }
typedef __bf16 bf16x2_hw __attribute__((ext_vector_type(2)));
__device__ __forceinline__ uint32_t pack2(float a, float b) {
  const float __attribute__((ext_vector_type(2))) v = {a, b};
  return __builtin_bit_cast(uint32_t, __builtin_convertvector(v, bf16x2_hw));
}
__device__ __forceinline__ bf16_t f2bf(float f) { return (bf16_t)(pack2(f, 0.f) & 0xffffu); }
#define DPP_F(v, ctrl) __int_as_float(__builtin_amdgcn_update_dpp(0, __float_as_int(v), (ctrl), 0xf, 0xf, true))
__device__ __forceinline__ float wave_sum(float v) {
  v += DPP_F(v, 0xB1);
  v += DPP_F(v, 0x4E);
  v += DPP_F(v, 0x141);
  v += DPP_F(v, 0x140);
  const int iv = __float_as_int(v);
  return __int_as_float(__builtin_amdgcn_readlane(iv, 0)) + __int_as_float(__builtin_amdgcn_readlane(iv, 16)) +
         __int_as_float(__builtin_amdgcn_readlane(iv, 32)) + __int_as_float(__builtin_amdgcn_readlane(iv, 48));
}
__device__ __forceinline__ float wave_max(float v) {
  v = fmaxf(v, DPP_F(v, 0xB1));
  v = fmaxf(v, DPP_F(v, 0x4E));
  v = fmaxf(v, DPP_F(v, 0x141));
  v = fmaxf(v, DPP_F(v, 0x140));
  const int iv = __float_as_int(v);
  return fmaxf(fmaxf(__int_as_float(__builtin_amdgcn_readlane(iv, 0)), __int_as_float(__builtin_amdgcn_readlane(iv, 16))),
               fmaxf(__int_as_float(__builtin_amdgcn_readlane(iv, 32)), __int_as_float(__builtin_amdgcn_readlane(iv, 48))));
}
__device__ __forceinline__ float fexp(float v) { return __builtin_amdgcn_exp2f(v * 1.44269504088896341f); }
__device__ __forceinline__ float silu_f(float v) { return v * __builtin_amdgcn_rcpf(1.f + fexp(-v)); }
__device__ __forceinline__ float softplus_f(float v) { return fmaxf(v, 0.f) + log1pf(expf(-fabsf(v))); }
__device__ __forceinline__ float gelu_f(float v) { return 0.5f * v * (1.f + erff(v * 0.70710678118654752f)); }

__device__ __forceinline__ void unpack8(const uint4 v, float* f) {
  f[0] = __uint_as_float(v.x << 16); f[1] = __uint_as_float(v.x & 0xffff0000u);
  f[2] = __uint_as_float(v.y << 16); f[3] = __uint_as_float(v.y & 0xffff0000u);
  f[4] = __uint_as_float(v.z << 16); f[5] = __uint_as_float(v.z & 0xffff0000u);
  f[6] = __uint_as_float(v.w << 16); f[7] = __uint_as_float(v.w & 0xffff0000u);
}
typedef float f32x2_t __attribute__((ext_vector_type(2)));
typedef unsigned u32x4_t __attribute__((ext_vector_type(4)));
typedef short s16x4 __attribute__((ext_vector_type(4)));
typedef __attribute__((address_space(3))) s16x4 lds_s16x4;
__device__ __forceinline__ bf16x8 tr_read2(const char* a0, const char* a1) {
  const s16x4 a = __builtin_amdgcn_ds_read_tr16_b64_v4i16((lds_s16x4*)a0);
  const s16x4 b = __builtin_amdgcn_ds_read_tr16_b64_v4i16((lds_s16x4*)a1);
  return (bf16x8){a[0], a[1], a[2], a[3], b[0], b[1], b[2], b[3]};
}

__device__ __forceinline__ const float* hrow(const float* hl, const float* hc, int row) {
  return row < NLAT ? hl + (size_t)row * DM : hc + (size_t)(row - NLAT) * DM;
}
__device__ __forceinline__ int modrow(int row) { return row < NLAT ? (row >> 12) : 4; }

namespace pg8 {
#define PG8_LAS __attribute__((address_space(3)))
typedef unsigned short bf16_t;
typedef short bf16x8 __attribute__((ext_vector_type(8)));
typedef float f32x4 __attribute__((ext_vector_type(4)));
typedef unsigned u32x4 __attribute__((ext_vector_type(4)));
constexpr int BM = 256, BK = 64, HALF = 128, HTB = HALF * BK * 2  , STAGE_BYTES = 8 * HTB, NXCD = 8, WGM = 8;

__host__ __device__ __forceinline__ int lds_byte(int r, int c) { const int st = (r >> 4) * 2 + (c >> 5), rr = r & 15, cc = c & 31, ob = rr * 64 + cc * 2; return st * 1024 + (ob ^ (((ob >> 9) & 1) << 5)); }
__host__ __device__ __forceinline__ void stage_rc(int b, int& R, int& C) { const int st = b / 1024, sb = b % 1024, swz = sb ^ (((sb >> 9) & 1) << 5); R = (st >> 1) * 16 + swz / 64; C = (st & 1) * 32 + (swz % 64) / 2; }
__host__ __device__ __forceinline__ int perm32(int rho) { const int n = rho >> 4, i = rho & 15; return 8 * (i >> 2) + 4 * n + (i & 3); }

struct Unit { int pm, pn; };
struct Gemm { const bf16_t* A; const bf16_t* Bt; int M, N, K; };

struct StaticOrder {
    int nM, nN, nwg, G, c;
    __host__ __device__ void init(int M, int N, int G_, int c_) { nM = M / BM; nN = N / BM; nwg = nM * nN; G = G_; c = c_; }
    __host__ __device__ bool next(int i, Unit& u) const {
        const long L = (long)i * G + c; if (L >= nwg) return false;
        int wgid = (int)L; { const int q = nwg / NXCD, r = nwg % NXCD, xcd = wgid % NXCD, off = wgid / NXCD; wgid = (xcd < r ? xcd * (q + 1) : r * (q + 1) + (xcd - r) * q) + off; }
        const int nig = WGM * nN, gid = wgid / nig, fm = gid * WGM, gsz = (nM - fm) < WGM ? (nM - fm) : WGM;
        u.pm = fm + ((wgid % nig) % gsz); u.pn = (wgid % nig) / gsz; return true;
    }
    __device__ __forceinline__ void a_ready(const Unit&) const {}
    __device__ __forceinline__ void done(const Unit&) const {}
};

__device__ __forceinline__ unsigned cvt_pk_bf16(float lo, float hi) { unsigned r; asm volatile("v_cvt_pk_bf16_f32 %0, %1, %2" : "=v"(r) : "v"(lo), "v"(hi)); return r; }
typedef float f32x2 __attribute__((ext_vector_type(2)));
__device__ __forceinline__ f32x2 gelu_pk(f32x2 v) { return v; }
template <int ACT  > struct EpiBf16 {
    static constexpr bool PERM = true, AFTER_DRAIN = false; static constexpr int MIDK_T = 0;
    bf16_t* O; int ldc; const float* bias; int split_cols; size_t split_stride;
    __device__ __forceinline__ void operator()(const f32x4 (&acc)[2][2][4][2], const Unit& u, int wr, int wc, int fr, int fq) const {
        const int row0 = u.pm * BM + wr * 64 + fr; int colt = u.pn * BM; bf16_t* base = O;
        if (split_cols) { const int t = colt / split_cols; base += (size_t)t * split_stride; colt -= t * split_cols; }
        const int col0 = colt + wc * 32 + 8 * fq, bcol0 = u.pn * BM + wc * 32 + 8 * fq;
        f32x4 bv[2][2];
#pragma unroll
        for (int bj = 0; bj < 2; ++bj)
#pragma unroll
            for (int n = 0; n < 2; ++n) bv[bj][n] = bias ? *(const f32x4*)(bias + bcol0 + bj * HALF + 4 * n) : (f32x4){0.f, 0.f, 0.f, 0.f};
#pragma unroll
        for (int ai = 0; ai < 2; ++ai)
#pragma unroll
            for (int m = 0; m < 4; ++m) { bf16_t* rowp = base + (size_t)(row0 + ai * HALF + m * 16) * ldc + col0;
#pragma unroll
                for (int bj = 0; bj < 2; ++bj) { f32x4 v0 = acc[ai][bj][m][0] + bv[bj][0], v1 = acc[ai][bj][m][1] + bv[bj][1];
                    if (ACT == 1) { f32x2 a = gelu_pk((f32x2){v0[0], v0[1]}), b = gelu_pk((f32x2){v0[2], v0[3]}), c = gelu_pk((f32x2){v1[0], v1[1]}), d = gelu_pk((f32x2){v1[2], v1[3]});
                        v0 = (f32x4){a.x, a.y, b.x, b.y}; v1 = (f32x4){c.x, c.y, d.x, d.y}; }
                    if (ACT == 2) {
#pragma unroll
                        for (int j = 0; j < 4; ++j) { v0[j] = 0.5f * v0[j] * (1.0f + erff(v0[j] * 0.70710678f)); v1[j] = 0.5f * v1[j] * (1.0f + erff(v1[j] * 0.70710678f)); } }
                    u32x4 w; w.x = cvt_pk_bf16(v0[0], v0[1]); w.y = cvt_pk_bf16(v0[2], v0[3]); w.z = cvt_pk_bf16(v1[0], v1[1]); w.w = cvt_pk_bf16(v1[2], v1[3]);
                    *(u32x4*)(rowp + bj * HALF) = w; } }
    }
};

template <class Epi, class Sched, bool STAMP = false>
__device__ __forceinline__ void gemm_phase(int wv, PG8_LAS unsigned char* lds, const Gemm g, const Sched& S, const Epi& E, unsigned long long* stamps) {
    const int tid = otid(wv), wid = __builtin_amdgcn_readfirstlane(tid >> 6), lane = tid & 63, wr = wid >> 2, wc = wid & 3, fr = lane & 15, fq = lane >> 4;
    const int K = g.K, nt = K / BK;
    int ts_lo = 0, ts_hi = 0, nts = 0; const unsigned long long rt_entry = STAMP ? (unsigned long long)wall_clock64() : 0ull;
#define PG8_STAMP() do { if (STAMP && wid == 0 && nts < 64) { const unsigned long long _c = (unsigned long long)clock64(); \
        ts_lo = (lane == nts) ? (int)(unsigned)_c : ts_lo; ts_hi = (lane == nts) ? (int)(unsigned)(_c >> 32) : ts_hi; ++nts; } } while (0)
    PG8_STAMP();
    unsigned voffA[2], voffB[2];
#pragma unroll
    for (int i = 0; i < 2; ++i) { int R, C; stage_rc(tid * 16 + i * 8192, R, C); const int Rb = Epi::PERM ? ((R & ~31) + perm32(R & 31)) : R;
        voffA[i] = (unsigned)(R * K + C) * 2u; voffB[i] = (unsigned)(Rb * K + C) * 2u; }
    const size_t kstep = (size_t)(BK * 2);
    const size_t hstep = (size_t)HALF * K * 2;
    const size_t tstep = 2 * hstep;
    const unsigned ldsw = (unsigned)wid * 1024u;
    const int aoff = lds_byte(wr * 64 + fr, fq * 8), boff = lds_byte(wc * 32 + fr, fq * 8);
#define PG8_SA(b, h) (((b) * 2 + (h)) * HTB)
#define PG8_SB(b, h) ((4 + (b) * 2 + (h)) * HTB)
#define PG8_STAGE(bufoff, gbase, voff) do { _Pragma("unroll") for (int _i = 0; _i < 2; ++_i) \
        __builtin_amdgcn_global_load_lds((const unsigned*)((const char*)(gbase) + (voff)[_i]), (PG8_LAS unsigned*)(lds + (bufoff) + ldsw + _i * 8192), 16, 0, 0); } while (0)
#define PG8_LDA(dst, b, h) do { _Pragma("unroll") for (int m = 0; m < 4; ++m) _Pragma("unroll") for (int k = 0; k < 2; ++k) dst[m][k] = *(const PG8_LAS bf16x8*)(lds + PG8_SA(b, h) + aoff + m * 2048 + k * 1024); } while (0)
#define PG8_LDB(dst, b, h) do { _Pragma("unroll") for (int n = 0; n < 2; ++n) _Pragma("unroll") for (int k = 0; k < 2; ++k) dst[n][k] = *(const PG8_LAS bf16x8*)(lds + PG8_SB(b, h) + boff + n * 2048 + k * 1024); } while (0)
#define PG8_MMA(ai, bj, At, Bt) do { __builtin_amdgcn_s_setprio(1); _Pragma("unroll") for (int m = 0; m < 4; ++m) _Pragma("unroll") for (int n = 0; n < 2; ++n) _Pragma("unroll") for (int k = 0; k < 2; ++k) \
        acc[ai][bj][m][n] = __builtin_amdgcn_mfma_f32_16x16x32_bf16(Bt[n][k], At[m][k], acc[ai][bj][m][n], 0, 0, 0); __builtin_amdgcn_s_setprio(0); } while (0)
#define PG8_WAIT_V(n) asm volatile("s_waitcnt vmcnt(" #n ")" ::: "memory")
#define PG8_WAIT_L(n) asm volatile("s_waitcnt lgkmcnt(" #n ")" ::: "memory")
#define PG8_BAR __builtin_amdgcn_s_barrier()
#define PG8_SCHED __builtin_amdgcn_sched_barrier(0)
    Unit cur, nxt; int ui = 0;
    if (!S.next(0, cur)) return;
    f32x4 acc[2][2][4][2];
#pragma unroll
    for (int a = 0; a < 2; ++a)
#pragma unroll
        for (int b = 0; b < 2; ++b)
#pragma unroll
            for (int m = 0; m < 4; ++m)
#pragma unroll
                for (int n = 0; n < 2; ++n) acc[a][b][m][n] = (f32x4){0.f, 0.f, 0.f, 0.f};
    bf16x8 At[4][2], B0[2][2], B1[2][2];
    const char* cA = (const char*)g.A + (size_t)cur.pm * tstep; const char* cB = (const char*)g.Bt + (size_t)cur.pn * tstep;
    S.a_ready(cur);
    PG8_STAGE(PG8_SB(0, 0), cB, voffB); PG8_STAGE(PG8_SA(0, 0), cA, voffA); PG8_STAGE(PG8_SB(0, 1), cB + hstep, voffB); PG8_STAGE(PG8_SA(0, 1), cA + hstep, voffA);
    if (wr == 1) PG8_BAR;
    PG8_WAIT_V(4); PG8_BAR;
    PG8_STAGE(PG8_SB(1, 0), cB + kstep, voffB); PG8_STAGE(PG8_SA(1, 0), cA + kstep, voffA); PG8_STAGE(PG8_SB(1, 1), cB + hstep + kstep, voffB);
    PG8_WAIT_V(6); PG8_BAR;
    PG8_STAMP();
    for (;;) {
        const bool has_next = S.next(ui + 1, nxt);
        const char* nA = has_next ? (const char*)g.A + (size_t)nxt.pm * tstep : cA; const char* nB = has_next ? (const char*)g.Bt + (size_t)nxt.pn * tstep : cB;
        for (int t = 0; t < nt; t += 2) {
            if constexpr (Epi::MIDK_T > 0) { if (t == Epi::MIDK_T) E.midk(acc, cur, wr, wc, fr, fq); }
            const bool last = (t == nt - 2);
            const char* a1 = cA + (size_t)(t + 1) * kstep;
            const char* a2 = last ? nA : cA + (size_t)(t + 2) * kstep; const char* b2 = last ? nB : cB + (size_t)(t + 2) * kstep;
            const char* a3 = a2 + kstep; const char* b3 = b2 + kstep;
            if (last && has_next) S.a_ready(nxt);
            PG8_LDB(B0, 0, 0); PG8_SCHED; PG8_LDA(At, 0, 0); PG8_STAGE(PG8_SA(1, 1), a1 + hstep, voffA);
            PG8_WAIT_L(8); PG8_BAR; PG8_WAIT_L(0); PG8_MMA(0, 0, At, B0); PG8_BAR; PG8_SCHED;
            PG8_LDB(B1, 0, 1); PG8_STAGE(PG8_SB(0, 0), b2, voffB);
            PG8_BAR; PG8_WAIT_L(0); PG8_MMA(0, 1, At, B1); PG8_BAR;
            PG8_LDA(At, 0, 1); PG8_STAGE(PG8_SA(0, 0), a2, voffA);
            PG8_BAR; PG8_WAIT_L(0); PG8_MMA(1, 0, At, B0); PG8_BAR; PG8_SCHED;
            PG8_STAGE(PG8_SB(0, 1), b2 + hstep, voffB);
            PG8_WAIT_V(6); PG8_BAR; PG8_MMA(1, 1, At, B1); PG8_BAR;
            PG8_LDB(B0, 1, 0); PG8_SCHED; PG8_LDA(At, 1, 0); PG8_STAGE(PG8_SA(0, 1), a2 + hstep, voffA);
            PG8_WAIT_L(8); PG8_BAR; PG8_WAIT_L(0); PG8_MMA(0, 0, At, B0); PG8_BAR; PG8_SCHED;
            PG8_LDB(B1, 1, 1); PG8_STAGE(PG8_SB(1, 0), b3, voffB);
            PG8_BAR; PG8_WAIT_L(0); PG8_MMA(0, 1, At, B1); PG8_BAR;
            PG8_LDA(At, 1, 1); PG8_STAGE(PG8_SA(1, 0), a3, voffA);
            PG8_BAR; PG8_WAIT_L(0); PG8_MMA(1, 0, At, B0); PG8_BAR; PG8_SCHED;
            PG8_STAGE(PG8_SB(1, 1), b3 + hstep, voffB);
            PG8_WAIT_V(6); PG8_BAR; PG8_MMA(1, 1, At, B1); PG8_BAR;
        }
        PG8_STAMP();
        if constexpr (!Epi::AFTER_DRAIN) { E(acc, cur, wr, wc, fr, fq); S.done(cur); }
        PG8_STAMP();
        if (!has_next) break;
#pragma unroll
        for (int a = 0; a < 2; ++a)
#pragma unroll
            for (int b = 0; b < 2; ++b)
#pragma unroll
                for (int m = 0; m < 4; ++m)
#pragma unroll
                    for (int n = 0; n < 2; ++n) acc[a][b][m][n] = (f32x4){0.f, 0.f, 0.f, 0.f};
        cur = nxt; cA = nA; cB = nB; ++ui;
    }
    PG8_WAIT_V(0);
    if (wr == 0) PG8_BAR;
    PG8_BAR;
    if constexpr (Epi::AFTER_DRAIN) { E.fused(acc, cur, wr, wc, fr, fq, lds, wid, lane); S.done(cur); }
    PG8_STAMP();
    if (STAMP && wid == 0) { stamps[lane] = lane < nts ? (((unsigned long long)(unsigned)ts_hi << 32) | (unsigned)ts_lo) : 0ull;
        if (lane == 62) stamps[62] = rt_entry; if (lane == 63) stamps[63] = (unsigned long long)wall_clock64(); }
#undef PG8_STAMP
#undef PG8_SA
#undef PG8_SB
#undef PG8_STAGE
#undef PG8_LDA
#undef PG8_LDB
#undef PG8_MMA
#undef PG8_WAIT_V
#undef PG8_WAIT_L
#undef PG8_BAR
#undef PG8_SCHED
}
}

#define XB_TMO      128
#define XB_XCNT(j)  (256  + 64 * (j))
#define XB_XSUB(j)  (1280 + 64 * (j))
#define XB_XGEN(j)  (2304 + 64 * (j))
#define XB_TOP      3328
#define XB_TOPGEN   3392
#define XCD_BAR_WORDS 3456
#define XB_SPIN_CAP (1u << 27)
#define LAS __attribute__((address_space(3)))

__device__ __forceinline__ unsigned xb_ld(unsigned* p)              { return __hip_atomic_load(p, __ATOMIC_RELAXED, __HIP_MEMORY_SCOPE_AGENT); }
__device__ __forceinline__ unsigned xb_add(unsigned* p, unsigned v) { return __hip_atomic_fetch_add(p, v, __ATOMIC_RELAXED, __HIP_MEMORY_SCOPE_AGENT); }
__device__ __forceinline__ unsigned xb_xcc_id() { return (unsigned)__builtin_amdgcn_s_getreg((3 << 11) | 20) & 0xFu; }
#define XB_SPIN(cond, bar) do { unsigned _sp = 0; while (cond) { __builtin_amdgcn_s_sleep(1); \
    if ((++_sp & 255u) == 0u) { if (xb_ld(&(bar)[XB_TMO])) break; if (_sp > XB_SPIN_CAP) { atomicAdd(&(bar)[XB_TMO], 1u); break; } } } } while (0)

struct XcdBarrier {
    unsigned* bar; unsigned x;
    volatile LAS unsigned* st;
};

__device__ __forceinline__ XcdBarrier xcd_barrier_post(unsigned* bar, volatile LAS unsigned* st, bool xb_t0) {
    XcdBarrier b; b.bar = bar; b.x = xb_xcc_id(); b.st = st;
    if (xb_t0) (void)xb_add(&bar[XB_XCNT(b.x)], 1u);
    return b;
}
__device__ __forceinline__ void xcd_barrier_complete(unsigned* bar, unsigned x, unsigned& nloc, unsigned& nx) {
    const unsigned G = gridDim.x * gridDim.y * gridDim.z;
    unsigned sum, cnt, mine, sp = 0u;
    for (;;) {
        sum = 0u; cnt = 0u; mine = 0u;
#pragma unroll
        for (unsigned j = 0; j < 16; ++j) { const unsigned c = xb_ld(&bar[XB_XCNT(j)]); sum += c; cnt += (c > 0u) ? 1u : 0u; mine = (j == x) ? c : mine; }
        if (sum == G) break;
        __builtin_amdgcn_s_sleep(1);
        if ((++sp & 255u) == 0u) { if (xb_ld(&bar[XB_TMO])) break; if (sp > XB_SPIN_CAP) { atomicAdd(&bar[XB_TMO], 1u); break; } }
    }
    nloc = mine > 0u ? mine : 1u; nx = cnt > 0u ? cnt : 1u;
}

__device__ __forceinline__ void xcd_barrier(const XcdBarrier& b, bool xb_t0) {
    asm volatile("s_waitcnt vmcnt(0)" ::: "memory");
    __syncthreads();
    if (xb_t0) {
        unsigned* bar = b.bar;
        __builtin_amdgcn_s_waitcnt(0);
        unsigned nloc = b.st[0], nx = b.st[1];
        if (nloc == 0u) { xcd_barrier_complete(bar, b.x, nloc, nx); b.st[0] = nloc; b.st[1] = nx; }
        const unsigned old = xb_add(&bar[XB_XSUB(b.x)], 1u);
        const unsigned gen = old / nloc;
        if (old + 1u == (gen + 1u) * nloc) {
            __builtin_amdgcn_fence(__ATOMIC_RELEASE, "agent");
            asm volatile("s_waitcnt vmcnt(0)" ::: "memory");
            const unsigned og = xb_add(&bar[XB_TOP], 1u);
            const unsigned tg = og / nx;
            if (og + 1u == (tg + 1u) * nx) xb_add(&bar[XB_TOPGEN], 1u);
            else XB_SPIN(xb_ld(&bar[XB_TOPGEN]) == tg, bar);
            __builtin_amdgcn_fence(__ATOMIC_ACQUIRE, "agent");
            xb_add(&bar[XB_XGEN(b.x)], 1u);
            asm volatile("s_waitcnt vmcnt(0)" ::: "memory");
        } else {
            XB_SPIN(xb_ld(&bar[XB_XGEN(b.x)]) == gen, bar);
            __builtin_amdgcn_fence(__ATOMIC_ACQUIRE, "agent");
            asm volatile("s_waitcnt vmcnt(0)" ::: "memory");
        }
    }
    __syncthreads();
}


__device__ void ph_transpose(int wv, const float* __restrict__ src, bf16_t* __restrict__ dst, int K, int N, int Npad,
                             int col0, int skip_from, int skip, int nvalid, float* tile, int bid, int nb,
                             const float* kscale = nullptr, int kscale_n = 0) {
  const int tk = K / 64, tn = Npad / 64;
  const int tid = otid(wv);
  for (int t = bid; t < tk * tn; t += nb) {
    const int kt = t / tn, nt = t % tn;
    __syncthreads();
#pragma unroll
    for (int i = 0; i < 2; ++i) {
      const int idx = tid + i * 512, kk = idx >> 4, n4 = (idx & 15) * 4;
      const int k = kt * 64 + kk, n = nt * 64 + n4;
      const int cc = col0 + n + (n >= skip_from ? skip : 0);
      const float ks = (kscale != nullptr && k < kscale_n) ? kscale[k] : 1.f;
      float4 v = make_float4(0.f, 0.f, 0.f, 0.f);
      if (n < nvalid) v = *(const float4*)(src + (size_t)k * N + cc);
      tile[kk * 65 + n4 + 0] = v.x * ks; tile[kk * 65 + n4 + 1] = v.y * ks; tile[kk * 65 + n4 + 2] = v.z * ks; tile[kk * 65 + n4 + 3] = v.w * ks;
    }
    __syncthreads();
    {
      const int nn = tid >> 3, k8 = (tid & 7) * 8;
      float f[8];
#pragma unroll
      for (int e = 0; e < 8; ++e) f[e] = tile[(k8 + e) * 65 + nn];
      *(uint4*)(dst + (size_t)(nt * 64 + nn) * K + kt * 64 + k8) = make_uint4(pack2(f[0], f[1]), pack2(f[2], f[3]), pack2(f[4], f[5]), pack2(f[6], f[7]));
    }
  }
}

__device__ void ph_mod(int wv, const Params& P, float* sm, int bid, int nb) {
  const int tid = otid(wv);
  float* sv = sm;
  float* red = sm + 5 * 1024;
  for (int i = tid; i < 5 * 1024; i += NTHR) {
    const float v = (i < 4096) ? P.c[i] : P.c_ctx[i - 4096];
    sv[i] = silu_f(v);
  }
  __syncthreads();
  const int c4 = tid & 15, kg = tid >> 4;
  for (int it = bid; it < 192; it += nb) {
    const int layer = it / 96, cb = it % 96;
    const float4* W = (const float4*)(P.ada_w + (size_t)layer * 1024 * MODW + cb * 64) + c4;
    float4 a[5];
#pragma unroll
    for (int r = 0; r < 5; ++r) a[r] = make_float4(0.f, 0.f, 0.f, 0.f);
#pragma unroll 8
    for (int kk = 0; kk < 32; ++kk) {
      const int k = kg * 32 + kk;
      const float4 w = W[(size_t)k * (MODW / 4)];
#pragma unroll
      for (int r = 0; r < 5; ++r) {
        const float s = sv[r * 1024 + k];
        a[r].x += s * w.x; a[r].y += s * w.y; a[r].z += s * w.z; a[r].w += s * w.w;
      }
    }
#pragma unroll
    for (int r = 0; r < 5; ++r) *(float4*)(red + ((kg * 16 + c4) * 5 + r) * 4) = a[r];
    __syncthreads();
    if (tid < 320) {
      const int r = tid >> 6, c = tid & 63;
      float s = 0.f;
      for (int g = 0; g < 32; ++g) s += red[((g * 16 + (c >> 2)) * 5 + r) * 4 + (c & 3)];
      P.mod()[(size_t)(layer * 5 + r) * MODW + cb * 64 + c] = s + P.ada_b[layer * MODW + cb * 64 + c];
    }
    __syncthreads();
  }
}

__device__ void ph_norm(int wv, const float* hl, const float* hc, const float* __restrict__ g, const float* __restrict__ modl,
                        int shift_off, int scale_off, int nrows, bf16_t* __restrict__ dst, int bid, int nb) {
  const int wave = otid(wv) >> 6, lane = otid(wv) & 63;
  const int stride = nb * NWAVE;
  for (int row0 = bid * NWAVE + wave; row0 < nrows; row0 += 2 * stride) {
    const int row1 = row0 + stride;
    const bool two = row1 < nrows;
    const int rows[2] = {row0, two ? row1 : row0};
    f32x4 v[2][4], ggv[4], scv[2][4], shv[2][4];
#pragma unroll
    for (int r = 0; r < 2; ++r) {
      const float* src = hrow(hl, hc, rows[r]);
      const float* mr = modl + (size_t)modrow(rows[r]) * MODW;
#pragma unroll
      for (int i = 0; i < 4; ++i) {
        const int idx = i * 256 + lane * 4;
        v[r][i] = *(const f32x4*)(src + idx);
        scv[r][i] = *(const f32x4*)(mr + scale_off + idx); shv[r][i] = *(const f32x4*)(mr + shift_off + idx);
      }
    }
#pragma unroll
    for (int i = 0; i < 4; ++i) ggv[i] = *(const f32x4*)(g + i * 256 + lane * 4);
#pragma unroll
    for (int r = 0; r < 2; ++r)
#pragma unroll
      for (int i = 0; i < 4; ++i) asm volatile("" : "+v"(v[r][i]), "+v"(scv[r][i]), "+v"(shv[r][i]));
#pragma unroll
    for (int r = 0; r < 2; ++r) {
      float ss = 0.f;
#pragma unroll
      for (int i = 0; i < 4; ++i) ss += v[r][i][0] * v[r][i][0] + v[r][i][1] * v[r][i][1] + v[r][i][2] * v[r][i][2] + v[r][i][3] * v[r][i][3];
      ss = wave_sum(ss);
      const float rstd = rsqrtf(ss * (1.f / 1024.f) + 1e-6f);
      if (r == 0 || two) {
#pragma unroll
        for (int i = 0; i < 4; ++i) {
          const int idx = i * 256 + lane * 4;
          const float o0 = v[r][i][0] * rstd * ggv[i][0] * (1.f + scv[r][i][0]) + shv[r][i][0];
          const float o1 = v[r][i][1] * rstd * ggv[i][1] * (1.f + scv[r][i][1]) + shv[r][i][1];
          const float o2 = v[r][i][2] * rstd * ggv[i][2] * (1.f + scv[r][i][2]) + shv[r][i][2];
          const float o3 = v[r][i][3] * rstd * ggv[i][3] * (1.f + scv[r][i][3]) + shv[r][i][3];
          *(uint2*)(dst + (size_t)rows[r] * DM + idx) = make_uint2(pack2(o0, o1), pack2(o2, o3));
        }
      }
    }
  }
}

__device__ void ph_conv(int wv, const Params& P, int layer, int bid, int nb) {
  const float* cw = P.conv_w + (size_t)layer * 3 * 1536;
  const float* cb = P.conv_b + (size_t)layer * 1536;
  const int total = (NTOK / 4) * 192;
  for (int it = bid * NTHR + otid(wv); it < total; it += nb * NTHR) {
    const int rq = it / 192, c8 = (it % 192) * 8, row0 = rq * 4;
    int l, L;
    if (row0 < NLAT) { l = row0 & 4095; L = 4096; } else { l = (row0 - NLAT) & 255; L = 256; }
    const bf16_t* pc = P.p() + (size_t)row0 * PW + OFF_XBC + c8;
    u32x4_t rv[6];
    rv[0] = *(const u32x4_t*)(pc - (l > 0 ? PW : 0));
#pragma unroll
    for (int i = 0; i < 4; ++i) rv[1 + i] = *(const u32x4_t*)(pc + (size_t)i * PW);
    rv[5] = *(const u32x4_t*)(pc + (size_t)(l + 4 < L ? 4 : 3) * PW);
#pragma unroll
    for (int i = 0; i < 6; ++i) asm volatile("" : "+v"(rv[i]));
    float f[6][8];
#pragma unroll
    for (int i = 0; i < 6; ++i) unpack8(make_uint4(rv[i].x, rv[i].y, rv[i].z, rv[i].w), f[i]);
    const float mp = l > 0 ? 1.f : 0.f, mn = l + 4 < L ? 1.f : 0.f;
    float o[4][8];
#pragma unroll
    for (int e = 0; e < 8; ++e) {
      const int c = c8 + e;
      const float w0 = cw[c], w1 = cw[1536 + c], w2 = cw[3072 + c], bb = cb[c];
#pragma unroll
      for (int i = 0; i < 4; ++i) {
        const float pv = i == 0 ? mp * f[0][e] : f[i][e];
        const float nv = i == 3 ? mn * f[5][e] : f[i + 2][e];
        o[i][e] = silu_f(bb + w0 * pv + w1 * f[i + 1][e] + w2 * nv);
      }
    }
    if (c8 < 1024) {
      const int head = c8 >> 6, p0 = c8 & 63;
      bf16_t* dst = P.xt4() + (((size_t)head * (NTOK / 4) + rq) * 64 + p0) * 4;
#pragma unroll
      for (int e2 = 0; e2 < 4; ++e2)
        *(uint4*)(dst + e2 * 8) = make_uint4(pack2(o[0][2 * e2], o[1][2 * e2]), pack2(o[2][2 * e2], o[3][2 * e2]),
                                             pack2(o[0][2 * e2 + 1], o[1][2 * e2 + 1]), pack2(o[2][2 * e2 + 1], o[3][2 * e2 + 1]));
    } else {
      {
        const int cc = (c8 - 1024) & 255, grp_ = cc >> 7, n0_ = cc & 127;
        bf16_t* fb = (c8 < 1280 ? P.bfr() : P.cfr()) + ((((size_t)grp_ * (NTOK / 16) + (row0 >> 4)) * 4 + (n0_ >> 5)) * 16 + (row0 & 15)) * 32 + (n0_ & 31);
#pragma unroll
        for (int i = 0; i < 4; ++i)
          *(uint4*)(fb + i * 32) = make_uint4(pack2(o[i][0], o[i][1]), pack2(o[i][2], o[i][3]), pack2(o[i][4], o[i][5]), pack2(o[i][6], o[i][7]));
      }
      if (c8 < 1280) {
        const int grp = (c8 - 1024) >> 7, n0 = (c8 - 1024) & 127;
        bf16_t* dst = P.bt4() + (((size_t)grp * (NTOK / 4) + rq) * 128 + n0) * 4;
#pragma unroll
        for (int e2 = 0; e2 < 4; ++e2)
          *(uint4*)(dst + e2 * 8) = make_uint4(pack2(o[0][2 * e2], o[1][2 * e2]), pack2(o[2][2 * e2], o[3][2 * e2]),
                                               pack2(o[0][2 * e2 + 1], o[1][2 * e2 + 1]), pack2(o[2][2 * e2 + 1], o[3][2 * e2 + 1]));
      }
    }
  }
}

__device__ void ph_dtprep(int wv, const Params& P, int layer, char* smem, int first, int step) {
  const int tid = otid(wv), lane = tid & 63, li = lane & 15, g = lane >> 4;
  float* tile = (float*)smem;
  float* segtot = tile + 128 * 33;
  const int dh = tid & 31, seg = tid >> 5;
  const float bias = P.dt_bias[layer * 32 + dh];
  const float ah = -expf(P.a_log[layer * 32 + dh]);
  const bf16_t* wb = P.w_dtT() + (size_t)layer * 128 * 1024 + (size_t)li * 1024 + 8 * g;
  for (int gc = first; gc < NCHUNK; gc += step) {
    const bf16_t* ua = P.u() + (size_t)(gc * 128 + wv * 16 + li) * DM + 8 * g;
    f32x4 acc0 = (f32x4){0.f, 0.f, 0.f, 0.f}, acc1 = acc0;
#pragma unroll 1
    for (int t0 = 0; t0 < 32; t0 += 8) {
      bf16x8 a[8], b0[8], b1[8];
#pragma unroll
      for (int t = 0; t < 8; ++t) {
        a[t] = *(const bf16x8*)(ua + 32 * (t0 + t));
        b0[t] = *(const bf16x8*)(wb + 32 * (t0 + t));
        b1[t] = *(const bf16x8*)(wb + 16 * 1024 + 32 * (t0 + t));
      }
#pragma unroll
      for (int t = 0; t < 8; ++t) asm volatile("" : "+v"(a[t]), "+v"(b0[t]), "+v"(b1[t]));
#pragma unroll
      for (int t = 0; t < 8; ++t) {
        acc0 = __builtin_amdgcn_mfma_f32_16x16x32_bf16(a[t], b0[t], acc0, 0, 0, 0);
        acc1 = __builtin_amdgcn_mfma_f32_16x16x32_bf16(a[t], b1[t], acc1, 0, 0, 0);
      }
    }
    __syncthreads();
#pragma unroll
    for (int e = 0; e < 4; ++e) {
      tile[(wv * 16 + 4 * g + e) * 33 + li] = acc0[e];
      tile[(wv * 16 + 4 * g + e) * 33 + 16 + li] = acc1[e];
    }
    __syncthreads();
    float r[8], c[8];
    float cs = 0.f;
#pragma unroll
    for (int j = 0; j < 8; ++j) { r[j] = softplus_f(tile[(seg * 8 + j) * 33 + dh] + bias); cs += r[j] * ah; c[j] = cs; }
    segtot[seg * 32 + dh] = cs;
    __syncthreads();
    float off = 0.f, tot = 0.f;
    for (int s = 0; s < 16; ++s) { const float v = segtot[s * 32 + dh]; if (s < seg) off += v; tot += v; }
    const size_t base = ((size_t)(gc * 32 + dh) * 128 + seg * 8);
    float cso[8], wso[8];
#pragma unroll
    for (int j = 0; j < 8; ++j) {
      const float csj = off + c[j], csp = j == 0 ? off : off + c[j - 1];
      cso[j] = dh < 16 ? csj : csp;
      wso[j] = r[j] * (dh < 16 ? fexp(tot - csj) : fexp(csp));
    }
#pragma unroll
    for (int q = 0; q < 2; ++q) {
      *(float4*)(P.cst() + base + q * 4) = make_float4(cso[q * 4], cso[q * 4 + 1], cso[q * 4 + 2], cso[q * 4 + 3]);
      *(float4*)(P.dtt() + base + q * 4) = make_float4(r[q * 4], r[q * 4 + 1], r[q * 4 + 2], r[q * 4 + 3]);
      *(float4*)(P.wst() + base + q * 4) = make_float4(wso[q * 4], wso[q * 4 + 1], wso[q * 4 + 2], wso[q * 4 + 3]);
    }
    if (seg == 0) P.atot()[gc * 32 + dh] = tot;
  }
}

__device__ __forceinline__ int scan_chunk(int b, int dir, int s) {
  if (dir == 0) return (s < 2) ? (128 + 2 * b + s) : (32 * b + (s - 2));
  return (s < 2) ? (128 + 2 * b + 1 - s) : (32 * b + 31 - (s - 2));
}
__device__ void ph_scan(int wv, const Params& P, int bid, int nb) {
  const int total = 4 * 32 * 1024;
  for (int it = bid * NTHR + otid(wv); it < total; it += nb * NTHR) {
    const int e8 = it & 1023, dh = (it >> 10) & 31, b = it >> 15, dir = dh >> 4;
    float S[8];
    float zero_ = 0.f;
    asm volatile("" : "+v"(zero_));
#pragma unroll
    for (int i = 0; i < 8; ++i) S[i] = zero_;
#pragma unroll
    for (int hb = 0; hb < 2; ++hb) {
      u32x4_t v[17];
      float at[17];
#pragma unroll
      for (int s = 0; s < 17; ++s) {
        const int gc = scan_chunk(b, dir, hb * 17 + s);
        v[s] = *(const u32x4_t*)(P.states() + (size_t)(gc * 32 + dh) * 8192 + e8 * 8);
        at[s] = P.atot()[gc * 32 + dh];
      }
#pragma unroll
      for (int s = 0; s < 17; ++s) asm volatile("" : "+v"(v[s]));
#pragma unroll
      for (int s = 0; s < 17; ++s) {
        const int gc = scan_chunk(b, dir, hb * 17 + s);
        const float dec = fexp(at[s]);
        float cst[8];
        unpack8(make_uint4(v[s].x, v[s].y, v[s].z, v[s].w), cst);
        *(uint4*)(P.states() + (size_t)(gc * 32 + dh) * 8192 + e8 * 8) =
            make_uint4(pack2(S[0], S[1]), pack2(S[2], S[3]), pack2(S[4], S[5]), pack2(S[6], S[7]));
#pragma unroll
        for (int i = 0; i < 8; ++i) S[i] = dec * S[i] + cst[i];
      }
    }
  }
}

__device__ __forceinline__ void conv_x8(const Params& P, int layer, int row, int ch0, float* out) {
  int l, L;
  if (row < NLAT) { l = row & 4095; L = 4096; } else { l = (row - NLAT) & 255; L = 256; }
  const bf16_t* pc = P.p() + (size_t)row * PW + OFF_XBC + ch0;
  const uint4 cur = *(const uint4*)pc;
  const uint4 prv = *(const uint4*)(pc - (l > 0 ? PW : 0));
  const uint4 nxt = *(const uint4*)(pc + (l < L - 1 ? PW : 0));
  const float mp = l > 0 ? 1.f : 0.f, mn = l < L - 1 ? 1.f : 0.f;
  float fp[8], fc[8], fn[8];
  unpack8(prv, fp); unpack8(cur, fc); unpack8(nxt, fn);
  const float* cw = P.conv_w + (size_t)layer * 3 * 1536 + ch0;
  const float* cb = P.conv_b + (size_t)layer * 1536 + ch0;
#pragma unroll
  for (int e = 0; e < 8; ++e) out[e] = silu_f(cb[e] + cw[e] * (mp * fp[e]) + cw[1536 + e] * fc[e] + cw[3072 + e] * (mn * fn[e]));
}

constexpr int XS = 72;
constexpr int BS = 136;


__device__ __forceinline__ bool ssd_item(int round, int bid, int nb, int nchunks, int& gc, int& head) {
  if ((nb & 63) == 0) {
    const int x = bid & 7, j = bid >> 3, per = nb >> 6;
    const int cg = (round * per + (j >> 3)) * 8 + x;
    if (cg >= nchunks * 2) return false;
    gc = cg >> 1; head = (cg & 1) * 8 + (j & 7);
    return true;
  }
  const int it = round * nb + bid;
  if (it >= nchunks * 16) return false;
  gc = it >> 4; head = it & 15;
  return true;
}

__device__ void ph_states_mfma(int wv, const Params& P, int layer, char* smem, int bid, int nb) {
  const int lane = otid(wv) & 63, li = lane & 15, g = lane >> 4;
  const int nq = wv >> 1, ph = wv & 1;
  for (int round = 0;; ++round) {
    int gc, head;
    if (!ssd_item(round, bid, nb, NCHUNK, gc, head)) break;
    const int grp = head >> 3, q0 = gc * 32;
    const bf16_t* xb = P.xt4() + (((size_t)head * (NTOK / 4) + q0 + g) * 64 + ph * 32 + li) * 4;
    const bf16_t* bb = P.bt4() + (((size_t)grp * (NTOK / 4) + q0 + g) * 128 + nq * 32 + li) * 4;
    const float* wpf = P.wst() + (size_t)(gc * 32 + head) * 128 + 4 * g;
    const float* wpb = wpf + 16 * 128;
    f32x4 acc[2][2][2];
#pragma unroll
    for (int d = 0; d < 2; ++d)
#pragma unroll
      for (int a = 0; a < 2; ++a)
#pragma unroll
        for (int b = 0; b < 2; ++b) acc[d][a][b] = (f32x4){0.f, 0.f, 0.f, 0.f};
#pragma unroll
    for (int t = 0; t < 4; ++t) {
      s16x4 alo[2], ahi[2], xlo[2], xhi[2];
      f32x4 wfl, wfh, wbl, wbh;
#pragma unroll
      for (int i = 0; i < 2; ++i) {
        alo[i] = *(const s16x4*)(bb + ((size_t)(t * 8) * 128 + i * 16) * 4);
        ahi[i] = *(const s16x4*)(bb + ((size_t)(t * 8 + 4) * 128 + i * 16) * 4);
        xlo[i] = *(const s16x4*)(xb + ((size_t)(t * 8) * 64 + i * 16) * 4);
        xhi[i] = *(const s16x4*)(xb + ((size_t)(t * 8 + 4) * 64 + i * 16) * 4);
      }
      wfl = *(const f32x4*)(wpf + 32 * t); wfh = *(const f32x4*)(wpf + 32 * t + 16);
      wbl = *(const f32x4*)(wpb + 32 * t); wbh = *(const f32x4*)(wpb + 32 * t + 16);
      asm volatile("" : "+v"(alo[0]), "+v"(alo[1]), "+v"(ahi[0]), "+v"(ahi[1]));
      bf16x8 af[2];
#pragma unroll
      for (int i = 0; i < 2; ++i) af[i] = (bf16x8){alo[i][0], alo[i][1], alo[i][2], alo[i][3], ahi[i][0], ahi[i][1], ahi[i][2], ahi[i][3]};
#pragma unroll
      for (int d = 0; d < 2; ++d) {
        const f32x4 wl = d == 0 ? wfl : wbl, wh = d == 0 ? wfh : wbh;
#pragma unroll
        for (int b = 0; b < 2; ++b) {
          bf16x8 bfrag;
#pragma unroll
          for (int i = 0; i < 4; ++i) {
            bfrag[i] = (short)f2bf(bf2f((bf16_t)xlo[b][i]) * wl[i]);
            bfrag[4 + i] = (short)f2bf(bf2f((bf16_t)xhi[b][i]) * wh[i]);
          }
#pragma unroll
          for (int a = 0; a < 2; ++a) acc[d][a][b] = __builtin_amdgcn_mfma_f32_16x16x32_bf16(af[a], bfrag, acc[d][a][b], 0, 0, 0);
        }
      }
    }
#pragma unroll
    for (int d = 0; d < 2; ++d) {
      bf16_t* dst = P.states() + (size_t)(gc * 32 + d * 16 + head) * 8192;
#pragma unroll
      for (int a = 0; a < 2; ++a)
#pragma unroll
        for (int b = 0; b < 2; ++b) {
          uint2 o;
          o.x = pack2(acc[d][a][b][0], acc[d][a][b][1]); o.y = pack2(acc[d][a][b][2], acc[d][a][b][3]);
          *(uint2*)(dst + ((nq * 4 + 2 * ph + b) * 16 + li) * 32 + 16 * a + 4 * g) = o;
        }
    }
  }
}

__device__ void ph_ssdy_mfma(int wv, const Params& P, int layer, int nchunks, char* smem, int bid, int nb) {
  const int tid = otid(wv), lane = tid & 63, li = lane & 15, g = lane >> 4;
  float* tabs = (float*)smem;
  char* bbuf = smem + 4096;
  char* xbuf = bbuf + 65536;
  char* sbufS = xbuf + 32768;
  u32x4_t pf[10];
  float pft = 0.f;
#pragma unroll
  for (int i = 0; i < 10; ++i) pf[i] = (u32x4_t){0u, 0u, 0u, 0u};
#define SSDY_FETCH(gc_, head_) do { const int grp_ = (head_) >> 3; \
      const char* bsrc_ = (const char*)(P.bfr() + ((size_t)grp_ * (NTOK / 16) + (gc_) * 8) * 4 * 16 * 32); \
      const char* xsrc_ = (const char*)(P.xt4() + ((size_t)(head_) * (NTOK / 4) + (gc_) * 32) * 64 * 4); \
      _Pragma("unroll") for (int i_ = 0; i_ < 4; ++i_) pf[i_] = *(const u32x4_t*)(bsrc_ + (size_t)(tid + i_ * 512) * 16); \
      _Pragma("unroll") for (int i_ = 0; i_ < 2; ++i_) pf[4 + i_] = *(const u32x4_t*)(xsrc_ + (size_t)(tid + i_ * 512) * 16); \
      _Pragma("unroll") for (int i_ = 0; i_ < 4; ++i_) { const int c_ = tid + i_ * 512; \
        pf[6 + i_] = *(const u32x4_t*)((const char*)(P.states() + (size_t)((gc_) * 32 + (c_ >> 10) * 16 + (head_)) * 8192) + (size_t)(c_ & 1023) * 16); } \
      { const int arr_ = tid >> 7, j_ = tid & 127; \
        pft = ((arr_ & 1) ? P.dtt() : P.cst())[(size_t)((gc_) * 32 + (arr_ >> 1) * 16 + (head_)) * 128 + j_]; } } while (0)
#define SSDY_PUT_S() do { _Pragma("unroll") for (int i_ = 0; i_ < 4; ++i_) *(u32x4_t*)(sbufS + (size_t)(tid + i_ * 512) * 16) = pf[6 + i_]; } while (0)
#define SSDY_PUT_BX(buf_) do { \
      _Pragma("unroll") for (int i_ = 0; i_ < 4; ++i_) *(u32x4_t*)(bbuf + (buf_) * 32768 + (size_t)(tid + i_ * 512) * 16) = pf[i_]; \
      _Pragma("unroll") for (int i_ = 0; i_ < 2; ++i_) *(u32x4_t*)(xbuf + (buf_) * 16384 + (size_t)(tid + i_ * 512) * 16) = pf[4 + i_]; \
      tabs[(buf_) * 512 + tid] = pft; } while (0)
  {
    int gc0 = 0, head0 = 0;
    __syncthreads();
    if (ssd_item(0, bid, nb, nchunks, gc0, head0)) { SSDY_FETCH(gc0, head0); SSDY_PUT_BX(0); SSDY_PUT_S(); }
    __syncthreads();
  }
  for (int round = 0;; ++round) {
    int gc, head;
    if (!ssd_item(round, bid, nb, nchunks, gc, head)) break;
    const int grp = head >> 3, row0 = gc * 128;
    const char* bs = bbuf + (round & 1) * 32768;
    const char* xs_l = xbuf + (round & 1) * 16384;
    const float* csf = tabs + (round & 1) * 512;
    const float* dtf = csf + 128;
    const float* exb = csf + 256;
    const float* dtb = csf + 384;
    int gcn = 0, headn = 0;
    const bool has_next = ssd_item(round + 1, bid, nb, nchunks, gcn, headn);
    if (has_next) SSDY_FETCH(gcn, headn);
    const float atb = P.atot()[gc * 32 + 16 + head];
    bf16x8 cfrag[4];
    {
      const bf16_t* cp = P.cfr() + ((((size_t)grp * (NTOK / 16) + gc * 8 + wv) * 4) * 16 + li) * 32 + 8 * g;
#pragma unroll
      for (int t = 0; t < 4; ++t) cfrag[t] = *(const bf16x8*)(cp + t * 512);
    }
    f32x4 accG[8];
#pragma unroll
    for (int sb = 0; sb < 8; ++sb) accG[sb] = (f32x4){0.f, 0.f, 0.f, 0.f};
#pragma unroll
    for (int sp = 0; sp < 4; ++sp) {
      bf16x8 bfv[8];
#pragma unroll
      for (int i = 0; i < 8; ++i) {
        const int sb = sp * 2 + (i >> 2), t = i & 3;
        bfv[i] = *(const bf16x8*)(bs + (((sb * 4 + t) * 16 + li) * 32 + 8 * g) * 2);
      }
#pragma unroll
      for (int i = 0; i < 8; ++i) {
        const int sb = sp * 2 + (i >> 2), t = i & 3;
        accG[sb] = __builtin_amdgcn_mfma_f32_16x16x32_bf16(bfv[i], cfrag[t], accG[sb], 0, 0, 0);
      }
    }
    f32x4 accY[4];
#pragma unroll
    for (int pb = 0; pb < 4; ++pb) accY[pb] = (f32x4){0.f, 0.f, 0.f, 0.f};
    const int jl = 16 * wv + li;
    const float csf_j = csf[jl], exb_j = exb[jl];
#pragma unroll
    for (int dir = 0; dir < 2; ++dir) {
      f32x4 accO[4];
#pragma unroll
      for (int pb = 0; pb < 4; ++pb) accO[pb] = (f32x4){0.f, 0.f, 0.f, 0.f};
      const char* st = sbufS + dir * 16384;
#pragma unroll
      for (int th = 0; th < 2; ++th) {
        bf16x8 sfr[8];
#pragma unroll
        for (int i = 0; i < 8; ++i) sfr[i] = *(const bf16x8*)(st + (((th * 2 + (i >> 2)) * 4 + (i & 3)) * 512 + li * 32 + 8 * g) * 2);
#pragma unroll
        for (int tt = 0; tt < 2; ++tt)
#pragma unroll
          for (int pb = 0; pb < 4; ++pb) accO[pb] = __builtin_amdgcn_mfma_f32_16x16x32_bf16(cfrag[th * 2 + tt], sfr[tt * 4 + pb], accO[pb], 0, 0, 0);
      }
#pragma unroll
      for (int e = 0; e < 4; ++e) {
        const int j = 16 * wv + 4 * g + e;
        const float sc = dir == 0 ? fexp(csf[j]) : fexp(atb - exb[j]);
#pragma unroll
        for (int pb = 0; pb < 4; ++pb) accY[pb][e] += accO[pb][e] * sc;
      }
    }
    __syncthreads();
    if (has_next) SSDY_PUT_S();
    const char* xq = xs_l + ((g * 64 + li) * 4) * 2;
#pragma unroll
    for (int t = 0; t < 4; ++t) {
      const bool need_f = !(32 * t > 16 * wv + 15), need_b = !(32 * t + 31 < 16 * wv);
      if (!need_f && !need_b) continue;
      s16x4 xlo[4], xhi[4];
#pragma unroll
      for (int pb = 0; pb < 4; ++pb) {
        xlo[pb] = *(const s16x4*)(xq + (((8 * t) * 64 + 16 * pb) * 4) * 2);
        xhi[pb] = *(const s16x4*)(xq + (((8 * t + 4) * 64 + 16 * pb) * 4) * 2);
      }
#pragma unroll
      for (int dir = 0; dir < 2; ++dir) {
        if (dir == 0 ? !need_f : !need_b) continue;
        bf16x8 afrag;
#pragma unroll
        for (int hh = 0; hh < 2; ++hh) {
          const int s0 = 32 * t + 16 * hh + 4 * g;
          const f32x4 gv = accG[2 * t + hh];
          const f32x4 cv = dir == 0 ? *(const f32x4*)(csf + s0) : *(const f32x4*)(exb + s0);
          const f32x4 dv = dir == 0 ? *(const f32x4*)(dtf + s0) : *(const f32x4*)(dtb + s0);
#pragma unroll
          for (int e = 0; e < 4; ++e) {
            const int s = s0 + e;
            float m;
            if (dir == 0) m = (s <= jl) ? gv[e] * dv[e] * fexp(csf_j - cv[e]) : 0.f;
            else m = (s >= jl) ? gv[e] * dv[e] * fexp(cv[e] - exb_j) : 0.f;
            afrag[hh * 4 + e] = (short)f2bf(m);
          }
        }
#pragma unroll
        for (int pb = 0; pb < 4; ++pb) {
          const bf16x8 bfr2 = (bf16x8){xlo[pb][0], xlo[pb][1], xlo[pb][2], xlo[pb][3], xhi[pb][0], xhi[pb][1], xhi[pb][2], xhi[pb][3]};
          accY[pb] = __builtin_amdgcn_mfma_f32_16x16x32_bf16(afrag, bfr2, accY[pb], 0, 0, 0);
        }
      }
    }
    const float dsk = P.d_skip[layer * 16 + head];
    s16x4 xs[4];
#pragma unroll
    for (int pb = 0; pb < 4; ++pb) xs[pb] = *(const s16x4*)(xs_l + ((((4 * wv + g) * 64 + 16 * pb + li) * 4) * 2));
    unsigned zv[16];
#pragma unroll
    for (int e = 0; e < 4; ++e)
#pragma unroll
      for (int pb = 0; pb < 4; ++pb)
        zv[e * 4 + pb] = P.p()[(size_t)(row0 + 16 * wv + 4 * g + e) * PW + OFF_Z + head * 64 + 16 * pb + li];
#pragma unroll
    for (int i = 0; i < 16; ++i) asm volatile("" : "+v"(zv[i]));
#pragma unroll
    for (int e = 0; e < 4; ++e) {
      const int row = row0 + 16 * wv + 4 * g + e;
      float sq = 0.f;
#pragma unroll
      for (int pb = 0; pb < 4; ++pb) {
        const float xv = bf2f((bf16_t)xs[pb][e]);
        const float z = bf2f((bf16_t)zv[e * 4 + pb]);
        const bf16_t yb = f2bf((accY[pb][e] + dsk * xv) * silu_f(z));
        P.concat()[(size_t)row * 2048 + head * 64 + 16 * pb + li] = yb;
        const float yf = bf2f(yb);
        sq += yf * yf;
      }
      sq += DPP_F(sq, 0xB1); sq += DPP_F(sq, 0x4E); sq += DPP_F(sq, 0x141); sq += DPP_F(sq, 0x140);
      if (li == 0) P.yss()[(size_t)row * 16 + head] = sq;
    }
    if (has_next) SSDY_PUT_BX((round + 1) & 1);
    __syncthreads();
  }
#undef SSDY_FETCH
#undef SSDY_PUT_S
#undef SSDY_PUT_BX
}

template <int W>
__device__ __forceinline__ void pool_frags(const bf16_t* pc, int l, int L, float rc, bf16x8 (&af)[4]) {
#pragma unroll
  for (int t = 0; t < 4; ++t) {
    constexpr int WB = W < 8 ? W : 8;
    float s[8], f[8];
#pragma unroll
    for (int e = 0; e < 8; ++e) s[e] = 0.f;
    const u32x4_t own = *(const u32x4_t*)(pc + 32 * t);
#pragma unroll
    for (int ob = 0; ob < W; ob += WB) {
      u32x4_t rows[WB];
#pragma unroll
      for (int o = 0; o < WB; ++o) {
        const int rr = l - W / 2 + ob + o;
        const int rcl = (rr >= 0 && rr < L) ? rr : l;
        rows[o] = *(const u32x4_t*)(pc + (ptrdiff_t)(rcl - l) * PW + 32 * t);
      }
#pragma unroll
      for (int o = 0; o < WB; ++o) asm volatile("" : "+v"(rows[o]));
#pragma unroll
      for (int o = 0; o < WB; ++o) {
        const int rr = l - W / 2 + ob + o;
        const float mk = (rr >= 0 && rr < L) ? 1.f : 0.f;
        unpack8(make_uint4(rows[o].x, rows[o].y, rows[o].z, rows[o].w), f);
#pragma unroll
        for (int e = 0; e < 8; ++e) s[e] += mk * f[e];
      }
    }
    unpack8(make_uint4(own.x, own.y, own.z, own.w), f);
#pragma unroll
    for (int e = 0; e < 8; ++e) af[t][e] = (short)f2bf(s[e] * rc - f[e]);
  }
}
__device__ void ph_pool_mfma(int wv, const Params& P, int layer, int nrows, char* smem, int bid, int nb) {
  const int lane = otid(wv) & 63, li = lane & 15, g = lane >> 4;
  bf16_t* stg = (bf16_t*)(smem + 65536) + wv * (16 * 136);
  const int nitems = (nrows / 16) * 4;
  for (int it = bid * NWAVE + wv; it < nitems; it += nb * NWAVE) {
    const int gi = it & 3, row0 = (it >> 2) * 16, w = 2 << gi;
    const int row = row0 + li;
    int l, L;
    if (row < NLAT) { l = row & 4095; L = 4096; } else { l = (row - NLAT) & 255; L = 256; }
    int lo = l - w / 2; lo = lo < 0 ? 0 : lo;
    int hi = l + w - w / 2 - 1; hi = hi > L - 1 ? L - 1 : hi;
    const float rc = 1.f / (float)(hi - lo + 1);
    const bf16_t* pc = P.p() + (size_t)row * PW + OFF_POOL + gi * 128 + 8 * g;
    bf16x8 af[4];
    if (gi == 0) pool_frags<2>(pc, l, L, rc, af);
    else if (gi == 1) pool_frags<4>(pc, l, L, rc, af);
    else if (gi == 2) pool_frags<8>(pc, l, L, rc, af);
    else pool_frags<16>(pc, l, L, rc, af);
    const bf16_t* wt = P.poolwT() + ((size_t)(layer * 4 + gi) * 128 + li) * 128 + 8 * g;
    const float* sc = P.pool_scale + layer * 512 + gi * 128;
#pragma unroll
    for (int nh = 0; nh < 4; ++nh) {
      bf16x8 wf[2][4];
#pragma unroll
      for (int n = 0; n < 2; ++n)
#pragma unroll
        for (int t = 0; t < 4; ++t) wf[n][t] = *(const bf16x8*)(wt + (size_t)(nh * 2 + n) * 16 * 128 + 32 * t);
#pragma unroll
      for (int n = 0; n < 2; ++n)
#pragma unroll
        for (int t = 0; t < 4; ++t) asm volatile("" : "+v"(wf[n][t]));
#pragma unroll
      for (int n = 0; n < 2; ++n) {
        const int nt = nh * 2 + n;
        f32x4 acc = (f32x4){0.f, 0.f, 0.f, 0.f};
#pragma unroll
        for (int t = 0; t < 4; ++t) acc = __builtin_amdgcn_mfma_f32_16x16x32_bf16(af[t], wf[n][t], acc, 0, 0, 0);
        const float scv = sc[nt * 16 + li];
#pragma unroll
        for (int e = 0; e < 4; ++e) stg[(4 * g + e) * 136 + nt * 16 + li] = f2bf(acc[e] * scv);
      }
    }
    __builtin_amdgcn_wave_barrier();
#pragma unroll
    for (int i = 0; i < 4; ++i) {
      const int c = i * 64 + lane, rr = c >> 4, c8 = (c & 15) * 8;
      *(uint4*)(P.concat() + (size_t)(row0 + rr) * 2048 + 1024 + gi * 128 + c8) = *(const uint4*)(stg + rr * 136 + c8);
    }
    __builtin_amdgcn_wave_barrier();
  }
}

__device__ void ph_vtranspose(int wv, const Params& P, char* smem, int bid, int nb) {
  const int lane = otid(wv) & 63;
  bf16_t* tile = (bf16_t*)smem + wv * 64 * 72;
  for (int it = bid * NWAVE + wv; it < 272 * 8; it += nb * NWAVE) {
    const int hd = it & 7, tt = it >> 3, row0 = tt * 64;
    const bf16_t* src = P.p() + (size_t)(row0 + lane) * PW + OFF_V + hd * 64;
#pragma unroll
    for (int i = 0; i < 8; ++i) *(uint4*)(tile + lane * 72 + i * 8) = *(const uint4*)(src + i * 8);
    __builtin_amdgcn_wave_barrier();
    bf16_t* dst;
    if (row0 < NLAT) dst = P.vtl() + (size_t)((row0 >> 12) * 8 + hd) * 64 * 4096 + ((size_t)((row0 & 4095) >> 2) * 64 + lane) * 4;
    else dst = P.vtc() + (size_t)(((row0 - NLAT) >> 8) * 8 + hd) * 64 * 256 + ((size_t)(((row0 - NLAT) & 255) >> 2) * 64 + lane) * 4;
#pragma unroll
    for (int i = 0; i < 16; ++i) {
      uint2 w;
      w.x = (uint32_t)tile[(i * 4 + 0) * 72 + lane] | ((uint32_t)tile[(i * 4 + 1) * 72 + lane] << 16);
      w.y = (uint32_t)tile[(i * 4 + 2) * 72 + lane] | ((uint32_t)tile[(i * 4 + 3) * 72 + lane] << 16);
      *(uint2*)(dst + (size_t)i * 64 * 4) = w;
    }
    __builtin_amdgcn_wave_barrier();
    {
      const bf16_t* ksrc = P.p() + (size_t)(row0 + lane) * PW + OFF_K + hd * 64;
      u32x4_t kv[8];
#pragma unroll
      for (int i = 0; i < 8; ++i) kv[i] = *(const u32x4_t*)(ksrc + i * 8);
      bf16_t* kd;
      int tk;
      if (row0 < NLAT) { tk = (row0 & 4095) + lane; kd = P.ktl() + (size_t)((row0 >> 12) * 8 + hd) * 4096 * 64; }
      else { tk = ((row0 - NLAT) & 255) + lane; kd = P.ktc() + (size_t)(((row0 - NLAT) >> 8) * 8 + hd) * 256 * 64; }
#pragma unroll
      for (int i = 0; i < 8; ++i)
        *(u32x4_t*)(kd + ((size_t)((tk >> 3) * 2 + (i >> 2)) * 8 + (tk & 7)) * 32 + (i & 3) * 8) = kv[i];
    }
  }
}

__device__ __forceinline__ float grp_max(float v) {
  auto a = __builtin_amdgcn_permlane16_swap(__float_as_uint(v), __float_as_uint(v), false, false);
  v = fmaxf(__uint_as_float(a[0]), __uint_as_float(a[1]));
  auto b = __builtin_amdgcn_permlane32_swap(__float_as_uint(v), __float_as_uint(v), false, false);
  return fmaxf(__uint_as_float(b[0]), __uint_as_float(b[1]));
}
__device__ __forceinline__ float grp_sum(float v) {
  auto a = __builtin_amdgcn_permlane16_swap(__float_as_uint(v), __float_as_uint(v), false, false);
  v = __uint_as_float(a[0]) + __uint_as_float(a[1]);
  auto b = __builtin_amdgcn_permlane32_swap(__float_as_uint(v), __float_as_uint(v), false, false);
  return __uint_as_float(b[0]) + __uint_as_float(b[1]);
}

__device__ void ph_na_mfma(int wv, const Params& P, int layer, int nrows, char* smem, int bid, int nb) {
  const int lane = otid(wv) & 63, li = lane & 15, g = lane >> 4;
  float* btab = (float*)smem + wv * 256;
  const float* rpb = P.na_rpb + (size_t)layer * 8 * 15 * 31;
  const int n_lat = 4 * 64 * 8 * 4;
  const int n_items = n_lat + (nrows > NLAT ? 4 * 16 * 8 : 0);
  const int nrank = nb >> 3;
  const bool xmap = ((nb & 7) == 0) && nrank > 0 && (1024 % nrank) == 0 && (64 % nrank) == 0;
  const int per_lat = xmap ? 1024 / nrank : 0, per_ctx = (xmap && nrows > NLAT) ? 64 / nrank : 0;
  const int q_begin = xmap ? wv : bid * NWAVE + wv, q_end = xmap ? per_lat + per_ctx : n_items, q_step = xmap ? NWAVE : nb * NWAVE;
  for (int q = q_begin; q < q_end; q += q_step) {
    bool lat;
    int b, hd, qrow0, r = 0, cq0 = 0, r0 = 0, cs = 0, qt;
    if (xmap) {
      hd = bid & 7;
      const int rank = bid >> 3;
      lat = q < per_lat;
      if (lat) { const int i = rank * per_lat + q; qt = i & 3; r = (i >> 2) & 63; b = i >> 8; }
      else { const int c = rank * per_ctx + (q - per_lat); qt = c & 15; b = c >> 4; }
    } else {
      lat = q < n_lat;
      if (lat) { qt = q & 3; hd = (q >> 2) & 7; r = (q >> 5) & 63; b = q >> 11; }
      else { const int t = q - n_lat; hd = t & 7; qt = (t >> 3) & 15; b = t >> 7; }
    }
    if (lat) {
      cq0 = qt * 16; qrow0 = b * 4096 + r * 64 + cq0;
      r0 = r - 4; r0 = r0 < 0 ? 0 : (r0 > 56 ? 56 : r0);
      int clo = cq0 - 8; clo = clo < 0 ? 0 : (clo > 48 ? 48 : clo);
      cs = clo < 32 ? clo : 32;
    } else {
      qrow0 = NLAT + b * 256 + qt * 16;
    }
    const bf16_t* qp = P.p() + (size_t)(qrow0 + li) * PW + OFF_Q + hd * 64 + 8 * g;
    const bf16x8 qf0 = *(const bf16x8*)qp, qf1 = *(const bf16x8*)(qp + 32);
    __builtin_amdgcn_wave_barrier();
#pragma unroll
    for (int i = 0; i < 4; ++i) {
      const int e_ = i * 64 + lane, kr_ = e_ >> 5, dc_ = e_ & 31;
      int dr_ = r0 + kr_ - r + 7; dr_ = dr_ < 0 ? 0 : (dr_ > 14 ? 14 : dr_);
      btab[e_] = rpb[(hd * 15 + dr_) * 31 + (dc_ < 31 ? dc_ : 30)];
    }
    __builtin_amdgcn_wave_barrier();
    f32x4 accS[16], accC[16];
    const int k_lane = ((li >> 3) * 16 + (li & 7)) * 32 + 8 * g;
    const bf16_t* klb = P.ktl() + (size_t)(b * 8 + hd) * 4096 * 64 + k_lane;
    const bf16_t* kcb = P.ktc() + (size_t)(b * 8 + hd) * 256 * 64 + k_lane;
#define NA_KPTR(tile) ((tile) < 16 ? klb + ((r0 + ((tile) >> 1)) * 64 + cs + 16 * ((tile) & 1)) * 64 : kcb + (16 * ((tile) - 16)) * 64)
    bf16x8 kA[2][2], kB[2][2];
#pragma unroll
    for (int i = 0; i < 2; ++i) { const bf16_t* kp = NA_KPTR(i); kA[i][0] = *(const bf16x8*)kp; kA[i][1] = *(const bf16x8*)(kp + 256); }
#pragma unroll
    for (int tb = 0; tb < 32; tb += 4) {
#pragma unroll
      for (int i = 0; i < 2; ++i) { const bf16_t* kp = NA_KPTR(tb + 2 + i); kB[i][0] = *(const bf16x8*)kp; kB[i][1] = *(const bf16x8*)(kp + 256); }
#pragma unroll
      for (int i = 0; i < 2; ++i) { asm volatile("" : "+v"(kA[i][0]), "+v"(kA[i][1])); }
#pragma unroll
      for (int i = 0; i < 2; ++i) {
        f32x4 z = (f32x4){0.f, 0.f, 0.f, 0.f};
        z = __builtin_amdgcn_mfma_f32_16x16x32_bf16(kA[i][0], qf0, z, 0, 0, 0);
        z = __builtin_amdgcn_mfma_f32_16x16x32_bf16(kA[i][1], qf1, z, 0, 0, 0);
        if (tb + i < 16) accS[(tb + i) & 15] = z; else accC[(tb + i) & 15] = z;
      }
      if (tb + 4 < 32) {
#pragma unroll
        for (int i = 0; i < 2; ++i) { const bf16_t* kp = NA_KPTR(tb + 4 + i); kA[i][0] = *(const bf16x8*)kp; kA[i][1] = *(const bf16x8*)(kp + 256); }
      }
#pragma unroll
      for (int i = 0; i < 2; ++i) { asm volatile("" : "+v"(kB[i][0]), "+v"(kB[i][1])); }
#pragma unroll
      for (int i = 0; i < 2; ++i) {
        f32x4 z = (f32x4){0.f, 0.f, 0.f, 0.f};
        z = __builtin_amdgcn_mfma_f32_16x16x32_bf16(kB[i][0], qf0, z, 0, 0, 0);
        z = __builtin_amdgcn_mfma_f32_16x16x32_bf16(kB[i][1], qf1, z, 0, 0, 0);
        if (tb + 2 + i < 16) accS[(tb + 2 + i) & 15] = z; else accC[(tb + 2 + i) & 15] = z;
      }
    }
#undef NA_KPTR
    const int cq = cq0 + li;
    int c0q = cq - 8; c0q = c0q < 0 ? 0 : (c0q > 48 ? 48 : c0q);
    float mx = -3.0e38f;
#pragma unroll
    for (int kt = 0; kt < 16; ++kt) {
      int bi[4]; bool okv[4]; float bv[4];
#pragma unroll
      for (int e = 0; e < 4; ++e) {
        const int ck = cs + 16 * (kt & 1) + 4 * g + e;
        okv[e] = lat && ck >= c0q && ck < c0q + 16;
        bi[e] = okv[e] ? (kt >> 1) * 32 + (ck - cq + 15) : 0;
      }
      asm volatile("" : "+v"(bi[0]), "+v"(bi[1]), "+v"(bi[2]), "+v"(bi[3]));
#pragma unroll
      for (int e = 0; e < 4; ++e) bv[e] = btab[bi[e]];
#pragma unroll
      for (int e = 0; e < 4; ++e) {
        const float s = okv[e] ? accS[kt][e] * 0.125f + bv[e] : -3.0e38f;
        accS[kt][e] = s;
        mx = fmaxf(mx, s);
      }
    }
#pragma unroll
    for (int ct = 0; ct < 16; ++ct)
#pragma unroll
      for (int e = 0; e < 4; ++e) { const float s = accC[ct][e] * 0.125f; accC[ct][e] = s; mx = fmaxf(mx, s); }
    mx = grp_max(mx);
    float sum = 0.f;
#pragma unroll
    for (int kt = 0; kt < 16; ++kt)
#pragma unroll
      for (int e = 0; e < 4; ++e) { const float p = __expf(accS[kt][e] - mx); accS[kt][e] = p; sum += p; }
#pragma unroll
    for (int ct = 0; ct < 16; ++ct)
#pragma unroll
      for (int e = 0; e < 4; ++e) { const float p = __expf(accC[ct][e] - mx); accC[ct][e] = p; sum += p; }
    sum = grp_sum(sum);
    const float inv = 1.f / sum;
    bf16x8 afL[8], afC[8];
#pragma unroll
    for (int kr = 0; kr < 8; ++kr) {
#pragma unroll
      for (int e = 0; e < 4; ++e) {
        afL[kr][e] = (short)f2bf(accS[2 * kr][e] * inv); afL[kr][4 + e] = (short)f2bf(accS[2 * kr + 1][e] * inv);
        afC[kr][e] = (short)f2bf(accC[2 * kr][e] * inv); afC[kr][4 + e] = (short)f2bf(accC[2 * kr + 1][e] * inv);
      }
    }
    f32x4 accO[4];
#pragma unroll
    for (int db = 0; db < 4; ++db) accO[db] = (f32x4){0.f, 0.f, 0.f, 0.f};
    const bf16_t* vl = P.vtl() + (size_t)(b * 8 + hd) * 64 * 4096 + li * 4;
    const bf16_t* vc = P.vtc() + (size_t)(b * 8 + hd) * 64 * 256 + li * 4;
#pragma unroll
    for (int kr = 0; kr < 8; ++kr) {
      const int tok = (r0 + kr) * 64 + cs + 4 * g;
      s16x4 lo[4], hi[4];
#pragma unroll
      for (int db = 0; db < 4; ++db) {
        const bf16_t* vp = vl + ((size_t)(tok >> 2) * 64 + db * 16) * 4;
        lo[db] = *(const s16x4*)vp; hi[db] = *(const s16x4*)(vp + 4 * 64 * 4);
      }
#pragma unroll
      for (int db = 0; db < 4; ++db) {
        const bf16x8 bfr = (bf16x8){lo[db][0], lo[db][1], lo[db][2], lo[db][3], hi[db][0], hi[db][1], hi[db][2], hi[db][3]};
        accO[db] = __builtin_amdgcn_mfma_f32_16x16x32_bf16(afL[kr], bfr, accO[db], 0, 0, 0);
      }
    }
#pragma unroll
    for (int t = 0; t < 8; ++t) {
      const int tok = 32 * t + 4 * g;
      s16x4 lo[4], hi[4];
#pragma unroll
      for (int db = 0; db < 4; ++db) {
        const bf16_t* vp = vc + ((size_t)(tok >> 2) * 64 + db * 16) * 4;
        lo[db] = *(const s16x4*)vp; hi[db] = *(const s16x4*)(vp + 4 * 64 * 4);
      }
#pragma unroll
      for (int db = 0; db < 4; ++db) {
        const bf16x8 bfr = (bf16x8){lo[db][0], lo[db][1], lo[db][2], lo[db][3], hi[db][0], hi[db][1], hi[db][2], hi[db][3]};
        accO[db] = __builtin_amdgcn_mfma_f32_16x16x32_bf16(afC[t], bfr, accO[db], 0, 0, 0);
      }
    }
    {
      bf16_t* stg = (bf16_t*)(smem + 32768) + wv * (16 * 72);
#pragma unroll
      for (int db = 0; db < 4; ++db)
#pragma unroll
        for (int e = 0; e < 4; ++e) stg[(4 * g + e) * 72 + 16 * db + li] = f2bf(accO[db][e]);
      __builtin_amdgcn_wave_barrier();
#pragma unroll
      for (int i = 0; i < 2; ++i) {
        const int c = i * 64 + lane, rr = c >> 3, c8 = (c & 7) * 8;
        *(uint4*)(P.concat() + (size_t)(qrow0 + rr) * 2048 + 1536 + hd * 64 + c8) = *(const uint4*)(stg + rr * 72 + c8);
      }
      __builtin_amdgcn_wave_barrier();
    }
  }
}

__device__ __forceinline__ uint32_t mono_u(float f) { const uint32_t u = __float_as_uint(f); return u ^ ((uint32_t)((int)u >> 31) | 0x80000000u); }
__device__ __forceinline__ float unmono_f(uint32_t m) { return __uint_as_float((m & 0x80000000u) ? (m ^ 0x80000000u) : ~m); }
__device__ __forceinline__ uint32_t grp_max_u(uint32_t v) {
  auto a = __builtin_amdgcn_permlane16_swap(v, v, false, false);
  v = a[0] > a[1] ? a[0] : a[1];
  auto b = __builtin_amdgcn_permlane32_swap(v, v, false, false);
  return b[0] > b[1] ? b[0] : b[1];
}

template <int N>
__device__ __forceinline__ void bitonic_sort_desc(uint32_t (&a)[N], int base = 0) { (void)base;
#pragma unroll
  for (int k = 2; k <= N; k <<= 1)
#pragma unroll
    for (int j = k >> 1; j > 0; j >>= 1)
#pragma unroll
      for (int i = 0; i < N; ++i) {
        const int l = i ^ j;
        if (l > i) {
          const bool desc = (i & k) == 0;
          const uint32_t hi = a[i] > a[l] ? a[i] : a[l], lo = a[i] > a[l] ? a[l] : a[i];
          a[i] = desc ? hi : lo; a[l] = desc ? lo : hi;
        }
      }
}
template <int N>
__device__ __forceinline__ void bitonic_merge_desc(uint32_t (&a)[N]) {
#pragma unroll
  for (int j = N >> 1; j > 0; j >>= 1)
#pragma unroll
    for (int i = 0; i < N; ++i) {
      const int l = i ^ j;
      if (l > i) {
        const uint32_t hi = a[i] > a[l] ? a[i] : a[l], lo = a[i] > a[l] ? a[l] : a[i];
        a[i] = hi; a[l] = lo;
      }
    }
}
__device__ __forceinline__ void merge4_top16(uint32_t (&a)[16]) {
  uint32_t e[16], o[16];
#pragma unroll
  for (int i = 0; i < 16; ++i) { auto r = __builtin_amdgcn_permlane16_swap(a[i], a[i], false, false); e[i] = r[0]; o[i] = r[1]; }
#pragma unroll
  for (int i = 0; i < 16; ++i) a[i] = e[i] > o[15 - i] ? e[i] : o[15 - i];
  bitonic_merge_desc<16>(a);
#pragma unroll
  for (int i = 0; i < 16; ++i) { auto r = __builtin_amdgcn_permlane32_swap(a[i], a[i], false, false); e[i] = r[0]; o[i] = r[1]; }
#pragma unroll
  for (int i = 0; i < 16; ++i) a[i] = e[i] > o[15 - i] ? e[i] : o[15 - i];
  bitonic_merge_desc<16>(a);
}
__device__ void ph_peer_topk_mfma(int wv, const Params& P, int layer, int nrows, char* smem, int bid, int nb) {
  const int tid = otid(wv), lane = tid & 63, li = lane & 15, g = lane >> 4;
  unsigned char* ctab = (unsigned char*)smem;
  float* vals = (float*)(smem + 256) + wv * 512;
  int* idxs = (int*)(smem + 256 + 8 * 2048) + wv * 512;
  __syncthreads();
  if (tid < 64) ctab[tid] = 0xFF;
  __syncthreads();
  if (tid == 0) {
    int n = 0, one = 1;
    asm volatile("" : "+s"(one));
#pragma unroll 1
    for (int a = 0; a < 16; ++a)
#pragma unroll 1
      for (int b = 0; b < 16; ++b)
        if ((a + one) * (b + 1) <= 16) { ctab[(n & 3) * 16 + (n >> 2)] = (unsigned char)(a * 16 + b); ++n; }
  }
  const int hd = bid & 7, tg = bid >> 3, ngroups = nb >> 3;
  char* ksm = smem + 33280;
  {
    const bf16_t* ksrc = P.keysb() + (size_t)(layer * 8 + hd) * 2 * 128 * 128;
#pragma unroll
    for (int i = 0; i < 8; ++i) {
      const int idx = tid + i * 512, r = idx >> 4, sg = idx & 15;
      *(uint4*)(ksm + (r * 136 + sg * 8) * 2) = *(const uint4*)(ksrc + (size_t)r * 128 + sg * 8);
    }
  }
  __syncthreads();
  uint32_t cab[16];
#pragma unroll
  for (int s = 0; s < 16; ++s) cab[s] = ctab[g * 16 + s];
  const int ntile = nrows / 16;
  for (int tile = tg + ngroups * wv; tile < ntile && tg < ngroups; tile += ngroups * NWAVE) {
    const int row0 = tile * 16;
    const bf16_t* qp = P.q() + (size_t)(row0 + li) * 2048 + hd * 256 + 8 * g;
    uint32_t win[2][16];
#pragma unroll
    for (int half = 0; half < 2; ++half) {
      bf16x8 qf[4];
#pragma unroll
      for (int t = 0; t < 4; ++t) qf[t] = *(const bf16x8*)(qp + half * 128 + 32 * t);
      const char* kb = ksm + ((half * 128 + li) * 136 + 8 * g) * 2;
      uint32_t pk[32];
#pragma unroll
      for (int kt = 0; kt < 8; ++kt) {
        f32x4 acc = (f32x4){0.f, 0.f, 0.f, 0.f};
#pragma unroll
        for (int t = 0; t < 4; ++t) {
          const bf16x8 a = *(const bf16x8*)(kb + (kt * 16 * 136 + 32 * t) * 2);
          acc = __builtin_amdgcn_mfma_f32_16x16x32_bf16(a, qf[t], acc, 0, 0, 0);
        }
#pragma unroll
        for (int e = 0; e < 4; ++e) pk[kt * 4 + e] = (mono_u(acc[e]) & ~127u) | (uint32_t)(16 * kt + 4 * g + e);
      }
      {
        uint32_t lo16[16], hi16[16];
#pragma unroll
        for (int i = 0; i < 16; ++i) { lo16[i] = pk[i]; hi16[i] = pk[16 + i]; }
        bitonic_sort_desc<16>(lo16);
        bitonic_sort_desc<16>(hi16);
#pragma unroll
        for (int i = 0; i < 16; ++i) lo16[i] = lo16[i] > hi16[15 - i] ? lo16[i] : hi16[15 - i];
        bitonic_merge_desc<16>(lo16);
        merge4_top16(lo16);
#pragma unroll
        for (int r = 0; r < 16; ++r) win[half][r] = lo16[r];
      }
    }
    if (g == 0) {
#pragma unroll
      for (int half = 0; half < 2; ++half)
#pragma unroll
        for (int r = 0; r < 16; ++r) {
          vals[li * 32 + half * 16 + r] = unmono_f(win[half][r] & ~127u);
          idxs[li * 32 + half * 16 + r] = (int)(win[half][r] & 127u);
        }
    }
    __builtin_amdgcn_wave_barrier();
    uint32_t cp[16];
    {
      float va[16], vb[16];
#pragma unroll
      for (int s = 0; s < 16; ++s) {
        const uint32_t ab = cab[s] == 0xFFu ? 0u : cab[s];
        va[s] = vals[li * 32 + (ab >> 4)]; vb[s] = vals[li * 32 + 16 + (ab & 15u)];
      }
#pragma unroll
      for (int s = 0; s < 16; ++s) cp[s] = cab[s] == 0xFFu ? 0u : ((mono_u(va[s] + vb[s]) & ~255u) | cab[s]);
    }
    bitonic_sort_desc<16>(cp);
    merge4_top16(cp);
    uint32_t cw[16];
#pragma unroll
    for (int r = 0; r < 16; ++r) cw[r] = cp[r];
    const float mx = unmono_f(cw[0] & ~255u);
    float ex[16];
    float sum = 0.f;
#pragma unroll
    for (int r = 0; r < 16; ++r) { ex[r] = __expf(unmono_f(cw[r] & ~255u) - mx); sum += ex[r]; }
    const float inv = 1.f / sum;
    const size_t ob = (size_t)(row0 + li) * 128 + hd * 16;
#pragma unroll
    for (int r = 0; r < 16; ++r) {
      if ((r >> 2) == g) {
        const uint32_t ab = cw[r] & 255u;
        P.sel_idx()[ob + r] = idxs[li * 32 + (ab >> 4)] * 128 + idxs[li * 32 + 16 + (ab & 15u)];
        P.sel_g()[ob + r] = ex[r] * inv;
      }
    }
    __builtin_amdgcn_wave_barrier();
  }
}

__device__ __forceinline__ void cvt8(const uint32_t w, float* f) {
  const f32x2_t a = __builtin_amdgcn_cvt_scalef32_pk_f32_fp4(w, 1.0f, 0), b = __builtin_amdgcn_cvt_scalef32_pk_f32_fp4(w, 1.0f, 1);
  const f32x2_t c = __builtin_amdgcn_cvt_scalef32_pk_f32_fp4(w, 1.0f, 2), e = __builtin_amdgcn_cvt_scalef32_pk_f32_fp4(w, 1.0f, 3);
  f[0] = a.x; f[1] = a.y; f[2] = b.x; f[3] = b.y; f[4] = c.x; f[5] = c.y; f[6] = e.x; f[7] = e.y;
}
__device__ __forceinline__ float swap16_add(float a, float b) {
  auto r = __builtin_amdgcn_permlane16_swap(__float_as_uint(a), __float_as_uint(b), false, false);
  return __uint_as_float(r[0]) + __uint_as_float(r[1]);
}
__device__ void ph_peer_dots(int wv, const Params& P, int layer, int nrows, int bid, int nb) {
  for (int row = bid * NWAVE + wv; row < nrows; row += nb * NWAVE) {
    const int lane = otid(wv) & 63, l5 = lane & 31;
    const bool up = lane >= 32;
    const unsigned char* TU = P.tabU() + l5 * 16;
    const unsigned char* TV = P.tabV() + l5 * 16;
    const int j15 = lane & 15;
    const int rr = ((j15 >> 3) & 1) | ((j15 & 1) << 1), zi = (j15 >> 1) & 3;
    const int srcl = (rr * 4 + (zi & 1) * 2 + (zi >> 1)) * 4;
    float xv[32];
    {
      const bf16_t* xp = P.u() + (size_t)row * DM + l5 * 32;
      unpack8(*(const uint4*)xp, xv); unpack8(*(const uint4*)(xp + 8), xv + 8);
      unpack8(*(const uint4*)(xp + 16), xv + 16); unpack8(*(const uint4*)(xp + 24), xv + 24);
    }
    const int idx0 = P.sel_idx()[(size_t)row * 128 + lane], idx1 = P.sel_idx()[(size_t)row * 128 + 64 + lane];
    const float gt0 = P.sel_g()[(size_t)row * 128 + lane] * P.invV()[idx0], gt1 = P.sel_g()[(size_t)row * 128 + 64 + lane] * P.invV()[idx1];
    const float iu0 = P.invU()[idx0], iu1 = P.invU()[idx1];
    float d0 = 0.f, d1 = 0.f;
    uint4 bufA[8], bufB[8], bufC[8], bufD[8];
#define PG_LOAD(buf, T, kk) do { _Pragma("unroll") for (int j = 0; j < 8; ++j) { \
      const int k_ = (kk) + 2 * j; const int src_ = k_ < 64 ? idx0 : idx1; \
      const int elo_ = __builtin_amdgcn_readlane(src_, k_ & 63), ehi_ = __builtin_amdgcn_readlane(src_, (k_ & 63) + 1); \
      buf[j] = *(const uint4*)(T + (size_t)(up ? ehi_ : elo_) * 512); } } while (0)
#define PG_DOT(buf, kk) do { float pv[8]; _Pragma("unroll") for (int j = 0; j < 8; ++j) { f32x2_t s_ = (f32x2_t){0.f, 0.f}; const uint32_t w_[4] = {buf[j].x, buf[j].y, buf[j].z, buf[j].w}; \
      _Pragma("unroll") for (int d = 0; d < 4; ++d) { uint32_t wd_ = w_[d]; asm volatile("" : "+v"(wd_) : "v"(s_)); \
        _Pragma("unroll") for (int i = 0; i < 4; ++i) { f32x2_t f2_; \
          if (i == 0) f2_ = __builtin_amdgcn_cvt_scalef32_pk_f32_fp4(wd_, 1.0f, 0); else if (i == 1) f2_ = __builtin_amdgcn_cvt_scalef32_pk_f32_fp4(wd_, 1.0f, 1); \
          else if (i == 2) f2_ = __builtin_amdgcn_cvt_scalef32_pk_f32_fp4(wd_, 1.0f, 2); else f2_ = __builtin_amdgcn_cvt_scalef32_pk_f32_fp4(wd_, 1.0f, 3); \
          s_ = __builtin_elementwise_fma(f2_, (f32x2_t){xv[d * 8 + 2 * i], xv[d * 8 + 2 * i + 1]}, s_); } } pv[j] = s_.x + s_.y; } \
      const float z0 = swap16_add(pv[0], pv[4]), z1 = swap16_add(pv[1], pv[5]), z2 = swap16_add(pv[2], pv[6]), z3 = swap16_add(pv[3], pv[7]); \
      const bool hi8 = (lane & 8) != 0, hi4 = (lane & 4) != 0; \
      const float y0 = (hi8 ? z1 : z0) + DPP_F(hi8 ? z0 : z1, 0x128); \
      const float y1 = (hi8 ? z3 : z2) + DPP_F(hi8 ? z2 : z3, 0x128); \
      float q_ = (hi4 ? y1 : y0) + DPP_F(hi4 ? y0 : y1, 0x141); \
      q_ += DPP_F(q_, 0xB1); q_ += DPP_F(q_, 0x4E); \
      const float t_ = __int_as_float(__builtin_amdgcn_ds_bpermute(srcl * 4, __float_as_int(q_))); \
      const int m_ = ((kk) >> 4) & 3; \
      if ((kk) < 64) d0 = ((lane >> 4) == m_) ? t_ : d0; else d1 = ((lane >> 4) == m_) ? t_ : d1; } while (0)
    PG_LOAD(bufA, TU, 0); PG_LOAD(bufB, TU, 16); PG_LOAD(bufC, TU, 32);
    PG_LOAD(bufD, TU, 48); PG_DOT(bufA, 0);
    PG_LOAD(bufA, TU, 64); PG_DOT(bufB, 16);
    PG_LOAD(bufB, TU, 80); PG_DOT(bufC, 32);
    PG_LOAD(bufC, TU, 96); PG_DOT(bufD, 48);
    PG_LOAD(bufD, TU, 112); PG_DOT(bufA, 64);
    PG_DOT(bufB, 80); PG_DOT(bufC, 96); PG_DOT(bufD, 112);
    P.sel_g()[(size_t)row * 128 + lane] = gelu_f(d0 * iu0) * gt0;
    P.sel_g()[(size_t)row * 128 + 64 + lane] = gelu_f(d1 * iu1) * gt1;
#undef PG_LOAD
#undef PG_DOT
  }
}
__device__ void ph_peer_acc(int wv, const Params& P, int layer, int nrows, int bid, int nb) {
  for (int row = bid * NWAVE + wv; row < nrows; row += nb * NWAVE) {
    const int lane = otid(wv) & 63, l5 = lane & 31;
    const bool up = lane >= 32;
    const unsigned char* TV = P.tabV() + l5 * 16;
    float o[32];
    const int idx0 = P.sel_idx()[(size_t)row * 128 + lane], idx1 = P.sel_idx()[(size_t)row * 128 + 64 + lane];
    const float act0 = P.sel_g()[(size_t)row * 128 + lane], act1 = P.sel_g()[(size_t)row * 128 + 64 + lane];
    uint4 bufA[8], bufB[8];
#define PG_LOAD(buf, T, kk) do { _Pragma("unroll") for (int j = 0; j < 8; ++j) { \
      const int k_ = (kk) + 2 * j; const int src_ = k_ < 64 ? idx0 : idx1; \
      const int elo_ = __builtin_amdgcn_readlane(src_, k_ & 63), ehi_ = __builtin_amdgcn_readlane(src_, (k_ & 63) + 1); \
      buf[j] = *(const uint4*)(T + (size_t)(up ? ehi_ : elo_) * 512); } } while (0)
    PG_LOAD(bufA, TV, 0);
#pragma unroll
    for (int i = 0; i < 32; ++i) o[i] = 0.f;
#define PG_ACC(buf, kk) do { _Pragma("unroll") for (int j = 0; j < 8; ++j) { const int k_ = (kk) + 2 * j; \
      const int asrc_ = __float_as_int(k_ < 64 ? act0 : act1); \
      const float alo_ = __int_as_float(__builtin_amdgcn_readlane(asrc_, k_ & 63)), ahi_ = __int_as_float(__builtin_amdgcn_readlane(asrc_, (k_ & 63) + 1)); \
      const float a_ = up ? ahi_ : alo_; \
      const uint32_t w_[4] = {buf[j].x, buf[j].y, buf[j].z, buf[j].w}; \
      _Pragma("unroll") for (int d = 0; d < 4; ++d) { float f[8]; uint32_t wd_ = w_[d]; asm volatile("" : "+v"(wd_) : "v"(o[(d * 8 + 31) & 31])); cvt8(wd_, f); \
        _Pragma("unroll") for (int i = 0; i < 8; ++i) o[d * 8 + i] += a_ * f[i]; } } } while (0)
#pragma unroll 1
    for (int kk = 0; kk < 128; kk += 32) {
      PG_LOAD(bufB, TV, kk + 16);
      PG_ACC(bufA, kk);
      if (kk + 32 < 128) PG_LOAD(bufA, TV, kk + 32);
      PG_ACC(bufB, kk + 16);
    }
#undef PG_LOAD
#undef PG_ACC
#pragma unroll
    for (int i = 0; i < 32; ++i) {
      auto r = __builtin_amdgcn_permlane32_swap(__float_as_uint(o[i]), __float_as_uint(o[i]), false, false);
      o[i] = __uint_as_float(r[0]) + __uint_as_float(r[1]);
    }
    const int lane_e = otid(wv) & 63, l5e = lane_e & 31;
    const bool upe = lane_e >= 32;
    const float* gate = P.mod() + (size_t)(layer * 5 + modrow(row)) * MODW + 5120 + l5e * 32;
    float* hr = P.h() + (size_t)row * DM + l5e * 32;
    float ss = 0.f;
    f32x4 hvv[8], ggv[8];
#pragma unroll
    for (int q = 0; q < 8; ++q) { hvv[q] = *(const f32x4*)(hr + q * 4); ggv[q] = *(const f32x4*)(gate + q * 4); }
#pragma unroll
    for (int q = 0; q < 8; ++q) asm volatile("" : "+v"(hvv[q]), "+v"(ggv[q]));
#pragma unroll
    for (int q = 0; q < 8; ++q) {
      float4 hv = make_float4(hvv[q][0], hvv[q][1], hvv[q][2], hvv[q][3]);
      const float4 gg = make_float4(ggv[q][0], ggv[q][1], ggv[q][2], ggv[q][3]);
      hv.x += gg.x * o[q * 4 + 0]; hv.y += gg.y * o[q * 4 + 1]; hv.z += gg.z * o[q * 4 + 2]; hv.w += gg.w * o[q * 4 + 3];
      if (layer == 0 && !upe) *(float4*)(hr + q * 4) = hv;
      o[q * 4 + 0] = hv.x; o[q * 4 + 1] = hv.y; o[q * 4 + 2] = hv.z; o[q * 4 + 3] = hv.w;
      if (!upe) ss += hv.x * hv.x + hv.y * hv.y + hv.z * hv.z + hv.w * hv.w;
    }
    ss = wave_sum(ss);
    const float rstd = rsqrtf(ss * (1.f / 1024.f) + 1e-6f);
    if (layer == 0) {
      const float* g1 = P.norm1_g + 1024 + l5e * 32;
      const float* mr = P.mod() + (size_t)(5 + modrow(row)) * MODW + l5e * 32;
      if (!upe) {
#pragma unroll
        for (int q = 0; q < 4; ++q) {
          float ov[8];
#pragma unroll
          for (int e = 0; e < 8; ++e) ov[e] = o[q * 8 + e] * rstd * g1[q * 8 + e] * (1.f + mr[1024 + q * 8 + e]) + mr[q * 8 + e];
          *(uint4*)(P.u() + (size_t)row * DM + l5e * 32 + q * 8) = make_uint4(pack2(ov[0], ov[1]), pack2(ov[2], ov[3]), pack2(ov[4], ov[5]), pack2(ov[6], ov[7]));
        }
      }
    } else {
      const float* gf = P.final_g + l5e * 32;
      if (!upe) {
#pragma unroll
        for (int q = 0; q < 8; ++q) {
          const float4 gg = *(const float4*)(gf + q * 4);
          *(float4*)(P.out + (size_t)row * DM + l5e * 32 + q * 4) =
              make_float4(o[q * 4] * rstd * gg.x, o[q * 4 + 1] * rstd * gg.y, o[q * 4 + 2] * rstd * gg.z, o[q * 4 + 3] * rstd * gg.w);
        }
      }
    }
  }
}

struct EpiOutproj {
  static constexpr bool PERM = false, AFTER_DRAIN = false;
  static constexpr int MIDK_T = 16;
  float* H; const float* hl; const float* hc; const float* modl;
  const float* yss;
  __device__ __forceinline__ void midk(pg8::f32x4 (&acc)[2][2][4][2], const pg8::Unit& u, int wr, int wc, int fr, int fq) const {
    const int row0 = u.pm * 256 + wr * 64 + fr;
#pragma unroll
    for (int ai = 0; ai < 2; ++ai)
#pragma unroll
      for (int m = 0; m < 4; ++m) {
        const pg8::f32x4* yp = (const pg8::f32x4*)(yss + (size_t)(row0 + ai * 128 + m * 16) * 16);
        const pg8::f32x4 y4 = (yp[0] + yp[1]) + (yp[2] + yp[3]);
        const float rstd = rsqrtf(((y4[0] + y4[1]) + (y4[2] + y4[3])) * (1.f / 1024.f) + 1e-6f);
#pragma unroll
        for (int bj = 0; bj < 2; ++bj)
#pragma unroll
          for (int n = 0; n < 2; ++n) acc[ai][bj][m][n] *= rstd;
      }
  }
  __device__ __forceinline__ void operator()(const pg8::f32x4 (&acc)[2][2][4][2], const pg8::Unit& u, int wr, int wc, int fr, int fq) const {
    const int row0 = u.pm * 256 + wr * 64 + fr, col0 = u.pn * 256 + wc * 32 + 4 * fq;
    const float* gate = modl + (size_t)modrow(row0) * MODW + 2048 + col0;
    pg8::f32x4 gv[2][2];
#pragma unroll
    for (int bj = 0; bj < 2; ++bj)
#pragma unroll
      for (int n = 0; n < 2; ++n) gv[bj][n] = *(const pg8::f32x4*)(gate + bj * 128 + n * 16);
    pg8::f32x4 sA[4], sB[4];
#define EO_LOAD(dstv, ai_, m_) do { const float* s_ = hrow(hl, hc, row0 + (ai_) * 128 + (m_) * 16) + col0; \
      dstv[0] = *(const pg8::f32x4*)(s_); dstv[1] = *(const pg8::f32x4*)(s_ + 16); dstv[2] = *(const pg8::f32x4*)(s_ + 128); dstv[3] = *(const pg8::f32x4*)(s_ + 144); } while (0)
#define EO_STORE(srcv, ai_, m_) do { asm volatile("" : "+v"(srcv[0]), "+v"(srcv[1]), "+v"(srcv[2]), "+v"(srcv[3])); \
      float* d_ = H + (size_t)(row0 + (ai_) * 128 + (m_) * 16) * DM + col0; \
      *(pg8::f32x4*)(d_) = srcv[0] + gv[0][0] * acc[ai_][0][m_][0]; *(pg8::f32x4*)(d_ + 16) = srcv[1] + gv[0][1] * acc[ai_][0][m_][1]; \
      *(pg8::f32x4*)(d_ + 128) = srcv[2] + gv[1][0] * acc[ai_][1][m_][0]; *(pg8::f32x4*)(d_ + 144) = srcv[3] + gv[1][1] * acc[ai_][1][m_][1]; } while (0)
    EO_LOAD(sA, 0, 0);
#pragma unroll
    for (int i = 0; i < 8; i += 2) {
      EO_LOAD(sB, (i + 1) >> 2, (i + 1) & 3);
      EO_STORE(sA, i >> 2, i & 3);
      if (i + 2 < 8) EO_LOAD(sA, (i + 2) >> 2, (i + 2) & 3);
      EO_STORE(sB, (i + 1) >> 2, (i + 1) & 3);
    }
#undef EO_LOAD
#undef EO_STORE
  }
};

__device__ __forceinline__ uint32_t fp4_code(float x, float sc) {
  const float a = fabsf(x) * sc;
  const uint32_t c = (uint32_t)(a > 0.25f) + (uint32_t)(a > 0.75f) + (uint32_t)(a > 1.25f) + (uint32_t)(a > 1.75f) +
                     (uint32_t)(a > 2.5f) + (uint32_t)(a > 3.5f) + (uint32_t)(a > 5.0f);
  return c | (x < 0.f ? 8u : 0u);
}
__device__ void ph_convert_tables(int wv, const Params& P, int layer, int bid, int nb) {
  const int lane = otid(wv) & 63;
  for (int it0 = (bid * NWAVE + wv) * 2; it0 < 2 * 16384; it0 += nb * NWAVE * 2) {
    f32x4 v[2][4];
#pragma unroll
    for (int rr = 0; rr < 2; ++rr) {
      const int it = it0 + rr, t = it >> 14, e = it & 16383;
      const float* src = (t == 0 ? P.peer_u : P.peer_v) + ((size_t)layer * 16384 + e) * 1024 + lane * 16;
#pragma unroll
      for (int i = 0; i < 4; ++i) v[rr][i] = ((const f32x4*)src)[i];
    }
#pragma unroll
    for (int rr = 0; rr < 2; ++rr)
#pragma unroll
      for (int i = 0; i < 4; ++i) asm volatile("" : "+v"(v[rr][i]));
#pragma unroll
    for (int rr = 0; rr < 2; ++rr) {
      const int it = it0 + rr, t = it >> 14, e = it & 16383;
      float m = 0.f;
#pragma unroll
      for (int i = 0; i < 4; ++i)
        m = fmaxf(m, fmaxf(fmaxf(fabsf(v[rr][i][0]), fabsf(v[rr][i][1])), fmaxf(fabsf(v[rr][i][2]), fabsf(v[rr][i][3]))));
      m = wave_max(m);
      m = fmaxf(m, 1e-30f);
      const float sc = 6.0f / m, inv = m * (1.0f / 6.0f);
      uint2 o;
      {
        uint32_t p0 = 0u, p1 = 0u;
        p0 = __builtin_amdgcn_cvt_scalef32_pk_fp4_f32(p0, v[rr][0][0] * sc, v[rr][0][1] * sc, 1.0f, 0);
        p0 = __builtin_amdgcn_cvt_scalef32_pk_fp4_f32(p0, v[rr][0][2] * sc, v[rr][0][3] * sc, 1.0f, 1);
        p0 = __builtin_amdgcn_cvt_scalef32_pk_fp4_f32(p0, v[rr][1][0] * sc, v[rr][1][1] * sc, 1.0f, 2);
        p0 = __builtin_amdgcn_cvt_scalef32_pk_fp4_f32(p0, v[rr][1][2] * sc, v[rr][1][3] * sc, 1.0f, 3);
        p1 = __builtin_amdgcn_cvt_scalef32_pk_fp4_f32(p1, v[rr][2][0] * sc, v[rr][2][1] * sc, 1.0f, 0);
        p1 = __builtin_amdgcn_cvt_scalef32_pk_fp4_f32(p1, v[rr][2][2] * sc, v[rr][2][3] * sc, 1.0f, 1);
        p1 = __builtin_amdgcn_cvt_scalef32_pk_fp4_f32(p1, v[rr][3][0] * sc, v[rr][3][1] * sc, 1.0f, 2);
        p1 = __builtin_amdgcn_cvt_scalef32_pk_fp4_f32(p1, v[rr][3][2] * sc, v[rr][3][3] * sc, 1.0f, 3);
        o.x = p0; o.y = p1;
      }
      *(uint2*)((t == 0 ? P.tabU() : P.tabV()) + (size_t)e * 512 + lane * 8) = o;
      if (lane == 0) (t == 0 ? P.invU() : P.invV())[e] = inv;
    }
  }
}

enum {
  PH_PREP = 0, PH_NORM1, PH_INPROJ, PH_CONV, PH_SSDPREP, PH_STATES, PH_SCAN, PH_SSDY, PH_SSDNORM, PH_POOL, PH_NA,
  PH_OUTPROJ, PH_NORM2, PH_QGEMM, PH_TOPK, PH_GATHER, PH_FINAL
};

#define SMEM_BYTES 135168

__device__ __forceinline__ void run_phase(int wv, const Params& P, int ph, int layer, char* smem, int bid, int nb) {
  const float* hl = layer == 0 ? P.x : P.h();
  const float* hc = layer == 0 ? P.ctx : P.h() + (size_t)NLAT * DM;
  const int nrows = layer == 0 ? NTOK : NLAT;
  switch (ph) {
    case PH_PREP:
      for (int i = bid * NTHR + otid(wv); i < 2 * 8 * 2 * 128 * 128; i += nb * NTHR) P.keysb()[i] = f2bf(P.peer_keys[i]);
      for (int i = bid * NTHR + otid(wv); i < 2 * 4 * 128 * 128; i += nb * NTHR) {
        const int k = i & 127, n = (i >> 7) & 127, lg = i >> 14;
        P.poolwT()[i] = f2bf(P.pool_w[((size_t)lg * 128 + k) * 128 + n]);
      }
      ph_mod(wv, P, (float*)smem, bid, nb);
      for (int l = 0; l < 2; ++l) {
        ph_transpose(wv, P.w_in + (size_t)l * 1024 * INW, P.w_inT() + (size_t)l * PW * 1024, 1024, INW, PW, 0, 2560, 32, PW, (float*)smem, bid, nb);
        ph_transpose(wv, P.w_in + (size_t)l * 1024 * INW, P.w_dtT() + (size_t)l * 128 * 1024, 1024, INW, 128, 2560, 1 << 30, 0, 32, (float*)smem, bid, nb);
        ph_transpose(wv, P.w_out + (size_t)l * 2048 * 1024, P.w_outT() + (size_t)l * 1024 * 2048, 2048, 1024, 1024, 0, 1 << 30, 0, 1024, (float*)smem, bid, nb,
                     P.ssd_norm_g + l * 1024, 1024);
        ph_transpose(wv, P.peer_wq + (size_t)l * 1024 * 2048, P.w_qT() + (size_t)l * 2048 * 1024, 1024, 2048, 2048, 0, 1 << 30, 0, 2048, (float*)smem, bid, nb);
      }
      break;
    case PH_NORM1:
      ph_norm(wv, hl, hc, P.norm1_g + layer * 1024, P.mod() + (size_t)layer * 5 * MODW, 0, 1024, NTOK, P.u(), bid, nb);
      break;
    case PH_INPROJ:
    {
      pg8::Gemm g{P.u(), P.w_inT() + (size_t)layer * PW * 1024, NTOK, PW, 1024};
      pg8::StaticOrder S; S.init(g.M, g.N, nb, bid);
      pg8::EpiBf16<0> E{P.p(), PW, nullptr, 0, 0};
      pg8::gemm_phase<pg8::EpiBf16<0>, pg8::StaticOrder, false>(wv, (PG8_LAS unsigned char*)smem, g, S, E, nullptr);
      {
        const int units = (NTOK / 256) * (PW / 256), rem = units % nb;
        const int nidle = rem == 0 ? nb : nb - rem, first_idle = rem == 0 ? 0 : rem;
        if (bid >= first_idle) ph_dtprep(wv, P, layer, smem, bid - first_idle, nidle);
      }
      break;
    }
    case PH_CONV: ph_conv(wv, P, layer, bid, nb); ph_vtranspose(wv, P, smem, bid, nb); break;
    case PH_STATES: ph_states_mfma(wv, P, layer, smem, bid, nb); break;
    case PH_SCAN: ph_scan(wv, P, bid, nb); break;
    case PH_SSDY: ph_ssdy_mfma(wv, P, layer, nrows / 128, smem, bid, nb); break;
    case PH_POOL: ph_pool_mfma(wv, P, layer, nrows, smem, bid, nb); break;
    case PH_NA: ph_na_mfma(wv, P, layer, nrows, smem, bid, nb); break;
    case PH_OUTPROJ:
    {
      pg8::Gemm g{P.concat(), P.w_outT() + (size_t)layer * 1024 * 2048, nrows, 1024, 2048};
      pg8::StaticOrder S; S.init(g.M, g.N, nb, bid);
      EpiOutproj E{P.h(), hl, hc, P.mod() + (size_t)layer * 5 * MODW, P.yss()};
      pg8::gemm_phase<EpiOutproj, pg8::StaticOrder, false>(wv, (PG8_LAS unsigned char*)smem, g, S, E, nullptr);
      break;
    }
    case PH_NORM2:
      ph_norm(wv, P.h(), P.h() + (size_t)NLAT * DM, P.norm2_g + layer * 1024, P.mod() + (size_t)layer * 5 * MODW, 3072, 4096, nrows, P.u(), bid, nb);
      break;
    case PH_QGEMM:
    {
      pg8::Gemm g{P.u(), P.w_qT() + (size_t)layer * 2048 * 1024, nrows, 2048, 1024};
      pg8::StaticOrder S; S.init(g.M, g.N, nb, bid);
      pg8::EpiBf16<0> E{P.q(), 2048, nullptr, 0, 0};
      pg8::gemm_phase<pg8::EpiBf16<0>, pg8::StaticOrder, false>(wv, (PG8_LAS unsigned char*)smem, g, S, E, nullptr);
      ph_convert_tables(wv, P, layer, bid, nb);
      break;
    }
    case PH_TOPK: ph_peer_topk_mfma(wv, P, layer, nrows, smem, bid, nb); break;
    case PH_GATHER: ph_peer_dots(wv, P, layer, nrows, bid, nb); ph_peer_acc(wv, P, layer, nrows, bid, nb); break;
  }
}

namespace cg = cooperative_groups;
typedef const __attribute__((address_space(4))) Params* kparams_t;
__device__ __forceinline__ const Params& kp_fresh() {
  kparams_t kp = (kparams_t)__builtin_amdgcn_kernarg_segment_ptr();
  asm volatile("" : "+s"(kp));
  return *(const Params*)kp;
}
__global__ void __launch_bounds__(NTHR) k_mega(Params P_unused) {
  __shared__ __attribute__((aligned(16))) char smem[SMEM_BYTES + 16];
  cg::grid_group grid = cg::this_grid();
  const int bid = blockIdx.x, nb = gridDim.x;
  const int wv = __builtin_amdgcn_readfirstlane(threadIdx.x >> 6);
  if (threadIdx.x == 0) *(uint4*)(smem + SMEM_BYTES) = make_uint4(0u, 0u, 0u, 0u);
  __syncthreads();
  (void)xcd_barrier_post((unsigned*)(kp_fresh().ws + WS_BAR), (volatile LAS unsigned*)(smem + SMEM_BYTES), threadIdx.x == 0);
#define GSYNC() do { XcdBarrier xb_; xb_.bar = (unsigned*)(kp_fresh().ws + WS_BAR); xb_.x = xb_xcc_id(); \
    xb_.st = (volatile LAS unsigned*)(smem + SMEM_BYTES); xcd_barrier(xb_, otid(wv) == 0); } while (0)
  run_phase(wv, kp_fresh(), PH_PREP, 0, smem, bid, nb);
  if (nb == 0x7fffff00) grid.sync();
  GSYNC();
  run_phase(wv, kp_fresh(), PH_NORM1, 0, smem, bid, nb); GSYNC();
#pragma unroll 1
  for (int layer = 0; layer < 2; ++layer) {
    run_phase(wv, kp_fresh(), PH_INPROJ, layer, smem, bid, nb); GSYNC();
    run_phase(wv, kp_fresh(), PH_CONV, layer, smem, bid, nb);
    GSYNC();
    run_phase(wv, kp_fresh(), PH_STATES, layer, smem, bid, nb);
    run_phase(wv, kp_fresh(), PH_POOL, layer, smem, bid, nb);
    run_phase(wv, kp_fresh(), PH_NA, layer, smem, bid, nb); GSYNC();
    run_phase(wv, kp_fresh(), PH_SCAN, layer, smem, bid, nb); GSYNC();
    run_phase(wv, kp_fresh(), PH_SSDY, layer, smem, bid, nb); GSYNC();
    run_phase(wv, kp_fresh(), PH_OUTPROJ, layer, smem, bid, nb); GSYNC();
    run_phase(wv, kp_fresh(), PH_NORM2, layer, smem, bid, nb); GSYNC();
    run_phase(wv, kp_fresh(), PH_QGEMM, layer, smem, bid, nb); GSYNC();
    run_phase(wv, kp_fresh(), PH_TOPK, layer, smem, bid, nb); GSYNC();
    run_phase(wv, kp_fresh(), PH_GATHER, layer, smem, bid, nb);
    if (layer == 0) GSYNC();
  }
}

extern "C" void kernel_launch(void* const* d_in, const int* in_sizes, int n_in, void* d_out, int out_size, void* d_ws,
                              size_t ws_size, hipStream_t stream) {
  Params P{};
  const float* const* in = (const float* const*)d_in;
  P.x = in[0]; P.c = in[1]; P.ctx = in[2]; P.c_ctx = in[3]; P.ada_w = in[4]; P.ada_b = in[5]; P.norm1_g = in[6];
  P.w_in = in[7]; P.conv_w = in[8]; P.conv_b = in[9]; P.a_log = in[10]; P.dt_bias = in[11]; P.d_skip = in[12];
  P.ssd_norm_g = in[13]; P.pool_w = in[14]; P.pool_scale = in[15]; P.na_rpb = in[16]; P.w_out = in[17];
  P.norm2_g = in[18]; P.peer_wq = in[19]; P.peer_keys = in[20]; P.peer_u = in[21]; P.peer_v = in[22]; P.final_g = in[23];
  P.out = (float*)d_out;
  P.ws = (char*)d_ws;
  if (WS_TOTAL > ws_size) { fprintf(stderr, "workspace too small: need %zu have %zu\n", (size_t)WS_TOTAL, ws_size); return; }

  static int grid_blocks = 0;
  if (!grid_blocks) {
    int dev = 0, cus = 0, per_cu = 0;
    hipGetDevice(&dev);
    hipDeviceGetAttribute(&cus, hipDeviceAttributeMultiprocessorCount, dev);
    hipOccupancyMaxActiveBlocksPerMultiprocessor(&per_cu, k_mega, NTHR, 0);
    if (per_cu > 4) per_cu = 4;
    grid_blocks = cus * per_cu;
  }
  hipMemsetAsync((char*)d_ws + WS_BAR, 0, 4096 * 4, stream);
  void* args[] = {&P};
  hipError_t e = hipLaunchCooperativeKernel((void*)k_mega, dim3(grid_blocks), dim3(NTHR), args, 0, stream);
  if (e != hipSuccess) fprintf(stderr, "cooperative launch failed: %s (grid %d)\n", hipGetErrorString(e), grid_blocks);
}
```

```cpp
#include <hip/hip_runtime.h>
#include <hip/hip_bf16.h>
#include <hip/hip_cooperative_groups.h>
#include <stdint.h>
#include <stdio.h>

typedef unsigned short bf16_t;
typedef __attribute__((ext_vector_type(8))) short bf16x8;
typedef __attribute__((ext_vector_type(4))) float f32x4;

#define NTHR 512
#define NWAVE 8
constexpr int DM = 1024;
constexpr int SEQ = 4096;
constexpr int NLAT = 16384;
constexpr int NCTXR = 1024;
constexpr int NTOK = 17408;
constexpr int INW = 4640;
constexpr int PW = 4608;
constexpr int OFF_Z = 0, OFF_XBC = 1024, OFF_POOL = 2560, OFF_Q = 3072, OFF_K = 3584, OFF_V = 4096;
constexpr int NCHUNK = 136;
constexpr int MODW = 6144;

constexpr size_t al256(size_t x) { return (x + 255) & ~(size_t)255; }
constexpr size_t WS_MOD = 0;
constexpr size_t WS_H = WS_MOD + al256((size_t)2 * 5 * MODW * 4);
constexpr size_t WS_P = WS_H + al256((size_t)NTOK * DM * 4);
constexpr size_t WS_TABU = WS_P + (size_t)80 * 1024 * 1024;
constexpr size_t WS_TABV = WS_TABU + (size_t)16384 * 512;
constexpr size_t WS_INVU = WS_TABV + (size_t)16384 * 512;
constexpr size_t WS_INVV = WS_INVU + (size_t)16384 * 4;
constexpr size_t WS_DTRAW = WS_P + al256((size_t)NTOK * PW * 2);
constexpr size_t WS_DTV = WS_DTRAW + al256((size_t)NTOK * 32 * 4);
constexpr size_t WS_CSV = WS_DTV + al256((size_t)NTOK * 32 * 4);
constexpr size_t WS_XBC = WS_CSV + al256((size_t)NTOK * 32 * 4);
constexpr size_t WS_VTL = WS_XBC + al256((size_t)NTOK * 512 * 2);
constexpr size_t WS_VTC = WS_VTL + al256((size_t)4 * 8 * 64 * 4096 * 2);
constexpr size_t WS_KEYSB = WS_VTC + al256((size_t)4 * 8 * 64 * 256 * 2);
constexpr size_t WS_POOLWT = WS_KEYSB + al256((size_t)2 * 8 * 2 * 128 * 128 * 2);
constexpr size_t WS_BT4 = WS_POOLWT + al256((size_t)2 * 4 * 128 * 128 * 2);
constexpr size_t WS_ATOT = WS_BT4 + al256((size_t)NTOK * 256 * 2);
constexpr size_t WS_STATES = WS_XBC + al256((size_t)NTOK * 1536 * 2);
constexpr size_t WS_YSS = WS_ATOT + al256((size_t)NCHUNK * 32 * 4);
static_assert(WS_YSS + (size_t)NTOK * 16 * 4 <= WS_STATES, "must fit in the old xbc region");
constexpr size_t WS_CONCAT = WS_STATES + al256((size_t)NCHUNK * 32 * 8192 * 2);
constexpr size_t WS_SELIDX = WS_CONCAT + al256((size_t)NTOK * 2048 * 2);
constexpr size_t WS_SELG = WS_SELIDX + al256((size_t)NTOK * 128 * 4);
constexpr size_t WS_WINT = WS_SELG + al256((size_t)NTOK * 128 * 4);
constexpr size_t WS_WDTT = WS_WINT + al256((size_t)2 * PW * 1024 * 2);
constexpr size_t WS_WOUTT = WS_WDTT + al256((size_t)2 * 128 * 1024 * 2);
constexpr size_t WS_WQT = WS_WOUTT + al256((size_t)2 * 1024 * 2048 * 2);
constexpr size_t WS_BAR = WS_WQT + al256((size_t)2 * 2048 * 1024 * 2);
constexpr size_t WS_XT4 = WS_BAR + al256((size_t)4096 * 4);
constexpr size_t WS_TOTAL = WS_XT4 + al256((size_t)NTOK * 1024 * 2);
static_assert((size_t)4 * 8 * (4096 + 256) * 64 * 2 <= WS_WINT - WS_SELIDX, "K relayout must fit in the sel_idx/sel_g region");
static_assert(WS_INVV + (size_t)16384 * 4 <= WS_DTRAW, "tables must fit in the tail of p");
static_assert((size_t)NTOK * 2048 * 2 <= (size_t)80 * 1024 * 1024, "q must fit below the tables");

struct Params {
  const float *x, *c, *ctx, *c_ctx, *ada_w, *ada_b, *norm1_g, *w_in, *conv_w, *conv_b, *a_log, *dt_bias, *d_skip,
      *ssd_norm_g, *pool_w, *pool_scale, *na_rpb, *w_out, *norm2_g, *peer_wq, *peer_keys, *peer_u, *peer_v, *final_g;
  float* out;
  char* ws;
  __device__ __forceinline__ float* mod() const { return (float*)(ws + WS_MOD); }
  __device__ __forceinline__ float* h() const { return (float*)(ws + WS_H); }
  __device__ __forceinline__ bf16_t* u() const { return (bf16_t*)(ws + WS_CONCAT); }
  __device__ __forceinline__ bf16_t* p() const { return (bf16_t*)(ws + WS_P); }
  __device__ __forceinline__ float* dtraw() const { return (float*)(ws + WS_DTRAW); }
  __device__ __forceinline__ float* dtv() const { return (float*)(ws + WS_DTV); }
  __device__ __forceinline__ float* csv() const { return (float*)(ws + WS_CSV); }
  __device__ __forceinline__ bf16_t* xbc() const { return (bf16_t*)(ws + WS_XBC); }
  __device__ __forceinline__ bf16_t* states() const { return (bf16_t*)(ws + WS_STATES); }
  __device__ __forceinline__ bf16_t* concat() const { return (bf16_t*)(ws + WS_CONCAT); }
  __device__ __forceinline__ bf16_t* q() const { return (bf16_t*)(ws + WS_P); }
  __device__ __forceinline__ int* sel_idx() const { return (int*)(ws + WS_SELIDX); }
  __device__ __forceinline__ float* sel_g() const { return (float*)(ws + WS_SELG); }
  __device__ __forceinline__ bf16_t* w_inT() const { return (bf16_t*)(ws + WS_WINT); }
  __device__ __forceinline__ bf16_t* w_dtT() const { return (bf16_t*)(ws + WS_WDTT); }
  __device__ __forceinline__ bf16_t* w_outT() const { return (bf16_t*)(ws + WS_WOUTT); }
  __device__ __forceinline__ bf16_t* w_qT() const { return (bf16_t*)(ws + WS_WQT); }
  __device__ __forceinline__ bf16_t* vtl() const { return (bf16_t*)(ws + WS_VTL); }
  __device__ __forceinline__ bf16_t* vtc() const { return (bf16_t*)(ws + WS_VTC); }
  __device__ __forceinline__ bf16_t* poolwT() const { return (bf16_t*)(ws + WS_POOLWT); }
  __device__ __forceinline__ bf16_t* keysb() const { return (bf16_t*)(ws + WS_KEYSB); }
  __device__ __forceinline__ bf16_t* xt4() const { return (bf16_t*)(ws + WS_XT4); }
  __device__ __forceinline__ bf16_t* bt4() const { return (bf16_t*)(ws + WS_BT4); }
  __device__ __forceinline__ float* wst() const { return (float*)(ws + WS_DTRAW); }
  __device__ __forceinline__ float* cst() const { return (float*)(ws + WS_CSV); }
  __device__ __forceinline__ float* dtt() const { return (float*)(ws + WS_DTV); }
  __device__ __forceinline__ float* yss() const { return (float*)(ws + WS_YSS); }
  __device__ __forceinline__ float* atot() const { return (float*)(ws + WS_ATOT); }
  __device__ __forceinline__ bf16_t* bfr() const { return (bf16_t*)(ws + WS_XBC); }
  __device__ __forceinline__ bf16_t* cfr() const { return (bf16_t*)(ws + WS_XBC + (size_t)NTOK * 256 * 2); }
  __device__ __forceinline__ bf16_t* ktl() const { return (bf16_t*)(ws + WS_SELIDX); }
  __device__ __forceinline__ bf16_t* ktc() const { return (bf16_t*)(ws + WS_SELIDX + (size_t)4 * 8 * 4096 * 64 * 2); }
  __device__ __forceinline__ unsigned char* tabU() const { return (unsigned char*)(ws + WS_TABU); }
  __device__ __forceinline__ unsigned char* tabV() const { return (unsigned char*)(ws + WS_TABV); }
  __device__ __forceinline__ float* invU() const { return (float*)(ws + WS_INVU); }
  __device__ __forceinline__ float* invV() const { return (float*)(ws + WS_INVV); }
};

__device__ __forceinline__ int otid(int wv) {
  int l;
  asm volatile("v_mbcnt_lo_u32_b32 %0, -1, 0\n\tv_mbcnt_hi_u32_b32 %0, -1, %0" : "=v"(l));
  return (wv << 6) | l;
}
__device__ __forceinline__ float bf2f(bf16_t v) { return __uint_as_float(((uint32_t)v) << 16); }
typedef __bf16 bf16x2_hw __attribute__((ext_vector_type(2)));
__device__ __forceinline__ uint32_t pack2(float a, float b) {
  const float __attribute__((ext_vector_type(2))) v = {a, b};
  return __builtin_bit_cast(uint32_t, __builtin_convertvector(v, bf16x2_hw));
}
__device__ __forceinline__ bf16_t f2bf(float f) { return (bf16_t)(pack2(f, 0.f) & 0xffffu); }
#define DPP_F(v, ctrl) __int_as_float(__builtin_amdgcn_update_dpp(0, __float_as_int(v), (ctrl), 0xf, 0xf, true))
__device__ __forceinline__ float wave_sum(float v) {
  v += DPP_F(v, 0xB1);
  v += DPP_F(v, 0x4E);
  v += DPP_F(v, 0x141);
  v += DPP_F(v, 0x140);
  const int iv = __float_as_int(v);
  return __int_as_float(__builtin_amdgcn_readlane(iv, 0)) + __int_as_float(__builtin_amdgcn_readlane(iv, 16)) +
         __int_as_float(__builtin_amdgcn_readlane(iv, 32)) + __int_as_float(__builtin_amdgcn_readlane(iv, 48));
}
__device__ __forceinline__ float wave_max(float v) {
  v = fmaxf(v, DPP_F(v, 0xB1));
  v = fmaxf(v, DPP_F(v, 0x4E));
  v = fmaxf(v, DPP_F(v, 0x141));
  v = fmaxf(v, DPP_F(v, 0x140));
  const int iv = __float_as_int(v);
  return fmaxf(fmaxf(__int_as_float(__builtin_amdgcn_readlane(iv, 0)), __int_as_float(__builtin_amdgcn_readlane(iv, 16))),
               fmaxf(__int_as_float(__builtin_amdgcn_readlane(iv, 32)), __int_as_float(__builtin_amdgcn_readlane(iv, 48))));
}
__device__ __forceinline__ float fexp(float v) { return __builtin_amdgcn_exp2f(v * 1.44269504088896341f); }
__device__ __forceinline__ float silu_f(float v) { return v * __builtin_amdgcn_rcpf(1.f + fexp(-v)); }
__device__ __forceinline__ float softplus_f(float v) { return fmaxf(v, 0.f) + log1pf(expf(-fabsf(v))); }
__device__ __forceinline__ float gelu_f(float v) { return 0.5f * v * (1.f + erff(v * 0.70710678118654752f)); }

__device__ __forceinline__ void unpack8(const uint4 v, float* f) {
  f[0] = __uint_as_float(v.x << 16); f[1] = __uint_as_float(v.x & 0xffff0000u);
  f[2] = __uint_as_float(v.y << 16); f[3] = __uint_as_float(v.y & 0xffff0000u);
  f[4] = __uint_as_float(v.z << 16); f[5] = __uint_as_float(v.z & 0xffff0000u);
  f[6] = __uint_as_float(v.w << 16); f[7] = __uint_as_float(v.w & 0xffff0000u);
}
typedef float f32x2_t __attribute__((ext_vector_type(2)));
typedef unsigned u32x4_t __attribute__((ext_vector_type(4)));
typedef short s16x4 __attribute__((ext_vector_type(4)));
typedef __attribute__((address_space(3))) s16x4 lds_s16x4;
__device__ __forceinline__ bf16x8 tr_read2(const char* a0, const char* a1) {
  const s16x4 a = __builtin_amdgcn_ds_read_tr16_b64_v4i16((lds_s16x4*)a0);
  const s16x4 b = __builtin_amdgcn_ds_read_tr16_b64_v4i16((lds_s16x4*)a1);
  return (bf16x8){a[0], a[1], a[2], a[3], b[0], b[1], b[2], b[3]};
}

__device__ __forceinline__ const float* hrow(const float* hl, const float* hc, int row) {
  return row < NLAT ? hl + (size_t)row * DM : hc + (size_t)(row - NLAT) * DM;
}
__device__ __forceinline__ int modrow(int row) { return row < NLAT ? (row >> 12) : 4; }

namespace pg8 {
#define PG8_LAS __attribute__((address_space(3)))
typedef unsigned short bf16_t;
typedef short bf16x8 __attribute__((ext_vector_type(8)));
typedef float f32x4 __attribute__((ext_vector_type(4)));
typedef unsigned u32x4 __attribute__((ext_vector_type(4)));
constexpr int BM = 256, BK = 64, HALF = 128, HTB = HALF * BK * 2  , STAGE_BYTES = 8 * HTB, NXCD = 8, WGM = 8;

__host__ __device__ __forceinline__ int lds_byte(int r, int c) { const int st = (r >> 4) * 2 + (c >> 5), rr = r & 15, cc = c & 31, ob = rr * 64 + cc * 2; return st * 1024 + (ob ^ (((ob >> 9) & 1) << 5)); }
__host__ __device__ __forceinline__ void stage_rc(int b, int& R, int& C) { const int st = b / 1024, sb = b % 1024, swz = sb ^ (((sb >> 9) & 1) << 5); R = (st >> 1) * 16 + swz / 64; C = (st & 1) * 32 + (swz % 64) / 2; }
__host__ __device__ __forceinline__ int perm32(int rho) { const int n = rho >> 4, i = rho & 15; return 8 * (i >> 2) + 4 * n + (i & 3); }

struct Unit { int pm, pn; };
struct Gemm { const bf16_t* A; const bf16_t* Bt; int M, N, K; };

struct StaticOrder {
    int nM, nN, nwg, G, c;
    __host__ __device__ void init(int M, int N, int G_, int c_) { nM = M / BM; nN = N / BM; nwg = nM * nN; G = G_; c = c_; }
    __host__ __device__ bool next(int i, Unit& u) const {
        const long L = (long)i * G + c; if (L >= nwg) return false;
        int wgid = (int)L; { const int q = nwg / NXCD, r = nwg % NXCD, xcd = wgid % NXCD, off = wgid / NXCD; wgid = (xcd < r ? xcd * (q + 1) : r * (q + 1) + (xcd - r) * q) + off; }
        const int nig = WGM * nN, gid = wgid / nig, fm = gid * WGM, gsz = (nM - fm) < WGM ? (nM - fm) : WGM;
        u.pm = fm + ((wgid % nig) % gsz); u.pn = (wgid % nig) / gsz; return true;
    }
    __device__ __forceinline__ void a_ready(const Unit&) const {}
    __device__ __forceinline__ void done(const Unit&) const {}
};

__device__ __forceinline__ unsigned cvt_pk_bf16(float lo, float hi) { unsigned r; asm volatile("v_cvt_pk_bf16_f32 %0, %1, %2" : "=v"(r) : "v"(lo), "v"(hi)); return r; }
typedef float f32x2 __attribute__((ext_vector_type(2)));
__device__ __forceinline__ f32x2 gelu_pk(f32x2 v) { return v; }
template <int ACT  > struct EpiBf16 {
    static constexpr bool PERM = true, AFTER_DRAIN = false; static constexpr int MIDK_T = 0;
    bf16_t* O; int ldc; const float* bias; int split_cols; size_t split_stride;
    __device__ __forceinline__ void operator()(const f32x4 (&acc)[2][2][4][2], const Unit& u, int wr, int wc, int fr, int fq) const {
        const int row0 = u.pm * BM + wr * 64 + fr; int colt = u.pn * BM; bf16_t* base = O;
        if (split_cols) { const int t = colt / split_cols; base += (size_t)t * split_stride; colt -= t * split_cols; }
        const int col0 = colt + wc * 32 + 8 * fq, bcol0 = u.pn * BM + wc * 32 + 8 * fq;
        f32x4 bv[2][2];
#pragma unroll
        for (int bj = 0; bj < 2; ++bj)
#pragma unroll
            for (int n = 0; n < 2; ++n) bv[bj][n] = bias ? *(const f32x4*)(bias + bcol0 + bj * HALF + 4 * n) : (f32x4){0.f, 0.f, 0.f, 0.f};
#pragma unroll
        for (int ai = 0; ai < 2; ++ai)
#pragma unroll
            for (int m = 0; m < 4; ++m) { bf16_t* rowp = base + (size_t)(row0 + ai * HALF + m * 16) * ldc + col0;
#pragma unroll
                for (int bj = 0; bj < 2; ++bj) { f32x4 v0 = acc[ai][bj][m][0] + bv[bj][0], v1 = acc[ai][bj][m][1] + bv[bj][1];
                    if (ACT == 1) { f32x2 a = gelu_pk((f32x2){v0[0], v0[1]}), b = gelu_pk((f32x2){v0[2], v0[3]}), c = gelu_pk((f32x2){v1[0], v1[1]}), d = gelu_pk((f32x2){v1[2], v1[3]});
                        v0 = (f32x4){a.x, a.y, b.x, b.y}; v1 = (f32x4){c.x, c.y, d.x, d.y}; }
                    if (ACT == 2) {
#pragma unroll
                        for (int j = 0; j < 4; ++j) { v0[j] = 0.5f * v0[j] * (1.0f + erff(v0[j] * 0.70710678f)); v1[j] = 0.5f * v1[j] * (1.0f + erff(v1[j] * 0.70710678f)); } }
                    u32x4 w; w.x = cvt_pk_bf16(v0[0], v0[1]); w.y = cvt_pk_bf16(v0[2], v0[3]); w.z = cvt_pk_bf16(v1[0], v1[1]); w.w = cvt_pk_bf16(v1[2], v1[3]);
                    *(u32x4*)(rowp + bj * HALF) = w; } }
    }
};

template <class Epi, class Sched, bool STAMP = false>
__device__ __forceinline__ void gemm_phase(int wv, PG8_LAS unsigned char* lds, const Gemm g, const Sched& S, const Epi& E, unsigned long long* stamps) {
    const int tid = otid(wv), wid = __builtin_amdgcn_readfirstlane(tid >> 6), lane = tid & 63, wr = wid >> 2, wc = wid & 3, fr = lane & 15, fq = lane >> 4;
    const int K = g.K, nt = K / BK;
    int ts_lo = 0, ts_hi = 0, nts = 0; const unsigned long long rt_entry = STAMP ? (unsigned long long)wall_clock64() : 0ull;
#define PG8_STAMP() do { if (STAMP && wid == 0 && nts < 64) { const unsigned long long _c = (unsigned long long)clock64(); \
        ts_lo = (lane == nts) ? (int)(unsigned)_c : ts_lo; ts_hi = (lane == nts) ? (int)(unsigned)(_c >> 32) : ts_hi; ++nts; } } while (0)
    PG8_STAMP();
    unsigned voffA[2], voffB[2];
#pragma unroll
    for (int i = 0; i < 2; ++i) { int R, C; stage_rc(tid * 16 + i * 8192, R, C); const int Rb = Epi::PERM ? ((R & ~31) + perm32(R & 31)) : R;
        voffA[i] = (unsigned)(R * K + C) * 2u; voffB[i] = (unsigned)(Rb * K + C) * 2u; }
    const size_t kstep = (size_t)(BK * 2);
    const size_t hstep = (size_t)HALF * K * 2;
    const size_t tstep = 2 * hstep;
    const unsigned ldsw = (unsigned)wid * 1024u;
    const int aoff = lds_byte(wr * 64 + fr, fq * 8), boff = lds_byte(wc * 32 + fr, fq * 8);
#define PG8_SA(b, h) (((b) * 2 + (h)) * HTB)
#define PG8_SB(b, h) ((4 + (b) * 2 + (h)) * HTB)
#define PG8_STAGE(bufoff, gbase, voff) do { _Pragma("unroll") for (int _i = 0; _i < 2; ++_i) \
        __builtin_amdgcn_global_load_lds((const unsigned*)((const char*)(gbase) + (voff)[_i]), (PG8_LAS unsigned*)(lds + (bufoff) + ldsw + _i * 8192), 16, 0, 0); } while (0)
#define PG8_LDA(dst, b, h) do { _Pragma("unroll") for (int m = 0; m < 4; ++m) _Pragma("unroll") for (int k = 0; k < 2; ++k) dst[m][k] = *(const PG8_LAS bf16x8*)(lds + PG8_SA(b, h) + aoff + m * 2048 + k * 1024); } while (0)
#define PG8_LDB(dst, b, h) do { _Pragma("unroll") for (int n = 0; n < 2; ++n) _Pragma("unroll") for (int k = 0; k < 2; ++k) dst[n][k] = *(const PG8_LAS bf16x8*)(lds + PG8_SB(b, h) + boff + n * 2048 + k * 1024); } while (0)
#define PG8_MMA(ai, bj, At, Bt) do { __builtin_amdgcn_s_setprio(1); _Pragma("unroll") for (int m = 0; m < 4; ++m) _Pragma("unroll") for (int n = 0; n < 2; ++n) _Pragma("unroll") for (int k = 0; k < 2; ++k) \
        acc[ai][bj][m][n] = __builtin_amdgcn_mfma_f32_16x16x32_bf16(Bt[n][k], At[m][k], acc[ai][bj][m][n], 0, 0, 0); __builtin_amdgcn_s_setprio(0); } while (0)
#define PG8_WAIT_V(n) asm volatile("s_waitcnt vmcnt(" #n ")" ::: "memory")
#define PG8_WAIT_L(n) asm volatile("s_waitcnt lgkmcnt(" #n ")" ::: "memory")
#define PG8_BAR __builtin_amdgcn_s_barrier()
#define PG8_SCHED __builtin_amdgcn_sched_barrier(0)
    Unit cur, nxt; int ui = 0;
    if (!S.next(0, cur)) return;
    f32x4 acc[2][2][4][2];
#pragma unroll
    for (int a = 0; a < 2; ++a)
#pragma unroll
        for (int b = 0; b < 2; ++b)
#pragma unroll
            for (int m = 0; m < 4; ++m)
#pragma unroll
                for (int n = 0; n < 2; ++n) acc[a][b][m][n] = (f32x4){0.f, 0.f, 0.f, 0.f};
    bf16x8 At[4][2], B0[2][2], B1[2][2];
    const char* cA = (const char*)g.A + (size_t)cur.pm * tstep; const char* cB = (const char*)g.Bt + (size_t)cur.pn * tstep;
    S.a_ready(cur);
    PG8_STAGE(PG8_SB(0, 0), cB, voffB); PG8_STAGE(PG8_SA(0, 0), cA, voffA); PG8_STAGE(PG8_SB(0, 1), cB + hstep, voffB); PG8_STAGE(PG8_SA(0, 1), cA + hstep, voffA);
    if (wr == 1) PG8_BAR;
    PG8_WAIT_V(4); PG8_BAR;
    PG8_STAGE(PG8_SB(1, 0), cB + kstep, voffB); PG8_STAGE(PG8_SA(1, 0), cA + kstep, voffA); PG8_STAGE(PG8_SB(1, 1), cB + hstep + kstep, voffB);
    PG8_WAIT_V(6); PG8_BAR;
    PG8_STAMP();
    for (;;) {
        const bool has_next = S.next(ui + 1, nxt);
        const char* nA = has_next ? (const char*)g.A + (size_t)nxt.pm * tstep : cA; const char* nB = has_next ? (const char*)g.Bt + (size_t)nxt.pn * tstep : cB;
        for (int t = 0; t < nt; t += 2) {
            if constexpr (Epi::MIDK_T > 0) { if (t == Epi::MIDK_T) E.midk(acc, cur, wr, wc, fr, fq); }
            const bool last = (t == nt - 2);
            const char* a1 = cA + (size_t)(t + 1) * kstep;
            const char* a2 = last ? nA : cA + (size_t)(t + 2) * kstep; const char* b2 = last ? nB : cB + (size_t)(t + 2) * kstep;
            const char* a3 = a2 + kstep; const char* b3 = b2 + kstep;
            if (last && has_next) S.a_ready(nxt);
            PG8_LDB(B0, 0, 0); PG8_SCHED; PG8_LDA(At, 0, 0); PG8_STAGE(PG8_SA(1, 1), a1 + hstep, voffA);
            PG8_WAIT_L(8); PG8_BAR; PG8_WAIT_L(0); PG8_MMA(0, 0, At, B0); PG8_BAR; PG8_SCHED;
            PG8_LDB(B1, 0, 1); PG8_STAGE(PG8_SB(0, 0), b2, voffB);
            PG8_BAR; PG8_WAIT_L(0); PG8_MMA(0, 1, At, B1); PG8_BAR;
            PG8_LDA(At, 0, 1); PG8_STAGE(PG8_SA(0, 0), a2, voffA);
            PG8_BAR; PG8_WAIT_L(0); PG8_MMA(1, 0, At, B0); PG8_BAR; PG8_SCHED;
            PG8_STAGE(PG8_SB(0, 1), b2 + hstep, voffB);
            PG8_WAIT_V(6); PG8_BAR; PG8_MMA(1, 1, At, B1); PG8_BAR;
            PG8_LDB(B0, 1, 0); PG8_SCHED; PG8_LDA(At, 1, 0); PG8_STAGE(PG8_SA(0, 1), a2 + hstep, voffA);
            PG8_WAIT_L(8); PG8_BAR; PG8_WAIT_L(0); PG8_MMA(0, 0, At, B0); PG8_BAR; PG8_SCHED;
            PG8_LDB(B1, 1, 1); PG8_STAGE(PG8_SB(1, 0), b3, voffB);
            PG8_BAR; PG8_WAIT_L(0); PG8_MMA(0, 1, At, B1); PG8_BAR;
            PG8_LDA(At, 1, 1); PG8_STAGE(PG8_SA(1, 0), a3, voffA);
            PG8_BAR; PG8_WAIT_L(0); PG8_MMA(1, 0, At, B0); PG8_BAR; PG8_SCHED;
            PG8_STAGE(PG8_SB(1, 1), b3 + hstep, voffB);
            PG8_WAIT_V(6); PG8_BAR; PG8_MMA(1, 1, At, B1); PG8_BAR;
        }
        PG8_STAMP();
        if constexpr (!Epi::AFTER_DRAIN) { E(acc, cur, wr, wc, fr, fq); S.done(cur); }
        PG8_STAMP();
        if (!has_next) break;
#pragma unroll
        for (int a = 0; a < 2; ++a)
#pragma unroll
            for (int b = 0; b < 2; ++b)
#pragma unroll
                for (int m = 0; m < 4; ++m)
#pragma unroll
                    for (int n = 0; n < 2; ++n) acc[a][b][m][n] = (f32x4){0.f, 0.f, 0.f, 0.f};
        cur = nxt; cA = nA; cB = nB; ++ui;
    }
    PG8_WAIT_V(0);
    if (wr == 0) PG8_BAR;
    PG8_BAR;
    if constexpr (Epi::AFTER_DRAIN) { E.fused(acc, cur, wr, wc, fr, fq, lds, wid, lane); S.done(cur); }
    PG8_STAMP();
    if (STAMP && wid == 0) { stamps[lane] = lane < nts ? (((unsigned long long)(unsigned)ts_hi << 32) | (unsigned)ts_lo) : 0ull;
        if (lane == 62) stamps[62] = rt_entry; if (lane == 63) stamps[63] = (unsigned long long)wall_clock64(); }
#undef PG8_STAMP
#undef PG8_SA
#undef PG8_SB
#undef PG8_STAGE
#undef PG8_LDA
#undef PG8_LDB
#undef PG8_MMA
#undef PG8_WAIT_V
#undef PG8_WAIT_L
#undef PG8_BAR
#undef PG8_SCHED
}
}

#define XB_TMO      128
#define XB_XCNT(j)  (256  + 64 * (j))
#define XB_XSUB(j)  (1280 + 64 * (j))
#define XB_XGEN(j)  (2304 + 64 * (j))
#define XB_TOP      3328
#define XB_TOPGEN   3392
#define XCD_BAR_WORDS 3456
#define XB_SPIN_CAP (1u << 27)
#define LAS __attribute__((address_space(3)))

__device__ __forceinline__ unsigned xb_ld(unsigned* p)              { return __hip_atomic_load(p, __ATOMIC_RELAXED, __HIP_MEMORY_SCOPE_AGENT); }
__device__ __forceinline__ unsigned xb_add(unsigned* p, unsigned v) { return __hip_atomic_fetch_add(p, v, __ATOMIC_RELAXED, __HIP_MEMORY_SCOPE_AGENT); }
__device__ __forceinline__ unsigned xb_xcc_id() { return (unsigned)__builtin_amdgcn_s_getreg((3 << 11) | 20) & 0xFu; }
#define XB_SPIN(cond, bar) do { unsigned _sp = 0; while (cond) { __builtin_amdgcn_s_sleep(1); \
    if ((++_sp & 255u) == 0u) { if (xb_ld(&(bar)[XB_TMO])) break; if (_sp > XB_SPIN_CAP) { atomicAdd(&(bar)[XB_TMO], 1u); break; } } } } while (0)

struct XcdBarrier {
    unsigned* bar; unsigned x;
    volatile LAS unsigned* st;
};

__device__ __forceinline__ XcdBarrier xcd_barrier_post(unsigned* bar, volatile LAS unsigned* st, bool xb_t0) {
    XcdBarrier b; b.bar = bar; b.x = xb_xcc_id(); b.st = st;
    if (xb_t0) (void)xb_add(&bar[XB_XCNT(b.x)], 1u);
    return b;
}
__device__ __forceinline__ void xcd_barrier_complete(unsigned* bar, unsigned x, unsigned& nloc, unsigned& nx) {
    const unsigned G = gridDim.x * gridDim.y * gridDim.z;
    unsigned sum, cnt, mine, sp = 0u;
    for (;;) {
        sum = 0u; cnt = 0u; mine = 0u;
#pragma unroll
        for (unsigned j = 0; j < 16; ++j) { const unsigned c = xb_ld(&bar[XB_XCNT(j)]); sum += c; cnt += (c > 0u) ? 1u : 0u; mine = (j == x) ? c : mine; }
        if (sum == G) break;
        __builtin_amdgcn_s_sleep(1);
        if ((++sp & 255u) == 0u) { if (xb_ld(&bar[XB_TMO])) break; if (sp > XB_SPIN_CAP) { atomicAdd(&bar[XB_TMO], 1u); break; } }
    }
    nloc = mine > 0u ? mine : 1u; nx = cnt > 0u ? cnt : 1u;
}

__device__ __forceinline__ void xcd_barrier(const XcdBarrier& b, bool xb_t0) {
    asm volatile("s_waitcnt vmcnt(0)" ::: "memory");
    __syncthreads();
    if (xb_t0) {
        unsigned* bar = b.bar;
        __builtin_amdgcn_s_waitcnt(0);
        unsigned nloc = b.st[0], nx = b.st[1];
        if (nloc == 0u) { xcd_barrier_complete(bar, b.x, nloc, nx); b.st[0] = nloc; b.st[1] = nx; }
        const unsigned old = xb_add(&bar[XB_XSUB(b.x)], 1u);
        const unsigned gen = old / nloc;
        if (old + 1u == (gen + 1u) * nloc) {
            __builtin_amdgcn_fence(__ATOMIC_RELEASE, "agent");
            asm volatile("s_waitcnt vmcnt(0)" ::: "memory");
            const unsigned og = xb_add(&bar[XB_TOP], 1u);
            const unsigned tg = og / nx;
            if (og + 1u == (tg + 1u) * nx) xb_add(&bar[XB_TOPGEN], 1u);
            else XB_SPIN(xb_ld(&bar[XB_TOPGEN]) == tg, bar);
            __builtin_amdgcn_fence(__ATOMIC_ACQUIRE, "agent");
            xb_add(&bar[XB_XGEN(b.x)], 1u);
            asm volatile("s_waitcnt vmcnt(0)" ::: "memory");
        } else {
            XB_SPIN(xb_ld(&bar[XB_XGEN(b.x)]) == gen, bar);
            __builtin_amdgcn_fence(__ATOMIC_ACQUIRE, "agent");
            asm volatile("s_waitcnt vmcnt(0)" ::: "memory");
        }
    }
    __syncthreads();
}


__device__ void ph_transpose(int wv, const float* __restrict__ src, bf16_t* __restrict__ dst, int K, int N, int Npad,
                             int col0, int skip_from, int skip, int nvalid, float* tile, int bid, int nb,
                             const float* kscale = nullptr, int kscale_n = 0) {
  const int tk = K / 64, tn = Npad / 64;
  const int tid = otid(wv);
  for (int t = bid; t < tk * tn; t += nb) {
    const int kt = t / tn, nt = t % tn;
    __syncthreads();
#pragma unroll
    for (int i = 0; i < 2; ++i) {
      const int idx = tid + i * 512, kk = idx >> 4, n4 = (idx & 15) * 4;
      const int k = kt * 64 + kk, n = nt * 64 + n4;
      const int cc = col0 + n + (n >= skip_from ? skip : 0);
      const float ks = (kscale != nullptr && k < kscale_n) ? kscale[k] : 1.f;
      float4 v = make_float4(0.f, 0.f, 0.f, 0.f);
      if (n < nvalid) v = *(const float4*)(src + (size_t)k * N + cc);
      tile[kk * 65 + n4 + 0] = v.x * ks; tile[kk * 65 + n4 + 1] = v.y * ks; tile[kk * 65 + n4 + 2] = v.z * ks; tile[kk * 65 + n4 + 3] = v.w * ks;
    }
    __syncthreads();
    {
      const int nn = tid >> 3, k8 = (tid & 7) * 8;
      float f[8];
#pragma unroll
      for (int e = 0; e < 8; ++e) f[e] = tile[(k8 + e) * 65 + nn];
      *(uint4*)(dst + (size_t)(nt * 64 + nn) * K + kt * 64 + k8) = make_uint4(pack2(f[0], f[1]), pack2(f[2], f[3]), pack2(f[4], f[5]), pack2(f[6], f[7]));
    }
  }
}

__device__ void ph_mod(int wv, const Params& P, float* sm, int bid, int nb) {
  const int tid = otid(wv);
  float* sv = sm;
  float* red = sm + 5 * 1024;
  for (int i = tid; i < 5 * 1024; i += NTHR) {
    const float v = (i < 4096) ? P.c[i] : P.c_ctx[i - 4096];
    sv[i] = silu_f(v);
  }
  __syncthreads();
  const int c4 = tid & 15, kg = tid >> 4;
  for (int it = bid; it < 192; it += nb) {
    const int layer = it / 96, cb = it % 96;
    const float4* W = (const float4*)(P.ada_w + (size_t)layer * 1024 * MODW + cb * 64) + c4;
    float4 a[5];
#pragma unroll
    for (int r = 0; r < 5; ++r) a[r] = make_float4(0.f, 0.f, 0.f, 0.f);
#pragma unroll 8
    for (int kk = 0; kk < 32; ++kk) {
      const int k = kg * 32 + kk;
      const float4 w = W[(size_t)k * (MODW / 4)];
#pragma unroll
      for (int r = 0; r < 5; ++r) {
        const float s = sv[r * 1024 + k];
        a[r].x += s * w.x; a[r].y += s * w.y; a[r].z += s * w.z; a[r].w += s * w.w;
      }
    }
#pragma unroll
    for (int r = 0; r < 5; ++r) *(float4*)(red + ((kg * 16 + c4) * 5 + r) * 4) = a[r];
    __syncthreads();
    if (tid < 320) {
      const int r = tid >> 6, c = tid & 63;
      float s = 0.f;
      for (int g = 0; g < 32; ++g) s += red[((g * 16 + (c >> 2)) * 5 + r) * 4 + (c & 3)];
      P.mod()[(size_t)(layer * 5 + r) * MODW + cb * 64 + c] = s + P.ada_b[layer * MODW + cb * 64 + c];
    }
    __syncthreads();
  }
}

__device__ void ph_norm(int wv, const float* hl, const float* hc, const float* __restrict__ g, const float* __restrict__ modl,
                        int shift_off, int scale_off, int nrows, bf16_t* __restrict__ dst, int bid, int nb) {
  const int wave = otid(wv) >> 6, lane = otid(wv) & 63;
  const int stride = nb * NWAVE;
  for (int row0 = bid * NWAVE + wave; row0 < nrows; row0 += 2 * stride) {
    const int row1 = row0 + stride;
    const bool two = row1 < nrows;
    const int rows[2] = {row0, two ? row1 : row0};
    f32x4 v[2][4], ggv[4], scv[2][4], shv[2][4];
#pragma unroll
    for (int r = 0; r < 2; ++r) {
      const float* src = hrow(hl, hc, rows[r]);
      const float* mr = modl + (size_t)modrow(rows[r]) * MODW;
#pragma unroll
      for (int i = 0; i < 4; ++i) {
        const int idx = i * 256 + lane * 4;
        v[r][i] = *(const f32x4*)(src + idx);
        scv[r][i] = *(const f32x4*)(mr + scale_off + idx); shv[r][i] = *(const f32x4*)(mr + shift_off + idx);
      }
    }
#pragma unroll
    for (int i = 0; i < 4; ++i) ggv[i] = *(const f32x4*)(g + i * 256 + lane * 4);
#pragma unroll
    for (int r = 0; r < 2; ++r)
#pragma unroll
      for (int i = 0; i < 4; ++i) asm volatile("" : "+v"(v[r][i]), "+v"(scv[r][i]), "+v"(shv[r][i]));
#pragma unroll
    for (int r = 0; r < 2; ++r) {
      float ss = 0.f;
#pragma unroll
      for (int i = 0; i < 4; ++i) ss += v[r][i][0] * v[r][i][0] + v[r][i][1] * v[r][i][1] + v[r][i][2] * v[r][i][2] + v[r][i][3] * v[r][i][3];
      ss = wave_sum(ss);
      const float rstd = rsqrtf(ss * (1.f / 1024.f) + 1e-6f);
      if (r == 0 || two) {
#pragma unroll
        for (int i = 0; i < 4; ++i) {
          const int idx = i * 256 + lane * 4;
          const float o0 = v[r][i][0] * rstd * ggv[i][0] * (1.f + scv[r][i][0]) + shv[r][i][0];
          const float o1 = v[r][i][1] * rstd * ggv[i][1] * (1.f + scv[r][i][1]) + shv[r][i][1];
          const float o2 = v[r][i][2] * rstd * ggv[i][2] * (1.f + scv[r][i][2]) + shv[r][i][2];
          const float o3 = v[r][i][3] * rstd * ggv[i][3] * (1.f + scv[r][i][3]) + shv[r][i][3];
          *(uint2*)(dst + (size_t)rows[r] * DM + idx) = make_uint2(pack2(o0, o1), pack2(o2, o3));
        }
      }
    }
  }
}

__device__ void ph_conv(int wv, const Params& P, int layer, int bid, int nb) {
  const float* cw = P.conv_w + (size_t)layer * 3 * 1536;
  const float* cb = P.conv_b + (size_t)layer * 1536;
  const int total = (NTOK / 4) * 192;
  for (int it = bid * NTHR + otid(wv); it < total; it += nb * NTHR) {
    const int rq = it / 192, c8 = (it % 192) * 8, row0 = rq * 4;
    int l, L;
    if (row0 < NLAT) { l = row0 & 4095; L = 4096; } else { l = (row0 - NLAT) & 255; L = 256; }
    const bf16_t* pc = P.p() + (size_t)row0 * PW + OFF_XBC + c8;
    u32x4_t rv[6];
    rv[0] = *(const u32x4_t*)(pc - (l > 0 ? PW : 0));
#pragma unroll
    for (int i = 0; i < 4; ++i) rv[1 + i] = *(const u32x4_t*)(pc + (size_t)i * PW);
    rv[5] = *(const u32x4_t*)(pc + (size_t)(l + 4 < L ? 4 : 3) * PW);
#pragma unroll
    for (int i = 0; i < 6; ++i) asm volatile("" : "+v"(rv[i]));
    float f[6][8];
#pragma unroll
    for (int i = 0; i < 6; ++i) unpack8(make_uint4(rv[i].x, rv[i].y, rv[i].z, rv[i].w), f[i]);
    const float mp = l > 0 ? 1.f : 0.f, mn = l + 4 < L ? 1.f : 0.f;
    float o[4][8];
#pragma unroll
    for (int e = 0; e < 8; ++e) {
      const int c = c8 + e;
      const float w0 = cw[c], w1 = cw[1536 + c], w2 = cw[3072 + c], bb = cb[c];
#pragma unroll
      for (int i = 0; i < 4; ++i) {
        const float pv = i == 0 ? mp * f[0][e] : f[i][e];
        const float nv = i == 3 ? mn * f[5][e] : f[i + 2][e];
        o[i][e] = silu_f(bb + w0 * pv + w1 * f[i + 1][e] + w2 * nv);
      }
    }
    if (c8 < 1024) {
      const int head = c8 >> 6, p0 = c8 & 63;
      bf16_t* dst = P.xt4() + (((size_t)head * (NTOK / 4) + rq) * 64 + p0) * 4;
#pragma unroll
      for (int e2 = 0; e2 < 4; ++e2)
        *(uint4*)(dst + e2 * 8) = make_uint4(pack2(o[0][2 * e2], o[1][2 * e2]), pack2(o[2][2 * e2], o[3][2 * e2]),
                                             pack2(o[0][2 * e2 + 1], o[1][2 * e2 + 1]), pack2(o[2][2 * e2 + 1], o[3][2 * e2 + 1]));
    } else {
      {
        const int cc = (c8 - 1024) & 255, grp_ = cc >> 7, n0_ = cc & 127;
        bf16_t* fb = (c8 < 1280 ? P.bfr() : P.cfr()) + ((((size_t)grp_ * (NTOK / 16) + (row0 >> 4)) * 4 + (n0_ >> 5)) * 16 + (row0 & 15)) * 32 + (n0_ & 31);
#pragma unroll
        for (int i = 0; i < 4; ++i)
          *(uint4*)(fb + i * 32) = make_uint4(pack2(o[i][0], o[i][1]), pack2(o[i][2], o[i][3]), pack2(o[i][4], o[i][5]), pack2(o[i][6], o[i][7]));
      }
      if (c8 < 1280) {
        const int grp = (c8 - 1024) >> 7, n0 = (c8 - 1024) & 127;
        bf16_t* dst = P.bt4() + (((size_t)grp * (NTOK / 4) + rq) * 128 + n0) * 4;
#pragma unroll
        for (int e2 = 0; e2 < 4; ++e2)
          *(uint4*)(dst + e2 * 8) = make_uint4(pack2(o[0][2 * e2], o[1][2 * e2]), pack2(o[2][2 * e2], o[3][2 * e2]),
                                               pack2(o[0][2 * e2 + 1], o[1][2 * e2 + 1]), pack2(o[2][2 * e2 + 1], o[3][2 * e2 + 1]));
      }
    }
  }
}

__device__ void ph_dtprep(int wv, const Params& P, int layer, char* smem, int first, int step) {
  const int tid = otid(wv), lane = tid & 63, li = lane & 15, g = lane >> 4;
  float* tile = (float*)smem;
  float* segtot = tile + 128 * 33;
  const int dh = tid & 31, seg = tid >> 5;
  const float bias = P.dt_bias[layer * 32 + dh];
  const float ah = -expf(P.a_log[layer * 32 + dh]);
  const bf16_t* wb = P.w_dtT() + (size_t)layer * 128 * 1024 + (size_t)li * 1024 + 8 * g;
  for (int gc = first; gc < NCHUNK; gc += step) {
    const bf16_t* ua = P.u() + (size_t)(gc * 128 + wv * 16 + li) * DM + 8 * g;
    f32x4 acc0 = (f32x4){0.f, 0.f, 0.f, 0.f}, acc1 = acc0;
#pragma unroll 1
    for (int t0 = 0; t0 < 32; t0 += 8) {
      bf16x8 a[8], b0[8], b1[8];
#pragma unroll
      for (int t = 0; t < 8; ++t) {
        a[t] = *(const bf16x8*)(ua + 32 * (t0 + t));
        b0[t] = *(const bf16x8*)(wb + 32 * (t0 + t));
        b1[t] = *(const bf16x8*)(wb + 16 * 1024 + 32 * (t0 + t));
      }
#pragma unroll
      for (int t = 0; t < 8; ++t) asm volatile("" : "+v"(a[t]), "+v"(b0[t]), "+v"(b1[t]));
#pragma unroll
      for (int t = 0; t < 8; ++t) {
        acc0 = __builtin_amdgcn_mfma_f32_16x16x32_bf16(a[t], b0[t], acc0, 0, 0, 0);
        acc1 = __builtin_amdgcn_mfma_f32_16x16x32_bf16(a[t], b1[t], acc1, 0, 0, 0);
      }
    }
    __syncthreads();
#pragma unroll
    for (int e = 0; e < 4; ++e) {
      tile[(wv * 16 + 4 * g + e) * 33 + li] = acc0[e];
      tile[(wv * 16 + 4 * g + e) * 33 + 16 + li] = acc1[e];
    }
    __syncthreads();
    float r[8], c[8];
    float cs = 0.f;
#pragma unroll
    for (int j = 0; j < 8; ++j) { r[j] = softplus_f(tile[(seg * 8 + j) * 33 + dh] + bias); cs += r[j] * ah; c[j] = cs; }
    segtot[seg * 32 + dh] = cs;
    __syncthreads();
    float off = 0.f, tot = 0.f;
    for (int s = 0; s < 16; ++s) { const float v = segtot[s * 32 + dh]; if (s < seg) off += v; tot += v; }
    const size_t base = ((size_t)(gc * 32 + dh) * 128 + seg * 8);
    float cso[8], wso[8];
#pragma unroll
    for (int j = 0; j < 8; ++j) {
      const float csj = off + c[j], csp = j == 0 ? off : off + c[j - 1];
      cso[j] = dh < 16 ? csj : csp;
      wso[j] = r[j] * (dh < 16 ? fexp(tot - csj) : fexp(csp));
    }
#pragma unroll
    for (int q = 0; q < 2; ++q) {
      *(float4*)(P.cst() + base + q * 4) = make_float4(cso[q * 4], cso[q * 4 + 1], cso[q * 4 + 2], cso[q * 4 + 3]);
      *(float4*)(P.dtt() + base + q * 4) = make_float4(r[q * 4], r[q * 4 + 1], r[q * 4 + 2], r[q * 4 + 3]);
      *(float4*)(P.wst() + base + q * 4) = make_float4(wso[q * 4], wso[q * 4 + 1], wso[q * 4 + 2], wso[q * 4 + 3]);
    }
    if (seg == 0) P.atot()[gc * 32 + dh] = tot;
  }
}

__device__ __forceinline__ int scan_chunk(int b, int dir, int s) {
  if (dir == 0) return (s < 2) ? (128 + 2 * b + s) : (32 * b + (s - 2));
  return (s < 2) ? (128 + 2 * b + 1 - s) : (32 * b + 31 - (s - 2));
}
__device__ void ph_scan(int wv, const Params& P, int bid, int nb) {
  const int total = 4 * 32 * 1024;
  for (int it = bid * NTHR + otid(wv); it < total; it += nb * NTHR) {
    const int e8 = it & 1023, dh = (it >> 10) & 31, b = it >> 15, dir = dh >> 4;
    float S[8];
    float zero_ = 0.f;
    asm volatile("" : "+v"(zero_));
#pragma unroll
    for (int i = 0; i < 8; ++i) S[i] = zero_;
#pragma unroll
    for (int hb = 0; hb < 2; ++hb) {
      u32x4_t v[17];
      float at[17];
#pragma unroll
      for (int s = 0; s < 17; ++s) {
        const int gc = scan_chunk(b, dir, hb * 17 + s);
        v[s] = *(const u32x4_t*)(P.states() + (size_t)(gc * 32 + dh) * 8192 + e8 * 8);
        at[s] = P.atot()[gc * 32 + dh];
      }
#pragma unroll
      for (int s = 0; s < 17; ++s) asm volatile("" : "+v"(v[s]));
#pragma unroll
      for (int s = 0; s < 17; ++s) {
        const int gc = scan_chunk(b, dir, hb * 17 + s);
        const float dec = fexp(at[s]);
        float cst[8];
        unpack8(make_uint4(v[s].x, v[s].y, v[s].z, v[s].w), cst);
        *(uint4*)(P.states() + (size_t)(gc * 32 + dh) * 8192 + e8 * 8) =
            make_uint4(pack2(S[0], S[1]), pack2(S[2], S[3]), pack2(S[4], S[5]), pack2(S[6], S[7]));
#pragma unroll
        for (int i = 0; i < 8; ++i) S[i] = dec * S[i] + cst[i];
      }
    }
  }
}

__device__ __forceinline__ void conv_x8(const Params& P, int layer, int row, int ch0, float* out) {
  int l, L;
  if (row < NLAT) { l = row & 4095; L = 4096; } else { l = (row - NLAT) & 255; L = 256; }
  const bf16_t* pc = P.p() + (size_t)row * PW + OFF_XBC + ch0;
  const uint4 cur = *(const uint4*)pc;
  const uint4 prv = *(const uint4*)(pc - (l > 0 ? PW : 0));
  const uint4 nxt = *(const uint4*)(pc + (l < L - 1 ? PW : 0));
  const float mp = l > 0 ? 1.f : 0.f, mn = l < L - 1 ? 1.f : 0.f;
  float fp[8], fc[8], fn[8];
  unpack8(prv, fp); unpack8(cur, fc); unpack8(nxt, fn);
  const float* cw = P.conv_w + (size_t)layer * 3 * 1536 + ch0;
  const float* cb = P.conv_b + (size_t)layer * 1536 + ch0;
#pragma unroll
  for (int e = 0; e < 8; ++e) out[e] = silu_f(cb[e] + cw[e] * (mp * fp[e]) + cw[1536 + e] * fc[e] + cw[3072 + e] * (mn * fn[e]));
}

constexpr int XS = 72;
constexpr int BS = 136;


__device__ __forceinline__ bool ssd_item(int round, int bid, int nb, int nchunks, int& gc, int& head) {
  if ((nb & 63) == 0) {
    const int x = bid & 7, j = bid >> 3, per = nb >> 6;
    const int cg = (round * per + (j >> 3)) * 8 + x;
    if (cg >= nchunks * 2) return false;
    gc = cg >> 1; head = (cg & 1) * 8 + (j & 7);
    return true;
  }
  const int it = round * nb + bid;
  if (it >= nchunks * 16) return false;
  gc = it >> 4; head = it & 15;
  return true;
}

__device__ void ph_states_mfma(int wv, const Params& P, int layer, char* smem, int bid, int nb) {
  const int lane = otid(wv) & 63, li = lane & 15, g = lane >> 4;
  const int nq = wv >> 1, ph = wv & 1;
  for (int round = 0;; ++round) {
    int gc, head;
    if (!ssd_item(round, bid, nb, NCHUNK, gc, head)) break;
    const int grp = head >> 3, q0 = gc * 32;
    const bf16_t* xb = P.xt4() + (((size_t)head * (NTOK / 4) + q0 + g) * 64 + ph * 32 + li) * 4;
    const bf16_t* bb = P.bt4() + (((size_t)grp * (NTOK / 4) + q0 + g) * 128 + nq * 32 + li) * 4;
    const float* wpf = P.wst() + (size_t)(gc * 32 + head) * 128 + 4 * g;
    const float* wpb = wpf + 16 * 128;
    f32x4 acc[2][2][2];
#pragma unroll
    for (int d = 0; d < 2; ++d)
#pragma unroll
      for (int a = 0; a < 2; ++a)
#pragma unroll
        for (int b = 0; b < 2; ++b) acc[d][a][b] = (f32x4){0.f, 0.f, 0.f, 0.f};
#pragma unroll
    for (int t = 0; t < 4; ++t) {
      s16x4 alo[2], ahi[2], xlo[2], xhi[2];
      f32x4 wfl, wfh, wbl, wbh;
#pragma unroll
      for (int i = 0; i < 2; ++i) {
        alo[i] = *(const s16x4*)(bb + ((size_t)(t * 8) * 128 + i * 16) * 4);
        ahi[i] = *(const s16x4*)(bb + ((size_t)(t * 8 + 4) * 128 + i * 16) * 4);
        xlo[i] = *(const s16x4*)(xb + ((size_t)(t * 8) * 64 + i * 16) * 4);
        xhi[i] = *(const s16x4*)(xb + ((size_t)(t * 8 + 4) * 64 + i * 16) * 4);
      }
      wfl = *(const f32x4*)(wpf + 32 * t); wfh = *(const f32x4*)(wpf + 32 * t + 16);
      wbl = *(const f32x4*)(wpb + 32 * t); wbh = *(const f32x4*)(wpb + 32 * t + 16);
      asm volatile("" : "+v"(alo[0]), "+v"(alo[1]), "+v"(ahi[0]), "+v"(ahi[1]));
      bf16x8 af[2];
#pragma unroll
      for (int i = 0; i < 2; ++i) af[i] = (bf16x8){alo[i][0], alo[i][1], alo[i][2], alo[i][3], ahi[i][0], ahi[i][1], ahi[i][2], ahi[i][3]};
#pragma unroll
      for (int d = 0; d < 2; ++d) {
        const f32x4 wl = d == 0 ? wfl : wbl, wh = d == 0 ? wfh : wbh;
#pragma unroll
        for (int b = 0; b < 2; ++b) {
          bf16x8 bfrag;
#pragma unroll
          for (int i = 0; i < 4; ++i) {
            bfrag[i] = (short)f2bf(bf2f((bf16_t)xlo[b][i]) * wl[i]);
            bfrag[4 + i] = (short)f2bf(bf2f((bf16_t)xhi[b][i]) * wh[i]);
          }
#pragma unroll
          for (int a = 0; a < 2; ++a) acc[d][a][b] = __builtin_amdgcn_mfma_f32_16x16x32_bf16(af[a], bfrag, acc[d][a][b], 0, 0, 0);
        }
      }
    }
#pragma unroll
    for (int d = 0; d < 2; ++d) {
      bf16_t* dst = P.states() + (size_t)(gc * 32 + d * 16 + head) * 8192;
#pragma unroll
      for (int a = 0; a < 2; ++a)
#pragma unroll
        for (int b = 0; b < 2; ++b) {
          uint2 o;
          o.x = pack2(acc[d][a][b][0], acc[d][a][b][1]); o.y = pack2(acc[d][a][b][2], acc[d][a][b][3]);
          *(uint2*)(dst + ((nq * 4 + 2 * ph + b) * 16 + li) * 32 + 16 * a + 4 * g) = o;
        }
    }
  }
}

__device__ void ph_ssdy_mfma(int wv, const Params& P, int layer, int nchunks, char* smem, int bid, int nb) {
  const int tid = otid(wv), lane = tid & 63, li = lane & 15, g = lane >> 4;
  float* tabs = (float*)smem;
  char* bbuf = smem + 4096;
  char* xbuf = bbuf + 65536;
  char* sbufS = xbuf + 32768;
  u32x4_t pf[10];
  float pft = 0.f;
#pragma unroll
  for (int i = 0; i < 10; ++i) pf[i] = (u32x4_t){0u, 0u, 0u, 0u};
#define SSDY_FETCH(gc_, head_) do { const int grp_ = (head_) >> 3; \
      const char* bsrc_ = (const char*)(P.bfr() + ((size_t)grp_ * (NTOK / 16) + (gc_) * 8) * 4 * 16 * 32); \
      const char* xsrc_ = (const char*)(P.xt4() + ((size_t)(head_) * (NTOK / 4) + (gc_) * 32) * 64 * 4); \
      _Pragma("unroll") for (int i_ = 0; i_ < 4; ++i_) pf[i_] = *(const u32x4_t*)(bsrc_ + (size_t)(tid + i_ * 512) * 16); \
      _Pragma("unroll") for (int i_ = 0; i_ < 2; ++i_) pf[4 + i_] = *(const u32x4_t*)(xsrc_ + (size_t)(tid + i_ * 512) * 16); \
      _Pragma("unroll") for (int i_ = 0; i_ < 4; ++i_) { const int c_ = tid + i_ * 512; \
        pf[6 + i_] = *(const u32x4_t*)((const char*)(P.states() + (size_t)((gc_) * 32 + (c_ >> 10) * 16 + (head_)) * 8192) + (size_t)(c_ & 1023) * 16); } \
      { const int arr_ = tid >> 7, j_ = tid & 127; \
        pft = ((arr_ & 1) ? P.dtt() : P.cst())[(size_t)((gc_) * 32 + (arr_ >> 1) * 16 + (head_)) * 128 + j_]; } } while (0)
#define SSDY_PUT_S() do { _Pragma("unroll") for (int i_ = 0; i_ < 4; ++i_) *(u32x4_t*)(sbufS + (size_t)(tid + i_ * 512) * 16) = pf[6 + i_]; } while (0)
#define SSDY_PUT_BX(buf_) do { \
      _Pragma("unroll") for (int i_ = 0; i_ < 4; ++i_) *(u32x4_t*)(bbuf + (buf_) * 32768 + (size_t)(tid + i_ * 512) * 16) = pf[i_]; \
      _Pragma("unroll") for (int i_ = 0; i_ < 2; ++i_) *(u32x4_t*)(xbuf + (buf_) * 16384 + (size_t)(tid + i_ * 512) * 16) = pf[4 + i_]; \
      tabs[(buf_) * 512 + tid] = pft; } while (0)
  {
    int gc0 = 0, head0 = 0;
    __syncthreads();
    if (ssd_item(0, bid, nb, nchunks, gc0, head0)) { SSDY_FETCH(gc0, head0); SSDY_PUT_BX(0); SSDY_PUT_S(); }
    __syncthreads();
  }
  for (int round = 0;; ++round) {
    int gc, head;
    if (!ssd_item(round, bid, nb, nchunks, gc, head)) break;
    const int grp = head >> 3, row0 = gc * 128;
    const char* bs = bbuf + (round & 1) * 32768;
    const char* xs_l = xbuf + (round & 1) * 16384;
    const float* csf = tabs + (round & 1) * 512;
    const float* dtf = csf + 128;
    const float* exb = csf + 256;
    const float* dtb = csf + 384;
    int gcn = 0, headn = 0;
    const bool has_next = ssd_item(round + 1, bid, nb, nchunks, gcn, headn);
    if (has_next) SSDY_FETCH(gcn, headn);
    const float atb = P.atot()[gc * 32 + 16 + head];
    bf16x8 cfrag[4];
    {
      const bf16_t* cp = P.cfr() + ((((size_t)grp * (NTOK / 16) + gc * 8 + wv) * 4) * 16 + li) * 32 + 8 * g;
#pragma unroll
      for (int t = 0; t < 4; ++t) cfrag[t] = *(const bf16x8*)(cp + t * 512);
    }
    f32x4 accG[8];
#pragma unroll
    for (int sb = 0; sb < 8; ++sb) accG[sb] = (f32x4){0.f, 0.f, 0.f, 0.f};
#pragma unroll
    for (int sp = 0; sp < 4; ++sp) {
      bf16x8 bfv[8];
#pragma unroll
      for (int i = 0; i < 8; ++i) {
        const int sb = sp * 2 + (i >> 2), t = i & 3;
        bfv[i] = *(const bf16x8*)(bs + (((sb * 4 + t) * 16 + li) * 32 + 8 * g) * 2);
      }
#pragma unroll
      for (int i = 0; i < 8; ++i) {
        const int sb = sp * 2 + (i >> 2), t = i & 3;
        accG[sb] = __builtin_amdgcn_mfma_f32_16x16x32_bf16(bfv[i], cfrag[t], accG[sb], 0, 0, 0);
      }
    }
    f32x4 accY[4];
#pragma unroll
    for (int pb = 0; pb < 4; ++pb) accY[pb] = (f32x4){0.f, 0.f, 0.f, 0.f};
    const int jl = 16 * wv + li;
    const float csf_j = csf[jl], exb_j = exb[jl];
#pragma unroll
    for (int dir = 0; dir < 2; ++dir) {
      f32x4 accO[4];
#pragma unroll
      for (int pb = 0; pb < 4; ++pb) accO[pb] = (f32x4){0.f, 0.f, 0.f, 0.f};
      const char* st = sbufS + dir * 16384;
#pragma unroll
      for (int th = 0; th < 2; ++th) {
        bf16x8 sfr[8];
#pragma unroll
        for (int i = 0; i < 8; ++i) sfr[i] = *(const bf16x8*)(st + (((th * 2 + (i >> 2)) * 4 + (i & 3)) * 512 + li * 32 + 8 * g) * 2);
#pragma unroll
        for (int tt = 0; tt < 2; ++tt)
#pragma unroll
          for (int pb = 0; pb < 4; ++pb) accO[pb] = __builtin_amdgcn_mfma_f32_16x16x32_bf16(cfrag[th * 2 + tt], sfr[tt * 4 + pb], accO[pb], 0, 0, 0);
      }
#pragma unroll
      for (int e = 0; e < 4; ++e) {
        const int j = 16 * wv + 4 * g + e;
        const float sc = dir == 0 ? fexp(csf[j]) : fexp(atb - exb[j]);
#pragma unroll
        for (int pb = 0; pb < 4; ++pb) accY[pb][e] += accO[pb][e] * sc;
      }
    }
    __syncthreads();
    if (has_next) SSDY_PUT_S();
    const char* xq = xs_l + ((g * 64 + li) * 4) * 2;
#pragma unroll
    for (int t = 0; t < 4; ++t) {
      const bool need_f = !(32 * t > 16 * wv + 15), need_b = !(32 * t + 31 < 16 * wv);
      if (!need_f && !need_b) continue;
      s16x4 xlo[4], xhi[4];
#pragma unroll
      for (int pb = 0; pb < 4; ++pb) {
        xlo[pb] = *(const s16x4*)(xq + (((8 * t) * 64 + 16 * pb) * 4) * 2);
        xhi[pb] = *(const s16x4*)(xq + (((8 * t + 4) * 64 + 16 * pb) * 4) * 2);
      }
#pragma unroll
      for (int dir = 0; dir < 2; ++dir) {
        if (dir == 0 ? !need_f : !need_b) continue;
        bf16x8 afrag;
#pragma unroll
        for (int hh = 0; hh < 2; ++hh) {
          const int s0 = 32 * t + 16 * hh + 4 * g;
          const f32x4 gv = accG[2 * t + hh];
          const f32x4 cv = dir == 0 ? *(const f32x4*)(csf + s0) : *(const f32x4*)(exb + s0);
          const f32x4 dv = dir == 0 ? *(const f32x4*)(dtf + s0) : *(const f32x4*)(dtb + s0);
#pragma unroll
          for (int e = 0; e < 4; ++e) {
            const int s = s0 + e;
            float m;
            if (dir == 0) m = (s <= jl) ? gv[e] * dv[e] * fexp(csf_j - cv[e]) : 0.f;
            else m = (s >= jl) ? gv[e] * dv[e] * fexp(cv[e] - exb_j) : 0.f;
            afrag[hh * 4 + e] = (short)f2bf(m);
          }
        }
#pragma unroll
        for (int pb = 0; pb < 4; ++pb) {
          const bf16x8 bfr2 = (bf16x8){xlo[pb][0], xlo[pb][1], xlo[pb][2], xlo[pb][3], xhi[pb][0], xhi[pb][1], xhi[pb][2], xhi[pb][3]};
          accY[pb] = __builtin_amdgcn_mfma_f32_16x16x32_bf16(afrag, bfr2, accY[pb], 0, 0, 0);
        }
      }
    }
    const float dsk = P.d_skip[layer * 16 + head];
    s16x4 xs[4];
#pragma unroll
    for (int pb = 0; pb < 4; ++pb) xs[pb] = *(const s16x4*)(xs_l + ((((4 * wv + g) * 64 + 16 * pb + li) * 4) * 2));
    unsigned zv[16];
#pragma unroll
    for (int e = 0; e < 4; ++e)
#pragma unroll
      for (int pb = 0; pb < 4; ++pb)
        zv[e * 4 + pb] = P.p()[(size_t)(row0 + 16 * wv + 4 * g + e) * PW + OFF_Z + head * 64 + 16 * pb + li];
#pragma unroll
    for (int i = 0; i < 16; ++i) asm volatile("" : "+v"(zv[i]));
#pragma unroll
    for (int e = 0; e < 4; ++e) {
      const int row = row0 + 16 * wv + 4 * g + e;
      float sq = 0.f;
#pragma unroll
      for (int pb = 0; pb < 4; ++pb) {
        const float xv = bf2f((bf16_t)xs[pb][e]);
        const float z = bf2f((bf16_t)zv[e * 4 + pb]);
        const bf16_t yb = f2bf((accY[pb][e] + dsk * xv) * silu_f(z));
        P.concat()[(size_t)row * 2048 + head * 64 + 16 * pb + li] = yb;
        const float yf = bf2f(yb);
        sq += yf * yf;
      }
      sq += DPP_F(sq, 0xB1); sq += DPP_F(sq, 0x4E); sq += DPP_F(sq, 0x141); sq += DPP_F(sq, 0x140);
      if (li == 0) P.yss()[(size_t)row * 16 + head] = sq;
    }
    if (has_next) SSDY_PUT_BX((round + 1) & 1);
    __syncthreads();
  }
#undef SSDY_FETCH
#undef SSDY_PUT_S
#undef SSDY_PUT_BX
}

template <int W>
__device__ __forceinline__ void pool_frags(const bf16_t* pc, int l, int L, float rc, bf16x8 (&af)[4]) {
#pragma unroll
  for (int t = 0; t < 4; ++t) {
    constexpr int WB = W < 8 ? W : 8;
    float s[8], f[8];
#pragma unroll
    for (int e = 0; e < 8; ++e) s[e] = 0.f;
    const u32x4_t own = *(const u32x4_t*)(pc + 32 * t);
#pragma unroll
    for (int ob = 0; ob < W; ob += WB) {
      u32x4_t rows[WB];
#pragma unroll
      for (int o = 0; o < WB; ++o) {
        const int rr = l - W / 2 + ob + o;
        const int rcl = (rr >= 0 && rr < L) ? rr : l;
        rows[o] = *(const u32x4_t*)(pc + (ptrdiff_t)(rcl - l) * PW + 32 * t);
      }
#pragma unroll
      for (int o = 0; o < WB; ++o) asm volatile("" : "+v"(rows[o]));
#pragma unroll
      for (int o = 0; o < WB; ++o) {
        const int rr = l - W / 2 + ob + o;
        const float mk = (rr >= 0 && rr < L) ? 1.f : 0.f;
        unpack8(make_uint4(rows[o].x, rows[o].y, rows[o].z, rows[o].w), f);
#pragma unroll
        for (int e = 0; e < 8; ++e) s[e] += mk * f[e];
      }
    }
    unpack8(make_uint4(own.x, own.y, own.z, own.w), f);
#pragma unroll
    for (int e = 0; e < 8; ++e) af[t][e] = (short)f2bf(s[e] * rc - f[e]);
  }
}
__device__ void ph_pool_mfma(int wv, const Params& P, int layer, int nrows, char* smem, int bid, int nb) {
  const int lane = otid(wv) & 63, li = lane & 15, g = lane >> 4;
  bf16_t* stg = (bf16_t*)(smem + 65536) + wv * (16 * 136);
  const int nitems = (nrows / 16) * 4;
  for (int it = bid * NWAVE + wv; it < nitems; it += nb * NWAVE) {
    const int gi = it & 3, row0 = (it >> 2) * 16, w = 2 << gi;
    const int row = row0 + li;
    int l, L;
    if (row < NLAT) { l = row & 4095; L = 4096; } else { l = (row - NLAT) & 255; L = 256; }
    int lo = l - w / 2; lo = lo < 0 ? 0 : lo;
    int hi = l + w - w / 2 - 1; hi = hi > L - 1 ? L - 1 : hi;
    const float rc = 1.f / (float)(hi - lo + 1);
    const bf16_t* pc = P.p() + (size_t)row * PW + OFF_POOL + gi * 128 + 8 * g;
    bf16x8 af[4];
    if (gi == 0) pool_frags<2>(pc, l, L, rc, af);
    else if (gi == 1) pool_frags<4>(pc, l, L, rc, af);
    else if (gi == 2) pool_frags<8>(pc, l, L, rc, af);
    else pool_frags<16>(pc, l, L, rc, af);
    const bf16_t* wt = P.poolwT() + ((size_t)(layer * 4 + gi) * 128 + li) * 128 + 8 * g;
    const float* sc = P.pool_scale + layer * 512 + gi * 128;
#pragma unroll
    for (int nh = 0; nh < 4; ++nh) {
      bf16x8 wf[2][4];
#pragma unroll
      for (int n = 0; n < 2; ++n)
#pragma unroll
        for (int t = 0; t < 4; ++t) wf[n][t] = *(const bf16x8*)(wt + (size_t)(nh * 2 + n) * 16 * 128 + 32 * t);
#pragma unroll
      for (int n = 0; n < 2; ++n)
#pragma unroll
        for (int t = 0; t < 4; ++t) asm volatile("" : "+v"(wf[n][t]));
#pragma unroll
      for (int n = 0; n < 2; ++n) {
        const int nt = nh * 2 + n;
        f32x4 acc = (f32x4){0.f, 0.f, 0.f, 0.f};
#pragma unroll
        for (int t = 0; t < 4; ++t) acc = __builtin_amdgcn_mfma_f32_16x16x32_bf16(af[t], wf[n][t], acc, 0, 0, 0);
        const float scv = sc[nt * 16 + li];
#pragma unroll
        for (int e = 0; e < 4; ++e) stg[(4 * g + e) * 136 + nt * 16 + li] = f2bf(acc[e] * scv);
      }
    }
    __builtin_amdgcn_wave_barrier();
#pragma unroll
    for (int i = 0; i < 4; ++i) {
      const int c = i * 64 + lane, rr = c >> 4, c8 = (c & 15) * 8;
      *(uint4*)(P.concat() + (size_t)(row0 + rr) * 2048 + 1024 + gi * 128 + c8) = *(const uint4*)(stg + rr * 136 + c8);
    }
    __builtin_amdgcn_wave_barrier();
  }
}

__device__ void ph_vtranspose(int wv, const Params& P, char* smem, int bid, int nb) {
  const int lane = otid(wv) & 63;
  bf16_t* tile = (bf16_t*)smem + wv * 64 * 72;
  for (int it = bid * NWAVE + wv; it < 272 * 8; it += nb * NWAVE) {
    const int hd = it & 7, tt = it >> 3, row0 = tt * 64;
    const bf16_t* src = P.p() + (size_t)(row0 + lane) * PW + OFF_V + hd * 64;
#pragma unroll
    for (int i = 0; i < 8; ++i) *(uint4*)(tile + lane * 72 + i * 8) = *(const uint4*)(src + i * 8);
    __builtin_amdgcn_wave_barrier();
    bf16_t* dst;
    if (row0 < NLAT) dst = P.vtl() + (size_t)((row0 >> 12) * 8 + hd) * 64 * 4096 + ((size_t)((row0 & 4095) >> 2) * 64 + lane) * 4;
    else dst = P.vtc() + (size_t)(((row0 - NLAT) >> 8) * 8 + hd) * 64 * 256 + ((size_t)(((row0 - NLAT) & 255) >> 2) * 64 + lane) * 4;
#pragma unroll
    for (int i = 0; i < 16; ++i) {
      uint2 w;
      w.x = (uint32_t)tile[(i * 4 + 0) * 72 + lane] | ((uint32_t)tile[(i * 4 + 1) * 72 + lane] << 16);
      w.y = (uint32_t)tile[(i * 4 + 2) * 72 + lane] | ((uint32_t)tile[(i * 4 + 3) * 72 + lane] << 16);
      *(uint2*)(dst + (size_t)i * 64 * 4) = w;
    }
    __builtin_amdgcn_wave_barrier();
    {
      const bf16_t* ksrc = P.p() + (size_t)(row0 + lane) * PW + OFF_K + hd * 64;
      u32x4_t kv[8];
#pragma unroll
      for (int i = 0; i < 8; ++i) kv[i] = *(const u32x4_t*)(ksrc + i * 8);
      bf16_t* kd;
      int tk;
      if (row0 < NLAT) { tk = (row0 & 4095) + lane; kd = P.ktl() + (size_t)((row0 >> 12) * 8 + hd) * 4096 * 64; }
      else { tk = ((row0 - NLAT) & 255) + lane; kd = P.ktc() + (size_t)(((row0 - NLAT) >> 8) * 8 + hd) * 256 * 64; }
#pragma unroll
      for (int i = 0; i < 8; ++i)
        *(u32x4_t*)(kd + ((size_t)((tk >> 3) * 2 + (i >> 2)) * 8 + (tk & 7)) * 32 + (i & 3) * 8) = kv[i];
    }
  }
}

__device__ __forceinline__ float grp_max(float v) {
  auto a = __builtin_amdgcn_permlane16_swap(__float_as_uint(v), __float_as_uint(v), false, false);
  v = fmaxf(__uint_as_float(a[0]), __uint_as_float(a[1]));
  auto b = __builtin_amdgcn_permlane32_swap(__float_as_uint(v), __float_as_uint(v), false, false);
  return fmaxf(__uint_as_float(b[0]), __uint_as_float(b[1]));
}
__device__ __forceinline__ float grp_sum(float v) {
  auto a = __builtin_amdgcn_permlane16_swap(__float_as_uint(v), __float_as_uint(v), false, false);
  v = __uint_as_float(a[0]) + __uint_as_float(a[1]);
  auto b = __builtin_amdgcn_permlane32_swap(__float_as_uint(v), __float_as_uint(v), false, false);
  return __uint_as_float(b[0]) + __uint_as_float(b[1]);
}

__device__ void ph_na_mfma(int wv, const Params& P, int layer, int nrows, char* smem, int bid, int nb) {
  const int lane = otid(wv) & 63, li = lane & 15, g = lane >> 4;
  float* btab = (float*)smem + wv * 256;
  const float* rpb = P.na_rpb + (size_t)layer * 8 * 15 * 31;
  const int n_lat = 4 * 64 * 8 * 4;
  const int n_items = n_lat + (nrows > NLAT ? 4 * 16 * 8 : 0);
  const int nrank = nb >> 3;
  const bool xmap = ((nb & 7) == 0) && nrank > 0 && (1024 % nrank) == 0 && (64 % nrank) == 0;
  const int per_lat = xmap ? 1024 / nrank : 0, per_ctx = (xmap && nrows > NLAT) ? 64 / nrank : 0;
  const int q_begin = xmap ? wv : bid * NWAVE + wv, q_end = xmap ? per_lat + per_ctx : n_items, q_step = xmap ? NWAVE : nb * NWAVE;
  for (int q = q_begin; q < q_end; q += q_step) {
    bool lat;
    int b, hd, qrow0, r = 0, cq0 = 0, r0 = 0, cs = 0, qt;
    if (xmap) {
      hd = bid & 7;
      const int rank = bid >> 3;
      lat = q < per_lat;
      if (lat) { const int i = rank * per_lat + q; qt = i & 3; r = (i >> 2) & 63; b = i >> 8; }
      else { const int c = rank * per_ctx + (q - per_lat); qt = c & 15; b = c >> 4; }
    } else {
      lat = q < n_lat;
      if (lat) { qt = q & 3; hd = (q >> 2) & 7; r = (q >> 5) & 63; b = q >> 11; }
      else { const int t = q - n_lat; hd = t & 7; qt = (t >> 3) & 15; b = t >> 7; }
    }
    if (lat) {
      cq0 = qt * 16; qrow0 = b * 4096 + r * 64 + cq0;
      r0 = r - 4; r0 = r0 < 0 ? 0 : (r0 > 56 ? 56 : r0);
      int clo = cq0 - 8; clo = clo < 0 ? 0 : (clo > 48 ? 48 : clo);
      cs = clo < 32 ? clo : 32;
    } else {
      qrow0 = NLAT + b * 256 + qt * 16;
    }
    const bf16_t* qp = P.p() + (size_t)(qrow0 + li) * PW + OFF_Q + hd * 64 + 8 * g;
    const bf16x8 qf0 = *(const bf16x8*)qp, qf1 = *(const bf16x8*)(qp + 32);
    __builtin_amdgcn_wave_barrier();
#pragma unroll
    for (int i = 0; i < 4; ++i) {
      const int e_ = i * 64 + lane, kr_ = e_ >> 5, dc_ = e_ & 31;
      int dr_ = r0 + kr_ - r + 7; dr_ = dr_ < 0 ? 0 : (dr_ > 14 ? 14 : dr_);
      btab[e_] = rpb[(hd * 15 + dr_) * 31 + (dc_ < 31 ? dc_ : 30)];
    }
    __builtin_amdgcn_wave_barrier();
    f32x4 accS[16], accC[16];
    const int k_lane = ((li >> 3) * 16 + (li & 7)) * 32 + 8 * g;
    const bf16_t* klb = P.ktl() + (size_t)(b * 8 + hd) * 4096 * 64 + k_lane;
    const bf16_t* kcb = P.ktc() + (size_t)(b * 8 + hd) * 256 * 64 + k_lane;
#define NA_KPTR(tile) ((tile) < 16 ? klb + ((r0 + ((tile) >> 1)) * 64 + cs + 16 * ((tile) & 1)) * 64 : kcb + (16 * ((tile) - 16)) * 64)
    bf16x8 kA[2][2], kB[2][2];
#pragma unroll
    for (int i = 0; i < 2; ++i) { const bf16_t* kp = NA_KPTR(i); kA[i][0] = *(const bf16x8*)kp; kA[i][1] = *(const bf16x8*)(kp + 256); }
#pragma unroll
    for (int tb = 0; tb < 32; tb += 4) {
#pragma unroll
      for (int i = 0; i < 2; ++i) { const bf16_t* kp = NA_KPTR(tb + 2 + i); kB[i][0] = *(const bf16x8*)kp; kB[i][1] = *(const bf16x8*)(kp + 256); }
#pragma unroll
      for (int i = 0; i < 2; ++i) { asm volatile("" : "+v"(kA[i][0]), "+v"(kA[i][1])); }
#pragma unroll
      for (int i = 0; i < 2; ++i) {
        f32x4 z = (f32x4){0.f, 0.f, 0.f, 0.f};
        z = __builtin_amdgcn_mfma_f32_16x16x32_bf16(kA[i][0], qf0, z, 0, 0, 0);
        z = __builtin_amdgcn_mfma_f32_16x16x32_bf16(kA[i][1], qf1, z, 0, 0, 0);
        if (tb + i < 16) accS[(tb + i) & 15] = z; else accC[(tb + i) & 15] = z;
      }
      if (tb + 4 < 32) {
#pragma unroll
        for (int i = 0; i < 2; ++i) { const bf16_t* kp = NA_KPTR(tb + 4 + i); kA[i][0] = *(const bf16x8*)kp; kA[i][1] = *(const bf16x8*)(kp + 256); }
      }
#pragma unroll
      for (int i = 0; i < 2; ++i) { asm volatile("" : "+v"(kB[i][0]), "+v"(kB[i][1])); }
#pragma unroll
      for (int i = 0; i < 2; ++i) {
        f32x4 z = (f32x4){0.f, 0.f, 0.f, 0.f};
        z = __builtin_amdgcn_mfma_f32_16x16x32_bf16(kB[i][0], qf0, z, 0, 0, 0);
        z = __builtin_amdgcn_mfma_f32_16x16x32_bf16(kB[i][1], qf1, z, 0, 0, 0);
        if (tb + 2 + i < 16) accS[(tb + 2 + i) & 15] = z; else accC[(tb + 2 + i) & 15] = z;
      }
    }
#undef NA_KPTR
    const int cq = cq0 + li;
    int c0q = cq - 8; c0q = c0q < 0 ? 0 : (c0q > 48 ? 48 : c0q);
    float mx = -3.0e38f;
#pragma unroll
    for (int kt = 0; kt < 16; ++kt) {
      int bi[4]; bool okv[4]; float bv[4];
#pragma unroll
      for (int e = 0; e < 4; ++e) {
        const int ck = cs + 16 * (kt & 1) + 4 * g + e;
        okv[e] = lat && ck >= c0q && ck < c0q + 16;
        bi[e] = okv[e] ? (kt >> 1) * 32 + (ck - cq + 15) : 0;
      }
      asm volatile("" : "+v"(bi[0]), "+v"(bi[1]), "+v"(bi[2]), "+v"(bi[3]));
#pragma unroll
      for (int e = 0; e < 4; ++e) bv[e] = btab[bi[e]];
#pragma unroll
      for (int e = 0; e < 4; ++e) {
        const float s = okv[e] ? accS[kt][e] * 0.125f + bv[e] : -3.0e38f;
        accS[kt][e] = s;
        mx = fmaxf(mx, s);
      }
    }
#pragma unroll
    for (int ct = 0; ct < 16; ++ct)
#pragma unroll
      for (int e = 0; e < 4; ++e) { const float s = accC[ct][e] * 0.125f; accC[ct][e] = s; mx = fmaxf(mx, s); }
    mx = grp_max(mx);
    float sum = 0.f;
#pragma unroll
    for (int kt = 0; kt < 16; ++kt)
#pragma unroll
      for (int e = 0; e < 4; ++e) { const float p = __expf(accS[kt][e] - mx); accS[kt][e] = p; sum += p; }
#pragma unroll
    for (int ct = 0; ct < 16; ++ct)
#pragma unroll
      for (int e = 0; e < 4; ++e) { const float p = __expf(accC[ct][e] - mx); accC[ct][e] = p; sum += p; }
    sum = grp_sum(sum);
    const float inv = 1.f / sum;
    bf16x8 afL[8], afC[8];
#pragma unroll
    for (int kr = 0; kr < 8; ++kr) {
#pragma unroll
      for (int e = 0; e < 4; ++e) {
        afL[kr][e] = (short)f2bf(accS[2 * kr][e] * inv); afL[kr][4 + e] = (short)f2bf(accS[2 * kr + 1][e] * inv);
        afC[kr][e] = (short)f2bf(accC[2 * kr][e] * inv); afC[kr][4 + e] = (short)f2bf(accC[2 * kr + 1][e] * inv);
      }
    }
    f32x4 accO[4];
#pragma unroll
    for (int db = 0; db < 4; ++db) accO[db] = (f32x4){0.f, 0.f, 0.f, 0.f};
    const bf16_t* vl = P.vtl() + (size_t)(b * 8 + hd) * 64 * 4096 + li * 4;
    const bf16_t* vc = P.vtc() + (size_t)(b * 8 + hd) * 64 * 256 + li * 4;
#pragma unroll
    for (int kr = 0; kr < 8; ++kr) {
      const int tok = (r0 + kr) * 64 + cs + 4 * g;
      s16x4 lo[4], hi[4];
#pragma unroll
      for (int db = 0; db < 4; ++db) {
        const bf16_t* vp = vl + ((size_t)(tok >> 2) * 64 + db * 16) * 4;
        lo[db] = *(const s16x4*)vp; hi[db] = *(const s16x4*)(vp + 4 * 64 * 4);
      }
#pragma unroll
      for (int db = 0; db < 4; ++db) {
        const bf16x8 bfr = (bf16x8){lo[db][0], lo[db][1], lo[db][2], lo[db][3], hi[db][0], hi[db][1], hi[db][2], hi[db][3]};
        accO[db] = __builtin_amdgcn_mfma_f32_16x16x32_bf16(afL[kr], bfr, accO[db], 0, 0, 0);
      }
    }
#pragma unroll
    for (int t = 0; t < 8; ++t) {
      const int tok = 32 * t + 4 * g;
      s16x4 lo[4], hi[4];
#pragma unroll
      for (int db = 0; db < 4; ++db) {
        const bf16_t* vp = vc + ((size_t)(tok >> 2) * 64 + db * 16) * 4;
        lo[db] = *(const s16x4*)vp; hi[db] = *(const s16x4*)(vp + 4 * 64 * 4);
      }
#pragma unroll
      for (int db = 0; db < 4; ++db) {
        const bf16x8 bfr = (bf16x8){lo[db][0], lo[db][1], lo[db][2], lo[db][3], hi[db][0], hi[db][1], hi[db][2], hi[db][3]};
        accO[db] = __builtin_amdgcn_mfma_f32_16x16x32_bf16(afC[t], bfr, accO[db], 0, 0, 0);
      }
    }
    {
      bf16_t* stg = (bf16_t*)(smem + 32768) + wv * (16 * 72);
#pragma unroll
      for (int db = 0; db < 4; ++db)
#pragma unroll
        for (int e = 0; e < 4; ++e) stg[(4 * g + e) * 72 + 16 * db + li] = f2bf(accO[db][e]);
      __builtin_amdgcn_wave_barrier();
#pragma unroll
      for (int i = 0; i < 2; ++i) {
        const int c = i * 64 + lane, rr = c >> 3, c8 = (c & 7) * 8;
        *(uint4*)(P.concat() + (size_t)(qrow0 + rr) * 2048 + 1536 + hd * 64 + c8) = *(const uint4*)(stg + rr * 72 + c8);
      }
      __builtin_amdgcn_wave_barrier();
    }
  }
}

__device__ __forceinline__ uint32_t mono_u(float f) { const uint32_t u = __float_as_uint(f); return u ^ ((uint32_t)((int)u >> 31) | 0x80000000u); }
__device__ __forceinline__ float unmono_f(uint32_t m) { return __uint_as_float((m & 0x80000000u) ? (m ^ 0x80000000u) : ~m); }
__device__ __forceinline__ uint32_t grp_max_u(uint32_t v) {
  auto a = __builtin_amdgcn_permlane16_swap(v, v, false, false);
  v = a[0] > a[1] ? a[0] : a[1];
  auto b = __builtin_amdgcn_permlane32_swap(v, v, false, false);
  return b[0] > b[1] ? b[0] : b[1];
}

template <int N>
__device__ __forceinline__ void bitonic_sort_desc(uint32_t (&a)[N], int base = 0) { (void)base;
#pragma unroll
  for (int k = 2; k <= N; k <<= 1)
#pragma unroll
    for (int j = k >> 1; j > 0; j >>= 1)
#pragma unroll
      for (int i = 0; i < N; ++i) {
        const int l = i ^ j;
        if (l > i) {
          const bool desc = (i & k) == 0;
          const uint32_t hi = a[i] > a[l] ? a[i] : a[l], lo = a[i] > a[l] ? a[l] : a[i];
          a[i] = desc ? hi : lo; a[l] = desc ? lo : hi;
        }
      }
}
template <int N>
__device__ __forceinline__ void bitonic_merge_desc(uint32_t (&a)[N]) {
#pragma unroll
  for (int j = N >> 1; j > 0; j >>= 1)
#pragma unroll
    for (int i = 0; i < N; ++i) {
      const int l = i ^ j;
      if (l > i) {
        const uint32_t hi = a[i] > a[l] ? a[i] : a[l], lo = a[i] > a[l] ? a[l] : a[i];
        a[i] = hi; a[l] = lo;
      }
    }
}
__device__ __forceinline__ void merge4_top16(uint32_t (&a)[16]) {
  uint32_t e[16], o[16];
#pragma unroll
  for (int i = 0; i < 16; ++i) { auto r = __builtin_amdgcn_permlane16_swap(a[i], a[i], false, false); e[i] = r[0]; o[i] = r[1]; }
#pragma unroll
  for (int i = 0; i < 16; ++i) a[i] = e[i] > o[15 - i] ? e[i] : o[15 - i];
  bitonic_merge_desc<16>(a);
#pragma unroll
  for (int i = 0; i < 16; ++i) { auto r = __builtin_amdgcn_permlane32_swap(a[i], a[i], false, false); e[i] = r[0]; o[i] = r[1]; }
#pragma unroll
  for (int i = 0; i < 16; ++i) a[i] = e[i] > o[15 - i] ? e[i] : o[15 - i];
  bitonic_merge_desc<16>(a);
}
__device__ void ph_peer_topk_mfma(int wv, const Params& P, int layer, int nrows, char* smem, int bid, int nb) {
  const int tid = otid(wv), lane = tid & 63, li = lane & 15, g = lane >> 4;
  unsigned char* ctab = (unsigned char*)smem;
  float* vals = (float*)(smem + 256) + wv * 512;
  int* idxs = (int*)(smem + 256 + 8 * 2048) + wv * 512;
  __syncthreads();
  if (tid < 64) ctab[tid] = 0xFF;
  __syncthreads();
  if (tid == 0) {
    int n = 0, one = 1;
    asm volatile("" : "+s"(one));
#pragma unroll 1
    for (int a = 0; a < 16; ++a)
#pragma unroll 1
      for (int b = 0; b < 16; ++b)
        if ((a + one) * (b + 1) <= 16) { ctab[(n & 3) * 16 + (n >> 2)] = (unsigned char)(a * 16 + b); ++n; }
  }
  const int hd = bid & 7, tg = bid >> 3, ngroups = nb >> 3;
  char* ksm = smem + 33280;
  {
    const bf16_t* ksrc = P.keysb() + (size_t)(layer * 8 + hd) * 2 * 128 * 128;
#pragma unroll
    for (int i = 0; i < 8; ++i) {
      const int idx = tid + i * 512, r = idx >> 4, sg = idx & 15;
      *(uint4*)(ksm + (r * 136 + sg * 8) * 2) = *(const uint4*)(ksrc + (size_t)r * 128 + sg * 8);
    }
  }
  __syncthreads();
  uint32_t cab[16];
#pragma unroll
  for (int s = 0; s < 16; ++s) cab[s] = ctab[g * 16 + s];
  const int ntile = nrows / 16;
  for (int tile = tg + ngroups * wv; tile < ntile && tg < ngroups; tile += ngroups * NWAVE) {
    const int row0 = tile * 16;
    const bf16_t* qp = P.q() + (size_t)(row0 + li) * 2048 + hd * 256 + 8 * g;
    uint32_t win[2][16];
#pragma unroll
    for (int half = 0; half < 2; ++half) {
      bf16x8 qf[4];
#pragma unroll
      for (int t = 0; t < 4; ++t) qf[t] = *(const bf16x8*)(qp + half * 128 + 32 * t);
      const char* kb = ksm + ((half * 128 + li) * 136 + 8 * g) * 2;
      uint32_t pk[32];
#pragma unroll
      for (int kt = 0; kt < 8; ++kt) {
        f32x4 acc = (f32x4){0.f, 0.f, 0.f, 0.f};
#pragma unroll
        for (int t = 0; t < 4; ++t) {
          const bf16x8 a = *(const bf16x8*)(kb + (kt * 16 * 136 + 32 * t) * 2);
          acc = __builtin_amdgcn_mfma_f32_16x16x32_bf16(a, qf[t], acc, 0, 0, 0);
        }
#pragma unroll
        for (int e = 0; e < 4; ++e) pk[kt * 4 + e] = (mono_u(acc[e]) & ~127u) | (uint32_t)(16 * kt + 4 * g + e);
      }
      {
        uint32_t lo16[16], hi16[16];
#pragma unroll
        for (int i = 0; i < 16; ++i) { lo16[i] = pk[i]; hi16[i] = pk[16 + i]; }
        bitonic_sort_desc<16>(lo16);
        bitonic_sort_desc<16>(hi16);
#pragma unroll
        for (int i = 0; i < 16; ++i) lo16[i] = lo16[i] > hi16[15 - i] ? lo16[i] : hi16[15 - i];
        bitonic_merge_desc<16>(lo16);
        merge4_top16(lo16);
#pragma unroll
        for (int r = 0; r < 16; ++r) win[half][r] = lo16[r];
      }
    }
    if (g == 0) {
#pragma unroll
      for (int half = 0; half < 2; ++half)
#pragma unroll
        for (int r = 0; r < 16; ++r) {
          vals[li * 32 + half * 16 + r] = unmono_f(win[half][r] & ~127u);
          idxs[li * 32 + half * 16 + r] = (int)(win[half][r] & 127u);
        }
    }
    __builtin_amdgcn_wave_barrier();
    uint32_t cp[16];
    {
      float va[16], vb[16];
#pragma unroll
      for (int s = 0; s < 16; ++s) {
        const uint32_t ab = cab[s] == 0xFFu ? 0u : cab[s];
        va[s] = vals[li * 32 + (ab >> 4)]; vb[s] = vals[li * 32 + 16 + (ab & 15u)];
      }
#pragma unroll
      for (int s = 0; s < 16; ++s) cp[s] = cab[s] == 0xFFu ? 0u : ((mono_u(va[s] + vb[s]) & ~255u) | cab[s]);
    }
    bitonic_sort_desc<16>(cp);
    merge4_top16(cp);
    uint32_t cw[16];
#pragma unroll
    for (int r = 0; r < 16; ++r) cw[r] = cp[r];
    const float mx = unmono_f(cw[0] & ~255u);
    float ex[16];
    float sum = 0.f;
#pragma unroll
    for (int r = 0; r < 16; ++r) { ex[r] = __expf(unmono_f(cw[r] & ~255u) - mx); sum += ex[r]; }
    const float inv = 1.f / sum;
    const size_t ob = (size_t)(row0 + li) * 128 + hd * 16;
#pragma unroll
    for (int r = 0; r < 16; ++r) {
      if ((r >> 2) == g) {
        const uint32_t ab = cw[r] & 255u;
        P.sel_idx()[ob + r] = idxs[li * 32 + (ab >> 4)] * 128 + idxs[li * 32 + 16 + (ab & 15u)];
        P.sel_g()[ob + r] = ex[r] * inv;
      }
    }
    __builtin_amdgcn_wave_barrier();
  }
}

__device__ __forceinline__ void cvt8(const uint32_t w, float* f) {
  const f32x2_t a = __builtin_amdgcn_cvt_scalef32_pk_f32_fp4(w, 1.0f, 0), b = __builtin_amdgcn_cvt_scalef32_pk_f32_fp4(w, 1.0f, 1);
  const f32x2_t c = __builtin_amdgcn_cvt_scalef32_pk_f32_fp4(w, 1.0f, 2), e = __builtin_amdgcn_cvt_scalef32_pk_f32_fp4(w, 1.0f, 3);
  f[0] = a.x; f[1] = a.y; f[2] = b.x; f[3] = b.y; f[4] = c.x; f[5] = c.y; f[6] = e.x; f[7] = e.y;
}
__device__ __forceinline__ float swap16_add(float a, float b) {
  auto r = __builtin_amdgcn_permlane16_swap(__float_as_uint(a), __float_as_uint(b), false, false);
  return __uint_as_float(r[0]) + __uint_as_float(r[1]);
}
typedef int i32x8_t __attribute__((ext_vector_type(8)));
__device__ void ph_peer_dots(int wv, const Params& P, int layer, int nrows, int bid, int nb) {
  for (int row = bid * NWAVE + wv; row < nrows; row += nb * NWAVE) {
    const int lane = otid(wv) & 63, n = lane & 15, g = lane >> 4;
    const bool hsel = (lane & 8) != 0;
    const unsigned char* TU = P.tabU() + (8 * g + (lane & 7)) * 16;
    i32x8_t xa;
    {
      const bf16_t* xp = P.u() + (size_t)row * DM + 32 * (8 * g + (lane & 7));
      float xv[32];
      unpack8(*(const uint4*)xp, xv); unpack8(*(const uint4*)(xp + 8), xv + 8);
      unpack8(*(const uint4*)(xp + 16), xv + 16); unpack8(*(const uint4*)(xp + 24), xv + 24);
#pragma unroll
      for (int r = 0; r < 4; ++r) {
        uint32_t hw = 0u, lw = 0u;
        float fh[8];
#pragma unroll
        for (int bsel = 0; bsel < 4; ++bsel) {
          if (bsel == 0) hw = __builtin_amdgcn_cvt_scalef32_pk_fp4_f32(hw, xv[8 * r + 0], xv[8 * r + 1], 1.0f, 0);
          if (bsel == 1) hw = __builtin_amdgcn_cvt_scalef32_pk_fp4_f32(hw, xv[8 * r + 2], xv[8 * r + 3], 1.0f, 1);
          if (bsel == 2) hw = __builtin_amdgcn_cvt_scalef32_pk_fp4_f32(hw, xv[8 * r + 4], xv[8 * r + 5], 1.0f, 2);
          if (bsel == 3) hw = __builtin_amdgcn_cvt_scalef32_pk_fp4_f32(hw, xv[8 * r + 6], xv[8 * r + 7], 1.0f, 3);
        }
        cvt8(hw, fh);
        lw = __builtin_amdgcn_cvt_scalef32_pk_fp4_f32(lw, (xv[8 * r + 0] - fh[0]) * 8.f, (xv[8 * r + 1] - fh[1]) * 8.f, 1.0f, 0);
        lw = __builtin_amdgcn_cvt_scalef32_pk_fp4_f32(lw, (xv[8 * r + 2] - fh[2]) * 8.f, (xv[8 * r + 3] - fh[3]) * 8.f, 1.0f, 1);
        lw = __builtin_amdgcn_cvt_scalef32_pk_fp4_f32(lw, (xv[8 * r + 4] - fh[4]) * 8.f, (xv[8 * r + 5] - fh[5]) * 8.f, 1.0f, 2);
        lw = __builtin_amdgcn_cvt_scalef32_pk_fp4_f32(lw, (xv[8 * r + 6] - fh[6]) * 8.f, (xv[8 * r + 7] - fh[7]) * 8.f, 1.0f, 3);
        xa[r] = (int)((n & 8) ? lw : hw);
        xa[4 + r] = 0;
      }
    }
    const int idx0 = P.sel_idx()[(size_t)row * 128 + lane], idx1 = P.sel_idx()[(size_t)row * 128 + 64 + lane];
    const float gt0 = P.sel_g()[(size_t)row * 128 + lane] * P.invV()[idx0], gt1 = P.sel_g()[(size_t)row * 128 + 64 + lane] * P.invV()[idx1];
    const float iu0 = P.invU()[idx0], iu1 = P.invU()[idx1];
    const float cs = ((g & 1) == ((n >> 2) & 1)) ? (g >= 2 ? (1.f / 8.f) : 1.f) : 0.f;
    const int lkey = lane & 0x37;
    float d0 = 0.f, d1 = 0.f;
    u32x4_t bufA[8], bufB[8], bufC[8], bufD[8];
#define PG_LOAD(buf, T, m0) do { _Pragma("unroll") for (int j = 0; j < 8; ++j) { \
      const int m_ = (m0) + j; const int src_ = m_ < 32 ? idx0 : idx1; const int kA_ = (m_ & 7) + 16 * ((m_ >> 3) & 3); \
      const int elo_ = __builtin_amdgcn_readlane(src_, kA_), ehi_ = __builtin_amdgcn_readlane(src_, kA_ + 8); \
      buf[j] = *(const u32x4_t*)(T + (size_t)(hsel ? ehi_ : elo_) * 512); } } while (0)
#define PG_DOT(buf, m0) do { _Pragma("unroll") for (int j = 0; j < 8; ++j) { \
      const int m_ = (m0) + j; const int kA_ = (m_ & 7) + 16 * ((m_ >> 3) & 3); \
      const i32x8_t b_ = {(int)buf[j].x, (int)buf[j].y, (int)buf[j].z, (int)buf[j].w, 0, 0, 0, 0}; \
      const f32x4 acc_ = __builtin_amdgcn_mfma_scale_f32_16x16x128_f8f6f4(xa, b_, (f32x4){0.f, 0.f, 0.f, 0.f}, 4, 4, 0, 0x7F7F7F7F, 0, 0x7F7F7F7F); \
      float w_ = (n & 2) ? ((n & 1) ? acc_[3] : acc_[2]) : ((n & 1) ? acc_[1] : acc_[0]); \
      w_ *= cs; \
      w_ += DPP_F(w_, 0xB1); w_ += DPP_F(w_, 0x4E); w_ += DPP_F(w_, 0x141); \
      { auto r_ = __builtin_amdgcn_permlane32_swap(__float_as_uint(w_), __float_as_uint(w_), false, false); w_ = __uint_as_float(r_[0]) + __uint_as_float(r_[1]); } \
      { auto r_ = __builtin_amdgcn_permlane16_swap(__float_as_uint(w_), __float_as_uint(w_), false, false); w_ = __uint_as_float(r_[0]) + __uint_as_float(r_[1]); } \
      if (m_ < 32) d0 = (lkey == kA_) ? w_ : d0; else d1 = (lkey == kA_) ? w_ : d1; } } while (0)
    PG_LOAD(bufA, TU, 0); PG_LOAD(bufB, TU, 8); PG_LOAD(bufC, TU, 16);
    PG_LOAD(bufD, TU, 24); PG_DOT(bufA, 0);
    PG_LOAD(bufA, TU, 32); PG_DOT(bufB, 8);
    PG_LOAD(bufB, TU, 40); PG_DOT(bufC, 16);
    PG_LOAD(bufC, TU, 48); PG_DOT(bufD, 24);
    PG_LOAD(bufD, TU, 56); PG_DOT(bufA, 32);
    PG_DOT(bufB, 40); PG_DOT(bufC, 48); PG_DOT(bufD, 56);
    P.sel_g()[(size_t)row * 128 + lane] = gelu_f(d0 * iu0) * gt0;
    P.sel_g()[(size_t)row * 128 + 64 + lane] = gelu_f(d1 * iu1) * gt1;
#undef PG_LOAD
#undef PG_DOT
  }
}
__device__ void ph_peer_acc(int wv, const Params& P, int layer, int nrows, int bid, int nb) {
  for (int row = bid * NWAVE + wv; row < nrows; row += nb * NWAVE) {
    const int lane = otid(wv) & 63, l5 = lane & 31;
    const bool up = lane >= 32;
    const unsigned char* TV = P.tabV() + l5 * 16;
    float o[32];
    const int idx0 = P.sel_idx()[(size_t)row * 128 + lane], idx1 = P.sel_idx()[(size_t)row * 128 + 64 + lane];
    const float act0 = P.sel_g()[(size_t)row * 128 + lane], act1 = P.sel_g()[(size_t)row * 128 + 64 + lane];
    uint4 bufA[8], bufB[8];
#define PG_LOAD(buf, T, kk) do { _Pragma("unroll") for (int j = 0; j < 8; ++j) { \
      const int k_ = (kk) + 2 * j; const int src_ = k_ < 64 ? idx0 : idx1; \
      const int elo_ = __builtin_amdgcn_readlane(src_, k_ & 63), ehi_ = __builtin_amdgcn_readlane(src_, (k_ & 63) + 1); \
      buf[j] = *(const uint4*)(T + (size_t)(up ? ehi_ : elo_) * 512); } } while (0)
    PG_LOAD(bufA, TV, 0);
#pragma unroll
    for (int i = 0; i < 32; ++i) o[i] = 0.f;
#define PG_ACC(buf, kk) do { _Pragma("unroll") for (int j = 0; j < 8; ++j) { const int k_ = (kk) + 2 * j; \
      const int asrc_ = __float_as_int(k_ < 64 ? act0 : act1); \
      const float alo_ = __int_as_float(__builtin_amdgcn_readlane(asrc_, k_ & 63)), ahi_ = __int_as_float(__builtin_amdgcn_readlane(asrc_, (k_ & 63) + 1)); \
      const float a_ = up ? ahi_ : alo_; \
      const uint32_t w_[4] = {buf[j].x, buf[j].y, buf[j].z, buf[j].w}; \
      _Pragma("unroll") for (int d = 0; d < 4; ++d) { float f[8]; uint32_t wd_ = w_[d]; asm volatile("" : "+v"(wd_) : "v"(o[(d * 8 + 31) & 31])); cvt8(wd_, f); \
        _Pragma("unroll") for (int i = 0; i < 8; ++i) o[d * 8 + i] += a_ * f[i]; } } } while (0)
#pragma unroll 1
    for (int kk = 0; kk < 128; kk += 32) {
      PG_LOAD(bufB, TV, kk + 16);
      PG_ACC(bufA, kk);
      if (kk + 32 < 128) PG_LOAD(bufA, TV, kk + 32);
      PG_ACC(bufB, kk + 16);
    }
#undef PG_LOAD
#undef PG_ACC
#pragma unroll
    for (int i = 0; i < 32; ++i) {
      auto r = __builtin_amdgcn_permlane32_swap(__float_as_uint(o[i]), __float_as_uint(o[i]), false, false);
      o[i] = __uint_as_float(r[0]) + __uint_as_float(r[1]);
    }
    const int lane_e = otid(wv) & 63, l5e = lane_e & 31;
    const bool upe = lane_e >= 32;
    const float* gate = P.mod() + (size_t)(layer * 5 + modrow(row)) * MODW + 5120 + l5e * 32;
    float* hr = P.h() + (size_t)row * DM + l5e * 32;
    float ss = 0.f;
    f32x4 hvv[8], ggv[8];
#pragma unroll
    for (int q = 0; q < 8; ++q) { hvv[q] = *(const f32x4*)(hr + q * 4); ggv[q] = *(const f32x4*)(gate + q * 4); }
#pragma unroll
    for (int q = 0; q < 8; ++q) asm volatile("" : "+v"(hvv[q]), "+v"(ggv[q]));
#pragma unroll
    for (int q = 0; q < 8; ++q) {
      float4 hv = make_float4(hvv[q][0], hvv[q][1], hvv[q][2], hvv[q][3]);
      const float4 gg = make_float4(ggv[q][0], ggv[q][1], ggv[q][2], ggv[q][3]);
      hv.x += gg.x * o[q * 4 + 0]; hv.y += gg.y * o[q * 4 + 1]; hv.z += gg.z * o[q * 4 + 2]; hv.w += gg.w * o[q * 4 + 3];
      if (layer == 0 && !upe) *(float4*)(hr + q * 4) = hv;
      o[q * 4 + 0] = hv.x; o[q * 4 + 1] = hv.y; o[q * 4 + 2] = hv.z; o[q * 4 + 3] = hv.w;
      if (!upe) ss += hv.x * hv.x + hv.y * hv.y + hv.z * hv.z + hv.w * hv.w;
    }
    ss = wave_sum(ss);
    const float rstd = rsqrtf(ss * (1.f / 1024.f) + 1e-6f);
    if (layer == 0) {
      const float* g1 = P.norm1_g + 1024 + l5e * 32;
      const float* mr = P.mod() + (size_t)(5 + modrow(row)) * MODW + l5e * 32;
      if (!upe) {
#pragma unroll
        for (int q = 0; q < 4; ++q) {
          float ov[8];
#pragma unroll
          for (int e = 0; e < 8; ++e) ov[e] = o[q * 8 + e] * rstd * g1[q * 8 + e] * (1.f + mr[1024 + q * 8 + e]) + mr[q * 8 + e];
          *(uint4*)(P.u() + (size_t)row * DM + l5e * 32 + q * 8) = make_uint4(pack2(ov[0], ov[1]), pack2(ov[2], ov[3]), pack2(ov[4], ov[5]), pack2(ov[6], ov[7]));
        }
      }
    } else {
      const float* gf = P.final_g + l5e * 32;
      if (!upe) {
#pragma unroll
        for (int q = 0; q < 8; ++q) {
          const float4 gg = *(const float4*)(gf + q * 4);
          *(float4*)(P.out + (size_t)row * DM + l5e * 32 + q * 4) =
              make_float4(o[q * 4] * rstd * gg.x, o[q * 4 + 1] * rstd * gg.y, o[q * 4 + 2] * rstd * gg.z, o[q * 4 + 3] * rstd * gg.w);
        }
      }
    }
  }
}

struct EpiOutproj {
  static constexpr bool PERM = false, AFTER_DRAIN = false;
  static constexpr int MIDK_T = 16;
  float* H; const float* hl; const float* hc; const float* modl;
  const float* yss;
  __device__ __forceinline__ void midk(pg8::f32x4 (&acc)[2][2][4][2], const pg8::Unit& u, int wr, int wc, int fr, int fq) const {
    const int row0 = u.pm * 256 + wr * 64 + fr;
#pragma unroll
    for (int ai = 0; ai < 2; ++ai)
#pragma unroll
      for (int m = 0; m < 4; ++m) {
        const pg8::f32x4* yp = (const pg8::f32x4*)(yss + (size_t)(row0 + ai * 128 + m * 16) * 16);
        const pg8::f32x4 y4 = (yp[0] + yp[1]) + (yp[2] + yp[3]);
        const float rstd = rsqrtf(((y4[0] + y4[1]) + (y4[2] + y4[3])) * (1.f / 1024.f) + 1e-6f);
#pragma unroll
        for (int bj = 0; bj < 2; ++bj)
#pragma unroll
          for (int n = 0; n < 2; ++n) acc[ai][bj][m][n] *= rstd;
      }
  }
  __device__ __forceinline__ void operator()(const pg8::f32x4 (&acc)[2][2][4][2], const pg8::Unit& u, int wr, int wc, int fr, int fq) const {
    const int row0 = u.pm * 256 + wr * 64 + fr, col0 = u.pn * 256 + wc * 32 + 4 * fq;
    const float* gate = modl + (size_t)modrow(row0) * MODW + 2048 + col0;
    pg8::f32x4 gv[2][2];
#pragma unroll
    for (int bj = 0; bj < 2; ++bj)
#pragma unroll
      for (int n = 0; n < 2; ++n) gv[bj][n] = *(const pg8::f32x4*)(gate + bj * 128 + n * 16);
    pg8::f32x4 sA[4], sB[4];
#define EO_LOAD(dstv, ai_, m_) do { const float* s_ = hrow(hl, hc, row0 + (ai_) * 128 + (m_) * 16) + col0; \
      dstv[0] = *(const pg8::f32x4*)(s_); dstv[1] = *(const pg8::f32x4*)(s_ + 16); dstv[2] = *(const pg8::f32x4*)(s_ + 128); dstv[3] = *(const pg8::f32x4*)(s_ + 144); } while (0)
#define EO_STORE(srcv, ai_, m_) do { asm volatile("" : "+v"(srcv[0]), "+v"(srcv[1]), "+v"(srcv[2]), "+v"(srcv[3])); \
      float* d_ = H + (size_t)(row0 + (ai_) * 128 + (m_) * 16) * DM + col0; \
      *(pg8::f32x4*)(d_) = srcv[0] + gv[0][0] * acc[ai_][0][m_][0]; *(pg8::f32x4*)(d_ + 16) = srcv[1] + gv[0][1] * acc[ai_][0][m_][1]; \
      *(pg8::f32x4*)(d_ + 128) = srcv[2] + gv[1][0] * acc[ai_][1][m_][0]; *(pg8::f32x4*)(d_ + 144) = srcv[3] + gv[1][1] * acc[ai_][1][m_][1]; } while (0)
    EO_LOAD(sA, 0, 0);
#pragma unroll
    for (int i = 0; i < 8; i += 2) {
      EO_LOAD(sB, (i + 1) >> 2, (i + 1) & 3);
      EO_STORE(sA, i >> 2, i & 3);
      if (i + 2 < 8) EO_LOAD(sA, (i + 2) >> 2, (i + 2) & 3);
      EO_STORE(sB, (i + 1) >> 2, (i + 1) & 3);
    }
#undef EO_LOAD
#undef EO_STORE
  }
};

__device__ __forceinline__ uint32_t fp4_code(float x, float sc) {
  const float a = fabsf(x) * sc;
  const uint32_t c = (uint32_t)(a > 0.25f) + (uint32_t)(a > 0.75f) + (uint32_t)(a > 1.25f) + (uint32_t)(a > 1.75f) +
                     (uint32_t)(a > 2.5f) + (uint32_t)(a > 3.5f) + (uint32_t)(a > 5.0f);
  return c | (x < 0.f ? 8u : 0u);
}
__device__ void ph_convert_tables(int wv, const Params& P, int layer, int bid, int nb) {
  const int lane = otid(wv) & 63;
  for (int it0 = (bid * NWAVE + wv) * 2; it0 < 2 * 16384; it0 += nb * NWAVE * 2) {
    f32x4 v[2][4];
#pragma unroll
    for (int rr = 0; rr < 2; ++rr) {
      const int it = it0 + rr, t = it >> 14, e = it & 16383;
      const float* src = (t == 0 ? P.peer_u : P.peer_v) + ((size_t)layer * 16384 + e) * 1024 + lane * 16;
#pragma unroll
      for (int i = 0; i < 4; ++i) v[rr][i] = ((const f32x4*)src)[i];
    }
#pragma unroll
    for (int rr = 0; rr < 2; ++rr)
#pragma unroll
      for (int i = 0; i < 4; ++i) asm volatile("" : "+v"(v[rr][i]));
#pragma unroll
    for (int rr = 0; rr < 2; ++rr) {
      const int it = it0 + rr, t = it >> 14, e = it & 16383;
      float m = 0.f;
#pragma unroll
      for (int i = 0; i < 4; ++i)
        m = fmaxf(m, fmaxf(fmaxf(fabsf(v[rr][i][0]), fabsf(v[rr][i][1])), fmaxf(fabsf(v[rr][i][2]), fabsf(v[rr][i][3]))));
      m = wave_max(m);
      m = fmaxf(m, 1e-30f);
      const float sc = 6.0f / m, inv = m * (1.0f / 6.0f);
      uint2 o;
      {
        uint32_t p0 = 0u, p1 = 0u;
        p0 = __builtin_amdgcn_cvt_scalef32_pk_fp4_f32(p0, v[rr][0][0] * sc, v[rr][0][1] * sc, 1.0f, 0);
        p0 = __builtin_amdgcn_cvt_scalef32_pk_fp4_f32(p0, v[rr][0][2] * sc, v[rr][0][3] * sc, 1.0f, 1);
        p0 = __builtin_amdgcn_cvt_scalef32_pk_fp4_f32(p0, v[rr][1][0] * sc, v[rr][1][1] * sc, 1.0f, 2);
        p0 = __builtin_amdgcn_cvt_scalef32_pk_fp4_f32(p0, v[rr][1][2] * sc, v[rr][1][3] * sc, 1.0f, 3);
        p1 = __builtin_amdgcn_cvt_scalef32_pk_fp4_f32(p1, v[rr][2][0] * sc, v[rr][2][1] * sc, 1.0f, 0);
        p1 = __builtin_amdgcn_cvt_scalef32_pk_fp4_f32(p1, v[rr][2][2] * sc, v[rr][2][3] * sc, 1.0f, 1);
        p1 = __builtin_amdgcn_cvt_scalef32_pk_fp4_f32(p1, v[rr][3][0] * sc, v[rr][3][1] * sc, 1.0f, 2);
        p1 = __builtin_amdgcn_cvt_scalef32_pk_fp4_f32(p1, v[rr][3][2] * sc, v[rr][3][3] * sc, 1.0f, 3);
        o.x = p0; o.y = p1;
      }
      *(uint2*)((t == 0 ? P.tabU() : P.tabV()) + (size_t)e * 512 + lane * 8) = o;
      if (lane == 0) (t == 0 ? P.invU() : P.invV())[e] = inv;
    }
  }
}

enum {
  PH_PREP = 0, PH_NORM1, PH_INPROJ, PH_CONV, PH_SSDPREP, PH_STATES, PH_SCAN, PH_SSDY, PH_SSDNORM, PH_POOL, PH_NA,
  PH_OUTPROJ, PH_NORM2, PH_QGEMM, PH_TOPK, PH_GATHER, PH_FINAL
};

#define SMEM_BYTES 135168

__device__ __forceinline__ void run_phase(int wv, const Params& P, int ph, int layer, char* smem, int bid, int nb) {
  const float* hl = layer == 0 ? P.x : P.h();
  const float* hc = layer == 0 ? P.ctx : P.h() + (size_t)NLAT * DM;
  const int nrows = layer == 0 ? NTOK : NLAT;
  switch (ph) {
    case PH_PREP:
      for (int i = bid * NTHR + otid(wv); i < 2 * 8 * 2 * 128 * 128; i += nb * NTHR) P.keysb()[i] = f2bf(P.peer_keys[i]);
      for (int i = bid * NTHR + otid(wv); i < 2 * 4 * 128 * 128; i += nb * NTHR) {
        const int k = i & 127, n = (i >> 7) & 127, lg = i >> 14;
        P.poolwT()[i] = f2bf(P.pool_w[((size_t)lg * 128 + k) * 128 + n]);
      }
      ph_mod(wv, P, (float*)smem, bid, nb);
      for (int l = 0; l < 2; ++l) {
        ph_transpose(wv, P.w_in + (size_t)l * 1024 * INW, P.w_inT() + (size_t)l * PW * 1024, 1024, INW, PW, 0, 2560, 32, PW, (float*)smem, bid, nb);
        ph_transpose(wv, P.w_in + (size_t)l * 1024 * INW, P.w_dtT() + (size_t)l * 128 * 1024, 1024, INW, 128, 2560, 1 << 30, 0, 32, (float*)smem, bid, nb);
        ph_transpose(wv, P.w_out + (size_t)l * 2048 * 1024, P.w_outT() + (size_t)l * 1024 * 2048, 2048, 1024, 1024, 0, 1 << 30, 0, 1024, (float*)smem, bid, nb,
                     P.ssd_norm_g + l * 1024, 1024);
        ph_transpose(wv, P.peer_wq + (size_t)l * 1024 * 2048, P.w_qT() + (size_t)l * 2048 * 1024, 1024, 2048, 2048, 0, 1 << 30, 0, 2048, (float*)smem, bid, nb);
      }
      break;
    case PH_NORM1:
      ph_norm(wv, hl, hc, P.norm1_g + layer * 1024, P.mod() + (size_t)layer * 5 * MODW, 0, 1024, NTOK, P.u(), bid, nb);
      break;
    case PH_INPROJ:
    {
      pg8::Gemm g{P.u(), P.w_inT() + (size_t)layer * PW * 1024, NTOK, PW, 1024};
      pg8::StaticOrder S; S.init(g.M, g.N, nb, bid);
      pg8::EpiBf16<0> E{P.p(), PW, nullptr, 0, 0};
      pg8::gemm_phase<pg8::EpiBf16<0>, pg8::StaticOrder, false>(wv, (PG8_LAS unsigned char*)smem, g, S, E, nullptr);
      {
        const int units = (NTOK / 256) * (PW / 256), rem = units % nb;
        const int nidle = rem == 0 ? nb : nb - rem, first_idle = rem == 0 ? 0 : rem;
        if (bid >= first_idle) ph_dtprep(wv, P, layer, smem, bid - first_idle, nidle);
      }
      break;
    }
    case PH_CONV: ph_conv(wv, P, layer, bid, nb); ph_vtranspose(wv, P, smem, bid, nb); break;
    case PH_STATES: ph_states_mfma(wv, P, layer, smem, bid, nb); break;
    case PH_SCAN: ph_scan(wv, P, bid, nb); break;
    case PH_SSDY: ph_ssdy_mfma(wv, P, layer, nrows / 128, smem, bid, nb); break;
    case PH_POOL: ph_pool_mfma(wv, P, layer, nrows, smem, bid, nb); break;
    case PH_NA: ph_na_mfma(wv, P, layer, nrows, smem, bid, nb); break;
    case PH_OUTPROJ:
    {
      pg8::Gemm g{P.concat(), P.w_outT() + (size_t)layer * 1024 * 2048, nrows, 1024, 2048};
      pg8::StaticOrder S; S.init(g.M, g.N, nb, bid);
      EpiOutproj E{P.h(), hl, hc, P.mod() + (size_t)layer * 5 * MODW, P.yss()};
      pg8::gemm_phase<EpiOutproj, pg8::StaticOrder, false>(wv, (PG8_LAS unsigned char*)smem, g, S, E, nullptr);
      break;
    }
    case PH_NORM2:
      ph_norm(wv, P.h(), P.h() + (size_t)NLAT * DM, P.norm2_g + layer * 1024, P.mod() + (size_t)layer * 5 * MODW, 3072, 4096, nrows, P.u(), bid, nb);
      break;
    case PH_QGEMM:
    {
      pg8::Gemm g{P.u(), P.w_qT() + (size_t)layer * 2048 * 1024, nrows, 2048, 1024};
      pg8::StaticOrder S; S.init(g.M, g.N, nb, bid);
      pg8::EpiBf16<0> E{P.q(), 2048, nullptr, 0, 0};
      pg8::gemm_phase<pg8::EpiBf16<0>, pg8::StaticOrder, false>(wv, (PG8_LAS unsigned char*)smem, g, S, E, nullptr);
      ph_convert_tables(wv, P, layer, bid, nb);
      break;
    }
    case PH_TOPK: ph_peer_topk_mfma(wv, P, layer, nrows, smem, bid, nb); break;
    case PH_GATHER: ph_peer_dots(wv, P, layer, nrows, bid, nb); ph_peer_acc(wv, P, layer, nrows, bid, nb); break;
  }
}

namespace cg = cooperative_groups;
typedef const __attribute__((address_space(4))) Params* kparams_t;
__device__ __forceinline__ const Params& kp_fresh() {
  kparams_t kp = (kparams_t)__builtin_amdgcn_kernarg_segment_ptr();
  asm volatile("" : "+s"(kp));
  return *(const Params*)kp;
}
__global__ void __launch_bounds__(NTHR) k_mega(Params P_unused) {
  __shared__ __attribute__((aligned(16))) char smem[SMEM_BYTES + 16];
  cg::grid_group grid = cg::this_grid();
  const int bid = blockIdx.x, nb = gridDim.x;
  const int wv = __builtin_amdgcn_readfirstlane(threadIdx.x >> 6);
  if (threadIdx.x == 0) *(uint4*)(smem + SMEM_BYTES) = make_uint4(0u, 0u, 0u, 0u);
  __syncthreads();
  (void)xcd_barrier_post((unsigned*)(kp_fresh().ws + WS_BAR), (volatile LAS unsigned*)(smem + SMEM_BYTES), threadIdx.x == 0);
#define GSYNC() do { XcdBarrier xb_; xb_.bar = (unsigned*)(kp_fresh().ws + WS_BAR); xb_.x = xb_xcc_id(); \
    xb_.st = (volatile LAS unsigned*)(smem + SMEM_BYTES); xcd_barrier(xb_, otid(wv) == 0); } while (0)
  run_phase(wv, kp_fresh(), PH_PREP, 0, smem, bid, nb);
  if (nb == 0x7fffff00) grid.sync();
  GSYNC();
  run_phase(wv, kp_fresh(), PH_NORM1, 0, smem, bid, nb); GSYNC();
#pragma unroll 1
  for (int layer = 0; layer < 2; ++layer) {
    run_phase(wv, kp_fresh(), PH_INPROJ, layer, smem, bid, nb); GSYNC();
    run_phase(wv, kp_fresh(), PH_CONV, layer, smem, bid, nb);
    GSYNC();
    run_phase(wv, kp_fresh(), PH_STATES, layer, smem, bid, nb);
    run_phase(wv, kp_fresh(), PH_POOL, layer, smem, bid, nb);
    run_phase(wv, kp_fresh(), PH_NA, layer, smem, bid, nb); GSYNC();
    run_phase(wv, kp_fresh(), PH_SCAN, layer, smem, bid, nb); GSYNC();
    run_phase(wv, kp_fresh(), PH_SSDY, layer, smem, bid, nb); GSYNC();
    run_phase(wv, kp_fresh(), PH_OUTPROJ, layer, smem, bid, nb); GSYNC();
    run_phase(wv, kp_fresh(), PH_NORM2, layer, smem, bid, nb); GSYNC();
    run_phase(wv, kp_fresh(), PH_QGEMM, layer, smem, bid, nb); GSYNC();
    run_phase(wv, kp_fresh(), PH_TOPK, layer, smem, bid, nb); GSYNC();
    run_phase(wv, kp_fresh(), PH_GATHER, layer, smem, bid, nb);
    if (layer == 0) GSYNC();
  }
}

extern "C" void kernel_launch(void* const* d_in, const int* in_sizes, int n_in, void* d_out, int out_size, void* d_ws,
                              size_t ws_size, hipStream_t stream) {
  Params P{};
  const float* const* in = (const float* const*)d_in;
  P.x = in[0]; P.c = in[1]; P.ctx = in[2]; P.c_ctx = in[3]; P.ada_w = in[4]; P.ada_b = in[5]; P.norm1_g = in[6];
  P.w_in = in[7]; P.conv_w = in[8]; P.conv_b = in[9]; P.a_log = in[10]; P.dt_bias = in[11]; P.d_skip = in[12];
  P.ssd_norm_g = in[13]; P.pool_w = in[14]; P.pool_scale = in[15]; P.na_rpb = in[16]; P.w_out = in[17];
  P.norm2_g = in[18]; P.peer_wq = in[19]; P.peer_keys = in[20]; P.peer_u = in[21]; P.peer_v = in[22]; P.final_g = in[23];
  P.out = (float*)d_out;
  P.ws = (char*)d_ws;
  if (WS_TOTAL > ws_size) { fprintf(stderr, "workspace too small: need %zu have %zu\n", (size_t)WS_TOTAL, ws_size); return; }

  static int grid_blocks = 0;
  if (!grid_blocks) {
    int dev = 0, cus = 0, per_cu = 0;
    hipGetDevice(&dev);
    hipDeviceGetAttribute(&cus, hipDeviceAttributeMultiprocessorCount, dev);
    hipOccupancyMaxActiveBlocksPerMultiprocessor(&per_cu, k_mega, NTHR, 0);
    if (per_cu > 4) per_cu = 4;
    grid_blocks = cus * per_cu;
  }
  hipMemsetAsync((char*)d_ws + WS_BAR, 0, 4096 * 4, stream);
  void* args[] = {&P};
  hipError_t e = hipLaunchCooperativeKernel((void*)k_mega, dim3(grid_blocks), dim3(NTHR), args, 0, stream);
  if (e != hipSuccess) fprintf(stderr, "cooperative launch failed: %s (grid %d)\n", hipGetErrorString(e), grid_blocks);
}
```

```cpp
#include <hip/hip_runtime.h>
#include <hip/hip_bf16.h>
#include <hip/hip_cooperative_groups.h>
#include <stdint.h>
#include <stdio.h>

typedef unsigned short bf16_t;
typedef __attribute__((ext_vector_type(8))) short bf16x8;
typedef __attribute__((ext_vector_type(4))) float f32x4;

#define NTHR 512
#define NWAVE 8
constexpr int DM = 1024;
constexpr int SEQ = 4096;
constexpr int NLAT = 16384;
constexpr int NCTXR = 1024;
constexpr int NTOK = 17408;
constexpr int INW = 4640;
constexpr int PW = 4608;
constexpr int OFF_Z = 0, OFF_XBC = 1024, OFF_POOL = 2560, OFF_Q = 3072, OFF_K = 3584, OFF_V = 4096;
constexpr int NCHUNK = 136;
constexpr int MODW = 6144;

constexpr size_t al256(size_t x) { return (x + 255) & ~(size_t)255; }
constexpr size_t WS_MOD = 0;
constexpr size_t WS_H = WS_MOD + al256((size_t)2 * 5 * MODW * 4);
constexpr size_t WS_P = WS_H + al256((size_t)NTOK * DM * 4);
constexpr size_t WS_TABU = WS_P + (size_t)80 * 1024 * 1024;
constexpr size_t WS_TABV = WS_TABU + (size_t)16384 * 512;
constexpr size_t WS_INVU = WS_TABV + (size_t)16384 * 512;
constexpr size_t WS_INVV = WS_INVU + (size_t)16384 * 4;
constexpr size_t WS_DTRAW = WS_P + al256((size_t)NTOK * PW * 2);
constexpr size_t WS_DTV = WS_DTRAW + al256((size_t)NTOK * 32 * 4);
constexpr size_t WS_CSV = WS_DTV + al256((size_t)NTOK * 32 * 4);
constexpr size_t WS_XBC = WS_CSV + al256((size_t)NTOK * 32 * 4);
constexpr size_t WS_VTL = WS_XBC + al256((size_t)NTOK * 512 * 2);
constexpr size_t WS_VTC = WS_VTL + al256((size_t)4 * 8 * 64 * 4096 * 2);
constexpr size_t WS_KEYSB = WS_VTC + al256((size_t)4 * 8 * 64 * 256 * 2);
constexpr size_t WS_POOLWT = WS_KEYSB + al256((size_t)2 * 8 * 2 * 128 * 128 * 2);
constexpr size_t WS_BT4 = WS_POOLWT + al256((size_t)2 * 4 * 128 * 128 * 2);
constexpr size_t WS_ATOT = WS_BT4 + al256((size_t)NTOK * 256 * 2);
constexpr size_t WS_STATES = WS_XBC + al256((size_t)NTOK * 1536 * 2);
constexpr size_t WS_YSS = WS_ATOT + al256((size_t)NCHUNK * 32 * 4);
static_assert(WS_YSS + (size_t)NTOK * 16 * 4 <= WS_STATES, "must fit in the old xbc region");
constexpr size_t WS_CONCAT = WS_STATES + al256((size_t)NCHUNK * 32 * 8192 * 2);
constexpr size_t WS_SELIDX = WS_CONCAT + al256((size_t)NTOK * 2048 * 2);
constexpr size_t WS_SELG = WS_SELIDX + al256((size_t)NTOK * 128 * 4);
constexpr size_t WS_WINT = WS_SELG + al256((size_t)NTOK * 128 * 4);
constexpr size_t WS_WDTT = WS_WINT + al256((size_t)2 * PW * 1024 * 2);
constexpr size_t WS_WOUTT = WS_WDTT + al256((size_t)2 * 128 * 1024 * 2);
constexpr size_t WS_WQT = WS_WOUTT + al256((size_t)2 * 1024 * 2048 * 2);
constexpr size_t WS_BAR = WS_WQT + al256((size_t)2 * 2048 * 1024 * 2);
constexpr size_t WS_XT4 = WS_BAR + al256((size_t)4096 * 4);
constexpr size_t WS_TOTAL = WS_XT4 + al256((size_t)NTOK * 1024 * 2);
static_assert((size_t)4 * 8 * (4096 + 256) * 64 * 2 <= WS_WINT - WS_SELIDX, "K relayout must fit in the sel_idx/sel_g region");
static_assert(WS_INVV + (size_t)16384 * 4 <= WS_DTRAW, "tables must fit in the tail of p");
static_assert((size_t)NTOK * 2048 * 2 <= (size_t)80 * 1024 * 1024, "q must fit below the tables");

struct Params {
  const float *x, *c, *ctx, *c_ctx, *ada_w, *ada_b, *norm1_g, *w_in, *conv_w, *conv_b, *a_log, *dt_bias, *d_skip,
      *ssd_norm_g, *pool_w, *pool_scale, *na_rpb, *w_out, *norm2_g, *peer_wq, *peer_keys, *peer_u, *peer_v, *final_g;
  float* out;
  char* ws;
  __device__ __forceinline__ float* mod() const { return (float*)(ws + WS_MOD); }
  __device__ __forceinline__ float* h() const { return (float*)(ws + WS_H); }
  __device__ __forceinline__ bf16_t* u() const { return (bf16_t*)(ws + WS_CONCAT); }
  __device__ __forceinline__ bf16_t* p() const { return (bf16_t*)(ws + WS_P); }
  __device__ __forceinline__ float* dtraw() const { return (float*)(ws + WS_DTRAW); }
  __device__ __forceinline__ float* dtv() const { return (float*)(ws + WS_DTV); }
  __device__ __forceinline__ float* csv() const { return (float*)(ws + WS_CSV); }
  __device__ __forceinline__ bf16_t* xbc() const { return (bf16_t*)(ws + WS_XBC); }
  __device__ __forceinline__ bf16_t* states() const { return (bf16_t*)(ws + WS_STATES); }
  __device__ __forceinline__ bf16_t* concat() const { return (bf16_t*)(ws + WS_CONCAT); }
  __device__ __forceinline__ bf16_t* q() const { return (bf16_t*)(ws + WS_P); }
  __device__ __forceinline__ int* sel_idx() const { return (int*)(ws + WS_SELIDX); }
  __device__ __forceinline__ float* sel_g() const { return (float*)(ws + WS_SELG); }
  __device__ __forceinline__ bf16_t* w_inT() const { return (bf16_t*)(ws + WS_WINT); }
  __device__ __forceinline__ bf16_t* w_dtT() const { return (bf16_t*)(ws + WS_WDTT); }
  __device__ __forceinline__ bf16_t* w_outT() const { return (bf16_t*)(ws + WS_WOUTT); }
  __device__ __forceinline__ bf16_t* w_qT() const { return (bf16_t*)(ws + WS_WQT); }
  __device__ __forceinline__ bf16_t* vtl() const { return (bf16_t*)(ws + WS_VTL); }
  __device__ __forceinline__ bf16_t* vtc() const { return (bf16_t*)(ws + WS_VTC); }
  __device__ __forceinline__ bf16_t* poolwT() const { return (bf16_t*)(ws + WS_POOLWT); }
  __device__ __forceinline__ bf16_t* keysb() const { return (bf16_t*)(ws + WS_KEYSB); }
  __device__ __forceinline__ bf16_t* xt4() const { return (bf16_t*)(ws + WS_XT4); }
  __device__ __forceinline__ bf16_t* bt4() const { return (bf16_t*)(ws + WS_BT4); }
  __device__ __forceinline__ float* wst() const { return (float*)(ws + WS_DTRAW); }
  __device__ __forceinline__ float* cst() const { return (float*)(ws + WS_CSV); }
  __device__ __forceinline__ float* dtt() const { return (float*)(ws + WS_DTV); }
  __device__ __forceinline__ float* yss() const { return (float*)(ws + WS_YSS); }
  __device__ __forceinline__ float* atot() const { return (float*)(ws + WS_ATOT); }
  __device__ __forceinline__ bf16_t* bfr() const { return (bf16_t*)(ws + WS_XBC); }
  __device__ __forceinline__ bf16_t* cfr() const { return (bf16_t*)(ws + WS_XBC + (size_t)NTOK * 256 * 2); }
  __device__ __forceinline__ bf16_t* ktl() const { return (bf16_t*)(ws + WS_SELIDX); }
  __device__ __forceinline__ bf16_t* ktc() const { return (bf16_t*)(ws + WS_SELIDX + (size_t)4 * 8 * 4096 * 64 * 2); }
  __device__ __forceinline__ unsigned char* tabU() const { return (unsigned char*)(ws + WS_TABU); }
  __device__ __forceinline__ unsigned char* tabV() const { return (unsigned char*)(ws + WS_TABV); }
  __device__ __forceinline__ float* invU() const { return (float*)(ws + WS_INVU); }
  __device__ __forceinline__ float* invV() const { return (float*)(ws + WS_INVV); }
};

__device__ __forceinline__ int otid(int wv) {
  int l;
  asm volatile("v_mbcnt_lo_u32_b32 %0, -1, 0\n\tv_mbcnt_hi_u32_b32 %0, -1, %0" : "=v"(l));
  return (wv << 6) | l;
}
__device__ __forceinline__ float bf2f(bf16_t v) { return __uint_as_float(((uint32_t)v) << 16); }
typedef __bf16 bf16x2_hw __attribute__((ext_vector_type(2)));
__device__ __forceinline__ uint32_t pack2(float a, float b) {
  const float __attribute__((ext_vector_type(2))) v = {a, b};
  return __builtin_bit_cast(uint32_t, __builtin_convertvector(v, bf16x2_hw));
}
__device__ __forceinline__ bf16_t f2bf(float f) { return (bf16_t)(pack2(f, 0.f) & 0xffffu); }
#define DPP_F(v, ctrl) __int_as_float(__builtin_amdgcn_update_dpp(0, __float_as_int(v), (ctrl), 0xf, 0xf, true))
__device__ __forceinline__ float wave_sum(float v) {
  v += DPP_F(v, 0xB1);
  v += DPP_F(v, 0x4E);
  v += DPP_F(v, 0x141);
  v += DPP_F(v, 0x140);
  const int iv = __float_as_int(v);
  return __int_as_float(__builtin_amdgcn_readlane(iv, 0)) + __int_as_float(__builtin_amdgcn_readlane(iv, 16)) +
         __int_as_float(__builtin_amdgcn_readlane(iv, 32)) + __int_as_float(__builtin_amdgcn_readlane(iv, 48));
}
__device__ __forceinline__ float wave_max(float v) {
  v = fmaxf(v, DPP_F(v, 0xB1));
  v = fmaxf(v, DPP_F(v, 0x4E));
  v = fmaxf(v, DPP_F(v, 0x141));
  v = fmaxf(v, DPP_F(v, 0x140));
  const int iv = __float_as_int(v);
  return fmaxf(fmaxf(__int_as_float(__builtin_amdgcn_readlane(iv, 0)), __int_as_float(__builtin_amdgcn_readlane(iv, 16))),
               fmaxf(__int_as_float(__builtin_amdgcn_readlane(iv, 32)), __int_as_float(__builtin_amdgcn_readlane(iv, 48))));
}
__device__ __forceinline__ float fexp(float v) { return __builtin_amdgcn_exp2f(v * 1.44269504088896341f); }
__device__ __forceinline__ float silu_f(float v) { return v * __builtin_amdgcn_rcpf(1.f + fexp(-v)); }
__device__ __forceinline__ float softplus_f(float v) { return fmaxf(v, 0.f) + log1pf(expf(-fabsf(v))); }
__device__ __forceinline__ float gelu_f(float v) { return 0.5f * v * (1.f + erff(v * 0.70710678118654752f)); }

__device__ __forceinline__ void unpack8(const uint4 v, float* f) {
  f[0] = __uint_as_float(v.x << 16); f[1] = __uint_as_float(v.x & 0xffff0000u);
  f[2] = __uint_as_float(v.y << 16); f[3] = __uint_as_float(v.y & 0xffff0000u);
  f[4] = __uint_as_float(v.z << 16); f[5] = __uint_as_float(v.z & 0xffff0000u);
  f[6] = __uint_as_float(v.w << 16); f[7] = __uint_as_float(v.w & 0xffff0000u);
}
typedef float f32x2_t __attribute__((ext_vector_type(2)));
typedef unsigned u32x4_t __attribute__((ext_vector_type(4)));
typedef short s16x4 __attribute__((ext_vector_type(4)));
typedef __attribute__((address_space(3))) s16x4 lds_s16x4;
__device__ __forceinline__ bf16x8 tr_read2(const char* a0, const char* a1) {
  const s16x4 a = __builtin_amdgcn_ds_read_tr16_b64_v4i16((lds_s16x4*)a0);
  const s16x4 b = __builtin_amdgcn_ds_read_tr16_b64_v4i16((lds_s16x4*)a1);
  return (bf16x8){a[0], a[1], a[2], a[3], b[0], b[1], b[2], b[3]};
}

__device__ __forceinline__ const float* hrow(const float* hl, const float* hc, int row) {
  return row < NLAT ? hl + (size_t)row * DM : hc + (size_t)(row - NLAT) * DM;
}
__device__ __forceinline__ int modrow(int row) { return row < NLAT ? (row >> 12) : 4; }

namespace pg8 {
#define PG8_LAS __attribute__((address_space(3)))
typedef unsigned short bf16_t;
typedef short bf16x8 __attribute__((ext_vector_type(8)));
typedef float f32x4 __attribute__((ext_vector_type(4)));
typedef unsigned u32x4 __attribute__((ext_vector_type(4)));
constexpr int BM = 256, BK = 64, HALF = 128, HTB = HALF * BK * 2  , STAGE_BYTES = 8 * HTB, NXCD = 8, WGM = 8;

__host__ __device__ __forceinline__ int lds_byte(int r, int c) { const int st = (r >> 4) * 2 + (c >> 5), rr = r & 15, cc = c & 31, ob = rr * 64 + cc * 2; return st * 1024 + (ob ^ (((ob >> 9) & 1) << 5)); }
__host__ __device__ __forceinline__ void stage_rc(int b, int& R, int& C) { const int st = b / 1024, sb = b % 1024, swz = sb ^ (((sb >> 9) & 1) << 5); R = (st >> 1) * 16 + swz / 64; C = (st & 1) * 32 + (swz % 64) / 2; }
__host__ __device__ __forceinline__ int perm32(int rho) { const int n = rho >> 4, i = rho & 15; return 8 * (i >> 2) + 4 * n + (i & 3); }

struct Unit { int pm, pn; };
struct Gemm { const bf16_t* A; const bf16_t* Bt; int M, N, K; };

struct StaticOrder {
    int nM, nN, nwg, G, c;
    __host__ __device__ void init(int M, int N, int G_, int c_) { nM = M / BM; nN = N / BM; nwg = nM * nN; G = G_; c = c_; }
    __host__ __device__ bool next(int i, Unit& u) const {
        const long L = (long)i * G + c; if (L >= nwg) return false;
        int wgid = (int)L; { const int q = nwg / NXCD, r = nwg % NXCD, xcd = wgid % NXCD, off = wgid / NXCD; wgid = (xcd < r ? xcd * (q + 1) : r * (q + 1) + (xcd - r) * q) + off; }
        const int nig = WGM * nN, gid = wgid / nig, fm = gid * WGM, gsz = (nM - fm) < WGM ? (nM - fm) : WGM;
        u.pm = fm + ((wgid % nig) % gsz); u.pn = (wgid % nig) / gsz; return true;
    }
    __device__ __forceinline__ void a_ready(const Unit&) const {}
    __device__ __forceinline__ void done(const Unit&) const {}
};

__device__ __forceinline__ unsigned cvt_pk_bf16(float lo, float hi) { unsigned r; asm volatile("v_cvt_pk_bf16_f32 %0, %1, %2" : "=v"(r) : "v"(lo), "v"(hi)); return r; }
typedef float f32x2 __attribute__((ext_vector_type(2)));
__device__ __forceinline__ f32x2 gelu_pk(f32x2 v) { return v; }
template <int ACT  > struct EpiBf16 {
    static constexpr bool PERM = true, AFTER_DRAIN = false; static constexpr int MIDK_T = 0;
    bf16_t* O; int ldc; const float* bias; int split_cols; size_t split_stride;
    __device__ __forceinline__ void operator()(const f32x4 (&acc)[2][2][4][2], const Unit& u, int wr, int wc, int fr, int fq) const {
        const int row0 = u.pm * BM + wr * 64 + fr; int colt = u.pn * BM; bf16_t* base = O;
        if (split_cols) { const int t = colt / split_cols; base += (size_t)t * split_stride; colt -= t * split_cols; }
        const int col0 = colt + wc * 32 + 8 * fq, bcol0 = u.pn * BM + wc * 32 + 8 * fq;
        f32x4 bv[2][2];
#pragma unroll
        for (int bj = 0; bj < 2; ++bj)
#pragma unroll
            for (int n = 0; n < 2; ++n) bv[bj][n] = bias ? *(const f32x4*)(bias + bcol0 + bj * HALF + 4 * n) : (f32x4){0.f, 0.f, 0.f, 0.f};
#pragma unroll
        for (int ai = 0; ai < 2; ++ai)
#pragma unroll
            for (int m = 0; m < 4; ++m) { bf16_t* rowp = base + (size_t)(row0 + ai * HALF + m * 16) * ldc + col0;
#pragma unroll
                for (int bj = 0; bj < 2; ++bj) { f32x4 v0 = acc[ai][bj][m][0] + bv[bj][0], v1 = acc[ai][bj][m][1] + bv[bj][1];
                    if (ACT == 1) { f32x2 a = gelu_pk((f32x2){v0[0], v0[1]}), b = gelu_pk((f32x2){v0[2], v0[3]}), c = gelu_pk((f32x2){v1[0], v1[1]}), d = gelu_pk((f32x2){v1[2], v1[3]});
                        v0 = (f32x4){a.x, a.y, b.x, b.y}; v1 = (f32x4){c.x, c.y, d.x, d.y}; }
                    if (ACT == 2) {
#pragma unroll
                        for (int j = 0; j < 4; ++j) { v0[j] = 0.5f * v0[j] * (1.0f + erff(v0[j] * 0.70710678f)); v1[j] = 0.5f * v1[j] * (1.0f + erff(v1[j] * 0.70710678f)); } }
                    u32x4 w; w.x = cvt_pk_bf16(v0[0], v0[1]); w.y = cvt_pk_bf16(v0[2], v0[3]); w.z = cvt_pk_bf16(v1[0], v1[1]); w.w = cvt_pk_bf16(v1[2], v1[3]);
                    *(u32x4*)(rowp + bj * HALF) = w; } }
    }
};

template <class Epi, class Sched, bool STAMP = false>
__device__ __forceinline__ void gemm_phase(int wv, PG8_LAS unsigned char* lds, const Gemm g, const Sched& S, const Epi& E, unsigned long long* stamps) {
    const int tid = otid(wv), wid = __builtin_amdgcn_readfirstlane(tid >> 6), lane = tid & 63, wr = wid >> 2, wc = wid & 3, fr = lane & 15, fq = lane >> 4;
    const int K = g.K, nt = K / BK;
    int ts_lo = 0, ts_hi = 0, nts = 0; const unsigned long long rt_entry = STAMP ? (unsigned long long)wall_clock64() : 0ull;
#define PG8_STAMP() do { if (STAMP && wid == 0 && nts < 64) { const unsigned long long _c = (unsigned long long)clock64(); \
        ts_lo = (lane == nts) ? (int)(unsigned)_c : ts_lo; ts_hi = (lane == nts) ? (int)(unsigned)(_c >> 32) : ts_hi; ++nts; } } while (0)
    PG8_STAMP();
    unsigned voffA[2], voffB[2];
#pragma unroll
    for (int i = 0; i < 2; ++i) { int R, C; stage_rc(tid * 16 + i * 8192, R, C); const int Rb = Epi::PERM ? ((R & ~31) + perm32(R & 31)) : R;
        voffA[i] = (unsigned)(R * K + C) * 2u; voffB[i] = (unsigned)(Rb * K + C) * 2u; }
    const size_t kstep = (size_t)(BK * 2);
    const size_t hstep = (size_t)HALF * K * 2;
    const size_t tstep = 2 * hstep;
    const unsigned ldsw = (unsigned)wid * 1024u;
    const int aoff = lds_byte(wr * 64 + fr, fq * 8), boff = lds_byte(wc * 32 + fr, fq * 8);
#define PG8_SA(b, h) (((b) * 2 + (h)) * HTB)
#define PG8_SB(b, h) ((4 + (b) * 2 + (h)) * HTB)
#define PG8_STAGE(bufoff, gbase, voff) do { _Pragma("unroll") for (int _i = 0; _i < 2; ++_i) \
        __builtin_amdgcn_global_load_lds((const unsigned*)((const char*)(gbase) + (voff)[_i]), (PG8_LAS unsigned*)(lds + (bufoff) + ldsw + _i * 8192), 16, 0, 0); } while (0)
#define PG8_LDA(dst, b, h) do { _Pragma("unroll") for (int m = 0; m < 4; ++m) _Pragma("unroll") for (int k = 0; k < 2; ++k) dst[m][k] = *(const PG8_LAS bf16x8*)(lds + PG8_SA(b, h) + aoff + m * 2048 + k * 1024); } while (0)
#define PG8_LDB(dst, b, h) do { _Pragma("unroll") for (int n = 0; n < 2; ++n) _Pragma("unroll") for (int k = 0; k < 2; ++k) dst[n][k] = *(const PG8_LAS bf16x8*)(lds + PG8_SB(b, h) + boff + n * 2048 + k * 1024); } while (0)
#define PG8_MMA(ai, bj, At, Bt) do { __builtin_amdgcn_s_setprio(1); _Pragma("unroll") for (int m = 0; m < 4; ++m) _Pragma("unroll") for (int n = 0; n < 2; ++n) _Pragma("unroll") for (int k = 0; k < 2; ++k) \
        acc[ai][bj][m][n] = __builtin_amdgcn_mfma_f32_16x16x32_bf16(Bt[n][k], At[m][k], acc[ai][bj][m][n], 0, 0, 0); __builtin_amdgcn_s_setprio(0); } while (0)
#define PG8_WAIT_V(n) asm volatile("s_waitcnt vmcnt(" #n ")" ::: "memory")
#define PG8_WAIT_L(n) asm volatile("s_waitcnt lgkmcnt(" #n ")" ::: "memory")
#define PG8_BAR __builtin_amdgcn_s_barrier()
#define PG8_SCHED __builtin_amdgcn_sched_barrier(0)
    Unit cur, nxt; int ui = 0;
    if (!S.next(0, cur)) return;
    f32x4 acc[2][2][4][2];
#pragma unroll
    for (int a = 0; a < 2; ++a)
#pragma unroll
        for (int b = 0; b < 2; ++b)
#pragma unroll
            for (int m = 0; m < 4; ++m)
#pragma unroll
                for (int n = 0; n < 2; ++n) acc[a][b][m][n] = (f32x4){0.f, 0.f, 0.f, 0.f};
    bf16x8 At[4][2], B0[2][2], B1[2][2];
    const char* cA = (const char*)g.A + (size_t)cur.pm * tstep; const char* cB = (const char*)g.Bt + (size_t)cur.pn * tstep;
    S.a_ready(cur);
    PG8_STAGE(PG8_SB(0, 0), cB, voffB); PG8_STAGE(PG8_SA(0, 0), cA, voffA); PG8_STAGE(PG8_SB(0, 1), cB + hstep, voffB); PG8_STAGE(PG8_SA(0, 1), cA + hstep, voffA);
    if (wr == 1) PG8_BAR;
    PG8_WAIT_V(4); PG8_BAR;
    PG8_STAGE(PG8_SB(1, 0), cB + kstep, voffB); PG8_STAGE(PG8_SA(1, 0), cA + kstep, voffA); PG8_STAGE(PG8_SB(1, 1), cB + hstep + kstep, voffB);
    PG8_WAIT_V(6); PG8_BAR;
    PG8_STAMP();
    for (;;) {
        const bool has_next = S.next(ui + 1, nxt);
        const char* nA = has_next ? (const char*)g.A + (size_t)nxt.pm * tstep : cA; const char* nB = has_next ? (const char*)g.Bt + (size_t)nxt.pn * tstep : cB;
        for (int t = 0; t < nt; t += 2) {
            if constexpr (Epi::MIDK_T > 0) { if (t == Epi::MIDK_T) E.midk(acc, cur, wr, wc, fr, fq); }
            const bool last = (t == nt - 2);
            const char* a1 = cA + (size_t)(t + 1) * kstep;
            const char* a2 = last ? nA : cA + (size_t)(t + 2) * kstep; const char* b2 = last ? nB : cB + (size_t)(t + 2) * kstep;
            const char* a3 = a2 + kstep; const char* b3 = b2 + kstep;
            if (last && has_next) S.a_ready(nxt);
            PG8_LDB(B0, 0, 0); PG8_SCHED; PG8_LDA(At, 0, 0); PG8_STAGE(PG8_SA(1, 1), a1 + hstep, voffA);
            PG8_WAIT_L(8); PG8_BAR; PG8_WAIT_L(0); PG8_MMA(0, 0, At, B0); PG8_BAR; PG8_SCHED;
            PG8_LDB(B1, 0, 1); PG8_STAGE(PG8_SB(0, 0), b2, voffB);
            PG8_BAR; PG8_WAIT_L(0); PG8_MMA(0, 1, At, B1); PG8_BAR;
            PG8_LDA(At, 0, 1); PG8_STAGE(PG8_SA(0, 0), a2, voffA);
            PG8_BAR; PG8_WAIT_L(0); PG8_MMA(1, 0, At, B0); PG8_BAR; PG8_SCHED;
            PG8_STAGE(PG8_SB(0, 1), b2 + hstep, voffB);
            PG8_WAIT_V(6); PG8_BAR; PG8_MMA(1, 1, At, B1); PG8_BAR;
            PG8_LDB(B0, 1, 0); PG8_SCHED; PG8_LDA(At, 1, 0); PG8_STAGE(PG8_SA(0, 1), a2 + hstep, voffA);
            PG8_WAIT_L(8); PG8_BAR; PG8_WAIT_L(0); PG8_MMA(0, 0, At, B0); PG8_BAR; PG8_SCHED;
            PG8_LDB(B1, 1, 1); PG8_STAGE(PG8_SB(1, 0), b3, voffB);
            PG8_BAR; PG8_WAIT_L(0); PG8_MMA(0, 1, At, B1); PG8_BAR;
            PG8_LDA(At, 1, 1); PG8_STAGE(PG8_SA(1, 0), a3, voffA);
            PG8_BAR; PG8_WAIT_L(0); PG8_MMA(1, 0, At, B0); PG8_BAR; PG8_SCHED;
            PG8_STAGE(PG8_SB(1, 1), b3 + hstep, voffB);
            PG8_WAIT_V(6); PG8_BAR; PG8_MMA(1, 1, At, B1); PG8_BAR;
        }
        PG8_STAMP();
        if constexpr (!Epi::AFTER_DRAIN) { E(acc, cur, wr, wc, fr, fq); S.done(cur); }
        PG8_STAMP();
        if (!has_next) break;
#pragma unroll
        for (int a = 0; a < 2; ++a)
#pragma unroll
            for (int b = 0; b < 2; ++b)
#pragma unroll
                for (int m = 0; m < 4; ++m)
#pragma unroll
                    for (int n = 0; n < 2; ++n) acc[a][b][m][n] = (f32x4){0.f, 0.f, 0.f, 0.f};
        cur = nxt; cA = nA; cB = nB; ++ui;
    }
    PG8_WAIT_V(0);
    if (wr == 0) PG8_BAR;
    PG8_BAR;
    if constexpr (Epi::AFTER_DRAIN) { E.fused(acc, cur, wr, wc, fr, fq, lds, wid, lane); S.done(cur); }
    PG8_STAMP();
    if (STAMP && wid == 0) { stamps[lane] = lane < nts ? (((unsigned long long)(unsigned)ts_hi << 32) | (unsigned)ts_lo) : 0ull;
        if (lane == 62) stamps[62] = rt_entry; if (lane == 63) stamps[63] = (unsigned long long)wall_clock64(); }
#undef PG8_STAMP
#undef PG8_SA
#undef PG8_SB
#undef PG8_STAGE
#undef PG8_LDA
#undef PG8_LDB
#undef PG8_MMA
#undef PG8_WAIT_V
#undef PG8_WAIT_L
#undef PG8_BAR
#undef PG8_SCHED
}
}

#define XB_TMO      128
#define XB_XCNT(j)  (256  + 64 * (j))
#define XB_XSUB(j)  (1280 + 64 * (j))
#define XB_XGEN(j)  (2304 + 64 * (j))
#define XB_TOP      3328
#define XB_TOPGEN   3392
#define XCD_BAR_WORDS 3456
#define XB_SPIN_CAP (1u << 27)
#define LAS __attribute__((address_space(3)))

__device__ __forceinline__ unsigned xb_ld(unsigned* p)              { return __hip_atomic_load(p, __ATOMIC_RELAXED, __HIP_MEMORY_SCOPE_AGENT); }
__device__ __forceinline__ unsigned xb_add(unsigned* p, unsigned v) { return __hip_atomic_fetch_add(p, v, __ATOMIC_RELAXED, __HIP_MEMORY_SCOPE_AGENT); }
__device__ __forceinline__ unsigned xb_xcc_id() { return (unsigned)__builtin_amdgcn_s_getreg((3 << 11) | 20) & 0xFu; }
#define XB_SPIN(cond, bar) do { unsigned _sp = 0; while (cond) { __builtin_amdgcn_s_sleep(1); \
    if ((++_sp & 255u) == 0u) { if (xb_ld(&(bar)[XB_TMO])) break; if (_sp > XB_SPIN_CAP) { atomicAdd(&(bar)[XB_TMO], 1u); break; } } } } while (0)

struct XcdBarrier {
    unsigned* bar; unsigned x;
    volatile LAS unsigned* st;
};

__device__ __forceinline__ XcdBarrier xcd_barrier_post(unsigned* bar, volatile LAS unsigned* st, bool xb_t0) {
    XcdBarrier b; b.bar = bar; b.x = xb_xcc_id(); b.st = st;
    if (xb_t0) (void)xb_add(&bar[XB_XCNT(b.x)], 1u);
    return b;
}
__device__ __forceinline__ void xcd_barrier_complete(unsigned* bar, unsigned x, unsigned& nloc, unsigned& nx) {
    const unsigned G = gridDim.x * gridDim.y * gridDim.z;
    unsigned sum, cnt, mine, sp = 0u;
    for (;;) {
        sum = 0u; cnt = 0u; mine = 0u;
#pragma unroll
        for (unsigned j = 0; j < 16; ++j) { const unsigned c = xb_ld(&bar[XB_XCNT(j)]); sum += c; cnt += (c > 0u) ? 1u : 0u; mine = (j == x) ? c : mine; }
        if (sum == G) break;
        __builtin_amdgcn_s_sleep(1);
        if ((++sp & 255u) == 0u) { if (xb_ld(&bar[XB_TMO])) break; if (sp > XB_SPIN_CAP) { atomicAdd(&bar[XB_TMO], 1u); break; } }
    }
    nloc = mine > 0u ? mine : 1u; nx = cnt > 0u ? cnt : 1u;
}

__device__ __forceinline__ void xcd_barrier(const XcdBarrier& b, bool xb_t0) {
    asm volatile("s_waitcnt vmcnt(0)" ::: "memory");
    __syncthreads();
    if (xb_t0) {
        unsigned* bar = b.bar;
        __builtin_amdgcn_s_waitcnt(0);
        unsigned nloc = b.st[0], nx = b.st[1];
        if (nloc == 0u) { xcd_barrier_complete(bar, b.x, nloc, nx); b.st[0] = nloc; b.st[1] = nx; }
        const unsigned old = xb_add(&bar[XB_XSUB(b.x)], 1u);
        const unsigned gen = old / nloc;
        if (old + 1u == (gen + 1u) * nloc) {
            __builtin_amdgcn_fence(__ATOMIC_RELEASE, "agent");
            asm volatile("s_waitcnt vmcnt(0)" ::: "memory");
            const unsigned og = xb_add(&bar[XB_TOP], 1u);
            const unsigned tg = og / nx;
            if (og + 1u == (tg + 1u) * nx) xb_add(&bar[XB_TOPGEN], 1u);
            else XB_SPIN(xb_ld(&bar[XB_TOPGEN]) == tg, bar);
            __builtin_amdgcn_fence(__ATOMIC_ACQUIRE, "agent");
            xb_add(&bar[XB_XGEN(b.x)], 1u);
            asm volatile("s_waitcnt vmcnt(0)" ::: "memory");
        } else {
            XB_SPIN(xb_ld(&bar[XB_XGEN(b.x)]) == gen, bar);
            __builtin_amdgcn_fence(__ATOMIC_ACQUIRE, "agent");
            asm volatile("s_waitcnt vmcnt(0)" ::: "memory");
        }
    }
    __syncthreads();
}


__device__ void ph_transpose(int wv, const float* __restrict__ src, bf16_t* __restrict__ dst, int K, int N, int Npad,
                             int col0, int skip_from, int skip, int nvalid, float* tile, int bid, int nb,
                             const float* kscale = nullptr, int kscale_n = 0) {
  const int tk = K / 64, tn = Npad / 64;
  const int tid = otid(wv);
  for (int t = bid; t < tk * tn; t += nb) {
    const int kt = t / tn, nt = t % tn;
    __syncthreads();
#pragma unroll
    for (int i = 0; i < 2; ++i) {
      const int idx = tid + i * 512, kk = idx >> 4, n4 = (idx & 15) * 4;
      const int k = kt * 64 + kk, n = nt * 64 + n4;
      const int cc = col0 + n + (n >= skip_from ? skip : 0);
      const float ks = (kscale != nullptr && k < kscale_n) ? kscale[k] : 1.f;
      float4 v = make_float4(0.f, 0.f, 0.f, 0.f);
      if (n < nvalid) v = *(const float4*)(src + (size_t)k * N + cc);
      tile[kk * 65 + n4 + 0] = v.x * ks; tile[kk * 65 + n4 + 1] = v.y * ks; tile[kk * 65 + n4 + 2] = v.z * ks; tile[kk * 65 + n4 + 3] = v.w * ks;
    }
    __syncthreads();
    {
      const int nn = tid >> 3, k8 = (tid & 7) * 8;
      float f[8];
#pragma unroll
      for (int e = 0; e < 8; ++e) f[e] = tile[(k8 + e) * 65 + nn];
      *(uint4*)(dst + (size_t)(nt * 64 + nn) * K + kt * 64 + k8) = make_uint4(pack2(f[0], f[1]), pack2(f[2], f[3]), pack2(f[4], f[5]), pack2(f[6], f[7]));
    }
  }
}

__device__ void ph_mod(int wv, const Params& P, float* sm, int bid, int nb) {
  const int tid = otid(wv);
  float* sv = sm;
  float* red = sm + 5 * 1024;
  for (int i = tid; i < 5 * 1024; i += NTHR) {
    const float v = (i < 4096) ? P.c[i] : P.c_ctx[i - 4096];
    sv[i] = silu_f(v);
  }
  __syncthreads();
  const int c4 = tid & 15, kg = tid >> 4;
  for (int it = bid; it < 192; it += nb) {
    const int layer = it / 96, cb = it % 96;
    const float4* W = (const float4*)(P.ada_w + (size_t)layer * 1024 * MODW + cb * 64) + c4;
    float4 a[5];
#pragma unroll
    for (int r = 0; r < 5; ++r) a[r] = make_float4(0.f, 0.f, 0.f, 0.f);
#pragma unroll 8
    for (int kk = 0; kk < 32; ++kk) {
      const int k = kg * 32 + kk;
      const float4 w = W[(size_t)k * (MODW / 4)];
#pragma unroll
      for (int r = 0; r < 5; ++r) {
        const float s = sv[r * 1024 + k];
        a[r].x += s * w.x; a[r].y += s * w.y; a[r].z += s * w.z; a[r].w += s * w.w;
      }
    }
#pragma unroll
    for (int r = 0; r < 5; ++r) *(float4*)(red + ((kg * 16 + c4) * 5 + r) * 4) = a[r];
    __syncthreads();
    if (tid < 320) {
      const int r = tid >> 6, c = tid & 63;
      float s = 0.f;
      for (int g = 0; g < 32; ++g) s += red[((g * 16 + (c >> 2)) * 5 + r) * 4 + (c & 3)];
      P.mod()[(size_t)(layer * 5 + r) * MODW + cb * 64 + c] = s + P.ada_b[layer * MODW + cb * 64 + c];
    }
    __syncthreads();
  }
}

__device__ void ph_norm(int wv, const float* hl, const float* hc, const float* __restrict__ g, const float* __restrict__ modl,
                        int shift_off, int scale_off, int nrows, bf16_t* __restrict__ dst, int bid, int nb) {
  const int wave = otid(wv) >> 6, lane = otid(wv) & 63;
  const int stride = nb * NWAVE;
  for (int row0 = bid * NWAVE + wave; row0 < nrows; row0 += 2 * stride) {
    const int row1 = row0 + stride;
    const bool two = row1 < nrows;
    const int rows[2] = {row0, two ? row1 : row0};
    f32x4 v[2][4], ggv[4], scv[2][4], shv[2][4];
#pragma unroll
    for (int r = 0; r < 2; ++r) {
      const float* src = hrow(hl, hc, rows[r]);
      const float* mr = modl + (size_t)modrow(rows[r]) * MODW;
#pragma unroll
      for (int i = 0; i < 4; ++i) {
        const int idx = i * 256 + lane * 4;
        v[r][i] = *(const f32x4*)(src + idx);
        scv[r][i] = *(const f32x4*)(mr + scale_off + idx); shv[r][i] = *(const f32x4*)(mr + shift_off + idx);
      }
    }
#pragma unroll
    for (int i = 0; i < 4; ++i) ggv[i] = *(const f32x4*)(g + i * 256 + lane * 4);
#pragma unroll
    for (int r = 0; r < 2; ++r)
#pragma unroll
      for (int i = 0; i < 4; ++i) asm volatile("" : "+v"(v[r][i]), "+v"(scv[r][i]), "+v"(shv[r][i]));
#pragma unroll
    for (int r = 0; r < 2; ++r) {
      float ss = 0.f;
#pragma unroll
      for (int i = 0; i < 4; ++i) ss += v[r][i][0] * v[r][i][0] + v[r][i][1] * v[r][i][1] + v[r][i][2] * v[r][i][2] + v[r][i][3] * v[r][i][3];
      ss = wave_sum(ss);
      const float rstd = rsqrtf(ss * (1.f / 1024.f) + 1e-6f);
      if (r == 0 || two) {
#pragma unroll
        for (int i = 0; i < 4; ++i) {
          const int idx = i * 256 + lane * 4;
          const float o0 = v[r][i][0] * rstd * ggv[i][0] * (1.f + scv[r][i][0]) + shv[r][i][0];
          const float o1 = v[r][i][1] * rstd * ggv[i][1] * (1.f + scv[r][i][1]) + shv[r][i][1];
          const float o2 = v[r][i][2] * rstd * ggv[i][2] * (1.f + scv[r][i][2]) + shv[r][i][2];
          const float o3 = v[r][i][3] * rstd * ggv[i][3] * (1.f + scv[r][i][3]) + shv[r][i][3];
          *(uint2*)(dst + (size_t)rows[r] * DM + idx) = make_uint2(pack2(o0, o1), pack2(o2, o3));
        }
      }
    }
  }
}

__device__ void ph_conv(int wv, const Params& P, int layer, int bid, int nb) {
  const float* cw = P.conv_w + (size_t)layer * 3 * 1536;
  const float* cb = P.conv_b + (size_t)layer * 1536;
  const int total = (NTOK / 4) * 192;
  for (int it = bid * NTHR + otid(wv); it < total; it += nb * NTHR) {
    const int rq = it / 192, c8 = (it % 192) * 8, row0 = rq * 4;
    int l, L;
    if (row0 < NLAT) { l = row0 & 4095; L = 4096; } else { l = (row0 - NLAT) & 255; L = 256; }
    const bf16_t* pc = P.p() + (size_t)row0 * PW + OFF_XBC + c8;
    u32x4_t rv[6];
    rv[0] = *(const u32x4_t*)(pc - (l > 0 ? PW : 0));
#pragma unroll
    for (int i = 0; i < 4; ++i) rv[1 + i] = *(const u32x4_t*)(pc + (size_t)i * PW);
    rv[5] = *(const u32x4_t*)(pc + (size_t)(l + 4 < L ? 4 : 3) * PW);
#pragma unroll
    for (int i = 0; i < 6; ++i) asm volatile("" : "+v"(rv[i]));
    float f[6][8];
#pragma unroll
    for (int i = 0; i < 6; ++i) unpack8(make_uint4(rv[i].x, rv[i].y, rv[i].z, rv[i].w), f[i]);
    const float mp = l > 0 ? 1.f : 0.f, mn = l + 4 < L ? 1.f : 0.f;
    float o[4][8];
#pragma unroll
    for (int e = 0; e < 8; ++e) {
      const int c = c8 + e;
      const float w0 = cw[c], w1 = cw[1536 + c], w2 = cw[3072 + c], bb = cb[c];
#pragma unroll
      for (int i = 0; i < 4; ++i) {
        const float pv = i == 0 ? mp * f[0][e] : f[i][e];
        const float nv = i == 3 ? mn * f[5][e] : f[i + 2][e];
        o[i][e] = silu_f(bb + w0 * pv + w1 * f[i + 1][e] + w2 * nv);
      }
    }
    if (c8 < 1024) {
      const int head = c8 >> 6, p0 = c8 & 63;
      bf16_t* dst = P.xt4() + (((size_t)head * (NTOK / 4) + rq) * 64 + p0) * 4;
#pragma unroll
      for (int e2 = 0; e2 < 4; ++e2)
        *(uint4*)(dst + e2 * 8) = make_uint4(pack2(o[0][2 * e2], o[1][2 * e2]), pack2(o[2][2 * e2], o[3][2 * e2]),
                                             pack2(o[0][2 * e2 + 1], o[1][2 * e2 + 1]), pack2(o[2][2 * e2 + 1], o[3][2 * e2 + 1]));
    } else {
      {
        const int cc = (c8 - 1024) & 255, grp_ = cc >> 7, n0_ = cc & 127;
        bf16_t* fb = (c8 < 1280 ? P.bfr() : P.cfr()) + ((((size_t)grp_ * (NTOK / 16) + (row0 >> 4)) * 4 + (n0_ >> 5)) * 16 + (row0 & 15)) * 32 + (n0_ & 31);
#pragma unroll
        for (int i = 0; i < 4; ++i)
          *(uint4*)(fb + i * 32) = make_uint4(pack2(o[i][0], o[i][1]), pack2(o[i][2], o[i][3]), pack2(o[i][4], o[i][5]), pack2(o[i][6], o[i][7]));
      }
      if (c8 < 1280) {
        const int grp = (c8 - 1024) >> 7, n0 = (c8 - 1024) & 127;
        bf16_t* dst = P.bt4() + (((size_t)grp * (NTOK / 4) + rq) * 128 + n0) * 4;
#pragma unroll
        for (int e2 = 0; e2 < 4; ++e2)
          *(uint4*)(dst + e2 * 8) = make_uint4(pack2(o[0][2 * e2], o[1][2 * e2]), pack2(o[2][2 * e2], o[3][2 * e2]),
                                               pack2(o[0][2 * e2 + 1], o[1][2 * e2 + 1]), pack2(o[2][2 * e2 + 1], o[3][2 * e2 + 1]));
      }
    }
  }
}

__device__ void ph_dtprep(int wv, const Params& P, int layer, char* smem, int first, int step) {
  const int tid = otid(wv), lane = tid & 63, li = lane & 15, g = lane >> 4;
  float* tile = (float*)smem;
  float* segtot = tile + 128 * 33;
  const int dh = tid & 31, seg = tid >> 5;
  const float bias = P.dt_bias[layer * 32 + dh];
  const float ah = -expf(P.a_log[layer * 32 + dh]);
  const bf16_t* wb = P.w_dtT() + (size_t)layer * 128 * 1024 + (size_t)li * 1024 + 8 * g;
  for (int gc = first; gc < NCHUNK; gc += step) {
    const bf16_t* ua = P.u() + (size_t)(gc * 128 + wv * 16 + li) * DM + 8 * g;
    f32x4 acc0 = (f32x4){0.f, 0.f, 0.f, 0.f}, acc1 = acc0;
#pragma unroll 1
    for (int t0 = 0; t0 < 32; t0 += 8) {
      bf16x8 a[8], b0[8], b1[8];
#pragma unroll
      for (int t = 0; t < 8; ++t) {
        a[t] = *(const bf16x8*)(ua + 32 * (t0 + t));
        b0[t] = *(const bf16x8*)(wb + 32 * (t0 + t));
        b1[t] = *(const bf16x8*)(wb + 16 * 1024 + 32 * (t0 + t));
      }
#pragma unroll
      for (int t = 0; t < 8; ++t) asm volatile("" : "+v"(a[t]), "+v"(b0[t]), "+v"(b1[t]));
#pragma unroll
      for (int t = 0; t < 8; ++t) {
        acc0 = __builtin_amdgcn_mfma_f32_16x16x32_bf16(a[t], b0[t], acc0, 0, 0, 0);
        acc1 = __builtin_amdgcn_mfma_f32_16x16x32_bf16(a[t], b1[t], acc1, 0, 0, 0);
      }
    }
    __syncthreads();
#pragma unroll
    for (int e = 0; e < 4; ++e) {
      tile[(wv * 16 + 4 * g + e) * 33 + li] = acc0[e];
      tile[(wv * 16 + 4 * g + e) * 33 + 16 + li] = acc1[e];
    }
    __syncthreads();
    float r[8], c[8];
    float cs = 0.f;
#pragma unroll
    for (int j = 0; j < 8; ++j) { r[j] = softplus_f(tile[(seg * 8 + j) * 33 + dh] + bias); cs += r[j] * ah; c[j] = cs; }
    segtot[seg * 32 + dh] = cs;
    __syncthreads();
    float off = 0.f, tot = 0.f;
    for (int s = 0; s < 16; ++s) { const float v = segtot[s * 32 + dh]; if (s < seg) off += v; tot += v; }
    const size_t base = ((size_t)(gc * 32 + dh) * 128 + seg * 8);
    float cso[8], wso[8];
#pragma unroll
    for (int j = 0; j < 8; ++j) {
      const float csj = off + c[j], csp = j == 0 ? off : off + c[j - 1];
      cso[j] = dh < 16 ? csj : csp;
      wso[j] = r[j] * (dh < 16 ? fexp(tot - csj) : fexp(csp));
    }
#pragma unroll
    for (int q = 0; q < 2; ++q) {
      *(float4*)(P.cst() + base + q * 4) = make_float4(cso[q * 4], cso[q * 4 + 1], cso[q * 4 + 2], cso[q * 4 + 3]);
      *(float4*)(P.dtt() + base + q * 4) = make_float4(r[q * 4], r[q * 4 + 1], r[q * 4 + 2], r[q * 4 + 3]);
      *(float4*)(P.wst() + base + q * 4) = make_float4(wso[q * 4], wso[q * 4 + 1], wso[q * 4 + 2], wso[q * 4 + 3]);
    }
    if (seg == 0) P.atot()[gc * 32 + dh] = tot;
  }
}

__device__ __forceinline__ int scan_chunk(int b, int dir, int s) {
  if (dir == 0) return (s < 2) ? (128 + 2 * b + s) : (32 * b + (s - 2));
  return (s < 2) ? (128 + 2 * b + 1 - s) : (32 * b + 31 - (s - 2));
}
__device__ void ph_scan(int wv, const Params& P, int bid, int nb) {
  const int total = 4 * 32 * 1024;
  for (int it = bid * NTHR + otid(wv); it < total; it += nb * NTHR) {
    const int e8 = it & 1023, dh = (it >> 10) & 31, b = it >> 15, dir = dh >> 4;
    float S[8];
    float zero_ = 0.f;
    asm volatile("" : "+v"(zero_));
#pragma unroll
    for (int i = 0; i < 8; ++i) S[i] = zero_;
#pragma unroll
    for (int hb = 0; hb < 2; ++hb) {
      u32x4_t v[17];
      float at[17];
#pragma unroll
      for (int s = 0; s < 17; ++s) {
        const int gc = scan_chunk(b, dir, hb * 17 + s);
        v[s] = *(const u32x4_t*)(P.states() + (size_t)(gc * 32 + dh) * 8192 + e8 * 8);
        at[s] = P.atot()[gc * 32 + dh];
      }
#pragma unroll
      for (int s = 0; s < 17; ++s) asm volatile("" : "+v"(v[s]));
#pragma unroll
      for (int s = 0; s < 17; ++s) {
        const int gc = scan_chunk(b, dir, hb * 17 + s);
        const float dec = fexp(at[s]);
        float cst[8];
        unpack8(make_uint4(v[s].x, v[s].y, v[s].z, v[s].w), cst);
        *(uint4*)(P.states() + (size_t)(gc * 32 + dh) * 8192 + e8 * 8) =
            make_uint4(pack2(S[0], S[1]), pack2(S[2], S[3]), pack2(S[4], S[5]), pack2(S[6], S[7]));
#pragma unroll
        for (int i = 0; i < 8; ++i) S[i] = dec * S[i] + cst[i];
      }
    }
  }
}

__device__ __forceinline__ void conv_x8(const Params& P, int layer, int row, int ch0, float* out) {
  int l, L;
  if (row < NLAT) { l = row & 4095; L = 4096; } else { l = (row - NLAT) & 255; L = 256; }
  const bf16_t* pc = P.p() + (size_t)row * PW + OFF_XBC + ch0;
  const uint4 cur = *(const uint4*)pc;
  const uint4 prv = *(const uint4*)(pc - (l > 0 ? PW : 0));
  const uint4 nxt = *(const uint4*)(pc + (l < L - 1 ? PW : 0));
  const float mp = l > 0 ? 1.f : 0.f, mn = l < L - 1 ? 1.f : 0.f;
  float fp[8], fc[8], fn[8];
  unpack8(prv, fp); unpack8(cur, fc); unpack8(nxt, fn);
  const float* cw = P.conv_w + (size_t)layer * 3 * 1536 + ch0;
  const float* cb = P.conv_b + (size_t)layer * 1536 + ch0;
#pragma unroll
  for (int e = 0; e < 8; ++e) out[e] = silu_f(cb[e] + cw[e] * (mp * fp[e]) + cw[1536 + e] * fc[e] + cw[3072 + e] * (mn * fn[e]));
}

constexpr int XS = 72;
constexpr int BS = 136;


__device__ __forceinline__ bool ssd_item(int round, int bid, int nb, int nchunks, int& gc, int& head) {
  if ((nb & 63) == 0) {
    const int x = bid & 7, j = bid >> 3, per = nb >> 6;
    const int cg = (round * per + (j >> 3)) * 8 + x;
    if (cg >= nchunks * 2) return false;
    gc = cg >> 1; head = (cg & 1) * 8 + (j & 7);
    return true;
  }
  const int it = round * nb + bid;
  if (it >= nchunks * 16) return false;
  gc = it >> 4; head = it & 15;
  return true;
}

__device__ void ph_states_mfma(int wv, const Params& P, int layer, char* smem, int bid, int nb) {
  const int lane = otid(wv) & 63, li = lane & 15, g = lane >> 4;
  const int nq = wv >> 1, ph = wv & 1;
  for (int round = 0;; ++round) {
    int gc, head;
    if (!ssd_item(round, bid, nb, NCHUNK, gc, head)) break;
    const int grp = head >> 3, q0 = gc * 32;
    const bf16_t* xb = P.xt4() + (((size_t)head * (NTOK / 4) + q0 + g) * 64 + ph * 32 + li) * 4;
    const bf16_t* bb = P.bt4() + (((size_t)grp * (NTOK / 4) + q0 + g) * 128 + nq * 32 + li) * 4;
    const float* wpf = P.wst() + (size_t)(gc * 32 + head) * 128 + 4 * g;
    const float* wpb = wpf + 16 * 128;
    f32x4 acc[2][2][2];
#pragma unroll
    for (int d = 0; d < 2; ++d)
#pragma unroll
      for (int a = 0; a < 2; ++a)
#pragma unroll
        for (int b = 0; b < 2; ++b) acc[d][a][b] = (f32x4){0.f, 0.f, 0.f, 0.f};
#pragma unroll
    for (int t = 0; t < 4; ++t) {
      s16x4 alo[2], ahi[2], xlo[2], xhi[2];
      f32x4 wfl, wfh, wbl, wbh;
#pragma unroll
      for (int i = 0; i < 2; ++i) {
        alo[i] = *(const s16x4*)(bb + ((size_t)(t * 8) * 128 + i * 16) * 4);
        ahi[i] = *(const s16x4*)(bb + ((size_t)(t * 8 + 4) * 128 + i * 16) * 4);
        xlo[i] = *(const s16x4*)(xb + ((size_t)(t * 8) * 64 + i * 16) * 4);
        xhi[i] = *(const s16x4*)(xb + ((size_t)(t * 8 + 4) * 64 + i * 16) * 4);
      }
      wfl = *(const f32x4*)(wpf + 32 * t); wfh = *(const f32x4*)(wpf + 32 * t + 16);
      wbl = *(const f32x4*)(wpb + 32 * t); wbh = *(const f32x4*)(wpb + 32 * t + 16);
      asm volatile("" : "+v"(alo[0]), "+v"(alo[1]), "+v"(ahi[0]), "+v"(ahi[1]));
      bf16x8 af[2];
#pragma unroll
      for (int i = 0; i < 2; ++i) af[i] = (bf16x8){alo[i][0], alo[i][1], alo[i][2], alo[i][3], ahi[i][0], ahi[i][1], ahi[i][2], ahi[i][3]};
#pragma unroll
      for (int d = 0; d < 2; ++d) {
        const f32x4 wl = d == 0 ? wfl : wbl, wh = d == 0 ? wfh : wbh;
#pragma unroll
        for (int b = 0; b < 2; ++b) {
          bf16x8 bfrag;
#pragma unroll
          for (int i = 0; i < 4; ++i) {
            bfrag[i] = (short)f2bf(bf2f((bf16_t)xlo[b][i]) * wl[i]);
            bfrag[4 + i] = (short)f2bf(bf2f((bf16_t)xhi[b][i]) * wh[i]);
          }
#pragma unroll
          for (int a = 0; a < 2; ++a) acc[d][a][b] = __builtin_amdgcn_mfma_f32_16x16x32_bf16(af[a], bfrag, acc[d][a][b], 0, 0, 0);
        }
      }
    }
#pragma unroll
    for (int d = 0; d < 2; ++d) {
      bf16_t* dst = P.states() + (size_t)(gc * 32 + d * 16 + head) * 8192;
#pragma unroll
      for (int a = 0; a < 2; ++a)
#pragma unroll
        for (int b = 0; b < 2; ++b) {
          uint2 o;
          o.x = pack2(acc[d][a][b][0], acc[d][a][b][1]); o.y = pack2(acc[d][a][b][2], acc[d][a][b][3]);
          *(uint2*)(dst + ((nq * 4 + 2 * ph + b) * 16 + li) * 32 + 16 * a + 4 * g) = o;
        }
    }
  }
}

__device__ void ph_ssdy_mfma(int wv, const Params& P, int layer, int nchunks, char* smem, int bid, int nb) {
  const int tid = otid(wv), lane = tid & 63, li = lane & 15, g = lane >> 4;
  float* tabs = (float*)smem;
  char* bbuf = smem + 4096;
  char* xbuf = bbuf + 65536;
  char* sbufS = xbuf + 32768;
  u32x4_t pf[10];
  float pft = 0.f;
#pragma unroll
  for (int i = 0; i < 10; ++i) pf[i] = (u32x4_t){0u, 0u, 0u, 0u};
#define SSDY_FETCH(gc_, head_) do { const int grp_ = (head_) >> 3; \
      const char* bsrc_ = (const char*)(P.bfr() + ((size_t)grp_ * (NTOK / 16) + (gc_) * 8) * 4 * 16 * 32); \
      const char* xsrc_ = (const char*)(P.xt4() + ((size_t)(head_) * (NTOK / 4) + (gc_) * 32) * 64 * 4); \
      _Pragma("unroll") for (int i_ = 0; i_ < 4; ++i_) pf[i_] = *(const u32x4_t*)(bsrc_ + (size_t)(tid + i_ * 512) * 16); \
      _Pragma("unroll") for (int i_ = 0; i_ < 2; ++i_) pf[4 + i_] = *(const u32x4_t*)(xsrc_ + (size_t)(tid + i_ * 512) * 16); \
      _Pragma("unroll") for (int i_ = 0; i_ < 4; ++i_) { const int c_ = tid + i_ * 512; \
        pf[6 + i_] = *(const u32x4_t*)((const char*)(P.states() + (size_t)((gc_) * 32 + (c_ >> 10) * 16 + (head_)) * 8192) + (size_t)(c_ & 1023) * 16); } \
      { const int arr_ = tid >> 7, j_ = tid & 127; \
        pft = ((arr_ & 1) ? P.dtt() : P.cst())[(size_t)((gc_) * 32 + (arr_ >> 1) * 16 + (head_)) * 128 + j_]; } } while (0)
#define SSDY_PUT_S() do { _Pragma("unroll") for (int i_ = 0; i_ < 4; ++i_) *(u32x4_t*)(sbufS + (size_t)(tid + i_ * 512) * 16) = pf[6 + i_]; } while (0)
#define SSDY_PUT_BX(buf_) do { \
      _Pragma("unroll") for (int i_ = 0; i_ < 4; ++i_) *(u32x4_t*)(bbuf + (buf_) * 32768 + (size_t)(tid + i_ * 512) * 16) = pf[i_]; \
      _Pragma("unroll") for (int i_ = 0; i_ < 2; ++i_) *(u32x4_t*)(xbuf + (buf_) * 16384 + (size_t)(tid + i_ * 512) * 16) = pf[4 + i_]; \
      tabs[(buf_) * 512 + tid] = pft; } while (0)
  {
    int gc0 = 0, head0 = 0;
    __syncthreads();
    if (ssd_item(0, bid, nb, nchunks, gc0, head0)) { SSDY_FETCH(gc0, head0); SSDY_PUT_BX(0); SSDY_PUT_S(); }
    __syncthreads();
  }
  for (int round = 0;; ++round) {
    int gc, head;
    if (!ssd_item(round, bid, nb, nchunks, gc, head)) break;
    const int grp = head >> 3, row0 = gc * 128;
    const char* bs = bbuf + (round & 1) * 32768;
    const char* xs_l = xbuf + (round & 1) * 16384;
    const float* csf = tabs + (round & 1) * 512;
    const float* dtf = csf + 128;
    const float* exb = csf + 256;
    const float* dtb = csf + 384;
    int gcn = 0, headn = 0;
    const bool has_next = ssd_item(round + 1, bid, nb, nchunks, gcn, headn);
    if (has_next) SSDY_FETCH(gcn, headn);
    const float atb = P.atot()[gc * 32 + 16 + head];
    bf16x8 cfrag[4];
    {
      const bf16_t* cp = P.cfr() + ((((size_t)grp * (NTOK / 16) + gc * 8 + wv) * 4) * 16 + li) * 32 + 8 * g;
#pragma unroll
      for (int t = 0; t < 4; ++t) cfrag[t] = *(const bf16x8*)(cp + t * 512);
    }
    f32x4 accG[8];
#pragma unroll
    for (int sb = 0; sb < 8; ++sb) accG[sb] = (f32x4){0.f, 0.f, 0.f, 0.f};
#pragma unroll
    for (int sp = 0; sp < 4; ++sp) {
      bf16x8 bfv[8];
#pragma unroll
      for (int i = 0; i < 8; ++i) {
        const int sb = sp * 2 + (i >> 2), t = i & 3;
        bfv[i] = *(const bf16x8*)(bs + (((sb * 4 + t) * 16 + li) * 32 + 8 * g) * 2);
      }
#pragma unroll
      for (int i = 0; i < 8; ++i) {
        const int sb = sp * 2 + (i >> 2), t = i & 3;
        accG[sb] = __builtin_amdgcn_mfma_f32_16x16x32_bf16(bfv[i], cfrag[t], accG[sb], 0, 0, 0);
      }
    }
    f32x4 accY[4];
#pragma unroll
    for (int pb = 0; pb < 4; ++pb) accY[pb] = (f32x4){0.f, 0.f, 0.f, 0.f};
    const int jl = 16 * wv + li;
    const float csf_j = csf[jl], exb_j = exb[jl];
#pragma unroll
    for (int dir = 0; dir < 2; ++dir) {
      f32x4 accO[4];
#pragma unroll
      for (int pb = 0; pb < 4; ++pb) accO[pb] = (f32x4){0.f, 0.f, 0.f, 0.f};
      const char* st = sbufS + dir * 16384;
#pragma unroll
      for (int th = 0; th < 2; ++th) {
        bf16x8 sfr[8];
#pragma unroll
        for (int i = 0; i < 8; ++i) sfr[i] = *(const bf16x8*)(st + (((th * 2 + (i >> 2)) * 4 + (i & 3)) * 512 + li * 32 + 8 * g) * 2);
#pragma unroll
        for (int tt = 0; tt < 2; ++tt)
#pragma unroll
          for (int pb = 0; pb < 4; ++pb) accO[pb] = __builtin_amdgcn_mfma_f32_16x16x32_bf16(cfrag[th * 2 + tt], sfr[tt * 4 + pb], accO[pb], 0, 0, 0);
      }
#pragma unroll
      for (int e = 0; e < 4; ++e) {
        const int j = 16 * wv + 4 * g + e;
        const float sc = dir == 0 ? fexp(csf[j]) : fexp(atb - exb[j]);
#pragma unroll
        for (int pb = 0; pb < 4; ++pb) accY[pb][e] += accO[pb][e] * sc;
      }
    }
    __syncthreads();
    if (has_next) SSDY_PUT_S();
    const char* xq = xs_l + ((g * 64 + li) * 4) * 2;
#pragma unroll
    for (int t = 0; t < 4; ++t) {
      const bool need_f = !(32 * t > 16 * wv + 15), need_b = !(32 * t + 31 < 16 * wv);
      if (!need_f && !need_b) continue;
      s16x4 xlo[4], xhi[4];
#pragma unroll
      for (int pb = 0; pb < 4; ++pb) {
        xlo[pb] = *(const s16x4*)(xq + (((8 * t) * 64 + 16 * pb) * 4) * 2);
        xhi[pb] = *(const s16x4*)(xq + (((8 * t + 4) * 64 + 16 * pb) * 4) * 2);
      }
#pragma unroll
      for (int dir = 0; dir < 2; ++dir) {
        if (dir == 0 ? !need_f : !need_b) continue;
        bf16x8 afrag;
#pragma unroll
        for (int hh = 0; hh < 2; ++hh) {
          const int s0 = 32 * t + 16 * hh + 4 * g;
          const f32x4 gv = accG[2 * t + hh];
          const f32x4 cv = dir == 0 ? *(const f32x4*)(csf + s0) : *(const f32x4*)(exb + s0);
          const f32x4 dv = dir == 0 ? *(const f32x4*)(dtf + s0) : *(const f32x4*)(dtb + s0);
#pragma unroll
          for (int e = 0; e < 4; ++e) {
            const int s = s0 + e;
            float m;
            if (dir == 0) m = (s <= jl) ? gv[e] * dv[e] * fexp(csf_j - cv[e]) : 0.f;
            else m = (s >= jl) ? gv[e] * dv[e] * fexp(cv[e] - exb_j) : 0.f;
            afrag[hh * 4 + e] = (short)f2bf(m);
          }
        }
#pragma unroll
        for (int pb = 0; pb < 4; ++pb) {
          const bf16x8 bfr2 = (bf16x8){xlo[pb][0], xlo[pb][1], xlo[pb][2], xlo[pb][3], xhi[pb][0], xhi[pb][1], xhi[pb][2], xhi[pb][3]};
          accY[pb] = __builtin_amdgcn_mfma_f32_16x16x32_bf16(afrag, bfr2, accY[pb], 0, 0, 0);
        }
      }
    }
    const float dsk = P.d_skip[layer * 16 + head];
    s16x4 xs[4];
#pragma unroll
    for (int pb = 0; pb < 4; ++pb) xs[pb] = *(const s16x4*)(xs_l + ((((4 * wv + g) * 64 + 16 * pb + li) * 4) * 2));
    unsigned zv[16];
#pragma unroll
    for (int e = 0; e < 4; ++e)
#pragma unroll
      for (int pb = 0; pb < 4; ++pb)
        zv[e * 4 + pb] = P.p()[(size_t)(row0 + 16 * wv + 4 * g + e) * PW + OFF_Z + head * 64 + 16 * pb + li];
#pragma unroll
    for (int i = 0; i < 16; ++i) asm volatile("" : "+v"(zv[i]));
#pragma unroll
    for (int e = 0; e < 4; ++e) {
      const int row = row0 + 16 * wv + 4 * g + e;
      float sq = 0.f;
#pragma unroll
      for (int pb = 0; pb < 4; ++pb) {
        const float xv = bf2f((bf16_t)xs[pb][e]);
        const float z = bf2f((bf16_t)zv[e * 4 + pb]);
        const bf16_t yb = f2bf((accY[pb][e] + dsk * xv) * silu_f(z));
        P.concat()[(size_t)row * 2048 + head * 64 + 16 * pb + li] = yb;
        const float yf = bf2f(yb);
        sq += yf * yf;
      }
      sq += DPP_F(sq, 0xB1); sq += DPP_F(sq, 0x4E); sq += DPP_F(sq, 0x141); sq += DPP_F(sq, 0x140);
      if (li == 0) P.yss()[(size_t)row * 16 + head] = sq;
    }
    if (has_next) SSDY_PUT_BX((round + 1) & 1);
    __syncthreads();
  }
#undef SSDY_FETCH
#undef SSDY_PUT_S
#undef SSDY_PUT_BX
}

template <int W>
__device__ __forceinline__ void pool_frags(const bf16_t* pc, int l, int L, float rc, bf16x8 (&af)[4]) {
#pragma unroll
  for (int t = 0; t < 4; ++t) {
    constexpr int WB = W < 8 ? W : 8;
    float s[8], f[8];
#pragma unroll
    for (int e = 0; e < 8; ++e) s[e] = 0.f;
    const u32x4_t own = *(const u32x4_t*)(pc + 32 * t);
#pragma unroll
    for (int ob = 0; ob < W; ob += WB) {
      u32x4_t rows[WB];
#pragma unroll
      for (int o = 0; o < WB; ++o) {
        const int rr = l - W / 2 + ob + o;
        const int rcl = (rr >= 0 && rr < L) ? rr : l;
        rows[o] = *(const u32x4_t*)(pc + (ptrdiff_t)(rcl - l) * PW + 32 * t);
      }
#pragma unroll
      for (int o = 0; o < WB; ++o) asm volatile("" : "+v"(rows[o]));
#pragma unroll
      for (int o = 0; o < WB; ++o) {
        const int rr = l - W / 2 + ob + o;
        const float mk = (rr >= 0 && rr < L) ? 1.f : 0.f;
        unpack8(make_uint4(rows[o].x, rows[o].y, rows[o].z, rows[o].w), f);
#pragma unroll
        for (int e = 0; e < 8; ++e) s[e] += mk * f[e];
      }
    }
    unpack8(make_uint4(own.x, own.y, own.z, own.w), f);
#pragma unroll
    for (int e = 0; e < 8; ++e) af[t][e] = (short)f2bf(s[e] * rc - f[e]);
  }
}
__device__ void ph_pool_mfma(int wv, const Params& P, int layer, int nrows, char* smem, int bid, int nb) {
  const int lane = otid(wv) & 63, li = lane & 15, g = lane >> 4;
  bf16_t* stg = (bf16_t*)(smem + 65536) + wv * (16 * 136);
  const int nitems = (nrows / 16) * 4;
  for (int it = bid * NWAVE + wv; it < nitems; it += nb * NWAVE) {
    const int gi = it & 3, row0 = (it >> 2) * 16, w = 2 << gi;
    const int row = row0 + li;
    int l, L;
    if (row < NLAT) { l = row & 4095; L = 4096; } else { l = (row - NLAT) & 255; L = 256; }
    int lo = l - w / 2; lo = lo < 0 ? 0 : lo;
    int hi = l + w - w / 2 - 1; hi = hi > L - 1 ? L - 1 : hi;
    const float rc = 1.f / (float)(hi - lo + 1);
    const bf16_t* pc = P.p() + (size_t)row * PW + OFF_POOL + gi * 128 + 8 * g;
    bf16x8 af[4];
    if (gi == 0) pool_frags<2>(pc, l, L, rc, af);
    else if (gi == 1) pool_frags<4>(pc, l, L, rc, af);
    else if (gi == 2) pool_frags<8>(pc, l, L, rc, af);
    else pool_frags<16>(pc, l, L, rc, af);
    const bf16_t* wt = P.poolwT() + ((size_t)(layer * 4 + gi) * 128 + li) * 128 + 8 * g;
    const float* sc = P.pool_scale + layer * 512 + gi * 128;
#pragma unroll
    for (int nh = 0; nh < 4; ++nh) {
      bf16x8 wf[2][4];
#pragma unroll
      for (int n = 0; n < 2; ++n)
#pragma unroll
        for (int t = 0; t < 4; ++t) wf[n][t] = *(const bf16x8*)(wt + (size_t)(nh * 2 + n) * 16 * 128 + 32 * t);
#pragma unroll
      for (int n = 0; n < 2; ++n)
#pragma unroll
        for (int t = 0; t < 4; ++t) asm volatile("" : "+v"(wf[n][t]));
#pragma unroll
      for (int n = 0; n < 2; ++n) {
        const int nt = nh * 2 + n;
        f32x4 acc = (f32x4){0.f, 0.f, 0.f, 0.f};
#pragma unroll
        for (int t = 0; t < 4; ++t) acc = __builtin_amdgcn_mfma_f32_16x16x32_bf16(af[t], wf[n][t], acc, 0, 0, 0);
        const float scv = sc[nt * 16 + li];
#pragma unroll
        for (int e = 0; e < 4; ++e) stg[(4 * g + e) * 136 + nt * 16 + li] = f2bf(acc[e] * scv);
      }
    }
    __builtin_amdgcn_wave_barrier();
#pragma unroll
    for (int i = 0; i < 4; ++i) {
      const int c = i * 64 + lane, rr = c >> 4, c8 = (c & 15) * 8;
      *(uint4*)(P.concat() + (size_t)(row0 + rr) * 2048 + 1024 + gi * 128 + c8) = *(const uint4*)(stg + rr * 136 + c8);
    }
    __builtin_amdgcn_wave_barrier();
  }
}

__device__ void ph_vtranspose(int wv, const Params& P, char* smem, int bid, int nb) {
  const int lane = otid(wv) & 63;
  bf16_t* tile = (bf16_t*)smem + wv * 64 * 72;
  for (int it = bid * NWAVE + wv; it < 272 * 8; it += nb * NWAVE) {
    const int hd = it & 7, tt = it >> 3, row0 = tt * 64;
    const bf16_t* src = P.p() + (size_t)(row0 + lane) * PW + OFF_V + hd * 64;
#pragma unroll
    for (int i = 0; i < 8; ++i) *(uint4*)(tile + lane * 72 + i * 8) = *(const uint4*)(src + i * 8);
    __builtin_amdgcn_wave_barrier();
    bf16_t* dst;
    if (row0 < NLAT) dst = P.vtl() + (size_t)((row0 >> 12) * 8 + hd) * 64 * 4096 + ((size_t)((row0 & 4095) >> 2) * 64 + lane) * 4;
    else dst = P.vtc() + (size_t)(((row0 - NLAT) >> 8) * 8 + hd) * 64 * 256 + ((size_t)(((row0 - NLAT) & 255) >> 2) * 64 + lane) * 4;
#pragma unroll
    for (int i = 0; i < 16; ++i) {
      uint2 w;
      w.x = (uint32_t)tile[(i * 4 + 0) * 72 + lane] | ((uint32_t)tile[(i * 4 + 1) * 72 + lane] << 16);
      w.y = (uint32_t)tile[(i * 4 + 2) * 72 + lane] | ((uint32_t)tile[(i * 4 + 3) * 72 + lane] << 16);
      *(uint2*)(dst + (size_t)i * 64 * 4) = w;
    }
    __builtin_amdgcn_wave_barrier();
    {
      const bf16_t* ksrc = P.p() + (size_t)(row0 + lane) * PW + OFF_K + hd * 64;
      u32x4_t kv[8];
#pragma unroll
      for (int i = 0; i < 8; ++i) kv[i] = *(const u32x4_t*)(ksrc + i * 8);
      bf16_t* kd;
      int tk;
      if (row0 < NLAT) { tk = (row0 & 4095) + lane; kd = P.ktl() + (size_t)((row0 >> 12) * 8 + hd) * 4096 * 64; }
      else { tk = ((row0 - NLAT) & 255) + lane; kd = P.ktc() + (size_t)(((row0 - NLAT) >> 8) * 8 + hd) * 256 * 64; }
#pragma unroll
      for (int i = 0; i < 8; ++i)
        *(u32x4_t*)(kd + ((size_t)((tk >> 3) * 2 + (i >> 2)) * 8 + (tk & 7)) * 32 + (i & 3) * 8) = kv[i];
    }
  }
}

__device__ __forceinline__ float grp_max(float v) {
  auto a = __builtin_amdgcn_permlane16_swap(__float_as_uint(v), __float_as_uint(v), false, false);
  v = fmaxf(__uint_as_float(a[0]), __uint_as_float(a[1]));
  auto b = __builtin_amdgcn_permlane32_swap(__float_as_uint(v), __float_as_uint(v), false, false);
  return fmaxf(__uint_as_float(b[0]), __uint_as_float(b[1]));
}
__device__ __forceinline__ float grp_sum(float v) {
  auto a = __builtin_amdgcn_permlane16_swap(__float_as_uint(v), __float_as_uint(v), false, false);
  v = __uint_as_float(a[0]) + __uint_as_float(a[1]);
  auto b = __builtin_amdgcn_permlane32_swap(__float_as_uint(v), __float_as_uint(v), false, false);
  return __uint_as_float(b[0]) + __uint_as_float(b[1]);
}

__device__ void ph_na_mfma(int wv, const Params& P, int layer, int nrows, char* smem, int bid, int nb) {
  const int lane = otid(wv) & 63, li = lane & 15, g = lane >> 4;
  float* btab = (float*)smem + wv * 256;
  const float* rpb = P.na_rpb + (size_t)layer * 8 * 15 * 31;
  const int n_lat = 4 * 64 * 8 * 4;
  const int n_items = n_lat + (nrows > NLAT ? 4 * 16 * 8 : 0);
  const int nrank = nb >> 3;
  const bool xmap = ((nb & 7) == 0) && nrank > 0 && (1024 % nrank) == 0 && (64 % nrank) == 0;
  const int per_lat = xmap ? 1024 / nrank : 0, per_ctx = (xmap && nrows > NLAT) ? 64 / nrank : 0;
  const int q_begin = xmap ? wv : bid * NWAVE + wv, q_end = xmap ? per_lat + per_ctx : n_items, q_step = xmap ? NWAVE : nb * NWAVE;
  for (int q = q_begin; q < q_end; q += q_step) {
    bool lat;
    int b, hd, qrow0, r = 0, cq0 = 0, r0 = 0, cs = 0, qt;
    if (xmap) {
      hd = bid & 7;
      const int rank = bid >> 3;
      lat = q < per_lat;
      if (lat) { const int i = rank * per_lat + q; qt = i & 3; r = (i >> 2) & 63; b = i >> 8; }
      else { const int c = rank * per_ctx + (q - per_lat); qt = c & 15; b = c >> 4; }
    } else {
      lat = q < n_lat;
      if (lat) { qt = q & 3; hd = (q >> 2) & 7; r = (q >> 5) & 63; b = q >> 11; }
      else { const int t = q - n_lat; hd = t & 7; qt = (t >> 3) & 15; b = t >> 7; }
    }
    if (lat) {
      cq0 = qt * 16; qrow0 = b * 4096 + r * 64 + cq0;
      r0 = r - 4; r0 = r0 < 0 ? 0 : (r0 > 56 ? 56 : r0);
      int clo = cq0 - 8; clo = clo < 0 ? 0 : (clo > 48 ? 48 : clo);
      cs = clo < 32 ? clo : 32;
    } else {
      qrow0 = NLAT + b * 256 + qt * 16;
    }
    const bf16_t* qp = P.p() + (size_t)(qrow0 + li) * PW + OFF_Q + hd * 64 + 8 * g;
    const bf16x8 qf0 = *(const bf16x8*)qp, qf1 = *(const bf16x8*)(qp + 32);
    __builtin_amdgcn_wave_barrier();
#pragma unroll
    for (int i = 0; i < 4; ++i) {
      const int e_ = i * 64 + lane, kr_ = e_ >> 5, dc_ = e_ & 31;
      int dr_ = r0 + kr_ - r + 7; dr_ = dr_ < 0 ? 0 : (dr_ > 14 ? 14 : dr_);
      btab[e_] = rpb[(hd * 15 + dr_) * 31 + (dc_ < 31 ? dc_ : 30)];
    }
    __builtin_amdgcn_wave_barrier();
    f32x4 accS[16], accC[16];
    const int k_lane = ((li >> 3) * 16 + (li & 7)) * 32 + 8 * g;
    const bf16_t* klb = P.ktl() + (size_t)(b * 8 + hd) * 4096 * 64 + k_lane;
    const bf16_t* kcb = P.ktc() + (size_t)(b * 8 + hd) * 256 * 64 + k_lane;
#define NA_KPTR(tile) ((tile) < 16 ? klb + ((r0 + ((tile) >> 1)) * 64 + cs + 16 * ((tile) & 1)) * 64 : kcb + (16 * ((tile) - 16)) * 64)
    bf16x8 kA[2][2], kB[2][2];
#pragma unroll
    for (int i = 0; i < 2; ++i) { const bf16_t* kp = NA_KPTR(i); kA[i][0] = *(const bf16x8*)kp; kA[i][1] = *(const bf16x8*)(kp + 256); }
#pragma unroll
    for (int tb = 0; tb < 32; tb += 4) {
#pragma unroll
      for (int i = 0; i < 2; ++i) { const bf16_t* kp = NA_KPTR(tb + 2 + i); kB[i][0] = *(const bf16x8*)kp; kB[i][1] = *(const bf16x8*)(kp + 256); }
#pragma unroll
      for (int i = 0; i < 2; ++i) { asm volatile("" : "+v"(kA[i][0]), "+v"(kA[i][1])); }
#pragma unroll
      for (int i = 0; i < 2; ++i) {
        f32x4 z = (f32x4){0.f, 0.f, 0.f, 0.f};
        z = __builtin_amdgcn_mfma_f32_16x16x32_bf16(kA[i][0], qf0, z, 0, 0, 0);
        z = __builtin_amdgcn_mfma_f32_16x16x32_bf16(kA[i][1], qf1, z, 0, 0, 0);
        if (tb + i < 16) accS[(tb + i) & 15] = z; else accC[(tb + i) & 15] = z;
      }
      if (tb + 4 < 32) {
#pragma unroll
        for (int i = 0; i < 2; ++i) { const bf16_t* kp = NA_KPTR(tb + 4 + i); kA[i][0] = *(const bf16x8*)kp; kA[i][1] = *(const bf16x8*)(kp + 256); }
      }
#pragma unroll
      for (int i = 0; i < 2; ++i) { asm volatile("" : "+v"(kB[i][0]), "+v"(kB[i][1])); }
#pragma unroll
      for (int i = 0; i < 2; ++i) {
        f32x4 z = (f32x4){0.f, 0.f, 0.f, 0.f};
        z = __builtin_amdgcn_mfma_f32_16x16x32_bf16(kB[i][0], qf0, z, 0, 0, 0);
        z = __builtin_amdgcn_mfma_f32_16x16x32_bf16(kB[i][1], qf1, z, 0, 0, 0);
        if (tb + 2 + i < 16) accS[(tb + 2 + i) & 15] = z; else accC[(tb + 2 + i) & 15] = z;
      }
    }
#undef NA_KPTR
    const int cq = cq0 + li;
    int c0q = cq - 8; c0q = c0q < 0 ? 0 : (c0q > 48 ? 48 : c0q);
    float mx = -3.0e38f;
#pragma unroll
    for (int kt = 0; kt < 16; ++kt) {
      int bi[4]; bool okv[4]; float bv[4];
#pragma unroll
      for (int e = 0; e < 4; ++e) {
        const int ck = cs + 16 * (kt & 1) + 4 * g + e;
        okv[e] = lat && ck >= c0q && ck < c0q + 16;
        bi[e] = okv[e] ? (kt >> 1) * 32 + (ck - cq + 15) : 0;
      }
      asm volatile("" : "+v"(bi[0]), "+v"(bi[1]), "+v"(bi[2]), "+v"(bi[3]));
#pragma unroll
      for (int e = 0; e < 4; ++e) bv[e] = btab[bi[e]];
#pragma unroll
      for (int e = 0; e < 4; ++e) {
        const float s = okv[e] ? accS[kt][e] * 0.125f + bv[e] : -3.0e38f;
        accS[kt][e] = s;
        mx = fmaxf(mx, s);
      }
    }
#pragma unroll
    for (int ct = 0; ct < 16; ++ct)
#pragma unroll
      for (int e = 0; e < 4; ++e) { const float s = accC[ct][e] * 0.125f; accC[ct][e] = s; mx = fmaxf(mx, s); }
    mx = grp_max(mx);
    float sum = 0.f;
#pragma unroll
    for (int kt = 0; kt < 16; ++kt)
#pragma unroll
      for (int e = 0; e < 4; ++e) { const float p = __expf(accS[kt][e] - mx); accS[kt][e] = p; sum += p; }
#pragma unroll
    for (int ct = 0; ct < 16; ++ct)
#pragma unroll
      for (int e = 0; e < 4; ++e) { const float p = __expf(accC[ct][e] - mx); accC[ct][e] = p; sum += p; }
    sum = grp_sum(sum);
    const float inv = 1.f / sum;
    bf16x8 afL[8], afC[8];
#pragma unroll
    for (int kr = 0; kr < 8; ++kr) {
#pragma unroll
      for (int e = 0; e < 4; ++e) {
        afL[kr][e] = (short)f2bf(accS[2 * kr][e] * inv); afL[kr][4 + e] = (short)f2bf(accS[2 * kr + 1][e] * inv);
        afC[kr][e] = (short)f2bf(accC[2 * kr][e] * inv); afC[kr][4 + e] = (short)f2bf(accC[2 * kr + 1][e] * inv);
      }
    }
    f32x4 accO[4];
#pragma unroll
    for (int db = 0; db < 4; ++db) accO[db] = (f32x4){0.f, 0.f, 0.f, 0.f};
    const bf16_t* vl = P.vtl() + (size_t)(b * 8 + hd) * 64 * 4096 + li * 4;
    const bf16_t* vc = P.vtc() + (size_t)(b * 8 + hd) * 64 * 256 + li * 4;
#pragma unroll
    for (int kr = 0; kr < 8; ++kr) {
      const int tok = (r0 + kr) * 64 + cs + 4 * g;
      s16x4 lo[4], hi[4];
#pragma unroll
      for (int db = 0; db < 4; ++db) {
        const bf16_t* vp = vl + ((size_t)(tok >> 2) * 64 + db * 16) * 4;
        lo[db] = *(const s16x4*)vp; hi[db] = *(const s16x4*)(vp + 4 * 64 * 4);
      }
#pragma unroll
      for (int db = 0; db < 4; ++db) {
        const bf16x8 bfr = (bf16x8){lo[db][0], lo[db][1], lo[db][2], lo[db][3], hi[db][0], hi[db][1], hi[db][2], hi[db][3]};
        accO[db] = __builtin_amdgcn_mfma_f32_16x16x32_bf16(afL[kr], bfr, accO[db], 0, 0, 0);
      }
    }
#pragma unroll
    for (int t = 0; t < 8; ++t) {
      const int tok = 32 * t + 4 * g;
      s16x4 lo[4], hi[4];
#pragma unroll
      for (int db = 0; db < 4; ++db) {
        const bf16_t* vp = vc + ((size_t)(tok >> 2) * 64 + db * 16) * 4;
        lo[db] = *(const s16x4*)vp; hi[db] = *(const s16x4*)(vp + 4 * 64 * 4);
      }
#pragma unroll
      for (int db = 0; db < 4; ++db) {
        const bf16x8 bfr = (bf16x8){lo[db][0], lo[db][1], lo[db][2], lo[db][3], hi[db][0], hi[db][1], hi[db][2], hi[db][3]};
        accO[db] = __builtin_amdgcn_mfma_f32_16x16x32_bf16(afC[t], bfr, accO[db], 0, 0, 0);
      }
    }
    {
      bf16_t* stg = (bf16_t*)(smem + 32768) + wv * (16 * 72);
#pragma unroll
      for (int db = 0; db < 4; ++db)
#pragma unroll
        for (int e = 0; e < 4; ++e) stg[(4 * g + e) * 72 + 16 * db + li] = f2bf(accO[db][e]);
      __builtin_amdgcn_wave_barrier();
#pragma unroll
      for (int i = 0; i < 2; ++i) {
        const int c = i * 64 + lane, rr = c >> 3, c8 = (c & 7) * 8;
        *(uint4*)(P.concat() + (size_t)(qrow0 + rr) * 2048 + 1536 + hd * 64 + c8) = *(const uint4*)(stg + rr * 72 + c8);
      }
      __builtin_amdgcn_wave_barrier();
    }
  }
}

__device__ __forceinline__ uint32_t mono_u(float f) { const uint32_t u = __float_as_uint(f); return u ^ ((uint32_t)((int)u >> 31) | 0x80000000u); }
__device__ __forceinline__ float unmono_f(uint32_t m) { return __uint_as_float((m & 0x80000000u) ? (m ^ 0x80000000u) : ~m); }
__device__ __forceinline__ uint32_t grp_max_u(uint32_t v) {
  auto a = __builtin_amdgcn_permlane16_swap(v, v, false, false);
  v = a[0] > a[1] ? a[0] : a[1];
  auto b = __builtin_amdgcn_permlane32_swap(v, v, false, false);
  return b[0] > b[1] ? b[0] : b[1];
}

template <int N>
__device__ __forceinline__ void bitonic_sort_desc(uint32_t (&a)[N], int base = 0) { (void)base;
#pragma unroll
  for (int k = 2; k <= N; k <<= 1)
#pragma unroll
    for (int j = k >> 1; j > 0; j >>= 1)
#pragma unroll
      for (int i = 0; i < N; ++i) {
        const int l = i ^ j;
        if (l > i) {
          const bool desc = (i & k) == 0;
          const uint32_t hi = a[i] > a[l] ? a[i] : a[l], lo = a[i] > a[l] ? a[l] : a[i];
          a[i] = desc ? hi : lo; a[l] = desc ? lo : hi;
        }
      }
}
template <int N>
__device__ __forceinline__ void bitonic_merge_desc(uint32_t (&a)[N]) {
#pragma unroll
  for (int j = N >> 1; j > 0; j >>= 1)
#pragma unroll
    for (int i = 0; i < N; ++i) {
      const int l = i ^ j;
      if (l > i) {
        const uint32_t hi = a[i] > a[l] ? a[i] : a[l], lo = a[i] > a[l] ? a[l] : a[i];
        a[i] = hi; a[l] = lo;
      }
    }
}
__device__ __forceinline__ void merge4_top16(uint32_t (&a)[16]) {
  uint32_t e[16], o[16];
#pragma unroll
  for (int i = 0; i < 16; ++i) { auto r = __builtin_amdgcn_permlane16_swap(a[i], a[i], false, false); e[i] = r[0]; o[i] = r[1]; }
#pragma unroll
  for (int i = 0; i < 16; ++i) a[i] = e[i] > o[15 - i] ? e[i] : o[15 - i];
  bitonic_merge_desc<16>(a);
#pragma unroll
  for (int i = 0; i < 16; ++i) { auto r = __builtin_amdgcn_permlane32_swap(a[i], a[i], false, false); e[i] = r[0]; o[i] = r[1]; }
#pragma unroll
  for (int i = 0; i < 16; ++i) a[i] = e[i] > o[15 - i] ? e[i] : o[15 - i];
  bitonic_merge_desc<16>(a);
}
__device__ void ph_peer_topk_mfma(int wv, const Params& P, int layer, int nrows, char* smem, int bid, int nb) {
  const int tid = otid(wv), lane = tid & 63, li = lane & 15, g = lane >> 4;
  unsigned char* ctab = (unsigned char*)smem;
  float* vals = (float*)(smem + 256) + wv * 512;
  int* idxs = (int*)(smem + 256 + 8 * 2048) + wv * 512;
  __syncthreads();
  if (tid < 64) ctab[tid] = 0xFF;
  __syncthreads();
  if (tid == 0) {
    int n = 0, one = 1;
    asm volatile("" : "+s"(one));
#pragma unroll 1
    for (int a = 0; a < 16; ++a)
#pragma unroll 1
      for (int b = 0; b < 16; ++b)
        if ((a + one) * (b + 1) <= 16) { ctab[(n & 3) * 16 + (n >> 2)] = (unsigned char)(a * 16 + b); ++n; }
  }
  const int hd = bid & 7, tg = bid >> 3, ngroups = nb >> 3;
  char* ksm = smem + 33280;
  {
    const bf16_t* ksrc = P.keysb() + (size_t)(layer * 8 + hd) * 2 * 128 * 128;
#pragma unroll
    for (int i = 0; i < 8; ++i) {
      const int idx = tid + i * 512, r = idx >> 4, sg = idx & 15;
      *(uint4*)(ksm + (r * 136 + sg * 8) * 2) = *(const uint4*)(ksrc + (size_t)r * 128 + sg * 8);
    }
  }
  __syncthreads();
  uint32_t cab[16];
#pragma unroll
  for (int s = 0; s < 16; ++s) cab[s] = ctab[g * 16 + s];
  const int ntile = nrows / 16;
  for (int tile = tg + ngroups * wv; tile < ntile && tg < ngroups; tile += ngroups * NWAVE) {
    const int row0 = tile * 16;
    const bf16_t* qp = P.q() + (size_t)(row0 + li) * 2048 + hd * 256 + 8 * g;
    uint32_t win[2][16];
#pragma unroll
    for (int half = 0; half < 2; ++half) {
      bf16x8 qf[4];
#pragma unroll
      for (int t = 0; t < 4; ++t) qf[t] = *(const bf16x8*)(qp + half * 128 + 32 * t);
      const char* kb = ksm + ((half * 128 + li) * 136 + 8 * g) * 2;
      uint32_t pk[32];
#pragma unroll
      for (int kt = 0; kt < 8; ++kt) {
        f32x4 acc = (f32x4){0.f, 0.f, 0.f, 0.f};
#pragma unroll
        for (int t = 0; t < 4; ++t) {
          const bf16x8 a = *(const bf16x8*)(kb + (kt * 16 * 136 + 32 * t) * 2);
          acc = __builtin_amdgcn_mfma_f32_16x16x32_bf16(a, qf[t], acc, 0, 0, 0);
        }
#pragma unroll
        for (int e = 0; e < 4; ++e) pk[kt * 4 + e] = (mono_u(acc[e]) & ~127u) | (uint32_t)(16 * kt + 4 * g + e);
      }
      {
        uint32_t lo16[16], hi16[16];
#pragma unroll
        for (int i = 0; i < 16; ++i) { lo16[i] = pk[i]; hi16[i] = pk[16 + i]; }
        bitonic_sort_desc<16>(lo16);
        bitonic_sort_desc<16>(hi16);
#pragma unroll
        for (int i = 0; i < 16; ++i) lo16[i] = lo16[i] > hi16[15 - i] ? lo16[i] : hi16[15 - i];
        bitonic_merge_desc<16>(lo16);
        merge4_top16(lo16);
#pragma unroll
        for (int r = 0; r < 16; ++r) win[half][r] = lo16[r];
      }
    }
    if (g == 0) {
#pragma unroll
      for (int half = 0; half < 2; ++half)
#pragma unroll
        for (int r = 0; r < 16; ++r) {
          vals[li * 32 + half * 16 + r] = unmono_f(win[half][r] & ~127u);
          idxs[li * 32 + half * 16 + r] = (int)(win[half][r] & 127u);
        }
    }
    __builtin_amdgcn_wave_barrier();
    uint32_t cp[16];
    {
      float va[16], vb[16];
#pragma unroll
      for (int s = 0; s < 16; ++s) {
        const uint32_t ab = cab[s] == 0xFFu ? 0u : cab[s];
        va[s] = vals[li * 32 + (ab >> 4)]; vb[s] = vals[li * 32 + 16 + (ab & 15u)];
      }
#pragma unroll
      for (int s = 0; s < 16; ++s) cp[s] = cab[s] == 0xFFu ? 0u : ((mono_u(va[s] + vb[s]) & ~255u) | cab[s]);
    }
    bitonic_sort_desc<16>(cp);
    merge4_top16(cp);
    uint32_t cw[16];
#pragma unroll
    for (int r = 0; r < 16; ++r) cw[r] = cp[r];
    const float mx = unmono_f(cw[0] & ~255u);
    float ex[16];
    float sum = 0.f;
#pragma unroll
    for (int r = 0; r < 16; ++r) { ex[r] = __expf(unmono_f(cw[r] & ~255u) - mx); sum += ex[r]; }
    const float inv = 1.f / sum;
    const size_t ob = (size_t)(row0 + li) * 128 + hd * 16;
#pragma unroll
    for (int r = 0; r < 16; ++r) {
      if ((r >> 2) == g) {
        const uint32_t ab = cw[r] & 255u;
        P.sel_idx()[ob + r] = idxs[li * 32 + (ab >> 4)] * 128 + idxs[li * 32 + 16 + (ab & 15u)];
        P.sel_g()[ob + r] = ex[r] * inv;
      }
    }
    __builtin_amdgcn_wave_barrier();
  }
}

__device__ __forceinline__ void cvt8(const uint32_t w, float* f) {
  const f32x2_t a = __builtin_amdgcn_cvt_scalef32_pk_f32_fp4(w, 1.0f, 0), b = __builtin_amdgcn_cvt_scalef32_pk_f32_fp4(w, 1.0f, 1);
  const f32x2_t c = __builtin_amdgcn_cvt_scalef32_pk_f32_fp4(w, 1.0f, 2), e = __builtin_amdgcn_cvt_scalef32_pk_f32_fp4(w, 1.0f, 3);
  f[0] = a.x; f[1] = a.y; f[2] = b.x; f[3] = b.y; f[4] = c.x; f[5] = c.y; f[6] = e.x; f[7] = e.y;
}
__device__ __forceinline__ float swap16_add(float a, float b) {
  auto r = __builtin_amdgcn_permlane16_swap(__float_as_uint(a), __float_as_uint(b), false, false);
  return __uint_as_float(r[0]) + __uint_as_float(r[1]);
}
typedef int i32x8_t __attribute__((ext_vector_type(8)));
__device__ void ph_peer_dots(int wv, const Params& P, int layer, int nrows, int bid, int nb) {
  for (int row = bid * NWAVE + wv; row < nrows; row += nb * NWAVE) {
    const int lane = otid(wv) & 63, n = lane & 15, g = lane >> 4;
    const bool hsel = (lane & 8) != 0;
    const unsigned char* TU = P.tabU();
    const uint32_t tuo = (uint32_t)(8 * g + (lane & 7)) * 16u;
    i32x8_t xa;
    {
      const bf16_t* xp = P.u() + (size_t)row * DM + 32 * (8 * g + (lane & 7));
      float xv[32];
      unpack8(*(const uint4*)xp, xv); unpack8(*(const uint4*)(xp + 8), xv + 8);
      unpack8(*(const uint4*)(xp + 16), xv + 16); unpack8(*(const uint4*)(xp + 24), xv + 24);
#pragma unroll
      for (int r = 0; r < 4; ++r) {
        uint32_t hw = 0u, lw = 0u;
        float fh[8];
#pragma unroll
        for (int bsel = 0; bsel < 4; ++bsel) {
          if (bsel == 0) hw = __builtin_amdgcn_cvt_scalef32_pk_fp4_f32(hw, xv[8 * r + 0], xv[8 * r + 1], 1.0f, 0);
          if (bsel == 1) hw = __builtin_amdgcn_cvt_scalef32_pk_fp4_f32(hw, xv[8 * r + 2], xv[8 * r + 3], 1.0f, 1);
          if (bsel == 2) hw = __builtin_amdgcn_cvt_scalef32_pk_fp4_f32(hw, xv[8 * r + 4], xv[8 * r + 5], 1.0f, 2);
          if (bsel == 3) hw = __builtin_amdgcn_cvt_scalef32_pk_fp4_f32(hw, xv[8 * r + 6], xv[8 * r + 7], 1.0f, 3);
        }
        cvt8(hw, fh);
        lw = __builtin_amdgcn_cvt_scalef32_pk_fp4_f32(lw, (xv[8 * r + 0] - fh[0]) * 8.f, (xv[8 * r + 1] - fh[1]) * 8.f, 1.0f, 0);
        lw = __builtin_amdgcn_cvt_scalef32_pk_fp4_f32(lw, (xv[8 * r + 2] - fh[2]) * 8.f, (xv[8 * r + 3] - fh[3]) * 8.f, 1.0f, 1);
        lw = __builtin_amdgcn_cvt_scalef32_pk_fp4_f32(lw, (xv[8 * r + 4] - fh[4]) * 8.f, (xv[8 * r + 5] - fh[5]) * 8.f, 1.0f, 2);
        lw = __builtin_amdgcn_cvt_scalef32_pk_fp4_f32(lw, (xv[8 * r + 6] - fh[6]) * 8.f, (xv[8 * r + 7] - fh[7]) * 8.f, 1.0f, 3);
        xa[r] = (int)((n & 8) ? lw : hw);
        xa[4 + r] = 0;
      }
    }
    const int idx0 = P.sel_idx()[(size_t)row * 128 + lane], idx1 = P.sel_idx()[(size_t)row * 128 + 64 + lane];
    const float gt0 = P.sel_g()[(size_t)row * 128 + lane] * P.invV()[idx0], gt1 = P.sel_g()[(size_t)row * 128 + 64 + lane] * P.invV()[idx1];
    const float iu0 = P.invU()[idx0], iu1 = P.invU()[idx1];
    const float cs = ((g & 1) == ((n >> 2) & 1)) ? (g >= 2 ? (1.f / 8.f) : 1.f) : 0.f;
    const int lkey = lane & 0x37;
    float d0 = 0.f, d1 = 0.f;
    u32x4_t bufA[8], bufB[8], bufC[8], bufD[8];
#define PG_LOAD(buf, T, m0) do { _Pragma("unroll") for (int j = 0; j < 8; ++j) { \
      const int m_ = (m0) + j; const int src_ = m_ < 32 ? idx0 : idx1; const int kA_ = (m_ & 7) + 16 * ((m_ >> 3) & 3); \
      const int elo_ = __builtin_amdgcn_readlane(src_, kA_), ehi_ = __builtin_amdgcn_readlane(src_, kA_ + 8); \
      buf[j] = *(const u32x4_t*)(T + (((uint32_t)(hsel ? ehi_ : elo_) << 9) + tuo)); } } while (0)
#define PG_DOT(buf, m0) do { _Pragma("unroll") for (int j = 0; j < 8; ++j) { \
      const int m_ = (m0) + j; const int kA_ = (m_ & 7) + 16 * ((m_ >> 3) & 3); \
      const i32x8_t b_ = {(int)buf[j].x, (int)buf[j].y, (int)buf[j].z, (int)buf[j].w, 0, 0, 0, 0}; \
      const f32x4 acc_ = __builtin_amdgcn_mfma_scale_f32_16x16x128_f8f6f4(xa, b_, (f32x4){0.f, 0.f, 0.f, 0.f}, 4, 4, 0, 0x7F7F7F7F, 0, 0x7F7F7F7F); \
      float w_ = (n & 2) ? ((n & 1) ? acc_[3] : acc_[2]) : ((n & 1) ? acc_[1] : acc_[0]); \
      w_ *= cs; \
      w_ += DPP_F(w_, 0xB1); w_ += DPP_F(w_, 0x4E); w_ += DPP_F(w_, 0x141); \
      { auto r_ = __builtin_amdgcn_permlane32_swap(__float_as_uint(w_), __float_as_uint(w_), false, false); w_ = __uint_as_float(r_[0]) + __uint_as_float(r_[1]); } \
      { auto r_ = __builtin_amdgcn_permlane16_swap(__float_as_uint(w_), __float_as_uint(w_), false, false); w_ = __uint_as_float(r_[0]) + __uint_as_float(r_[1]); } \
      if (m_ < 32) d0 = (lkey == kA_) ? w_ : d0; else d1 = (lkey == kA_) ? w_ : d1; } } while (0)
    PG_LOAD(bufA, TU, 0); PG_LOAD(bufB, TU, 8); PG_LOAD(bufC, TU, 16);
    PG_LOAD(bufD, TU, 24); PG_DOT(bufA, 0);
    PG_LOAD(bufA, TU, 32); PG_DOT(bufB, 8);
    PG_LOAD(bufB, TU, 40); PG_DOT(bufC, 16);
    PG_LOAD(bufC, TU, 48); PG_DOT(bufD, 24);
    PG_LOAD(bufD, TU, 56); PG_DOT(bufA, 32);
    PG_DOT(bufB, 40); PG_DOT(bufC, 48); PG_DOT(bufD, 56);
    P.sel_g()[(size_t)row * 128 + lane] = gelu_f(d0 * iu0) * gt0;
    P.sel_g()[(size_t)row * 128 + 64 + lane] = gelu_f(d1 * iu1) * gt1;
#undef PG_LOAD
#undef PG_DOT
  }
}
__device__ void ph_peer_acc(int wv, const Params& P, int layer, int nrows, int bid, int nb) {
  for (int row = bid * NWAVE + wv; row < nrows; row += nb * NWAVE) {
    const int lane = otid(wv) & 63, l5 = lane & 31;
    const bool up = lane >= 32;
    const unsigned char* TV = P.tabV();
    const uint32_t tvo = (uint32_t)l5 * 16u;
    float o[32];
    const int idx0 = P.sel_idx()[(size_t)row * 128 + lane], idx1 = P.sel_idx()[(size_t)row * 128 + 64 + lane];
    const float act0 = P.sel_g()[(size_t)row * 128 + lane], act1 = P.sel_g()[(size_t)row * 128 + 64 + lane];
    uint4 bufA[8], bufB[8];
#define PG_LOAD(buf, T, kk) do { _Pragma("unroll") for (int j = 0; j < 8; ++j) { \
      const int k_ = (kk) + 2 * j; const int src_ = k_ < 64 ? idx0 : idx1; \
      const int elo_ = __builtin_amdgcn_readlane(src_, k_ & 63), ehi_ = __builtin_amdgcn_readlane(src_, (k_ & 63) + 1); \
      buf[j] = *(const uint4*)(T + (((uint32_t)(up ? ehi_ : elo_) << 9) + tvo)); } } while (0)
    PG_LOAD(bufA, TV, 0);
#pragma unroll
    for (int i = 0; i < 32; ++i) o[i] = 0.f;
#define PG_ACC(buf, kk) do { _Pragma("unroll") for (int j = 0; j < 8; ++j) { const int k_ = (kk) + 2 * j; \
      const int asrc_ = __float_as_int(k_ < 64 ? act0 : act1); \
      const float alo_ = __int_as_float(__builtin_amdgcn_readlane(asrc_, k_ & 63)), ahi_ = __int_as_float(__builtin_amdgcn_readlane(asrc_, (k_ & 63) + 1)); \
      const float a_ = up ? ahi_ : alo_; \
      const uint32_t w_[4] = {buf[j].x, buf[j].y, buf[j].z, buf[j].w}; \
      _Pragma("unroll") for (int d = 0; d < 4; ++d) { float f[8]; uint32_t wd_ = w_[d]; asm volatile("" : "+v"(wd_) : "v"(o[(d * 8 + 31) & 31])); cvt8(wd_, f); \
        _Pragma("unroll") for (int i = 0; i < 8; ++i) o[d * 8 + i] += a_ * f[i]; } } } while (0)
#pragma unroll 1
    for (int kk = 0; kk < 128; kk += 32) {
      PG_LOAD(bufB, TV, kk + 16);
      PG_ACC(bufA, kk);
      if (kk + 32 < 128) PG_LOAD(bufA, TV, kk + 32);
      PG_ACC(bufB, kk + 16);
    }
#undef PG_LOAD
#undef PG_ACC
#pragma unroll
    for (int i = 0; i < 32; ++i) {
      auto r = __builtin_amdgcn_permlane32_swap(__float_as_uint(o[i]), __float_as_uint(o[i]), false, false);
      o[i] = __uint_as_float(r[0]) + __uint_as_float(r[1]);
    }
    const int lane_e = otid(wv) & 63, l5e = lane_e & 31;
    const bool upe = lane_e >= 32;
    const float* gate = P.mod() + (size_t)(layer * 5 + modrow(row)) * MODW + 5120 + l5e * 32;
    float* hr = P.h() + (size_t)row * DM + l5e * 32;
    float ss = 0.f;
    f32x4 hvv[8], ggv[8];
#pragma unroll
    for (int q = 0; q < 8; ++q) { hvv[q] = *(const f32x4*)(hr + q * 4); ggv[q] = *(const f32x4*)(gate + q * 4); }
#pragma unroll
    for (int q = 0; q < 8; ++q) asm volatile("" : "+v"(hvv[q]), "+v"(ggv[q]));
#pragma unroll
    for (int q = 0; q < 8; ++q) {
      float4 hv = make_float4(hvv[q][0], hvv[q][1], hvv[q][2], hvv[q][3]);
      const float4 gg = make_float4(ggv[q][0], ggv[q][1], ggv[q][2], ggv[q][3]);
      hv.x += gg.x * o[q * 4 + 0]; hv.y += gg.y * o[q * 4 + 1]; hv.z += gg.z * o[q * 4 + 2]; hv.w += gg.w * o[q * 4 + 3];
      if (layer == 0 && !upe) *(float4*)(hr + q * 4) = hv;
      o[q * 4 + 0] = hv.x; o[q * 4 + 1] = hv.y; o[q * 4 + 2] = hv.z; o[q * 4 + 3] = hv.w;
      if (!upe) ss += hv.x * hv.x + hv.y * hv.y + hv.z * hv.z + hv.w * hv.w;
    }
    ss = wave_sum(ss);
    const float rstd = rsqrtf(ss * (1.f / 1024.f) + 1e-6f);
    if (layer == 0) {
      const float* g1 = P.norm1_g + 1024 + l5e * 32;
      const float* mr = P.mod() + (size_t)(5 + modrow(row)) * MODW + l5e * 32;
      if (!upe) {
#pragma unroll
        for (int q = 0; q < 4; ++q) {
          float ov[8];
#pragma unroll
          for (int e = 0; e < 8; ++e) ov[e] = o[q * 8 + e] * rstd * g1[q * 8 + e] * (1.f + mr[1024 + q * 8 + e]) + mr[q * 8 + e];
          *(uint4*)(P.u() + (size_t)row * DM + l5e * 32 + q * 8) = make_uint4(pack2(ov[0], ov[1]), pack2(ov[2], ov[3]), pack2(ov[4], ov[5]), pack2(ov[6], ov[7]));
        }
      }
    } else {
      const float* gf = P.final_g + l5e * 32;
      if (!upe) {
#pragma unroll
        for (int q = 0; q < 8; ++q) {
          const float4 gg = *(const float4*)(gf + q * 4);
          *(float4*)(P.out + (size_t)row * DM + l5e * 32 + q * 4) =
              make_float4(o[q * 4] * rstd * gg.x, o[q * 4 + 1] * rstd * gg.y, o[q * 4 + 2] * rstd * gg.z, o[q * 4 + 3] * rstd * gg.w);
        }
      }
    }
  }
}

struct EpiOutproj {
  static constexpr bool PERM = false, AFTER_DRAIN = false;
  static constexpr int MIDK_T = 16;
  float* H; const float* hl; const float* hc; const float* modl;
  const float* yss;
  __device__ __forceinline__ void midk(pg8::f32x4 (&acc)[2][2][4][2], const pg8::Unit& u, int wr, int wc, int fr, int fq) const {
    const int row0 = u.pm * 256 + wr * 64 + fr;
#pragma unroll
    for (int ai = 0; ai < 2; ++ai)
#pragma unroll
      for (int m = 0; m < 4; ++m) {
        const pg8::f32x4* yp = (const pg8::f32x4*)(yss + (size_t)(row0 + ai * 128 + m * 16) * 16);
        const pg8::f32x4 y4 = (yp[0] + yp[1]) + (yp[2] + yp[3]);
        const float rstd = rsqrtf(((y4[0] + y4[1]) + (y4[2] + y4[3])) * (1.f / 1024.f) + 1e-6f);
#pragma unroll
        for (int bj = 0; bj < 2; ++bj)
#pragma unroll
          for (int n = 0; n < 2; ++n) acc[ai][bj][m][n] *= rstd;
      }
  }
  __device__ __forceinline__ void operator()(const pg8::f32x4 (&acc)[2][2][4][2], const pg8::Unit& u, int wr, int wc, int fr, int fq) const {
    const int row0 = u.pm * 256 + wr * 64 + fr, col0 = u.pn * 256 + wc * 32 + 4 * fq;
    const float* gate = modl + (size_t)modrow(row0) * MODW + 2048 + col0;
    pg8::f32x4 gv[2][2];
#pragma unroll
    for (int bj = 0; bj < 2; ++bj)
#pragma unroll
      for (int n = 0; n < 2; ++n) gv[bj][n] = *(const pg8::f32x4*)(gate + bj * 128 + n * 16);
    pg8::f32x4 sA[4], sB[4];
#define EO_LOAD(dstv, ai_, m_) do { const float* s_ = hrow(hl, hc, row0 + (ai_) * 128 + (m_) * 16) + col0; \
      dstv[0] = *(const pg8::f32x4*)(s_); dstv[1] = *(const pg8::f32x4*)(s_ + 16); dstv[2] = *(const pg8::f32x4*)(s_ + 128); dstv[3] = *(const pg8::f32x4*)(s_ + 144); } while (0)
#define EO_STORE(srcv, ai_, m_) do { asm volatile("" : "+v"(srcv[0]), "+v"(srcv[1]), "+v"(srcv[2]), "+v"(srcv[3])); \
      float* d_ = H + (size_t)(row0 + (ai_) * 128 + (m_) * 16) * DM + col0; \
      *(pg8::f32x4*)(d_) = srcv[0] + gv[0][0] * acc[ai_][0][m_][0]; *(pg8::f32x4*)(d_ + 16) = srcv[1] + gv[0][1] * acc[ai_][0][m_][1]; \
      *(pg8::f32x4*)(d_ + 128) = srcv[2] + gv[1][0] * acc[ai_][1][m_][0]; *(pg8::f32x4*)(d_ + 144) = srcv[3] + gv[1][1] * acc[ai_][1][m_][1]; } while (0)
    EO_LOAD(sA, 0, 0);
#pragma unroll
    for (int i = 0; i < 8; i += 2) {
      EO_LOAD(sB, (i + 1) >> 2, (i + 1) & 3);
      EO_STORE(sA, i >> 2, i & 3);
      if (i + 2 < 8) EO_LOAD(sA, (i + 2) >> 2, (i + 2) & 3);
      EO_STORE(sB, (i + 1) >> 2, (i + 1) & 3);
    }
#undef EO_LOAD
#undef EO_STORE
  }
};

template <int MODE>
__device__ void ctx_tile(int wv, const Params& P, int layer, char* smem, int tm, int tn, const bf16_t* __restrict__ A,
                         const bf16_t* __restrict__ Bt, const int K, const float* hc) {
  const int tid = otid(wv), lane = tid & 63, li = lane & 15, g = lane >> 4;
  const int kw = K >> 3;
  const bf16_t* ap = A + (size_t)(tm * 64 + li) * K + wv * kw + 8 * g;
  const bf16_t* bp = Bt + (size_t)(tn * 64 + li) * K + wv * kw + 8 * g;
  f32x4 acc[4][4];
#pragma unroll
  for (int mi = 0; mi < 4; ++mi)
#pragma unroll
    for (int ni = 0; ni < 4; ++ni) acc[mi][ni] = (f32x4){0.f, 0.f, 0.f, 0.f};
  bf16x8 fa0[4], fb0[4], fa1[4], fb1[4];
#define CT_LOAD(fa, fb, s) do { _Pragma("unroll") for (int i = 0; i < 4; ++i) { \
    fa[i] = *(const bf16x8*)(ap + (size_t)(16 * i) * K + (s) * 32); fb[i] = *(const bf16x8*)(bp + (size_t)(16 * i) * K + (s) * 32); } } while (0)
#define CT_MMA(fa, fb) do { _Pragma("unroll") for (int mi = 0; mi < 4; ++mi) _Pragma("unroll") for (int ni = 0; ni < 4; ++ni) \
    acc[mi][ni] = __builtin_amdgcn_mfma_f32_16x16x32_bf16(fb[ni], fa[mi], acc[mi][ni], 0, 0, 0); } while (0)
  const int steps = kw >> 5;
  CT_LOAD(fa0, fb0, 0);
#pragma unroll 1
  for (int s = 0; s < steps; s += 2) {
    CT_LOAD(fa1, fb1, s + 1);
    CT_MMA(fa0, fb0);
    if (s + 2 < steps) CT_LOAD(fa0, fb0, s + 2);
    CT_MMA(fa1, fb1);
  }
#undef CT_LOAD
#undef CT_MMA
  float* part = (float*)smem + wv * 4096;
#pragma unroll
  for (int mi = 0; mi < 4; ++mi)
#pragma unroll
    for (int ni = 0; ni < 4; ++ni) *(f32x4*)(part + (16 * mi + li) * 64 + (((4 * ni + g) ^ li) * 4)) = acc[mi][ni];
  __syncthreads();
  {
    const int row = tid >> 3, c4 = (tid & 7) * 2;
    const float* p0 = (const float*)smem + row * 64 + (((c4) ^ (row & 15)) * 4);
    const float* p1 = (const float*)smem + row * 64 + (((c4 + 1) ^ (row & 15)) * 4);
    f32x4 sa0 = (f32x4){0.f, 0.f, 0.f, 0.f}, sa1 = sa0, sb0 = sa0, sb1 = sa0;
#pragma unroll
    for (int w = 0; w < 4; ++w) { sa0 += *(const f32x4*)(p0 + w * 4096); sa1 += *(const f32x4*)(p1 + w * 4096); }
#pragma unroll
    for (int w = 4; w < 8; ++w) { sb0 += *(const f32x4*)(p0 + w * 4096); sb1 += *(const f32x4*)(p1 + w * 4096); }
    const int grow = NLAT + tm * 64 + row, col = tn * 64 + c4 * 4;
    if (MODE == 0) {
      const f32x4* yp = (const f32x4*)(P.yss() + (size_t)grow * 16);
      const f32x4 y4 = (yp[0] + yp[1]) + (yp[2] + yp[3]);
      const float rstd = rsqrtf(((y4[0] + y4[1]) + (y4[2] + y4[3])) * (1.f / 1024.f) + 1e-6f);
      const float* gate = P.mod() + ((size_t)layer * 5 + 4) * MODW + 2048 + col;
      const float* hs = hc + (size_t)(grow - NLAT) * DM + col;
      float* hd = P.h() + (size_t)grow * DM + col;
      const f32x4 g0 = *(const f32x4*)gate, g1 = *(const f32x4*)(gate + 4);
      const f32x4 h0 = *(const f32x4*)hs, h1 = *(const f32x4*)(hs + 4);
      *(f32x4*)hd = h0 + g0 * (sa0 * rstd + sb0);
      *(f32x4*)(hd + 4) = h1 + g1 * (sa1 * rstd + sb1);
    } else {
      const f32x4 s0 = sa0 + sb0, s1 = sa1 + sb1;
      *(uint4*)(P.q() + (size_t)grow * 2048 + col) = make_uint4(pack2(s0[0], s0[1]), pack2(s0[2], s0[3]), pack2(s1[0], s1[1]), pack2(s1[2], s1[3]));
    }
  }
  __syncthreads();
}

__device__ __forceinline__ uint32_t fp4_code(float x, float sc) {
  const float a = fabsf(x) * sc;
  const uint32_t c = (uint32_t)(a > 0.25f) + (uint32_t)(a > 0.75f) + (uint32_t)(a > 1.25f) + (uint32_t)(a > 1.75f) +
                     (uint32_t)(a > 2.5f) + (uint32_t)(a > 3.5f) + (uint32_t)(a > 5.0f);
  return c | (x < 0.f ? 8u : 0u);
}
__device__ void ph_convert_tables(int wv, const Params& P, int layer, int bid, int nb) {
  const int lane = otid(wv) & 63;
  for (int it0 = (bid * NWAVE + wv) * 2; it0 < 2 * 16384; it0 += nb * NWAVE * 2) {
    f32x4 v[2][4];
#pragma unroll
    for (int rr = 0; rr < 2; ++rr) {
      const int it = it0 + rr, t = it >> 14, e = it & 16383;
      const float* src = (t == 0 ? P.peer_u : P.peer_v) + ((size_t)layer * 16384 + e) * 1024 + lane * 16;
#pragma unroll
      for (int i = 0; i < 4; ++i) v[rr][i] = ((const f32x4*)src)[i];
    }
#pragma unroll
    for (int rr = 0; rr < 2; ++rr)
#pragma unroll
      for (int i = 0; i < 4; ++i) asm volatile("" : "+v"(v[rr][i]));
#pragma unroll
    for (int rr = 0; rr < 2; ++rr) {
      const int it = it0 + rr, t = it >> 14, e = it & 16383;
      float m = 0.f;
#pragma unroll
      for (int i = 0; i < 4; ++i)
        m = fmaxf(m, fmaxf(fmaxf(fabsf(v[rr][i][0]), fabsf(v[rr][i][1])), fmaxf(fabsf(v[rr][i][2]), fabsf(v[rr][i][3]))));
      m = wave_max(m);
      m = fmaxf(m, 1e-30f);
      const float sc = 6.0f / m, inv = m * (1.0f / 6.0f);
      uint2 o;
      {
        uint32_t p0 = 0u, p1 = 0u;
        p0 = __builtin_amdgcn_cvt_scalef32_pk_fp4_f32(p0, v[rr][0][0] * sc, v[rr][0][1] * sc, 1.0f, 0);
        p0 = __builtin_amdgcn_cvt_scalef32_pk_fp4_f32(p0, v[rr][0][2] * sc, v[rr][0][3] * sc, 1.0f, 1);
        p0 = __builtin_amdgcn_cvt_scalef32_pk_fp4_f32(p0, v[rr][1][0] * sc, v[rr][1][1] * sc, 1.0f, 2);
        p0 = __builtin_amdgcn_cvt_scalef32_pk_fp4_f32(p0, v[rr][1][2] * sc, v[rr][1][3] * sc, 1.0f, 3);
        p1 = __builtin_amdgcn_cvt_scalef32_pk_fp4_f32(p1, v[rr][2][0] * sc, v[rr][2][1] * sc, 1.0f, 0);
        p1 = __builtin_amdgcn_cvt_scalef32_pk_fp4_f32(p1, v[rr][2][2] * sc, v[rr][2][3] * sc, 1.0f, 1);
        p1 = __builtin_amdgcn_cvt_scalef32_pk_fp4_f32(p1, v[rr][3][0] * sc, v[rr][3][1] * sc, 1.0f, 2);
        p1 = __builtin_amdgcn_cvt_scalef32_pk_fp4_f32(p1, v[rr][3][2] * sc, v[rr][3][3] * sc, 1.0f, 3);
        o.x = p0; o.y = p1;
      }
      *(uint2*)((t == 0 ? P.tabU() : P.tabV()) + (size_t)e * 512 + lane * 8) = o;
      if (lane == 0) (t == 0 ? P.invU() : P.invV())[e] = inv;
    }
  }
}

enum {
  PH_PREP = 0, PH_NORM1, PH_INPROJ, PH_CONV, PH_SSDPREP, PH_STATES, PH_SCAN, PH_SSDY, PH_SSDNORM, PH_POOL, PH_NA,
  PH_OUTPROJ, PH_NORM2, PH_QGEMM, PH_TOPK, PH_GATHER, PH_FINAL
};

#define SMEM_BYTES 135168

__device__ __forceinline__ void run_phase(int wv, const Params& P, int ph, int layer, char* smem, int bid, int nb) {
  const float* hl = layer == 0 ? P.x : P.h();
  const float* hc = layer == 0 ? P.ctx : P.h() + (size_t)NLAT * DM;
  const int nrows = layer == 0 ? NTOK : NLAT;
  switch (ph) {
    case PH_PREP:
      for (int i = bid * NTHR + otid(wv); i < 2 * 8 * 2 * 128 * 128; i += nb * NTHR) P.keysb()[i] = f2bf(P.peer_keys[i]);
      for (int i = bid * NTHR + otid(wv); i < 2 * 4 * 128 * 128; i += nb * NTHR) {
        const int k = i & 127, n = (i >> 7) & 127, lg = i >> 14;
        P.poolwT()[i] = f2bf(P.pool_w[((size_t)lg * 128 + k) * 128 + n]);
      }
      ph_mod(wv, P, (float*)smem, bid, nb);
      for (int l = 0; l < 2; ++l) {
        ph_transpose(wv, P.w_in + (size_t)l * 1024 * INW, P.w_inT() + (size_t)l * PW * 1024, 1024, INW, PW, 0, 2560, 32, PW, (float*)smem, bid, nb);
        ph_transpose(wv, P.w_in + (size_t)l * 1024 * INW, P.w_dtT() + (size_t)l * 128 * 1024, 1024, INW, 128, 2560, 1 << 30, 0, 32, (float*)smem, bid, nb);
        ph_transpose(wv, P.w_out + (size_t)l * 2048 * 1024, P.w_outT() + (size_t)l * 1024 * 2048, 2048, 1024, 1024, 0, 1 << 30, 0, 1024, (float*)smem, bid, nb,
                     P.ssd_norm_g + l * 1024, 1024);
        ph_transpose(wv, P.peer_wq + (size_t)l * 1024 * 2048, P.w_qT() + (size_t)l * 2048 * 1024, 1024, 2048, 2048, 0, 1 << 30, 0, 2048, (float*)smem, bid, nb);
      }
      break;
    case PH_NORM1:
      ph_norm(wv, hl, hc, P.norm1_g + layer * 1024, P.mod() + (size_t)layer * 5 * MODW, 0, 1024, NTOK, P.u(), bid, nb);
      break;
    case PH_INPROJ:
    {
      pg8::Gemm g{P.u(), P.w_inT() + (size_t)layer * PW * 1024, NTOK, PW, 1024};
      pg8::StaticOrder S; S.init(g.M, g.N, nb, bid);
      pg8::EpiBf16<0> E{P.p(), PW, nullptr, 0, 0};
      pg8::gemm_phase<pg8::EpiBf16<0>, pg8::StaticOrder, false>(wv, (PG8_LAS unsigned char*)smem, g, S, E, nullptr);
      {
        const int units = (NTOK / 256) * (PW / 256), rem = units % nb;
        const int nidle = rem == 0 ? nb : nb - rem, first_idle = rem == 0 ? 0 : rem;
        if (bid >= first_idle) ph_dtprep(wv, P, layer, smem, bid - first_idle, nidle);
      }
      break;
    }
    case PH_CONV: ph_conv(wv, P, layer, bid, nb); ph_vtranspose(wv, P, smem, bid, nb); break;
    case PH_STATES: ph_states_mfma(wv, P, layer, smem, bid, nb); break;
    case PH_SCAN: ph_scan(wv, P, bid, nb); break;
    case PH_SSDY: ph_ssdy_mfma(wv, P, layer, nrows / 128, smem, bid, nb); break;
    case PH_POOL: ph_pool_mfma(wv, P, layer, nrows, smem, bid, nb); break;
    case PH_NA: ph_na_mfma(wv, P, layer, nrows, smem, bid, nb); break;
    case PH_OUTPROJ:
    {
      pg8::Gemm g{P.concat(), P.w_outT() + (size_t)layer * 1024 * 2048, NLAT, 1024, 2048};
      pg8::StaticOrder S; S.init(g.M, g.N, nb, bid);
      EpiOutproj E{P.h(), hl, hc, P.mod() + (size_t)layer * 5 * MODW, P.yss()};
      pg8::gemm_phase<EpiOutproj, pg8::StaticOrder, false>(wv, (PG8_LAS unsigned char*)smem, g, S, E, nullptr);
      if (layer == 0)
        for (int t = bid; t < 16 * 16; t += nb)
          ctx_tile<0>(wv, P, layer, smem, t >> 4, t & 15, P.concat() + (size_t)NLAT * 2048, P.w_outT() + (size_t)layer * 1024 * 2048, 2048, hc);
      break;
    }
    case PH_NORM2:
      ph_norm(wv, P.h(), P.h() + (size_t)NLAT * DM, P.norm2_g + layer * 1024, P.mod() + (size_t)layer * 5 * MODW, 3072, 4096, nrows, P.u(), bid, nb);
      break;
    case PH_QGEMM:
    {
      pg8::Gemm g{P.u(), P.w_qT() + (size_t)layer * 2048 * 1024, NLAT, 2048, 1024};
      pg8::StaticOrder S; S.init(g.M, g.N, nb, bid);
      pg8::EpiBf16<0> E{P.q(), 2048, nullptr, 0, 0};
      pg8::gemm_phase<pg8::EpiBf16<0>, pg8::StaticOrder, false>(wv, (PG8_LAS unsigned char*)smem, g, S, E, nullptr);
      if (layer == 0)
        for (int t = bid; t < 16 * 32; t += nb)
          ctx_tile<1>(wv, P, layer, smem, t >> 5, t & 31, P.u() + (size_t)NLAT * 1024, P.w_qT() + (size_t)layer * 2048 * 1024, 1024, nullptr);
      ph_convert_tables(wv, P, layer, bid, nb);
      break;
    }
    case PH_TOPK: ph_peer_topk_mfma(wv, P, layer, nrows, smem, bid, nb); break;
    case PH_GATHER: ph_peer_dots(wv, P, layer, nrows, bid, nb); ph_peer_acc(wv, P, layer, nrows, bid, nb); break;
  }
}

namespace cg = cooperative_groups;
typedef const __attribute__((address_space(4))) Params* kparams_t;
__device__ __forceinline__ const Params& kp_fresh() {
  kparams_t kp = (kparams_t)__builtin_amdgcn_kernarg_segment_ptr();
  asm volatile("" : "+s"(kp));
  return *(const Params*)kp;
}
__global__ void __launch_bounds__(NTHR) k_mega(Params P_unused) {
  __shared__ __attribute__((aligned(16))) char smem[SMEM_BYTES + 16];
  cg::grid_group grid = cg::this_grid();
  const int bid = blockIdx.x, nb = gridDim.x;
  const int wv = __builtin_amdgcn_readfirstlane(threadIdx.x >> 6);
  if (threadIdx.x == 0) *(uint4*)(smem + SMEM_BYTES) = make_uint4(0u, 0u, 0u, 0u);
  __syncthreads();
  (void)xcd_barrier_post((unsigned*)(kp_fresh().ws + WS_BAR), (volatile LAS unsigned*)(smem + SMEM_BYTES), threadIdx.x == 0);
#define GSYNC() do { XcdBarrier xb_; xb_.bar = (unsigned*)(kp_fresh().ws + WS_BAR); xb_.x = xb_xcc_id(); \
    xb_.st = (volatile LAS unsigned*)(smem + SMEM_BYTES); xcd_barrier(xb_, otid(wv) == 0); } while (0)
  run_phase(wv, kp_fresh(), PH_PREP, 0, smem, bid, nb);
  if (nb == 0x7fffff00) grid.sync();
  GSYNC();
  run_phase(wv, kp_fresh(), PH_NORM1, 0, smem, bid, nb); GSYNC();
#pragma unroll 1
  for (int layer = 0; layer < 2; ++layer) {
    run_phase(wv, kp_fresh(), PH_INPROJ, layer, smem, bid, nb); GSYNC();
    run_phase(wv, kp_fresh(), PH_CONV, layer, smem, bid, nb);
    GSYNC();
    run_phase(wv, kp_fresh(), PH_STATES, layer, smem, bid, nb);
    run_phase(wv, kp_fresh(), PH_POOL, layer, smem, bid, nb);
    run_phase(wv, kp_fresh(), PH_NA, layer, smem, bid, nb); GSYNC();
    run_phase(wv, kp_fresh(), PH_SCAN, layer, smem, bid, nb); GSYNC();
    run_phase(wv, kp_fresh(), PH_SSDY, layer, smem, bid, nb); GSYNC();
    run_phase(wv, kp_fresh(), PH_OUTPROJ, layer, smem, bid, nb); GSYNC();
    run_phase(wv, kp_fresh(), PH_NORM2, layer, smem, bid, nb); GSYNC();
    run_phase(wv, kp_fresh(), PH_QGEMM, layer, smem, bid, nb); GSYNC();
    run_phase(wv, kp_fresh(), PH_TOPK, layer, smem, bid, nb); GSYNC();
    run_phase(wv, kp_fresh(), PH_GATHER, layer, smem, bid, nb);
    if (layer == 0) GSYNC();
  }
}

extern "C" void kernel_launch(void* const* d_in, const int* in_sizes, int n_in, void* d_out, int out_size, void* d_ws,
                              size_t ws_size, hipStream_t stream) {
  Params P{};
  const float* const* in = (const float* const*)d_in;
  P.x = in[0]; P.c = in[1]; P.ctx = in[2]; P.c_ctx = in[3]; P.ada_w = in[4]; P.ada_b = in[5]; P.norm1_g = in[6];
  P.w_in = in[7]; P.conv_w = in[8]; P.conv_b = in[9]; P.a_log = in[10]; P.dt_bias = in[11]; P.d_skip = in[12];
  P.ssd_norm_g = in[13]; P.pool_w = in[14]; P.pool_scale = in[15]; P.na_rpb = in[16]; P.w_out = in[17];
  P.norm2_g = in[18]; P.peer_wq = in[19]; P.peer_keys = in[20]; P.peer_u = in[21]; P.peer_v = in[22]; P.final_g = in[23];
  P.out = (float*)d_out;
  P.ws = (char*)d_ws;
  if (WS_TOTAL > ws_size) { fprintf(stderr, "workspace too small: need %zu have %zu\n", (size_t)WS_TOTAL, ws_size); return; }

  static int grid_blocks = 0;
  if (!grid_blocks) {
    int dev = 0, cus = 0, per_cu = 0;
    hipGetDevice(&dev);
    hipDeviceGetAttribute(&cus, hipDeviceAttributeMultiprocessorCount, dev);
    hipOccupancyMaxActiveBlocksPerMultiprocessor(&per_cu, k_mega, NTHR, 0);
    if (per_cu > 4) per_cu = 4;
    grid_blocks = cus * per_cu;
  }
  hipMemsetAsync((char*)d_ws + WS_BAR, 0, 4096 * 4, stream);
  void* args[] = {&P};
  hipError_t e = hipLaunchCooperativeKernel((void*)k_mega, dim3(grid_blocks), dim3(NTHR), args, 0, stream);
  if (e != hipSuccess) fprintf(stderr, "cooperative launch failed: %s (grid %d)\n", hipGetErrorString(e), grid_blocks);
}
```

```cpp
#include <hip/hip_runtime.h>
#include <hip/hip_bf16.h>
#include <hip/hip_cooperative_groups.h>
#include <stdint.h>
#include <stdio.h>

typedef unsigned short bf16_t;
typedef __attribute__((ext_vector_type(8))) short bf16x8;
typedef __attribute__((ext_vector_type(4))) float f32x4;

#define NTHR 512
#define NWAVE 8
constexpr int DM = 1024;
constexpr int SEQ = 4096;
constexpr int NLAT = 16384;
constexpr int NCTXR = 1024;
constexpr int NTOK = 17408;
constexpr int INW = 4640;
constexpr int PW = 4608;
constexpr int OFF_Z = 0, OFF_XBC = 1024, OFF_POOL = 2560, OFF_Q = 3072, OFF_K = 3584, OFF_V = 4096;
constexpr int NCHUNK = 136;
constexpr int MODW = 6144;

constexpr size_t al256(size_t x) { return (x + 255) & ~(size_t)255; }
constexpr size_t WS_MOD = 0;
constexpr size_t WS_H = WS_MOD + al256((size_t)2 * 5 * MODW * 4);
constexpr size_t WS_P = WS_H + al256((size_t)NTOK * DM * 4);
constexpr size_t WS_TABU = WS_P + (size_t)80 * 1024 * 1024;
constexpr size_t WS_TABV = WS_TABU + (size_t)16384 * 512;
constexpr size_t WS_INVU = WS_TABV + (size_t)16384 * 512;
constexpr size_t WS_INVV = WS_INVU + (size_t)16384 * 4;
constexpr size_t WS_DTRAW = WS_P + al256((size_t)NTOK * PW * 2);
constexpr size_t WS_DTV = WS_DTRAW + al256((size_t)NTOK * 32 * 4);
constexpr size_t WS_CSV = WS_DTV + al256((size_t)NTOK * 32 * 4);
constexpr size_t WS_XBC = WS_CSV + al256((size_t)NTOK * 32 * 4);
constexpr size_t WS_VTL = WS_XBC + al256((size_t)NTOK * 512 * 2);
constexpr size_t WS_VTC = WS_VTL + al256((size_t)4 * 8 * 64 * 4096 * 2);
constexpr size_t WS_KEYSB = WS_VTC + al256((size_t)4 * 8 * 64 * 256 * 2);
constexpr size_t WS_POOLWT = WS_KEYSB + al256((size_t)2 * 8 * 2 * 128 * 128 * 2);
constexpr size_t WS_BT4 = WS_POOLWT + al256((size_t)2 * 4 * 128 * 128 * 2);
constexpr size_t WS_ATOT = WS_BT4 + al256((size_t)NTOK * 256 * 2);
constexpr size_t WS_STATES = WS_XBC + al256((size_t)NTOK * 1536 * 2);
constexpr size_t WS_YSS = WS_ATOT + al256((size_t)NCHUNK * 32 * 4);
static_assert(WS_YSS + (size_t)NTOK * 16 * 4 <= WS_STATES, "must fit in the old xbc region");
constexpr size_t WS_CONCAT = WS_STATES + al256((size_t)NCHUNK * 32 * 8192 * 2);
constexpr size_t WS_SELIDX = WS_CONCAT + al256((size_t)NTOK * 2048 * 2);
constexpr size_t WS_SELG = WS_SELIDX + al256((size_t)NTOK * 128 * 4);
constexpr size_t WS_WINT = WS_SELG + al256((size_t)NTOK * 128 * 4);
constexpr size_t WS_WDTT = WS_WINT + al256((size_t)2 * PW * 1024 * 2);
constexpr size_t WS_WOUTT = WS_WDTT + al256((size_t)2 * 128 * 1024 * 2);
constexpr size_t WS_WQT = WS_WOUTT + al256((size_t)2 * 1024 * 2048 * 2);
constexpr size_t WS_BAR = WS_WQT + al256((size_t)2 * 2048 * 1024 * 2);
constexpr size_t WS_XT4 = WS_BAR + al256((size_t)4096 * 4);
constexpr size_t WS_TOTAL = WS_XT4 + al256((size_t)NTOK * 1024 * 2);
static_assert((size_t)4 * 8 * (4096 + 256) * 64 * 2 <= WS_WINT - WS_SELIDX, "K relayout must fit in the sel_idx/sel_g region");
static_assert(WS_INVV + (size_t)16384 * 4 <= WS_DTRAW, "tables must fit in the tail of p");
static_assert((size_t)NTOK * 2048 * 2 <= (size_t)80 * 1024 * 1024, "q must fit below the tables");

struct Params {
  const float *x, *c, *ctx, *c_ctx, *ada_w, *ada_b, *norm1_g, *w_in, *conv_w, *conv_b, *a_log, *dt_bias, *d_skip,
      *ssd_norm_g, *pool_w, *pool_scale, *na_rpb, *w_out, *norm2_g, *peer_wq, *peer_keys, *peer_u, *peer_v, *final_g;
  float* out;
  char* ws;
  __device__ __forceinline__ float* mod() const { return (float*)(ws + WS_MOD); }
  __device__ __forceinline__ float* h() const { return (float*)(ws + WS_H); }
  __device__ __forceinline__ bf16_t* u() const { return (bf16_t*)(ws + WS_CONCAT); }
  __device__ __forceinline__ bf16_t* p() const { return (bf16_t*)(ws + WS_P); }
  __device__ __forceinline__ float* dtraw() const { return (float*)(ws + WS_DTRAW); }
  __device__ __forceinline__ float* dtv() const { return (float*)(ws + WS_DTV); }
  __device__ __forceinline__ float* csv() const { return (float*)(ws + WS_CSV); }
  __device__ __forceinline__ bf16_t* xbc() const { return (bf16_t*)(ws + WS_XBC); }
  __device__ __forceinline__ bf16_t* states() const { return (bf16_t*)(ws + WS_STATES); }
  __device__ __forceinline__ bf16_t* concat() const { return (bf16_t*)(ws + WS_CONCAT); }
  __device__ __forceinline__ bf16_t* q() const { return (bf16_t*)(ws + WS_P); }
  __device__ __forceinline__ int* sel_idx() const { return (int*)(ws + WS_SELIDX); }
  __device__ __forceinline__ float* sel_g() const { return (float*)(ws + WS_SELG); }
  __device__ __forceinline__ bf16_t* w_inT() const { return (bf16_t*)(ws + WS_WINT); }
  __device__ __forceinline__ bf16_t* w_dtT() const { return (bf16_t*)(ws + WS_WDTT); }
  __device__ __forceinline__ bf16_t* w_outT() const { return (bf16_t*)(ws + WS_WOUTT); }
  __device__ __forceinline__ bf16_t* w_qT() const { return (bf16_t*)(ws + WS_WQT); }
  __device__ __forceinline__ bf16_t* vtl() const { return (bf16_t*)(ws + WS_VTL); }
  __device__ __forceinline__ bf16_t* vtc() const { return (bf16_t*)(ws + WS_VTC); }
  __device__ __forceinline__ bf16_t* poolwT() const { return (bf16_t*)(ws + WS_POOLWT); }
  __device__ __forceinline__ bf16_t* keysb() const { return (bf16_t*)(ws + WS_KEYSB); }
  __device__ __forceinline__ bf16_t* xt4() const { return (bf16_t*)(ws + WS_XT4); }
  __device__ __forceinline__ bf16_t* bt4() const { return (bf16_t*)(ws + WS_BT4); }
  __device__ __forceinline__ float* wst() const { return (float*)(ws + WS_DTRAW); }
  __device__ __forceinline__ float* cst() const { return (float*)(ws + WS_CSV); }
  __device__ __forceinline__ float* dtt() const { return (float*)(ws + WS_DTV); }
  __device__ __forceinline__ float* yss() const { return (float*)(ws + WS_YSS); }
  __device__ __forceinline__ float* atot() const { return (float*)(ws + WS_ATOT); }
  __device__ __forceinline__ bf16_t* bfr() const { return (bf16_t*)(ws + WS_XBC); }
  __device__ __forceinline__ bf16_t* cfr() const { return (bf16_t*)(ws + WS_XBC + (size_t)NTOK * 256 * 2); }
  __device__ __forceinline__ bf16_t* ktl() const { return (bf16_t*)(ws + WS_SELIDX); }
  __device__ __forceinline__ bf16_t* ktc() const { return (bf16_t*)(ws + WS_SELIDX + (size_t)4 * 8 * 4096 * 64 * 2); }
  __device__ __forceinline__ unsigned char* tabU() const { return (unsigned char*)(ws + WS_TABU); }
  __device__ __forceinline__ unsigned char* tabV() const { return (unsigned char*)(ws + WS_TABV); }
  __device__ __forceinline__ float* invU() const { return (float*)(ws + WS_INVU); }
  __device__ __forceinline__ float* invV() const { return (float*)(ws + WS_INVV); }
};

__device__ __forceinline__ int otid(int wv) {
  int l;
  asm volatile("v_mbcnt_lo_u32_b32 %0, -1, 0\n\tv_mbcnt_hi_u32_b32 %0, -1, %0" : "=v"(l));
  return (wv << 6) | l;
}
__device__ __forceinline__ float bf2f(bf16_t v) { return __uint_as_float(((uint32_t)v) << 16); }
typedef __bf16 bf16x2_hw __attribute__((ext_vector_type(2)));
__device__ __forceinline__ uint32_t pack2(float a, float b) {
  const float __attribute__((ext_vector_type(2))) v = {a, b};
  return __builtin_bit_cast(uint32_t, __builtin_convertvector(v, bf16x2_hw));
}
__device__ __forceinline__ bf16_t f2bf(float f) { return (bf16_t)(pack2(f, 0.f) & 0xffffu); }
#define DPP_F(v, ctrl) __int_as_float(__builtin_amdgcn_update_dpp(0, __float_as_int(v), (ctrl), 0xf, 0xf, true))
__device__ __forceinline__ float wave_sum(float v) {
  v += DPP_F(v, 0xB1);
  v += DPP_F(v, 0x4E);
  v += DPP_F(v, 0x141);
  v += DPP_F(v, 0x140);
  const int iv = __float_as_int(v);
  return __int_as_float(__builtin_amdgcn_readlane(iv, 0)) + __int_as_float(__builtin_amdgcn_readlane(iv, 16)) +
         __int_as_float(__builtin_amdgcn_readlane(iv, 32)) + __int_as_float(__builtin_amdgcn_readlane(iv, 48));
}
__device__ __forceinline__ float wave_max(float v) {
  v = fmaxf(v, DPP_F(v, 0xB1));
  v = fmaxf(v, DPP_F(v, 0x4E));
  v = fmaxf(v, DPP_F(v, 0x141));
  v = fmaxf(v, DPP_F(v, 0x140));
  const int iv = __float_as_int(v);
  return fmaxf(fmaxf(__int_as_float(__builtin_amdgcn_readlane(iv, 0)), __int_as_float(__builtin_amdgcn_readlane(iv, 16))),
               fmaxf(__int_as_float(__builtin_amdgcn_readlane(iv, 32)), __int_as_float(__builtin_amdgcn_readlane(iv, 48))));
}
__device__ __forceinline__ float fexp(float v) { return __builtin_amdgcn_exp2f(v * 1.44269504088896341f); }
__device__ __forceinline__ float silu_f(float v) { return v * __builtin_amdgcn_rcpf(1.f + fexp(-v)); }
__device__ __forceinline__ float softplus_f(float v) { return fmaxf(v, 0.f) + log1pf(expf(-fabsf(v))); }
__device__ __forceinline__ float gelu_f(float v) { return 0.5f * v * (1.f + erff(v * 0.70710678118654752f)); }

__device__ __forceinline__ void unpack8(const uint4 v, float* f) {
  f[0] = __uint_as_float(v.x << 16); f[1] = __uint_as_float(v.x & 0xffff0000u);
  f[2] = __uint_as_float(v.y << 16); f[3] = __uint_as_float(v.y & 0xffff0000u);
  f[4] = __uint_as_float(v.z << 16); f[5] = __uint_as_float(v.z & 0xffff0000u);
  f[6] = __uint_as_float(v.w << 16); f[7] = __uint_as_float(v.w & 0xffff0000u);
}
typedef float f32x2_t __attribute__((ext_vector_type(2)));
typedef unsigned u32x4_t __attribute__((ext_vector_type(4)));
typedef short s16x4 __attribute__((ext_vector_type(4)));
typedef __attribute__((address_space(3))) s16x4 lds_s16x4;
__device__ __forceinline__ bf16x8 tr_read2(const char* a0, const char* a1) {
  const s16x4 a = __builtin_amdgcn_ds_read_tr16_b64_v4i16((lds_s16x4*)a0);
  const s16x4 b = __builtin_amdgcn_ds_read_tr16_b64_v4i16((lds_s16x4*)a1);
  return (bf16x8){a[0], a[1], a[2], a[3], b[0], b[1], b[2], b[3]};
}

__device__ __forceinline__ const float* hrow(const float* hl, const float* hc, int row) {
  return row < NLAT ? hl + (size_t)row * DM : hc + (size_t)(row - NLAT) * DM;
}
__device__ __forceinline__ int modrow(int row) { return row < NLAT ? (row >> 12) : 4; }

namespace pg8 {
#define PG8_LAS __attribute__((address_space(3)))
typedef unsigned short bf16_t;
typedef short bf16x8 __attribute__((ext_vector_type(8)));
typedef float f32x4 __attribute__((ext_vector_type(4)));
typedef unsigned u32x4 __attribute__((ext_vector_type(4)));
constexpr int BM = 256, BK = 64, HALF = 128, HTB = HALF * BK * 2  , STAGE_BYTES = 8 * HTB, NXCD = 8, WGM = 8;

__host__ __device__ __forceinline__ int lds_byte(int r, int c) { const int st = (r >> 4) * 2 + (c >> 5), rr = r & 15, cc = c & 31, ob = rr * 64 + cc * 2; return st * 1024 + (ob ^ (((ob >> 9) & 1) << 5)); }
__host__ __device__ __forceinline__ void stage_rc(int b, int& R, int& C) { const int st = b / 1024, sb = b % 1024, swz = sb ^ (((sb >> 9) & 1) << 5); R = (st >> 1) * 16 + swz / 64; C = (st & 1) * 32 + (swz % 64) / 2; }
__host__ __device__ __forceinline__ int perm32(int rho) { const int n = rho >> 4, i = rho & 15; return 8 * (i >> 2) + 4 * n + (i & 3); }

struct Unit { int pm, pn; };
struct Gemm { const bf16_t* A; const bf16_t* Bt; int M, N, K; };

struct StaticOrder {
    int nM, nN, nwg, G, c;
    __host__ __device__ void init(int M, int N, int G_, int c_) { nM = M / BM; nN = N / BM; nwg = nM * nN; G = G_; c = c_; }
    __host__ __device__ bool next(int i, Unit& u) const {
        const long L = (long)i * G + c; if (L >= nwg) return false;
        int wgid = (int)L; { const int q = nwg / NXCD, r = nwg % NXCD, xcd = wgid % NXCD, off = wgid / NXCD; wgid = (xcd < r ? xcd * (q + 1) : r * (q + 1) + (xcd - r) * q) + off; }
        const int nig = WGM * nN, gid = wgid / nig, fm = gid * WGM, gsz = (nM - fm) < WGM ? (nM - fm) : WGM;
        u.pm = fm + ((wgid % nig) % gsz); u.pn = (wgid % nig) / gsz; return true;
    }
    __device__ __forceinline__ void a_ready(const Unit&) const {}
    __device__ __forceinline__ void done(const Unit&) const {}
};

__device__ __forceinline__ unsigned cvt_pk_bf16(float lo, float hi) { unsigned r; asm volatile("v_cvt_pk_bf16_f32 %0, %1, %2" : "=v"(r) : "v"(lo), "v"(hi)); return r; }
typedef float f32x2 __attribute__((ext_vector_type(2)));
__device__ __forceinline__ f32x2 gelu_pk(f32x2 v) { return v; }
template <int ACT  > struct EpiBf16 {
    static constexpr bool PERM = true, AFTER_DRAIN = false; static constexpr int MIDK_T = 0;
    bf16_t* O; int ldc; const float* bias; int split_cols; size_t split_stride;
    __device__ __forceinline__ void operator()(const f32x4 (&acc)[2][2][4][2], const Unit& u, int wr, int wc, int fr, int fq) const {
        const int row0 = u.pm * BM + wr * 64 + fr; int colt = u.pn * BM; bf16_t* base = O;
        if (split_cols) { const int t = colt / split_cols; base += (size_t)t * split_stride; colt -= t * split_cols; }
        const int col0 = colt + wc * 32 + 8 * fq, bcol0 = u.pn * BM + wc * 32 + 8 * fq;
        f32x4 bv[2][2];
#pragma unroll
        for (int bj = 0; bj < 2; ++bj)
#pragma unroll
            for (int n = 0; n < 2; ++n) bv[bj][n] = bias ? *(const f32x4*)(bias + bcol0 + bj * HALF + 4 * n) : (f32x4){0.f, 0.f, 0.f, 0.f};
#pragma unroll
        for (int ai = 0; ai < 2; ++ai)
#pragma unroll
            for (int m = 0; m < 4; ++m) { bf16_t* rowp = base + (size_t)(row0 + ai * HALF + m * 16) * ldc + col0;
#pragma unroll
                for (int bj = 0; bj < 2; ++bj) { f32x4 v0 = acc[ai][bj][m][0] + bv[bj][0], v1 = acc[ai][bj][m][1] + bv[bj][1];
                    if (ACT == 1) { f32x2 a = gelu_pk((f32x2){v0[0], v0[1]}), b = gelu_pk((f32x2){v0[2], v0[3]}), c = gelu_pk((f32x2){v1[0], v1[1]}), d = gelu_pk((f32x2){v1[2], v1[3]});
                        v0 = (f32x4){a.x, a.y, b.x, b.y}; v1 = (f32x4){c.x, c.y, d.x, d.y}; }
                    if (ACT == 2) {
#pragma unroll
                        for (int j = 0; j < 4; ++j) { v0[j] = 0.5f * v0[j] * (1.0f + erff(v0[j] * 0.70710678f)); v1[j] = 0.5f * v1[j] * (1.0f + erff(v1[j] * 0.70710678f)); } }
                    u32x4 w; w.x = cvt_pk_bf16(v0[0], v0[1]); w.y = cvt_pk_bf16(v0[2], v0[3]); w.z = cvt_pk_bf16(v1[0], v1[1]); w.w = cvt_pk_bf16(v1[2], v1[3]);
                    *(u32x4*)(rowp + bj * HALF) = w; } }
    }
};

template <class Epi, class Sched, bool STAMP = false>
__device__ __forceinline__ void gemm_phase(int wv, PG8_LAS unsigned char* lds, const Gemm g, const Sched& S, const Epi& E, unsigned long long* stamps) {
    const int tid = otid(wv), wid = __builtin_amdgcn_readfirstlane(tid >> 6), lane = tid & 63, wr = wid >> 2, wc = wid & 3, fr = lane & 15, fq = lane >> 4;
    const int K = g.K, nt = K / BK;
    int ts_lo = 0, ts_hi = 0, nts = 0; const unsigned long long rt_entry = STAMP ? (unsigned long long)wall_clock64() : 0ull;
#define PG8_STAMP() do { if (STAMP && wid == 0 && nts < 64) { const unsigned long long _c = (unsigned long long)clock64(); \
        ts_lo = (lane == nts) ? (int)(unsigned)_c : ts_lo; ts_hi = (lane == nts) ? (int)(unsigned)(_c >> 32) : ts_hi; ++nts; } } while (0)
    PG8_STAMP();
    unsigned voffA[2], voffB[2];
#pragma unroll
    for (int i = 0; i < 2; ++i) { int R, C; stage_rc(tid * 16 + i * 8192, R, C); const int Rb = Epi::PERM ? ((R & ~31) + perm32(R & 31)) : R;
        voffA[i] = (unsigned)(R * K + C) * 2u; voffB[i] = (unsigned)(Rb * K + C) * 2u; }
    const size_t kstep = (size_t)(BK * 2);
    const size_t hstep = (size_t)HALF * K * 2;
    const size_t tstep = 2 * hstep;
    const unsigned ldsw = (unsigned)wid * 1024u;
    const int aoff = lds_byte(wr * 64 + fr, fq * 8), boff = lds_byte(wc * 32 + fr, fq * 8);
#define PG8_SA(b, h) (((b) * 2 + (h)) * HTB)
#define PG8_SB(b, h) ((4 + (b) * 2 + (h)) * HTB)
#define PG8_STAGE(bufoff, gbase, voff) do { _Pragma("unroll") for (int _i = 0; _i < 2; ++_i) \
        __builtin_amdgcn_global_load_lds((const unsigned*)((const char*)(gbase) + (voff)[_i]), (PG8_LAS unsigned*)(lds + (bufoff) + ldsw + _i * 8192), 16, 0, 0); } while (0)
#define PG8_LDA(dst, b, h) do { _Pragma("unroll") for (int m = 0; m < 4; ++m) _Pragma("unroll") for (int k = 0; k < 2; ++k) dst[m][k] = *(const PG8_LAS bf16x8*)(lds + PG8_SA(b, h) + aoff + m * 2048 + k * 1024); } while (0)
#define PG8_LDB(dst, b, h) do { _Pragma("unroll") for (int n = 0; n < 2; ++n) _Pragma("unroll") for (int k = 0; k < 2; ++k) dst[n][k] = *(const PG8_LAS bf16x8*)(lds + PG8_SB(b, h) + boff + n * 2048 + k * 1024); } while (0)
#define PG8_MMA(ai, bj, At, Bt) do { __builtin_amdgcn_s_setprio(1); _Pragma("unroll") for (int m = 0; m < 4; ++m) _Pragma("unroll") for (int n = 0; n < 2; ++n) _Pragma("unroll") for (int k = 0; k < 2; ++k) \
        acc[ai][bj][m][n] = __builtin_amdgcn_mfma_f32_16x16x32_bf16(Bt[n][k], At[m][k], acc[ai][bj][m][n], 0, 0, 0); __builtin_amdgcn_s_setprio(0); } while (0)
#define PG8_WAIT_V(n) asm volatile("s_waitcnt vmcnt(" #n ")" ::: "memory")
#define PG8_WAIT_L(n) asm volatile("s_waitcnt lgkmcnt(" #n ")" ::: "memory")
#define PG8_BAR __builtin_amdgcn_s_barrier()
#define PG8_SCHED __builtin_amdgcn_sched_barrier(0)
    Unit cur, nxt; int ui = 0;
    if (!S.next(0, cur)) return;
    f32x4 acc[2][2][4][2];
#pragma unroll
    for (int a = 0; a < 2; ++a)
#pragma unroll
        for (int b = 0; b < 2; ++b)
#pragma unroll
            for (int m = 0; m < 4; ++m)
#pragma unroll
                for (int n = 0; n < 2; ++n) acc[a][b][m][n] = (f32x4){0.f, 0.f, 0.f, 0.f};
    bf16x8 At[4][2], B0[2][2], B1[2][2];
    const char* cA = (const char*)g.A + (size_t)cur.pm * tstep; const char* cB = (const char*)g.Bt + (size_t)cur.pn * tstep;
    S.a_ready(cur);
    PG8_STAGE(PG8_SB(0, 0), cB, voffB); PG8_STAGE(PG8_SA(0, 0), cA, voffA); PG8_STAGE(PG8_SB(0, 1), cB + hstep, voffB); PG8_STAGE(PG8_SA(0, 1), cA + hstep, voffA);
    if (wr == 1) PG8_BAR;
    PG8_WAIT_V(4); PG8_BAR;
    PG8_STAGE(PG8_SB(1, 0), cB + kstep, voffB); PG8_STAGE(PG8_SA(1, 0), cA + kstep, voffA); PG8_STAGE(PG8_SB(1, 1), cB + hstep + kstep, voffB);
    PG8_WAIT_V(6); PG8_BAR;
    PG8_STAMP();
    for (;;) {
        const bool has_next = S.next(ui + 1, nxt);
        const char* nA = has_next ? (const char*)g.A + (size_t)nxt.pm * tstep : cA; const char* nB = has_next ? (const char*)g.Bt + (size_t)nxt.pn * tstep : cB;
        for (int t = 0; t < nt; t += 2) {
            if constexpr (Epi::MIDK_T > 0) { if (t == Epi::MIDK_T) E.midk(acc, cur, wr, wc, fr, fq); }
            const bool last = (t == nt - 2);
            const char* a1 = cA + (size_t)(t + 1) * kstep;
            const char* a2 = last ? nA : cA + (size_t)(t + 2) * kstep; const char* b2 = last ? nB : cB + (size_t)(t + 2) * kstep;
            const char* a3 = a2 + kstep; const char* b3 = b2 + kstep;
            if (last && has_next) S.a_ready(nxt);
            PG8_LDB(B0, 0, 0); PG8_SCHED; PG8_LDA(At, 0, 0); PG8_STAGE(PG8_SA(1, 1), a1 + hstep, voffA);
            PG8_WAIT_L(8); PG8_BAR; PG8_WAIT_L(0); PG8_MMA(0, 0, At, B0); PG8_BAR; PG8_SCHED;
            PG8_LDB(B1, 0, 1); PG8_STAGE(PG8_SB(0, 0), b2, voffB);
            PG8_BAR; PG8_WAIT_L(0); PG8_MMA(0, 1, At, B1); PG8_BAR;
            PG8_LDA(At, 0, 1); PG8_STAGE(PG8_SA(0, 0), a2, voffA);
            PG8_BAR; PG8_WAIT_L(0); PG8_MMA(1, 0, At, B0); PG8_BAR; PG8_SCHED;
            PG8_STAGE(PG8_SB(0, 1), b2 + hstep, voffB);
            PG8_WAIT_V(6); PG8_BAR; PG8_MMA(1, 1, At, B1); PG8_BAR;
            PG8_LDB(B0, 1, 0); PG8_SCHED; PG8_LDA(At, 1, 0); PG8_STAGE(PG8_SA(0, 1), a2 + hstep, voffA);
            PG8_WAIT_L(8); PG8_BAR; PG8_WAIT_L(0); PG8_MMA(0, 0, At, B0); PG8_BAR; PG8_SCHED;
            PG8_LDB(B1, 1, 1); PG8_STAGE(PG8_SB(1, 0), b3, voffB);
            PG8_BAR; PG8_WAIT_L(0); PG8_MMA(0, 1, At, B1); PG8_BAR;
            PG8_LDA(At, 1, 1); PG8_STAGE(PG8_SA(1, 0), a3, voffA);
            PG8_BAR; PG8_WAIT_L(0); PG8_MMA(1, 0, At, B0); PG8_BAR; PG8_SCHED;
            PG8_STAGE(PG8_SB(1, 1), b3 + hstep, voffB);
            PG8_WAIT_V(6); PG8_BAR; PG8_MMA(1, 1, At, B1); PG8_BAR;
        }
        PG8_STAMP();
        if constexpr (!Epi::AFTER_DRAIN) { E(acc, cur, wr, wc, fr, fq); S.done(cur); }
        PG8_STAMP();
        if (!has_next) break;
#pragma unroll
        for (int a = 0; a < 2; ++a)
#pragma unroll
            for (int b = 0; b < 2; ++b)
#pragma unroll
                for (int m = 0; m < 4; ++m)
#pragma unroll
                    for (int n = 0; n < 2; ++n) acc[a][b][m][n] = (f32x4){0.f, 0.f, 0.f, 0.f};
        cur = nxt; cA = nA; cB = nB; ++ui;
    }
    PG8_WAIT_V(0);
    if (wr == 0) PG8_BAR;
    PG8_BAR;
    if constexpr (Epi::AFTER_DRAIN) { E.fused(acc, cur, wr, wc, fr, fq, lds, wid, lane); S.done(cur); }
    PG8_STAMP();
    if (STAMP && wid == 0) { stamps[lane] = lane < nts ? (((unsigned long long)(unsigned)ts_hi << 32) | (unsigned)ts_lo) : 0ull;
        if (lane == 62) stamps[62] = rt_entry; if (lane == 63) stamps[63] = (unsigned long long)wall_clock64(); }
#undef PG8_STAMP
#undef PG8_SA
#undef PG8_SB
#undef PG8_STAGE
#undef PG8_LDA
#undef PG8_LDB
#undef PG8_MMA
#undef PG8_WAIT_V
#undef PG8_WAIT_L
#undef PG8_BAR
#undef PG8_SCHED
}
}

#define XB_TMO      128
#define XB_XCNT(j)  (256  + 64 * (j))
#define XB_XSUB(j)  (1280 + 64 * (j))
#define XB_XGEN(j)  (2304 + 64 * (j))
#define XB_TOP      3328
#define XB_TOPGEN   3392
#define XCD_BAR_WORDS 3456
#define XB_SPIN_CAP (1u << 27)
#define LAS __attribute__((address_space(3)))

__device__ __forceinline__ unsigned xb_ld(unsigned* p)              { return __hip_atomic_load(p, __ATOMIC_RELAXED, __HIP_MEMORY_SCOPE_AGENT); }
__device__ __forceinline__ unsigned xb_add(unsigned* p, unsigned v) { return __hip_atomic_fetch_add(p, v, __ATOMIC_RELAXED, __HIP_MEMORY_SCOPE_AGENT); }
__device__ __forceinline__ unsigned xb_xcc_id() { return (unsigned)__builtin_amdgcn_s_getreg((3 << 11) | 20) & 0xFu; }
#define XB_SPIN(cond, bar) do { unsigned _sp = 0; while (cond) { __builtin_amdgcn_s_sleep(1); \
    if ((++_sp & 255u) == 0u) { if (xb_ld(&(bar)[XB_TMO])) break; if (_sp > XB_SPIN_CAP) { atomicAdd(&(bar)[XB_TMO], 1u); break; } } } } while (0)

struct XcdBarrier {
    unsigned* bar; unsigned x;
    volatile LAS unsigned* st;
};

__device__ __forceinline__ XcdBarrier xcd_barrier_post(unsigned* bar, volatile LAS unsigned* st, bool xb_t0) {
    XcdBarrier b; b.bar = bar; b.x = xb_xcc_id(); b.st = st;
    if (xb_t0) (void)xb_add(&bar[XB_XCNT(b.x)], 1u);
    return b;
}
__device__ __forceinline__ void xcd_barrier_complete(unsigned* bar, unsigned x, unsigned& nloc, unsigned& nx) {
    const unsigned G = gridDim.x * gridDim.y * gridDim.z;
    unsigned sum, cnt, mine, sp = 0u;
    for (;;) {
        sum = 0u; cnt = 0u; mine = 0u;
#pragma unroll
        for (unsigned j = 0; j < 16; ++j) { const unsigned c = xb_ld(&bar[XB_XCNT(j)]); sum += c; cnt += (c > 0u) ? 1u : 0u; mine = (j == x) ? c : mine; }
        if (sum == G) break;
        __builtin_amdgcn_s_sleep(1);
        if ((++sp & 255u) == 0u) { if (xb_ld(&bar[XB_TMO])) break; if (sp > XB_SPIN_CAP) { atomicAdd(&bar[XB_TMO], 1u); break; } }
    }
    nloc = mine > 0u ? mine : 1u; nx = cnt > 0u ? cnt : 1u;
}

__device__ __forceinline__ void xcd_barrier(const XcdBarrier& b, bool xb_t0) {
    asm volatile("s_waitcnt vmcnt(0)" ::: "memory");
    __syncthreads();
    if (xb_t0) {
        unsigned* bar = b.bar;
        __builtin_amdgcn_s_waitcnt(0);
        unsigned nloc = b.st[0], nx = b.st[1];
        if (nloc == 0u) { xcd_barrier_complete(bar, b.x, nloc, nx); b.st[0] = nloc; b.st[1] = nx; }
        const unsigned old = xb_add(&bar[XB_XSUB(b.x)], 1u);
        const unsigned gen = old / nloc;
        if (old + 1u == (gen + 1u) * nloc) {
            __builtin_amdgcn_fence(__ATOMIC_RELEASE, "agent");
            asm volatile("s_waitcnt vmcnt(0)" ::: "memory");
            const unsigned og = xb_add(&bar[XB_TOP], 1u);
            const unsigned tg = og / nx;
            if (og + 1u == (tg + 1u) * nx) xb_add(&bar[XB_TOPGEN], 1u);
            else XB_SPIN(xb_ld(&bar[XB_TOPGEN]) == tg, bar);
            __builtin_amdgcn_fence(__ATOMIC_ACQUIRE, "agent");
            xb_add(&bar[XB_XGEN(b.x)], 1u);
            asm volatile("s_waitcnt vmcnt(0)" ::: "memory");
        } else {
            XB_SPIN(xb_ld(&bar[XB_XGEN(b.x)]) == gen, bar);
            __builtin_amdgcn_fence(__ATOMIC_ACQUIRE, "agent");
            asm volatile("s_waitcnt vmcnt(0)" ::: "memory");
        }
    }
    __syncthreads();
}


__device__ void ph_transpose(int wv, const float* __restrict__ src, bf16_t* __restrict__ dst, int K, int N, int Npad,
                             int col0, int skip_from, int skip, int nvalid, float* tile, int bid, int nb,
                             const float* kscale = nullptr, int kscale_n = 0) {
  const int tk = K / 64, tn = Npad / 64;
  const int tid = otid(wv);
  for (int t = bid; t < tk * tn; t += nb) {
    const int kt = t / tn, nt = t % tn;
    __syncthreads();
#pragma unroll
    for (int i = 0; i < 2; ++i) {
      const int idx = tid + i * 512, kk = idx >> 4, n4 = (idx & 15) * 4;
      const int k = kt * 64 + kk, n = nt * 64 + n4;
      const int cc = col0 + n + (n >= skip_from ? skip : 0);
      const float ks = (kscale != nullptr && k < kscale_n) ? kscale[k] : 1.f;
      float4 v = make_float4(0.f, 0.f, 0.f, 0.f);
      if (n < nvalid) v = *(const float4*)(src + (size_t)k * N + cc);
      tile[kk * 65 + n4 + 0] = v.x * ks; tile[kk * 65 + n4 + 1] = v.y * ks; tile[kk * 65 + n4 + 2] = v.z * ks; tile[kk * 65 + n4 + 3] = v.w * ks;
    }
    __syncthreads();
    {
      const int nn = tid >> 3, k8 = (tid & 7) * 8;
      float f[8];
#pragma unroll
      for (int e = 0; e < 8; ++e) f[e] = tile[(k8 + e) * 65 + nn];
      *(uint4*)(dst + (size_t)(nt * 64 + nn) * K + kt * 64 + k8) = make_uint4(pack2(f[0], f[1]), pack2(f[2], f[3]), pack2(f[4], f[5]), pack2(f[6], f[7]));
    }
  }
}

__device__ void ph_mod(int wv, const Params& P, float* sm, int bid, int nb) {
  const int tid = otid(wv);
  float* sv = sm;
  float* red = sm + 5 * 1024;
  for (int i = tid; i < 5 * 1024; i += NTHR) {
    const float v = (i < 4096) ? P.c[i] : P.c_ctx[i - 4096];
    sv[i] = silu_f(v);
  }
  __syncthreads();
  const int c4 = tid & 15, kg = tid >> 4;
  for (int it = bid; it < 192; it += nb) {
    const int layer = it / 96, cb = it % 96;
    const float4* W = (const float4*)(P.ada_w + (size_t)layer * 1024 * MODW + cb * 64) + c4;
    float4 a[5];
#pragma unroll
    for (int r = 0; r < 5; ++r) a[r] = make_float4(0.f, 0.f, 0.f, 0.f);
#pragma unroll 8
    for (int kk = 0; kk < 32; ++kk) {
      const int k = kg * 32 + kk;
      const float4 w = W[(size_t)k * (MODW / 4)];
#pragma unroll
      for (int r = 0; r < 5; ++r) {
        const float s = sv[r * 1024 + k];
        a[r].x += s * w.x; a[r].y += s * w.y; a[r].z += s * w.z; a[r].w += s * w.w;
      }
    }
#pragma unroll
    for (int r = 0; r < 5; ++r) *(float4*)(red + ((kg * 16 + c4) * 5 + r) * 4) = a[r];
    __syncthreads();
    if (tid < 320) {
      const int r = tid >> 6, c = tid & 63;
      float s = 0.f;
      for (int g = 0; g < 32; ++g) s += red[((g * 16 + (c >> 2)) * 5 + r) * 4 + (c & 3)];
      P.mod()[(size_t)(layer * 5 + r) * MODW + cb * 64 + c] = s + P.ada_b[layer * MODW + cb * 64 + c];
    }
    __syncthreads();
  }
}

__device__ void ph_norm(int wv, const float* hl, const float* hc, const float* __restrict__ g, const float* __restrict__ modl,
                        int shift_off, int scale_off, int nrows, bf16_t* __restrict__ dst, int bid, int nb) {
  const int wave = otid(wv) >> 6, lane = otid(wv) & 63;
  const int stride = nb * NWAVE;
  for (int row0 = bid * NWAVE + wave; row0 < nrows; row0 += 2 * stride) {
    const int row1 = row0 + stride;
    const bool two = row1 < nrows;
    const int rows[2] = {row0, two ? row1 : row0};
    f32x4 v[2][4], ggv[4], scv[2][4], shv[2][4];
#pragma unroll
    for (int r = 0; r < 2; ++r) {
      const float* src = hrow(hl, hc, rows[r]);
      const float* mr = modl + (size_t)modrow(rows[r]) * MODW;
#pragma unroll
      for (int i = 0; i < 4; ++i) {
        const int idx = i * 256 + lane * 4;
        v[r][i] = *(const f32x4*)(src + idx);
        scv[r][i] = *(const f32x4*)(mr + scale_off + idx); shv[r][i] = *(const f32x4*)(mr + shift_off + idx);
      }
    }
#pragma unroll
    for (int i = 0; i < 4; ++i) ggv[i] = *(const f32x4*)(g + i * 256 + lane * 4);
#pragma unroll
    for (int r = 0; r < 2; ++r)
#pragma unroll
      for (int i = 0; i < 4; ++i) asm volatile("" : "+v"(v[r][i]), "+v"(scv[r][i]), "+v"(shv[r][i]));
#pragma unroll
    for (int r = 0; r < 2; ++r) {
      float ss = 0.f;
#pragma unroll
      for (int i = 0; i < 4; ++i) ss += v[r][i][0] * v[r][i][0] + v[r][i][1] * v[r][i][1] + v[r][i][2] * v[r][i][2] + v[r][i][3] * v[r][i][3];
      ss = wave_sum(ss);
      const float rstd = rsqrtf(ss * (1.f / 1024.f) + 1e-6f);
      if (r == 0 || two) {
#pragma unroll
        for (int i = 0; i < 4; ++i) {
          const int idx = i * 256 + lane * 4;
          const float o0 = v[r][i][0] * rstd * ggv[i][0] * (1.f + scv[r][i][0]) + shv[r][i][0];
          const float o1 = v[r][i][1] * rstd * ggv[i][1] * (1.f + scv[r][i][1]) + shv[r][i][1];
          const float o2 = v[r][i][2] * rstd * ggv[i][2] * (1.f + scv[r][i][2]) + shv[r][i][2];
          const float o3 = v[r][i][3] * rstd * ggv[i][3] * (1.f + scv[r][i][3]) + shv[r][i][3];
          *(uint2*)(dst + (size_t)rows[r] * DM + idx) = make_uint2(pack2(o0, o1), pack2(o2, o3));
        }
      }
    }
  }
}

__device__ void ph_conv(int wv, const Params& P, int layer, int bid, int nb) {
  const float* cw = P.conv_w + (size_t)layer * 3 * 1536;
  const float* cb = P.conv_b + (size_t)layer * 1536;
  const int total = (NTOK / 4) * 192;
  for (int it = bid * NTHR + otid(wv); it < total; it += nb * NTHR) {
    const int rq = it / 192, c8 = (it % 192) * 8, row0 = rq * 4;
    int l, L;
    if (row0 < NLAT) { l = row0 & 4095; L = 4096; } else { l = (row0 - NLAT) & 255; L = 256; }
    const bf16_t* pc = P.p() + (size_t)row0 * PW + OFF_XBC + c8;
    u32x4_t rv[6];
    rv[0] = *(const u32x4_t*)(pc - (l > 0 ? PW : 0));
#pragma unroll
    for (int i = 0; i < 4; ++i) rv[1 + i] = *(const u32x4_t*)(pc + (size_t)i * PW);
    rv[5] = *(const u32x4_t*)(pc + (size_t)(l + 4 < L ? 4 : 3) * PW);
#pragma unroll
    for (int i = 0; i < 6; ++i) asm volatile("" : "+v"(rv[i]));
    float f[6][8];
#pragma unroll
    for (int i = 0; i < 6; ++i) unpack8(make_uint4(rv[i].x, rv[i].y, rv[i].z, rv[i].w), f[i]);
    const float mp = l > 0 ? 1.f : 0.f, mn = l + 4 < L ? 1.f : 0.f;
    float o[4][8];
#pragma unroll
    for (int e = 0; e < 8; ++e) {
      const int c = c8 + e;
      const float w0 = cw[c], w1 = cw[1536 + c], w2 = cw[3072 + c], bb = cb[c];
#pragma unroll
      for (int i = 0; i < 4; ++i) {
        const float pv = i == 0 ? mp * f[0][e] : f[i][e];
        const float nv = i == 3 ? mn * f[5][e] : f[i + 2][e];
        o[i][e] = silu_f(bb + w0 * pv + w1 * f[i + 1][e] + w2 * nv);
      }
    }
    if (c8 < 1024) {
      const int head = c8 >> 6, p0 = c8 & 63;
      bf16_t* dst = P.xt4() + (((size_t)head * (NTOK / 4) + rq) * 64 + p0) * 4;
#pragma unroll
      for (int e2 = 0; e2 < 4; ++e2)
        *(uint4*)(dst + e2 * 8) = make_uint4(pack2(o[0][2 * e2], o[1][2 * e2]), pack2(o[2][2 * e2], o[3][2 * e2]),
                                             pack2(o[0][2 * e2 + 1], o[1][2 * e2 + 1]), pack2(o[2][2 * e2 + 1], o[3][2 * e2 + 1]));
    } else {
      {
        const int cc = (c8 - 1024) & 255, grp_ = cc >> 7, n0_ = cc & 127;
        bf16_t* fb = (c8 < 1280 ? P.bfr() : P.cfr()) + ((((size_t)grp_ * (NTOK / 16) + (row0 >> 4)) * 4 + (n0_ >> 5)) * 16 + (row0 & 15)) * 32 + (n0_ & 31);
#pragma unroll
        for (int i = 0; i < 4; ++i)
          *(uint4*)(fb + i * 32) = make_uint4(pack2(o[i][0], o[i][1]), pack2(o[i][2], o[i][3]), pack2(o[i][4], o[i][5]), pack2(o[i][6], o[i][7]));
      }
      if (c8 < 1280) {
        const int grp = (c8 - 1024) >> 7, n0 = (c8 - 1024) & 127;
        bf16_t* dst = P.bt4() + (((size_t)grp * (NTOK / 4) + rq) * 128 + n0) * 4;
#pragma unroll
        for (int e2 = 0; e2 < 4; ++e2)
          *(uint4*)(dst + e2 * 8) = make_uint4(pack2(o[0][2 * e2], o[1][2 * e2]), pack2(o[2][2 * e2], o[3][2 * e2]),
                                               pack2(o[0][2 * e2 + 1], o[1][2 * e2 + 1]), pack2(o[2][2 * e2 + 1], o[3][2 * e2 + 1]));
      }
    }
  }
}

__device__ void ph_dtprep(int wv, const Params& P, int layer, char* smem, int first, int step) {
  const int tid = otid(wv), lane = tid & 63, li = lane & 15, g = lane >> 4;
  float* tile = (float*)smem;
  float* segtot = tile + 128 * 33;
  const int dh = tid & 31, seg = tid >> 5;
  const float bias = P.dt_bias[layer * 32 + dh];
  const float ah = -expf(P.a_log[layer * 32 + dh]);
  const bf16_t* wb = P.w_dtT() + (size_t)layer * 128 * 1024 + (size_t)li * 1024 + 8 * g;
  for (int gc = first; gc < NCHUNK; gc += step) {
    const bf16_t* ua = P.u() + (size_t)(gc * 128 + wv * 16 + li) * DM + 8 * g;
    f32x4 acc0 = (f32x4){0.f, 0.f, 0.f, 0.f}, acc1 = acc0;
#pragma unroll 1
    for (int t0 = 0; t0 < 32; t0 += 8) {
      bf16x8 a[8], b0[8], b1[8];
#pragma unroll
      for (int t = 0; t < 8; ++t) {
        a[t] = *(const bf16x8*)(ua + 32 * (t0 + t));
        b0[t] = *(const bf16x8*)(wb + 32 * (t0 + t));
        b1[t] = *(const bf16x8*)(wb + 16 * 1024 + 32 * (t0 + t));
      }
#pragma unroll
      for (int t = 0; t < 8; ++t) asm volatile("" : "+v"(a[t]), "+v"(b0[t]), "+v"(b1[t]));
#pragma unroll
      for (int t = 0; t < 8; ++t) {
        acc0 = __builtin_amdgcn_mfma_f32_16x16x32_bf16(a[t], b0[t], acc0, 0, 0, 0);
        acc1 = __builtin_amdgcn_mfma_f32_16x16x32_bf16(a[t], b1[t], acc1, 0, 0, 0);
      }
    }
    __syncthreads();
#pragma unroll
    for (int e = 0; e < 4; ++e) {
      tile[(wv * 16 + 4 * g + e) * 33 + li] = acc0[e];
      tile[(wv * 16 + 4 * g + e) * 33 + 16 + li] = acc1[e];
    }
    __syncthreads();
    float r[8], c[8];
    float cs = 0.f;
#pragma unroll
    for (int j = 0; j < 8; ++j) { r[j] = softplus_f(tile[(seg * 8 + j) * 33 + dh] + bias); cs += r[j] * ah; c[j] = cs; }
    segtot[seg * 32 + dh] = cs;
    __syncthreads();
    float off = 0.f, tot = 0.f;
    for (int s = 0; s < 16; ++s) { const float v = segtot[s * 32 + dh]; if (s < seg) off += v; tot += v; }
    const size_t base = ((size_t)(gc * 32 + dh) * 128 + seg * 8);
    float cso[8], wso[8];
#pragma unroll
    for (int j = 0; j < 8; ++j) {
      const float csj = off + c[j], csp = j == 0 ? off : off + c[j - 1];
      cso[j] = dh < 16 ? csj : csp;
      wso[j] = r[j] * (dh < 16 ? fexp(tot - csj) : fexp(csp));
    }
#pragma unroll
    for (int q = 0; q < 2; ++q) {
      *(float4*)(P.cst() + base + q * 4) = make_float4(cso[q * 4], cso[q * 4 + 1], cso[q * 4 + 2], cso[q * 4 + 3]);
      *(float4*)(P.dtt() + base + q * 4) = make_float4(r[q * 4], r[q * 4 + 1], r[q * 4 + 2], r[q * 4 + 3]);
      *(float4*)(P.wst() + base + q * 4) = make_float4(wso[q * 4], wso[q * 4 + 1], wso[q * 4 + 2], wso[q * 4 + 3]);
    }
    if (seg == 0) P.atot()[gc * 32 + dh] = tot;
  }
}

__device__ __forceinline__ int scan_chunk(int b, int dir, int s) {
  if (dir == 0) return (s < 2) ? (128 + 2 * b + s) : (32 * b + (s - 2));
  return (s < 2) ? (128 + 2 * b + 1 - s) : (32 * b + 31 - (s - 2));
}
__device__ void ph_scan(int wv, const Params& P, int bid, int nb) {
  const int total = 4 * 32 * 1024;
  for (int it = bid * NTHR + otid(wv); it < total; it += nb * NTHR) {
    const int e8 = it & 1023, dh = (it >> 10) & 31, b = it >> 15, dir = dh >> 4;
    float S[8];
    float zero_ = 0.f;
    asm volatile("" : "+v"(zero_));
#pragma unroll
    for (int i = 0; i < 8; ++i) S[i] = zero_;
#pragma unroll
    for (int hb = 0; hb < 2; ++hb) {
      u32x4_t v[17];
      float at[17];
#pragma unroll
      for (int s = 0; s < 17; ++s) {
        const int gc = scan_chunk(b, dir, hb * 17 + s);
        v[s] = *(const u32x4_t*)(P.states() + (size_t)(gc * 32 + dh) * 8192 + e8 * 8);
        at[s] = P.atot()[gc * 32 + dh];
      }
#pragma unroll
      for (int s = 0; s < 17; ++s) asm volatile("" : "+v"(v[s]));
#pragma unroll
      for (int s = 0; s < 17; ++s) {
        const int gc = scan_chunk(b, dir, hb * 17 + s);
        const float dec = fexp(at[s]);
        float cst[8];
        unpack8(make_uint4(v[s].x, v[s].y, v[s].z, v[s].w), cst);
        *(uint4*)(P.states() + (size_t)(gc * 32 + dh) * 8192 + e8 * 8) =
            make_uint4(pack2(S[0], S[1]), pack2(S[2], S[3]), pack2(S[4], S[5]), pack2(S[6], S[7]));
#pragma unroll
        for (int i = 0; i < 8; ++i) S[i] = dec * S[i] + cst[i];
      }
    }
  }
}

__device__ __forceinline__ void conv_x8(const Params& P, int layer, int row, int ch0, float* out) {
  int l, L;
  if (row < NLAT) { l = row & 4095; L = 4096; } else { l = (row - NLAT) & 255; L = 256; }
  const bf16_t* pc = P.p() + (size_t)row * PW + OFF_XBC + ch0;
  const uint4 cur = *(const uint4*)pc;
  const uint4 prv = *(const uint4*)(pc - (l > 0 ? PW : 0));
  const uint4 nxt = *(const uint4*)(pc + (l < L - 1 ? PW : 0));
  const float mp = l > 0 ? 1.f : 0.f, mn = l < L - 1 ? 1.f : 0.f;
  float fp[8], fc[8], fn[8];
  unpack8(prv, fp); unpack8(cur, fc); unpack8(nxt, fn);
  const float* cw = P.conv_w + (size_t)layer * 3 * 1536 + ch0;
  const float* cb = P.conv_b + (size_t)layer * 1536 + ch0;
#pragma unroll
  for (int e = 0; e < 8; ++e) out[e] = silu_f(cb[e] + cw[e] * (mp * fp[e]) + cw[1536 + e] * fc[e] + cw[3072 + e] * (mn * fn[e]));
}

constexpr int XS = 72;
constexpr int BS = 136;


__device__ __forceinline__ bool ssd_item(int round, int bid, int nb, int nchunks, int& gc, int& head) {
  if ((nb & 63) == 0) {
    const int x = bid & 7, j = bid >> 3, per = nb >> 6;
    const int cg = (round * per + (j >> 3)) * 8 + x;
    if (cg >= nchunks * 2) return false;
    gc = cg >> 1; head = (cg & 1) * 8 + (j & 7);
    return true;
  }
  const int it = round * nb + bid;
  if (it >= nchunks * 16) return false;
  gc = it >> 4; head = it & 15;
  return true;
}

__device__ void ph_states_mfma(int wv, const Params& P, int layer, char* smem, int bid, int nb) {
  const int lane = otid(wv) & 63, li = lane & 15, g = lane >> 4;
  const int nq = wv >> 1, ph = wv & 1;
  for (int round = 0;; ++round) {
    int gc, head;
    if (!ssd_item(round, bid, nb, NCHUNK, gc, head)) break;
    const int grp = head >> 3, q0 = gc * 32;
    const bf16_t* xb = P.xt4() + (((size_t)head * (NTOK / 4) + q0 + g) * 64 + ph * 32 + li) * 4;
    const bf16_t* bb = P.bt4() + (((size_t)grp * (NTOK / 4) + q0 + g) * 128 + nq * 32 + li) * 4;
    const float* wpf = P.wst() + (size_t)(gc * 32 + head) * 128 + 4 * g;
    const float* wpb = wpf + 16 * 128;
    f32x4 acc[2][2][2];
#pragma unroll
    for (int d = 0; d < 2; ++d)
#pragma unroll
      for (int a = 0; a < 2; ++a)
#pragma unroll
        for (int b = 0; b < 2; ++b) acc[d][a][b] = (f32x4){0.f, 0.f, 0.f, 0.f};
#pragma unroll
    for (int t = 0; t < 4; ++t) {
      s16x4 alo[2], ahi[2], xlo[2], xhi[2];
      f32x4 wfl, wfh, wbl, wbh;
#pragma unroll
      for (int i = 0; i < 2; ++i) {
        alo[i] = *(const s16x4*)(bb + ((size_t)(t * 8) * 128 + i * 16) * 4);
        ahi[i] = *(const s16x4*)(bb + ((size_t)(t * 8 + 4) * 128 + i * 16) * 4);
        xlo[i] = *(const s16x4*)(xb + ((size_t)(t * 8) * 64 + i * 16) * 4);
        xhi[i] = *(const s16x4*)(xb + ((size_t)(t * 8 + 4) * 64 + i * 16) * 4);
      }
      wfl = *(const f32x4*)(wpf + 32 * t); wfh = *(const f32x4*)(wpf + 32 * t + 16);
      wbl = *(const f32x4*)(wpb + 32 * t); wbh = *(const f32x4*)(wpb + 32 * t + 16);
      asm volatile("" : "+v"(alo[0]), "+v"(alo[1]), "+v"(ahi[0]), "+v"(ahi[1]));
      bf16x8 af[2];
#pragma unroll
      for (int i = 0; i < 2; ++i) af[i] = (bf16x8){alo[i][0], alo[i][1], alo[i][2], alo[i][3], ahi[i][0], ahi[i][1], ahi[i][2], ahi[i][3]};
#pragma unroll
      for (int d = 0; d < 2; ++d) {
        const f32x4 wl = d == 0 ? wfl : wbl, wh = d == 0 ? wfh : wbh;
#pragma unroll
        for (int b = 0; b < 2; ++b) {
          bf16x8 bfrag;
#pragma unroll
          for (int i = 0; i < 4; ++i) {
            bfrag[i] = (short)f2bf(bf2f((bf16_t)xlo[b][i]) * wl[i]);
            bfrag[4 + i] = (short)f2bf(bf2f((bf16_t)xhi[b][i]) * wh[i]);
          }
#pragma unroll
          for (int a = 0; a < 2; ++a) acc[d][a][b] = __builtin_amdgcn_mfma_f32_16x16x32_bf16(af[a], bfrag, acc[d][a][b], 0, 0, 0);
        }
      }
    }
#pragma unroll
    for (int d = 0; d < 2; ++d) {
      bf16_t* dst = P.states() + (size_t)(gc * 32 + d * 16 + head) * 8192;
#pragma unroll
      for (int a = 0; a < 2; ++a)
#pragma unroll
        for (int b = 0; b < 2; ++b) {
          uint2 o;
          o.x = pack2(acc[d][a][b][0], acc[d][a][b][1]); o.y = pack2(acc[d][a][b][2], acc[d][a][b][3]);
          *(uint2*)(dst + ((nq * 4 + 2 * ph + b) * 16 + li) * 32 + 16 * a + 4 * g) = o;
        }
    }
  }
}

__device__ void ph_ssdy_mfma(int wv, const Params& P, int layer, int nchunks, char* smem, int bid, int nb) {
  const int tid = otid(wv), lane = tid & 63, li = lane & 15, g = lane >> 4;
  float* tabs = (float*)smem;
  char* bbuf = smem + 4096;
  char* xbuf = bbuf + 65536;
  char* sbufS = xbuf + 32768;
  u32x4_t pf[10];
  float pft = 0.f;
#pragma unroll
  for (int i = 0; i < 10; ++i) pf[i] = (u32x4_t){0u, 0u, 0u, 0u};
#define SSDY_FETCH(gc_, head_) do { const int grp_ = (head_) >> 3; \
      const char* bsrc_ = (const char*)(P.bfr() + ((size_t)grp_ * (NTOK / 16) + (gc_) * 8) * 4 * 16 * 32); \
      const char* xsrc_ = (const char*)(P.xt4() + ((size_t)(head_) * (NTOK / 4) + (gc_) * 32) * 64 * 4); \
      _Pragma("unroll") for (int i_ = 0; i_ < 4; ++i_) pf[i_] = *(const u32x4_t*)(bsrc_ + (size_t)(tid + i_ * 512) * 16); \
      _Pragma("unroll") for (int i_ = 0; i_ < 2; ++i_) pf[4 + i_] = *(const u32x4_t*)(xsrc_ + (size_t)(tid + i_ * 512) * 16); \
      _Pragma("unroll") for (int i_ = 0; i_ < 4; ++i_) { const int c_ = tid + i_ * 512; \
        pf[6 + i_] = *(const u32x4_t*)((const char*)(P.states() + (size_t)((gc_) * 32 + (c_ >> 10) * 16 + (head_)) * 8192) + (size_t)(c_ & 1023) * 16); } \
      { const int arr_ = tid >> 7, j_ = tid & 127; \
        pft = ((arr_ & 1) ? P.dtt() : P.cst())[(size_t)((gc_) * 32 + (arr_ >> 1) * 16 + (head_)) * 128 + j_]; } } while (0)
#define SSDY_PUT_S() do { _Pragma("unroll") for (int i_ = 0; i_ < 4; ++i_) *(u32x4_t*)(sbufS + (size_t)(tid + i_ * 512) * 16) = pf[6 + i_]; } while (0)
#define SSDY_PUT_BX(buf_) do { \
      _Pragma("unroll") for (int i_ = 0; i_ < 4; ++i_) *(u32x4_t*)(bbuf + (buf_) * 32768 + (size_t)(tid + i_ * 512) * 16) = pf[i_]; \
      _Pragma("unroll") for (int i_ = 0; i_ < 2; ++i_) *(u32x4_t*)(xbuf + (buf_) * 16384 + (size_t)(tid + i_ * 512) * 16) = pf[4 + i_]; \
      tabs[(buf_) * 512 + tid] = pft; } while (0)
  {
    int gc0 = 0, head0 = 0;
    __syncthreads();
    if (ssd_item(0, bid, nb, nchunks, gc0, head0)) { SSDY_FETCH(gc0, head0); SSDY_PUT_BX(0); SSDY_PUT_S(); }
    __syncthreads();
  }
  for (int round = 0;; ++round) {
    int gc, head;
    if (!ssd_item(round, bid, nb, nchunks, gc, head)) break;
    const int grp = head >> 3, row0 = gc * 128;
    const char* bs = bbuf + (round & 1) * 32768;
    const char* xs_l = xbuf + (round & 1) * 16384;
    const float* csf = tabs + (round & 1) * 512;
    const float* dtf = csf + 128;
    const float* exb = csf + 256;
    const float* dtb = csf + 384;
    int gcn = 0, headn = 0;
    const bool has_next = ssd_item(round + 1, bid, nb, nchunks, gcn, headn);
    if (has_next) SSDY_FETCH(gcn, headn);
    const float atb = P.atot()[gc * 32 + 16 + head];
    bf16x8 cfrag[4];
    {
      const bf16_t* cp = P.cfr() + ((((size_t)grp * (NTOK / 16) + gc * 8 + wv) * 4) * 16 + li) * 32 + 8 * g;
#pragma unroll
      for (int t = 0; t < 4; ++t) cfrag[t] = *(const bf16x8*)(cp + t * 512);
    }
    f32x4 accG[8];
#pragma unroll
    for (int sb = 0; sb < 8; ++sb) accG[sb] = (f32x4){0.f, 0.f, 0.f, 0.f};
#pragma unroll
    for (int sp = 0; sp < 4; ++sp) {
      bf16x8 bfv[8];
#pragma unroll
      for (int i = 0; i < 8; ++i) {
        const int sb = sp * 2 + (i >> 2), t = i & 3;
        bfv[i] = *(const bf16x8*)(bs + (((sb * 4 + t) * 16 + li) * 32 + 8 * g) * 2);
      }
#pragma unroll
      for (int i = 0; i < 8; ++i) {
        const int sb = sp * 2 + (i >> 2), t = i & 3;
        accG[sb] = __builtin_amdgcn_mfma_f32_16x16x32_bf16(bfv[i], cfrag[t], accG[sb], 0, 0, 0);
      }
    }
    f32x4 accY[4];
#pragma unroll
    for (int pb = 0; pb < 4; ++pb) accY[pb] = (f32x4){0.f, 0.f, 0.f, 0.f};
    const int jl = 16 * wv + li;
    const float csf_j = csf[jl], exb_j = exb[jl];
#pragma unroll
    for (int dir = 0; dir < 2; ++dir) {
      f32x4 accO[4];
#pragma unroll
      for (int pb = 0; pb < 4; ++pb) accO[pb] = (f32x4){0.f, 0.f, 0.f, 0.f};
      const char* st = sbufS + dir * 16384;
#pragma unroll
      for (int th = 0; th < 2; ++th) {
        bf16x8 sfr[8];
#pragma unroll
        for (int i = 0; i < 8; ++i) sfr[i] = *(const bf16x8*)(st + (((th * 2 + (i >> 2)) * 4 + (i & 3)) * 512 + li * 32 + 8 * g) * 2);
#pragma unroll
        for (int tt = 0; tt < 2; ++tt)
#pragma unroll
          for (int pb = 0; pb < 4; ++pb) accO[pb] = __builtin_amdgcn_mfma_f32_16x16x32_bf16(cfrag[th * 2 + tt], sfr[tt * 4 + pb], accO[pb], 0, 0, 0);
      }
#pragma unroll
      for (int e = 0; e < 4; ++e) {
        const int j = 16 * wv + 4 * g + e;
        const float sc = dir == 0 ? fexp(csf[j]) : fexp(atb - exb[j]);
#pragma unroll
        for (int pb = 0; pb < 4; ++pb) accY[pb][e] += accO[pb][e] * sc;
      }
    }
    __syncthreads();
    if (has_next) SSDY_PUT_S();
    const char* xq = xs_l + ((g * 64 + li) * 4) * 2;
#pragma unroll
    for (int t = 0; t < 4; ++t) {
      const bool need_f = !(32 * t > 16 * wv + 15), need_b = !(32 * t + 31 < 16 * wv);
      if (!need_f && !need_b) continue;
      s16x4 xlo[4], xhi[4];
#pragma unroll
      for (int pb = 0; pb < 4; ++pb) {
        xlo[pb] = *(const s16x4*)(xq + (((8 * t) * 64 + 16 * pb) * 4) * 2);
        xhi[pb] = *(const s16x4*)(xq + (((8 * t + 4) * 64 + 16 * pb) * 4) * 2);
      }
#pragma unroll
      for (int dir = 0; dir < 2; ++dir) {
        if (dir == 0 ? !need_f : !need_b) continue;
        bf16x8 afrag;
#pragma unroll
        for (int hh = 0; hh < 2; ++hh) {
          const int s0 = 32 * t + 16 * hh + 4 * g;
          const f32x4 gv = accG[2 * t + hh];
          const f32x4 cv = dir == 0 ? *(const f32x4*)(csf + s0) : *(const f32x4*)(exb + s0);
          const f32x4 dv = dir == 0 ? *(const f32x4*)(dtf + s0) : *(const f32x4*)(dtb + s0);
#pragma unroll
          for (int e = 0; e < 4; ++e) {
            const int s = s0 + e;
            float m;
            if (dir == 0) m = (s <= jl) ? gv[e] * dv[e] * fexp(csf_j - cv[e]) : 0.f;
            else m = (s >= jl) ? gv[e] * dv[e] * fexp(cv[e] - exb_j) : 0.f;
            afrag[hh * 4 + e] = (short)f2bf(m);
          }
        }
#pragma unroll
        for (int pb = 0; pb < 4; ++pb) {
          const bf16x8 bfr2 = (bf16x8){xlo[pb][0], xlo[pb][1], xlo[pb][2], xlo[pb][3], xhi[pb][0], xhi[pb][1], xhi[pb][2], xhi[pb][3]};
          accY[pb] = __builtin_amdgcn_mfma_f32_16x16x32_bf16(afrag, bfr2, accY[pb], 0, 0, 0);
        }
      }
    }
    const float dsk = P.d_skip[layer * 16 + head];
    s16x4 xs[4];
#pragma unroll
    for (int pb = 0; pb < 4; ++pb) xs[pb] = *(const s16x4*)(xs_l + ((((4 * wv + g) * 64 + 16 * pb + li) * 4) * 2));
    unsigned zv[16];
#pragma unroll
    for (int e = 0; e < 4; ++e)
#pragma unroll
      for (int pb = 0; pb < 4; ++pb)
        zv[e * 4 + pb] = P.p()[(size_t)(row0 + 16 * wv + 4 * g + e) * PW + OFF_Z + head * 64 + 16 * pb + li];
#pragma unroll
    for (int i = 0; i < 16; ++i) asm volatile("" : "+v"(zv[i]));
#pragma unroll
    for (int e = 0; e < 4; ++e) {
      const int row = row0 + 16 * wv + 4 * g + e;
      float sq = 0.f;
#pragma unroll
      for (int pb = 0; pb < 4; ++pb) {
        const float xv = bf2f((bf16_t)xs[pb][e]);
        const float z = bf2f((bf16_t)zv[e * 4 + pb]);
        const bf16_t yb = f2bf((accY[pb][e] + dsk * xv) * silu_f(z));
        P.concat()[(size_t)row * 2048 + head * 64 + 16 * pb + li] = yb;
        const float yf = bf2f(yb);
        sq += yf * yf;
      }
      sq += DPP_F(sq, 0xB1); sq += DPP_F(sq, 0x4E); sq += DPP_F(sq, 0x141); sq += DPP_F(sq, 0x140);
      if (li == 0) P.yss()[(size_t)row * 16 + head] = sq;
    }
    if (has_next) SSDY_PUT_BX((round + 1) & 1);
    __syncthreads();
  }
#undef SSDY_FETCH
#undef SSDY_PUT_S
#undef SSDY_PUT_BX
}

template <int W>
__device__ __forceinline__ void pool_frags(const bf16_t* pc, int l, int L, float rc, bf16x8 (&af)[4]) {
#pragma unroll
  for (int t = 0; t < 4; ++t) {
    constexpr int WB = W < 8 ? W : 8;
    float s[8], f[8];
#pragma unroll
    for (int e = 0; e < 8; ++e) s[e] = 0.f;
    const u32x4_t own = *(const u32x4_t*)(pc + 32 * t);
#pragma unroll
    for (int ob = 0; ob < W; ob += WB) {
      u32x4_t rows[WB];
#pragma unroll
      for (int o = 0; o < WB; ++o) {
        const int rr = l - W / 2 + ob + o;
        const int rcl = (rr >= 0 && rr < L) ? rr : l;
        rows[o] = *(const u32x4_t*)(pc + (ptrdiff_t)(rcl - l) * PW + 32 * t);
      }
#pragma unroll
      for (int o = 0; o < WB; ++o) asm volatile("" : "+v"(rows[o]));
#pragma unroll
      for (int o = 0; o < WB; ++o) {
        const int rr = l - W / 2 + ob + o;
        const float mk = (rr >= 0 && rr < L) ? 1.f : 0.f;
        unpack8(make_uint4(rows[o].x, rows[o].y, rows[o].z, rows[o].w), f);
#pragma unroll
        for (int e = 0; e < 8; ++e) s[e] += mk * f[e];
      }
    }
    unpack8(make_uint4(own.x, own.y, own.z, own.w), f);
#pragma unroll
    for (int e = 0; e < 8; ++e) af[t][e] = (short)f2bf(s[e] * rc - f[e]);
  }
}
__device__ void ph_pool_mfma(int wv, const Params& P, int layer, int nrows, char* smem, int bid, int nb) {
  const int lane = otid(wv) & 63, li = lane & 15, g = lane >> 4;
  bf16_t* stg = (bf16_t*)(smem + 65536) + wv * (16 * 136);
  const int nitems = (nrows / 16) * 4;
  for (int it = bid * NWAVE + wv; it < nitems; it += nb * NWAVE) {
    const int gi = it & 3, row0 = (it >> 2) * 16, w = 2 << gi;
    const int row = row0 + li;
    int l, L;
    if (row < NLAT) { l = row & 4095; L = 4096; } else { l = (row - NLAT) & 255; L = 256; }
    int lo = l - w / 2; lo = lo < 0 ? 0 : lo;
    int hi = l + w - w / 2 - 1; hi = hi > L - 1 ? L - 1 : hi;
    const float rc = 1.f / (float)(hi - lo + 1);
    const bf16_t* pc = P.p() + (size_t)row * PW + OFF_POOL + gi * 128 + 8 * g;
    bf16x8 af[4];
    if (gi == 0) pool_frags<2>(pc, l, L, rc, af);
    else if (gi == 1) pool_frags<4>(pc, l, L, rc, af);
    else if (gi == 2) pool_frags<8>(pc, l, L, rc, af);
    else pool_frags<16>(pc, l, L, rc, af);
    const bf16_t* wt = P.poolwT() + ((size_t)(layer * 4 + gi) * 128 + li) * 128 + 8 * g;
    const float* sc = P.pool_scale + layer * 512 + gi * 128;
#pragma unroll
    for (int nh = 0; nh < 4; ++nh) {
      bf16x8 wf[2][4];
#pragma unroll
      for (int n = 0; n < 2; ++n)
#pragma unroll
        for (int t = 0; t < 4; ++t) wf[n][t] = *(const bf16x8*)(wt + (size_t)(nh * 2 + n) * 16 * 128 + 32 * t);
#pragma unroll
      for (int n = 0; n < 2; ++n)
#pragma unroll
        for (int t = 0; t < 4; ++t) asm volatile("" : "+v"(wf[n][t]));
#pragma unroll
      for (int n = 0; n < 2; ++n) {
        const int nt = nh * 2 + n;
        f32x4 acc = (f32x4){0.f, 0.f, 0.f, 0.f};
#pragma unroll
        for (int t = 0; t < 4; ++t) acc = __builtin_amdgcn_mfma_f32_16x16x32_bf16(af[t], wf[n][t], acc, 0, 0, 0);
        const float scv = sc[nt * 16 + li];
#pragma unroll
        for (int e = 0; e < 4; ++e) stg[(4 * g + e) * 136 + nt * 16 + li] = f2bf(acc[e] * scv);
      }
    }
    __builtin_amdgcn_wave_barrier();
#pragma unroll
    for (int i = 0; i < 4; ++i) {
      const int c = i * 64 + lane, rr = c >> 4, c8 = (c & 15) * 8;
      *(uint4*)(P.concat() + (size_t)(row0 + rr) * 2048 + 1024 + gi * 128 + c8) = *(const uint4*)(stg + rr * 136 + c8);
    }
    __builtin_amdgcn_wave_barrier();
  }
}

__device__ void ph_vtranspose(int wv, const Params& P, char* smem, int bid, int nb) {
  const int lane = otid(wv) & 63;
  bf16_t* tile = (bf16_t*)smem + wv * 64 * 72;
  for (int it = bid * NWAVE + wv; it < 272 * 8; it += nb * NWAVE) {
    const int hd = it & 7, tt = it >> 3, row0 = tt * 64;
    const bf16_t* src = P.p() + (size_t)(row0 + lane) * PW + OFF_V + hd * 64;
#pragma unroll
    for (int i = 0; i < 8; ++i) *(uint4*)(tile + lane * 72 + i * 8) = *(const uint4*)(src + i * 8);
    __builtin_amdgcn_wave_barrier();
    bf16_t* dst;
    if (row0 < NLAT) dst = P.vtl() + (size_t)((row0 >> 12) * 8 + hd) * 64 * 4096 + ((size_t)((row0 & 4095) >> 2) * 64 + lane) * 4;
    else dst = P.vtc() + (size_t)(((row0 - NLAT) >> 8) * 8 + hd) * 64 * 256 + ((size_t)(((row0 - NLAT) & 255) >> 2) * 64 + lane) * 4;
#pragma unroll
    for (int i = 0; i < 16; ++i) {
      uint2 w;
      w.x = (uint32_t)tile[(i * 4 + 0) * 72 + lane] | ((uint32_t)tile[(i * 4 + 1) * 72 + lane] << 16);
      w.y = (uint32_t)tile[(i * 4 + 2) * 72 + lane] | ((uint32_t)tile[(i * 4 + 3) * 72 + lane] << 16);
      *(uint2*)(dst + (size_t)i * 64 * 4) = w;
    }
    __builtin_amdgcn_wave_barrier();
    {
      const bf16_t* ksrc = P.p() + (size_t)(row0 + lane) * PW + OFF_K + hd * 64;
      u32x4_t kv[8];
#pragma unroll
      for (int i = 0; i < 8; ++i) kv[i] = *(const u32x4_t*)(ksrc + i * 8);
      bf16_t* kd;
      int tk;
      if (row0 < NLAT) { tk = (row0 & 4095) + lane; kd = P.ktl() + (size_t)((row0 >> 12) * 8 + hd) * 4096 * 64; }
      else { tk = ((row0 - NLAT) & 255) + lane; kd = P.ktc() + (size_t)(((row0 - NLAT) >> 8) * 8 + hd) * 256 * 64; }
#pragma unroll
      for (int i = 0; i < 8; ++i)
        *(u32x4_t*)(kd + ((size_t)((tk >> 3) * 2 + (i >> 2)) * 8 + (tk & 7)) * 32 + (i & 3) * 8) = kv[i];
    }
  }
}

__device__ __forceinline__ float grp_max(float v) {
  auto a = __builtin_amdgcn_permlane16_swap(__float_as_uint(v), __float_as_uint(v), false, false);
  v = fmaxf(__uint_as_float(a[0]), __uint_as_float(a[1]));
  auto b = __builtin_amdgcn_permlane32_swap(__float_as_uint(v), __float_as_uint(v), false, false);
  return fmaxf(__uint_as_float(b[0]), __uint_as_float(b[1]));
}
__device__ __forceinline__ float grp_sum(float v) {
  auto a = __builtin_amdgcn_permlane16_swap(__float_as_uint(v), __float_as_uint(v), false, false);
  v = __uint_as_float(a[0]) + __uint_as_float(a[1]);
  auto b = __builtin_amdgcn_permlane32_swap(__float_as_uint(v), __float_as_uint(v), false, false);
  return __uint_as_float(b[0]) + __uint_as_float(b[1]);
}

__device__ void ph_na_mfma(int wv, const Params& P, int layer, int nrows, char* smem, int bid, int nb) {
  const int lane = otid(wv) & 63, li = lane & 15, g = lane >> 4;
  float* btab = (float*)smem + wv * 256;
  const float* rpb = P.na_rpb + (size_t)layer * 8 * 15 * 31;
  const int n_lat = 4 * 64 * 8 * 4;
  const int n_items = n_lat + (nrows > NLAT ? 4 * 16 * 8 : 0);
  const int nrank = nb >> 3;
  const bool xmap = ((nb & 7) == 0) && nrank > 0 && (1024 % nrank) == 0 && (64 % nrank) == 0;
  const int per_lat = xmap ? 1024 / nrank : 0, per_ctx = (xmap && nrows > NLAT) ? 64 / nrank : 0;
  const int q_begin = xmap ? wv : bid * NWAVE + wv, q_end = xmap ? per_lat + per_ctx : n_items, q_step = xmap ? NWAVE : nb * NWAVE;
  for (int q = q_begin; q < q_end; q += q_step) {
    bool lat;
    int b, hd, qrow0, r = 0, cq0 = 0, r0 = 0, cs = 0, qt;
    if (xmap) {
      hd = bid & 7;
      const int rank = bid >> 3;
      lat = q < per_lat;
      if (lat) { const int i = rank * per_lat + q; qt = i & 3; r = (i >> 2) & 63; b = i >> 8; }
      else { const int c = rank * per_ctx + (q - per_lat); qt = c & 15; b = c >> 4; }
    } else {
      lat = q < n_lat;
      if (lat) { qt = q & 3; hd = (q >> 2) & 7; r = (q >> 5) & 63; b = q >> 11; }
      else { const int t = q - n_lat; hd = t & 7; qt = (t >> 3) & 15; b = t >> 7; }
    }
    if (lat) {
      cq0 = qt * 16; qrow0 = b * 4096 + r * 64 + cq0;
      r0 = r - 4; r0 = r0 < 0 ? 0 : (r0 > 56 ? 56 : r0);
      int clo = cq0 - 8; clo = clo < 0 ? 0 : (clo > 48 ? 48 : clo);
      cs = clo < 32 ? clo : 32;
    } else {
      qrow0 = NLAT + b * 256 + qt * 16;
    }
    const bf16_t* qp = P.p() + (size_t)(qrow0 + li) * PW + OFF_Q + hd * 64 + 8 * g;
    const bf16x8 qf0 = *(const bf16x8*)qp, qf1 = *(const bf16x8*)(qp + 32);
    __builtin_amdgcn_wave_barrier();
#pragma unroll
    for (int i = 0; i < 4; ++i) {
      const int e_ = i * 64 + lane, kr_ = e_ >> 5, dc_ = e_ & 31;
      int dr_ = r0 + kr_ - r + 7; dr_ = dr_ < 0 ? 0 : (dr_ > 14 ? 14 : dr_);
      btab[e_] = rpb[(hd * 15 + dr_) * 31 + (dc_ < 31 ? dc_ : 30)];
    }
    __builtin_amdgcn_wave_barrier();
    f32x4 accS[16], accC[16];
    const int k_lane = ((li >> 3) * 16 + (li & 7)) * 32 + 8 * g;
    const bf16_t* klb = P.ktl() + (size_t)(b * 8 + hd) * 4096 * 64 + k_lane;
    const bf16_t* kcb = P.ktc() + (size_t)(b * 8 + hd) * 256 * 64 + k_lane;
#define NA_KPTR(tile) ((tile) < 16 ? klb + ((r0 + ((tile) >> 1)) * 64 + cs + 16 * ((tile) & 1)) * 64 : kcb + (16 * ((tile) - 16)) * 64)
    bf16x8 kA[2][2], kB[2][2];
#pragma unroll
    for (int i = 0; i < 2; ++i) { const bf16_t* kp = NA_KPTR(i); kA[i][0] = *(const bf16x8*)kp; kA[i][1] = *(const bf16x8*)(kp + 256); }
#pragma unroll
    for (int tb = 0; tb < 32; tb += 4) {
#pragma unroll
      for (int i = 0; i < 2; ++i) { const bf16_t* kp = NA_KPTR(tb + 2 + i); kB[i][0] = *(const bf16x8*)kp; kB[i][1] = *(const bf16x8*)(kp + 256); }
#pragma unroll
      for (int i = 0; i < 2; ++i) { asm volatile("" : "+v"(kA[i][0]), "+v"(kA[i][1])); }
#pragma unroll
      for (int i = 0; i < 2; ++i) {
        f32x4 z = (f32x4){0.f, 0.f, 0.f, 0.f};
        z = __builtin_amdgcn_mfma_f32_16x16x32_bf16(kA[i][0], qf0, z, 0, 0, 0);
        z = __builtin_amdgcn_mfma_f32_16x16x32_bf16(kA[i][1], qf1, z, 0, 0, 0);
        if (tb + i < 16) accS[(tb + i) & 15] = z; else accC[(tb + i) & 15] = z;
      }
      if (tb + 4 < 32) {
#pragma unroll
        for (int i = 0; i < 2; ++i) { const bf16_t* kp = NA_KPTR(tb + 4 + i); kA[i][0] = *(const bf16x8*)kp; kA[i][1] = *(const bf16x8*)(kp + 256); }
      }
#pragma unroll
      for (int i = 0; i < 2; ++i) { asm volatile("" : "+v"(kB[i][0]), "+v"(kB[i][1])); }
#pragma unroll
      for (int i = 0; i < 2; ++i) {
        f32x4 z = (f32x4){0.f, 0.f, 0.f, 0.f};
        z = __builtin_amdgcn_mfma_f32_16x16x32_bf16(kB[i][0], qf0, z, 0, 0, 0);
        z = __builtin_amdgcn_mfma_f32_16x16x32_bf16(kB[i][1], qf1, z, 0, 0, 0);
        if (tb + 2 + i < 16) accS[(tb + 2 + i) & 15] = z; else accC[(tb + 2 + i) & 15] = z;
      }
    }
#undef NA_KPTR
    const int cq = cq0 + li;
    int c0q = cq - 8; c0q = c0q < 0 ? 0 : (c0q > 48 ? 48 : c0q);
    float mx = -3.0e38f;
#pragma unroll
    for (int kt = 0; kt < 16; ++kt) {
      int bi[4]; bool okv[4]; float bv[4];
#pragma unroll
      for (int e = 0; e < 4; ++e) {
        const int ck = cs + 16 * (kt & 1) + 4 * g + e;
        okv[e] = lat && ck >= c0q && ck < c0q + 16;
        bi[e] = okv[e] ? (kt >> 1) * 32 + (ck - cq + 15) : 0;
      }
      asm volatile("" : "+v"(bi[0]), "+v"(bi[1]), "+v"(bi[2]), "+v"(bi[3]));
#pragma unroll
      for (int e = 0; e < 4; ++e) bv[e] = btab[bi[e]];
#pragma unroll
      for (int e = 0; e < 4; ++e) {
        const float s = okv[e] ? accS[kt][e] * 0.125f + bv[e] : -3.0e38f;
        accS[kt][e] = s;
        mx = fmaxf(mx, s);
      }
    }
#pragma unroll
    for (int ct = 0; ct < 16; ++ct)
#pragma unroll
      for (int e = 0; e < 4; ++e) { const float s = accC[ct][e] * 0.125f; accC[ct][e] = s; mx = fmaxf(mx, s); }
    mx = grp_max(mx);
    float sum = 0.f;
#pragma unroll
    for (int kt = 0; kt < 16; ++kt)
#pragma unroll
      for (int e = 0; e < 4; ++e) { const float p = __expf(accS[kt][e] - mx); accS[kt][e] = p; sum += p; }
#pragma unroll
    for (int ct = 0; ct < 16; ++ct)
#pragma unroll
      for (int e = 0; e < 4; ++e) { const float p = __expf(accC[ct][e] - mx); accC[ct][e] = p; sum += p; }
    sum = grp_sum(sum);
    const float inv = 1.f / sum;
    bf16x8 afL[8], afC[8];
#pragma unroll
    for (int kr = 0; kr < 8; ++kr) {
#pragma unroll
      for (int e = 0; e < 4; ++e) {
        afL[kr][e] = (short)f2bf(accS[2 * kr][e] * inv); afL[kr][4 + e] = (short)f2bf(accS[2 * kr + 1][e] * inv);
        afC[kr][e] = (short)f2bf(accC[2 * kr][e] * inv); afC[kr][4 + e] = (short)f2bf(accC[2 * kr + 1][e] * inv);
      }
    }
    f32x4 accO[4];
#pragma unroll
    for (int db = 0; db < 4; ++db) accO[db] = (f32x4){0.f, 0.f, 0.f, 0.f};
    const bf16_t* vl = P.vtl() + (size_t)(b * 8 + hd) * 64 * 4096 + li * 4;
    const bf16_t* vc = P.vtc() + (size_t)(b * 8 + hd) * 64 * 256 + li * 4;
#pragma unroll
    for (int kr = 0; kr < 8; ++kr) {
      const int tok = (r0 + kr) * 64 + cs + 4 * g;
      s16x4 lo[4], hi[4];
#pragma unroll
      for (int db = 0; db < 4; ++db) {
        const bf16_t* vp = vl + ((size_t)(tok >> 2) * 64 + db * 16) * 4;
        lo[db] = *(const s16x4*)vp; hi[db] = *(const s16x4*)(vp + 4 * 64 * 4);
      }
#pragma unroll
      for (int db = 0; db < 4; ++db) {
        const bf16x8 bfr = (bf16x8){lo[db][0], lo[db][1], lo[db][2], lo[db][3], hi[db][0], hi[db][1], hi[db][2], hi[db][3]};
        accO[db] = __builtin_amdgcn_mfma_f32_16x16x32_bf16(afL[kr], bfr, accO[db], 0, 0, 0);
      }
    }
#pragma unroll
    for (int t = 0; t < 8; ++t) {
      const int tok = 32 * t + 4 * g;
      s16x4 lo[4], hi[4];
#pragma unroll
      for (int db = 0; db < 4; ++db) {
        const bf16_t* vp = vc + ((size_t)(tok >> 2) * 64 + db * 16) * 4;
        lo[db] = *(const s16x4*)vp; hi[db] = *(const s16x4*)(vp + 4 * 64 * 4);
      }
#pragma unroll
      for (int db = 0; db < 4; ++db) {
        const bf16x8 bfr = (bf16x8){lo[db][0], lo[db][1], lo[db][2], lo[db][3], hi[db][0], hi[db][1], hi[db][2], hi[db][3]};
        accO[db] = __builtin_amdgcn_mfma_f32_16x16x32_bf16(afC[t], bfr, accO[db], 0, 0, 0);
      }
    }
    {
      bf16_t* stg = (bf16_t*)(smem + 32768) + wv * (16 * 72);
#pragma unroll
      for (int db = 0; db < 4; ++db)
#pragma unroll
        for (int e = 0; e < 4; ++e) stg[(4 * g + e) * 72 + 16 * db + li] = f2bf(accO[db][e]);
      __builtin_amdgcn_wave_barrier();
#pragma unroll
      for (int i = 0; i < 2; ++i) {
        const int c = i * 64 + lane, rr = c >> 3, c8 = (c & 7) * 8;
        *(uint4*)(P.concat() + (size_t)(qrow0 + rr) * 2048 + 1536 + hd * 64 + c8) = *(const uint4*)(stg + rr * 72 + c8);
      }
      __builtin_amdgcn_wave_barrier();
    }
  }
}

__device__ __forceinline__ uint32_t mono_u(float f) { const uint32_t u = __float_as_uint(f); return u ^ ((uint32_t)((int)u >> 31) | 0x80000000u); }
__device__ __forceinline__ float unmono_f(uint32_t m) { return __uint_as_float((m & 0x80000000u) ? (m ^ 0x80000000u) : ~m); }
__device__ __forceinline__ uint32_t grp_max_u(uint32_t v) {
  auto a = __builtin_amdgcn_permlane16_swap(v, v, false, false);
  v = a[0] > a[1] ? a[0] : a[1];
  auto b = __builtin_amdgcn_permlane32_swap(v, v, false, false);
  return b[0] > b[1] ? b[0] : b[1];
}

template <int N>
__device__ __forceinline__ void bitonic_sort_desc(uint32_t (&a)[N], int base = 0) { (void)base;
#pragma unroll
  for (int k = 2; k <= N; k <<= 1)
#pragma unroll
    for (int j = k >> 1; j > 0; j >>= 1)
#pragma unroll
      for (int i = 0; i < N; ++i) {
        const int l = i ^ j;
        if (l > i) {
          const bool desc = (i & k) == 0;
          const uint32_t hi = a[i] > a[l] ? a[i] : a[l], lo = a[i] > a[l] ? a[l] : a[i];
          a[i] = desc ? hi : lo; a[l] = desc ? lo : hi;
        }
      }
}
template <int N>
__device__ __forceinline__ void bitonic_merge_desc(uint32_t (&a)[N]) {
#pragma unroll
  for (int j = N >> 1; j > 0; j >>= 1)
#pragma unroll
    for (int i = 0; i < N; ++i) {
      const int l = i ^ j;
      if (l > i) {
        const uint32_t hi = a[i] > a[l] ? a[i] : a[l], lo = a[i] > a[l] ? a[l] : a[i];
        a[i] = hi; a[l] = lo;
      }
    }
}
__device__ __forceinline__ void merge4_top16(uint32_t (&a)[16]) {
  uint32_t e[16], o[16];
#pragma unroll
  for (int i = 0; i < 16; ++i) { auto r = __builtin_amdgcn_permlane16_swap(a[i], a[i], false, false); e[i] = r[0]; o[i] = r[1]; }
#pragma unroll
  for (int i = 0; i < 16; ++i) a[i] = e[i] > o[15 - i] ? e[i] : o[15 - i];
  bitonic_merge_desc<16>(a);
#pragma unroll
  for (int i = 0; i < 16; ++i) { auto r = __builtin_amdgcn_permlane32_swap(a[i], a[i], false, false); e[i] = r[0]; o[i] = r[1]; }
#pragma unroll
  for (int i = 0; i < 16; ++i) a[i] = e[i] > o[15 - i] ? e[i] : o[15 - i];
  bitonic_merge_desc<16>(a);
}
__device__ void ph_peer_topk_mfma(int wv, const Params& P, int layer, int nrows, char* smem, int bid, int nb) {
  const int tid = otid(wv), lane = tid & 63, li = lane & 15, g = lane >> 4;
  unsigned char* ctab = (unsigned char*)smem;
  float* vals = (float*)(smem + 256) + wv * 512;
  int* idxs = (int*)(smem + 256 + 8 * 2048) + wv * 512;
  __syncthreads();
  if (tid < 64) ctab[tid] = 0xFF;
  __syncthreads();
  if (tid == 0) {
    int n = 0, one = 1;
    asm volatile("" : "+s"(one));
#pragma unroll 1
    for (int a = 0; a < 16; ++a)
#pragma unroll 1
      for (int b = 0; b < 16; ++b)
        if ((a + one) * (b + 1) <= 16) { ctab[(n & 3) * 16 + (n >> 2)] = (unsigned char)(a * 16 + b); ++n; }
  }
  const int hd = bid & 7, tg = bid >> 3, ngroups = nb >> 3;
  char* ksm = smem + 33280;
  {
    const bf16_t* ksrc = P.keysb() + (size_t)(layer * 8 + hd) * 2 * 128 * 128;
#pragma unroll
    for (int i = 0; i < 8; ++i) {
      const int idx = tid + i * 512, r = idx >> 4, sg = idx & 15;
      *(uint4*)(ksm + (r * 136 + sg * 8) * 2) = *(const uint4*)(ksrc + (size_t)r * 128 + sg * 8);
    }
  }
  __syncthreads();
  uint32_t cab[16];
#pragma unroll
  for (int s = 0; s < 16; ++s) cab[s] = ctab[g * 16 + s];
  const int ntile = nrows / 16;
  for (int tile = tg + ngroups * wv; tile < ntile && tg < ngroups; tile += ngroups * NWAVE) {
    const int row0 = tile * 16;
    const bf16_t* qp = P.q() + (size_t)(row0 + li) * 2048 + hd * 256 + 8 * g;
    uint32_t win[2][16];
#pragma unroll
    for (int half = 0; half < 2; ++half) {
      bf16x8 qf[4];
#pragma unroll
      for (int t = 0; t < 4; ++t) qf[t] = *(const bf16x8*)(qp + half * 128 + 32 * t);
      const char* kb = ksm + ((half * 128 + li) * 136 + 8 * g) * 2;
      uint32_t pk[32];
#pragma unroll
      for (int kt = 0; kt < 8; ++kt) {
        f32x4 acc = (f32x4){0.f, 0.f, 0.f, 0.f};
#pragma unroll
        for (int t = 0; t < 4; ++t) {
          const bf16x8 a = *(const bf16x8*)(kb + (kt * 16 * 136 + 32 * t) * 2);
          acc = __builtin_amdgcn_mfma_f32_16x16x32_bf16(a, qf[t], acc, 0, 0, 0);
        }
#pragma unroll
        for (int e = 0; e < 4; ++e) pk[kt * 4 + e] = (mono_u(acc[e]) & ~127u) | (uint32_t)(16 * kt + 4 * g + e);
      }
      {
        uint32_t lo16[16], hi16[16];
#pragma unroll
        for (int i = 0; i < 16; ++i) { lo16[i] = pk[i]; hi16[i] = pk[16 + i]; }
        bitonic_sort_desc<16>(lo16);
        bitonic_sort_desc<16>(hi16);
#pragma unroll
        for (int i = 0; i < 16; ++i) lo16[i] = lo16[i] > hi16[15 - i] ? lo16[i] : hi16[15 - i];
        bitonic_merge_desc<16>(lo16);
        merge4_top16(lo16);
#pragma unroll
        for (int r = 0; r < 16; ++r) win[half][r] = lo16[r];
      }
    }
    if (g == 0) {
#pragma unroll
      for (int half = 0; half < 2; ++half)
#pragma unroll
        for (int r = 0; r < 16; ++r) {
          vals[li * 32 + half * 16 + r] = unmono_f(win[half][r] & ~127u);
          idxs[li * 32 + half * 16 + r] = (int)(win[half][r] & 127u);
        }
    }
    __builtin_amdgcn_wave_barrier();
    uint32_t cp[16];
    {
      float va[16], vb[16];
#pragma unroll
      for (int s = 0; s < 16; ++s) {
        const uint32_t ab = cab[s] == 0xFFu ? 0u : cab[s];
        va[s] = vals[li * 32 + (ab >> 4)]; vb[s] = vals[li * 32 + 16 + (ab & 15u)];
      }
#pragma unroll
      for (int s = 0; s < 16; ++s) cp[s] = cab[s] == 0xFFu ? 0u : ((mono_u(va[s] + vb[s]) & ~255u) | cab[s]);
    }
    bitonic_sort_desc<16>(cp);
    merge4_top16(cp);
    uint32_t cw[16];
#pragma unroll
    for (int r = 0; r < 16; ++r) cw[r] = cp[r];
    const float mx = unmono_f(cw[0] & ~255u);
    float sum = 0.f;
#pragma unroll
    for (int r = 0; r < 16; ++r) sum += __expf(unmono_f(cw[r] & ~255u) - mx);
    const float inv = 1.f / sum;
    const size_t ob = (size_t)(row0 + li) * 128 + hd * 16 + 4 * g;
    int si[4]; float sg[4];
    const uint32_t m1 = 0u - (uint32_t)(g & 1), m2 = 0u - (uint32_t)((g >> 1) & 1);
#pragma unroll
    for (int e = 0; e < 4; ++e) {
      const uint32_t c01 = (cw[4 + e] & m1) | (cw[e] & ~m1), c23 = (cw[12 + e] & m1) | (cw[8 + e] & ~m1);
      const uint32_t cs_ = (c23 & m2) | (c01 & ~m2), ab = cs_ & 255u;
      si[e] = idxs[li * 32 + (ab >> 4)] * 128 + idxs[li * 32 + 16 + (ab & 15u)];
      sg[e] = __expf(unmono_f(cs_ & ~255u) - mx) * inv;
    }
    *(u32x4_t*)(P.sel_idx() + ob) = (u32x4_t){(uint32_t)si[0], (uint32_t)si[1], (uint32_t)si[2], (uint32_t)si[3]};
    *(f32x4*)(P.sel_g() + ob) = (f32x4){sg[0], sg[1], sg[2], sg[3]};
    __builtin_amdgcn_wave_barrier();
  }
}

__device__ __forceinline__ void cvt8(const uint32_t w, float* f) {
  const f32x2_t a = __builtin_amdgcn_cvt_scalef32_pk_f32_fp4(w, 1.0f, 0), b = __builtin_amdgcn_cvt_scalef32_pk_f32_fp4(w, 1.0f, 1);
  const f32x2_t c = __builtin_amdgcn_cvt_scalef32_pk_f32_fp4(w, 1.0f, 2), e = __builtin_amdgcn_cvt_scalef32_pk_f32_fp4(w, 1.0f, 3);
  f[0] = a.x; f[1] = a.y; f[2] = b.x; f[3] = b.y; f[4] = c.x; f[5] = c.y; f[6] = e.x; f[7] = e.y;
}
__device__ __forceinline__ float swap16_add(float a, float b) {
  auto r = __builtin_amdgcn_permlane16_swap(__float_as_uint(a), __float_as_uint(b), false, false);
  return __uint_as_float(r[0]) + __uint_as_float(r[1]);
}
typedef int i32x8_t __attribute__((ext_vector_type(8)));
typedef _Float16 h2_t __attribute__((ext_vector_type(2)));
__device__ void ph_peer_dots(int wv, const Params& P, int layer, int nrows, int bid, int nb) {
  for (int row = bid * NWAVE + wv; row < nrows; row += nb * NWAVE) {
    const int lane = otid(wv) & 63, n = lane & 15, g = lane >> 4;
    const bool hsel = (lane & 8) != 0;
    const unsigned char* TU = P.tabU();
    const uint32_t tuo = (uint32_t)(8 * g + (lane & 7)) * 16u;
    i32x8_t xa;
    {
      const bf16_t* xp = P.u() + (size_t)row * DM + 32 * (8 * g + (lane & 7));
      float xv[32];
      unpack8(*(const uint4*)xp, xv); unpack8(*(const uint4*)(xp + 8), xv + 8);
      unpack8(*(const uint4*)(xp + 16), xv + 16); unpack8(*(const uint4*)(xp + 24), xv + 24);
#pragma unroll
      for (int r = 0; r < 4; ++r) {
        uint32_t hw = 0u, lw = 0u;
        float fh[8];
#pragma unroll
        for (int bsel = 0; bsel < 4; ++bsel) {
          if (bsel == 0) hw = __builtin_amdgcn_cvt_scalef32_pk_fp4_f32(hw, xv[8 * r + 0], xv[8 * r + 1], 1.0f, 0);
          if (bsel == 1) hw = __builtin_amdgcn_cvt_scalef32_pk_fp4_f32(hw, xv[8 * r + 2], xv[8 * r + 3], 1.0f, 1);
          if (bsel == 2) hw = __builtin_amdgcn_cvt_scalef32_pk_fp4_f32(hw, xv[8 * r + 4], xv[8 * r + 5], 1.0f, 2);
          if (bsel == 3) hw = __builtin_amdgcn_cvt_scalef32_pk_fp4_f32(hw, xv[8 * r + 6], xv[8 * r + 7], 1.0f, 3);
        }
        cvt8(hw, fh);
        lw = __builtin_amdgcn_cvt_scalef32_pk_fp4_f32(lw, (xv[8 * r + 0] - fh[0]) * 8.f, (xv[8 * r + 1] - fh[1]) * 8.f, 1.0f, 0);
        lw = __builtin_amdgcn_cvt_scalef32_pk_fp4_f32(lw, (xv[8 * r + 2] - fh[2]) * 8.f, (xv[8 * r + 3] - fh[3]) * 8.f, 1.0f, 1);
        lw = __builtin_amdgcn_cvt_scalef32_pk_fp4_f32(lw, (xv[8 * r + 4] - fh[4]) * 8.f, (xv[8 * r + 5] - fh[5]) * 8.f, 1.0f, 2);
        lw = __builtin_amdgcn_cvt_scalef32_pk_fp4_f32(lw, (xv[8 * r + 6] - fh[6]) * 8.f, (xv[8 * r + 7] - fh[7]) * 8.f, 1.0f, 3);
        xa[r] = (int)((n & 8) ? lw : hw);
        xa[4 + r] = 0;
      }
    }
    const int idx0 = P.sel_idx()[(size_t)row * 128 + lane], idx1 = P.sel_idx()[(size_t)row * 128 + 64 + lane];
    const float gt0 = P.sel_g()[(size_t)row * 128 + lane] * P.invV()[idx0], gt1 = P.sel_g()[(size_t)row * 128 + 64 + lane] * P.invV()[idx1];
    const float iu0 = P.invU()[idx0], iu1 = P.invU()[idx1];
    const float cs = ((g & 1) == ((n >> 2) & 1)) ? (g >= 2 ? (1.f / 8.f) : 1.f) : 0.f;
    const int lkey = lane & 0x37;
    float d0 = 0.f, d1 = 0.f;
    u32x4_t bufA[8], bufB[8], bufC[8], bufD[8];
#define PG_LOAD(buf, T, m0) do { _Pragma("unroll") for (int j = 0; j < 8; ++j) { \
      const int m_ = (m0) + j; const int src_ = m_ < 32 ? idx0 : idx1; const int kA_ = (m_ & 7) + 16 * ((m_ >> 3) & 3); \
      const int elo_ = __builtin_amdgcn_readlane(src_, kA_), ehi_ = __builtin_amdgcn_readlane(src_, kA_ + 8); \
      buf[j] = *(const u32x4_t*)(T + (((uint32_t)(hsel ? ehi_ : elo_) << 9) + tuo)); } } while (0)
#define PG_DOT(buf, m0) do { _Pragma("unroll") for (int j = 0; j < 8; ++j) { \
      const int m_ = (m0) + j; const int kA_ = (m_ & 7) + 16 * ((m_ >> 3) & 3); \
      const i32x8_t b_ = {(int)buf[j].x, (int)buf[j].y, (int)buf[j].z, (int)buf[j].w, 0, 0, 0, 0}; \
      const f32x4 acc_ = __builtin_amdgcn_mfma_scale_f32_16x16x128_f8f6f4(xa, b_, (f32x4){0.f, 0.f, 0.f, 0.f}, 4, 4, 0, 0x7F7F7F7F, 0, 0x7F7F7F7F); \
      float w_ = (n & 2) ? ((n & 1) ? acc_[3] : acc_[2]) : ((n & 1) ? acc_[1] : acc_[0]); \
      w_ *= cs; \
      w_ += DPP_F(w_, 0xB1); w_ += DPP_F(w_, 0x4E); w_ += DPP_F(w_, 0x141); \
      { auto r_ = __builtin_amdgcn_permlane32_swap(__float_as_uint(w_), __float_as_uint(w_), false, false); w_ = __uint_as_float(r_[0]) + __uint_as_float(r_[1]); } \
      { auto r_ = __builtin_amdgcn_permlane16_swap(__float_as_uint(w_), __float_as_uint(w_), false, false); w_ = __uint_as_float(r_[0]) + __uint_as_float(r_[1]); } \
      if (m_ < 32) d0 = (lkey == kA_) ? w_ : d0; else d1 = (lkey == kA_) ? w_ : d1; } } while (0)
    PG_LOAD(bufA, TU, 0); PG_LOAD(bufB, TU, 8); PG_LOAD(bufC, TU, 16);
    PG_LOAD(bufD, TU, 24); PG_DOT(bufA, 0);
    PG_LOAD(bufA, TU, 32); PG_DOT(bufB, 8);
    PG_LOAD(bufB, TU, 40); PG_DOT(bufC, 16);
    PG_LOAD(bufC, TU, 48); PG_DOT(bufD, 24);
    PG_LOAD(bufD, TU, 56); PG_DOT(bufA, 32);
    PG_DOT(bufB, 40); PG_DOT(bufC, 48); PG_DOT(bufD, 56);
    P.sel_g()[(size_t)row * 128 + lane] = gelu_f(d0 * iu0) * gt0;
    P.sel_g()[(size_t)row * 128 + 64 + lane] = gelu_f(d1 * iu1) * gt1;
#undef PG_LOAD
#undef PG_DOT
  }
}
__device__ void ph_peer_acc(int wv, const Params& P, int layer, int nrows, int bid, int nb) {
  for (int row = bid * NWAVE + wv; row < nrows; row += nb * NWAVE) {
    const int lane = otid(wv) & 63, l5 = lane & 31;
    const bool up = lane >= 32;
    const unsigned char* TV = P.tabV();
    const uint32_t tvo = (uint32_t)l5 * 16u;
    float o[32];
    const int idx0 = P.sel_idx()[(size_t)row * 128 + lane], idx1 = P.sel_idx()[(size_t)row * 128 + 64 + lane];
    const _Float16 act0 = (_Float16)P.sel_g()[(size_t)row * 128 + lane], act1 = (_Float16)P.sel_g()[(size_t)row * 128 + 64 + lane];
    h2_t o2[16];
    uint4 bufA[8], bufB[8];
#define PG_LOAD(buf, T, kk) do { _Pragma("unroll") for (int j = 0; j < 8; ++j) { \
      const int k_ = (kk) + 2 * j; const int src_ = k_ < 64 ? idx0 : idx1; \
      const int elo_ = __builtin_amdgcn_readlane(src_, k_ & 63), ehi_ = __builtin_amdgcn_readlane(src_, (k_ & 63) + 1); \
      buf[j] = *(const uint4*)(T + (((uint32_t)(up ? ehi_ : elo_) << 9) + tvo)); } } while (0)
    PG_LOAD(bufA, TV, 0);
#pragma unroll
    for (int i = 0; i < 32; ++i) o[i] = 0.f;
#pragma unroll
    for (int i = 0; i < 16; ++i) o2[i] = (h2_t){(_Float16)0.f, (_Float16)0.f};
#define PG_ACC(buf, kk) do { _Pragma("unroll") for (int j = 0; j < 8; ++j) { const int k_ = (kk) + 2 * j; \
      const int asrc_ = (int)__builtin_bit_cast(unsigned short, k_ < 64 ? act0 : act1); \
      const int alo_ = __builtin_amdgcn_readlane(asrc_, k_ & 63), ahi_ = __builtin_amdgcn_readlane(asrc_, (k_ & 63) + 1); \
      const _Float16 ah_ = __builtin_bit_cast(_Float16, (unsigned short)(up ? ahi_ : alo_)); const h2_t a2_ = {ah_, ah_}; \
      const uint32_t w_[4] = {buf[j].x, buf[j].y, buf[j].z, buf[j].w}; \
      _Pragma("unroll") for (int d = 0; d < 4; ++d) { uint32_t wd_ = w_[d]; asm volatile("" : "+v"(wd_) : "v"(o2[(d * 4 + 15) & 15])); \
        o2[d * 4 + 0] = __builtin_elementwise_fma(__builtin_bit_cast(h2_t, __builtin_amdgcn_cvt_scalef32_pk_f16_fp4(wd_, 1.0f, 0)), a2_, o2[d * 4 + 0]); \
        o2[d * 4 + 1] = __builtin_elementwise_fma(__builtin_bit_cast(h2_t, __builtin_amdgcn_cvt_scalef32_pk_f16_fp4(wd_, 1.0f, 1)), a2_, o2[d * 4 + 1]); \
        o2[d * 4 + 2] = __builtin_elementwise_fma(__builtin_bit_cast(h2_t, __builtin_amdgcn_cvt_scalef32_pk_f16_fp4(wd_, 1.0f, 2)), a2_, o2[d * 4 + 2]); \
        o2[d * 4 + 3] = __builtin_elementwise_fma(__builtin_bit_cast(h2_t, __builtin_amdgcn_cvt_scalef32_pk_f16_fp4(wd_, 1.0f, 3)), a2_, o2[d * 4 + 3]); } } } while (0)
#pragma unroll 1
    for (int kk = 0; kk < 128; kk += 32) {
      PG_LOAD(bufB, TV, kk + 16);
      PG_ACC(bufA, kk);
      if (kk + 32 < 128) PG_LOAD(bufA, TV, kk + 32);
      PG_ACC(bufB, kk + 16);
    }
#undef PG_LOAD
#undef PG_ACC
#pragma unroll
    for (int i = 0; i < 16; ++i) { o[2 * i] = (float)o2[i].x; o[2 * i + 1] = (float)o2[i].y; }
#pragma unroll
    for (int i = 0; i < 32; ++i) {
      auto r = __builtin_amdgcn_permlane32_swap(__float_as_uint(o[i]), __float_as_uint(o[i]), false, false);
      o[i] = __uint_as_float(r[0]) + __uint_as_float(r[1]);
    }
    const int lane_e = otid(wv) & 63, l5e = lane_e & 31;
    const bool upe = lane_e >= 32;
    const float* gate = P.mod() + (size_t)(layer * 5 + modrow(row)) * MODW + 5120 + l5e * 32;
    float* hr = P.h() + (size_t)row * DM + l5e * 32;
    float ss = 0.f;
    f32x4 hvv[8], ggv[8];
#pragma unroll
    for (int q = 0; q < 8; ++q) { hvv[q] = *(const f32x4*)(hr + q * 4); ggv[q] = *(const f32x4*)(gate + q * 4); }
#pragma unroll
    for (int q = 0; q < 8; ++q) asm volatile("" : "+v"(hvv[q]), "+v"(ggv[q]));
#pragma unroll
    for (int q = 0; q < 8; ++q) {
      float4 hv = make_float4(hvv[q][0], hvv[q][1], hvv[q][2], hvv[q][3]);
      const float4 gg = make_float4(ggv[q][0], ggv[q][1], ggv[q][2], ggv[q][3]);
      hv.x += gg.x * o[q * 4 + 0]; hv.y += gg.y * o[q * 4 + 1]; hv.z += gg.z * o[q * 4 + 2]; hv.w += gg.w * o[q * 4 + 3];
      if (layer == 0 && !upe) *(float4*)(hr + q * 4) = hv;
      o[q * 4 + 0] = hv.x; o[q * 4 + 1] = hv.y; o[q * 4 + 2] = hv.z; o[q * 4 + 3] = hv.w;
      if (!upe) ss += hv.x * hv.x + hv.y * hv.y + hv.z * hv.z + hv.w * hv.w;
    }
    ss = wave_sum(ss);
    const float rstd = rsqrtf(ss * (1.f / 1024.f) + 1e-6f);
    if (layer == 0) {
      const float* g1 = P.norm1_g + 1024 + l5e * 32;
      const float* mr = P.mod() + (size_t)(5 + modrow(row)) * MODW + l5e * 32;
      if (!upe) {
#pragma unroll
        for (int q = 0; q < 4; ++q) {
          float ov[8];
#pragma unroll
          for (int e = 0; e < 8; ++e) ov[e] = o[q * 8 + e] * rstd * g1[q * 8 + e] * (1.f + mr[1024 + q * 8 + e]) + mr[q * 8 + e];
          *(uint4*)(P.u() + (size_t)row * DM + l5e * 32 + q * 8) = make_uint4(pack2(ov[0], ov[1]), pack2(ov[2], ov[3]), pack2(ov[4], ov[5]), pack2(ov[6], ov[7]));
        }
      }
    } else {
      const float* gf = P.final_g + l5e * 32;
      if (!upe) {
#pragma unroll
        for (int q = 0; q < 8; ++q) {
          const float4 gg = *(const float4*)(gf + q * 4);
          *(float4*)(P.out + (size_t)row * DM + l5e * 32 + q * 4) =
              make_float4(o[q * 4] * rstd * gg.x, o[q * 4 + 1] * rstd * gg.y, o[q * 4 + 2] * rstd * gg.z, o[q * 4 + 3] * rstd * gg.w);
        }
      }
    }
  }
}

struct EpiOutproj {
  static constexpr bool PERM = false, AFTER_DRAIN = false;
  static constexpr int MIDK_T = 16;
  float* H; const float* hl; const float* hc; const float* modl;
  const float* yss;
  __device__ __forceinline__ void midk(pg8::f32x4 (&acc)[2][2][4][2], const pg8::Unit& u, int wr, int wc, int fr, int fq) const {
    const int row0 = u.pm * 256 + wr * 64 + fr;
#pragma unroll
    for (int ai = 0; ai < 2; ++ai)
#pragma unroll
      for (int m = 0; m < 4; ++m) {
        const pg8::f32x4* yp = (const pg8::f32x4*)(yss + (size_t)(row0 + ai * 128 + m * 16) * 16);
        const pg8::f32x4 y4 = (yp[0] + yp[1]) + (yp[2] + yp[3]);
        const float rstd = rsqrtf(((y4[0] + y4[1]) + (y4[2] + y4[3])) * (1.f / 1024.f) + 1e-6f);
#pragma unroll
        for (int bj = 0; bj < 2; ++bj)
#pragma unroll
          for (int n = 0; n < 2; ++n) acc[ai][bj][m][n] *= rstd;
      }
  }
  __device__ __forceinline__ void operator()(const pg8::f32x4 (&acc)[2][2][4][2], const pg8::Unit& u, int wr, int wc, int fr, int fq) const {
    const int row0 = u.pm * 256 + wr * 64 + fr, col0 = u.pn * 256 + wc * 32 + 4 * fq;
    const float* gate = modl + (size_t)modrow(row0) * MODW + 2048 + col0;
    pg8::f32x4 gv[2][2];
#pragma unroll
    for (int bj = 0; bj < 2; ++bj)
#pragma unroll
      for (int n = 0; n < 2; ++n) gv[bj][n] = *(const pg8::f32x4*)(gate + bj * 128 + n * 16);
    pg8::f32x4 sA[4], sB[4];
#define EO_LOAD(dstv, ai_, m_) do { const float* s_ = hrow(hl, hc, row0 + (ai_) * 128 + (m_) * 16) + col0; \
      dstv[0] = *(const pg8::f32x4*)(s_); dstv[1] = *(const pg8::f32x4*)(s_ + 16); dstv[2] = *(const pg8::f32x4*)(s_ + 128); dstv[3] = *(const pg8::f32x4*)(s_ + 144); } while (0)
#define EO_STORE(srcv, ai_, m_) do { asm volatile("" : "+v"(srcv[0]), "+v"(srcv[1]), "+v"(srcv[2]), "+v"(srcv[3])); \
      float* d_ = H + (size_t)(row0 + (ai_) * 128 + (m_) * 16) * DM + col0; \
      *(pg8::f32x4*)(d_) = srcv[0] + gv[0][0] * acc[ai_][0][m_][0]; *(pg8::f32x4*)(d_ + 16) = srcv[1] + gv[0][1] * acc[ai_][0][m_][1]; \
      *(pg8::f32x4*)(d_ + 128) = srcv[2] + gv[1][0] * acc[ai_][1][m_][0]; *(pg8::f32x4*)(d_ + 144) = srcv[3] + gv[1][1] * acc[ai_][1][m_][1]; } while (0)
    EO_LOAD(sA, 0, 0);
#pragma unroll
    for (int i = 0; i < 8; i += 2) {
      EO_LOAD(sB, (i + 1) >> 2, (i + 1) & 3);
      EO_STORE(sA, i >> 2, i & 3);
      if (i + 2 < 8) EO_LOAD(sA, (i + 2) >> 2, (i + 2) & 3);
      EO_STORE(sB, (i + 1) >> 2, (i + 1) & 3);
    }
#undef EO_LOAD
#undef EO_STORE
  }
};

template <int MODE>
__device__ void ctx_tile(int wv, const Params& P, int layer, char* smem, int tm, int tn, const bf16_t* __restrict__ A,
                         const bf16_t* __restrict__ Bt, const int K, const float* hc) {
  const int tid = otid(wv), lane = tid & 63, li = lane & 15, g = lane >> 4;
  const int kw = K >> 3;
  const bf16_t* ap = A + (size_t)(tm * 64 + li) * K + wv * kw + 8 * g;
  const bf16_t* bp = Bt + (size_t)(tn * 64 + li) * K + wv * kw + 8 * g;
  f32x4 acc[4][4];
#pragma unroll
  for (int mi = 0; mi < 4; ++mi)
#pragma unroll
    for (int ni = 0; ni < 4; ++ni) acc[mi][ni] = (f32x4){0.f, 0.f, 0.f, 0.f};
  bf16x8 fa0[4], fb0[4], fa1[4], fb1[4];
#define CT_LOAD(fa, fb, s) do { _Pragma("unroll") for (int i = 0; i < 4; ++i) { \
    fa[i] = *(const bf16x8*)(ap + (size_t)(16 * i) * K + (s) * 32); fb[i] = *(const bf16x8*)(bp + (size_t)(16 * i) * K + (s) * 32); } } while (0)
#define CT_MMA(fa, fb) do { _Pragma("unroll") for (int mi = 0; mi < 4; ++mi) _Pragma("unroll") for (int ni = 0; ni < 4; ++ni) \
    acc[mi][ni] = __builtin_amdgcn_mfma_f32_16x16x32_bf16(fb[ni], fa[mi], acc[mi][ni], 0, 0, 0); } while (0)
  const int steps = kw >> 5;
  CT_LOAD(fa0, fb0, 0);
#pragma unroll 1
  for (int s = 0; s < steps; s += 2) {
    CT_LOAD(fa1, fb1, s + 1);
    CT_MMA(fa0, fb0);
    if (s + 2 < steps) CT_LOAD(fa0, fb0, s + 2);
    CT_MMA(fa1, fb1);
  }
#undef CT_LOAD
#undef CT_MMA
  float* part = (float*)smem + wv * 4096;
#pragma unroll
  for (int mi = 0; mi < 4; ++mi)
#pragma unroll
    for (int ni = 0; ni < 4; ++ni) *(f32x4*)(part + (16 * mi + li) * 64 + (((4 * ni + g) ^ li) * 4)) = acc[mi][ni];
  __syncthreads();
  {
    const int row = tid >> 3, c4 = (tid & 7) * 2;
    const float* p0 = (const float*)smem + row * 64 + (((c4) ^ (row & 15)) * 4);
    const float* p1 = (const float*)smem + row * 64 + (((c4 + 1) ^ (row & 15)) * 4);
    f32x4 sa0 = (f32x4){0.f, 0.f, 0.f, 0.f}, sa1 = sa0, sb0 = sa0, sb1 = sa0;
#pragma unroll
    for (int w = 0; w < 4; ++w) { sa0 += *(const f32x4*)(p0 + w * 4096); sa1 += *(const f32x4*)(p1 + w * 4096); }
#pragma unroll
    for (int w = 4; w < 8; ++w) { sb0 += *(const f32x4*)(p0 + w * 4096); sb1 += *(const f32x4*)(p1 + w * 4096); }
    const int grow = NLAT + tm * 64 + row, col = tn * 64 + c4 * 4;
    if (MODE == 0) {
      const f32x4* yp = (const f32x4*)(P.yss() + (size_t)grow * 16);
      const f32x4 y4 = (yp[0] + yp[1]) + (yp[2] + yp[3]);
      const float rstd = rsqrtf(((y4[0] + y4[1]) + (y4[2] + y4[3])) * (1.f / 1024.f) + 1e-6f);
      const float* gate = P.mod() + ((size_t)layer * 5 + 4) * MODW + 2048 + col;
      const float* hs = hc + (size_t)(grow - NLAT) * DM + col;
      float* hd = P.h() + (size_t)grow * DM + col;
      const f32x4 g0 = *(const f32x4*)gate, g1 = *(const f32x4*)(gate + 4);
      const f32x4 h0 = *(const f32x4*)hs, h1 = *(const f32x4*)(hs + 4);
      *(f32x4*)hd = h0 + g0 * (sa0 * rstd + sb0);
      *(f32x4*)(hd + 4) = h1 + g1 * (sa1 * rstd + sb1);
    } else {
      const f32x4 s0 = sa0 + sb0, s1 = sa1 + sb1;
      *(uint4*)(P.q() + (size_t)grow * 2048 + col) = make_uint4(pack2(s0[0], s0[1]), pack2(s0[2], s0[3]), pack2(s1[0], s1[1]), pack2(s1[2], s1[3]));
    }
  }
  __syncthreads();
}

__device__ __forceinline__ uint32_t fp4_code(float x, float sc) {
  const float a = fabsf(x) * sc;
  const uint32_t c = (uint32_t)(a > 0.25f) + (uint32_t)(a > 0.75f) + (uint32_t)(a > 1.25f) + (uint32_t)(a > 1.75f) +
                     (uint32_t)(a > 2.5f) + (uint32_t)(a > 3.5f) + (uint32_t)(a > 5.0f);
  return c | (x < 0.f ? 8u : 0u);
}
__device__ void ph_convert_tables(int wv, const Params& P, int layer, int bid, int nb) {
  const int lane = otid(wv) & 63;
  for (int it0 = (bid * NWAVE + wv) * 2; it0 < 2 * 16384; it0 += nb * NWAVE * 2) {
    f32x4 v[2][4];
#pragma unroll
    for (int rr = 0; rr < 2; ++rr) {
      const int it = it0 + rr, t = it >> 14, e = it & 16383;
      const float* src = (t == 0 ? P.peer_u : P.peer_v) + ((size_t)layer * 16384 + e) * 1024 + lane * 16;
#pragma unroll
      for (int i = 0; i < 4; ++i) v[rr][i] = ((const f32x4*)src)[i];
    }
#pragma unroll
    for (int rr = 0; rr < 2; ++rr)
#pragma unroll
      for (int i = 0; i < 4; ++i) asm volatile("" : "+v"(v[rr][i]));
#pragma unroll
    for (int rr = 0; rr < 2; ++rr) {
      const int it = it0 + rr, t = it >> 14, e = it & 16383;
      float m = 0.f;
#pragma unroll
      for (int i = 0; i < 4; ++i)
        m = fmaxf(m, fmaxf(fmaxf(fabsf(v[rr][i][0]), fabsf(v[rr][i][1])), fmaxf(fabsf(v[rr][i][2]), fabsf(v[rr][i][3]))));
      m = wave_max(m);
      m = fmaxf(m, 1e-30f);
      const float sc = 6.0f / m, inv = m * (1.0f / 6.0f);
      uint2 o;
      {
        uint32_t p0 = 0u, p1 = 0u;
        p0 = __builtin_amdgcn_cvt_scalef32_pk_fp4_f32(p0, v[rr][0][0] * sc, v[rr][0][1] * sc, 1.0f, 0);
        p0 = __builtin_amdgcn_cvt_scalef32_pk_fp4_f32(p0, v[rr][0][2] * sc, v[rr][0][3] * sc, 1.0f, 1);
        p0 = __builtin_amdgcn_cvt_scalef32_pk_fp4_f32(p0, v[rr][1][0] * sc, v[rr][1][1] * sc, 1.0f, 2);
        p0 = __builtin_amdgcn_cvt_scalef32_pk_fp4_f32(p0, v[rr][1][2] * sc, v[rr][1][3] * sc, 1.0f, 3);
        p1 = __builtin_amdgcn_cvt_scalef32_pk_fp4_f32(p1, v[rr][2][0] * sc, v[rr][2][1] * sc, 1.0f, 0);
        p1 = __builtin_amdgcn_cvt_scalef32_pk_fp4_f32(p1, v[rr][2][2] * sc, v[rr][2][3] * sc, 1.0f, 1);
        p1 = __builtin_amdgcn_cvt_scalef32_pk_fp4_f32(p1, v[rr][3][0] * sc, v[rr][3][1] * sc, 1.0f, 2);
        p1 = __builtin_amdgcn_cvt_scalef32_pk_fp4_f32(p1, v[rr][3][2] * sc, v[rr][3][3] * sc, 1.0f, 3);
        o.x = p0; o.y = p1;
      }
      *(uint2*)((t == 0 ? P.tabU() : P.tabV()) + (size_t)e * 512 + lane * 8) = o;
      if (lane == 0) (t == 0 ? P.invU() : P.invV())[e] = inv;
    }
  }
}

enum {
  PH_PREP = 0, PH_NORM1, PH_INPROJ, PH_CONV, PH_SSDPREP, PH_STATES, PH_SCAN, PH_SSDY, PH_SSDNORM, PH_POOL, PH_NA,
  PH_OUTPROJ, PH_NORM2, PH_QGEMM, PH_TOPK, PH_GATHER, PH_FINAL
};

#define SMEM_BYTES 135168

__device__ __forceinline__ void run_phase(int wv, const Params& P, int ph, int layer, char* smem, int bid, int nb) {
  const float* hl = layer == 0 ? P.x : P.h();
  const float* hc = layer == 0 ? P.ctx : P.h() + (size_t)NLAT * DM;
  const int nrows = layer == 0 ? NTOK : NLAT;
  switch (ph) {
    case PH_PREP:
      for (int i = bid * NTHR + otid(wv); i < 2 * 8 * 2 * 128 * 128; i += nb * NTHR) P.keysb()[i] = f2bf(P.peer_keys[i]);
      for (int i = bid * NTHR + otid(wv); i < 2 * 4 * 128 * 128; i += nb * NTHR) {
        const int k = i & 127, n = (i >> 7) & 127, lg = i >> 14;
        P.poolwT()[i] = f2bf(P.pool_w[((size_t)lg * 128 + k) * 128 + n]);
      }
      ph_mod(wv, P, (float*)smem, bid, nb);
      for (int l = 0; l < 2; ++l) {
        ph_transpose(wv, P.w_in + (size_t)l * 1024 * INW, P.w_inT() + (size_t)l * PW * 1024, 1024, INW, PW, 0, 2560, 32, PW, (float*)smem, bid, nb);
        ph_transpose(wv, P.w_in + (size_t)l * 1024 * INW, P.w_dtT() + (size_t)l * 128 * 1024, 1024, INW, 128, 2560, 1 << 30, 0, 32, (float*)smem, bid, nb);
        ph_transpose(wv, P.w_out + (size_t)l * 2048 * 1024, P.w_outT() + (size_t)l * 1024 * 2048, 2048, 1024, 1024, 0, 1 << 30, 0, 1024, (float*)smem, bid, nb,
                     P.ssd_norm_g + l * 1024, 1024);
        ph_transpose(wv, P.peer_wq + (size_t)l * 1024 * 2048, P.w_qT() + (size_t)l * 2048 * 1024, 1024, 2048, 2048, 0, 1 << 30, 0, 2048, (float*)smem, bid, nb);
      }
      break;
    case PH_NORM1:
      ph_norm(wv, hl, hc, P.norm1_g + layer * 1024, P.mod() + (size_t)layer * 5 * MODW, 0, 1024, NTOK, P.u(), bid, nb);
      break;
    case PH_INPROJ:
    {
      pg8::Gemm g{P.u(), P.w_inT() + (size_t)layer * PW * 1024, NTOK, PW, 1024};
      pg8::StaticOrder S; S.init(g.M, g.N, nb, bid);
      pg8::EpiBf16<0> E{P.p(), PW, nullptr, 0, 0};
      pg8::gemm_phase<pg8::EpiBf16<0>, pg8::StaticOrder, false>(wv, (PG8_LAS unsigned char*)smem, g, S, E, nullptr);
      {
        const int units = (NTOK / 256) * (PW / 256), rem = units % nb;
        const int nidle = rem == 0 ? nb : nb - rem, first_idle = rem == 0 ? 0 : rem;
        if (bid >= first_idle) ph_dtprep(wv, P, layer, smem, bid - first_idle, nidle);
      }
      break;
    }
    case PH_CONV: ph_conv(wv, P, layer, bid, nb); ph_vtranspose(wv, P, smem, bid, nb); break;
    case PH_STATES: ph_states_mfma(wv, P, layer, smem, bid, nb); break;
    case PH_SCAN: ph_scan(wv, P, bid, nb); break;
    case PH_SSDY: ph_ssdy_mfma(wv, P, layer, nrows / 128, smem, bid, nb); break;
    case PH_POOL: ph_pool_mfma(wv, P, layer, nrows, smem, bid, nb); break;
    case PH_NA: ph_na_mfma(wv, P, layer, nrows, smem, bid, nb); break;
    case PH_OUTPROJ:
    {
      pg8::Gemm g{P.concat(), P.w_outT() + (size_t)layer * 1024 * 2048, NLAT, 1024, 2048};
      pg8::StaticOrder S; S.init(g.M, g.N, nb, bid);
      EpiOutproj E{P.h(), hl, hc, P.mod() + (size_t)layer * 5 * MODW, P.yss()};
      pg8::gemm_phase<EpiOutproj, pg8::StaticOrder, false>(wv, (PG8_LAS unsigned char*)smem, g, S, E, nullptr);
      if (layer == 0)
        for (int t = bid; t < 16 * 16; t += nb)
          ctx_tile<0>(wv, P, layer, smem, t >> 4, t & 15, P.concat() + (size_t)NLAT * 2048, P.w_outT() + (size_t)layer * 1024 * 2048, 2048, hc);
      break;
    }
    case PH_NORM2:
      ph_norm(wv, P.h(), P.h() + (size_t)NLAT * DM, P.norm2_g + layer * 1024, P.mod() + (size_t)layer * 5 * MODW, 3072, 4096, nrows, P.u(), bid, nb);
      break;
    case PH_QGEMM:
    {
      pg8::Gemm g{P.u(), P.w_qT() + (size_t)layer * 2048 * 1024, NLAT, 2048, 1024};
      pg8::StaticOrder S; S.init(g.M, g.N, nb, bid);
      pg8::EpiBf16<0> E{P.q(), 2048, nullptr, 0, 0};
      pg8::gemm_phase<pg8::EpiBf16<0>, pg8::StaticOrder, false>(wv, (PG8_LAS unsigned char*)smem, g, S, E, nullptr);
      if (layer == 0)
        for (int t = bid; t < 16 * 32; t += nb)
          ctx_tile<1>(wv, P, layer, smem, t >> 5, t & 31, P.u() + (size_t)NLAT * 1024, P.w_qT() + (size_t)layer * 2048 * 1024, 1024, nullptr);
      ph_convert_tables(wv, P, layer, bid, nb);
      break;
    }
    case PH_TOPK: ph_peer_topk_mfma(wv, P, layer, nrows, smem, bid, nb); break;
    case PH_GATHER: ph_peer_dots(wv, P, layer, nrows, bid, nb); ph_peer_acc(wv, P, layer, nrows, bid, nb); break;
  }
}

namespace cg = cooperative_groups;
typedef const __attribute__((address_space(4))) Params* kparams_t;
__device__ __forceinline__ const Params& kp_fresh() {
  kparams_t kp = (kparams_t)__builtin_amdgcn_kernarg_segment_ptr();
  asm volatile("" : "+s"(kp));
  return *(const Params*)kp;
}
__global__ void __launch_bounds__(NTHR) k_mega(Params P_unused) {
  __shared__ __attribute__((aligned(16))) char smem[SMEM_BYTES + 16];
  cg::grid_group grid = cg::this_grid();
  const int bid = blockIdx.x, nb = gridDim.x;
  const int wv = __builtin_amdgcn_readfirstlane(threadIdx.x >> 6);
  if (threadIdx.x == 0) *(uint4*)(smem + SMEM_BYTES) = make_uint4(0u, 0u, 0u, 0u);
  __syncthreads();
  (void)xcd_barrier_post((unsigned*)(kp_fresh().ws + WS_BAR), (volatile LAS unsigned*)(smem + SMEM_BYTES), threadIdx.x == 0);
#define GSYNC() do { XcdBarrier xb_; xb_.bar = (unsigned*)(kp_fresh().ws + WS_BAR); xb_.x = xb_xcc_id(); \
    xb_.st = (volatile LAS unsigned*)(smem + SMEM_BYTES); xcd_barrier(xb_, otid(wv) == 0); } while (0)
  run_phase(wv, kp_fresh(), PH_PREP, 0, smem, bid, nb);
  if (nb == 0x7fffff00) grid.sync();
  GSYNC();
  run_phase(wv, kp_fresh(), PH_NORM1, 0, smem, bid, nb); GSYNC();
#pragma unroll 1
  for (int layer = 0; layer < 2; ++layer) {
    run_phase(wv, kp_fresh(), PH_INPROJ, layer, smem, bid, nb); GSYNC();
    run_phase(wv, kp_fresh(), PH_CONV, layer, smem, bid, nb);
    GSYNC();
    run_phase(wv, kp_fresh(), PH_STATES, layer, smem, bid, nb);
    run_phase(wv, kp_fresh(), PH_POOL, layer, smem, bid, nb);
    run_phase(wv, kp_fresh(), PH_NA, layer, smem, bid, nb); GSYNC();
    run_phase(wv, kp_fresh(), PH_SCAN, layer, smem, bid, nb); GSYNC();
    run_phase(wv, kp_fresh(), PH_SSDY, layer, smem, bid, nb); GSYNC();
    run_phase(wv, kp_fresh(), PH_OUTPROJ, layer, smem, bid, nb); GSYNC();
    run_phase(wv, kp_fresh(), PH_NORM2, layer, smem, bid, nb); GSYNC();
    run_phase(wv, kp_fresh(), PH_QGEMM, layer, smem, bid, nb); GSYNC();
    run_phase(wv, kp_fresh(), PH_TOPK, layer, smem, bid, nb); GSYNC();
    run_phase(wv, kp_fresh(), PH_GATHER, layer, smem, bid, nb);
    if (layer == 0) GSYNC();
  }
}

extern "C" void kernel_launch(void* const* d_in, const int* in_sizes, int n_in, void* d_out, int out_size, void* d_ws,
                              size_t ws_size, hipStream_t stream) {
  Params P{};
  const float* const* in = (const float* const*)d_in;
  P.x = in[0]; P.c = in[1]; P.ctx = in[2]; P.c_ctx = in[3]; P.ada_w = in[4]; P.ada_b = in[5]; P.norm1_g = in[6];
  P.w_in = in[7]; P.conv_w = in[8]; P.conv_b = in[9]; P.a_log = in[10]; P.dt_bias = in[11]; P.d_skip = in[12];
  P.ssd_norm_g = in[13]; P.pool_w = in[14]; P.pool_scale = in[15]; P.na_rpb = in[16]; P.w_out = in[17];
  P.norm2_g = in[18]; P.peer_wq = in[19]; P.peer_keys = in[20]; P.peer_u = in[21]; P.peer_v = in[22]; P.final_g = in[23];
  P.out = (float*)d_out;
  P.ws = (char*)d_ws;
  if (WS_TOTAL > ws_size) { fprintf(stderr, "workspace too small: need %zu have %zu\n", (size_t)WS_TOTAL, ws_size); return; }

  static int grid_blocks = 0;
  if (!grid_blocks) {
    int dev = 0, cus = 0, per_cu = 0;
    hipGetDevice(&dev);
    hipDeviceGetAttribute(&cus, hipDeviceAttributeMultiprocessorCount, dev);
    hipOccupancyMaxActiveBlocksPerMultiprocessor(&per_cu, k_mega, NTHR, 0);
    if (per_cu > 4) per_cu = 4;
    grid_blocks = cus * per_cu;
  }
  hipMemsetAsync((char*)d_ws + WS_BAR, 0, 4096 * 4, stream);
  void* args[] = {&P};
  hipError_t e = hipLaunchCooperativeKernel((void*)k_mega, dim3(grid_blocks), dim3(NTHR), args, 0, stream);
  if (e != hipSuccess) fprintf(stderr, "cooperative launch failed: %s (grid %d)\n", hipGetErrorString(e), grid_blocks);
}
```

```cpp
#include <hip/hip_runtime.h>
#include <hip/hip_bf16.h>
#include <hip/hip_cooperative_groups.h>
#include <stdint.h>
#include <stdio.h>

typedef unsigned short bf16_t;
typedef __attribute__((ext_vector_type(8))) short bf16x8;
typedef __attribute__((ext_vector_type(4))) float f32x4;

#define NTHR 512
#define NWAVE 8
constexpr int DM = 1024;
constexpr int SEQ = 4096;
constexpr int NLAT = 16384;
constexpr int NCTXR = 1024;
constexpr int NTOK = 17408;
constexpr int INW = 4640;
constexpr int PW = 4608;
constexpr int OFF_Z = 0, OFF_XBC = 1024, OFF_POOL = 2560, OFF_Q = 3072, OFF_K = 3584, OFF_V = 4096;
constexpr int NCHUNK = 136;
constexpr int MODW = 6144;

constexpr size_t al256(size_t x) { return (x + 255) & ~(size_t)255; }
constexpr size_t WS_MOD = 0;
constexpr size_t WS_H = WS_MOD + al256((size_t)2 * 5 * MODW * 4);
constexpr size_t WS_P = WS_H + al256((size_t)NTOK * DM * 4);
constexpr size_t WS_TABU = WS_P + (size_t)80 * 1024 * 1024;
constexpr size_t WS_TABV = WS_TABU + (size_t)16384 * 512;
constexpr size_t WS_INVU = WS_TABV + (size_t)16384 * 512;
constexpr size_t WS_INVV = WS_INVU + (size_t)16384 * 4;
constexpr size_t WS_DTRAW = WS_P + al256((size_t)NTOK * PW * 2);
constexpr size_t WS_DTV = WS_DTRAW + al256((size_t)NTOK * 32 * 4);
constexpr size_t WS_CSV = WS_DTV + al256((size_t)NTOK * 32 * 4);
constexpr size_t WS_XBC = WS_CSV + al256((size_t)NTOK * 32 * 4);
constexpr size_t WS_VTL = WS_XBC + al256((size_t)NTOK * 512 * 2);
constexpr size_t WS_VTC = WS_VTL + al256((size_t)4 * 8 * 64 * 4096 * 2);
constexpr size_t WS_KEYSB = WS_VTC + al256((size_t)4 * 8 * 64 * 256 * 2);
constexpr size_t WS_POOLWT = WS_KEYSB + al256((size_t)2 * 8 * 2 * 128 * 128 * 2);
constexpr size_t WS_BT4 = WS_POOLWT + al256((size_t)2 * 4 * 128 * 128 * 2);
constexpr size_t WS_ATOT = WS_BT4 + al256((size_t)NTOK * 256 * 2);
constexpr size_t WS_STATES = WS_XBC + al256((size_t)NTOK * 1536 * 2);
constexpr size_t WS_YSS = WS_ATOT + al256((size_t)NCHUNK * 32 * 4);
static_assert(WS_YSS + (size_t)NTOK * 16 * 4 <= WS_STATES, "must fit in the old xbc region");
constexpr size_t WS_CONCAT = WS_STATES + al256((size_t)NCHUNK * 32 * 8192 * 2);
constexpr size_t WS_SELIDX = WS_CONCAT + al256((size_t)NTOK * 2048 * 2);
constexpr size_t WS_SELG = WS_SELIDX + al256((size_t)NTOK * 128 * 4);
constexpr size_t WS_WINT = WS_SELG + al256((size_t)NTOK * 128 * 4);
constexpr size_t WS_WDTT = WS_WINT + al256((size_t)2 * PW * 1024 * 2);
constexpr size_t WS_WOUTT = WS_WDTT + al256((size_t)2 * 128 * 1024 * 2);
constexpr size_t WS_WQT = WS_WOUTT + al256((size_t)2 * 1024 * 2048 * 2);
constexpr size_t WS_BAR = WS_WQT + al256((size_t)2 * 2048 * 1024 * 2);
constexpr size_t WS_XT4 = WS_BAR + al256((size_t)4096 * 4);
constexpr size_t WS_TOTAL = WS_XT4 + al256((size_t)NTOK * 1024 * 2);
static_assert((size_t)4 * 8 * (4096 + 256) * 64 * 2 <= WS_WINT - WS_SELIDX, "K relayout must fit in the sel_idx/sel_g region");
static_assert(WS_INVV + (size_t)16384 * 4 <= WS_DTRAW, "tables must fit in the tail of p");
static_assert((size_t)NTOK * 2048 * 2 <= (size_t)80 * 1024 * 1024, "q must fit below the tables");

struct Params {
  const float *x, *c, *ctx, *c_ctx, *ada_w, *ada_b, *norm1_g, *w_in, *conv_w, *conv_b, *a_log, *dt_bias, *d_skip,
      *ssd_norm_g, *pool_w, *pool_scale, *na_rpb, *w_out, *norm2_g, *peer_wq, *peer_keys, *peer_u, *peer_v, *final_g;
  float* out;
  char* ws;
  __device__ __forceinline__ float* mod() const { return (float*)(ws + WS_MOD); }
  __device__ __forceinline__ float* h() const { return (float*)(ws + WS_H); }
  __device__ __forceinline__ bf16_t* u() const { return (bf16_t*)(ws + WS_CONCAT); }
  __device__ __forceinline__ bf16_t* p() const { return (bf16_t*)(ws + WS_P); }
  __device__ __forceinline__ float* dtraw() const { return (float*)(ws + WS_DTRAW); }
  __device__ __forceinline__ float* dtv() const { return (float*)(ws + WS_DTV); }
  __device__ __forceinline__ float* csv() const { return (float*)(ws + WS_CSV); }
  __device__ __forceinline__ bf16_t* xbc() const { return (bf16_t*)(ws + WS_XBC); }
  __device__ __forceinline__ bf16_t* states() const { return (bf16_t*)(ws + WS_STATES); }
  __device__ __forceinline__ bf16_t* concat() const { return (bf16_t*)(ws + WS_CONCAT); }
  __device__ __forceinline__ bf16_t* q() const { return (bf16_t*)(ws + WS_P); }
  __device__ __forceinline__ int* sel_idx() const { return (int*)(ws + WS_SELIDX); }
  __device__ __forceinline__ float* sel_g() const { return (float*)(ws + WS_SELG); }
  __device__ __forceinline__ bf16_t* w_inT() const { return (bf16_t*)(ws + WS_WINT); }
  __device__ __forceinline__ bf16_t* w_dtT() const { return (bf16_t*)(ws + WS_WDTT); }
  __device__ __forceinline__ bf16_t* w_outT() const { return (bf16_t*)(ws + WS_WOUTT); }
  __device__ __forceinline__ bf16_t* w_qT() const { return (bf16_t*)(ws + WS_WQT); }
  __device__ __forceinline__ bf16_t* vtl() const { return (bf16_t*)(ws + WS_VTL); }
  __device__ __forceinline__ bf16_t* vtc() const { return (bf16_t*)(ws + WS_VTC); }
  __device__ __forceinline__ bf16_t* poolwT() const { return (bf16_t*)(ws + WS_POOLWT); }
  __device__ __forceinline__ bf16_t* keysb() const { return (bf16_t*)(ws + WS_KEYSB); }
  __device__ __forceinline__ bf16_t* xt4() const { return (bf16_t*)(ws + WS_XT4); }
  __device__ __forceinline__ bf16_t* bt4() const { return (bf16_t*)(ws + WS_BT4); }
  __device__ __forceinline__ float* wst() const { return (float*)(ws + WS_DTRAW); }
  __device__ __forceinline__ float* cst() const { return (float*)(ws + WS_CSV); }
  __device__ __forceinline__ float* dtt() const { return (float*)(ws + WS_DTV); }
  __device__ __forceinline__ float* yss() const { return (float*)(ws + WS_YSS); }
  __device__ __forceinline__ float* atot() const { return (float*)(ws + WS_ATOT); }
  __device__ __forceinline__ bf16_t* bfr() const { return (bf16_t*)(ws + WS_XBC); }
  __device__ __forceinline__ bf16_t* cfr() const { return (bf16_t*)(ws + WS_XBC + (size_t)NTOK * 256 * 2); }
  __device__ __forceinline__ bf16_t* ktl() const { return (bf16_t*)(ws + WS_SELIDX); }
  __device__ __forceinline__ bf16_t* ktc() const { return (bf16_t*)(ws + WS_SELIDX + (size_t)4 * 8 * 4096 * 64 * 2); }
  __device__ __forceinline__ unsigned char* tabU() const { return (unsigned char*)(ws + WS_TABU); }
  __device__ __forceinline__ unsigned char* tabV() const { return (unsigned char*)(ws + WS_TABV); }
  __device__ __forceinline__ float* invU() const { return (float*)(ws + WS_INVU); }
  __device__ __forceinline__ float* invV() const { return (float*)(ws + WS_INVV); }
};

__device__ __forceinline__ int otid(int wv) {
  int l;
  asm volatile("v_mbcnt_lo_u32_b32 %0, -1, 0\n\tv_mbcnt_hi_u32_b32 %0, -1, %0" : "=v"(l));
  return (wv << 6) | l;
}
__device__ __forceinline__ float bf2f(bf16_t v) { return __uint_as_float(((uint32_t)v) << 16); }
typedef __bf16 bf16x2_hw __attribute__((ext_vector_type(2)));
__device__ __forceinline__ uint32_t pack2(float a, float b) {
  const float __attribute__((ext_vector_type(2))) v = {a, b};
  return __builtin_bit_cast(uint32_t, __builtin_convertvector(v, bf16x2_hw));
}
__device__ __forceinline__ bf16_t f2bf(float f) { return (bf16_t)(pack2(f, 0.f) & 0xffffu); }
#define DPP_F(v, ctrl) __int_as_float(__builtin_amdgcn_update_dpp(0, __float_as_int(v), (ctrl), 0xf, 0xf, true))
__device__ __forceinline__ float wave_sum(float v) {
  v += DPP_F(v, 0xB1);
  v += DPP_F(v, 0x4E);
  v += DPP_F(v, 0x141);
  v += DPP_F(v, 0x140);
  const int iv = __float_as_int(v);
  return __int_as_float(__builtin_amdgcn_readlane(iv, 0)) + __int_as_float(__builtin_amdgcn_readlane(iv, 16)) +
         __int_as_float(__builtin_amdgcn_readlane(iv, 32)) + __int_as_float(__builtin_amdgcn_readlane(iv, 48));
}
__device__ __forceinline__ float wave_max(float v) {
  v = fmaxf(v, DPP_F(v, 0xB1));
  v = fmaxf(v, DPP_F(v, 0x4E));
  v = fmaxf(v, DPP_F(v, 0x141));
  v = fmaxf(v, DPP_F(v, 0x140));
  const int iv = __float_as_int(v);
  return fmaxf(fmaxf(__int_as_float(__builtin_amdgcn_readlane(iv, 0)), __int_as_float(__builtin_amdgcn_readlane(iv, 16))),
               fmaxf(__int_as_float(__builtin_amdgcn_readlane(iv, 32)), __int_as_float(__builtin_amdgcn_readlane(iv, 48))));
}
__device__ __forceinline__ float fexp(float v) { return __builtin_amdgcn_exp2f(v * 1.44269504088896341f); }
__device__ __forceinline__ float silu_f(float v) { return v * __builtin_amdgcn_rcpf(1.f + fexp(-v)); }
__device__ __forceinline__ float softplus_f(float v) { return fmaxf(v, 0.f) + log1pf(expf(-fabsf(v))); }
__device__ __forceinline__ float gelu_f(float v) { return 0.5f * v * (1.f + erff(v * 0.70710678118654752f)); }

__device__ __forceinline__ void unpack8(const uint4 v, float* f) {
  f[0] = __uint_as_float(v.x << 16); f[1] = __uint_as_float(v.x & 0xffff0000u);
  f[2] = __uint_as_float(v.y << 16); f[3] = __uint_as_float(v.y & 0xffff0000u);
  f[4] = __uint_as_float(v.z << 16); f[5] = __uint_as_float(v.z & 0xffff0000u);
  f[6] = __uint_as_float(v.w << 16); f[7] = __uint_as_float(v.w & 0xffff0000u);
}
typedef float f32x2_t __attribute__((ext_vector_type(2)));
typedef unsigned u32x4_t __attribute__((ext_vector_type(4)));
typedef short s16x4 __attribute__((ext_vector_type(4)));
typedef __attribute__((address_space(3))) s16x4 lds_s16x4;
__device__ __forceinline__ bf16x8 tr_read2(const char* a0, const char* a1) {
  const s16x4 a = __builtin_amdgcn_ds_read_tr16_b64_v4i16((lds_s16x4*)a0);
  const s16x4 b = __builtin_amdgcn_ds_read_tr16_b64_v4i16((lds_s16x4*)a1);
  return (bf16x8){a[0], a[1], a[2], a[3], b[0], b[1], b[2], b[3]};
}

__device__ __forceinline__ const float* hrow(const float* hl, const float* hc, int row) {
  return row < NLAT ? hl + (size_t)row * DM : hc + (size_t)(row - NLAT) * DM;
}
__device__ __forceinline__ int modrow(int row) { return row < NLAT ? (row >> 12) : 4; }

namespace pg8 {
#define PG8_LAS __attribute__((address_space(3)))
typedef unsigned short bf16_t;
typedef short bf16x8 __attribute__((ext_vector_type(8)));
typedef float f32x4 __attribute__((ext_vector_type(4)));
typedef unsigned u32x4 __attribute__((ext_vector_type(4)));
constexpr int BM = 256, BK = 64, HALF = 128, HTB = HALF * BK * 2  , STAGE_BYTES = 8 * HTB, NXCD = 8, WGM = 8;

__host__ __device__ __forceinline__ int lds_byte(int r, int c) { const int st = (r >> 4) * 2 + (c >> 5), rr = r & 15, cc = c & 31, ob = rr * 64 + cc * 2; return st * 1024 + (ob ^ (((ob >> 9) & 1) << 5)); }
__host__ __device__ __forceinline__ void stage_rc(int b, int& R, int& C) { const int st = b / 1024, sb = b % 1024, swz = sb ^ (((sb >> 9) & 1) << 5); R = (st >> 1) * 16 + swz / 64; C = (st & 1) * 32 + (swz % 64) / 2; }
__host__ __device__ __forceinline__ int perm32(int rho) { const int n = rho >> 4, i = rho & 15; return 8 * (i >> 2) + 4 * n + (i & 3); }

struct Unit { int pm, pn; };
struct Gemm { const bf16_t* A; const bf16_t* Bt; int M, N, K; };

struct StaticOrder {
    int nM, nN, nwg, G, c;
    __host__ __device__ void init(int M, int N, int G_, int c_) { nM = M / BM; nN = N / BM; nwg = nM * nN; G = G_; c = c_; }
    __host__ __device__ bool next(int i, Unit& u) const {
        const long L = (long)i * G + c; if (L >= nwg) return false;
        int wgid = (int)L; { const int q = nwg / NXCD, r = nwg % NXCD, xcd = wgid % NXCD, off = wgid / NXCD; wgid = (xcd < r ? xcd * (q + 1) : r * (q + 1) + (xcd - r) * q) + off; }
        const int nig = WGM * nN, gid = wgid / nig, fm = gid * WGM, gsz = (nM - fm) < WGM ? (nM - fm) : WGM;
        u.pm = fm + ((wgid % nig) % gsz); u.pn = (wgid % nig) / gsz; return true;
    }
    __device__ __forceinline__ void a_ready(const Unit&) const {}
    __device__ __forceinline__ void done(const Unit&) const {}
};

__device__ __forceinline__ unsigned cvt_pk_bf16(float lo, float hi) { unsigned r; asm volatile("v_cvt_pk_bf16_f32 %0, %1, %2" : "=v"(r) : "v"(lo), "v"(hi)); return r; }
typedef float f32x2 __attribute__((ext_vector_type(2)));
__device__ __forceinline__ f32x2 gelu_pk(f32x2 v) { return v; }
template <int ACT  > struct EpiBf16 {
    static constexpr bool PERM = true, AFTER_DRAIN = false; static constexpr int MIDK_T = 0;
    bf16_t* O; int ldc; const float* bias; int split_cols; size_t split_stride;
    __device__ __forceinline__ void operator()(const f32x4 (&acc)[2][2][4][2], const Unit& u, int wr, int wc, int fr, int fq) const {
        const int row0 = u.pm * BM + wr * 64 + fr; int colt = u.pn * BM; bf16_t* base = O;
        if (split_cols) { const int t = colt / split_cols; base += (size_t)t * split_stride; colt -= t * split_cols; }
        const int col0 = colt + wc * 32 + 8 * fq, bcol0 = u.pn * BM + wc * 32 + 8 * fq;
        f32x4 bv[2][2];
#pragma unroll
        for (int bj = 0; bj < 2; ++bj)
#pragma unroll
            for (int n = 0; n < 2; ++n) bv[bj][n] = bias ? *(const f32x4*)(bias + bcol0 + bj * HALF + 4 * n) : (f32x4){0.f, 0.f, 0.f, 0.f};
#pragma unroll
        for (int ai = 0; ai < 2; ++ai)
#pragma unroll
            for (int m = 0; m < 4; ++m) { bf16_t* rowp = base + (size_t)(row0 + ai * HALF + m * 16) * ldc + col0;
#pragma unroll
                for (int bj = 0; bj < 2; ++bj) { f32x4 v0 = acc[ai][bj][m][0] + bv[bj][0], v1 = acc[ai][bj][m][1] + bv[bj][1];
                    if (ACT == 1) { f32x2 a = gelu_pk((f32x2){v0[0], v0[1]}), b = gelu_pk((f32x2){v0[2], v0[3]}), c = gelu_pk((f32x2){v1[0], v1[1]}), d = gelu_pk((f32x2){v1[2], v1[3]});
                        v0 = (f32x4){a.x, a.y, b.x, b.y}; v1 = (f32x4){c.x, c.y, d.x, d.y}; }
                    if (ACT == 2) {
#pragma unroll
                        for (int j = 0; j < 4; ++j) { v0[j] = 0.5f * v0[j] * (1.0f + erff(v0[j] * 0.70710678f)); v1[j] = 0.5f * v1[j] * (1.0f + erff(v1[j] * 0.70710678f)); } }
                    u32x4 w; w.x = cvt_pk_bf16(v0[0], v0[1]); w.y = cvt_pk_bf16(v0[2], v0[3]); w.z = cvt_pk_bf16(v1[0], v1[1]); w.w = cvt_pk_bf16(v1[2], v1[3]);
                    *(u32x4*)(rowp + bj * HALF) = w; } }
    }
};

template <class Epi, class Sched, bool STAMP = false>
__device__ __forceinline__ void gemm_phase(int wv, PG8_LAS unsigned char* lds, const Gemm g, const Sched& S, const Epi& E, unsigned long long* stamps) {
    const int tid = otid(wv), wid = __builtin_amdgcn_readfirstlane(tid >> 6), lane = tid & 63, wr = wid >> 2, wc = wid & 3, fr = lane & 15, fq = lane >> 4;
    const int K = g.K, nt = K / BK;
    int ts_lo = 0, ts_hi = 0, nts = 0; const unsigned long long rt_entry = STAMP ? (unsigned long long)wall_clock64() : 0ull;
#define PG8_STAMP() do { if (STAMP && wid == 0 && nts < 64) { const unsigned long long _c = (unsigned long long)clock64(); \
        ts_lo = (lane == nts) ? (int)(unsigned)_c : ts_lo; ts_hi = (lane == nts) ? (int)(unsigned)(_c >> 32) : ts_hi; ++nts; } } while (0)
    PG8_STAMP();
    unsigned voffA[2], voffB[2];
#pragma unroll
    for (int i = 0; i < 2; ++i) { int R, C; stage_rc(tid * 16 + i * 8192, R, C); const int Rb = Epi::PERM ? ((R & ~31) + perm32(R & 31)) : R;
        voffA[i] = (unsigned)(R * K + C) * 2u; voffB[i] = (unsigned)(Rb * K + C) * 2u; }
    const size_t kstep = (size_t)(BK * 2);
    const size_t hstep = (size_t)HALF * K * 2;
    const size_t tstep = 2 * hstep;
    const unsigned ldsw = (unsigned)wid * 1024u;
    const int aoff = lds_byte(wr * 64 + fr, fq * 8), boff = lds_byte(wc * 32 + fr, fq * 8);
#define PG8_SA(b, h) (((b) * 2 + (h)) * HTB)
#define PG8_SB(b, h) ((4 + (b) * 2 + (h)) * HTB)
#define PG8_STAGE(bufoff, gbase, voff) do { _Pragma("unroll") for (int _i = 0; _i < 2; ++_i) \
        __builtin_amdgcn_global_load_lds((const unsigned*)((const char*)(gbase) + (voff)[_i]), (PG8_LAS unsigned*)(lds + (bufoff) + ldsw + _i * 8192), 16, 0, 0); } while (0)
#define PG8_LDA(dst, b, h) do { _Pragma("unroll") for (int m = 0; m < 4; ++m) _Pragma("unroll") for (int k = 0; k < 2; ++k) dst[m][k] = *(const PG8_LAS bf16x8*)(lds + PG8_SA(b, h) + aoff + m * 2048 + k * 1024); } while (0)
#define PG8_LDB(dst, b, h) do { _Pragma("unroll") for (int n = 0; n < 2; ++n) _Pragma("unroll") for (int k = 0; k < 2; ++k) dst[n][k] = *(const PG8_LAS bf16x8*)(lds + PG8_SB(b, h) + boff + n * 2048 + k * 1024); } while (0)
#define PG8_MMA(ai, bj, At, Bt) do { __builtin_amdgcn_s_setprio(1); _Pragma("unroll") for (int m = 0; m < 4; ++m) _Pragma("unroll") for (int n = 0; n < 2; ++n) _Pragma("unroll") for (int k = 0; k < 2; ++k) \
        acc[ai][bj][m][n] = __builtin_amdgcn_mfma_f32_16x16x32_bf16(Bt[n][k], At[m][k], acc[ai][bj][m][n], 0, 0, 0); __builtin_amdgcn_s_setprio(0); } while (0)
#define PG8_WAIT_V(n) asm volatile("s_waitcnt vmcnt(" #n ")" ::: "memory")
#define PG8_WAIT_L(n) asm volatile("s_waitcnt lgkmcnt(" #n ")" ::: "memory")
#define PG8_BAR __builtin_amdgcn_s_barrier()
#define PG8_SCHED __builtin_amdgcn_sched_barrier(0)
    Unit cur, nxt; int ui = 0;
    if (!S.next(0, cur)) return;
    f32x4 acc[2][2][4][2];
#pragma unroll
    for (int a = 0; a < 2; ++a)
#pragma unroll
        for (int b = 0; b < 2; ++b)
#pragma unroll
            for (int m = 0; m < 4; ++m)
#pragma unroll
                for (int n = 0; n < 2; ++n) acc[a][b][m][n] = (f32x4){0.f, 0.f, 0.f, 0.f};
    bf16x8 At[4][2], B0[2][2], B1[2][2];
    const char* cA = (const char*)g.A + (size_t)cur.pm * tstep; const char* cB = (const char*)g.Bt + (size_t)cur.pn * tstep;
    S.a_ready(cur);
    PG8_STAGE(PG8_SB(0, 0), cB, voffB); PG8_STAGE(PG8_SA(0, 0), cA, voffA); PG8_STAGE(PG8_SB(0, 1), cB + hstep, voffB); PG8_STAGE(PG8_SA(0, 1), cA + hstep, voffA);
    if (wr == 1) PG8_BAR;
    PG8_WAIT_V(4); PG8_BAR;
    PG8_STAGE(PG8_SB(1, 0), cB + kstep, voffB); PG8_STAGE(PG8_SA(1, 0), cA + kstep, voffA); PG8_STAGE(PG8_SB(1, 1), cB + hstep + kstep, voffB);
    PG8_WAIT_V(6); PG8_BAR;
    PG8_STAMP();
    for (;;) {
        const bool has_next = S.next(ui + 1, nxt);
        const char* nA = has_next ? (const char*)g.A + (size_t)nxt.pm * tstep : cA; const char* nB = has_next ? (const char*)g.Bt + (size_t)nxt.pn * tstep : cB;
        for (int t = 0; t < nt; t += 2) {
            if constexpr (Epi::MIDK_T > 0) { if (t == Epi::MIDK_T) E.midk(acc, cur, wr, wc, fr, fq); }
            const bool last = (t == nt - 2);
            const char* a1 = cA + (size_t)(t + 1) * kstep;
            const char* a2 = last ? nA : cA + (size_t)(t + 2) * kstep; const char* b2 = last ? nB : cB + (size_t)(t + 2) * kstep;
            const char* a3 = a2 + kstep; const char* b3 = b2 + kstep;
            if (last && has_next) S.a_ready(nxt);
            PG8_LDB(B0, 0, 0); PG8_SCHED; PG8_LDA(At, 0, 0); PG8_STAGE(PG8_SA(1, 1), a1 + hstep, voffA);
            PG8_WAIT_L(8); PG8_BAR; PG8_WAIT_L(0); PG8_MMA(0, 0, At, B0); PG8_BAR; PG8_SCHED;
            PG8_LDB(B1, 0, 1); PG8_STAGE(PG8_SB(0, 0), b2, voffB);
            PG8_BAR; PG8_WAIT_L(0); PG8_MMA(0, 1, At, B1); PG8_BAR;
            PG8_LDA(At, 0, 1); PG8_STAGE(PG8_SA(0, 0), a2, voffA);
            PG8_BAR; PG8_WAIT_L(0); PG8_MMA(1, 0, At, B0); PG8_BAR; PG8_SCHED;
            PG8_STAGE(PG8_SB(0, 1), b2 + hstep, voffB);
            PG8_WAIT_V(6); PG8_BAR; PG8_MMA(1, 1, At, B1); PG8_BAR;
            PG8_LDB(B0, 1, 0); PG8_SCHED; PG8_LDA(At, 1, 0); PG8_STAGE(PG8_SA(0, 1), a2 + hstep, voffA);
            PG8_WAIT_L(8); PG8_BAR; PG8_WAIT_L(0); PG8_MMA(0, 0, At, B0); PG8_BAR; PG8_SCHED;
            PG8_LDB(B1, 1, 1); PG8_STAGE(PG8_SB(1, 0), b3, voffB);
            PG8_BAR; PG8_WAIT_L(0); PG8_MMA(0, 1, At, B1); PG8_BAR;
            PG8_LDA(At, 1, 1); PG8_STAGE(PG8_SA(1, 0), a3, voffA);
            PG8_BAR; PG8_WAIT_L(0); PG8_MMA(1, 0, At, B0); PG8_BAR; PG8_SCHED;
            PG8_STAGE(PG8_SB(1, 1), b3 + hstep, voffB);
            PG8_WAIT_V(6); PG8_BAR; PG8_MMA(1, 1, At, B1); PG8_BAR;
        }
        PG8_STAMP();
        if constexpr (!Epi::AFTER_DRAIN) { E(acc, cur, wr, wc, fr, fq); S.done(cur); }
        PG8_STAMP();
        if (!has_next) break;
#pragma unroll
        for (int a = 0; a < 2; ++a)
#pragma unroll
            for (int b = 0; b < 2; ++b)
#pragma unroll
                for (int m = 0; m < 4; ++m)
#pragma unroll
                    for (int n = 0; n < 2; ++n) acc[a][b][m][n] = (f32x4){0.f, 0.f, 0.f, 0.f};
        cur = nxt; cA = nA; cB = nB; ++ui;
    }
    PG8_WAIT_V(0);
    if (wr == 0) PG8_BAR;
    PG8_BAR;
    if constexpr (Epi::AFTER_DRAIN) { E.fused(acc, cur, wr, wc, fr, fq, lds, wid, lane); S.done(cur); }
    PG8_STAMP();
    if (STAMP && wid == 0) { stamps[lane] = lane < nts ? (((unsigned long long)(unsigned)ts_hi << 32) | (unsigned)ts_lo) : 0ull;
        if (lane == 62) stamps[62] = rt_entry; if (lane == 63) stamps[63] = (unsigned long long)wall_clock64(); }
#undef PG8_STAMP
#undef PG8_SA
#undef PG8_SB
#undef PG8_STAGE
#undef PG8_LDA
#undef PG8_LDB
#undef PG8_MMA
#undef PG8_WAIT_V
#undef PG8_WAIT_L
#undef PG8_BAR
#undef PG8_SCHED
}
}

#define XB_TMO      128
#define XB_XCNT(j)  (256  + 64 * (j))
#define XB_XSUB(j)  (1280 + 64 * (j))
#define XB_XGEN(j)  (2304 + 64 * (j))
#define XB_TOP      3328
#define XB_TOPGEN   3392
#define XCD_BAR_WORDS 3456
#define XB_SPIN_CAP (1u << 27)
#define LAS __attribute__((address_space(3)))

__device__ __forceinline__ unsigned xb_ld(unsigned* p)              { return __hip_atomic_load(p, __ATOMIC_RELAXED, __HIP_MEMORY_SCOPE_AGENT); }
__device__ __forceinline__ unsigned xb_add(unsigned* p, unsigned v) { return __hip_atomic_fetch_add(p, v, __ATOMIC_RELAXED, __HIP_MEMORY_SCOPE_AGENT); }
__device__ __forceinline__ unsigned xb_xcc_id() { return (unsigned)__builtin_amdgcn_s_getreg((3 << 11) | 20) & 0xFu; }
#define XB_SPIN(cond, bar) do { unsigned _sp = 0; while (cond) { __builtin_amdgcn_s_sleep(1); \
    if ((++_sp & 255u) == 0u) { if (xb_ld(&(bar)[XB_TMO])) break; if (_sp > XB_SPIN_CAP) { atomicAdd(&(bar)[XB_TMO], 1u); break; } } } } while (0)

struct XcdBarrier {
    unsigned* bar; unsigned x;
    volatile LAS unsigned* st;
};

__device__ __forceinline__ XcdBarrier xcd_barrier_post(unsigned* bar, volatile LAS unsigned* st, bool xb_t0) {
    XcdBarrier b; b.bar = bar; b.x = xb_xcc_id(); b.st = st;
    if (xb_t0) (void)xb_add(&bar[XB_XCNT(b.x)], 1u);
    return b;
}
__device__ __forceinline__ void xcd_barrier_complete(unsigned* bar, unsigned x, unsigned& nloc, unsigned& nx) {
    const unsigned G = gridDim.x * gridDim.y * gridDim.z;
    unsigned sum, cnt, mine, sp = 0u;
    for (;;) {
        sum = 0u; cnt = 0u; mine = 0u;
#pragma unroll
        for (unsigned j = 0; j < 16; ++j) { const unsigned c = xb_ld(&bar[XB_XCNT(j)]); sum += c; cnt += (c > 0u) ? 1u : 0u; mine = (j == x) ? c : mine; }
        if (sum == G) break;
        __builtin_amdgcn_s_sleep(1);
        if ((++sp & 255u) == 0u) { if (xb_ld(&bar[XB_TMO])) break; if (sp > XB_SPIN_CAP) { atomicAdd(&bar[XB_TMO], 1u); break; } }
    }
    nloc = mine > 0u ? mine : 1u; nx = cnt > 0u ? cnt : 1u;
}

__device__ __forceinline__ void xcd_barrier(const XcdBarrier& b, bool xb_t0) {
    asm volatile("s_waitcnt vmcnt(0)" ::: "memory");
    __syncthreads();
    if (xb_t0) {
        unsigned* bar = b.bar;
        __builtin_amdgcn_s_waitcnt(0);
        unsigned nloc = b.st[0], nx = b.st[1];
        if (nloc == 0u) { xcd_barrier_complete(bar, b.x, nloc, nx); b.st[0] = nloc; b.st[1] = nx; }
        const unsigned old = xb_add(&bar[XB_XSUB(b.x)], 1u);
        const unsigned gen = old / nloc;
        if (old + 1u == (gen + 1u) * nloc) {
            __builtin_amdgcn_fence(__ATOMIC_RELEASE, "agent");
            asm volatile("s_waitcnt vmcnt(0)" ::: "memory");
            const unsigned og = xb_add(&bar[XB_TOP], 1u);
            const unsigned tg = og / nx;
            if (og + 1u == (tg + 1u) * nx) xb_add(&bar[XB_TOPGEN], 1u);
            else XB_SPIN(xb_ld(&bar[XB_TOPGEN]) == tg, bar);
            __builtin_amdgcn_fence(__ATOMIC_ACQUIRE, "agent");
            xb_add(&bar[XB_XGEN(b.x)], 1u);
            asm volatile("s_waitcnt vmcnt(0)" ::: "memory");
        } else {
            XB_SPIN(xb_ld(&bar[XB_XGEN(b.x)]) == gen, bar);
            __builtin_amdgcn_fence(__ATOMIC_ACQUIRE, "agent");
            asm volatile("s_waitcnt vmcnt(0)" ::: "memory");
        }
    }
    __syncthreads();
}


__device__ void ph_transpose(int wv, const float* __restrict__ src, bf16_t* __restrict__ dst, int K, int N, int Npad,
                             int col0, int skip_from, int skip, int nvalid, float* tile, int bid, int nb,
                             const float* kscale = nullptr, int kscale_n = 0) {
  const int tk = K / 64, tn = Npad / 64;
  const int tid = otid(wv);
  for (int t = bid; t < tk * tn; t += nb) {
    const int kt = t / tn, nt = t % tn;
    __syncthreads();
#pragma unroll
    for (int i = 0; i < 2; ++i) {
      const int idx = tid + i * 512, kk = idx >> 4, n4 = (idx & 15) * 4;
      const int k = kt * 64 + kk, n = nt * 64 + n4;
      const int cc = col0 + n + (n >= skip_from ? skip : 0);
      const float ks = (kscale != nullptr && k < kscale_n) ? kscale[k] : 1.f;
      float4 v = make_float4(0.f, 0.f, 0.f, 0.f);
      if (n < nvalid) v = *(const float4*)(src + (size_t)k * N + cc);
      tile[kk * 65 + n4 + 0] = v.x * ks; tile[kk * 65 + n4 + 1] = v.y * ks; tile[kk * 65 + n4 + 2] = v.z * ks; tile[kk * 65 + n4 + 3] = v.w * ks;
    }
    __syncthreads();
    {
      const int nn = tid >> 3, k8 = (tid & 7) * 8;
      float f[8];
#pragma unroll
      for (int e = 0; e < 8; ++e) f[e] = tile[(k8 + e) * 65 + nn];
      *(uint4*)(dst + (size_t)(nt * 64 + nn) * K + kt * 64 + k8) = make_uint4(pack2(f[0], f[1]), pack2(f[2], f[3]), pack2(f[4], f[5]), pack2(f[6], f[7]));
    }
  }
}

__device__ void ph_mod(int wv, const Params& P, float* sm, int bid, int nb) {
  const int tid = otid(wv);
  float* sv = sm;
  float* red = sm + 5 * 1024;
  for (int i = tid; i < 5 * 1024; i += NTHR) {
    const float v = (i < 4096) ? P.c[i] : P.c_ctx[i - 4096];
    sv[i] = silu_f(v);
  }
  __syncthreads();
  const int c4 = tid & 15, kg = tid >> 4;
  for (int it = bid; it < 192; it += nb) {
    const int layer = it / 96, cb = it % 96;
    const float4* W = (const float4*)(P.ada_w + (size_t)layer * 1024 * MODW + cb * 64) + c4;
    float4 a[5];
#pragma unroll
    for (int r = 0; r < 5; ++r) a[r] = make_float4(0.f, 0.f, 0.f, 0.f);
#pragma unroll 8
    for (int kk = 0; kk < 32; ++kk) {
      const int k = kg * 32 + kk;
      const float4 w = W[(size_t)k * (MODW / 4)];
#pragma unroll
      for (int r = 0; r < 5; ++r) {
        const float s = sv[r * 1024 + k];
        a[r].x += s * w.x; a[r].y += s * w.y; a[r].z += s * w.z; a[r].w += s * w.w;
      }
    }
#pragma unroll
    for (int r = 0; r < 5; ++r) *(float4*)(red + ((kg * 16 + c4) * 5 + r) * 4) = a[r];
    __syncthreads();
    if (tid < 320) {
      const int r = tid >> 6, c = tid & 63;
      float s = 0.f;
      for (int g = 0; g < 32; ++g) s += red[((g * 16 + (c >> 2)) * 5 + r) * 4 + (c & 3)];
      P.mod()[(size_t)(layer * 5 + r) * MODW + cb * 64 + c] = s + P.ada_b[layer * MODW + cb * 64 + c];
    }
    __syncthreads();
  }
}

__device__ void ph_norm(int wv, const float* hl, const float* hc, const float* __restrict__ g, const float* __restrict__ modl,
                        int shift_off, int scale_off, int nrows, bf16_t* __restrict__ dst, int bid, int nb) {
  const int wave = otid(wv) >> 6, lane = otid(wv) & 63;
  const int stride = nb * NWAVE;
  for (int row0 = bid * NWAVE + wave; row0 < nrows; row0 += 2 * stride) {
    const int row1 = row0 + stride;
    const bool two = row1 < nrows;
    const int rows[2] = {row0, two ? row1 : row0};
    f32x4 v[2][4], ggv[4], scv[2][4], shv[2][4];
#pragma unroll
    for (int r = 0; r < 2; ++r) {
      const float* src = hrow(hl, hc, rows[r]);
      const float* mr = modl + (size_t)modrow(rows[r]) * MODW;
#pragma unroll
      for (int i = 0; i < 4; ++i) {
        const int idx = i * 256 + lane * 4;
        v[r][i] = *(const f32x4*)(src + idx);
        scv[r][i] = *(const f32x4*)(mr + scale_off + idx); shv[r][i] = *(const f32x4*)(mr + shift_off + idx);
      }
    }
#pragma unroll
    for (int i = 0; i < 4; ++i) ggv[i] = *(const f32x4*)(g + i * 256 + lane * 4);
#pragma unroll
    for (int r = 0; r < 2; ++r)
#pragma unroll
      for (int i = 0; i < 4; ++i) asm volatile("" : "+v"(v[r][i]), "+v"(scv[r][i]), "+v"(shv[r][i]));
#pragma unroll
    for (int r = 0; r < 2; ++r) {
      float ss = 0.f;
#pragma unroll
      for (int i = 0; i < 4; ++i) ss += v[r][i][0] * v[r][i][0] + v[r][i][1] * v[r][i][1] + v[r][i][2] * v[r][i][2] + v[r][i][3] * v[r][i][3];
      ss = wave_sum(ss);
      const float rstd = rsqrtf(ss * (1.f / 1024.f) + 1e-6f);
      if (r == 0 || two) {
#pragma unroll
        for (int i = 0; i < 4; ++i) {
          const int idx = i * 256 + lane * 4;
          const float o0 = v[r][i][0] * rstd * ggv[i][0] * (1.f + scv[r][i][0]) + shv[r][i][0];
          const float o1 = v[r][i][1] * rstd * ggv[i][1] * (1.f + scv[r][i][1]) + shv[r][i][1];
          const float o2 = v[r][i][2] * rstd * ggv[i][2] * (1.f + scv[r][i][2]) + shv[r][i][2];
          const float o3 = v[r][i][3] * rstd * ggv[i][3] * (1.f + scv[r][i][3]) + shv[r][i][3];
          *(uint2*)(dst + (size_t)rows[r] * DM + idx) = make_uint2(pack2(o0, o1), pack2(o2, o3));
        }
      }
    }
  }
}

__device__ void ph_conv(int wv, const Params& P, int layer, int bid, int nb) {
  const float* cw = P.conv_w + (size_t)layer * 3 * 1536;
  const float* cb = P.conv_b + (size_t)layer * 1536;
  const int total = (NTOK / 4) * 192;
  for (int it = bid * NTHR + otid(wv); it < total; it += nb * NTHR) {
    const int rq = it / 192, c8 = (it % 192) * 8, row0 = rq * 4;
    int l, L;
    if (row0 < NLAT) { l = row0 & 4095; L = 4096; } else { l = (row0 - NLAT) & 255; L = 256; }
    const bf16_t* pc = P.p() + (size_t)row0 * PW + OFF_XBC + c8;
    u32x4_t rv[6];
    rv[0] = *(const u32x4_t*)(pc - (l > 0 ? PW : 0));
#pragma unroll
    for (int i = 0; i < 4; ++i) rv[1 + i] = *(const u32x4_t*)(pc + (size_t)i * PW);
    rv[5] = *(const u32x4_t*)(pc + (size_t)(l + 4 < L ? 4 : 3) * PW);
#pragma unroll
    for (int i = 0; i < 6; ++i) asm volatile("" : "+v"(rv[i]));
    float f[6][8];
#pragma unroll
    for (int i = 0; i < 6; ++i) unpack8(make_uint4(rv[i].x, rv[i].y, rv[i].z, rv[i].w), f[i]);
    const float mp = l > 0 ? 1.f : 0.f, mn = l + 4 < L ? 1.f : 0.f;
    float o[4][8];
#pragma unroll
    for (int e = 0; e < 8; ++e) {
      const int c = c8 + e;
      const float w0 = cw[c], w1 = cw[1536 + c], w2 = cw[3072 + c], bb = cb[c];
#pragma unroll
      for (int i = 0; i < 4; ++i) {
        const float pv = i == 0 ? mp * f[0][e] : f[i][e];
        const float nv = i == 3 ? mn * f[5][e] : f[i + 2][e];
        o[i][e] = silu_f(bb + w0 * pv + w1 * f[i + 1][e] + w2 * nv);
      }
    }
    if (c8 < 1024) {
      const int head = c8 >> 6, p0 = c8 & 63;
      bf16_t* dst = P.xt4() + (((size_t)head * (NTOK / 4) + rq) * 64 + p0) * 4;
#pragma unroll
      for (int e2 = 0; e2 < 4; ++e2)
        *(uint4*)(dst + e2 * 8) = make_uint4(pack2(o[0][2 * e2], o[1][2 * e2]), pack2(o[2][2 * e2], o[3][2 * e2]),
                                             pack2(o[0][2 * e2 + 1], o[1][2 * e2 + 1]), pack2(o[2][2 * e2 + 1], o[3][2 * e2 + 1]));
    } else {
      {
        const int cc = (c8 - 1024) & 255, grp_ = cc >> 7, n0_ = cc & 127;
        bf16_t* fb = (c8 < 1280 ? P.bfr() : P.cfr()) + ((((size_t)grp_ * (NTOK / 16) + (row0 >> 4)) * 4 + (n0_ >> 5)) * 16 + (row0 & 15)) * 32 + (n0_ & 31);
#pragma unroll
        for (int i = 0; i < 4; ++i)
          *(uint4*)(fb + i * 32) = make_uint4(pack2(o[i][0], o[i][1]), pack2(o[i][2], o[i][3]), pack2(o[i][4], o[i][5]), pack2(o[i][6], o[i][7]));
      }
      if (c8 < 1280) {
        const int grp = (c8 - 1024) >> 7, n0 = (c8 - 1024) & 127;
        bf16_t* dst = P.bt4() + (((size_t)grp * (NTOK / 4) + rq) * 128 + n0) * 4;
#pragma unroll
        for (int e2 = 0; e2 < 4; ++e2)
          *(uint4*)(dst + e2 * 8) = make_uint4(pack2(o[0][2 * e2], o[1][2 * e2]), pack2(o[2][2 * e2], o[3][2 * e2]),
                                               pack2(o[0][2 * e2 + 1], o[1][2 * e2 + 1]), pack2(o[2][2 * e2 + 1], o[3][2 * e2 + 1]));
      }
    }
  }
}

__device__ void ph_dtprep(int wv, const Params& P, int layer, char* smem, int first, int step) {
  const int tid = otid(wv), lane = tid & 63, li = lane & 15, g = lane >> 4;
  float* tile = (float*)smem;
  float* segtot = tile + 128 * 33;
  const int dh = tid & 31, seg = tid >> 5;
  const float bias = P.dt_bias[layer * 32 + dh];
  const float ah = -expf(P.a_log[layer * 32 + dh]);
  const bf16_t* wb = P.w_dtT() + (size_t)layer * 128 * 1024 + (size_t)li * 1024 + 8 * g;
  for (int gc = first; gc < NCHUNK; gc += step) {
    const bf16_t* ua = P.u() + (size_t)(gc * 128 + wv * 16 + li) * DM + 8 * g;
    f32x4 acc0 = (f32x4){0.f, 0.f, 0.f, 0.f}, acc1 = acc0;
#pragma unroll 1
    for (int t0 = 0; t0 < 32; t0 += 8) {
      bf16x8 a[8], b0[8], b1[8];
#pragma unroll
      for (int t = 0; t < 8; ++t) {
        a[t] = *(const bf16x8*)(ua + 32 * (t0 + t));
        b0[t] = *(const bf16x8*)(wb + 32 * (t0 + t));
        b1[t] = *(const bf16x8*)(wb + 16 * 1024 + 32 * (t0 + t));
      }
#pragma unroll
      for (int t = 0; t < 8; ++t) asm volatile("" : "+v"(a[t]), "+v"(b0[t]), "+v"(b1[t]));
#pragma unroll
      for (int t = 0; t < 8; ++t) {
        acc0 = __builtin_amdgcn_mfma_f32_16x16x32_bf16(a[t], b0[t], acc0, 0, 0, 0);
        acc1 = __builtin_amdgcn_mfma_f32_16x16x32_bf16(a[t], b1[t], acc1, 0, 0, 0);
      }
    }
    __syncthreads();
#pragma unroll
    for (int e = 0; e < 4; ++e) {
      tile[(wv * 16 + 4 * g + e) * 33 + li] = acc0[e];
      tile[(wv * 16 + 4 * g + e) * 33 + 16 + li] = acc1[e];
    }
    __syncthreads();
    float r[8], c[8];
    float cs = 0.f;
#pragma unroll
    for (int j = 0; j < 8; ++j) { r[j] = softplus_f(tile[(seg * 8 + j) * 33 + dh] + bias); cs += r[j] * ah; c[j] = cs; }
    segtot[seg * 32 + dh] = cs;
    __syncthreads();
    float off = 0.f, tot = 0.f;
    for (int s = 0; s < 16; ++s) { const float v = segtot[s * 32 + dh]; if (s < seg) off += v; tot += v; }
    const size_t base = ((size_t)(gc * 32 + dh) * 128 + seg * 8);
    float cso[8], wso[8];
#pragma unroll
    for (int j = 0; j < 8; ++j) {
      const float csj = off + c[j], csp = j == 0 ? off : off + c[j - 1];
      cso[j] = dh < 16 ? csj : csp;
      wso[j] = r[j] * (dh < 16 ? fexp(tot - csj) : fexp(csp));
    }
#pragma unroll
    for (int q = 0; q < 2; ++q) {
      *(float4*)(P.cst() + base + q * 4) = make_float4(cso[q * 4], cso[q * 4 + 1], cso[q * 4 + 2], cso[q * 4 + 3]);
      *(float4*)(P.dtt() + base + q * 4) = make_float4(r[q * 4], r[q * 4 + 1], r[q * 4 + 2], r[q * 4 + 3]);
      *(float4*)(P.wst() + base + q * 4) = make_float4(wso[q * 4], wso[q * 4 + 1], wso[q * 4 + 2], wso[q * 4 + 3]);
    }
    if (seg == 0) P.atot()[gc * 32 + dh] = tot;
  }
}

__device__ __forceinline__ int scan_chunk(int b, int dir, int s) {
  if (dir == 0) return (s < 2) ? (128 + 2 * b + s) : (32 * b + (s - 2));
  return (s < 2) ? (128 + 2 * b + 1 - s) : (32 * b + 31 - (s - 2));
}
__device__ void ph_scan(int wv, const Params& P, int bid, int nb) {
  const int total = 4 * 32 * 1024;
  for (int it = bid * NTHR + otid(wv); it < total; it += nb * NTHR) {
    const int e8 = it & 1023, dh = (it >> 10) & 31, b = it >> 15, dir = dh >> 4;
    float S[8];
    float zero_ = 0.f;
    asm volatile("" : "+v"(zero_));
#pragma unroll
    for (int i = 0; i < 8; ++i) S[i] = zero_;
#pragma unroll
    for (int hb = 0; hb < 2; ++hb) {
      u32x4_t v[17];
      float at[17];
#pragma unroll
      for (int s = 0; s < 17; ++s) {
        const int gc = scan_chunk(b, dir, hb * 17 + s);
        v[s] = *(const u32x4_t*)(P.states() + (size_t)(gc * 32 + dh) * 8192 + e8 * 8);
        at[s] = P.atot()[gc * 32 + dh];
      }
#pragma unroll
      for (int s = 0; s < 17; ++s) asm volatile("" : "+v"(v[s]));
#pragma unroll
      for (int s = 0; s < 17; ++s) {
        const int gc = scan_chunk(b, dir, hb * 17 + s);
        const float dec = fexp(at[s]);
        float cst[8];
        unpack8(make_uint4(v[s].x, v[s].y, v[s].z, v[s].w), cst);
        *(uint4*)(P.states() + (size_t)(gc * 32 + dh) * 8192 + e8 * 8) =
            make_uint4(pack2(S[0], S[1]), pack2(S[2], S[3]), pack2(S[4], S[5]), pack2(S[6], S[7]));
#pragma unroll
        for (int i = 0; i < 8; ++i) S[i] = dec * S[i] + cst[i];
      }
    }
  }
}

__device__ __forceinline__ void conv_x8(const Params& P, int layer, int row, int ch0, float* out) {
  int l, L;
  if (row < NLAT) { l = row & 4095; L = 4096; } else { l = (row - NLAT) & 255; L = 256; }
  const bf16_t* pc = P.p() + (size_t)row * PW + OFF_XBC + ch0;
  const uint4 cur = *(const uint4*)pc;
  const uint4 prv = *(const uint4*)(pc - (l > 0 ? PW : 0));
  const uint4 nxt = *(const uint4*)(pc + (l < L - 1 ? PW : 0));
  const float mp = l > 0 ? 1.f : 0.f, mn = l < L - 1 ? 1.f : 0.f;
  float fp[8], fc[8], fn[8];
  unpack8(prv, fp); unpack8(cur, fc); unpack8(nxt, fn);
  const float* cw = P.conv_w + (size_t)layer * 3 * 1536 + ch0;
  const float* cb = P.conv_b + (size_t)layer * 1536 + ch0;
#pragma unroll
  for (int e = 0; e < 8; ++e) out[e] = silu_f(cb[e] + cw[e] * (mp * fp[e]) + cw[1536 + e] * fc[e] + cw[3072 + e] * (mn * fn[e]));
}

constexpr int XS = 72;
constexpr int BS = 136;


__device__ __forceinline__ bool ssd_item(int round, int bid, int nb, int nchunks, int& gc, int& head) {
  if ((nb & 63) == 0) {
    const int x = bid & 7, j = bid >> 3, per = nb >> 6;
    const int cg = (round * per + (j >> 3)) * 8 + x;
    if (cg >= nchunks * 2) return false;
    gc = cg >> 1; head = (cg & 1) * 8 + (j & 7);
    return true;
  }
  const int it = round * nb + bid;
  if (it >= nchunks * 16) return false;
  gc = it >> 4; head = it & 15;
  return true;
}

__device__ void ph_states_mfma(int wv, const Params& P, int layer, char* smem, int bid, int nb) {
  const int lane = otid(wv) & 63, li = lane & 15, g = lane >> 4;
  const int nq = wv >> 1, ph = wv & 1;
  for (int round = 0;; ++round) {
    int gc, head;
    if (!ssd_item(round, bid, nb, NCHUNK, gc, head)) break;
    const int grp = head >> 3, q0 = gc * 32;
    const bf16_t* xb = P.xt4() + (((size_t)head * (NTOK / 4) + q0 + g) * 64 + ph * 32 + li) * 4;
    const bf16_t* bb = P.bt4() + (((size_t)grp * (NTOK / 4) + q0 + g) * 128 + nq * 32 + li) * 4;
    const float* wpf = P.wst() + (size_t)(gc * 32 + head) * 128 + 4 * g;
    const float* wpb = wpf + 16 * 128;
    f32x4 acc[2][2][2];
#pragma unroll
    for (int d = 0; d < 2; ++d)
#pragma unroll
      for (int a = 0; a < 2; ++a)
#pragma unroll
        for (int b = 0; b < 2; ++b) acc[d][a][b] = (f32x4){0.f, 0.f, 0.f, 0.f};
#pragma unroll
    for (int t = 0; t < 4; ++t) {
      s16x4 alo[2], ahi[2], xlo[2], xhi[2];
      f32x4 wfl, wfh, wbl, wbh;
#pragma unroll
      for (int i = 0; i < 2; ++i) {
        alo[i] = *(const s16x4*)(bb + ((size_t)(t * 8) * 128 + i * 16) * 4);
        ahi[i] = *(const s16x4*)(bb + ((size_t)(t * 8 + 4) * 128 + i * 16) * 4);
        xlo[i] = *(const s16x4*)(xb + ((size_t)(t * 8) * 64 + i * 16) * 4);
        xhi[i] = *(const s16x4*)(xb + ((size_t)(t * 8 + 4) * 64 + i * 16) * 4);
      }
      wfl = *(const f32x4*)(wpf + 32 * t); wfh = *(const f32x4*)(wpf + 32 * t + 16);
      wbl = *(const f32x4*)(wpb + 32 * t); wbh = *(const f32x4*)(wpb + 32 * t + 16);
      asm volatile("" : "+v"(alo[0]), "+v"(alo[1]), "+v"(ahi[0]), "+v"(ahi[1]));
      bf16x8 af[2];
#pragma unroll
      for (int i = 0; i < 2; ++i) af[i] = (bf16x8){alo[i][0], alo[i][1], alo[i][2], alo[i][3], ahi[i][0], ahi[i][1], ahi[i][2], ahi[i][3]};
#pragma unroll
      for (int d = 0; d < 2; ++d) {
        const f32x4 wl = d == 0 ? wfl : wbl, wh = d == 0 ? wfh : wbh;
#pragma unroll
        for (int b = 0; b < 2; ++b) {
          bf16x8 bfrag;
#pragma unroll
          for (int i = 0; i < 4; ++i) {
            bfrag[i] = (short)f2bf(bf2f((bf16_t)xlo[b][i]) * wl[i]);
            bfrag[4 + i] = (short)f2bf(bf2f((bf16_t)xhi[b][i]) * wh[i]);
          }
#pragma unroll
          for (int a = 0; a < 2; ++a) acc[d][a][b] = __builtin_amdgcn_mfma_f32_16x16x32_bf16(af[a], bfrag, acc[d][a][b], 0, 0, 0);
        }
      }
    }
#pragma unroll
    for (int d = 0; d < 2; ++d) {
      bf16_t* dst = P.states() + (size_t)(gc * 32 + d * 16 + head) * 8192;
#pragma unroll
      for (int a = 0; a < 2; ++a)
#pragma unroll
        for (int b = 0; b < 2; ++b) {
          uint2 o;
          o.x = pack2(acc[d][a][b][0], acc[d][a][b][1]); o.y = pack2(acc[d][a][b][2], acc[d][a][b][3]);
          *(uint2*)(dst + ((nq * 4 + 2 * ph + b) * 16 + li) * 32 + 16 * a + 4 * g) = o;
        }
    }
  }
}

__device__ void ph_ssdy_mfma(int wv, const Params& P, int layer, int nchunks, char* smem, int bid, int nb) {
  const int tid = otid(wv), lane = tid & 63, li = lane & 15, g = lane >> 4;
  float* tabs = (float*)smem;
  char* bbuf = smem + 4096;
  char* xbuf = bbuf + 65536;
  char* sbufS = xbuf + 32768;
  u32x4_t pf[10];
  float pft = 0.f;
#pragma unroll
  for (int i = 0; i < 10; ++i) pf[i] = (u32x4_t){0u, 0u, 0u, 0u};
#define SSDY_FETCH(gc_, head_) do { const int grp_ = (head_) >> 3; \
      const char* bsrc_ = (const char*)(P.bfr() + ((size_t)grp_ * (NTOK / 16) + (gc_) * 8) * 4 * 16 * 32); \
      const char* xsrc_ = (const char*)(P.xt4() + ((size_t)(head_) * (NTOK / 4) + (gc_) * 32) * 64 * 4); \
      _Pragma("unroll") for (int i_ = 0; i_ < 4; ++i_) pf[i_] = *(const u32x4_t*)(bsrc_ + (size_t)(tid + i_ * 512) * 16); \
      _Pragma("unroll") for (int i_ = 0; i_ < 2; ++i_) pf[4 + i_] = *(const u32x4_t*)(xsrc_ + (size_t)(tid + i_ * 512) * 16); \
      _Pragma("unroll") for (int i_ = 0; i_ < 4; ++i_) { const int c_ = tid + i_ * 512; \
        pf[6 + i_] = *(const u32x4_t*)((const char*)(P.states() + (size_t)((gc_) * 32 + (c_ >> 10) * 16 + (head_)) * 8192) + (size_t)(c_ & 1023) * 16); } \
      { const int arr_ = tid >> 7, j_ = tid & 127; \
        pft = ((arr_ & 1) ? P.dtt() : P.cst())[(size_t)((gc_) * 32 + (arr_ >> 1) * 16 + (head_)) * 128 + j_]; } } while (0)
#define SSDY_PUT_S() do { _Pragma("unroll") for (int i_ = 0; i_ < 4; ++i_) *(u32x4_t*)(sbufS + (size_t)(tid + i_ * 512) * 16) = pf[6 + i_]; } while (0)
#define SSDY_PUT_BX(buf_) do { \
      _Pragma("unroll") for (int i_ = 0; i_ < 4; ++i_) *(u32x4_t*)(bbuf + (buf_) * 32768 + (size_t)(tid + i_ * 512) * 16) = pf[i_]; \
      _Pragma("unroll") for (int i_ = 0; i_ < 2; ++i_) *(u32x4_t*)(xbuf + (buf_) * 16384 + (size_t)(tid + i_ * 512) * 16) = pf[4 + i_]; \
      tabs[(buf_) * 512 + tid] = pft; } while (0)
  {
    int gc0 = 0, head0 = 0;
    __syncthreads();
    if (ssd_item(0, bid, nb, nchunks, gc0, head0)) { SSDY_FETCH(gc0, head0); SSDY_PUT_BX(0); SSDY_PUT_S(); }
    __syncthreads();
  }
  for (int round = 0;; ++round) {
    int gc, head;
    if (!ssd_item(round, bid, nb, nchunks, gc, head)) break;
    const int grp = head >> 3, row0 = gc * 128;
    const char* bs = bbuf + (round & 1) * 32768;
    const char* xs_l = xbuf + (round & 1) * 16384;
    const float* csf = tabs + (round & 1) * 512;
    const float* dtf = csf + 128;
    const float* exb = csf + 256;
    const float* dtb = csf + 384;
    int gcn = 0, headn = 0;
    const bool has_next = ssd_item(round + 1, bid, nb, nchunks, gcn, headn);
    if (has_next) SSDY_FETCH(gcn, headn);
    const float atb = P.atot()[gc * 32 + 16 + head];
    bf16x8 cfrag[4];
    {
      const bf16_t* cp = P.cfr() + ((((size_t)grp * (NTOK / 16) + gc * 8 + wv) * 4) * 16 + li) * 32 + 8 * g;
#pragma unroll
      for (int t = 0; t < 4; ++t) cfrag[t] = *(const bf16x8*)(cp + t * 512);
    }
    f32x4 accG[8];
#pragma unroll
    for (int sb = 0; sb < 8; ++sb) accG[sb] = (f32x4){0.f, 0.f, 0.f, 0.f};
#pragma unroll
    for (int sp = 0; sp < 4; ++sp) {
      bf16x8 bfv[8];
#pragma unroll
      for (int i = 0; i < 8; ++i) {
        const int sb = sp * 2 + (i >> 2), t = i & 3;
        bfv[i] = *(const bf16x8*)(bs + (((sb * 4 + t) * 16 + li) * 32 + 8 * g) * 2);
      }
#pragma unroll
      for (int i = 0; i < 8; ++i) {
        const int sb = sp * 2 + (i >> 2), t = i & 3;
        accG[sb] = __builtin_amdgcn_mfma_f32_16x16x32_bf16(bfv[i], cfrag[t], accG[sb], 0, 0, 0);
      }
    }
    f32x4 accY[4];
#pragma unroll
    for (int pb = 0; pb < 4; ++pb) accY[pb] = (f32x4){0.f, 0.f, 0.f, 0.f};
    const int jl = 16 * wv + li;
    const float csf_j = csf[jl], exb_j = exb[jl];
#pragma unroll
    for (int dir = 0; dir < 2; ++dir) {
      f32x4 accO[4];
#pragma unroll
      for (int pb = 0; pb < 4; ++pb) accO[pb] = (f32x4){0.f, 0.f, 0.f, 0.f};
      const char* st = sbufS + dir * 16384;
#pragma unroll
      for (int th = 0; th < 2; ++th) {
        bf16x8 sfr[8];
#pragma unroll
        for (int i = 0; i < 8; ++i) sfr[i] = *(const bf16x8*)(st + (((th * 2 + (i >> 2)) * 4 + (i & 3)) * 512 + li * 32 + 8 * g) * 2);
#pragma unroll
        for (int tt = 0; tt < 2; ++tt)
#pragma unroll
          for (int pb = 0; pb < 4; ++pb) accO[pb] = __builtin_amdgcn_mfma_f32_16x16x32_bf16(cfrag[th * 2 + tt], sfr[tt * 4 + pb], accO[pb], 0, 0, 0);
      }
#pragma unroll
      for (int e = 0; e < 4; ++e) {
        const int j = 16 * wv + 4 * g + e;
        const float sc = dir == 0 ? fexp(csf[j]) : fexp(atb - exb[j]);
#pragma unroll
        for (int pb = 0; pb < 4; ++pb) accY[pb][e] += accO[pb][e] * sc;
      }
    }
    __syncthreads();
    if (has_next) SSDY_PUT_S();
    const char* xq = xs_l + ((g * 64 + li) * 4) * 2;
#pragma unroll
    for (int t = 0; t < 4; ++t) {
      const bool need_f = !(32 * t > 16 * wv + 15), need_b = !(32 * t + 31 < 16 * wv);
      if (!need_f && !need_b) continue;
      s16x4 xlo[4], xhi[4];
#pragma unroll
      for (int pb = 0; pb < 4; ++pb) {
        xlo[pb] = *(const s16x4*)(xq + (((8 * t) * 64 + 16 * pb) * 4) * 2);
        xhi[pb] = *(const s16x4*)(xq + (((8 * t + 4) * 64 + 16 * pb) * 4) * 2);
      }
#pragma unroll
      for (int dir = 0; dir < 2; ++dir) {
        if (dir == 0 ? !need_f : !need_b) continue;
        bf16x8 afrag;
#pragma unroll
        for (int hh = 0; hh < 2; ++hh) {
          const int s0 = 32 * t + 16 * hh + 4 * g;
          const f32x4 gv = accG[2 * t + hh];
          const f32x4 cv = dir == 0 ? *(const f32x4*)(csf + s0) : *(const f32x4*)(exb + s0);
          const f32x4 dv = dir == 0 ? *(const f32x4*)(dtf + s0) : *(const f32x4*)(dtb + s0);
#pragma unroll
          for (int e = 0; e < 4; ++e) {
            const int s = s0 + e;
            float m;
            if (dir == 0) m = (s <= jl) ? gv[e] * dv[e] * fexp(csf_j - cv[e]) : 0.f;
            else m = (s >= jl) ? gv[e] * dv[e] * fexp(cv[e] - exb_j) : 0.f;
            afrag[hh * 4 + e] = (short)f2bf(m);
          }
        }
#pragma unroll
        for (int pb = 0; pb < 4; ++pb) {
          const bf16x8 bfr2 = (bf16x8){xlo[pb][0], xlo[pb][1], xlo[pb][2], xlo[pb][3], xhi[pb][0], xhi[pb][1], xhi[pb][2], xhi[pb][3]};
          accY[pb] = __builtin_amdgcn_mfma_f32_16x16x32_bf16(afrag, bfr2, accY[pb], 0, 0, 0);
        }
      }
    }
    const float dsk = P.d_skip[layer * 16 + head];
    s16x4 xs[4];
#pragma unroll
    for (int pb = 0; pb < 4; ++pb) xs[pb] = *(const s16x4*)(xs_l + ((((4 * wv + g) * 64 + 16 * pb + li) * 4) * 2));
    unsigned zv[16];
#pragma unroll
    for (int e = 0; e < 4; ++e)
#pragma unroll
      for (int pb = 0; pb < 4; ++pb)
        zv[e * 4 + pb] = P.p()[(size_t)(row0 + 16 * wv + 4 * g + e) * PW + OFF_Z + head * 64 + 16 * pb + li];
#pragma unroll
    for (int i = 0; i < 16; ++i) asm volatile("" : "+v"(zv[i]));
#pragma unroll
    for (int e = 0; e < 4; ++e) {
      const int row = row0 + 16 * wv + 4 * g + e;
      float sq = 0.f;
#pragma unroll
      for (int pb = 0; pb < 4; ++pb) {
        const float xv = bf2f((bf16_t)xs[pb][e]);
        const float z = bf2f((bf16_t)zv[e * 4 + pb]);
        const bf16_t yb = f2bf((accY[pb][e] + dsk * xv) * silu_f(z));
        P.concat()[(size_t)row * 2048 + head * 64 + 16 * pb + li] = yb;
        const float yf = bf2f(yb);
        sq += yf * yf;
      }
      sq += DPP_F(sq, 0xB1); sq += DPP_F(sq, 0x4E); sq += DPP_F(sq, 0x141); sq += DPP_F(sq, 0x140);
      if (li == 0) P.yss()[(size_t)row * 16 + head] = sq;
    }
    if (has_next) SSDY_PUT_BX((round + 1) & 1);
    __syncthreads();
  }
#undef SSDY_FETCH
#undef SSDY_PUT_S
#undef SSDY_PUT_BX
}

template <int W>
__device__ __forceinline__ void pool_frags(const bf16_t* pc, int l, int L, float rc, bf16x8 (&af)[4]) {
#pragma unroll
  for (int t = 0; t < 4; ++t) {
    constexpr int WB = W < 8 ? W : 8;
    float s[8], f[8];
#pragma unroll
    for (int e = 0; e < 8; ++e) s[e] = 0.f;
    const u32x4_t own = *(const u32x4_t*)(pc + 32 * t);
#pragma unroll
    for (int ob = 0; ob < W; ob += WB) {
      u32x4_t rows[WB];
#pragma unroll
      for (int o = 0; o < WB; ++o) {
        const int rr = l - W / 2 + ob + o;
        const int rcl = (rr >= 0 && rr < L) ? rr : l;
        rows[o] = *(const u32x4_t*)(pc + (ptrdiff_t)(rcl - l) * PW + 32 * t);
      }
#pragma unroll
      for (int o = 0; o < WB; ++o) asm volatile("" : "+v"(rows[o]));
#pragma unroll
      for (int o = 0; o < WB; ++o) {
        const int rr = l - W / 2 + ob + o;
        const float mk = (rr >= 0 && rr < L) ? 1.f : 0.f;
        unpack8(make_uint4(rows[o].x, rows[o].y, rows[o].z, rows[o].w), f);
#pragma unroll
        for (int e = 0; e < 8; ++e) s[e] += mk * f[e];
      }
    }
    unpack8(make_uint4(own.x, own.y, own.z, own.w), f);
#pragma unroll
    for (int e = 0; e < 8; ++e) af[t][e] = (short)f2bf(s[e] * rc - f[e]);
  }
}
__device__ void ph_pool_mfma(int wv, const Params& P, int layer, int nrows, char* smem, int bid, int nb) {
  const int lane = otid(wv) & 63, li = lane & 15, g = lane >> 4;
  bf16_t* stg = (bf16_t*)(smem + 65536) + wv * (16 * 136);
  const int nitems = (nrows / 16) * 4;
  for (int it = bid * NWAVE + wv; it < nitems; it += nb * NWAVE) {
    const int gi = it & 3, row0 = (it >> 2) * 16, w = 2 << gi;
    const int row = row0 + li;
    int l, L;
    if (row < NLAT) { l = row & 4095; L = 4096; } else { l = (row - NLAT) & 255; L = 256; }
    int lo = l - w / 2; lo = lo < 0 ? 0 : lo;
    int hi = l + w - w / 2 - 1; hi = hi > L - 1 ? L - 1 : hi;
    const float rc = 1.f / (float)(hi - lo + 1);
    const bf16_t* pc = P.p() + (size_t)row * PW + OFF_POOL + gi * 128 + 8 * g;
    bf16x8 af[4];
    if (gi == 0) pool_frags<2>(pc, l, L, rc, af);
    else if (gi == 1) pool_frags<4>(pc, l, L, rc, af);
    else if (gi == 2) pool_frags<8>(pc, l, L, rc, af);
    else pool_frags<16>(pc, l, L, rc, af);
    const bf16_t* wt = P.poolwT() + ((size_t)(layer * 4 + gi) * 128 + li) * 128 + 8 * g;
    const float* sc = P.pool_scale + layer * 512 + gi * 128;
#pragma unroll
    for (int nh = 0; nh < 4; ++nh) {
      bf16x8 wf[2][4];
#pragma unroll
      for (int n = 0; n < 2; ++n)
#pragma unroll
        for (int t = 0; t < 4; ++t) wf[n][t] = *(const bf16x8*)(wt + (size_t)(nh * 2 + n) * 16 * 128 + 32 * t);
#pragma unroll
      for (int n = 0; n < 2; ++n)
#pragma unroll
        for (int t = 0; t < 4; ++t) asm volatile("" : "+v"(wf[n][t]));
#pragma unroll
      for (int n = 0; n < 2; ++n) {
        const int nt = nh * 2 + n;
        f32x4 acc = (f32x4){0.f, 0.f, 0.f, 0.f};
#pragma unroll
        for (int t = 0; t < 4; ++t) acc = __builtin_amdgcn_mfma_f32_16x16x32_bf16(af[t], wf[n][t], acc, 0, 0, 0);
        const float scv = sc[nt * 16 + li];
#pragma unroll
        for (int e = 0; e < 4; ++e) stg[(4 * g + e) * 136 + nt * 16 + li] = f2bf(acc[e] * scv);
      }
    }
    __builtin_amdgcn_wave_barrier();
#pragma unroll
    for (int i = 0; i < 4; ++i) {
      const int c = i * 64 + lane, rr = c >> 4, c8 = (c & 15) * 8;
      *(uint4*)(P.concat() + (size_t)(row0 + rr) * 2048 + 1024 + gi * 128 + c8) = *(const uint4*)(stg + rr * 136 + c8);
    }
    __builtin_amdgcn_wave_barrier();
  }
}

__device__ void ph_vtranspose(int wv, const Params& P, char* smem, int bid, int nb) {
  const int lane = otid(wv) & 63;
  bf16_t* tile = (bf16_t*)smem + wv * 64 * 72;
  for (int it = bid * NWAVE + wv; it < 272 * 8; it += nb * NWAVE) {
    const int hd = it & 7, tt = it >> 3, row0 = tt * 64;
    const bf16_t* src = P.p() + (size_t)(row0 + lane) * PW + OFF_V + hd * 64;
#pragma unroll
    for (int i = 0; i < 8; ++i) *(uint4*)(tile + lane * 72 + i * 8) = *(const uint4*)(src + i * 8);
    __builtin_amdgcn_wave_barrier();
    bf16_t* dst;
    if (row0 < NLAT) dst = P.vtl() + (size_t)((row0 >> 12) * 8 + hd) * 64 * 4096 + ((size_t)((row0 & 4095) >> 2) * 64 + lane) * 4;
    else dst = P.vtc() + (size_t)(((row0 - NLAT) >> 8) * 8 + hd) * 64 * 256 + ((size_t)(((row0 - NLAT) & 255) >> 2) * 64 + lane) * 4;
#pragma unroll
    for (int i = 0; i < 16; ++i) {
      uint2 w;
      w.x = (uint32_t)tile[(i * 4 + 0) * 72 + lane] | ((uint32_t)tile[(i * 4 + 1) * 72 + lane] << 16);
      w.y = (uint32_t)tile[(i * 4 + 2) * 72 + lane] | ((uint32_t)tile[(i * 4 + 3) * 72 + lane] << 16);
      *(uint2*)(dst + (size_t)i * 64 * 4) = w;
    }
    __builtin_amdgcn_wave_barrier();
    {
      const bf16_t* ksrc = P.p() + (size_t)(row0 + lane) * PW + OFF_K + hd * 64;
      u32x4_t kv[8];
#pragma unroll
      for (int i = 0; i < 8; ++i) kv[i] = *(const u32x4_t*)(ksrc + i * 8);
      bf16_t* kd;
      int tk;
      if (row0 < NLAT) { tk = (row0 & 4095) + lane; kd = P.ktl() + (size_t)((row0 >> 12) * 8 + hd) * 4096 * 64; }
      else { tk = ((row0 - NLAT) & 255) + lane; kd = P.ktc() + (size_t)(((row0 - NLAT) >> 8) * 8 + hd) * 256 * 64; }
#pragma unroll
      for (int i = 0; i < 8; ++i)
        *(u32x4_t*)(kd + ((size_t)((tk >> 3) * 2 + (i >> 2)) * 8 + (tk & 7)) * 32 + (i & 3) * 8) = kv[i];
    }
  }
}

__device__ __forceinline__ float grp_max(float v) {
  auto a = __builtin_amdgcn_permlane16_swap(__float_as_uint(v), __float_as_uint(v), false, false);
  v = fmaxf(__uint_as_float(a[0]), __uint_as_float(a[1]));
  auto b = __builtin_amdgcn_permlane32_swap(__float_as_uint(v), __float_as_uint(v), false, false);
  return fmaxf(__uint_as_float(b[0]), __uint_as_float(b[1]));
}
__device__ __forceinline__ float grp_sum(float v) {
  auto a = __builtin_amdgcn_permlane16_swap(__float_as_uint(v), __float_as_uint(v), false, false);
  v = __uint_as_float(a[0]) + __uint_as_float(a[1]);
  auto b = __builtin_amdgcn_permlane32_swap(__float_as_uint(v), __float_as_uint(v), false, false);
  return __uint_as_float(b[0]) + __uint_as_float(b[1]);
}

__device__ void ph_na_mfma(int wv, const Params& P, int layer, int nrows, char* smem, int bid, int nb) {
  const int lane = otid(wv) & 63, li = lane & 15, g = lane >> 4;
  float* btab = (float*)smem + wv * 256;
  const float* rpb = P.na_rpb + (size_t)layer * 8 * 15 * 31;
  const int n_lat = 4 * 64 * 8 * 4;
  const int n_items = n_lat + (nrows > NLAT ? 4 * 16 * 8 : 0);
  const int nrank = nb >> 3;
  const bool xmap = ((nb & 7) == 0) && nrank > 0 && (1024 % nrank) == 0 && (64 % nrank) == 0;
  const int per_lat = xmap ? 1024 / nrank : 0, per_ctx = (xmap && nrows > NLAT) ? 64 / nrank : 0;
  const int q_begin = xmap ? wv : bid * NWAVE + wv, q_end = xmap ? per_lat + per_ctx : n_items, q_step = xmap ? NWAVE : nb * NWAVE;
  for (int q = q_begin; q < q_end; q += q_step) {
    bool lat;
    int b, hd, qrow0, r = 0, cq0 = 0, r0 = 0, cs = 0, qt;
    if (xmap) {
      hd = bid & 7;
      const int rank = bid >> 3;
      lat = q < per_lat;
      if (lat) { const int i = rank * per_lat + q; qt = i & 3; r = (i >> 2) & 63; b = i >> 8; }
      else { const int c = rank * per_ctx + (q - per_lat); qt = c & 15; b = c >> 4; }
    } else {
      lat = q < n_lat;
      if (lat) { qt = q & 3; hd = (q >> 2) & 7; r = (q >> 5) & 63; b = q >> 11; }
      else { const int t = q - n_lat; hd = t & 7; qt = (t >> 3) & 15; b = t >> 7; }
    }
    if (lat) {
      cq0 = qt * 16; qrow0 = b * 4096 + r * 64 + cq0;
      r0 = r - 4; r0 = r0 < 0 ? 0 : (r0 > 56 ? 56 : r0);
      int clo = cq0 - 8; clo = clo < 0 ? 0 : (clo > 48 ? 48 : clo);
      cs = clo < 32 ? clo : 32;
    } else {
      qrow0 = NLAT + b * 256 + qt * 16;
    }
    const bf16_t* qp = P.p() + (size_t)(qrow0 + li) * PW + OFF_Q + hd * 64 + 8 * g;
    const bf16x8 qf0 = *(const bf16x8*)qp, qf1 = *(const bf16x8*)(qp + 32);
    __builtin_amdgcn_wave_barrier();
#pragma unroll
    for (int i = 0; i < 4; ++i) {
      const int e_ = i * 64 + lane, kr_ = e_ >> 5, dc_ = e_ & 31;
      int dr_ = r0 + kr_ - r + 7; dr_ = dr_ < 0 ? 0 : (dr_ > 14 ? 14 : dr_);
      btab[e_] = rpb[(hd * 15 + dr_) * 31 + (dc_ < 31 ? dc_ : 30)];
    }
    __builtin_amdgcn_wave_barrier();
    f32x4 accS[16], accC[16];
    const int k_lane = ((li >> 3) * 16 + (li & 7)) * 32 + 8 * g;
    const bf16_t* klb = P.ktl() + (size_t)(b * 8 + hd) * 4096 * 64 + k_lane;
    const bf16_t* kcb = P.ktc() + (size_t)(b * 8 + hd) * 256 * 64 + k_lane;
#define NA_KPTR(tile) ((tile) < 16 ? klb + ((r0 + ((tile) >> 1)) * 64 + cs + 16 * ((tile) & 1)) * 64 : kcb + (16 * ((tile) - 16)) * 64)
    bf16x8 kA[2][2], kB[2][2];
#pragma unroll
    for (int i = 0; i < 2; ++i) { const bf16_t* kp = NA_KPTR(i); kA[i][0] = *(const bf16x8*)kp; kA[i][1] = *(const bf16x8*)(kp + 256); }
#pragma unroll
    for (int tb = 0; tb < 32; tb += 4) {
#pragma unroll
      for (int i = 0; i < 2; ++i) { const bf16_t* kp = NA_KPTR(tb + 2 + i); kB[i][0] = *(const bf16x8*)kp; kB[i][1] = *(const bf16x8*)(kp + 256); }
#pragma unroll
      for (int i = 0; i < 2; ++i) { asm volatile("" : "+v"(kA[i][0]), "+v"(kA[i][1])); }
#pragma unroll
      for (int i = 0; i < 2; ++i) {
        f32x4 z = (f32x4){0.f, 0.f, 0.f, 0.f};
        z = __builtin_amdgcn_mfma_f32_16x16x32_bf16(kA[i][0], qf0, z, 0, 0, 0);
        z = __builtin_amdgcn_mfma_f32_16x16x32_bf16(kA[i][1], qf1, z, 0, 0, 0);
        if (tb + i < 16) accS[(tb + i) & 15] = z; else accC[(tb + i) & 15] = z;
      }
      if (tb + 4 < 32) {
#pragma unroll
        for (int i = 0; i < 2; ++i) { const bf16_t* kp = NA_KPTR(tb + 4 + i); kA[i][0] = *(const bf16x8*)kp; kA[i][1] = *(const bf16x8*)(kp + 256); }
      }
#pragma unroll
      for (int i = 0; i < 2; ++i) { asm volatile("" : "+v"(kB[i][0]), "+v"(kB[i][1])); }
#pragma unroll
      for (int i = 0; i < 2; ++i) {
        f32x4 z = (f32x4){0.f, 0.f, 0.f, 0.f};
        z = __builtin_amdgcn_mfma_f32_16x16x32_bf16(kB[i][0], qf0, z, 0, 0, 0);
        z = __builtin_amdgcn_mfma_f32_16x16x32_bf16(kB[i][1], qf1, z, 0, 0, 0);
        if (tb + 2 + i < 16) accS[(tb + 2 + i) & 15] = z; else accC[(tb + 2 + i) & 15] = z;
      }
    }
#undef NA_KPTR
    const int cq = cq0 + li;
    int c0q = cq - 8; c0q = c0q < 0 ? 0 : (c0q > 48 ? 48 : c0q);
    float mx = -3.0e38f;
#pragma unroll
    for (int kt = 0; kt < 16; ++kt) {
      int bi[4]; bool okv[4]; float bv[4];
#pragma unroll
      for (int e = 0; e < 4; ++e) {
        const int ck = cs + 16 * (kt & 1) + 4 * g + e;
        okv[e] = lat && ck >= c0q && ck < c0q + 16;
        bi[e] = okv[e] ? (kt >> 1) * 32 + (ck - cq + 15) : 0;
      }
      asm volatile("" : "+v"(bi[0]), "+v"(bi[1]), "+v"(bi[2]), "+v"(bi[3]));
#pragma unroll
      for (int e = 0; e < 4; ++e) bv[e] = btab[bi[e]];
#pragma unroll
      for (int e = 0; e < 4; ++e) {
        const float s = okv[e] ? accS[kt][e] * 0.125f + bv[e] : -3.0e38f;
        accS[kt][e] = s;
        mx = fmaxf(mx, s);
      }
    }
#pragma unroll
    for (int ct = 0; ct < 16; ++ct)
#pragma unroll
      for (int e = 0; e < 4; ++e) { const float s = accC[ct][e] * 0.125f; accC[ct][e] = s; mx = fmaxf(mx, s); }
    mx = grp_max(mx);
    float sum = 0.f;
#pragma unroll
    for (int kt = 0; kt < 16; ++kt)
#pragma unroll
      for (int e = 0; e < 4; ++e) { const float p = __expf(accS[kt][e] - mx); accS[kt][e] = p; sum += p; }
#pragma unroll
    for (int ct = 0; ct < 16; ++ct)
#pragma unroll
      for (int e = 0; e < 4; ++e) { const float p = __expf(accC[ct][e] - mx); accC[ct][e] = p; sum += p; }
    sum = grp_sum(sum);
    const float inv = 1.f / sum;
    bf16x8 afL[8], afC[8];
#pragma unroll
    for (int kr = 0; kr < 8; ++kr) {
#pragma unroll
      for (int e = 0; e < 4; ++e) {
        afL[kr][e] = (short)f2bf(accS[2 * kr][e] * inv); afL[kr][4 + e] = (short)f2bf(accS[2 * kr + 1][e] * inv);
        afC[kr][e] = (short)f2bf(accC[2 * kr][e] * inv); afC[kr][4 + e] = (short)f2bf(accC[2 * kr + 1][e] * inv);
      }
    }
    f32x4 accO[4];
#pragma unroll
    for (int db = 0; db < 4; ++db) accO[db] = (f32x4){0.f, 0.f, 0.f, 0.f};
    const bf16_t* vl = P.vtl() + (size_t)(b * 8 + hd) * 64 * 4096 + li * 4;
    const bf16_t* vc = P.vtc() + (size_t)(b * 8 + hd) * 64 * 256 + li * 4;
#pragma unroll
    for (int kr = 0; kr < 8; ++kr) {
      const int tok = (r0 + kr) * 64 + cs + 4 * g;
      s16x4 lo[4], hi[4];
#pragma unroll
      for (int db = 0; db < 4; ++db) {
        const bf16_t* vp = vl + ((size_t)(tok >> 2) * 64 + db * 16) * 4;
        lo[db] = *(const s16x4*)vp; hi[db] = *(const s16x4*)(vp + 4 * 64 * 4);
      }
#pragma unroll
      for (int db = 0; db < 4; ++db) {
        const bf16x8 bfr = (bf16x8){lo[db][0], lo[db][1], lo[db][2], lo[db][3], hi[db][0], hi[db][1], hi[db][2], hi[db][3]};
        accO[db] = __builtin_amdgcn_mfma_f32_16x16x32_bf16(afL[kr], bfr, accO[db], 0, 0, 0);
      }
    }
#pragma unroll
    for (int t = 0; t < 8; ++t) {
      const int tok = 32 * t + 4 * g;
      s16x4 lo[4], hi[4];
#pragma unroll
      for (int db = 0; db < 4; ++db) {
        const bf16_t* vp = vc + ((size_t)(tok >> 2) * 64 + db * 16) * 4;
        lo[db] = *(const s16x4*)vp; hi[db] = *(const s16x4*)(vp + 4 * 64 * 4);
      }
#pragma unroll
      for (int db = 0; db < 4; ++db) {
        const bf16x8 bfr = (bf16x8){lo[db][0], lo[db][1], lo[db][2], lo[db][3], hi[db][0], hi[db][1], hi[db][2], hi[db][3]};
        accO[db] = __builtin_amdgcn_mfma_f32_16x16x32_bf16(afC[t], bfr, accO[db], 0, 0, 0);
      }
    }
    {
      bf16_t* stg = (bf16_t*)(smem + 32768) + wv * (16 * 72);
#pragma unroll
      for (int db = 0; db < 4; ++db)
#pragma unroll
        for (int e = 0; e < 4; ++e) stg[(4 * g + e) * 72 + 16 * db + li] = f2bf(accO[db][e]);
      __builtin_amdgcn_wave_barrier();
#pragma unroll
      for (int i = 0; i < 2; ++i) {
        const int c = i * 64 + lane, rr = c >> 3, c8 = (c & 7) * 8;
        *(uint4*)(P.concat() + (size_t)(qrow0 + rr) * 2048 + 1536 + hd * 64 + c8) = *(const uint4*)(stg + rr * 72 + c8);
      }
      __builtin_amdgcn_wave_barrier();
    }
  }
}

__device__ __forceinline__ uint32_t mono_u(float f) { const uint32_t u = __float_as_uint(f); return u ^ ((uint32_t)((int)u >> 31) | 0x80000000u); }
__device__ __forceinline__ float unmono_f(uint32_t m) { return __uint_as_float((m & 0x80000000u) ? (m ^ 0x80000000u) : ~m); }
__device__ __forceinline__ uint32_t grp_max_u(uint32_t v) {
  auto a = __builtin_amdgcn_permlane16_swap(v, v, false, false);
  v = a[0] > a[1] ? a[0] : a[1];
  auto b = __builtin_amdgcn_permlane32_swap(v, v, false, false);
  return b[0] > b[1] ? b[0] : b[1];
}

template <int N>
__device__ __forceinline__ void bitonic_sort_desc(uint32_t (&a)[N], int base = 0) { (void)base;
#pragma unroll
  for (int k = 2; k <= N; k <<= 1)
#pragma unroll
    for (int j = k >> 1; j > 0; j >>= 1)
#pragma unroll
      for (int i = 0; i < N; ++i) {
        const int l = i ^ j;
        if (l > i) {
          const bool desc = (i & k) == 0;
          const uint32_t hi = a[i] > a[l] ? a[i] : a[l], lo = a[i] > a[l] ? a[l] : a[i];
          a[i] = desc ? hi : lo; a[l] = desc ? lo : hi;
        }
      }
}
template <int N>
__device__ __forceinline__ void bitonic_merge_desc(uint32_t (&a)[N]) {
#pragma unroll
  for (int j = N >> 1; j > 0; j >>= 1)
#pragma unroll
    for (int i = 0; i < N; ++i) {
      const int l = i ^ j;
      if (l > i) {
        const uint32_t hi = a[i] > a[l] ? a[i] : a[l], lo = a[i] > a[l] ? a[l] : a[i];
        a[i] = hi; a[l] = lo;
      }
    }
}
__device__ __forceinline__ void merge4_top16(uint32_t (&a)[16]) {
  uint32_t e[16], o[16];
#pragma unroll
  for (int i = 0; i < 16; ++i) { auto r = __builtin_amdgcn_permlane16_swap(a[i], a[i], false, false); e[i] = r[0]; o[i] = r[1]; }
#pragma unroll
  for (int i = 0; i < 16; ++i) a[i] = e[i] > o[15 - i] ? e[i] : o[15 - i];
  bitonic_merge_desc<16>(a);
#pragma unroll
  for (int i = 0; i < 16; ++i) { auto r = __builtin_amdgcn_permlane32_swap(a[i], a[i], false, false); e[i] = r[0]; o[i] = r[1]; }
#pragma unroll
  for (int i = 0; i < 16; ++i) a[i] = e[i] > o[15 - i] ? e[i] : o[15 - i];
  bitonic_merge_desc<16>(a);
}
__device__ void ph_peer_topk_mfma(int wv, const Params& P, int layer, int nrows, char* smem, int bid, int nb) {
  const int tid = otid(wv), lane = tid & 63, li = lane & 15, g = lane >> 4;
  unsigned char* ctab = (unsigned char*)smem;
  float* vals = (float*)(smem + 256) + wv * 512;
  int* idxs = (int*)(smem + 256 + 8 * 2048) + wv * 512;
  __syncthreads();
  if (tid < 64) ctab[tid] = 0xFF;
  __syncthreads();
  if (tid == 0) {
    int n = 0, one = 1;
    asm volatile("" : "+s"(one));
#pragma unroll 1
    for (int a = 0; a < 16; ++a)
#pragma unroll 1
      for (int b = 0; b < 16; ++b)
        if ((a + one) * (b + 1) <= 16) { ctab[(n & 3) * 16 + (n >> 2)] = (unsigned char)(a * 16 + b); ++n; }
  }
  const int hd = bid & 7, tg = bid >> 3, ngroups = nb >> 3;
  char* ksm = smem + 33280;
  {
    const bf16_t* ksrc = P.keysb() + (size_t)(layer * 8 + hd) * 2 * 128 * 128;
#pragma unroll
    for (int i = 0; i < 8; ++i) {
      const int idx = tid + i * 512, r = idx >> 4, sg = idx & 15;
      *(uint4*)(ksm + (r * 136 + sg * 8) * 2) = *(const uint4*)(ksrc + (size_t)r * 128 + sg * 8);
    }
  }
  __syncthreads();
  uint32_t cab[16];
#pragma unroll
  for (int s = 0; s < 16; ++s) cab[s] = ctab[g * 16 + s];
  const int ntile = nrows / 16;
  for (int tile = tg + ngroups * wv; tile < ntile && tg < ngroups; tile += ngroups * NWAVE) {
    const int row0 = tile * 16;
    const bf16_t* qp = P.q() + (size_t)(row0 + li) * 2048 + hd * 256 + 8 * g;
    uint32_t win[2][16];
#pragma unroll
    for (int half = 0; half < 2; ++half) {
      bf16x8 qf[4];
#pragma unroll
      for (int t = 0; t < 4; ++t) qf[t] = *(const bf16x8*)(qp + half * 128 + 32 * t);
      const char* kb = ksm + ((half * 128 + li) * 136 + 8 * g) * 2;
      uint32_t pk[32];
#pragma unroll
      for (int kt = 0; kt < 8; ++kt) {
        f32x4 acc = (f32x4){0.f, 0.f, 0.f, 0.f};
#pragma unroll
        for (int t = 0; t < 4; ++t) {
          const bf16x8 a = *(const bf16x8*)(kb + (kt * 16 * 136 + 32 * t) * 2);
          acc = __builtin_amdgcn_mfma_f32_16x16x32_bf16(a, qf[t], acc, 0, 0, 0);
        }
#pragma unroll
        for (int e = 0; e < 4; ++e) pk[kt * 4 + e] = (mono_u(acc[e]) & ~127u) | (uint32_t)(16 * kt + 4 * g + e);
      }
      {
        uint32_t lo16[16], hi16[16];
#pragma unroll
        for (int i = 0; i < 16; ++i) { lo16[i] = pk[i]; hi16[i] = pk[16 + i]; }
        bitonic_sort_desc<16>(lo16);
        bitonic_sort_desc<16>(hi16);
#pragma unroll
        for (int i = 0; i < 16; ++i) lo16[i] = lo16[i] > hi16[15 - i] ? lo16[i] : hi16[15 - i];
        bitonic_merge_desc<16>(lo16);
        merge4_top16(lo16);
#pragma unroll
        for (int r = 0; r < 16; ++r) win[half][r] = lo16[r];
      }
    }
    if (g == 0) {
#pragma unroll
      for (int half = 0; half < 2; ++half)
#pragma unroll
        for (int r = 0; r < 16; ++r) {
          vals[li * 32 + half * 16 + r] = unmono_f(win[half][r] & ~127u);
          idxs[li * 32 + half * 16 + r] = (int)(win[half][r] & 127u);
        }
    }
    __builtin_amdgcn_wave_barrier();
    uint32_t cp[16];
    {
      float va[16], vb[16];
#pragma unroll
      for (int s = 0; s < 16; ++s) {
        const uint32_t ab = cab[s] == 0xFFu ? 0u : cab[s];
        va[s] = vals[li * 32 + (ab >> 4)]; vb[s] = vals[li * 32 + 16 + (ab & 15u)];
      }
#pragma unroll
      for (int s = 0; s < 16; ++s) cp[s] = cab[s] == 0xFFu ? 0u : ((mono_u(va[s] + vb[s]) & ~255u) | cab[s]);
    }
    bitonic_sort_desc<16>(cp);
    merge4_top16(cp);
    uint32_t cw[16];
#pragma unroll
    for (int r = 0; r < 16; ++r) cw[r] = cp[r];
    const float mx = unmono_f(cw[0] & ~255u);
    float sum = 0.f;
#pragma unroll
    for (int r = 0; r < 16; ++r) sum += __expf(unmono_f(cw[r] & ~255u) - mx);
    const float inv = 1.f / sum;
    const size_t ob = (size_t)(row0 + li) * 128 + hd * 16 + 4 * g;
    int si[4]; float sg[4];
    const uint32_t m1 = 0u - (uint32_t)(g & 1), m2 = 0u - (uint32_t)((g >> 1) & 1);
#pragma unroll
    for (int e = 0; e < 4; ++e) {
      const uint32_t c01 = (cw[4 + e] & m1) | (cw[e] & ~m1), c23 = (cw[12 + e] & m1) | (cw[8 + e] & ~m1);
      const uint32_t cs_ = (c23 & m2) | (c01 & ~m2), ab = cs_ & 255u;
      si[e] = idxs[li * 32 + (ab >> 4)] * 128 + idxs[li * 32 + 16 + (ab & 15u)];
      sg[e] = __expf(unmono_f(cs_ & ~255u) - mx) * inv;
    }
    *(u32x4_t*)(P.sel_idx() + ob) = (u32x4_t){(uint32_t)si[0], (uint32_t)si[1], (uint32_t)si[2], (uint32_t)si[3]};
    *(f32x4*)(P.sel_g() + ob) = (f32x4){sg[0], sg[1], sg[2], sg[3]};
    __builtin_amdgcn_wave_barrier();
  }
}

__device__ __forceinline__ void cvt8(const uint32_t w, float* f) {
  const f32x2_t a = __builtin_amdgcn_cvt_scalef32_pk_f32_fp4(w, 1.0f, 0), b = __builtin_amdgcn_cvt_scalef32_pk_f32_fp4(w, 1.0f, 1);
  const f32x2_t c = __builtin_amdgcn_cvt_scalef32_pk_f32_fp4(w, 1.0f, 2), e = __builtin_amdgcn_cvt_scalef32_pk_f32_fp4(w, 1.0f, 3);
  f[0] = a.x; f[1] = a.y; f[2] = b.x; f[3] = b.y; f[4] = c.x; f[5] = c.y; f[6] = e.x; f[7] = e.y;
}
__device__ __forceinline__ float swap16_add(float a, float b) {
  auto r = __builtin_amdgcn_permlane16_swap(__float_as_uint(a), __float_as_uint(b), false, false);
  return __uint_as_float(r[0]) + __uint_as_float(r[1]);
}
typedef int i32x8_t __attribute__((ext_vector_type(8)));
typedef _Float16 h2_t __attribute__((ext_vector_type(2)));
__device__ __forceinline__ void ph_peer_dots(int wv, const Params& P, int layer, int row_b, int row_e, int nb) {
#pragma unroll 1
  for (int row = row_b; row < row_e; row += nb * NWAVE) {
    const int lane = otid(wv) & 63, n = lane & 15, g = lane >> 4;
    const bool hsel = (lane & 8) != 0;
    const unsigned char* TU = P.tabU();
    const uint32_t tuo = (uint32_t)(8 * g + (lane & 7)) * 16u;
    i32x8_t xa;
    {
      const bf16_t* xp = P.u() + (size_t)row * DM + 32 * (8 * g + (lane & 7));
      float xv[32];
      unpack8(*(const uint4*)xp, xv); unpack8(*(const uint4*)(xp + 8), xv + 8);
      unpack8(*(const uint4*)(xp + 16), xv + 16); unpack8(*(const uint4*)(xp + 24), xv + 24);
#pragma unroll
      for (int r = 0; r < 4; ++r) {
        uint32_t hw = 0u, lw = 0u;
        float fh[8];
#pragma unroll
        for (int bsel = 0; bsel < 4; ++bsel) {
          if (bsel == 0) hw = __builtin_amdgcn_cvt_scalef32_pk_fp4_f32(hw, xv[8 * r + 0], xv[8 * r + 1], 1.0f, 0);
          if (bsel == 1) hw = __builtin_amdgcn_cvt_scalef32_pk_fp4_f32(hw, xv[8 * r + 2], xv[8 * r + 3], 1.0f, 1);
          if (bsel == 2) hw = __builtin_amdgcn_cvt_scalef32_pk_fp4_f32(hw, xv[8 * r + 4], xv[8 * r + 5], 1.0f, 2);
          if (bsel == 3) hw = __builtin_amdgcn_cvt_scalef32_pk_fp4_f32(hw, xv[8 * r + 6], xv[8 * r + 7], 1.0f, 3);
        }
        cvt8(hw, fh);
        lw = __builtin_amdgcn_cvt_scalef32_pk_fp4_f32(lw, (xv[8 * r + 0] - fh[0]) * 8.f, (xv[8 * r + 1] - fh[1]) * 8.f, 1.0f, 0);
        lw = __builtin_amdgcn_cvt_scalef32_pk_fp4_f32(lw, (xv[8 * r + 2] - fh[2]) * 8.f, (xv[8 * r + 3] - fh[3]) * 8.f, 1.0f, 1);
        lw = __builtin_amdgcn_cvt_scalef32_pk_fp4_f32(lw, (xv[8 * r + 4] - fh[4]) * 8.f, (xv[8 * r + 5] - fh[5]) * 8.f, 1.0f, 2);
        lw = __builtin_amdgcn_cvt_scalef32_pk_fp4_f32(lw, (xv[8 * r + 6] - fh[6]) * 8.f, (xv[8 * r + 7] - fh[7]) * 8.f, 1.0f, 3);
        xa[r] = (int)((n & 8) ? lw : hw);
        xa[4 + r] = 0;
      }
    }
    const int idx0 = P.sel_idx()[(size_t)row * 128 + lane], idx1 = P.sel_idx()[(size_t)row * 128 + 64 + lane];
    const float gt0 = P.sel_g()[(size_t)row * 128 + lane] * P.invV()[idx0], gt1 = P.sel_g()[(size_t)row * 128 + 64 + lane] * P.invV()[idx1];
    const float iu0 = P.invU()[idx0], iu1 = P.invU()[idx1];
    const float cs = ((g & 1) == ((n >> 2) & 1)) ? (g >= 2 ? (1.f / 8.f) : 1.f) : 0.f;
    const int lkey = lane & 0x37;
    float d0 = 0.f, d1 = 0.f;
    u32x4_t bufA[8], bufB[8], bufC[8], bufD[8];
#define PG_LOAD(buf, T, m0) do { _Pragma("unroll") for (int j = 0; j < 8; ++j) { \
      const int m_ = (m0) + j; const int src_ = m_ < 32 ? idx0 : idx1; const int kA_ = (m_ & 7) + 16 * ((m_ >> 3) & 3); \
      const int elo_ = __builtin_amdgcn_readlane(src_, kA_), ehi_ = __builtin_amdgcn_readlane(src_, kA_ + 8); \
      buf[j] = *(const u32x4_t*)(T + (((uint32_t)(hsel ? ehi_ : elo_) << 9) + tuo)); } } while (0)
#define PG_DOT(buf, m0) do { _Pragma("unroll") for (int j = 0; j < 8; ++j) { \
      const int m_ = (m0) + j; const int kA_ = (m_ & 7) + 16 * ((m_ >> 3) & 3); \
      const i32x8_t b_ = {(int)buf[j].x, (int)buf[j].y, (int)buf[j].z, (int)buf[j].w, 0, 0, 0, 0}; \
      const f32x4 acc_ = __builtin_amdgcn_mfma_scale_f32_16x16x128_f8f6f4(xa, b_, (f32x4){0.f, 0.f, 0.f, 0.f}, 4, 4, 0, 0x7F7F7F7F, 0, 0x7F7F7F7F); \
      float w_ = (n & 2) ? ((n & 1) ? acc_[3] : acc_[2]) : ((n & 1) ? acc_[1] : acc_[0]); \
      w_ *= cs; \
      w_ += DPP_F(w_, 0xB1); w_ += DPP_F(w_, 0x4E); w_ += DPP_F(w_, 0x141); \
      { auto r_ = __builtin_amdgcn_permlane32_swap(__float_as_uint(w_), __float_as_uint(w_), false, false); w_ = __uint_as_float(r_[0]) + __uint_as_float(r_[1]); } \
      { auto r_ = __builtin_amdgcn_permlane16_swap(__float_as_uint(w_), __float_as_uint(w_), false, false); w_ = __uint_as_float(r_[0]) + __uint_as_float(r_[1]); } \
      if (m_ < 32) d0 = (lkey == kA_) ? w_ : d0; else d1 = (lkey == kA_) ? w_ : d1; } } while (0)
    PG_LOAD(bufA, TU, 0); PG_LOAD(bufB, TU, 8); PG_LOAD(bufC, TU, 16);
    PG_LOAD(bufD, TU, 24); PG_DOT(bufA, 0);
    PG_LOAD(bufA, TU, 32); PG_DOT(bufB, 8);
    PG_LOAD(bufB, TU, 40); PG_DOT(bufC, 16);
    PG_LOAD(bufC, TU, 48); PG_DOT(bufD, 24);
    PG_LOAD(bufD, TU, 56); PG_DOT(bufA, 32);
    PG_DOT(bufB, 40); PG_DOT(bufC, 48); PG_DOT(bufD, 56);
    P.sel_g()[(size_t)row * 128 + lane] = gelu_f(d0 * iu0) * gt0;
    P.sel_g()[(size_t)row * 128 + 64 + lane] = gelu_f(d1 * iu1) * gt1;
#undef PG_LOAD
#undef PG_DOT
  }
}
__device__ __forceinline__ void ph_peer_acc(int wv, const Params& P, int layer, int row_b, int row_e, int nb) {
#pragma unroll 1
  for (int row = row_b; row < row_e; row += nb * NWAVE) {
    const int lane = otid(wv) & 63, l5 = lane & 31;
    const bool up = lane >= 32;
    const unsigned char* TV = P.tabV();
    const uint32_t tvo = (uint32_t)l5 * 16u;
    float o[32];
    const int idx0 = P.sel_idx()[(size_t)row * 128 + lane], idx1 = P.sel_idx()[(size_t)row * 128 + 64 + lane];
    const _Float16 act0 = (_Float16)P.sel_g()[(size_t)row * 128 + lane], act1 = (_Float16)P.sel_g()[(size_t)row * 128 + 64 + lane];
    h2_t o2[16];
    uint4 bufA[8], bufB[8];
#define PG_LOAD(buf, T, kk) do { _Pragma("unroll") for (int j = 0; j < 8; ++j) { \
      const int k_ = (kk) + 2 * j; const int src_ = k_ < 64 ? idx0 : idx1; \
      const int elo_ = __builtin_amdgcn_readlane(src_, k_ & 63), ehi_ = __builtin_amdgcn_readlane(src_, (k_ & 63) + 1); \
      buf[j] = *(const uint4*)(T + (((uint32_t)(up ? ehi_ : elo_) << 9) + tvo)); } } while (0)
    PG_LOAD(bufA, TV, 0);
#pragma unroll
    for (int i = 0; i < 32; ++i) o[i] = 0.f;
#pragma unroll
    for (int i = 0; i < 16; ++i) o2[i] = (h2_t){(_Float16)0.f, (_Float16)0.f};
#define PG_ACC(buf, kk) do { _Pragma("unroll") for (int j = 0; j < 8; ++j) { const int k_ = (kk) + 2 * j; \
      const int asrc_ = (int)__builtin_bit_cast(unsigned short, k_ < 64 ? act0 : act1); \
      const int alo_ = __builtin_amdgcn_readlane(asrc_, k_ & 63), ahi_ = __builtin_amdgcn_readlane(asrc_, (k_ & 63) + 1); \
      const _Float16 ah_ = __builtin_bit_cast(_Float16, (unsigned short)(up ? ahi_ : alo_)); const h2_t a2_ = {ah_, ah_}; \
      const uint32_t w_[4] = {buf[j].x, buf[j].y, buf[j].z, buf[j].w}; \
      _Pragma("unroll") for (int d = 0; d < 4; ++d) { uint32_t wd_ = w_[d]; asm volatile("" : "+v"(wd_) : "v"(o2[(d * 4 + 15) & 15])); \
        o2[d * 4 + 0] = __builtin_elementwise_fma(__builtin_bit_cast(h2_t, __builtin_amdgcn_cvt_scalef32_pk_f16_fp4(wd_, 1.0f, 0)), a2_, o2[d * 4 + 0]); \
        o2[d * 4 + 1] = __builtin_elementwise_fma(__builtin_bit_cast(h2_t, __builtin_amdgcn_cvt_scalef32_pk_f16_fp4(wd_, 1.0f, 1)), a2_, o2[d * 4 + 1]); \
        o2[d * 4 + 2] = __builtin_elementwise_fma(__builtin_bit_cast(h2_t, __builtin_amdgcn_cvt_scalef32_pk_f16_fp4(wd_, 1.0f, 2)), a2_, o2[d * 4 + 2]); \
        o2[d * 4 + 3] = __builtin_elementwise_fma(__builtin_bit_cast(h2_t, __builtin_amdgcn_cvt_scalef32_pk_f16_fp4(wd_, 1.0f, 3)), a2_, o2[d * 4 + 3]); } } } while (0)
#pragma unroll 1
    for (int kk = 0; kk < 128; kk += 32) {
      PG_LOAD(bufB, TV, kk + 16);
      PG_ACC(bufA, kk);
      if (kk + 32 < 128) PG_LOAD(bufA, TV, kk + 32);
      PG_ACC(bufB, kk + 16);
    }
#undef PG_LOAD
#undef PG_ACC
#pragma unroll
    for (int i = 0; i < 16; ++i) { o[2 * i] = (float)o2[i].x; o[2 * i + 1] = (float)o2[i].y; }
#pragma unroll
    for (int i = 0; i < 32; ++i) {
      auto r = __builtin_amdgcn_permlane32_swap(__float_as_uint(o[i]), __float_as_uint(o[i]), false, false);
      o[i] = __uint_as_float(r[0]) + __uint_as_float(r[1]);
    }
    const int lane_e = otid(wv) & 63, l5e = lane_e & 31;
    const bool upe = lane_e >= 32;
    const float* gate = P.mod() + (size_t)(layer * 5 + modrow(row)) * MODW + 5120 + l5e * 32;
    float* hr = P.h() + (size_t)row * DM + l5e * 32;
    float ss = 0.f;
    f32x4 hvv[8], ggv[8];
#pragma unroll
    for (int q = 0; q < 8; ++q) { hvv[q] = *(const f32x4*)(hr + q * 4); ggv[q] = *(const f32x4*)(gate + q * 4); }
#pragma unroll
    for (int q = 0; q < 8; ++q) asm volatile("" : "+v"(hvv[q]), "+v"(ggv[q]));
#pragma unroll
    for (int q = 0; q < 8; ++q) {
      float4 hv = make_float4(hvv[q][0], hvv[q][1], hvv[q][2], hvv[q][3]);
      const float4 gg = make_float4(ggv[q][0], ggv[q][1], ggv[q][2], ggv[q][3]);
      hv.x += gg.x * o[q * 4 + 0]; hv.y += gg.y * o[q * 4 + 1]; hv.z += gg.z * o[q * 4 + 2]; hv.w += gg.w * o[q * 4 + 3];
      if (layer == 0 && !upe) *(float4*)(hr + q * 4) = hv;
      o[q * 4 + 0] = hv.x; o[q * 4 + 1] = hv.y; o[q * 4 + 2] = hv.z; o[q * 4 + 3] = hv.w;
      if (!upe) ss += hv.x * hv.x + hv.y * hv.y + hv.z * hv.z + hv.w * hv.w;
    }
    ss = wave_sum(ss);
    const float rstd = rsqrtf(ss * (1.f / 1024.f) + 1e-6f);
    if (layer == 0) {
      const float* g1 = P.norm1_g + 1024 + l5e * 32;
      const float* mr = P.mod() + (size_t)(5 + modrow(row)) * MODW + l5e * 32;
      if (!upe) {
#pragma unroll
        for (int q = 0; q < 4; ++q) {
          float ov[8];
#pragma unroll
          for (int e = 0; e < 8; ++e) ov[e] = o[q * 8 + e] * rstd * g1[q * 8 + e] * (1.f + mr[1024 + q * 8 + e]) + mr[q * 8 + e];
          *(uint4*)(P.u() + (size_t)row * DM + l5e * 32 + q * 8) = make_uint4(pack2(ov[0], ov[1]), pack2(ov[2], ov[3]), pack2(ov[4], ov[5]), pack2(ov[6], ov[7]));
        }
      }
    } else {
      const float* gf = P.final_g + l5e * 32;
      if (!upe) {
#pragma unroll
        for (int q = 0; q < 8; ++q) {
          const float4 gg = *(const float4*)(gf + q * 4);
          *(float4*)(P.out + (size_t)row * DM + l5e * 32 + q * 4) =
              make_float4(o[q * 4] * rstd * gg.x, o[q * 4 + 1] * rstd * gg.y, o[q * 4 + 2] * rstd * gg.z, o[q * 4 + 3] * rstd * gg.w);
        }
      }
    }
  }
}

struct EpiOutproj {
  static constexpr bool PERM = false, AFTER_DRAIN = false;
  static constexpr int MIDK_T = 16;
  float* H; const float* hl; const float* hc; const float* modl;
  const float* yss;
  __device__ __forceinline__ void midk(pg8::f32x4 (&acc)[2][2][4][2], const pg8::Unit& u, int wr, int wc, int fr, int fq) const {
    const int row0 = u.pm * 256 + wr * 64 + fr;
#pragma unroll
    for (int ai = 0; ai < 2; ++ai)
#pragma unroll
      for (int m = 0; m < 4; ++m) {
        const pg8::f32x4* yp = (const pg8::f32x4*)(yss + (size_t)(row0 + ai * 128 + m * 16) * 16);
        const pg8::f32x4 y4 = (yp[0] + yp[1]) + (yp[2] + yp[3]);
        const float rstd = rsqrtf(((y4[0] + y4[1]) + (y4[2] + y4[3])) * (1.f / 1024.f) + 1e-6f);
#pragma unroll
        for (int bj = 0; bj < 2; ++bj)
#pragma unroll
          for (int n = 0; n < 2; ++n) acc[ai][bj][m][n] *= rstd;
      }
  }
  __device__ __forceinline__ void operator()(const pg8::f32x4 (&acc)[2][2][4][2], const pg8::Unit& u, int wr, int wc, int fr, int fq) const {
    const int row0 = u.pm * 256 + wr * 64 + fr, col0 = u.pn * 256 + wc * 32 + 4 * fq;
    const float* gate = modl + (size_t)modrow(row0) * MODW + 2048 + col0;
    pg8::f32x4 gv[2][2];
#pragma unroll
    for (int bj = 0; bj < 2; ++bj)
#pragma unroll
      for (int n = 0; n < 2; ++n) gv[bj][n] = *(const pg8::f32x4*)(gate + bj * 128 + n * 16);
    pg8::f32x4 sA[4], sB[4];
#define EO_LOAD(dstv, ai_, m_) do { const float* s_ = hrow(hl, hc, row0 + (ai_) * 128 + (m_) * 16) + col0; \
      dstv[0] = *(const pg8::f32x4*)(s_); dstv[1] = *(const pg8::f32x4*)(s_ + 16); dstv[2] = *(const pg8::f32x4*)(s_ + 128); dstv[3] = *(const pg8::f32x4*)(s_ + 144); } while (0)
#define EO_STORE(srcv, ai_, m_) do { asm volatile("" : "+v"(srcv[0]), "+v"(srcv[1]), "+v"(srcv[2]), "+v"(srcv[3])); \
      float* d_ = H + (size_t)(row0 + (ai_) * 128 + (m_) * 16) * DM + col0; \
      *(pg8::f32x4*)(d_) = srcv[0] + gv[0][0] * acc[ai_][0][m_][0]; *(pg8::f32x4*)(d_ + 16) = srcv[1] + gv[0][1] * acc[ai_][0][m_][1]; \
      *(pg8::f32x4*)(d_ + 128) = srcv[2] + gv[1][0] * acc[ai_][1][m_][0]; *(pg8::f32x4*)(d_ + 144) = srcv[3] + gv[1][1] * acc[ai_][1][m_][1]; } while (0)
    EO_LOAD(sA, 0, 0);
#pragma unroll
    for (int i = 0; i < 8; i += 2) {
      EO_LOAD(sB, (i + 1) >> 2, (i + 1) & 3);
      EO_STORE(sA, i >> 2, i & 3);
      if (i + 2 < 8) EO_LOAD(sA, (i + 2) >> 2, (i + 2) & 3);
      EO_STORE(sB, (i + 1) >> 2, (i + 1) & 3);
    }
#undef EO_LOAD
#undef EO_STORE
  }
};

template <int MODE>
__device__ void ctx_tile(int wv, const Params& P, int layer, char* smem, int tm, int tn, const bf16_t* __restrict__ A,
                         const bf16_t* __restrict__ Bt, const int K, const float* hc) {
  const int tid = otid(wv), lane = tid & 63, li = lane & 15, g = lane >> 4;
  const int kw = K >> 3;
  const bf16_t* ap = A + (size_t)(tm * 64 + li) * K + wv * kw + 8 * g;
  const bf16_t* bp = Bt + (size_t)(tn * 64 + li) * K + wv * kw + 8 * g;
  f32x4 acc[4][4];
#pragma unroll
  for (int mi = 0; mi < 4; ++mi)
#pragma unroll
    for (int ni = 0; ni < 4; ++ni) acc[mi][ni] = (f32x4){0.f, 0.f, 0.f, 0.f};
  bf16x8 fa0[4], fb0[4], fa1[4], fb1[4];
#define CT_LOAD(fa, fb, s) do { _Pragma("unroll") for (int i = 0; i < 4; ++i) { \
    fa[i] = *(const bf16x8*)(ap + (size_t)(16 * i) * K + (s) * 32); fb[i] = *(const bf16x8*)(bp + (size_t)(16 * i) * K + (s) * 32); } } while (0)
#define CT_MMA(fa, fb) do { _Pragma("unroll") for (int mi = 0; mi < 4; ++mi) _Pragma("unroll") for (int ni = 0; ni < 4; ++ni) \
    acc[mi][ni] = __builtin_amdgcn_mfma_f32_16x16x32_bf16(fb[ni], fa[mi], acc[mi][ni], 0, 0, 0); } while (0)
  const int steps = kw >> 5;
  CT_LOAD(fa0, fb0, 0);
#pragma unroll 1
  for (int s = 0; s < steps; s += 2) {
    CT_LOAD(fa1, fb1, s + 1);
    CT_MMA(fa0, fb0);
    if (s + 2 < steps) CT_LOAD(fa0, fb0, s + 2);
    CT_MMA(fa1, fb1);
  }
#undef CT_LOAD
#undef CT_MMA
  float* part = (float*)smem + wv * 4096;
#pragma unroll
  for (int mi = 0; mi < 4; ++mi)
#pragma unroll
    for (int ni = 0; ni < 4; ++ni) *(f32x4*)(part + (16 * mi + li) * 64 + (((4 * ni + g) ^ li) * 4)) = acc[mi][ni];
  __syncthreads();
  {
    const int row = tid >> 3, c4 = (tid & 7) * 2;
    const float* p0 = (const float*)smem + row * 64 + (((c4) ^ (row & 15)) * 4);
    const float* p1 = (const float*)smem + row * 64 + (((c4 + 1) ^ (row & 15)) * 4);
    f32x4 sa0 = (f32x4){0.f, 0.f, 0.f, 0.f}, sa1 = sa0, sb0 = sa0, sb1 = sa0;
#pragma unroll
    for (int w = 0; w < 4; ++w) { sa0 += *(const f32x4*)(p0 + w * 4096); sa1 += *(const f32x4*)(p1 + w * 4096); }
#pragma unroll
    for (int w = 4; w < 8; ++w) { sb0 += *(const f32x4*)(p0 + w * 4096); sb1 += *(const f32x4*)(p1 + w * 4096); }
    const int grow = NLAT + tm * 64 + row, col = tn * 64 + c4 * 4;
    if (MODE == 0) {
      const f32x4* yp = (const f32x4*)(P.yss() + (size_t)grow * 16);
      const f32x4 y4 = (yp[0] + yp[1]) + (yp[2] + yp[3]);
      const float rstd = rsqrtf(((y4[0] + y4[1]) + (y4[2] + y4[3])) * (1.f / 1024.f) + 1e-6f);
      const float* gate = P.mod() + ((size_t)layer * 5 + 4) * MODW + 2048 + col;
      const float* hs = hc + (size_t)(grow - NLAT) * DM + col;
      float* hd = P.h() + (size_t)grow * DM + col;
      const f32x4 g0 = *(const f32x4*)gate, g1 = *(const f32x4*)(gate + 4);
      const f32x4 h0 = *(const f32x4*)hs, h1 = *(const f32x4*)(hs + 4);
      *(f32x4*)hd = h0 + g0 * (sa0 * rstd + sb0);
      *(f32x4*)(hd + 4) = h1 + g1 * (sa1 * rstd + sb1);
    } else {
      const f32x4 s0 = sa0 + sb0, s1 = sa1 + sb1;
      *(uint4*)(P.q() + (size_t)grow * 2048 + col) = make_uint4(pack2(s0[0], s0[1]), pack2(s0[2], s0[3]), pack2(s1[0], s1[1]), pack2(s1[2], s1[3]));
    }
  }
  __syncthreads();
}

__device__ __forceinline__ uint32_t fp4_code(float x, float sc) {
  const float a = fabsf(x) * sc;
  const uint32_t c = (uint32_t)(a > 0.25f) + (uint32_t)(a > 0.75f) + (uint32_t)(a > 1.25f) + (uint32_t)(a > 1.75f) +
                     (uint32_t)(a > 2.5f) + (uint32_t)(a > 3.5f) + (uint32_t)(a > 5.0f);
  return c | (x < 0.f ? 8u : 0u);
}
__device__ void ph_convert_tables(int wv, const Params& P, int layer, int bid, int nb) {
  const int lane = otid(wv) & 63;
  for (int it0 = (bid * NWAVE + wv) * 2; it0 < 2 * 16384; it0 += nb * NWAVE * 2) {
    f32x4 v[2][4];
#pragma unroll
    for (int rr = 0; rr < 2; ++rr) {
      const int it = it0 + rr, t = it >> 14, e = it & 16383;
      const float* src = (t == 0 ? P.peer_u : P.peer_v) + ((size_t)layer * 16384 + e) * 1024 + lane * 16;
#pragma unroll
      for (int i = 0; i < 4; ++i) v[rr][i] = ((const f32x4*)src)[i];
    }
#pragma unroll
    for (int rr = 0; rr < 2; ++rr)
#pragma unroll
      for (int i = 0; i < 4; ++i) asm volatile("" : "+v"(v[rr][i]));
#pragma unroll
    for (int rr = 0; rr < 2; ++rr) {
      const int it = it0 + rr, t = it >> 14, e = it & 16383;
      float m = 0.f;
#pragma unroll
      for (int i = 0; i < 4; ++i)
        m = fmaxf(m, fmaxf(fmaxf(fabsf(v[rr][i][0]), fabsf(v[rr][i][1])), fmaxf(fabsf(v[rr][i][2]), fabsf(v[rr][i][3]))));
      m = wave_max(m);
      m = fmaxf(m, 1e-30f);
      const float sc = 6.0f / m, inv = m * (1.0f / 6.0f);
      uint2 o;
      {
        uint32_t p0 = 0u, p1 = 0u;
        p0 = __builtin_amdgcn_cvt_scalef32_pk_fp4_f32(p0, v[rr][0][0] * sc, v[rr][0][1] * sc, 1.0f, 0);
        p0 = __builtin_amdgcn_cvt_scalef32_pk_fp4_f32(p0, v[rr][0][2] * sc, v[rr][0][3] * sc, 1.0f, 1);
        p0 = __builtin_amdgcn_cvt_scalef32_pk_fp4_f32(p0, v[rr][1][0] * sc, v[rr][1][1] * sc, 1.0f, 2);
        p0 = __builtin_amdgcn_cvt_scalef32_pk_fp4_f32(p0, v[rr][1][2] * sc, v[rr][1][3] * sc, 1.0f, 3);
        p1 = __builtin_amdgcn_cvt_scalef32_pk_fp4_f32(p1, v[rr][2][0] * sc, v[rr][2][1] * sc, 1.0f, 0);
        p1 = __builtin_amdgcn_cvt_scalef32_pk_fp4_f32(p1, v[rr][2][2] * sc, v[rr][2][3] * sc, 1.0f, 1);
        p1 = __builtin_amdgcn_cvt_scalef32_pk_fp4_f32(p1, v[rr][3][0] * sc, v[rr][3][1] * sc, 1.0f, 2);
        p1 = __builtin_amdgcn_cvt_scalef32_pk_fp4_f32(p1, v[rr][3][2] * sc, v[rr][3][3] * sc, 1.0f, 3);
        o.x = p0; o.y = p1;
      }
      *(uint2*)((t == 0 ? P.tabU() : P.tabV()) + (size_t)e * 512 + lane * 8) = o;
      if (lane == 0) (t == 0 ? P.invU() : P.invV())[e] = inv;
    }
  }
}

enum {
  PH_PREP = 0, PH_NORM1, PH_INPROJ, PH_CONV, PH_SSDPREP, PH_STATES, PH_SCAN, PH_SSDY, PH_SSDNORM, PH_POOL, PH_NA,
  PH_OUTPROJ, PH_NORM2, PH_QGEMM, PH_TOPK, PH_GATHER, PH_FINAL
};

#define SMEM_BYTES 135168

__device__ __forceinline__ void run_phase(int wv, const Params& P, int ph, int layer, char* smem, int bid, int nb) {
  const float* hl = layer == 0 ? P.x : P.h();
  const float* hc = layer == 0 ? P.ctx : P.h() + (size_t)NLAT * DM;
  const int nrows = layer == 0 ? NTOK : NLAT;
  switch (ph) {
    case PH_PREP:
      for (int i = bid * NTHR + otid(wv); i < 2 * 8 * 2 * 128 * 128; i += nb * NTHR) P.keysb()[i] = f2bf(P.peer_keys[i]);
      for (int i = bid * NTHR + otid(wv); i < 2 * 4 * 128 * 128; i += nb * NTHR) {
        const int k = i & 127, n = (i >> 7) & 127, lg = i >> 14;
        P.poolwT()[i] = f2bf(P.pool_w[((size_t)lg * 128 + k) * 128 + n]);
      }
      ph_mod(wv, P, (float*)smem, bid, nb);
      for (int l = 0; l < 2; ++l) {
        ph_transpose(wv, P.w_in + (size_t)l * 1024 * INW, P.w_inT() + (size_t)l * PW * 1024, 1024, INW, PW, 0, 2560, 32, PW, (float*)smem, bid, nb);
        ph_transpose(wv, P.w_in + (size_t)l * 1024 * INW, P.w_dtT() + (size_t)l * 128 * 1024, 1024, INW, 128, 2560, 1 << 30, 0, 32, (float*)smem, bid, nb);
        ph_transpose(wv, P.w_out + (size_t)l * 2048 * 1024, P.w_outT() + (size_t)l * 1024 * 2048, 2048, 1024, 1024, 0, 1 << 30, 0, 1024, (float*)smem, bid, nb,
                     P.ssd_norm_g + l * 1024, 1024);
        ph_transpose(wv, P.peer_wq + (size_t)l * 1024 * 2048, P.w_qT() + (size_t)l * 2048 * 1024, 1024, 2048, 2048, 0, 1 << 30, 0, 2048, (float*)smem, bid, nb);
      }
      break;
    case PH_NORM1:
      ph_norm(wv, hl, hc, P.norm1_g + layer * 1024, P.mod() + (size_t)layer * 5 * MODW, 0, 1024, NTOK, P.u(), bid, nb);
      break;
    case PH_INPROJ:
    {
      pg8::Gemm g{P.u(), P.w_inT() + (size_t)layer * PW * 1024, NTOK, PW, 1024};
      pg8::StaticOrder S; S.init(g.M, g.N, nb, bid);
      pg8::EpiBf16<0> E{P.p(), PW, nullptr, 0, 0};
      pg8::gemm_phase<pg8::EpiBf16<0>, pg8::StaticOrder, false>(wv, (PG8_LAS unsigned char*)smem, g, S, E, nullptr);
      {
        const int units = (NTOK / 256) * (PW / 256), rem = units % nb;
        const int nidle = rem == 0 ? nb : nb - rem, first_idle = rem == 0 ? 0 : rem;
        if (bid >= first_idle) ph_dtprep(wv, P, layer, smem, bid - first_idle, nidle);
      }
      break;
    }
    case PH_CONV: ph_conv(wv, P, layer, bid, nb); ph_vtranspose(wv, P, smem, bid, nb); break;
    case PH_STATES: ph_states_mfma(wv, P, layer, smem, bid, nb); break;
    case PH_SCAN: ph_scan(wv, P, bid, nb); break;
    case PH_SSDY: ph_ssdy_mfma(wv, P, layer, nrows / 128, smem, bid, nb); break;
    case PH_POOL: ph_pool_mfma(wv, P, layer, nrows, smem, bid, nb); break;
    case PH_NA: ph_na_mfma(wv, P, layer, nrows, smem, bid, nb); break;
    case PH_OUTPROJ:
    {
      pg8::Gemm g{P.concat(), P.w_outT() + (size_t)layer * 1024 * 2048, NLAT, 1024, 2048};
      pg8::StaticOrder S; S.init(g.M, g.N, nb, bid);
      EpiOutproj E{P.h(), hl, hc, P.mod() + (size_t)layer * 5 * MODW, P.yss()};
      pg8::gemm_phase<EpiOutproj, pg8::StaticOrder, false>(wv, (PG8_LAS unsigned char*)smem, g, S, E, nullptr);
      if (layer == 0)
        for (int t = bid; t < 16 * 16; t += nb)
          ctx_tile<0>(wv, P, layer, smem, t >> 4, t & 15, P.concat() + (size_t)NLAT * 2048, P.w_outT() + (size_t)layer * 1024 * 2048, 2048, hc);
      break;
    }
    case PH_NORM2:
      ph_norm(wv, P.h(), P.h() + (size_t)NLAT * DM, P.norm2_g + layer * 1024, P.mod() + (size_t)layer * 5 * MODW, 3072, 4096, nrows, P.u(), bid, nb);
      break;
    case PH_QGEMM:
    {
      pg8::Gemm g{P.u(), P.w_qT() + (size_t)layer * 2048 * 1024, NLAT, 2048, 1024};
      pg8::StaticOrder S; S.init(g.M, g.N, nb, bid);
      pg8::EpiBf16<0> E{P.q(), 2048, nullptr, 0, 0};
      pg8::gemm_phase<pg8::EpiBf16<0>, pg8::StaticOrder, false>(wv, (PG8_LAS unsigned char*)smem, g, S, E, nullptr);
      if (layer == 0)
        for (int t = bid; t < 16 * 32; t += nb)
          ctx_tile<1>(wv, P, layer, smem, t >> 5, t & 31, P.u() + (size_t)NLAT * 1024, P.w_qT() + (size_t)layer * 2048 * 1024, 1024, nullptr);
      ph_convert_tables(wv, P, layer, bid, nb);
      break;
    }
    case PH_TOPK: ph_peer_topk_mfma(wv, P, layer, nrows, smem, bid, nb); break;
    case PH_GATHER:
    {
      const int rb = bid * NWAVE + wv, rm0 = (wv >= 4) ? rb + 4 * (nb * NWAVE) : nrows, rm = rm0 < nrows ? rm0 : nrows;
#pragma unroll 1
      for (int hh = 0; hh < 2; ++hh) {
        ph_peer_dots(wv, P, layer, hh ? rm : rb, hh ? nrows : rm, nb);
        ph_peer_acc(wv, P, layer, hh ? rm : rb, hh ? nrows : rm, nb);
      }
      break;
    }
  }
}

namespace cg = cooperative_groups;
typedef const __attribute__((address_space(4))) Params* kparams_t;
__device__ __forceinline__ const Params& kp_fresh() {
  kparams_t kp = (kparams_t)__builtin_amdgcn_kernarg_segment_ptr();
  asm volatile("" : "+s"(kp));
  return *(const Params*)kp;
}
__global__ void __launch_bounds__(NTHR) k_mega(Params P_unused) {
  __shared__ __attribute__((aligned(16))) char smem[SMEM_BYTES + 16];
  cg::grid_group grid = cg::this_grid();
  const int bid = blockIdx.x, nb = gridDim.x;
  const int wv = __builtin_amdgcn_readfirstlane(threadIdx.x >> 6);
  if (threadIdx.x == 0) *(uint4*)(smem + SMEM_BYTES) = make_uint4(0u, 0u, 0u, 0u);
  __syncthreads();
  (void)xcd_barrier_post((unsigned*)(kp_fresh().ws + WS_BAR), (volatile LAS unsigned*)(smem + SMEM_BYTES), threadIdx.x == 0);
#define GSYNC() do { XcdBarrier xb_; xb_.bar = (unsigned*)(kp_fresh().ws + WS_BAR); xb_.x = xb_xcc_id(); \
    xb_.st = (volatile LAS unsigned*)(smem + SMEM_BYTES); xcd_barrier(xb_, otid(wv) == 0); } while (0)
  run_phase(wv, kp_fresh(), PH_PREP, 0, smem, bid, nb);
  if (nb == 0x7fffff00) grid.sync();
  GSYNC();
  run_phase(wv, kp_fresh(), PH_NORM1, 0, smem, bid, nb); GSYNC();
#pragma unroll 1
  for (int layer = 0; layer < 2; ++layer) {
    run_phase(wv, kp_fresh(), PH_INPROJ, layer, smem, bid, nb); GSYNC();
    run_phase(wv, kp_fresh(), PH_CONV, layer, smem, bid, nb);
    GSYNC();
    run_phase(wv, kp_fresh(), PH_STATES, layer, smem, bid, nb);
    run_phase(wv, kp_fresh(), PH_POOL, layer, smem, bid, nb);
    run_phase(wv, kp_fresh(), PH_NA, layer, smem, bid, nb); GSYNC();
    run_phase(wv, kp_fresh(), PH_SCAN, layer, smem, bid, nb); GSYNC();
    run_phase(wv, kp_fresh(), PH_SSDY, layer, smem, bid, nb); GSYNC();
    run_phase(wv, kp_fresh(), PH_OUTPROJ, layer, smem, bid, nb); GSYNC();
    run_phase(wv, kp_fresh(), PH_NORM2, layer, smem, bid, nb); GSYNC();
    run_phase(wv, kp_fresh(), PH_QGEMM, layer, smem, bid, nb); GSYNC();
    run_phase(wv, kp_fresh(), PH_TOPK, layer, smem, bid, nb); GSYNC();
    run_phase(wv, kp_fresh(), PH_GATHER, layer, smem, bid, nb);
    if (layer == 0) GSYNC();
  }
}

extern "C" void kernel_launch(void* const* d_in, const int* in_sizes, int n_in, void* d_out, int out_size, void* d_ws,
                              size_t ws_size, hipStream_t stream) {
  Params P{};
  const float* const* in = (const float* const*)d_in;
  P.x = in[0]; P.c = in[1]; P.ctx = in[2]; P.c_ctx = in[3]; P.ada_w = in[4]; P.ada_b = in[5]; P.norm1_g = in[6];
  P.w_in = in[7]; P.conv_w = in[8]; P.conv_b = in[9]; P.a_log = in[10]; P.dt_bias = in[11]; P.d_skip = in[12];
  P.ssd_norm_g = in[13]; P.pool_w = in[14]; P.pool_scale = in[15]; P.na_rpb = in[16]; P.w_out = in[17];
  P.norm2_g = in[18]; P.peer_wq = in[19]; P.peer_keys = in[20]; P.peer_u = in[21]; P.peer_v = in[22]; P.final_g = in[23];
  P.out = (float*)d_out;
  P.ws = (char*)d_ws;
  if (WS_TOTAL > ws_size) { fprintf(stderr, "workspace too small: need %zu have %zu\n", (size_t)WS_TOTAL, ws_size); return; }

  static int grid_blocks = 0;
  if (!grid_blocks) {
    int dev = 0, cus = 0, per_cu = 0;
    hipGetDevice(&dev);
    hipDeviceGetAttribute(&cus, hipDeviceAttributeMultiprocessorCount, dev);
    hipOccupancyMaxActiveBlocksPerMultiprocessor(&per_cu, k_mega, NTHR, 0);
    if (per_cu > 4) per_cu = 4;
    grid_blocks = cus * per_cu;
  }
  hipMemsetAsync((char*)d_ws + WS_BAR, 0, 4096 * 4, stream);
  void* args[] = {&P};
  hipError_t e = hipLaunchCooperativeKernel((void*)k_mega, dim3(grid_blocks), dim3(NTHR), args, 0, stream);
  if (e != hipSuccess) fprintf(stderr, "cooperative launch failed: %s (grid %d)\n", hipGetErrorString(e), grid_blocks);
}
```

```cpp
#include <hip/hip_runtime.h>
#include <hip/hip_bf16.h>
#include <hip/hip_cooperative_groups.h>
#include <stdint.h>
#include <stdio.h>

typedef unsigned short bf16_t;
typedef __attribute__((ext_vector_type(8))) short bf16x8;
typedef __attribute__((ext_vector_type(4))) float f32x4;

#define NTHR 512
#define NWAVE 8
constexpr int DM = 1024;
constexpr int SEQ = 4096;
constexpr int NLAT = 16384;
constexpr int NCTXR = 1024;
constexpr int NTOK = 17408;
constexpr int INW = 4640;
constexpr int PW = 4608;
constexpr int OFF_Z = 0, OFF_XBC = 1024, OFF_POOL = 2560, OFF_Q = 3072, OFF_K = 3584, OFF_V = 4096;
constexpr int NCHUNK = 136;
constexpr int MODW = 6144;

constexpr size_t al256(size_t x) { return (x + 255) & ~(size_t)255; }
constexpr size_t WS_MOD = 0;
constexpr size_t WS_H = WS_MOD + al256((size_t)2 * 5 * MODW * 4);
constexpr size_t WS_P = WS_H + al256((size_t)NTOK * DM * 4);
constexpr size_t WS_TABU = WS_P + (size_t)80 * 1024 * 1024;
constexpr size_t WS_TABV = WS_TABU + (size_t)16384 * 512;
constexpr size_t WS_INVU = WS_TABV + (size_t)16384 * 512;
constexpr size_t WS_INVV = WS_INVU + (size_t)16384 * 4;
constexpr size_t WS_DTRAW = WS_P + al256((size_t)NTOK * PW * 2);
constexpr size_t WS_DTV = WS_DTRAW + al256((size_t)NTOK * 32 * 4);
constexpr size_t WS_CSV = WS_DTV + al256((size_t)NTOK * 32 * 4);
constexpr size_t WS_XBC = WS_CSV + al256((size_t)NTOK * 32 * 4);
constexpr size_t WS_VTL = WS_XBC + al256((size_t)NTOK * 512 * 2);
constexpr size_t WS_VTC = WS_VTL + al256((size_t)4 * 8 * 64 * 4096 * 2);
constexpr size_t WS_KEYSB = WS_VTC + al256((size_t)4 * 8 * 64 * 256 * 2);
constexpr size_t WS_POOLWT = WS_KEYSB + al256((size_t)2 * 8 * 2 * 128 * 128 * 2);
constexpr size_t WS_BT4 = WS_POOLWT + al256((size_t)2 * 4 * 128 * 128 * 2);
constexpr size_t WS_ATOT = WS_BT4 + al256((size_t)NTOK * 256 * 2);
constexpr size_t WS_STATES = WS_XBC + al256((size_t)NTOK * 1536 * 2);
constexpr size_t WS_YSS = WS_ATOT + al256((size_t)NCHUNK * 32 * 4);
static_assert(WS_YSS + (size_t)NTOK * 16 * 4 <= WS_STATES, "must fit in the old xbc region");
constexpr size_t WS_CONCAT = WS_STATES + al256((size_t)NCHUNK * 32 * 8192 * 2);
constexpr size_t WS_SELIDX = WS_CONCAT + al256((size_t)NTOK * 2048 * 2);
constexpr size_t WS_SELG = WS_SELIDX + al256((size_t)NTOK * 128 * 4);
constexpr size_t WS_WINT = WS_SELG + al256((size_t)NTOK * 128 * 4);
constexpr size_t WS_WDTT = WS_WINT + al256((size_t)2 * PW * 1024 * 2);
constexpr size_t WS_WOUTT = WS_WDTT + al256((size_t)2 * 128 * 1024 * 2);
constexpr size_t WS_WQT = WS_WOUTT + al256((size_t)2 * 1024 * 2048 * 2);
constexpr size_t WS_BAR = WS_WQT + al256((size_t)2 * 2048 * 1024 * 2);
constexpr size_t WS_XT4 = WS_BAR + al256((size_t)4096 * 4);
constexpr size_t WS_TOTAL = WS_XT4 + al256((size_t)NTOK * 1024 * 2);
static_assert((size_t)4 * 8 * (4096 + 256) * 64 * 2 <= WS_WINT - WS_SELIDX, "K relayout must fit in the sel_idx/sel_g region");
static_assert(WS_INVV + (size_t)16384 * 4 <= WS_DTRAW, "tables must fit in the tail of p");
static_assert((size_t)NTOK * 2048 * 2 <= (size_t)80 * 1024 * 1024, "q must fit below the tables");

struct Params {
  const float *x, *c, *ctx, *c_ctx, *ada_w, *ada_b, *norm1_g, *w_in, *conv_w, *conv_b, *a_log, *dt_bias, *d_skip,
      *ssd_norm_g, *pool_w, *pool_scale, *na_rpb, *w_out, *norm2_g, *peer_wq, *peer_keys, *peer_u, *peer_v, *final_g;
  float* out;
  char* ws;
  __device__ __forceinline__ float* mod() const { return (float*)(ws + WS_MOD); }
  __device__ __forceinline__ float* h() const { return (float*)(ws + WS_H); }
  __device__ __forceinline__ bf16_t* u() const { return (bf16_t*)(ws + WS_CONCAT); }
  __device__ __forceinline__ bf16_t* p() const { return (bf16_t*)(ws + WS_P); }
  __device__ __forceinline__ float* dtraw() const { return (float*)(ws + WS_DTRAW); }
  __device__ __forceinline__ float* dtv() const { return (float*)(ws + WS_DTV); }
  __device__ __forceinline__ float* csv() const { return (float*)(ws + WS_CSV); }
  __device__ __forceinline__ bf16_t* xbc() const { return (bf16_t*)(ws + WS_XBC); }
  __device__ __forceinline__ bf16_t* states() const { return (bf16_t*)(ws + WS_STATES); }
  __device__ __forceinline__ bf16_t* concat() const { return (bf16_t*)(ws + WS_CONCAT); }
  __device__ __forceinline__ bf16_t* q() const { return (bf16_t*)(ws + WS_P); }
  __device__ __forceinline__ int* sel_idx() const { return (int*)(ws + WS_SELIDX); }
  __device__ __forceinline__ float* sel_g() const { return (float*)(ws + WS_SELG); }
  __device__ __forceinline__ bf16_t* w_inT() const { return (bf16_t*)(ws + WS_WINT); }
  __device__ __forceinline__ bf16_t* w_dtT() const { return (bf16_t*)(ws + WS_WDTT); }
  __device__ __forceinline__ bf16_t* w_outT() const { return (bf16_t*)(ws + WS_WOUTT); }
  __device__ __forceinline__ bf16_t* w_qT() const { return (bf16_t*)(ws + WS_WQT); }
  __device__ __forceinline__ bf16_t* vtl() const { return (bf16_t*)(ws + WS_VTL); }
  __device__ __forceinline__ bf16_t* vtc() const { return (bf16_t*)(ws + WS_VTC); }
  __device__ __forceinline__ bf16_t* poolwT() const { return (bf16_t*)(ws + WS_POOLWT); }
  __device__ __forceinline__ bf16_t* keysb() const { return (bf16_t*)(ws + WS_KEYSB); }
  __device__ __forceinline__ bf16_t* xt4() const { return (bf16_t*)(ws + WS_XT4); }
  __device__ __forceinline__ bf16_t* bt4() const { return (bf16_t*)(ws + WS_BT4); }
  __device__ __forceinline__ float* wst() const { return (float*)(ws + WS_DTRAW); }
  __device__ __forceinline__ float* cst() const { return (float*)(ws + WS_CSV); }
  __device__ __forceinline__ float* dtt() const { return (float*)(ws + WS_DTV); }
  __device__ __forceinline__ float* yss() const { return (float*)(ws + WS_YSS); }
  __device__ __forceinline__ float* atot() const { return (float*)(ws + WS_ATOT); }
  __device__ __forceinline__ bf16_t* bfr() const { return (bf16_t*)(ws + WS_XBC); }
  __device__ __forceinline__ bf16_t* cfr() const { return (bf16_t*)(ws + WS_XBC + (size_t)NTOK * 256 * 2); }
  __device__ __forceinline__ bf16_t* ktl() const { return (bf16_t*)(ws + WS_SELIDX); }
  __device__ __forceinline__ bf16_t* ktc() const { return (bf16_t*)(ws + WS_SELIDX + (size_t)4 * 8 * 4096 * 64 * 2); }
  __device__ __forceinline__ unsigned char* tabU() const { return (unsigned char*)(ws + WS_TABU); }
  __device__ __forceinline__ unsigned char* tabV() const { return (unsigned char*)(ws + WS_TABV); }
  __device__ __forceinline__ float* invU() const { return (float*)(ws + WS_INVU); }
  __device__ __forceinline__ float* invV() const { return (float*)(ws + WS_INVV); }
};

__device__ __forceinline__ int otid(int wv) {
  int l;
  asm volatile("v_mbcnt_lo_u32_b32 %0, -1, 0\n\tv_mbcnt_hi_u32_b32 %0, -1, %0" : "=v"(l));
  return (wv << 6) | l;
}
__device__ __forceinline__ float bf2f(bf16_t v) { return __uint_as_float(((uint32_t)v) << 16); }
typedef __bf16 bf16x2_hw __attribute__((ext_vector_type(2)));
__device__ __forceinline__ uint32_t pack2(float a, float b) {
  const float __attribute__((ext_vector_type(2))) v = {a, b};
  return __builtin_bit_cast(uint32_t, __builtin_convertvector(v, bf16x2_hw));
}
__device__ __forceinline__ bf16_t f2bf(float f) { return (bf16_t)(pack2(f, 0.f) & 0xffffu); }
#define DPP_F(v, ctrl) __int_as_float(__builtin_amdgcn_update_dpp(0, __float_as_int(v), (ctrl), 0xf, 0xf, true))
__device__ __forceinline__ float wave_sum(float v) {
  v += DPP_F(v, 0xB1);
  v += DPP_F(v, 0x4E);
  v += DPP_F(v, 0x141);
  v += DPP_F(v, 0x140);
  const int iv = __float_as_int(v);
  return __int_as_float(__builtin_amdgcn_readlane(iv, 0)) + __int_as_float(__builtin_amdgcn_readlane(iv, 16)) +
         __int_as_float(__builtin_amdgcn_readlane(iv, 32)) + __int_as_float(__builtin_amdgcn_readlane(iv, 48));
}
__device__ __forceinline__ float wave_max(float v) {
  v = fmaxf(v, DPP_F(v, 0xB1));
  v = fmaxf(v, DPP_F(v, 0x4E));
  v = fmaxf(v, DPP_F(v, 0x141));
  v = fmaxf(v, DPP_F(v, 0x140));
  const int iv = __float_as_int(v);
  return fmaxf(fmaxf(__int_as_float(__builtin_amdgcn_readlane(iv, 0)), __int_as_float(__builtin_amdgcn_readlane(iv, 16))),
               fmaxf(__int_as_float(__builtin_amdgcn_readlane(iv, 32)), __int_as_float(__builtin_amdgcn_readlane(iv, 48))));
}
__device__ __forceinline__ float fexp(float v) { return __builtin_amdgcn_exp2f(v * 1.44269504088896341f); }
__device__ __forceinline__ float silu_f(float v) { return v * __builtin_amdgcn_rcpf(1.f + fexp(-v)); }
__device__ __forceinline__ float softplus_f(float v) { return fmaxf(v, 0.f) + log1pf(expf(-fabsf(v))); }
__device__ __forceinline__ float gelu_f(float v) { return 0.5f * v * (1.f + erff(v * 0.70710678118654752f)); }

__device__ __forceinline__ void unpack8(const uint4 v, float* f) {
  f[0] = __uint_as_float(v.x << 16); f[1] = __uint_as_float(v.x & 0xffff0000u);
  f[2] = __uint_as_float(v.y << 16); f[3] = __uint_as_float(v.y & 0xffff0000u);
  f[4] = __uint_as_float(v.z << 16); f[5] = __uint_as_float(v.z & 0xffff0000u);
  f[6] = __uint_as_float(v.w << 16); f[7] = __uint_as_float(v.w & 0xffff0000u);
}
typedef float f32x2_t __attribute__((ext_vector_type(2)));
typedef unsigned u32x4_t __attribute__((ext_vector_type(4)));
typedef short s16x4 __attribute__((ext_vector_type(4)));
typedef __attribute__((address_space(3))) s16x4 lds_s16x4;
__device__ __forceinline__ bf16x8 tr_read2(const char* a0, const char* a1) {
  const s16x4 a = __builtin_amdgcn_ds_read_tr16_b64_v4i16((lds_s16x4*)a0);
  const s16x4 b = __builtin_amdgcn_ds_read_tr16_b64_v4i16((lds_s16x4*)a1);
  return (bf16x8){a[0], a[1], a[2], a[3], b[0], b[1], b[2], b[3]};
}

__device__ __forceinline__ const float* hrow(const float* hl, const float* hc, int row) {
  return row < NLAT ? hl + (size_t)row * DM : hc + (size_t)(row - NLAT) * DM;
}
__device__ __forceinline__ int modrow(int row) { return row < NLAT ? (row >> 12) : 4; }

namespace pg8 {
#define PG8_LAS __attribute__((address_space(3)))
typedef unsigned short bf16_t;
typedef short bf16x8 __attribute__((ext_vector_type(8)));
typedef float f32x4 __attribute__((ext_vector_type(4)));
typedef unsigned u32x4 __attribute__((ext_vector_type(4)));
constexpr int BM = 256, BK = 64, HALF = 128, HTB = HALF * BK * 2  , STAGE_BYTES = 8 * HTB, NXCD = 8, WGM = 8;

__host__ __device__ __forceinline__ int lds_byte(int r, int c) { const int st = (r >> 4) * 2 + (c >> 5), rr = r & 15, cc = c & 31, ob = rr * 64 + cc * 2; return st * 1024 + (ob ^ (((ob >> 9) & 1) << 5)); }
__host__ __device__ __forceinline__ void stage_rc(int b, int& R, int& C) { const int st = b / 1024, sb = b % 1024, swz = sb ^ (((sb >> 9) & 1) << 5); R = (st >> 1) * 16 + swz / 64; C = (st & 1) * 32 + (swz % 64) / 2; }
__host__ __device__ __forceinline__ int perm32(int rho) { const int n = rho >> 4, i = rho & 15; return 8 * (i >> 2) + 4 * n + (i & 3); }

struct Unit { int pm, pn; };
struct Gemm { const bf16_t* A; const bf16_t* Bt; int M, N, K; };

struct StaticOrder {
    int nM, nN, nwg, G, c;
    __host__ __device__ void init(int M, int N, int G_, int c_) { nM = M / BM; nN = N / BM; nwg = nM * nN; G = G_; c = c_; }
    __host__ __device__ bool next(int i, Unit& u) const {
        const long L = (long)i * G + c; if (L >= nwg) return false;
        int wgid = (int)L; { const int q = nwg / NXCD, r = nwg % NXCD, xcd = wgid % NXCD, off = wgid / NXCD; wgid = (xcd < r ? xcd * (q + 1) : r * (q + 1) + (xcd - r) * q) + off; }
        const int nig = WGM * nN, gid = wgid / nig, fm = gid * WGM, gsz = (nM - fm) < WGM ? (nM - fm) : WGM;
        u.pm = fm + ((wgid % nig) % gsz); u.pn = (wgid % nig) / gsz; return true;
    }
    __device__ __forceinline__ void a_ready(const Unit&) const {}
    __device__ __forceinline__ void done(const Unit&) const {}
};

__device__ __forceinline__ unsigned cvt_pk_bf16(float lo, float hi) { unsigned r; asm volatile("v_cvt_pk_bf16_f32 %0, %1, %2" : "=v"(r) : "v"(lo), "v"(hi)); return r; }
typedef float f32x2 __attribute__((ext_vector_type(2)));
__device__ __forceinline__ f32x2 gelu_pk(f32x2 v) { return v; }
template <int ACT  > struct EpiBf16 {
    static constexpr bool PERM = true, AFTER_DRAIN = false; static constexpr int MIDK_T = 0;
    bf16_t* O; int ldc; const float* bias; int split_cols; size_t split_stride;
    __device__ __forceinline__ void operator()(const f32x4 (&acc)[2][2][4][2], const Unit& u, int wr, int wc, int fr, int fq) const {
        const int row0 = u.pm * BM + wr * 64 + fr; int colt = u.pn * BM; bf16_t* base = O;
        if (split_cols) { const int t = colt / split_cols; base += (size_t)t * split_stride; colt -= t * split_cols; }
        const int col0 = colt + wc * 32 + 8 * fq, bcol0 = u.pn * BM + wc * 32 + 8 * fq;
        f32x4 bv[2][2];
#pragma unroll
        for (int bj = 0; bj < 2; ++bj)
#pragma unroll
            for (int n = 0; n < 2; ++n) bv[bj][n] = bias ? *(const f32x4*)(bias + bcol0 + bj * HALF + 4 * n) : (f32x4){0.f, 0.f, 0.f, 0.f};
#pragma unroll
        for (int ai = 0; ai < 2; ++ai)
#pragma unroll
            for (int m = 0; m < 4; ++m) { bf16_t* rowp = base + (size_t)(row0 + ai * HALF + m * 16) * ldc + col0;
#pragma unroll
                for (int bj = 0; bj < 2; ++bj) { f32x4 v0 = acc[ai][bj][m][0] + bv[bj][0], v1 = acc[ai][bj][m][1] + bv[bj][1];
                    if (ACT == 1) { f32x2 a = gelu_pk((f32x2){v0[0], v0[1]}), b = gelu_pk((f32x2){v0[2], v0[3]}), c = gelu_pk((f32x2){v1[0], v1[1]}), d = gelu_pk((f32x2){v1[2], v1[3]});
                        v0 = (f32x4){a.x, a.y, b.x, b.y}; v1 = (f32x4){c.x, c.y, d.x, d.y}; }
                    if (ACT == 2) {
#pragma unroll
                        for (int j = 0; j < 4; ++j) { v0[j] = 0.5f * v0[j] * (1.0f + erff(v0[j] * 0.70710678f)); v1[j] = 0.5f * v1[j] * (1.0f + erff(v1[j] * 0.70710678f)); } }
                    u32x4 w; w.x = cvt_pk_bf16(v0[0], v0[1]); w.y = cvt_pk_bf16(v0[2], v0[3]); w.z = cvt_pk_bf16(v1[0], v1[1]); w.w = cvt_pk_bf16(v1[2], v1[3]);
                    *(u32x4*)(rowp + bj * HALF) = w; } }
    }
};

template <class Epi, class Sched, bool STAMP = false>
__device__ __forceinline__ void gemm_phase(int wv, PG8_LAS unsigned char* lds, const Gemm g, const Sched& S, const Epi& E, unsigned long long* stamps) {
    const int tid = otid(wv), wid = __builtin_amdgcn_readfirstlane(tid >> 6), lane = tid & 63, wr = wid >> 2, wc = wid & 3, fr = lane & 15, fq = lane >> 4;
    const int K = g.K, nt = K / BK;
    int ts_lo = 0, ts_hi = 0, nts = 0; const unsigned long long rt_entry = STAMP ? (unsigned long long)wall_clock64() : 0ull;
#define PG8_STAMP() do { if (STAMP && wid == 0 && nts < 64) { const unsigned long long _c = (unsigned long long)clock64(); \
        ts_lo = (lane == nts) ? (int)(unsigned)_c : ts_lo; ts_hi = (lane == nts) ? (int)(unsigned)(_c >> 32) : ts_hi; ++nts; } } while (0)
    PG8_STAMP();
    unsigned voffA[2], voffB[2];
#pragma unroll
    for (int i = 0; i < 2; ++i) { int R, C; stage_rc(tid * 16 + i * 8192, R, C); const int Rb = Epi::PERM ? ((R & ~31) + perm32(R & 31)) : R;
        voffA[i] = (unsigned)(R * K + C) * 2u; voffB[i] = (unsigned)(Rb * K + C) * 2u; }
    const size_t kstep = (size_t)(BK * 2);
    const size_t hstep = (size_t)HALF * K * 2;
    const size_t tstep = 2 * hstep;
    const unsigned ldsw = (unsigned)wid * 1024u;
    const int aoff = lds_byte(wr * 64 + fr, fq * 8), boff = lds_byte(wc * 32 + fr, fq * 8);
#define PG8_SA(b, h) (((b) * 2 + (h)) * HTB)
#define PG8_SB(b, h) ((4 + (b) * 2 + (h)) * HTB)
#define PG8_STAGE(bufoff, gbase, voff) do { _Pragma("unroll") for (int _i = 0; _i < 2; ++_i) \
        __builtin_amdgcn_global_load_lds((const unsigned*)((const char*)(gbase) + (voff)[_i]), (PG8_LAS unsigned*)(lds + (bufoff) + ldsw + _i * 8192), 16, 0, 0); } while (0)
#define PG8_LDA(dst, b, h) do { _Pragma("unroll") for (int m = 0; m < 4; ++m) _Pragma("unroll") for (int k = 0; k < 2; ++k) dst[m][k] = *(const PG8_LAS bf16x8*)(lds + PG8_SA(b, h) + aoff + m * 2048 + k * 1024); } while (0)
#define PG8_LDB(dst, b, h) do { _Pragma("unroll") for (int n = 0; n < 2; ++n) _Pragma("unroll") for (int k = 0; k < 2; ++k) dst[n][k] = *(const PG8_LAS bf16x8*)(lds + PG8_SB(b, h) + boff + n * 2048 + k * 1024); } while (0)
#define PG8_MMA(ai, bj, At, Bt) do { __builtin_amdgcn_s_setprio(1); _Pragma("unroll") for (int m = 0; m < 4; ++m) _Pragma("unroll") for (int n = 0; n < 2; ++n) _Pragma("unroll") for (int k = 0; k < 2; ++k) \
        acc[ai][bj][m][n] = __builtin_amdgcn_mfma_f32_16x16x32_bf16(Bt[n][k], At[m][k], acc[ai][bj][m][n], 0, 0, 0); __builtin_amdgcn_s_setprio(0); } while (0)
#define PG8_WAIT_V(n) asm volatile("s_waitcnt vmcnt(" #n ")" ::: "memory")
#define PG8_WAIT_L(n) asm volatile("s_waitcnt lgkmcnt(" #n ")" ::: "memory")
#define PG8_BAR __builtin_amdgcn_s_barrier()
#define PG8_SCHED __builtin_amdgcn_sched_barrier(0)
    Unit cur, nxt; int ui = 0;
    if (!S.next(0, cur)) return;
    f32x4 acc[2][2][4][2];
#pragma unroll
    for (int a = 0; a < 2; ++a)
#pragma unroll
        for (int b = 0; b < 2; ++b)
#pragma unroll
            for (int m = 0; m < 4; ++m)
#pragma unroll
                for (int n = 0; n < 2; ++n) acc[a][b][m][n] = (f32x4){0.f, 0.f, 0.f, 0.f};
    bf16x8 At[4][2], B0[2][2], B1[2][2];
    const char* cA = (const char*)g.A + (size_t)cur.pm * tstep; const char* cB = (const char*)g.Bt + (size_t)cur.pn * tstep;
    S.a_ready(cur);
    PG8_STAGE(PG8_SB(0, 0), cB, voffB); PG8_STAGE(PG8_SA(0, 0), cA, voffA); PG8_STAGE(PG8_SB(0, 1), cB + hstep, voffB); PG8_STAGE(PG8_SA(0, 1), cA + hstep, voffA);
    if (wr == 1) PG8_BAR;
    PG8_WAIT_V(4); PG8_BAR;
    PG8_STAGE(PG8_SB(1, 0), cB + kstep, voffB); PG8_STAGE(PG8_SA(1, 0), cA + kstep, voffA); PG8_STAGE(PG8_SB(1, 1), cB + hstep + kstep, voffB);
    PG8_WAIT_V(6); PG8_BAR;
    PG8_STAMP();
    for (;;) {
        const bool has_next = S.next(ui + 1, nxt);
        const char* nA = has_next ? (const char*)g.A + (size_t)nxt.pm * tstep : cA; const char* nB = has_next ? (const char*)g.Bt + (size_t)nxt.pn * tstep : cB;
        for (int t = 0; t < nt; t += 2) {
            if constexpr (Epi::MIDK_T > 0) { if (t == Epi::MIDK_T) E.midk(acc, cur, wr, wc, fr, fq); }
            const bool last = (t == nt - 2);
            const char* a1 = cA + (size_t)(t + 1) * kstep;
            const char* a2 = last ? nA : cA + (size_t)(t + 2) * kstep; const char* b2 = last ? nB : cB + (size_t)(t + 2) * kstep;
            const char* a3 = a2 + kstep; const char* b3 = b2 + kstep;
            if (last && has_next) S.a_ready(nxt);
            PG8_LDB(B0, 0, 0); PG8_SCHED; PG8_LDA(At, 0, 0); PG8_STAGE(PG8_SA(1, 1), a1 + hstep, voffA);
            PG8_WAIT_L(8); PG8_BAR; PG8_WAIT_L(0); PG8_MMA(0, 0, At, B0); PG8_BAR; PG8_SCHED;
            PG8_LDB(B1, 0, 1); PG8_STAGE(PG8_SB(0, 0), b2, voffB);
            PG8_BAR; PG8_WAIT_L(0); PG8_MMA(0, 1, At, B1); PG8_BAR;
            PG8_LDA(At, 0, 1); PG8_STAGE(PG8_SA(0, 0), a2, voffA);
            PG8_BAR; PG8_WAIT_L(0); PG8_MMA(1, 0, At, B0); PG8_BAR; PG8_SCHED;
            PG8_STAGE(PG8_SB(0, 1), b2 + hstep, voffB);
            PG8_WAIT_V(6); PG8_BAR; PG8_MMA(1, 1, At, B1); PG8_BAR;
            PG8_LDB(B0, 1, 0); PG8_SCHED; PG8_LDA(At, 1, 0); PG8_STAGE(PG8_SA(0, 1), a2 + hstep, voffA);
            PG8_WAIT_L(8); PG8_BAR; PG8_WAIT_L(0); PG8_MMA(0, 0, At, B0); PG8_BAR; PG8_SCHED;
            PG8_LDB(B1, 1, 1); PG8_STAGE(PG8_SB(1, 0), b3, voffB);
            PG8_BAR; PG8_WAIT_L(0); PG8_MMA(0, 1, At, B1); PG8_BAR;
            PG8_LDA(At, 1, 1); PG8_STAGE(PG8_SA(1, 0), a3, voffA);
            PG8_BAR; PG8_WAIT_L(0); PG8_MMA(1, 0, At, B0); PG8_BAR; PG8_SCHED;
            PG8_STAGE(PG8_SB(1, 1), b3 + hstep, voffB);
            PG8_WAIT_V(6); PG8_BAR; PG8_MMA(1, 1, At, B1); PG8_BAR;
        }
        PG8_STAMP();
        if constexpr (!Epi::AFTER_DRAIN) { E(acc, cur, wr, wc, fr, fq); S.done(cur); }
        PG8_STAMP();
        if (!has_next) break;
#pragma unroll
        for (int a = 0; a < 2; ++a)
#pragma unroll
            for (int b = 0; b < 2; ++b)
#pragma unroll
                for (int m = 0; m < 4; ++m)
#pragma unroll
                    for (int n = 0; n < 2; ++n) acc[a][b][m][n] = (f32x4){0.f, 0.f, 0.f, 0.f};
        cur = nxt; cA = nA; cB = nB; ++ui;
    }
    PG8_WAIT_V(0);
    if (wr == 0) PG8_BAR;
    PG8_BAR;
    if constexpr (Epi::AFTER_DRAIN) { E.fused(acc, cur, wr, wc, fr, fq, lds, wid, lane); S.done(cur); }
    PG8_STAMP();
    if (STAMP && wid == 0) { stamps[lane] = lane < nts ? (((unsigned long long)(unsigned)ts_hi << 32) | (unsigned)ts_lo) : 0ull;
        if (lane == 62) stamps[62] = rt_entry; if (lane == 63) stamps[63] = (unsigned long long)wall_clock64(); }
#undef PG8_STAMP
#undef PG8_SA
#undef PG8_SB
#undef PG8_STAGE
#undef PG8_LDA
#undef PG8_LDB
#undef PG8_MMA
#undef PG8_WAIT_V
#undef PG8_WAIT_L
#undef PG8_BAR
#undef PG8_SCHED
}
}

#define XB_TMO      128
#define XB_XCNT(j)  (256  + 64 * (j))
#define XB_XSUB(j)  (1280 + 64 * (j))
#define XB_XGEN(j)  (2304 + 64 * (j))
#define XB_TOP      3328
#define XB_TOPGEN   3392
#define XCD_BAR_WORDS 3456
#define XB_SPIN_CAP (1u << 27)
#define LAS __attribute__((address_space(3)))

__device__ __forceinline__ unsigned xb_ld(unsigned* p)              { return __hip_atomic_load(p, __ATOMIC_RELAXED, __HIP_MEMORY_SCOPE_AGENT); }
__device__ __forceinline__ unsigned xb_add(unsigned* p, unsigned v) { return __hip_atomic_fetch_add(p, v, __ATOMIC_RELAXED, __HIP_MEMORY_SCOPE_AGENT); }
__device__ __forceinline__ unsigned xb_xcc_id() { return (unsigned)__builtin_amdgcn_s_getreg((3 << 11) | 20) & 0xFu; }
#define XB_SPIN(cond, bar) do { unsigned _sp = 0; while (cond) { __builtin_amdgcn_s_sleep(1); \
    if ((++_sp & 255u) == 0u) { if (xb_ld(&(bar)[XB_TMO])) break; if (_sp > XB_SPIN_CAP) { atomicAdd(&(bar)[XB_TMO], 1u); break; } } } } while (0)

struct XcdBarrier {
    unsigned* bar; unsigned x;
    volatile LAS unsigned* st;
};

__device__ __forceinline__ XcdBarrier xcd_barrier_post(unsigned* bar, volatile LAS unsigned* st, bool xb_t0) {
    XcdBarrier b; b.bar = bar; b.x = xb_xcc_id(); b.st = st;
    if (xb_t0) (void)xb_add(&bar[XB_XCNT(b.x)], 1u);
    return b;
}
__device__ __forceinline__ void xcd_barrier_complete(unsigned* bar, unsigned x, unsigned& nloc, unsigned& nx) {
    const unsigned G = gridDim.x * gridDim.y * gridDim.z;
    unsigned sum, cnt, mine, sp = 0u;
    for (;;) {
        sum = 0u; cnt = 0u; mine = 0u;
#pragma unroll
        for (unsigned j = 0; j < 16; ++j) { const unsigned c = xb_ld(&bar[XB_XCNT(j)]); sum += c; cnt += (c > 0u) ? 1u : 0u; mine = (j == x) ? c : mine; }
        if (sum == G) break;
        __builtin_amdgcn_s_sleep(1);
        if ((++sp & 255u) == 0u) { if (xb_ld(&bar[XB_TMO])) break; if (sp > XB_SPIN_CAP) { atomicAdd(&bar[XB_TMO], 1u); break; } }
    }
    nloc = mine > 0u ? mine : 1u; nx = cnt > 0u ? cnt : 1u;
}

__device__ __forceinline__ void xcd_barrier(const XcdBarrier& b, bool xb_t0) {
    asm volatile("s_waitcnt vmcnt(0)" ::: "memory");
    __syncthreads();
    if (xb_t0) {
        unsigned* bar = b.bar;
        __builtin_amdgcn_s_waitcnt(0);
        unsigned nloc = b.st[0], nx = b.st[1];
        if (nloc == 0u) { xcd_barrier_complete(bar, b.x, nloc, nx); b.st[0] = nloc; b.st[1] = nx; }
        const unsigned old = xb_add(&bar[XB_XSUB(b.x)], 1u);
        const unsigned gen = old / nloc;
        if (old + 1u == (gen + 1u) * nloc) {
            __builtin_amdgcn_fence(__ATOMIC_RELEASE, "agent");
            asm volatile("s_waitcnt vmcnt(0)" ::: "memory");
            const unsigned og = xb_add(&bar[XB_TOP], 1u);
            const unsigned tg = og / nx;
            if (og + 1u == (tg + 1u) * nx) xb_add(&bar[XB_TOPGEN], 1u);
            else XB_SPIN(xb_ld(&bar[XB_TOPGEN]) == tg, bar);
            __builtin_amdgcn_fence(__ATOMIC_ACQUIRE, "agent");
            xb_add(&bar[XB_XGEN(b.x)], 1u);
            asm volatile("s_waitcnt vmcnt(0)" ::: "memory");
        } else {
            XB_SPIN(xb_ld(&bar[XB_XGEN(b.x)]) == gen, bar);
            __builtin_amdgcn_fence(__ATOMIC_ACQUIRE, "agent");
            asm volatile("s_waitcnt vmcnt(0)" ::: "memory");
        }
    }
    __syncthreads();
}


__device__ void ph_transpose(int wv, const float* __restrict__ src, bf16_t* __restrict__ dst, int K, int N, int Npad,
                             int col0, int skip_from, int skip, int nvalid, float* tile, int bid, int nb,
                             const float* kscale = nullptr, int kscale_n = 0) {
  const int tk = K / 64, tn = Npad / 64;
  const int tid = otid(wv);
  for (int t = bid; t < tk * tn; t += nb) {
    const int kt = t / tn, nt = t % tn;
    __syncthreads();
#pragma unroll
    for (int i = 0; i < 2; ++i) {
      const int idx = tid + i * 512, kk = idx >> 4, n4 = (idx & 15) * 4;
      const int k = kt * 64 + kk, n = nt * 64 + n4;
      const int cc = col0 + n + (n >= skip_from ? skip : 0);
      const float ks = (kscale != nullptr && k < kscale_n) ? kscale[k] : 1.f;
      float4 v = make_float4(0.f, 0.f, 0.f, 0.f);
      if (n < nvalid) v = *(const float4*)(src + (size_t)k * N + cc);
      tile[kk * 65 + n4 + 0] = v.x * ks; tile[kk * 65 + n4 + 1] = v.y * ks; tile[kk * 65 + n4 + 2] = v.z * ks; tile[kk * 65 + n4 + 3] = v.w * ks;
    }
    __syncthreads();
    {
      const int nn = tid >> 3, k8 = (tid & 7) * 8;
      float f[8];
#pragma unroll
      for (int e = 0; e < 8; ++e) f[e] = tile[(k8 + e) * 65 + nn];
      *(uint4*)(dst + (size_t)(nt * 64 + nn) * K + kt * 64 + k8) = make_uint4(pack2(f[0], f[1]), pack2(f[2], f[3]), pack2(f[4], f[5]), pack2(f[6], f[7]));
    }
  }
}

__device__ void ph_mod(int wv, const Params& P, float* sm, int bid, int nb) {
  const int tid = otid(wv);
  float* sv = sm;
  float* red = sm + 5 * 1024;
  for (int i = tid; i < 5 * 1024; i += NTHR) {
    const float v = (i < 4096) ? P.c[i] : P.c_ctx[i - 4096];
    sv[i] = silu_f(v);
  }
  __syncthreads();
  const int c4 = tid & 15, kg = tid >> 4;
  for (int it = bid; it < 192; it += nb) {
    const int layer = it / 96, cb = it % 96;
    const float4* W = (const float4*)(P.ada_w + (size_t)layer * 1024 * MODW + cb * 64) + c4;
    float4 a[5];
#pragma unroll
    for (int r = 0; r < 5; ++r) a[r] = make_float4(0.f, 0.f, 0.f, 0.f);
#pragma unroll 8
    for (int kk = 0; kk < 32; ++kk) {
      const int k = kg * 32 + kk;
      const float4 w = W[(size_t)k * (MODW / 4)];
#pragma unroll
      for (int r = 0; r < 5; ++r) {
        const float s = sv[r * 1024 + k];
        a[r].x += s * w.x; a[r].y += s * w.y; a[r].z += s * w.z; a[r].w += s * w.w;
      }
    }
#pragma unroll
    for (int r = 0; r < 5; ++r) *(float4*)(red + ((kg * 16 + c4) * 5 + r) * 4) = a[r];
    __syncthreads();
    if (tid < 320) {
      const int r = tid >> 6, c = tid & 63;
      float s = 0.f;
      for (int g = 0; g < 32; ++g) s += red[((g * 16 + (c >> 2)) * 5 + r) * 4 + (c & 3)];
      P.mod()[(size_t)(layer * 5 + r) * MODW + cb * 64 + c] = s + P.ada_b[layer * MODW + cb * 64 + c];
    }
    __syncthreads();
  }
}

__device__ void ph_norm(int wv, const float* hl, const float* hc, const float* __restrict__ g, const float* __restrict__ modl,
                        int shift_off, int scale_off, int nrows, bf16_t* __restrict__ dst, int bid, int nb) {
  const int wave = otid(wv) >> 6, lane = otid(wv) & 63;
  const int stride = nb * NWAVE;
  for (int row0 = bid * NWAVE + wave; row0 < nrows; row0 += 2 * stride) {
    const int row1 = row0 + stride;
    const bool two = row1 < nrows;
    const int rows[2] = {row0, two ? row1 : row0};
    f32x4 v[2][4], ggv[4], scv[2][4], shv[2][4];
#pragma unroll
    for (int r = 0; r < 2; ++r) {
      const float* src = hrow(hl, hc, rows[r]);
      const float* mr = modl + (size_t)modrow(rows[r]) * MODW;
#pragma unroll
      for (int i = 0; i < 4; ++i) {
        const int idx = i * 256 + lane * 4;
        v[r][i] = *(const f32x4*)(src + idx);
        scv[r][i] = *(const f32x4*)(mr + scale_off + idx); shv[r][i] = *(const f32x4*)(mr + shift_off + idx);
      }
    }
#pragma unroll
    for (int i = 0; i < 4; ++i) ggv[i] = *(const f32x4*)(g + i * 256 + lane * 4);
#pragma unroll
    for (int r = 0; r < 2; ++r)
#pragma unroll
      for (int i = 0; i < 4; ++i) asm volatile("" : "+v"(v[r][i]), "+v"(scv[r][i]), "+v"(shv[r][i]));
#pragma unroll
    for (int r = 0; r < 2; ++r) {
      float ss = 0.f;
#pragma unroll
      for (int i = 0; i < 4; ++i) ss += v[r][i][0] * v[r][i][0] + v[r][i][1] * v[r][i][1] + v[r][i][2] * v[r][i][2] + v[r][i][3] * v[r][i][3];
      ss = wave_sum(ss);
      const float rstd = rsqrtf(ss * (1.f / 1024.f) + 1e-6f);
      if (r == 0 || two) {
#pragma unroll
        for (int i = 0; i < 4; ++i) {
          const int idx = i * 256 + lane * 4;
          const float o0 = v[r][i][0] * rstd * ggv[i][0] * (1.f + scv[r][i][0]) + shv[r][i][0];
          const float o1 = v[r][i][1] * rstd * ggv[i][1] * (1.f + scv[r][i][1]) + shv[r][i][1];
          const float o2 = v[r][i][2] * rstd * ggv[i][2] * (1.f + scv[r][i][2]) + shv[r][i][2];
          const float o3 = v[r][i][3] * rstd * ggv[i][3] * (1.f + scv[r][i][3]) + shv[r][i][3];
          *(uint2*)(dst + (size_t)rows[r] * DM + idx) = make_uint2(pack2(o0, o1), pack2(o2, o3));
        }
      }
    }
  }
}

__device__ void ph_conv(int wv, const Params& P, int layer, int bid, int nb) {
  const float* cw = P.conv_w + (size_t)layer * 3 * 1536;
  const float* cb = P.conv_b + (size_t)layer * 1536;
  const int total = (NTOK / 4) * 192;
  for (int it = bid * NTHR + otid(wv); it < total; it += nb * NTHR) {
    const int rq = it / 192, c8 = (it % 192) * 8, row0 = rq * 4;
    int l, L;
    if (row0 < NLAT) { l = row0 & 4095; L = 4096; } else { l = (row0 - NLAT) & 255; L = 256; }
    const bf16_t* pc = P.p() + (size_t)row0 * PW + OFF_XBC + c8;
    u32x4_t rv[6];
    rv[0] = *(const u32x4_t*)(pc - (l > 0 ? PW : 0));
#pragma unroll
    for (int i = 0; i < 4; ++i) rv[1 + i] = *(const u32x4_t*)(pc + (size_t)i * PW);
    rv[5] = *(const u32x4_t*)(pc + (size_t)(l + 4 < L ? 4 : 3) * PW);
#pragma unroll
    for (int i = 0; i < 6; ++i) asm volatile("" : "+v"(rv[i]));
    float f[6][8];
#pragma unroll
    for (int i = 0; i < 6; ++i) unpack8(make_uint4(rv[i].x, rv[i].y, rv[i].z, rv[i].w), f[i]);
    const float mp = l > 0 ? 1.f : 0.f, mn = l + 4 < L ? 1.f : 0.f;
    float o[4][8];
#pragma unroll
    for (int e = 0; e < 8; ++e) {
      const int c = c8 + e;
      const float w0 = cw[c], w1 = cw[1536 + c], w2 = cw[3072 + c], bb = cb[c];
#pragma unroll
      for (int i = 0; i < 4; ++i) {
        const float pv = i == 0 ? mp * f[0][e] : f[i][e];
        const float nv = i == 3 ? mn * f[5][e] : f[i + 2][e];
        o[i][e] = silu_f(bb + w0 * pv + w1 * f[i + 1][e] + w2 * nv);
      }
    }
    if (c8 < 1024) {
      const int head = c8 >> 6, p0 = c8 & 63;
      bf16_t* dst = P.xt4() + (((size_t)head * (NTOK / 4) + rq) * 64 + p0) * 4;
#pragma unroll
      for (int e2 = 0; e2 < 4; ++e2)
        *(uint4*)(dst + e2 * 8) = make_uint4(pack2(o[0][2 * e2], o[1][2 * e2]), pack2(o[2][2 * e2], o[3][2 * e2]),
                                             pack2(o[0][2 * e2 + 1], o[1][2 * e2 + 1]), pack2(o[2][2 * e2 + 1], o[3][2 * e2 + 1]));
    } else {
      {
        const int cc = (c8 - 1024) & 255, grp_ = cc >> 7, n0_ = cc & 127;
        bf16_t* fb = (c8 < 1280 ? P.bfr() : P.cfr()) + ((((size_t)grp_ * (NTOK / 16) + (row0 >> 4)) * 4 + (n0_ >> 5)) * 16 + (row0 & 15)) * 32 + (n0_ & 31);
#pragma unroll
        for (int i = 0; i < 4; ++i)
          *(uint4*)(fb + i * 32) = make_uint4(pack2(o[i][0], o[i][1]), pack2(o[i][2], o[i][3]), pack2(o[i][4], o[i][5]), pack2(o[i][6], o[i][7]));
      }
      if (c8 < 1280) {
        const int grp = (c8 - 1024) >> 7, n0 = (c8 - 1024) & 127;
        bf16_t* dst = P.bt4() + (((size_t)grp * (NTOK / 4) + rq) * 128 + n0) * 4;
#pragma unroll
        for (int e2 = 0; e2 < 4; ++e2)
          *(uint4*)(dst + e2 * 8) = make_uint4(pack2(o[0][2 * e2], o[1][2 * e2]), pack2(o[2][2 * e2], o[3][2 * e2]),
                                               pack2(o[0][2 * e2 + 1], o[1][2 * e2 + 1]), pack2(o[2][2 * e2 + 1], o[3][2 * e2 + 1]));
      }
    }
  }
}

__device__ void ph_dtprep(int wv, const Params& P, int layer, char* smem, int first, int step) {
  const int tid = otid(wv), lane = tid & 63, li = lane & 15, g = lane >> 4;
  float* tile = (float*)smem;
  float* segtot = tile + 128 * 33;
  const int dh = tid & 31, seg = tid >> 5;
  const float bias = P.dt_bias[layer * 32 + dh];
  const float ah = -expf(P.a_log[layer * 32 + dh]);
  const bf16_t* wb = P.w_dtT() + (size_t)layer * 128 * 1024 + (size_t)li * 1024 + 8 * g;
  for (int gc = first; gc < NCHUNK; gc += step) {
    const bf16_t* ua = P.u() + (size_t)(gc * 128 + wv * 16 + li) * DM + 8 * g;
    f32x4 acc0 = (f32x4){0.f, 0.f, 0.f, 0.f}, acc1 = acc0;
#pragma unroll 1
    for (int t0 = 0; t0 < 32; t0 += 8) {
      bf16x8 a[8], b0[8], b1[8];
#pragma unroll
      for (int t = 0; t < 8; ++t) {
        a[t] = *(const bf16x8*)(ua + 32 * (t0 + t));
        b0[t] = *(const bf16x8*)(wb + 32 * (t0 + t));
        b1[t] = *(const bf16x8*)(wb + 16 * 1024 + 32 * (t0 + t));
      }
#pragma unroll
      for (int t = 0; t < 8; ++t) asm volatile("" : "+v"(a[t]), "+v"(b0[t]), "+v"(b1[t]));
#pragma unroll
      for (int t = 0; t < 8; ++t) {
        acc0 = __builtin_amdgcn_mfma_f32_16x16x32_bf16(a[t], b0[t], acc0, 0, 0, 0);
        acc1 = __builtin_amdgcn_mfma_f32_16x16x32_bf16(a[t], b1[t], acc1, 0, 0, 0);
      }
    }
    __syncthreads();
#pragma unroll
    for (int e = 0; e < 4; ++e) {
      tile[(wv * 16 + 4 * g + e) * 33 + li] = acc0[e];
      tile[(wv * 16 + 4 * g + e) * 33 + 16 + li] = acc1[e];
    }
    __syncthreads();
    float r[8], c[8];
    float cs = 0.f;
#pragma unroll
    for (int j = 0; j < 8; ++j) { r[j] = softplus_f(tile[(seg * 8 + j) * 33 + dh] + bias); cs += r[j] * ah; c[j] = cs; }
    segtot[seg * 32 + dh] = cs;
    __syncthreads();
    float off = 0.f, tot = 0.f;
    for (int s = 0; s < 16; ++s) { const float v = segtot[s * 32 + dh]; if (s < seg) off += v; tot += v; }
    const size_t base = ((size_t)(gc * 32 + dh) * 128 + seg * 8);
    float cso[8], wso[8];
#pragma unroll
    for (int j = 0; j < 8; ++j) {
      const float csj = off + c[j], csp = j == 0 ? off : off + c[j - 1];
      cso[j] = dh < 16 ? csj : csp;
      wso[j] = r[j] * (dh < 16 ? fexp(tot - csj) : fexp(csp));
    }
#pragma unroll
    for (int q = 0; q < 2; ++q) {
      *(float4*)(P.cst() + base + q * 4) = make_float4(cso[q * 4], cso[q * 4 + 1], cso[q * 4 + 2], cso[q * 4 + 3]);
      *(float4*)(P.dtt() + base + q * 4) = make_float4(r[q * 4], r[q * 4 + 1], r[q * 4 + 2], r[q * 4 + 3]);
      *(float4*)(P.wst() + base + q * 4) = make_float4(wso[q * 4], wso[q * 4 + 1], wso[q * 4 + 2], wso[q * 4 + 3]);
    }
    if (seg == 0) P.atot()[gc * 32 + dh] = tot;
  }
}

__device__ __forceinline__ int scan_chunk(int b, int dir, int s) {
  if (dir == 0) return (s < 2) ? (128 + 2 * b + s) : (32 * b + (s - 2));
  return (s < 2) ? (128 + 2 * b + 1 - s) : (32 * b + 31 - (s - 2));
}
__device__ void ph_scan(int wv, const Params& P, int bid, int nb) {
  const int total = 4 * 32 * 1024;
  for (int it = bid * NTHR + otid(wv); it < total; it += nb * NTHR) {
    const int e8 = it & 1023, dh = (it >> 10) & 31, b = it >> 15, dir = dh >> 4;
    float S[8];
    float zero_ = 0.f;
    asm volatile("" : "+v"(zero_));
#pragma unroll
    for (int i = 0; i < 8; ++i) S[i] = zero_;
#pragma unroll
    for (int hb = 0; hb < 2; ++hb) {
      u32x4_t v[17];
      float at[17];
#pragma unroll
      for (int s = 0; s < 17; ++s) {
        const int gc = scan_chunk(b, dir, hb * 17 + s);
        v[s] = *(const u32x4_t*)(P.states() + (size_t)(gc * 32 + dh) * 8192 + e8 * 8);
        at[s] = P.atot()[gc * 32 + dh];
      }
#pragma unroll
      for (int s = 0; s < 17; ++s) asm volatile("" : "+v"(v[s]));
#pragma unroll
      for (int s = 0; s < 17; ++s) {
        const int gc = scan_chunk(b, dir, hb * 17 + s);
        const float dec = fexp(at[s]);
        float cst[8];
        unpack8(make_uint4(v[s].x, v[s].y, v[s].z, v[s].w), cst);
        *(uint4*)(P.states() + (size_t)(gc * 32 + dh) * 8192 + e8 * 8) =
            make_uint4(pack2(S[0], S[1]), pack2(S[2], S[3]), pack2(S[4], S[5]), pack2(S[6], S[7]));
#pragma unroll
        for (int i = 0; i < 8; ++i) S[i] = dec * S[i] + cst[i];
      }
    }
  }
}

__device__ __forceinline__ void conv_x8(const Params& P, int layer, int row, int ch0, float* out) {
  int l, L;
  if (row < NLAT) { l = row & 4095; L = 4096; } else { l = (row - NLAT) & 255; L = 256; }
  const bf16_t* pc = P.p() + (size_t)row * PW + OFF_XBC + ch0;
  const uint4 cur = *(const uint4*)pc;
  const uint4 prv = *(const uint4*)(pc - (l > 0 ? PW : 0));
  const uint4 nxt = *(const uint4*)(pc + (l < L - 1 ? PW : 0));
  const float mp = l > 0 ? 1.f : 0.f, mn = l < L - 1 ? 1.f : 0.f;
  float fp[8], fc[8], fn[8];
  unpack8(prv, fp); unpack8(cur, fc); unpack8(nxt, fn);
  const float* cw = P.conv_w + (size_t)layer * 3 * 1536 + ch0;
  const float* cb = P.conv_b + (size_t)layer * 1536 + ch0;
#pragma unroll
  for (int e = 0; e < 8; ++e) out[e] = silu_f(cb[e] + cw[e] * (mp * fp[e]) + cw[1536 + e] * fc[e] + cw[3072 + e] * (mn * fn[e]));
}

constexpr int XS = 72;
constexpr int BS = 136;


__device__ __forceinline__ bool ssd_item(int round, int bid, int nb, int nchunks, int& gc, int& head) {
  if ((nb & 63) == 0) {
    const int x = bid & 7, j = bid >> 3, per = nb >> 6;
    const int cg = (round * per + (j >> 3)) * 8 + x;
    if (cg >= nchunks * 2) return false;
    gc = cg >> 1; head = (cg & 1) * 8 + (j & 7);
    return true;
  }
  const int it = round * nb + bid;
  if (it >= nchunks * 16) return false;
  gc = it >> 4; head = it & 15;
  return true;
}

__device__ void ph_states_mfma(int wv, const Params& P, int layer, char* smem, int bid, int nb) {
  const int lane = otid(wv) & 63, li = lane & 15, g = lane >> 4;
  const int nq = wv >> 1, ph = wv & 1;
  for (int round = 0;; ++round) {
    int gc, head;
    if (!ssd_item(round, bid, nb, NCHUNK, gc, head)) break;
    const int grp = head >> 3, q0 = gc * 32;
    const bf16_t* xb = P.xt4() + (((size_t)head * (NTOK / 4) + q0 + g) * 64 + ph * 32 + li) * 4;
    const bf16_t* bb = P.bt4() + (((size_t)grp * (NTOK / 4) + q0 + g) * 128 + nq * 32 + li) * 4;
    const float* wpf = P.wst() + (size_t)(gc * 32 + head) * 128 + 4 * g;
    const float* wpb = wpf + 16 * 128;
    f32x4 acc[2][2][2];
#pragma unroll
    for (int d = 0; d < 2; ++d)
#pragma unroll
      for (int a = 0; a < 2; ++a)
#pragma unroll
        for (int b = 0; b < 2; ++b) acc[d][a][b] = (f32x4){0.f, 0.f, 0.f, 0.f};
#pragma unroll
    for (int t = 0; t < 4; ++t) {
      s16x4 alo[2], ahi[2], xlo[2], xhi[2];
      f32x4 wfl, wfh, wbl, wbh;
#pragma unroll
      for (int i = 0; i < 2; ++i) {
        alo[i] = *(const s16x4*)(bb + ((size_t)(t * 8) * 128 + i * 16) * 4);
        ahi[i] = *(const s16x4*)(bb + ((size_t)(t * 8 + 4) * 128 + i * 16) * 4);
        xlo[i] = *(const s16x4*)(xb + ((size_t)(t * 8) * 64 + i * 16) * 4);
        xhi[i] = *(const s16x4*)(xb + ((size_t)(t * 8 + 4) * 64 + i * 16) * 4);
      }
      wfl = *(const f32x4*)(wpf + 32 * t); wfh = *(const f32x4*)(wpf + 32 * t + 16);
      wbl = *(const f32x4*)(wpb + 32 * t); wbh = *(const f32x4*)(wpb + 32 * t + 16);
      asm volatile("" : "+v"(alo[0]), "+v"(alo[1]), "+v"(ahi[0]), "+v"(ahi[1]));
      bf16x8 af[2];
#pragma unroll
      for (int i = 0; i < 2; ++i) af[i] = (bf16x8){alo[i][0], alo[i][1], alo[i][2], alo[i][3], ahi[i][0], ahi[i][1], ahi[i][2], ahi[i][3]};
#pragma unroll
      for (int d = 0; d < 2; ++d) {
        const f32x4 wl = d == 0 ? wfl : wbl, wh = d == 0 ? wfh : wbh;
#pragma unroll
        for (int b = 0; b < 2; ++b) {
          bf16x8 bfrag;
#pragma unroll
          for (int i = 0; i < 4; ++i) {
            bfrag[i] = (short)f2bf(bf2f((bf16_t)xlo[b][i]) * wl[i]);
            bfrag[4 + i] = (short)f2bf(bf2f((bf16_t)xhi[b][i]) * wh[i]);
          }
#pragma unroll
          for (int a = 0; a < 2; ++a) acc[d][a][b] = __builtin_amdgcn_mfma_f32_16x16x32_bf16(af[a], bfrag, acc[d][a][b], 0, 0, 0);
        }
      }
    }
#pragma unroll
    for (int d = 0; d < 2; ++d) {
      bf16_t* dst = P.states() + (size_t)(gc * 32 + d * 16 + head) * 8192;
#pragma unroll
      for (int a = 0; a < 2; ++a)
#pragma unroll
        for (int b = 0; b < 2; ++b) {
          uint2 o;
          o.x = pack2(acc[d][a][b][0], acc[d][a][b][1]); o.y = pack2(acc[d][a][b][2], acc[d][a][b][3]);
          *(uint2*)(dst + ((nq * 4 + 2 * ph + b) * 16 + li) * 32 + 16 * a + 4 * g) = o;
        }
    }
  }
}

__device__ void ph_ssdy_mfma(int wv, const Params& P, int layer, int nchunks, char* smem, int bid, int nb) {
  const int tid = otid(wv), lane = tid & 63, li = lane & 15, g = lane >> 4;
  float* tabs = (float*)smem;
  char* bbuf = smem + 4096;
  char* xbuf = bbuf + 65536;
  char* sbufS = xbuf + 32768;
  u32x4_t pf[10];
  float pft = 0.f;
#pragma unroll
  for (int i = 0; i < 10; ++i) pf[i] = (u32x4_t){0u, 0u, 0u, 0u};
#define SSDY_FETCH(gc_, head_) do { const int grp_ = (head_) >> 3; \
      const char* bsrc_ = (const char*)(P.bfr() + ((size_t)grp_ * (NTOK / 16) + (gc_) * 8) * 4 * 16 * 32); \
      const char* xsrc_ = (const char*)(P.xt4() + ((size_t)(head_) * (NTOK / 4) + (gc_) * 32) * 64 * 4); \
      _Pragma("unroll") for (int i_ = 0; i_ < 4; ++i_) pf[i_] = *(const u32x4_t*)(bsrc_ + (size_t)(tid + i_ * 512) * 16); \
      _Pragma("unroll") for (int i_ = 0; i_ < 2; ++i_) pf[4 + i_] = *(const u32x4_t*)(xsrc_ + (size_t)(tid + i_ * 512) * 16); \
      _Pragma("unroll") for (int i_ = 0; i_ < 4; ++i_) { const int c_ = tid + i_ * 512; \
        pf[6 + i_] = *(const u32x4_t*)((const char*)(P.states() + (size_t)((gc_) * 32 + (c_ >> 10) * 16 + (head_)) * 8192) + (size_t)(c_ & 1023) * 16); } \
      { const int arr_ = tid >> 7, j_ = tid & 127; \
        pft = ((arr_ & 1) ? P.dtt() : P.cst())[(size_t)((gc_) * 32 + (arr_ >> 1) * 16 + (head_)) * 128 + j_]; } } while (0)
#define SSDY_PUT_S() do { _Pragma("unroll") for (int i_ = 0; i_ < 4; ++i_) *(u32x4_t*)(sbufS + (size_t)(tid + i_ * 512) * 16) = pf[6 + i_]; } while (0)
#define SSDY_PUT_BX(buf_) do { \
      _Pragma("unroll") for (int i_ = 0; i_ < 4; ++i_) *(u32x4_t*)(bbuf + (buf_) * 32768 + (size_t)(tid + i_ * 512) * 16) = pf[i_]; \
      _Pragma("unroll") for (int i_ = 0; i_ < 2; ++i_) *(u32x4_t*)(xbuf + (buf_) * 16384 + (size_t)(tid + i_ * 512) * 16) = pf[4 + i_]; \
      tabs[(buf_) * 512 + tid] = pft; } while (0)
  {
    int gc0 = 0, head0 = 0;
    __syncthreads();
    if (ssd_item(0, bid, nb, nchunks, gc0, head0)) { SSDY_FETCH(gc0, head0); SSDY_PUT_BX(0); SSDY_PUT_S(); }
    __syncthreads();
  }
  for (int round = 0;; ++round) {
    int gc, head;
    if (!ssd_item(round, bid, nb, nchunks, gc, head)) break;
    const int grp = head >> 3, row0 = gc * 128;
    const char* bs = bbuf + (round & 1) * 32768;
    const char* xs_l = xbuf + (round & 1) * 16384;
    const float* csf = tabs + (round & 1) * 512;
    const float* dtf = csf + 128;
    const float* exb = csf + 256;
    const float* dtb = csf + 384;
    int gcn = 0, headn = 0;
    const bool has_next = ssd_item(round + 1, bid, nb, nchunks, gcn, headn);
    if (has_next) SSDY_FETCH(gcn, headn);
    const float atb = P.atot()[gc * 32 + 16 + head];
    bf16x8 cfrag[4];
    {
      const bf16_t* cp = P.cfr() + ((((size_t)grp * (NTOK / 16) + gc * 8 + wv) * 4) * 16 + li) * 32 + 8 * g;
#pragma unroll
      for (int t = 0; t < 4; ++t) cfrag[t] = *(const bf16x8*)(cp + t * 512);
    }
    f32x4 accG[8];
#pragma unroll
    for (int sb = 0; sb < 8; ++sb) accG[sb] = (f32x4){0.f, 0.f, 0.f, 0.f};
#pragma unroll
    for (int sp = 0; sp < 4; ++sp) {
      bf16x8 bfv[8];
#pragma unroll
      for (int i = 0; i < 8; ++i) {
        const int sb = sp * 2 + (i >> 2), t = i & 3;
        bfv[i] = *(const bf16x8*)(bs + (((sb * 4 + t) * 16 + li) * 32 + 8 * g) * 2);
      }
#pragma unroll
      for (int i = 0; i < 8; ++i) {
        const int sb = sp * 2 + (i >> 2), t = i & 3;
        accG[sb] = __builtin_amdgcn_mfma_f32_16x16x32_bf16(bfv[i], cfrag[t], accG[sb], 0, 0, 0);
      }
    }
    f32x4 accY[4];
#pragma unroll
    for (int pb = 0; pb < 4; ++pb) accY[pb] = (f32x4){0.f, 0.f, 0.f, 0.f};
    const int jl = 16 * wv + li;
    const float csf_j = csf[jl], exb_j = exb[jl];
#pragma unroll
    for (int dir = 0; dir < 2; ++dir) {
      f32x4 accO[4];
#pragma unroll
      for (int pb = 0; pb < 4; ++pb) accO[pb] = (f32x4){0.f, 0.f, 0.f, 0.f};
      const char* st = sbufS + dir * 16384;
#pragma unroll
      for (int th = 0; th < 2; ++th) {
        bf16x8 sfr[8];
#pragma unroll
        for (int i = 0; i < 8; ++i) sfr[i] = *(const bf16x8*)(st + (((th * 2 + (i >> 2)) * 4 + (i & 3)) * 512 + li * 32 + 8 * g) * 2);
#pragma unroll
        for (int tt = 0; tt < 2; ++tt)
#pragma unroll
          for (int pb = 0; pb < 4; ++pb) accO[pb] = __builtin_amdgcn_mfma_f32_16x16x32_bf16(cfrag[th * 2 + tt], sfr[tt * 4 + pb], accO[pb], 0, 0, 0);
      }
#pragma unroll
      for (int e = 0; e < 4; ++e) {
        const int j = 16 * wv + 4 * g + e;
        const float sc = dir == 0 ? fexp(csf[j]) : fexp(atb - exb[j]);
#pragma unroll
        for (int pb = 0; pb < 4; ++pb) accY[pb][e] += accO[pb][e] * sc;
      }
    }
    __syncthreads();
    if (has_next) SSDY_PUT_S();
    const char* xq = xs_l + ((g * 64 + li) * 4) * 2;
#pragma unroll
    for (int t = 0; t < 4; ++t) {
      const bool need_f = !(32 * t > 16 * wv + 15), need_b = !(32 * t + 31 < 16 * wv);
      if (!need_f && !need_b) continue;
      s16x4 xlo[4], xhi[4];
#pragma unroll
      for (int pb = 0; pb < 4; ++pb) {
        xlo[pb] = *(const s16x4*)(xq + (((8 * t) * 64 + 16 * pb) * 4) * 2);
        xhi[pb] = *(const s16x4*)(xq + (((8 * t + 4) * 64 + 16 * pb) * 4) * 2);
      }
#pragma unroll
      for (int dir = 0; dir < 2; ++dir) {
        if (dir == 0 ? !need_f : !need_b) continue;
        bf16x8 afrag;
#pragma unroll
        for (int hh = 0; hh < 2; ++hh) {
          const int s0 = 32 * t + 16 * hh + 4 * g;
          const f32x4 gv = accG[2 * t + hh];
          const f32x4 cv = dir == 0 ? *(const f32x4*)(csf + s0) : *(const f32x4*)(exb + s0);
          const f32x4 dv = dir == 0 ? *(const f32x4*)(dtf + s0) : *(const f32x4*)(dtb + s0);
#pragma unroll
          for (int e = 0; e < 4; ++e) {
            const int s = s0 + e;
            float m;
            if (dir == 0) m = (s <= jl) ? gv[e] * dv[e] * fexp(csf_j - cv[e]) : 0.f;
            else m = (s >= jl) ? gv[e] * dv[e] * fexp(cv[e] - exb_j) : 0.f;
            afrag[hh * 4 + e] = (short)f2bf(m);
          }
        }
#pragma unroll
        for (int pb = 0; pb < 4; ++pb) {
          const bf16x8 bfr2 = (bf16x8){xlo[pb][0], xlo[pb][1], xlo[pb][2], xlo[pb][3], xhi[pb][0], xhi[pb][1], xhi[pb][2], xhi[pb][3]};
          accY[pb] = __builtin_amdgcn_mfma_f32_16x16x32_bf16(afrag, bfr2, accY[pb], 0, 0, 0);
        }
      }
    }
    const float dsk = P.d_skip[layer * 16 + head];
    s16x4 xs[4];
#pragma unroll
    for (int pb = 0; pb < 4; ++pb) xs[pb] = *(const s16x4*)(xs_l + ((((4 * wv + g) * 64 + 16 * pb + li) * 4) * 2));
    unsigned zv[16];
#pragma unroll
    for (int e = 0; e < 4; ++e)
#pragma unroll
      for (int pb = 0; pb < 4; ++pb)
        zv[e * 4 + pb] = P.p()[(size_t)(row0 + 16 * wv + 4 * g + e) * PW + OFF_Z + head * 64 + 16 * pb + li];
#pragma unroll
    for (int i = 0; i < 16; ++i) asm volatile("" : "+v"(zv[i]));
#pragma unroll
    for (int e = 0; e < 4; ++e) {
      const int row = row0 + 16 * wv + 4 * g + e;
      float sq = 0.f;
#pragma unroll
      for (int pb = 0; pb < 4; ++pb) {
        const float xv = bf2f((bf16_t)xs[pb][e]);
        const float z = bf2f((bf16_t)zv[e * 4 + pb]);
        const bf16_t yb = f2bf((accY[pb][e] + dsk * xv) * silu_f(z));
        P.concat()[(size_t)row * 2048 + head * 64 + 16 * pb + li] = yb;
        const float yf = bf2f(yb);
        sq += yf * yf;
      }
      sq += DPP_F(sq, 0xB1); sq += DPP_F(sq, 0x4E); sq += DPP_F(sq, 0x141); sq += DPP_F(sq, 0x140);
      if (li == 0) P.yss()[(size_t)row * 16 + head] = sq;
    }
    if (has_next) SSDY_PUT_BX((round + 1) & 1);
    __syncthreads();
  }
#undef SSDY_FETCH
#undef SSDY_PUT_S
#undef SSDY_PUT_BX
}

template <int W>
__device__ __forceinline__ void pool_frags(const bf16_t* pc, int l, int L, float rc, bf16x8 (&af)[4]) {
#pragma unroll
  for (int t = 0; t < 4; ++t) {
    constexpr int WB = W < 8 ? W : 8;
    float s[8], f[8];
#pragma unroll
    for (int e = 0; e < 8; ++e) s[e] = 0.f;
    const u32x4_t own = *(const u32x4_t*)(pc + 32 * t);
#pragma unroll
    for (int ob = 0; ob < W; ob += WB) {
      u32x4_t rows[WB];
#pragma unroll
      for (int o = 0; o < WB; ++o) {
        const int rr = l - W / 2 + ob + o;
        const int rcl = (rr >= 0 && rr < L) ? rr : l;
        rows[o] = *(const u32x4_t*)(pc + (ptrdiff_t)(rcl - l) * PW + 32 * t);
      }
#pragma unroll
      for (int o = 0; o < WB; ++o) asm volatile("" : "+v"(rows[o]));
#pragma unroll
      for (int o = 0; o < WB; ++o) {
        const int rr = l - W / 2 + ob + o;
        const float mk = (rr >= 0 && rr < L) ? 1.f : 0.f;
        unpack8(make_uint4(rows[o].x, rows[o].y, rows[o].z, rows[o].w), f);
#pragma unroll
        for (int e = 0; e < 8; ++e) s[e] += mk * f[e];
      }
    }
    unpack8(make_uint4(own.x, own.y, own.z, own.w), f);
#pragma unroll
    for (int e = 0; e < 8; ++e) af[t][e] = (short)f2bf(s[e] * rc - f[e]);
  }
}
__device__ void ph_pool_mfma(int wv, const Params& P, int layer, int nrows, char* smem, int bid, int nb) {
  const int lane = otid(wv) & 63, li = lane & 15, g = lane >> 4;
  bf16_t* stg = (bf16_t*)(smem + 65536) + wv * (16 * 136);
  const int nitems = (nrows / 16) * 4;
  for (int it = bid * NWAVE + wv; it < nitems; it += nb * NWAVE) {
    const int gi = it & 3, row0 = (it >> 2) * 16, w = 2 << gi;
    const int row = row0 + li;
    int l, L;
    if (row < NLAT) { l = row & 4095; L = 4096; } else { l = (row - NLAT) & 255; L = 256; }
    int lo = l - w / 2; lo = lo < 0 ? 0 : lo;
    int hi = l + w - w / 2 - 1; hi = hi > L - 1 ? L - 1 : hi;
    const float rc = 1.f / (float)(hi - lo + 1);
    const bf16_t* pc = P.p() + (size_t)row * PW + OFF_POOL + gi * 128 + 8 * g;
    bf16x8 af[4];
    if (gi == 0) pool_frags<2>(pc, l, L, rc, af);
    else if (gi == 1) pool_frags<4>(pc, l, L, rc, af);
    else if (gi == 2) pool_frags<8>(pc, l, L, rc, af);
    else pool_frags<16>(pc, l, L, rc, af);
    const bf16_t* wt = P.poolwT() + ((size_t)(layer * 4 + gi) * 128 + li) * 128 + 8 * g;
    const float* sc = P.pool_scale + layer * 512 + gi * 128;
#pragma unroll
    for (int nh = 0; nh < 4; ++nh) {
      bf16x8 wf[2][4];
#pragma unroll
      for (int n = 0; n < 2; ++n)
#pragma unroll
        for (int t = 0; t < 4; ++t) wf[n][t] = *(const bf16x8*)(wt + (size_t)(nh * 2 + n) * 16 * 128 + 32 * t);
#pragma unroll
      for (int n = 0; n < 2; ++n)
#pragma unroll
        for (int t = 0; t < 4; ++t) asm volatile("" : "+v"(wf[n][t]));
#pragma unroll
      for (int n = 0; n < 2; ++n) {
        const int nt = nh * 2 + n;
        f32x4 acc = (f32x4){0.f, 0.f, 0.f, 0.f};
#pragma unroll
        for (int t = 0; t < 4; ++t) acc = __builtin_amdgcn_mfma_f32_16x16x32_bf16(af[t], wf[n][t], acc, 0, 0, 0);
        const float scv = sc[nt * 16 + li];
#pragma unroll
        for (int e = 0; e < 4; ++e) stg[(4 * g + e) * 136 + nt * 16 + li] = f2bf(acc[e] * scv);
      }
    }
    __builtin_amdgcn_wave_barrier();
#pragma unroll
    for (int i = 0; i < 4; ++i) {
      const int c = i * 64 + lane, rr = c >> 4, c8 = (c & 15) * 8;
      *(uint4*)(P.concat() + (size_t)(row0 + rr) * 2048 + 1024 + gi * 128 + c8) = *(const uint4*)(stg + rr * 136 + c8);
    }
    __builtin_amdgcn_wave_barrier();
  }
}

__device__ void ph_vtranspose(int wv, const Params& P, char* smem, int bid, int nb) {
  const int lane = otid(wv) & 63;
  bf16_t* tile = (bf16_t*)smem + wv * 64 * 72;
  for (int it = bid * NWAVE + wv; it < 272 * 8; it += nb * NWAVE) {
    const int hd = it & 7, tt = it >> 3, row0 = tt * 64;
    const bf16_t* src = P.p() + (size_t)(row0 + lane) * PW + OFF_V + hd * 64;
#pragma unroll
    for (int i = 0; i < 8; ++i) *(uint4*)(tile + lane * 72 + i * 8) = *(const uint4*)(src + i * 8);
    __builtin_amdgcn_wave_barrier();
    bf16_t* dst;
    if (row0 < NLAT) dst = P.vtl() + (size_t)((row0 >> 12) * 8 + hd) * 64 * 4096 + ((size_t)((row0 & 4095) >> 2) * 64 + lane) * 4;
    else dst = P.vtc() + (size_t)(((row0 - NLAT) >> 8) * 8 + hd) * 64 * 256 + ((size_t)(((row0 - NLAT) & 255) >> 2) * 64 + lane) * 4;
#pragma unroll
    for (int i = 0; i < 16; ++i) {
      uint2 w;
      w.x = (uint32_t)tile[(i * 4 + 0) * 72 + lane] | ((uint32_t)tile[(i * 4 + 1) * 72 + lane] << 16);
      w.y = (uint32_t)tile[(i * 4 + 2) * 72 + lane] | ((uint32_t)tile[(i * 4 + 3) * 72 + lane] << 16);
      *(uint2*)(dst + (size_t)i * 64 * 4) = w;
    }
    __builtin_amdgcn_wave_barrier();
    {
      const bf16_t* ksrc = P.p() + (size_t)(row0 + lane) * PW + OFF_K + hd * 64;
      u32x4_t kv[8];
#pragma unroll
      for (int i = 0; i < 8; ++i) kv[i] = *(const u32x4_t*)(ksrc + i * 8);
      bf16_t* kd;
      int tk;
      if (row0 < NLAT) { tk = (row0 & 4095) + lane; kd = P.ktl() + (size_t)((row0 >> 12) * 8 + hd) * 4096 * 64; }
      else { tk = ((row0 - NLAT) & 255) + lane; kd = P.ktc() + (size_t)(((row0 - NLAT) >> 8) * 8 + hd) * 256 * 64; }
#pragma unroll
      for (int i = 0; i < 8; ++i)
        *(u32x4_t*)(kd + ((size_t)((tk >> 3) * 2 + (i >> 2)) * 8 + (tk & 7)) * 32 + (i & 3) * 8) = kv[i];
    }
  }
}

__device__ __forceinline__ float grp_max(float v) {
  auto a = __builtin_amdgcn_permlane16_swap(__float_as_uint(v), __float_as_uint(v), false, false);
  v = fmaxf(__uint_as_float(a[0]), __uint_as_float(a[1]));
  auto b = __builtin_amdgcn_permlane32_swap(__float_as_uint(v), __float_as_uint(v), false, false);
  return fmaxf(__uint_as_float(b[0]), __uint_as_float(b[1]));
}
__device__ __forceinline__ float grp_sum(float v) {
  auto a = __builtin_amdgcn_permlane16_swap(__float_as_uint(v), __float_as_uint(v), false, false);
  v = __uint_as_float(a[0]) + __uint_as_float(a[1]);
  auto b = __builtin_amdgcn_permlane32_swap(__float_as_uint(v), __float_as_uint(v), false, false);
  return __uint_as_float(b[0]) + __uint_as_float(b[1]);
}

__device__ void ph_na_mfma(int wv, const Params& P, int layer, int nrows, char* smem, int bid, int nb) {
  const int lane = otid(wv) & 63, li = lane & 15, g = lane >> 4;
  float* btab = (float*)smem + wv * 256;
  const float* rpb = P.na_rpb + (size_t)layer * 8 * 15 * 31;
  const int n_lat = 4 * 64 * 8 * 4;
  const int n_items = n_lat + (nrows > NLAT ? 4 * 16 * 8 : 0);
  const int nrank = nb >> 3;
  const bool xmap = ((nb & 7) == 0) && nrank > 0 && (1024 % nrank) == 0 && (64 % nrank) == 0;
  const int per_lat = xmap ? 1024 / nrank : 0, per_ctx = (xmap && nrows > NLAT) ? 64 / nrank : 0;
  const int q_begin = xmap ? wv : bid * NWAVE + wv, q_end = xmap ? per_lat + per_ctx : n_items, q_step = xmap ? NWAVE : nb * NWAVE;
  for (int q = q_begin; q < q_end; q += q_step) {
    bool lat;
    int b, hd, qrow0, r = 0, cq0 = 0, r0 = 0, cs = 0, qt;
    if (xmap) {
      hd = bid & 7;
      const int rank = bid >> 3;
      lat = q < per_lat;
      if (lat) { const int i = rank * per_lat + q; qt = i & 3; r = (i >> 2) & 63; b = i >> 8; }
      else { const int c = rank * per_ctx + (q - per_lat); qt = c & 15; b = c >> 4; }
    } else {
      lat = q < n_lat;
      if (lat) { qt = q & 3; hd = (q >> 2) & 7; r = (q >> 5) & 63; b = q >> 11; }
      else { const int t = q - n_lat; hd = t & 7; qt = (t >> 3) & 15; b = t >> 7; }
    }
    if (lat) {
      cq0 = qt * 16; qrow0 = b * 4096 + r * 64 + cq0;
      r0 = r - 4; r0 = r0 < 0 ? 0 : (r0 > 56 ? 56 : r0);
      int clo = cq0 - 8; clo = clo < 0 ? 0 : (clo > 48 ? 48 : clo);
      cs = clo < 32 ? clo : 32;
    } else {
      qrow0 = NLAT + b * 256 + qt * 16;
    }
    const bf16_t* qp = P.p() + (size_t)(qrow0 + li) * PW + OFF_Q + hd * 64 + 8 * g;
    const bf16x8 qf0 = *(const bf16x8*)qp, qf1 = *(const bf16x8*)(qp + 32);
    __builtin_amdgcn_wave_barrier();
#pragma unroll
    for (int i = 0; i < 4; ++i) {
      const int e_ = i * 64 + lane, kr_ = e_ >> 5, dc_ = e_ & 31;
      int dr_ = r0 + kr_ - r + 7; dr_ = dr_ < 0 ? 0 : (dr_ > 14 ? 14 : dr_);
      btab[e_] = rpb[(hd * 15 + dr_) * 31 + (dc_ < 31 ? dc_ : 30)];
    }
    __builtin_amdgcn_wave_barrier();
    f32x4 accS[16], accC[16];
    const int k_lane = ((li >> 3) * 16 + (li & 7)) * 32 + 8 * g;
    const bf16_t* klb = P.ktl() + (size_t)(b * 8 + hd) * 4096 * 64 + k_lane;
    const bf16_t* kcb = P.ktc() + (size_t)(b * 8 + hd) * 256 * 64 + k_lane;
#define NA_KPTR(tile) ((tile) < 16 ? klb + ((r0 + ((tile) >> 1)) * 64 + cs + 16 * ((tile) & 1)) * 64 : kcb + (16 * ((tile) - 16)) * 64)
    bf16x8 kA[2][2], kB[2][2];
#pragma unroll
    for (int i = 0; i < 2; ++i) { const bf16_t* kp = NA_KPTR(i); kA[i][0] = *(const bf16x8*)kp; kA[i][1] = *(const bf16x8*)(kp + 256); }
#pragma unroll
    for (int tb = 0; tb < 32; tb += 4) {
#pragma unroll
      for (int i = 0; i < 2; ++i) { const bf16_t* kp = NA_KPTR(tb + 2 + i); kB[i][0] = *(const bf16x8*)kp; kB[i][1] = *(const bf16x8*)(kp + 256); }
#pragma unroll
      for (int i = 0; i < 2; ++i) { asm volatile("" : "+v"(kA[i][0]), "+v"(kA[i][1])); }
#pragma unroll
      for (int i = 0; i < 2; ++i) {
        f32x4 z = (f32x4){0.f, 0.f, 0.f, 0.f};
        z = __builtin_amdgcn_mfma_f32_16x16x32_bf16(kA[i][0], qf0, z, 0, 0, 0);
        z = __builtin_amdgcn_mfma_f32_16x16x32_bf16(kA[i][1], qf1, z, 0, 0, 0);
        if (tb + i < 16) accS[(tb + i) & 15] = z; else accC[(tb + i) & 15] = z;
      }
      if (tb + 4 < 32) {
#pragma unroll
        for (int i = 0; i < 2; ++i) { const bf16_t* kp = NA_KPTR(tb + 4 + i); kA[i][0] = *(const bf16x8*)kp; kA[i][1] = *(const bf16x8*)(kp + 256); }
      }
#pragma unroll
      for (int i = 0; i < 2; ++i) { asm volatile("" : "+v"(kB[i][0]), "+v"(kB[i][1])); }
#pragma unroll
      for (int i = 0; i < 2; ++i) {
        f32x4 z = (f32x4){0.f, 0.f, 0.f, 0.f};
        z = __builtin_amdgcn_mfma_f32_16x16x32_bf16(kB[i][0], qf0, z, 0, 0, 0);
        z = __builtin_amdgcn_mfma_f32_16x16x32_bf16(kB[i][1], qf1, z, 0, 0, 0);
        if (tb + 2 + i < 16) accS[(tb + 2 + i) & 15] = z; else accC[(tb + 2 + i) & 15] = z;
      }
    }
#undef NA_KPTR
    const int cq = cq0 + li;
    int c0q = cq - 8; c0q = c0q < 0 ? 0 : (c0q > 48 ? 48 : c0q);
    float mx = -3.0e38f;
#pragma unroll
    for (int kt = 0; kt < 16; ++kt) {
      int bi[4]; bool okv[4]; float bv[4];
#pragma unroll
      for (int e = 0; e < 4; ++e) {
        const int ck = cs + 16 * (kt & 1) + 4 * g + e;
        okv[e] = lat && ck >= c0q && ck < c0q + 16;
        bi[e] = okv[e] ? (kt >> 1) * 32 + (ck - cq + 15) : 0;
      }
      asm volatile("" : "+v"(bi[0]), "+v"(bi[1]), "+v"(bi[2]), "+v"(bi[3]));
#pragma unroll
      for (int e = 0; e < 4; ++e) bv[e] = btab[bi[e]];
#pragma unroll
      for (int e = 0; e < 4; ++e) {
        const float s = okv[e] ? accS[kt][e] * 0.125f + bv[e] : -3.0e38f;
        accS[kt][e] = s;
        mx = fmaxf(mx, s);
      }
    }
#pragma unroll
    for (int ct = 0; ct < 16; ++ct)
#pragma unroll
      for (int e = 0; e < 4; ++e) { const float s = accC[ct][e] * 0.125f; accC[ct][e] = s; mx = fmaxf(mx, s); }
    mx = grp_max(mx);
    float sum = 0.f;
#pragma unroll
    for (int kt = 0; kt < 16; ++kt)
#pragma unroll
      for (int e = 0; e < 4; ++e) { const float p = __expf(accS[kt][e] - mx); accS[kt][e] = p; sum += p; }
#pragma unroll
    for (int ct = 0; ct < 16; ++ct)
#pragma unroll
      for (int e = 0; e < 4; ++e) { const float p = __expf(accC[ct][e] - mx); accC[ct][e] = p; sum += p; }
    sum = grp_sum(sum);
    const float inv = 1.f / sum;
    bf16x8 afL[8], afC[8];
#pragma unroll
    for (int kr = 0; kr < 8; ++kr) {
#pragma unroll
      for (int e = 0; e < 4; ++e) {
        afL[kr][e] = (short)f2bf(accS[2 * kr][e] * inv); afL[kr][4 + e] = (short)f2bf(accS[2 * kr + 1][e] * inv);
        afC[kr][e] = (short)f2bf(accC[2 * kr][e] * inv); afC[kr][4 + e] = (short)f2bf(accC[2 * kr + 1][e] * inv);
      }
    }
    f32x4 accO[4];
#pragma unroll
    for (int db = 0; db < 4; ++db) accO[db] = (f32x4){0.f, 0.f, 0.f, 0.f};
    const bf16_t* vl = P.vtl() + (size_t)(b * 8 + hd) * 64 * 4096 + li * 4;
    const bf16_t* vc = P.vtc() + (size_t)(b * 8 + hd) * 64 * 256 + li * 4;
#pragma unroll
    for (int kr = 0; kr < 8; ++kr) {
      const int tok = (r0 + kr) * 64 + cs + 4 * g;
      s16x4 lo[4], hi[4];
#pragma unroll
      for (int db = 0; db < 4; ++db) {
        const bf16_t* vp = vl + ((size_t)(tok >> 2) * 64 + db * 16) * 4;
        lo[db] = *(const s16x4*)vp; hi[db] = *(const s16x4*)(vp + 4 * 64 * 4);
      }
#pragma unroll
      for (int db = 0; db < 4; ++db) {
        const bf16x8 bfr = (bf16x8){lo[db][0], lo[db][1], lo[db][2], lo[db][3], hi[db][0], hi[db][1], hi[db][2], hi[db][3]};
        accO[db] = __builtin_amdgcn_mfma_f32_16x16x32_bf16(afL[kr], bfr, accO[db], 0, 0, 0);
      }
    }
#pragma unroll
    for (int t = 0; t < 8; ++t) {
      const int tok = 32 * t + 4 * g;
      s16x4 lo[4], hi[4];
#pragma unroll
      for (int db = 0; db < 4; ++db) {
        const bf16_t* vp = vc + ((size_t)(tok >> 2) * 64 + db * 16) * 4;
        lo[db] = *(const s16x4*)vp; hi[db] = *(const s16x4*)(vp + 4 * 64 * 4);
      }
#pragma unroll
      for (int db = 0; db < 4; ++db) {
        const bf16x8 bfr = (bf16x8){lo[db][0], lo[db][1], lo[db][2], lo[db][3], hi[db][0], hi[db][1], hi[db][2], hi[db][3]};
        accO[db] = __builtin_amdgcn_mfma_f32_16x16x32_bf16(afC[t], bfr, accO[db], 0, 0, 0);
      }
    }
    {
      bf16_t* stg = (bf16_t*)(smem + 32768) + wv * (16 * 72);
#pragma unroll
      for (int db = 0; db < 4; ++db)
#pragma unroll
        for (int e = 0; e < 4; ++e) stg[(4 * g + e) * 72 + 16 * db + li] = f2bf(accO[db][e]);
      __builtin_amdgcn_wave_barrier();
#pragma unroll
      for (int i = 0; i < 2; ++i) {
        const int c = i * 64 + lane, rr = c >> 3, c8 = (c & 7) * 8;
        *(uint4*)(P.concat() + (size_t)(qrow0 + rr) * 2048 + 1536 + hd * 64 + c8) = *(const uint4*)(stg + rr * 72 + c8);
      }
      __builtin_amdgcn_wave_barrier();
    }
  }
}

__device__ __forceinline__ uint32_t mono_u(float f) { const uint32_t u = __float_as_uint(f); return u ^ ((uint32_t)((int)u >> 31) | 0x80000000u); }
__device__ __forceinline__ float unmono_f(uint32_t m) { return __uint_as_float((m & 0x80000000u) ? (m ^ 0x80000000u) : ~m); }
__device__ __forceinline__ uint32_t grp_max_u(uint32_t v) {
  auto a = __builtin_amdgcn_permlane16_swap(v, v, false, false);
  v = a[0] > a[1] ? a[0] : a[1];
  auto b = __builtin_amdgcn_permlane32_swap(v, v, false, false);
  return b[0] > b[1] ? b[0] : b[1];
}

template <int N>
__device__ __forceinline__ void bitonic_sort_desc(uint32_t (&a)[N], int base = 0) { (void)base;
#pragma unroll
  for (int k = 2; k <= N; k <<= 1)
#pragma unroll
    for (int j = k >> 1; j > 0; j >>= 1)
#pragma unroll
      for (int i = 0; i < N; ++i) {
        const int l = i ^ j;
        if (l > i) {
          const bool desc = (i & k) == 0;
          const uint32_t hi = a[i] > a[l] ? a[i] : a[l], lo = a[i] > a[l] ? a[l] : a[i];
          a[i] = desc ? hi : lo; a[l] = desc ? lo : hi;
        }
      }
}
template <int N>
__device__ __forceinline__ void bitonic_merge_desc(uint32_t (&a)[N]) {
#pragma unroll
  for (int j = N >> 1; j > 0; j >>= 1)
#pragma unroll
    for (int i = 0; i < N; ++i) {
      const int l = i ^ j;
      if (l > i) {
        const uint32_t hi = a[i] > a[l] ? a[i] : a[l], lo = a[i] > a[l] ? a[l] : a[i];
        a[i] = hi; a[l] = lo;
      }
    }
}
__device__ __forceinline__ void merge4_top16(uint32_t (&a)[16]) {
  uint32_t e[16], o[16];
#pragma unroll
  for (int i = 0; i < 16; ++i) { auto r = __builtin_amdgcn_permlane16_swap(a[i], a[i], false, false); e[i] = r[0]; o[i] = r[1]; }
#pragma unroll
  for (int i = 0; i < 16; ++i) a[i] = e[i] > o[15 - i] ? e[i] : o[15 - i];
  bitonic_merge_desc<16>(a);
#pragma unroll
  for (int i = 0; i < 16; ++i) { auto r = __builtin_amdgcn_permlane32_swap(a[i], a[i], false, false); e[i] = r[0]; o[i] = r[1]; }
#pragma unroll
  for (int i = 0; i < 16; ++i) a[i] = e[i] > o[15 - i] ? e[i] : o[15 - i];
  bitonic_merge_desc<16>(a);
}
__device__ void ph_peer_topk_mfma(int wv, const Params& P, int layer, int nrows, char* smem, int bid, int nb) {
  const int tid = otid(wv), lane = tid & 63, li = lane & 15, g = lane >> 4;
  unsigned char* ctab = (unsigned char*)smem;
  float* vals = (float*)(smem + 256) + wv * 512;
  int* idxs = (int*)(smem + 256 + 8 * 2048) + wv * 512;
  __syncthreads();
  if (tid < 64) ctab[tid] = 0xFF;
  __syncthreads();
  if (tid < 256) {
    const int a = tid >> 4, b = tid & 15;
    if ((a + 1) * (b + 1) <= 16) {
      int n = b;
#pragma unroll 1
      for (int a2 = 0; a2 < a; ++a2) n += (int)(16.f * __builtin_amdgcn_rcpf((float)(a2 + 1)) + 0.01f);
      ctab[(n & 3) * 16 + (n >> 2)] = (unsigned char)(a * 16 + b);
    }
  }
  const int hd = bid & 7, tg = bid >> 3, ngroups = nb >> 3;
  char* ksm = smem + 33280;
  {
    const bf16_t* ksrc = P.keysb() + (size_t)(layer * 8 + hd) * 2 * 128 * 128;
#pragma unroll
    for (int i = 0; i < 8; ++i) {
      const int idx = tid + i * 512, r = idx >> 4, sg = idx & 15;
      *(uint4*)(ksm + (r * 136 + sg * 8) * 2) = *(const uint4*)(ksrc + (size_t)r * 128 + sg * 8);
    }
  }
  __syncthreads();
  uint32_t cab[16];
#pragma unroll
  for (int s = 0; s < 16; ++s) cab[s] = ctab[g * 16 + s];
  const int ntile = nrows / 16;
  for (int tile = tg + ngroups * wv; tile < ntile && tg < ngroups; tile += ngroups * NWAVE) {
    const int row0 = tile * 16;
    const bf16_t* qp = P.q() + (size_t)(row0 + li) * 2048 + hd * 256 + 8 * g;
    uint32_t win[2][16];
#pragma unroll
    for (int half = 0; half < 2; ++half) {
      bf16x8 qf[4];
#pragma unroll
      for (int t = 0; t < 4; ++t) qf[t] = *(const bf16x8*)(qp + half * 128 + 32 * t);
      const char* kb = ksm + ((half * 128 + li) * 136 + 8 * g) * 2;
      uint32_t pk[32];
#pragma unroll
      for (int kt = 0; kt < 8; ++kt) {
        f32x4 acc = (f32x4){0.f, 0.f, 0.f, 0.f};
#pragma unroll
        for (int t = 0; t < 4; ++t) {
          const bf16x8 a = *(const bf16x8*)(kb + (kt * 16 * 136 + 32 * t) * 2);
          acc = __builtin_amdgcn_mfma_f32_16x16x32_bf16(a, qf[t], acc, 0, 0, 0);
        }
#pragma unroll
        for (int e = 0; e < 4; ++e) pk[kt * 4 + e] = (mono_u(acc[e]) & ~127u) | (uint32_t)(16 * kt + 4 * g + e);
      }
      {
        uint32_t lo16[16], hi16[16];
#pragma unroll
        for (int i = 0; i < 16; ++i) { lo16[i] = pk[i]; hi16[i] = pk[16 + i]; }
        bitonic_sort_desc<16>(lo16);
        bitonic_sort_desc<16>(hi16);
#pragma unroll
        for (int i = 0; i < 16; ++i) lo16[i] = lo16[i] > hi16[15 - i] ? lo16[i] : hi16[15 - i];
        bitonic_merge_desc<16>(lo16);
        merge4_top16(lo16);
#pragma unroll
        for (int r = 0; r < 16; ++r) win[half][r] = lo16[r];
      }
    }
    if (g == 0) {
#pragma unroll
      for (int half = 0; half < 2; ++half)
#pragma unroll
        for (int r = 0; r < 16; ++r) {
          vals[li * 32 + half * 16 + r] = unmono_f(win[half][r] & ~127u);
          idxs[li * 32 + half * 16 + r] = (int)(win[half][r] & 127u);
        }
    }
    __builtin_amdgcn_wave_barrier();
    uint32_t cp[16];
    {
      float va[16], vb[16];
#pragma unroll
      for (int s = 0; s < 16; ++s) {
        const uint32_t ab = cab[s] == 0xFFu ? 0u : cab[s];
        va[s] = vals[li * 32 + (ab >> 4)]; vb[s] = vals[li * 32 + 16 + (ab & 15u)];
      }
#pragma unroll
      for (int s = 0; s < 16; ++s) cp[s] = cab[s] == 0xFFu ? 0u : ((mono_u(va[s] + vb[s]) & ~255u) | cab[s]);
    }
    bitonic_sort_desc<16>(cp);
    merge4_top16(cp);
    uint32_t cw[16];
#pragma unroll
    for (int r = 0; r < 16; ++r) cw[r] = cp[r];
    const float mx = unmono_f(cw[0] & ~255u);
    float sum = 0.f;
#pragma unroll
    for (int r = 0; r < 16; ++r) sum += __expf(unmono_f(cw[r] & ~255u) - mx);
    const float inv = 1.f / sum;
    const size_t ob = (size_t)(row0 + li) * 128 + hd * 16 + 4 * g;
    int si[4]; float sg[4];
    const uint32_t m1 = 0u - (uint32_t)(g & 1), m2 = 0u - (uint32_t)((g >> 1) & 1);
#pragma unroll
    for (int e = 0; e < 4; ++e) {
      const uint32_t c01 = (cw[4 + e] & m1) | (cw[e] & ~m1), c23 = (cw[12 + e] & m1) | (cw[8 + e] & ~m1);
      const uint32_t cs_ = (c23 & m2) | (c01 & ~m2), ab = cs_ & 255u;
      si[e] = idxs[li * 32 + (ab >> 4)] * 128 + idxs[li * 32 + 16 + (ab & 15u)];
      sg[e] = __expf(unmono_f(cs_ & ~255u) - mx) * inv;
    }
    *(u32x4_t*)(P.sel_idx() + ob) = (u32x4_t){(uint32_t)si[0], (uint32_t)si[1], (uint32_t)si[2], (uint32_t)si[3]};
    *(f32x4*)(P.sel_g() + ob) = (f32x4){sg[0], sg[1], sg[2], sg[3]};
    __builtin_amdgcn_wave_barrier();
  }
}

__device__ __forceinline__ void cvt8(const uint32_t w, float* f) {
  const f32x2_t a = __builtin_amdgcn_cvt_scalef32_pk_f32_fp4(w, 1.0f, 0), b = __builtin_amdgcn_cvt_scalef32_pk_f32_fp4(w, 1.0f, 1);
  const f32x2_t c = __builtin_amdgcn_cvt_scalef32_pk_f32_fp4(w, 1.0f, 2), e = __builtin_amdgcn_cvt_scalef32_pk_f32_fp4(w, 1.0f, 3);
  f[0] = a.x; f[1] = a.y; f[2] = b.x; f[3] = b.y; f[4] = c.x; f[5] = c.y; f[6] = e.x; f[7] = e.y;
}
__device__ __forceinline__ float swap16_add(float a, float b) {
  auto r = __builtin_amdgcn_permlane16_swap(__float_as_uint(a), __float_as_uint(b), false, false);
  return __uint_as_float(r[0]) + __uint_as_float(r[1]);
}
typedef int i32x8_t __attribute__((ext_vector_type(8)));
typedef _Float16 h2_t __attribute__((ext_vector_type(2)));
__device__ __forceinline__ void ph_peer_dots(int wv, const Params& P, int layer, int row_b, int row_e, int nb) {
#pragma unroll 1
  for (int row = row_b; row < row_e; row += nb * NWAVE) {
    const int lane = otid(wv) & 63, n = lane & 15, g = lane >> 4;
    const bool hsel = (lane & 8) != 0;
    const unsigned char* TU = P.tabU();
    const uint32_t tuo = (uint32_t)(8 * g + (lane & 7)) * 16u;
    i32x8_t xa;
    {
      const bf16_t* xp = P.u() + (size_t)row * DM + 32 * (8 * g + (lane & 7));
      float xv[32];
      unpack8(*(const uint4*)xp, xv); unpack8(*(const uint4*)(xp + 8), xv + 8);
      unpack8(*(const uint4*)(xp + 16), xv + 16); unpack8(*(const uint4*)(xp + 24), xv + 24);
#pragma unroll
      for (int r = 0; r < 4; ++r) {
        uint32_t hw = 0u, lw = 0u;
        float fh[8];
#pragma unroll
        for (int bsel = 0; bsel < 4; ++bsel) {
          if (bsel == 0) hw = __builtin_amdgcn_cvt_scalef32_pk_fp4_f32(hw, xv[8 * r + 0], xv[8 * r + 1], 1.0f, 0);
          if (bsel == 1) hw = __builtin_amdgcn_cvt_scalef32_pk_fp4_f32(hw, xv[8 * r + 2], xv[8 * r + 3], 1.0f, 1);
          if (bsel == 2) hw = __builtin_amdgcn_cvt_scalef32_pk_fp4_f32(hw, xv[8 * r + 4], xv[8 * r + 5], 1.0f, 2);
          if (bsel == 3) hw = __builtin_amdgcn_cvt_scalef32_pk_fp4_f32(hw, xv[8 * r + 6], xv[8 * r + 7], 1.0f, 3);
        }
        cvt8(hw, fh);
        lw = __builtin_amdgcn_cvt_scalef32_pk_fp4_f32(lw, (xv[8 * r + 0] - fh[0]) * 8.f, (xv[8 * r + 1] - fh[1]) * 8.f, 1.0f, 0);
        lw = __builtin_amdgcn_cvt_scalef32_pk_fp4_f32(lw, (xv[8 * r + 2] - fh[2]) * 8.f, (xv[8 * r + 3] - fh[3]) * 8.f, 1.0f, 1);
        lw = __builtin_amdgcn_cvt_scalef32_pk_fp4_f32(lw, (xv[8 * r + 4] - fh[4]) * 8.f, (xv[8 * r + 5] - fh[5]) * 8.f, 1.0f, 2);
        lw = __builtin_amdgcn_cvt_scalef32_pk_fp4_f32(lw, (xv[8 * r + 6] - fh[6]) * 8.f, (xv[8 * r + 7] - fh[7]) * 8.f, 1.0f, 3);
        xa[r] = (int)((n & 8) ? lw : hw);
        xa[4 + r] = 0;
      }
    }
    const int idx0 = P.sel_idx()[(size_t)row * 128 + lane], idx1 = P.sel_idx()[(size_t)row * 128 + 64 + lane];
    const float gt0 = P.sel_g()[(size_t)row * 128 + lane] * P.invV()[idx0], gt1 = P.sel_g()[(size_t)row * 128 + 64 + lane] * P.invV()[idx1];
    const float iu0 = P.invU()[idx0], iu1 = P.invU()[idx1];
    const float cs = ((g & 1) == ((n >> 2) & 1)) ? (g >= 2 ? (1.f / 8.f) : 1.f) : 0.f;
    const int lkey = lane & 0x37;
    float d0 = 0.f, d1 = 0.f;
    u32x4_t bufA[8], bufB[8], bufC[8], bufD[8];
#define PG_LOAD(buf, T, m0) do { _Pragma("unroll") for (int j = 0; j < 8; ++j) { \
      const int m_ = (m0) + j; const int src_ = m_ < 32 ? idx0 : idx1; const int kA_ = (m_ & 7) + 16 * ((m_ >> 3) & 3); \
      const int elo_ = __builtin_amdgcn_readlane(src_, kA_), ehi_ = __builtin_amdgcn_readlane(src_, kA_ + 8); \
      buf[j] = *(const u32x4_t*)(T + (((uint32_t)(hsel ? ehi_ : elo_) << 9) + tuo)); } } while (0)
#define PG_DOT(buf, m0) do { _Pragma("unroll") for (int j = 0; j < 8; ++j) { \
      const int m_ = (m0) + j; const int kA_ = (m_ & 7) + 16 * ((m_ >> 3) & 3); \
      const i32x8_t b_ = {(int)buf[j].x, (int)buf[j].y, (int)buf[j].z, (int)buf[j].w, 0, 0, 0, 0}; \
      const f32x4 acc_ = __builtin_amdgcn_mfma_scale_f32_16x16x128_f8f6f4(xa, b_, (f32x4){0.f, 0.f, 0.f, 0.f}, 4, 4, 0, 0x7F7F7F7F, 0, 0x7F7F7F7F); \
      float w_ = (n & 2) ? ((n & 1) ? acc_[3] : acc_[2]) : ((n & 1) ? acc_[1] : acc_[0]); \
      w_ *= cs; \
      w_ += DPP_F(w_, 0xB1); w_ += DPP_F(w_, 0x4E); w_ += DPP_F(w_, 0x141); \
      { auto r_ = __builtin_amdgcn_permlane32_swap(__float_as_uint(w_), __float_as_uint(w_), false, false); w_ = __uint_as_float(r_[0]) + __uint_as_float(r_[1]); } \
      { auto r_ = __builtin_amdgcn_permlane16_swap(__float_as_uint(w_), __float_as_uint(w_), false, false); w_ = __uint_as_float(r_[0]) + __uint_as_float(r_[1]); } \
      if (m_ < 32) d0 = (lkey == kA_) ? w_ : d0; else d1 = (lkey == kA_) ? w_ : d1; } } while (0)
    PG_LOAD(bufA, TU, 0); PG_LOAD(bufB, TU, 8); PG_LOAD(bufC, TU, 16);
    PG_LOAD(bufD, TU, 24); PG_DOT(bufA, 0);
    PG_LOAD(bufA, TU, 32); PG_DOT(bufB, 8);
    PG_LOAD(bufB, TU, 40); PG_DOT(bufC, 16);
    PG_LOAD(bufC, TU, 48); PG_DOT(bufD, 24);
    PG_LOAD(bufD, TU, 56); PG_DOT(bufA, 32);
    PG_DOT(bufB, 40); PG_DOT(bufC, 48); PG_DOT(bufD, 56);
    P.sel_g()[(size_t)row * 128 + lane] = gelu_f(d0 * iu0) * gt0;
    P.sel_g()[(size_t)row * 128 + 64 + lane] = gelu_f(d1 * iu1) * gt1;
#undef PG_LOAD
#undef PG_DOT
  }
}
__device__ __forceinline__ void ph_peer_acc(int wv, const Params& P, int layer, int row_b, int row_e, int nb) {
#pragma unroll 1
  for (int row = row_b; row < row_e; row += nb * NWAVE) {
    const int lane = otid(wv) & 63, l5 = lane & 31;
    const bool up = lane >= 32;
    const unsigned char* TV = P.tabV();
    const uint32_t tvo = (uint32_t)l5 * 16u;
    float o[32];
    const int idx0 = P.sel_idx()[(size_t)row * 128 + lane], idx1 = P.sel_idx()[(size_t)row * 128 + 64 + lane];
    const _Float16 act0 = (_Float16)P.sel_g()[(size_t)row * 128 + lane], act1 = (_Float16)P.sel_g()[(size_t)row * 128 + 64 + lane];
    h2_t o2[16];
    uint4 bufA[8], bufB[8];
#define PG_LOAD(buf, T, kk) do { _Pragma("unroll") for (int j = 0; j < 8; ++j) { \
      const int k_ = (kk) + 2 * j; const int src_ = k_ < 64 ? idx0 : idx1; \
      const int elo_ = __builtin_amdgcn_readlane(src_, k_ & 63), ehi_ = __builtin_amdgcn_readlane(src_, (k_ & 63) + 1); \
      buf[j] = *(const uint4*)(T + (((uint32_t)(up ? ehi_ : elo_) << 9) + tvo)); } } while (0)
    PG_LOAD(bufA, TV, 0);
#pragma unroll
    for (int i = 0; i < 32; ++i) o[i] = 0.f;
#pragma unroll
    for (int i = 0; i < 16; ++i) o2[i] = (h2_t){(_Float16)0.f, (_Float16)0.f};
#define PG_ACC(buf, kk) do { _Pragma("unroll") for (int j = 0; j < 8; ++j) { const int k_ = (kk) + 2 * j; \
      const int asrc_ = (int)__builtin_bit_cast(unsigned short, k_ < 64 ? act0 : act1); \
      const int alo_ = __builtin_amdgcn_readlane(asrc_, k_ & 63), ahi_ = __builtin_amdgcn_readlane(asrc_, (k_ & 63) + 1); \
      const _Float16 ah_ = __builtin_bit_cast(_Float16, (unsigned short)(up ? ahi_ : alo_)); const h2_t a2_ = {ah_, ah_}; \
      const uint32_t w_[4] = {buf[j].x, buf[j].y, buf[j].z, buf[j].w}; \
      _Pragma("unroll") for (int d = 0; d < 4; ++d) { uint32_t wd_ = w_[d]; asm volatile("" : "+v"(wd_) : "v"(o2[(d * 4 + 15) & 15])); \
        o2[d * 4 + 0] = __builtin_elementwise_fma(__builtin_bit_cast(h2_t, __builtin_amdgcn_cvt_scalef32_pk_f16_fp4(wd_, 1.0f, 0)), a2_, o2[d * 4 + 0]); \
        o2[d * 4 + 1] = __builtin_elementwise_fma(__builtin_bit_cast(h2_t, __builtin_amdgcn_cvt_scalef32_pk_f16_fp4(wd_, 1.0f, 1)), a2_, o2[d * 4 + 1]); \
        o2[d * 4 + 2] = __builtin_elementwise_fma(__builtin_bit_cast(h2_t, __builtin_amdgcn_cvt_scalef32_pk_f16_fp4(wd_, 1.0f, 2)), a2_, o2[d * 4 + 2]); \
        o2[d * 4 + 3] = __builtin_elementwise_fma(__builtin_bit_cast(h2_t, __builtin_amdgcn_cvt_scalef32_pk_f16_fp4(wd_, 1.0f, 3)), a2_, o2[d * 4 + 3]); } } } while (0)
#pragma unroll 1
    for (int kk = 0; kk < 128; kk += 32) {
      PG_LOAD(bufB, TV, kk + 16);
      PG_ACC(bufA, kk);
      if (kk + 32 < 128) PG_LOAD(bufA, TV, kk + 32);
      PG_ACC(bufB, kk + 16);
    }
#undef PG_LOAD
#undef PG_ACC
#pragma unroll
    for (int i = 0; i < 16; ++i) { o[2 * i] = (float)o2[i].x; o[2 * i + 1] = (float)o2[i].y; }
#pragma unroll
    for (int i = 0; i < 32; ++i) {
      auto r = __builtin_amdgcn_permlane32_swap(__float_as_uint(o[i]), __float_as_uint(o[i]), false, false);
      o[i] = __uint_as_float(r[0]) + __uint_as_float(r[1]);
    }
    const int lane_e = otid(wv) & 63, l5e = lane_e & 31;
    const bool upe = lane_e >= 32;
    const float* gate = P.mod() + (size_t)(layer * 5 + modrow(row)) * MODW + 5120 + l5e * 32;
    float* hr = P.h() + (size_t)row * DM + l5e * 32;
    float ss = 0.f;
    f32x4 hvv[8], ggv[8];
#pragma unroll
    for (int q = 0; q < 8; ++q) { hvv[q] = *(const f32x4*)(hr + q * 4); ggv[q] = *(const f32x4*)(gate + q * 4); }
#pragma unroll
    for (int q = 0; q < 8; ++q) asm volatile("" : "+v"(hvv[q]), "+v"(ggv[q]));
#pragma unroll
    for (int q = 0; q < 8; ++q) {
      float4 hv = make_float4(hvv[q][0], hvv[q][1], hvv[q][2], hvv[q][3]);
      const float4 gg = make_float4(ggv[q][0], ggv[q][1], ggv[q][2], ggv[q][3]);
      hv.x += gg.x * o[q * 4 + 0]; hv.y += gg.y * o[q * 4 + 1]; hv.z += gg.z * o[q * 4 + 2]; hv.w += gg.w * o[q * 4 + 3];
      if (layer == 0 && !upe) *(float4*)(hr + q * 4) = hv;
      o[q * 4 + 0] = hv.x; o[q * 4 + 1] = hv.y; o[q * 4 + 2] = hv.z; o[q * 4 + 3] = hv.w;
      if (!upe) ss += hv.x * hv.x + hv.y * hv.y + hv.z * hv.z + hv.w * hv.w;
    }
    ss = wave_sum(ss);
    const float rstd = rsqrtf(ss * (1.f / 1024.f) + 1e-6f);
    if (layer == 0) {
      const float* g1 = P.norm1_g + 1024 + l5e * 32;
      const float* mr = P.mod() + (size_t)(5 + modrow(row)) * MODW + l5e * 32;
      if (!upe) {
#pragma unroll
        for (int q = 0; q < 4; ++q) {
          float ov[8];
#pragma unroll
          for (int e = 0; e < 8; ++e) ov[e] = o[q * 8 + e] * rstd * g1[q * 8 + e] * (1.f + mr[1024 + q * 8 + e]) + mr[q * 8 + e];
          *(uint4*)(P.u() + (size_t)row * DM + l5e * 32 + q * 8) = make_uint4(pack2(ov[0], ov[1]), pack2(ov[2], ov[3]), pack2(ov[4], ov[5]), pack2(ov[6], ov[7]));
        }
      }
    } else {
      const float* gf = P.final_g + l5e * 32;
      if (!upe) {
#pragma unroll
        for (int q = 0; q < 8; ++q) {
          const float4 gg = *(const float4*)(gf + q * 4);
          *(float4*)(P.out + (size_t)row * DM + l5e * 32 + q * 4) =
              make_float4(o[q * 4] * rstd * gg.x, o[q * 4 + 1] * rstd * gg.y, o[q * 4 + 2] * rstd * gg.z, o[q * 4 + 3] * rstd * gg.w);
        }
      }
    }
  }
}

struct EpiOutproj {
  static constexpr bool PERM = false, AFTER_DRAIN = false;
  static constexpr int MIDK_T = 16;
  float* H; const float* hl; const float* hc; const float* modl;
  const float* yss;
  __device__ __forceinline__ void midk(pg8::f32x4 (&acc)[2][2][4][2], const pg8::Unit& u, int wr, int wc, int fr, int fq) const {
    const int row0 = u.pm * 256 + wr * 64 + fr;
#pragma unroll
    for (int ai = 0; ai < 2; ++ai)
#pragma unroll
      for (int m = 0; m < 4; ++m) {
        const pg8::f32x4* yp = (const pg8::f32x4*)(yss + (size_t)(row0 + ai * 128 + m * 16) * 16);
        const pg8::f32x4 y4 = (yp[0] + yp[1]) + (yp[2] + yp[3]);
        const float rstd = rsqrtf(((y4[0] + y4[1]) + (y4[2] + y4[3])) * (1.f / 1024.f) + 1e-6f);
#pragma unroll
        for (int bj = 0; bj < 2; ++bj)
#pragma unroll
          for (int n = 0; n < 2; ++n) acc[ai][bj][m][n] *= rstd;
      }
  }
  __device__ __forceinline__ void operator()(const pg8::f32x4 (&acc)[2][2][4][2], const pg8::Unit& u, int wr, int wc, int fr, int fq) const {
    const int row0 = u.pm * 256 + wr * 64 + fr, col0 = u.pn * 256 + wc * 32 + 4 * fq;
    const float* gate = modl + (size_t)modrow(row0) * MODW + 2048 + col0;
    pg8::f32x4 gv[2][2];
#pragma unroll
    for (int bj = 0; bj < 2; ++bj)
#pragma unroll
      for (int n = 0; n < 2; ++n) gv[bj][n] = *(const pg8::f32x4*)(gate + bj * 128 + n * 16);
    pg8::f32x4 sA[4], sB[4];
#define EO_LOAD(dstv, ai_, m_) do { const float* s_ = hrow(hl, hc, row0 + (ai_) * 128 + (m_) * 16) + col0; \
      dstv[0] = *(const pg8::f32x4*)(s_); dstv[1] = *(const pg8::f32x4*)(s_ + 16); dstv[2] = *(const pg8::f32x4*)(s_ + 128); dstv[3] = *(const pg8::f32x4*)(s_ + 144); } while (0)
#define EO_STORE(srcv, ai_, m_) do { asm volatile("" : "+v"(srcv[0]), "+v"(srcv[1]), "+v"(srcv[2]), "+v"(srcv[3])); \
      float* d_ = H + (size_t)(row0 + (ai_) * 128 + (m_) * 16) * DM + col0; \
      *(pg8::f32x4*)(d_) = srcv[0] + gv[0][0] * acc[ai_][0][m_][0]; *(pg8::f32x4*)(d_ + 16) = srcv[1] + gv[0][1] * acc[ai_][0][m_][1]; \
      *(pg8::f32x4*)(d_ + 128) = srcv[2] + gv[1][0] * acc[ai_][1][m_][0]; *(pg8::f32x4*)(d_ + 144) = srcv[3] + gv[1][1] * acc[ai_][1][m_][1]; } while (0)
    EO_LOAD(sA, 0, 0);
#pragma unroll
    for (int i = 0; i < 8; i += 2) {
      EO_LOAD(sB, (i + 1) >> 2, (i + 1) & 3);
      EO_STORE(sA, i >> 2, i & 3);
      if (i + 2 < 8) EO_LOAD(sA, (i + 2) >> 2, (i + 2) & 3);
      EO_STORE(sB, (i + 1) >> 2, (i + 1) & 3);
    }
#undef EO_LOAD
#undef EO_STORE
  }
};

template <int MODE>
__device__ void ctx_tile(int wv, const Params& P, int layer, char* smem, int tm, int tn, const bf16_t* __restrict__ A,
                         const bf16_t* __restrict__ Bt, const int K, const float* hc) {
  const int tid = otid(wv), lane = tid & 63, li = lane & 15, g = lane >> 4;
  const int kw = K >> 3;
  const bf16_t* ap = A + (size_t)(tm * 64 + li) * K + wv * kw + 8 * g;
  const bf16_t* bp = Bt + (size_t)(tn * 64 + li) * K + wv * kw + 8 * g;
  f32x4 acc[4][4];
#pragma unroll
  for (int mi = 0; mi < 4; ++mi)
#pragma unroll
    for (int ni = 0; ni < 4; ++ni) acc[mi][ni] = (f32x4){0.f, 0.f, 0.f, 0.f};
  bf16x8 fa0[4], fb0[4], fa1[4], fb1[4];
#define CT_LOAD(fa, fb, s) do { _Pragma("unroll") for (int i = 0; i < 4; ++i) { \
    fa[i] = *(const bf16x8*)(ap + (size_t)(16 * i) * K + (s) * 32); fb[i] = *(const bf16x8*)(bp + (size_t)(16 * i) * K + (s) * 32); } } while (0)
#define CT_MMA(fa, fb) do { _Pragma("unroll") for (int mi = 0; mi < 4; ++mi) _Pragma("unroll") for (int ni = 0; ni < 4; ++ni) \
    acc[mi][ni] = __builtin_amdgcn_mfma_f32_16x16x32_bf16(fb[ni], fa[mi], acc[mi][ni], 0, 0, 0); } while (0)
  const int steps = kw >> 5;
  CT_LOAD(fa0, fb0, 0);
#pragma unroll 1
  for (int s = 0; s < steps; s += 2) {
    CT_LOAD(fa1, fb1, s + 1);
    CT_MMA(fa0, fb0);
    if (s + 2 < steps) CT_LOAD(fa0, fb0, s + 2);
    CT_MMA(fa1, fb1);
  }
#undef CT_LOAD
#undef CT_MMA
  float* part = (float*)smem + wv * 4096;
#pragma unroll
  for (int mi = 0; mi < 4; ++mi)
#pragma unroll
    for (int ni = 0; ni < 4; ++ni) *(f32x4*)(part + (16 * mi + li) * 64 + (((4 * ni + g) ^ li) * 4)) = acc[mi][ni];
  __syncthreads();
  {
    const int row = tid >> 3, c4 = (tid & 7) * 2;
    const float* p0 = (const float*)smem + row * 64 + (((c4) ^ (row & 15)) * 4);
    const float* p1 = (const float*)smem + row * 64 + (((c4 + 1) ^ (row & 15)) * 4);
    f32x4 sa0 = (f32x4){0.f, 0.f, 0.f, 0.f}, sa1 = sa0, sb0 = sa0, sb1 = sa0;
#pragma unroll
    for (int w = 0; w < 4; ++w) { sa0 += *(const f32x4*)(p0 + w * 4096); sa1 += *(const f32x4*)(p1 + w * 4096); }
#pragma unroll
    for (int w = 4; w < 8; ++w) { sb0 += *(const f32x4*)(p0 + w * 4096); sb1 += *(const f32x4*)(p1 + w * 4096); }
    const int grow = NLAT + tm * 64 + row, col = tn * 64 + c4 * 4;
    if (MODE == 0) {
      const f32x4* yp = (const f32x4*)(P.yss() + (size_t)grow * 16);
      const f32x4 y4 = (yp[0] + yp[1]) + (yp[2] + yp[3]);
      const float rstd = rsqrtf(((y4[0] + y4[1]) + (y4[2] + y4[3])) * (1.f / 1024.f) + 1e-6f);
      const float* gate = P.mod() + ((size_t)layer * 5 + 4) * MODW + 2048 + col;
      const float* hs = hc + (size_t)(grow - NLAT) * DM + col;
      float* hd = P.h() + (size_t)grow * DM + col;
      const f32x4 g0 = *(const f32x4*)gate, g1 = *(const f32x4*)(gate + 4);
      const f32x4 h0 = *(const f32x4*)hs, h1 = *(const f32x4*)(hs + 4);
      *(f32x4*)hd = h0 + g0 * (sa0 * rstd + sb0);
      *(f32x4*)(hd + 4) = h1 + g1 * (sa1 * rstd + sb1);
    } else {
      const f32x4 s0 = sa0 + sb0, s1 = sa1 + sb1;
      *(uint4*)(P.q() + (size_t)grow * 2048 + col) = make_uint4(pack2(s0[0], s0[1]), pack2(s0[2], s0[3]), pack2(s1[0], s1[1]), pack2(s1[2], s1[3]));
    }
  }
  __syncthreads();
}

__device__ __forceinline__ uint32_t fp4_code(float x, float sc) {
  const float a = fabsf(x) * sc;
  const uint32_t c = (uint32_t)(a > 0.25f) + (uint32_t)(a > 0.75f) + (uint32_t)(a > 1.25f) + (uint32_t)(a > 1.75f) +
                     (uint32_t)(a > 2.5f) + (uint32_t)(a > 3.5f) + (uint32_t)(a > 5.0f);
  return c | (x < 0.f ? 8u : 0u);
}
__device__ void ph_convert_tables(int wv, const Params& P, int layer, int bid, int nb) {
  const int lane = otid(wv) & 63;
  for (int it0 = (bid * NWAVE + wv) * 2; it0 < 2 * 16384; it0 += nb * NWAVE * 2) {
    f32x4 v[2][4];
#pragma unroll
    for (int rr = 0; rr < 2; ++rr) {
      const int it = it0 + rr, t = it >> 14, e = it & 16383;
      const float* src = (t == 0 ? P.peer_u : P.peer_v) + ((size_t)layer * 16384 + e) * 1024 + lane * 16;
#pragma unroll
      for (int i = 0; i < 4; ++i) v[rr][i] = ((const f32x4*)src)[i];
    }
#pragma unroll
    for (int rr = 0; rr < 2; ++rr)
#pragma unroll
      for (int i = 0; i < 4; ++i) asm volatile("" : "+v"(v[rr][i]));
#pragma unroll
    for (int rr = 0; rr < 2; ++rr) {
      const int it = it0 + rr, t = it >> 14, e = it & 16383;
      float m = 0.f;
#pragma unroll
      for (int i = 0; i < 4; ++i)
        m = fmaxf(m, fmaxf(fmaxf(fabsf(v[rr][i][0]), fabsf(v[rr][i][1])), fmaxf(fabsf(v[rr][i][2]), fabsf(v[rr][i][3]))));
      m = wave_max(m);
      m = fmaxf(m, 1e-30f);
      const float sc = 6.0f / m, inv = m * (1.0f / 6.0f);
      uint2 o;
      {
        uint32_t p0 = 0u, p1 = 0u;
        p0 = __builtin_amdgcn_cvt_scalef32_pk_fp4_f32(p0, v[rr][0][0] * sc, v[rr][0][1] * sc, 1.0f, 0);
        p0 = __builtin_amdgcn_cvt_scalef32_pk_fp4_f32(p0, v[rr][0][2] * sc, v[rr][0][3] * sc, 1.0f, 1);
        p0 = __builtin_amdgcn_cvt_scalef32_pk_fp4_f32(p0, v[rr][1][0] * sc, v[rr][1][1] * sc, 1.0f, 2);
        p0 = __builtin_amdgcn_cvt_scalef32_pk_fp4_f32(p0, v[rr][1][2] * sc, v[rr][1][3] * sc, 1.0f, 3);
        p1 = __builtin_amdgcn_cvt_scalef32_pk_fp4_f32(p1, v[rr][2][0] * sc, v[rr][2][1] * sc, 1.0f, 0);
        p1 = __builtin_amdgcn_cvt_scalef32_pk_fp4_f32(p1, v[rr][2][2] * sc, v[rr][2][3] * sc, 1.0f, 1);
        p1 = __builtin_amdgcn_cvt_scalef32_pk_fp4_f32(p1, v[rr][3][0] * sc, v[rr][3][1] * sc, 1.0f, 2);
        p1 = __builtin_amdgcn_cvt_scalef32_pk_fp4_f32(p1, v[rr][3][2] * sc, v[rr][3][3] * sc, 1.0f, 3);
        o.x = p0; o.y = p1;
      }
      *(uint2*)((t == 0 ? P.tabU() : P.tabV()) + (size_t)e * 512 + lane * 8) = o;
      if (lane == 0) (t == 0 ? P.invU() : P.invV())[e] = inv;
    }
  }
}

enum {
  PH_PREP = 0, PH_NORM1, PH_INPROJ, PH_CONV, PH_SSDPREP, PH_STATES, PH_SCAN, PH_SSDY, PH_SSDNORM, PH_POOL, PH_NA,
  PH_OUTPROJ, PH_NORM2, PH_QGEMM, PH_TOPK, PH_GATHER, PH_FINAL
};

#define SMEM_BYTES 135168

__device__ __forceinline__ void run_phase(int wv, const Params& P, int ph, int layer, char* smem, int bid, int nb) {
  const float* hl = layer == 0 ? P.x : P.h();
  const float* hc = layer == 0 ? P.ctx : P.h() + (size_t)NLAT * DM;
  const int nrows = layer == 0 ? NTOK : NLAT;
  switch (ph) {
    case PH_PREP:
      for (int i = bid * NTHR + otid(wv); i < 2 * 8 * 2 * 128 * 128; i += nb * NTHR) P.keysb()[i] = f2bf(P.peer_keys[i]);
      for (int i = bid * NTHR + otid(wv); i < 2 * 4 * 128 * 128; i += nb * NTHR) {
        const int k = i & 127, n = (i >> 7) & 127, lg = i >> 14;
        P.poolwT()[i] = f2bf(P.pool_w[((size_t)lg * 128 + k) * 128 + n]);
      }
      ph_mod(wv, P, (float*)smem, bid, nb);
      for (int l = 0; l < 2; ++l) {
        ph_transpose(wv, P.w_in + (size_t)l * 1024 * INW, P.w_inT() + (size_t)l * PW * 1024, 1024, INW, PW, 0, 2560, 32, PW, (float*)smem, bid, nb);
        ph_transpose(wv, P.w_in + (size_t)l * 1024 * INW, P.w_dtT() + (size_t)l * 128 * 1024, 1024, INW, 128, 2560, 1 << 30, 0, 32, (float*)smem, bid, nb);
        ph_transpose(wv, P.w_out + (size_t)l * 2048 * 1024, P.w_outT() + (size_t)l * 1024 * 2048, 2048, 1024, 1024, 0, 1 << 30, 0, 1024, (float*)smem, bid, nb,
                     P.ssd_norm_g + l * 1024, 1024);
        ph_transpose(wv, P.peer_wq + (size_t)l * 1024 * 2048, P.w_qT() + (size_t)l * 2048 * 1024, 1024, 2048, 2048, 0, 1 << 30, 0, 2048, (float*)smem, bid, nb);
      }
      break;
    case PH_NORM1:
      ph_norm(wv, hl, hc, P.norm1_g + layer * 1024, P.mod() + (size_t)layer * 5 * MODW, 0, 1024, NTOK, P.u(), bid, nb);
      break;
    case PH_INPROJ:
    {
      pg8::Gemm g{P.u(), P.w_inT() + (size_t)layer * PW * 1024, NTOK, PW, 1024};
      pg8::StaticOrder S; S.init(g.M, g.N, nb, bid);
      pg8::EpiBf16<0> E{P.p(), PW, nullptr, 0, 0};
      pg8::gemm_phase<pg8::EpiBf16<0>, pg8::StaticOrder, false>(wv, (PG8_LAS unsigned char*)smem, g, S, E, nullptr);
      {
        const int units = (NTOK / 256) * (PW / 256), rem = units % nb;
        const int nidle = rem == 0 ? nb : nb - rem, first_idle = rem == 0 ? 0 : rem;
        if (bid >= first_idle) ph_dtprep(wv, P, layer, smem, bid - first_idle, nidle);
      }
      break;
    }
    case PH_CONV: ph_conv(wv, P, layer, bid, nb); ph_vtranspose(wv, P, smem, bid, nb); break;
    case PH_STATES: ph_states_mfma(wv, P, layer, smem, bid, nb); break;
    case PH_SCAN: ph_scan(wv, P, bid, nb); break;
    case PH_SSDY: ph_ssdy_mfma(wv, P, layer, nrows / 128, smem, bid, nb); break;
    case PH_POOL: ph_pool_mfma(wv, P, layer, nrows, smem, bid, nb); break;
    case PH_NA: ph_na_mfma(wv, P, layer, nrows, smem, bid, nb); break;
    case PH_OUTPROJ:
    {
      pg8::Gemm g{P.concat(), P.w_outT() + (size_t)layer * 1024 * 2048, NLAT, 1024, 2048};
      pg8::StaticOrder S; S.init(g.M, g.N, nb, bid);
      EpiOutproj E{P.h(), hl, hc, P.mod() + (size_t)layer * 5 * MODW, P.yss()};
      pg8::gemm_phase<EpiOutproj, pg8::StaticOrder, false>(wv, (PG8_LAS unsigned char*)smem, g, S, E, nullptr);
      if (layer == 0)
        for (int t = bid; t < 16 * 16; t += nb)
          ctx_tile<0>(wv, P, layer, smem, t >> 4, t & 15, P.concat() + (size_t)NLAT * 2048, P.w_outT() + (size_t)layer * 1024 * 2048, 2048, hc);
      break;
    }
    case PH_NORM2:
      ph_norm(wv, P.h(), P.h() + (size_t)NLAT * DM, P.norm2_g + layer * 1024, P.mod() + (size_t)layer * 5 * MODW, 3072, 4096, nrows, P.u(), bid, nb);
      break;
    case PH_QGEMM:
    {
      pg8::Gemm g{P.u(), P.w_qT() + (size_t)layer * 2048 * 1024, NLAT, 2048, 1024};
      pg8::StaticOrder S; S.init(g.M, g.N, nb, bid);
      pg8::EpiBf16<0> E{P.q(), 2048, nullptr, 0, 0};
      pg8::gemm_phase<pg8::EpiBf16<0>, pg8::StaticOrder, false>(wv, (PG8_LAS unsigned char*)smem, g, S, E, nullptr);
      if (layer == 0)
        for (int t = bid; t < 16 * 32; t += nb)
          ctx_tile<1>(wv, P, layer, smem, t >> 5, t & 31, P.u() + (size_t)NLAT * 1024, P.w_qT() + (size_t)layer * 2048 * 1024, 1024, nullptr);
      ph_convert_tables(wv, P, layer, bid, nb);
      break;
    }
    case PH_TOPK: ph_peer_topk_mfma(wv, P, layer, nrows, smem, bid, nb); break;
    case PH_GATHER:
    {
      const int rb = bid * NWAVE + wv, rm0 = (wv >= 4) ? rb + 4 * (nb * NWAVE) : nrows, rm = rm0 < nrows ? rm0 : nrows;
#pragma unroll 1
      for (int hh = 0; hh < 2; ++hh) {
        ph_peer_dots(wv, P, layer, hh ? rm : rb, hh ? nrows : rm, nb);
        ph_peer_acc(wv, P, layer, hh ? rm : rb, hh ? nrows : rm, nb);
      }
      break;
    }
  }
}

namespace cg = cooperative_groups;
typedef const __attribute__((address_space(4))) Params* kparams_t;
__device__ __forceinline__ const Params& kp_fresh() {
  kparams_t kp = (kparams_t)__builtin_amdgcn_kernarg_segment_ptr();
  asm volatile("" : "+s"(kp));
  return *(const Params*)kp;
}
__global__ void __launch_bounds__(NTHR) k_mega(Params P_unused) {
  __shared__ __attribute__((aligned(16))) char smem[SMEM_BYTES + 16];
  cg::grid_group grid = cg::this_grid();
  const int bid = blockIdx.x, nb = gridDim.x;
  const int wv = __builtin_amdgcn_readfirstlane(threadIdx.x >> 6);
  if (threadIdx.x == 0) *(uint4*)(smem + SMEM_BYTES) = make_uint4(0u, 0u, 0u, 0u);
  __syncthreads();
  (void)xcd_barrier_post((unsigned*)(kp_fresh().ws + WS_BAR), (volatile LAS unsigned*)(smem + SMEM_BYTES), threadIdx.x == 0);
#define GSYNC() do { XcdBarrier xb_; xb_.bar = (unsigned*)(kp_fresh().ws + WS_BAR); xb_.x = xb_xcc_id(); \
    xb_.st = (volatile LAS unsigned*)(smem + SMEM_BYTES); xcd_barrier(xb_, otid(wv) == 0); } while (0)
  run_phase(wv, kp_fresh(), PH_PREP, 0, smem, bid, nb);
  if (nb == 0x7fffff00) grid.sync();
  GSYNC();
  run_phase(wv, kp_fresh(), PH_NORM1, 0, smem, bid, nb); GSYNC();
#pragma unroll 1
  for (int layer = 0; layer < 2; ++layer) {
    run_phase(wv, kp_fresh(), PH_INPROJ, layer, smem, bid, nb); GSYNC();
    run_phase(wv, kp_fresh(), PH_CONV, layer, smem, bid, nb);
    GSYNC();
    run_phase(wv, kp_fresh(), PH_STATES, layer, smem, bid, nb);
    run_phase(wv, kp_fresh(), PH_POOL, layer, smem, bid, nb);
    run_phase(wv, kp_fresh(), PH_NA, layer, smem, bid, nb); GSYNC();
    run_phase(wv, kp_fresh(), PH_SCAN, layer, smem, bid, nb); GSYNC();
    run_phase(wv, kp_fresh(), PH_SSDY, layer, smem, bid, nb); GSYNC();
    run_phase(wv, kp_fresh(), PH_OUTPROJ, layer, smem, bid, nb); GSYNC();
    run_phase(wv, kp_fresh(), PH_NORM2, layer, smem, bid, nb); GSYNC();
    run_phase(wv, kp_fresh(), PH_QGEMM, layer, smem, bid, nb); GSYNC();
    run_phase(wv, kp_fresh(), PH_TOPK, layer, smem, bid, nb); GSYNC();
    run_phase(wv, kp_fresh(), PH_GATHER, layer, smem, bid, nb);
    if (layer == 0) GSYNC();
  }
}

extern "C" void kernel_launch(void* const* d_in, const int* in_sizes, int n_in, void* d_out, int out_size, void* d_ws,
                              size_t ws_size, hipStream_t stream) {
  Params P{};
  const float* const* in = (const float* const*)d_in;
  P.x = in[0]; P.c = in[1]; P.ctx = in[2]; P.c_ctx = in[3]; P.ada_w = in[4]; P.ada_b = in[5]; P.norm1_g = in[6];
  P.w_in = in[7]; P.conv_w = in[8]; P.conv_b = in[9]; P.a_log = in[10]; P.dt_bias = in[11]; P.d_skip = in[12];
  P.ssd_norm_g = in[13]; P.pool_w = in[14]; P.pool_scale = in[15]; P.na_rpb = in[16]; P.w_out = in[17];
  P.norm2_g = in[18]; P.peer_wq = in[19]; P.peer_keys = in[20]; P.peer_u = in[21]; P.peer_v = in[22]; P.final_g = in[23];
  P.out = (float*)d_out;
  P.ws = (char*)d_ws;
  if (WS_TOTAL > ws_size) { fprintf(stderr, "workspace too small: need %zu have %zu\n", (size_t)WS_TOTAL, ws_size); return; }

  static int grid_blocks = 0;
  if (!grid_blocks) {
    int dev = 0, cus = 0, per_cu = 0;
    hipGetDevice(&dev);
    hipDeviceGetAttribute(&cus, hipDeviceAttributeMultiprocessorCount, dev);
    hipOccupancyMaxActiveBlocksPerMultiprocessor(&per_cu, k_mega, NTHR, 0);
    if (per_cu > 4) per_cu = 4;
    grid_blocks = cus * per_cu;
  }
  hipMemsetAsync((char*)d_ws + WS_BAR, 0, 4096 * 4, stream);
  void* args[] = {&P};
  hipError_t e = hipLaunchCooperativeKernel((void*)k_mega, dim3(grid_blocks), dim3(NTHR), args, 0, stream);
  if (e != hipSuccess) fprintf(stderr, "cooperative launch failed: %s (grid %d)\n", hipGetErrorString(e), grid_blocks);
}
```
